# Optimizing an MI355X kernel written in HIP

```python
import math
import jax, jax.numpy as jnp
from jax import lax
import numpy as np

D_MODEL = 1024
BATCH = 4
SEQ = 4096
DEPTH = 2

HEAD_DIM = 64
N_MIXERS = 4
N_HEADS_TOTAL = D_MODEL // HEAD_DIM
HPM = N_HEADS_TOTAL // N_MIXERS
GW = HPM * HEAD_DIM
MIX_WIDTH = GW * N_MIXERS
DIFF_QK_DIM = HEAD_DIM // 2
D_FF = 2816
CONV_WIDTH = 3
NUM_BUCKETS = 32
MAX_EXACT = NUM_BUCKETS // 2
MAX_DISTANCE = 128
N_BIAS_HEADS = 2 * HPM
Q_BLOCK = 128
CMP_LEN = 32
CMP_STRIDE = 16
SEL_LEN = 64
N_SEL = 16
WINDOW = 512
FORCED_SCORE = 1.0e4
NEG = -1.0e30
EPS = 1e-6

SPLIT_SIZES = (
    GW, GW, GW,
    GW, GW, GW, HPM,
    GW, GW, GW,
    GW, HEAD_DIM, HEAD_DIM, HEAD_DIM, HEAD_DIM, HEAD_DIM, HEAD_DIM, 3 * HPM,
)
P_IN = sum(SPLIT_SIZES)

kernel_name = "hymba_style_hybrid_diff_fox_stickbreak_nsa"


def _split_points(sizes):
    pts, acc = [], 0
    for s in sizes[:-1]:
        acc += s
        pts.append(acc)
    return pts


def rmsnorm(x, g):
    xf = x.astype(jnp.float32)
    y = xf * lax.rsqrt(jnp.mean(xf * xf, axis=-1, keepdims=True) + EPS)
    return (y * g).astype(x.dtype)


def _heads(t, n_heads):
    b, s, _ = t.shape
    return t.reshape(b, s, n_heads, -1).transpose(0, 2, 1, 3)


def _merge_blocks(o):
    nb, b, h, qb, dv = o.shape
    return o.transpose(1, 0, 3, 2, 4).reshape(b, nb * qb, h * dv)


def _t5_bucket(dist):
    n = jnp.maximum(dist, 0)
    large = MAX_EXACT + (jnp.log(jnp.maximum(n, 1).astype(jnp.float32) / MAX_EXACT)
                         / math.log(MAX_DISTANCE / MAX_EXACT) * (NUM_BUCKETS - MAX_EXACT)).astype(jnp.int32)
    return jnp.where(n < MAX_EXACT, n, jnp.minimum(large, NUM_BUCKETS - 1))


def _t5_bias(table, dist):
    return jnp.moveaxis(table[_t5_bucket(dist)], -1, -3).astype(jnp.float32)


def diff_attention(q, k, v, g_q, g_k, lam_vec, sub_g, table, lam_init):
    q = rmsnorm(q, g_q)
    k = rmsnorm(k, g_k)
    lam_f = lam_vec.astype(jnp.float32)
    lam = jnp.exp(jnp.sum(lam_f[0] * lam_f[1])) - jnp.exp(jnp.sum(lam_f[2] * lam_f[3])) + lam_init
    scale = DIFF_QK_DIM ** -0.5
    s_len = q.shape[2]
    k_pos = jnp.arange(s_len)

    def block(i):
        qb = lax.dynamic_slice_in_dim(q, i * Q_BLOCK, Q_BLOCK, axis=2)
        q_pos = i * Q_BLOCK + jnp.arange(Q_BLOCK)
        dist = q_pos[:, None] - k_pos[None, :]
        s = jnp.einsum('bhqmd,bhkmd->bhmqk', qb, k).astype(jnp.float32) * scale
        s = s + _t5_bias(table, dist)[:, None]
        s = jnp.where(dist >= 0, s, NEG)
        p = jax.nn.softmax(s, axis=-1)
        w = p[:, :, 0] - lam * p[:, :, 1]
        return jnp.einsum('bhqk,bhkd->bhqd', w.astype(v.dtype), v)

    o = lax.map(block, jnp.arange(s_len // Q_BLOCK))
    o = rmsnorm(o, sub_g) * (1.0 - lam_init)
    return _merge_blocks(o)


def forgetting_attention(q, k, v, f_logit, g_q, g_k):
    q = rmsnorm(q, g_q)
    k = rmsnorm(k, g_k)
    log_f = jax.nn.log_sigmoid(f_logit.astype(jnp.float32)).transpose(0, 2, 1)
    cum = jnp.cumsum(log_f, axis=-1)
    scale = HEAD_DIM ** -0.5
    s_len = q.shape[2]
    k_pos = jnp.arange(s_len)

    def block(i):
        qb = lax.dynamic_slice_in_dim(q, i * Q_BLOCK, Q_BLOCK, axis=2)
        cq = lax.dynamic_slice_in_dim(cum, i * Q_BLOCK, Q_BLOCK, axis=2)
        q_pos = i * Q_BLOCK + jnp.arange(Q_BLOCK)
        dist = q_pos[:, None] - k_pos[None, :]
        s = jnp.einsum('bhqd,bhkd->bhqk', qb, k).astype(jnp.float32) * scale
        s = s + (cq[..., :, None] - cum[..., None, :])
        s = jnp.where(dist >= 0, s, NEG)
        p = jax.nn.softmax(s, axis=-1)
        return jnp.einsum('bhqk,bhkd->bhqd', p.astype(v.dtype), v)

    return _merge_blocks(lax.map(block, jnp.arange(s_len // Q_BLOCK)))


def stick_breaking_attention(q, k, v):
    scale = HEAD_DIM ** -0.5
    s_len = q.shape[2]
    k_pos = jnp.arange(s_len)

    def block(i):
        qb = lax.dynamic_slice_in_dim(q, i * Q_BLOCK, Q_BLOCK, axis=2)
        q_pos = i * Q_BLOCK + jnp.arange(Q_BLOCK)
        past = (q_pos[:, None] - k_pos[None, :]) > 0
        z = jnp.einsum('bhqd,bhkd->bhqk', qb, k).astype(jnp.float32) * scale
        log_beta = jax.nn.log_sigmoid(z)
        log_keep = jnp.where(past, jax.nn.log_sigmoid(-z), 0.0)
        tail = lax.cumsum(log_keep, axis=3, reverse=True) - log_keep
        a = jnp.where(past, jnp.exp(log_beta + tail), 0.0)
        return jnp.einsum('bhqk,bhkd->bhqd', a.astype(v.dtype), v)

    return _merge_blocks(lax.map(block, jnp.arange(s_len // Q_BLOCK)))


def native_sparse_attention(q, k_cmp, v_cmp, k_slc, v_slc, k_win, v_win, gate_logit,
                            g_q, g_k, pe, phi_w, table):
    b, h, s_len, d = q.shape
    scale = d ** -0.5
    q = rmsnorm(q, g_q)
    n_cmp = (s_len - CMP_LEN) // CMP_STRIDE + 1
    cmp_idx = np.arange(n_cmp)[:, None] * CMP_STRIDE + np.arange(CMP_LEN)[None, :]
    kc = (k_cmp[:, cmp_idx] + pe[0]).reshape(b, n_cmp, CMP_LEN * d) @ phi_w[0]
    vc = (v_cmp[:, cmp_idx] + pe[1]).reshape(b, n_cmp, CMP_LEN * d) @ phi_w[1]
    kc = rmsnorm(kc, g_k[0])
    ks = rmsnorm(k_slc, g_k[1])
    kw = rmsnorm(k_win, g_k[2])
    cmp_end = jnp.asarray(cmp_idx[:, -1])
    n_sel_blocks = s_len // SEL_LEN
    n_sel = min(N_SEL, n_sel_blocks)
    c_start = np.arange(n_cmp) * CMP_STRIDE
    s_start = np.arange(n_sel_blocks) * SEL_LEN
    overlap = jnp.asarray(((c_start[:, None] < s_start[None, :] + SEL_LEN)
                           & (s_start[None, :] < c_start[:, None] + CMP_LEN)).astype(np.float32))
    sel_start = jnp.asarray(s_start)
    blk_ids = jnp.arange(n_sel_blocks)
    kw_pad = jnp.pad(kw, ((0, 0), (WINDOW, 0), (0, 0)))
    vw_pad = jnp.pad(v_win, ((0, 0), (WINDOW, 0), (0, 0)))
    gates = jax.nn.sigmoid(gate_logit.astype(jnp.float32)).reshape(b, s_len, 3, h)
    gather = jax.vmap(lambda arr, idx: arr[idx])

    def block(i):
        q_pos = i * Q_BLOCK + jnp.arange(Q_BLOCK)
        qb = lax.dynamic_slice_in_dim(q, i * Q_BLOCK, Q_BLOCK, axis=2)
        dist_c = q_pos[:, None] - cmp_end[None, :]
        valid_c = dist_c >= 0
        s_c = jnp.einsum('bhqd,bnd->bhqn', qb, kc).astype(jnp.float32) * scale + _t5_bias(table, dist_c)
        p_c = jnp.where(valid_c, jax.nn.softmax(jnp.where(valid_c, s_c, NEG), axis=-1), 0.0)
        o_c = jnp.einsum('bhqn,bnd->bhqd', p_c.astype(vc.dtype), vc)
        imp = jnp.einsum('bhqn,nj->bqj', p_c, overlap)
        forced = (blk_ids[None, :] == (q_pos // SEL_LEN)[:, None]) | (blk_ids[None, :] == 0)
        imp = jnp.where(forced, FORCED_SCORE, imp)
        imp = jnp.where(sel_start[None, :] <= q_pos[:, None], imp, -1.0)
        _, sel = lax.top_k(imp, n_sel)
        tok = (sel[..., None] * SEL_LEN + jnp.arange(SEL_LEN)).reshape(b, Q_BLOCK, n_sel * SEL_LEN)
        ks_g = gather(ks, tok.reshape(b, -1)).reshape(b, Q_BLOCK, n_sel * SEL_LEN, d)
        vs_g = gather(v_slc, tok.reshape(b, -1)).reshape(b, Q_BLOCK, n_sel * SEL_LEN, d)
        dist_s = q_pos[None, :, None] - tok
        s_s = jnp.einsum('bhqd,bqkd->bhqk', qb, ks_g).astype(jnp.float32) * scale + _t5_bias(table, dist_s)
        s_s = jnp.where((dist_s >= 0)[:, None], s_s, NEG)
        p_s = jax.nn.softmax(s_s, axis=-1)
        o_s = jnp.einsum('bhqk,bqkd->bhqd', p_s.astype(vs_g.dtype), vs_g)
        kwb = lax.dynamic_slice_in_dim(kw_pad, i * Q_BLOCK, Q_BLOCK + WINDOW, axis=1)
        vwb = lax.dynamic_slice_in_dim(vw_pad, i * Q_BLOCK, Q_BLOCK + WINDOW, axis=1)
        k_pos_w = i * Q_BLOCK - WINDOW + jnp.arange(Q_BLOCK + WINDOW)
        dist_w = q_pos[:, None] - k_pos_w[None, :]
        valid_w = (dist_w >= 0) & (dist_w < WINDOW) & (k_pos_w >= 0)[None, :]
        s_w = jnp.einsum('bhqd,bkd->bhqk', qb, kwb).astype(jnp.float32) * scale + _t5_bias(table, dist_w)
        p_w = jax.nn.softmax(jnp.where(valid_w, s_w, NEG), axis=-1)
        o_w = jnp.einsum('bhqk,bkd->bhqd', p_w.astype(vwb.dtype), vwb)
        g = lax.dynamic_slice_in_dim(gates, i * Q_BLOCK, Q_BLOCK, axis=1).transpose(0, 2, 3, 1)
        o = g[:, 0, :, :, None] * o_c + g[:, 1, :, :, None] * o_s + g[:, 2, :, :, None] * o_w
        return o.astype(q.dtype)

    return _merge_blocks(lax.map(block, jnp.arange(s_len // Q_BLOCK)))


def conv_ffn(h, w_up, conv_w, conv_b, w_down):
    u = h @ w_up
    gate, val = jnp.split(u, 2, axis=-1)
    gate = lax.conv_general_dilated(gate, conv_w, window_strides=(1,), padding=[(CONV_WIDTH - 1, 0)],
                                    dimension_numbers=('NWC', 'WIO', 'NWC'),
                                    feature_group_count=D_FF) + conv_b
    return (jax.nn.silu(gate) * val) @ w_down


def setup_inputs(seed: int = 0) -> dict:
    key = jax.random.key(seed)
    ks = jax.random.split(key, 26)

    def nrm(i, shape, s):
        return jax.random.normal(ks[i], shape, jnp.float32) * s

    return {
        "x": nrm(0, (BATCH, SEQ, D_MODEL), 1.0),
        "c": nrm(1, (BATCH, D_MODEL), 1.0),
        "rel_bias": nrm(2, (NUM_BUCKETS, N_BIAS_HEADS), 0.5),
        "ada_w": nrm(3, (DEPTH, D_MODEL, 6 * D_MODEL), 0.5 * D_MODEL ** -0.5),
        "ada_b": nrm(4, (DEPTH, 6 * D_MODEL), 0.02),
        "norm_mix_g": 1.0 + nrm(5, (DEPTH, D_MODEL), 0.02),
        "norm_ffn_g": 1.0 + nrm(6, (DEPTH, D_MODEL), 0.02),
        "w_in": nrm(7, (DEPTH, D_MODEL, P_IN), D_MODEL ** -0.5),
        "w_out": nrm(8, (DEPTH, MIX_WIDTH, D_MODEL), MIX_WIDTH ** -0.5),
        "diff_qnorm_g": 1.0 + nrm(9, (DEPTH, DIFF_QK_DIM), 0.02),
        "diff_knorm_g": 1.0 + nrm(10, (DEPTH, DIFF_QK_DIM), 0.02),
        "diff_lambda": nrm(11, (DEPTH, 4, DIFF_QK_DIM), 0.1),
        "diff_subln_g": 1.0 + nrm(12, (DEPTH, 2 * DIFF_QK_DIM), 0.02),
        "fox_qnorm_g": 1.0 + nrm(13, (DEPTH, HEAD_DIM), 0.02),
        "fox_knorm_g": 1.0 + nrm(14, (DEPTH, HEAD_DIM), 0.02),
        "fox_b_f": 3.0 + nrm(15, (DEPTH, HPM), 0.1),
        "nsa_qnorm_g": 1.0 + nrm(16, (DEPTH, HEAD_DIM), 0.02),
        "nsa_knorm_g": 1.0 + nrm(17, (DEPTH, 3, HEAD_DIM), 0.02),
        "nsa_pe": nrm(18, (DEPTH, 2, CMP_LEN, HEAD_DIM), 0.5),
        "nsa_phi_w": nrm(19, (DEPTH, 2, CMP_LEN * HEAD_DIM, HEAD_DIM), (CMP_LEN * HEAD_DIM) ** -0.5),
        "ffn_w_up": nrm(20, (DEPTH, D_MODEL, 2 * D_FF), D_MODEL ** -0.5),
        "ffn_conv_w": nrm(21, (DEPTH, CONV_WIDTH, 1, D_FF), CONV_WIDTH ** -0.5),
        "ffn_conv_b": nrm(22, (DEPTH, D_FF), 0.02),
        "ffn_w_down": nrm(23, (DEPTH, D_FF, D_MODEL), D_FF ** -0.5),
    }


def reference(x, c, rel_bias, ada_w, ada_b, norm_mix_g, norm_ffn_g, w_in, w_out,
              diff_qnorm_g, diff_knorm_g, diff_lambda, diff_subln_g,
              fox_qnorm_g, fox_knorm_g, fox_b_f,
              nsa_qnorm_g, nsa_knorm_g, nsa_pe, nsa_phi_w,
              ffn_w_up, ffn_conv_w, ffn_conv_b, ffn_w_down):
    b, s_len, _ = x.shape
    table_diff = rel_bias[:, :HPM]
    table_nsa = rel_bias[:, HPM:]
    split_pts = _split_points(SPLIT_SIZES)
    c_act = jax.nn.silu(c)
    for l in range(DEPTH):
        mod = c_act @ ada_w[l] + ada_b[l]
        sh_a, sc_a, gt_a, sh_m, sc_m, gt_m = [m[:, None, :] for m in jnp.split(mod, 6, axis=-1)]
        h = rmsnorm(x, norm_mix_g[l]) * (1.0 + sc_a) + sh_a
        proj = h @ w_in[l]
        (a_q, a_k, a_v, b_q, b_k, b_v, b_f, c_q, c_k, c_v,
         d_q, d_kc, d_vc, d_ks, d_vs, d_kw, d_vw, d_g) = jnp.split(proj, split_pts, axis=-1)
        lam_init = 0.8 - 0.6 * math.exp(-0.3 * l)
        o_a = diff_attention(_heads(a_q, HPM).reshape(b, HPM, s_len, 2, DIFF_QK_DIM),
                             _heads(a_k, HPM).reshape(b, HPM, s_len, 2, DIFF_QK_DIM),
                             _heads(a_v, HPM), diff_qnorm_g[l], diff_knorm_g[l], diff_lambda[l],
                             diff_subln_g[l], table_diff, lam_init)
        o_b = forgetting_attention(_heads(b_q, HPM), _heads(b_k, HPM), _heads(b_v, HPM),
                                   b_f + fox_b_f[l], fox_qnorm_g[l], fox_knorm_g[l])
        o_c = stick_breaking_attention(_heads(c_q, HPM), _heads(c_k, HPM), _heads(c_v, HPM))
        o_d = native_sparse_attention(_heads(d_q, HPM), d_kc, d_vc, d_ks, d_vs, d_kw, d_vw, d_g,
                                      nsa_qnorm_g[l], nsa_knorm_g[l], nsa_pe[l], nsa_phi_w[l], table_nsa)
        mixed = jnp.concatenate([o_a, o_b, o_c, o_d], axis=-1) @ w_out[l]
        x = x + gt_a * mixed
        h = rmsnorm(x, norm_ffn_g[l]) * (1.0 + sc_m) + sh_m
        x = x + gt_m * conv_ffn(h, ffn_w_up[l], ffn_conv_w[l], ffn_conv_b[l], ffn_w_down[l])
    return x
```

```cpp
#include <hip/hip_runtime.h>
#include <cstdint>
#include <cstdio>

typedef unsigned short bf16_t;
typedef short bf16x8 __attribute__((ext_vector_type(8)));
typedef float f32x4 __attribute__((ext_vector_type(4)));
typedef unsigned u32x4 __attribute__((ext_vector_type(4)));

constexpr int NB = 4, SEQ = 4096, DM = 1024, MTOK = NB * SEQ, DEPTH = 2;
constexpr int HD = 64, HPM = 4, DFF = 2816, PIN = 2960, PINP = 3072, NUP = 2 * DFF;
constexpr float EPS = 1e-6f;
constexpr int NTHR = 512;

constexpr int CA_Q = 0, CA_K = 256, CA_V = 512, CB_Q = 768, CB_K = 1024, CB_V = 1280, CC_Q = 1536, CC_K = 1792, CC_V = 2048;
constexpr int CD_Q = 2304, CD_KC = 2560, CD_VC = 2624, CD_KS = 2688, CD_VS = 2752, CD_KW = 2816, CD_VW = 2880, C_BF = 2944, C_DG = 2948;

constexpr size_t MiB = 1u << 20;
constexpr size_t WS_CTL = 0;
constexpr size_t WS_MOD = 1 * MiB;
constexpr size_t WS_CBIN = WS_MOD + 2 * 4 * 6144 * 4;
constexpr size_t WS_CBUP = WS_CBIN + 2 * 4 * 3072 * 4;
constexpr size_t WS_TB = WS_CBUP + 2 * 4 * 5632 * 4;
constexpr size_t WS_LAM = WS_TB + 2 * 4 * 128 * 4;
constexpr size_t WS_CUM = WS_LAM + 256;
constexpr size_t WS_KC = WS_CUM + 16 * 4096 * 4;
constexpr size_t WS_VC = WS_KC + 4 * 256 * 64 * 2;
constexpr size_t WS_SELM = WS_VC + 4 * 256 * 64 * 2;
constexpr size_t WS_SMALL_END = WS_SELM + 16384 * 8;
static_assert(WS_SMALL_END <= 4 * MiB, "small region");
constexpr size_t WS_RSA = 4 * MiB;
constexpr size_t WS_RSB = 5 * MiB;
constexpr size_t WS_SIDE = 6 * MiB;
constexpr size_t WS_IMP = 7 * MiB;
constexpr size_t WS_ML = 11 * MiB;
constexpr size_t WS_W = 12 * MiB;
constexpr size_t WS_WIN = WS_W;
constexpr size_t WS_WOUT = WS_WIN + (size_t)PINP * DM * 2;
constexpr size_t WS_WUP = WS_WOUT + (size_t)DM * DM * 2;
constexpr size_t WS_WDN = WS_WUP + (size_t)NUP * DM * 2;
constexpr size_t WS_W_END = WS_WDN + (size_t)DM * DFF * 2;
static_assert(WS_W_END <= 38 * MiB, "weights region");
constexpr size_t WS_XA = 38 * MiB;
constexpr size_t WS_BIG = 70 * MiB;
constexpr size_t WS_PROJ = WS_BIG;
constexpr size_t WS_MIX = WS_BIG + 96 * MiB;
constexpr size_t WS_UG = WS_BIG;
constexpr size_t WS_UV = WS_BIG + 88 * MiB;
constexpr size_t WS_END = WS_BIG + 176 * MiB;
static_assert(WS_END <= 256 * MiB, "workspace");

struct Params {
    const float *x, *c, *rel_bias, *ada_w, *ada_b, *norm_mix_g, *norm_ffn_g, *w_in, *w_out;
    const float *diff_qn, *diff_kn, *diff_lam, *diff_sub, *fox_qn, *fox_kn, *fox_bf;
    const float *nsa_qn, *nsa_kn, *nsa_pe, *nsa_phi, *w_up, *conv_w, *conv_b, *w_down;
    float* out;
    unsigned char* ws;
};

__device__ __forceinline__ float bf2f(bf16_t v) { return __uint_as_float(((unsigned)v) << 16); }
__device__ __forceinline__ bf16_t f2bf(float f) { unsigned u = __float_as_uint(f); return (bf16_t)((u + 0x7fffu + ((u >> 16) & 1u)) >> 16); }
__device__ __forceinline__ unsigned pk2(float lo, float hi) { return (unsigned)f2bf(lo) | ((unsigned)f2bf(hi) << 16); }
__device__ __forceinline__ float siluf(float v) { return v / (1.f + __expf(-v)); }
__device__ __forceinline__ float logsigf(float v) { return fminf(v, 0.f) - log1pf(__expf(-fabsf(v))); }
__device__ __forceinline__ float wave_sum(float v) {
#pragma unroll
    for (int o = 1; o < 64; o <<= 1) v += __shfl_xor(v, o);
    return v;
}
__device__ __forceinline__ int t5_bucket(int n) {
    if (n < 16) return n < 0 ? 0 : n;
    return 16 + (n >= 19) + (n >= 21) + (n >= 24) + (n >= 27) + (n >= 31) + (n >= 35) + (n >= 40) + (n >= 46) + (n >= 52) + (n >= 59) + (n >= 67) + (n >= 77) + (n >= 87) + (n >= 99) + (n >= 113);
}
__host__ __device__ __forceinline__ int in_col_map(int n) {
    if (n < 1536) return n;
    if (n < 2944) return n + 4;
    if (n < 2948) return 1536 + (n - 2944);
    if (n < 2960) return n;
    return -1;
}
__host__ __device__ __forceinline__ int up_col_map(int n) {
    const int pn = n >> 8, c = n & 255;
    return c < 128 ? (128 * pn + c) : (DFF + 128 * pn + (c - 128));
}

#define GTID() ((int)(blockIdx.x * blockDim.x + threadIdx.x))
#define GSIZE() ((int)(gridDim.x * blockDim.x))

__device__ void ph_mod(const Params& p) {
    float* mod = (float*)(p.ws + WS_MOD);
    float* tb = (float*)(p.ws + WS_TB);
    float* lamv = (float*)(p.ws + WS_LAM);
    const int gt = GTID(), gs = GSIZE();
    for (int idx = gt; idx < DEPTH * 6144; idx += gs) {
        const int l = idx / 6144, j = idx % 6144;
        float a0 = 0.f, a1 = 0.f, a2 = 0.f, a3 = 0.f;
        const float* w = p.ada_w + (size_t)l * DM * 6144 + j;
        for (int k = 0; k < DM; ++k) {
            const float wv = w[(size_t)k * 6144];
            a0 += siluf(p.c[k]) * wv; a1 += siluf(p.c[DM + k]) * wv; a2 += siluf(p.c[2 * DM + k]) * wv; a3 += siluf(p.c[3 * DM + k]) * wv;
        }
        const float bb = p.ada_b[l * 6144 + j];
        mod[(l * 4 + 0) * 6144 + j] = a0 + bb; mod[(l * 4 + 1) * 6144 + j] = a1 + bb;
        mod[(l * 4 + 2) * 6144 + j] = a2 + bb; mod[(l * 4 + 3) * 6144 + j] = a3 + bb;
    }
    for (int idx = gt; idx < 2 * 4 * 128; idx += gs) {
        const int type = idx / 512, h = (idx / 128) & 3, d = idx & 127;
        tb[idx] = p.rel_bias[t5_bucket(d) * 8 + type * 4 + h];
    }
    for (int idx = gt; idx < DEPTH; idx += gs) {
        const float* lv = p.diff_lam + idx * 4 * 32;
        float s1 = 0.f, s2 = 0.f;
        for (int i = 0; i < 32; ++i) { s1 += lv[i] * lv[32 + i]; s2 += lv[64 + i] * lv[96 + i]; }
        const float lam_init = 0.8f - 0.6f * expf(-0.3f * (float)idx);
        lamv[idx] = expf(s1) - expf(s2) + lam_init;
    }
}

__device__ void ph_cbias(const Params& p, int l) {
    const float* mod = (const float*)(p.ws + WS_MOD);
    float* cbin = (float*)(p.ws + WS_CBIN) + (size_t)l * 4 * PINP;
    float* cbup = (float*)(p.ws + WS_CBUP) + (size_t)l * 4 * NUP;
    const int gt = GTID(), gs = GSIZE();
    for (int idx = gt; idx < PINP + NUP; idx += gs) {
        const bool isin = idx < PINP;
        const int n = isin ? idx : idx - PINP;
        const int oc = isin ? in_col_map(n) : up_col_map(n);
        const int ncol = isin ? PIN : NUP;
        const float* W = (isin ? p.w_in + (size_t)l * DM * PIN : p.w_up + (size_t)l * DM * NUP);
        const int shoff = isin ? 0 : 3072;
        float a0 = 0.f, a1 = 0.f, a2 = 0.f, a3 = 0.f;
        if (oc >= 0) {
            for (int k = 0; k < DM; ++k) {
                const float wv = W[(size_t)k * ncol + oc];
                a0 += mod[(l * 4 + 0) * 6144 + shoff + k] * wv; a1 += mod[(l * 4 + 1) * 6144 + shoff + k] * wv;
                a2 += mod[(l * 4 + 2) * 6144 + shoff + k] * wv; a3 += mod[(l * 4 + 3) * 6144 + shoff + k] * wv;
            }
        }
        float* o = isin ? cbin : cbup; const int ld = isin ? PINP : NUP;
        o[0 * ld + n] = a0; o[1 * ld + n] = a1; o[2 * ld + n] = a2; o[3 * ld + n] = a3;
    }
}
template <int MAPK>
__device__ void convert_weight(const float* W, int K, int Nsrc, int Npad, bf16_t* Wt, float* scr  , int gw, int ngw, int lane) {
    const int nkb = K / 32, nnb = Npad / 32;
    for (int it = gw; it < nkb * nnb; it += ngw) {
        const int kb = it / nnb, nb = it % nnb, k0 = kb * 32, n0 = nb * 32;
        {
            const int nn = lane & 31; const int n = n0 + nn;
            const int oc = MAPK == 0 ? n : (MAPK == 1 ? in_col_map(n) : up_col_map(n));
#pragma unroll 4
            for (int i = 0; i < 16; ++i) { const int kk = 2 * i + (lane >> 5); scr[kk * 33 + nn] = (oc >= 0) ? W[(size_t)(k0 + kk) * Nsrc + oc] : 0.f; }
        }
        __builtin_amdgcn_s_waitcnt(0); __builtin_amdgcn_wave_barrier();
        {
            const int kk2 = (lane & 15) * 2;
#pragma unroll 4
            for (int i = 0; i < 8; ++i) { const int nn = 4 * i + (lane >> 4);
                *(unsigned*)(Wt + (size_t)(n0 + nn) * K + k0 + kk2) = pk2(scr[kk2 * 33 + nn], scr[(kk2 + 1) * 33 + nn]); }
        }
        __builtin_amdgcn_s_waitcnt(0); __builtin_amdgcn_wave_barrier();
    }
}
__device__ void ph_weights(const Params& p, int l, float* lds) {
    const int lane = threadIdx.x & 63, wv = threadIdx.x >> 6;
    const int gw = blockIdx.x * (blockDim.x >> 6) + wv, ngw = gridDim.x * (blockDim.x >> 6);
    float* scr = lds + wv * (32 * 33);
    convert_weight<1>(p.w_in + (size_t)l * DM * PIN, DM, PIN, PINP, (bf16_t*)(p.ws + WS_WIN), scr, gw, ngw, lane);
    convert_weight<0>(p.w_out + (size_t)l * DM * DM, DM, DM, DM, (bf16_t*)(p.ws + WS_WOUT), scr, gw, ngw, lane);
    convert_weight<2>(p.w_up + (size_t)l * DM * NUP, DM, NUP, NUP, (bf16_t*)(p.ws + WS_WUP), scr, gw, ngw, lane);
    convert_weight<0>(p.w_down + (size_t)l * DFF * DM, DFF, DM, DM, (bf16_t*)(p.ws + WS_WDN), scr, gw, ngw, lane);
}
__device__ void ph_xa_from(const Params& p, const float* src, int l, int which  , bf16_t* XA, float* rowss, bool write_xa) {
    const float* mod = (const float*)(p.ws + WS_MOD);
    const float* g = (which == 0 ? p.norm_mix_g : p.norm_ffn_g) + l * DM;
    const int lane = threadIdx.x & 63, wv = threadIdx.x >> 6;
    const int gw = blockIdx.x * (blockDim.x >> 6) + wv, ngw = gridDim.x * (blockDim.x >> 6);
    for (int row = gw; row < MTOK; row += ngw) {
        const int b = row / SEQ;
        const float* sc = mod + (size_t)(l * 4 + b) * 6144 + (which == 0 ? 1024 : 4096);
        float ss = 0.f;
#pragma unroll
        for (int j = 0; j < 4; ++j) {
            const int k = j * 256 + lane * 4;
            const f32x4 v = *(const f32x4*)(src + (size_t)row * DM + k);
            ss += v[0] * v[0] + v[1] * v[1] + v[2] * v[2] + v[3] * v[3];
            if (write_xa) {
                const f32x4 gv = *(const f32x4*)(g + k); const f32x4 sv = *(const f32x4*)(sc + k);
                uint2 o; o.x = pk2(v[0] * gv[0] * (1.f + sv[0]), v[1] * gv[1] * (1.f + sv[1])); o.y = pk2(v[2] * gv[2] * (1.f + sv[2]), v[3] * gv[3] * (1.f + sv[3]));
                *(uint2*)(XA + (size_t)row * DM + k) = o;
            }
        }
        ss = wave_sum(ss);
        if (lane < 16) rowss[(size_t)row * 16 + lane] = (lane == 0) ? ss : 0.f;
    }
}

template <class Epi>
__device__ void gemm_simple(const bf16_t* A, const bf16_t* Bt, int M, int N, int K, const Epi& E, unsigned char* lds) {
    bf16_t* sA = (bf16_t*)lds;
    bf16_t* sB = (bf16_t*)(lds + 128 * 80);
    const int tid = threadIdx.x, lane = tid & 63, w = tid >> 6, fr = lane & 15, fq = lane >> 4;
    const int ntn = N / 64, ntm = M / 128;
    for (int tile = blockIdx.x; tile < ntn * ntm; tile += gridDim.x) {
        const int tm = tile / ntn, tn = tile % ntn, m0 = tm * 128, n0 = tn * 64;
        f32x4 acc[4];
#pragma unroll
        for (int i = 0; i < 4; ++i) acc[i] = (f32x4){0.f, 0.f, 0.f, 0.f};
        for (int k0 = 0; k0 < K; k0 += 32) {
            { const int r = tid >> 2, ch = tid & 3; *(u32x4*)(sA + r * 40 + ch * 8) = *(const u32x4*)(A + (size_t)(m0 + r) * K + k0 + ch * 8); }
            if (tid < 256) { const int r = tid >> 2, ch = tid & 3; *(u32x4*)(sB + r * 40 + ch * 8) = *(const u32x4*)(Bt + (size_t)(n0 + r) * K + k0 + ch * 8); }
            __syncthreads();
            const bf16x8 a = *(const bf16x8*)(sA + (16 * w + fr) * 40 + fq * 8);
#pragma unroll
            for (int nt = 0; nt < 4; ++nt) {
                const bf16x8 b = *(const bf16x8*)(sB + (16 * nt + fr) * 40 + fq * 8);
                acc[nt] = __builtin_amdgcn_mfma_f32_16x16x32_bf16(a, b, acc[nt], 0, 0, 0);
            }
            __syncthreads();
        }
#pragma unroll
        for (int nt = 0; nt < 4; ++nt)
#pragma unroll
            for (int j = 0; j < 4; ++j) E(m0 + 16 * w + fq * 4 + j, n0 + 16 * nt + fr, acc[nt][j]);
    }
}
__device__ __forceinline__ float row_rstd(const float* rowss, int row) {
    const f32x4* r = (const f32x4*)(rowss + (size_t)row * 16);
    const f32x4 a = r[0], b = r[1], c = r[2], d = r[3];
    const float s = ((a[0] + a[1]) + (a[2] + a[3])) + ((b[0] + b[1]) + (b[2] + b[3])) + ((c[0] + c[1]) + (c[2] + c[3])) + ((d[0] + d[1]) + (d[2] + d[3]));
    return rsqrtf(s * (1.f / DM) + EPS);
}
struct EpiProj {
    const float* rowss; const float* cb; bf16_t* proj; float* side;
    __device__ void operator()(int row, int col, float v) const {
        const int b = row / SEQ; const float o = v * row_rstd(rowss, row) + cb[b * PINP + col];
        proj[(size_t)row * PINP + col] = f2bf(o);
        if (col >= C_BF && col < PIN) side[(size_t)row * 16 + (col - C_BF)] = o;
    }
};
struct EpiRes {
    const float* xin; float* xout; const float* mod_gate;
    const float* g; const float* mod_sc; bf16_t* xa;
    __device__ void operator()(int row, int col, float v) const {
        const int b = row / SEQ; const float o = xin[(size_t)row * DM + col] + mod_gate[b * 6144 + col] * v;
        xout[(size_t)row * DM + col] = o;
        if (xa) xa[(size_t)row * DM + col] = f2bf(o * g[col] * (1.f + mod_sc[b * 6144 + col]));
    }
};
struct EpiUp {
    const float* rowss; const float* cb; bf16_t* ug; bf16_t* uv;
    __device__ void operator()(int row, int col, float v) const {
        const int b = row / SEQ; const float o = v * row_rstd(rowss, row) + cb[b * NUP + col];
        const int pn = col >> 8, c = col & 255;
        if (c < 128) ug[(size_t)row * DFF + 128 * pn + c] = f2bf(o); else uv[(size_t)row * DFF + 128 * pn + (c - 128)] = f2bf(o);
    }
};

__device__ void ph_prep_knorm(const Params& p, int l) {
    bf16_t* proj = (bf16_t*)(p.ws + WS_PROJ);
    const int lane = threadIdx.x & 63, wv = threadIdx.x >> 6;
    const int gw = blockIdx.x * (blockDim.x >> 6) + wv, ngw = gridDim.x * (blockDim.x >> 6);
    for (int row = gw; row < MTOK; row += ngw) {
        bf16_t* pr = proj + (size_t)row * PINP;
        {
            uint2 raw = *(const uint2*)(pr + CA_K + 4 * lane);
            float v0 = bf2f(raw.x & 0xffff), v1 = bf2f(raw.x >> 16), v2 = bf2f(raw.y & 0xffff), v3 = bf2f(raw.y >> 16);
            float ss = v0 * v0 + v1 * v1 + v2 * v2 + v3 * v3;
            ss += __shfl_xor(ss, 1); ss += __shfl_xor(ss, 2); ss += __shfl_xor(ss, 4);
            const float r = rsqrtf(ss * (1.f / 32.f) + EPS); const float* g = p.diff_kn + l * 32 + ((4 * lane) & 31);
            raw.x = pk2(v0 * r * g[0], v1 * r * g[1]); raw.y = pk2(v2 * r * g[2], v3 * r * g[3]);
            *(uint2*)(pr + CA_K + 4 * lane) = raw;
        }
        {
            uint2 raw = *(const uint2*)(pr + CB_K + 4 * lane);
            float v0 = bf2f(raw.x & 0xffff), v1 = bf2f(raw.x >> 16), v2 = bf2f(raw.y & 0xffff), v3 = bf2f(raw.y >> 16);
            float ss = v0 * v0 + v1 * v1 + v2 * v2 + v3 * v3;
            ss += __shfl_xor(ss, 1); ss += __shfl_xor(ss, 2); ss += __shfl_xor(ss, 4); ss += __shfl_xor(ss, 8);
            const float r = rsqrtf(ss * (1.f / 64.f) + EPS); const float* g = p.fox_kn + l * 64 + ((4 * lane) & 63);
            raw.x = pk2(v0 * r * g[0], v1 * r * g[1]); raw.y = pk2(v2 * r * g[2], v3 * r * g[3]);
            *(uint2*)(pr + CB_K + 4 * lane) = raw;
        }
        {
            const int hi = lane >> 5, li = lane & 31; bf16_t* q = pr + (hi ? CD_KW : CD_KS) + 2 * li;
            unsigned raw = *(const unsigned*)q; float v0 = bf2f(raw & 0xffff), v1 = bf2f(raw >> 16);
            float ss = v0 * v0 + v1 * v1;
            ss += __shfl_xor(ss, 1); ss += __shfl_xor(ss, 2); ss += __shfl_xor(ss, 4); ss += __shfl_xor(ss, 8); ss += __shfl_xor(ss, 16);
            const float r = rsqrtf(ss * (1.f / 64.f) + EPS); const float* g = p.nsa_kn + (l * 3 + (hi ? 2 : 1)) * 64 + 2 * li;
            *(unsigned*)q = pk2(v0 * r * g[0], v1 * r * g[1]);
        }
    }
}
__device__ void ph_prep_cum(const Params& p, int l) {
    const float* side = (const float*)(p.ws + WS_SIDE);
    float* cum = (float*)(p.ws + WS_CUM);
    const int lane = threadIdx.x & 63, wv = threadIdx.x >> 6;
    const int gw = blockIdx.x * (blockDim.x >> 6) + wv, ngw = gridDim.x * (blockDim.x >> 6);
    for (int bh = gw; bh < 16; bh += ngw) {
        const int b = bh >> 2, h = bh & 3; const float bf = p.fox_bf[l * 4 + h];
        float tot = 0.f;
        for (int i = 0; i < 64; ++i) tot += logsigf(side[(size_t)(b * SEQ + lane * 64 + i) * 16 + h] + bf);
        float inc = tot;
#pragma unroll
        for (int o = 1; o < 64; o <<= 1) { const float v = __shfl_up(inc, o); if (lane >= o) inc += v; }
        float run = inc - tot;
        for (int i = 0; i < 64; ++i) { run += logsigf(side[(size_t)(b * SEQ + lane * 64 + i) * 16 + h] + bf); cum[bh * SEQ + lane * 64 + i] = run; }
    }
}
__device__ void ph_prep_cmp(const Params& p, int l, unsigned char* lds) {
    const bf16_t* proj = (const bf16_t*)(p.ws + WS_PROJ);
    float* win = (float*)lds; float* red = (float*)(lds + 36864);
    const int tid = threadIdx.x, e = tid & 63, part = tid >> 6;
    for (int item = blockIdx.x; item < 4 * 2 * 32; item += gridDim.x) {
        const int b = item >> 6, which = (item >> 5) & 1, n0 = (item & 31) * 8;
        const int colbase = which ? CD_VC : CD_KC;
        __syncthreads();
        for (int i = tid; i < 144 * 64; i += NTHR) { const int tk = 16 * n0 + (i >> 6); win[i] = tk < SEQ ? bf2f(proj[(size_t)(b * SEQ + tk) * PINP + colbase + (i & 63)]) : 0.f; }
        __syncthreads();
        float acc[8];
#pragma unroll
        for (int nn = 0; nn < 8; ++nn) acc[nn] = 0.f;
        const float* phi = p.nsa_phi + (size_t)(l * 2 + which) * 2048 * 64; const float* pe = p.nsa_pe + (size_t)(l * 2 + which) * 32 * 64;
        for (int i = 4 * part; i < 4 * part + 4; ++i)
            for (int d = 0; d < 64; ++d) {
                const float ph = phi[(size_t)(i * 64 + d) * 64 + e], pv = pe[i * 64 + d];
#pragma unroll
                for (int nn = 0; nn < 8; ++nn) acc[nn] += (win[(16 * nn + i) * 64 + d] + pv) * ph;
            }
#pragma unroll
        for (int nn = 0; nn < 8; ++nn) red[(part * 8 + nn) * 64 + e] = acc[nn];
        __syncthreads();
        {
            const int nn = part, n = n0 + nn; float v = 0.f;
#pragma unroll
            for (int pp = 0; pp < 8; ++pp) v += red[(pp * 8 + nn) * 64 + e];
            bf16_t* dst = (bf16_t*)(p.ws + (which ? WS_VC : WS_KC)) + (size_t)(b * 256 + n) * 64 + e;
            if (n >= 255) *dst = 0;
            else if (which == 0) { const float ss = wave_sum(v * v); *dst = f2bf(v * rsqrtf(ss * (1.f / 64.f) + EPS) * p.nsa_kn[(l * 3 + 0) * 64 + e]); }
            else *dst = f2bf(v);
        }
    }
}

__device__ __forceinline__ void load8(const bf16_t* p, float* d) {
    const u32x4 r = *(const u32x4*)p;
    d[0] = bf2f(r[0] & 0xffff); d[1] = bf2f(r[0] >> 16); d[2] = bf2f(r[1] & 0xffff); d[3] = bf2f(r[1] >> 16);
    d[4] = bf2f(r[2] & 0xffff); d[5] = bf2f(r[2] >> 16); d[6] = bf2f(r[3] & 0xffff); d[7] = bf2f(r[3] >> 16);
}
template <int N> __device__ __forceinline__ float dotn(const float* q, const bf16_t* k) {
    float s = 0.f;
#pragma unroll
    for (int c = 0; c < N / 8; ++c) { float t[8]; load8(k + 8 * c, t);
#pragma unroll
        for (int j = 0; j < 8; ++j) s += q[8 * c + j] * t[j]; }
    return s;
}
template <int N> __device__ __forceinline__ void axpyn(float* o, float w, const bf16_t* v) {
#pragma unroll
    for (int c = 0; c < N / 8; ++c) { float t[8]; load8(v + 8 * c, t);
#pragma unroll
        for (int j = 0; j < 8; ++j) o[8 * c + j] += w * t[j]; }
}
template <int N> __device__ __forceinline__ void loadq_norm(float* q, const bf16_t* src, const float* g, float scale, bool norm) {
    float ss = 0.f;
#pragma unroll
    for (int c = 0; c < N / 8; ++c) load8(src + 8 * c, q + 8 * c);
#pragma unroll
    for (int j = 0; j < N; ++j) ss += q[j] * q[j];
    const float r = norm ? rsqrtf(ss * (1.f / N) + EPS) : 1.f;
#pragma unroll
    for (int j = 0; j < N; ++j) q[j] = q[j] * r * (norm ? g[j] : 1.f) * scale;
}
__device__ __forceinline__ void store64(bf16_t* dst, const float* o) {
#pragma unroll
    for (int c = 0; c < 8; ++c) { u32x4 w; w[0] = pk2(o[8 * c], o[8 * c + 1]); w[1] = pk2(o[8 * c + 2], o[8 * c + 3]); w[2] = pk2(o[8 * c + 4], o[8 * c + 5]); w[3] = pk2(o[8 * c + 6], o[8 * c + 7]); *(u32x4*)(dst + 8 * c) = w; }
}

__device__ void nv_attn_diff(const Params& p, int l) {
    const bf16_t* proj = (const bf16_t*)(p.ws + WS_PROJ); bf16_t* mix = (bf16_t*)(p.ws + WS_MIX);
    const float* tb = (const float*)(p.ws + WS_TB); const float lam = ((const float*)(p.ws + WS_LAM))[l];
    const float lam_init = 0.8f - 0.6f * expf(-0.3f * (float)l);
    const float scale = 0.17677669529663687f;
    for (int idx = GTID(); idx < 4 * 4 * SEQ; idx += GSIZE()) {
        const int t = idx & (SEQ - 1), h = (idx >> 12) & 3, b = idx >> 14; const size_t rb = (size_t)b * SEQ;
        float q[64];
        loadq_norm<32>(q, proj + (rb + t) * PINP + CA_Q + 64 * h, p.diff_qn + l * 32, scale, true);
        loadq_norm<32>(q + 32, proj + (rb + t) * PINP + CA_Q + 64 * h + 32, p.diff_qn + l * 32, scale, true);
        const float* tbh = tb + h * 128;
        const bf16_t* kb = proj + rb * PINP + CA_K + 64 * h; const bf16_t* vb = proj + rb * PINP + CA_V + 64 * h;
        float m1 = -INFINITY, m2 = -INFINITY;
        for (int k = 0; k <= t; ++k) { const float bias = tbh[min(t - k, 127)];
            const float s1 = dotn<32>(q, kb + (size_t)k * PINP) + bias, s2 = dotn<32>(q + 32, kb + (size_t)k * PINP + 32) + bias; m1 = fmaxf(m1, s1); m2 = fmaxf(m2, s2); }
        float l1 = 0.f, l2 = 0.f;
        for (int k = 0; k <= t; ++k) { const float bias = tbh[min(t - k, 127)];
            const float s1 = dotn<32>(q, kb + (size_t)k * PINP) + bias, s2 = dotn<32>(q + 32, kb + (size_t)k * PINP + 32) + bias; l1 += __expf(s1 - m1); l2 += __expf(s2 - m2); }
        float o[64];
#pragma unroll
        for (int j = 0; j < 64; ++j) o[j] = 0.f;
        const float i1 = 1.f / l1, i2 = lam / l2;
        for (int k = 0; k <= t; ++k) { const float bias = tbh[min(t - k, 127)];
            const float s1 = dotn<32>(q, kb + (size_t)k * PINP) + bias, s2 = dotn<32>(q + 32, kb + (size_t)k * PINP + 32) + bias;
            const float w = __expf(s1 - m1) * i1 - __expf(s2 - m2) * i2; axpyn<64>(o, w, vb + (size_t)k * PINP); }
        float ss = 0.f;
#pragma unroll
        for (int j = 0; j < 64; ++j) ss += o[j] * o[j];
        const float r = rsqrtf(ss * (1.f / 64.f) + EPS) * (1.f - lam_init);
#pragma unroll
        for (int j = 0; j < 64; ++j) o[j] = o[j] * r * p.diff_sub[l * 64 + j];
        store64(mix + (rb + t) * DM + 0 + 64 * h, o);
    }
}
__device__ void nv_attn_fox(const Params& p, int l) {
    const bf16_t* proj = (const bf16_t*)(p.ws + WS_PROJ); bf16_t* mix = (bf16_t*)(p.ws + WS_MIX);
    const float* cum = (const float*)(p.ws + WS_CUM);
    for (int idx = GTID(); idx < 4 * 4 * SEQ; idx += GSIZE()) {
        const int t = idx & (SEQ - 1), h = (idx >> 12) & 3, b = idx >> 14; const size_t rb = (size_t)b * SEQ;
        float q[64]; loadq_norm<64>(q, proj + (rb + t) * PINP + CB_Q + 64 * h, p.fox_qn + l * 64, 0.125f, true);
        const bf16_t* kb = proj + rb * PINP + CB_K + 64 * h; const bf16_t* vb = proj + rb * PINP + CB_V + 64 * h;
        const float* cm = cum + (b * 4 + h) * SEQ; const float cq = cm[t];
        float m = -INFINITY;
        for (int k = 0; k <= t; ++k) m = fmaxf(m, dotn<64>(q, kb + (size_t)k * PINP) + (cq - cm[k]));
        float o[64], ls = 0.f;
#pragma unroll
        for (int j = 0; j < 64; ++j) o[j] = 0.f;
        for (int k = 0; k <= t; ++k) { const float e = __expf(dotn<64>(q, kb + (size_t)k * PINP) + (cq - cm[k]) - m); ls += e; axpyn<64>(o, e, vb + (size_t)k * PINP); }
        const float il = 1.f / ls;
#pragma unroll
        for (int j = 0; j < 64; ++j) o[j] *= il;
        store64(mix + (rb + t) * DM + 256 + 64 * h, o);
    }
}
__device__ void nv_attn_stick(const Params& p, int l) {
    const bf16_t* proj = (const bf16_t*)(p.ws + WS_PROJ); bf16_t* mix = (bf16_t*)(p.ws + WS_MIX);
    for (int idx = GTID(); idx < 4 * 4 * SEQ; idx += GSIZE()) {
        const int t = idx & (SEQ - 1), h = (idx >> 12) & 3, b = idx >> 14; const size_t rb = (size_t)b * SEQ;
        float q[64]; loadq_norm<64>(q, proj + (rb + t) * PINP + CC_Q + 64 * h, nullptr, 0.125f, false);
        const bf16_t* kb = proj + rb * PINP + CC_K + 64 * h; const bf16_t* vb = proj + rb * PINP + CC_V + 64 * h;
        float o[64], tail = 0.f;
#pragma unroll
        for (int j = 0; j < 64; ++j) o[j] = 0.f;
        for (int k = t - 1; k >= 0; --k) { const float z = dotn<64>(q, kb + (size_t)k * PINP); const float lb = logsigf(z);
            axpyn<64>(o, __expf(lb + tail), vb + (size_t)k * PINP); tail += lb - z; }
        store64(mix + (rb + t) * DM + 512 + 64 * h, o);
    }
}
__device__ void nv_nsa_stats(const Params& p, int l) {
    const bf16_t* proj = (const bf16_t*)(p.ws + WS_PROJ); const bf16_t* kc = (const bf16_t*)(p.ws + WS_KC);
    const float* tb = (const float*)(p.ws + WS_TB) + 512; float* ml = (float*)(p.ws + WS_ML);
    for (int idx = GTID(); idx < 4 * 4 * SEQ; idx += GSIZE()) {
        const int t = idx & (SEQ - 1), h = (idx >> 12) & 3, b = idx >> 14; const size_t row = (size_t)b * SEQ + t;
        float q[64]; loadq_norm<64>(q, proj + row * PINP + CD_Q + 64 * h, p.nsa_qn + l * 64, 0.125f, true);
        const int nmax = (t >= 31) ? (t - 31) / 16 : -1;
        float m = -INFINITY;
        for (int n = 0; n <= nmax; ++n) m = fmaxf(m, dotn<64>(q, kc + (size_t)(b * 256 + n) * 64) + tb[h * 128 + min(t - 16 * n - 31, 127)]);
        float ls = 0.f;
        for (int n = 0; n <= nmax; ++n) ls += __expf(dotn<64>(q, kc + (size_t)(b * 256 + n) * 64) + tb[h * 128 + min(t - 16 * n - 31, 127)] - m);
        ml[(row * 4 + h) * 2 + 0] = m; ml[(row * 4 + h) * 2 + 1] = ls;
    }
}
__device__ void nv_nsa_imp(const Params& p, int l) {
    const bf16_t* proj = (const bf16_t*)(p.ws + WS_PROJ); const bf16_t* kc = (const bf16_t*)(p.ws + WS_KC);
    const float* tb = (const float*)(p.ws + WS_TB) + 512; const float* ml = (const float*)(p.ws + WS_ML); float* imp = (float*)(p.ws + WS_IMP);
    for (int idx = GTID(); idx < MTOK * 64; idx += GSIZE()) {
        const int j = idx & 63; const size_t row = (size_t)(idx >> 6); const int t = (int)(row & (SEQ - 1)), b = (int)(row >> 12);
        float v;
        if (64 * j > t) v = -1.0f;
        else if (j == (t >> 6) || j == 0) v = 1.0e4f;
        else {
            const int nmax = (t >= 31) ? (t - 31) / 16 : -1; v = 0.f;
            for (int h = 0; h < 4; ++h) {
                float q[64]; loadq_norm<64>(q, proj + row * PINP + CD_Q + 64 * h, p.nsa_qn + l * 64, 0.125f, true);
                const float m = ml[(row * 4 + h) * 2], il = 1.f / ml[(row * 4 + h) * 2 + 1];
                for (int n = 4 * j - 1; n <= 4 * j + 3; ++n) if (n >= 0 && n <= nmax && n < 255)
                    v += __expf(dotn<64>(q, kc + (size_t)(b * 256 + n) * 64) + tb[h * 128 + min(t - 16 * n - 31, 127)] - m) * il;
            }
        }
        imp[idx] = v;
    }
}
__device__ void nv_nsa_topk(const Params& p) {
    const float* imp = (const float*)(p.ws + WS_IMP); unsigned long long* selm = (unsigned long long*)(p.ws + WS_SELM);
    for (int row = GTID(); row < MTOK; row += GSIZE()) {
        const float* v = imp + (size_t)row * 64; unsigned long long mask = 0ull;
        for (int j = 0; j < 64; ++j) { const float vj = v[j]; int rank = 0;
            for (int i = 0; i < 64; ++i) { const float vi = v[i]; rank += (vi > vj || (vi == vj && i < j)) ? 1 : 0; }
            if (rank < 16) mask |= (1ull << j); }
        selm[row] = mask;
    }
}
__device__ void nv_nsa_out(const Params& p, int l) {
    const bf16_t* proj = (const bf16_t*)(p.ws + WS_PROJ); bf16_t* mix = (bf16_t*)(p.ws + WS_MIX);
    const bf16_t* kc = (const bf16_t*)(p.ws + WS_KC); const bf16_t* vc = (const bf16_t*)(p.ws + WS_VC);
    const float* tb = (const float*)(p.ws + WS_TB) + 512; const float* ml = (const float*)(p.ws + WS_ML);
    const unsigned long long* selm = (const unsigned long long*)(p.ws + WS_SELM); const float* side = (const float*)(p.ws + WS_SIDE);
    for (int idx = GTID(); idx < 4 * 4 * SEQ; idx += GSIZE()) {
        const int t = idx & (SEQ - 1), h = (idx >> 12) & 3, b = idx >> 14; const size_t rb = (size_t)b * SEQ, row = rb + t;
        float q[64]; loadq_norm<64>(q, proj + row * PINP + CD_Q + 64 * h, p.nsa_qn + l * 64, 0.125f, true);
        const float* tbh = tb + h * 128;
        const float gc = 1.f / (1.f + __expf(-side[row * 16 + 4 + 0 * 4 + h])), gs = 1.f / (1.f + __expf(-side[row * 16 + 4 + 1 * 4 + h])), gwn = 1.f / (1.f + __expf(-side[row * 16 + 4 + 2 * 4 + h]));
        float acc[64];
#pragma unroll
        for (int j = 0; j < 64; ++j) acc[j] = 0.f;
        {
            const int nmax = (t >= 31) ? (t - 31) / 16 : -1; const float m = ml[(row * 4 + h) * 2], ls = ml[(row * 4 + h) * 2 + 1];
            const float f = (nmax >= 0) ? gc / ls : 0.f;
            for (int n = 0; n <= nmax; ++n) { const float e = __expf(dotn<64>(q, kc + (size_t)(b * 256 + n) * 64) + tbh[min(t - 16 * n - 31, 127)] - m); axpyn<64>(acc, e * f, vc + (size_t)(b * 256 + n) * 64); }
        }
        {
            const unsigned long long mask = selm[row]; const bf16_t* kb = proj + rb * PINP + CD_KS; const bf16_t* vb = proj + rb * PINP + CD_VS;
            float m = -INFINITY;
            for (int k = 0; k <= t; ++k) if ((mask >> (k >> 6)) & 1ull) m = fmaxf(m, dotn<64>(q, kb + (size_t)k * PINP) + tbh[min(t - k, 127)]);
            float ls = 0.f;
            for (int k = 0; k <= t; ++k) if ((mask >> (k >> 6)) & 1ull) ls += __expf(dotn<64>(q, kb + (size_t)k * PINP) + tbh[min(t - k, 127)] - m);
            const float f = gs / ls;
            for (int k = 0; k <= t; ++k) if ((mask >> (k >> 6)) & 1ull) { const float e = __expf(dotn<64>(q, kb + (size_t)k * PINP) + tbh[min(t - k, 127)] - m); axpyn<64>(acc, e * f, vb + (size_t)k * PINP); }
        }
        {
            const bf16_t* kb = proj + rb * PINP + CD_KW; const bf16_t* vb = proj + rb * PINP + CD_VW; const int k0 = max(0, t - 511);
            float m = -INFINITY;
            for (int k = k0; k <= t; ++k) m = fmaxf(m, dotn<64>(q, kb + (size_t)k * PINP) + tbh[min(t - k, 127)]);
            float ls = 0.f;
            for (int k = k0; k <= t; ++k) ls += __expf(dotn<64>(q, kb + (size_t)k * PINP) + tbh[min(t - k, 127)] - m);
            const float f = gwn / ls;
            for (int k = k0; k <= t; ++k) { const float e = __expf(dotn<64>(q, kb + (size_t)k * PINP) + tbh[min(t - k, 127)] - m); axpyn<64>(acc, e * f, vb + (size_t)k * PINP); }
        }
        store64(mix + row * DM + 768 + 64 * h, acc);
    }
}

__device__ void ph_act(const Params& p, int l) {
    const bf16_t* ug = (const bf16_t*)(p.ws + WS_UG); bf16_t* uv = (bf16_t*)(p.ws + WS_UV);
    const float* cw = p.conv_w + (size_t)l * 3 * DFF; const float* cb = p.conv_b + (size_t)l * DFF;
    constexpr int NC = DFF / 8;
    for (int idx = GTID(); idx < MTOK * NC; idx += GSIZE()) {
        const int c8 = (idx % NC) * 8; const size_t row = (size_t)(idx / NC); const int t = (int)(row & (SEQ - 1));
        float g0[8], g1[8], g2[8], v[8];
        load8(ug + row * DFF + c8, g0);
        if (t >= 1) load8(ug + (row - 1) * DFF + c8, g1); else {
#pragma unroll
            for (int j = 0; j < 8; ++j) g1[j] = 0.f; }
        if (t >= 2) load8(ug + (row - 2) * DFF + c8, g2); else {
#pragma unroll
            for (int j = 0; j < 8; ++j) g2[j] = 0.f; }
        load8(uv + row * DFF + c8, v);
        float o[8];
#pragma unroll
        for (int j = 0; j < 8; ++j) { const float cv = cw[c8 + j] * g2[j] + cw[DFF + c8 + j] * g1[j] + cw[2 * DFF + c8 + j] * g0[j] + cb[c8 + j]; o[j] = siluf(cv) * v[j]; }
        u32x4 w; w[0] = pk2(o[0], o[1]); w[1] = pk2(o[2], o[3]); w[2] = pk2(o[4], o[5]); w[3] = pk2(o[6], o[7]);
        *(u32x4*)(uv + row * DFF + c8) = w;
    }
}

__global__ void __launch_bounds__(NTHR) k_mod(Params p) { ph_mod(p); }
__global__ void __launch_bounds__(NTHR) k_p1(Params p, int l) {
    __shared__ float lds[8 * 32 * 33];
    ph_cbias(p, l); ph_weights(p, l, lds);
    if (l == 0) ph_xa_from(p, p.x, 0, 0, (bf16_t*)(p.ws + WS_XA), (float*)(p.ws + WS_RSA), true);
}
__global__ void __launch_bounds__(NTHR) k_rowss(Params p, int which) {
    ph_xa_from(p, p.out, 0, 0, nullptr, (float*)(p.ws + (which ? WS_RSB : WS_RSA)), false);
}
__global__ void __launch_bounds__(NTHR) k_gemm_proj(Params p, int l) {
    __shared__ __attribute__((aligned(16))) unsigned char lds[128 * 80 + 64 * 80];
    EpiProj E{(const float*)(p.ws + WS_RSA), (const float*)(p.ws + WS_CBIN) + (size_t)l * 4 * PINP, (bf16_t*)(p.ws + WS_PROJ), (float*)(p.ws + WS_SIDE)};
    gemm_simple((const bf16_t*)(p.ws + WS_XA), (const bf16_t*)(p.ws + WS_WIN), MTOK, PINP, DM, E, lds);
}
__global__ void __launch_bounds__(NTHR) k_gemm_out(Params p, int l) {
    __shared__ __attribute__((aligned(16))) unsigned char lds[128 * 80 + 64 * 80];
    const float* mod = (const float*)(p.ws + WS_MOD) + (size_t)l * 4 * 6144;
    EpiRes E{l == 0 ? p.x : p.out, p.out, mod + 2048, p.norm_ffn_g + l * DM, mod + 4096, (bf16_t*)(p.ws + WS_XA)};
    gemm_simple((const bf16_t*)(p.ws + WS_MIX), (const bf16_t*)(p.ws + WS_WOUT), MTOK, DM, DM, E, lds);
}
__global__ void __launch_bounds__(NTHR) k_gemm_up(Params p, int l) {
    __shared__ __attribute__((aligned(16))) unsigned char lds[128 * 80 + 64 * 80];
    EpiUp E{(const float*)(p.ws + WS_RSB), (const float*)(p.ws + WS_CBUP) + (size_t)l * 4 * NUP, (bf16_t*)(p.ws + WS_UG), (bf16_t*)(p.ws + WS_UV)};
    gemm_simple((const bf16_t*)(p.ws + WS_XA), (const bf16_t*)(p.ws + WS_WUP), MTOK, NUP, DM, E, lds);
}
__global__ void __launch_bounds__(NTHR) k_gemm_down(Params p, int l) {
    __shared__ __attribute__((aligned(16))) unsigned char lds[128 * 80 + 64 * 80];
    const float* mod = (const float*)(p.ws + WS_MOD) + (size_t)l * 4 * 6144;
    const float* modn = (const float*)(p.ws + WS_MOD) + (size_t)(l + 1) * 4 * 6144;
    EpiRes E{p.out, p.out, mod + 5120, p.norm_mix_g + (l + 1) * DM, modn + 1024, (l + 1 < DEPTH) ? (bf16_t*)(p.ws + WS_XA) : nullptr};
    gemm_simple((const bf16_t*)(p.ws + WS_UV), (const bf16_t*)(p.ws + WS_WDN), MTOK, DM, DFF, E, lds);
}
__global__ void __launch_bounds__(NTHR) k_prep(Params p, int l) {
    __shared__ __attribute__((aligned(16))) unsigned char lds[36864 + 16384];
    ph_prep_knorm(p, l); ph_prep_cum(p, l); ph_prep_cmp(p, l, lds);
}
__global__ void __launch_bounds__(NTHR) k_diff(Params p, int l) { nv_attn_diff(p, l); }
__global__ void __launch_bounds__(NTHR) k_fox(Params p, int l) { nv_attn_fox(p, l); }
__global__ void __launch_bounds__(NTHR) k_stick(Params p, int l) { nv_attn_stick(p, l); }
__global__ void __launch_bounds__(NTHR) k_nsa1(Params p, int l) { nv_nsa_stats(p, l); }
__global__ void __launch_bounds__(NTHR) k_nsa2(Params p, int l) { nv_nsa_imp(p, l); }
__global__ void __launch_bounds__(NTHR) k_nsa3(Params p) { nv_nsa_topk(p); }
__global__ void __launch_bounds__(NTHR) k_nsa4(Params p, int l) { nv_nsa_out(p, l); }
__global__ void __launch_bounds__(NTHR) k_act(Params p, int l) { ph_act(p, l); }

extern "C" void kernel_launch(void* const* d_in, const int* in_sizes, int n_in, void* d_out, int out_size, void* d_ws, size_t ws_size, hipStream_t stream) {
    if (n_in != 24 || ws_size < WS_END || out_size != MTOK * DM) { fprintf(stderr, "kernel_launch: unexpected sizes (n_in %d, ws %zu, out %d)\n", n_in, ws_size, out_size); return; }
    Params p{};
    const float** f = (const float**)&p;
    for (int i = 0; i < 24; ++i) f[i] = (const float*)d_in[i];
    p.out = (float*)d_out; p.ws = (unsigned char*)d_ws;
    const dim3 blk(NTHR);
    k_mod<<<dim3(24), blk, 0, stream>>>(p);
    for (int l = 0; l < DEPTH; ++l) {
        k_p1<<<dim3(1024), blk, 0, stream>>>(p, l);
        k_gemm_proj<<<dim3(128 * 48), blk, 0, stream>>>(p, l);
        k_prep<<<dim3(2048), blk, 0, stream>>>(p, l);
        k_diff<<<dim3(128), blk, 0, stream>>>(p, l);
        k_fox<<<dim3(128), blk, 0, stream>>>(p, l);
        k_stick<<<dim3(128), blk, 0, stream>>>(p, l);
        k_nsa1<<<dim3(128), blk, 0, stream>>>(p, l);
        k_nsa2<<<dim3(2048), blk, 0, stream>>>(p, l);
        k_nsa3<<<dim3(32), blk, 0, stream>>>(p);
        k_nsa4<<<dim3(128), blk, 0, stream>>>(p, l);
        k_gemm_out<<<dim3(128 * 16), blk, 0, stream>>>(p, l);
        k_rowss<<<dim3(1024), blk, 0, stream>>>(p, 1);
        k_gemm_up<<<dim3(128 * 88), blk, 0, stream>>>(p, l);
        k_act<<<dim3(4096), blk, 0, stream>>>(p, l);
        k_gemm_down<<<dim3(128 * 16), blk, 0, stream>>>(p, l);
        if (l + 1 < DEPTH) k_rowss<<<dim3(1024), blk, 0, stream>>>(p, 0);
    }
}
```

```cpp
#include <hip/hip_runtime.h>
#include <hip/hip_cooperative_groups.h>
#include <cstdint>
#include <cstdio>

typedef unsigned short bf16_t;
typedef short bf16x8 __attribute__((ext_vector_type(8)));
typedef float f32x4 __attribute__((ext_vector_type(4)));
typedef unsigned u32x4 __attribute__((ext_vector_type(4)));

constexpr int NB = 4, SEQ = 4096, DM = 1024, MTOK = NB * SEQ, DEPTH = 2;
constexpr int HD = 64, HPM = 4, DFF = 2816, PIN = 2960, PINP = 3072, NUP = 2 * DFF;
constexpr float EPS = 1e-6f;
constexpr int NTHR = 512;

constexpr int CA_Q = 0, CA_K = 256, CA_V = 512, CB_Q = 768, CB_K = 1024, CB_V = 1280, CC_Q = 1536, CC_K = 1792, CC_V = 2048;
constexpr int CD_Q = 2304, CD_KC = 2560, CD_VC = 2624, CD_KS = 2688, CD_VS = 2752, CD_KW = 2816, CD_VW = 2880, C_BF = 2944, C_DG = 2948;

constexpr size_t MiB = 1u << 20;
constexpr size_t WS_CTL = 0;
constexpr size_t WS_MOD = 1 * MiB;
constexpr size_t WS_CBIN = WS_MOD + 2 * 4 * 6144 * 4;
constexpr size_t WS_CBUP = WS_CBIN + 2 * 4 * 3072 * 4;
constexpr size_t WS_TB = WS_CBUP + 2 * 4 * 5632 * 4;
constexpr size_t WS_LAM = WS_TB + 2 * 4 * 128 * 4;
constexpr size_t WS_CUM = WS_LAM + 256;
constexpr size_t WS_KC = WS_CUM + 16 * 4096 * 4;
constexpr size_t WS_VC = WS_KC + 4 * 256 * 64 * 2;
constexpr size_t WS_SELM = WS_VC + 4 * 256 * 64 * 2;
constexpr size_t WS_SMALL_END = WS_SELM + 16384 * 8;
static_assert(WS_SMALL_END <= 4 * MiB, "small region");
constexpr size_t WS_RSA = 4 * MiB;
constexpr size_t WS_RSB = 5 * MiB;
constexpr size_t WS_SIDE = 6 * MiB;
constexpr size_t WS_IMP = 7 * MiB;
constexpr size_t WS_ML = 11 * MiB;
constexpr size_t WS_W = 12 * MiB;
constexpr size_t WS_WIN = WS_W;
constexpr size_t WS_WOUT = WS_WIN + (size_t)PINP * DM * 2;
constexpr size_t WS_WUP = WS_WOUT + (size_t)DM * DM * 2;
constexpr size_t WS_WDN = WS_WUP + (size_t)NUP * DM * 2;
constexpr size_t WS_W_END = WS_WDN + (size_t)DM * DFF * 2;
static_assert(WS_W_END <= 38 * MiB, "weights region");
constexpr size_t WS_XA = 38 * MiB;
constexpr size_t WS_BIG = 70 * MiB;
constexpr size_t WS_PROJ = WS_BIG;
constexpr size_t WS_MIX = WS_BIG + 96 * MiB;
constexpr size_t WS_UG = WS_BIG;
constexpr size_t WS_UV = WS_BIG + 88 * MiB;
constexpr size_t WS_END = WS_BIG + 176 * MiB;
static_assert(WS_END <= 256 * MiB, "workspace");

struct Params {
    const float *x, *c, *rel_bias, *ada_w, *ada_b, *norm_mix_g, *norm_ffn_g, *w_in, *w_out;
    const float *diff_qn, *diff_kn, *diff_lam, *diff_sub, *fox_qn, *fox_kn, *fox_bf;
    const float *nsa_qn, *nsa_kn, *nsa_pe, *nsa_phi, *w_up, *conv_w, *conv_b, *w_down;
    float* out;
    unsigned char* ws;
};

__device__ __forceinline__ float bf2f(bf16_t v) { return __uint_as_float(((unsigned)v) << 16); }
__device__ __forceinline__ bf16_t f2bf(float f) { unsigned u = __float_as_uint(f); return (bf16_t)((u + 0x7fffu + ((u >> 16) & 1u)) >> 16); }
__device__ __forceinline__ unsigned pk2(float lo, float hi) { return (unsigned)f2bf(lo) | ((unsigned)f2bf(hi) << 16); }
__device__ __forceinline__ float siluf(float v) { return v / (1.f + __expf(-v)); }
__device__ __forceinline__ float logsigf(float v) { return fminf(v, 0.f) - log1pf(__expf(-fabsf(v))); }
__device__ __forceinline__ float wave_sum(float v) {
#pragma unroll
    for (int o = 1; o < 64; o <<= 1) v += __shfl_xor(v, o);
    return v;
}
__device__ __forceinline__ int t5_bucket(int n) {
    if (n < 16) return n < 0 ? 0 : n;
    return 16 + (n >= 19) + (n >= 21) + (n >= 24) + (n >= 27) + (n >= 31) + (n >= 35) + (n >= 40) + (n >= 46) + (n >= 52) + (n >= 59) + (n >= 67) + (n >= 77) + (n >= 87) + (n >= 99) + (n >= 113);
}
__host__ __device__ __forceinline__ int in_col_map(int n) {
    if (n < 1536) return n;
    if (n < 2944) return n + 4;
    if (n < 2948) return 1536 + (n - 2944);
    if (n < 2960) return n;
    return -1;
}
__host__ __device__ __forceinline__ int up_col_map(int n) {
    const int pn = n >> 8, c = n & 255;
    return c < 128 ? (128 * pn + c) : (DFF + 128 * pn + (c - 128));
}

__device__ __forceinline__ int opaque_v(int v) { asm volatile("" : "+v"(v)); return v; }
#define TID() opaque_v((int)threadIdx.x)
#define GTID() ((int)(blockIdx.x * blockDim.x) + TID())
#define GSIZE() ((int)(gridDim.x * blockDim.x))

__device__ void ph_mod(const Params& p) {
    float* mod = (float*)(p.ws + WS_MOD);
    float* tb = (float*)(p.ws + WS_TB);
    float* lamv = (float*)(p.ws + WS_LAM);
    const int gt = GTID(), gs = GSIZE();
    for (int idx = gt; idx < DEPTH * 6144; idx += gs) {
        const int l = idx / 6144, j = idx % 6144;
        float a0 = 0.f, a1 = 0.f, a2 = 0.f, a3 = 0.f;
        const float* w = p.ada_w + (size_t)l * DM * 6144 + j;
        for (int k = 0; k < DM; ++k) {
            const float wv = w[(size_t)k * 6144];
            a0 += siluf(p.c[k]) * wv; a1 += siluf(p.c[DM + k]) * wv; a2 += siluf(p.c[2 * DM + k]) * wv; a3 += siluf(p.c[3 * DM + k]) * wv;
        }
        const float bb = p.ada_b[l * 6144 + j];
        mod[(l * 4 + 0) * 6144 + j] = a0 + bb; mod[(l * 4 + 1) * 6144 + j] = a1 + bb;
        mod[(l * 4 + 2) * 6144 + j] = a2 + bb; mod[(l * 4 + 3) * 6144 + j] = a3 + bb;
    }
    for (int idx = gt; idx < 2 * 4 * 128; idx += gs) {
        const int type = idx / 512, h = (idx / 128) & 3, d = idx & 127;
        tb[idx] = p.rel_bias[t5_bucket(d) * 8 + type * 4 + h];
    }
    for (int idx = gt; idx < DEPTH; idx += gs) {
        const float* lv = p.diff_lam + idx * 4 * 32;
        float s1 = 0.f, s2 = 0.f;
        for (int i = 0; i < 32; ++i) { s1 += lv[i] * lv[32 + i]; s2 += lv[64 + i] * lv[96 + i]; }
        const float lam_init = 0.8f - 0.6f * expf(-0.3f * (float)idx);
        lamv[idx] = expf(s1) - expf(s2) + lam_init;
    }
}

__device__ void ph_cbias(const Params& p, int l) {
    const float* mod = (const float*)(p.ws + WS_MOD);
    float* cbin = (float*)(p.ws + WS_CBIN) + (size_t)l * 4 * PINP;
    float* cbup = (float*)(p.ws + WS_CBUP) + (size_t)l * 4 * NUP;
    const int gt = GTID(), gs = GSIZE();
    for (int idx = gt; idx < PINP + NUP; idx += gs) {
        const bool isin = idx < PINP;
        const int n = isin ? idx : idx - PINP;
        const int oc = isin ? in_col_map(n) : up_col_map(n);
        const int ncol = isin ? PIN : NUP;
        const float* W = (isin ? p.w_in + (size_t)l * DM * PIN : p.w_up + (size_t)l * DM * NUP);
        const int shoff = isin ? 0 : 3072;
        float a0 = 0.f, a1 = 0.f, a2 = 0.f, a3 = 0.f;
        if (oc >= 0) {
            for (int k = 0; k < DM; ++k) {
                const float wv = W[(size_t)k * ncol + oc];
                a0 += mod[(l * 4 + 0) * 6144 + shoff + k] * wv; a1 += mod[(l * 4 + 1) * 6144 + shoff + k] * wv;
                a2 += mod[(l * 4 + 2) * 6144 + shoff + k] * wv; a3 += mod[(l * 4 + 3) * 6144 + shoff + k] * wv;
            }
        }
        float* o = isin ? cbin : cbup; const int ld = isin ? PINP : NUP;
        o[0 * ld + n] = a0; o[1 * ld + n] = a1; o[2 * ld + n] = a2; o[3 * ld + n] = a3;
    }
}
template <int MAPK>
__device__ void convert_weight(const float* W, int K, int Nsrc, int Npad, bf16_t* Wt, float* scr  , int gw, int ngw, int lane) {
    const int nkb = K / 32, nnb = Npad / 32;
    for (int it = gw; it < nkb * nnb; it += ngw) {
        const int kb = it / nnb, nb = it % nnb, k0 = kb * 32, n0 = nb * 32;
        {
            const int nn = lane & 31; const int n = n0 + nn;
            const int oc = MAPK == 0 ? n : (MAPK == 1 ? in_col_map(n) : up_col_map(n));
#pragma unroll 4
            for (int i = 0; i < 16; ++i) { const int kk = 2 * i + (lane >> 5); scr[kk * 33 + nn] = (oc >= 0) ? W[(size_t)(k0 + kk) * Nsrc + oc] : 0.f; }
        }
        __builtin_amdgcn_s_waitcnt(0); __builtin_amdgcn_wave_barrier();
        {
            const int kk2 = (lane & 15) * 2;
#pragma unroll 4
            for (int i = 0; i < 8; ++i) { const int nn = 4 * i + (lane >> 4);
                *(unsigned*)(Wt + (size_t)(n0 + nn) * K + k0 + kk2) = pk2(scr[kk2 * 33 + nn], scr[(kk2 + 1) * 33 + nn]); }
        }
        __builtin_amdgcn_s_waitcnt(0); __builtin_amdgcn_wave_barrier();
    }
}
__device__ void ph_weights(const Params& p, int l, float* lds) {
    const int tid_ = TID(); const int lane = tid_ & 63, wv = tid_ >> 6;
    const int gw = blockIdx.x * (blockDim.x >> 6) + wv, ngw = gridDim.x * (blockDim.x >> 6);
    float* scr = lds + wv * (32 * 33);
    convert_weight<1>(p.w_in + (size_t)l * DM * PIN, DM, PIN, PINP, (bf16_t*)(p.ws + WS_WIN), scr, gw, ngw, lane);
    convert_weight<0>(p.w_out + (size_t)l * DM * DM, DM, DM, DM, (bf16_t*)(p.ws + WS_WOUT), scr, gw, ngw, lane);
    convert_weight<2>(p.w_up + (size_t)l * DM * NUP, DM, NUP, NUP, (bf16_t*)(p.ws + WS_WUP), scr, gw, ngw, lane);
    convert_weight<0>(p.w_down + (size_t)l * DFF * DM, DFF, DM, DM, (bf16_t*)(p.ws + WS_WDN), scr, gw, ngw, lane);
}
__device__ void ph_xa_from(const Params& p, const float* src, int l, int which  , bf16_t* XA, float* rowss, bool write_xa) {
    const float* mod = (const float*)(p.ws + WS_MOD);
    const float* g = (which == 0 ? p.norm_mix_g : p.norm_ffn_g) + l * DM;
    const int tid_ = TID(); const int lane = tid_ & 63, wv = tid_ >> 6;
    const int gw = blockIdx.x * (blockDim.x >> 6) + wv, ngw = gridDim.x * (blockDim.x >> 6);
    for (int row = gw; row < MTOK; row += ngw) {
        const int b = row / SEQ;
        const float* sc = mod + (size_t)(l * 4 + b) * 6144 + (which == 0 ? 1024 : 4096);
        float ss = 0.f;
#pragma unroll
        for (int j = 0; j < 4; ++j) {
            const int k = j * 256 + lane * 4;
            const f32x4 v = *(const f32x4*)(src + (size_t)row * DM + k);
            ss += v[0] * v[0] + v[1] * v[1] + v[2] * v[2] + v[3] * v[3];
            if (write_xa) {
                const f32x4 gv = *(const f32x4*)(g + k); const f32x4 sv = *(const f32x4*)(sc + k);
                uint2 o; o.x = pk2(v[0] * gv[0] * (1.f + sv[0]), v[1] * gv[1] * (1.f + sv[1])); o.y = pk2(v[2] * gv[2] * (1.f + sv[2]), v[3] * gv[3] * (1.f + sv[3]));
                *(uint2*)(XA + (size_t)row * DM + k) = o;
            }
        }
        ss = wave_sum(ss);
        if (lane < 16) rowss[(size_t)row * 16 + lane] = (lane == 0) ? ss : 0.f;
    }
}

template <class Epi>
__device__ void gemm_simple(const bf16_t* A, const bf16_t* Bt, int M, int N, int K, const Epi& E, unsigned char* lds) {
    bf16_t* sA = (bf16_t*)lds;
    bf16_t* sB = (bf16_t*)(lds + 128 * 80);
    const int tid = TID(), lane = tid & 63, w = tid >> 6, fr = lane & 15, fq = lane >> 4;
    const int ntn = N / 64, ntm = M / 128;
    for (int tile = blockIdx.x; tile < ntn * ntm; tile += gridDim.x) {
        const int tm = tile / ntn, tn = tile % ntn, m0 = tm * 128, n0 = tn * 64;
        f32x4 acc[4];
#pragma unroll
        for (int i = 0; i < 4; ++i) acc[i] = (f32x4){0.f, 0.f, 0.f, 0.f};
        for (int k0 = 0; k0 < K; k0 += 32) {
            { const int r = tid >> 2, ch = tid & 3; *(u32x4*)(sA + r * 40 + ch * 8) = *(const u32x4*)(A + (size_t)(m0 + r) * K + k0 + ch * 8); }
            if (tid < 256) { const int r = tid >> 2, ch = tid & 3; *(u32x4*)(sB + r * 40 + ch * 8) = *(const u32x4*)(Bt + (size_t)(n0 + r) * K + k0 + ch * 8); }
            __syncthreads();
            const bf16x8 a = *(const bf16x8*)(sA + (16 * w + fr) * 40 + fq * 8);
#pragma unroll
            for (int nt = 0; nt < 4; ++nt) {
                const bf16x8 b = *(const bf16x8*)(sB + (16 * nt + fr) * 40 + fq * 8);
                acc[nt] = __builtin_amdgcn_mfma_f32_16x16x32_bf16(a, b, acc[nt], 0, 0, 0);
            }
            __syncthreads();
        }
#pragma unroll
        for (int nt = 0; nt < 4; ++nt)
#pragma unroll
            for (int j = 0; j < 4; ++j) E(m0 + 16 * w + fq * 4 + j, n0 + 16 * nt + fr, acc[nt][j]);
    }
}
__device__ __forceinline__ float row_rstd(const float* rowss, int row) {
    const f32x4* r = (const f32x4*)(rowss + (size_t)row * 16);
    const f32x4 a = r[0], b = r[1], c = r[2], d = r[3];
    const float s = ((a[0] + a[1]) + (a[2] + a[3])) + ((b[0] + b[1]) + (b[2] + b[3])) + ((c[0] + c[1]) + (c[2] + c[3])) + ((d[0] + d[1]) + (d[2] + d[3]));
    return rsqrtf(s * (1.f / DM) + EPS);
}
struct EpiProj {
    const float* rowss; const float* cb; bf16_t* proj; float* side;
    __device__ void operator()(int row, int col, float v) const {
        const int b = row / SEQ; const float o = v * row_rstd(rowss, row) + cb[b * PINP + col];
        proj[(size_t)row * PINP + col] = f2bf(o);
        if (col >= C_BF && col < PIN) side[(size_t)row * 16 + (col - C_BF)] = o;
    }
};
struct EpiRes {
    const float* xin; float* xout; const float* mod_gate;
    const float* g; const float* mod_sc; bf16_t* xa;
    __device__ void operator()(int row, int col, float v) const {
        const int b = row / SEQ; const float o = xin[(size_t)row * DM + col] + mod_gate[b * 6144 + col] * v;
        xout[(size_t)row * DM + col] = o;
        if (xa) xa[(size_t)row * DM + col] = f2bf(o * g[col] * (1.f + mod_sc[b * 6144 + col]));
    }
};
struct EpiUp {
    const float* rowss; const float* cb; bf16_t* ug; bf16_t* uv;
    __device__ void operator()(int row, int col, float v) const {
        const int b = row / SEQ; const float o = v * row_rstd(rowss, row) + cb[b * NUP + col];
        const int pn = col >> 8, c = col & 255;
        if (c < 128) ug[(size_t)row * DFF + 128 * pn + c] = f2bf(o); else uv[(size_t)row * DFF + 128 * pn + (c - 128)] = f2bf(o);
    }
};

__device__ void ph_prep_knorm(const Params& p, int l) {
    bf16_t* proj = (bf16_t*)(p.ws + WS_PROJ);
    const int tid_ = TID(); const int lane = tid_ & 63, wv = tid_ >> 6;
    const int gw = blockIdx.x * (blockDim.x >> 6) + wv, ngw = gridDim.x * (blockDim.x >> 6);
    for (int row = gw; row < MTOK; row += ngw) {
        bf16_t* pr = proj + (size_t)row * PINP;
        {
            uint2 raw = *(const uint2*)(pr + CA_K + 4 * lane);
            float v0 = bf2f(raw.x & 0xffff), v1 = bf2f(raw.x >> 16), v2 = bf2f(raw.y & 0xffff), v3 = bf2f(raw.y >> 16);
            float ss = v0 * v0 + v1 * v1 + v2 * v2 + v3 * v3;
            ss += __shfl_xor(ss, 1); ss += __shfl_xor(ss, 2); ss += __shfl_xor(ss, 4);
            const float r = rsqrtf(ss * (1.f / 32.f) + EPS); const float* g = p.diff_kn + l * 32 + ((4 * lane) & 31);
            raw.x = pk2(v0 * r * g[0], v1 * r * g[1]); raw.y = pk2(v2 * r * g[2], v3 * r * g[3]);
            *(uint2*)(pr + CA_K + 4 * lane) = raw;
        }
        {
            uint2 raw = *(const uint2*)(pr + CB_K + 4 * lane);
            float v0 = bf2f(raw.x & 0xffff), v1 = bf2f(raw.x >> 16), v2 = bf2f(raw.y & 0xffff), v3 = bf2f(raw.y >> 16);
            float ss = v0 * v0 + v1 * v1 + v2 * v2 + v3 * v3;
            ss += __shfl_xor(ss, 1); ss += __shfl_xor(ss, 2); ss += __shfl_xor(ss, 4); ss += __shfl_xor(ss, 8);
            const float r = rsqrtf(ss * (1.f / 64.f) + EPS); const float* g = p.fox_kn + l * 64 + ((4 * lane) & 63);
            raw.x = pk2(v0 * r * g[0], v1 * r * g[1]); raw.y = pk2(v2 * r * g[2], v3 * r * g[3]);
            *(uint2*)(pr + CB_K + 4 * lane) = raw;
        }
        {
            const int hi = lane >> 5, li = lane & 31; bf16_t* q = pr + (hi ? CD_KW : CD_KS) + 2 * li;
            unsigned raw = *(const unsigned*)q; float v0 = bf2f(raw & 0xffff), v1 = bf2f(raw >> 16);
            float ss = v0 * v0 + v1 * v1;
            ss += __shfl_xor(ss, 1); ss += __shfl_xor(ss, 2); ss += __shfl_xor(ss, 4); ss += __shfl_xor(ss, 8); ss += __shfl_xor(ss, 16);
            const float r = rsqrtf(ss * (1.f / 64.f) + EPS); const float* g = p.nsa_kn + (l * 3 + (hi ? 2 : 1)) * 64 + 2 * li;
            *(unsigned*)q = pk2(v0 * r * g[0], v1 * r * g[1]);
        }
    }
}
__device__ void ph_prep_cum(const Params& p, int l) {
    const float* side = (const float*)(p.ws + WS_SIDE);
    float* cum = (float*)(p.ws + WS_CUM);
    const int tid_ = TID(); const int lane = tid_ & 63, wv = tid_ >> 6;
    const int gw = blockIdx.x * (blockDim.x >> 6) + wv, ngw = gridDim.x * (blockDim.x >> 6);
    for (int bh = gw; bh < 16; bh += ngw) {
        const int b = bh >> 2, h = bh & 3; const float bf = p.fox_bf[l * 4 + h];
        float tot = 0.f;
        for (int i = 0; i < 64; ++i) tot += logsigf(side[(size_t)(b * SEQ + lane * 64 + i) * 16 + h] + bf);
        float inc = tot;
#pragma unroll
        for (int o = 1; o < 64; o <<= 1) { const float v = __shfl_up(inc, o); if (lane >= o) inc += v; }
        float run = inc - tot;
        for (int i = 0; i < 64; ++i) { run += logsigf(side[(size_t)(b * SEQ + lane * 64 + i) * 16 + h] + bf); cum[bh * SEQ + lane * 64 + i] = run; }
    }
}
__device__ void ph_prep_cmp(const Params& p, int l, unsigned char* lds) {
    const bf16_t* proj = (const bf16_t*)(p.ws + WS_PROJ);
    float* win = (float*)lds; float* red = (float*)(lds + 36864);
    const int tid = TID(), e = tid & 63, part = tid >> 6;
    for (int item = blockIdx.x; item < 4 * 2 * 32; item += gridDim.x) {
        const int b = item >> 6, which = (item >> 5) & 1, n0 = (item & 31) * 8;
        const int colbase = which ? CD_VC : CD_KC;
        __syncthreads();
        for (int i = tid; i < 144 * 64; i += NTHR) { const int tk = 16 * n0 + (i >> 6); win[i] = tk < SEQ ? bf2f(proj[(size_t)(b * SEQ + tk) * PINP + colbase + (i & 63)]) : 0.f; }
        __syncthreads();
        float acc[8];
#pragma unroll
        for (int nn = 0; nn < 8; ++nn) acc[nn] = 0.f;
        const float* phi = p.nsa_phi + (size_t)(l * 2 + which) * 2048 * 64; const float* pe = p.nsa_pe + (size_t)(l * 2 + which) * 32 * 64;
        for (int i = 4 * part; i < 4 * part + 4; ++i)
            for (int d = 0; d < 64; ++d) {
                const float ph = phi[(size_t)(i * 64 + d) * 64 + e], pv = pe[i * 64 + d];
#pragma unroll
                for (int nn = 0; nn < 8; ++nn) acc[nn] += (win[(16 * nn + i) * 64 + d] + pv) * ph;
            }
#pragma unroll
        for (int nn = 0; nn < 8; ++nn) red[(part * 8 + nn) * 64 + e] = acc[nn];
        __syncthreads();
        {
            const int nn = part, n = n0 + nn; float v = 0.f;
#pragma unroll
            for (int pp = 0; pp < 8; ++pp) v += red[(pp * 8 + nn) * 64 + e];
            bf16_t* dst = (bf16_t*)(p.ws + (which ? WS_VC : WS_KC)) + (size_t)(b * 256 + n) * 64 + e;
            if (n >= 255) *dst = 0;
            else if (which == 0) { const float ss = wave_sum(v * v); *dst = f2bf(v * rsqrtf(ss * (1.f / 64.f) + EPS) * p.nsa_kn[(l * 3 + 0) * 64 + e]); }
            else *dst = f2bf(v);
        }
    }
}

__device__ __forceinline__ void load8(const bf16_t* p, float* d) {
    const u32x4 r = *(const u32x4*)p;
    d[0] = bf2f(r[0] & 0xffff); d[1] = bf2f(r[0] >> 16); d[2] = bf2f(r[1] & 0xffff); d[3] = bf2f(r[1] >> 16);
    d[4] = bf2f(r[2] & 0xffff); d[5] = bf2f(r[2] >> 16); d[6] = bf2f(r[3] & 0xffff); d[7] = bf2f(r[3] >> 16);
}
template <int N> __device__ __forceinline__ float dotn(const float* q, const bf16_t* k) {
    float s = 0.f;
#pragma unroll
    for (int c = 0; c < N / 8; ++c) { float t[8]; load8(k + 8 * c, t);
#pragma unroll
        for (int j = 0; j < 8; ++j) s += q[8 * c + j] * t[j]; }
    return s;
}
template <int N> __device__ __forceinline__ void axpyn(float* o, float w, const bf16_t* v) {
#pragma unroll
    for (int c = 0; c < N / 8; ++c) { float t[8]; load8(v + 8 * c, t);
#pragma unroll
        for (int j = 0; j < 8; ++j) o[8 * c + j] += w * t[j]; }
}
template <int N> __device__ __forceinline__ void loadq_norm(float* q, const bf16_t* src, const float* g, float scale, bool norm) {
    float ss = 0.f;
#pragma unroll
    for (int c = 0; c < N / 8; ++c) load8(src + 8 * c, q + 8 * c);
#pragma unroll
    for (int j = 0; j < N; ++j) ss += q[j] * q[j];
    const float r = norm ? rsqrtf(ss * (1.f / N) + EPS) : 1.f;
#pragma unroll
    for (int j = 0; j < N; ++j) q[j] = q[j] * r * (norm ? g[j] : 1.f) * scale;
}
__device__ __forceinline__ void store64(bf16_t* dst, const float* o) {
#pragma unroll
    for (int c = 0; c < 8; ++c) { u32x4 w; w[0] = pk2(o[8 * c], o[8 * c + 1]); w[1] = pk2(o[8 * c + 2], o[8 * c + 3]); w[2] = pk2(o[8 * c + 4], o[8 * c + 5]); w[3] = pk2(o[8 * c + 6], o[8 * c + 7]); *(u32x4*)(dst + 8 * c) = w; }
}

__device__ void nv_attn_diff(const Params& p, int l) {
    const bf16_t* proj = (const bf16_t*)(p.ws + WS_PROJ); bf16_t* mix = (bf16_t*)(p.ws + WS_MIX);
    const float* tb = (const float*)(p.ws + WS_TB); const float lam = ((const float*)(p.ws + WS_LAM))[l];
    const float lam_init = 0.8f - 0.6f * expf(-0.3f * (float)l);
    const float scale = 0.17677669529663687f;
    for (int idx = GTID(); idx < 4 * 4 * SEQ; idx += GSIZE()) {
        const int t = idx & (SEQ - 1), h = (idx >> 12) & 3, b = idx >> 14; const size_t rb = (size_t)b * SEQ;
        float q[64];
        loadq_norm<32>(q, proj + (rb + t) * PINP + CA_Q + 64 * h, p.diff_qn + l * 32, scale, true);
        loadq_norm<32>(q + 32, proj + (rb + t) * PINP + CA_Q + 64 * h + 32, p.diff_qn + l * 32, scale, true);
        const float* tbh = tb + h * 128;
        const bf16_t* kb = proj + rb * PINP + CA_K + 64 * h; const bf16_t* vb = proj + rb * PINP + CA_V + 64 * h;
        float m1 = -INFINITY, m2 = -INFINITY;
        for (int k = 0; k <= t; ++k) { const float bias = tbh[min(t - k, 127)];
            const float s1 = dotn<32>(q, kb + (size_t)k * PINP) + bias, s2 = dotn<32>(q + 32, kb + (size_t)k * PINP + 32) + bias; m1 = fmaxf(m1, s1); m2 = fmaxf(m2, s2); }
        float l1 = 0.f, l2 = 0.f;
        for (int k = 0; k <= t; ++k) { const float bias = tbh[min(t - k, 127)];
            const float s1 = dotn<32>(q, kb + (size_t)k * PINP) + bias, s2 = dotn<32>(q + 32, kb + (size_t)k * PINP + 32) + bias; l1 += __expf(s1 - m1); l2 += __expf(s2 - m2); }
        float o[64];
#pragma unroll
        for (int j = 0; j < 64; ++j) o[j] = 0.f;
        const float i1 = 1.f / l1, i2 = lam / l2;
        for (int k = 0; k <= t; ++k) { const float bias = tbh[min(t - k, 127)];
            const float s1 = dotn<32>(q, kb + (size_t)k * PINP) + bias, s2 = dotn<32>(q + 32, kb + (size_t)k * PINP + 32) + bias;
            const float w = __expf(s1 - m1) * i1 - __expf(s2 - m2) * i2; axpyn<64>(o, w, vb + (size_t)k * PINP); }
        float ss = 0.f;
#pragma unroll
        for (int j = 0; j < 64; ++j) ss += o[j] * o[j];
        const float r = rsqrtf(ss * (1.f / 64.f) + EPS) * (1.f - lam_init);
#pragma unroll
        for (int j = 0; j < 64; ++j) o[j] = o[j] * r * p.diff_sub[l * 64 + j];
        store64(mix + (rb + t) * DM + 0 + 64 * h, o);
    }
}
__device__ void nv_attn_fox(const Params& p, int l) {
    const bf16_t* proj = (const bf16_t*)(p.ws + WS_PROJ); bf16_t* mix = (bf16_t*)(p.ws + WS_MIX);
    const float* cum = (const float*)(p.ws + WS_CUM);
    for (int idx = GTID(); idx < 4 * 4 * SEQ; idx += GSIZE()) {
        const int t = idx & (SEQ - 1), h = (idx >> 12) & 3, b = idx >> 14; const size_t rb = (size_t)b * SEQ;
        float q[64]; loadq_norm<64>(q, proj + (rb + t) * PINP + CB_Q + 64 * h, p.fox_qn + l * 64, 0.125f, true);
        const bf16_t* kb = proj + rb * PINP + CB_K + 64 * h; const bf16_t* vb = proj + rb * PINP + CB_V + 64 * h;
        const float* cm = cum + (b * 4 + h) * SEQ; const float cq = cm[t];
        float m = -INFINITY;
        for (int k = 0; k <= t; ++k) m = fmaxf(m, dotn<64>(q, kb + (size_t)k * PINP) + (cq - cm[k]));
        float o[64], ls = 0.f;
#pragma unroll
        for (int j = 0; j < 64; ++j) o[j] = 0.f;
        for (int k = 0; k <= t; ++k) { const float e = __expf(dotn<64>(q, kb + (size_t)k * PINP) + (cq - cm[k]) - m); ls += e; axpyn<64>(o, e, vb + (size_t)k * PINP); }
        const float il = 1.f / ls;
#pragma unroll
        for (int j = 0; j < 64; ++j) o[j] *= il;
        store64(mix + (rb + t) * DM + 256 + 64 * h, o);
    }
}
__device__ void nv_attn_stick(const Params& p, int l) {
    const bf16_t* proj = (const bf16_t*)(p.ws + WS_PROJ); bf16_t* mix = (bf16_t*)(p.ws + WS_MIX);
    for (int idx = GTID(); idx < 4 * 4 * SEQ; idx += GSIZE()) {
        const int t = idx & (SEQ - 1), h = (idx >> 12) & 3, b = idx >> 14; const size_t rb = (size_t)b * SEQ;
        float q[64]; loadq_norm<64>(q, proj + (rb + t) * PINP + CC_Q + 64 * h, nullptr, 0.125f, false);
        const bf16_t* kb = proj + rb * PINP + CC_K + 64 * h; const bf16_t* vb = proj + rb * PINP + CC_V + 64 * h;
        float o[64], tail = 0.f;
#pragma unroll
        for (int j = 0; j < 64; ++j) o[j] = 0.f;
        for (int k = t - 1; k >= 0; --k) { const float z = dotn<64>(q, kb + (size_t)k * PINP); const float lb = logsigf(z);
            axpyn<64>(o, __expf(lb + tail), vb + (size_t)k * PINP); tail += lb - z; }
        store64(mix + (rb + t) * DM + 512 + 64 * h, o);
    }
}
__device__ void nv_nsa_stats(const Params& p, int l) {
    const bf16_t* proj = (const bf16_t*)(p.ws + WS_PROJ); const bf16_t* kc = (const bf16_t*)(p.ws + WS_KC);
    const float* tb = (const float*)(p.ws + WS_TB) + 512; float* ml = (float*)(p.ws + WS_ML);
    for (int idx = GTID(); idx < 4 * 4 * SEQ; idx += GSIZE()) {
        const int t = idx & (SEQ - 1), h = (idx >> 12) & 3, b = idx >> 14; const size_t row = (size_t)b * SEQ + t;
        float q[64]; loadq_norm<64>(q, proj + row * PINP + CD_Q + 64 * h, p.nsa_qn + l * 64, 0.125f, true);
        const int nmax = (t >= 31) ? (t - 31) / 16 : -1;
        float m = -INFINITY;
        for (int n = 0; n <= nmax; ++n) m = fmaxf(m, dotn<64>(q, kc + (size_t)(b * 256 + n) * 64) + tb[h * 128 + min(t - 16 * n - 31, 127)]);
        float ls = 0.f;
        for (int n = 0; n <= nmax; ++n) ls += __expf(dotn<64>(q, kc + (size_t)(b * 256 + n) * 64) + tb[h * 128 + min(t - 16 * n - 31, 127)] - m);
        ml[(row * 4 + h) * 2 + 0] = m; ml[(row * 4 + h) * 2 + 1] = ls;
    }
}
__device__ void nv_nsa_imp(const Params& p, int l) {
    const bf16_t* proj = (const bf16_t*)(p.ws + WS_PROJ); const bf16_t* kc = (const bf16_t*)(p.ws + WS_KC);
    const float* tb = (const float*)(p.ws + WS_TB) + 512; const float* ml = (const float*)(p.ws + WS_ML); float* imp = (float*)(p.ws + WS_IMP);
    for (int idx = GTID(); idx < MTOK * 64; idx += GSIZE()) {
        const int j = idx & 63; const size_t row = (size_t)(idx >> 6); const int t = (int)(row & (SEQ - 1)), b = (int)(row >> 12);
        float v;
        if (64 * j > t) v = -1.0f;
        else if (j == (t >> 6) || j == 0) v = 1.0e4f;
        else {
            const int nmax = (t >= 31) ? (t - 31) / 16 : -1; v = 0.f;
            for (int h = 0; h < 4; ++h) {
                float q[64]; loadq_norm<64>(q, proj + row * PINP + CD_Q + 64 * h, p.nsa_qn + l * 64, 0.125f, true);
                const float m = ml[(row * 4 + h) * 2], il = 1.f / ml[(row * 4 + h) * 2 + 1];
                for (int n = 4 * j - 1; n <= 4 * j + 3; ++n) if (n >= 0 && n <= nmax && n < 255)
                    v += __expf(dotn<64>(q, kc + (size_t)(b * 256 + n) * 64) + tb[h * 128 + min(t - 16 * n - 31, 127)] - m) * il;
            }
        }
        imp[idx] = v;
    }
}
__device__ void nv_nsa_topk(const Params& p) {
    const float* imp = (const float*)(p.ws + WS_IMP); unsigned long long* selm = (unsigned long long*)(p.ws + WS_SELM);
    for (int row = GTID(); row < MTOK; row += GSIZE()) {
        const float* v = imp + (size_t)row * 64; unsigned long long mask = 0ull;
        for (int j = 0; j < 64; ++j) { const float vj = v[j]; int rank = 0;
            for (int i = 0; i < 64; ++i) { const float vi = v[i]; rank += (vi > vj || (vi == vj && i < j)) ? 1 : 0; }
            if (rank < 16) mask |= (1ull << j); }
        selm[row] = mask;
    }
}
__device__ void nv_nsa_out(const Params& p, int l) {
    const bf16_t* proj = (const bf16_t*)(p.ws + WS_PROJ); bf16_t* mix = (bf16_t*)(p.ws + WS_MIX);
    const bf16_t* kc = (const bf16_t*)(p.ws + WS_KC); const bf16_t* vc = (const bf16_t*)(p.ws + WS_VC);
    const float* tb = (const float*)(p.ws + WS_TB) + 512; const float* ml = (const float*)(p.ws + WS_ML);
    const unsigned long long* selm = (const unsigned long long*)(p.ws + WS_SELM); const float* side = (const float*)(p.ws + WS_SIDE);
    for (int idx = GTID(); idx < 4 * 4 * SEQ; idx += GSIZE()) {
        const int t = idx & (SEQ - 1), h = (idx >> 12) & 3, b = idx >> 14; const size_t rb = (size_t)b * SEQ, row = rb + t;
        float q[64]; loadq_norm<64>(q, proj + row * PINP + CD_Q + 64 * h, p.nsa_qn + l * 64, 0.125f, true);
        const float* tbh = tb + h * 128;
        const float gc = 1.f / (1.f + __expf(-side[row * 16 + 4 + 0 * 4 + h])), gs = 1.f / (1.f + __expf(-side[row * 16 + 4 + 1 * 4 + h])), gwn = 1.f / (1.f + __expf(-side[row * 16 + 4 + 2 * 4 + h]));
        float acc[64];
#pragma unroll
        for (int j = 0; j < 64; ++j) acc[j] = 0.f;
        {
            const int nmax = (t >= 31) ? (t - 31) / 16 : -1; const float m = ml[(row * 4 + h) * 2], ls = ml[(row * 4 + h) * 2 + 1];
            const float f = (nmax >= 0) ? gc / ls : 0.f;
            for (int n = 0; n <= nmax; ++n) { const float e = __expf(dotn<64>(q, kc + (size_t)(b * 256 + n) * 64) + tbh[min(t - 16 * n - 31, 127)] - m); axpyn<64>(acc, e * f, vc + (size_t)(b * 256 + n) * 64); }
        }
        {
            const unsigned long long mask = selm[row]; const bf16_t* kb = proj + rb * PINP + CD_KS; const bf16_t* vb = proj + rb * PINP + CD_VS;
            float m = -INFINITY;
            for (int k = 0; k <= t; ++k) if ((mask >> (k >> 6)) & 1ull) m = fmaxf(m, dotn<64>(q, kb + (size_t)k * PINP) + tbh[min(t - k, 127)]);
            float ls = 0.f;
            for (int k = 0; k <= t; ++k) if ((mask >> (k >> 6)) & 1ull) ls += __expf(dotn<64>(q, kb + (size_t)k * PINP) + tbh[min(t - k, 127)] - m);
            const float f = gs / ls;
            for (int k = 0; k <= t; ++k) if ((mask >> (k >> 6)) & 1ull) { const float e = __expf(dotn<64>(q, kb + (size_t)k * PINP) + tbh[min(t - k, 127)] - m); axpyn<64>(acc, e * f, vb + (size_t)k * PINP); }
        }
        {
            const bf16_t* kb = proj + rb * PINP + CD_KW; const bf16_t* vb = proj + rb * PINP + CD_VW; const int k0 = max(0, t - 511);
            float m = -INFINITY;
            for (int k = k0; k <= t; ++k) m = fmaxf(m, dotn<64>(q, kb + (size_t)k * PINP) + tbh[min(t - k, 127)]);
            float ls = 0.f;
            for (int k = k0; k <= t; ++k) ls += __expf(dotn<64>(q, kb + (size_t)k * PINP) + tbh[min(t - k, 127)] - m);
            const float f = gwn / ls;
            for (int k = k0; k <= t; ++k) { const float e = __expf(dotn<64>(q, kb + (size_t)k * PINP) + tbh[min(t - k, 127)] - m); axpyn<64>(acc, e * f, vb + (size_t)k * PINP); }
        }
        store64(mix + row * DM + 768 + 64 * h, acc);
    }
}

__device__ void ph_act(const Params& p, int l) {
    const bf16_t* ug = (const bf16_t*)(p.ws + WS_UG); bf16_t* uv = (bf16_t*)(p.ws + WS_UV);
    const float* cw = p.conv_w + (size_t)l * 3 * DFF; const float* cb = p.conv_b + (size_t)l * DFF;
    constexpr int NC = DFF / 8;
    for (int idx = GTID(); idx < MTOK * NC; idx += GSIZE()) {
        const int c8 = (idx % NC) * 8; const size_t row = (size_t)(idx / NC); const int t = (int)(row & (SEQ - 1));
        float g0[8], g1[8], g2[8], v[8];
        load8(ug + row * DFF + c8, g0);
        if (t >= 1) load8(ug + (row - 1) * DFF + c8, g1); else {
#pragma unroll
            for (int j = 0; j < 8; ++j) g1[j] = 0.f; }
        if (t >= 2) load8(ug + (row - 2) * DFF + c8, g2); else {
#pragma unroll
            for (int j = 0; j < 8; ++j) g2[j] = 0.f; }
        load8(uv + row * DFF + c8, v);
        float o[8];
#pragma unroll
        for (int j = 0; j < 8; ++j) { const float cv = cw[c8 + j] * g2[j] + cw[DFF + c8 + j] * g1[j] + cw[2 * DFF + c8 + j] * g0[j] + cb[c8 + j]; o[j] = siluf(cv) * v[j]; }
        u32x4 w; w[0] = pk2(o[0], o[1]); w[1] = pk2(o[2], o[3]); w[2] = pk2(o[4], o[5]); w[3] = pk2(o[6], o[7]);
        *(u32x4*)(uv + row * DFF + c8) = w;
    }
}

namespace cg = cooperative_groups;
constexpr int LDS_BYTES = 53248;
__global__ void __launch_bounds__(NTHR) mega(Params p) {
    extern __shared__ __attribute__((aligned(16))) unsigned char lds[];
    cg::grid_group grid = cg::this_grid();
    ph_mod(p);
    grid.sync();
    for (int l = 0; l < DEPTH; ++l) {
        const float* mod = (const float*)(p.ws + WS_MOD) + (size_t)l * 4 * 6144;
        ph_cbias(p, l); ph_weights(p, l, (float*)lds);
        if (l == 0) ph_xa_from(p, p.x, 0, 0, (bf16_t*)(p.ws + WS_XA), (float*)(p.ws + WS_RSA), true);
        grid.sync();
        {   EpiProj E{(const float*)(p.ws + WS_RSA), (const float*)(p.ws + WS_CBIN) + (size_t)l * 4 * PINP, (bf16_t*)(p.ws + WS_PROJ), (float*)(p.ws + WS_SIDE)};
            gemm_simple((const bf16_t*)(p.ws + WS_XA), (const bf16_t*)(p.ws + WS_WIN), MTOK, PINP, DM, E, lds); }
        grid.sync();
        ph_prep_knorm(p, l); ph_prep_cum(p, l); ph_prep_cmp(p, l, lds);
        grid.sync();
        nv_attn_diff(p, l); nv_attn_fox(p, l); nv_attn_stick(p, l); nv_nsa_stats(p, l);
        grid.sync();
        nv_nsa_imp(p, l);
        grid.sync();
        nv_nsa_topk(p);
        grid.sync();
        nv_nsa_out(p, l);
        grid.sync();
        {   EpiRes E{l == 0 ? p.x : p.out, p.out, mod + 2048, p.norm_ffn_g + l * DM, mod + 4096, (bf16_t*)(p.ws + WS_XA)};
            gemm_simple((const bf16_t*)(p.ws + WS_MIX), (const bf16_t*)(p.ws + WS_WOUT), MTOK, DM, DM, E, lds); }
        grid.sync();
        ph_xa_from(p, p.out, 0, 0, nullptr, (float*)(p.ws + WS_RSB), false);
        grid.sync();
        {   EpiUp E{(const float*)(p.ws + WS_RSB), (const float*)(p.ws + WS_CBUP) + (size_t)l * 4 * NUP, (bf16_t*)(p.ws + WS_UG), (bf16_t*)(p.ws + WS_UV)};
            gemm_simple((const bf16_t*)(p.ws + WS_XA), (const bf16_t*)(p.ws + WS_WUP), MTOK, NUP, DM, E, lds); }
        grid.sync();
        ph_act(p, l);
        grid.sync();
        {   const float* modn = (const float*)(p.ws + WS_MOD) + (size_t)(l + 1) * 4 * 6144;
            EpiRes E{p.out, p.out, mod + 5120, p.norm_mix_g + (l + 1) * DM, modn + 1024, (l + 1 < DEPTH) ? (bf16_t*)(p.ws + WS_XA) : nullptr};
            gemm_simple((const bf16_t*)(p.ws + WS_UV), (const bf16_t*)(p.ws + WS_WDN), MTOK, DM, DFF, E, lds); }
        if (l + 1 < DEPTH) {
            grid.sync();
            ph_xa_from(p, p.out, 0, 0, nullptr, (float*)(p.ws + WS_RSA), false);
            grid.sync();
        }
    }
}

extern "C" void kernel_launch(void* const* d_in, const int* in_sizes, int n_in, void* d_out, int out_size, void* d_ws, size_t ws_size, hipStream_t stream) {
    if (n_in != 24 || ws_size < WS_END || out_size != MTOK * DM) { fprintf(stderr, "kernel_launch: unexpected sizes (n_in %d, ws %zu, out %d)\n", n_in, ws_size, out_size); return; }
    static int grid_blocks = 0;
    if (!grid_blocks) {
        int dev = 0, cus = 0, per_cu = 0;
        hipGetDevice(&dev);
        hipDeviceGetAttribute(&cus, hipDeviceAttributeMultiprocessorCount, dev);
        hipFuncSetAttribute((const void*)mega, hipFuncAttributeMaxDynamicSharedMemorySize, LDS_BYTES);
        hipOccupancyMaxActiveBlocksPerMultiprocessor(&per_cu, (const void*)mega, NTHR, LDS_BYTES);
        if (per_cu < 1) { fprintf(stderr, "kernel_launch: occupancy query returned %d\n", per_cu); per_cu = 1; }
        if (per_cu > 1) per_cu = 1;
        grid_blocks = cus * per_cu;
        fprintf(stderr, "kernel_launch: cus %d per_cu %d grid %d\n", cus, per_cu, grid_blocks);
    }
    Params p{};
    const float** f = (const float**)&p;
    for (int i = 0; i < 24; ++i) f[i] = (const float*)d_in[i];
    p.out = (float*)d_out; p.ws = (unsigned char*)d_ws;
    void* args[] = {&p};
    hipError_t e = hipLaunchCooperativeKernel((const void*)mega, dim3(grid_blocks), dim3(NTHR), args, LDS_BYTES, stream);
    if (e != hipSuccess) fprintf(stderr, "cooperative launch failed: %s (grid %d)\n", hipGetErrorString(e), grid_blocks);
}
```

```cpp
#include <hip/hip_runtime.h>
#include <hip/hip_cooperative_groups.h>
#include <cstdint>
#include <cstdio>

typedef unsigned short bf16_t;
typedef short bf16x8 __attribute__((ext_vector_type(8)));
typedef float f32x4 __attribute__((ext_vector_type(4)));
typedef unsigned u32x4 __attribute__((ext_vector_type(4)));

constexpr int NB = 4, SEQ = 4096, DM = 1024, MTOK = NB * SEQ, DEPTH = 2;
constexpr int HD = 64, HPM = 4, DFF = 2816, PIN = 2960, PINP = 3072, NUP = 2 * DFF;
constexpr float EPS = 1e-6f;
constexpr int NTHR = 512;

constexpr int CA_Q = 0, CA_K = 256, CA_V = 512, CB_Q = 768, CB_K = 1024, CB_V = 1280, CC_Q = 1536, CC_K = 1792, CC_V = 2048;
constexpr int CD_Q = 2304, CD_KC = 2560, CD_VC = 2624, CD_KS = 2688, CD_VS = 2752, CD_KW = 2816, CD_VW = 2880, C_BF = 2944, C_DG = 2948;

constexpr size_t MiB = 1u << 20;
constexpr size_t WS_CTL = 0;
constexpr size_t WS_MOD = 1 * MiB;
constexpr size_t WS_CBIN = WS_MOD + 2 * 4 * 6144 * 4;
constexpr size_t WS_CBUP = WS_CBIN + 2 * 4 * 3072 * 4;
constexpr size_t WS_TB = WS_CBUP + 2 * 4 * 5632 * 4;
constexpr size_t WS_LAM = WS_TB + 2 * 4 * 128 * 4;
constexpr size_t WS_CUM = WS_LAM + 256;
constexpr size_t WS_KC = WS_CUM + 16 * 4096 * 4;
constexpr size_t WS_VC = WS_KC + 4 * 256 * 64 * 2;
constexpr size_t WS_SELM = WS_VC + 4 * 256 * 64 * 2;
constexpr size_t WS_SMALL_END = WS_SELM + 16384 * 8;
static_assert(WS_SMALL_END <= 4 * MiB, "small region");
constexpr size_t WS_RSA = 4 * MiB;
constexpr size_t WS_RSB = 5 * MiB;
constexpr size_t WS_SIDE = 6 * MiB;
constexpr size_t WS_IMP = 7 * MiB;
constexpr size_t WS_ML = 11 * MiB;
constexpr size_t WS_W = 12 * MiB;
constexpr size_t WS_WIN = WS_W;
constexpr size_t WS_WOUT = WS_WIN + (size_t)PINP * DM * 2;
constexpr size_t WS_WUP = WS_WOUT + (size_t)DM * DM * 2;
constexpr size_t WS_WDN = WS_WUP + (size_t)NUP * DM * 2;
constexpr size_t WS_W_END = WS_WDN + (size_t)DM * DFF * 2;
static_assert(WS_W_END <= 38 * MiB, "weights region");
constexpr size_t WS_XA = 38 * MiB;
constexpr size_t WS_BIG = 70 * MiB;
constexpr size_t WS_PROJ = WS_BIG;
constexpr size_t WS_MIX = WS_BIG + 96 * MiB;
constexpr size_t WS_UG = WS_BIG;
constexpr size_t WS_UV = WS_BIG + 88 * MiB;
constexpr size_t WS_END = WS_BIG + 176 * MiB;
static_assert(WS_END <= 256 * MiB, "workspace");

struct Params {
    const float *x, *c, *rel_bias, *ada_w, *ada_b, *norm_mix_g, *norm_ffn_g, *w_in, *w_out;
    const float *diff_qn, *diff_kn, *diff_lam, *diff_sub, *fox_qn, *fox_kn, *fox_bf;
    const float *nsa_qn, *nsa_kn, *nsa_pe, *nsa_phi, *w_up, *conv_w, *conv_b, *w_down;
    float* out;
    unsigned char* ws;
};

__device__ __forceinline__ float bf2f(bf16_t v) { return __uint_as_float(((unsigned)v) << 16); }
__device__ __forceinline__ bf16_t f2bf(float f) { unsigned u = __float_as_uint(f); return (bf16_t)((u + 0x7fffu + ((u >> 16) & 1u)) >> 16); }
__device__ __forceinline__ unsigned pk2(float lo, float hi) { return (unsigned)f2bf(lo) | ((unsigned)f2bf(hi) << 16); }
__device__ __forceinline__ float siluf(float v) { return v / (1.f + __expf(-v)); }
__device__ __forceinline__ float logsigf(float v) { return fminf(v, 0.f) - log1pf(__expf(-fabsf(v))); }
__device__ __forceinline__ float wave_sum(float v) {
#pragma unroll
    for (int o = 1; o < 64; o <<= 1) v += __shfl_xor(v, o);
    return v;
}
__device__ __forceinline__ int t5_bucket(int n) {
    if (n < 16) return n < 0 ? 0 : n;
    return 16 + (n >= 19) + (n >= 21) + (n >= 24) + (n >= 27) + (n >= 31) + (n >= 35) + (n >= 40) + (n >= 46) + (n >= 52) + (n >= 59) + (n >= 67) + (n >= 77) + (n >= 87) + (n >= 99) + (n >= 113);
}
__host__ __device__ __forceinline__ int in_col_map(int n) {
    if (n < 1536) return n;
    if (n < 2944) return n + 4;
    if (n < 2948) return 1536 + (n - 2944);
    if (n < 2960) return n;
    return -1;
}
__host__ __device__ __forceinline__ int up_col_map(int n) {
    const int pn = n >> 8, c = n & 255;
    return c < 128 ? (128 * pn + c) : (DFF + 128 * pn + (c - 128));
}

__device__ __forceinline__ int opaque_v(int v) { asm volatile("" : "+v"(v)); return v; }
#define TID() opaque_v((int)threadIdx.x)
#define GTID() ((int)(blockIdx.x * blockDim.x) + TID())
#define GSIZE() ((int)(gridDim.x * blockDim.x))

__device__ void ph_mod(const Params& p) {
    float* mod = (float*)(p.ws + WS_MOD);
    float* tb = (float*)(p.ws + WS_TB);
    float* lamv = (float*)(p.ws + WS_LAM);
    const int gt = GTID(), gs = GSIZE();
    for (int idx = gt; idx < DEPTH * 6144; idx += gs) {
        const int l = idx / 6144, j = idx % 6144;
        float a0 = 0.f, a1 = 0.f, a2 = 0.f, a3 = 0.f;
        const float* w = p.ada_w + (size_t)l * DM * 6144 + j;
        for (int k = 0; k < DM; ++k) {
            const float wv = w[(size_t)k * 6144];
            a0 += siluf(p.c[k]) * wv; a1 += siluf(p.c[DM + k]) * wv; a2 += siluf(p.c[2 * DM + k]) * wv; a3 += siluf(p.c[3 * DM + k]) * wv;
        }
        const float bb = p.ada_b[l * 6144 + j];
        mod[(l * 4 + 0) * 6144 + j] = a0 + bb; mod[(l * 4 + 1) * 6144 + j] = a1 + bb;
        mod[(l * 4 + 2) * 6144 + j] = a2 + bb; mod[(l * 4 + 3) * 6144 + j] = a3 + bb;
    }
    for (int idx = gt; idx < 2 * 4 * 128; idx += gs) {
        const int type = idx / 512, h = (idx / 128) & 3, d = idx & 127;
        tb[idx] = p.rel_bias[t5_bucket(d) * 8 + type * 4 + h];
    }
    for (int idx = gt; idx < DEPTH; idx += gs) {
        const float* lv = p.diff_lam + idx * 4 * 32;
        float s1 = 0.f, s2 = 0.f;
        for (int i = 0; i < 32; ++i) { s1 += lv[i] * lv[32 + i]; s2 += lv[64 + i] * lv[96 + i]; }
        const float lam_init = 0.8f - 0.6f * expf(-0.3f * (float)idx);
        lamv[idx] = expf(s1) - expf(s2) + lam_init;
    }
}

__device__ void ph_cbias(const Params& p, int l) {
    const float* mod = (const float*)(p.ws + WS_MOD);
    float* cbin = (float*)(p.ws + WS_CBIN) + (size_t)l * 4 * PINP;
    float* cbup = (float*)(p.ws + WS_CBUP) + (size_t)l * 4 * NUP;
    const int gt = GTID(), gs = GSIZE();
    for (int idx = gt; idx < PINP + NUP; idx += gs) {
        const bool isin = idx < PINP;
        const int n = isin ? idx : idx - PINP;
        const int oc = isin ? in_col_map(n) : up_col_map(n);
        const int ncol = isin ? PIN : NUP;
        const float* W = (isin ? p.w_in + (size_t)l * DM * PIN : p.w_up + (size_t)l * DM * NUP);
        const int shoff = isin ? 0 : 3072;
        float a0 = 0.f, a1 = 0.f, a2 = 0.f, a3 = 0.f;
        if (oc >= 0) {
            for (int k = 0; k < DM; ++k) {
                const float wv = W[(size_t)k * ncol + oc];
                a0 += mod[(l * 4 + 0) * 6144 + shoff + k] * wv; a1 += mod[(l * 4 + 1) * 6144 + shoff + k] * wv;
                a2 += mod[(l * 4 + 2) * 6144 + shoff + k] * wv; a3 += mod[(l * 4 + 3) * 6144 + shoff + k] * wv;
            }
        }
        float* o = isin ? cbin : cbup; const int ld = isin ? PINP : NUP;
        o[0 * ld + n] = a0; o[1 * ld + n] = a1; o[2 * ld + n] = a2; o[3 * ld + n] = a3;
    }
}
template <int MAPK>
__device__ void convert_weight(const float* W, int K, int Nsrc, int Npad, bf16_t* Wt, float* scr  , int gw, int ngw, int lane) {
    const int nkb = K / 32, nnb = Npad / 32;
    for (int it = gw; it < nkb * nnb; it += ngw) {
        const int kb = it / nnb, nb = it % nnb, k0 = kb * 32, n0 = nb * 32;
        {
            const int nn = lane & 31; const int n = n0 + nn;
            const int oc = MAPK == 0 ? n : (MAPK == 1 ? in_col_map(n) : up_col_map(n));
#pragma unroll 4
            for (int i = 0; i < 16; ++i) { const int kk = 2 * i + (lane >> 5); scr[kk * 33 + nn] = (oc >= 0) ? W[(size_t)(k0 + kk) * Nsrc + oc] : 0.f; }
        }
        __builtin_amdgcn_s_waitcnt(0); __builtin_amdgcn_wave_barrier();
        {
            const int kk2 = (lane & 15) * 2;
#pragma unroll 4
            for (int i = 0; i < 8; ++i) { const int nn = 4 * i + (lane >> 4);
                *(unsigned*)(Wt + (size_t)(n0 + nn) * K + k0 + kk2) = pk2(scr[kk2 * 33 + nn], scr[(kk2 + 1) * 33 + nn]); }
        }
        __builtin_amdgcn_s_waitcnt(0); __builtin_amdgcn_wave_barrier();
    }
}
__device__ void ph_weights(const Params& p, int l, float* lds) {
    const int tid_ = TID(); const int lane = tid_ & 63, wv = tid_ >> 6;
    const int gw = blockIdx.x * (blockDim.x >> 6) + wv, ngw = gridDim.x * (blockDim.x >> 6);
    float* scr = lds + wv * (32 * 33);
    convert_weight<1>(p.w_in + (size_t)l * DM * PIN, DM, PIN, PINP, (bf16_t*)(p.ws + WS_WIN), scr, gw, ngw, lane);
    convert_weight<0>(p.w_out + (size_t)l * DM * DM, DM, DM, DM, (bf16_t*)(p.ws + WS_WOUT), scr, gw, ngw, lane);
    convert_weight<2>(p.w_up + (size_t)l * DM * NUP, DM, NUP, NUP, (bf16_t*)(p.ws + WS_WUP), scr, gw, ngw, lane);
    convert_weight<0>(p.w_down + (size_t)l * DFF * DM, DFF, DM, DM, (bf16_t*)(p.ws + WS_WDN), scr, gw, ngw, lane);
}
__device__ void ph_xa_from(const Params& p, const float* src, int l, int which  , bf16_t* XA, float* rowss, bool write_xa) {
    const float* mod = (const float*)(p.ws + WS_MOD);
    const float* g = (which == 0 ? p.norm_mix_g : p.norm_ffn_g) + l * DM;
    const int tid_ = TID(); const int lane = tid_ & 63, wv = tid_ >> 6;
    const int gw = blockIdx.x * (blockDim.x >> 6) + wv, ngw = gridDim.x * (blockDim.x >> 6);
    for (int row = gw; row < MTOK; row += ngw) {
        const int b = row / SEQ;
        const float* sc = mod + (size_t)(l * 4 + b) * 6144 + (which == 0 ? 1024 : 4096);
        float ss = 0.f;
#pragma unroll
        for (int j = 0; j < 4; ++j) {
            const int k = j * 256 + lane * 4;
            const f32x4 v = *(const f32x4*)(src + (size_t)row * DM + k);
            ss += v[0] * v[0] + v[1] * v[1] + v[2] * v[2] + v[3] * v[3];
            if (write_xa) {
                const f32x4 gv = *(const f32x4*)(g + k); const f32x4 sv = *(const f32x4*)(sc + k);
                uint2 o; o.x = pk2(v[0] * gv[0] * (1.f + sv[0]), v[1] * gv[1] * (1.f + sv[1])); o.y = pk2(v[2] * gv[2] * (1.f + sv[2]), v[3] * gv[3] * (1.f + sv[3]));
                *(uint2*)(XA + (size_t)row * DM + k) = o;
            }
        }
        ss = wave_sum(ss);
        if (lane < 16) rowss[(size_t)row * 16 + lane] = (lane == 0) ? ss : 0.f;
    }
}

template <class Epi>
__device__ void gemm_simple(const bf16_t* A, const bf16_t* Bt, int M, int N, int K, const Epi& E, unsigned char* lds) {
    bf16_t* sA = (bf16_t*)lds;
    bf16_t* sB = (bf16_t*)(lds + 128 * 80);
    const int tid = TID(), lane = tid & 63, w = tid >> 6, fr = lane & 15, fq = lane >> 4;
    const int ntn = N / 64, ntm = M / 128;
    for (int tile = blockIdx.x; tile < ntn * ntm; tile += gridDim.x) {
        const int tm = tile / ntn, tn = tile % ntn, m0 = tm * 128, n0 = tn * 64;
        f32x4 acc[4];
#pragma unroll
        for (int i = 0; i < 4; ++i) acc[i] = (f32x4){0.f, 0.f, 0.f, 0.f};
        for (int k0 = 0; k0 < K; k0 += 32) {
            { const int r = tid >> 2, ch = tid & 3; *(u32x4*)(sA + r * 40 + ch * 8) = *(const u32x4*)(A + (size_t)(m0 + r) * K + k0 + ch * 8); }
            if (tid < 256) { const int r = tid >> 2, ch = tid & 3; *(u32x4*)(sB + r * 40 + ch * 8) = *(const u32x4*)(Bt + (size_t)(n0 + r) * K + k0 + ch * 8); }
            __syncthreads();
            const bf16x8 a = *(const bf16x8*)(sA + (16 * w + fr) * 40 + fq * 8);
#pragma unroll
            for (int nt = 0; nt < 4; ++nt) {
                const bf16x8 b = *(const bf16x8*)(sB + (16 * nt + fr) * 40 + fq * 8);
                acc[nt] = __builtin_amdgcn_mfma_f32_16x16x32_bf16(a, b, acc[nt], 0, 0, 0);
            }
            __syncthreads();
        }
#pragma unroll
        for (int nt = 0; nt < 4; ++nt)
#pragma unroll
            for (int j = 0; j < 4; ++j) E(m0 + 16 * w + fq * 4 + j, n0 + 16 * nt + fr, acc[nt][j]);
    }
}
__device__ __forceinline__ float row_rstd(const float* rowss, int row) {
    const f32x4* r = (const f32x4*)(rowss + (size_t)row * 16);
    const f32x4 a = r[0], b = r[1], c = r[2], d = r[3];
    const float s = ((a[0] + a[1]) + (a[2] + a[3])) + ((b[0] + b[1]) + (b[2] + b[3])) + ((c[0] + c[1]) + (c[2] + c[3])) + ((d[0] + d[1]) + (d[2] + d[3]));
    return rsqrtf(s * (1.f / DM) + EPS);
}
struct EpiProj {
    const float* rowss; const float* cb; bf16_t* proj; float* side;
    __device__ void operator()(int row, int col, float v) const {
        const int b = row / SEQ; const float o = v * row_rstd(rowss, row) + cb[b * PINP + col];
        proj[(size_t)row * PINP + col] = f2bf(o);
        if (col >= C_BF && col < PIN) side[(size_t)row * 16 + (col - C_BF)] = o;
    }
};
struct EpiRes {
    const float* xin; float* xout; const float* mod_gate;
    const float* g; const float* mod_sc; bf16_t* xa;
    __device__ void operator()(int row, int col, float v) const {
        const int b = row / SEQ; const float o = xin[(size_t)row * DM + col] + mod_gate[b * 6144 + col] * v;
        xout[(size_t)row * DM + col] = o;
        if (xa) xa[(size_t)row * DM + col] = f2bf(o * g[col] * (1.f + mod_sc[b * 6144 + col]));
    }
};
struct EpiUp {
    const float* rowss; const float* cb; bf16_t* ug; bf16_t* uv;
    __device__ void operator()(int row, int col, float v) const {
        const int b = row / SEQ; const float o = v * row_rstd(rowss, row) + cb[b * NUP + col];
        const int pn = col >> 8, c = col & 255;
        if (c < 128) ug[(size_t)row * DFF + 128 * pn + c] = f2bf(o); else uv[(size_t)row * DFF + 128 * pn + (c - 128)] = f2bf(o);
    }
};

namespace pg8 {
#define PG8_LAS __attribute__((address_space(3)))
typedef unsigned short bf16_t;
typedef short bf16x8 __attribute__((ext_vector_type(8)));
typedef float f32x4 __attribute__((ext_vector_type(4)));
typedef unsigned u32x4 __attribute__((ext_vector_type(4)));
constexpr int BM = 256, BK = 64, HALF = 128, HTB = HALF * BK * 2  , STAGE_BYTES = 8 * HTB, NXCD = 8, WGM = 8;

__host__ __device__ __forceinline__ int lds_byte(int r, int c) { const int st = (r >> 4) * 2 + (c >> 5), rr = r & 15, cc = c & 31, ob = rr * 64 + cc * 2; return st * 1024 + (ob ^ (((ob >> 9) & 1) << 5)); }
__host__ __device__ __forceinline__ void stage_rc(int b, int& R, int& C) { const int st = b / 1024, sb = b % 1024, swz = sb ^ (((sb >> 9) & 1) << 5); R = (st >> 1) * 16 + swz / 64; C = (st & 1) * 32 + (swz % 64) / 2; }
__host__ __device__ __forceinline__ int perm32(int rho) { const int n = rho >> 4, i = rho & 15; return 8 * (i >> 2) + 4 * n + (i & 3); }

struct Unit { int pm, pn; };
struct Gemm { const bf16_t* A; const bf16_t* Bt; int M, N, K; };

struct StaticOrder {
    int nM, nN, nwg, G, c;
    __host__ __device__ void init(int M, int N, int G_, int c_) { nM = M / BM; nN = N / BM; nwg = nM * nN; G = G_; c = c_; }
    __host__ __device__ bool next(int i, Unit& u) const {
        const long L = (long)i * G + c; if (L >= nwg) return false;
        int wgid = (int)L; { const int q = nwg / NXCD, r = nwg % NXCD, xcd = wgid % NXCD, off = wgid / NXCD; wgid = (xcd < r ? xcd * (q + 1) : r * (q + 1) + (xcd - r) * q) + off; }
        const int nig = WGM * nN, gid = wgid / nig, fm = gid * WGM, gsz = (nM - fm) < WGM ? (nM - fm) : WGM;
        u.pm = fm + ((wgid % nig) % gsz); u.pn = (wgid % nig) / gsz; return true;
    }
    __device__ __forceinline__ void a_ready(const Unit&) const {}
    __device__ __forceinline__ void done(const Unit&) const {}
};


__device__ __forceinline__ unsigned cvt_pk_bf16(float lo, float hi) { unsigned r; asm volatile("v_cvt_pk_bf16_f32 %0, %1, %2" : "=v"(r) : "v"(lo), "v"(hi)); return r; }
template <class Epi, class Sched, bool ALIGN_EPI = false, bool SP2 = false>
__device__ __forceinline__ void gemm_phase(PG8_LAS unsigned char* lds, const Gemm g, const Sched& S, const Epi& E) {
    const int tid = TID(), wid = __builtin_amdgcn_readfirstlane(tid >> 6), lane = tid & 63, wr = wid >> 2, wc = wid & 3, fr = lane & 15, fq = lane >> 4;
    const int K = g.K, nt = K / BK;
    unsigned voffA[2], voffB[2];
#pragma unroll
    for (int i = 0; i < 2; ++i) { int R, C; stage_rc(tid * 16 + i * 8192, R, C); const int Rb = Epi::PERM ? ((R & ~31) + perm32(R & 31)) : R;
        voffA[i] = (unsigned)(R * K + C) * 2u; voffB[i] = (unsigned)(Rb * K + C) * 2u; }
    const size_t kstep = (size_t)(BK * 2);
    const size_t hstep = (size_t)HALF * K * 2;
    const size_t tstep = 2 * hstep;
    const unsigned ldsw = (unsigned)wid * 1024u;
    const int aoff = lds_byte(wr * 64 + fr, fq * 8), boff = lds_byte(wc * 32 + fr, fq * 8);
#define PG8_SA(b, h) (((b) * 2 + (h)) * HTB)
#define PG8_SB(b, h) ((4 + (b) * 2 + (h)) * HTB)
#define PG8_STAGE(bufoff, gbase, voff) do { _Pragma("unroll") for (int _i = 0; _i < 2; ++_i) \
        __builtin_amdgcn_global_load_lds((const unsigned*)((const char*)(gbase) + (voff)[_i]), (PG8_LAS unsigned*)(lds + (bufoff) + ldsw + _i * 8192), 16, 0, 0); } while (0)
#define PG8_LDA(dst, b, h) do { _Pragma("unroll") for (int m = 0; m < 4; ++m) _Pragma("unroll") for (int k = 0; k < 2; ++k) dst[m][k] = *(const PG8_LAS bf16x8*)(lds + PG8_SA(b, h) + aoff + m * 2048 + k * 1024); } while (0)
#define PG8_LDB(dst, b, h) do { _Pragma("unroll") for (int n = 0; n < 2; ++n) _Pragma("unroll") for (int k = 0; k < 2; ++k) dst[n][k] = *(const PG8_LAS bf16x8*)(lds + PG8_SB(b, h) + boff + n * 2048 + k * 1024); } while (0)
#define PG8_MMA(ai, bj, At, Bt) do { __builtin_amdgcn_s_setprio(1); _Pragma("unroll") for (int m = 0; m < 4; ++m) _Pragma("unroll") for (int n = 0; n < 2; ++n) _Pragma("unroll") for (int k = 0; k < 2; ++k) \
        acc[ai][bj][m][n] = __builtin_amdgcn_mfma_f32_16x16x32_bf16(Bt[n][k], At[m][k], acc[ai][bj][m][n], 0, 0, 0); __builtin_amdgcn_s_setprio(0); } while (0)
#define PG8_WAIT_V(n) asm volatile("s_waitcnt vmcnt(" #n ")" ::: "memory")
#define PG8_WAIT_L(n) asm volatile("s_waitcnt lgkmcnt(" #n ")" ::: "memory")
#define PG8_BAR __builtin_amdgcn_s_barrier()
#define PG8_SCHED __builtin_amdgcn_sched_barrier(0)
    Unit cur, nxt; int ui = 0;
    if (!S.next(0, cur)) return;
    f32x4 acc[2][2][4][2];
#pragma unroll
    for (int a = 0; a < 2; ++a)
#pragma unroll
        for (int b = 0; b < 2; ++b)
#pragma unroll
            for (int m = 0; m < 4; ++m)
#pragma unroll
                for (int n = 0; n < 2; ++n) acc[a][b][m][n] = (f32x4){0.f, 0.f, 0.f, 0.f};
    bf16x8 At[4][2], B0[2][2], B1[2][2];
    const char* cA = (const char*)g.A + (size_t)cur.pm * tstep; const char* cB = (const char*)g.Bt + (size_t)cur.pn * tstep;
    S.a_ready(cur);
    if constexpr (SP2) {
        PG8_STAGE(PG8_SB(0, 0), cB, voffB); PG8_STAGE(PG8_SB(0, 1), cB + hstep, voffB); PG8_STAGE(PG8_SA(0, 0), cA, voffA); PG8_STAGE(PG8_SA(0, 1), cA + hstep, voffA);
        if (wr == 1) PG8_BAR;
        PG8_WAIT_V(2); PG8_BAR;
        PG8_STAGE(PG8_SB(1, 0), cB + kstep, voffB); PG8_STAGE(PG8_SA(1, 0), cA + kstep, voffA); PG8_STAGE(PG8_SB(1, 1), cB + hstep + kstep, voffB);
        PG8_WAIT_V(6); PG8_BAR;
    } else {
        PG8_STAGE(PG8_SB(0, 0), cB, voffB); PG8_STAGE(PG8_SA(0, 0), cA, voffA); PG8_STAGE(PG8_SB(0, 1), cB + hstep, voffB); PG8_STAGE(PG8_SA(0, 1), cA + hstep, voffA);
        if (wr == 1) PG8_BAR;
        PG8_WAIT_V(4); PG8_BAR;
        PG8_STAGE(PG8_SB(1, 0), cB + kstep, voffB); PG8_STAGE(PG8_SA(1, 0), cA + kstep, voffA); PG8_STAGE(PG8_SB(1, 1), cB + hstep + kstep, voffB);
        PG8_WAIT_V(6); PG8_BAR;
    }
    for (;;) {
        const bool has_next = S.next(ui + 1, nxt);
        const char* nA = has_next ? (const char*)g.A + (size_t)nxt.pm * tstep : cA; const char* nB = has_next ? (const char*)g.Bt + (size_t)nxt.pn * tstep : cB;
        for (int t = 0; t < nt; t += 2) {
            const bool last = (t == nt - 2);
            const char* a1 = cA + (size_t)(t + 1) * kstep;
            const char* a2 = last ? nA : cA + (size_t)(t + 2) * kstep; const char* b2 = last ? nB : cB + (size_t)(t + 2) * kstep;
            const char* a3 = a2 + kstep; const char* b3 = b2 + kstep;
            if (last && has_next) S.a_ready(nxt);
            if constexpr (SP2) {
            PG8_LDB(B0, 0, 0); PG8_LDB(B1, 0, 1); PG8_SCHED; PG8_LDA(At, 0, 0); PG8_STAGE(PG8_SA(1, 1), a1 + hstep, voffA);
            PG8_WAIT_V(8); PG8_WAIT_L(0); PG8_BAR; PG8_MMA(0, 0, At, B0); PG8_MMA(0, 1, At, B1); PG8_BAR; PG8_SCHED;
            PG8_LDA(At, 0, 1); PG8_STAGE(PG8_SB(0, 0), b2, voffB); PG8_STAGE(PG8_SB(0, 1), b2 + hstep, voffB); PG8_STAGE(PG8_SA(0, 0), a2, voffA);
            PG8_WAIT_V(8); PG8_WAIT_L(0); PG8_BAR; PG8_MMA(1, 0, At, B0); PG8_MMA(1, 1, At, B1); PG8_BAR; PG8_SCHED;
            PG8_LDB(B0, 1, 0); PG8_LDB(B1, 1, 1); PG8_SCHED; PG8_LDA(At, 1, 0); PG8_STAGE(PG8_SA(0, 1), a2 + hstep, voffA);
            PG8_WAIT_V(8); PG8_WAIT_L(0); PG8_BAR; PG8_MMA(0, 0, At, B0); PG8_MMA(0, 1, At, B1); PG8_BAR; PG8_SCHED;
            PG8_LDA(At, 1, 1); PG8_STAGE(PG8_SB(1, 0), b3, voffB); PG8_STAGE(PG8_SB(1, 1), b3 + hstep, voffB); PG8_STAGE(PG8_SA(1, 0), a3, voffA);
            PG8_WAIT_V(8); PG8_WAIT_L(0); PG8_BAR; PG8_MMA(1, 0, At, B0); PG8_MMA(1, 1, At, B1); PG8_BAR; PG8_SCHED;
            } else {
            PG8_LDB(B0, 0, 0); PG8_SCHED; PG8_LDA(At, 0, 0); PG8_STAGE(PG8_SA(1, 1), a1 + hstep, voffA);
            PG8_WAIT_L(8); PG8_BAR; PG8_WAIT_L(0); PG8_MMA(0, 0, At, B0); PG8_BAR; PG8_SCHED;
            PG8_LDB(B1, 0, 1); PG8_STAGE(PG8_SB(0, 0), b2, voffB);
            PG8_BAR; PG8_WAIT_L(0); PG8_MMA(0, 1, At, B1); PG8_BAR;
            PG8_LDA(At, 0, 1); PG8_STAGE(PG8_SA(0, 0), a2, voffA);
            PG8_BAR; PG8_WAIT_L(0); PG8_MMA(1, 0, At, B0); PG8_BAR; PG8_SCHED;
            PG8_STAGE(PG8_SB(0, 1), b2 + hstep, voffB);
            PG8_WAIT_V(6); PG8_BAR; PG8_MMA(1, 1, At, B1); PG8_BAR;
            PG8_LDB(B0, 1, 0); PG8_SCHED; PG8_LDA(At, 1, 0); PG8_STAGE(PG8_SA(0, 1), a2 + hstep, voffA);
            PG8_WAIT_L(8); PG8_BAR; PG8_WAIT_L(0); PG8_MMA(0, 0, At, B0); PG8_BAR; PG8_SCHED;
            PG8_LDB(B1, 1, 1); PG8_STAGE(PG8_SB(1, 0), b3, voffB);
            PG8_BAR; PG8_WAIT_L(0); PG8_MMA(0, 1, At, B1); PG8_BAR;
            PG8_LDA(At, 1, 1); PG8_STAGE(PG8_SA(1, 0), a3, voffA);
            PG8_BAR; PG8_WAIT_L(0); PG8_MMA(1, 0, At, B0); PG8_BAR; PG8_SCHED;
            PG8_STAGE(PG8_SB(1, 1), b3 + hstep, voffB);
            PG8_WAIT_V(6); PG8_BAR; PG8_MMA(1, 1, At, B1); PG8_BAR;
            }
        }
        if constexpr (ALIGN_EPI) { if (wr == 0) PG8_BAR; }
        if constexpr (!Epi::AFTER_DRAIN) { E(acc, cur, wr, wc, fr, fq); S.done(cur); }
        if (!has_next) break;
#pragma unroll
        for (int a = 0; a < 2; ++a)
#pragma unroll
            for (int b = 0; b < 2; ++b)
#pragma unroll
                for (int m = 0; m < 4; ++m)
#pragma unroll
                    for (int n = 0; n < 2; ++n) acc[a][b][m][n] = (f32x4){0.f, 0.f, 0.f, 0.f};
        cur = nxt; cA = nA; cB = nB; ++ui;
        if constexpr (ALIGN_EPI) { if (wr == 1) PG8_BAR; }
    }
    PG8_WAIT_V(0);
    if constexpr (!ALIGN_EPI) { if (wr == 0) PG8_BAR; }
    PG8_BAR;
    if constexpr (Epi::AFTER_DRAIN) { E.fused(acc, cur, wr, wc, fr, fq, lds, wid, lane); S.done(cur); }
#undef PG8_SA
#undef PG8_SB
#undef PG8_STAGE
#undef PG8_LDA
#undef PG8_LDB
#undef PG8_MMA
#undef PG8_WAIT_V
#undef PG8_WAIT_L
#undef PG8_BAR
#undef PG8_SCHED
}
}

#ifndef PG8_SP2
#define PG8_SP2 true
#endif
#ifndef PG8_ALIGN
#define PG8_ALIGN true
#endif

__device__ __forceinline__ float row_rstd16(const float* rowss, int row) {
    const f32x4* r = (const f32x4*)(rowss + (size_t)row * 16);
    const f32x4 a = r[0], b = r[1], c = r[2], d = r[3];
    const float s = ((a[0] + a[1]) + (a[2] + a[3])) + ((b[0] + b[1]) + (b[2] + b[3])) + ((c[0] + c[1]) + (c[2] + c[3])) + ((d[0] + d[1]) + (d[2] + d[3]));
    return rsqrtf(s * (1.f / DM) + EPS);
}
struct EpiProjF {
    static constexpr bool PERM = true, AFTER_DRAIN = false;
    const float* rowss; const float* cb; bf16_t* proj; float* side;
    __device__ __forceinline__ void operator()(const pg8::f32x4 (&acc)[2][2][4][2], const pg8::Unit& u, int wr, int wc, int fr, int fq) const {
        const int b = u.pm >> 4, colt = u.pn * 256 + wc * 32 + 8 * fq;
        f32x4 cv[2][2];
#pragma unroll
        for (int bj = 0; bj < 2; ++bj)
#pragma unroll
            for (int n = 0; n < 2; ++n) cv[bj][n] = *(const f32x4*)(cb + b * PINP + colt + bj * 128 + 4 * n);
#pragma unroll
        for (int ai = 0; ai < 2; ++ai)
#pragma unroll
            for (int m = 0; m < 4; ++m) {
                const int row = u.pm * 256 + ai * 128 + wr * 64 + m * 16 + fr; const float rs = row_rstd16(rowss, row);
#pragma unroll
                for (int bj = 0; bj < 2; ++bj) {
                    const f32x4 v0 = acc[ai][bj][m][0] * rs + cv[bj][0], v1 = acc[ai][bj][m][1] * rs + cv[bj][1]; const int col0 = colt + bj * 128;
                    u32x4 w; w[0] = pg8::cvt_pk_bf16(v0[0], v0[1]); w[1] = pg8::cvt_pk_bf16(v0[2], v0[3]); w[2] = pg8::cvt_pk_bf16(v1[0], v1[1]); w[3] = pg8::cvt_pk_bf16(v1[2], v1[3]);
                    *(u32x4*)(proj + (size_t)row * PINP + col0) = w;
                    if (col0 >= C_BF && col0 < PIN) { *(f32x4*)(side + (size_t)row * 16 + (col0 - C_BF)) = v0; *(f32x4*)(side + (size_t)row * 16 + (col0 - C_BF) + 4) = v1; }
                }
            }
    }
};
struct EpiUpF {
    static constexpr bool PERM = true, AFTER_DRAIN = false;
    const float* rowss; const float* cb; bf16_t* ug; bf16_t* uv;
    __device__ __forceinline__ void operator()(const pg8::f32x4 (&acc)[2][2][4][2], const pg8::Unit& u, int wr, int wc, int fr, int fq) const {
        const int b = u.pm >> 4, colt = u.pn * 256 + wc * 32 + 8 * fq, oc = u.pn * 128 + wc * 32 + 8 * fq;
        f32x4 cv[2][2];
#pragma unroll
        for (int bj = 0; bj < 2; ++bj)
#pragma unroll
            for (int n = 0; n < 2; ++n) cv[bj][n] = *(const f32x4*)(cb + b * NUP + colt + bj * 128 + 4 * n);
#pragma unroll
        for (int ai = 0; ai < 2; ++ai)
#pragma unroll
            for (int m = 0; m < 4; ++m) {
                const int row = u.pm * 256 + ai * 128 + wr * 64 + m * 16 + fr; const float rs = row_rstd16(rowss, row);
#pragma unroll
                for (int bj = 0; bj < 2; ++bj) {
                    const f32x4 v0 = acc[ai][bj][m][0] * rs + cv[bj][0], v1 = acc[ai][bj][m][1] * rs + cv[bj][1];
                    u32x4 w; w[0] = pg8::cvt_pk_bf16(v0[0], v0[1]); w[1] = pg8::cvt_pk_bf16(v0[2], v0[3]); w[2] = pg8::cvt_pk_bf16(v1[0], v1[1]); w[3] = pg8::cvt_pk_bf16(v1[2], v1[3]);
                    *(u32x4*)((bj ? uv : ug) + (size_t)row * DFF + oc) = w;
                }
            }
    }
};
struct EpiResF {
    static constexpr bool PERM = false, AFTER_DRAIN = false;
    const float* xin; float* xout; const float* gate; const float* g; const float* sc; bf16_t* xa; float* rowss;
    __device__ __forceinline__ void operator()(const pg8::f32x4 (&acc)[2][2][4][2], const pg8::Unit& u, int wr, int wc, int fr, int fq) const {
        const int b = u.pm >> 4, col0 = u.pn * 256 + wc * 32 + 4 * fq;
        f32x4 gt[2][2], gm[2][2];
#pragma unroll
        for (int bj = 0; bj < 2; ++bj)
#pragma unroll
            for (int n = 0; n < 2; ++n) { const int c = col0 + bj * 128 + n * 16; gt[bj][n] = *(const f32x4*)(gate + b * 6144 + c);
                if (xa) gm[bj][n] = *(const f32x4*)(g + c) * (*(const f32x4*)(sc + b * 6144 + c) + 1.0f); else gm[bj][n] = (f32x4){0.f, 0.f, 0.f, 0.f}; }
#pragma unroll
        for (int ai = 0; ai < 2; ++ai)
#pragma unroll
            for (int m = 0; m < 4; ++m) {
                const int row = u.pm * 256 + ai * 128 + wr * 64 + m * 16 + fr; float ss = 0.f;
#pragma unroll
                for (int bj = 0; bj < 2; ++bj)
#pragma unroll
                    for (int n = 0; n < 2; ++n) { const size_t off = (size_t)row * DM + col0 + bj * 128 + n * 16;
                        const f32x4 o = *(const f32x4*)(xin + off) + gt[bj][n] * acc[ai][bj][m][n];
                        *(f32x4*)(xout + off) = o; ss += (o[0] * o[0] + o[1] * o[1]) + (o[2] * o[2] + o[3] * o[3]);
                        if (xa) { const f32x4 q = o * gm[bj][n]; uint2 w; w.x = pg8::cvt_pk_bf16(q[0], q[1]); w.y = pg8::cvt_pk_bf16(q[2], q[3]); *(uint2*)(xa + off) = w; } }
                if (rowss) { ss += __shfl_xor(ss, 16); ss += __shfl_xor(ss, 32); if (fq == 0) rowss[(size_t)row * 16 + u.pn * 4 + wc] = ss; }
            }
    }
};

__device__ void ph_prep_knorm(const Params& p, int l) {
    bf16_t* proj = (bf16_t*)(p.ws + WS_PROJ);
    const int tid_ = TID(); const int lane = tid_ & 63, wv = tid_ >> 6;
    const int gw = blockIdx.x * (blockDim.x >> 6) + wv, ngw = gridDim.x * (blockDim.x >> 6);
    for (int row = gw; row < MTOK; row += ngw) {
        bf16_t* pr = proj + (size_t)row * PINP;
        {
            uint2 raw = *(const uint2*)(pr + CA_K + 4 * lane);
            float v0 = bf2f(raw.x & 0xffff), v1 = bf2f(raw.x >> 16), v2 = bf2f(raw.y & 0xffff), v3 = bf2f(raw.y >> 16);
            float ss = v0 * v0 + v1 * v1 + v2 * v2 + v3 * v3;
            ss += __shfl_xor(ss, 1); ss += __shfl_xor(ss, 2); ss += __shfl_xor(ss, 4);
            const float r = rsqrtf(ss * (1.f / 32.f) + EPS); const float* g = p.diff_kn + l * 32 + ((4 * lane) & 31);
            raw.x = pk2(v0 * r * g[0], v1 * r * g[1]); raw.y = pk2(v2 * r * g[2], v3 * r * g[3]);
            *(uint2*)(pr + CA_K + 4 * lane) = raw;
        }
        {
            uint2 raw = *(const uint2*)(pr + CB_K + 4 * lane);
            float v0 = bf2f(raw.x & 0xffff), v1 = bf2f(raw.x >> 16), v2 = bf2f(raw.y & 0xffff), v3 = bf2f(raw.y >> 16);
            float ss = v0 * v0 + v1 * v1 + v2 * v2 + v3 * v3;
            ss += __shfl_xor(ss, 1); ss += __shfl_xor(ss, 2); ss += __shfl_xor(ss, 4); ss += __shfl_xor(ss, 8);
            const float r = rsqrtf(ss * (1.f / 64.f) + EPS); const float* g = p.fox_kn + l * 64 + ((4 * lane) & 63);
            raw.x = pk2(v0 * r * g[0], v1 * r * g[1]); raw.y = pk2(v2 * r * g[2], v3 * r * g[3]);
            *(uint2*)(pr + CB_K + 4 * lane) = raw;
        }
        {
            const int hi = lane >> 5, li = lane & 31; bf16_t* q = pr + (hi ? CD_KW : CD_KS) + 2 * li;
            unsigned raw = *(const unsigned*)q; float v0 = bf2f(raw & 0xffff), v1 = bf2f(raw >> 16);
            float ss = v0 * v0 + v1 * v1;
            ss += __shfl_xor(ss, 1); ss += __shfl_xor(ss, 2); ss += __shfl_xor(ss, 4); ss += __shfl_xor(ss, 8); ss += __shfl_xor(ss, 16);
            const float r = rsqrtf(ss * (1.f / 64.f) + EPS); const float* g = p.nsa_kn + (l * 3 + (hi ? 2 : 1)) * 64 + 2 * li;
            *(unsigned*)q = pk2(v0 * r * g[0], v1 * r * g[1]);
        }
    }
}
__device__ void ph_prep_cum(const Params& p, int l) {
    const float* side = (const float*)(p.ws + WS_SIDE);
    float* cum = (float*)(p.ws + WS_CUM);
    const int tid_ = TID(); const int lane = tid_ & 63, wv = tid_ >> 6;
    const int gw = blockIdx.x * (blockDim.x >> 6) + wv, ngw = gridDim.x * (blockDim.x >> 6);
    for (int bh = gw; bh < 16; bh += ngw) {
        const int b = bh >> 2, h = bh & 3; const float bf = p.fox_bf[l * 4 + h];
        float tot = 0.f;
        for (int i = 0; i < 64; ++i) tot += logsigf(side[(size_t)(b * SEQ + lane * 64 + i) * 16 + h] + bf);
        float inc = tot;
#pragma unroll
        for (int o = 1; o < 64; o <<= 1) { const float v = __shfl_up(inc, o); if (lane >= o) inc += v; }
        float run = inc - tot;
        for (int i = 0; i < 64; ++i) { run += logsigf(side[(size_t)(b * SEQ + lane * 64 + i) * 16 + h] + bf); cum[bh * SEQ + lane * 64 + i] = run; }
    }
}
__device__ void ph_prep_cmp(const Params& p, int l, unsigned char* lds) {
    const bf16_t* proj = (const bf16_t*)(p.ws + WS_PROJ);
    float* win = (float*)lds; float* red = (float*)(lds + 36864);
    const int tid = TID(), e = tid & 63, part = tid >> 6;
    for (int item = blockIdx.x; item < 4 * 2 * 32; item += gridDim.x) {
        const int b = item >> 6, which = (item >> 5) & 1, n0 = (item & 31) * 8;
        const int colbase = which ? CD_VC : CD_KC;
        __syncthreads();
        for (int i = tid; i < 144 * 64; i += NTHR) { const int tk = 16 * n0 + (i >> 6); win[i] = tk < SEQ ? bf2f(proj[(size_t)(b * SEQ + tk) * PINP + colbase + (i & 63)]) : 0.f; }
        __syncthreads();
        float acc[8];
#pragma unroll
        for (int nn = 0; nn < 8; ++nn) acc[nn] = 0.f;
        const float* phi = p.nsa_phi + (size_t)(l * 2 + which) * 2048 * 64; const float* pe = p.nsa_pe + (size_t)(l * 2 + which) * 32 * 64;
        for (int i = 4 * part; i < 4 * part + 4; ++i)
            for (int d = 0; d < 64; ++d) {
                const float ph = phi[(size_t)(i * 64 + d) * 64 + e], pv = pe[i * 64 + d];
#pragma unroll
                for (int nn = 0; nn < 8; ++nn) acc[nn] += (win[(16 * nn + i) * 64 + d] + pv) * ph;
            }
#pragma unroll
        for (int nn = 0; nn < 8; ++nn) red[(part * 8 + nn) * 64 + e] = acc[nn];
        __syncthreads();
        {
            const int nn = part, n = n0 + nn; float v = 0.f;
#pragma unroll
            for (int pp = 0; pp < 8; ++pp) v += red[(pp * 8 + nn) * 64 + e];
            bf16_t* dst = (bf16_t*)(p.ws + (which ? WS_VC : WS_KC)) + (size_t)(b * 256 + n) * 64 + e;
            if (n >= 255) *dst = 0;
            else if (which == 0) { const float ss = wave_sum(v * v); *dst = f2bf(v * rsqrtf(ss * (1.f / 64.f) + EPS) * p.nsa_kn[(l * 3 + 0) * 64 + e]); }
            else *dst = f2bf(v);
        }
    }
}

__device__ __forceinline__ void load8(const bf16_t* p, float* d) {
    const u32x4 r = *(const u32x4*)p;
    d[0] = bf2f(r[0] & 0xffff); d[1] = bf2f(r[0] >> 16); d[2] = bf2f(r[1] & 0xffff); d[3] = bf2f(r[1] >> 16);
    d[4] = bf2f(r[2] & 0xffff); d[5] = bf2f(r[2] >> 16); d[6] = bf2f(r[3] & 0xffff); d[7] = bf2f(r[3] >> 16);
}
template <int N> __device__ __forceinline__ float dotn(const float* q, const bf16_t* k) {
    float s = 0.f;
#pragma unroll
    for (int c = 0; c < N / 8; ++c) { float t[8]; load8(k + 8 * c, t);
#pragma unroll
        for (int j = 0; j < 8; ++j) s += q[8 * c + j] * t[j]; }
    return s;
}
template <int N> __device__ __forceinline__ void axpyn(float* o, float w, const bf16_t* v) {
#pragma unroll
    for (int c = 0; c < N / 8; ++c) { float t[8]; load8(v + 8 * c, t);
#pragma unroll
        for (int j = 0; j < 8; ++j) o[8 * c + j] += w * t[j]; }
}
template <int N> __device__ __forceinline__ void loadq_norm(float* q, const bf16_t* src, const float* g, float scale, bool norm) {
    float ss = 0.f;
#pragma unroll
    for (int c = 0; c < N / 8; ++c) load8(src + 8 * c, q + 8 * c);
#pragma unroll
    for (int j = 0; j < N; ++j) ss += q[j] * q[j];
    const float r = norm ? rsqrtf(ss * (1.f / N) + EPS) : 1.f;
#pragma unroll
    for (int j = 0; j < N; ++j) q[j] = q[j] * r * (norm ? g[j] : 1.f) * scale;
}
__device__ __forceinline__ void store64(bf16_t* dst, const float* o) {
#pragma unroll
    for (int c = 0; c < 8; ++c) { u32x4 w; w[0] = pk2(o[8 * c], o[8 * c + 1]); w[1] = pk2(o[8 * c + 2], o[8 * c + 3]); w[2] = pk2(o[8 * c + 4], o[8 * c + 5]); w[3] = pk2(o[8 * c + 6], o[8 * c + 7]); *(u32x4*)(dst + 8 * c) = w; }
}

__device__ void nv_attn_diff(const Params& p, int l) {
    const bf16_t* proj = (const bf16_t*)(p.ws + WS_PROJ); bf16_t* mix = (bf16_t*)(p.ws + WS_MIX);
    const float* tb = (const float*)(p.ws + WS_TB); const float lam = ((const float*)(p.ws + WS_LAM))[l];
    const float lam_init = 0.8f - 0.6f * expf(-0.3f * (float)l);
    const float scale = 0.17677669529663687f;
    for (int idx = GTID(); idx < 4 * 4 * SEQ; idx += GSIZE()) {
        const int t = idx & (SEQ - 1), h = (idx >> 12) & 3, b = idx >> 14; const size_t rb = (size_t)b * SEQ;
        float q[64];
        loadq_norm<32>(q, proj + (rb + t) * PINP + CA_Q + 64 * h, p.diff_qn + l * 32, scale, true);
        loadq_norm<32>(q + 32, proj + (rb + t) * PINP + CA_Q + 64 * h + 32, p.diff_qn + l * 32, scale, true);
        const float* tbh = tb + h * 128;
        const bf16_t* kb = proj + rb * PINP + CA_K + 64 * h; const bf16_t* vb = proj + rb * PINP + CA_V + 64 * h;
        float m1 = -INFINITY, m2 = -INFINITY;
        for (int k = 0; k <= t; ++k) { const float bias = tbh[min(t - k, 127)];
            const float s1 = dotn<32>(q, kb + (size_t)k * PINP) + bias, s2 = dotn<32>(q + 32, kb + (size_t)k * PINP + 32) + bias; m1 = fmaxf(m1, s1); m2 = fmaxf(m2, s2); }
        float l1 = 0.f, l2 = 0.f;
        for (int k = 0; k <= t; ++k) { const float bias = tbh[min(t - k, 127)];
            const float s1 = dotn<32>(q, kb + (size_t)k * PINP) + bias, s2 = dotn<32>(q + 32, kb + (size_t)k * PINP + 32) + bias; l1 += __expf(s1 - m1); l2 += __expf(s2 - m2); }
        float o[64];
#pragma unroll
        for (int j = 0; j < 64; ++j) o[j] = 0.f;
        const float i1 = 1.f / l1, i2 = lam / l2;
        for (int k = 0; k <= t; ++k) { const float bias = tbh[min(t - k, 127)];
            const float s1 = dotn<32>(q, kb + (size_t)k * PINP) + bias, s2 = dotn<32>(q + 32, kb + (size_t)k * PINP + 32) + bias;
            const float w = __expf(s1 - m1) * i1 - __expf(s2 - m2) * i2; axpyn<64>(o, w, vb + (size_t)k * PINP); }
        float ss = 0.f;
#pragma unroll
        for (int j = 0; j < 64; ++j) ss += o[j] * o[j];
        const float r = rsqrtf(ss * (1.f / 64.f) + EPS) * (1.f - lam_init);
#pragma unroll
        for (int j = 0; j < 64; ++j) o[j] = o[j] * r * p.diff_sub[l * 64 + j];
        store64(mix + (rb + t) * DM + 0 + 64 * h, o);
    }
}
__device__ void nv_attn_fox(const Params& p, int l) {
    const bf16_t* proj = (const bf16_t*)(p.ws + WS_PROJ); bf16_t* mix = (bf16_t*)(p.ws + WS_MIX);
    const float* cum = (const float*)(p.ws + WS_CUM);
    for (int idx = GTID(); idx < 4 * 4 * SEQ; idx += GSIZE()) {
        const int t = idx & (SEQ - 1), h = (idx >> 12) & 3, b = idx >> 14; const size_t rb = (size_t)b * SEQ;
        float q[64]; loadq_norm<64>(q, proj + (rb + t) * PINP + CB_Q + 64 * h, p.fox_qn + l * 64, 0.125f, true);
        const bf16_t* kb = proj + rb * PINP + CB_K + 64 * h; const bf16_t* vb = proj + rb * PINP + CB_V + 64 * h;
        const float* cm = cum + (b * 4 + h) * SEQ; const float cq = cm[t];
        float m = -INFINITY;
        for (int k = 0; k <= t; ++k) m = fmaxf(m, dotn<64>(q, kb + (size_t)k * PINP) + (cq - cm[k]));
        float o[64], ls = 0.f;
#pragma unroll
        for (int j = 0; j < 64; ++j) o[j] = 0.f;
        for (int k = 0; k <= t; ++k) { const float e = __expf(dotn<64>(q, kb + (size_t)k * PINP) + (cq - cm[k]) - m); ls += e; axpyn<64>(o, e, vb + (size_t)k * PINP); }
        const float il = 1.f / ls;
#pragma unroll
        for (int j = 0; j < 64; ++j) o[j] *= il;
        store64(mix + (rb + t) * DM + 256 + 64 * h, o);
    }
}
__device__ void nv_attn_stick(const Params& p, int l) {
    const bf16_t* proj = (const bf16_t*)(p.ws + WS_PROJ); bf16_t* mix = (bf16_t*)(p.ws + WS_MIX);
    for (int idx = GTID(); idx < 4 * 4 * SEQ; idx += GSIZE()) {
        const int t = idx & (SEQ - 1), h = (idx >> 12) & 3, b = idx >> 14; const size_t rb = (size_t)b * SEQ;
        float q[64]; loadq_norm<64>(q, proj + (rb + t) * PINP + CC_Q + 64 * h, nullptr, 0.125f, false);
        const bf16_t* kb = proj + rb * PINP + CC_K + 64 * h; const bf16_t* vb = proj + rb * PINP + CC_V + 64 * h;
        float o[64], tail = 0.f;
#pragma unroll
        for (int j = 0; j < 64; ++j) o[j] = 0.f;
        for (int k = t - 1; k >= 0; --k) { const float z = dotn<64>(q, kb + (size_t)k * PINP); const float lb = logsigf(z);
            axpyn<64>(o, __expf(lb + tail), vb + (size_t)k * PINP); tail += lb - z; }
        store64(mix + (rb + t) * DM + 512 + 64 * h, o);
    }
}
__device__ void nv_nsa_stats(const Params& p, int l) {
    const bf16_t* proj = (const bf16_t*)(p.ws + WS_PROJ); const bf16_t* kc = (const bf16_t*)(p.ws + WS_KC);
    const float* tb = (const float*)(p.ws + WS_TB) + 512; float* ml = (float*)(p.ws + WS_ML);
    for (int idx = GTID(); idx < 4 * 4 * SEQ; idx += GSIZE()) {
        const int t = idx & (SEQ - 1), h = (idx >> 12) & 3, b = idx >> 14; const size_t row = (size_t)b * SEQ + t;
        float q[64]; loadq_norm<64>(q, proj + row * PINP + CD_Q + 64 * h, p.nsa_qn + l * 64, 0.125f, true);
        const int nmax = (t >= 31) ? (t - 31) / 16 : -1;
        float m = -INFINITY;
        for (int n = 0; n <= nmax; ++n) m = fmaxf(m, dotn<64>(q, kc + (size_t)(b * 256 + n) * 64) + tb[h * 128 + min(t - 16 * n - 31, 127)]);
        float ls = 0.f;
        for (int n = 0; n <= nmax; ++n) ls += __expf(dotn<64>(q, kc + (size_t)(b * 256 + n) * 64) + tb[h * 128 + min(t - 16 * n - 31, 127)] - m);
        ml[(row * 4 + h) * 2 + 0] = m; ml[(row * 4 + h) * 2 + 1] = ls;
    }
}
__device__ void nv_nsa_imp(const Params& p, int l) {
    const bf16_t* proj = (const bf16_t*)(p.ws + WS_PROJ); const bf16_t* kc = (const bf16_t*)(p.ws + WS_KC);
    const float* tb = (const float*)(p.ws + WS_TB) + 512; const float* ml = (const float*)(p.ws + WS_ML); float* imp = (float*)(p.ws + WS_IMP);
    for (int idx = GTID(); idx < MTOK * 64; idx += GSIZE()) {
        const int j = idx & 63; const size_t row = (size_t)(idx >> 6); const int t = (int)(row & (SEQ - 1)), b = (int)(row >> 12);
        float v;
        if (64 * j > t) v = -1.0f;
        else if (j == (t >> 6) || j == 0) v = 1.0e4f;
        else {
            const int nmax = (t >= 31) ? (t - 31) / 16 : -1; v = 0.f;
            for (int h = 0; h < 4; ++h) {
                float q[64]; loadq_norm<64>(q, proj + row * PINP + CD_Q + 64 * h, p.nsa_qn + l * 64, 0.125f, true);
                const float m = ml[(row * 4 + h) * 2], il = 1.f / ml[(row * 4 + h) * 2 + 1];
                for (int n = 4 * j - 1; n <= 4 * j + 3; ++n) if (n >= 0 && n <= nmax && n < 255)
                    v += __expf(dotn<64>(q, kc + (size_t)(b * 256 + n) * 64) + tb[h * 128 + min(t - 16 * n - 31, 127)] - m) * il;
            }
        }
        imp[idx] = v;
    }
}
__device__ void nv_nsa_topk(const Params& p) {
    const float* imp = (const float*)(p.ws + WS_IMP); unsigned long long* selm = (unsigned long long*)(p.ws + WS_SELM);
    for (int row = GTID(); row < MTOK; row += GSIZE()) {
        const float* v = imp + (size_t)row * 64; unsigned long long mask = 0ull;
        for (int j = 0; j < 64; ++j) { const float vj = v[j]; int rank = 0;
            for (int i = 0; i < 64; ++i) { const float vi = v[i]; rank += (vi > vj || (vi == vj && i < j)) ? 1 : 0; }
            if (rank < 16) mask |= (1ull << j); }
        selm[row] = mask;
    }
}
__device__ void nv_nsa_out(const Params& p, int l) {
    const bf16_t* proj = (const bf16_t*)(p.ws + WS_PROJ); bf16_t* mix = (bf16_t*)(p.ws + WS_MIX);
    const bf16_t* kc = (const bf16_t*)(p.ws + WS_KC); const bf16_t* vc = (const bf16_t*)(p.ws + WS_VC);
    const float* tb = (const float*)(p.ws + WS_TB) + 512; const float* ml = (const float*)(p.ws + WS_ML);
    const unsigned long long* selm = (const unsigned long long*)(p.ws + WS_SELM); const float* side = (const float*)(p.ws + WS_SIDE);
    for (int idx = GTID(); idx < 4 * 4 * SEQ; idx += GSIZE()) {
        const int t = idx & (SEQ - 1), h = (idx >> 12) & 3, b = idx >> 14; const size_t rb = (size_t)b * SEQ, row = rb + t;
        float q[64]; loadq_norm<64>(q, proj + row * PINP + CD_Q + 64 * h, p.nsa_qn + l * 64, 0.125f, true);
        const float* tbh = tb + h * 128;
        const float gc = 1.f / (1.f + __expf(-side[row * 16 + 4 + 0 * 4 + h])), gs = 1.f / (1.f + __expf(-side[row * 16 + 4 + 1 * 4 + h])), gwn = 1.f / (1.f + __expf(-side[row * 16 + 4 + 2 * 4 + h]));
        float acc[64];
#pragma unroll
        for (int j = 0; j < 64; ++j) acc[j] = 0.f;
        {
            const int nmax = (t >= 31) ? (t - 31) / 16 : -1; const float m = ml[(row * 4 + h) * 2], ls = ml[(row * 4 + h) * 2 + 1];
            const float f = (nmax >= 0) ? gc / ls : 0.f;
            for (int n = 0; n <= nmax; ++n) { const float e = __expf(dotn<64>(q, kc + (size_t)(b * 256 + n) * 64) + tbh[min(t - 16 * n - 31, 127)] - m); axpyn<64>(acc, e * f, vc + (size_t)(b * 256 + n) * 64); }
        }
        {
            const unsigned long long mask = selm[row]; const bf16_t* kb = proj + rb * PINP + CD_KS; const bf16_t* vb = proj + rb * PINP + CD_VS;
            float m = -INFINITY;
            for (int k = 0; k <= t; ++k) if ((mask >> (k >> 6)) & 1ull) m = fmaxf(m, dotn<64>(q, kb + (size_t)k * PINP) + tbh[min(t - k, 127)]);
            float ls = 0.f;
            for (int k = 0; k <= t; ++k) if ((mask >> (k >> 6)) & 1ull) ls += __expf(dotn<64>(q, kb + (size_t)k * PINP) + tbh[min(t - k, 127)] - m);
            const float f = gs / ls;
            for (int k = 0; k <= t; ++k) if ((mask >> (k >> 6)) & 1ull) { const float e = __expf(dotn<64>(q, kb + (size_t)k * PINP) + tbh[min(t - k, 127)] - m); axpyn<64>(acc, e * f, vb + (size_t)k * PINP); }
        }
        {
            const bf16_t* kb = proj + rb * PINP + CD_KW; const bf16_t* vb = proj + rb * PINP + CD_VW; const int k0 = max(0, t - 511);
            float m = -INFINITY;
            for (int k = k0; k <= t; ++k) m = fmaxf(m, dotn<64>(q, kb + (size_t)k * PINP) + tbh[min(t - k, 127)]);
            float ls = 0.f;
            for (int k = k0; k <= t; ++k) ls += __expf(dotn<64>(q, kb + (size_t)k * PINP) + tbh[min(t - k, 127)] - m);
            const float f = gwn / ls;
            for (int k = k0; k <= t; ++k) { const float e = __expf(dotn<64>(q, kb + (size_t)k * PINP) + tbh[min(t - k, 127)] - m); axpyn<64>(acc, e * f, vb + (size_t)k * PINP); }
        }
        store64(mix + row * DM + 768 + 64 * h, acc);
    }
}


typedef float f32x16 __attribute__((ext_vector_type(16)));
typedef short s16x4 __attribute__((ext_vector_type(4)));
#define LDSP __attribute__((address_space(3)))
constexpr float LOG2E = 1.4426950408889634f;
constexpr int KSTR = 144;
constexpr int AL_K = 0, AL_V = 64 * KSTR  , AL_BK = AL_V + 8192  , AL_TB = AL_BK + 256  , AL_WSF = AL_TB + 512  ,
              AL_OST = AL_WSF + 2048  , AL_MISC = AL_OST + 32768  , AL_END = AL_MISC + 64;
__device__ __forceinline__ int crow(int r, int hi) { return (r & 3) + 8 * (r >> 2) + 4 * hi; }
__device__ __forceinline__ float ex2(float v) { return __builtin_amdgcn_exp2f(v); }
__device__ __forceinline__ s16x4 vtr(const LDSP unsigned char* p) { typedef short v4i16_t __attribute__((ext_vector_type(4))); return __builtin_bit_cast(s16x4, __builtin_amdgcn_ds_read_tr16_b64_v4i16((LDSP v4i16_t*)p)); }
__device__ __forceinline__ bf16x8 pack8(const f32x16& p, int b) {
    u32x4 w; w[0] = pg8::cvt_pk_bf16(p[b], p[b + 1]); w[1] = pg8::cvt_pk_bf16(p[b + 2], p[b + 3]); w[2] = pg8::cvt_pk_bf16(p[b + 4], p[b + 5]); w[3] = pg8::cvt_pk_bf16(p[b + 6], p[b + 7]);
    return __builtin_bit_cast(bf16x8, w);
}
template <int NK16>
__device__ __forceinline__ void qkt(f32x16& p0, f32x16& p1, const LDSP unsigned char* Kt, const bf16x8* qf, int dbase, int r32, int hi) {
    const LDSP unsigned char* kb = Kt + r32 * KSTR + hi * 16 + dbase * 32;
#pragma unroll
    for (int d0 = 0; d0 < NK16; ++d0) {
        const bf16x8 a0 = *(const LDSP bf16x8*)(kb + d0 * 32), a1 = *(const LDSP bf16x8*)(kb + 32 * KSTR + d0 * 32);
        p0 = __builtin_amdgcn_mfma_f32_32x32x16_bf16(a0, qf[d0], p0, 0, 0, 0);
        p1 = __builtin_amdgcn_mfma_f32_32x32x16_bf16(a1, qf[d0], p1, 0, 0, 0);
    }
}
__device__ __forceinline__ void pv(f32x16* o, const LDSP unsigned char* Vt, int vb, const f32x16& p0, const f32x16& p1) {
    bf16x8 pa[4]; pa[0] = pack8(p0, 0); pa[1] = pack8(p0, 8); pa[2] = pack8(p1, 0); pa[3] = pack8(p1, 8);
#pragma unroll
    for (int d0 = 0; d0 < 2; ++d0)
#pragma unroll
        for (int ks = 0; ks < 4; ++ks) {
            const s16x4 lo = vtr(Vt + vb + d0 * 4096 + ks * 1024), hh = vtr(Vt + vb + d0 * 4096 + ks * 1024 + 512);
            const bf16x8 vf = (bf16x8){lo[0], lo[1], lo[2], lo[3], hh[0], hh[1], hh[2], hh[3]};
            o[d0] = __builtin_amdgcn_mfma_f32_32x32x16_bf16(pa[ks], vf, o[d0], 0, 0, 0);
        }
}
__device__ __forceinline__ void softmax_tile(f32x16& p0, f32x16& p1, float& m_run, float& l_run, f32x16* o, LDSP float* wsf, int r32, int hi) {
    float mt = fmaxf(p0[0], p1[0]);
#pragma unroll
    for (int r = 1; r < 16; ++r) mt = fmaxf(mt, fmaxf(p0[r], p1[r]));
    mt = fmaxf(mt, __shfl_xor(mt, 32));
    const float m_new = fmaxf(m_run, mt);
    const float m_use = (m_new == -INFINITY) ? 0.f : m_new;
    if (__any(m_new != m_run)) {
        const float alpha = ex2(m_run - m_use);
        l_run *= alpha;
        if (hi == 0) wsf[r32] = alpha;
        __builtin_amdgcn_s_waitcnt(0xc07f);
        __builtin_amdgcn_wave_barrier();
#pragma unroll
        for (int g = 0; g < 4; ++g) { const f32x4 a = *(const LDSP f32x4*)(wsf + 8 * g + 4 * hi);
#pragma unroll
            for (int i = 0; i < 4; ++i) { o[0][4 * g + i] *= a[i]; o[1][4 * g + i] *= a[i]; } }
        __builtin_amdgcn_wave_barrier();
    }
    m_run = m_new;
    float ls = 0.f;
#pragma unroll
    for (int r = 0; r < 16; ++r) { p0[r] = ex2(p0[r] - m_use); p1[r] = ex2(p1[r] - m_use); ls += p0[r] + p1[r]; }
    l_run += ls;
}
__device__ __forceinline__ void scale_rows(f32x16* o, float f, LDSP float* wsf, int r32, int hi) {
    __builtin_amdgcn_wave_barrier();
    if (hi == 0) wsf[r32] = f;
    __builtin_amdgcn_s_waitcnt(0xc07f);
    __builtin_amdgcn_wave_barrier();
#pragma unroll
    for (int g = 0; g < 4; ++g) { const f32x4 a = *(const LDSP f32x4*)(wsf + 8 * g + 4 * hi);
#pragma unroll
        for (int i = 0; i < 4; ++i) { o[0][4 * g + i] *= a[i]; o[1][4 * g + i] *= a[i]; } }
    __builtin_amdgcn_wave_barrier();
}
__device__ __forceinline__ void store_o(const f32x16* o, LDSP bf16_t* stg, bf16_t* dst, int lane, int r32, int hi) {
    __builtin_amdgcn_wave_barrier();
#pragma unroll
    for (int r = 0; r < 16; ++r) { const int orow = crow(r, hi); stg[orow * 64 + r32] = f2bf(o[0][r]); stg[orow * 64 + 32 + r32] = f2bf(o[1][r]); }
    __builtin_amdgcn_s_waitcnt(0xc07f);
    __builtin_amdgcn_wave_barrier();
#pragma unroll
    for (int i = 0; i < 4; ++i) { const int row = i * 8 + (lane >> 3), ch = lane & 7; const u32x4 v = *(const LDSP u32x4*)(stg + row * 64 + ch * 8); *(u32x4*)(dst + (size_t)row * DM + ch * 8) = v; }
    __builtin_amdgcn_s_waitcnt(0xc07f);
    __builtin_amdgcn_wave_barrier();
}
template <int NG>
__device__ __forceinline__ void load_q(bf16x8* qf, const bf16_t* qrow  , const float* g, float sc, bool norm, int hi) {
    float v[4][8];
#pragma unroll
    for (int d0 = 0; d0 < 4; ++d0) load8(qrow + 16 * d0 + 8 * hi, v[d0]);
    float r0 = 1.f, r1 = 1.f;
    if (norm) {
        float s0 = 0.f, s1 = 0.f;
#pragma unroll
        for (int j = 0; j < 8; ++j) { s0 += v[0][j] * v[0][j] + v[1][j] * v[1][j]; s1 += v[2][j] * v[2][j] + v[3][j] * v[3][j]; }
        s0 += __shfl_xor(s0, 32); s1 += __shfl_xor(s1, 32);
        if (NG == 64) { r0 = rsqrtf((s0 + s1) * (1.f / 64.f) + EPS); r1 = r0; } else { r0 = rsqrtf(s0 * (1.f / 32.f) + EPS); r1 = rsqrtf(s1 * (1.f / 32.f) + EPS); }
    }
#pragma unroll
    for (int d0 = 0; d0 < 4; ++d0) {
        const float rr = (d0 < 2 ? r0 : r1) * sc; float w[8];
#pragma unroll
        for (int j = 0; j < 8; ++j) { const int d = 16 * d0 + 8 * hi + j; w[j] = v[d0][j] * rr * (norm ? g[d % NG] : 1.f); }
        u32x4 u; u[0] = pg8::cvt_pk_bf16(w[0], w[1]); u[1] = pg8::cvt_pk_bf16(w[2], w[3]); u[2] = pg8::cvt_pk_bf16(w[4], w[5]); u[3] = pg8::cvt_pk_bf16(w[6], w[7]);
        qf[d0] = __builtin_bit_cast(bf16x8, u);
    }
}
__device__ __forceinline__ void kv_load(u32x4& kr, u32x4& vr, const bf16_t* Kb, const bf16_t* Vb, int k0, int tid) {
    const size_t off = (size_t)(k0 + (tid >> 3)) * PINP + (tid & 7) * 8;
    kr = *(const u32x4*)(Kb + off); vr = *(const u32x4*)(Vb + off);
}
__device__ __forceinline__ void kv_store(const u32x4& kr, const u32x4& vr, LDSP unsigned char* L, int tid) {
    const int key = tid >> 3, ch = tid & 7;
    *(LDSP u32x4*)(L + AL_K + key * KSTR + ch * 16) = kr;
    *(LDSP u32x4*)(L + AL_V + (ch >> 2) * 4096 + (key >> 4) * 1024 + ((key >> 3) & 1) * 512 + (key & 7) * 64 + (ch & 3) * 16) = vr;
}


__device__ __forceinline__ void bias_near(f32x16& p0, f32x16& p1, const LDSP float* tbl, int tk0  , int wnd, bool rowok, int hi) {
#pragma unroll
    for (int g = 0; g < 4; ++g) {
#pragma unroll
        for (int i = 0; i < 4; ++i) { const int r = 4 * g + i; const int d0_ = tk0 - crow(r, hi), d1_ = d0_ - 32;
            const float b0 = tbl[min(max(d0_, 0), 127)], b1 = tbl[min(max(d1_, 0), 127)];
            p0[r] = (d0_ < 0 || d0_ >= wnd || !rowok) ? -INFINITY : p0[r] + b0; p1[r] = (d1_ < 0 || d1_ >= wnd || !rowok) ? -INFINITY : p1[r] + b1; }
        asm volatile("" ::: "memory");
    }
}
__device__ void fa_fox_unit(const Params& p, int l, int b, int h, int qb, LDSP unsigned char* L) {
    const int tid = TID(), lane = tid & 63, wid = __builtin_amdgcn_readfirstlane(tid >> 6), r32 = lane & 31, hi = lane >> 5;
    const bf16_t* proj = (const bf16_t*)(p.ws + WS_PROJ); bf16_t* mix = (bf16_t*)(p.ws + WS_MIX);
    const size_t rb = (size_t)b * SEQ; const int q0 = qb * 256, qw = q0 + 32 * wid, t = qw + r32;
    const bf16_t* Kb = proj + rb * PINP + CB_K + 64 * h; const bf16_t* Vb = proj + rb * PINP + CB_V + 64 * h;
    const float* cm = (const float*)(p.ws + WS_CUM) + (b * 4 + h) * SEQ;
    LDSP float* wsf = (LDSP float*)(L + AL_WSF) + wid * 64; LDSP float* bk = (LDSP float*)(L + AL_BK);
    const int vb = ((lane >> 4) & 1) * 32 + (lane & 3) * 8 + (4 * hi + ((lane & 15) >> 2)) * 64;
    bf16x8 qf[4]; load_q<64>(qf, proj + (rb + t) * PINP + CB_Q + 64 * h, p.fox_qn + l * 64, 0.125f * LOG2E, true, hi);
    f32x16 o[2]; o[0] = (f32x16){}; o[1] = (f32x16){};
    float m_run = -INFINITY, l_run = 0.f;
    const int NT = 4 * qb + 4, jd = 4 * qb + (wid >> 1);
    u32x4 kr, vr; float cr = 0.f;
    kv_load(kr, vr, Kb, Vb, 0, tid); if (tid < 64) cr = cm[tid];
    for (int j = 0; j < NT; ++j) {
        __syncthreads();
        kv_store(kr, vr, L, tid); if (tid < 64) bk[tid] = -cr * LOG2E;
        __syncthreads();
        if (j + 1 < NT) { kv_load(kr, vr, Kb, Vb, 64 * (j + 1), tid); if (tid < 64) cr = cm[64 * (j + 1) + tid]; }
        if (j <= jd) {
            f32x16 p0 = (f32x16){}, p1 = (f32x16){};
            qkt<4>(p0, p1, L + AL_K, qf, 0, r32, hi);
            const int k0 = 64 * j;
#pragma unroll
            for (int g = 0; g < 4; ++g) { const f32x4 b0 = *(const LDSP f32x4*)(bk + 8 * g + 4 * hi), b1 = *(const LDSP f32x4*)(bk + 32 + 8 * g + 4 * hi);
#pragma unroll
                for (int i = 0; i < 4; ++i) { p0[4 * g + i] += b0[i]; p1[4 * g + i] += b1[i]; } }
            if (j == jd) {
#pragma unroll
                for (int r = 0; r < 16; ++r) { const int kk = k0 + crow(r, hi); if (kk > t) p0[r] = -INFINITY; if (kk + 32 > t) p1[r] = -INFINITY; }
            }
            softmax_tile(p0, p1, m_run, l_run, o, wsf, r32, hi);
            pv(o, L + AL_V, vb, p0, p1);
        }
    }
    l_run += __shfl_xor(l_run, 32);
    scale_rows(o, 1.f / l_run, wsf, r32, hi);
    store_o(o, (LDSP bf16_t*)(L + AL_OST) + wid * 2048, mix + (rb + qw) * DM + 256 + 64 * h, lane, r32, hi);
}
__device__ void fa_phase_fox(const Params& p, int l, LDSP unsigned char* L) {
    for (int u = blockIdx.x; u < 256; u += gridDim.x) { const int qb = 15 - (u >> 4), bh = u & 15; fa_fox_unit(p, l, bh >> 2, bh & 3, qb, L); }
}


__device__ void fa_diff_unit(const Params& p, int l, int b, int h, int qb, LDSP unsigned char* L) {
    const int tid = TID(), lane = tid & 63, wid = __builtin_amdgcn_readfirstlane(tid >> 6), r32 = lane & 31, hi = lane >> 5;
    const bf16_t* proj = (const bf16_t*)(p.ws + WS_PROJ); bf16_t* mix = (bf16_t*)(p.ws + WS_MIX);
    const size_t rb = (size_t)b * SEQ; const int q0 = qb * 256, qw = q0 + 32 * wid, t = qw + r32;
    const bf16_t* Kb = proj + rb * PINP + CA_K + 64 * h; const bf16_t* Vb = proj + rb * PINP + CA_V + 64 * h;
    LDSP float* wsf = (LDSP float*)(L + AL_WSF) + wid * 64; LDSP float* tbl = (LDSP float*)(L + AL_TB);
    const int vb = ((lane >> 4) & 1) * 32 + (lane & 3) * 8 + (4 * hi + ((lane & 15) >> 2)) * 64;
    const float lam = ((const float*)(p.ws + WS_LAM))[l]; const float lam_init = 0.8f - 0.6f * __expf(-0.3f * (float)l);
    __syncthreads();
    if (tid < 128) tbl[tid] = ((const float*)(p.ws + WS_TB))[h * 128 + tid] * LOG2E;
    bf16x8 qf[4]; load_q<32>(qf, proj + (rb + t) * PINP + CA_Q + 64 * h, p.diff_qn + l * 32, 0.17677669529663687f * LOG2E, true, hi);
    f32x16 o1[2], o2[2]; o1[0] = (f32x16){}; o1[1] = (f32x16){}; o2[0] = (f32x16){}; o2[1] = (f32x16){};
    float m1 = -INFINITY, l1 = 0.f, m2 = -INFINITY, l2 = 0.f;
    const int NT = 4 * qb + 4, jd = 4 * qb + (wid >> 1);
    u32x4 kr, vr;
    kv_load(kr, vr, Kb, Vb, 0, tid);
    for (int j = 0; j < NT; ++j) {
        __syncthreads();
        kv_store(kr, vr, L, tid);
        __syncthreads();
        if (j + 1 < NT) kv_load(kr, vr, Kb, Vb, 64 * (j + 1), tid);
        if (j <= jd) {
            const int k0 = 64 * j; const bool nearb = (qw - (k0 + 63)) < 113; const float b31 = tbl[127];
#pragma unroll
            for (int mp = 0; mp < 2; ++mp) {
                f32x16 p0 = (f32x16){}, p1 = (f32x16){};
                qkt<2>(p0, p1, L + AL_K, qf + 2 * mp, 2 * mp, r32, hi);
                if (nearb) { bias_near(p0, p1, tbl, t - k0, 1 << 30, true, hi);
                } else {
#pragma unroll
                    for (int r = 0; r < 16; ++r) { p0[r] += b31; p1[r] += b31; }
                }
                if (mp == 0) { softmax_tile(p0, p1, m1, l1, o1, wsf, r32, hi); pv(o1, L + AL_V, vb, p0, p1); }
                else { softmax_tile(p0, p1, m2, l2, o2, wsf, r32, hi); pv(o2, L + AL_V, vb, p0, p1); }
            }
        }
    }
    l1 += __shfl_xor(l1, 32); l2 += __shfl_xor(l2, 32);
    scale_rows(o1, 1.f / l1, wsf, r32, hi); scale_rows(o2, lam / l2, wsf, r32, hi);
    o1[0] -= o2[0]; o1[1] -= o2[1];
    const float g0 = p.diff_sub[l * 64 + r32] * (1.f - lam_init), g1 = p.diff_sub[l * 64 + 32 + r32] * (1.f - lam_init);
#pragma unroll
    for (int r = 0; r < 16; ++r) {
        float ss = o1[0][r] * o1[0][r] + o1[1][r] * o1[1][r];
        ss += __shfl_xor(ss, 1); ss += __shfl_xor(ss, 2); ss += __shfl_xor(ss, 4); ss += __shfl_xor(ss, 8); ss += __shfl_xor(ss, 16);
        const float rs = rsqrtf(ss * (1.f / 64.f) + EPS); o1[0][r] *= rs * g0; o1[1][r] *= rs * g1;
    }
    store_o(o1, (LDSP bf16_t*)(L + AL_OST) + wid * 2048, mix + (rb + qw) * DM + 0 + 64 * h, lane, r32, hi);
}
__device__ __forceinline__ void stick_sub(f32x16& y, float& carry, int kbase  , int t, bool diag, int hi) {
    float lk[16];
#pragma unroll
    for (int r = 0; r < 16; ++r) {
        const float v = y[r]; const float e = ex2(-fabsf(v)); const float lb = fminf(v, 0.f) - __builtin_amdgcn_logf(1.f + e);
        const bool valid = !diag || (kbase + crow(r, hi) < t);
        lk[r] = valid ? (lb - v) : 0.f; y[r] = valid ? lb : -INFINITY;
    }
    float T[4], Go[4];
#pragma unroll
    for (int g = 0; g < 4; ++g) { const float Gs = (lk[4 * g] + lk[4 * g + 1]) + (lk[4 * g + 2] + lk[4 * g + 3]); Go[g] = __shfl_xor(Gs, 32); T[g] = Gs + Go[g]; }
    float sx = 0.f;
#pragma unroll
    for (int g = 3; g >= 0; --g) {
        float tail = carry + sx + (hi == 0 ? Go[g] : 0.f);
#pragma unroll
        for (int i = 3; i >= 0; --i) { y[4 * g + i] = ex2(y[4 * g + i] + tail); tail += lk[4 * g + i]; }
        sx += T[g];
    }
    carry += sx;
}
__device__ void fa_stick_unit(const Params& p, int l, int b, int h, int qb, LDSP unsigned char* L) {
    const int tid = TID(), lane = tid & 63, wid = __builtin_amdgcn_readfirstlane(tid >> 6), r32 = lane & 31, hi = lane >> 5;
    const bf16_t* proj = (const bf16_t*)(p.ws + WS_PROJ); bf16_t* mix = (bf16_t*)(p.ws + WS_MIX);
    const size_t rb = (size_t)b * SEQ; const int q0 = qb * 256, qw = q0 + 32 * wid, t = qw + r32;
    const bf16_t* Kb = proj + rb * PINP + CC_K + 64 * h; const bf16_t* Vb = proj + rb * PINP + CC_V + 64 * h;
    const int vb = ((lane >> 4) & 1) * 32 + (lane & 3) * 8 + (4 * hi + ((lane & 15) >> 2)) * 64;
    bf16x8 qf[4]; load_q<64>(qf, proj + (rb + t) * PINP + CC_Q + 64 * h, nullptr, 0.125f * LOG2E, false, hi);
    f32x16 o[2]; o[0] = (f32x16){}; o[1] = (f32x16){};
    float carry = 0.f;
    const int NT = 4 * qb + 4, jd = 4 * qb + (wid >> 1);
    u32x4 kr, vr;
    kv_load(kr, vr, Kb, Vb, 64 * (NT - 1), tid);
    for (int j = NT - 1; j >= 0; --j) {
        __syncthreads();
        kv_store(kr, vr, L, tid);
        __syncthreads();
        if (j > 0) kv_load(kr, vr, Kb, Vb, 64 * (j - 1), tid);
        if (j <= jd) {
            f32x16 p0 = (f32x16){}, p1 = (f32x16){};
            qkt<4>(p0, p1, L + AL_K, qf, 0, r32, hi);
            const int k0 = 64 * j; const bool diag = (j == jd);
            stick_sub(p1, carry, k0 + 32, t, diag, hi);
            stick_sub(p0, carry, k0, t, diag, hi);
            pv(o, L + AL_V, vb, p0, p1);
        }
    }
    store_o(o, (LDSP bf16_t*)(L + AL_OST) + wid * 2048, mix + (rb + qw) * DM + 512 + 64 * h, lane, r32, hi);
}
__device__ void fa_phase_abc(const Params& p, int l, LDSP unsigned char* L) {
    for (int u = blockIdx.x; u < 768; u += gridDim.x) {
        const int typ = u % 3, v = u / 3, qb = 15 - (v >> 4), bh = v & 15;
        if (typ == 0) fa_diff_unit(p, l, bh >> 2, bh & 3, qb, L);
        else if (typ == 1) fa_fox_unit(p, l, bh >> 2, bh & 3, qb, L);
        else fa_stick_unit(p, l, bh >> 2, bh & 3, qb, L);
    }
}


constexpr int AL_IMP = 53248  , AL_SELM = AL_IMP + 65536  , AL_TB4 = AL_SELM + 512  , AL_D_END = AL_TB4 + 2048;
static_assert(AL_END <= AL_IMP && AL_D_END <= 131072 + 4096, "attention LDS map");
__device__ __forceinline__ void kv_load64(u32x4& kr, u32x4& vr, const bf16_t* Kb, const bf16_t* Vb, int n0, int tid) {
    const size_t off = (size_t)(n0 + (tid >> 3)) * 64 + (tid & 7) * 8;
    kr = *(const u32x4*)(Kb + off); vr = *(const u32x4*)(Vb + off);
}
__device__ void fa_nsa_unit(const Params& p, int l, int b, int u, LDSP unsigned char* L) {
    const int tid = TID(), lane = tid & 63, wid = __builtin_amdgcn_readfirstlane(tid >> 6), r32 = lane & 31, hi = lane >> 5;
    const int hh = wid >> 1, sub = wid & 1;
    const bf16_t* proj = (const bf16_t*)(p.ws + WS_PROJ); bf16_t* mix = (bf16_t*)(p.ws + WS_MIX);
    const size_t rb = (size_t)b * SEQ; const int q0 = 64 * u, qw = q0 + 32 * sub, t = qw + r32; const int ql = 32 * sub + r32;
    LDSP float* wsf = (LDSP float*)(L + AL_WSF) + wid * 64; LDSP float* tbl = (LDSP float*)(L + AL_TB4) + hh * 128;
    LDSP float* imp = (LDSP float*)(L + AL_IMP); LDSP unsigned* selm = (LDSP unsigned*)(L + AL_SELM);
    const int vb = ((lane >> 4) & 1) * 32 + (lane & 3) * 8 + (4 * hi + ((lane & 15) >> 2)) * 64;
    __syncthreads();
    ((LDSP float*)(L + AL_TB4))[tid] = ((const float*)(p.ws + WS_TB))[512 + tid] * LOG2E;
    bf16x8 qf[4]; load_q<64>(qf, proj + (rb + t) * PINP + CD_Q + 64 * hh, p.nsa_qn + l * 64, 0.125f * LOG2E, true, hi);
    const float* sd = (const float*)(p.ws + WS_SIDE) + (rb + t) * 16 + 4 + hh;
    const float gc = 1.f / (1.f + __expf(-sd[0])), gs = 1.f / (1.f + __expf(-sd[4])), gwn = 1.f / (1.f + __expf(-sd[8]));
    f32x16 o[2]; o[0] = (f32x16){}; o[1] = (f32x16){};
    LDSP float* ofl = (LDSP float*)(L + AL_IMP) + wid * 2048 + lane;
    u32x4 kr, vr;
    {
        const bf16_t* Kc = (const bf16_t*)(p.ws + WS_KC) + (size_t)b * 256 * 64; const bf16_t* Vc = (const bf16_t*)(p.ws + WS_VC) + (size_t)b * 256 * 64;
        const int ntc = (4 * u + 2) / 64 + 1;
        float m_run = -INFINITY, l_run = 0.f;
        for (int pass = 0; pass < 2; ++pass) {
            float inv = 0.f, m_use = 0.f, prevE3 = 0.f;
            if (pass == 1) { l_run += __shfl_xor(l_run, 32); inv = (l_run > 0.f) ? 1.f / l_run : 0.f; m_use = (m_run == -INFINITY) ? 0.f : m_run; }
            kv_load64(kr, vr, Kc, Vc, 0, tid);
            for (int T = 0; T < ntc; ++T) {
                __syncthreads();
                kv_store(kr, vr, L, tid);
                __syncthreads();
                if (T + 1 < ntc) kv_load64(kr, vr, Kc, Vc, 64 * (T + 1), tid);
                f32x16 p0 = (f32x16){}, p1 = (f32x16){};
                qkt<4>(p0, p1, L + AL_K, qf, 0, r32, hi);
#pragma unroll
                for (int g = 0; g < 4; ++g) {
#pragma unroll
                    for (int i = 0; i < 4; ++i) { const int r = 4 * g + i; const int d0_ = t - 16 * (64 * T + crow(r, hi)) - 31, d1_ = d0_ - 512;
                        const float b0 = tbl[min(max(d0_, 0), 127)], b1 = tbl[min(max(d1_, 0), 127)];
                        p0[r] = (d0_ < 0) ? -INFINITY : p0[r] + b0; p1[r] = (d1_ < 0) ? -INFINITY : p1[r] + b1; }
                    asm volatile("" ::: "memory");
                }
                if (pass == 0) {
                    float mt = fmaxf(p0[0], p1[0]);
#pragma unroll
                    for (int r = 1; r < 16; ++r) mt = fmaxf(mt, fmaxf(p0[r], p1[r]));
                    mt = fmaxf(mt, __shfl_xor(mt, 32));
                    const float m_new = fmaxf(m_run, mt), mu = (m_new == -INFINITY) ? 0.f : m_new;
                    float ls = 0.f;
#pragma unroll
                    for (int r = 0; r < 16; ++r) ls += ex2(p0[r] - mu) + ex2(p1[r] - mu);
                    l_run = l_run * ex2(m_run - mu) + ls; m_run = m_new;
                } else {
#pragma unroll
                    for (int r = 0; r < 16; ++r) { p0[r] = ex2(p0[r] - m_use) * inv; p1[r] = ex2(p1[r] - m_use) * inv; }
#pragma unroll
                    for (int s2 = 0; s2 < 2; ++s2) {
                        float G[4], E[4], Eo[4];
#pragma unroll
                        for (int g = 0; g < 4; ++g) { const float a0 = s2 ? p1[4 * g] : p0[4 * g], a1 = s2 ? p1[4 * g + 1] : p0[4 * g + 1], a2 = s2 ? p1[4 * g + 2] : p0[4 * g + 2], a3 = s2 ? p1[4 * g + 3] : p0[4 * g + 3];
                            G[g] = (a0 + a1) + (a2 + a3); E[g] = a3; Eo[g] = __shfl_xor(a3, 32); }
#pragma unroll
                        for (int g = 0; g < 4; ++g) { const float eprev = hi ? Eo[g] : (g > 0 ? Eo[g - 1] : prevE3);
                            imp[(hh * 64 + ql) * 64 + 16 * T + 8 * s2 + 2 * g + hi] = G[g] + eprev; }
                        prevE3 = Eo[3];
                    }
                    pv(o, L + AL_V, vb, p0, p1);
                }
            }
        }
        scale_rows(o, gc, wsf, r32, hi);
    }
    __syncthreads();
    {
        const int q = tid >> 3, part = tid & 7;
        float vj[8];
#pragma unroll
        for (int jj = 0; jj < 8; ++jj) { const int j = part * 8 + jj;
            const float sum = ((imp[(0 * 64 + q) * 64 + j] + imp[(1 * 64 + q) * 64 + j]) + imp[(2 * 64 + q) * 64 + j]) + imp[(3 * 64 + q) * 64 + j];
            vj[jj] = (j > u) ? -1.0f : ((j == u || j == 0) ? 1.0e4f : sum); }
        __syncthreads();
#pragma unroll
        for (int jj = 0; jj < 8; ++jj) imp[q * 64 + part * 8 + jj] = vj[jj];
        __syncthreads();
        int rank[8];
#pragma unroll
        for (int jj = 0; jj < 8; ++jj) rank[jj] = 0;
        for (int i = 0; i < 64; ++i) { const float vi = imp[q * 64 + i];
#pragma unroll
            for (int jj = 0; jj < 8; ++jj) rank[jj] += (vi > vj[jj] || (vi == vj[jj] && i < part * 8 + jj)) ? 1 : 0; }
        unsigned bits = 0;
#pragma unroll
        for (int jj = 0; jj < 8; ++jj) if (rank[jj] < 16 && (part * 8 + jj) <= u) bits |= 1u << jj;
        unsigned mlo = (part < 4) ? (bits << (8 * part)) : 0u, mhi = (part >= 4) ? (bits << (8 * (part - 4))) : 0u;
        mlo |= __shfl_xor(mlo, 1); mhi |= __shfl_xor(mhi, 1); mlo |= __shfl_xor(mlo, 2); mhi |= __shfl_xor(mhi, 2); mlo |= __shfl_xor(mlo, 4); mhi |= __shfl_xor(mhi, 4);
        if (part == 0) { selm[2 * q] = mlo; selm[2 * q + 1] = mhi; }
    }
    __syncthreads();
#pragma unroll
    for (int r = 0; r < 16; ++r) { ofl[(2 * r) * 64] = o[0][r]; ofl[(2 * r + 1) * 64] = o[1][r]; }
    o[0] = (f32x16){}; o[1] = (f32x16){};
    {
        const unsigned long long mymask = (unsigned long long)selm[2 * ql] | ((unsigned long long)selm[2 * ql + 1] << 32);
        unsigned ulo = selm[2 * lane], uhi = selm[2 * lane + 1];
#pragma unroll
        for (int s2 = 1; s2 < 64; s2 <<= 1) { ulo |= __shfl_xor(ulo, s2); uhi |= __shfl_xor(uhi, s2); }
        unsigned long long um = (unsigned long long)(unsigned)__builtin_amdgcn_readfirstlane((int)ulo) | ((unsigned long long)(unsigned)__builtin_amdgcn_readfirstlane((int)uhi) << 32);
        const bf16_t* Kb = proj + rb * PINP + CD_KS; const bf16_t* Vb = proj + rb * PINP + CD_VS;
        float m_run = -INFINITY, l_run = 0.f; const float b31 = tbl[127];
        int j = __builtin_ctzll(um); um &= um - 1;
        kv_load(kr, vr, Kb, Vb, 64 * j, tid);
        for (;;) {
            __syncthreads();
            kv_store(kr, vr, L, tid);
            __syncthreads();
            const int jn = um ? __builtin_ctzll(um) : -1; um &= um - 1;
            if (jn >= 0) kv_load(kr, vr, Kb, Vb, 64 * jn, tid);
            const bool mine = (mymask >> j) & 1ull;
            if (__any(mine)) {
                f32x16 p0 = (f32x16){}, p1 = (f32x16){};
                qkt<4>(p0, p1, L + AL_K, qf, 0, r32, hi);
                const int k0 = 64 * j; const bool nearb = (qw - (k0 + 63)) < 113;
                if (nearb) { bias_near(p0, p1, tbl, t - k0, 1 << 30, mine, hi);
                } else {
#pragma unroll
                    for (int r = 0; r < 16; ++r) { p0[r] = mine ? p0[r] + b31 : -INFINITY; p1[r] = mine ? p1[r] + b31 : -INFINITY; }
                }
                softmax_tile(p0, p1, m_run, l_run, o, wsf, r32, hi);
                pv(o, L + AL_V, vb, p0, p1);
            }
            if (jn < 0) break;
            j = jn;
        }
        l_run += __shfl_xor(l_run, 32);
        scale_rows(o, gs / l_run, wsf, r32, hi);
#pragma unroll
        for (int r = 0; r < 16; ++r) { ofl[(2 * r) * 64] += o[0][r]; ofl[(2 * r + 1) * 64] += o[1][r]; }
        o[0] = (f32x16){}; o[1] = (f32x16){};
    }
    {
        const bf16_t* Kb = proj + rb * PINP + CD_KW; const bf16_t* Vb = proj + rb * PINP + CD_VW;
        float m_run = -INFINITY, l_run = 0.f; const float b31 = tbl[127];
        const int jlo = max(0, u - 8);
        kv_load(kr, vr, Kb, Vb, 64 * jlo, tid);
        for (int j = jlo; j <= u; ++j) {
            __syncthreads();
            kv_store(kr, vr, L, tid);
            __syncthreads();
            if (j < u) kv_load(kr, vr, Kb, Vb, 64 * (j + 1), tid);
            f32x16 p0 = (f32x16){}, p1 = (f32x16){};
            qkt<4>(p0, p1, L + AL_K, qf, 0, r32, hi);
            const int k0 = 64 * j;
            if (j == u || j == u - 8 || (qw - (k0 + 63)) < 113) { bias_near(p0, p1, tbl, t - k0, 512, true, hi);
            } else {
#pragma unroll
                for (int r = 0; r < 16; ++r) { p0[r] += b31; p1[r] += b31; }
            }
            softmax_tile(p0, p1, m_run, l_run, o, wsf, r32, hi);
            pv(o, L + AL_V, vb, p0, p1);
        }
        l_run += __shfl_xor(l_run, 32);
        scale_rows(o, gwn / l_run, wsf, r32, hi);
#pragma unroll
        for (int r = 0; r < 16; ++r) { o[0][r] += ofl[(2 * r) * 64]; o[1][r] += ofl[(2 * r + 1) * 64]; }
    }
    store_o(o, (LDSP bf16_t*)(L + AL_OST) + wid * 2048, mix + (rb + qw) * DM + 768 + 64 * hh, lane, r32, hi);
}
__device__ __forceinline__ int unit_cost(int idx) {
    const int typ = idx >> 8, v = idx & 255;
    if (typ == 3) { const int u = v & 63; return 10 * (min(u + 1, 28) + min(u + 1, 9) + 2 * ((4 * u + 2) / 64 + 1)) + 40; }
    const int nt = 4 * (v >> 4) + 4; return (typ == 0 ? 16 : (typ == 1 ? 10 : 14)) * nt + 20;
}
__device__ void ph_build_order(const Params& p) {
    unsigned* ctl = (unsigned*)(p.ws + WS_CTL);
    const int gt = GTID(), gs = GSIZE();
    for (int idx = gt; idx < 1024; idx += gs) {
        const int c = unit_cost(idx); int rank = 0;
        for (int i = 0; i < 1024; ++i) { const int ci = unit_cost(i); rank += (ci > c || (ci == c && i < idx)) ? 1 : 0; }
        ctl[64 + rank] = (unsigned)idx;
    }
    if (gt < 8) ctl[gt] = 0u;
}
__device__ void fa_phase_all(const Params& p, int l, LDSP unsigned char* L) {
    unsigned* ctl = (unsigned*)(p.ws + WS_CTL);
    LDSP unsigned* misc = (LDSP unsigned*)(L + AL_MISC);
    for (;;) {
        __syncthreads();
        if (threadIdx.x == 0) misc[0] = atomicAdd(&ctl[l], 1u);
        __syncthreads();
        const unsigned qi = misc[0];
        if (qi >= 1024u) break;
        const int idx = (int)ctl[64 + qi]; const int typ = idx >> 8, v = idx & 255;
        if (typ == 0) fa_diff_unit(p, l, (v & 15) >> 2, v & 3, v >> 4, L);
        else if (typ == 1) fa_fox_unit(p, l, (v & 15) >> 2, v & 3, v >> 4, L);
        else if (typ == 2) fa_stick_unit(p, l, (v & 15) >> 2, v & 3, v >> 4, L);
        else fa_nsa_unit(p, l, v >> 6, v & 63, L);
    }
}

__device__ void ph_act(const Params& p, int l) {
    const bf16_t* ug = (const bf16_t*)(p.ws + WS_UG); bf16_t* uv = (bf16_t*)(p.ws + WS_UV);
    const float* cw = p.conv_w + (size_t)l * 3 * DFF; const float* cb = p.conv_b + (size_t)l * DFF;
    constexpr int NC = DFF / 8;
    for (int idx = GTID(); idx < MTOK * NC; idx += GSIZE()) {
        const int c8 = (idx % NC) * 8; const size_t row = (size_t)(idx / NC); const int t = (int)(row & (SEQ - 1));
        float g0[8], g1[8], g2[8], v[8];
        load8(ug + row * DFF + c8, g0);
        if (t >= 1) load8(ug + (row - 1) * DFF + c8, g1); else {
#pragma unroll
            for (int j = 0; j < 8; ++j) g1[j] = 0.f; }
        if (t >= 2) load8(ug + (row - 2) * DFF + c8, g2); else {
#pragma unroll
            for (int j = 0; j < 8; ++j) g2[j] = 0.f; }
        load8(uv + row * DFF + c8, v);
        float o[8];
#pragma unroll
        for (int j = 0; j < 8; ++j) { const float cv = cw[c8 + j] * g2[j] + cw[DFF + c8 + j] * g1[j] + cw[2 * DFF + c8 + j] * g0[j] + cb[c8 + j]; o[j] = siluf(cv) * v[j]; }
        u32x4 w; w[0] = pk2(o[0], o[1]); w[1] = pk2(o[2], o[3]); w[2] = pk2(o[4], o[5]); w[3] = pk2(o[6], o[7]);
        *(u32x4*)(uv + row * DFF + c8) = w;
    }
}

namespace cg = cooperative_groups;
constexpr int LDS_BYTES = 131072 + 4096;
#define LAS3 __attribute__((address_space(3)))
__global__ void __launch_bounds__(NTHR, 2) mega(Params p) {
    extern __shared__ __attribute__((aligned(16))) unsigned char lds[];
    cg::grid_group grid = cg::this_grid();
    LAS3 unsigned char* lds3 = (LAS3 unsigned char*)lds;
    ph_mod(p); ph_build_order(p);
    grid.sync();
    for (int l = 0; l < DEPTH; ++l) {
        const float* mod = (const float*)(p.ws + WS_MOD) + (size_t)l * 4 * 6144;
        ph_cbias(p, l); ph_weights(p, l, (float*)lds);
        if (l == 0) ph_xa_from(p, p.x, 0, 0, (bf16_t*)(p.ws + WS_XA), (float*)(p.ws + WS_RSA), true);
        grid.sync();
        {   pg8::Gemm g{(const bf16_t*)(p.ws + WS_XA), (const bf16_t*)(p.ws + WS_WIN), MTOK, PINP, DM}; pg8::StaticOrder S; S.init(MTOK, PINP, (int)gridDim.x, (int)blockIdx.x);
            EpiProjF E{(const float*)(p.ws + WS_RSA), (const float*)(p.ws + WS_CBIN) + (size_t)l * 4 * PINP, (bf16_t*)(p.ws + WS_PROJ), (float*)(p.ws + WS_SIDE)};
            pg8::gemm_phase<EpiProjF, pg8::StaticOrder, PG8_ALIGN, PG8_SP2>(lds3, g, S, E); }
        grid.sync();
        ph_prep_knorm(p, l); ph_prep_cum(p, l); ph_prep_cmp(p, l, lds);
        grid.sync();
        fa_phase_all(p, l, lds3);
        grid.sync();
        {   pg8::Gemm g{(const bf16_t*)(p.ws + WS_MIX), (const bf16_t*)(p.ws + WS_WOUT), MTOK, DM, DM}; pg8::StaticOrder S; S.init(MTOK, DM, (int)gridDim.x, (int)blockIdx.x);
            EpiResF E{l == 0 ? p.x : p.out, p.out, mod + 2048, p.norm_ffn_g + l * DM, mod + 4096, (bf16_t*)(p.ws + WS_XA), (float*)(p.ws + WS_RSB)};
            pg8::gemm_phase<EpiResF, pg8::StaticOrder, PG8_ALIGN, PG8_SP2>(lds3, g, S, E); }
        grid.sync();
        {   pg8::Gemm g{(const bf16_t*)(p.ws + WS_XA), (const bf16_t*)(p.ws + WS_WUP), MTOK, NUP, DM}; pg8::StaticOrder S; S.init(MTOK, NUP, (int)gridDim.x, (int)blockIdx.x);
            EpiUpF E{(const float*)(p.ws + WS_RSB), (const float*)(p.ws + WS_CBUP) + (size_t)l * 4 * NUP, (bf16_t*)(p.ws + WS_UG), (bf16_t*)(p.ws + WS_UV)};
            pg8::gemm_phase<EpiUpF, pg8::StaticOrder, PG8_ALIGN, PG8_SP2>(lds3, g, S, E); }
        grid.sync();
        ph_act(p, l);
        grid.sync();
        {   const float* modn = (const float*)(p.ws + WS_MOD) + (size_t)(l + 1) * 4 * 6144; const bool more = (l + 1 < DEPTH);
            pg8::Gemm g{(const bf16_t*)(p.ws + WS_UV), (const bf16_t*)(p.ws + WS_WDN), MTOK, DM, DFF}; pg8::StaticOrder S; S.init(MTOK, DM, (int)gridDim.x, (int)blockIdx.x);
            EpiResF E{p.out, p.out, mod + 5120, p.norm_mix_g + (more ? l + 1 : l) * DM, more ? modn + 1024 : mod + 1024, more ? (bf16_t*)(p.ws + WS_XA) : nullptr, more ? (float*)(p.ws + WS_RSA) : nullptr};
            pg8::gemm_phase<EpiResF, pg8::StaticOrder, PG8_ALIGN, PG8_SP2>(lds3, g, S, E); }
        if (l + 1 < DEPTH) grid.sync();
    }
}

extern "C" void kernel_launch(void* const* d_in, const int* in_sizes, int n_in, void* d_out, int out_size, void* d_ws, size_t ws_size, hipStream_t stream) {
    if (n_in != 24 || ws_size < WS_END || out_size != MTOK * DM) { fprintf(stderr, "kernel_launch: unexpected sizes (n_in %d, ws %zu, out %d)\n", n_in, ws_size, out_size); return; }
    static int grid_blocks = 0;
    if (!grid_blocks) {
        int dev = 0, cus = 0, per_cu = 0;
        hipGetDevice(&dev);
        hipDeviceGetAttribute(&cus, hipDeviceAttributeMultiprocessorCount, dev);
        hipFuncSetAttribute((const void*)mega, hipFuncAttributeMaxDynamicSharedMemorySize, LDS_BYTES);
        hipOccupancyMaxActiveBlocksPerMultiprocessor(&per_cu, (const void*)mega, NTHR, LDS_BYTES);
        if (per_cu < 1) { fprintf(stderr, "kernel_launch: occupancy query returned %d\n", per_cu); per_cu = 1; }
        if (per_cu > 1) per_cu = 1;
        grid_blocks = cus * per_cu;
        fprintf(stderr, "kernel_launch: cus %d per_cu %d grid %d\n", cus, per_cu, grid_blocks);
    }
    Params p{};
    const float** f = (const float**)&p;
    for (int i = 0; i < 24; ++i) f[i] = (const float*)d_in[i];
    p.out = (float*)d_out; p.ws = (unsigned char*)d_ws;
    void* args[] = {&p};
    hipError_t e = hipLaunchCooperativeKernel((const void*)mega, dim3(grid_blocks), dim3(NTHR), args, LDS_BYTES, stream);
    if (e != hipSuccess) fprintf(stderr, "cooperative launch failed: %s (grid %d)\n", hipGetErrorString(e), grid_blocks);
}
```

```cpp
#include <hip/hip_runtime.h>
#include <hip/hip_cooperative_groups.h>
#include <cstdint>
#include <cstdio>

typedef unsigned short bf16_t;
typedef short bf16x8 __attribute__((ext_vector_type(8)));
typedef float f32x4 __attribute__((ext_vector_type(4)));
typedef unsigned u32x4 __attribute__((ext_vector_type(4)));

constexpr int NB = 4, SEQ = 4096, DM = 1024, MTOK = NB * SEQ, DEPTH = 2;
constexpr int HD = 64, HPM = 4, DFF = 2816, PIN = 2960, PINP = 3072, NUP = 2 * DFF;
constexpr float EPS = 1e-6f;
constexpr int NTHR = 512;

constexpr int CA_Q = 0, CA_K = 256, CA_V = 512, CB_Q = 768, CB_K = 1024, CB_V = 1280, CC_Q = 1536, CC_K = 1792, CC_V = 2048;
constexpr int CD_Q = 2304, CD_KC = 2560, CD_VC = 2624, CD_KS = 2688, CD_VS = 2752, CD_KW = 2816, CD_VW = 2880, C_BF = 2944, C_DG = 2948;

constexpr size_t MiB = 1u << 20;
constexpr size_t WS_CTL = 0;
constexpr size_t WS_MOD = 1 * MiB;
constexpr size_t WS_CBIN = WS_MOD + 2 * 4 * 6144 * 4;
constexpr size_t WS_CBUP = WS_CBIN + 2 * 4 * 3072 * 4;
constexpr size_t WS_TB = WS_CBUP + 2 * 4 * 5632 * 4;
constexpr size_t WS_LAM = WS_TB + 2 * 4 * 128 * 4;
constexpr size_t WS_CUM = WS_LAM + 256;
constexpr size_t WS_KC = WS_CUM + 16 * 4096 * 4;
constexpr size_t WS_VC = WS_KC + 4 * 256 * 64 * 2;
constexpr size_t WS_SELM = WS_VC + 4 * 256 * 64 * 2;
constexpr size_t WS_SMALL_END = WS_SELM + 16384 * 8;
static_assert(WS_SMALL_END <= 4 * MiB, "small region");
constexpr size_t WS_RSA = 4 * MiB;
constexpr size_t WS_RSB = 5 * MiB;
constexpr size_t WS_SIDE = 6 * MiB;
constexpr size_t WS_IMP = 7 * MiB;
constexpr size_t WS_ML = 11 * MiB;
constexpr size_t WS_W = 12 * MiB;
constexpr size_t WS_WIN = WS_W;
constexpr size_t WS_WOUT = WS_WIN + (size_t)PINP * DM * 2;
constexpr size_t WS_WUP = WS_WOUT + (size_t)DM * DM * 2;
constexpr size_t WS_WDN = WS_WUP + (size_t)NUP * DM * 2;
constexpr size_t WS_W_END = WS_WDN + (size_t)DM * DFF * 2;
static_assert(WS_W_END <= 38 * MiB, "weights region");
constexpr size_t WS_XA = 38 * MiB;
constexpr size_t WS_BIG = 70 * MiB;
constexpr size_t WS_PROJ = WS_BIG;
constexpr size_t WS_MIX = WS_BIG + 96 * MiB;
constexpr size_t WS_UG = WS_BIG;
constexpr size_t WS_UV = WS_BIG + 88 * MiB;
constexpr size_t WS_END = WS_BIG + 176 * MiB;
static_assert(WS_END <= 256 * MiB, "workspace");

struct Params {
    const float *x, *c, *rel_bias, *ada_w, *ada_b, *norm_mix_g, *norm_ffn_g, *w_in, *w_out;
    const float *diff_qn, *diff_kn, *diff_lam, *diff_sub, *fox_qn, *fox_kn, *fox_bf;
    const float *nsa_qn, *nsa_kn, *nsa_pe, *nsa_phi, *w_up, *conv_w, *conv_b, *w_down;
    float* out;
    unsigned char* ws;
};

__device__ __forceinline__ float bf2f(bf16_t v) { return __uint_as_float(((unsigned)v) << 16); }
__device__ __forceinline__ bf16_t f2bf(float f) { unsigned u = __float_as_uint(f); return (bf16_t)((u + 0x7fffu + ((u >> 16) & 1u)) >> 16); }
__device__ __forceinline__ unsigned pk2(float lo, float hi) { return (unsigned)f2bf(lo) | ((unsigned)f2bf(hi) << 16); }
__device__ __forceinline__ float siluf(float v) { return v / (1.f + __expf(-v)); }
__device__ __forceinline__ float logsigf(float v) { return fminf(v, 0.f) - log1pf(__expf(-fabsf(v))); }
__device__ __forceinline__ float wave_sum(float v) {
#pragma unroll
    for (int o = 1; o < 64; o <<= 1) v += __shfl_xor(v, o);
    return v;
}
__device__ __forceinline__ int t5_bucket(int n) {
    if (n < 16) return n < 0 ? 0 : n;
    return 16 + (n >= 19) + (n >= 21) + (n >= 24) + (n >= 27) + (n >= 31) + (n >= 35) + (n >= 40) + (n >= 46) + (n >= 52) + (n >= 59) + (n >= 67) + (n >= 77) + (n >= 87) + (n >= 99) + (n >= 113);
}
__host__ __device__ __forceinline__ int in_col_map(int n) {
    if (n < 1536) return n;
    if (n < 2944) return n + 4;
    if (n < 2948) return 1536 + (n - 2944);
    if (n < 2960) return n;
    return -1;
}
__host__ __device__ __forceinline__ int up_col_map(int n) {
    const int pn = n >> 8, c = n & 255;
    return c < 128 ? (128 * pn + c) : (DFF + 128 * pn + (c - 128));
}

__device__ __forceinline__ int opaque_v(int v) { asm volatile("" : "+v"(v)); return v; }
#define TID() opaque_v((int)threadIdx.x)
#define GTID() ((int)(blockIdx.x * blockDim.x) + TID())
#define GSIZE() ((int)(gridDim.x * blockDim.x))

#define LDSF __attribute__((address_space(3)))
__device__ __forceinline__ void gemv4_block(const float* W, int ld, int oc, const LDSF float* vec, LDSF float* red, float* out0, int ostride, int n, float bias, int tid) {
    const int lane = tid & 63, wv = tid >> 6;
    float a0 = 0.f, a1 = 0.f, a2 = 0.f, a3 = 0.f;
    if (oc >= 0) {
        const float* w = W + (size_t)(wv * 128) * ld + oc;
#pragma unroll 16
        for (int k = 0; k < 128; ++k) { const float wk = w[(size_t)k * ld]; const f32x4 v = *(const LDSF f32x4*)(vec + (wv * 128 + k) * 4); a0 += v[0] * wk; a1 += v[1] * wk; a2 += v[2] * wk; a3 += v[3] * wk; }
    }
    red[(wv * 4 + 0) * 64 + lane] = a0; red[(wv * 4 + 1) * 64 + lane] = a1; red[(wv * 4 + 2) * 64 + lane] = a2; red[(wv * 4 + 3) * 64 + lane] = a3;
    __syncthreads();
    if (tid < 256) { const int bt = tid >> 6; float sacc = 0.f;
#pragma unroll
        for (int w8 = 0; w8 < 8; ++w8) sacc += red[(w8 * 4 + bt) * 64 + lane];
        out0[(size_t)bt * ostride + n] = sacc + bias; }
    __syncthreads();
}
__device__ void ph_mod(const Params& p, unsigned char* lds) {
    float* mod = (float*)(p.ws + WS_MOD);
    float* tb = (float*)(p.ws + WS_TB);
    float* lamv = (float*)(p.ws + WS_LAM);
    LDSF float* vec = (LDSF float*)lds; LDSF float* red = (LDSF float*)(lds + 16384);
    const int tid = TID();
    bool loaded = false;
    for (int item = blockIdx.x; item < DEPTH * 96; item += gridDim.x) {
        if (!loaded) { for (int i = tid; i < 4096; i += NTHR) { const int bt = i >> 10, k = i & 1023; vec[k * 4 + bt] = siluf(p.c[bt * DM + k]); } __syncthreads(); loaded = true; }
        const int l = item / 96, n = (item % 96) * 64 + (tid & 63);
        gemv4_block(p.ada_w + (size_t)l * DM * 6144, 6144, n, vec, red, mod + (size_t)l * 4 * 6144, 6144, n, p.ada_b[l * 6144 + n], tid);
    }
    const int gt = GTID(), gs = GSIZE();
    for (int idx = gt; idx < 2 * 4 * 128; idx += gs) {
        const int type = idx / 512, h = (idx / 128) & 3, d = idx & 127;
        tb[idx] = p.rel_bias[t5_bucket(d) * 8 + type * 4 + h];
    }
    for (int idx = gt; idx < DEPTH; idx += gs) {
        const float* lv = p.diff_lam + idx * 4 * 32;
        float s1 = 0.f, s2 = 0.f;
        for (int i = 0; i < 32; ++i) { s1 += lv[i] * lv[32 + i]; s2 += lv[64 + i] * lv[96 + i]; }
        const float lam_init = 0.8f - 0.6f * expf(-0.3f * (float)idx);
        lamv[idx] = expf(s1) - expf(s2) + lam_init;
    }
}
__device__ void ph_cbias(const Params& p, unsigned char* lds) {
    const float* mod = (const float*)(p.ws + WS_MOD);
    LDSF float* vec = (LDSF float*)lds; LDSF float* red = (LDSF float*)(lds + 16384);
    const int tid = TID();
    for (int item = blockIdx.x; item < DEPTH * 136; item += gridDim.x) {
        const int l = item / 136, r = item % 136; const bool isin = r < 48; const int n = (isin ? r : r - 48) * 64 + (tid & 63);
        const int shoff = isin ? 0 : 3072;
        __syncthreads();
        for (int i = tid; i < 4096; i += NTHR) { const int bt = i >> 10, k = i & 1023; vec[k * 4 + bt] = mod[(size_t)(l * 4 + bt) * 6144 + shoff + k]; }
        __syncthreads();
        if (isin) gemv4_block(p.w_in + (size_t)l * DM * PIN, PIN, in_col_map(n), vec, red, (float*)(p.ws + WS_CBIN) + (size_t)l * 4 * PINP, PINP, n, 0.f, tid);
        else gemv4_block(p.w_up + (size_t)l * DM * NUP, NUP, up_col_map(n), vec, red, (float*)(p.ws + WS_CBUP) + (size_t)l * 4 * NUP, NUP, n, 0.f, tid);
    }
}
template <int MAPK>
__device__ void convert_weight(const float* W, int K, int Nsrc, int Npad, bf16_t* Wt, LDSF float* scr, int gw, int ngw, int lane) {
    const int nkb = K / 64, nnb = Npad / 32;
    for (int it = gw; it < nkb * nnb; it += ngw) {
        const int kb = it / nnb, nb = it % nnb, k0 = kb * 64, n0 = nb * 32;
        {
            const int nn = lane & 31; const int n = n0 + nn;
            const int oc = MAPK == 0 ? n : (MAPK == 1 ? in_col_map(n) : up_col_map(n));
#pragma unroll 8
            for (int i = 0; i < 32; ++i) { const int kk = 2 * i + (lane >> 5); scr[kk * 33 + nn] = (oc >= 0) ? W[(size_t)(k0 + kk) * Nsrc + oc] : 0.f; }
        }
        __builtin_amdgcn_s_waitcnt(0xc07f); __builtin_amdgcn_wave_barrier();
        {
            const int c = lane & 7;
#pragma unroll
            for (int j = 0; j < 4; ++j) { const int n = (lane >> 3) + 8 * j; const LDSF float* sp = scr + (8 * c) * 33 + n;
                u32x4 o; o[0] = pk2(sp[0], sp[33]); o[1] = pk2(sp[66], sp[99]); o[2] = pk2(sp[132], sp[165]); o[3] = pk2(sp[198], sp[231]);
                *(u32x4*)(Wt + (size_t)(n0 + n) * K + k0 + 8 * c) = o; }
        }
        __builtin_amdgcn_s_waitcnt(0xc07f); __builtin_amdgcn_wave_barrier();
    }
}
__device__ void ph_weights(const Params& p, int l, unsigned char* lds) {
    const int tid_ = TID(); const int lane = tid_ & 63, wv = tid_ >> 6;
    const int gw = blockIdx.x * (NTHR >> 6) + wv, ngw = gridDim.x * (NTHR >> 6);
    LDSF float* scr = (LDSF float*)lds + wv * (64 * 33);
    convert_weight<1>(p.w_in + (size_t)l * DM * PIN, DM, PIN, PINP, (bf16_t*)(p.ws + WS_WIN), scr, gw, ngw, lane);
    convert_weight<0>(p.w_out + (size_t)l * DM * DM, DM, DM, DM, (bf16_t*)(p.ws + WS_WOUT), scr, gw, ngw, lane);
    convert_weight<2>(p.w_up + (size_t)l * DM * NUP, DM, NUP, NUP, (bf16_t*)(p.ws + WS_WUP), scr, gw, ngw, lane);
    convert_weight<0>(p.w_down + (size_t)l * DFF * DM, DFF, DM, DM, (bf16_t*)(p.ws + WS_WDN), scr, gw, ngw, lane);
}
__device__ void ph_xa_from(const Params& p, const float* src, int l, int which  , bf16_t* XA, float* rowss, bool write_xa) {
    const float* mod = (const float*)(p.ws + WS_MOD);
    const float* g = (which == 0 ? p.norm_mix_g : p.norm_ffn_g) + l * DM;
    const int tid_ = TID(); const int lane = tid_ & 63, wv = tid_ >> 6;
    const int gw = blockIdx.x * (blockDim.x >> 6) + wv, ngw = gridDim.x * (blockDim.x >> 6);
    for (int row = gw; row < MTOK; row += ngw) {
        const int b = row / SEQ;
        const float* sc = mod + (size_t)(l * 4 + b) * 6144 + (which == 0 ? 1024 : 4096);
        float ss = 0.f;
#pragma unroll
        for (int j = 0; j < 4; ++j) {
            const int k = j * 256 + lane * 4;
            const f32x4 v = *(const f32x4*)(src + (size_t)row * DM + k);
            ss += v[0] * v[0] + v[1] * v[1] + v[2] * v[2] + v[3] * v[3];
            if (write_xa) {
                const f32x4 gv = *(const f32x4*)(g + k); const f32x4 sv = *(const f32x4*)(sc + k);
                uint2 o; o.x = pk2(v[0] * gv[0] * (1.f + sv[0]), v[1] * gv[1] * (1.f + sv[1])); o.y = pk2(v[2] * gv[2] * (1.f + sv[2]), v[3] * gv[3] * (1.f + sv[3]));
                *(uint2*)(XA + (size_t)row * DM + k) = o;
            }
        }
        ss = wave_sum(ss);
        if (lane < 16) rowss[(size_t)row * 16 + lane] = (lane == 0) ? ss : 0.f;
    }
}

template <class Epi>
__device__ void gemm_simple(const bf16_t* A, const bf16_t* Bt, int M, int N, int K, const Epi& E, unsigned char* lds) {
    bf16_t* sA = (bf16_t*)lds;
    bf16_t* sB = (bf16_t*)(lds + 128 * 80);
    const int tid = TID(), lane = tid & 63, w = tid >> 6, fr = lane & 15, fq = lane >> 4;
    const int ntn = N / 64, ntm = M / 128;
    for (int tile = blockIdx.x; tile < ntn * ntm; tile += gridDim.x) {
        const int tm = tile / ntn, tn = tile % ntn, m0 = tm * 128, n0 = tn * 64;
        f32x4 acc[4];
#pragma unroll
        for (int i = 0; i < 4; ++i) acc[i] = (f32x4){0.f, 0.f, 0.f, 0.f};
        for (int k0 = 0; k0 < K; k0 += 32) {
            { const int r = tid >> 2, ch = tid & 3; *(u32x4*)(sA + r * 40 + ch * 8) = *(const u32x4*)(A + (size_t)(m0 + r) * K + k0 + ch * 8); }
            if (tid < 256) { const int r = tid >> 2, ch = tid & 3; *(u32x4*)(sB + r * 40 + ch * 8) = *(const u32x4*)(Bt + (size_t)(n0 + r) * K + k0 + ch * 8); }
            __syncthreads();
            const bf16x8 a = *(const bf16x8*)(sA + (16 * w + fr) * 40 + fq * 8);
#pragma unroll
            for (int nt = 0; nt < 4; ++nt) {
                const bf16x8 b = *(const bf16x8*)(sB + (16 * nt + fr) * 40 + fq * 8);
                acc[nt] = __builtin_amdgcn_mfma_f32_16x16x32_bf16(a, b, acc[nt], 0, 0, 0);
            }
            __syncthreads();
        }
#pragma unroll
        for (int nt = 0; nt < 4; ++nt)
#pragma unroll
            for (int j = 0; j < 4; ++j) E(m0 + 16 * w + fq * 4 + j, n0 + 16 * nt + fr, acc[nt][j]);
    }
}
__device__ __forceinline__ float row_rstd(const float* rowss, int row) {
    const f32x4* r = (const f32x4*)(rowss + (size_t)row * 16);
    const f32x4 a = r[0], b = r[1], c = r[2], d = r[3];
    const float s = ((a[0] + a[1]) + (a[2] + a[3])) + ((b[0] + b[1]) + (b[2] + b[3])) + ((c[0] + c[1]) + (c[2] + c[3])) + ((d[0] + d[1]) + (d[2] + d[3]));
    return rsqrtf(s * (1.f / DM) + EPS);
}
struct EpiProj {
    const float* rowss; const float* cb; bf16_t* proj; float* side;
    __device__ void operator()(int row, int col, float v) const {
        const int b = row / SEQ; const float o = v * row_rstd(rowss, row) + cb[b * PINP + col];
        proj[(size_t)row * PINP + col] = f2bf(o);
        if (col >= C_BF && col < PIN) side[(size_t)row * 16 + (col - C_BF)] = o;
    }
};
struct EpiRes {
    const float* xin; float* xout; const float* mod_gate;
    const float* g; const float* mod_sc; bf16_t* xa;
    __device__ void operator()(int row, int col, float v) const {
        const int b = row / SEQ; const float o = xin[(size_t)row * DM + col] + mod_gate[b * 6144 + col] * v;
        xout[(size_t)row * DM + col] = o;
        if (xa) xa[(size_t)row * DM + col] = f2bf(o * g[col] * (1.f + mod_sc[b * 6144 + col]));
    }
};
struct EpiUp {
    const float* rowss; const float* cb; bf16_t* ug; bf16_t* uv;
    __device__ void operator()(int row, int col, float v) const {
        const int b = row / SEQ; const float o = v * row_rstd(rowss, row) + cb[b * NUP + col];
        const int pn = col >> 8, c = col & 255;
        if (c < 128) ug[(size_t)row * DFF + 128 * pn + c] = f2bf(o); else uv[(size_t)row * DFF + 128 * pn + (c - 128)] = f2bf(o);
    }
};

namespace pg8 {
#define PG8_LAS __attribute__((address_space(3)))
typedef unsigned short bf16_t;
typedef short bf16x8 __attribute__((ext_vector_type(8)));
typedef float f32x4 __attribute__((ext_vector_type(4)));
typedef unsigned u32x4 __attribute__((ext_vector_type(4)));
constexpr int BM = 256, BK = 64, HALF = 128, HTB = HALF * BK * 2  , STAGE_BYTES = 8 * HTB, NXCD = 8, WGM = 8;

__host__ __device__ __forceinline__ int lds_byte(int r, int c) { const int st = (r >> 4) * 2 + (c >> 5), rr = r & 15, cc = c & 31, ob = rr * 64 + cc * 2; return st * 1024 + (ob ^ (((ob >> 9) & 1) << 5)); }
__host__ __device__ __forceinline__ void stage_rc(int b, int& R, int& C) { const int st = b / 1024, sb = b % 1024, swz = sb ^ (((sb >> 9) & 1) << 5); R = (st >> 1) * 16 + swz / 64; C = (st & 1) * 32 + (swz % 64) / 2; }
__host__ __device__ __forceinline__ int perm32(int rho) { const int n = rho >> 4, i = rho & 15; return 8 * (i >> 2) + 4 * n + (i & 3); }

struct Unit { int pm, pn; };
struct Gemm { const bf16_t* A; const bf16_t* Bt; int M, N, K; };

struct StaticOrder {
    int nM, nN, nwg, G, c;
    __host__ __device__ void init(int M, int N, int G_, int c_) { nM = M / BM; nN = N / BM; nwg = nM * nN; G = G_; c = c_; }
    __host__ __device__ bool next(int i, Unit& u) const {
        const long L = (long)i * G + c; if (L >= nwg) return false;
        int wgid = (int)L; { const int q = nwg / NXCD, r = nwg % NXCD, xcd = wgid % NXCD, off = wgid / NXCD; wgid = (xcd < r ? xcd * (q + 1) : r * (q + 1) + (xcd - r) * q) + off; }
        const int nig = WGM * nN, gid = wgid / nig, fm = gid * WGM, gsz = (nM - fm) < WGM ? (nM - fm) : WGM;
        u.pm = fm + ((wgid % nig) % gsz); u.pn = (wgid % nig) / gsz; return true;
    }
    __device__ __forceinline__ void a_ready(const Unit&) const {}
    __device__ __forceinline__ void done(const Unit&) const {}
};


__device__ __forceinline__ unsigned cvt_pk_bf16(float lo, float hi) { unsigned r; asm volatile("v_cvt_pk_bf16_f32 %0, %1, %2" : "=v"(r) : "v"(lo), "v"(hi)); return r; }
template <class Epi, class Sched, bool ALIGN_EPI = false, bool SP2 = false>
__device__ __forceinline__ void gemm_phase(PG8_LAS unsigned char* lds, const Gemm g, const Sched& S, const Epi& E) {
    const int tid = TID(), wid = __builtin_amdgcn_readfirstlane(tid >> 6), lane = tid & 63, wr = wid >> 2, wc = wid & 3, fr = lane & 15, fq = lane >> 4;
    const int K = g.K, nt = K / BK;
    unsigned voffA[2], voffB[2];
#pragma unroll
    for (int i = 0; i < 2; ++i) { int R, C; stage_rc(tid * 16 + i * 8192, R, C); const int Rb = Epi::PERM ? ((R & ~31) + perm32(R & 31)) : R;
        voffA[i] = (unsigned)(R * K + C) * 2u; voffB[i] = (unsigned)(Rb * K + C) * 2u; }
    const size_t kstep = (size_t)(BK * 2);
    const size_t hstep = (size_t)HALF * K * 2;
    const size_t tstep = 2 * hstep;
    const unsigned ldsw = (unsigned)wid * 1024u;
    const int aoff = lds_byte(wr * 64 + fr, fq * 8), boff = lds_byte(wc * 32 + fr, fq * 8);
#define PG8_SA(b, h) (((b) * 2 + (h)) * HTB)
#define PG8_SB(b, h) ((4 + (b) * 2 + (h)) * HTB)
#define PG8_STAGE(bufoff, gbase, voff) do { _Pragma("unroll") for (int _i = 0; _i < 2; ++_i) \
        __builtin_amdgcn_global_load_lds((const unsigned*)((const char*)(gbase) + (voff)[_i]), (PG8_LAS unsigned*)(lds + (bufoff) + ldsw + _i * 8192), 16, 0, 0); } while (0)
#define PG8_LDA(dst, b, h) do { _Pragma("unroll") for (int m = 0; m < 4; ++m) _Pragma("unroll") for (int k = 0; k < 2; ++k) dst[m][k] = *(const PG8_LAS bf16x8*)(lds + PG8_SA(b, h) + aoff + m * 2048 + k * 1024); } while (0)
#define PG8_LDB(dst, b, h) do { _Pragma("unroll") for (int n = 0; n < 2; ++n) _Pragma("unroll") for (int k = 0; k < 2; ++k) dst[n][k] = *(const PG8_LAS bf16x8*)(lds + PG8_SB(b, h) + boff + n * 2048 + k * 1024); } while (0)
#define PG8_MMA(ai, bj, At, Bt) do { __builtin_amdgcn_s_setprio(1); _Pragma("unroll") for (int m = 0; m < 4; ++m) _Pragma("unroll") for (int n = 0; n < 2; ++n) _Pragma("unroll") for (int k = 0; k < 2; ++k) \
        acc[ai][bj][m][n] = __builtin_amdgcn_mfma_f32_16x16x32_bf16(Bt[n][k], At[m][k], acc[ai][bj][m][n], 0, 0, 0); __builtin_amdgcn_s_setprio(0); } while (0)
#define PG8_WAIT_V(n) asm volatile("s_waitcnt vmcnt(" #n ")" ::: "memory")
#define PG8_WAIT_L(n) asm volatile("s_waitcnt lgkmcnt(" #n ")" ::: "memory")
#define PG8_BAR __builtin_amdgcn_s_barrier()
#define PG8_SCHED __builtin_amdgcn_sched_barrier(0)
    Unit cur, nxt; int ui = 0;
    if (!S.next(0, cur)) return;
    f32x4 acc[2][2][4][2];
#pragma unroll
    for (int a = 0; a < 2; ++a)
#pragma unroll
        for (int b = 0; b < 2; ++b)
#pragma unroll
            for (int m = 0; m < 4; ++m)
#pragma unroll
                for (int n = 0; n < 2; ++n) acc[a][b][m][n] = (f32x4){0.f, 0.f, 0.f, 0.f};
    bf16x8 At[4][2], B0[2][2], B1[2][2];
    const char* cA = (const char*)g.A + (size_t)cur.pm * tstep; const char* cB = (const char*)g.Bt + (size_t)cur.pn * tstep;
    S.a_ready(cur);
    if constexpr (SP2) {
        PG8_STAGE(PG8_SB(0, 0), cB, voffB); PG8_STAGE(PG8_SB(0, 1), cB + hstep, voffB); PG8_STAGE(PG8_SA(0, 0), cA, voffA); PG8_STAGE(PG8_SA(0, 1), cA + hstep, voffA);
        if (wr == 1) PG8_BAR;
        PG8_WAIT_V(2); PG8_BAR;
        PG8_STAGE(PG8_SB(1, 0), cB + kstep, voffB); PG8_STAGE(PG8_SA(1, 0), cA + kstep, voffA); PG8_STAGE(PG8_SB(1, 1), cB + hstep + kstep, voffB);
        PG8_WAIT_V(6); PG8_BAR;
    } else {
        PG8_STAGE(PG8_SB(0, 0), cB, voffB); PG8_STAGE(PG8_SA(0, 0), cA, voffA); PG8_STAGE(PG8_SB(0, 1), cB + hstep, voffB); PG8_STAGE(PG8_SA(0, 1), cA + hstep, voffA);
        if (wr == 1) PG8_BAR;
        PG8_WAIT_V(4); PG8_BAR;
        PG8_STAGE(PG8_SB(1, 0), cB + kstep, voffB); PG8_STAGE(PG8_SA(1, 0), cA + kstep, voffA); PG8_STAGE(PG8_SB(1, 1), cB + hstep + kstep, voffB);
        PG8_WAIT_V(6); PG8_BAR;
    }
    for (;;) {
        const bool has_next = S.next(ui + 1, nxt);
        const char* nA = has_next ? (const char*)g.A + (size_t)nxt.pm * tstep : cA; const char* nB = has_next ? (const char*)g.Bt + (size_t)nxt.pn * tstep : cB;
        for (int t = 0; t < nt; t += 2) {
            const bool last = (t == nt - 2);
            const char* a1 = cA + (size_t)(t + 1) * kstep;
            const char* a2 = last ? nA : cA + (size_t)(t + 2) * kstep; const char* b2 = last ? nB : cB + (size_t)(t + 2) * kstep;
            const char* a3 = a2 + kstep; const char* b3 = b2 + kstep;
            if (last && has_next) S.a_ready(nxt);
            if constexpr (SP2) {
            PG8_LDB(B0, 0, 0); PG8_LDB(B1, 0, 1); PG8_SCHED; PG8_LDA(At, 0, 0); PG8_STAGE(PG8_SA(1, 1), a1 + hstep, voffA);
            PG8_WAIT_V(8); PG8_WAIT_L(0); PG8_BAR; PG8_MMA(0, 0, At, B0); PG8_MMA(0, 1, At, B1); PG8_BAR; PG8_SCHED;
            PG8_LDA(At, 0, 1); PG8_STAGE(PG8_SB(0, 0), b2, voffB); PG8_STAGE(PG8_SB(0, 1), b2 + hstep, voffB); PG8_STAGE(PG8_SA(0, 0), a2, voffA);
            PG8_WAIT_V(8); PG8_WAIT_L(0); PG8_BAR; PG8_MMA(1, 0, At, B0); PG8_MMA(1, 1, At, B1); PG8_BAR; PG8_SCHED;
            PG8_LDB(B0, 1, 0); PG8_LDB(B1, 1, 1); PG8_SCHED; PG8_LDA(At, 1, 0); PG8_STAGE(PG8_SA(0, 1), a2 + hstep, voffA);
            PG8_WAIT_V(8); PG8_WAIT_L(0); PG8_BAR; PG8_MMA(0, 0, At, B0); PG8_MMA(0, 1, At, B1); PG8_BAR; PG8_SCHED;
            PG8_LDA(At, 1, 1); PG8_STAGE(PG8_SB(1, 0), b3, voffB); PG8_STAGE(PG8_SB(1, 1), b3 + hstep, voffB); PG8_STAGE(PG8_SA(1, 0), a3, voffA);
            PG8_WAIT_V(8); PG8_WAIT_L(0); PG8_BAR; PG8_MMA(1, 0, At, B0); PG8_MMA(1, 1, At, B1); PG8_BAR; PG8_SCHED;
            } else {
            PG8_LDB(B0, 0, 0); PG8_SCHED; PG8_LDA(At, 0, 0); PG8_STAGE(PG8_SA(1, 1), a1 + hstep, voffA);
            PG8_WAIT_L(8); PG8_BAR; PG8_WAIT_L(0); PG8_MMA(0, 0, At, B0); PG8_BAR; PG8_SCHED;
            PG8_LDB(B1, 0, 1); PG8_STAGE(PG8_SB(0, 0), b2, voffB);
            PG8_BAR; PG8_WAIT_L(0); PG8_MMA(0, 1, At, B1); PG8_BAR;
            PG8_LDA(At, 0, 1); PG8_STAGE(PG8_SA(0, 0), a2, voffA);
            PG8_BAR; PG8_WAIT_L(0); PG8_MMA(1, 0, At, B0); PG8_BAR; PG8_SCHED;
            PG8_STAGE(PG8_SB(0, 1), b2 + hstep, voffB);
            PG8_WAIT_V(6); PG8_BAR; PG8_MMA(1, 1, At, B1); PG8_BAR;
            PG8_LDB(B0, 1, 0); PG8_SCHED; PG8_LDA(At, 1, 0); PG8_STAGE(PG8_SA(0, 1), a2 + hstep, voffA);
            PG8_WAIT_L(8); PG8_BAR; PG8_WAIT_L(0); PG8_MMA(0, 0, At, B0); PG8_BAR; PG8_SCHED;
            PG8_LDB(B1, 1, 1); PG8_STAGE(PG8_SB(1, 0), b3, voffB);
            PG8_BAR; PG8_WAIT_L(0); PG8_MMA(0, 1, At, B1); PG8_BAR;
            PG8_LDA(At, 1, 1); PG8_STAGE(PG8_SA(1, 0), a3, voffA);
            PG8_BAR; PG8_WAIT_L(0); PG8_MMA(1, 0, At, B0); PG8_BAR; PG8_SCHED;
            PG8_STAGE(PG8_SB(1, 1), b3 + hstep, voffB);
            PG8_WAIT_V(6); PG8_BAR; PG8_MMA(1, 1, At, B1); PG8_BAR;
            }
        }
        if constexpr (ALIGN_EPI) { if (wr == 0) PG8_BAR; }
        if constexpr (!Epi::AFTER_DRAIN) { E(acc, cur, wr, wc, fr, fq); S.done(cur); }
        if (!has_next) break;
#pragma unroll
        for (int a = 0; a < 2; ++a)
#pragma unroll
            for (int b = 0; b < 2; ++b)
#pragma unroll
                for (int m = 0; m < 4; ++m)
#pragma unroll
                    for (int n = 0; n < 2; ++n) acc[a][b][m][n] = (f32x4){0.f, 0.f, 0.f, 0.f};
        cur = nxt; cA = nA; cB = nB; ++ui;
        if constexpr (ALIGN_EPI) { if (wr == 1) PG8_BAR; }
    }
    PG8_WAIT_V(0);
    if constexpr (!ALIGN_EPI) { if (wr == 0) PG8_BAR; }
    PG8_BAR;
    if constexpr (Epi::AFTER_DRAIN) { E.fused(acc, cur, wr, wc, fr, fq, lds, wid, lane); S.done(cur); }
#undef PG8_SA
#undef PG8_SB
#undef PG8_STAGE
#undef PG8_LDA
#undef PG8_LDB
#undef PG8_MMA
#undef PG8_WAIT_V
#undef PG8_WAIT_L
#undef PG8_BAR
#undef PG8_SCHED
}
}

#ifndef PG8_SP2
#define PG8_SP2 true
#endif
#ifndef PG8_ALIGN
#define PG8_ALIGN true
#endif

__device__ __forceinline__ float row_rstd16(const float* rowss, int row) {
    const f32x4* r = (const f32x4*)(rowss + (size_t)row * 16);
    const f32x4 a = r[0], b = r[1], c = r[2], d = r[3];
    const float s = ((a[0] + a[1]) + (a[2] + a[3])) + ((b[0] + b[1]) + (b[2] + b[3])) + ((c[0] + c[1]) + (c[2] + c[3])) + ((d[0] + d[1]) + (d[2] + d[3]));
    return rsqrtf(s * (1.f / DM) + EPS);
}
struct EpiProjF {
    static constexpr bool PERM = true, AFTER_DRAIN = false;
    const float* rowss; const float* cb; bf16_t* proj; float* side;
    __device__ __forceinline__ void operator()(const pg8::f32x4 (&acc)[2][2][4][2], const pg8::Unit& u, int wr, int wc, int fr, int fq) const {
        const int b = u.pm >> 4, colt = u.pn * 256 + wc * 32 + 8 * fq;
        f32x4 cv[2][2];
#pragma unroll
        for (int bj = 0; bj < 2; ++bj)
#pragma unroll
            for (int n = 0; n < 2; ++n) cv[bj][n] = *(const f32x4*)(cb + b * PINP + colt + bj * 128 + 4 * n);
#pragma unroll
        for (int ai = 0; ai < 2; ++ai)
#pragma unroll
            for (int m = 0; m < 4; ++m) {
                const int row = u.pm * 256 + ai * 128 + wr * 64 + m * 16 + fr; const float rs = row_rstd16(rowss, row);
#pragma unroll
                for (int bj = 0; bj < 2; ++bj) {
                    const f32x4 v0 = acc[ai][bj][m][0] * rs + cv[bj][0], v1 = acc[ai][bj][m][1] * rs + cv[bj][1]; const int col0 = colt + bj * 128;
                    u32x4 w; w[0] = pg8::cvt_pk_bf16(v0[0], v0[1]); w[1] = pg8::cvt_pk_bf16(v0[2], v0[3]); w[2] = pg8::cvt_pk_bf16(v1[0], v1[1]); w[3] = pg8::cvt_pk_bf16(v1[2], v1[3]);
                    *(u32x4*)(proj + (size_t)row * PINP + col0) = w;
                    if (col0 >= C_BF && col0 < PIN) { *(f32x4*)(side + (size_t)row * 16 + (col0 - C_BF)) = v0; *(f32x4*)(side + (size_t)row * 16 + (col0 - C_BF) + 4) = v1; }
                }
            }
    }
};
struct EpiUpF {
    static constexpr bool PERM = true, AFTER_DRAIN = false;
    const float* rowss; const float* cb; bf16_t* ug; bf16_t* uv;
    __device__ __forceinline__ void operator()(const pg8::f32x4 (&acc)[2][2][4][2], const pg8::Unit& u, int wr, int wc, int fr, int fq) const {
        const int b = u.pm >> 4, colt = u.pn * 256 + wc * 32 + 8 * fq, oc = u.pn * 128 + wc * 32 + 8 * fq;
        f32x4 cv[2][2];
#pragma unroll
        for (int bj = 0; bj < 2; ++bj)
#pragma unroll
            for (int n = 0; n < 2; ++n) cv[bj][n] = *(const f32x4*)(cb + b * NUP + colt + bj * 128 + 4 * n);
#pragma unroll
        for (int ai = 0; ai < 2; ++ai)
#pragma unroll
            for (int m = 0; m < 4; ++m) {
                const int row = u.pm * 256 + ai * 128 + wr * 64 + m * 16 + fr; const float rs = row_rstd16(rowss, row);
#pragma unroll
                for (int bj = 0; bj < 2; ++bj) {
                    const f32x4 v0 = acc[ai][bj][m][0] * rs + cv[bj][0], v1 = acc[ai][bj][m][1] * rs + cv[bj][1];
                    u32x4 w; w[0] = pg8::cvt_pk_bf16(v0[0], v0[1]); w[1] = pg8::cvt_pk_bf16(v0[2], v0[3]); w[2] = pg8::cvt_pk_bf16(v1[0], v1[1]); w[3] = pg8::cvt_pk_bf16(v1[2], v1[3]);
                    *(u32x4*)((bj ? uv : ug) + (size_t)row * DFF + oc) = w;
                }
            }
    }
};
struct EpiResF {
    static constexpr bool PERM = false, AFTER_DRAIN = false;
    const float* xin; float* xout; const float* gate; const float* g; const float* sc; bf16_t* xa; float* rowss;
    __device__ __forceinline__ void operator()(const pg8::f32x4 (&acc)[2][2][4][2], const pg8::Unit& u, int wr, int wc, int fr, int fq) const {
        const int b = u.pm >> 4, col0 = u.pn * 256 + wc * 32 + 4 * fq;
        f32x4 gt[2][2], gm[2][2];
#pragma unroll
        for (int bj = 0; bj < 2; ++bj)
#pragma unroll
            for (int n = 0; n < 2; ++n) { const int c = col0 + bj * 128 + n * 16; gt[bj][n] = *(const f32x4*)(gate + b * 6144 + c);
                if (xa) gm[bj][n] = *(const f32x4*)(g + c) * (*(const f32x4*)(sc + b * 6144 + c) + 1.0f); else gm[bj][n] = (f32x4){0.f, 0.f, 0.f, 0.f}; }
#pragma unroll
        for (int ai = 0; ai < 2; ++ai)
#pragma unroll
            for (int m = 0; m < 4; ++m) {
                const int row = u.pm * 256 + ai * 128 + wr * 64 + m * 16 + fr; float ss = 0.f;
#pragma unroll
                for (int bj = 0; bj < 2; ++bj)
#pragma unroll
                    for (int n = 0; n < 2; ++n) { const size_t off = (size_t)row * DM + col0 + bj * 128 + n * 16;
                        const f32x4 o = *(const f32x4*)(xin + off) + gt[bj][n] * acc[ai][bj][m][n];
                        *(f32x4*)(xout + off) = o; ss += (o[0] * o[0] + o[1] * o[1]) + (o[2] * o[2] + o[3] * o[3]);
                        if (xa) { const f32x4 q = o * gm[bj][n]; uint2 w; w.x = pg8::cvt_pk_bf16(q[0], q[1]); w.y = pg8::cvt_pk_bf16(q[2], q[3]); *(uint2*)(xa + off) = w; } }
                if (rowss) { ss += __shfl_xor(ss, 16); ss += __shfl_xor(ss, 32); if (fq == 0) rowss[(size_t)row * 16 + u.pn * 4 + wc] = ss; }
            }
    }
};

__device__ void ph_prep_knorm(const Params& p, int l) {
    bf16_t* proj = (bf16_t*)(p.ws + WS_PROJ);
    const int tid_ = TID(); const int lane = tid_ & 63, wv = tid_ >> 6;
    const int gw = blockIdx.x * (blockDim.x >> 6) + wv, ngw = gridDim.x * (blockDim.x >> 6);
    for (int row = gw; row < MTOK; row += ngw) {
        bf16_t* pr = proj + (size_t)row * PINP;
        {
            uint2 raw = *(const uint2*)(pr + CA_K + 4 * lane);
            float v0 = bf2f(raw.x & 0xffff), v1 = bf2f(raw.x >> 16), v2 = bf2f(raw.y & 0xffff), v3 = bf2f(raw.y >> 16);
            float ss = v0 * v0 + v1 * v1 + v2 * v2 + v3 * v3;
            ss += __shfl_xor(ss, 1); ss += __shfl_xor(ss, 2); ss += __shfl_xor(ss, 4);
            const float r = rsqrtf(ss * (1.f / 32.f) + EPS); const float* g = p.diff_kn + l * 32 + ((4 * lane) & 31);
            raw.x = pk2(v0 * r * g[0], v1 * r * g[1]); raw.y = pk2(v2 * r * g[2], v3 * r * g[3]);
            *(uint2*)(pr + CA_K + 4 * lane) = raw;
        }
        {
            uint2 raw = *(const uint2*)(pr + CB_K + 4 * lane);
            float v0 = bf2f(raw.x & 0xffff), v1 = bf2f(raw.x >> 16), v2 = bf2f(raw.y & 0xffff), v3 = bf2f(raw.y >> 16);
            float ss = v0 * v0 + v1 * v1 + v2 * v2 + v3 * v3;
            ss += __shfl_xor(ss, 1); ss += __shfl_xor(ss, 2); ss += __shfl_xor(ss, 4); ss += __shfl_xor(ss, 8);
            const float r = rsqrtf(ss * (1.f / 64.f) + EPS); const float* g = p.fox_kn + l * 64 + ((4 * lane) & 63);
            raw.x = pk2(v0 * r * g[0], v1 * r * g[1]); raw.y = pk2(v2 * r * g[2], v3 * r * g[3]);
            *(uint2*)(pr + CB_K + 4 * lane) = raw;
        }
        {
            const int hi = lane >> 5, li = lane & 31; bf16_t* q = pr + (hi ? CD_KW : CD_KS) + 2 * li;
            unsigned raw = *(const unsigned*)q; float v0 = bf2f(raw & 0xffff), v1 = bf2f(raw >> 16);
            float ss = v0 * v0 + v1 * v1;
            ss += __shfl_xor(ss, 1); ss += __shfl_xor(ss, 2); ss += __shfl_xor(ss, 4); ss += __shfl_xor(ss, 8); ss += __shfl_xor(ss, 16);
            const float r = rsqrtf(ss * (1.f / 64.f) + EPS); const float* g = p.nsa_kn + (l * 3 + (hi ? 2 : 1)) * 64 + 2 * li;
            *(unsigned*)q = pk2(v0 * r * g[0], v1 * r * g[1]);
        }
    }
}
__device__ void ph_prep_cum(const Params& p, int l, unsigned char* lds) {
    const float* side = (const float*)(p.ws + WS_SIDE);
    float* cum = (float*)(p.ws + WS_CUM);
    LDSF float* wt = (LDSF float*)(lds + 60000);
    const int tid = TID(), lane = tid & 63, wv = tid >> 6;
    for (int bh = blockIdx.x; bh < 16; bh += gridDim.x) {
        const int b = bh >> 2, h = bh & 3; const float bf = p.fox_bf[l * 4 + h];
        float v[8]; float tot = 0.f;
#pragma unroll
        for (int i = 0; i < 8; ++i) { v[i] = logsigf(side[(size_t)(b * SEQ + tid * 8 + i) * 16 + h] + bf); tot += v[i]; v[i] = tot; }
        float inc = tot;
#pragma unroll
        for (int o = 1; o < 64; o <<= 1) { const float u = __shfl_up(inc, o); if (lane >= o) inc += u; }
        __syncthreads();
        if (lane == 63) wt[wv] = inc;
        __syncthreads();
        float base = inc - tot;
        for (int w8 = 0; w8 < wv; ++w8) base += wt[w8];
#pragma unroll
        for (int i = 0; i < 8; ++i) cum[bh * SEQ + tid * 8 + i] = base + v[i];
    }
}
__device__ void ph_prep_cmp(const Params& p, int l, unsigned char* lds) {
    const bf16_t* proj = (const bf16_t*)(p.ws + WS_PROJ);
    float* win = (float*)lds; float* red = (float*)(lds + 36864);
    const int tid = TID(), e = tid & 63, part = tid >> 6;
    for (int item = blockIdx.x; item < 4 * 2 * 32; item += gridDim.x) {
        const int b = item >> 6, which = (item >> 5) & 1, n0 = (item & 31) * 8;
        const int colbase = which ? CD_VC : CD_KC;
        __syncthreads();
        for (int i = tid; i < 144 * 64; i += NTHR) { const int tk = 16 * n0 + (i >> 6); win[i] = tk < SEQ ? bf2f(proj[(size_t)(b * SEQ + tk) * PINP + colbase + (i & 63)]) : 0.f; }
        __syncthreads();
        float acc[8];
#pragma unroll
        for (int nn = 0; nn < 8; ++nn) acc[nn] = 0.f;
        const float* phi = p.nsa_phi + (size_t)(l * 2 + which) * 2048 * 64; const float* pe = p.nsa_pe + (size_t)(l * 2 + which) * 32 * 64;
        for (int i = 4 * part; i < 4 * part + 4; ++i)
            for (int d = 0; d < 64; ++d) {
                const float ph = phi[(size_t)(i * 64 + d) * 64 + e], pv = pe[i * 64 + d];
#pragma unroll
                for (int nn = 0; nn < 8; ++nn) acc[nn] += (win[(16 * nn + i) * 64 + d] + pv) * ph;
            }
#pragma unroll
        for (int nn = 0; nn < 8; ++nn) red[(part * 8 + nn) * 64 + e] = acc[nn];
        __syncthreads();
        {
            const int nn = part, n = n0 + nn; float v = 0.f;
#pragma unroll
            for (int pp = 0; pp < 8; ++pp) v += red[(pp * 8 + nn) * 64 + e];
            bf16_t* dst = (bf16_t*)(p.ws + (which ? WS_VC : WS_KC)) + (size_t)(b * 256 + n) * 64 + e;
            if (n >= 255) *dst = 0;
            else if (which == 0) { const float ss = wave_sum(v * v); *dst = f2bf(v * rsqrtf(ss * (1.f / 64.f) + EPS) * p.nsa_kn[(l * 3 + 0) * 64 + e]); }
            else *dst = f2bf(v);
        }
    }
}

__device__ __forceinline__ void load8(const bf16_t* p, float* d) {
    const u32x4 r = *(const u32x4*)p;
    d[0] = bf2f(r[0] & 0xffff); d[1] = bf2f(r[0] >> 16); d[2] = bf2f(r[1] & 0xffff); d[3] = bf2f(r[1] >> 16);
    d[4] = bf2f(r[2] & 0xffff); d[5] = bf2f(r[2] >> 16); d[6] = bf2f(r[3] & 0xffff); d[7] = bf2f(r[3] >> 16);
}
template <int N> __device__ __forceinline__ float dotn(const float* q, const bf16_t* k) {
    float s = 0.f;
#pragma unroll
    for (int c = 0; c < N / 8; ++c) { float t[8]; load8(k + 8 * c, t);
#pragma unroll
        for (int j = 0; j < 8; ++j) s += q[8 * c + j] * t[j]; }
    return s;
}
template <int N> __device__ __forceinline__ void axpyn(float* o, float w, const bf16_t* v) {
#pragma unroll
    for (int c = 0; c < N / 8; ++c) { float t[8]; load8(v + 8 * c, t);
#pragma unroll
        for (int j = 0; j < 8; ++j) o[8 * c + j] += w * t[j]; }
}
template <int N> __device__ __forceinline__ void loadq_norm(float* q, const bf16_t* src, const float* g, float scale, bool norm) {
    float ss = 0.f;
#pragma unroll
    for (int c = 0; c < N / 8; ++c) load8(src + 8 * c, q + 8 * c);
#pragma unroll
    for (int j = 0; j < N; ++j) ss += q[j] * q[j];
    const float r = norm ? rsqrtf(ss * (1.f / N) + EPS) : 1.f;
#pragma unroll
    for (int j = 0; j < N; ++j) q[j] = q[j] * r * (norm ? g[j] : 1.f) * scale;
}
__device__ __forceinline__ void store64(bf16_t* dst, const float* o) {
#pragma unroll
    for (int c = 0; c < 8; ++c) { u32x4 w; w[0] = pk2(o[8 * c], o[8 * c + 1]); w[1] = pk2(o[8 * c + 2], o[8 * c + 3]); w[2] = pk2(o[8 * c + 4], o[8 * c + 5]); w[3] = pk2(o[8 * c + 6], o[8 * c + 7]); *(u32x4*)(dst + 8 * c) = w; }
}

__device__ void nv_attn_diff(const Params& p, int l) {
    const bf16_t* proj = (const bf16_t*)(p.ws + WS_PROJ); bf16_t* mix = (bf16_t*)(p.ws + WS_MIX);
    const float* tb = (const float*)(p.ws + WS_TB); const float lam = ((const float*)(p.ws + WS_LAM))[l];
    const float lam_init = 0.8f - 0.6f * expf(-0.3f * (float)l);
    const float scale = 0.17677669529663687f;
    for (int idx = GTID(); idx < 4 * 4 * SEQ; idx += GSIZE()) {
        const int t = idx & (SEQ - 1), h = (idx >> 12) & 3, b = idx >> 14; const size_t rb = (size_t)b * SEQ;
        float q[64];
        loadq_norm<32>(q, proj + (rb + t) * PINP + CA_Q + 64 * h, p.diff_qn + l * 32, scale, true);
        loadq_norm<32>(q + 32, proj + (rb + t) * PINP + CA_Q + 64 * h + 32, p.diff_qn + l * 32, scale, true);
        const float* tbh = tb + h * 128;
        const bf16_t* kb = proj + rb * PINP + CA_K + 64 * h; const bf16_t* vb = proj + rb * PINP + CA_V + 64 * h;
        float m1 = -INFINITY, m2 = -INFINITY;
        for (int k = 0; k <= t; ++k) { const float bias = tbh[min(t - k, 127)];
            const float s1 = dotn<32>(q, kb + (size_t)k * PINP) + bias, s2 = dotn<32>(q + 32, kb + (size_t)k * PINP + 32) + bias; m1 = fmaxf(m1, s1); m2 = fmaxf(m2, s2); }
        float l1 = 0.f, l2 = 0.f;
        for (int k = 0; k <= t; ++k) { const float bias = tbh[min(t - k, 127)];
            const float s1 = dotn<32>(q, kb + (size_t)k * PINP) + bias, s2 = dotn<32>(q + 32, kb + (size_t)k * PINP + 32) + bias; l1 += __expf(s1 - m1); l2 += __expf(s2 - m2); }
        float o[64];
#pragma unroll
        for (int j = 0; j < 64; ++j) o[j] = 0.f;
        const float i1 = 1.f / l1, i2 = lam / l2;
        for (int k = 0; k <= t; ++k) { const float bias = tbh[min(t - k, 127)];
            const float s1 = dotn<32>(q, kb + (size_t)k * PINP) + bias, s2 = dotn<32>(q + 32, kb + (size_t)k * PINP + 32) + bias;
            const float w = __expf(s1 - m1) * i1 - __expf(s2 - m2) * i2; axpyn<64>(o, w, vb + (size_t)k * PINP); }
        float ss = 0.f;
#pragma unroll
        for (int j = 0; j < 64; ++j) ss += o[j] * o[j];
        const float r = rsqrtf(ss * (1.f / 64.f) + EPS) * (1.f - lam_init);
#pragma unroll
        for (int j = 0; j < 64; ++j) o[j] = o[j] * r * p.diff_sub[l * 64 + j];
        store64(mix + (rb + t) * DM + 0 + 64 * h, o);
    }
}
__device__ void nv_attn_fox(const Params& p, int l) {
    const bf16_t* proj = (const bf16_t*)(p.ws + WS_PROJ); bf16_t* mix = (bf16_t*)(p.ws + WS_MIX);
    const float* cum = (const float*)(p.ws + WS_CUM);
    for (int idx = GTID(); idx < 4 * 4 * SEQ; idx += GSIZE()) {
        const int t = idx & (SEQ - 1), h = (idx >> 12) & 3, b = idx >> 14; const size_t rb = (size_t)b * SEQ;
        float q[64]; loadq_norm<64>(q, proj + (rb + t) * PINP + CB_Q + 64 * h, p.fox_qn + l * 64, 0.125f, true);
        const bf16_t* kb = proj + rb * PINP + CB_K + 64 * h; const bf16_t* vb = proj + rb * PINP + CB_V + 64 * h;
        const float* cm = cum + (b * 4 + h) * SEQ; const float cq = cm[t];
        float m = -INFINITY;
        for (int k = 0; k <= t; ++k) m = fmaxf(m, dotn<64>(q, kb + (size_t)k * PINP) + (cq - cm[k]));
        float o[64], ls = 0.f;
#pragma unroll
        for (int j = 0; j < 64; ++j) o[j] = 0.f;
        for (int k = 0; k <= t; ++k) { const float e = __expf(dotn<64>(q, kb + (size_t)k * PINP) + (cq - cm[k]) - m); ls += e; axpyn<64>(o, e, vb + (size_t)k * PINP); }
        const float il = 1.f / ls;
#pragma unroll
        for (int j = 0; j < 64; ++j) o[j] *= il;
        store64(mix + (rb + t) * DM + 256 + 64 * h, o);
    }
}
__device__ void nv_attn_stick(const Params& p, int l) {
    const bf16_t* proj = (const bf16_t*)(p.ws + WS_PROJ); bf16_t* mix = (bf16_t*)(p.ws + WS_MIX);
    for (int idx = GTID(); idx < 4 * 4 * SEQ; idx += GSIZE()) {
        const int t = idx & (SEQ - 1), h = (idx >> 12) & 3, b = idx >> 14; const size_t rb = (size_t)b * SEQ;
        float q[64]; loadq_norm<64>(q, proj + (rb + t) * PINP + CC_Q + 64 * h, nullptr, 0.125f, false);
        const bf16_t* kb = proj + rb * PINP + CC_K + 64 * h; const bf16_t* vb = proj + rb * PINP + CC_V + 64 * h;
        float o[64], tail = 0.f;
#pragma unroll
        for (int j = 0; j < 64; ++j) o[j] = 0.f;
        for (int k = t - 1; k >= 0; --k) { const float z = dotn<64>(q, kb + (size_t)k * PINP); const float lb = logsigf(z);
            axpyn<64>(o, __expf(lb + tail), vb + (size_t)k * PINP); tail += lb - z; }
        store64(mix + (rb + t) * DM + 512 + 64 * h, o);
    }
}
__device__ void nv_nsa_stats(const Params& p, int l) {
    const bf16_t* proj = (const bf16_t*)(p.ws + WS_PROJ); const bf16_t* kc = (const bf16_t*)(p.ws + WS_KC);
    const float* tb = (const float*)(p.ws + WS_TB) + 512; float* ml = (float*)(p.ws + WS_ML);
    for (int idx = GTID(); idx < 4 * 4 * SEQ; idx += GSIZE()) {
        const int t = idx & (SEQ - 1), h = (idx >> 12) & 3, b = idx >> 14; const size_t row = (size_t)b * SEQ + t;
        float q[64]; loadq_norm<64>(q, proj + row * PINP + CD_Q + 64 * h, p.nsa_qn + l * 64, 0.125f, true);
        const int nmax = (t >= 31) ? (t - 31) / 16 : -1;
        float m = -INFINITY;
        for (int n = 0; n <= nmax; ++n) m = fmaxf(m, dotn<64>(q, kc + (size_t)(b * 256 + n) * 64) + tb[h * 128 + min(t - 16 * n - 31, 127)]);
        float ls = 0.f;
        for (int n = 0; n <= nmax; ++n) ls += __expf(dotn<64>(q, kc + (size_t)(b * 256 + n) * 64) + tb[h * 128 + min(t - 16 * n - 31, 127)] - m);
        ml[(row * 4 + h) * 2 + 0] = m; ml[(row * 4 + h) * 2 + 1] = ls;
    }
}
__device__ void nv_nsa_imp(const Params& p, int l) {
    const bf16_t* proj = (const bf16_t*)(p.ws + WS_PROJ); const bf16_t* kc = (const bf16_t*)(p.ws + WS_KC);
    const float* tb = (const float*)(p.ws + WS_TB) + 512; const float* ml = (const float*)(p.ws + WS_ML); float* imp = (float*)(p.ws + WS_IMP);
    for (int idx = GTID(); idx < MTOK * 64; idx += GSIZE()) {
        const int j = idx & 63; const size_t row = (size_t)(idx >> 6); const int t = (int)(row & (SEQ - 1)), b = (int)(row >> 12);
        float v;
        if (64 * j > t) v = -1.0f;
        else if (j == (t >> 6) || j == 0) v = 1.0e4f;
        else {
            const int nmax = (t >= 31) ? (t - 31) / 16 : -1; v = 0.f;
            for (int h = 0; h < 4; ++h) {
                float q[64]; loadq_norm<64>(q, proj + row * PINP + CD_Q + 64 * h, p.nsa_qn + l * 64, 0.125f, true);
                const float m = ml[(row * 4 + h) * 2], il = 1.f / ml[(row * 4 + h) * 2 + 1];
                for (int n = 4 * j - 1; n <= 4 * j + 3; ++n) if (n >= 0 && n <= nmax && n < 255)
                    v += __expf(dotn<64>(q, kc + (size_t)(b * 256 + n) * 64) + tb[h * 128 + min(t - 16 * n - 31, 127)] - m) * il;
            }
        }
        imp[idx] = v;
    }
}
__device__ void nv_nsa_topk(const Params& p) {
    const float* imp = (const float*)(p.ws + WS_IMP); unsigned long long* selm = (unsigned long long*)(p.ws + WS_SELM);
    for (int row = GTID(); row < MTOK; row += GSIZE()) {
        const float* v = imp + (size_t)row * 64; unsigned long long mask = 0ull;
        for (int j = 0; j < 64; ++j) { const float vj = v[j]; int rank = 0;
            for (int i = 0; i < 64; ++i) { const float vi = v[i]; rank += (vi > vj || (vi == vj && i < j)) ? 1 : 0; }
            if (rank < 16) mask |= (1ull << j); }
        selm[row] = mask;
    }
}
__device__ void nv_nsa_out(const Params& p, int l) {
    const bf16_t* proj = (const bf16_t*)(p.ws + WS_PROJ); bf16_t* mix = (bf16_t*)(p.ws + WS_MIX);
    const bf16_t* kc = (const bf16_t*)(p.ws + WS_KC); const bf16_t* vc = (const bf16_t*)(p.ws + WS_VC);
    const float* tb = (const float*)(p.ws + WS_TB) + 512; const float* ml = (const float*)(p.ws + WS_ML);
    const unsigned long long* selm = (const unsigned long long*)(p.ws + WS_SELM); const float* side = (const float*)(p.ws + WS_SIDE);
    for (int idx = GTID(); idx < 4 * 4 * SEQ; idx += GSIZE()) {
        const int t = idx & (SEQ - 1), h = (idx >> 12) & 3, b = idx >> 14; const size_t rb = (size_t)b * SEQ, row = rb + t;
        float q[64]; loadq_norm<64>(q, proj + row * PINP + CD_Q + 64 * h, p.nsa_qn + l * 64, 0.125f, true);
        const float* tbh = tb + h * 128;
        const float gc = 1.f / (1.f + __expf(-side[row * 16 + 4 + 0 * 4 + h])), gs = 1.f / (1.f + __expf(-side[row * 16 + 4 + 1 * 4 + h])), gwn = 1.f / (1.f + __expf(-side[row * 16 + 4 + 2 * 4 + h]));
        float acc[64];
#pragma unroll
        for (int j = 0; j < 64; ++j) acc[j] = 0.f;
        {
            const int nmax = (t >= 31) ? (t - 31) / 16 : -1; const float m = ml[(row * 4 + h) * 2], ls = ml[(row * 4 + h) * 2 + 1];
            const float f = (nmax >= 0) ? gc / ls : 0.f;
            for (int n = 0; n <= nmax; ++n) { const float e = __expf(dotn<64>(q, kc + (size_t)(b * 256 + n) * 64) + tbh[min(t - 16 * n - 31, 127)] - m); axpyn<64>(acc, e * f, vc + (size_t)(b * 256 + n) * 64); }
        }
        {
            const unsigned long long mask = selm[row]; const bf16_t* kb = proj + rb * PINP + CD_KS; const bf16_t* vb = proj + rb * PINP + CD_VS;
            float m = -INFINITY;
            for (int k = 0; k <= t; ++k) if ((mask >> (k >> 6)) & 1ull) m = fmaxf(m, dotn<64>(q, kb + (size_t)k * PINP) + tbh[min(t - k, 127)]);
            float ls = 0.f;
            for (int k = 0; k <= t; ++k) if ((mask >> (k >> 6)) & 1ull) ls += __expf(dotn<64>(q, kb + (size_t)k * PINP) + tbh[min(t - k, 127)] - m);
            const float f = gs / ls;
            for (int k = 0; k <= t; ++k) if ((mask >> (k >> 6)) & 1ull) { const float e = __expf(dotn<64>(q, kb + (size_t)k * PINP) + tbh[min(t - k, 127)] - m); axpyn<64>(acc, e * f, vb + (size_t)k * PINP); }
        }
        {
            const bf16_t* kb = proj + rb * PINP + CD_KW; const bf16_t* vb = proj + rb * PINP + CD_VW; const int k0 = max(0, t - 511);
            float m = -INFINITY;
            for (int k = k0; k <= t; ++k) m = fmaxf(m, dotn<64>(q, kb + (size_t)k * PINP) + tbh[min(t - k, 127)]);
            float ls = 0.f;
            for (int k = k0; k <= t; ++k) ls += __expf(dotn<64>(q, kb + (size_t)k * PINP) + tbh[min(t - k, 127)] - m);
            const float f = gwn / ls;
            for (int k = k0; k <= t; ++k) { const float e = __expf(dotn<64>(q, kb + (size_t)k * PINP) + tbh[min(t - k, 127)] - m); axpyn<64>(acc, e * f, vb + (size_t)k * PINP); }
        }
        store64(mix + row * DM + 768 + 64 * h, acc);
    }
}


typedef float f32x16 __attribute__((ext_vector_type(16)));
typedef short s16x4 __attribute__((ext_vector_type(4)));
#define LDSP __attribute__((address_space(3)))
constexpr float LOG2E = 1.4426950408889634f;
constexpr int KSTR = 144;
constexpr int AL_K = 0, AL_V = 64 * KSTR  , AL_BK = AL_V + 8192  , AL_TB = AL_BK + 256  , AL_WSF = AL_TB + 512  ,
              AL_OST = AL_WSF + 2048  , AL_MISC = AL_OST + 32768  , AL_END = AL_MISC + 64;
__device__ __forceinline__ int crow(int r, int hi) { return (r & 3) + 8 * (r >> 2) + 4 * hi; }
__device__ __forceinline__ float ex2(float v) { return __builtin_amdgcn_exp2f(v); }
__device__ __forceinline__ s16x4 vtr(const LDSP unsigned char* p) { typedef short v4i16_t __attribute__((ext_vector_type(4))); return __builtin_bit_cast(s16x4, __builtin_amdgcn_ds_read_tr16_b64_v4i16((LDSP v4i16_t*)p)); }
__device__ __forceinline__ bf16x8 pack8(const f32x16& p, int b) {
    u32x4 w; w[0] = pg8::cvt_pk_bf16(p[b], p[b + 1]); w[1] = pg8::cvt_pk_bf16(p[b + 2], p[b + 3]); w[2] = pg8::cvt_pk_bf16(p[b + 4], p[b + 5]); w[3] = pg8::cvt_pk_bf16(p[b + 6], p[b + 7]);
    return __builtin_bit_cast(bf16x8, w);
}
template <int NK16>
__device__ __forceinline__ void qkt(f32x16& p0, f32x16& p1, const LDSP unsigned char* Kt, const bf16x8* qf, int dbase, int r32, int hi) {
    const LDSP unsigned char* kb = Kt + r32 * KSTR + hi * 16 + dbase * 32;
#pragma unroll
    for (int d0 = 0; d0 < NK16; ++d0) {
        const bf16x8 a0 = *(const LDSP bf16x8*)(kb + d0 * 32), a1 = *(const LDSP bf16x8*)(kb + 32 * KSTR + d0 * 32);
        p0 = __builtin_amdgcn_mfma_f32_32x32x16_bf16(a0, qf[d0], p0, 0, 0, 0);
        p1 = __builtin_amdgcn_mfma_f32_32x32x16_bf16(a1, qf[d0], p1, 0, 0, 0);
    }
}
__device__ __forceinline__ void pv(f32x16* o, const LDSP unsigned char* Vt, int vb, const f32x16& p0, const f32x16& p1) {
    bf16x8 pa[4]; pa[0] = pack8(p0, 0); pa[1] = pack8(p0, 8); pa[2] = pack8(p1, 0); pa[3] = pack8(p1, 8);
#pragma unroll
    for (int d0 = 0; d0 < 2; ++d0)
#pragma unroll
        for (int ks = 0; ks < 4; ++ks) {
            const s16x4 lo = vtr(Vt + vb + d0 * 4096 + ks * 1024), hh = vtr(Vt + vb + d0 * 4096 + ks * 1024 + 512);
            const bf16x8 vf = (bf16x8){lo[0], lo[1], lo[2], lo[3], hh[0], hh[1], hh[2], hh[3]};
            o[d0] = __builtin_amdgcn_mfma_f32_32x32x16_bf16(pa[ks], vf, o[d0], 0, 0, 0);
        }
}
__device__ __forceinline__ void softmax_tile(f32x16& p0, f32x16& p1, float& m_run, float& l_run, f32x16* o, LDSP float* wsf, int r32, int hi) {
    float mt = fmaxf(p0[0], p1[0]);
#pragma unroll
    for (int r = 1; r < 16; ++r) mt = fmaxf(mt, fmaxf(p0[r], p1[r]));
    mt = fmaxf(mt, __shfl_xor(mt, 32));
    const float m_new = fmaxf(m_run, mt);
    const float m_use = (m_new == -INFINITY) ? 0.f : m_new;
    if (__any(m_new != m_run)) {
        const float alpha = ex2(m_run - m_use);
        l_run *= alpha;
        if (hi == 0) wsf[r32] = alpha;
        __builtin_amdgcn_s_waitcnt(0xc07f);
        __builtin_amdgcn_wave_barrier();
#pragma unroll
        for (int g = 0; g < 4; ++g) { const f32x4 a = *(const LDSP f32x4*)(wsf + 8 * g + 4 * hi);
#pragma unroll
            for (int i = 0; i < 4; ++i) { o[0][4 * g + i] *= a[i]; o[1][4 * g + i] *= a[i]; } }
        __builtin_amdgcn_wave_barrier();
    }
    m_run = m_new;
    float ls = 0.f;
#pragma unroll
    for (int r = 0; r < 16; ++r) { p0[r] = ex2(p0[r] - m_use); p1[r] = ex2(p1[r] - m_use); ls += p0[r] + p1[r]; }
    l_run += ls;
}
__device__ __forceinline__ void scale_rows(f32x16* o, float f, LDSP float* wsf, int r32, int hi) {
    __builtin_amdgcn_wave_barrier();
    if (hi == 0) wsf[r32] = f;
    __builtin_amdgcn_s_waitcnt(0xc07f);
    __builtin_amdgcn_wave_barrier();
#pragma unroll
    for (int g = 0; g < 4; ++g) { const f32x4 a = *(const LDSP f32x4*)(wsf + 8 * g + 4 * hi);
#pragma unroll
        for (int i = 0; i < 4; ++i) { o[0][4 * g + i] *= a[i]; o[1][4 * g + i] *= a[i]; } }
    __builtin_amdgcn_wave_barrier();
}
__device__ __forceinline__ void store_o(const f32x16* o, LDSP bf16_t* stg, bf16_t* dst, int lane, int r32, int hi) {
    __builtin_amdgcn_wave_barrier();
#pragma unroll
    for (int r = 0; r < 16; ++r) { const int orow = crow(r, hi); stg[orow * 64 + r32] = f2bf(o[0][r]); stg[orow * 64 + 32 + r32] = f2bf(o[1][r]); }
    __builtin_amdgcn_s_waitcnt(0xc07f);
    __builtin_amdgcn_wave_barrier();
#pragma unroll
    for (int i = 0; i < 4; ++i) { const int row = i * 8 + (lane >> 3), ch = lane & 7; const u32x4 v = *(const LDSP u32x4*)(stg + row * 64 + ch * 8); *(u32x4*)(dst + (size_t)row * DM + ch * 8) = v; }
    __builtin_amdgcn_s_waitcnt(0xc07f);
    __builtin_amdgcn_wave_barrier();
}
template <int NG>
__device__ __forceinline__ void load_q(bf16x8* qf, const bf16_t* qrow  , const float* g, float sc, bool norm, int hi) {
    float v[4][8];
#pragma unroll
    for (int d0 = 0; d0 < 4; ++d0) load8(qrow + 16 * d0 + 8 * hi, v[d0]);
    float r0 = 1.f, r1 = 1.f;
    if (norm) {
        float s0 = 0.f, s1 = 0.f;
#pragma unroll
        for (int j = 0; j < 8; ++j) { s0 += v[0][j] * v[0][j] + v[1][j] * v[1][j]; s1 += v[2][j] * v[2][j] + v[3][j] * v[3][j]; }
        s0 += __shfl_xor(s0, 32); s1 += __shfl_xor(s1, 32);
        if (NG == 64) { r0 = rsqrtf((s0 + s1) * (1.f / 64.f) + EPS); r1 = r0; } else { r0 = rsqrtf(s0 * (1.f / 32.f) + EPS); r1 = rsqrtf(s1 * (1.f / 32.f) + EPS); }
    }
#pragma unroll
    for (int d0 = 0; d0 < 4; ++d0) {
        const float rr = (d0 < 2 ? r0 : r1) * sc; float w[8];
#pragma unroll
        for (int j = 0; j < 8; ++j) { const int d = 16 * d0 + 8 * hi + j; w[j] = v[d0][j] * rr * (norm ? g[d % NG] : 1.f); }
        u32x4 u; u[0] = pg8::cvt_pk_bf16(w[0], w[1]); u[1] = pg8::cvt_pk_bf16(w[2], w[3]); u[2] = pg8::cvt_pk_bf16(w[4], w[5]); u[3] = pg8::cvt_pk_bf16(w[6], w[7]);
        qf[d0] = __builtin_bit_cast(bf16x8, u);
    }
}
__device__ __forceinline__ void kv_load(u32x4& kr, u32x4& vr, const bf16_t* Kb, const bf16_t* Vb, int k0, int tid) {
    const size_t off = (size_t)(k0 + (tid >> 3)) * PINP + (tid & 7) * 8;
    kr = *(const u32x4*)(Kb + off); vr = *(const u32x4*)(Vb + off);
}
__device__ __forceinline__ void kv_store(const u32x4& kr, const u32x4& vr, LDSP unsigned char* L, int tid) {
    const int key = tid >> 3, ch = tid & 7;
    *(LDSP u32x4*)(L + AL_K + key * KSTR + ch * 16) = kr;
    *(LDSP u32x4*)(L + AL_V + (ch >> 2) * 4096 + (key >> 4) * 1024 + ((key >> 3) & 1) * 512 + (key & 7) * 64 + (ch & 3) * 16) = vr;
}


__device__ __forceinline__ void bias_near(f32x16& p0, f32x16& p1, const LDSP float* tbl, int tk0  , int wnd, bool rowok, int hi) {
#pragma unroll
    for (int g = 0; g < 4; ++g) {
#pragma unroll
        for (int i = 0; i < 4; ++i) { const int r = 4 * g + i; const int d0_ = tk0 - crow(r, hi), d1_ = d0_ - 32;
            const float b0 = tbl[min(max(d0_, 0), 127)], b1 = tbl[min(max(d1_, 0), 127)];
            p0[r] = (d0_ < 0 || d0_ >= wnd || !rowok) ? -INFINITY : p0[r] + b0; p1[r] = (d1_ < 0 || d1_ >= wnd || !rowok) ? -INFINITY : p1[r] + b1; }
        asm volatile("" ::: "memory");
    }
}
__device__ void fa_fox_unit(const Params& p, int l, int b, int h, int qb, LDSP unsigned char* L) {
    const int tid = TID(), lane = tid & 63, wid = __builtin_amdgcn_readfirstlane(tid >> 6), r32 = lane & 31, hi = lane >> 5;
    const bf16_t* proj = (const bf16_t*)(p.ws + WS_PROJ); bf16_t* mix = (bf16_t*)(p.ws + WS_MIX);
    const size_t rb = (size_t)b * SEQ; const int q0 = qb * 256, qw = q0 + 32 * wid, t = qw + r32;
    const bf16_t* Kb = proj + rb * PINP + CB_K + 64 * h; const bf16_t* Vb = proj + rb * PINP + CB_V + 64 * h;
    const float* cm = (const float*)(p.ws + WS_CUM) + (b * 4 + h) * SEQ;
    LDSP float* wsf = (LDSP float*)(L + AL_WSF) + wid * 64; LDSP float* bk = (LDSP float*)(L + AL_BK);
    const int vb = ((lane >> 4) & 1) * 32 + (lane & 3) * 8 + (4 * hi + ((lane & 15) >> 2)) * 64;
    bf16x8 qf[4]; load_q<64>(qf, proj + (rb + t) * PINP + CB_Q + 64 * h, p.fox_qn + l * 64, 0.125f * LOG2E, true, hi);
    f32x16 o[2]; o[0] = (f32x16){}; o[1] = (f32x16){};
    float m_run = -INFINITY, l_run = 0.f;
    const int NT = 4 * qb + 4, jd = 4 * qb + (wid >> 1);
    u32x4 kr, vr; float cr = 0.f;
    kv_load(kr, vr, Kb, Vb, 0, tid); if (tid < 64) cr = cm[tid];
    for (int j = 0; j < NT; ++j) {
        __syncthreads();
        kv_store(kr, vr, L, tid); if (tid < 64) bk[tid] = -cr * LOG2E;
        __syncthreads();
        if (j + 1 < NT) { kv_load(kr, vr, Kb, Vb, 64 * (j + 1), tid); if (tid < 64) cr = cm[64 * (j + 1) + tid]; }
        if (j <= jd) {
            f32x16 p0 = (f32x16){}, p1 = (f32x16){};
            qkt<4>(p0, p1, L + AL_K, qf, 0, r32, hi);
            const int k0 = 64 * j;
#pragma unroll
            for (int g = 0; g < 4; ++g) { const f32x4 b0 = *(const LDSP f32x4*)(bk + 8 * g + 4 * hi), b1 = *(const LDSP f32x4*)(bk + 32 + 8 * g + 4 * hi);
#pragma unroll
                for (int i = 0; i < 4; ++i) { p0[4 * g + i] += b0[i]; p1[4 * g + i] += b1[i]; } }
            if (j == jd) {
#pragma unroll
                for (int r = 0; r < 16; ++r) { const int kk = k0 + crow(r, hi); if (kk > t) p0[r] = -INFINITY; if (kk + 32 > t) p1[r] = -INFINITY; }
            }
            softmax_tile(p0, p1, m_run, l_run, o, wsf, r32, hi);
            pv(o, L + AL_V, vb, p0, p1);
        }
    }
    l_run += __shfl_xor(l_run, 32);
    scale_rows(o, 1.f / l_run, wsf, r32, hi);
    store_o(o, (LDSP bf16_t*)(L + AL_OST) + wid * 2048, mix + (rb + qw) * DM + 256 + 64 * h, lane, r32, hi);
}
__device__ void fa_phase_fox(const Params& p, int l, LDSP unsigned char* L) {
    for (int u = blockIdx.x; u < 256; u += gridDim.x) { const int qb = 15 - (u >> 4), bh = u & 15; fa_fox_unit(p, l, bh >> 2, bh & 3, qb, L); }
}


__device__ void fa_diff_unit(const Params& p, int l, int b, int h, int qb, LDSP unsigned char* L) {
    const int tid = TID(), lane = tid & 63, wid = __builtin_amdgcn_readfirstlane(tid >> 6), r32 = lane & 31, hi = lane >> 5;
    const bf16_t* proj = (const bf16_t*)(p.ws + WS_PROJ); bf16_t* mix = (bf16_t*)(p.ws + WS_MIX);
    const size_t rb = (size_t)b * SEQ; const int q0 = qb * 256, qw = q0 + 32 * wid, t = qw + r32;
    const bf16_t* Kb = proj + rb * PINP + CA_K + 64 * h; const bf16_t* Vb = proj + rb * PINP + CA_V + 64 * h;
    LDSP float* wsf = (LDSP float*)(L + AL_WSF) + wid * 64; LDSP float* tbl = (LDSP float*)(L + AL_TB);
    const int vb = ((lane >> 4) & 1) * 32 + (lane & 3) * 8 + (4 * hi + ((lane & 15) >> 2)) * 64;
    const float lam = ((const float*)(p.ws + WS_LAM))[l]; const float lam_init = 0.8f - 0.6f * __expf(-0.3f * (float)l);
    __syncthreads();
    if (tid < 128) tbl[tid] = ((const float*)(p.ws + WS_TB))[h * 128 + tid] * LOG2E;
    bf16x8 qf[4]; load_q<32>(qf, proj + (rb + t) * PINP + CA_Q + 64 * h, p.diff_qn + l * 32, 0.17677669529663687f * LOG2E, true, hi);
    f32x16 o1[2], o2[2]; o1[0] = (f32x16){}; o1[1] = (f32x16){}; o2[0] = (f32x16){}; o2[1] = (f32x16){};
    float m1 = -INFINITY, l1 = 0.f, m2 = -INFINITY, l2 = 0.f;
    const int NT = 4 * qb + 4, jd = 4 * qb + (wid >> 1);
    u32x4 kr, vr;
    kv_load(kr, vr, Kb, Vb, 0, tid);
    for (int j = 0; j < NT; ++j) {
        __syncthreads();
        kv_store(kr, vr, L, tid);
        __syncthreads();
        if (j + 1 < NT) kv_load(kr, vr, Kb, Vb, 64 * (j + 1), tid);
        if (j <= jd) {
            const int k0 = 64 * j; const bool nearb = (qw - (k0 + 63)) < 113; const float b31 = tbl[127];
#pragma unroll
            for (int mp = 0; mp < 2; ++mp) {
                f32x16 p0 = (f32x16){}, p1 = (f32x16){};
                qkt<2>(p0, p1, L + AL_K, qf + 2 * mp, 2 * mp, r32, hi);
                if (nearb) { bias_near(p0, p1, tbl, t - k0, 1 << 30, true, hi);
                } else {
#pragma unroll
                    for (int r = 0; r < 16; ++r) { p0[r] += b31; p1[r] += b31; }
                }
                if (mp == 0) { softmax_tile(p0, p1, m1, l1, o1, wsf, r32, hi); pv(o1, L + AL_V, vb, p0, p1); }
                else { softmax_tile(p0, p1, m2, l2, o2, wsf, r32, hi); pv(o2, L + AL_V, vb, p0, p1); }
            }
        }
    }
    l1 += __shfl_xor(l1, 32); l2 += __shfl_xor(l2, 32);
    scale_rows(o1, 1.f / l1, wsf, r32, hi); scale_rows(o2, lam / l2, wsf, r32, hi);
    o1[0] -= o2[0]; o1[1] -= o2[1];
    const float g0 = p.diff_sub[l * 64 + r32] * (1.f - lam_init), g1 = p.diff_sub[l * 64 + 32 + r32] * (1.f - lam_init);
#pragma unroll
    for (int r = 0; r < 16; ++r) {
        float ss = o1[0][r] * o1[0][r] + o1[1][r] * o1[1][r];
        ss += __shfl_xor(ss, 1); ss += __shfl_xor(ss, 2); ss += __shfl_xor(ss, 4); ss += __shfl_xor(ss, 8); ss += __shfl_xor(ss, 16);
        const float rs = rsqrtf(ss * (1.f / 64.f) + EPS); o1[0][r] *= rs * g0; o1[1][r] *= rs * g1;
    }
    store_o(o1, (LDSP bf16_t*)(L + AL_OST) + wid * 2048, mix + (rb + qw) * DM + 0 + 64 * h, lane, r32, hi);
}
__device__ __forceinline__ void stick_sub(f32x16& y, float& carry, int kbase  , int t, bool diag, int hi) {
    float lk[16];
#pragma unroll
    for (int r = 0; r < 16; ++r) {
        const float v = y[r]; const float e = ex2(-fabsf(v)); const float lb = fminf(v, 0.f) - __builtin_amdgcn_logf(1.f + e);
        const bool valid = !diag || (kbase + crow(r, hi) < t);
        lk[r] = valid ? (lb - v) : 0.f; y[r] = valid ? lb : -INFINITY;
    }
    float T[4], Go[4];
#pragma unroll
    for (int g = 0; g < 4; ++g) { const float Gs = (lk[4 * g] + lk[4 * g + 1]) + (lk[4 * g + 2] + lk[4 * g + 3]); Go[g] = __shfl_xor(Gs, 32); T[g] = Gs + Go[g]; }
    float sx = 0.f;
#pragma unroll
    for (int g = 3; g >= 0; --g) {
        float tail = carry + sx + (hi == 0 ? Go[g] : 0.f);
#pragma unroll
        for (int i = 3; i >= 0; --i) { y[4 * g + i] = ex2(y[4 * g + i] + tail); tail += lk[4 * g + i]; }
        sx += T[g];
    }
    carry += sx;
}
__device__ void fa_stick_unit(const Params& p, int l, int b, int h, int qb, LDSP unsigned char* L) {
    const int tid = TID(), lane = tid & 63, wid = __builtin_amdgcn_readfirstlane(tid >> 6), r32 = lane & 31, hi = lane >> 5;
    const bf16_t* proj = (const bf16_t*)(p.ws + WS_PROJ); bf16_t* mix = (bf16_t*)(p.ws + WS_MIX);
    const size_t rb = (size_t)b * SEQ; const int q0 = qb * 256, qw = q0 + 32 * wid, t = qw + r32;
    const bf16_t* Kb = proj + rb * PINP + CC_K + 64 * h; const bf16_t* Vb = proj + rb * PINP + CC_V + 64 * h;
    const int vb = ((lane >> 4) & 1) * 32 + (lane & 3) * 8 + (4 * hi + ((lane & 15) >> 2)) * 64;
    bf16x8 qf[4]; load_q<64>(qf, proj + (rb + t) * PINP + CC_Q + 64 * h, nullptr, 0.125f * LOG2E, false, hi);
    f32x16 o[2]; o[0] = (f32x16){}; o[1] = (f32x16){};
    float carry = 0.f;
    const int NT = 4 * qb + 4, jd = 4 * qb + (wid >> 1);
    u32x4 kr, vr;
    kv_load(kr, vr, Kb, Vb, 64 * (NT - 1), tid);
    for (int j = NT - 1; j >= 0; --j) {
        __syncthreads();
        kv_store(kr, vr, L, tid);
        __syncthreads();
        if (j > 0) kv_load(kr, vr, Kb, Vb, 64 * (j - 1), tid);
        if (j <= jd) {
            f32x16 p0 = (f32x16){}, p1 = (f32x16){};
            qkt<4>(p0, p1, L + AL_K, qf, 0, r32, hi);
            const int k0 = 64 * j; const bool diag = (j == jd);
            stick_sub(p1, carry, k0 + 32, t, diag, hi);
            stick_sub(p0, carry, k0, t, diag, hi);
            pv(o, L + AL_V, vb, p0, p1);
        }
    }
    store_o(o, (LDSP bf16_t*)(L + AL_OST) + wid * 2048, mix + (rb + qw) * DM + 512 + 64 * h, lane, r32, hi);
}
__device__ void fa_phase_abc(const Params& p, int l, LDSP unsigned char* L) {
    for (int u = blockIdx.x; u < 768; u += gridDim.x) {
        const int typ = u % 3, v = u / 3, qb = 15 - (v >> 4), bh = v & 15;
        if (typ == 0) fa_diff_unit(p, l, bh >> 2, bh & 3, qb, L);
        else if (typ == 1) fa_fox_unit(p, l, bh >> 2, bh & 3, qb, L);
        else fa_stick_unit(p, l, bh >> 2, bh & 3, qb, L);
    }
}


constexpr int AL_IMP = 53248  , AL_SELM = AL_IMP + 65536  , AL_TB4 = AL_SELM + 512  , AL_D_END = AL_TB4 + 2048;
static_assert(AL_END <= AL_IMP && AL_D_END <= 131072 + 4096, "attention LDS map");
__device__ __forceinline__ void kv_load64(u32x4& kr, u32x4& vr, const bf16_t* Kb, const bf16_t* Vb, int n0, int tid) {
    const size_t off = (size_t)(n0 + (tid >> 3)) * 64 + (tid & 7) * 8;
    kr = *(const u32x4*)(Kb + off); vr = *(const u32x4*)(Vb + off);
}
__device__ void fa_nsa_unit(const Params& p, int l, int b, int u, LDSP unsigned char* L) {
    const int tid = TID(), lane = tid & 63, wid = __builtin_amdgcn_readfirstlane(tid >> 6), r32 = lane & 31, hi = lane >> 5;
    const int hh = wid >> 1, sub = wid & 1;
    const bf16_t* proj = (const bf16_t*)(p.ws + WS_PROJ); bf16_t* mix = (bf16_t*)(p.ws + WS_MIX);
    const size_t rb = (size_t)b * SEQ; const int q0 = 64 * u, qw = q0 + 32 * sub, t = qw + r32; const int ql = 32 * sub + r32;
    LDSP float* wsf = (LDSP float*)(L + AL_WSF) + wid * 64; LDSP float* tbl = (LDSP float*)(L + AL_TB4) + hh * 128;
    LDSP float* imp = (LDSP float*)(L + AL_IMP); LDSP unsigned* selm = (LDSP unsigned*)(L + AL_SELM);
    const int vb = ((lane >> 4) & 1) * 32 + (lane & 3) * 8 + (4 * hi + ((lane & 15) >> 2)) * 64;
    __syncthreads();
    ((LDSP float*)(L + AL_TB4))[tid] = ((const float*)(p.ws + WS_TB))[512 + tid] * LOG2E;
    bf16x8 qf[4]; load_q<64>(qf, proj + (rb + t) * PINP + CD_Q + 64 * hh, p.nsa_qn + l * 64, 0.125f * LOG2E, true, hi);
    const float* sd = (const float*)(p.ws + WS_SIDE) + (rb + t) * 16 + 4 + hh;
    const float gc = 1.f / (1.f + __expf(-sd[0])), gs = 1.f / (1.f + __expf(-sd[4])), gwn = 1.f / (1.f + __expf(-sd[8]));
    f32x16 o[2]; o[0] = (f32x16){}; o[1] = (f32x16){};
    LDSP float* ofl = (LDSP float*)(L + AL_IMP) + wid * 2048 + lane;
    u32x4 kr, vr;
    {
        const bf16_t* Kc = (const bf16_t*)(p.ws + WS_KC) + (size_t)b * 256 * 64; const bf16_t* Vc = (const bf16_t*)(p.ws + WS_VC) + (size_t)b * 256 * 64;
        const int ntc = (4 * u + 2) / 64 + 1;
        float m_run = -INFINITY, l_run = 0.f;
        for (int pass = 0; pass < 2; ++pass) {
            float inv = 0.f, m_use = 0.f, prevE3 = 0.f;
            if (pass == 1) { l_run += __shfl_xor(l_run, 32); inv = (l_run > 0.f) ? 1.f / l_run : 0.f; m_use = (m_run == -INFINITY) ? 0.f : m_run; }
            kv_load64(kr, vr, Kc, Vc, 0, tid);
            for (int T = 0; T < ntc; ++T) {
                __syncthreads();
                kv_store(kr, vr, L, tid);
                __syncthreads();
                if (T + 1 < ntc) kv_load64(kr, vr, Kc, Vc, 64 * (T + 1), tid);
                f32x16 p0 = (f32x16){}, p1 = (f32x16){};
                qkt<4>(p0, p1, L + AL_K, qf, 0, r32, hi);
#pragma unroll
                for (int g = 0; g < 4; ++g) {
#pragma unroll
                    for (int i = 0; i < 4; ++i) { const int r = 4 * g + i; const int d0_ = t - 16 * (64 * T + crow(r, hi)) - 31, d1_ = d0_ - 512;
                        const float b0 = tbl[min(max(d0_, 0), 127)], b1 = tbl[min(max(d1_, 0), 127)];
                        p0[r] = (d0_ < 0) ? -INFINITY : p0[r] + b0; p1[r] = (d1_ < 0) ? -INFINITY : p1[r] + b1; }
                    asm volatile("" ::: "memory");
                }
                if (pass == 0) {
                    float mt = fmaxf(p0[0], p1[0]);
#pragma unroll
                    for (int r = 1; r < 16; ++r) mt = fmaxf(mt, fmaxf(p0[r], p1[r]));
                    mt = fmaxf(mt, __shfl_xor(mt, 32));
                    const float m_new = fmaxf(m_run, mt), mu = (m_new == -INFINITY) ? 0.f : m_new;
                    float ls = 0.f;
#pragma unroll
                    for (int r = 0; r < 16; ++r) ls += ex2(p0[r] - mu) + ex2(p1[r] - mu);
                    l_run = l_run * ex2(m_run - mu) + ls; m_run = m_new;
                } else {
#pragma unroll
                    for (int r = 0; r < 16; ++r) { p0[r] = ex2(p0[r] - m_use) * inv; p1[r] = ex2(p1[r] - m_use) * inv; }
#pragma unroll
                    for (int s2 = 0; s2 < 2; ++s2) {
                        float G[4], E[4], Eo[4];
#pragma unroll
                        for (int g = 0; g < 4; ++g) { const float a0 = s2 ? p1[4 * g] : p0[4 * g], a1 = s2 ? p1[4 * g + 1] : p0[4 * g + 1], a2 = s2 ? p1[4 * g + 2] : p0[4 * g + 2], a3 = s2 ? p1[4 * g + 3] : p0[4 * g + 3];
                            G[g] = (a0 + a1) + (a2 + a3); E[g] = a3; Eo[g] = __shfl_xor(a3, 32); }
#pragma unroll
                        for (int g = 0; g < 4; ++g) { const float eprev = hi ? Eo[g] : (g > 0 ? Eo[g - 1] : prevE3);
                            imp[(hh * 64 + ql) * 64 + 16 * T + 8 * s2 + 2 * g + hi] = G[g] + eprev; }
                        prevE3 = Eo[3];
                    }
                    pv(o, L + AL_V, vb, p0, p1);
                }
            }
        }
        scale_rows(o, gc, wsf, r32, hi);
    }
    __syncthreads();
    {
        const int q = tid >> 3, part = tid & 7;
        float vj[8];
#pragma unroll
        for (int jj = 0; jj < 8; ++jj) { const int j = part * 8 + jj;
            const float sum = ((imp[(0 * 64 + q) * 64 + j] + imp[(1 * 64 + q) * 64 + j]) + imp[(2 * 64 + q) * 64 + j]) + imp[(3 * 64 + q) * 64 + j];
            vj[jj] = (j > u) ? -1.0f : ((j == u || j == 0) ? 1.0e4f : sum); }
        __syncthreads();
#pragma unroll
        for (int jj = 0; jj < 8; ++jj) imp[q * 64 + part * 8 + jj] = vj[jj];
        __syncthreads();
        int rank[8];
#pragma unroll
        for (int jj = 0; jj < 8; ++jj) rank[jj] = 0;
        for (int i = 0; i < 64; ++i) { const float vi = imp[q * 64 + i];
#pragma unroll
            for (int jj = 0; jj < 8; ++jj) rank[jj] += (vi > vj[jj] || (vi == vj[jj] && i < part * 8 + jj)) ? 1 : 0; }
        unsigned bits = 0;
#pragma unroll
        for (int jj = 0; jj < 8; ++jj) if (rank[jj] < 16 && (part * 8 + jj) <= u) bits |= 1u << jj;
        unsigned mlo = (part < 4) ? (bits << (8 * part)) : 0u, mhi = (part >= 4) ? (bits << (8 * (part - 4))) : 0u;
        mlo |= __shfl_xor(mlo, 1); mhi |= __shfl_xor(mhi, 1); mlo |= __shfl_xor(mlo, 2); mhi |= __shfl_xor(mhi, 2); mlo |= __shfl_xor(mlo, 4); mhi |= __shfl_xor(mhi, 4);
        if (part == 0) { selm[2 * q] = mlo; selm[2 * q + 1] = mhi; }
    }
    __syncthreads();
#pragma unroll
    for (int r = 0; r < 16; ++r) { ofl[(2 * r) * 64] = o[0][r]; ofl[(2 * r + 1) * 64] = o[1][r]; }
    o[0] = (f32x16){}; o[1] = (f32x16){};
    {
        const unsigned long long mymask = (unsigned long long)selm[2 * ql] | ((unsigned long long)selm[2 * ql + 1] << 32);
        unsigned ulo = selm[2 * lane], uhi = selm[2 * lane + 1];
#pragma unroll
        for (int s2 = 1; s2 < 64; s2 <<= 1) { ulo |= __shfl_xor(ulo, s2); uhi |= __shfl_xor(uhi, s2); }
        unsigned long long um = (unsigned long long)(unsigned)__builtin_amdgcn_readfirstlane((int)ulo) | ((unsigned long long)(unsigned)__builtin_amdgcn_readfirstlane((int)uhi) << 32);
        const bf16_t* Kb = proj + rb * PINP + CD_KS; const bf16_t* Vb = proj + rb * PINP + CD_VS;
        float m_run = -INFINITY, l_run = 0.f; const float b31 = tbl[127];
        int j = __builtin_ctzll(um); um &= um - 1;
        kv_load(kr, vr, Kb, Vb, 64 * j, tid);
        for (;;) {
            __syncthreads();
            kv_store(kr, vr, L, tid);
            __syncthreads();
            const int jn = um ? __builtin_ctzll(um) : -1; um &= um - 1;
            if (jn >= 0) kv_load(kr, vr, Kb, Vb, 64 * jn, tid);
            const bool mine = (mymask >> j) & 1ull;
            if (__any(mine)) {
                f32x16 p0 = (f32x16){}, p1 = (f32x16){};
                qkt<4>(p0, p1, L + AL_K, qf, 0, r32, hi);
                const int k0 = 64 * j; const bool nearb = (qw - (k0 + 63)) < 113;
                if (nearb) { bias_near(p0, p1, tbl, t - k0, 1 << 30, mine, hi);
                } else {
#pragma unroll
                    for (int r = 0; r < 16; ++r) { p0[r] = mine ? p0[r] + b31 : -INFINITY; p1[r] = mine ? p1[r] + b31 : -INFINITY; }
                }
                softmax_tile(p0, p1, m_run, l_run, o, wsf, r32, hi);
                pv(o, L + AL_V, vb, p0, p1);
            }
            if (jn < 0) break;
            j = jn;
        }
        l_run += __shfl_xor(l_run, 32);
        scale_rows(o, gs / l_run, wsf, r32, hi);
#pragma unroll
        for (int r = 0; r < 16; ++r) { ofl[(2 * r) * 64] += o[0][r]; ofl[(2 * r + 1) * 64] += o[1][r]; }
        o[0] = (f32x16){}; o[1] = (f32x16){};
    }
    {
        const bf16_t* Kb = proj + rb * PINP + CD_KW; const bf16_t* Vb = proj + rb * PINP + CD_VW;
        float m_run = -INFINITY, l_run = 0.f; const float b31 = tbl[127];
        const int jlo = max(0, u - 8);
        kv_load(kr, vr, Kb, Vb, 64 * jlo, tid);
        for (int j = jlo; j <= u; ++j) {
            __syncthreads();
            kv_store(kr, vr, L, tid);
            __syncthreads();
            if (j < u) kv_load(kr, vr, Kb, Vb, 64 * (j + 1), tid);
            f32x16 p0 = (f32x16){}, p1 = (f32x16){};
            qkt<4>(p0, p1, L + AL_K, qf, 0, r32, hi);
            const int k0 = 64 * j;
            if (j == u || j == u - 8 || (qw - (k0 + 63)) < 113) { bias_near(p0, p1, tbl, t - k0, 512, true, hi);
            } else {
#pragma unroll
                for (int r = 0; r < 16; ++r) { p0[r] += b31; p1[r] += b31; }
            }
            softmax_tile(p0, p1, m_run, l_run, o, wsf, r32, hi);
            pv(o, L + AL_V, vb, p0, p1);
        }
        l_run += __shfl_xor(l_run, 32);
        scale_rows(o, gwn / l_run, wsf, r32, hi);
#pragma unroll
        for (int r = 0; r < 16; ++r) { o[0][r] += ofl[(2 * r) * 64]; o[1][r] += ofl[(2 * r + 1) * 64]; }
    }
    store_o(o, (LDSP bf16_t*)(L + AL_OST) + wid * 2048, mix + (rb + qw) * DM + 768 + 64 * hh, lane, r32, hi);
}
__device__ __forceinline__ int unit_cost(int idx) {
    const int typ = idx >> 8, v = idx & 255;
    if (typ == 3) { const int u = v & 63; return 10 * (min(u + 1, 28) + min(u + 1, 9) + 2 * ((4 * u + 2) / 64 + 1)) + 40; }
    const int nt = 4 * (v >> 4) + 4; return (typ == 0 ? 16 : (typ == 1 ? 10 : 14)) * nt + 20;
}
__device__ void ph_build_order(const Params& p) {
    unsigned* ctl = (unsigned*)(p.ws + WS_CTL);
    const int gt = GTID(), gs = GSIZE();
    for (int idx = gt; idx < 1024; idx += gs) {
        const int c = unit_cost(idx); int rank = 0;
        for (int i = 0; i < 1024; ++i) { const int ci = unit_cost(i); rank += (ci > c || (ci == c && i < idx)) ? 1 : 0; }
        ctl[64 + rank] = (unsigned)idx;
    }
    if (gt < 8) ctl[gt] = 0u;
}
__device__ void fa_phase_all(const Params& p, int l, LDSP unsigned char* L, int qslot) {
    unsigned* ctl = (unsigned*)(p.ws + WS_CTL);
    LDSP unsigned* misc = (LDSP unsigned*)(L + AL_MISC);
    for (;;) {
        __syncthreads();
        if (threadIdx.x == 0) misc[0] = atomicAdd(&ctl[qslot], 1u);
        __syncthreads();
        const unsigned qi = misc[0];
        if (qi >= 1024u) break;
        const int idx = (int)ctl[64 + qi]; const int typ = idx >> 8, v = idx & 255;
        if (typ == 0) fa_diff_unit(p, l, (v & 15) >> 2, v & 3, v >> 4, L);
        else if (typ == 1) fa_fox_unit(p, l, (v & 15) >> 2, v & 3, v >> 4, L);
        else if (typ == 2) fa_stick_unit(p, l, (v & 15) >> 2, v & 3, v >> 4, L);
        else fa_nsa_unit(p, l, v >> 6, v & 63, L);
    }
}

__device__ void ph_act(const Params& p, int l) {
    const bf16_t* ug = (const bf16_t*)(p.ws + WS_UG); bf16_t* uv = (bf16_t*)(p.ws + WS_UV);
    const float* cw = p.conv_w + (size_t)l * 3 * DFF; const float* cb = p.conv_b + (size_t)l * DFF;
    constexpr int NC = DFF / 8;
    for (int idx = GTID(); idx < MTOK * NC; idx += GSIZE()) {
        const int c8 = (idx % NC) * 8; const size_t row = (size_t)(idx / NC); const int t = (int)(row & (SEQ - 1));
        float g0[8], g1[8], g2[8], v[8];
        load8(ug + row * DFF + c8, g0);
        if (t >= 1) load8(ug + (row - 1) * DFF + c8, g1); else {
#pragma unroll
            for (int j = 0; j < 8; ++j) g1[j] = 0.f; }
        if (t >= 2) load8(ug + (row - 2) * DFF + c8, g2); else {
#pragma unroll
            for (int j = 0; j < 8; ++j) g2[j] = 0.f; }
        load8(uv + row * DFF + c8, v);
        float o[8];
#pragma unroll
        for (int j = 0; j < 8; ++j) { const float cv = cw[c8 + j] * g2[j] + cw[DFF + c8 + j] * g1[j] + cw[2 * DFF + c8 + j] * g0[j] + cb[c8 + j]; o[j] = siluf(cv) * v[j]; }
        u32x4 w; w[0] = pk2(o[0], o[1]); w[1] = pk2(o[2], o[3]); w[2] = pk2(o[4], o[5]); w[3] = pk2(o[6], o[7]);
        *(u32x4*)(uv + row * DFF + c8) = w;
    }
}

#define XB_TMO      128
#define XB_XCNT(j)  (256  + 64 * (j))
#define XB_XSUB(j)  (1280 + 64 * (j))
#define XB_XGEN(j)  (2304 + 64 * (j))
#define XB_TOP      3328
#define XB_TOPGEN   3392
#define XCD_BAR_WORDS 3456
#define XB_SPIN_CAP (1u << 18)

__device__ __forceinline__ unsigned xb_ld(unsigned* p)              { return __hip_atomic_load(p, __ATOMIC_RELAXED, __HIP_MEMORY_SCOPE_AGENT); }
__device__ __forceinline__ unsigned xb_add(unsigned* p, unsigned v) { return __hip_atomic_fetch_add(p, v, __ATOMIC_RELAXED, __HIP_MEMORY_SCOPE_AGENT); }
__device__ __forceinline__ unsigned xb_xcc_id() { return (unsigned)__builtin_amdgcn_s_getreg((3 << 11) | 20) & 0xFu; }
#define XB_SPIN(cond, bar) do { unsigned _sp = 0; while (cond) { __builtin_amdgcn_s_sleep(1); \
    if ((++_sp & 255u) == 0u) { if (xb_ld(&(bar)[XB_TMO])) break; if (_sp > XB_SPIN_CAP) { atomicAdd(&(bar)[XB_TMO], 1u); break; } } } } while (0)

struct XcdBarrier {
    unsigned* bar; unsigned x;
    volatile LDSF unsigned* st;
};

__device__ __forceinline__ XcdBarrier xcd_barrier_post(unsigned* bar, volatile LDSF unsigned* st) {
    XcdBarrier b; b.bar = bar; b.x = xb_xcc_id(); b.st = st;
    if (threadIdx.x == 0) (void)xb_add(&bar[XB_XCNT(b.x)], 1u);
    return b;
}
__device__ __forceinline__ void xcd_barrier_complete(unsigned* bar, unsigned x, unsigned& nloc, unsigned& nx) {
    const unsigned G = gridDim.x * gridDim.y * gridDim.z;
    unsigned sum, cnt, mine, sp = 0u;
    for (;;) {
        sum = 0u; cnt = 0u; mine = 0u;
#pragma unroll
        for (unsigned j = 0; j < 16; ++j) { const unsigned c = xb_ld(&bar[XB_XCNT(j)]); sum += c; cnt += (c > 0u) ? 1u : 0u; mine = (j == x) ? c : mine; }
        if (sum == G) break;
        __builtin_amdgcn_s_sleep(1);
        if ((++sp & 255u) == 0u) { if (xb_ld(&bar[XB_TMO])) break; if (sp > XB_SPIN_CAP) { atomicAdd(&bar[XB_TMO], 1u); break; } }
    }
    nloc = mine > 0u ? mine : 1u; nx = cnt > 0u ? cnt : 1u;
}

__device__ __forceinline__ void xcd_barrier(const XcdBarrier& b) {
    asm volatile("s_waitcnt vmcnt(0)" ::: "memory");
    __syncthreads();
    if (threadIdx.x == 0) {
        unsigned* bar = b.bar;
        __builtin_amdgcn_s_waitcnt(0);
        unsigned nloc = b.st[0], nx = b.st[1];
        if (nloc == 0u) { xcd_barrier_complete(bar, b.x, nloc, nx); b.st[0] = nloc; b.st[1] = nx; }
        const unsigned old = xb_add(&bar[XB_XSUB(b.x)], 1u);
        const unsigned gen = old / nloc;
        if (old + 1u == (gen + 1u) * nloc) {
            __builtin_amdgcn_fence(__ATOMIC_RELEASE, "agent");
            asm volatile("s_waitcnt vmcnt(0)" ::: "memory");
            const unsigned og = xb_add(&bar[XB_TOP], 1u);
            const unsigned tg = og / nx;
            if (og + 1u == (tg + 1u) * nx) xb_add(&bar[XB_TOPGEN], 1u);
            else XB_SPIN(xb_ld(&bar[XB_TOPGEN]) == tg, bar);
            __builtin_amdgcn_fence(__ATOMIC_ACQUIRE, "agent");
            xb_add(&bar[XB_XGEN(b.x)], 1u);
            asm volatile("s_waitcnt vmcnt(0)" ::: "memory");
        } else {
            XB_SPIN(xb_ld(&bar[XB_XGEN(b.x)]) == gen, bar);
            __builtin_amdgcn_fence(__ATOMIC_ACQUIRE, "agent");
            asm volatile("s_waitcnt vmcnt(0)" ::: "memory");
        }
    }
    __syncthreads();
}

namespace cg = cooperative_groups;
constexpr int LDS_BYTES = 131072 + 4096;
#define LAS3 __attribute__((address_space(3)))
#ifndef PROBE
#define PROBE 0
#endif
__global__ void __launch_bounds__(NTHR, 2) mega(Params p) {
    extern __shared__ __attribute__((aligned(16))) unsigned char lds[];
    cg::grid_group grid = cg::this_grid();
#if PROBE
    unsigned long long tacc = 0, tph = 0, t0_;
#define GSYNC() do { t0_ = __builtin_amdgcn_s_memrealtime(); xcd_barrier(xbar); tacc += __builtin_amdgcn_s_memrealtime() - t0_; } while (0)
#define TPH(stmt) do { t0_ = __builtin_amdgcn_s_memrealtime(); stmt; tph += __builtin_amdgcn_s_memrealtime() - t0_; } while (0)
#else
#define GSYNC() xcd_barrier(xbar)
#define TPH(stmt) do { stmt; } while (0)
#endif
    LAS3 unsigned char* lds3 = (LAS3 unsigned char*)lds;
    volatile LDSF unsigned* bst = (volatile LDSF unsigned*)(lds3 + 131072 + 2048);
    if (threadIdx.x < 2) bst[threadIdx.x] = 0u;
    __syncthreads();
    XcdBarrier xbar = xcd_barrier_post((unsigned*)(p.ws + WS_CTL) + 16384, bst);
    TPH(ph_mod(p, lds); ph_build_order(p));
    grid.sync();
    for (int l = 0; l < DEPTH; ++l) {
        const float* mod = (const float*)(p.ws + WS_MOD) + (size_t)l * 4 * 6144;
        TPH(if (l == 0) ph_cbias(p, lds); ph_weights(p, l, lds);
        if (l == 0) ph_xa_from(p, p.x, 0, 0, (bf16_t*)(p.ws + WS_XA), (float*)(p.ws + WS_RSA), true));
        GSYNC();
        {   pg8::Gemm g{(const bf16_t*)(p.ws + WS_XA), (const bf16_t*)(p.ws + WS_WIN), MTOK, PINP, DM}; pg8::StaticOrder S; S.init(MTOK, PINP, (int)gridDim.x, (int)blockIdx.x);
            EpiProjF E{(const float*)(p.ws + WS_RSA), (const float*)(p.ws + WS_CBIN) + (size_t)l * 4 * PINP, (bf16_t*)(p.ws + WS_PROJ), (float*)(p.ws + WS_SIDE)};
            pg8::gemm_phase<EpiProjF, pg8::StaticOrder, PG8_ALIGN, PG8_SP2>(lds3, g, S, E); }
        GSYNC();
        TPH(ph_prep_knorm(p, l); ph_prep_cum(p, l, lds); ph_prep_cmp(p, l, lds));
        GSYNC();
        fa_phase_all(p, l, lds3, l);
#if PROBE == 1
        GSYNC(); fa_phase_all(p, l, lds3, l + 2);
#endif
        GSYNC();
        {   pg8::Gemm g{(const bf16_t*)(p.ws + WS_MIX), (const bf16_t*)(p.ws + WS_WOUT), MTOK, DM, DM}; pg8::StaticOrder S; S.init(MTOK, DM, (int)gridDim.x, (int)blockIdx.x);
            EpiResF E{l == 0 ? p.x : p.out, p.out, mod + 2048, p.norm_ffn_g + l * DM, mod + 4096, (bf16_t*)(p.ws + WS_XA), (float*)(p.ws + WS_RSB)};
            pg8::gemm_phase<EpiResF, pg8::StaticOrder, PG8_ALIGN, PG8_SP2>(lds3, g, S, E); }
        GSYNC();
        {   pg8::Gemm g{(const bf16_t*)(p.ws + WS_XA), (const bf16_t*)(p.ws + WS_WUP), MTOK, NUP, DM}; pg8::StaticOrder S; S.init(MTOK, NUP, (int)gridDim.x, (int)blockIdx.x);
            EpiUpF E{(const float*)(p.ws + WS_RSB), (const float*)(p.ws + WS_CBUP) + (size_t)l * 4 * NUP, (bf16_t*)(p.ws + WS_UG), (bf16_t*)(p.ws + WS_UV)};
            pg8::gemm_phase<EpiUpF, pg8::StaticOrder, PG8_ALIGN, PG8_SP2>(lds3, g, S, E); }
        GSYNC();
        TPH(ph_act(p, l));
        GSYNC();
        {   const float* modn = (const float*)(p.ws + WS_MOD) + (size_t)(l + 1) * 4 * 6144; const bool more = (l + 1 < DEPTH);
            pg8::Gemm g{(const bf16_t*)(p.ws + WS_UV), (const bf16_t*)(p.ws + WS_WDN), MTOK, DM, DFF}; pg8::StaticOrder S; S.init(MTOK, DM, (int)gridDim.x, (int)blockIdx.x);
            EpiResF E{p.out, p.out, mod + 5120, p.norm_mix_g + (more ? l + 1 : l) * DM, more ? modn + 1024 : mod + 1024, more ? (bf16_t*)(p.ws + WS_XA) : nullptr, more ? (float*)(p.ws + WS_RSA) : nullptr};
            pg8::gemm_phase<EpiResF, pg8::StaticOrder, PG8_ALIGN, PG8_SP2>(lds3, g, S, E); }
        if (l + 1 < DEPTH) GSYNC();
    }
#if PROBE == 1
    if (blockIdx.x == 0 && threadIdx.x == 0) p.out[0] += 0.05f + (float)tacc * 0.01f * 2e-4f;
#elif PROBE == 2
    if (blockIdx.x == 0 && threadIdx.x == 0) p.out[0] += 0.05f + (float)tph * 0.01f * 1e-4f;
#endif
}

extern "C" void kernel_launch(void* const* d_in, const int* in_sizes, int n_in, void* d_out, int out_size, void* d_ws, size_t ws_size, hipStream_t stream) {
    if (n_in != 24 || ws_size < WS_END || out_size != MTOK * DM) { fprintf(stderr, "kernel_launch: unexpected sizes (n_in %d, ws %zu, out %d)\n", n_in, ws_size, out_size); return; }
    static int grid_blocks = 0;
    if (!grid_blocks) {
        int dev = 0, cus = 0, per_cu = 0;
        hipGetDevice(&dev);
        hipDeviceGetAttribute(&cus, hipDeviceAttributeMultiprocessorCount, dev);
        hipFuncSetAttribute((const void*)mega, hipFuncAttributeMaxDynamicSharedMemorySize, LDS_BYTES);
        hipOccupancyMaxActiveBlocksPerMultiprocessor(&per_cu, (const void*)mega, NTHR, LDS_BYTES);
        if (per_cu < 1) { fprintf(stderr, "kernel_launch: occupancy query returned %d\n", per_cu); per_cu = 1; }
        if (per_cu > 1) per_cu = 1;
        grid_blocks = cus * per_cu;
        fprintf(stderr, "kernel_launch: cus %d per_cu %d grid %d\n", cus, per_cu, grid_blocks);
    }
    if (hipMemsetAsync((char*)d_ws + WS_CTL + 65536, 0, XCD_BAR_WORDS * 4, stream) != hipSuccess) { fprintf(stderr, "kernel_launch: memset failed\n"); return; }
    Params p{};
    const float** f = (const float**)&p;
    for (int i = 0; i < 24; ++i) f[i] = (const float*)d_in[i];
    p.out = (float*)d_out; p.ws = (unsigned char*)d_ws;
    void* args[] = {&p};
    hipError_t e = hipLaunchCooperativeKernel((const void*)mega, dim3(grid_blocks), dim3(NTHR), args, LDS_BYTES, stream);
    if (e != hipSuccess) fprintf(stderr, "cooperative launch failed: %s (grid %d)\n", hipGetErrorString(e), grid_blocks);
}
```

```cpp
#include <hip/hip_runtime.h>
#include <hip/hip_cooperative_groups.h>
#include <cstdint>
#include <cstdio>

typedef unsigned short bf16_t;
typedef short bf16x8 __attribute__((ext_vector_type(8)));
typedef float f32x4 __attribute__((ext_vector_type(4)));
typedef unsigned u32x4 __attribute__((ext_vector_type(4)));

constexpr int NB = 4, SEQ = 4096, DM = 1024, MTOK = NB * SEQ, DEPTH = 2;
constexpr int HD = 64, HPM = 4, DFF = 2816, PIN = 2960, PINP = 3072, NUP = 2 * DFF;
constexpr float EPS = 1e-6f;
constexpr float LOG2E = 1.4426950408889634f;
constexpr int NTHR = 512;

constexpr int CA_Q = 0, CA_K = 256, CA_V = 512, CB_Q = 768, CB_K = 1024, CB_V = 1280, CC_Q = 1536, CC_K = 1792, CC_V = 2048;
constexpr int CD_Q = 2304, CD_KC = 2560, CD_VC = 2624, CD_KS = 2688, CD_VS = 2752, CD_KW = 2816, CD_VW = 2880, C_BF = 2944, C_DG = 2948;

constexpr size_t MiB = 1u << 20;
constexpr size_t WS_CTL = 0;
constexpr size_t WS_MOD = 1 * MiB;
constexpr size_t WS_CBIN = WS_MOD + 2 * 4 * 6144 * 4;
constexpr size_t WS_CBUP = WS_CBIN + 2 * 4 * 3072 * 4;
constexpr size_t WS_TB = WS_CBUP + 2 * 4 * 5632 * 4;
constexpr size_t WS_LAM = WS_TB + 2 * 4 * 128 * 4;
constexpr size_t WS_BND = WS_LAM + 64;
constexpr size_t WS_CUM = WS_LAM + 512;
constexpr size_t WS_KC = WS_CUM + 16 * 4096 * 4;
constexpr size_t WS_VC = WS_KC + 4 * 256 * 64 * 2;
constexpr size_t WS_SELM = WS_VC + 4 * 256 * 64 * 2;
constexpr size_t WS_SMALL_END = WS_SELM + 16384 * 8;
static_assert(WS_SMALL_END <= 4 * MiB, "small region");
constexpr size_t WS_RSA = 4 * MiB;
constexpr size_t WS_RSB = 5 * MiB;
constexpr size_t WS_SIDE = 6 * MiB;
constexpr size_t WS_IMP = 7 * MiB;
constexpr size_t WS_ML = 11 * MiB;
constexpr size_t WS_PHIT = 7 * MiB;
constexpr size_t WS_W = 12 * MiB;
constexpr size_t WS_WIN = WS_W;
constexpr size_t WS_WOUT = WS_WIN + (size_t)PINP * DM * 2;
constexpr size_t WS_WUP = WS_WOUT + (size_t)DM * DM * 2;
constexpr size_t WS_WDN = WS_WUP + (size_t)NUP * DM * 2;
constexpr size_t WS_W_END = WS_WDN + (size_t)DM * DFF * 2;
static_assert(WS_W_END <= 38 * MiB, "weights region");
constexpr size_t WS_XA = 38 * MiB;
constexpr size_t WS_BIG = 70 * MiB;
constexpr size_t WS_PROJ = WS_BIG;
constexpr size_t WS_MIX = WS_BIG + 96 * MiB;
constexpr size_t WS_UG = WS_BIG;
constexpr size_t WS_UV = WS_BIG + 88 * MiB;
constexpr size_t WS_END = WS_BIG + 176 * MiB;
static_assert(WS_END <= 256 * MiB, "workspace");

struct Params {
    const float *x, *c, *rel_bias, *ada_w, *ada_b, *norm_mix_g, *norm_ffn_g, *w_in, *w_out;
    const float *diff_qn, *diff_kn, *diff_lam, *diff_sub, *fox_qn, *fox_kn, *fox_bf;
    const float *nsa_qn, *nsa_kn, *nsa_pe, *nsa_phi, *w_up, *conv_w, *conv_b, *w_down;
    float* out;
    unsigned char* ws;
};

__device__ __forceinline__ float bf2f(bf16_t v) { return __uint_as_float(((unsigned)v) << 16); }
__device__ __forceinline__ bf16_t f2bf(float f) { unsigned u = __float_as_uint(f); return (bf16_t)((u + 0x7fffu + ((u >> 16) & 1u)) >> 16); }
__device__ __forceinline__ unsigned pk2(float lo, float hi) { return (unsigned)f2bf(lo) | ((unsigned)f2bf(hi) << 16); }
__device__ __forceinline__ float siluf(float v) { return v / (1.f + __expf(-v)); }
__device__ __forceinline__ float logsigf(float v) { return fminf(v, 0.f) - log1pf(__expf(-fabsf(v))); }
__device__ __forceinline__ float wave_sum(float v) {
#pragma unroll
    for (int o = 1; o < 64; o <<= 1) v += __shfl_xor(v, o);
    return v;
}
__device__ __forceinline__ int t5_bucket(int n) {
    if (n < 16) return n < 0 ? 0 : n;
    return 16 + (n >= 19) + (n >= 21) + (n >= 24) + (n >= 27) + (n >= 31) + (n >= 35) + (n >= 40) + (n >= 46) + (n >= 52) + (n >= 59) + (n >= 67) + (n >= 77) + (n >= 87) + (n >= 99) + (n >= 113);
}
__host__ __device__ __forceinline__ int in_col_map(int n) {
    if (n < 1536) return n;
    if (n < 2944) return n + 4;
    if (n < 2948) return 1536 + (n - 2944);
    if (n < 2960) return n;
    return -1;
}
__host__ __device__ __forceinline__ int up_col_map(int n) {
    const int pn = n >> 8, c = n & 255;
    return c < 128 ? (128 * pn + c) : (DFF + 128 * pn + (c - 128));
}

__device__ __forceinline__ int opaque_v(int v) { asm volatile("" : "+v"(v)); return v; }
#define TID() opaque_v((int)threadIdx.x)
#define GTID() ((int)(blockIdx.x * blockDim.x) + TID())
#define GSIZE() ((int)(gridDim.x * blockDim.x))

#define LDSF __attribute__((address_space(3)))
__device__ __forceinline__ void gemv4_block(const float* W, int ld, int oc, const LDSF float* vec, LDSF float* red, float* out0, int ostride, int n, float bias, int tid) {
    const int lane = tid & 63, wv = tid >> 6;
    float a0 = 0.f, a1 = 0.f, a2 = 0.f, a3 = 0.f;
    if (oc >= 0) {
        const float* w = W + (size_t)(wv * 128) * ld + oc;
#pragma unroll 16
        for (int k = 0; k < 128; ++k) { const float wk = w[(size_t)k * ld]; const f32x4 v = *(const LDSF f32x4*)(vec + (wv * 128 + k) * 4); a0 += v[0] * wk; a1 += v[1] * wk; a2 += v[2] * wk; a3 += v[3] * wk; }
    }
    red[(wv * 4 + 0) * 64 + lane] = a0; red[(wv * 4 + 1) * 64 + lane] = a1; red[(wv * 4 + 2) * 64 + lane] = a2; red[(wv * 4 + 3) * 64 + lane] = a3;
    __syncthreads();
    if (tid < 256) { const int bt = tid >> 6; float sacc = 0.f;
#pragma unroll
        for (int w8 = 0; w8 < 8; ++w8) sacc += red[(w8 * 4 + bt) * 64 + lane];
        out0[(size_t)bt * ostride + n] = sacc + bias; }
    __syncthreads();
}
__device__ void ph_mod(const Params& p, unsigned char* lds) {
    float* mod = (float*)(p.ws + WS_MOD);
    float* tb = (float*)(p.ws + WS_TB);
    float* lamv = (float*)(p.ws + WS_LAM);
    LDSF float* vec = (LDSF float*)lds; LDSF float* red = (LDSF float*)(lds + 16384);
    const int tid = TID();
    bool loaded = false;
    for (int item = blockIdx.x; item < DEPTH * 96; item += gridDim.x) {
        if (!loaded) { for (int i = tid; i < 4096; i += NTHR) { const int bt = i >> 10, k = i & 1023; vec[k * 4 + bt] = siluf(p.c[bt * DM + k]); } __syncthreads(); loaded = true; }
        const int l = item / 96, n = (item % 96) * 64 + (tid & 63);
        gemv4_block(p.ada_w + (size_t)l * DM * 6144, 6144, n, vec, red, mod + (size_t)l * 4 * 6144, 6144, n, p.ada_b[l * 6144 + n], tid);
    }
    const int gt = GTID(), gs = GSIZE();
    for (int idx = gt; idx < 2 * 4 * 128; idx += gs) {
        const int type = idx / 512, h = (idx / 128) & 3, d = idx & 127;
        tb[idx] = p.rel_bias[t5_bucket(d) * 8 + type * 4 + h];
    }
    for (int idx = gt; idx < DEPTH * 32; idx += gs) {
        const int l = idx >> 5, e = idx & 31; float v = 0.f;
        if (e < 17) {
            const int type = (e < 5) ? 0 : 1, h = (e < 4) ? e : ((e == 4) ? 0 : ((e - 5) & 3));
            const int ng = (e < 4) ? 32 : 64;
            const float* gq = (e < 4) ? p.diff_qn + l * 32 : ((e == 4) ? p.fox_qn + l * 64 : p.nsa_qn + l * 64);
            const float* gk = (e < 4) ? p.diff_kn + l * 32 : ((e == 4) ? p.fox_kn + l * 64 : p.nsa_kn + (l * 3 + (e - 5) / 4) * 64);
            float mq = 0.f, mk = 0.f; for (int i = 0; i < ng; ++i) { mq = fmaxf(mq, fabsf(gq[i])); mk = fmaxf(mk, fabsf(gk[i])); }
            float tm = 0.f; if (e != 4) { tm = -INFINITY; for (int bk2 = 0; bk2 < 32; ++bk2) tm = fmaxf(tm, p.rel_bias[bk2 * 8 + type * 4 + h]); }
            v = sqrtf((float)ng) * mq * mk * 1.02f * LOG2E + tm * LOG2E;
        }
        ((float*)(p.ws + WS_BND))[idx] = v;
    }
    for (int idx = gt; idx < DEPTH; idx += gs) {
        const float* lv = p.diff_lam + idx * 4 * 32;
        float s1 = 0.f, s2 = 0.f;
        for (int i = 0; i < 32; ++i) { s1 += lv[i] * lv[32 + i]; s2 += lv[64 + i] * lv[96 + i]; }
        const float lam_init = 0.8f - 0.6f * expf(-0.3f * (float)idx);
        lamv[idx] = expf(s1) - expf(s2) + lam_init;
    }
}
__device__ void ph_cbias(const Params& p, unsigned char* lds) {
    const float* mod = (const float*)(p.ws + WS_MOD);
    LDSF float* vec = (LDSF float*)lds; LDSF float* red = (LDSF float*)(lds + 16384);
    const int tid = TID();
    for (int item = blockIdx.x; item < DEPTH * 136; item += gridDim.x) {
        const int l = item / 136, r = item % 136; const bool isin = r < 48; const int n = (isin ? r : r - 48) * 64 + (tid & 63);
        const int shoff = isin ? 0 : 3072;
        __syncthreads();
        for (int i = tid; i < 4096; i += NTHR) { const int bt = i >> 10, k = i & 1023; vec[k * 4 + bt] = mod[(size_t)(l * 4 + bt) * 6144 + shoff + k]; }
        __syncthreads();
        if (isin) gemv4_block(p.w_in + (size_t)l * DM * PIN, PIN, in_col_map(n), vec, red, (float*)(p.ws + WS_CBIN) + (size_t)l * 4 * PINP, PINP, n, 0.f, tid);
        else gemv4_block(p.w_up + (size_t)l * DM * NUP, NUP, up_col_map(n), vec, red, (float*)(p.ws + WS_CBUP) + (size_t)l * 4 * NUP, NUP, n, 0.f, tid);
    }
}
template <int MAPK>
__device__ void convert_weight(const float* W, int K, int Nsrc, int Npad, bf16_t* Wt, LDSF float* scr, int gw, int ngw, int lane) {
    const int nkb = K / 64, nnb = Npad / 32;
    for (int it = gw; it < nkb * nnb; it += ngw) {
        const int kb = it / nnb, nb = it % nnb, k0 = kb * 64, n0 = nb * 32;
        {
            const int nn = lane & 31; const int n = n0 + nn;
            const int oc = MAPK == 0 ? n : (MAPK == 1 ? in_col_map(n) : up_col_map(n));
#pragma unroll 8
            for (int i = 0; i < 32; ++i) { const int kk = 2 * i + (lane >> 5); scr[kk * 33 + nn] = (oc >= 0) ? W[(size_t)(k0 + kk) * Nsrc + oc] : 0.f; }
        }
        __builtin_amdgcn_s_waitcnt(0xc07f); __builtin_amdgcn_wave_barrier();
        {
            const int c = lane & 7;
#pragma unroll
            for (int j = 0; j < 4; ++j) { const int n = (lane >> 3) + 8 * j; const LDSF float* sp = scr + (8 * c) * 33 + n;
                u32x4 o; o[0] = pk2(sp[0], sp[33]); o[1] = pk2(sp[66], sp[99]); o[2] = pk2(sp[132], sp[165]); o[3] = pk2(sp[198], sp[231]);
                *(u32x4*)(Wt + (size_t)(n0 + n) * K + k0 + 8 * c) = o; }
        }
        __builtin_amdgcn_s_waitcnt(0xc07f); __builtin_amdgcn_wave_barrier();
    }
}
__device__ void ph_weights(const Params& p, int l, unsigned char* lds) {
    const int tid_ = TID(); const int lane = tid_ & 63, wv = tid_ >> 6;
    const int gw = blockIdx.x * (NTHR >> 6) + wv, ngw = gridDim.x * (NTHR >> 6);
    LDSF float* scr = (LDSF float*)lds + wv * (64 * 33);
    convert_weight<1>(p.w_in + (size_t)l * DM * PIN, DM, PIN, PINP, (bf16_t*)(p.ws + WS_WIN), scr, gw, ngw, lane);
    convert_weight<0>(p.w_out + (size_t)l * DM * DM, DM, DM, DM, (bf16_t*)(p.ws + WS_WOUT), scr, gw, ngw, lane);
    convert_weight<2>(p.w_up + (size_t)l * DM * NUP, DM, NUP, NUP, (bf16_t*)(p.ws + WS_WUP), scr, gw, ngw, lane);
    convert_weight<0>(p.w_down + (size_t)l * DFF * DM, DFF, DM, DM, (bf16_t*)(p.ws + WS_WDN), scr, gw, ngw, lane);
    for (int w2 = 0; w2 < 2; ++w2) convert_weight<0>(p.nsa_phi + (size_t)(l * 2 + w2) * 2048 * 64, 2048, 64, 64, (bf16_t*)(p.ws + WS_PHIT) + (size_t)(l * 2 + w2) * 64 * 2048, scr, gw, ngw, lane);
}
__device__ void ph_xa_from(const Params& p, const float* src, int l, int which  , bf16_t* XA, float* rowss, bool write_xa) {
    const float* mod = (const float*)(p.ws + WS_MOD);
    const float* g = (which == 0 ? p.norm_mix_g : p.norm_ffn_g) + l * DM;
    const int tid_ = TID(); const int lane = tid_ & 63, wv = tid_ >> 6;
    const int gw = blockIdx.x * (blockDim.x >> 6) + wv, ngw = gridDim.x * (blockDim.x >> 6);
    for (int row = gw; row < MTOK; row += ngw) {
        const int b = row / SEQ;
        const float* sc = mod + (size_t)(l * 4 + b) * 6144 + (which == 0 ? 1024 : 4096);
        float ss = 0.f;
#pragma unroll
        for (int j = 0; j < 4; ++j) {
            const int k = j * 256 + lane * 4;
            const f32x4 v = *(const f32x4*)(src + (size_t)row * DM + k);
            ss += v[0] * v[0] + v[1] * v[1] + v[2] * v[2] + v[3] * v[3];
            if (write_xa) {
                const f32x4 gv = *(const f32x4*)(g + k); const f32x4 sv = *(const f32x4*)(sc + k);
                uint2 o; o.x = pk2(v[0] * gv[0] * (1.f + sv[0]), v[1] * gv[1] * (1.f + sv[1])); o.y = pk2(v[2] * gv[2] * (1.f + sv[2]), v[3] * gv[3] * (1.f + sv[3]));
                *(uint2*)(XA + (size_t)row * DM + k) = o;
            }
        }
        ss = wave_sum(ss);
        if (lane < 16) rowss[(size_t)row * 16 + lane] = (lane == 0) ? ss : 0.f;
    }
}

namespace pg8 {
#define PG8_LAS __attribute__((address_space(3)))
typedef unsigned short bf16_t;
typedef short bf16x8 __attribute__((ext_vector_type(8)));
typedef float f32x4 __attribute__((ext_vector_type(4)));
typedef unsigned u32x4 __attribute__((ext_vector_type(4)));
constexpr int BM = 256, BK = 64, HALF = 128, HTB = HALF * BK * 2  , STAGE_BYTES = 8 * HTB, NXCD = 8, WGM = 8;

__host__ __device__ __forceinline__ int lds_byte(int r, int c) { const int st = (r >> 4) * 2 + (c >> 5), rr = r & 15, cc = c & 31, ob = rr * 64 + cc * 2; return st * 1024 + (ob ^ (((ob >> 9) & 1) << 5)); }
__host__ __device__ __forceinline__ void stage_rc(int b, int& R, int& C) { const int st = b / 1024, sb = b % 1024, swz = sb ^ (((sb >> 9) & 1) << 5); R = (st >> 1) * 16 + swz / 64; C = (st & 1) * 32 + (swz % 64) / 2; }
__host__ __device__ __forceinline__ int perm32(int rho) { const int n = rho >> 4, i = rho & 15; return 8 * (i >> 2) + 4 * n + (i & 3); }

struct Unit { int pm, pn; };
struct Gemm { const bf16_t* A; const bf16_t* Bt; int M, N, K; };

struct StaticOrder {
    int nM, nN, nwg, G, c;
    __host__ __device__ void init(int M, int N, int G_, int c_) { nM = M / BM; nN = N / BM; nwg = nM * nN; G = G_; c = c_; }
    __host__ __device__ bool next(int i, Unit& u) const {
        const long L = (long)i * G + c; if (L >= nwg) return false;
        int wgid = (int)L; { const int q = nwg / NXCD, r = nwg % NXCD, xcd = wgid % NXCD, off = wgid / NXCD; wgid = (xcd < r ? xcd * (q + 1) : r * (q + 1) + (xcd - r) * q) + off; }
        const int nig = WGM * nN, gid = wgid / nig, fm = gid * WGM, gsz = (nM - fm) < WGM ? (nM - fm) : WGM;
        u.pm = fm + ((wgid % nig) % gsz); u.pn = (wgid % nig) / gsz; return true;
    }
    __device__ __forceinline__ void a_ready(const Unit&) const {}
    __device__ __forceinline__ void done(const Unit&) const {}
};


__device__ __forceinline__ unsigned cvt_pk_bf16(float lo, float hi) { unsigned r; asm volatile("v_cvt_pk_bf16_f32 %0, %1, %2" : "=v"(r) : "v"(lo), "v"(hi)); return r; }
template <class Epi, class Sched, bool ALIGN_EPI = false, bool SP2 = false>
__device__ __forceinline__ void gemm_phase(PG8_LAS unsigned char* lds, const Gemm g, const Sched& S, const Epi& E) {
    const int tid = TID(), wid = __builtin_amdgcn_readfirstlane(tid >> 6), lane = tid & 63, wr = wid >> 2, wc = wid & 3, fr = lane & 15, fq = lane >> 4;
    const int K = g.K, nt = K / BK;
    unsigned voffA[2], voffB[2];
#pragma unroll
    for (int i = 0; i < 2; ++i) { int R, C; stage_rc(tid * 16 + i * 8192, R, C); const int Rb = Epi::PERM ? ((R & ~31) + perm32(R & 31)) : R;
        voffA[i] = (unsigned)(R * K + C) * 2u; voffB[i] = (unsigned)(Rb * K + C) * 2u; }
    const size_t kstep = (size_t)(BK * 2);
    const size_t hstep = (size_t)HALF * K * 2;
    const size_t tstep = 2 * hstep;
    const unsigned ldsw = (unsigned)wid * 1024u;
    const int aoff = lds_byte(wr * 64 + fr, fq * 8), boff = lds_byte(wc * 32 + fr, fq * 8);
#define PG8_SA(b, h) (((b) * 2 + (h)) * HTB)
#define PG8_SB(b, h) ((4 + (b) * 2 + (h)) * HTB)
#define PG8_STAGE(bufoff, gbase, voff) do { _Pragma("unroll") for (int _i = 0; _i < 2; ++_i) \
        __builtin_amdgcn_global_load_lds((const unsigned*)((const char*)(gbase) + (voff)[_i]), (PG8_LAS unsigned*)(lds + (bufoff) + ldsw + _i * 8192), 16, 0, 0); } while (0)
#define PG8_LDA(dst, b, h) do { _Pragma("unroll") for (int m = 0; m < 4; ++m) _Pragma("unroll") for (int k = 0; k < 2; ++k) dst[m][k] = *(const PG8_LAS bf16x8*)(lds + PG8_SA(b, h) + aoff + m * 2048 + k * 1024); } while (0)
#define PG8_LDB(dst, b, h) do { _Pragma("unroll") for (int n = 0; n < 2; ++n) _Pragma("unroll") for (int k = 0; k < 2; ++k) dst[n][k] = *(const PG8_LAS bf16x8*)(lds + PG8_SB(b, h) + boff + n * 2048 + k * 1024); } while (0)
#define PG8_MMA(ai, bj, At, Bt) do { __builtin_amdgcn_s_setprio(1); _Pragma("unroll") for (int m = 0; m < 4; ++m) _Pragma("unroll") for (int n = 0; n < 2; ++n) _Pragma("unroll") for (int k = 0; k < 2; ++k) \
        acc[ai][bj][m][n] = __builtin_amdgcn_mfma_f32_16x16x32_bf16(Bt[n][k], At[m][k], acc[ai][bj][m][n], 0, 0, 0); __builtin_amdgcn_s_setprio(0); } while (0)
#define PG8_WAIT_V(n) asm volatile("s_waitcnt vmcnt(" #n ")" ::: "memory")
#define PG8_WAIT_L(n) asm volatile("s_waitcnt lgkmcnt(" #n ")" ::: "memory")
#define PG8_BAR __builtin_amdgcn_s_barrier()
#define PG8_SCHED __builtin_amdgcn_sched_barrier(0)
    Unit cur, nxt; int ui = 0;
    if (!S.next(0, cur)) return;
    f32x4 acc[2][2][4][2];
#pragma unroll
    for (int a = 0; a < 2; ++a)
#pragma unroll
        for (int b = 0; b < 2; ++b)
#pragma unroll
            for (int m = 0; m < 4; ++m)
#pragma unroll
                for (int n = 0; n < 2; ++n) acc[a][b][m][n] = (f32x4){0.f, 0.f, 0.f, 0.f};
    bf16x8 At[4][2], B0[2][2], B1[2][2];
    const char* cA = (const char*)g.A + (size_t)cur.pm * tstep; const char* cB = (const char*)g.Bt + (size_t)cur.pn * tstep;
    S.a_ready(cur);
    if constexpr (SP2) {
        PG8_STAGE(PG8_SB(0, 0), cB, voffB); PG8_STAGE(PG8_SB(0, 1), cB + hstep, voffB); PG8_STAGE(PG8_SA(0, 0), cA, voffA); PG8_STAGE(PG8_SA(0, 1), cA + hstep, voffA);
        if (wr == 1) PG8_BAR;
        PG8_WAIT_V(2); PG8_BAR;
        PG8_STAGE(PG8_SB(1, 0), cB + kstep, voffB); PG8_STAGE(PG8_SA(1, 0), cA + kstep, voffA); PG8_STAGE(PG8_SB(1, 1), cB + hstep + kstep, voffB);
        PG8_WAIT_V(6); PG8_BAR;
    } else {
        PG8_STAGE(PG8_SB(0, 0), cB, voffB); PG8_STAGE(PG8_SA(0, 0), cA, voffA); PG8_STAGE(PG8_SB(0, 1), cB + hstep, voffB); PG8_STAGE(PG8_SA(0, 1), cA + hstep, voffA);
        if (wr == 1) PG8_BAR;
        PG8_WAIT_V(4); PG8_BAR;
        PG8_STAGE(PG8_SB(1, 0), cB + kstep, voffB); PG8_STAGE(PG8_SA(1, 0), cA + kstep, voffA); PG8_STAGE(PG8_SB(1, 1), cB + hstep + kstep, voffB);
        PG8_WAIT_V(6); PG8_BAR;
    }
    for (;;) {
        const bool has_next = S.next(ui + 1, nxt);
        const char* nA = has_next ? (const char*)g.A + (size_t)nxt.pm * tstep : cA; const char* nB = has_next ? (const char*)g.Bt + (size_t)nxt.pn * tstep : cB;
        for (int t = 0; t < nt; t += 2) {
            const bool last = (t == nt - 2);
            const char* a1 = cA + (size_t)(t + 1) * kstep;
            const char* a2 = last ? nA : cA + (size_t)(t + 2) * kstep; const char* b2 = last ? nB : cB + (size_t)(t + 2) * kstep;
            const char* a3 = a2 + kstep; const char* b3 = b2 + kstep;
            if (last && has_next) S.a_ready(nxt);
            if constexpr (SP2) {
            PG8_LDB(B0, 0, 0); PG8_LDB(B1, 0, 1); PG8_SCHED; PG8_LDA(At, 0, 0); PG8_STAGE(PG8_SA(1, 1), a1 + hstep, voffA);
            PG8_WAIT_V(8); PG8_WAIT_L(0); PG8_BAR; PG8_MMA(0, 0, At, B0); PG8_MMA(0, 1, At, B1); PG8_BAR; PG8_SCHED;
            PG8_LDA(At, 0, 1); PG8_STAGE(PG8_SB(0, 0), b2, voffB); PG8_STAGE(PG8_SB(0, 1), b2 + hstep, voffB); PG8_STAGE(PG8_SA(0, 0), a2, voffA);
            PG8_WAIT_V(8); PG8_WAIT_L(0); PG8_BAR; PG8_MMA(1, 0, At, B0); PG8_MMA(1, 1, At, B1); PG8_BAR; PG8_SCHED;
            PG8_LDB(B0, 1, 0); PG8_LDB(B1, 1, 1); PG8_SCHED; PG8_LDA(At, 1, 0); PG8_STAGE(PG8_SA(0, 1), a2 + hstep, voffA);
            PG8_WAIT_V(8); PG8_WAIT_L(0); PG8_BAR; PG8_MMA(0, 0, At, B0); PG8_MMA(0, 1, At, B1); PG8_BAR; PG8_SCHED;
            PG8_LDA(At, 1, 1); PG8_STAGE(PG8_SB(1, 0), b3, voffB); PG8_STAGE(PG8_SB(1, 1), b3 + hstep, voffB); PG8_STAGE(PG8_SA(1, 0), a3, voffA);
            PG8_WAIT_V(8); PG8_WAIT_L(0); PG8_BAR; PG8_MMA(1, 0, At, B0); PG8_MMA(1, 1, At, B1); PG8_BAR; PG8_SCHED;
            } else {
            PG8_LDB(B0, 0, 0); PG8_SCHED; PG8_LDA(At, 0, 0); PG8_STAGE(PG8_SA(1, 1), a1 + hstep, voffA);
            PG8_WAIT_L(8); PG8_BAR; PG8_WAIT_L(0); PG8_MMA(0, 0, At, B0); PG8_BAR; PG8_SCHED;
            PG8_LDB(B1, 0, 1); PG8_STAGE(PG8_SB(0, 0), b2, voffB);
            PG8_BAR; PG8_WAIT_L(0); PG8_MMA(0, 1, At, B1); PG8_BAR;
            PG8_LDA(At, 0, 1); PG8_STAGE(PG8_SA(0, 0), a2, voffA);
            PG8_BAR; PG8_WAIT_L(0); PG8_MMA(1, 0, At, B0); PG8_BAR; PG8_SCHED;
            PG8_STAGE(PG8_SB(0, 1), b2 + hstep, voffB);
            PG8_WAIT_V(6); PG8_BAR; PG8_MMA(1, 1, At, B1); PG8_BAR;
            PG8_LDB(B0, 1, 0); PG8_SCHED; PG8_LDA(At, 1, 0); PG8_STAGE(PG8_SA(0, 1), a2 + hstep, voffA);
            PG8_WAIT_L(8); PG8_BAR; PG8_WAIT_L(0); PG8_MMA(0, 0, At, B0); PG8_BAR; PG8_SCHED;
            PG8_LDB(B1, 1, 1); PG8_STAGE(PG8_SB(1, 0), b3, voffB);
            PG8_BAR; PG8_WAIT_L(0); PG8_MMA(0, 1, At, B1); PG8_BAR;
            PG8_LDA(At, 1, 1); PG8_STAGE(PG8_SA(1, 0), a3, voffA);
            PG8_BAR; PG8_WAIT_L(0); PG8_MMA(1, 0, At, B0); PG8_BAR; PG8_SCHED;
            PG8_STAGE(PG8_SB(1, 1), b3 + hstep, voffB);
            PG8_WAIT_V(6); PG8_BAR; PG8_MMA(1, 1, At, B1); PG8_BAR;
            }
        }
        if constexpr (ALIGN_EPI) { if (wr == 0) PG8_BAR; }
        if constexpr (!Epi::AFTER_DRAIN) { E(acc, cur, wr, wc, fr, fq); S.done(cur); }
        if (!has_next) break;
#pragma unroll
        for (int a = 0; a < 2; ++a)
#pragma unroll
            for (int b = 0; b < 2; ++b)
#pragma unroll
                for (int m = 0; m < 4; ++m)
#pragma unroll
                    for (int n = 0; n < 2; ++n) acc[a][b][m][n] = (f32x4){0.f, 0.f, 0.f, 0.f};
        cur = nxt; cA = nA; cB = nB; ++ui;
        if constexpr (ALIGN_EPI) { if (wr == 1) PG8_BAR; }
    }
    PG8_WAIT_V(0);
    if constexpr (!ALIGN_EPI) { if (wr == 0) PG8_BAR; }
    PG8_BAR;
    if constexpr (Epi::AFTER_DRAIN) { E.fused(acc, cur, wr, wc, fr, fq, lds, wid, lane); S.done(cur); }
#undef PG8_SA
#undef PG8_SB
#undef PG8_STAGE
#undef PG8_LDA
#undef PG8_LDB
#undef PG8_MMA
#undef PG8_WAIT_V
#undef PG8_WAIT_L
#undef PG8_BAR
#undef PG8_SCHED
}
}

#ifndef PG8_SP2
#define PG8_SP2 true
#endif
#ifndef PG8_ALIGN
#define PG8_ALIGN true
#endif

__device__ __forceinline__ float row_rstd16(const float* rowss, int row) {
    const f32x4* r = (const f32x4*)(rowss + (size_t)row * 16);
    const f32x4 a = r[0], b = r[1], c = r[2], d = r[3];
    const float s = ((a[0] + a[1]) + (a[2] + a[3])) + ((b[0] + b[1]) + (b[2] + b[3])) + ((c[0] + c[1]) + (c[2] + c[3])) + ((d[0] + d[1]) + (d[2] + d[3]));
    return rsqrtf(s * (1.f / DM) + EPS);
}
struct EpiProjF {
    static constexpr bool PERM = true, AFTER_DRAIN = false;
    const float* rowss; const float* cb; bf16_t* proj; float* side;
    __device__ __forceinline__ void operator()(const pg8::f32x4 (&acc)[2][2][4][2], const pg8::Unit& u, int wr, int wc, int fr, int fq) const {
        const int b = u.pm >> 4, colt = u.pn * 256 + wc * 32 + 8 * fq;
        f32x4 cv[2][2];
#pragma unroll
        for (int bj = 0; bj < 2; ++bj)
#pragma unroll
            for (int n = 0; n < 2; ++n) cv[bj][n] = *(const f32x4*)(cb + b * PINP + colt + bj * 128 + 4 * n);
#pragma unroll
        for (int ai = 0; ai < 2; ++ai)
#pragma unroll
            for (int m = 0; m < 4; ++m) {
                const int row = u.pm * 256 + ai * 128 + wr * 64 + m * 16 + fr; const float rs = row_rstd16(rowss, row);
#pragma unroll
                for (int bj = 0; bj < 2; ++bj) {
                    const f32x4 v0 = acc[ai][bj][m][0] * rs + cv[bj][0], v1 = acc[ai][bj][m][1] * rs + cv[bj][1]; const int col0 = colt + bj * 128;
                    u32x4 w; w[0] = pg8::cvt_pk_bf16(v0[0], v0[1]); w[1] = pg8::cvt_pk_bf16(v0[2], v0[3]); w[2] = pg8::cvt_pk_bf16(v1[0], v1[1]); w[3] = pg8::cvt_pk_bf16(v1[2], v1[3]);
                    *(u32x4*)(proj + (size_t)row * PINP + col0) = w;
                    if (col0 >= C_BF && col0 < PIN) { *(f32x4*)(side + (size_t)row * 16 + (col0 - C_BF)) = v0; *(f32x4*)(side + (size_t)row * 16 + (col0 - C_BF) + 4) = v1; }
                }
            }
    }
};
struct EpiUpF {
    static constexpr bool PERM = true, AFTER_DRAIN = false;
    const float* rowss; const float* cb; bf16_t* ug; bf16_t* uv;
    __device__ __forceinline__ void operator()(const pg8::f32x4 (&acc)[2][2][4][2], const pg8::Unit& u, int wr, int wc, int fr, int fq) const {
        const int b = u.pm >> 4, colt = u.pn * 256 + wc * 32 + 8 * fq, oc = u.pn * 128 + wc * 32 + 8 * fq;
        f32x4 cv[2][2];
#pragma unroll
        for (int bj = 0; bj < 2; ++bj)
#pragma unroll
            for (int n = 0; n < 2; ++n) cv[bj][n] = *(const f32x4*)(cb + b * NUP + colt + bj * 128 + 4 * n);
#pragma unroll
        for (int ai = 0; ai < 2; ++ai)
#pragma unroll
            for (int m = 0; m < 4; ++m) {
                const int row = u.pm * 256 + ai * 128 + wr * 64 + m * 16 + fr; const float rs = row_rstd16(rowss, row);
#pragma unroll
                for (int bj = 0; bj < 2; ++bj) {
                    const f32x4 v0 = acc[ai][bj][m][0] * rs + cv[bj][0], v1 = acc[ai][bj][m][1] * rs + cv[bj][1];
                    u32x4 w; w[0] = pg8::cvt_pk_bf16(v0[0], v0[1]); w[1] = pg8::cvt_pk_bf16(v0[2], v0[3]); w[2] = pg8::cvt_pk_bf16(v1[0], v1[1]); w[3] = pg8::cvt_pk_bf16(v1[2], v1[3]);
                    *(u32x4*)((bj ? uv : ug) + (size_t)row * DFF + oc) = w;
                }
            }
    }
};
struct EpiResF {
    static constexpr bool PERM = false, AFTER_DRAIN = false;
    const float* xin; float* xout; const float* gate; const float* g; const float* sc; bf16_t* xa; float* rowss;
    __device__ __forceinline__ void operator()(const pg8::f32x4 (&acc)[2][2][4][2], const pg8::Unit& u, int wr, int wc, int fr, int fq) const {
        const int b = u.pm >> 4, col0 = u.pn * 256 + wc * 32 + 4 * fq;
        f32x4 gt[2][2], gm[2][2];
#pragma unroll
        for (int bj = 0; bj < 2; ++bj)
#pragma unroll
            for (int n = 0; n < 2; ++n) { const int c = col0 + bj * 128 + n * 16; gt[bj][n] = *(const f32x4*)(gate + b * 6144 + c);
                if (xa) gm[bj][n] = *(const f32x4*)(g + c) * (*(const f32x4*)(sc + b * 6144 + c) + 1.0f); else gm[bj][n] = (f32x4){0.f, 0.f, 0.f, 0.f}; }
#pragma unroll
        for (int ai = 0; ai < 2; ++ai)
#pragma unroll
            for (int m = 0; m < 4; ++m) {
                const int row = u.pm * 256 + ai * 128 + wr * 64 + m * 16 + fr; float ss = 0.f;
#pragma unroll
                for (int bj = 0; bj < 2; ++bj)
#pragma unroll
                    for (int n = 0; n < 2; ++n) { const size_t off = (size_t)row * DM + col0 + bj * 128 + n * 16;
                        const f32x4 o = *(const f32x4*)(xin + off) + gt[bj][n] * acc[ai][bj][m][n];
                        *(f32x4*)(xout + off) = o; ss += (o[0] * o[0] + o[1] * o[1]) + (o[2] * o[2] + o[3] * o[3]);
                        if (xa) { const f32x4 q = o * gm[bj][n]; uint2 w; w.x = pg8::cvt_pk_bf16(q[0], q[1]); w.y = pg8::cvt_pk_bf16(q[2], q[3]); *(uint2*)(xa + off) = w; } }
                if (rowss) { ss += __shfl_xor(ss, 16); ss += __shfl_xor(ss, 32); if (fq == 0) rowss[(size_t)row * 16 + u.pn * 4 + wc] = ss; }
            }
    }
};

__device__ void ph_prep_knorm(const Params& p, int l) {
    bf16_t* proj = (bf16_t*)(p.ws + WS_PROJ);
    const int tid_ = TID(); const int lane = tid_ & 63, wv = tid_ >> 6;
    const int gw = blockIdx.x * (blockDim.x >> 6) + wv, ngw = gridDim.x * (blockDim.x >> 6);
    for (int row = gw; row < MTOK; row += ngw) {
        bf16_t* pr = proj + (size_t)row * PINP;
        {
            uint2 raw = *(const uint2*)(pr + CA_K + 4 * lane);
            float v0 = bf2f(raw.x & 0xffff), v1 = bf2f(raw.x >> 16), v2 = bf2f(raw.y & 0xffff), v3 = bf2f(raw.y >> 16);
            float ss = v0 * v0 + v1 * v1 + v2 * v2 + v3 * v3;
            ss += __shfl_xor(ss, 1); ss += __shfl_xor(ss, 2); ss += __shfl_xor(ss, 4);
            const float r = rsqrtf(ss * (1.f / 32.f) + EPS); const float* g = p.diff_kn + l * 32 + ((4 * lane) & 31);
            raw.x = pk2(v0 * r * g[0], v1 * r * g[1]); raw.y = pk2(v2 * r * g[2], v3 * r * g[3]);
            *(uint2*)(pr + CA_K + 4 * lane) = raw;
        }
        {
            uint2 raw = *(const uint2*)(pr + CB_K + 4 * lane);
            float v0 = bf2f(raw.x & 0xffff), v1 = bf2f(raw.x >> 16), v2 = bf2f(raw.y & 0xffff), v3 = bf2f(raw.y >> 16);
            float ss = v0 * v0 + v1 * v1 + v2 * v2 + v3 * v3;
            ss += __shfl_xor(ss, 1); ss += __shfl_xor(ss, 2); ss += __shfl_xor(ss, 4); ss += __shfl_xor(ss, 8);
            const float r = rsqrtf(ss * (1.f / 64.f) + EPS); const float* g = p.fox_kn + l * 64 + ((4 * lane) & 63);
            raw.x = pk2(v0 * r * g[0], v1 * r * g[1]); raw.y = pk2(v2 * r * g[2], v3 * r * g[3]);
            *(uint2*)(pr + CB_K + 4 * lane) = raw;
        }
        {
            const int hi = lane >> 5, li = lane & 31; bf16_t* q = pr + (hi ? CD_KW : CD_KS) + 2 * li;
            unsigned raw = *(const unsigned*)q; float v0 = bf2f(raw & 0xffff), v1 = bf2f(raw >> 16);
            float ss = v0 * v0 + v1 * v1;
            ss += __shfl_xor(ss, 1); ss += __shfl_xor(ss, 2); ss += __shfl_xor(ss, 4); ss += __shfl_xor(ss, 8); ss += __shfl_xor(ss, 16);
            const float r = rsqrtf(ss * (1.f / 64.f) + EPS); const float* g = p.nsa_kn + (l * 3 + (hi ? 2 : 1)) * 64 + 2 * li;
            *(unsigned*)q = pk2(v0 * r * g[0], v1 * r * g[1]);
        }
    }
}
__device__ void ph_prep_cum_bh(const Params& p, int l, int bh, unsigned char* lds) {
    const float* side = (const float*)(p.ws + WS_SIDE);
    float* cum = (float*)(p.ws + WS_CUM);
    LDSF float* wt = (LDSF float*)(lds + 70000);
    const int tid = TID(), lane = tid & 63, wv = tid >> 6;
    {
        const int b = bh >> 2, h = bh & 3; const float bf = p.fox_bf[l * 4 + h];
        float v[8]; float tot = 0.f;
#pragma unroll
        for (int i = 0; i < 8; ++i) { v[i] = logsigf(side[(size_t)(b * SEQ + tid * 8 + i) * 16 + h] + bf); tot += v[i]; v[i] = tot; }
        float inc = tot;
#pragma unroll
        for (int o = 1; o < 64; o <<= 1) { const float u = __shfl_up(inc, o); if (lane >= o) inc += u; }
        __syncthreads();
        if (lane == 63) wt[wv] = inc;
        __syncthreads();
        float base = inc - tot;
        for (int w8 = 0; w8 < wv; ++w8) base += wt[w8];
#pragma unroll
        for (int i = 0; i < 8; ++i) cum[bh * SEQ + tid * 8 + i] = base + v[i];
    }
}
__device__ void ph_prep_cmp(const Params& p, int l, unsigned char* lds) {
    const bf16_t* proj = (const bf16_t*)(p.ws + WS_PROJ);
    float* win = (float*)lds; float* red = (float*)(lds + 36864);
    const int tid = TID(), e = tid & 63, part = tid >> 6;
    for (int item = blockIdx.x; item < 4 * 2 * 32; item += gridDim.x) {
        const int b = item >> 6, which = (item >> 5) & 1, n0 = (item & 31) * 8;
        const int colbase = which ? CD_VC : CD_KC;
        __syncthreads();
        for (int i = tid; i < 144 * 64; i += NTHR) { const int tk = 16 * n0 + (i >> 6); win[i] = tk < SEQ ? bf2f(proj[(size_t)(b * SEQ + tk) * PINP + colbase + (i & 63)]) : 0.f; }
        __syncthreads();
        float acc[8];
#pragma unroll
        for (int nn = 0; nn < 8; ++nn) acc[nn] = 0.f;
        const float* phi = p.nsa_phi + (size_t)(l * 2 + which) * 2048 * 64; const float* pe = p.nsa_pe + (size_t)(l * 2 + which) * 32 * 64;
        for (int i = 4 * part; i < 4 * part + 4; ++i)
            for (int d = 0; d < 64; ++d) {
                const float ph = phi[(size_t)(i * 64 + d) * 64 + e], pv = pe[i * 64 + d];
#pragma unroll
                for (int nn = 0; nn < 8; ++nn) acc[nn] += (win[(16 * nn + i) * 64 + d] + pv) * ph;
            }
#pragma unroll
        for (int nn = 0; nn < 8; ++nn) red[(part * 8 + nn) * 64 + e] = acc[nn];
        __syncthreads();
        {
            const int nn = part, n = n0 + nn; float v = 0.f;
#pragma unroll
            for (int pp = 0; pp < 8; ++pp) v += red[(pp * 8 + nn) * 64 + e];
            bf16_t* dst = (bf16_t*)(p.ws + (which ? WS_VC : WS_KC)) + (size_t)(b * 256 + n) * 64 + e;
            if (n >= 255) *dst = 0;
            else if (which == 0) { const float ss = wave_sum(v * v); *dst = f2bf(v * rsqrtf(ss * (1.f / 64.f) + EPS) * p.nsa_kn[(l * 3 + 0) * 64 + e]); }
            else *dst = f2bf(v);
        }
    }
}

__device__ __forceinline__ void load8(const bf16_t* p, float* d) {
    const u32x4 r = *(const u32x4*)p;
    d[0] = bf2f(r[0] & 0xffff); d[1] = bf2f(r[0] >> 16); d[2] = bf2f(r[1] & 0xffff); d[3] = bf2f(r[1] >> 16);
    d[4] = bf2f(r[2] & 0xffff); d[5] = bf2f(r[2] >> 16); d[6] = bf2f(r[3] & 0xffff); d[7] = bf2f(r[3] >> 16);
}
template <int N> __device__ __forceinline__ float dotn(const float* q, const bf16_t* k) {
    float s = 0.f;
#pragma unroll
    for (int c = 0; c < N / 8; ++c) { float t[8]; load8(k + 8 * c, t);
#pragma unroll
        for (int j = 0; j < 8; ++j) s += q[8 * c + j] * t[j]; }
    return s;
}
template <int N> __device__ __forceinline__ void axpyn(float* o, float w, const bf16_t* v) {
#pragma unroll
    for (int c = 0; c < N / 8; ++c) { float t[8]; load8(v + 8 * c, t);
#pragma unroll
        for (int j = 0; j < 8; ++j) o[8 * c + j] += w * t[j]; }
}
template <int N> __device__ __forceinline__ void loadq_norm(float* q, const bf16_t* src, const float* g, float scale, bool norm) {
    float ss = 0.f;
#pragma unroll
    for (int c = 0; c < N / 8; ++c) load8(src + 8 * c, q + 8 * c);
#pragma unroll
    for (int j = 0; j < N; ++j) ss += q[j] * q[j];
    const float r = norm ? rsqrtf(ss * (1.f / N) + EPS) : 1.f;
#pragma unroll
    for (int j = 0; j < N; ++j) q[j] = q[j] * r * (norm ? g[j] : 1.f) * scale;
}
__device__ __forceinline__ void store64(bf16_t* dst, const float* o) {
#pragma unroll
    for (int c = 0; c < 8; ++c) { u32x4 w; w[0] = pk2(o[8 * c], o[8 * c + 1]); w[1] = pk2(o[8 * c + 2], o[8 * c + 3]); w[2] = pk2(o[8 * c + 4], o[8 * c + 5]); w[3] = pk2(o[8 * c + 6], o[8 * c + 7]); *(u32x4*)(dst + 8 * c) = w; }
}

typedef float f32x16 __attribute__((ext_vector_type(16)));
typedef short s16x4 __attribute__((ext_vector_type(4)));
#define LDSP __attribute__((address_space(3)))
constexpr int KSTR = 144;
constexpr int AL_KV = 17408;
constexpr int AL_BK = 2 * AL_KV  , AL_TB = AL_BK + 512  , AL_WSF = AL_TB + 512  , AL_MISC = AL_WSF + 2048  ,
              AL_IMP = 38912  , AL_SELM = AL_IMP + 65536  ,
              AL_TB4 = AL_SELM + 512  , AL_INVL = AL_TB4 + 2048  , AL_D_END = AL_INVL + 1024;
static_assert(AL_MISC + 64 <= AL_IMP && AL_D_END <= 131072, "attention LDS map");
__device__ __forceinline__ int crow(int r, int hi) { return (r & 3) + 8 * (r >> 2) + 4 * hi; }
__device__ __forceinline__ float ex2(float v) { return __builtin_amdgcn_exp2f(v); }
__device__ __forceinline__ s16x4 vtr(const LDSP unsigned char* p) { typedef short v4i16_t __attribute__((ext_vector_type(4))); return __builtin_bit_cast(s16x4, __builtin_amdgcn_ds_read_tr16_b64_v4i16((LDSP v4i16_t*)p)); }
__device__ __forceinline__ bf16x8 pack8(const f32x16& p, int b) {
    u32x4 w; w[0] = pg8::cvt_pk_bf16(p[b], p[b + 1]); w[1] = pg8::cvt_pk_bf16(p[b + 2], p[b + 3]); w[2] = pg8::cvt_pk_bf16(p[b + 4], p[b + 5]); w[3] = pg8::cvt_pk_bf16(p[b + 6], p[b + 7]);
    return __builtin_bit_cast(bf16x8, w);
}
__device__ __forceinline__ f32x16 splat16(float v) { return (f32x16){v, v, v, v, v, v, v, v, v, v, v, v, v, v, v, v}; }
template <int NK16>
__device__ __forceinline__ void qkt(f32x16& p0, f32x16& p1, const LDSP unsigned char* Kt, const bf16x8* qf, int dbase, int r32, int hi) {
    const LDSP unsigned char* kb = Kt + r32 * KSTR + hi * 16 + dbase * 32;
#pragma unroll
    for (int d0 = 0; d0 < NK16; ++d0) {
        const bf16x8 a0 = *(const LDSP bf16x8*)(kb + d0 * 32), a1 = *(const LDSP bf16x8*)(kb + 32 * KSTR + d0 * 32);
        p0 = __builtin_amdgcn_mfma_f32_32x32x16_bf16(a0, qf[d0], p0, 0, 0, 0);
        p1 = __builtin_amdgcn_mfma_f32_32x32x16_bf16(a1, qf[d0], p1, 0, 0, 0);
    }
}
__device__ __forceinline__ void pv(f32x16* o, const LDSP unsigned char* Vt, int vb, const f32x16& p0, const f32x16& p1) {
    bf16x8 pa[4]; pa[0] = pack8(p0, 0); pa[1] = pack8(p0, 8); pa[2] = pack8(p1, 0); pa[3] = pack8(p1, 8);
#pragma unroll
    for (int d0 = 0; d0 < 2; ++d0)
#pragma unroll
        for (int ks = 0; ks < 4; ++ks) {
            const s16x4 lo = vtr(Vt + vb + d0 * 4096 + ks * 1024), hh = vtr(Vt + vb + d0 * 4096 + ks * 1024 + 512);
            const bf16x8 vf = (bf16x8){lo[0], lo[1], lo[2], lo[3], hh[0], hh[1], hh[2], hh[3]};
            o[d0] = __builtin_amdgcn_mfma_f32_32x32x16_bf16(pa[ks], vf, o[d0], 0, 0, 0);
        }
}
__device__ __forceinline__ float exp_sum(f32x16& p0, f32x16& p1) {
    float s0 = 0.f, s1 = 0.f;
#pragma unroll
    for (int r = 0; r < 16; ++r) { p0[r] = ex2(p0[r]); p1[r] = ex2(p1[r]); s0 += p0[r]; s1 += p1[r]; }
    return s0 + s1;
}
__device__ __forceinline__ void scale_rows(f32x16* o, float f, LDSP float* wsf, int r32, int hi) {
    __builtin_amdgcn_wave_barrier();
    if (hi == 0) wsf[r32] = f;
    __builtin_amdgcn_s_waitcnt(0xc07f);
    __builtin_amdgcn_wave_barrier();
#pragma unroll
    for (int g = 0; g < 4; ++g) { const f32x4 a = *(const LDSP f32x4*)(wsf + 8 * g + 4 * hi);
#pragma unroll
        for (int i = 0; i < 4; ++i) { o[0][4 * g + i] *= a[i]; o[1][4 * g + i] *= a[i]; } }
    __builtin_amdgcn_wave_barrier();
}
__device__ __forceinline__ void store_o(const f32x16* o, LDSP bf16_t* stg, bf16_t* dst, int lane, int r32, int hi) {
    __builtin_amdgcn_wave_barrier();
#pragma unroll
    for (int r = 0; r < 16; ++r) { const int orow = crow(r, hi); stg[orow * 64 + r32] = f2bf(o[0][r]); stg[orow * 64 + 32 + r32] = f2bf(o[1][r]); }
    __builtin_amdgcn_s_waitcnt(0xc07f);
    __builtin_amdgcn_wave_barrier();
#pragma unroll
    for (int i = 0; i < 4; ++i) { const int row = i * 8 + (lane >> 3), ch = lane & 7; const u32x4 v = *(const LDSP u32x4*)(stg + row * 64 + ch * 8); *(u32x4*)(dst + (size_t)row * DM + ch * 8) = v; }
    __builtin_amdgcn_s_waitcnt(0xc07f);
    __builtin_amdgcn_wave_barrier();
}
template <int NG>
__device__ __forceinline__ void load_q(bf16x8* qf, const bf16_t* qrow  , const float* g, float sc, bool norm, int hi) {
    float v[4][8];
#pragma unroll
    for (int d0 = 0; d0 < 4; ++d0) load8(qrow + 16 * d0 + 8 * hi, v[d0]);
    float r0 = 1.f, r1 = 1.f;
    if (norm) {
        float s0 = 0.f, s1 = 0.f;
#pragma unroll
        for (int j = 0; j < 8; ++j) { s0 += v[0][j] * v[0][j] + v[1][j] * v[1][j]; s1 += v[2][j] * v[2][j] + v[3][j] * v[3][j]; }
        s0 += __shfl_xor(s0, 32); s1 += __shfl_xor(s1, 32);
        if (NG == 64) { r0 = rsqrtf((s0 + s1) * (1.f / 64.f) + EPS); r1 = r0; } else { r0 = rsqrtf(s0 * (1.f / 32.f) + EPS); r1 = rsqrtf(s1 * (1.f / 32.f) + EPS); }
    }
#pragma unroll
    for (int d0 = 0; d0 < 4; ++d0) {
        const float rr = (d0 < 2 ? r0 : r1) * sc; float w[8];
#pragma unroll
        for (int j = 0; j < 8; ++j) { const int d = 16 * d0 + 8 * hi + j; w[j] = v[d0][j] * rr * (norm ? g[d % NG] : 1.f); }
        u32x4 u; u[0] = pg8::cvt_pk_bf16(w[0], w[1]); u[1] = pg8::cvt_pk_bf16(w[2], w[3]); u[2] = pg8::cvt_pk_bf16(w[4], w[5]); u[3] = pg8::cvt_pk_bf16(w[6], w[7]);
        qf[d0] = __builtin_bit_cast(bf16x8, u);
    }
}
__device__ __forceinline__ void kv_load(u32x4& kr, u32x4& vr, const bf16_t* Kb, const bf16_t* Vb, int k0, int tid) {
    const size_t off = (size_t)(k0 + (tid >> 3)) * PINP + (tid & 7) * 8;
    kr = *(const u32x4*)(Kb + off); vr = *(const u32x4*)(Vb + off);
}
__device__ __forceinline__ void kv_load64(u32x4& kr, u32x4& vr, const bf16_t* Kb, const bf16_t* Vb, int n0, int tid) {
    const size_t off = (size_t)(n0 + (tid >> 3)) * 64 + (tid & 7) * 8;
    kr = *(const u32x4*)(Kb + off); vr = *(const u32x4*)(Vb + off);
}
__device__ __forceinline__ void kv_store(const u32x4& kr, const u32x4& vr, LDSP unsigned char* buf, int tid) {
    const int key = tid >> 3, ch = tid & 7;
    *(LDSP u32x4*)(buf + key * KSTR + ch * 16) = kr;
    *(LDSP u32x4*)(buf + 9216 + (ch >> 2) * 4096 + (key >> 4) * 1024 + ((key >> 3) & 1) * 512 + (key & 7) * 64 + (ch & 3) * 16) = vr;
}
template <int NG>
__device__ __forceinline__ void knorm_chunk(u32x4& kr, const float* gp  ) {
    float v[8];
    v[0] = bf2f(kr[0] & 0xffff); v[1] = bf2f(kr[0] >> 16); v[2] = bf2f(kr[1] & 0xffff); v[3] = bf2f(kr[1] >> 16);
    v[4] = bf2f(kr[2] & 0xffff); v[5] = bf2f(kr[2] >> 16); v[6] = bf2f(kr[3] & 0xffff); v[7] = bf2f(kr[3] >> 16);
    float ss = 0.f;
#pragma unroll
    for (int j = 0; j < 8; ++j) ss += v[j] * v[j];
    ss += __shfl_xor(ss, 1); ss += __shfl_xor(ss, 2); if (NG == 64) ss += __shfl_xor(ss, 4);
    const float r = rsqrtf(ss * (1.f / NG) + EPS);
    const f32x4 ga = *(const f32x4*)gp, gb = *(const f32x4*)(gp + 4);
    kr[0] = pg8::cvt_pk_bf16(v[0] * r * ga[0], v[1] * r * ga[1]); kr[1] = pg8::cvt_pk_bf16(v[2] * r * ga[2], v[3] * r * ga[3]);
    kr[2] = pg8::cvt_pk_bf16(v[4] * r * gb[0], v[5] * r * gb[1]); kr[3] = pg8::cvt_pk_bf16(v[6] * r * gb[2], v[7] * r * gb[3]);
}
__device__ __forceinline__ void bias_near(f32x16& p0, f32x16& p1, const LDSP float* tbl, int tk0  , int wnd, bool rowok, int hi) {
#pragma unroll
    for (int g = 0; g < 4; ++g) {
#pragma unroll
        for (int i = 0; i < 4; ++i) { const int r = 4 * g + i; const int d0_ = tk0 - crow(r, hi), d1_ = d0_ - 32;
            const float b0 = tbl[min(max(d0_, 0), 127)], b1 = tbl[min(max(d1_, 0), 127)];
            p0[r] = (d0_ < 0 || d0_ >= wnd || !rowok) ? -INFINITY : p0[r] + b0; p1[r] = (d1_ < 0 || d1_ >= wnd || !rowok) ? -INFINITY : p1[r] + b1; }
        asm volatile("" ::: "memory");
    }
}
#define KVBUF(L, i) ((L) + ((i) & 1) * AL_KV)

__device__ void fa_fox_unit(const Params& p, int l, int b, int h, int qb, LDSP unsigned char* L) {
    const int tid = TID(), lane = tid & 63, wid = __builtin_amdgcn_readfirstlane(tid >> 6), r32 = lane & 31, hi = lane >> 5;
    const bf16_t* proj = (const bf16_t*)(p.ws + WS_PROJ); bf16_t* mix = (bf16_t*)(p.ws + WS_MIX);
    const size_t rb = (size_t)b * SEQ; const int q0 = qb * 256, qw = q0 + 32 * wid, t = qw + r32;
    const bf16_t* Kb = proj + rb * PINP + CB_K + 64 * h; const bf16_t* Vb = proj + rb * PINP + CB_V + 64 * h;
    const float* cm = (const float*)(p.ws + WS_CUM) + (b * 4 + h) * SEQ;
    LDSP float* wsf = (LDSP float*)(L + AL_WSF) + wid * 64; LDSP float* bk = (LDSP float*)(L + AL_BK);
    const int vb = 9216 + ((lane >> 4) & 1) * 32 + (lane & 3) * 8 + (4 * hi + ((lane & 15) >> 2)) * 64;
    bf16x8 qf[4]; load_q<64>(qf, proj + (rb + t) * PINP + CB_Q + 64 * h, p.fox_qn + l * 64, 0.125f * LOG2E, true, hi);
    const float rowc = cm[t] * LOG2E - ((const float*)(p.ws + WS_BND))[l * 32 + 4];
    f32x16 o[2]; o[0] = (f32x16){}; o[1] = (f32x16){};
    float l_run = 0.f;
    const int NT = 4 * qb + 4, jd = 4 * qb + (wid >> 1);
    u32x4 kr, vr; float cr = 0.f; const float* gk = p.fox_kn + l * 64 + (tid & 7) * 8;
    __syncthreads();
    kv_load(kr, vr, Kb, Vb, 0, tid); if (tid < 64) cr = cm[tid];
    knorm_chunk<64>(kr, gk); kv_store(kr, vr, KVBUF(L, 0), tid); if (tid < 64) bk[tid] = -cr * LOG2E;
    kv_load(kr, vr, Kb, Vb, 64, tid); if (tid < 64) cr = cm[64 + tid];
    for (int j = 0; j < NT; ++j) {
        __syncthreads();
        if (j + 1 < NT) { knorm_chunk<64>(kr, gk); kv_store(kr, vr, KVBUF(L, j + 1), tid); if (tid < 64) bk[((j + 1) & 1) * 64 + tid] = -cr * LOG2E; }
        if (j + 2 < NT) { kv_load(kr, vr, Kb, Vb, 64 * (j + 2), tid); if (tid < 64) cr = cm[64 * (j + 2) + tid]; }
        if (j <= jd) {
            const LDSP unsigned char* buf = KVBUF(L, j); const LDSP float* bkj = bk + (j & 1) * 64;
            f32x16 p0, p1;
#pragma unroll
            for (int g = 0; g < 4; ++g) { const f32x4 b0 = *(const LDSP f32x4*)(bkj + 8 * g + 4 * hi), b1 = *(const LDSP f32x4*)(bkj + 32 + 8 * g + 4 * hi);
#pragma unroll
                for (int i = 0; i < 4; ++i) { p0[4 * g + i] = b0[i] + rowc; p1[4 * g + i] = b1[i] + rowc; } }
            qkt<4>(p0, p1, buf, qf, 0, r32, hi);
            if (j == jd) { const int k0 = 64 * j;
#pragma unroll
                for (int r = 0; r < 16; ++r) { const int kk = k0 + crow(r, hi); if (kk > t) p0[r] = -INFINITY; if (kk + 32 > t) p1[r] = -INFINITY; } }
            l_run += exp_sum(p0, p1);
            pv(o, buf, vb, p0, p1);
        }
    }
    l_run += __shfl_xor(l_run, 32);
    scale_rows(o, 1.f / l_run, wsf, r32, hi);
    store_o(o, (LDSP bf16_t*)(L + AL_IMP + wid * 8192), mix + (rb + qw) * DM + 256 + 64 * h, lane, r32, hi);
}

__device__ void fa_diff_unit(const Params& p, int l, int b, int h, int qb, LDSP unsigned char* L) {
    const int tid = TID(), lane = tid & 63, wid = __builtin_amdgcn_readfirstlane(tid >> 6), r32 = lane & 31, hi = lane >> 5;
    const bf16_t* proj = (const bf16_t*)(p.ws + WS_PROJ); bf16_t* mix = (bf16_t*)(p.ws + WS_MIX);
    const size_t rb = (size_t)b * SEQ; const int q0 = qb * 256, qw = q0 + 32 * wid, t = qw + r32;
    const bf16_t* Kb = proj + rb * PINP + CA_K + 64 * h; const bf16_t* Vb = proj + rb * PINP + CA_V + 64 * h;
    LDSP float* wsf = (LDSP float*)(L + AL_WSF) + wid * 64; LDSP float* tbl = (LDSP float*)(L + AL_TB);
    const int vb = 9216 + ((lane >> 4) & 1) * 32 + (lane & 3) * 8 + (4 * hi + ((lane & 15) >> 2)) * 64;
    const float lam = ((const float*)(p.ws + WS_LAM))[l]; const float lam_init = 0.8f - 0.6f * __expf(-0.3f * (float)l);
    const float nbound = -((const float*)(p.ws + WS_BND))[l * 32 + h];
    __syncthreads();
    if (tid < 128) tbl[tid] = ((const float*)(p.ws + WS_TB))[h * 128 + tid] * LOG2E;
    bf16x8 qf[4]; load_q<32>(qf, proj + (rb + t) * PINP + CA_Q + 64 * h, p.diff_qn + l * 32, 0.17677669529663687f * LOG2E, true, hi);
    f32x16 o1[2], o2[2]; o1[0] = (f32x16){}; o1[1] = (f32x16){}; o2[0] = (f32x16){}; o2[1] = (f32x16){};
    float l1 = 0.f, l2 = 0.f;
    const int NT = 4 * qb + 4, jd = 4 * qb + (wid >> 1);
    u32x4 kr, vr; const float* gk = p.diff_kn + l * 32 + (tid & 3) * 8;
    kv_load(kr, vr, Kb, Vb, 0, tid);
    knorm_chunk<32>(kr, gk); kv_store(kr, vr, KVBUF(L, 0), tid);
    kv_load(kr, vr, Kb, Vb, 64, tid);
    for (int j = 0; j < NT; ++j) {
        __syncthreads();
        if (j + 1 < NT) { knorm_chunk<32>(kr, gk); kv_store(kr, vr, KVBUF(L, j + 1), tid); }
        if (j + 2 < NT) kv_load(kr, vr, Kb, Vb, 64 * (j + 2), tid);
        if (j <= jd) {
            const LDSP unsigned char* buf = KVBUF(L, j);
            const int k0 = 64 * j; const bool nearb = (qw - (k0 + 63)) < 113; const float cfar = tbl[127] + nbound;
#pragma unroll
            for (int mp = 0; mp < 2; ++mp) {
                f32x16 p0 = splat16(nearb ? nbound : cfar), p1 = p0;
                qkt<2>(p0, p1, buf, qf + 2 * mp, 2 * mp, r32, hi);
                if (nearb) bias_near(p0, p1, tbl, t - k0, 1 << 30, true, hi);
                if (mp == 0) { l1 += exp_sum(p0, p1); pv(o1, buf, vb, p0, p1); }
                else { l2 += exp_sum(p0, p1); pv(o2, buf, vb, p0, p1); }
            }
        }
    }
    l1 += __shfl_xor(l1, 32); l2 += __shfl_xor(l2, 32);
    scale_rows(o1, 1.f / l1, wsf, r32, hi); scale_rows(o2, lam / l2, wsf, r32, hi);
    o1[0] -= o2[0]; o1[1] -= o2[1];
    const float g0 = p.diff_sub[l * 64 + r32] * (1.f - lam_init), g1 = p.diff_sub[l * 64 + 32 + r32] * (1.f - lam_init);
#pragma unroll
    for (int r = 0; r < 16; ++r) {
        float ss = o1[0][r] * o1[0][r] + o1[1][r] * o1[1][r];
        ss += __shfl_xor(ss, 1); ss += __shfl_xor(ss, 2); ss += __shfl_xor(ss, 4); ss += __shfl_xor(ss, 8); ss += __shfl_xor(ss, 16);
        const float rs = rsqrtf(ss * (1.f / 64.f) + EPS); o1[0][r] *= rs * g0; o1[1][r] *= rs * g1;
    }
    store_o(o1, (LDSP bf16_t*)(L + AL_IMP + wid * 8192), mix + (rb + qw) * DM + 0 + 64 * h, lane, r32, hi);
}

__device__ __forceinline__ void stick_sub(f32x16& y, float& carry, int kbase  , int t, bool diag, int hi) {
    float lk[16];
#pragma unroll
    for (int r = 0; r < 16; ++r) {
        const float v = y[r]; const float e = ex2(-fabsf(v)); const float lb = fminf(v, 0.f) - __builtin_amdgcn_logf(1.f + e);
        const bool valid = !diag || (kbase + crow(r, hi) < t);
        lk[r] = valid ? (lb - v) : 0.f; y[r] = valid ? lb : -INFINITY;
    }
    float T[4], Go[4];
#pragma unroll
    for (int g = 0; g < 4; ++g) { const float Gs = (lk[4 * g] + lk[4 * g + 1]) + (lk[4 * g + 2] + lk[4 * g + 3]); Go[g] = __shfl_xor(Gs, 32); T[g] = Gs + Go[g]; }
    float sx = 0.f;
#pragma unroll
    for (int g = 3; g >= 0; --g) {
        float tail = carry + sx + (hi == 0 ? Go[g] : 0.f);
#pragma unroll
        for (int i = 3; i >= 0; --i) { y[4 * g + i] = ex2(y[4 * g + i] + tail); tail += lk[4 * g + i]; }
        sx += T[g];
    }
    carry += sx;
}
__device__ void fa_stick_unit(const Params& p, int l, int b, int h, int qb, LDSP unsigned char* L) {
    const int tid = TID(), lane = tid & 63, wid = __builtin_amdgcn_readfirstlane(tid >> 6), r32 = lane & 31, hi = lane >> 5;
    const bf16_t* proj = (const bf16_t*)(p.ws + WS_PROJ); bf16_t* mix = (bf16_t*)(p.ws + WS_MIX);
    const size_t rb = (size_t)b * SEQ; const int q0 = qb * 256, qw = q0 + 32 * wid, t = qw + r32;
    const bf16_t* Kb = proj + rb * PINP + CC_K + 64 * h; const bf16_t* Vb = proj + rb * PINP + CC_V + 64 * h;
    const int vb = 9216 + ((lane >> 4) & 1) * 32 + (lane & 3) * 8 + (4 * hi + ((lane & 15) >> 2)) * 64;
    bf16x8 qf[4]; load_q<64>(qf, proj + (rb + t) * PINP + CC_Q + 64 * h, nullptr, 0.125f * LOG2E, false, hi);
    f32x16 o[2]; o[0] = (f32x16){}; o[1] = (f32x16){};
    float carry = 0.f;
    const int NT = 4 * qb + 4, jd = 4 * qb + (wid >> 1);
    u32x4 kr, vr;
    kv_load(kr, vr, Kb, Vb, 64 * (NT - 1), tid);
    for (int j = NT - 1; j >= 0; --j) {
        __syncthreads();
        kv_store(kr, vr, KVBUF(L, 0), tid);
        __syncthreads();
        if (j > 0) kv_load(kr, vr, Kb, Vb, 64 * (j - 1), tid);
        if (j <= jd) {
            const LDSP unsigned char* buf = KVBUF(L, 0);
            f32x16 p0 = (f32x16){}, p1 = (f32x16){};
            qkt<4>(p0, p1, buf, qf, 0, r32, hi);
            const int k0 = 64 * j; const bool diag = (j == jd);
            stick_sub(p1, carry, k0 + 32, t, diag, hi);
            stick_sub(p0, carry, k0, t, diag, hi);
            pv(o, buf, vb, p0, p1);
        }
    }
    store_o(o, (LDSP bf16_t*)(L + AL_IMP + wid * 8192), mix + (rb + qw) * DM + 512 + 64 * h, lane, r32, hi);
}

__device__ void fa_nsa_unit(const Params& p, int l, int b, int u, LDSP unsigned char* L) {
    const int tid = TID(), lane = tid & 63, wid = __builtin_amdgcn_readfirstlane(tid >> 6), r32 = lane & 31, hi = lane >> 5;
    const int hh = wid >> 1, sub = wid & 1;
    const bf16_t* proj = (const bf16_t*)(p.ws + WS_PROJ); bf16_t* mix = (bf16_t*)(p.ws + WS_MIX);
    const size_t rb = (size_t)b * SEQ; const int q0 = 64 * u, qw = q0 + 32 * sub, t = qw + r32; const int ql = 32 * sub + r32;
    LDSP float* wsf = (LDSP float*)(L + AL_WSF) + wid * 64; LDSP float* tbl = (LDSP float*)(L + AL_TB4) + hh * 128;
    LDSP float* imp = (LDSP float*)(L + AL_IMP); LDSP unsigned* selm = (LDSP unsigned*)(L + AL_SELM); LDSP float* invl = (LDSP float*)(L + AL_INVL);
    LDSP float* ofl = (LDSP float*)(L + AL_IMP) + wid * 2048 + lane;
    const int vb = 9216 + ((lane >> 4) & 1) * 32 + (lane & 3) * 8 + (4 * hi + ((lane & 15) >> 2)) * 64;
    const float* bnd = (const float*)(p.ws + WS_BND) + l * 32;
    __syncthreads();
    ((LDSP float*)(L + AL_TB4))[tid] = ((const float*)(p.ws + WS_TB))[512 + tid] * LOG2E;
    bf16x8 qf[4]; load_q<64>(qf, proj + (rb + t) * PINP + CD_Q + 64 * hh, p.nsa_qn + l * 64, 0.125f * LOG2E, true, hi);
    const float* sd = (const float*)(p.ws + WS_SIDE) + (rb + t) * 16 + 4 + hh;
    const float gc = 1.f / (1.f + __expf(-sd[0])), gs = 1.f / (1.f + __expf(-sd[4])), gwn = 1.f / (1.f + __expf(-sd[8]));
    f32x16 o[2]; o[0] = (f32x16){}; o[1] = (f32x16){};
    u32x4 kr, vr;
    {
        const bf16_t* Kc = (const bf16_t*)(p.ws + WS_KC) + (size_t)b * 256 * 64; const bf16_t* Vc = (const bf16_t*)(p.ws + WS_VC) + (size_t)b * 256 * 64;
        const int ntc = (4 * u + 2) / 64 + 1; const float nbound = -bnd[5 + hh];
        float l_run = 0.f, prevE3 = 0.f;
        kv_load64(kr, vr, Kc, Vc, 0, tid);
        kv_store(kr, vr, KVBUF(L, 0), tid);
        if (ntc > 1) kv_load64(kr, vr, Kc, Vc, 64, tid);
        for (int T = 0; T < ntc; ++T) {
            __syncthreads();
            if (T + 1 < ntc) kv_store(kr, vr, KVBUF(L, T + 1), tid);
            if (T + 2 < ntc) kv_load64(kr, vr, Kc, Vc, 64 * (T + 2), tid);
            const LDSP unsigned char* buf = KVBUF(L, T);
            f32x16 p0 = splat16(nbound), p1 = p0;
            qkt<4>(p0, p1, buf, qf, 0, r32, hi);
#pragma unroll
            for (int g = 0; g < 4; ++g) {
#pragma unroll
                for (int i = 0; i < 4; ++i) { const int r = 4 * g + i; const int d0_ = t - 16 * (64 * T + crow(r, hi)) - 31, d1_ = d0_ - 512;
                    const float b0 = tbl[min(max(d0_, 0), 127)], b1 = tbl[min(max(d1_, 0), 127)];
                    p0[r] = (d0_ < 0) ? -INFINITY : p0[r] + b0; p1[r] = (d1_ < 0) ? -INFINITY : p1[r] + b1; }
                asm volatile("" ::: "memory");
            }
            l_run += exp_sum(p0, p1);
#pragma unroll
            for (int s2 = 0; s2 < 2; ++s2) {
                float G[4], Eo[4];
#pragma unroll
                for (int g = 0; g < 4; ++g) { const float a0 = s2 ? p1[4 * g] : p0[4 * g], a1 = s2 ? p1[4 * g + 1] : p0[4 * g + 1], a2 = s2 ? p1[4 * g + 2] : p0[4 * g + 2], a3 = s2 ? p1[4 * g + 3] : p0[4 * g + 3];
                    G[g] = (a0 + a1) + (a2 + a3); Eo[g] = __shfl_xor(a3, 32); }
#pragma unroll
                for (int g = 0; g < 4; ++g) { const float eprev = hi ? Eo[g] : (g > 0 ? Eo[g - 1] : prevE3);
                    imp[(hh * 64 + ql) * 64 + 16 * T + 8 * s2 + 2 * g + hi] = G[g] + eprev; }
                prevE3 = Eo[3];
            }
            pv(o, buf, vb, p0, p1);
        }
        l_run += __shfl_xor(l_run, 32);
        const float inv = (l_run > 0.f) ? 1.f / l_run : 0.f;
        if (hi == 0) invl[hh * 64 + ql] = inv;
        scale_rows(o, gc * inv, wsf, r32, hi);
    }
    __syncthreads();
    {
        const int q = tid >> 3, part = tid & 7;
        const float i0 = invl[q], i1 = invl[64 + q], i2 = invl[128 + q], i3 = invl[192 + q];
        float vj[8];
#pragma unroll
        for (int jj = 0; jj < 8; ++jj) { const int j = part * 8 + jj;
            const float sum = ((imp[(0 * 64 + q) * 64 + j] * i0 + imp[(1 * 64 + q) * 64 + j] * i1) + imp[(2 * 64 + q) * 64 + j] * i2) + imp[(3 * 64 + q) * 64 + j] * i3;
            vj[jj] = (j > u) ? -1.0f : ((j == u || j == 0) ? 1.0e4f : sum); }
        __syncthreads();
#pragma unroll
        for (int jj = 0; jj < 8; ++jj) imp[q * 64 + part * 8 + jj] = vj[jj];
        __syncthreads();
        int rank[8];
#pragma unroll
        for (int jj = 0; jj < 8; ++jj) rank[jj] = 0;
        for (int i = 0; i < 64; ++i) { const float vi = imp[q * 64 + i];
#pragma unroll
            for (int jj = 0; jj < 8; ++jj) rank[jj] += (vi > vj[jj] || (vi == vj[jj] && i < part * 8 + jj)) ? 1 : 0; }
        unsigned bits = 0;
#pragma unroll
        for (int jj = 0; jj < 8; ++jj) if (rank[jj] < 16 && (part * 8 + jj) <= u) bits |= 1u << jj;
        unsigned mlo = (part < 4) ? (bits << (8 * part)) : 0u, mhi = (part >= 4) ? (bits << (8 * (part - 4))) : 0u;
        mlo |= __shfl_xor(mlo, 1); mhi |= __shfl_xor(mhi, 1); mlo |= __shfl_xor(mlo, 2); mhi |= __shfl_xor(mhi, 2); mlo |= __shfl_xor(mlo, 4); mhi |= __shfl_xor(mhi, 4);
        if (part == 0) { selm[2 * q] = mlo; selm[2 * q + 1] = mhi; }
    }
    __syncthreads();
#pragma unroll
    for (int r = 0; r < 16; ++r) { ofl[(2 * r) * 64] = o[0][r]; ofl[(2 * r + 1) * 64] = o[1][r]; }
    o[0] = (f32x16){}; o[1] = (f32x16){};
    {
        const unsigned long long mymask = (unsigned long long)selm[2 * ql] | ((unsigned long long)selm[2 * ql + 1] << 32);
        unsigned ulo = selm[2 * lane], uhi = selm[2 * lane + 1];
#pragma unroll
        for (int s2 = 1; s2 < 64; s2 <<= 1) { ulo |= __shfl_xor(ulo, s2); uhi |= __shfl_xor(uhi, s2); }
        unsigned long long um = (unsigned long long)(unsigned)__builtin_amdgcn_readfirstlane((int)ulo) | ((unsigned long long)(unsigned)__builtin_amdgcn_readfirstlane((int)uhi) << 32);
        const bf16_t* Kb = proj + rb * PINP + CD_KS; const bf16_t* Vb = proj + rb * PINP + CD_VS;
        float l_run = 0.f; const float nbound = -bnd[9 + hh]; const float cfar = tbl[127] + nbound; const float* gk = p.nsa_kn + (l * 3 + 1) * 64 + (tid & 7) * 8;
        int j = __builtin_ctzll(um); um &= um - 1;
        int jn = um ? __builtin_ctzll(um) : -1; um &= um - 1;
        kv_load(kr, vr, Kb, Vb, 64 * j, tid);
        knorm_chunk<64>(kr, gk); kv_store(kr, vr, KVBUF(L, 0), tid);
        if (jn >= 0) kv_load(kr, vr, Kb, Vb, 64 * jn, tid);
        for (int it = 0;; ++it) {
            __syncthreads();
            const int jnn = um ? __builtin_ctzll(um) : -1; um &= um - 1;
            if (jn >= 0) { knorm_chunk<64>(kr, gk); kv_store(kr, vr, KVBUF(L, it + 1), tid); }
            if (jnn >= 0) kv_load(kr, vr, Kb, Vb, 64 * jnn, tid);
            const bool mine = (mymask >> j) & 1ull;
            if (__any(mine)) {
                const LDSP unsigned char* buf = KVBUF(L, it);
                const int k0 = 64 * j; const bool nearb = (qw - (k0 + 63)) < 113;
                f32x16 p0 = splat16(nearb ? nbound : (mine ? cfar : -INFINITY)), p1 = p0;
                qkt<4>(p0, p1, buf, qf, 0, r32, hi);
                if (nearb) bias_near(p0, p1, tbl, t - k0, 1 << 30, mine, hi);
                l_run += exp_sum(p0, p1);
                pv(o, buf, vb, p0, p1);
            }
            if (jn < 0) break;
            j = jn; jn = jnn;
        }
        l_run += __shfl_xor(l_run, 32);
        scale_rows(o, gs / l_run, wsf, r32, hi);
#pragma unroll
        for (int r = 0; r < 16; ++r) { ofl[(2 * r) * 64] += o[0][r]; ofl[(2 * r + 1) * 64] += o[1][r]; }
        o[0] = (f32x16){}; o[1] = (f32x16){};
    }
    {
        const bf16_t* Kb = proj + rb * PINP + CD_KW; const bf16_t* Vb = proj + rb * PINP + CD_VW;
        float l_run = 0.f; const float nbound = -bnd[13 + hh]; const float cfar = tbl[127] + nbound; const float* gk = p.nsa_kn + (l * 3 + 2) * 64 + (tid & 7) * 8;
        const int jlo = max(0, u - 8);
        __syncthreads();
        kv_load(kr, vr, Kb, Vb, 64 * jlo, tid);
        knorm_chunk<64>(kr, gk); kv_store(kr, vr, KVBUF(L, jlo), tid);
        if (jlo < u) kv_load(kr, vr, Kb, Vb, 64 * (jlo + 1), tid);
        for (int j = jlo; j <= u; ++j) {
            __syncthreads();
            if (j + 1 <= u) { knorm_chunk<64>(kr, gk); kv_store(kr, vr, KVBUF(L, j + 1), tid); }
            if (j + 2 <= u) kv_load(kr, vr, Kb, Vb, 64 * (j + 2), tid);
            const LDSP unsigned char* buf = KVBUF(L, j);
            const int k0 = 64 * j; const bool nearb = (j == u || j == u - 8 || (qw - (k0 + 63)) < 113);
            f32x16 p0 = splat16(nearb ? nbound : cfar), p1 = p0;
            qkt<4>(p0, p1, buf, qf, 0, r32, hi);
            if (nearb) bias_near(p0, p1, tbl, t - k0, 512, true, hi);
            l_run += exp_sum(p0, p1);
            pv(o, buf, vb, p0, p1);
        }
        l_run += __shfl_xor(l_run, 32);
        scale_rows(o, gwn / l_run, wsf, r32, hi);
#pragma unroll
        for (int r = 0; r < 16; ++r) { o[0][r] += ofl[(2 * r) * 64]; o[1][r] += ofl[(2 * r + 1) * 64]; }
    }
    store_o(o, (LDSP bf16_t*)(L + AL_IMP + wid * 8192), mix + (rb + qw) * DM + 768 + 64 * hh, lane, r32, hi);
}

__device__ void ph_reset_queues(const Params& p) { unsigned* ctl = (unsigned*)(p.ws + WS_CTL); const int gt = GTID(); if (gt < 8) ctl[gt] = 0u; }
__device__ void fa_phase_all(const Params& p, int l, LDSP unsigned char* L, int qslot) {
    unsigned* ctl = (unsigned*)(p.ws + WS_CTL);
    LDSP unsigned* misc = (LDSP unsigned*)(L + AL_MISC);
    for (;;) {
        __syncthreads();
        if (threadIdx.x == 0) misc[0] = atomicAdd(&ctl[qslot], 1u);
        __syncthreads();
        const unsigned qi = misc[0];
        if (qi >= 1024u) break;
        const int r = 15 - (int)(qi >> 6), j = (int)(qi & 63), typ = j >> 4, sub = j & 15;
        if (typ == 0) fa_diff_unit(p, l, sub >> 2, sub & 3, r, L);
        else if (typ == 1) fa_fox_unit(p, l, sub >> 2, sub & 3, r, L);
        else if (typ == 2) fa_stick_unit(p, l, sub >> 2, sub & 3, r, L);
        else fa_nsa_unit(p, l, sub >> 2, 4 * r + (sub & 3), L);
    }
}


__device__ void prep_cmp_task(const Params& p, int l, int task, LDSP unsigned char* L) {
    const int tid = TID(), lane = tid & 63, wid = __builtin_amdgcn_readfirstlane(tid >> 6), r32 = lane & 31, hi = lane >> 5;
    const int b = task >> 4, which = (task >> 3) & 1, nt = task & 7;
    const bf16_t* proj = (const bf16_t*)(p.ws + WS_PROJ);
    const bf16_t* phiT = (const bf16_t*)(p.ws + WS_PHIT) + (size_t)(l * 2 + which) * 64 * 2048;
    const float* pe = p.nsa_pe + (size_t)(l * 2 + which) * 32 * 64;
    const int n = 32 * nt + r32, colbase = which ? CD_VC : CD_KC;
    f32x16 acc0 = (f32x16){}, acc1 = (f32x16){};
#pragma unroll
    for (int ii = 0; ii < 4; ++ii) {
        const int i = 4 * wid + ii; const int tok = min(16 * n + i, SEQ - 1);
        const bf16_t* xr = proj + (size_t)(b * SEQ + tok) * PINP + colbase;
#pragma unroll
        for (int d0 = 0; d0 < 4; ++d0) {
            float xv[8]; load8(xr + 16 * d0 + 8 * hi, xv);
            const f32x4 pe0 = *(const f32x4*)(pe + i * 64 + 16 * d0 + 8 * hi), pe1 = *(const f32x4*)(pe + i * 64 + 16 * d0 + 8 * hi + 4);
            u32x4 aw; aw[0] = pg8::cvt_pk_bf16(xv[0] + pe0[0], xv[1] + pe0[1]); aw[1] = pg8::cvt_pk_bf16(xv[2] + pe0[2], xv[3] + pe0[3]);
            aw[2] = pg8::cvt_pk_bf16(xv[4] + pe1[0], xv[5] + pe1[1]); aw[3] = pg8::cvt_pk_bf16(xv[6] + pe1[2], xv[7] + pe1[3]);
            const bf16x8 af = __builtin_bit_cast(bf16x8, aw);
            const bf16x8 b0 = *(const bf16x8*)(phiT + (size_t)r32 * 2048 + i * 64 + 16 * d0 + 8 * hi);
            const bf16x8 b1 = *(const bf16x8*)(phiT + (size_t)(32 + r32) * 2048 + i * 64 + 16 * d0 + 8 * hi);
            acc0 = __builtin_amdgcn_mfma_f32_32x32x16_bf16(af, b0, acc0, 0, 0, 0);
            acc1 = __builtin_amdgcn_mfma_f32_32x32x16_bf16(af, b1, acc1, 0, 0, 0);
        }
    }
    LDSP float* red = (LDSP float*)L;
    __syncthreads();
#pragma unroll
    for (int r = 0; r < 16; ++r) { red[(wid * 32 + crow(r, hi)) * 64 + r32] = acc0[r]; red[(wid * 32 + crow(r, hi)) * 64 + 32 + r32] = acc1[r]; }
    __syncthreads();
    {
        const int row = tid >> 4, e4 = (tid & 15) * 4; f32x4 v = (f32x4){0.f, 0.f, 0.f, 0.f};
#pragma unroll
        for (int w8 = 0; w8 < 8; ++w8) v += *(const LDSP f32x4*)(red + (w8 * 32 + row) * 64 + e4);
        const int nn = 32 * nt + row;
        if (which == 0) {
            float ss = (v[0] * v[0] + v[1] * v[1]) + (v[2] * v[2] + v[3] * v[3]);
            ss += __shfl_xor(ss, 1); ss += __shfl_xor(ss, 2); ss += __shfl_xor(ss, 4); ss += __shfl_xor(ss, 8);
            const float rs = rsqrtf(ss * (1.f / 64.f) + EPS); const f32x4 g = *(const f32x4*)(p.nsa_kn + (l * 3 + 0) * 64 + e4);
            v = v * rs * g;
        }
        uint2 o; o.x = pk2(v[0], v[1]); o.y = pk2(v[2], v[3]);
        if (nn >= 255) { o.x = 0u; o.y = 0u; }
        *(uint2*)((bf16_t*)(p.ws + (which ? WS_VC : WS_KC)) + (size_t)(b * 256 + nn) * 64 + e4) = o;
    }
}
__device__ void ph_prep(const Params& p, int l, LDSP unsigned char* L, unsigned char* lds) {
    for (int t = blockIdx.x; t < 80; t += gridDim.x) { if (t < 64) prep_cmp_task(p, l, t, L); }
    if (gridDim.x >= 80) { if (blockIdx.x >= 64 && blockIdx.x < 80) ph_prep_cum_bh(p, l, blockIdx.x - 64, lds); }
    else for (int bh = blockIdx.x; bh < 16; bh += gridDim.x) ph_prep_cum_bh(p, l, bh, lds);
}

__device__ void ph_act(const Params& p, int l) {
    const bf16_t* ug = (const bf16_t*)(p.ws + WS_UG); bf16_t* uv = (bf16_t*)(p.ws + WS_UV);
    const float* cw = p.conv_w + (size_t)l * 3 * DFF; const float* cb = p.conv_b + (size_t)l * DFF;
    constexpr int NC = DFF / 8;
    for (int idx = GTID(); idx < MTOK * NC; idx += GSIZE()) {
        const int c8 = (idx % NC) * 8; const size_t row = (size_t)(idx / NC); const int t = (int)(row & (SEQ - 1));
        float g0[8], g1[8], g2[8], v[8];
        load8(ug + row * DFF + c8, g0);
        if (t >= 1) load8(ug + (row - 1) * DFF + c8, g1); else {
#pragma unroll
            for (int j = 0; j < 8; ++j) g1[j] = 0.f; }
        if (t >= 2) load8(ug + (row - 2) * DFF + c8, g2); else {
#pragma unroll
            for (int j = 0; j < 8; ++j) g2[j] = 0.f; }
        load8(uv + row * DFF + c8, v);
        float o[8];
#pragma unroll
        for (int j = 0; j < 8; ++j) { const float cv = cw[c8 + j] * g2[j] + cw[DFF + c8 + j] * g1[j] + cw[2 * DFF + c8 + j] * g0[j] + cb[c8 + j]; o[j] = siluf(cv) * v[j]; }
        u32x4 w; w[0] = pk2(o[0], o[1]); w[1] = pk2(o[2], o[3]); w[2] = pk2(o[4], o[5]); w[3] = pk2(o[6], o[7]);
        *(u32x4*)(uv + row * DFF + c8) = w;
    }
}

#define XB_TMO      128
#define XB_XCNT(j)  (256  + 64 * (j))
#define XB_XSUB(j)  (1280 + 64 * (j))
#define XB_XGEN(j)  (2304 + 64 * (j))
#define XB_TOP      3328
#define XB_TOPGEN   3392
#define XCD_BAR_WORDS 3456
#define XB_SPIN_CAP (1u << 18)

__device__ __forceinline__ unsigned xb_ld(unsigned* p)              { return __hip_atomic_load(p, __ATOMIC_RELAXED, __HIP_MEMORY_SCOPE_AGENT); }
__device__ __forceinline__ unsigned xb_add(unsigned* p, unsigned v) { return __hip_atomic_fetch_add(p, v, __ATOMIC_RELAXED, __HIP_MEMORY_SCOPE_AGENT); }
__device__ __forceinline__ unsigned xb_xcc_id() { return (unsigned)__builtin_amdgcn_s_getreg((3 << 11) | 20) & 0xFu; }
#define XB_SPIN(cond, bar) do { unsigned _sp = 0; while (cond) { __builtin_amdgcn_s_sleep(1); \
    if ((++_sp & 255u) == 0u) { if (xb_ld(&(bar)[XB_TMO])) break; if (_sp > XB_SPIN_CAP) { atomicAdd(&(bar)[XB_TMO], 1u); break; } } } } while (0)

struct XcdBarrier {
    unsigned* bar; unsigned x;
    volatile LDSF unsigned* st;
};

__device__ __forceinline__ XcdBarrier xcd_barrier_post(unsigned* bar, volatile LDSF unsigned* st) {
    XcdBarrier b; b.bar = bar; b.x = xb_xcc_id(); b.st = st;
    if (threadIdx.x == 0) (void)xb_add(&bar[XB_XCNT(b.x)], 1u);
    return b;
}
__device__ __forceinline__ void xcd_barrier_complete(unsigned* bar, unsigned x, unsigned& nloc, unsigned& nx) {
    const unsigned G = gridDim.x * gridDim.y * gridDim.z;
    unsigned sum, cnt, mine, sp = 0u;
    for (;;) {
        sum = 0u; cnt = 0u; mine = 0u;
#pragma unroll
        for (unsigned j = 0; j < 16; ++j) { const unsigned c = xb_ld(&bar[XB_XCNT(j)]); sum += c; cnt += (c > 0u) ? 1u : 0u; mine = (j == x) ? c : mine; }
        if (sum == G) break;
        __builtin_amdgcn_s_sleep(1);
        if ((++sp & 255u) == 0u) { if (xb_ld(&bar[XB_TMO])) break; if (sp > XB_SPIN_CAP) { atomicAdd(&bar[XB_TMO], 1u); break; } }
    }
    nloc = mine > 0u ? mine : 1u; nx = cnt > 0u ? cnt : 1u;
}

__device__ __forceinline__ void xcd_barrier(const XcdBarrier& b) {
    asm volatile("s_waitcnt vmcnt(0)" ::: "memory");
    __syncthreads();
    if (threadIdx.x == 0) {
        unsigned* bar = b.bar;
        __builtin_amdgcn_s_waitcnt(0);
        unsigned nloc = b.st[0], nx = b.st[1];
        if (nloc == 0u) { xcd_barrier_complete(bar, b.x, nloc, nx); b.st[0] = nloc; b.st[1] = nx; }
        const unsigned old = xb_add(&bar[XB_XSUB(b.x)], 1u);
        const unsigned gen = old / nloc;
        if (old + 1u == (gen + 1u) * nloc) {
            __builtin_amdgcn_fence(__ATOMIC_RELEASE, "agent");
            asm volatile("s_waitcnt vmcnt(0)" ::: "memory");
            const unsigned og = xb_add(&bar[XB_TOP], 1u);
            const unsigned tg = og / nx;
            if (og + 1u == (tg + 1u) * nx) xb_add(&bar[XB_TOPGEN], 1u);
            else XB_SPIN(xb_ld(&bar[XB_TOPGEN]) == tg, bar);
            __builtin_amdgcn_fence(__ATOMIC_ACQUIRE, "agent");
            xb_add(&bar[XB_XGEN(b.x)], 1u);
            asm volatile("s_waitcnt vmcnt(0)" ::: "memory");
        } else {
            XB_SPIN(xb_ld(&bar[XB_XGEN(b.x)]) == gen, bar);
            __builtin_amdgcn_fence(__ATOMIC_ACQUIRE, "agent");
            asm volatile("s_waitcnt vmcnt(0)" ::: "memory");
        }
    }
    __syncthreads();
}

namespace cg = cooperative_groups;
constexpr int LDS_BYTES = 131072 + 4096;
#define LAS3 __attribute__((address_space(3)))
#ifndef PROBE
#define PROBE 0
#endif
__global__ void __launch_bounds__(NTHR, 2) mega(Params p) {
    extern __shared__ __attribute__((aligned(16))) unsigned char lds[];
    cg::grid_group grid = cg::this_grid();
#if PROBE
    unsigned long long tacc = 0, tph = 0, t0_;
#define GSYNC() do { t0_ = __builtin_amdgcn_s_memrealtime(); xcd_barrier(xbar); tacc += __builtin_amdgcn_s_memrealtime() - t0_; } while (0)
#define TPK(k, ...) do { if (PROBE == (k)) { t0_ = __builtin_amdgcn_s_memrealtime(); __VA_ARGS__; tph += __builtin_amdgcn_s_memrealtime() - t0_; } else { __VA_ARGS__; } } while (0)
#else
#define GSYNC() xcd_barrier(xbar)
#define TPK(k, ...) do { __VA_ARGS__; } while (0)
#endif
    LAS3 unsigned char* lds3 = (LAS3 unsigned char*)lds;
    volatile LDSF unsigned* bst = (volatile LDSF unsigned*)(lds3 + 131072 + 2048);
    if (threadIdx.x < 2) bst[threadIdx.x] = 0u;
    __syncthreads();
    XcdBarrier xbar = xcd_barrier_post((unsigned*)(p.ws + WS_CTL) + 16384, bst);
    TPK(2, ph_mod(p, lds); ph_reset_queues(p); ph_weights(p, 0, lds));
    grid.sync();
    for (int l = 0; l < DEPTH; ++l) {
        const float* mod = (const float*)(p.ws + WS_MOD) + (size_t)l * 4 * 6144;
        TPK(2, if (l == 0) ph_cbias(p, lds); else ph_weights(p, l, lds);
        if (l == 0) ph_xa_from(p, p.x, 0, 0, (bf16_t*)(p.ws + WS_XA), (float*)(p.ws + WS_RSA), true));
        GSYNC();
        {   pg8::Gemm g{(const bf16_t*)(p.ws + WS_XA), (const bf16_t*)(p.ws + WS_WIN), MTOK, PINP, DM}; pg8::StaticOrder S; S.init(MTOK, PINP, (int)gridDim.x, (int)blockIdx.x);
            EpiProjF E{(const float*)(p.ws + WS_RSA), (const float*)(p.ws + WS_CBIN) + (size_t)l * 4 * PINP, (bf16_t*)(p.ws + WS_PROJ), (float*)(p.ws + WS_SIDE)};
            TPK(6, pg8::gemm_phase<EpiProjF, pg8::StaticOrder, PG8_ALIGN, PG8_SP2>(lds3, g, S, E)); }
        GSYNC();
        TPK(2, ph_prep(p, l, lds3, lds));
        GSYNC();
        TPK(7, fa_phase_all(p, l, lds3, l));
        GSYNC();
        {   pg8::Gemm g{(const bf16_t*)(p.ws + WS_MIX), (const bf16_t*)(p.ws + WS_WOUT), MTOK, DM, DM}; pg8::StaticOrder S; S.init(MTOK, DM, (int)gridDim.x, (int)blockIdx.x);
            EpiResF E{l == 0 ? p.x : p.out, p.out, mod + 2048, p.norm_ffn_g + l * DM, mod + 4096, (bf16_t*)(p.ws + WS_XA), (float*)(p.ws + WS_RSB)};
            TPK(6, pg8::gemm_phase<EpiResF, pg8::StaticOrder, PG8_ALIGN, PG8_SP2>(lds3, g, S, E)); }
        GSYNC();
        {   pg8::Gemm g{(const bf16_t*)(p.ws + WS_XA), (const bf16_t*)(p.ws + WS_WUP), MTOK, NUP, DM}; pg8::StaticOrder S; S.init(MTOK, NUP, (int)gridDim.x, (int)blockIdx.x);
            EpiUpF E{(const float*)(p.ws + WS_RSB), (const float*)(p.ws + WS_CBUP) + (size_t)l * 4 * NUP, (bf16_t*)(p.ws + WS_UG), (bf16_t*)(p.ws + WS_UV)};
            TPK(6, pg8::gemm_phase<EpiUpF, pg8::StaticOrder, PG8_ALIGN, PG8_SP2>(lds3, g, S, E)); }
        GSYNC();
        TPK(2, ph_act(p, l));
        GSYNC();
        {   const float* modn = (const float*)(p.ws + WS_MOD) + (size_t)(l + 1) * 4 * 6144; const bool more = (l + 1 < DEPTH);
            pg8::Gemm g{(const bf16_t*)(p.ws + WS_UV), (const bf16_t*)(p.ws + WS_WDN), MTOK, DM, DFF}; pg8::StaticOrder S; S.init(MTOK, DM, (int)gridDim.x, (int)blockIdx.x);
            EpiResF E{p.out, p.out, mod + 5120, p.norm_mix_g + (more ? l + 1 : l) * DM, more ? modn + 1024 : mod + 1024, more ? (bf16_t*)(p.ws + WS_XA) : nullptr, more ? (float*)(p.ws + WS_RSA) : nullptr};
            TPK(6, pg8::gemm_phase<EpiResF, pg8::StaticOrder, PG8_ALIGN, PG8_SP2>(lds3, g, S, E)); }
        if (l + 1 < DEPTH) GSYNC();
    }
#if PROBE == 1
    if (blockIdx.x == 0 && threadIdx.x == 0) p.out[0] += 0.05f + (float)tacc * 0.01f * 5e-4f;
#elif PROBE >= 2
    if (blockIdx.x == 0 && threadIdx.x == 0) p.out[0] += 0.05f + (float)tph * 0.01f * 1e-4f;
#endif
}

extern "C" void kernel_launch(void* const* d_in, const int* in_sizes, int in, void* d_out, int out_size, void* d_ws, size_t ws_size, hipStream_t stream) {
    if (in != 24 || ws_size < WS_END || out_size != MTOK * DM) { fprintf(stderr, "kernel_launch: unexpected sizes (in %d, ws %zu, out %d)\n", in, ws_size, out_size); return; }
    static int grid_blocks = 0;
    if (!grid_blocks) {
        int dev = 0, cus = 0, per_cu = 0;
        hipGetDevice(&dev);
        hipDeviceGetAttribute(&cus, hipDeviceAttributeMultiprocessorCount, dev);
        hipFuncSetAttribute((const void*)mega, hipFuncAttributeMaxDynamicSharedMemorySize, LDS_BYTES);
        hipOccupancyMaxActiveBlocksPerMultiprocessor(&per_cu, (const void*)mega, NTHR, LDS_BYTES);
        if (per_cu < 1) { fprintf(stderr, "kernel_launch: occupancy query returned %d\n", per_cu); per_cu = 1; }
        if (per_cu > 1) per_cu = 1;
        grid_blocks = cus * per_cu;
        fprintf(stderr, "kernel_launch: cus %d per_cu %d grid %d\n", cus, per_cu, grid_blocks);
    }
    if (hipMemsetAsync((char*)d_ws + WS_CTL + 65536, 0, XCD_BAR_WORDS * 4, stream) != hipSuccess) { fprintf(stderr, "kernel_launch: memset failed\n"); return; }
    Params p{};
    const float** f = (const float**)&p;
    for (int i = 0; i < 24; ++i) f[i] = (const float*)d_in[i];
    p.out = (float*)d_out; p.ws = (unsigned char*)d_ws;
    void* args[] = {&p};
    hipError_t e = hipLaunchCooperativeKernel((const void*)mega, dim3(grid_blocks), dim3(NTHR), args, LDS_BYTES, stream);
    if (e != hipSuccess) fprintf(stderr, "cooperative launch failed: %s (grid %d)\n", hipGetErrorString(e), grid_blocks);
}
```

```cpp
#include <hip/hip_runtime.h>
#include <hip/hip_cooperative_groups.h>
#include <cstdint>
#include <cstdio>

typedef unsigned short bf16_t;
typedef short bf16x8 __attribute__((ext_vector_type(8)));
typedef float f32x4 __attribute__((ext_vector_type(4)));
typedef unsigned u32x4 __attribute__((ext_vector_type(4)));

constexpr int NB = 4, SEQ = 4096, DM = 1024, MTOK = NB * SEQ, DEPTH = 2;
constexpr int HD = 64, HPM = 4, DFF = 2816, PIN = 2960, PINP = 3072, NUP = 2 * DFF;
constexpr float EPS = 1e-6f;
constexpr float LOG2E = 1.4426950408889634f;
constexpr int NTHR = 512;

constexpr int CA_Q = 0, CA_K = 256, CA_V = 512, CB_Q = 768, CB_K = 1024, CB_V = 1280, CC_Q = 1536, CC_K = 1792, CC_V = 2048;
constexpr int CD_Q = 2304, CD_KC = 2560, CD_VC = 2624, CD_KS = 2688, CD_VS = 2752, CD_KW = 2816, CD_VW = 2880, C_BF = 2944, C_DG = 2948;

constexpr size_t MiB = 1u << 20;
constexpr size_t WS_CTL = 0;
constexpr size_t WS_MOD = 1 * MiB;
constexpr size_t WS_CBIN = WS_MOD + 2 * 4 * 6144 * 4;
constexpr size_t WS_CBUP = WS_CBIN + 2 * 4 * 3072 * 4;
constexpr size_t WS_TB = WS_CBUP + 2 * 4 * 5632 * 4;
constexpr size_t WS_LAM = WS_TB + 2 * 4 * 128 * 4;
constexpr size_t WS_BND = WS_LAM + 64;
constexpr size_t WS_CUM = WS_LAM + 512;
constexpr size_t WS_KC = WS_CUM + 16 * 4096 * 4;
constexpr size_t WS_VC = WS_KC + 4 * 256 * 64 * 2;
constexpr size_t WS_SELM = WS_VC + 4 * 256 * 64 * 2;
constexpr size_t WS_SMALL_END = WS_SELM + 16384 * 8;
static_assert(WS_SMALL_END <= 4 * MiB, "small region");
constexpr size_t WS_RSA = 4 * MiB;
constexpr size_t WS_RSB = 5 * MiB;
constexpr size_t WS_SIDE = 6 * MiB;
constexpr size_t WS_IMP = 7 * MiB;
constexpr size_t WS_ML = 11 * MiB;
constexpr size_t WS_PHIT = 7 * MiB;
constexpr size_t WS_W = 12 * MiB;
constexpr size_t WS_WIN = WS_W;
constexpr size_t WS_WOUT = WS_WIN + (size_t)PINP * DM * 2;
constexpr size_t WS_WUP = WS_WOUT + (size_t)DM * DM * 2;
constexpr size_t WS_WDN = WS_WUP + (size_t)NUP * DM * 2;
constexpr size_t WS_W_END = WS_WDN + (size_t)DM * DFF * 2;
static_assert(WS_W_END <= 38 * MiB, "weights region");
constexpr size_t WS_XA = 38 * MiB;
constexpr size_t WS_BIG = 70 * MiB;
constexpr size_t WS_PROJ = WS_BIG;
constexpr size_t WS_MIX = WS_BIG + 96 * MiB;
constexpr size_t WS_ACT = WS_BIG;
constexpr size_t WS_W1OFF = 188 * MiB;
constexpr size_t WS_EG = 228 * MiB;
constexpr size_t WS_EV = 232 * MiB;
constexpr size_t WS_END = 236 * MiB;
static_assert(WS_W_END + WS_W1OFF <= WS_EG && WS_MIX + 32 * MiB <= WS_W + WS_W1OFF, "layer-1 weights");
static_assert(WS_END <= 256 * MiB, "workspace");

struct Params {
    const float *x, *c, *rel_bias, *ada_w, *ada_b, *norm_mix_g, *norm_ffn_g, *w_in, *w_out;
    const float *diff_qn, *diff_kn, *diff_lam, *diff_sub, *fox_qn, *fox_kn, *fox_bf;
    const float *nsa_qn, *nsa_kn, *nsa_pe, *nsa_phi, *w_up, *conv_w, *conv_b, *w_down;
    float* out;
    unsigned char* ws;
};

__device__ __forceinline__ float bf2f(bf16_t v) { return __uint_as_float(((unsigned)v) << 16); }
__device__ __forceinline__ bf16_t f2bf(float f) { unsigned u = __float_as_uint(f); return (bf16_t)((u + 0x7fffu + ((u >> 16) & 1u)) >> 16); }
__device__ __forceinline__ unsigned pk2(float lo, float hi) { return (unsigned)f2bf(lo) | ((unsigned)f2bf(hi) << 16); }
__device__ __forceinline__ float siluf(float v) { return v / (1.f + __expf(-v)); }
__device__ __forceinline__ float logsigf(float v) { return fminf(v, 0.f) - log1pf(__expf(-fabsf(v))); }
__device__ __forceinline__ float wave_sum(float v) {
#pragma unroll
    for (int o = 1; o < 64; o <<= 1) v += __shfl_xor(v, o);
    return v;
}
__device__ __forceinline__ int t5_bucket(int n) {
    if (n < 16) return n < 0 ? 0 : n;
    return 16 + (n >= 19) + (n >= 21) + (n >= 24) + (n >= 27) + (n >= 31) + (n >= 35) + (n >= 40) + (n >= 46) + (n >= 52) + (n >= 59) + (n >= 67) + (n >= 77) + (n >= 87) + (n >= 99) + (n >= 113);
}
__host__ __device__ __forceinline__ int in_col_map(int n) {
    if (n < 1536) return n;
    if (n < 2944) return n + 4;
    if (n < 2948) return 1536 + (n - 2944);
    if (n < 2960) return n;
    return -1;
}
__host__ __device__ __forceinline__ int up_col_map(int n) {
    const int pn = n >> 8, c = n & 255;
    return c < 128 ? (128 * pn + c) : (DFF + 128 * pn + (c - 128));
}

__device__ __forceinline__ int opaque_v(int v) { asm volatile("" : "+v"(v)); return v; }
#define TID() opaque_v((int)threadIdx.x)
#define GTID() ((int)(blockIdx.x * blockDim.x) + TID())
#define GSIZE() ((int)(gridDim.x * blockDim.x))

#define LDSF __attribute__((address_space(3)))
__device__ __forceinline__ void gemv4_block(const float* W, int ld, int oc, const LDSF float* vec, LDSF float* red, float* out0, int ostride, int n, float bias, int tid) {
    const int lane = tid & 63, wv = tid >> 6;
    float a0 = 0.f, a1 = 0.f, a2 = 0.f, a3 = 0.f;
    if (oc >= 0) {
        const float* w = W + (size_t)(wv * 128) * ld + oc;
#pragma unroll 32
        for (int k = 0; k < 128; ++k) { const float wk = w[(size_t)k * ld]; const f32x4 v = *(const LDSF f32x4*)(vec + (wv * 128 + k) * 4); a0 += v[0] * wk; a1 += v[1] * wk; a2 += v[2] * wk; a3 += v[3] * wk; }
    }
    red[(wv * 4 + 0) * 64 + lane] = a0; red[(wv * 4 + 1) * 64 + lane] = a1; red[(wv * 4 + 2) * 64 + lane] = a2; red[(wv * 4 + 3) * 64 + lane] = a3;
    __syncthreads();
    if (tid < 256) { const int bt = tid >> 6; float sacc = 0.f;
#pragma unroll
        for (int w8 = 0; w8 < 8; ++w8) sacc += red[(w8 * 4 + bt) * 64 + lane];
        out0[(size_t)bt * ostride + n] = sacc + bias; }
    __syncthreads();
}
__device__ void ph_mod(const Params& p, unsigned char* lds) {
    float* mod = (float*)(p.ws + WS_MOD);
    float* tb = (float*)(p.ws + WS_TB);
    float* lamv = (float*)(p.ws + WS_LAM);
    LDSF float* vec = (LDSF float*)lds; LDSF float* red = (LDSF float*)(lds + 16384);
    const int tid = TID();
    bool loaded = false;
    for (int item = blockIdx.x; item < DEPTH * 96; item += gridDim.x) {
        if (!loaded) { for (int i = tid; i < 4096; i += NTHR) { const int bt = i >> 10, k = i & 1023; vec[k * 4 + bt] = siluf(p.c[bt * DM + k]); } __syncthreads(); loaded = true; }
        const int l = item / 96, n = (item % 96) * 64 + (tid & 63);
        gemv4_block(p.ada_w + (size_t)l * DM * 6144, 6144, n, vec, red, mod + (size_t)l * 4 * 6144, 6144, n, p.ada_b[l * 6144 + n], tid);
    }
    const int gt = GTID(), gs = GSIZE();
    for (int idx = gt; idx < 2 * 4 * 128; idx += gs) {
        const int type = idx / 512, h = (idx / 128) & 3, d = idx & 127;
        tb[idx] = p.rel_bias[t5_bucket(d) * 8 + type * 4 + h];
    }
    for (int idx = gt; idx < DEPTH * 32; idx += gs) {
        const int l = idx >> 5, e = idx & 31; float v = 0.f;
        if (e < 17) {
            const int type = (e < 5) ? 0 : 1, h = (e < 4) ? e : ((e == 4) ? 0 : ((e - 5) & 3));
            const int ng = (e < 4) ? 32 : 64;
            const float* gq = (e < 4) ? p.diff_qn + l * 32 : ((e == 4) ? p.fox_qn + l * 64 : p.nsa_qn + l * 64);
            const float* gk = (e < 4) ? p.diff_kn + l * 32 : ((e == 4) ? p.fox_kn + l * 64 : p.nsa_kn + (l * 3 + (e - 5) / 4) * 64);
            float mq = 0.f, mk = 0.f; for (int i = 0; i < ng; ++i) { mq = fmaxf(mq, fabsf(gq[i])); mk = fmaxf(mk, fabsf(gk[i])); }
            float tm = 0.f; if (e != 4) { tm = -INFINITY; for (int bk2 = 0; bk2 < 32; ++bk2) tm = fmaxf(tm, p.rel_bias[bk2 * 8 + type * 4 + h]); }
            v = sqrtf((float)ng) * mq * mk * 1.02f * LOG2E + tm * LOG2E;
        }
        ((float*)(p.ws + WS_BND))[idx] = v;
    }
    for (int idx = gt; idx < DEPTH; idx += gs) {
        const float* lv = p.diff_lam + idx * 4 * 32;
        float s1 = 0.f, s2 = 0.f;
        for (int i = 0; i < 32; ++i) { s1 += lv[i] * lv[32 + i]; s2 += lv[64 + i] * lv[96 + i]; }
        const float lam_init = 0.8f - 0.6f * expf(-0.3f * (float)idx);
        lamv[idx] = expf(s1) - expf(s2) + lam_init;
    }
}
__device__ void ph_cbias(const Params& p, unsigned char* lds) {
    const float* mod = (const float*)(p.ws + WS_MOD);
    LDSF float* vec = (LDSF float*)lds; LDSF float* red = (LDSF float*)(lds + 16384);
    const int tid = TID();
    for (int item = blockIdx.x; item < DEPTH * 136; item += gridDim.x) {
        const int l = item / 136, r = item % 136; const bool isin = r < 48; const int n = (isin ? r : r - 48) * 64 + (tid & 63);
        const int shoff = isin ? 0 : 3072;
        __syncthreads();
        for (int i = tid; i < 4096; i += NTHR) { const int bt = i >> 10, k = i & 1023; vec[k * 4 + bt] = mod[(size_t)(l * 4 + bt) * 6144 + shoff + k]; }
        __syncthreads();
        if (isin) gemv4_block(p.w_in + (size_t)l * DM * PIN, PIN, in_col_map(n), vec, red, (float*)(p.ws + WS_CBIN) + (size_t)l * 4 * PINP, PINP, n, 0.f, tid);
        else gemv4_block(p.w_up + (size_t)l * DM * NUP, NUP, up_col_map(n), vec, red, (float*)(p.ws + WS_CBUP) + (size_t)l * 4 * NUP, NUP, n, 0.f, tid);
    }
}
template <int MAPK>
__device__ void convert_weight(const float* W, int K, int Nsrc, int Npad, bf16_t* Wt, LDSF float* scr, int gw, int ngw, int lane) {
    const int nkb = K / 64, nnb = Npad / 32;
    for (int it = gw; it < nkb * nnb; it += ngw) {
        const int kb = it / nnb, nb = it % nnb, k0 = kb * 64, n0 = nb * 32;
        {
            const int nn = lane & 31; const int n = n0 + nn;
            const int oc = MAPK == 0 ? n : (MAPK == 1 ? in_col_map(n) : up_col_map(n));
            float tv[32];
            const float* wp = W + (size_t)(k0 + (lane >> 5)) * Nsrc + (oc >= 0 ? oc : 0);
#pragma unroll
            for (int i = 0; i < 32; ++i) tv[i] = wp[(size_t)(2 * i) * Nsrc];
#pragma unroll
            for (int i = 0; i < 32; ++i) scr[(2 * i + (lane >> 5)) * 33 + nn] = (oc >= 0) ? tv[i] : 0.f;
        }
        __builtin_amdgcn_s_waitcnt(0xc07f); __builtin_amdgcn_wave_barrier();
        {
            const int c = lane & 7;
#pragma unroll
            for (int j = 0; j < 4; ++j) { const int n = (lane >> 3) + 8 * j; const LDSF float* sp = scr + (8 * c) * 33 + n;
                u32x4 o; o[0] = pk2(sp[0], sp[33]); o[1] = pk2(sp[66], sp[99]); o[2] = pk2(sp[132], sp[165]); o[3] = pk2(sp[198], sp[231]);
                *(u32x4*)(Wt + (size_t)(n0 + n) * K + k0 + 8 * c) = o; }
        }
        __builtin_amdgcn_s_waitcnt(0xc07f); __builtin_amdgcn_wave_barrier();
    }
}
__device__ void ph_weights(const Params& p, int l, unsigned char* lds) {
    const int tid_ = TID(); const int lane = tid_ & 63, wv = tid_ >> 6;
    const int gw = blockIdx.x * (NTHR >> 6) + wv, ngw = gridDim.x * (NTHR >> 6);
    LDSF float* scr = (LDSF float*)lds + wv * (64 * 33);
    convert_weight<1>(p.w_in + (size_t)l * DM * PIN, DM, PIN, PINP, (bf16_t*)(p.ws + WS_WIN + l * WS_W1OFF), scr, gw, ngw, lane);
    convert_weight<0>(p.w_out + (size_t)l * DM * DM, DM, DM, DM, (bf16_t*)(p.ws + WS_WOUT + l * WS_W1OFF), scr, gw, ngw, lane);
    convert_weight<2>(p.w_up + (size_t)l * DM * NUP, DM, NUP, NUP, (bf16_t*)(p.ws + WS_WUP + l * WS_W1OFF), scr, gw, ngw, lane);
    convert_weight<0>(p.w_down + (size_t)l * DFF * DM, DFF, DM, DM, (bf16_t*)(p.ws + WS_WDN + l * WS_W1OFF), scr, gw, ngw, lane);
    for (int w2 = 0; w2 < 2; ++w2) convert_weight<0>(p.nsa_phi + (size_t)(l * 2 + w2) * 2048 * 64, 2048, 64, 64, (bf16_t*)(p.ws + WS_PHIT) + (size_t)(l * 2 + w2) * 64 * 2048, scr, gw, ngw, lane);
}
__device__ void ph_xa_from(const Params& p, const float* src, int l, int which  , bf16_t* XA, float* rowss, bool write_xa) {
    const float* mod = (const float*)(p.ws + WS_MOD);
    const float* g = (which == 0 ? p.norm_mix_g : p.norm_ffn_g) + l * DM;
    const int tid_ = TID(); const int lane = tid_ & 63, wv = tid_ >> 6;
    const int gw = blockIdx.x * (blockDim.x >> 6) + wv, ngw = gridDim.x * (blockDim.x >> 6);
    for (int row = gw; row < MTOK; row += ngw) {
        const int b = row / SEQ;
        const float* sc = mod + (size_t)(l * 4 + b) * 6144 + (which == 0 ? 1024 : 4096);
        float ss = 0.f;
#pragma unroll
        for (int j = 0; j < 4; ++j) {
            const int k = j * 256 + lane * 4;
            const f32x4 v = *(const f32x4*)(src + (size_t)row * DM + k);
            ss += v[0] * v[0] + v[1] * v[1] + v[2] * v[2] + v[3] * v[3];
            if (write_xa) {
                const f32x4 gv = *(const f32x4*)(g + k); const f32x4 sv = *(const f32x4*)(sc + k);
                uint2 o; o.x = pk2(v[0] * gv[0] * (1.f + sv[0]), v[1] * gv[1] * (1.f + sv[1])); o.y = pk2(v[2] * gv[2] * (1.f + sv[2]), v[3] * gv[3] * (1.f + sv[3]));
                *(uint2*)(XA + (size_t)row * DM + k) = o;
            }
        }
        ss = wave_sum(ss);
        if (lane < 16) rowss[(size_t)row * 16 + lane] = (lane == 0) ? ss : 0.f;
    }
}

namespace pg8 {
#define PG8_LAS __attribute__((address_space(3)))
typedef unsigned short bf16_t;
typedef short bf16x8 __attribute__((ext_vector_type(8)));
typedef float f32x4 __attribute__((ext_vector_type(4)));
typedef unsigned u32x4 __attribute__((ext_vector_type(4)));
constexpr int BM = 256, BK = 64, HALF = 128, HTB = HALF * BK * 2  , STAGE_BYTES = 8 * HTB, NXCD = 8, WGM = 8;

__host__ __device__ __forceinline__ int lds_byte(int r, int c) { const int st = (r >> 4) * 2 + (c >> 5), rr = r & 15, cc = c & 31, ob = rr * 64 + cc * 2; return st * 1024 + (ob ^ (((ob >> 9) & 1) << 5)); }
__host__ __device__ __forceinline__ void stage_rc(int b, int& R, int& C) { const int st = b / 1024, sb = b % 1024, swz = sb ^ (((sb >> 9) & 1) << 5); R = (st >> 1) * 16 + swz / 64; C = (st & 1) * 32 + (swz % 64) / 2; }
__host__ __device__ __forceinline__ int perm32(int rho) { const int n = rho >> 4, i = rho & 15; return 8 * (i >> 2) + 4 * n + (i & 3); }

struct Unit { int pm, pn; };
struct Gemm { const bf16_t* A; const bf16_t* Bt; int M, N, K; };

struct StaticOrder {
    int nM, nN, nwg, G, c;
    __host__ __device__ void init(int M, int N, int G_, int c_) { nM = M / BM; nN = N / BM; nwg = nM * nN; G = G_; c = c_; }
    __host__ __device__ bool next(int i, Unit& u) const {
        const long L = (long)i * G + c; if (L >= nwg) return false;
        int wgid = (int)L; { const int q = nwg / NXCD, r = nwg % NXCD, xcd = wgid % NXCD, off = wgid / NXCD; wgid = (xcd < r ? xcd * (q + 1) : r * (q + 1) + (xcd - r) * q) + off; }
        const int nig = WGM * nN, gid = wgid / nig, fm = gid * WGM, gsz = (nM - fm) < WGM ? (nM - fm) : WGM;
        u.pm = fm + ((wgid % nig) % gsz); u.pn = (wgid % nig) / gsz; return true;
    }
    __device__ __forceinline__ void a_ready(const Unit&) const {}
    __device__ __forceinline__ void done(const Unit&) const {}
};


__device__ __forceinline__ unsigned cvt_pk_bf16(float lo, float hi) { unsigned r; asm volatile("v_cvt_pk_bf16_f32 %0, %1, %2" : "=v"(r) : "v"(lo), "v"(hi)); return r; }
template <class Epi, class Sched, bool ALIGN_EPI = false, bool SP2 = false>
__device__ __forceinline__ void gemm_phase(PG8_LAS unsigned char* lds, const Gemm g, const Sched& S, const Epi& E) {
    const int tid = TID(), wid = __builtin_amdgcn_readfirstlane(tid >> 6), lane = tid & 63, wr = wid >> 2, wc = wid & 3, fr = lane & 15, fq = lane >> 4;
    const int K = g.K, nt = K / BK;
    unsigned voffA[2], voffB[2];
#pragma unroll
    for (int i = 0; i < 2; ++i) { int R, C; stage_rc(tid * 16 + i * 8192, R, C); const int Rb = Epi::PERM ? ((R & ~31) + perm32(R & 31)) : R;
        voffA[i] = (unsigned)(R * K + C) * 2u; voffB[i] = (unsigned)(Rb * K + C) * 2u; }
    const size_t kstep = (size_t)(BK * 2);
    const size_t hstep = (size_t)HALF * K * 2;
    const size_t tstep = 2 * hstep;
    const unsigned ldsw = (unsigned)wid * 1024u;
    const int aoff = lds_byte(wr * 64 + fr, fq * 8), boff = lds_byte(wc * 32 + fr, fq * 8);
#define PG8_SA(b, h) (((b) * 2 + (h)) * HTB)
#define PG8_SB(b, h) ((4 + (b) * 2 + (h)) * HTB)
#define PG8_STAGE(bufoff, gbase, voff) do { _Pragma("unroll") for (int _i = 0; _i < 2; ++_i) \
        __builtin_amdgcn_global_load_lds((const unsigned*)((const char*)(gbase) + (voff)[_i]), (PG8_LAS unsigned*)(lds + (bufoff) + ldsw + _i * 8192), 16, 0, 0); } while (0)
#define PG8_LDA(dst, b, h) do { _Pragma("unroll") for (int m = 0; m < 4; ++m) _Pragma("unroll") for (int k = 0; k < 2; ++k) dst[m][k] = *(const PG8_LAS bf16x8*)(lds + PG8_SA(b, h) + aoff + m * 2048 + k * 1024); } while (0)
#define PG8_LDB(dst, b, h) do { _Pragma("unroll") for (int n = 0; n < 2; ++n) _Pragma("unroll") for (int k = 0; k < 2; ++k) dst[n][k] = *(const PG8_LAS bf16x8*)(lds + PG8_SB(b, h) + boff + n * 2048 + k * 1024); } while (0)
#define PG8_MMA(ai, bj, At, Bt) do { __builtin_amdgcn_s_setprio(1); _Pragma("unroll") for (int m = 0; m < 4; ++m) _Pragma("unroll") for (int n = 0; n < 2; ++n) _Pragma("unroll") for (int k = 0; k < 2; ++k) \
        acc[ai][bj][m][n] = __builtin_amdgcn_mfma_f32_16x16x32_bf16(Bt[n][k], At[m][k], acc[ai][bj][m][n], 0, 0, 0); __builtin_amdgcn_s_setprio(0); } while (0)
#define PG8_WAIT_V(n) asm volatile("s_waitcnt vmcnt(" #n ")" ::: "memory")
#define PG8_WAIT_L(n) asm volatile("s_waitcnt lgkmcnt(" #n ")" ::: "memory")
#define PG8_BAR __builtin_amdgcn_s_barrier()
#define PG8_SCHED __builtin_amdgcn_sched_barrier(0)
    Unit cur, nxt; int ui = 0;
    if (!S.next(0, cur)) return;
    f32x4 acc[2][2][4][2];
#pragma unroll
    for (int a = 0; a < 2; ++a)
#pragma unroll
        for (int b = 0; b < 2; ++b)
#pragma unroll
            for (int m = 0; m < 4; ++m)
#pragma unroll
                for (int n = 0; n < 2; ++n) acc[a][b][m][n] = (f32x4){0.f, 0.f, 0.f, 0.f};
    bf16x8 At[4][2], B0[2][2], B1[2][2];
    const char* cA = (const char*)g.A + (size_t)cur.pm * tstep; const char* cB = (const char*)g.Bt + (size_t)cur.pn * tstep;
    S.a_ready(cur);
    if constexpr (SP2) {
        PG8_STAGE(PG8_SB(0, 0), cB, voffB); PG8_STAGE(PG8_SB(0, 1), cB + hstep, voffB); PG8_STAGE(PG8_SA(0, 0), cA, voffA); PG8_STAGE(PG8_SA(0, 1), cA + hstep, voffA);
        if (wr == 1) PG8_BAR;
        PG8_WAIT_V(2); PG8_BAR;
        PG8_STAGE(PG8_SB(1, 0), cB + kstep, voffB); PG8_STAGE(PG8_SA(1, 0), cA + kstep, voffA); PG8_STAGE(PG8_SB(1, 1), cB + hstep + kstep, voffB);
        PG8_WAIT_V(6); PG8_BAR;
    } else {
        PG8_STAGE(PG8_SB(0, 0), cB, voffB); PG8_STAGE(PG8_SA(0, 0), cA, voffA); PG8_STAGE(PG8_SB(0, 1), cB + hstep, voffB); PG8_STAGE(PG8_SA(0, 1), cA + hstep, voffA);
        if (wr == 1) PG8_BAR;
        PG8_WAIT_V(4); PG8_BAR;
        PG8_STAGE(PG8_SB(1, 0), cB + kstep, voffB); PG8_STAGE(PG8_SA(1, 0), cA + kstep, voffA); PG8_STAGE(PG8_SB(1, 1), cB + hstep + kstep, voffB);
        PG8_WAIT_V(6); PG8_BAR;
    }
    for (;;) {
        const bool has_next = S.next(ui + 1, nxt);
        const char* nA = has_next ? (const char*)g.A + (size_t)nxt.pm * tstep : cA; const char* nB = has_next ? (const char*)g.Bt + (size_t)nxt.pn * tstep : cB;
        for (int t = 0; t < nt; t += 2) {
            const bool last = (t == nt - 2);
            const char* a1 = cA + (size_t)(t + 1) * kstep;
            const char* a2 = last ? nA : cA + (size_t)(t + 2) * kstep; const char* b2 = last ? nB : cB + (size_t)(t + 2) * kstep;
            const char* a3 = a2 + kstep; const char* b3 = b2 + kstep;
            if (last && has_next) S.a_ready(nxt);
            if constexpr (SP2) {
            PG8_LDB(B0, 0, 0); PG8_LDB(B1, 0, 1); PG8_SCHED; PG8_LDA(At, 0, 0); PG8_STAGE(PG8_SA(1, 1), a1 + hstep, voffA);
            PG8_WAIT_V(8); PG8_WAIT_L(0); PG8_BAR; PG8_MMA(0, 0, At, B0); PG8_MMA(0, 1, At, B1); PG8_BAR; PG8_SCHED;
            PG8_LDA(At, 0, 1); PG8_STAGE(PG8_SB(0, 0), b2, voffB); PG8_STAGE(PG8_SB(0, 1), b2 + hstep, voffB); PG8_STAGE(PG8_SA(0, 0), a2, voffA);
            PG8_WAIT_V(8); PG8_WAIT_L(0); PG8_BAR; PG8_MMA(1, 0, At, B0); PG8_MMA(1, 1, At, B1); PG8_BAR; PG8_SCHED;
            PG8_LDB(B0, 1, 0); PG8_LDB(B1, 1, 1); PG8_SCHED; PG8_LDA(At, 1, 0); PG8_STAGE(PG8_SA(0, 1), a2 + hstep, voffA);
            PG8_WAIT_V(8); PG8_WAIT_L(0); PG8_BAR; PG8_MMA(0, 0, At, B0); PG8_MMA(0, 1, At, B1); PG8_BAR; PG8_SCHED;
            PG8_LDA(At, 1, 1); PG8_STAGE(PG8_SB(1, 0), b3, voffB); PG8_STAGE(PG8_SB(1, 1), b3 + hstep, voffB); PG8_STAGE(PG8_SA(1, 0), a3, voffA);
            PG8_WAIT_V(8); PG8_WAIT_L(0); PG8_BAR; PG8_MMA(1, 0, At, B0); PG8_MMA(1, 1, At, B1); PG8_BAR; PG8_SCHED;
            } else {
            PG8_LDB(B0, 0, 0); PG8_SCHED; PG8_LDA(At, 0, 0); PG8_STAGE(PG8_SA(1, 1), a1 + hstep, voffA);
            PG8_WAIT_L(8); PG8_BAR; PG8_WAIT_L(0); PG8_MMA(0, 0, At, B0); PG8_BAR; PG8_SCHED;
            PG8_LDB(B1, 0, 1); PG8_STAGE(PG8_SB(0, 0), b2, voffB);
            PG8_BAR; PG8_WAIT_L(0); PG8_MMA(0, 1, At, B1); PG8_BAR;
            PG8_LDA(At, 0, 1); PG8_STAGE(PG8_SA(0, 0), a2, voffA);
            PG8_BAR; PG8_WAIT_L(0); PG8_MMA(1, 0, At, B0); PG8_BAR; PG8_SCHED;
            PG8_STAGE(PG8_SB(0, 1), b2 + hstep, voffB);
            PG8_WAIT_V(6); PG8_BAR; PG8_MMA(1, 1, At, B1); PG8_BAR;
            PG8_LDB(B0, 1, 0); PG8_SCHED; PG8_LDA(At, 1, 0); PG8_STAGE(PG8_SA(0, 1), a2 + hstep, voffA);
            PG8_WAIT_L(8); PG8_BAR; PG8_WAIT_L(0); PG8_MMA(0, 0, At, B0); PG8_BAR; PG8_SCHED;
            PG8_LDB(B1, 1, 1); PG8_STAGE(PG8_SB(1, 0), b3, voffB);
            PG8_BAR; PG8_WAIT_L(0); PG8_MMA(0, 1, At, B1); PG8_BAR;
            PG8_LDA(At, 1, 1); PG8_STAGE(PG8_SA(1, 0), a3, voffA);
            PG8_BAR; PG8_WAIT_L(0); PG8_MMA(1, 0, At, B0); PG8_BAR; PG8_SCHED;
            PG8_STAGE(PG8_SB(1, 1), b3 + hstep, voffB);
            PG8_WAIT_V(6); PG8_BAR; PG8_MMA(1, 1, At, B1); PG8_BAR;
            }
        }
        if constexpr (ALIGN_EPI) { if (wr == 0) PG8_BAR; }
        if constexpr (!Epi::AFTER_DRAIN) { E(acc, cur, wr, wc, fr, fq); S.done(cur); }
        if (!has_next) break;
#pragma unroll
        for (int a = 0; a < 2; ++a)
#pragma unroll
            for (int b = 0; b < 2; ++b)
#pragma unroll
                for (int m = 0; m < 4; ++m)
#pragma unroll
                    for (int n = 0; n < 2; ++n) acc[a][b][m][n] = (f32x4){0.f, 0.f, 0.f, 0.f};
        cur = nxt; cA = nA; cB = nB; ++ui;
        if constexpr (ALIGN_EPI) { if (wr == 1) PG8_BAR; }
    }
    PG8_WAIT_V(0);
    if constexpr (!ALIGN_EPI) { if (wr == 0) PG8_BAR; }
    PG8_BAR;
    if constexpr (Epi::AFTER_DRAIN) { E.fused(acc, cur, wr, wc, fr, fq, lds, wid, lane); S.done(cur); }
#undef PG8_SA
#undef PG8_SB
#undef PG8_STAGE
#undef PG8_LDA
#undef PG8_LDB
#undef PG8_MMA
#undef PG8_WAIT_V
#undef PG8_WAIT_L
#undef PG8_BAR
#undef PG8_SCHED
}
}

#ifndef PG8_SP2
#define PG8_SP2 true
#endif
#ifndef PG8_ALIGN
#define PG8_ALIGN true
#endif

__device__ __forceinline__ float row_rstd16(const float* rowss, int row) {
    const f32x4* r = (const f32x4*)(rowss + (size_t)row * 16);
    const f32x4 a = r[0], b = r[1], c = r[2], d = r[3];
    const float s = ((a[0] + a[1]) + (a[2] + a[3])) + ((b[0] + b[1]) + (b[2] + b[3])) + ((c[0] + c[1]) + (c[2] + c[3])) + ((d[0] + d[1]) + (d[2] + d[3]));
    return rsqrtf(s * (1.f / DM) + EPS);
}
struct EpiProjF {
    static constexpr bool PERM = true, AFTER_DRAIN = false;
    const float* rowss; const float* cb; bf16_t* proj; float* side;
    __device__ __forceinline__ void operator()(const pg8::f32x4 (&acc)[2][2][4][2], const pg8::Unit& u, int wr, int wc, int fr, int fq) const {
        const int b = u.pm >> 4, colt = u.pn * 256 + wc * 32 + 8 * fq;
        f32x4 cv[2][2];
#pragma unroll
        for (int bj = 0; bj < 2; ++bj)
#pragma unroll
            for (int n = 0; n < 2; ++n) cv[bj][n] = *(const f32x4*)(cb + b * PINP + colt + bj * 128 + 4 * n);
#pragma unroll
        for (int ai = 0; ai < 2; ++ai)
#pragma unroll
            for (int m = 0; m < 4; ++m) {
                const int row = u.pm * 256 + ai * 128 + wr * 64 + m * 16 + fr; const float rs = row_rstd16(rowss, row);
#pragma unroll
                for (int bj = 0; bj < 2; ++bj) {
                    const f32x4 v0 = acc[ai][bj][m][0] * rs + cv[bj][0], v1 = acc[ai][bj][m][1] * rs + cv[bj][1]; const int col0 = colt + bj * 128;
                    u32x4 w; w[0] = pg8::cvt_pk_bf16(v0[0], v0[1]); w[1] = pg8::cvt_pk_bf16(v0[2], v0[3]); w[2] = pg8::cvt_pk_bf16(v1[0], v1[1]); w[3] = pg8::cvt_pk_bf16(v1[2], v1[3]);
                    *(u32x4*)(proj + (size_t)row * PINP + col0) = w;
                    if (col0 >= C_BF && col0 < PIN) { *(f32x4*)(side + (size_t)row * 16 + (col0 - C_BF)) = v0; *(f32x4*)(side + (size_t)row * 16 + (col0 - C_BF) + 4) = v1; }
                }
            }
    }
};
struct EpiUpF {
    static constexpr bool PERM = true, AFTER_DRAIN = false;
    const float* rowss; const float* cb; bf16_t* ug; bf16_t* uv;
    __device__ __forceinline__ void operator()(const pg8::f32x4 (&acc)[2][2][4][2], const pg8::Unit& u, int wr, int wc, int fr, int fq) const {
        const int b = u.pm >> 4, colt = u.pn * 256 + wc * 32 + 8 * fq, oc = u.pn * 128 + wc * 32 + 8 * fq;
        f32x4 cv[2][2];
#pragma unroll
        for (int bj = 0; bj < 2; ++bj)
#pragma unroll
            for (int n = 0; n < 2; ++n) cv[bj][n] = *(const f32x4*)(cb + b * NUP + colt + bj * 128 + 4 * n);
#pragma unroll
        for (int ai = 0; ai < 2; ++ai)
#pragma unroll
            for (int m = 0; m < 4; ++m) {
                const int row = u.pm * 256 + ai * 128 + wr * 64 + m * 16 + fr; const float rs = row_rstd16(rowss, row);
#pragma unroll
                for (int bj = 0; bj < 2; ++bj) {
                    const f32x4 v0 = acc[ai][bj][m][0] * rs + cv[bj][0], v1 = acc[ai][bj][m][1] * rs + cv[bj][1];
                    u32x4 w; w[0] = pg8::cvt_pk_bf16(v0[0], v0[1]); w[1] = pg8::cvt_pk_bf16(v0[2], v0[3]); w[2] = pg8::cvt_pk_bf16(v1[0], v1[1]); w[3] = pg8::cvt_pk_bf16(v1[2], v1[3]);
                    *(u32x4*)((bj ? uv : ug) + (size_t)row * DFF + oc) = w;
                }
            }
    }
};
struct EpiResF {
    static constexpr bool PERM = false, AFTER_DRAIN = false;
    const float* xin; float* xout; const float* gate; const float* g; const float* sc; bf16_t* xa; float* rowss;
    __device__ __forceinline__ void operator()(const pg8::f32x4 (&acc)[2][2][4][2], const pg8::Unit& u, int wr, int wc, int fr, int fq) const {
        const int b = u.pm >> 4, col0 = u.pn * 256 + wc * 32 + 4 * fq;
        f32x4 gt[2][2], gm[2][2];
#pragma unroll
        for (int bj = 0; bj < 2; ++bj)
#pragma unroll
            for (int n = 0; n < 2; ++n) { const int c = col0 + bj * 128 + n * 16; gt[bj][n] = *(const f32x4*)(gate + b * 6144 + c);
                if (xa) gm[bj][n] = *(const f32x4*)(g + c) * (*(const f32x4*)(sc + b * 6144 + c) + 1.0f); else gm[bj][n] = (f32x4){0.f, 0.f, 0.f, 0.f}; }
#pragma unroll
        for (int ai = 0; ai < 2; ++ai)
#pragma unroll
            for (int m = 0; m < 4; ++m) {
                const int row = u.pm * 256 + ai * 128 + wr * 64 + m * 16 + fr; float ss = 0.f;
#pragma unroll
                for (int bj = 0; bj < 2; ++bj)
#pragma unroll
                    for (int n = 0; n < 2; ++n) { const size_t off = (size_t)row * DM + col0 + bj * 128 + n * 16;
                        const f32x4 o = *(const f32x4*)(xin + off) + gt[bj][n] * acc[ai][bj][m][n];
                        *(f32x4*)(xout + off) = o; ss += (o[0] * o[0] + o[1] * o[1]) + (o[2] * o[2] + o[3] * o[3]);
                        if (xa) { const f32x4 q = o * gm[bj][n]; uint2 w; w.x = pg8::cvt_pk_bf16(q[0], q[1]); w.y = pg8::cvt_pk_bf16(q[2], q[3]); *(uint2*)(xa + off) = w; } }
                if (rowss) { ss += __shfl_xor(ss, 16); ss += __shfl_xor(ss, 32); if (fq == 0) rowss[(size_t)row * 16 + u.pn * 4 + wc] = ss; }
            }
    }
};


#define DPPF(oldv, src, CTRL) __builtin_bit_cast(float, __builtin_amdgcn_update_dpp(__builtin_bit_cast(int, (float)(oldv)), __builtin_bit_cast(int, (float)(src)), (CTRL), 0xf, 0xf, false))
struct EpiUpAct {
    static constexpr bool PERM = true, AFTER_DRAIN = false;
    const float* rowss; const float* cb; bf16_t* act; float* eg; float* ev; const float* cw; const float* cbias; LDSF float* xch; LDSF float* cst  ;
    __device__ __forceinline__ void operator()(const pg8::f32x4 (&acc)[2][2][4][2], const pg8::Unit& u, int wr, int wc, int fr, int fq) const {
        const int b = u.pm >> 4, cih = wc * 32 + 8 * fq, jcol = u.pn * 128 + cih;
        const float* cbg = cb + b * NUP + u.pn * 256 + cih; const float* cbv = cbg + 128;
        {
            const int tid = (wr * 4 + wc) * 64 + fq * 16 + fr, col = tid & 127, arr = tid >> 7;
            const float* src = (arr == 0) ? cb + b * NUP + u.pn * 256 + col : (arr == 1) ? cb + b * NUP + u.pn * 256 + 128 + col : cw + (arr - 2) * DFF + u.pn * 128 + col;
            cst[arr * 128 + col] = *src;
            if (tid < 256) { const int a2 = 4 + (tid >> 7); cst[a2 * 128 + col] = (a2 == 4) ? cw[2 * DFF + u.pn * 128 + col] : cbias[u.pn * 128 + col]; }
            else cst[768 + (tid - 256)] = row_rstd16(rowss, u.pm * 256 + (tid - 256));
            const f32x4 cg0 = *(const f32x4*)cbg, cg1 = *(const f32x4*)(cbg + 4);
#pragma unroll
            for (int ai = 0; ai < 2; ++ai) {
                const float r3 = row_rstd16(rowss, u.pm * 256 + ai * 128 + wr * 64 + 48 + fr);
                const f32x4 g0 = acc[ai][0][3][0] * r3 + cg0, g1 = acc[ai][0][3][1] * r3 + cg1;
                if (fr >= 14) { LDSF float* x = xch + ((((wr * 2 + ai) * 4 + wc) * 2 + (fr - 14)) * 32 + 8 * fq); *(LDSF f32x4*)x = g0; *(LDSF f32x4*)(x + 4) = g1;
                    if (wr == 1 && ai == 1) { float* e = eg + ((size_t)(u.pm * 4 + 2 + (fr - 14))) * DFF + jcol; *(f32x4*)e = g0; *(f32x4*)(e + 4) = g1; } }
            }
            if (wr == 0 && fr < 2) {
                const f32x4 cv0 = *(const f32x4*)cbv, cv1 = *(const f32x4*)(cbv + 4); const float r0 = row_rstd16(rowss, u.pm * 256 + fr);
                float* e = eg + ((size_t)(u.pm * 4 + fr)) * DFF + jcol; float* v = ev + ((size_t)(u.pm * 2 + fr)) * DFF + jcol;
                *(f32x4*)e = acc[0][0][0][0] * r0 + cg0; *(f32x4*)(e + 4) = acc[0][0][0][1] * r0 + cg1;
                *(f32x4*)v = acc[0][1][0][0] * r0 + cv0; *(f32x4*)(v + 4) = acc[0][1][0][1] * r0 + cv1;
            }
        }
        asm volatile("s_waitcnt vmcnt(0) lgkmcnt(0)" ::: "memory"); __builtin_amdgcn_s_barrier(); asm volatile("" ::: "memory");
#pragma unroll
        for (int ai = 0; ai < 2; ++ai) {
            f32x4 pvv[2];
            if (ai == 0 && wr == 0) { pvv[0] = (f32x4){0.f, 0.f, 0.f, 0.f}; pvv[1] = pvv[0]; }
            else { const int swr = (wr == 1) ? 0 : 1, sai = (wr == 1) ? ai : ai - 1;
                const LDSF float* x = xch + ((((swr * 2 + sai) * 4 + wc) * 2 + (fr & 1)) * 32 + 8 * fq); pvv[0] = *(const LDSF f32x4*)x; pvv[1] = *(const LDSF f32x4*)(x + 4); }
#pragma unroll
            for (int m = 0; m < 4; ++m) {
                asm volatile("" ::: "memory");
                const int row = u.pm * 256 + ai * 128 + wr * 64 + m * 16 + fr; const float rsm = cst[768 + ai * 128 + wr * 64 + m * 16 + fr];
                u32x4 w;
#pragma unroll
                for (int n = 0; n < 2; ++n) {
                    const LDSF float* cc = cst + cih + 4 * n;
                    const f32x4 cgn = *(const LDSF f32x4*)cc, cvn = *(const LDSF f32x4*)(cc + 128);
                    const f32x4 k0 = *(const LDSF f32x4*)(cc + 256), k1 = *(const LDSF f32x4*)(cc + 384), k2 = *(const LDSF f32x4*)(cc + 512), kb = *(const LDSF f32x4*)(cc + 640);
                    const f32x4 c = acc[ai][0][m][n] * rsm + cgn, v = acc[ai][1][m][n] * rsm + cvn; float o[4];
#pragma unroll
                    for (int i = 0; i < 4; ++i) {
                        const float gm1 = DPPF(DPPF(0.f, pvv[n][i], 0x121), c[i], 0x111);
                        const float gm2 = DPPF(DPPF(0.f, pvv[n][i], 0x122), c[i], 0x112);
                        const float cvv = k0[i] * gm2 + k1[i] * gm1 + k2[i] * c[i] + kb[i];
                        o[i] = cvv * __builtin_amdgcn_rcpf(1.f + __builtin_amdgcn_exp2f(-cvv * LOG2E)) * v[i];
                    }
                    w[2 * n] = pg8::cvt_pk_bf16(o[0], o[1]); w[2 * n + 1] = pg8::cvt_pk_bf16(o[2], o[3]);
                    pvv[n] = c;
                }
                *(u32x4*)(act + (size_t)row * DFF + jcol) = w;
            }
        }
    }
};
__device__ void act_fixup(const Params& p, int l, int pm) {
    if ((pm & 15) == 0) return;
    const float* eg = (const float*)(p.ws + WS_EG); const float* ev = (const float*)(p.ws + WS_EV); bf16_t* act = (bf16_t*)(p.ws + WS_ACT);
    const float* cw = p.conv_w + (size_t)l * 3 * DFF; const float* cbias = p.conv_b + (size_t)l * DFF;
    for (int idx = TID(); idx < 2 * DFF; idx += NTHR) {
        const int r = idx / DFF, j = idx - r * DFF;
        const float a = eg[((size_t)((pm - 1) * 4 + 2)) * DFF + j], bq = eg[((size_t)((pm - 1) * 4 + 3)) * DFF + j], c0 = eg[((size_t)(pm * 4 + 0)) * DFF + j], c1 = eg[((size_t)(pm * 4 + 1)) * DFF + j];
        const float gm2 = r ? bq : a, gm1 = r ? c0 : bq, gc = r ? c1 : c0;
        const float cvv = cw[j] * gm2 + cw[DFF + j] * gm1 + cw[2 * DFF + j] * gc + cbias[j];
        act[(size_t)(pm * 256 + r) * DFF + j] = f2bf(siluf(cvv) * ev[((size_t)(pm * 2 + r)) * DFF + j]);
    }
}

__device__ void ph_prep_knorm(const Params& p, int l) {
    bf16_t* proj = (bf16_t*)(p.ws + WS_PROJ);
    const int tid_ = TID(); const int lane = tid_ & 63, wv = tid_ >> 6;
    const int gw = blockIdx.x * (blockDim.x >> 6) + wv, ngw = gridDim.x * (blockDim.x >> 6);
    for (int row = gw; row < MTOK; row += ngw) {
        bf16_t* pr = proj + (size_t)row * PINP;
        {
            uint2 raw = *(const uint2*)(pr + CA_K + 4 * lane);
            float v0 = bf2f(raw.x & 0xffff), v1 = bf2f(raw.x >> 16), v2 = bf2f(raw.y & 0xffff), v3 = bf2f(raw.y >> 16);
            float ss = v0 * v0 + v1 * v1 + v2 * v2 + v3 * v3;
            ss += __shfl_xor(ss, 1); ss += __shfl_xor(ss, 2); ss += __shfl_xor(ss, 4);
            const float r = rsqrtf(ss * (1.f / 32.f) + EPS); const float* g = p.diff_kn + l * 32 + ((4 * lane) & 31);
            raw.x = pk2(v0 * r * g[0], v1 * r * g[1]); raw.y = pk2(v2 * r * g[2], v3 * r * g[3]);
            *(uint2*)(pr + CA_K + 4 * lane) = raw;
        }
        {
            uint2 raw = *(const uint2*)(pr + CB_K + 4 * lane);
            float v0 = bf2f(raw.x & 0xffff), v1 = bf2f(raw.x >> 16), v2 = bf2f(raw.y & 0xffff), v3 = bf2f(raw.y >> 16);
            float ss = v0 * v0 + v1 * v1 + v2 * v2 + v3 * v3;
            ss += __shfl_xor(ss, 1); ss += __shfl_xor(ss, 2); ss += __shfl_xor(ss, 4); ss += __shfl_xor(ss, 8);
            const float r = rsqrtf(ss * (1.f / 64.f) + EPS); const float* g = p.fox_kn + l * 64 + ((4 * lane) & 63);
            raw.x = pk2(v0 * r * g[0], v1 * r * g[1]); raw.y = pk2(v2 * r * g[2], v3 * r * g[3]);
            *(uint2*)(pr + CB_K + 4 * lane) = raw;
        }
        {
            const int hi = lane >> 5, li = lane & 31; bf16_t* q = pr + (hi ? CD_KW : CD_KS) + 2 * li;
            unsigned raw = *(const unsigned*)q; float v0 = bf2f(raw & 0xffff), v1 = bf2f(raw >> 16);
            float ss = v0 * v0 + v1 * v1;
            ss += __shfl_xor(ss, 1); ss += __shfl_xor(ss, 2); ss += __shfl_xor(ss, 4); ss += __shfl_xor(ss, 8); ss += __shfl_xor(ss, 16);
            const float r = rsqrtf(ss * (1.f / 64.f) + EPS); const float* g = p.nsa_kn + (l * 3 + (hi ? 2 : 1)) * 64 + 2 * li;
            *(unsigned*)q = pk2(v0 * r * g[0], v1 * r * g[1]);
        }
    }
}
__device__ void ph_prep_cum_bh(const Params& p, int l, int bh, unsigned char* lds) {
    const float* side = (const float*)(p.ws + WS_SIDE);
    float* cum = (float*)(p.ws + WS_CUM);
    LDSF float* wt = (LDSF float*)(lds + 70000);
    const int tid = TID(), lane = tid & 63, wv = tid >> 6;
    {
        const int b = bh >> 2, h = bh & 3; const float bf = p.fox_bf[l * 4 + h];
        float v[8]; float tot = 0.f;
#pragma unroll
        for (int i = 0; i < 8; ++i) { v[i] = logsigf(side[(size_t)(b * SEQ + tid * 8 + i) * 16 + h] + bf); tot += v[i]; v[i] = tot; }
        float inc = tot;
#pragma unroll
        for (int o = 1; o < 64; o <<= 1) { const float u = __shfl_up(inc, o); if (lane >= o) inc += u; }
        __syncthreads();
        if (lane == 63) wt[wv] = inc;
        __syncthreads();
        float base = inc - tot;
        for (int w8 = 0; w8 < wv; ++w8) base += wt[w8];
#pragma unroll
        for (int i = 0; i < 8; ++i) cum[bh * SEQ + tid * 8 + i] = base + v[i];
    }
}
__device__ void ph_prep_cmp(const Params& p, int l, unsigned char* lds) {
    const bf16_t* proj = (const bf16_t*)(p.ws + WS_PROJ);
    float* win = (float*)lds; float* red = (float*)(lds + 36864);
    const int tid = TID(), e = tid & 63, part = tid >> 6;
    for (int item = blockIdx.x; item < 4 * 2 * 32; item += gridDim.x) {
        const int b = item >> 6, which = (item >> 5) & 1, n0 = (item & 31) * 8;
        const int colbase = which ? CD_VC : CD_KC;
        __syncthreads();
        for (int i = tid; i < 144 * 64; i += NTHR) { const int tk = 16 * n0 + (i >> 6); win[i] = tk < SEQ ? bf2f(proj[(size_t)(b * SEQ + tk) * PINP + colbase + (i & 63)]) : 0.f; }
        __syncthreads();
        float acc[8];
#pragma unroll
        for (int nn = 0; nn < 8; ++nn) acc[nn] = 0.f;
        const float* phi = p.nsa_phi + (size_t)(l * 2 + which) * 2048 * 64; const float* pe = p.nsa_pe + (size_t)(l * 2 + which) * 32 * 64;
        for (int i = 4 * part; i < 4 * part + 4; ++i)
            for (int d = 0; d < 64; ++d) {
                const float ph = phi[(size_t)(i * 64 + d) * 64 + e], pv = pe[i * 64 + d];
#pragma unroll
                for (int nn = 0; nn < 8; ++nn) acc[nn] += (win[(16 * nn + i) * 64 + d] + pv) * ph;
            }
#pragma unroll
        for (int nn = 0; nn < 8; ++nn) red[(part * 8 + nn) * 64 + e] = acc[nn];
        __syncthreads();
        {
            const int nn = part, n = n0 + nn; float v = 0.f;
#pragma unroll
            for (int pp = 0; pp < 8; ++pp) v += red[(pp * 8 + nn) * 64 + e];
            bf16_t* dst = (bf16_t*)(p.ws + (which ? WS_VC : WS_KC)) + (size_t)(b * 256 + n) * 64 + e;
            if (n >= 255) *dst = 0;
            else if (which == 0) { const float ss = wave_sum(v * v); *dst = f2bf(v * rsqrtf(ss * (1.f / 64.f) + EPS) * p.nsa_kn[(l * 3 + 0) * 64 + e]); }
            else *dst = f2bf(v);
        }
    }
}

__device__ __forceinline__ void load8(const bf16_t* p, float* d) {
    const u32x4 r = *(const u32x4*)p;
    d[0] = bf2f(r[0] & 0xffff); d[1] = bf2f(r[0] >> 16); d[2] = bf2f(r[1] & 0xffff); d[3] = bf2f(r[1] >> 16);
    d[4] = bf2f(r[2] & 0xffff); d[5] = bf2f(r[2] >> 16); d[6] = bf2f(r[3] & 0xffff); d[7] = bf2f(r[3] >> 16);
}
template <int N> __device__ __forceinline__ float dotn(const float* q, const bf16_t* k) {
    float s = 0.f;
#pragma unroll
    for (int c = 0; c < N / 8; ++c) { float t[8]; load8(k + 8 * c, t);
#pragma unroll
        for (int j = 0; j < 8; ++j) s += q[8 * c + j] * t[j]; }
    return s;
}
template <int N> __device__ __forceinline__ void axpyn(float* o, float w, const bf16_t* v) {
#pragma unroll
    for (int c = 0; c < N / 8; ++c) { float t[8]; load8(v + 8 * c, t);
#pragma unroll
        for (int j = 0; j < 8; ++j) o[8 * c + j] += w * t[j]; }
}
template <int N> __device__ __forceinline__ void loadq_norm(float* q, const bf16_t* src, const float* g, float scale, bool norm) {
    float ss = 0.f;
#pragma unroll
    for (int c = 0; c < N / 8; ++c) load8(src + 8 * c, q + 8 * c);
#pragma unroll
    for (int j = 0; j < N; ++j) ss += q[j] * q[j];
    const float r = norm ? rsqrtf(ss * (1.f / N) + EPS) : 1.f;
#pragma unroll
    for (int j = 0; j < N; ++j) q[j] = q[j] * r * (norm ? g[j] : 1.f) * scale;
}
__device__ __forceinline__ void store64(bf16_t* dst, const float* o) {
#pragma unroll
    for (int c = 0; c < 8; ++c) { u32x4 w; w[0] = pk2(o[8 * c], o[8 * c + 1]); w[1] = pk2(o[8 * c + 2], o[8 * c + 3]); w[2] = pk2(o[8 * c + 4], o[8 * c + 5]); w[3] = pk2(o[8 * c + 6], o[8 * c + 7]); *(u32x4*)(dst + 8 * c) = w; }
}

typedef float f32x16 __attribute__((ext_vector_type(16)));
typedef short s16x4 __attribute__((ext_vector_type(4)));
#define LDSP __attribute__((address_space(3)))
constexpr int KSTR = 144;
constexpr int AL_KV = 17408;
constexpr int AL_BK = 2 * AL_KV  , AL_TB = AL_BK + 512  , AL_WSF = AL_TB + 512  , AL_MISC = AL_WSF + 2048  ,
              AL_IMP = 38912  , AL_SELM = AL_IMP + 65536  ,
              AL_TB4 = AL_SELM + 512  , AL_INVL = AL_TB4 + 2048  , AL_D_END = AL_INVL + 1024;
static_assert(AL_MISC + 64 <= AL_IMP && AL_D_END <= 131072, "attention LDS map");
__device__ __forceinline__ int crow(int r, int hi) { return (r & 3) + 8 * (r >> 2) + 4 * hi; }
__device__ __forceinline__ float ex2(float v) { return __builtin_amdgcn_exp2f(v); }
__device__ __forceinline__ s16x4 vtr(const LDSP unsigned char* p) { typedef short v4i16_t __attribute__((ext_vector_type(4))); return __builtin_bit_cast(s16x4, __builtin_amdgcn_ds_read_tr16_b64_v4i16((LDSP v4i16_t*)p)); }
__device__ __forceinline__ bf16x8 pack8(const f32x16& p, int b) {
    u32x4 w; w[0] = pg8::cvt_pk_bf16(p[b], p[b + 1]); w[1] = pg8::cvt_pk_bf16(p[b + 2], p[b + 3]); w[2] = pg8::cvt_pk_bf16(p[b + 4], p[b + 5]); w[3] = pg8::cvt_pk_bf16(p[b + 6], p[b + 7]);
    return __builtin_bit_cast(bf16x8, w);
}
__device__ __forceinline__ f32x16 splat16(float v) { return (f32x16){v, v, v, v, v, v, v, v, v, v, v, v, v, v, v, v}; }
template <int NK16>
__device__ __forceinline__ void qkt(f32x16& p0, f32x16& p1, const LDSP unsigned char* Kt, const bf16x8* qf, int dbase, int r32, int hi) {
    const LDSP unsigned char* kb = Kt + r32 * KSTR + hi * 16 + dbase * 32;
#pragma unroll
    for (int d0 = 0; d0 < NK16; ++d0) {
        const bf16x8 a0 = *(const LDSP bf16x8*)(kb + d0 * 32), a1 = *(const LDSP bf16x8*)(kb + 32 * KSTR + d0 * 32);
        p0 = __builtin_amdgcn_mfma_f32_32x32x16_bf16(a0, qf[d0], p0, 0, 0, 0);
        p1 = __builtin_amdgcn_mfma_f32_32x32x16_bf16(a1, qf[d0], p1, 0, 0, 0);
    }
}
__device__ __forceinline__ void pv(f32x16* o, const LDSP unsigned char* Vt, int vb, const f32x16& p0, const f32x16& p1) {
    bf16x8 pa[4]; pa[0] = pack8(p0, 0); pa[1] = pack8(p0, 8); pa[2] = pack8(p1, 0); pa[3] = pack8(p1, 8);
#pragma unroll
    for (int d0 = 0; d0 < 2; ++d0)
#pragma unroll
        for (int ks = 0; ks < 4; ++ks) {
            const s16x4 lo = vtr(Vt + vb + d0 * 4096 + ks * 1024), hh = vtr(Vt + vb + d0 * 4096 + ks * 1024 + 512);
            const bf16x8 vf = (bf16x8){lo[0], lo[1], lo[2], lo[3], hh[0], hh[1], hh[2], hh[3]};
            o[d0] = __builtin_amdgcn_mfma_f32_32x32x16_bf16(pa[ks], vf, o[d0], 0, 0, 0);
        }
}
__device__ __forceinline__ float exp_sum(f32x16& p0, f32x16& p1) {
    float s0 = 0.f, s1 = 0.f;
#pragma unroll
    for (int r = 0; r < 16; ++r) { p0[r] = ex2(p0[r]); p1[r] = ex2(p1[r]); s0 += p0[r]; s1 += p1[r]; }
    return s0 + s1;
}
__device__ __forceinline__ void scale_rows(f32x16* o, float f, LDSP float* wsf, int r32, int hi) {
    __builtin_amdgcn_wave_barrier();
    if (hi == 0) wsf[r32] = f;
    __builtin_amdgcn_s_waitcnt(0xc07f);
    __builtin_amdgcn_wave_barrier();
#pragma unroll
    for (int g = 0; g < 4; ++g) { const f32x4 a = *(const LDSP f32x4*)(wsf + 8 * g + 4 * hi);
#pragma unroll
        for (int i = 0; i < 4; ++i) { o[0][4 * g + i] *= a[i]; o[1][4 * g + i] *= a[i]; } }
    __builtin_amdgcn_wave_barrier();
}
__device__ __forceinline__ void store_o(const f32x16* o, LDSP bf16_t* stg, bf16_t* dst, int lane, int r32, int hi) {
    __builtin_amdgcn_wave_barrier();
#pragma unroll
    for (int r = 0; r < 16; ++r) { const int orow = crow(r, hi); stg[orow * 64 + r32] = f2bf(o[0][r]); stg[orow * 64 + 32 + r32] = f2bf(o[1][r]); }
    __builtin_amdgcn_s_waitcnt(0xc07f);
    __builtin_amdgcn_wave_barrier();
#pragma unroll
    for (int i = 0; i < 4; ++i) { const int row = i * 8 + (lane >> 3), ch = lane & 7; const u32x4 v = *(const LDSP u32x4*)(stg + row * 64 + ch * 8); *(u32x4*)(dst + (size_t)row * DM + ch * 8) = v; }
    __builtin_amdgcn_s_waitcnt(0xc07f);
    __builtin_amdgcn_wave_barrier();
}
template <int NG>
__device__ __forceinline__ void load_q(bf16x8* qf, const bf16_t* qrow  , const float* g, float sc, bool norm, int hi) {
    float v[4][8];
#pragma unroll
    for (int d0 = 0; d0 < 4; ++d0) load8(qrow + 16 * d0 + 8 * hi, v[d0]);
    float r0 = 1.f, r1 = 1.f;
    if (norm) {
        float s0 = 0.f, s1 = 0.f;
#pragma unroll
        for (int j = 0; j < 8; ++j) { s0 += v[0][j] * v[0][j] + v[1][j] * v[1][j]; s1 += v[2][j] * v[2][j] + v[3][j] * v[3][j]; }
        s0 += __shfl_xor(s0, 32); s1 += __shfl_xor(s1, 32);
        if (NG == 64) { r0 = rsqrtf((s0 + s1) * (1.f / 64.f) + EPS); r1 = r0; } else { r0 = rsqrtf(s0 * (1.f / 32.f) + EPS); r1 = rsqrtf(s1 * (1.f / 32.f) + EPS); }
    }
#pragma unroll
    for (int d0 = 0; d0 < 4; ++d0) {
        const float rr = (d0 < 2 ? r0 : r1) * sc; float w[8];
#pragma unroll
        for (int j = 0; j < 8; ++j) { const int d = 16 * d0 + 8 * hi + j; w[j] = v[d0][j] * rr * (norm ? g[d % NG] : 1.f); }
        u32x4 u; u[0] = pg8::cvt_pk_bf16(w[0], w[1]); u[1] = pg8::cvt_pk_bf16(w[2], w[3]); u[2] = pg8::cvt_pk_bf16(w[4], w[5]); u[3] = pg8::cvt_pk_bf16(w[6], w[7]);
        qf[d0] = __builtin_bit_cast(bf16x8, u);
    }
}
__device__ __forceinline__ void kv_load(u32x4& kr, u32x4& vr, const bf16_t* Kb, const bf16_t* Vb, int k0, int tid) {
    const size_t off = (size_t)(k0 + (tid >> 3)) * PINP + (tid & 7) * 8;
    kr = *(const u32x4*)(Kb + off); vr = *(const u32x4*)(Vb + off);
}
__device__ __forceinline__ void kv_load64(u32x4& kr, u32x4& vr, const bf16_t* Kb, const bf16_t* Vb, int n0, int tid) {
    const size_t off = (size_t)(n0 + (tid >> 3)) * 64 + (tid & 7) * 8;
    kr = *(const u32x4*)(Kb + off); vr = *(const u32x4*)(Vb + off);
}
__device__ __forceinline__ void kv_store(const u32x4& kr, const u32x4& vr, LDSP unsigned char* buf, int tid) {
    const int key = tid >> 3, ch = tid & 7;
    *(LDSP u32x4*)(buf + key * KSTR + ch * 16) = kr;
    *(LDSP u32x4*)(buf + 9216 + (ch >> 2) * 4096 + (key >> 4) * 1024 + ((key >> 3) & 1) * 512 + (key & 7) * 64 + (ch & 3) * 16) = vr;
}
template <int NG>
__device__ __forceinline__ void knorm_chunk(u32x4& kr, const float* gp  ) {
    float v[8];
    v[0] = bf2f(kr[0] & 0xffff); v[1] = bf2f(kr[0] >> 16); v[2] = bf2f(kr[1] & 0xffff); v[3] = bf2f(kr[1] >> 16);
    v[4] = bf2f(kr[2] & 0xffff); v[5] = bf2f(kr[2] >> 16); v[6] = bf2f(kr[3] & 0xffff); v[7] = bf2f(kr[3] >> 16);
    float ss = 0.f;
#pragma unroll
    for (int j = 0; j < 8; ++j) ss += v[j] * v[j];
    ss += __shfl_xor(ss, 1); ss += __shfl_xor(ss, 2); if (NG == 64) ss += __shfl_xor(ss, 4);
    const float r = rsqrtf(ss * (1.f / NG) + EPS);
    const f32x4 ga = *(const f32x4*)gp, gb = *(const f32x4*)(gp + 4);
    kr[0] = pg8::cvt_pk_bf16(v[0] * r * ga[0], v[1] * r * ga[1]); kr[1] = pg8::cvt_pk_bf16(v[2] * r * ga[2], v[3] * r * ga[3]);
    kr[2] = pg8::cvt_pk_bf16(v[4] * r * gb[0], v[5] * r * gb[1]); kr[3] = pg8::cvt_pk_bf16(v[6] * r * gb[2], v[7] * r * gb[3]);
}
__device__ __forceinline__ void bias_near(f32x16& p0, f32x16& p1, const LDSP float* tbl, int tk0  , int wnd, bool rowok, int hi) {
#pragma unroll
    for (int g = 0; g < 4; ++g) {
#pragma unroll
        for (int i = 0; i < 4; ++i) { const int r = 4 * g + i; const int d0_ = tk0 - crow(r, hi), d1_ = d0_ - 32;
            const float b0 = tbl[min(max(d0_, 0), 127)], b1 = tbl[min(max(d1_, 0), 127)];
            p0[r] = (d0_ < 0 || d0_ >= wnd || !rowok) ? -INFINITY : p0[r] + b0; p1[r] = (d1_ < 0 || d1_ >= wnd || !rowok) ? -INFINITY : p1[r] + b1; }
        asm volatile("" ::: "memory");
    }
}
#define KVBUF(L, i) ((L) + ((i) & 1) * AL_KV)

__device__ void fa_fox_unit(const Params& p, int l, int b, int h, int qb, LDSP unsigned char* L) {
    const int tid = TID(), lane = tid & 63, wid = __builtin_amdgcn_readfirstlane(tid >> 6), r32 = lane & 31, hi = lane >> 5;
    const bf16_t* proj = (const bf16_t*)(p.ws + WS_PROJ); bf16_t* mix = (bf16_t*)(p.ws + WS_MIX);
    const size_t rb = (size_t)b * SEQ; const int q0 = qb * 256, qw = q0 + 32 * wid, t = qw + r32;
    const bf16_t* Kb = proj + rb * PINP + CB_K + 64 * h; const bf16_t* Vb = proj + rb * PINP + CB_V + 64 * h;
    const float* cm = (const float*)(p.ws + WS_CUM) + (b * 4 + h) * SEQ;
    LDSP float* wsf = (LDSP float*)(L + AL_WSF) + wid * 64; LDSP float* bk = (LDSP float*)(L + AL_BK);
    const int vb = 9216 + ((lane >> 4) & 1) * 32 + (lane & 3) * 8 + (4 * hi + ((lane & 15) >> 2)) * 64;
    bf16x8 qf[4]; load_q<64>(qf, proj + (rb + t) * PINP + CB_Q + 64 * h, p.fox_qn + l * 64, 0.125f * LOG2E, true, hi);
    const float rowc = cm[t] * LOG2E - ((const float*)(p.ws + WS_BND))[l * 32 + 4];
    f32x16 o[2]; o[0] = (f32x16){}; o[1] = (f32x16){};
    float l_run = 0.f;
    const int NT = 4 * qb + 4, jd = 4 * qb + (wid >> 1);
    u32x4 kr, vr; float cr = 0.f; const float* gk = p.fox_kn + l * 64 + (tid & 7) * 8;
    __syncthreads();
    kv_load(kr, vr, Kb, Vb, 0, tid); if (tid < 64) cr = cm[tid];
    knorm_chunk<64>(kr, gk); kv_store(kr, vr, KVBUF(L, 0), tid); if (tid < 64) bk[tid] = -cr * LOG2E;
    kv_load(kr, vr, Kb, Vb, 64, tid); if (tid < 64) cr = cm[64 + tid];
    for (int j = 0; j < NT; ++j) {
        __syncthreads();
        if (j + 1 < NT) { knorm_chunk<64>(kr, gk); kv_store(kr, vr, KVBUF(L, j + 1), tid); if (tid < 64) bk[((j + 1) & 1) * 64 + tid] = -cr * LOG2E; }
        if (j + 2 < NT) { kv_load(kr, vr, Kb, Vb, 64 * (j + 2), tid); if (tid < 64) cr = cm[64 * (j + 2) + tid]; }
        if (j <= jd) {
            const LDSP unsigned char* buf = KVBUF(L, j); const LDSP float* bkj = bk + (j & 1) * 64;
            f32x16 p0, p1;
#pragma unroll
            for (int g = 0; g < 4; ++g) { const f32x4 b0 = *(const LDSP f32x4*)(bkj + 8 * g + 4 * hi), b1 = *(const LDSP f32x4*)(bkj + 32 + 8 * g + 4 * hi);
#pragma unroll
                for (int i = 0; i < 4; ++i) { p0[4 * g + i] = b0[i] + rowc; p1[4 * g + i] = b1[i] + rowc; } }
            qkt<4>(p0, p1, buf, qf, 0, r32, hi);
            if (j == jd) { const int k0 = 64 * j;
#pragma unroll
                for (int r = 0; r < 16; ++r) { const int kk = k0 + crow(r, hi); if (kk > t) p0[r] = -INFINITY; if (kk + 32 > t) p1[r] = -INFINITY; } }
            l_run += exp_sum(p0, p1);
            pv(o, buf, vb, p0, p1);
        }
    }
    l_run += __shfl_xor(l_run, 32);
    scale_rows(o, 1.f / l_run, wsf, r32, hi);
    store_o(o, (LDSP bf16_t*)(L + AL_IMP + wid * 8192), mix + (rb + qw) * DM + 256 + 64 * h, lane, r32, hi);
}

__device__ void fa_diff_unit(const Params& p, int l, int b, int h, int qb, LDSP unsigned char* L) {
    const int tid = TID(), lane = tid & 63, wid = __builtin_amdgcn_readfirstlane(tid >> 6), r32 = lane & 31, hi = lane >> 5;
    const bf16_t* proj = (const bf16_t*)(p.ws + WS_PROJ); bf16_t* mix = (bf16_t*)(p.ws + WS_MIX);
    const size_t rb = (size_t)b * SEQ; const int q0 = qb * 256, qw = q0 + 32 * wid, t = qw + r32;
    const bf16_t* Kb = proj + rb * PINP + CA_K + 64 * h; const bf16_t* Vb = proj + rb * PINP + CA_V + 64 * h;
    LDSP float* wsf = (LDSP float*)(L + AL_WSF) + wid * 64; LDSP float* tbl = (LDSP float*)(L + AL_TB);
    const int vb = 9216 + ((lane >> 4) & 1) * 32 + (lane & 3) * 8 + (4 * hi + ((lane & 15) >> 2)) * 64;
    const float lam = ((const float*)(p.ws + WS_LAM))[l]; const float lam_init = 0.8f - 0.6f * __expf(-0.3f * (float)l);
    const float nbound = -((const float*)(p.ws + WS_BND))[l * 32 + h];
    __syncthreads();
    if (tid < 128) tbl[tid] = ((const float*)(p.ws + WS_TB))[h * 128 + tid] * LOG2E;
    bf16x8 qf[4]; load_q<32>(qf, proj + (rb + t) * PINP + CA_Q + 64 * h, p.diff_qn + l * 32, 0.17677669529663687f * LOG2E, true, hi);
    f32x16 o1[2], o2[2]; o1[0] = (f32x16){}; o1[1] = (f32x16){}; o2[0] = (f32x16){}; o2[1] = (f32x16){};
    float l1 = 0.f, l2 = 0.f;
    const int NT = 4 * qb + 4, jd = 4 * qb + (wid >> 1);
    u32x4 kr, vr; const float* gk = p.diff_kn + l * 32 + (tid & 3) * 8;
    kv_load(kr, vr, Kb, Vb, 0, tid);
    knorm_chunk<32>(kr, gk); kv_store(kr, vr, KVBUF(L, 0), tid);
    kv_load(kr, vr, Kb, Vb, 64, tid);
    for (int j = 0; j < NT; ++j) {
        __syncthreads();
        if (j + 1 < NT) { knorm_chunk<32>(kr, gk); kv_store(kr, vr, KVBUF(L, j + 1), tid); }
        if (j + 2 < NT) kv_load(kr, vr, Kb, Vb, 64 * (j + 2), tid);
        if (j <= jd) {
            const LDSP unsigned char* buf = KVBUF(L, j);
            const int k0 = 64 * j; const bool nearb = (qw - (k0 + 63)) < 113; const float cfar = tbl[127] + nbound;
#pragma unroll
            for (int mp = 0; mp < 2; ++mp) {
                f32x16 p0 = splat16(nearb ? nbound : cfar), p1 = p0;
                qkt<2>(p0, p1, buf, qf + 2 * mp, 2 * mp, r32, hi);
                if (nearb) bias_near(p0, p1, tbl, t - k0, 1 << 30, true, hi);
                if (mp == 0) { l1 += exp_sum(p0, p1); pv(o1, buf, vb, p0, p1); }
                else { l2 += exp_sum(p0, p1); pv(o2, buf, vb, p0, p1); }
            }
        }
    }
    l1 += __shfl_xor(l1, 32); l2 += __shfl_xor(l2, 32);
    scale_rows(o1, 1.f / l1, wsf, r32, hi); scale_rows(o2, lam / l2, wsf, r32, hi);
    o1[0] -= o2[0]; o1[1] -= o2[1];
    const float g0 = p.diff_sub[l * 64 + r32] * (1.f - lam_init), g1 = p.diff_sub[l * 64 + 32 + r32] * (1.f - lam_init);
#pragma unroll
    for (int r = 0; r < 16; ++r) {
        float ss = o1[0][r] * o1[0][r] + o1[1][r] * o1[1][r];
        ss += __shfl_xor(ss, 1); ss += __shfl_xor(ss, 2); ss += __shfl_xor(ss, 4); ss += __shfl_xor(ss, 8); ss += __shfl_xor(ss, 16);
        const float rs = rsqrtf(ss * (1.f / 64.f) + EPS); o1[0][r] *= rs * g0; o1[1][r] *= rs * g1;
    }
    store_o(o1, (LDSP bf16_t*)(L + AL_IMP + wid * 8192), mix + (rb + qw) * DM + 0 + 64 * h, lane, r32, hi);
}

__device__ __forceinline__ void stick_sub(f32x16& y, float& carry, int kbase  , int t, bool diag, int hi) {
    float lk[16];
#pragma unroll
    for (int r = 0; r < 16; ++r) {
        const float v = y[r]; const float e = ex2(-fabsf(v)); const float lb = fminf(v, 0.f) - __builtin_amdgcn_logf(1.f + e);
        const bool valid = !diag || (kbase + crow(r, hi) < t);
        lk[r] = valid ? (lb - v) : 0.f; y[r] = valid ? lb : -INFINITY;
    }
    float T[4], Go[4];
#pragma unroll
    for (int g = 0; g < 4; ++g) { const float Gs = (lk[4 * g] + lk[4 * g + 1]) + (lk[4 * g + 2] + lk[4 * g + 3]); Go[g] = __shfl_xor(Gs, 32); T[g] = Gs + Go[g]; }
    float sx = 0.f;
#pragma unroll
    for (int g = 3; g >= 0; --g) {
        float tail = carry + sx + (hi == 0 ? Go[g] : 0.f);
#pragma unroll
        for (int i = 3; i >= 0; --i) { y[4 * g + i] = ex2(y[4 * g + i] + tail); tail += lk[4 * g + i]; }
        sx += T[g];
    }
    carry += sx;
}
__device__ void fa_stick_unit(const Params& p, int l, int b, int h, int qb, LDSP unsigned char* L) {
    const int tid = TID(), lane = tid & 63, wid = __builtin_amdgcn_readfirstlane(tid >> 6), r32 = lane & 31, hi = lane >> 5;
    const bf16_t* proj = (const bf16_t*)(p.ws + WS_PROJ); bf16_t* mix = (bf16_t*)(p.ws + WS_MIX);
    const size_t rb = (size_t)b * SEQ; const int q0 = qb * 256, qw = q0 + 32 * wid, t = qw + r32;
    const bf16_t* Kb = proj + rb * PINP + CC_K + 64 * h; const bf16_t* Vb = proj + rb * PINP + CC_V + 64 * h;
    const int vb = 9216 + ((lane >> 4) & 1) * 32 + (lane & 3) * 8 + (4 * hi + ((lane & 15) >> 2)) * 64;
    bf16x8 qf[4]; load_q<64>(qf, proj + (rb + t) * PINP + CC_Q + 64 * h, nullptr, 0.125f * LOG2E, false, hi);
    f32x16 o[2]; o[0] = (f32x16){}; o[1] = (f32x16){};
    float carry = 0.f;
    const int NT = 4 * qb + 4, jd = 4 * qb + (wid >> 1);
    u32x4 kr, vr;
    kv_load(kr, vr, Kb, Vb, 64 * (NT - 1), tid);
    for (int j = NT - 1; j >= 0; --j) {
        __syncthreads();
        kv_store(kr, vr, KVBUF(L, 0), tid);
        __syncthreads();
        if (j > 0) kv_load(kr, vr, Kb, Vb, 64 * (j - 1), tid);
        if (j <= jd) {
            const LDSP unsigned char* buf = KVBUF(L, 0);
            f32x16 p0 = (f32x16){}, p1 = (f32x16){};
            qkt<4>(p0, p1, buf, qf, 0, r32, hi);
            const int k0 = 64 * j; const bool diag = (j == jd);
            stick_sub(p1, carry, k0 + 32, t, diag, hi);
            stick_sub(p0, carry, k0, t, diag, hi);
            pv(o, buf, vb, p0, p1);
        }
    }
    store_o(o, (LDSP bf16_t*)(L + AL_IMP + wid * 8192), mix + (rb + qw) * DM + 512 + 64 * h, lane, r32, hi);
}

__device__ void fa_nsa_unit(const Params& p, int l, int b, int u, LDSP unsigned char* L) {
    const int tid = TID(), lane = tid & 63, wid = __builtin_amdgcn_readfirstlane(tid >> 6), r32 = lane & 31, hi = lane >> 5;
    const int hh = wid >> 1, sub = wid & 1;
    const bf16_t* proj = (const bf16_t*)(p.ws + WS_PROJ); bf16_t* mix = (bf16_t*)(p.ws + WS_MIX);
    const size_t rb = (size_t)b * SEQ; const int q0 = 64 * u, qw = q0 + 32 * sub, t = qw + r32; const int ql = 32 * sub + r32;
    LDSP float* wsf = (LDSP float*)(L + AL_WSF) + wid * 64; LDSP float* tbl = (LDSP float*)(L + AL_TB4) + hh * 128;
    LDSP float* imp = (LDSP float*)(L + AL_IMP); LDSP unsigned* selm = (LDSP unsigned*)(L + AL_SELM); LDSP float* invl = (LDSP float*)(L + AL_INVL);
    LDSP float* ofl = (LDSP float*)(L + AL_IMP) + wid * 2048 + lane;
    const int vb = 9216 + ((lane >> 4) & 1) * 32 + (lane & 3) * 8 + (4 * hi + ((lane & 15) >> 2)) * 64;
    const float* bnd = (const float*)(p.ws + WS_BND) + l * 32;
    __syncthreads();
    ((LDSP float*)(L + AL_TB4))[tid] = ((const float*)(p.ws + WS_TB))[512 + tid] * LOG2E;
    bf16x8 qf[4]; load_q<64>(qf, proj + (rb + t) * PINP + CD_Q + 64 * hh, p.nsa_qn + l * 64, 0.125f * LOG2E, true, hi);
    const float* sd = (const float*)(p.ws + WS_SIDE) + (rb + t) * 16 + 4 + hh;
    const float gc = 1.f / (1.f + __expf(-sd[0])), gs = 1.f / (1.f + __expf(-sd[4])), gwn = 1.f / (1.f + __expf(-sd[8]));
    f32x16 o[2]; o[0] = (f32x16){}; o[1] = (f32x16){};
    u32x4 kr, vr;
    {
        const bf16_t* Kc = (const bf16_t*)(p.ws + WS_KC) + (size_t)b * 256 * 64; const bf16_t* Vc = (const bf16_t*)(p.ws + WS_VC) + (size_t)b * 256 * 64;
        const int ntc = (4 * u + 2) / 64 + 1; const float nbound = -bnd[5 + hh];
        float l_run = 0.f, prevE3 = 0.f;
        kv_load64(kr, vr, Kc, Vc, 0, tid);
        kv_store(kr, vr, KVBUF(L, 0), tid);
        if (ntc > 1) kv_load64(kr, vr, Kc, Vc, 64, tid);
        for (int T = 0; T < ntc; ++T) {
            __syncthreads();
            if (T + 1 < ntc) kv_store(kr, vr, KVBUF(L, T + 1), tid);
            if (T + 2 < ntc) kv_load64(kr, vr, Kc, Vc, 64 * (T + 2), tid);
            const LDSP unsigned char* buf = KVBUF(L, T);
            f32x16 p0 = splat16(nbound), p1 = p0;
            qkt<4>(p0, p1, buf, qf, 0, r32, hi);
#pragma unroll
            for (int g = 0; g < 4; ++g) {
#pragma unroll
                for (int i = 0; i < 4; ++i) { const int r = 4 * g + i; const int d0_ = t - 16 * (64 * T + crow(r, hi)) - 31, d1_ = d0_ - 512;
                    const float b0 = tbl[min(max(d0_, 0), 127)], b1 = tbl[min(max(d1_, 0), 127)];
                    p0[r] = (d0_ < 0) ? -INFINITY : p0[r] + b0; p1[r] = (d1_ < 0) ? -INFINITY : p1[r] + b1; }
                asm volatile("" ::: "memory");
            }
            l_run += exp_sum(p0, p1);
#pragma unroll
            for (int s2 = 0; s2 < 2; ++s2) {
                float G[4], Eo[4];
#pragma unroll
                for (int g = 0; g < 4; ++g) { const float a0 = s2 ? p1[4 * g] : p0[4 * g], a1 = s2 ? p1[4 * g + 1] : p0[4 * g + 1], a2 = s2 ? p1[4 * g + 2] : p0[4 * g + 2], a3 = s2 ? p1[4 * g + 3] : p0[4 * g + 3];
                    G[g] = (a0 + a1) + (a2 + a3); Eo[g] = __shfl_xor(a3, 32); }
#pragma unroll
                for (int g = 0; g < 4; ++g) { const float eprev = hi ? Eo[g] : (g > 0 ? Eo[g - 1] : prevE3);
                    imp[(hh * 64 + ql) * 64 + 16 * T + 8 * s2 + 2 * g + hi] = G[g] + eprev; }
                prevE3 = Eo[3];
            }
            pv(o, buf, vb, p0, p1);
        }
        l_run += __shfl_xor(l_run, 32);
        const float inv = (l_run > 0.f) ? 1.f / l_run : 0.f;
        if (hi == 0) invl[hh * 64 + ql] = inv;
        scale_rows(o, gc * inv, wsf, r32, hi);
    }
    __syncthreads();
    {
        const int q = tid >> 3, part = tid & 7;
        const float i0 = invl[q], i1 = invl[64 + q], i2 = invl[128 + q], i3 = invl[192 + q];
        float vj[8];
#pragma unroll
        for (int jj = 0; jj < 8; ++jj) { const int j = part * 8 + jj;
            const float sum = ((imp[(0 * 64 + q) * 64 + j] * i0 + imp[(1 * 64 + q) * 64 + j] * i1) + imp[(2 * 64 + q) * 64 + j] * i2) + imp[(3 * 64 + q) * 64 + j] * i3;
            vj[jj] = (j > u) ? -1.0f : ((j == u || j == 0) ? 1.0e4f : sum); }
        __syncthreads();
#pragma unroll
        for (int jj = 0; jj < 8; ++jj) imp[q * 64 + part * 8 + jj] = vj[jj];
        __syncthreads();
        int rank[8];
#pragma unroll
        for (int jj = 0; jj < 8; ++jj) rank[jj] = 0;
        for (int i = 0; i < 64; ++i) { const float vi = imp[q * 64 + i];
#pragma unroll
            for (int jj = 0; jj < 8; ++jj) rank[jj] += (vi > vj[jj] || (vi == vj[jj] && i < part * 8 + jj)) ? 1 : 0; }
        unsigned bits = 0;
#pragma unroll
        for (int jj = 0; jj < 8; ++jj) if (rank[jj] < 16 && (part * 8 + jj) <= u) bits |= 1u << jj;
        unsigned mlo = (part < 4) ? (bits << (8 * part)) : 0u, mhi = (part >= 4) ? (bits << (8 * (part - 4))) : 0u;
        mlo |= __shfl_xor(mlo, 1); mhi |= __shfl_xor(mhi, 1); mlo |= __shfl_xor(mlo, 2); mhi |= __shfl_xor(mhi, 2); mlo |= __shfl_xor(mlo, 4); mhi |= __shfl_xor(mhi, 4);
        if (part == 0) { selm[2 * q] = mlo; selm[2 * q + 1] = mhi; }
    }
    __syncthreads();
#pragma unroll
    for (int r = 0; r < 16; ++r) { ofl[(2 * r) * 64] = o[0][r]; ofl[(2 * r + 1) * 64] = o[1][r]; }
    o[0] = (f32x16){}; o[1] = (f32x16){};
    {
        const unsigned long long mymask = (unsigned long long)selm[2 * ql] | ((unsigned long long)selm[2 * ql + 1] << 32);
        unsigned ulo = selm[2 * lane], uhi = selm[2 * lane + 1];
#pragma unroll
        for (int s2 = 1; s2 < 64; s2 <<= 1) { ulo |= __shfl_xor(ulo, s2); uhi |= __shfl_xor(uhi, s2); }
        unsigned long long um = (unsigned long long)(unsigned)__builtin_amdgcn_readfirstlane((int)ulo) | ((unsigned long long)(unsigned)__builtin_amdgcn_readfirstlane((int)uhi) << 32);
        const bf16_t* Kb = proj + rb * PINP + CD_KS; const bf16_t* Vb = proj + rb * PINP + CD_VS;
        float l_run = 0.f; const float nbound = -bnd[9 + hh]; const float cfar = tbl[127] + nbound; const float* gk = p.nsa_kn + (l * 3 + 1) * 64 + (tid & 7) * 8;
        int j = __builtin_ctzll(um); um &= um - 1;
        int jn = um ? __builtin_ctzll(um) : -1; um &= um - 1;
        kv_load(kr, vr, Kb, Vb, 64 * j, tid);
        knorm_chunk<64>(kr, gk); kv_store(kr, vr, KVBUF(L, 0), tid);
        if (jn >= 0) kv_load(kr, vr, Kb, Vb, 64 * jn, tid);
        for (int it = 0;; ++it) {
            __syncthreads();
            const int jnn = um ? __builtin_ctzll(um) : -1; um &= um - 1;
            if (jn >= 0) { knorm_chunk<64>(kr, gk); kv_store(kr, vr, KVBUF(L, it + 1), tid); }
            if (jnn >= 0) kv_load(kr, vr, Kb, Vb, 64 * jnn, tid);
            const bool mine = (mymask >> j) & 1ull;
            if (__any(mine)) {
                const LDSP unsigned char* buf = KVBUF(L, it);
                const int k0 = 64 * j; const bool nearb = (qw - (k0 + 63)) < 113;
                f32x16 p0 = splat16(nearb ? nbound : (mine ? cfar : -INFINITY)), p1 = p0;
                qkt<4>(p0, p1, buf, qf, 0, r32, hi);
                if (nearb) bias_near(p0, p1, tbl, t - k0, 1 << 30, mine, hi);
                l_run += exp_sum(p0, p1);
                pv(o, buf, vb, p0, p1);
            }
            if (jn < 0) break;
            j = jn; jn = jnn;
        }
        l_run += __shfl_xor(l_run, 32);
        scale_rows(o, gs / l_run, wsf, r32, hi);
#pragma unroll
        for (int r = 0; r < 16; ++r) { ofl[(2 * r) * 64] += o[0][r]; ofl[(2 * r + 1) * 64] += o[1][r]; }
        o[0] = (f32x16){}; o[1] = (f32x16){};
    }
    {
        const bf16_t* Kb = proj + rb * PINP + CD_KW; const bf16_t* Vb = proj + rb * PINP + CD_VW;
        float l_run = 0.f; const float nbound = -bnd[13 + hh]; const float cfar = tbl[127] + nbound; const float* gk = p.nsa_kn + (l * 3 + 2) * 64 + (tid & 7) * 8;
        const int jlo = max(0, u - 8);
        __syncthreads();
        kv_load(kr, vr, Kb, Vb, 64 * jlo, tid);
        knorm_chunk<64>(kr, gk); kv_store(kr, vr, KVBUF(L, jlo), tid);
        if (jlo < u) kv_load(kr, vr, Kb, Vb, 64 * (jlo + 1), tid);
        for (int j = jlo; j <= u; ++j) {
            __syncthreads();
            if (j + 1 <= u) { knorm_chunk<64>(kr, gk); kv_store(kr, vr, KVBUF(L, j + 1), tid); }
            if (j + 2 <= u) kv_load(kr, vr, Kb, Vb, 64 * (j + 2), tid);
            const LDSP unsigned char* buf = KVBUF(L, j);
            const int k0 = 64 * j; const bool nearb = (j == u || j == u - 8 || (qw - (k0 + 63)) < 113);
            f32x16 p0 = splat16(nearb ? nbound : cfar), p1 = p0;
            qkt<4>(p0, p1, buf, qf, 0, r32, hi);
            if (nearb) bias_near(p0, p1, tbl, t - k0, 512, true, hi);
            l_run += exp_sum(p0, p1);
            pv(o, buf, vb, p0, p1);
        }
        l_run += __shfl_xor(l_run, 32);
        scale_rows(o, gwn / l_run, wsf, r32, hi);
#pragma unroll
        for (int r = 0; r < 16; ++r) { o[0][r] += ofl[(2 * r) * 64]; o[1][r] += ofl[(2 * r + 1) * 64]; }
    }
    store_o(o, (LDSP bf16_t*)(L + AL_IMP + wid * 8192), mix + (rb + qw) * DM + 768 + 64 * hh, lane, r32, hi);
}

__device__ void ph_reset_queues(const Params& p) { unsigned* ctl = (unsigned*)(p.ws + WS_CTL); const int gt = GTID(); if (gt < 8) ctl[gt] = 0u; }
__device__ void fa_phase_all(const Params& p, int l, LDSP unsigned char* L, int qslot) {
    unsigned* ctl = (unsigned*)(p.ws + WS_CTL);
    LDSP unsigned* misc = (LDSP unsigned*)(L + AL_MISC);
    for (;;) {
        __syncthreads();
        if (threadIdx.x == 0) misc[0] = atomicAdd(&ctl[qslot], 1u);
        __syncthreads();
        const unsigned qi = misc[0];
        if (qi >= 1024u) break;
        const int r = 15 - (int)(qi >> 6), j = (int)(qi & 63), typ = j >> 4, sub = j & 15;
        if (typ == 0) fa_diff_unit(p, l, sub >> 2, sub & 3, r, L);
        else if (typ == 1) fa_fox_unit(p, l, sub >> 2, sub & 3, r, L);
        else if (typ == 2) fa_stick_unit(p, l, sub >> 2, sub & 3, r, L);
        else fa_nsa_unit(p, l, sub >> 2, 4 * r + (sub & 3), L);
    }
}


__device__ void prep_cmp_task(const Params& p, int l, int task, LDSP unsigned char* L) {
    const int tid = TID(), lane = tid & 63, wid = __builtin_amdgcn_readfirstlane(tid >> 6), r32 = lane & 31, hi = lane >> 5;
    const int b = task >> 4, which = (task >> 3) & 1, nt = task & 7;
    const bf16_t* proj = (const bf16_t*)(p.ws + WS_PROJ);
    const bf16_t* phiT = (const bf16_t*)(p.ws + WS_PHIT) + (size_t)(l * 2 + which) * 64 * 2048;
    const float* pe = p.nsa_pe + (size_t)(l * 2 + which) * 32 * 64;
    const int n = 32 * nt + r32, colbase = which ? CD_VC : CD_KC;
    f32x16 acc0 = (f32x16){}, acc1 = (f32x16){};
#pragma unroll
    for (int ii = 0; ii < 4; ++ii) {
        const int i = 4 * wid + ii; const int tok = min(16 * n + i, SEQ - 1);
        const bf16_t* xr = proj + (size_t)(b * SEQ + tok) * PINP + colbase;
#pragma unroll
        for (int d0 = 0; d0 < 4; ++d0) {
            float xv[8]; load8(xr + 16 * d0 + 8 * hi, xv);
            const f32x4 pe0 = *(const f32x4*)(pe + i * 64 + 16 * d0 + 8 * hi), pe1 = *(const f32x4*)(pe + i * 64 + 16 * d0 + 8 * hi + 4);
            u32x4 aw; aw[0] = pg8::cvt_pk_bf16(xv[0] + pe0[0], xv[1] + pe0[1]); aw[1] = pg8::cvt_pk_bf16(xv[2] + pe0[2], xv[3] + pe0[3]);
            aw[2] = pg8::cvt_pk_bf16(xv[4] + pe1[0], xv[5] + pe1[1]); aw[3] = pg8::cvt_pk_bf16(xv[6] + pe1[2], xv[7] + pe1[3]);
            const bf16x8 af = __builtin_bit_cast(bf16x8, aw);
            const bf16x8 b0 = *(const bf16x8*)(phiT + (size_t)r32 * 2048 + i * 64 + 16 * d0 + 8 * hi);
            const bf16x8 b1 = *(const bf16x8*)(phiT + (size_t)(32 + r32) * 2048 + i * 64 + 16 * d0 + 8 * hi);
            acc0 = __builtin_amdgcn_mfma_f32_32x32x16_bf16(af, b0, acc0, 0, 0, 0);
            acc1 = __builtin_amdgcn_mfma_f32_32x32x16_bf16(af, b1, acc1, 0, 0, 0);
        }
    }
    LDSP float* red = (LDSP float*)L;
    __syncthreads();
#pragma unroll
    for (int r = 0; r < 16; ++r) { red[(wid * 32 + crow(r, hi)) * 64 + r32] = acc0[r]; red[(wid * 32 + crow(r, hi)) * 64 + 32 + r32] = acc1[r]; }
    __syncthreads();
    {
        const int row = tid >> 4, e4 = (tid & 15) * 4; f32x4 v = (f32x4){0.f, 0.f, 0.f, 0.f};
#pragma unroll
        for (int w8 = 0; w8 < 8; ++w8) v += *(const LDSP f32x4*)(red + (w8 * 32 + row) * 64 + e4);
        const int nn = 32 * nt + row;
        if (which == 0) {
            float ss = (v[0] * v[0] + v[1] * v[1]) + (v[2] * v[2] + v[3] * v[3]);
            ss += __shfl_xor(ss, 1); ss += __shfl_xor(ss, 2); ss += __shfl_xor(ss, 4); ss += __shfl_xor(ss, 8);
            const float rs = rsqrtf(ss * (1.f / 64.f) + EPS); const f32x4 g = *(const f32x4*)(p.nsa_kn + (l * 3 + 0) * 64 + e4);
            v = v * rs * g;
        }
        uint2 o; o.x = pk2(v[0], v[1]); o.y = pk2(v[2], v[3]);
        if (nn >= 255) { o.x = 0u; o.y = 0u; }
        *(uint2*)((bf16_t*)(p.ws + (which ? WS_VC : WS_KC)) + (size_t)(b * 256 + nn) * 64 + e4) = o;
    }
}
__device__ void ph_prep(const Params& p, int l, LDSP unsigned char* L, unsigned char* lds) {
    for (int t = blockIdx.x; t < 80; t += gridDim.x) { if (t < 64) prep_cmp_task(p, l, t, L); }
    if (gridDim.x >= 80) { if (blockIdx.x >= 64 && blockIdx.x < 80) ph_prep_cum_bh(p, l, blockIdx.x - 64, lds); }
    else for (int bh = blockIdx.x; bh < 16; bh += gridDim.x) ph_prep_cum_bh(p, l, bh, lds);
}

#define XB_TMO      128
#define XB_XCNT(j)  (256  + 64 * (j))
#define XB_XSUB(j)  (1280 + 64 * (j))
#define XB_XGEN(j)  (2304 + 64 * (j))
#define XB_TOP      3328
#define XB_TOPGEN   3392
#define XCD_BAR_WORDS 3456
#define XB_SPIN_CAP (1u << 18)

__device__ __forceinline__ unsigned xb_ld(unsigned* p)              { return __hip_atomic_load(p, __ATOMIC_RELAXED, __HIP_MEMORY_SCOPE_AGENT); }
__device__ __forceinline__ unsigned xb_add(unsigned* p, unsigned v) { return __hip_atomic_fetch_add(p, v, __ATOMIC_RELAXED, __HIP_MEMORY_SCOPE_AGENT); }
__device__ __forceinline__ unsigned xb_xcc_id() { return (unsigned)__builtin_amdgcn_s_getreg((3 << 11) | 20) & 0xFu; }
#define XB_SPIN(cond, bar) do { unsigned _sp = 0; while (cond) { __builtin_amdgcn_s_sleep(1); \
    if ((++_sp & 255u) == 0u) { if (xb_ld(&(bar)[XB_TMO])) break; if (_sp > XB_SPIN_CAP) { atomicAdd(&(bar)[XB_TMO], 1u); break; } } } } while (0)

struct XcdBarrier {
    unsigned* bar; unsigned x;
    volatile LDSF unsigned* st;
};

__device__ __forceinline__ XcdBarrier xcd_barrier_post(unsigned* bar, volatile LDSF unsigned* st) {
    XcdBarrier b; b.bar = bar; b.x = xb_xcc_id(); b.st = st;
    if (threadIdx.x == 0) (void)xb_add(&bar[XB_XCNT(b.x)], 1u);
    return b;
}
__device__ __forceinline__ void xcd_barrier_complete(unsigned* bar, unsigned x, unsigned& nloc, unsigned& nx) {
    const unsigned G = gridDim.x * gridDim.y * gridDim.z;
    unsigned sum, cnt, mine, sp = 0u;
    for (;;) {
        sum = 0u; cnt = 0u; mine = 0u;
#pragma unroll
        for (unsigned j = 0; j < 16; ++j) { const unsigned c = xb_ld(&bar[XB_XCNT(j)]); sum += c; cnt += (c > 0u) ? 1u : 0u; mine = (j == x) ? c : mine; }
        if (sum == G) break;
        __builtin_amdgcn_s_sleep(1);
        if ((++sp & 255u) == 0u) { if (xb_ld(&bar[XB_TMO])) break; if (sp > XB_SPIN_CAP) { atomicAdd(&bar[XB_TMO], 1u); break; } }
    }
    nloc = mine > 0u ? mine : 1u; nx = cnt > 0u ? cnt : 1u;
}

__device__ __forceinline__ void xcd_barrier(const XcdBarrier& b) {
    asm volatile("s_waitcnt vmcnt(0)" ::: "memory");
    __syncthreads();
    if (threadIdx.x == 0) {
        unsigned* bar = b.bar;
        __builtin_amdgcn_s_waitcnt(0);
        unsigned nloc = b.st[0], nx = b.st[1];
        if (nloc == 0u) { xcd_barrier_complete(bar, b.x, nloc, nx); b.st[0] = nloc; b.st[1] = nx; }
        const unsigned old = xb_add(&bar[XB_XSUB(b.x)], 1u);
        const unsigned gen = old / nloc;
        if (old + 1u == (gen + 1u) * nloc) {
            __builtin_amdgcn_fence(__ATOMIC_RELEASE, "agent");
            asm volatile("s_waitcnt vmcnt(0)" ::: "memory");
            const unsigned og = xb_add(&bar[XB_TOP], 1u);
            const unsigned tg = og / nx;
            if (og + 1u == (tg + 1u) * nx) xb_add(&bar[XB_TOPGEN], 1u);
            else XB_SPIN(xb_ld(&bar[XB_TOPGEN]) == tg, bar);
            __builtin_amdgcn_fence(__ATOMIC_ACQUIRE, "agent");
            xb_add(&bar[XB_XGEN(b.x)], 1u);
            asm volatile("s_waitcnt vmcnt(0)" ::: "memory");
        } else {
            XB_SPIN(xb_ld(&bar[XB_XGEN(b.x)]) == gen, bar);
            __builtin_amdgcn_fence(__ATOMIC_ACQUIRE, "agent");
            asm volatile("s_waitcnt vmcnt(0)" ::: "memory");
        }
    }
    __syncthreads();
}

namespace cg = cooperative_groups;
constexpr int LDS_BYTES = 131072 + 8192 + 4096;
#define LAS3 __attribute__((address_space(3)))
#ifndef PROBE
#define PROBE 0
#endif
__global__ void __launch_bounds__(NTHR, 2) mega(Params p) {
    extern __shared__ __attribute__((aligned(16))) unsigned char lds[];
    cg::grid_group grid = cg::this_grid();
#if PROBE
    unsigned long long tacc = 0, tph = 0, t0_;
#define GSYNC() do { t0_ = __builtin_amdgcn_s_memrealtime(); xcd_barrier(xbar); tacc += __builtin_amdgcn_s_memrealtime() - t0_; } while (0)
#define TPK(k, ...) do { if (PROBE == (k)) { t0_ = __builtin_amdgcn_s_memrealtime(); __VA_ARGS__; tph += __builtin_amdgcn_s_memrealtime() - t0_; } else { __VA_ARGS__; } } while (0)
#else
#define GSYNC() xcd_barrier(xbar)
#define TPK(k, ...) do { __VA_ARGS__; } while (0)
#endif
    LAS3 unsigned char* lds3 = (LAS3 unsigned char*)lds;
    volatile LDSF unsigned* bst = (volatile LDSF unsigned*)(lds3 + 131072 + 2048);
    if (threadIdx.x < 2) bst[threadIdx.x] = 0u;
    __syncthreads();
    XcdBarrier xbar = xcd_barrier_post((unsigned*)(p.ws + WS_CTL) + 16384, bst);
    TPK(2, ph_mod(p, lds); ph_reset_queues(p); ph_weights(p, 0, lds); ph_weights(p, 1, lds));
    grid.sync();
    for (int l = 0; l < DEPTH; ++l) {
        const float* mod = (const float*)(p.ws + WS_MOD) + (size_t)l * 4 * 6144;
        if (l == 0) {
            TPK(2, ph_cbias(p, lds); ph_xa_from(p, p.x, 0, 0, (bf16_t*)(p.ws + WS_XA), (float*)(p.ws + WS_RSA), true));
            GSYNC();
        }
        {   pg8::Gemm g{(const bf16_t*)(p.ws + WS_XA), (const bf16_t*)(p.ws + WS_WIN + l * WS_W1OFF), MTOK, PINP, DM}; pg8::StaticOrder S; S.init(MTOK, PINP, (int)gridDim.x, (int)blockIdx.x);
            EpiProjF E{(const float*)(p.ws + WS_RSA), (const float*)(p.ws + WS_CBIN) + (size_t)l * 4 * PINP, (bf16_t*)(p.ws + WS_PROJ), (float*)(p.ws + WS_SIDE)};
            TPK(6, pg8::gemm_phase<EpiProjF, pg8::StaticOrder, PG8_ALIGN, PG8_SP2>(lds3, g, S, E)); }
        GSYNC();
        TPK(2, ph_prep(p, l, lds3, lds));
        GSYNC();
        TPK(7, fa_phase_all(p, l, lds3, l));
        GSYNC();
        {   pg8::Gemm g{(const bf16_t*)(p.ws + WS_MIX), (const bf16_t*)(p.ws + WS_WOUT + l * WS_W1OFF), MTOK, DM, DM}; pg8::StaticOrder S; S.init(MTOK, DM, (int)gridDim.x, (int)blockIdx.x);
            EpiResF E{l == 0 ? p.x : p.out, p.out, mod + 2048, p.norm_ffn_g + l * DM, mod + 4096, (bf16_t*)(p.ws + WS_XA), (float*)(p.ws + WS_RSB)};
            TPK(6, pg8::gemm_phase<EpiResF, pg8::StaticOrder, PG8_ALIGN, PG8_SP2>(lds3, g, S, E)); }
        GSYNC();
        {   pg8::Gemm g{(const bf16_t*)(p.ws + WS_XA), (const bf16_t*)(p.ws + WS_WUP + l * WS_W1OFF), MTOK, NUP, DM}; pg8::StaticOrder S; S.init(MTOK, NUP, (int)gridDim.x, (int)blockIdx.x);
            EpiUpAct E{(const float*)(p.ws + WS_RSB), (const float*)(p.ws + WS_CBUP) + (size_t)l * 4 * NUP, (bf16_t*)(p.ws + WS_ACT), (float*)(p.ws + WS_EG), (float*)(p.ws + WS_EV),
                       p.conv_w + (size_t)l * 3 * DFF, p.conv_b + (size_t)l * DFF, (LDSF float*)(lds3 + 131072 + 4096), (LDSF float*)(lds3 + 131072 + 8192)};
            TPK(6, pg8::gemm_phase<EpiUpAct, pg8::StaticOrder, true, PG8_SP2>(lds3, g, S, E)); }
        GSYNC();
        {   const float* modn = (const float*)(p.ws + WS_MOD) + (size_t)(l + 1) * 4 * 6144; const bool more = (l + 1 < DEPTH);
            pg8::Gemm g{(const bf16_t*)(p.ws + WS_ACT), (const bf16_t*)(p.ws + WS_WDN + l * WS_W1OFF), MTOK, DM, DFF}; pg8::StaticOrder S; S.init(MTOK, DM, (int)gridDim.x, (int)blockIdx.x);
            { pg8::Unit fu; for (int i = 0; S.next(i, fu); ++i) act_fixup(p, l, fu.pm); }
            __builtin_amdgcn_fence(__ATOMIC_RELEASE, "agent"); __builtin_amdgcn_fence(__ATOMIC_ACQUIRE, "agent"); __syncthreads();
            EpiResF E{p.out, p.out, mod + 5120, p.norm_mix_g + (more ? l + 1 : l) * DM, more ? modn + 1024 : mod + 1024, more ? (bf16_t*)(p.ws + WS_XA) : nullptr, more ? (float*)(p.ws + WS_RSA) : nullptr};
            TPK(6, pg8::gemm_phase<EpiResF, pg8::StaticOrder, PG8_ALIGN, PG8_SP2>(lds3, g, S, E)); }
        if (l + 1 < DEPTH) GSYNC();
    }
#if PROBE == 1
    if (blockIdx.x == 0 && threadIdx.x == 0) p.out[0] += 0.05f + (float)tacc * 0.01f * 5e-4f;
#elif PROBE >= 2
    if (blockIdx.x == 0 && threadIdx.x == 0) p.out[0] += 0.05f + (float)tph * 0.01f * 1e-4f;
#endif
}

extern "C" void kernel_launch(void* const* d_in, const int* in_sizes, int in, void* d_out, int out_size, void* d_ws, size_t ws_size, hipStream_t stream) {
    if (in != 24 || ws_size < WS_END || out_size != MTOK * DM) { fprintf(stderr, "kernel_launch: unexpected sizes (in %d, ws %zu, out %d)\n", in, ws_size, out_size); return; }
    static int grid_blocks = 0;
    if (!grid_blocks) {
        int dev = 0, cus = 0, per_cu = 0;
        hipGetDevice(&dev);
        hipDeviceGetAttribute(&cus, hipDeviceAttributeMultiprocessorCount, dev);
        hipFuncSetAttribute((const void*)mega, hipFuncAttributeMaxDynamicSharedMemorySize, LDS_BYTES);
        hipOccupancyMaxActiveBlocksPerMultiprocessor(&per_cu, (const void*)mega, NTHR, LDS_BYTES);
        if (per_cu < 1) { fprintf(stderr, "kernel_launch: occupancy query returned %d\n", per_cu); per_cu = 1; }
        if (per_cu > 1) per_cu = 1;
        grid_blocks = cus * per_cu;
        fprintf(stderr, "kernel_launch: cus %d per_cu %d grid %d\n", cus, per_cu, grid_blocks);
    }
    if (hipMemsetAsync((char*)d_ws + WS_CTL + 65536, 0, XCD_BAR_WORDS * 4, stream) != hipSuccess) { fprintf(stderr, "kernel_launch: memset failed\n"); return; }
    Params p{};
    const float** f = (const float**)&p;
    for (int i = 0; i < 24; ++i) f[i] = (const float*)d_in[i];
    p.out = (float*)d_out; p.ws = (unsigned char*)d_ws;
    void* args[] = {&p};
    hipError_t e = hipLaunchCooperativeKernel((const void*)mega, dim3(grid_blocks), dim3(NTHR), args, LDS_BYTES, stream);
    if (e != hipSuccess) fprintf(stderr, "cooperative launch failed: %s (grid %d)\n", hipGetErrorString(e), grid_blocks);
}
```

```cpp
#include <hip/hip_runtime.h>
#include <hip/hip_cooperative_groups.h>
#include <cstdint>
#include <cstdio>

typedef unsigned short bf16_t;
typedef short bf16x8 __attribute__((ext_vector_type(8)));
typedef float f32x4 __attribute__((ext_vector_type(4)));
typedef unsigned u32x4 __attribute__((ext_vector_type(4)));

constexpr int NB = 4, SEQ = 4096, DM = 1024, MTOK = NB * SEQ, DEPTH = 2;
constexpr int HD = 64, HPM = 4, DFF = 2816, PIN = 2960, PINP = 3072, NUP = 2 * DFF;
constexpr float EPS = 1e-6f;
constexpr float LOG2E = 1.4426950408889634f;
constexpr int NTHR = 512;

constexpr int CA_Q = 0, CA_K = 256, CA_V = 512, CB_Q = 768, CB_K = 1024, CB_V = 1280, CC_Q = 1536, CC_K = 1792, CC_V = 2048;
constexpr int CD_Q = 2304, CD_KC = 2560, CD_VC = 2624, CD_KS = 2688, CD_VS = 2752, CD_KW = 2816, CD_VW = 2880, C_BF = 2944, C_DG = 2948;

constexpr size_t MiB = 1u << 20;
constexpr size_t WS_CTL = 0;
constexpr size_t WS_MOD = 1 * MiB;
constexpr size_t WS_CBIN = WS_MOD + 2 * 4 * 6144 * 4;
constexpr size_t WS_CBUP = WS_CBIN + 2 * 4 * 3072 * 4;
constexpr size_t WS_TB = WS_CBUP + 2 * 4 * 5632 * 4;
constexpr size_t WS_LAM = WS_TB + 2 * 4 * 128 * 4;
constexpr size_t WS_BND = WS_LAM + 64;
constexpr size_t WS_CUM = WS_LAM + 512;
constexpr size_t WS_KC = WS_CUM + 16 * 4096 * 4;
constexpr size_t WS_VC = WS_KC + 4 * 256 * 64 * 2;
constexpr size_t WS_SELM = WS_VC + 4 * 256 * 64 * 2;
constexpr size_t WS_SMALL_END = WS_SELM + 16384 * 8;
static_assert(WS_SMALL_END <= 4 * MiB, "small region");
constexpr size_t WS_RSA = 4 * MiB;
constexpr size_t WS_RSB = 5 * MiB;
constexpr size_t WS_SIDE = 6 * MiB;
constexpr size_t WS_IMP = 7 * MiB;
constexpr size_t WS_ML = 11 * MiB;
constexpr size_t WS_PHIT = 7 * MiB;
constexpr size_t WS_W = 12 * MiB;
constexpr size_t WS_WIN = WS_W;
constexpr size_t WS_WOUT = WS_WIN + (size_t)PINP * DM * 2;
constexpr size_t WS_WUP = WS_WOUT + (size_t)DM * DM * 2;
constexpr size_t WS_WDN = WS_WUP + (size_t)NUP * DM * 2;
constexpr size_t WS_W_END = WS_WDN + (size_t)DM * DFF * 2;
static_assert(WS_W_END <= 38 * MiB, "weights region");
constexpr size_t WS_XA = 38 * MiB;
constexpr size_t WS_BIG = 70 * MiB;
constexpr size_t WS_PROJ = WS_BIG;
constexpr size_t WS_MIX = WS_BIG + 96 * MiB;
constexpr size_t WS_ACT = WS_BIG;
constexpr size_t WS_W1OFF = 188 * MiB;
constexpr size_t WS_EG = 228 * MiB;
constexpr size_t WS_EV = 232 * MiB;
constexpr size_t WS_END = 236 * MiB;
static_assert(WS_W_END + WS_W1OFF <= WS_EG && WS_MIX + 32 * MiB <= WS_W + WS_W1OFF, "layer-1 weights");
static_assert(WS_END <= 256 * MiB, "workspace");

struct Params {
    const float *x, *c, *rel_bias, *ada_w, *ada_b, *norm_mix_g, *norm_ffn_g, *w_in, *w_out;
    const float *diff_qn, *diff_kn, *diff_lam, *diff_sub, *fox_qn, *fox_kn, *fox_bf;
    const float *nsa_qn, *nsa_kn, *nsa_pe, *nsa_phi, *w_up, *conv_w, *conv_b, *w_down;
    float* out;
    unsigned char* ws;
};

__device__ __forceinline__ float bf2f(bf16_t v) { return __uint_as_float(((unsigned)v) << 16); }
__device__ __forceinline__ bf16_t f2bf(float f) { unsigned u = __float_as_uint(f); return (bf16_t)((u + 0x7fffu + ((u >> 16) & 1u)) >> 16); }
__device__ __forceinline__ unsigned pk2(float lo, float hi) { return (unsigned)f2bf(lo) | ((unsigned)f2bf(hi) << 16); }
__device__ __forceinline__ float siluf(float v) { return v / (1.f + __expf(-v)); }
__device__ __forceinline__ float logsigf(float v) { return fminf(v, 0.f) - log1pf(__expf(-fabsf(v))); }
__device__ __forceinline__ float wave_sum(float v) {
#pragma unroll
    for (int o = 1; o < 64; o <<= 1) v += __shfl_xor(v, o);
    return v;
}
__device__ __forceinline__ int t5_bucket(int n) {
    if (n < 16) return n < 0 ? 0 : n;
    return 16 + (n >= 19) + (n >= 21) + (n >= 24) + (n >= 27) + (n >= 31) + (n >= 35) + (n >= 40) + (n >= 46) + (n >= 52) + (n >= 59) + (n >= 67) + (n >= 77) + (n >= 87) + (n >= 99) + (n >= 113);
}
__host__ __device__ __forceinline__ int in_col_map(int n) {
    if (n < 1536) return n;
    if (n < 2944) return n + 4;
    if (n < 2948) return 1536 + (n - 2944);
    if (n < 2960) return n;
    return -1;
}
__host__ __device__ __forceinline__ int up_col_map(int n) {
    const int pn = n >> 8, c = n & 255;
    return c < 128 ? (128 * pn + c) : (DFF + 128 * pn + (c - 128));
}

__device__ __forceinline__ int opaque_v(int v) { asm volatile("" : "+v"(v)); return v; }
#define TID() opaque_v((int)threadIdx.x)
#define GTID() ((int)(blockIdx.x * blockDim.x) + TID())
#define GSIZE() ((int)(gridDim.x * blockDim.x))

#define LDSF __attribute__((address_space(3)))
__device__ __forceinline__ void gemv4_block(const float* W, int ld, int oc, const LDSF float* vec, LDSF float* red, float* out0, int ostride, int n, float bias, int tid) {
    const int lane = tid & 63, wv = tid >> 6;
    float a0 = 0.f, a1 = 0.f, a2 = 0.f, a3 = 0.f;
    if (oc >= 0) {
        const float* w = W + (size_t)(wv * 128) * ld + oc;
#pragma unroll 32
        for (int k = 0; k < 128; ++k) { const float wk = w[(size_t)k * ld]; const f32x4 v = *(const LDSF f32x4*)(vec + (wv * 128 + k) * 4); a0 += v[0] * wk; a1 += v[1] * wk; a2 += v[2] * wk; a3 += v[3] * wk; }
    }
    red[(wv * 4 + 0) * 64 + lane] = a0; red[(wv * 4 + 1) * 64 + lane] = a1; red[(wv * 4 + 2) * 64 + lane] = a2; red[(wv * 4 + 3) * 64 + lane] = a3;
    __syncthreads();
    if (tid < 256) { const int bt = tid >> 6; float sacc = 0.f;
#pragma unroll
        for (int w8 = 0; w8 < 8; ++w8) sacc += red[(w8 * 4 + bt) * 64 + lane];
        out0[(size_t)bt * ostride + n] = sacc + bias; }
    __syncthreads();
}
__device__ void ph_mod(const Params& p, unsigned char* lds) {
    float* mod = (float*)(p.ws + WS_MOD);
    float* tb = (float*)(p.ws + WS_TB);
    float* lamv = (float*)(p.ws + WS_LAM);
    LDSF float* vec = (LDSF float*)lds; LDSF float* red = (LDSF float*)(lds + 16384);
    const int tid = TID();
    bool loaded = false;
    for (int item = blockIdx.x; item < DEPTH * 96; item += gridDim.x) {
        if (!loaded) { for (int i = tid; i < 4096; i += NTHR) { const int bt = i >> 10, k = i & 1023; vec[k * 4 + bt] = siluf(p.c[bt * DM + k]); } __syncthreads(); loaded = true; }
        const int l = item / 96, n = (item % 96) * 64 + (tid & 63);
        gemv4_block(p.ada_w + (size_t)l * DM * 6144, 6144, n, vec, red, mod + (size_t)l * 4 * 6144, 6144, n, p.ada_b[l * 6144 + n], tid);
    }
    const int gt = GTID(), gs = GSIZE();
    for (int idx = gt; idx < 2 * 4 * 128; idx += gs) {
        const int type = idx / 512, h = (idx / 128) & 3, d = idx & 127;
        tb[idx] = p.rel_bias[t5_bucket(d) * 8 + type * 4 + h];
    }
    for (int idx = gt; idx < DEPTH * 32; idx += gs) {
        const int l = idx >> 5, e = idx & 31; float v = 0.f;
        if (e < 17) {
            const int type = (e < 5) ? 0 : 1, h = (e < 4) ? e : ((e == 4) ? 0 : ((e - 5) & 3));
            const int ng = (e < 4) ? 32 : 64;
            const float* gq = (e < 4) ? p.diff_qn + l * 32 : ((e == 4) ? p.fox_qn + l * 64 : p.nsa_qn + l * 64);
            const float* gk = (e < 4) ? p.diff_kn + l * 32 : ((e == 4) ? p.fox_kn + l * 64 : p.nsa_kn + (l * 3 + (e - 5) / 4) * 64);
            float mq = 0.f, mk = 0.f; for (int i = 0; i < ng; ++i) { mq = fmaxf(mq, fabsf(gq[i])); mk = fmaxf(mk, fabsf(gk[i])); }
            float tm = 0.f; if (e != 4) { tm = -INFINITY; for (int bk2 = 0; bk2 < 32; ++bk2) tm = fmaxf(tm, p.rel_bias[bk2 * 8 + type * 4 + h]); }
            v = sqrtf((float)ng) * mq * mk * 1.02f * LOG2E + tm * LOG2E;
        }
        ((float*)(p.ws + WS_BND))[idx] = v;
    }
    for (int idx = gt; idx < DEPTH; idx += gs) {
        const float* lv = p.diff_lam + idx * 4 * 32;
        float s1 = 0.f, s2 = 0.f;
        for (int i = 0; i < 32; ++i) { s1 += lv[i] * lv[32 + i]; s2 += lv[64 + i] * lv[96 + i]; }
        const float lam_init = 0.8f - 0.6f * expf(-0.3f * (float)idx);
        lamv[idx] = expf(s1) - expf(s2) + lam_init;
    }
}
__device__ void ph_cbias(const Params& p, unsigned char* lds) {
    const float* mod = (const float*)(p.ws + WS_MOD);
    LDSF float* vec = (LDSF float*)lds; LDSF float* red = (LDSF float*)(lds + 16384);
    const int tid = TID();
    for (int item = blockIdx.x; item < DEPTH * 136; item += gridDim.x) {
        const int l = item / 136, r = item % 136; const bool isin = r < 48; const int n = (isin ? r : r - 48) * 64 + (tid & 63);
        const int shoff = isin ? 0 : 3072;
        __syncthreads();
        for (int i = tid; i < 4096; i += NTHR) { const int bt = i >> 10, k = i & 1023; vec[k * 4 + bt] = mod[(size_t)(l * 4 + bt) * 6144 + shoff + k]; }
        __syncthreads();
        if (isin) gemv4_block(p.w_in + (size_t)l * DM * PIN, PIN, in_col_map(n), vec, red, (float*)(p.ws + WS_CBIN) + (size_t)l * 4 * PINP, PINP, n, 0.f, tid);
        else gemv4_block(p.w_up + (size_t)l * DM * NUP, NUP, up_col_map(n), vec, red, (float*)(p.ws + WS_CBUP) + (size_t)l * 4 * NUP, NUP, n, 0.f, tid);
    }
}
template <int MAPK>
__device__ void convert_weight(const float* W, int K, int Nsrc, int Npad, bf16_t* Wt, LDSF float* scr, int gw, int ngw, int lane) {
    const int nkb = K / 64, nnb = Npad / 32;
    for (int it = gw; it < nkb * nnb; it += ngw) {
        const int kb = it / nnb, nb = it % nnb, k0 = kb * 64, n0 = nb * 32;
        {
            const int nn = lane & 31; const int n = n0 + nn;
            const int oc = MAPK == 0 ? n : (MAPK == 1 ? in_col_map(n) : up_col_map(n));
            float tv[32];
            const float* wp = W + (size_t)(k0 + (lane >> 5)) * Nsrc + (oc >= 0 ? oc : 0);
#pragma unroll
            for (int i = 0; i < 32; ++i) tv[i] = wp[(size_t)(2 * i) * Nsrc];
#pragma unroll
            for (int i = 0; i < 32; ++i) scr[(2 * i + (lane >> 5)) * 33 + nn] = (oc >= 0) ? tv[i] : 0.f;
        }
        __builtin_amdgcn_s_waitcnt(0xc07f); __builtin_amdgcn_wave_barrier();
        {
            const int c = lane & 7;
#pragma unroll
            for (int j = 0; j < 4; ++j) { const int n = (lane >> 3) + 8 * j; const LDSF float* sp = scr + (8 * c) * 33 + n;
                u32x4 o; o[0] = pk2(sp[0], sp[33]); o[1] = pk2(sp[66], sp[99]); o[2] = pk2(sp[132], sp[165]); o[3] = pk2(sp[198], sp[231]);
                *(u32x4*)(Wt + (size_t)(n0 + n) * K + k0 + 8 * c) = o; }
        }
        __builtin_amdgcn_s_waitcnt(0xc07f); __builtin_amdgcn_wave_barrier();
    }
}
__device__ void ph_weights(const Params& p, int l, unsigned char* lds) {
    const int tid_ = TID(); const int lane = tid_ & 63, wv = tid_ >> 6;
    const int gw = blockIdx.x * (NTHR >> 6) + wv, ngw = gridDim.x * (NTHR >> 6);
    LDSF float* scr = (LDSF float*)lds + wv * (64 * 33);
    convert_weight<1>(p.w_in + (size_t)l * DM * PIN, DM, PIN, PINP, (bf16_t*)(p.ws + WS_WIN + l * WS_W1OFF), scr, gw, ngw, lane);
    convert_weight<0>(p.w_out + (size_t)l * DM * DM, DM, DM, DM, (bf16_t*)(p.ws + WS_WOUT + l * WS_W1OFF), scr, gw, ngw, lane);
    convert_weight<2>(p.w_up + (size_t)l * DM * NUP, DM, NUP, NUP, (bf16_t*)(p.ws + WS_WUP + l * WS_W1OFF), scr, gw, ngw, lane);
    convert_weight<0>(p.w_down + (size_t)l * DFF * DM, DFF, DM, DM, (bf16_t*)(p.ws + WS_WDN + l * WS_W1OFF), scr, gw, ngw, lane);
    for (int w2 = 0; w2 < 2; ++w2) convert_weight<0>(p.nsa_phi + (size_t)(l * 2 + w2) * 2048 * 64, 2048, 64, 64, (bf16_t*)(p.ws + WS_PHIT) + (size_t)(l * 2 + w2) * 64 * 2048, scr, gw, ngw, lane);
}
__device__ void ph_xa_from(const Params& p, const float* src, int l, int which  , bf16_t* XA, float* rowss, bool write_xa) {
    const float* mod = (const float*)(p.ws + WS_MOD);
    const float* g = (which == 0 ? p.norm_mix_g : p.norm_ffn_g) + l * DM;
    const int tid_ = TID(); const int lane = tid_ & 63, wv = tid_ >> 6;
    const int gw = blockIdx.x * (blockDim.x >> 6) + wv, ngw = gridDim.x * (blockDim.x >> 6);
    for (int row = gw; row < MTOK; row += ngw) {
        const int b = row / SEQ;
        const float* sc = mod + (size_t)(l * 4 + b) * 6144 + (which == 0 ? 1024 : 4096);
        float ss = 0.f;
#pragma unroll
        for (int j = 0; j < 4; ++j) {
            const int k = j * 256 + lane * 4;
            const f32x4 v = *(const f32x4*)(src + (size_t)row * DM + k);
            ss += v[0] * v[0] + v[1] * v[1] + v[2] * v[2] + v[3] * v[3];
            if (write_xa) {
                const f32x4 gv = *(const f32x4*)(g + k); const f32x4 sv = *(const f32x4*)(sc + k);
                uint2 o; o.x = pk2(v[0] * gv[0] * (1.f + sv[0]), v[1] * gv[1] * (1.f + sv[1])); o.y = pk2(v[2] * gv[2] * (1.f + sv[2]), v[3] * gv[3] * (1.f + sv[3]));
                *(uint2*)(XA + (size_t)row * DM + k) = o;
            }
        }
        ss = wave_sum(ss);
        if (lane < 16) rowss[(size_t)row * 16 + lane] = (lane == 0) ? ss : 0.f;
    }
}

namespace pg8 {
#define PG8_LAS __attribute__((address_space(3)))
typedef unsigned short bf16_t;
typedef short bf16x8 __attribute__((ext_vector_type(8)));
typedef float f32x4 __attribute__((ext_vector_type(4)));
typedef unsigned u32x4 __attribute__((ext_vector_type(4)));
constexpr int BM = 256, BK = 64, HALF = 128, HTB = HALF * BK * 2  , STAGE_BYTES = 8 * HTB, NXCD = 8, WGM = 8;

__host__ __device__ __forceinline__ int lds_byte(int r, int c) { const int st = (r >> 4) * 2 + (c >> 5), rr = r & 15, cc = c & 31, ob = rr * 64 + cc * 2; return st * 1024 + (ob ^ (((ob >> 9) & 1) << 5)); }
__host__ __device__ __forceinline__ void stage_rc(int b, int& R, int& C) { const int st = b / 1024, sb = b % 1024, swz = sb ^ (((sb >> 9) & 1) << 5); R = (st >> 1) * 16 + swz / 64; C = (st & 1) * 32 + (swz % 64) / 2; }
__host__ __device__ __forceinline__ int perm32(int rho) { const int n = rho >> 4, i = rho & 15; return 8 * (i >> 2) + 4 * n + (i & 3); }

struct Unit { int pm, pn; };
struct Gemm { const bf16_t* A; const bf16_t* Bt; int M, N, K; };

struct StaticOrder {
    int nM, nN, nwg, G, c;
    __host__ __device__ void init(int M, int N, int G_, int c_) { nM = M / BM; nN = N / BM; nwg = nM * nN; G = G_; c = c_; }
    __host__ __device__ bool next(int i, Unit& u) const {
        const long L = (long)i * G + c; if (L >= nwg) return false;
        int wgid = (int)L; { const int q = nwg / NXCD, r = nwg % NXCD, xcd = wgid % NXCD, off = wgid / NXCD; wgid = (xcd < r ? xcd * (q + 1) : r * (q + 1) + (xcd - r) * q) + off; }
        const int nig = WGM * nN, gid = wgid / nig, fm = gid * WGM, gsz = (nM - fm) < WGM ? (nM - fm) : WGM;
        u.pm = fm + ((wgid % nig) % gsz); u.pn = (wgid % nig) / gsz; return true;
    }
    __device__ __forceinline__ void a_ready(const Unit&) const {}
    __device__ __forceinline__ void done(const Unit&) const {}
};


__device__ __forceinline__ unsigned cvt_pk_bf16(float lo, float hi) { unsigned r; asm volatile("v_cvt_pk_bf16_f32 %0, %1, %2" : "=v"(r) : "v"(lo), "v"(hi)); return r; }
template <class Epi, class Sched, bool ALIGN_EPI = false, bool SP2 = false>
__device__ __forceinline__ void gemm_phase(PG8_LAS unsigned char* lds, const Gemm g, const Sched& S, const Epi& E) {
    const int tid = TID(), wid = __builtin_amdgcn_readfirstlane(tid >> 6), lane = tid & 63, wr = wid >> 2, wc = wid & 3, fr = lane & 15, fq = lane >> 4;
    const int K = g.K, nt = K / BK;
    unsigned voffA[2], voffB[2];
#pragma unroll
    for (int i = 0; i < 2; ++i) { int R, C; stage_rc(tid * 16 + i * 8192, R, C); const int Rb = Epi::PERM ? ((R & ~31) + perm32(R & 31)) : R;
        voffA[i] = (unsigned)(R * K + C) * 2u; voffB[i] = (unsigned)(Rb * K + C) * 2u; }
    const size_t kstep = (size_t)(BK * 2);
    const size_t hstep = (size_t)HALF * K * 2;
    const size_t tstep = 2 * hstep;
    const unsigned ldsw = (unsigned)wid * 1024u;
    const int aoff = lds_byte(wr * 64 + fr, fq * 8), boff = lds_byte(wc * 32 + fr, fq * 8);
#define PG8_SA(b, h) (((b) * 2 + (h)) * HTB)
#define PG8_SB(b, h) ((4 + (b) * 2 + (h)) * HTB)
#define PG8_STAGE(bufoff, gbase, voff) do { _Pragma("unroll") for (int _i = 0; _i < 2; ++_i) \
        __builtin_amdgcn_global_load_lds((const unsigned*)((const char*)(gbase) + (voff)[_i]), (PG8_LAS unsigned*)(lds + (bufoff) + ldsw + _i * 8192), 16, 0, 0); } while (0)
#define PG8_LDA(dst, b, h) do { _Pragma("unroll") for (int m = 0; m < 4; ++m) _Pragma("unroll") for (int k = 0; k < 2; ++k) dst[m][k] = *(const PG8_LAS bf16x8*)(lds + PG8_SA(b, h) + aoff + m * 2048 + k * 1024); } while (0)
#define PG8_LDB(dst, b, h) do { _Pragma("unroll") for (int n = 0; n < 2; ++n) _Pragma("unroll") for (int k = 0; k < 2; ++k) dst[n][k] = *(const PG8_LAS bf16x8*)(lds + PG8_SB(b, h) + boff + n * 2048 + k * 1024); } while (0)
#define PG8_MMA(ai, bj, At, Bt) do { __builtin_amdgcn_s_setprio(1); _Pragma("unroll") for (int m = 0; m < 4; ++m) _Pragma("unroll") for (int n = 0; n < 2; ++n) _Pragma("unroll") for (int k = 0; k < 2; ++k) \
        acc[ai][bj][m][n] = __builtin_amdgcn_mfma_f32_16x16x32_bf16(Bt[n][k], At[m][k], acc[ai][bj][m][n], 0, 0, 0); __builtin_amdgcn_s_setprio(0); } while (0)
#define PG8_WAIT_V(n) asm volatile("s_waitcnt vmcnt(" #n ")" ::: "memory")
#define PG8_WAIT_L(n) asm volatile("s_waitcnt lgkmcnt(" #n ")" ::: "memory")
#define PG8_BAR __builtin_amdgcn_s_barrier()
#define PG8_SCHED __builtin_amdgcn_sched_barrier(0)
    Unit cur, nxt; int ui = 0;
    if (!S.next(0, cur)) return;
    f32x4 acc[2][2][4][2];
#pragma unroll
    for (int a = 0; a < 2; ++a)
#pragma unroll
        for (int b = 0; b < 2; ++b)
#pragma unroll
            for (int m = 0; m < 4; ++m)
#pragma unroll
                for (int n = 0; n < 2; ++n) acc[a][b][m][n] = (f32x4){0.f, 0.f, 0.f, 0.f};
    bf16x8 At[4][2], B0[2][2], B1[2][2];
    const char* cA = (const char*)g.A + (size_t)cur.pm * tstep; const char* cB = (const char*)g.Bt + (size_t)cur.pn * tstep;
    S.a_ready(cur);
    if constexpr (SP2) {
        PG8_STAGE(PG8_SB(0, 0), cB, voffB); PG8_STAGE(PG8_SB(0, 1), cB + hstep, voffB); PG8_STAGE(PG8_SA(0, 0), cA, voffA); PG8_STAGE(PG8_SA(0, 1), cA + hstep, voffA);
        if (wr == 1) PG8_BAR;
        PG8_WAIT_V(2); PG8_BAR;
        PG8_STAGE(PG8_SB(1, 0), cB + kstep, voffB); PG8_STAGE(PG8_SA(1, 0), cA + kstep, voffA); PG8_STAGE(PG8_SB(1, 1), cB + hstep + kstep, voffB);
        PG8_WAIT_V(6); PG8_BAR;
    } else {
        PG8_STAGE(PG8_SB(0, 0), cB, voffB); PG8_STAGE(PG8_SA(0, 0), cA, voffA); PG8_STAGE(PG8_SB(0, 1), cB + hstep, voffB); PG8_STAGE(PG8_SA(0, 1), cA + hstep, voffA);
        if (wr == 1) PG8_BAR;
        PG8_WAIT_V(4); PG8_BAR;
        PG8_STAGE(PG8_SB(1, 0), cB + kstep, voffB); PG8_STAGE(PG8_SA(1, 0), cA + kstep, voffA); PG8_STAGE(PG8_SB(1, 1), cB + hstep + kstep, voffB);
        PG8_WAIT_V(6); PG8_BAR;
    }
    for (;;) {
        const bool has_next = S.next(ui + 1, nxt);
        const char* nA = has_next ? (const char*)g.A + (size_t)nxt.pm * tstep : cA; const char* nB = has_next ? (const char*)g.Bt + (size_t)nxt.pn * tstep : cB;
        for (int t = 0; t < nt; t += 2) {
            const bool last = (t == nt - 2);
            const char* a1 = cA + (size_t)(t + 1) * kstep;
            const char* a2 = last ? nA : cA + (size_t)(t + 2) * kstep; const char* b2 = last ? nB : cB + (size_t)(t + 2) * kstep;
            const char* a3 = a2 + kstep; const char* b3 = b2 + kstep;
            if (last && has_next) S.a_ready(nxt);
            if constexpr (SP2) {
            PG8_LDB(B0, 0, 0); PG8_LDB(B1, 0, 1); PG8_SCHED; PG8_LDA(At, 0, 0); PG8_STAGE(PG8_SA(1, 1), a1 + hstep, voffA);
            PG8_WAIT_V(8); PG8_WAIT_L(0); PG8_BAR; PG8_MMA(0, 0, At, B0); PG8_MMA(0, 1, At, B1); PG8_BAR; PG8_SCHED;
            PG8_LDA(At, 0, 1); PG8_STAGE(PG8_SB(0, 0), b2, voffB); PG8_STAGE(PG8_SB(0, 1), b2 + hstep, voffB); PG8_STAGE(PG8_SA(0, 0), a2, voffA);
            PG8_WAIT_V(8); PG8_WAIT_L(0); PG8_BAR; PG8_MMA(1, 0, At, B0); PG8_MMA(1, 1, At, B1); PG8_BAR; PG8_SCHED;
            PG8_LDB(B0, 1, 0); PG8_LDB(B1, 1, 1); PG8_SCHED; PG8_LDA(At, 1, 0); PG8_STAGE(PG8_SA(0, 1), a2 + hstep, voffA);
            PG8_WAIT_V(8); PG8_WAIT_L(0); PG8_BAR; PG8_MMA(0, 0, At, B0); PG8_MMA(0, 1, At, B1); PG8_BAR; PG8_SCHED;
            PG8_LDA(At, 1, 1); PG8_STAGE(PG8_SB(1, 0), b3, voffB); PG8_STAGE(PG8_SB(1, 1), b3 + hstep, voffB); PG8_STAGE(PG8_SA(1, 0), a3, voffA);
            PG8_WAIT_V(8); PG8_WAIT_L(0); PG8_BAR; PG8_MMA(1, 0, At, B0); PG8_MMA(1, 1, At, B1); PG8_BAR; PG8_SCHED;
            } else {
            PG8_LDB(B0, 0, 0); PG8_SCHED; PG8_LDA(At, 0, 0); PG8_STAGE(PG8_SA(1, 1), a1 + hstep, voffA);
            PG8_WAIT_L(8); PG8_BAR; PG8_WAIT_L(0); PG8_MMA(0, 0, At, B0); PG8_BAR; PG8_SCHED;
            PG8_LDB(B1, 0, 1); PG8_STAGE(PG8_SB(0, 0), b2, voffB);
            PG8_BAR; PG8_WAIT_L(0); PG8_MMA(0, 1, At, B1); PG8_BAR;
            PG8_LDA(At, 0, 1); PG8_STAGE(PG8_SA(0, 0), a2, voffA);
            PG8_BAR; PG8_WAIT_L(0); PG8_MMA(1, 0, At, B0); PG8_BAR; PG8_SCHED;
            PG8_STAGE(PG8_SB(0, 1), b2 + hstep, voffB);
            PG8_WAIT_V(6); PG8_BAR; PG8_MMA(1, 1, At, B1); PG8_BAR;
            PG8_LDB(B0, 1, 0); PG8_SCHED; PG8_LDA(At, 1, 0); PG8_STAGE(PG8_SA(0, 1), a2 + hstep, voffA);
            PG8_WAIT_L(8); PG8_BAR; PG8_WAIT_L(0); PG8_MMA(0, 0, At, B0); PG8_BAR; PG8_SCHED;
            PG8_LDB(B1, 1, 1); PG8_STAGE(PG8_SB(1, 0), b3, voffB);
            PG8_BAR; PG8_WAIT_L(0); PG8_MMA(0, 1, At, B1); PG8_BAR;
            PG8_LDA(At, 1, 1); PG8_STAGE(PG8_SA(1, 0), a3, voffA);
            PG8_BAR; PG8_WAIT_L(0); PG8_MMA(1, 0, At, B0); PG8_BAR; PG8_SCHED;
            PG8_STAGE(PG8_SB(1, 1), b3 + hstep, voffB);
            PG8_WAIT_V(6); PG8_BAR; PG8_MMA(1, 1, At, B1); PG8_BAR;
            }
        }
        if constexpr (ALIGN_EPI) { if (wr == 0) PG8_BAR; }
        if constexpr (!Epi::AFTER_DRAIN) { E(acc, cur, wr, wc, fr, fq); S.done(cur); }
        if (!has_next) break;
#pragma unroll
        for (int a = 0; a < 2; ++a)
#pragma unroll
            for (int b = 0; b < 2; ++b)
#pragma unroll
                for (int m = 0; m < 4; ++m)
#pragma unroll
                    for (int n = 0; n < 2; ++n) acc[a][b][m][n] = (f32x4){0.f, 0.f, 0.f, 0.f};
        cur = nxt; cA = nA; cB = nB; ++ui;
        if constexpr (ALIGN_EPI) { if (wr == 1) PG8_BAR; }
    }
    PG8_WAIT_V(0);
    if constexpr (!ALIGN_EPI) { if (wr == 0) PG8_BAR; }
    PG8_BAR;
    if constexpr (Epi::AFTER_DRAIN) { E.fused(acc, cur, wr, wc, fr, fq, lds, wid, lane); S.done(cur); }
#undef PG8_SA
#undef PG8_SB
#undef PG8_STAGE
#undef PG8_LDA
#undef PG8_LDB
#undef PG8_MMA
#undef PG8_WAIT_V
#undef PG8_WAIT_L
#undef PG8_BAR
#undef PG8_SCHED
}
}

#ifndef PG8_SP2
#define PG8_SP2 true
#endif
#ifndef PG8_ALIGN
#define PG8_ALIGN true
#endif

__device__ __forceinline__ float row_rstd16(const float* rowss, int row) {
    const f32x4* r = (const f32x4*)(rowss + (size_t)row * 16);
    const f32x4 a = r[0], b = r[1], c = r[2], d = r[3];
    const float s = ((a[0] + a[1]) + (a[2] + a[3])) + ((b[0] + b[1]) + (b[2] + b[3])) + ((c[0] + c[1]) + (c[2] + c[3])) + ((d[0] + d[1]) + (d[2] + d[3]));
    return rsqrtf(s * (1.f / DM) + EPS);
}
struct EpiProjF {
    static constexpr bool PERM = true, AFTER_DRAIN = false;
    const float* rowss; const float* cb; bf16_t* proj; float* side; const float* g_a; const float* g_b; const float* g_ds; const float* g_dw; LDSF float* xs  ;
    __device__ __forceinline__ void operator()(const pg8::f32x4 (&acc)[2][2][4][2], const pg8::Unit& u, int wr, int wc, int fr, int fq) const {
        const int b = u.pm >> 4, colt = u.pn * 256 + wc * 32 + 8 * fq;
        const int knmode = (u.pn == 1) ? 1 : (u.pn == 4) ? 2 : (u.pn == 10) ? 3 : (u.pn == 11) ? 4 : 0;
        f32x4 cv[2][2];
#pragma unroll
        for (int bj = 0; bj < 2; ++bj)
#pragma unroll
            for (int n = 0; n < 2; ++n) cv[bj][n] = *(const f32x4*)(cb + b * PINP + colt + bj * 128 + 4 * n);
        if (knmode != 0) {
#pragma unroll
            for (int ai = 0; ai < 2; ++ai)
#pragma unroll
                for (int m = 0; m < 4; ++m) {
                    const float rsm = row_rstd16(rowss, u.pm * 256 + ai * 128 + wr * 64 + m * 16 + fr);
#pragma unroll
                    for (int bj = 0; bj < 2; ++bj) {
                        const f32x4 v0 = acc[ai][bj][m][0] * rsm + cv[bj][0], v1 = acc[ai][bj][m][1] * rsm + cv[bj][1];
                        float ss = (v0[0] * v0[0] + v0[1] * v0[1]) + (v0[2] * v0[2] + v0[3] * v0[3]) + (v1[0] * v1[0] + v1[1] * v1[1]) + (v1[2] * v1[2] + v1[3] * v1[3]);
                        ss += __shfl_xor(ss, 16); ss += __shfl_xor(ss, 32);
                        if (fq == 0) xs[((wr * 4 + wc) * 16 + (ai * 4 + m) * 2 + bj) * 16 + fr] = ss;
                    }
                }
            asm volatile("s_waitcnt lgkmcnt(0)" ::: "memory"); __builtin_amdgcn_s_barrier(); asm volatile("" ::: "memory");
        }
#pragma unroll
        for (int ai = 0; ai < 2; ++ai)
#pragma unroll
            for (int m = 0; m < 4; ++m) {
                const int row = u.pm * 256 + ai * 128 + wr * 64 + m * 16 + fr; const float rs = row_rstd16(rowss, row);
#pragma unroll
                for (int bj = 0; bj < 2; ++bj) {
                    f32x4 v0 = acc[ai][bj][m][0] * rs + cv[bj][0], v1 = acc[ai][bj][m][1] * rs + cv[bj][1]; const int col0 = colt + bj * 128;
                    if (col0 >= C_BF && col0 < PIN) { *(f32x4*)(side + (size_t)row * 16 + (col0 - C_BF)) = v0; *(f32x4*)(side + (size_t)row * 16 + (col0 - C_BF) + 4) = v1; }
                    const bool on = (knmode == 1) || (knmode == 2) || (knmode == 3 && bj == 1 && wc < 2) || (knmode == 4 && bj == 0 && wc < 2);
                    if (on) {
                        const int xi = (ai * 4 + m) * 2 + bj;
                        float tot = xs[((wr * 4 + wc) * 16 + xi) * 16 + fr]; float dn = 1.f / 32.f;
                        if (knmode != 1) { tot += xs[((wr * 4 + (wc ^ 1)) * 16 + xi) * 16 + fr]; dn = 1.f / 64.f; }
                        const float nrm = rsqrtf(tot * dn + EPS);
                        const float* gp = (knmode == 1) ? g_a + 8 * fq : ((knmode == 2) ? g_b : (knmode == 3 ? g_ds : g_dw)) + (wc & 1) * 32 + 8 * fq;
                        v0 = v0 * nrm * *(const f32x4*)gp; v1 = v1 * nrm * *(const f32x4*)(gp + 4);
                    }
                    u32x4 w; w[0] = pg8::cvt_pk_bf16(v0[0], v0[1]); w[1] = pg8::cvt_pk_bf16(v0[2], v0[3]); w[2] = pg8::cvt_pk_bf16(v1[0], v1[1]); w[3] = pg8::cvt_pk_bf16(v1[2], v1[3]);
                    *(u32x4*)(proj + (size_t)row * PINP + col0) = w;
                }
            }
    }
};
struct EpiResF {
    static constexpr bool PERM = false, AFTER_DRAIN = false;
    const float* xin; float* xout; const float* gate; const float* g; const float* sc; bf16_t* xa; float* rowss;
    __device__ __forceinline__ void operator()(const pg8::f32x4 (&acc)[2][2][4][2], const pg8::Unit& u, int wr, int wc, int fr, int fq) const {
        const int b = u.pm >> 4, col0 = u.pn * 256 + wc * 32 + 4 * fq;
        f32x4 gt[2][2], gm[2][2];
#pragma unroll
        for (int bj = 0; bj < 2; ++bj)
#pragma unroll
            for (int n = 0; n < 2; ++n) { const int c = col0 + bj * 128 + n * 16; gt[bj][n] = *(const f32x4*)(gate + b * 6144 + c);
                if (xa) gm[bj][n] = *(const f32x4*)(g + c) * (*(const f32x4*)(sc + b * 6144 + c) + 1.0f); else gm[bj][n] = (f32x4){0.f, 0.f, 0.f, 0.f}; }
#pragma unroll
        for (int ai = 0; ai < 2; ++ai)
#pragma unroll
            for (int m = 0; m < 4; ++m) {
                const int row = u.pm * 256 + ai * 128 + wr * 64 + m * 16 + fr; float ss = 0.f;
#pragma unroll
                for (int bj = 0; bj < 2; ++bj)
#pragma unroll
                    for (int n = 0; n < 2; ++n) { const size_t off = (size_t)row * DM + col0 + bj * 128 + n * 16;
                        const f32x4 o = *(const f32x4*)(xin + off) + gt[bj][n] * acc[ai][bj][m][n];
                        *(f32x4*)(xout + off) = o; ss += (o[0] * o[0] + o[1] * o[1]) + (o[2] * o[2] + o[3] * o[3]);
                        if (xa) { const f32x4 q = o * gm[bj][n]; uint2 w; w.x = pg8::cvt_pk_bf16(q[0], q[1]); w.y = pg8::cvt_pk_bf16(q[2], q[3]); *(uint2*)(xa + off) = w; } }
                if (rowss) { ss += __shfl_xor(ss, 16); ss += __shfl_xor(ss, 32); if (fq == 0) rowss[(size_t)row * 16 + u.pn * 4 + wc] = ss; }
            }
    }
};


#define DPPF(oldv, src, CTRL) __builtin_bit_cast(float, __builtin_amdgcn_update_dpp(__builtin_bit_cast(int, (float)(oldv)), __builtin_bit_cast(int, (float)(src)), (CTRL), 0xf, 0xf, false))
struct EpiUpAct {
    static constexpr bool PERM = true, AFTER_DRAIN = false;
    const float* rowss; const float* cb; bf16_t* act; float* eg; float* ev; const float* cw; const float* cbias; LDSF float* xch; LDSF float* cst  ;
    __device__ __forceinline__ void operator()(const pg8::f32x4 (&acc)[2][2][4][2], const pg8::Unit& u, int wr, int wc, int fr, int fq) const {
        const int b = u.pm >> 4, cih = wc * 32 + 8 * fq, jcol = u.pn * 128 + cih;
        const float* cbg = cb + b * NUP + u.pn * 256 + cih; const float* cbv = cbg + 128;
        {
            const int tid = (wr * 4 + wc) * 64 + fq * 16 + fr, col = tid & 127, arr = tid >> 7;
            const float* src = (arr == 0) ? cb + b * NUP + u.pn * 256 + col : (arr == 1) ? cb + b * NUP + u.pn * 256 + 128 + col : cw + (arr - 2) * DFF + u.pn * 128 + col;
            cst[arr * 128 + col] = *src;
            if (tid < 256) { const int a2 = 4 + (tid >> 7); cst[a2 * 128 + col] = (a2 == 4) ? cw[2 * DFF + u.pn * 128 + col] : cbias[u.pn * 128 + col]; }
            else cst[768 + (tid - 256)] = row_rstd16(rowss, u.pm * 256 + (tid - 256));
            const f32x4 cg0 = *(const f32x4*)cbg, cg1 = *(const f32x4*)(cbg + 4);
#pragma unroll
            for (int ai = 0; ai < 2; ++ai) {
                const float r3 = row_rstd16(rowss, u.pm * 256 + ai * 128 + wr * 64 + 48 + fr);
                const f32x4 g0 = acc[ai][0][3][0] * r3 + cg0, g1 = acc[ai][0][3][1] * r3 + cg1;
                if (fr >= 14) { LDSF float* x = xch + ((((wr * 2 + ai) * 4 + wc) * 2 + (fr - 14)) * 32 + 8 * fq); *(LDSF f32x4*)x = g0; *(LDSF f32x4*)(x + 4) = g1;
                    if (wr == 1 && ai == 1) { float* e = eg + ((size_t)(u.pm * 4 + 2 + (fr - 14))) * DFF + jcol; *(f32x4*)e = g0; *(f32x4*)(e + 4) = g1; } }
            }
            if (wr == 0 && fr < 2) {
                const f32x4 cv0 = *(const f32x4*)cbv, cv1 = *(const f32x4*)(cbv + 4); const float r0 = row_rstd16(rowss, u.pm * 256 + fr);
                float* e = eg + ((size_t)(u.pm * 4 + fr)) * DFF + jcol; float* v = ev + ((size_t)(u.pm * 2 + fr)) * DFF + jcol;
                *(f32x4*)e = acc[0][0][0][0] * r0 + cg0; *(f32x4*)(e + 4) = acc[0][0][0][1] * r0 + cg1;
                *(f32x4*)v = acc[0][1][0][0] * r0 + cv0; *(f32x4*)(v + 4) = acc[0][1][0][1] * r0 + cv1;
            }
        }
        asm volatile("s_waitcnt vmcnt(0) lgkmcnt(0)" ::: "memory"); __builtin_amdgcn_s_barrier(); asm volatile("" ::: "memory");
#pragma unroll
        for (int ai = 0; ai < 2; ++ai) {
            f32x4 pvv[2];
            if (ai == 0 && wr == 0) { pvv[0] = (f32x4){0.f, 0.f, 0.f, 0.f}; pvv[1] = pvv[0]; }
            else { const int swr = (wr == 1) ? 0 : 1, sai = (wr == 1) ? ai : ai - 1;
                const LDSF float* x = xch + ((((swr * 2 + sai) * 4 + wc) * 2 + (fr & 1)) * 32 + 8 * fq); pvv[0] = *(const LDSF f32x4*)x; pvv[1] = *(const LDSF f32x4*)(x + 4); }
#pragma unroll
            for (int m = 0; m < 4; ++m) {
                asm volatile("" ::: "memory");
                const int row = u.pm * 256 + ai * 128 + wr * 64 + m * 16 + fr; const float rsm = cst[768 + ai * 128 + wr * 64 + m * 16 + fr];
                u32x4 w;
#pragma unroll
                for (int n = 0; n < 2; ++n) {
                    const LDSF float* cc = cst + cih + 4 * n;
                    const f32x4 cgn = *(const LDSF f32x4*)cc, cvn = *(const LDSF f32x4*)(cc + 128);
                    const f32x4 k0 = *(const LDSF f32x4*)(cc + 256), k1 = *(const LDSF f32x4*)(cc + 384), k2 = *(const LDSF f32x4*)(cc + 512), kb = *(const LDSF f32x4*)(cc + 640);
                    const f32x4 c = acc[ai][0][m][n] * rsm + cgn, v = acc[ai][1][m][n] * rsm + cvn; float o[4];
#pragma unroll
                    for (int i = 0; i < 4; ++i) {
                        const float gm1 = DPPF(DPPF(0.f, pvv[n][i], 0x121), c[i], 0x111);
                        const float gm2 = DPPF(DPPF(0.f, pvv[n][i], 0x122), c[i], 0x112);
                        const float cvv = k0[i] * gm2 + k1[i] * gm1 + k2[i] * c[i] + kb[i];
                        o[i] = cvv * __builtin_amdgcn_rcpf(1.f + __builtin_amdgcn_exp2f(-cvv * LOG2E)) * v[i];
                    }
                    w[2 * n] = pg8::cvt_pk_bf16(o[0], o[1]); w[2 * n + 1] = pg8::cvt_pk_bf16(o[2], o[3]);
                    pvv[n] = c;
                }
                *(u32x4*)(act + (size_t)row * DFF + jcol) = w;
            }
        }
    }
};
__device__ void act_fixup(const Params& p, int l, int pm) {
    if ((pm & 15) == 0) return;
    const float* eg = (const float*)(p.ws + WS_EG); const float* ev = (const float*)(p.ws + WS_EV); bf16_t* act = (bf16_t*)(p.ws + WS_ACT);
    const float* cw = p.conv_w + (size_t)l * 3 * DFF; const float* cbias = p.conv_b + (size_t)l * DFF;
    for (int idx = TID(); idx < 2 * DFF; idx += NTHR) {
        const int r = idx / DFF, j = idx - r * DFF;
        const float a = eg[((size_t)((pm - 1) * 4 + 2)) * DFF + j], bq = eg[((size_t)((pm - 1) * 4 + 3)) * DFF + j], c0 = eg[((size_t)(pm * 4 + 0)) * DFF + j], c1 = eg[((size_t)(pm * 4 + 1)) * DFF + j];
        const float gm2 = r ? bq : a, gm1 = r ? c0 : bq, gc = r ? c1 : c0;
        const float cvv = cw[j] * gm2 + cw[DFF + j] * gm1 + cw[2 * DFF + j] * gc + cbias[j];
        act[(size_t)(pm * 256 + r) * DFF + j] = f2bf(siluf(cvv) * ev[((size_t)(pm * 2 + r)) * DFF + j]);
    }
}

__device__ void ph_prep_knorm(const Params& p, int l) {
    bf16_t* proj = (bf16_t*)(p.ws + WS_PROJ);
    const int tid_ = TID(); const int lane = tid_ & 63, wv = tid_ >> 6;
    const int gw = blockIdx.x * (blockDim.x >> 6) + wv, ngw = gridDim.x * (blockDim.x >> 6);
    for (int row = gw; row < MTOK; row += ngw) {
        bf16_t* pr = proj + (size_t)row * PINP;
        {
            uint2 raw = *(const uint2*)(pr + CA_K + 4 * lane);
            float v0 = bf2f(raw.x & 0xffff), v1 = bf2f(raw.x >> 16), v2 = bf2f(raw.y & 0xffff), v3 = bf2f(raw.y >> 16);
            float ss = v0 * v0 + v1 * v1 + v2 * v2 + v3 * v3;
            ss += __shfl_xor(ss, 1); ss += __shfl_xor(ss, 2); ss += __shfl_xor(ss, 4);
            const float r = rsqrtf(ss * (1.f / 32.f) + EPS); const float* g = p.diff_kn + l * 32 + ((4 * lane) & 31);
            raw.x = pk2(v0 * r * g[0], v1 * r * g[1]); raw.y = pk2(v2 * r * g[2], v3 * r * g[3]);
            *(uint2*)(pr + CA_K + 4 * lane) = raw;
        }
        {
            uint2 raw = *(const uint2*)(pr + CB_K + 4 * lane);
            float v0 = bf2f(raw.x & 0xffff), v1 = bf2f(raw.x >> 16), v2 = bf2f(raw.y & 0xffff), v3 = bf2f(raw.y >> 16);
            float ss = v0 * v0 + v1 * v1 + v2 * v2 + v3 * v3;
            ss += __shfl_xor(ss, 1); ss += __shfl_xor(ss, 2); ss += __shfl_xor(ss, 4); ss += __shfl_xor(ss, 8);
            const float r = rsqrtf(ss * (1.f / 64.f) + EPS); const float* g = p.fox_kn + l * 64 + ((4 * lane) & 63);
            raw.x = pk2(v0 * r * g[0], v1 * r * g[1]); raw.y = pk2(v2 * r * g[2], v3 * r * g[3]);
            *(uint2*)(pr + CB_K + 4 * lane) = raw;
        }
        {
            const int hi = lane >> 5, li = lane & 31; bf16_t* q = pr + (hi ? CD_KW : CD_KS) + 2 * li;
            unsigned raw = *(const unsigned*)q; float v0 = bf2f(raw & 0xffff), v1 = bf2f(raw >> 16);
            float ss = v0 * v0 + v1 * v1;
            ss += __shfl_xor(ss, 1); ss += __shfl_xor(ss, 2); ss += __shfl_xor(ss, 4); ss += __shfl_xor(ss, 8); ss += __shfl_xor(ss, 16);
            const float r = rsqrtf(ss * (1.f / 64.f) + EPS); const float* g = p.nsa_kn + (l * 3 + (hi ? 2 : 1)) * 64 + 2 * li;
            *(unsigned*)q = pk2(v0 * r * g[0], v1 * r * g[1]);
        }
    }
}
__device__ void ph_prep_cum_bh(const Params& p, int l, int bh, unsigned char* lds) {
    const float* side = (const float*)(p.ws + WS_SIDE);
    float* cum = (float*)(p.ws + WS_CUM);
    LDSF float* wt = (LDSF float*)(lds + 70000);
    const int tid = TID(), lane = tid & 63, wv = tid >> 6;
    {
        const int b = bh >> 2, h = bh & 3; const float bf = p.fox_bf[l * 4 + h];
        float v[8]; float tot = 0.f;
#pragma unroll
        for (int i = 0; i < 8; ++i) { v[i] = logsigf(side[(size_t)(b * SEQ + tid * 8 + i) * 16 + h] + bf); tot += v[i]; v[i] = tot; }
        float inc = tot;
#pragma unroll
        for (int o = 1; o < 64; o <<= 1) { const float u = __shfl_up(inc, o); if (lane >= o) inc += u; }
        __syncthreads();
        if (lane == 63) wt[wv] = inc;
        __syncthreads();
        float base = inc - tot;
        for (int w8 = 0; w8 < wv; ++w8) base += wt[w8];
#pragma unroll
        for (int i = 0; i < 8; ++i) cum[bh * SEQ + tid * 8 + i] = base + v[i];
    }
}
__device__ void ph_prep_cmp(const Params& p, int l, unsigned char* lds) {
    const bf16_t* proj = (const bf16_t*)(p.ws + WS_PROJ);
    float* win = (float*)lds; float* red = (float*)(lds + 36864);
    const int tid = TID(), e = tid & 63, part = tid >> 6;
    for (int item = blockIdx.x; item < 4 * 2 * 32; item += gridDim.x) {
        const int b = item >> 6, which = (item >> 5) & 1, n0 = (item & 31) * 8;
        const int colbase = which ? CD_VC : CD_KC;
        __syncthreads();
        for (int i = tid; i < 144 * 64; i += NTHR) { const int tk = 16 * n0 + (i >> 6); win[i] = tk < SEQ ? bf2f(proj[(size_t)(b * SEQ + tk) * PINP + colbase + (i & 63)]) : 0.f; }
        __syncthreads();
        float acc[8];
#pragma unroll
        for (int nn = 0; nn < 8; ++nn) acc[nn] = 0.f;
        const float* phi = p.nsa_phi + (size_t)(l * 2 + which) * 2048 * 64; const float* pe = p.nsa_pe + (size_t)(l * 2 + which) * 32 * 64;
        for (int i = 4 * part; i < 4 * part + 4; ++i)
            for (int d = 0; d < 64; ++d) {
                const float ph = phi[(size_t)(i * 64 + d) * 64 + e], pv = pe[i * 64 + d];
#pragma unroll
                for (int nn = 0; nn < 8; ++nn) acc[nn] += (win[(16 * nn + i) * 64 + d] + pv) * ph;
            }
#pragma unroll
        for (int nn = 0; nn < 8; ++nn) red[(part * 8 + nn) * 64 + e] = acc[nn];
        __syncthreads();
        {
            const int nn = part, n = n0 + nn; float v = 0.f;
#pragma unroll
            for (int pp = 0; pp < 8; ++pp) v += red[(pp * 8 + nn) * 64 + e];
            bf16_t* dst = (bf16_t*)(p.ws + (which ? WS_VC : WS_KC)) + (size_t)(b * 256 + n) * 64 + e;
            if (n >= 255) *dst = 0;
            else if (which == 0) { const float ss = wave_sum(v * v); *dst = f2bf(v * rsqrtf(ss * (1.f / 64.f) + EPS) * p.nsa_kn[(l * 3 + 0) * 64 + e]); }
            else *dst = f2bf(v);
        }
    }
}

__device__ __forceinline__ void load8(const bf16_t* p, float* d) {
    const u32x4 r = *(const u32x4*)p;
    d[0] = bf2f(r[0] & 0xffff); d[1] = bf2f(r[0] >> 16); d[2] = bf2f(r[1] & 0xffff); d[3] = bf2f(r[1] >> 16);
    d[4] = bf2f(r[2] & 0xffff); d[5] = bf2f(r[2] >> 16); d[6] = bf2f(r[3] & 0xffff); d[7] = bf2f(r[3] >> 16);
}
template <int N> __device__ __forceinline__ float dotn(const float* q, const bf16_t* k) {
    float s = 0.f;
#pragma unroll
    for (int c = 0; c < N / 8; ++c) { float t[8]; load8(k + 8 * c, t);
#pragma unroll
        for (int j = 0; j < 8; ++j) s += q[8 * c + j] * t[j]; }
    return s;
}
template <int N> __device__ __forceinline__ void axpyn(float* o, float w, const bf16_t* v) {
#pragma unroll
    for (int c = 0; c < N / 8; ++c) { float t[8]; load8(v + 8 * c, t);
#pragma unroll
        for (int j = 0; j < 8; ++j) o[8 * c + j] += w * t[j]; }
}
template <int N> __device__ __forceinline__ void loadq_norm(float* q, const bf16_t* src, const float* g, float scale, bool norm) {
    float ss = 0.f;
#pragma unroll
    for (int c = 0; c < N / 8; ++c) load8(src + 8 * c, q + 8 * c);
#pragma unroll
    for (int j = 0; j < N; ++j) ss += q[j] * q[j];
    const float r = norm ? rsqrtf(ss * (1.f / N) + EPS) : 1.f;
#pragma unroll
    for (int j = 0; j < N; ++j) q[j] = q[j] * r * (norm ? g[j] : 1.f) * scale;
}
__device__ __forceinline__ void store64(bf16_t* dst, const float* o) {
#pragma unroll
    for (int c = 0; c < 8; ++c) { u32x4 w; w[0] = pk2(o[8 * c], o[8 * c + 1]); w[1] = pk2(o[8 * c + 2], o[8 * c + 3]); w[2] = pk2(o[8 * c + 4], o[8 * c + 5]); w[3] = pk2(o[8 * c + 6], o[8 * c + 7]); *(u32x4*)(dst + 8 * c) = w; }
}

typedef float f32x16 __attribute__((ext_vector_type(16)));
typedef short s16x4 __attribute__((ext_vector_type(4)));
#define LDSP __attribute__((address_space(3)))
constexpr int KSTR = 144;
constexpr int AL_KV = 17408;
constexpr int AL_BK = 2 * AL_KV  , AL_TB = AL_BK + 512  , AL_WSF = AL_TB + 512  , AL_MISC = AL_WSF + 2048  ,
              AL_IMP = 38912  , AL_SELM = AL_IMP + 65536  ,
              AL_TB4 = AL_SELM + 512  , AL_INVL = AL_TB4 + 2048  , AL_D_END = AL_INVL + 1024;
static_assert(AL_MISC + 64 <= AL_IMP && AL_D_END <= 131072, "attention LDS map");
__device__ __forceinline__ int crow(int r, int hi) { return (r & 3) + 8 * (r >> 2) + 4 * hi; }
__device__ __forceinline__ float ex2(float v) { return __builtin_amdgcn_exp2f(v); }
__device__ __forceinline__ s16x4 vtr(const LDSP unsigned char* p) { typedef short v4i16_t __attribute__((ext_vector_type(4))); return __builtin_bit_cast(s16x4, __builtin_amdgcn_ds_read_tr16_b64_v4i16((LDSP v4i16_t*)p)); }
__device__ __forceinline__ bf16x8 pack8(const f32x16& p, int b) {
    u32x4 w; w[0] = pg8::cvt_pk_bf16(p[b], p[b + 1]); w[1] = pg8::cvt_pk_bf16(p[b + 2], p[b + 3]); w[2] = pg8::cvt_pk_bf16(p[b + 4], p[b + 5]); w[3] = pg8::cvt_pk_bf16(p[b + 6], p[b + 7]);
    return __builtin_bit_cast(bf16x8, w);
}
__device__ __forceinline__ f32x16 splat16(float v) { return (f32x16){v, v, v, v, v, v, v, v, v, v, v, v, v, v, v, v}; }
template <int NK16>
__device__ __forceinline__ void qkt(f32x16& p0, f32x16& p1, const LDSP unsigned char* Kt, const bf16x8* qf, int dbase, int r32, int hi) {
    const LDSP unsigned char* kb = Kt + r32 * KSTR + hi * 16 + dbase * 32;
#pragma unroll
    for (int d0 = 0; d0 < NK16; ++d0) {
        const bf16x8 a0 = *(const LDSP bf16x8*)(kb + d0 * 32), a1 = *(const LDSP bf16x8*)(kb + 32 * KSTR + d0 * 32);
        p0 = __builtin_amdgcn_mfma_f32_32x32x16_bf16(a0, qf[d0], p0, 0, 0, 0);
        p1 = __builtin_amdgcn_mfma_f32_32x32x16_bf16(a1, qf[d0], p1, 0, 0, 0);
    }
}
__device__ __forceinline__ void pv(f32x16* o, const LDSP unsigned char* Vt, int vb, const f32x16& p0, const f32x16& p1) {
    bf16x8 pa[4]; pa[0] = pack8(p0, 0); pa[1] = pack8(p0, 8); pa[2] = pack8(p1, 0); pa[3] = pack8(p1, 8);
#pragma unroll
    for (int d0 = 0; d0 < 2; ++d0)
#pragma unroll
        for (int ks = 0; ks < 4; ++ks) {
            const s16x4 lo = vtr(Vt + vb + d0 * 4096 + ks * 1024), hh = vtr(Vt + vb + d0 * 4096 + ks * 1024 + 512);
            const bf16x8 vf = (bf16x8){lo[0], lo[1], lo[2], lo[3], hh[0], hh[1], hh[2], hh[3]};
            o[d0] = __builtin_amdgcn_mfma_f32_32x32x16_bf16(pa[ks], vf, o[d0], 0, 0, 0);
        }
}
__device__ __forceinline__ float exp_sum(f32x16& p0, f32x16& p1) {
    float s0 = 0.f, s1 = 0.f;
#pragma unroll
    for (int r = 0; r < 16; ++r) { p0[r] = ex2(p0[r]); p1[r] = ex2(p1[r]); s0 += p0[r]; s1 += p1[r]; }
    return s0 + s1;
}
__device__ __forceinline__ void scale_rows(f32x16* o, float f, LDSP float* wsf, int r32, int hi) {
    __builtin_amdgcn_wave_barrier();
    if (hi == 0) wsf[r32] = f;
    __builtin_amdgcn_s_waitcnt(0xc07f);
    __builtin_amdgcn_wave_barrier();
#pragma unroll
    for (int g = 0; g < 4; ++g) { const f32x4 a = *(const LDSP f32x4*)(wsf + 8 * g + 4 * hi);
#pragma unroll
        for (int i = 0; i < 4; ++i) { o[0][4 * g + i] *= a[i]; o[1][4 * g + i] *= a[i]; } }
    __builtin_amdgcn_wave_barrier();
}
__device__ __forceinline__ void store_o(const f32x16* o, LDSP bf16_t* stg, bf16_t* dst, int lane, int r32, int hi) {
    __builtin_amdgcn_wave_barrier();
#pragma unroll
    for (int r = 0; r < 16; ++r) { const int orow = crow(r, hi); stg[orow * 64 + r32] = f2bf(o[0][r]); stg[orow * 64 + 32 + r32] = f2bf(o[1][r]); }
    __builtin_amdgcn_s_waitcnt(0xc07f);
    __builtin_amdgcn_wave_barrier();
#pragma unroll
    for (int i = 0; i < 4; ++i) { const int row = i * 8 + (lane >> 3), ch = lane & 7; const u32x4 v = *(const LDSP u32x4*)(stg + row * 64 + ch * 8); *(u32x4*)(dst + (size_t)row * DM + ch * 8) = v; }
    __builtin_amdgcn_s_waitcnt(0xc07f);
    __builtin_amdgcn_wave_barrier();
}
template <int NG>
__device__ __forceinline__ void load_q(bf16x8* qf, const bf16_t* qrow  , const float* g, float sc, bool norm, int hi) {
    float v[4][8];
#pragma unroll
    for (int d0 = 0; d0 < 4; ++d0) load8(qrow + 16 * d0 + 8 * hi, v[d0]);
    float r0 = 1.f, r1 = 1.f;
    if (norm) {
        float s0 = 0.f, s1 = 0.f;
#pragma unroll
        for (int j = 0; j < 8; ++j) { s0 += v[0][j] * v[0][j] + v[1][j] * v[1][j]; s1 += v[2][j] * v[2][j] + v[3][j] * v[3][j]; }
        s0 += __shfl_xor(s0, 32); s1 += __shfl_xor(s1, 32);
        if (NG == 64) { r0 = rsqrtf((s0 + s1) * (1.f / 64.f) + EPS); r1 = r0; } else { r0 = rsqrtf(s0 * (1.f / 32.f) + EPS); r1 = rsqrtf(s1 * (1.f / 32.f) + EPS); }
    }
#pragma unroll
    for (int d0 = 0; d0 < 4; ++d0) {
        const float rr = (d0 < 2 ? r0 : r1) * sc; float w[8];
#pragma unroll
        for (int j = 0; j < 8; ++j) { const int d = 16 * d0 + 8 * hi + j; w[j] = v[d0][j] * rr * (norm ? g[d % NG] : 1.f); }
        u32x4 u; u[0] = pg8::cvt_pk_bf16(w[0], w[1]); u[1] = pg8::cvt_pk_bf16(w[2], w[3]); u[2] = pg8::cvt_pk_bf16(w[4], w[5]); u[3] = pg8::cvt_pk_bf16(w[6], w[7]);
        qf[d0] = __builtin_bit_cast(bf16x8, u);
    }
}
__device__ __forceinline__ void kv_load(u32x4& kr, u32x4& vr, const bf16_t* Kb, const bf16_t* Vb, int k0, int tid) {
    const size_t off = (size_t)(k0 + (tid >> 3)) * PINP + (tid & 7) * 8;
    kr = *(const u32x4*)(Kb + off); vr = *(const u32x4*)(Vb + off);
}
__device__ __forceinline__ void kv_load64(u32x4& kr, u32x4& vr, const bf16_t* Kb, const bf16_t* Vb, int n0, int tid) {
    const size_t off = (size_t)(n0 + (tid >> 3)) * 64 + (tid & 7) * 8;
    kr = *(const u32x4*)(Kb + off); vr = *(const u32x4*)(Vb + off);
}
__device__ __forceinline__ void kv_store(const u32x4& kr, const u32x4& vr, LDSP unsigned char* buf, int tid) {
    const int key = tid >> 3, ch = tid & 7;
    *(LDSP u32x4*)(buf + key * KSTR + ch * 16) = kr;
    *(LDSP u32x4*)(buf + 9216 + (ch >> 2) * 4096 + (key >> 4) * 1024 + ((key >> 3) & 1) * 512 + (key & 7) * 64 + (ch & 3) * 16) = vr;
}
template <int NG>
__device__ __forceinline__ void knorm_chunk(u32x4& kr, const float* gp  ) {
    float v[8];
    v[0] = bf2f(kr[0] & 0xffff); v[1] = bf2f(kr[0] >> 16); v[2] = bf2f(kr[1] & 0xffff); v[3] = bf2f(kr[1] >> 16);
    v[4] = bf2f(kr[2] & 0xffff); v[5] = bf2f(kr[2] >> 16); v[6] = bf2f(kr[3] & 0xffff); v[7] = bf2f(kr[3] >> 16);
    float ss = 0.f;
#pragma unroll
    for (int j = 0; j < 8; ++j) ss += v[j] * v[j];
    ss += __shfl_xor(ss, 1); ss += __shfl_xor(ss, 2); if (NG == 64) ss += __shfl_xor(ss, 4);
    const float r = rsqrtf(ss * (1.f / NG) + EPS);
    const f32x4 ga = *(const f32x4*)gp, gb = *(const f32x4*)(gp + 4);
    kr[0] = pg8::cvt_pk_bf16(v[0] * r * ga[0], v[1] * r * ga[1]); kr[1] = pg8::cvt_pk_bf16(v[2] * r * ga[2], v[3] * r * ga[3]);
    kr[2] = pg8::cvt_pk_bf16(v[4] * r * gb[0], v[5] * r * gb[1]); kr[3] = pg8::cvt_pk_bf16(v[6] * r * gb[2], v[7] * r * gb[3]);
}
__device__ __forceinline__ void bias_near(f32x16& p0, f32x16& p1, const LDSP float* tbl, int tk0  , int wnd, bool rowok, int hi) {
#pragma unroll
    for (int g = 0; g < 4; ++g) {
#pragma unroll
        for (int i = 0; i < 4; ++i) { const int r = 4 * g + i; const int d0_ = tk0 - crow(r, hi), d1_ = d0_ - 32;
            const float b0 = tbl[min(max(d0_, 0), 127)], b1 = tbl[min(max(d1_, 0), 127)];
            p0[r] = (d0_ < 0 || d0_ >= wnd || !rowok) ? -INFINITY : p0[r] + b0; p1[r] = (d1_ < 0 || d1_ >= wnd || !rowok) ? -INFINITY : p1[r] + b1; }
        asm volatile("" ::: "memory");
    }
}
#define KVBUF(L, i) ((L) + ((i) & 1) * AL_KV)

__device__ void fa_fox_unit(const Params& p, int l, int b, int h, int qb, LDSP unsigned char* L) {
    const int tid = TID(), lane = tid & 63, wid = __builtin_amdgcn_readfirstlane(tid >> 6), r32 = lane & 31, hi = lane >> 5;
    const bf16_t* proj = (const bf16_t*)(p.ws + WS_PROJ); bf16_t* mix = (bf16_t*)(p.ws + WS_MIX);
    const size_t rb = (size_t)b * SEQ; const int q0 = qb * 256, qw = q0 + 32 * wid, t = qw + r32;
    const bf16_t* Kb = proj + rb * PINP + CB_K + 64 * h; const bf16_t* Vb = proj + rb * PINP + CB_V + 64 * h;
    const float* cm = (const float*)(p.ws + WS_CUM) + (b * 4 + h) * SEQ;
    LDSP float* wsf = (LDSP float*)(L + AL_WSF) + wid * 64; LDSP float* bk = (LDSP float*)(L + AL_BK);
    const int vb = 9216 + ((lane >> 4) & 1) * 32 + (lane & 3) * 8 + (4 * hi + ((lane & 15) >> 2)) * 64;
    bf16x8 qf[4]; load_q<64>(qf, proj + (rb + t) * PINP + CB_Q + 64 * h, p.fox_qn + l * 64, 0.125f * LOG2E, true, hi);
    const float rowc = cm[t] * LOG2E - ((const float*)(p.ws + WS_BND))[l * 32 + 4];
    f32x16 o[2]; o[0] = (f32x16){}; o[1] = (f32x16){};
    float l_run = 0.f;
    const int NT = 4 * qb + 4, jd = 4 * qb + (wid >> 1);
    u32x4 kr, vr; float cr = 0.f; const float* gk = p.fox_kn + l * 64 + (tid & 7) * 8;
    __syncthreads();
    kv_load(kr, vr, Kb, Vb, 0, tid); if (tid < 64) cr = cm[tid];
    kv_store(kr, vr, KVBUF(L, 0), tid); if (tid < 64) bk[tid] = -cr * LOG2E;
    kv_load(kr, vr, Kb, Vb, 64, tid); if (tid < 64) cr = cm[64 + tid];
    for (int j = 0; j < NT; ++j) {
        __syncthreads();
        if (j + 1 < NT) { kv_store(kr, vr, KVBUF(L, j + 1), tid); if (tid < 64) bk[((j + 1) & 1) * 64 + tid] = -cr * LOG2E; }
        if (j + 2 < NT) { kv_load(kr, vr, Kb, Vb, 64 * (j + 2), tid); if (tid < 64) cr = cm[64 * (j + 2) + tid]; }
        if (j <= jd) {
            const LDSP unsigned char* buf = KVBUF(L, j); const LDSP float* bkj = bk + (j & 1) * 64;
            f32x16 p0, p1;
#pragma unroll
            for (int g = 0; g < 4; ++g) { const f32x4 b0 = *(const LDSP f32x4*)(bkj + 8 * g + 4 * hi), b1 = *(const LDSP f32x4*)(bkj + 32 + 8 * g + 4 * hi);
#pragma unroll
                for (int i = 0; i < 4; ++i) { p0[4 * g + i] = b0[i] + rowc; p1[4 * g + i] = b1[i] + rowc; } }
            qkt<4>(p0, p1, buf, qf, 0, r32, hi);
            if (j == jd) { const int k0 = 64 * j;
#pragma unroll
                for (int r = 0; r < 16; ++r) { const int kk = k0 + crow(r, hi); if (kk > t) p0[r] = -INFINITY; if (kk + 32 > t) p1[r] = -INFINITY; } }
            l_run += exp_sum(p0, p1);
            pv(o, buf, vb, p0, p1);
        }
    }
    l_run += __shfl_xor(l_run, 32);
    scale_rows(o, 1.f / l_run, wsf, r32, hi);
    store_o(o, (LDSP bf16_t*)(L + AL_IMP + wid * 8192), mix + (rb + qw) * DM + 256 + 64 * h, lane, r32, hi);
}

__device__ void fa_diff_unit(const Params& p, int l, int b, int h, int qb, LDSP unsigned char* L) {
    const int tid = TID(), lane = tid & 63, wid = __builtin_amdgcn_readfirstlane(tid >> 6), r32 = lane & 31, hi = lane >> 5;
    const bf16_t* proj = (const bf16_t*)(p.ws + WS_PROJ); bf16_t* mix = (bf16_t*)(p.ws + WS_MIX);
    const size_t rb = (size_t)b * SEQ; const int q0 = qb * 256, qw = q0 + 32 * wid, t = qw + r32;
    const bf16_t* Kb = proj + rb * PINP + CA_K + 64 * h; const bf16_t* Vb = proj + rb * PINP + CA_V + 64 * h;
    LDSP float* wsf = (LDSP float*)(L + AL_WSF) + wid * 64; LDSP float* tbl = (LDSP float*)(L + AL_TB);
    const int vb = 9216 + ((lane >> 4) & 1) * 32 + (lane & 3) * 8 + (4 * hi + ((lane & 15) >> 2)) * 64;
    const float lam = ((const float*)(p.ws + WS_LAM))[l]; const float lam_init = 0.8f - 0.6f * __expf(-0.3f * (float)l);
    const float nbound = -((const float*)(p.ws + WS_BND))[l * 32 + h];
    __syncthreads();
    if (tid < 128) tbl[tid] = ((const float*)(p.ws + WS_TB))[h * 128 + tid] * LOG2E;
    bf16x8 qf[4]; load_q<32>(qf, proj + (rb + t) * PINP + CA_Q + 64 * h, p.diff_qn + l * 32, 0.17677669529663687f * LOG2E, true, hi);
    f32x16 o1[2], o2[2]; o1[0] = (f32x16){}; o1[1] = (f32x16){}; o2[0] = (f32x16){}; o2[1] = (f32x16){};
    float l1 = 0.f, l2 = 0.f;
    const int NT = 4 * qb + 4, jd = 4 * qb + (wid >> 1);
    u32x4 kr, vr; const float* gk = p.diff_kn + l * 32 + (tid & 3) * 8;
    kv_load(kr, vr, Kb, Vb, 0, tid);
    kv_store(kr, vr, KVBUF(L, 0), tid);
    kv_load(kr, vr, Kb, Vb, 64, tid);
    for (int j = 0; j < NT; ++j) {
        __syncthreads();
        if (j + 1 < NT) { kv_store(kr, vr, KVBUF(L, j + 1), tid); }
        if (j + 2 < NT) kv_load(kr, vr, Kb, Vb, 64 * (j + 2), tid);
        if (j <= jd) {
            const LDSP unsigned char* buf = KVBUF(L, j);
            const int k0 = 64 * j; const bool nearb = (qw - (k0 + 63)) < 113; const float cfar = tbl[127] + nbound;
#pragma unroll
            for (int mp = 0; mp < 2; ++mp) {
                f32x16 p0 = splat16(nearb ? nbound : cfar), p1 = p0;
                qkt<2>(p0, p1, buf, qf + 2 * mp, 2 * mp, r32, hi);
                if (nearb) bias_near(p0, p1, tbl, t - k0, 1 << 30, true, hi);
                if (mp == 0) { l1 += exp_sum(p0, p1); pv(o1, buf, vb, p0, p1); }
                else { l2 += exp_sum(p0, p1); pv(o2, buf, vb, p0, p1); }
            }
        }
    }
    l1 += __shfl_xor(l1, 32); l2 += __shfl_xor(l2, 32);
    scale_rows(o1, 1.f / l1, wsf, r32, hi); scale_rows(o2, lam / l2, wsf, r32, hi);
    o1[0] -= o2[0]; o1[1] -= o2[1];
    const float g0 = p.diff_sub[l * 64 + r32] * (1.f - lam_init), g1 = p.diff_sub[l * 64 + 32 + r32] * (1.f - lam_init);
#pragma unroll
    for (int r = 0; r < 16; ++r) {
        float ss = o1[0][r] * o1[0][r] + o1[1][r] * o1[1][r];
        ss += __shfl_xor(ss, 1); ss += __shfl_xor(ss, 2); ss += __shfl_xor(ss, 4); ss += __shfl_xor(ss, 8); ss += __shfl_xor(ss, 16);
        const float rs = rsqrtf(ss * (1.f / 64.f) + EPS); o1[0][r] *= rs * g0; o1[1][r] *= rs * g1;
    }
    store_o(o1, (LDSP bf16_t*)(L + AL_IMP + wid * 8192), mix + (rb + qw) * DM + 0 + 64 * h, lane, r32, hi);
}

__device__ __forceinline__ void stick_sub(f32x16& y, float& carry, int kbase  , int t, bool diag, int hi) {
    float lk[16];
#pragma unroll
    for (int r = 0; r < 16; ++r) {
        const float v = y[r]; const float e = ex2(-fabsf(v)); const float lb = fminf(v, 0.f) - __builtin_amdgcn_logf(1.f + e);
        const bool valid = !diag || (kbase + crow(r, hi) < t);
        lk[r] = valid ? (lb - v) : 0.f; y[r] = valid ? lb : -INFINITY;
    }
    float T[4], Go[4];
#pragma unroll
    for (int g = 0; g < 4; ++g) { const float Gs = (lk[4 * g] + lk[4 * g + 1]) + (lk[4 * g + 2] + lk[4 * g + 3]); Go[g] = __shfl_xor(Gs, 32); T[g] = Gs + Go[g]; }
    float sx = 0.f;
#pragma unroll
    for (int g = 3; g >= 0; --g) {
        float tail = carry + sx + (hi == 0 ? Go[g] : 0.f);
#pragma unroll
        for (int i = 3; i >= 0; --i) { y[4 * g + i] = ex2(y[4 * g + i] + tail); tail += lk[4 * g + i]; }
        sx += T[g];
    }
    carry += sx;
}
__device__ void fa_stick_unit(const Params& p, int l, int b, int h, int qb, LDSP unsigned char* L) {
    const int tid = TID(), lane = tid & 63, wid = __builtin_amdgcn_readfirstlane(tid >> 6), r32 = lane & 31, hi = lane >> 5;
    const bf16_t* proj = (const bf16_t*)(p.ws + WS_PROJ); bf16_t* mix = (bf16_t*)(p.ws + WS_MIX);
    const size_t rb = (size_t)b * SEQ; const int q0 = qb * 256, qw = q0 + 32 * wid, t = qw + r32;
    const bf16_t* Kb = proj + rb * PINP + CC_K + 64 * h; const bf16_t* Vb = proj + rb * PINP + CC_V + 64 * h;
    const int vb = 9216 + ((lane >> 4) & 1) * 32 + (lane & 3) * 8 + (4 * hi + ((lane & 15) >> 2)) * 64;
    bf16x8 qf[4]; load_q<64>(qf, proj + (rb + t) * PINP + CC_Q + 64 * h, nullptr, 0.125f * LOG2E, false, hi);
    f32x16 o[2]; o[0] = (f32x16){}; o[1] = (f32x16){};
    float carry = 0.f;
    const int NT = 4 * qb + 4, jd = 4 * qb + (wid >> 1);
    u32x4 kr, vr;
    kv_load(kr, vr, Kb, Vb, 64 * (NT - 1), tid);
    for (int j = NT - 1; j >= 0; --j) {
        __syncthreads();
        kv_store(kr, vr, KVBUF(L, 0), tid);
        __syncthreads();
        if (j > 0) kv_load(kr, vr, Kb, Vb, 64 * (j - 1), tid);
        if (j <= jd) {
            const LDSP unsigned char* buf = KVBUF(L, 0);
            f32x16 p0 = (f32x16){}, p1 = (f32x16){};
            qkt<4>(p0, p1, buf, qf, 0, r32, hi);
            const int k0 = 64 * j; const bool diag = (j == jd);
            stick_sub(p1, carry, k0 + 32, t, diag, hi);
            stick_sub(p0, carry, k0, t, diag, hi);
            pv(o, buf, vb, p0, p1);
        }
    }
    store_o(o, (LDSP bf16_t*)(L + AL_IMP + wid * 8192), mix + (rb + qw) * DM + 512 + 64 * h, lane, r32, hi);
}

__device__ void fa_nsa_unit(const Params& p, int l, int b, int u, LDSP unsigned char* L) {
    const int tid = TID(), lane = tid & 63, wid = __builtin_amdgcn_readfirstlane(tid >> 6), r32 = lane & 31, hi = lane >> 5;
    const int hh = wid >> 1, sub = wid & 1;
    const bf16_t* proj = (const bf16_t*)(p.ws + WS_PROJ); bf16_t* mix = (bf16_t*)(p.ws + WS_MIX);
    const size_t rb = (size_t)b * SEQ; const int q0 = 64 * u, qw = q0 + 32 * sub, t = qw + r32; const int ql = 32 * sub + r32;
    LDSP float* wsf = (LDSP float*)(L + AL_WSF) + wid * 64; LDSP float* tbl = (LDSP float*)(L + AL_TB4) + hh * 128;
    LDSP float* imp = (LDSP float*)(L + AL_IMP); LDSP unsigned* selm = (LDSP unsigned*)(L + AL_SELM); LDSP float* invl = (LDSP float*)(L + AL_INVL);
    LDSP float* ofl = (LDSP float*)(L + AL_IMP) + wid * 2048 + lane;
    const int vb = 9216 + ((lane >> 4) & 1) * 32 + (lane & 3) * 8 + (4 * hi + ((lane & 15) >> 2)) * 64;
    const float* bnd = (const float*)(p.ws + WS_BND) + l * 32;
    __syncthreads();
    ((LDSP float*)(L + AL_TB4))[tid] = ((const float*)(p.ws + WS_TB))[512 + tid] * LOG2E;
    bf16x8 qf[4]; load_q<64>(qf, proj + (rb + t) * PINP + CD_Q + 64 * hh, p.nsa_qn + l * 64, 0.125f * LOG2E, true, hi);
    const float* sd = (const float*)(p.ws + WS_SIDE) + (rb + t) * 16 + 4 + hh;
    const float gc = 1.f / (1.f + __expf(-sd[0])), gs = 1.f / (1.f + __expf(-sd[4])), gwn = 1.f / (1.f + __expf(-sd[8]));
    f32x16 o[2]; o[0] = (f32x16){}; o[1] = (f32x16){};
    u32x4 kr, vr;
    {
        const bf16_t* Kc = (const bf16_t*)(p.ws + WS_KC) + (size_t)b * 256 * 64; const bf16_t* Vc = (const bf16_t*)(p.ws + WS_VC) + (size_t)b * 256 * 64;
        const int ntc = (4 * u + 2) / 64 + 1; const float nbound = -bnd[5 + hh];
        float l_run = 0.f, prevE3 = 0.f;
        kv_load64(kr, vr, Kc, Vc, 0, tid);
        kv_store(kr, vr, KVBUF(L, 0), tid);
        if (ntc > 1) kv_load64(kr, vr, Kc, Vc, 64, tid);
        for (int T = 0; T < ntc; ++T) {
            __syncthreads();
            if (T + 1 < ntc) kv_store(kr, vr, KVBUF(L, T + 1), tid);
            if (T + 2 < ntc) kv_load64(kr, vr, Kc, Vc, 64 * (T + 2), tid);
            const LDSP unsigned char* buf = KVBUF(L, T);
            f32x16 p0 = splat16(nbound), p1 = p0;
            qkt<4>(p0, p1, buf, qf, 0, r32, hi);
#pragma unroll
            for (int g = 0; g < 4; ++g) {
#pragma unroll
                for (int i = 0; i < 4; ++i) { const int r = 4 * g + i; const int d0_ = t - 16 * (64 * T + crow(r, hi)) - 31, d1_ = d0_ - 512;
                    const float b0 = tbl[min(max(d0_, 0), 127)], b1 = tbl[min(max(d1_, 0), 127)];
                    p0[r] = (d0_ < 0) ? -INFINITY : p0[r] + b0; p1[r] = (d1_ < 0) ? -INFINITY : p1[r] + b1; }
                asm volatile("" ::: "memory");
            }
            l_run += exp_sum(p0, p1);
#pragma unroll
            for (int s2 = 0; s2 < 2; ++s2) {
                float G[4], Eo[4];
#pragma unroll
                for (int g = 0; g < 4; ++g) { const float a0 = s2 ? p1[4 * g] : p0[4 * g], a1 = s2 ? p1[4 * g + 1] : p0[4 * g + 1], a2 = s2 ? p1[4 * g + 2] : p0[4 * g + 2], a3 = s2 ? p1[4 * g + 3] : p0[4 * g + 3];
                    G[g] = (a0 + a1) + (a2 + a3); Eo[g] = __shfl_xor(a3, 32); }
#pragma unroll
                for (int g = 0; g < 4; ++g) { const float eprev = hi ? Eo[g] : (g > 0 ? Eo[g - 1] : prevE3);
                    imp[(hh * 64 + ql) * 64 + 16 * T + 8 * s2 + 2 * g + hi] = G[g] + eprev; }
                prevE3 = Eo[3];
            }
            pv(o, buf, vb, p0, p1);
        }
        l_run += __shfl_xor(l_run, 32);
        const float inv = (l_run > 0.f) ? 1.f / l_run : 0.f;
        if (hi == 0) invl[hh * 64 + ql] = inv;
        scale_rows(o, gc * inv, wsf, r32, hi);
    }
    __syncthreads();
    {
        const int q = tid >> 3, part = tid & 7;
        const float i0 = invl[q], i1 = invl[64 + q], i2 = invl[128 + q], i3 = invl[192 + q];
        float vj[8];
#pragma unroll
        for (int jj = 0; jj < 8; ++jj) { const int j = part * 8 + jj;
            const float sum = ((imp[(0 * 64 + q) * 64 + j] * i0 + imp[(1 * 64 + q) * 64 + j] * i1) + imp[(2 * 64 + q) * 64 + j] * i2) + imp[(3 * 64 + q) * 64 + j] * i3;
            vj[jj] = (j > u) ? -1.0f : ((j == u || j == 0) ? 1.0e4f : sum); }
        __syncthreads();
#pragma unroll
        for (int jj = 0; jj < 8; ++jj) imp[q * 64 + part * 8 + jj] = vj[jj];
        __syncthreads();
        int rank[8];
#pragma unroll
        for (int jj = 0; jj < 8; ++jj) rank[jj] = 0;
        for (int i = 0; i < 64; ++i) { const float vi = imp[q * 64 + i];
#pragma unroll
            for (int jj = 0; jj < 8; ++jj) rank[jj] += (vi > vj[jj] || (vi == vj[jj] && i < part * 8 + jj)) ? 1 : 0; }
        unsigned bits = 0;
#pragma unroll
        for (int jj = 0; jj < 8; ++jj) if (rank[jj] < 16 && (part * 8 + jj) <= u) bits |= 1u << jj;
        unsigned mlo = (part < 4) ? (bits << (8 * part)) : 0u, mhi = (part >= 4) ? (bits << (8 * (part - 4))) : 0u;
        mlo |= __shfl_xor(mlo, 1); mhi |= __shfl_xor(mhi, 1); mlo |= __shfl_xor(mlo, 2); mhi |= __shfl_xor(mhi, 2); mlo |= __shfl_xor(mlo, 4); mhi |= __shfl_xor(mhi, 4);
        if (part == 0) { selm[2 * q] = mlo; selm[2 * q + 1] = mhi; }
    }
    __syncthreads();
#pragma unroll
    for (int r = 0; r < 16; ++r) { ofl[(2 * r) * 64] = o[0][r]; ofl[(2 * r + 1) * 64] = o[1][r]; }
    o[0] = (f32x16){}; o[1] = (f32x16){};
    {
        const unsigned long long mymask = (unsigned long long)selm[2 * ql] | ((unsigned long long)selm[2 * ql + 1] << 32);
        unsigned ulo = selm[2 * lane], uhi = selm[2 * lane + 1];
#pragma unroll
        for (int s2 = 1; s2 < 64; s2 <<= 1) { ulo |= __shfl_xor(ulo, s2); uhi |= __shfl_xor(uhi, s2); }
        unsigned long long um = (unsigned long long)(unsigned)__builtin_amdgcn_readfirstlane((int)ulo) | ((unsigned long long)(unsigned)__builtin_amdgcn_readfirstlane((int)uhi) << 32);
        const bf16_t* Kb = proj + rb * PINP + CD_KS; const bf16_t* Vb = proj + rb * PINP + CD_VS;
        float l_run = 0.f; const float nbound = -bnd[9 + hh]; const float cfar = tbl[127] + nbound; const float* gk = p.nsa_kn + (l * 3 + 1) * 64 + (tid & 7) * 8;
        int j = __builtin_ctzll(um); um &= um - 1;
        int jn = um ? __builtin_ctzll(um) : -1; um &= um - 1;
        kv_load(kr, vr, Kb, Vb, 64 * j, tid);
        kv_store(kr, vr, KVBUF(L, 0), tid);
        if (jn >= 0) kv_load(kr, vr, Kb, Vb, 64 * jn, tid);
        for (int it = 0;; ++it) {
            __syncthreads();
            const int jnn = um ? __builtin_ctzll(um) : -1; um &= um - 1;
            if (jn >= 0) { kv_store(kr, vr, KVBUF(L, it + 1), tid); }
            if (jnn >= 0) kv_load(kr, vr, Kb, Vb, 64 * jnn, tid);
            const bool mine = (mymask >> j) & 1ull;
            if (__any(mine)) {
                const LDSP unsigned char* buf = KVBUF(L, it);
                const int k0 = 64 * j; const bool nearb = (qw - (k0 + 63)) < 113;
                f32x16 p0 = splat16(nearb ? nbound : (mine ? cfar : -INFINITY)), p1 = p0;
                qkt<4>(p0, p1, buf, qf, 0, r32, hi);
                if (nearb) bias_near(p0, p1, tbl, t - k0, 1 << 30, mine, hi);
                l_run += exp_sum(p0, p1);
                pv(o, buf, vb, p0, p1);
            }
            if (jn < 0) break;
            j = jn; jn = jnn;
        }
        l_run += __shfl_xor(l_run, 32);
        scale_rows(o, gs / l_run, wsf, r32, hi);
#pragma unroll
        for (int r = 0; r < 16; ++r) { ofl[(2 * r) * 64] += o[0][r]; ofl[(2 * r + 1) * 64] += o[1][r]; }
        o[0] = (f32x16){}; o[1] = (f32x16){};
    }
    {
        const bf16_t* Kb = proj + rb * PINP + CD_KW; const bf16_t* Vb = proj + rb * PINP + CD_VW;
        float l_run = 0.f; const float nbound = -bnd[13 + hh]; const float cfar = tbl[127] + nbound; const float* gk = p.nsa_kn + (l * 3 + 2) * 64 + (tid & 7) * 8;
        const int jlo = max(0, u - 8);
        __syncthreads();
        kv_load(kr, vr, Kb, Vb, 64 * jlo, tid);
        kv_store(kr, vr, KVBUF(L, jlo), tid);
        if (jlo < u) kv_load(kr, vr, Kb, Vb, 64 * (jlo + 1), tid);
        for (int j = jlo; j <= u; ++j) {
            __syncthreads();
            if (j + 1 <= u) { kv_store(kr, vr, KVBUF(L, j + 1), tid); }
            if (j + 2 <= u) kv_load(kr, vr, Kb, Vb, 64 * (j + 2), tid);
            const LDSP unsigned char* buf = KVBUF(L, j);
            const int k0 = 64 * j; const bool nearb = (j == u || j == u - 8 || (qw - (k0 + 63)) < 113);
            f32x16 p0 = splat16(nearb ? nbound : cfar), p1 = p0;
            qkt<4>(p0, p1, buf, qf, 0, r32, hi);
            if (nearb) bias_near(p0, p1, tbl, t - k0, 512, true, hi);
            l_run += exp_sum(p0, p1);
            pv(o, buf, vb, p0, p1);
        }
        l_run += __shfl_xor(l_run, 32);
        scale_rows(o, gwn / l_run, wsf, r32, hi);
#pragma unroll
        for (int r = 0; r < 16; ++r) { o[0][r] += ofl[(2 * r) * 64]; o[1][r] += ofl[(2 * r + 1) * 64]; }
    }
    store_o(o, (LDSP bf16_t*)(L + AL_IMP + wid * 8192), mix + (rb + qw) * DM + 768 + 64 * hh, lane, r32, hi);
}

__device__ void ph_reset_queues(const Params& p) { unsigned* ctl = (unsigned*)(p.ws + WS_CTL); const int gt = GTID(); if (gt < 8) ctl[gt] = 0u; }
__device__ void prep_cmp_task(const Params& p, int l, int task, LDSP unsigned char* L) {
    const int tid = TID(), lane = tid & 63, wid = __builtin_amdgcn_readfirstlane(tid >> 6), r32 = lane & 31, hi = lane >> 5;
    const int b = task >> 4, which = (task >> 3) & 1, nt = task & 7;
    const bf16_t* proj = (const bf16_t*)(p.ws + WS_PROJ);
    const bf16_t* phiT = (const bf16_t*)(p.ws + WS_PHIT) + (size_t)(l * 2 + which) * 64 * 2048;
    const float* pe = p.nsa_pe + (size_t)(l * 2 + which) * 32 * 64;
    const int n = 32 * nt + r32, colbase = which ? CD_VC : CD_KC;
    f32x16 acc0 = (f32x16){}, acc1 = (f32x16){};
#pragma unroll
    for (int ii = 0; ii < 4; ++ii) {
        const int i = 4 * wid + ii; const int tok = min(16 * n + i, SEQ - 1);
        const bf16_t* xr = proj + (size_t)(b * SEQ + tok) * PINP + colbase;
#pragma unroll
        for (int d0 = 0; d0 < 4; ++d0) {
            float xv[8]; load8(xr + 16 * d0 + 8 * hi, xv);
            const f32x4 pe0 = *(const f32x4*)(pe + i * 64 + 16 * d0 + 8 * hi), pe1 = *(const f32x4*)(pe + i * 64 + 16 * d0 + 8 * hi + 4);
            u32x4 aw; aw[0] = pg8::cvt_pk_bf16(xv[0] + pe0[0], xv[1] + pe0[1]); aw[1] = pg8::cvt_pk_bf16(xv[2] + pe0[2], xv[3] + pe0[3]);
            aw[2] = pg8::cvt_pk_bf16(xv[4] + pe1[0], xv[5] + pe1[1]); aw[3] = pg8::cvt_pk_bf16(xv[6] + pe1[2], xv[7] + pe1[3]);
            const bf16x8 af = __builtin_bit_cast(bf16x8, aw);
            const bf16x8 b0 = *(const bf16x8*)(phiT + (size_t)r32 * 2048 + i * 64 + 16 * d0 + 8 * hi);
            const bf16x8 b1 = *(const bf16x8*)(phiT + (size_t)(32 + r32) * 2048 + i * 64 + 16 * d0 + 8 * hi);
            acc0 = __builtin_amdgcn_mfma_f32_32x32x16_bf16(af, b0, acc0, 0, 0, 0);
            acc1 = __builtin_amdgcn_mfma_f32_32x32x16_bf16(af, b1, acc1, 0, 0, 0);
        }
    }
    LDSP float* red = (LDSP float*)L;
    __syncthreads();
#pragma unroll
    for (int r = 0; r < 16; ++r) { red[(wid * 32 + crow(r, hi)) * 64 + r32] = acc0[r]; red[(wid * 32 + crow(r, hi)) * 64 + 32 + r32] = acc1[r]; }
    __syncthreads();
    {
        const int row = tid >> 4, e4 = (tid & 15) * 4; f32x4 v = (f32x4){0.f, 0.f, 0.f, 0.f};
#pragma unroll
        for (int w8 = 0; w8 < 8; ++w8) v += *(const LDSP f32x4*)(red + (w8 * 32 + row) * 64 + e4);
        const int nn = 32 * nt + row;
        if (which == 0) {
            float ss = (v[0] * v[0] + v[1] * v[1]) + (v[2] * v[2] + v[3] * v[3]);
            ss += __shfl_xor(ss, 1); ss += __shfl_xor(ss, 2); ss += __shfl_xor(ss, 4); ss += __shfl_xor(ss, 8);
            const float rs = rsqrtf(ss * (1.f / 64.f) + EPS); const f32x4 g = *(const f32x4*)(p.nsa_kn + (l * 3 + 0) * 64 + e4);
            v = v * rs * g;
        }
        uint2 o; o.x = pk2(v[0], v[1]); o.y = pk2(v[2], v[3]);
        if (nn >= 255) { o.x = 0u; o.y = 0u; }
        *(uint2*)((bf16_t*)(p.ws + (which ? WS_VC : WS_KC)) + (size_t)(b * 256 + nn) * 64 + e4) = o;
    }
}
__device__ void ph_prep(const Params& p, int l, LDSP unsigned char* L, unsigned char* lds) {
    for (int t = blockIdx.x; t < 80; t += gridDim.x) { if (t < 64) prep_cmp_task(p, l, t, L); }
    if (gridDim.x >= 80) { if (blockIdx.x >= 64 && blockIdx.x < 80) ph_prep_cum_bh(p, l, blockIdx.x - 64, lds); }
    else for (int bh = blockIdx.x; bh < 16; bh += gridDim.x) ph_prep_cum_bh(p, l, bh, lds);
}


__device__ void fa_phase_all(const Params& p, int l, LDSP unsigned char* L, unsigned char* lds, int qslot) {
    unsigned* ctl = (unsigned*)(p.ws + WS_CTL);
    LDSP unsigned* misc = (LDSP unsigned*)(L + AL_MISC);
    bool prep_ok = false;
    for (;;) {
        __syncthreads();
        if (threadIdx.x == 0) misc[0] = atomicAdd(&ctl[qslot], 1u);
        __syncthreads();
        const unsigned qi0 = misc[0];
        if (qi0 >= 1104u) break;
        if (qi0 < 80u) {
            if (qi0 < 64u) prep_cmp_task(p, l, (int)qi0, L); else ph_prep_cum_bh(p, l, (int)qi0 - 64, lds);
            asm volatile("s_waitcnt vmcnt(0)" ::: "memory");
            __syncthreads();
            if (threadIdx.x == 0) { __threadfence(); atomicAdd(&ctl[4 + qslot], 1u); }
            continue;
        }
        const unsigned qi = qi0 - 80u;
        const int r = 15 - (int)(qi >> 6), j = (int)(qi & 63), typ = j >> 4, sub = j & 15;
        if ((typ == 2 || typ == 3) && !prep_ok) {
            if (threadIdx.x == 0) { while (__hip_atomic_load(&ctl[4 + qslot], __ATOMIC_RELAXED, __HIP_MEMORY_SCOPE_AGENT) < 80u) __builtin_amdgcn_s_sleep(8); __threadfence(); }
            asm volatile("s_waitcnt vmcnt(0)" ::: "memory");
            __syncthreads();
            prep_ok = true;
        }
        if (typ == 0) fa_diff_unit(p, l, sub >> 2, sub & 3, r, L);
        else if (typ == 1) fa_stick_unit(p, l, sub >> 2, sub & 3, r, L);
        else if (typ == 2) fa_fox_unit(p, l, sub >> 2, sub & 3, r, L);
        else fa_nsa_unit(p, l, sub >> 2, 4 * r + (sub & 3), L);
    }
}

#define XB_TMO      128
#define XB_XCNT(j)  (256  + 64 * (j))
#define XB_XSUB(j)  (1280 + 64 * (j))
#define XB_XGEN(j)  (2304 + 64 * (j))
#define XB_TOP      3328
#define XB_TOPGEN   3392
#define XCD_BAR_WORDS 3456
#define XB_SPIN_CAP (1u << 18)

__device__ __forceinline__ unsigned xb_ld(unsigned* p)              { return __hip_atomic_load(p, __ATOMIC_RELAXED, __HIP_MEMORY_SCOPE_AGENT); }
__device__ __forceinline__ unsigned xb_add(unsigned* p, unsigned v) { return __hip_atomic_fetch_add(p, v, __ATOMIC_RELAXED, __HIP_MEMORY_SCOPE_AGENT); }
__device__ __forceinline__ unsigned xb_xcc_id() { return (unsigned)__builtin_amdgcn_s_getreg((3 << 11) | 20) & 0xFu; }
#define XB_SPIN(cond, bar) do { unsigned _sp = 0; while (cond) { __builtin_amdgcn_s_sleep(1); \
    if ((++_sp & 255u) == 0u) { if (xb_ld(&(bar)[XB_TMO])) break; if (_sp > XB_SPIN_CAP) { atomicAdd(&(bar)[XB_TMO], 1u); break; } } } } while (0)

struct XcdBarrier {
    unsigned* bar; unsigned x;
    volatile LDSF unsigned* st;
};

__device__ __forceinline__ XcdBarrier xcd_barrier_post(unsigned* bar, volatile LDSF unsigned* st) {
    XcdBarrier b; b.bar = bar; b.x = xb_xcc_id(); b.st = st;
    if (threadIdx.x == 0) (void)xb_add(&bar[XB_XCNT(b.x)], 1u);
    return b;
}
__device__ __forceinline__ void xcd_barrier_complete(unsigned* bar, unsigned x, unsigned& nloc, unsigned& nx) {
    const unsigned G = gridDim.x * gridDim.y * gridDim.z;
    unsigned sum, cnt, mine, sp = 0u;
    for (;;) {
        sum = 0u; cnt = 0u; mine = 0u;
#pragma unroll
        for (unsigned j = 0; j < 16; ++j) { const unsigned c = xb_ld(&bar[XB_XCNT(j)]); sum += c; cnt += (c > 0u) ? 1u : 0u; mine = (j == x) ? c : mine; }
        if (sum == G) break;
        __builtin_amdgcn_s_sleep(1);
        if ((++sp & 255u) == 0u) { if (xb_ld(&bar[XB_TMO])) break; if (sp > XB_SPIN_CAP) { atomicAdd(&bar[XB_TMO], 1u); break; } }
    }
    nloc = mine > 0u ? mine : 1u; nx = cnt > 0u ? cnt : 1u;
}

__device__ __forceinline__ void xcd_barrier(const XcdBarrier& b) {
    asm volatile("s_waitcnt vmcnt(0)" ::: "memory");
    __syncthreads();
    if (threadIdx.x == 0) {
        unsigned* bar = b.bar;
        __builtin_amdgcn_s_waitcnt(0);
        unsigned nloc = b.st[0], nx = b.st[1];
        if (nloc == 0u) { xcd_barrier_complete(bar, b.x, nloc, nx); b.st[0] = nloc; b.st[1] = nx; }
        const unsigned old = xb_add(&bar[XB_XSUB(b.x)], 1u);
        const unsigned gen = old / nloc;
        if (old + 1u == (gen + 1u) * nloc) {
            __builtin_amdgcn_fence(__ATOMIC_RELEASE, "agent");
            asm volatile("s_waitcnt vmcnt(0)" ::: "memory");
            const unsigned og = xb_add(&bar[XB_TOP], 1u);
            const unsigned tg = og / nx;
            if (og + 1u == (tg + 1u) * nx) xb_add(&bar[XB_TOPGEN], 1u);
            else XB_SPIN(xb_ld(&bar[XB_TOPGEN]) == tg, bar);
            __builtin_amdgcn_fence(__ATOMIC_ACQUIRE, "agent");
            xb_add(&bar[XB_XGEN(b.x)], 1u);
            asm volatile("s_waitcnt vmcnt(0)" ::: "memory");
        } else {
            XB_SPIN(xb_ld(&bar[XB_XGEN(b.x)]) == gen, bar);
            __builtin_amdgcn_fence(__ATOMIC_ACQUIRE, "agent");
            asm volatile("s_waitcnt vmcnt(0)" ::: "memory");
        }
    }
    __syncthreads();
}

namespace cg = cooperative_groups;
constexpr int LDS_BYTES = 131072 + 8192 + 4096;
#define LAS3 __attribute__((address_space(3)))
#ifndef PROBE
#define PROBE 0
#endif
__global__ void __launch_bounds__(NTHR, 2) mega(Params p) {
    extern __shared__ __attribute__((aligned(16))) unsigned char lds[];
    cg::grid_group grid = cg::this_grid();
#if PROBE
    unsigned long long tacc = 0, tph = 0, t0_;
#define GSYNC() do { t0_ = __builtin_amdgcn_s_memrealtime(); xcd_barrier(xbar); tacc += __builtin_amdgcn_s_memrealtime() - t0_; } while (0)
#define TPK(k, ...) do { if (PROBE == (k)) { t0_ = __builtin_amdgcn_s_memrealtime(); __VA_ARGS__; tph += __builtin_amdgcn_s_memrealtime() - t0_; } else { __VA_ARGS__; } } while (0)
#else
#define GSYNC() xcd_barrier(xbar)
#define TPK(k, ...) do { __VA_ARGS__; } while (0)
#endif
    LAS3 unsigned char* lds3 = (LAS3 unsigned char*)lds;
    volatile LDSF unsigned* bst = (volatile LDSF unsigned*)(lds3 + 131072 + 2048);
    if (threadIdx.x < 2) bst[threadIdx.x] = 0u;
    __syncthreads();
    XcdBarrier xbar = xcd_barrier_post((unsigned*)(p.ws + WS_CTL) + 16384, bst);
    TPK(2, ph_mod(p, lds); ph_reset_queues(p); ph_weights(p, 0, lds); ph_weights(p, 1, lds));
    grid.sync();
    for (int l = 0; l < DEPTH; ++l) {
        const float* mod = (const float*)(p.ws + WS_MOD) + (size_t)l * 4 * 6144;
        if (l == 0) {
            TPK(2, ph_cbias(p, lds); ph_xa_from(p, p.x, 0, 0, (bf16_t*)(p.ws + WS_XA), (float*)(p.ws + WS_RSA), true));
            GSYNC();
        }
        {   pg8::Gemm g{(const bf16_t*)(p.ws + WS_XA), (const bf16_t*)(p.ws + WS_WIN + l * WS_W1OFF), MTOK, PINP, DM}; pg8::StaticOrder S; S.init(MTOK, PINP, (int)gridDim.x, (int)blockIdx.x);
            EpiProjF E{(const float*)(p.ws + WS_RSA), (const float*)(p.ws + WS_CBIN) + (size_t)l * 4 * PINP, (bf16_t*)(p.ws + WS_PROJ), (float*)(p.ws + WS_SIDE),
                       p.diff_kn + l * 32, p.fox_kn + l * 64, p.nsa_kn + (l * 3 + 1) * 64, p.nsa_kn + (l * 3 + 2) * 64, (LDSF float*)(lds3 + 131072 + 4096)};
            TPK(6, pg8::gemm_phase<EpiProjF, pg8::StaticOrder, true, PG8_SP2>(lds3, g, S, E)); }
        GSYNC();
        TPK(7, fa_phase_all(p, l, lds3, lds, l));
        GSYNC();
        {   pg8::Gemm g{(const bf16_t*)(p.ws + WS_MIX), (const bf16_t*)(p.ws + WS_WOUT + l * WS_W1OFF), MTOK, DM, DM}; pg8::StaticOrder S; S.init(MTOK, DM, (int)gridDim.x, (int)blockIdx.x);
            EpiResF E{l == 0 ? p.x : p.out, p.out, mod + 2048, p.norm_ffn_g + l * DM, mod + 4096, (bf16_t*)(p.ws + WS_XA), (float*)(p.ws + WS_RSB)};
            TPK(6, pg8::gemm_phase<EpiResF, pg8::StaticOrder, PG8_ALIGN, PG8_SP2>(lds3, g, S, E)); }
        GSYNC();
        {   pg8::Gemm g{(const bf16_t*)(p.ws + WS_XA), (const bf16_t*)(p.ws + WS_WUP + l * WS_W1OFF), MTOK, NUP, DM}; pg8::StaticOrder S; S.init(MTOK, NUP, (int)gridDim.x, (int)blockIdx.x);
            EpiUpAct E{(const float*)(p.ws + WS_RSB), (const float*)(p.ws + WS_CBUP) + (size_t)l * 4 * NUP, (bf16_t*)(p.ws + WS_ACT), (float*)(p.ws + WS_EG), (float*)(p.ws + WS_EV),
                       p.conv_w + (size_t)l * 3 * DFF, p.conv_b + (size_t)l * DFF, (LDSF float*)(lds3 + 131072 + 4096), (LDSF float*)(lds3 + 131072 + 8192)};
            TPK(6, pg8::gemm_phase<EpiUpAct, pg8::StaticOrder, true, PG8_SP2>(lds3, g, S, E)); }
        GSYNC();
        {   const float* modn = (const float*)(p.ws + WS_MOD) + (size_t)(l + 1) * 4 * 6144; const bool more = (l + 1 < DEPTH);
            pg8::Gemm g{(const bf16_t*)(p.ws + WS_ACT), (const bf16_t*)(p.ws + WS_WDN + l * WS_W1OFF), MTOK, DM, DFF}; pg8::StaticOrder S; S.init(MTOK, DM, (int)gridDim.x, (int)blockIdx.x);
            { pg8::Unit fu; for (int i = 0; S.next(i, fu); ++i) act_fixup(p, l, fu.pm); }
            __builtin_amdgcn_fence(__ATOMIC_RELEASE, "agent"); __builtin_amdgcn_fence(__ATOMIC_ACQUIRE, "agent"); __syncthreads();
            EpiResF E{p.out, p.out, mod + 5120, p.norm_mix_g + (more ? l + 1 : l) * DM, more ? modn + 1024 : mod + 1024, more ? (bf16_t*)(p.ws + WS_XA) : nullptr, more ? (float*)(p.ws + WS_RSA) : nullptr};
            TPK(6, pg8::gemm_phase<EpiResF, pg8::StaticOrder, PG8_ALIGN, PG8_SP2>(lds3, g, S, E)); }
        if (l + 1 < DEPTH) GSYNC();
    }
#if PROBE == 1
    if (blockIdx.x == 0 && threadIdx.x == 0) p.out[0] += 0.05f + (float)tacc * 0.01f * 5e-4f;
#elif PROBE >= 2
    if (blockIdx.x == 0 && threadIdx.x == 0) p.out[0] += 0.05f + (float)tph * 0.01f * 1e-4f;
#endif
}

extern "C" void kernel_launch(void* const* d_in, const int* in_sizes, int in, void* d_out, int out_size, void* d_ws, size_t ws_size, hipStream_t stream) {
    if (in != 24 || ws_size < WS_END || out_size != MTOK * DM) { fprintf(stderr, "kernel_launch: unexpected sizes (in %d, ws %zu, out %d)\n", in, ws_size, out_size); return; }
    static int grid_blocks = 0;
    if (!grid_blocks) {
        int dev = 0, cus = 0, per_cu = 0;
        hipGetDevice(&dev);
        hipDeviceGetAttribute(&cus, hipDeviceAttributeMultiprocessorCount, dev);
        hipFuncSetAttribute((const void*)mega, hipFuncAttributeMaxDynamicSharedMemorySize, LDS_BYTES);
        hipOccupancyMaxActiveBlocksPerMultiprocessor(&per_cu, (const void*)mega, NTHR, LDS_BYTES);
        if (per_cu < 1) { fprintf(stderr, "kernel_launch: occupancy query returned %d\n", per_cu); per_cu = 1; }
        if (per_cu > 1) per_cu = 1;
        grid_blocks = cus * per_cu;
        fprintf(stderr, "kernel_launch: cus %d per_cu %d grid %d\n", cus, per_cu, grid_blocks);
    }
    if (hipMemsetAsync((char*)d_ws + WS_CTL + 65536, 0, XCD_BAR_WORDS * 4, stream) != hipSuccess) { fprintf(stderr, "kernel_launch: memset failed\n"); return; }
    Params p{};
    const float** f = (const float**)&p;
    for (int i = 0; i < 24; ++i) f[i] = (const float*)d_in[i];
    p.out = (float*)d_out; p.ws = (unsigned char*)d_ws;
    void* args[] = {&p};
    hipError_t e = hipLaunchCooperativeKernel((const void*)mega, dim3(grid_blocks), dim3(NTHR), args, LDS_BYTES, stream);
    if (e != hipSuccess) fprintf(stderr, "cooperative launch failed: %s (grid %d)\n", hipGetErrorString(e), grid_blocks);
}
```

```cpp
#include <hip/hip_runtime.h>
#include <hip/hip_cooperative_groups.h>
#include <cstdint>
#include <cstdio>

typedef unsigned short bf16_t;
typedef short bf16x8 __attribute__((ext_vector_type(8)));
typedef float f32x4 __attribute__((ext_vector_type(4)));
typedef unsigned u32x4 __attribute__((ext_vector_type(4)));

constexpr int NB = 4, SEQ = 4096, DM = 1024, MTOK = NB * SEQ, DEPTH = 2;
constexpr int HD = 64, HPM = 4, DFF = 2816, PIN = 2960, PINP = 3072, NUP = 2 * DFF;
constexpr float EPS = 1e-6f;
constexpr float LOG2E = 1.4426950408889634f;
constexpr int NTHR = 512;

constexpr int CA_Q = 0, CA_K = 256, CA_V = 512, CB_Q = 768, CB_K = 1024, CB_V = 1280, CC_Q = 1536, CC_K = 1792, CC_V = 2048;
constexpr int CD_Q = 2304, CD_KC = 2560, CD_VC = 2624, CD_KS = 2688, CD_VS = 2752, CD_KW = 2816, CD_VW = 2880, C_BF = 2944, C_DG = 2948;

constexpr size_t MiB = 1u << 20;
constexpr size_t WS_CTL = 0;
constexpr size_t WS_MOD = 1 * MiB;
constexpr size_t WS_CBIN = WS_MOD + 2 * 4 * 6144 * 4;
constexpr size_t WS_CBUP = WS_CBIN + 2 * 4 * 3072 * 4;
constexpr size_t WS_TB = WS_CBUP + 2 * 4 * 5632 * 4;
constexpr size_t WS_LAM = WS_TB + 2 * 4 * 128 * 4;
constexpr size_t WS_BND = WS_LAM + 64;
constexpr size_t WS_CUM = WS_LAM + 512;
constexpr size_t WS_KC = WS_CUM + 16 * 4096 * 4;
constexpr size_t WS_VC = WS_KC + 4 * 256 * 64 * 2;
constexpr size_t WS_SELM = WS_VC + 4 * 256 * 64 * 2;
constexpr size_t WS_SMALL_END = WS_SELM + 16384 * 8;
static_assert(WS_SMALL_END <= 4 * MiB, "small region");
constexpr size_t WS_RSA = 4 * MiB;
constexpr size_t WS_RSB = 5 * MiB;
constexpr size_t WS_SIDE = 6 * MiB;
constexpr size_t WS_IMP = 7 * MiB;
constexpr size_t WS_ML = 11 * MiB;
constexpr size_t WS_PHIT = 7 * MiB;
constexpr size_t WS_W = 12 * MiB;
constexpr size_t WS_WIN = WS_W;
constexpr size_t WS_WOUT = WS_WIN + (size_t)PINP * DM * 2;
constexpr size_t WS_WUP = WS_WOUT + (size_t)DM * DM * 2;
constexpr size_t WS_WDN = WS_WUP + (size_t)NUP * DM * 2;
constexpr size_t WS_W_END = WS_WDN + (size_t)DM * DFF * 2;
static_assert(WS_W_END <= 38 * MiB, "weights region");
constexpr size_t WS_XA = 38 * MiB;
constexpr size_t WS_BIG = 70 * MiB;
constexpr size_t WS_PROJ = WS_BIG;
constexpr size_t WS_MIX = WS_BIG + 96 * MiB;
constexpr size_t WS_ACT = WS_BIG;
constexpr size_t WS_W1OFF = 188 * MiB;
constexpr size_t WS_EG = 228 * MiB;
constexpr size_t WS_EV = 232 * MiB;
constexpr size_t WS_END = 236 * MiB;
static_assert(WS_W_END + WS_W1OFF <= WS_EG && WS_MIX + 32 * MiB <= WS_W + WS_W1OFF, "layer-1 weights");
static_assert(WS_END <= 256 * MiB, "workspace");

struct Params {
    const float *x, *c, *rel_bias, *ada_w, *ada_b, *norm_mix_g, *norm_ffn_g, *w_in, *w_out;
    const float *diff_qn, *diff_kn, *diff_lam, *diff_sub, *fox_qn, *fox_kn, *fox_bf;
    const float *nsa_qn, *nsa_kn, *nsa_pe, *nsa_phi, *w_up, *conv_w, *conv_b, *w_down;
    float* out;
    unsigned char* ws;
};

__device__ __forceinline__ float bf2f(bf16_t v) { return __uint_as_float(((unsigned)v) << 16); }
__device__ __forceinline__ bf16_t f2bf(float f) { unsigned u = __float_as_uint(f); return (bf16_t)((u + 0x7fffu + ((u >> 16) & 1u)) >> 16); }
__device__ __forceinline__ unsigned pk2(float lo, float hi) { return (unsigned)f2bf(lo) | ((unsigned)f2bf(hi) << 16); }
__device__ __forceinline__ float siluf(float v) { return v / (1.f + __expf(-v)); }
__device__ __forceinline__ float logsigf(float v) { return fminf(v, 0.f) - log1pf(__expf(-fabsf(v))); }
__device__ __forceinline__ float wave_sum(float v) {
#pragma unroll
    for (int o = 1; o < 64; o <<= 1) v += __shfl_xor(v, o);
    return v;
}
__device__ __forceinline__ int t5_bucket(int n) {
    if (n < 16) return n < 0 ? 0 : n;
    return 16 + (n >= 19) + (n >= 21) + (n >= 24) + (n >= 27) + (n >= 31) + (n >= 35) + (n >= 40) + (n >= 46) + (n >= 52) + (n >= 59) + (n >= 67) + (n >= 77) + (n >= 87) + (n >= 99) + (n >= 113);
}
__host__ __device__ __forceinline__ int in_col_map(int n) {
    if (n < 1536) return n;
    if (n < 2944) return n + 4;
    if (n < 2948) return 1536 + (n - 2944);
    if (n < 2960) return n;
    return -1;
}
__host__ __device__ __forceinline__ int up_col_map(int n) {
    const int pn = n >> 8, c = n & 255;
    return c < 128 ? (128 * pn + c) : (DFF + 128 * pn + (c - 128));
}

__device__ __forceinline__ int opaque_v(int v) { asm volatile("" : "+v"(v)); return v; }
#define TID() opaque_v((int)threadIdx.x)
#define GTID() ((int)(blockIdx.x * blockDim.x) + TID())
#define GSIZE() ((int)(gridDim.x * blockDim.x))

#define LDSF __attribute__((address_space(3)))
__device__ __forceinline__ void gemv4_block(const float* W, int ld, int oc, const LDSF float* vec, LDSF float* red, float* out0, int ostride, int n, float bias, int tid) {
    const int lane = tid & 63, wv = tid >> 6;
    float a0 = 0.f, a1 = 0.f, a2 = 0.f, a3 = 0.f;
    if (oc >= 0) {
        const float* w = W + (size_t)(wv * 128) * ld + oc;
#pragma unroll 32
        for (int k = 0; k < 128; ++k) { const float wk = w[(size_t)k * ld]; const f32x4 v = *(const LDSF f32x4*)(vec + (wv * 128 + k) * 4); a0 += v[0] * wk; a1 += v[1] * wk; a2 += v[2] * wk; a3 += v[3] * wk; }
    }
    red[(wv * 4 + 0) * 64 + lane] = a0; red[(wv * 4 + 1) * 64 + lane] = a1; red[(wv * 4 + 2) * 64 + lane] = a2; red[(wv * 4 + 3) * 64 + lane] = a3;
    __syncthreads();
    if (tid < 256) { const int bt = tid >> 6; float sacc = 0.f;
#pragma unroll
        for (int w8 = 0; w8 < 8; ++w8) sacc += red[(w8 * 4 + bt) * 64 + lane];
        out0[(size_t)bt * ostride + n] = sacc + bias; }
    __syncthreads();
}
__device__ void ph_mod(const Params& p, unsigned char* lds) {
    float* mod = (float*)(p.ws + WS_MOD);
    float* tb = (float*)(p.ws + WS_TB);
    float* lamv = (float*)(p.ws + WS_LAM);
    LDSF float* vec = (LDSF float*)lds; LDSF float* red = (LDSF float*)(lds + 16384);
    const int tid = TID();
    bool loaded = false;
    for (int item = blockIdx.x; item < DEPTH * 96; item += gridDim.x) {
        if (!loaded) { for (int i = tid; i < 4096; i += NTHR) { const int bt = i >> 10, k = i & 1023; vec[k * 4 + bt] = siluf(p.c[bt * DM + k]); } __syncthreads(); loaded = true; }
        const int l = item / 96, n = (item % 96) * 64 + (tid & 63);
        gemv4_block(p.ada_w + (size_t)l * DM * 6144, 6144, n, vec, red, mod + (size_t)l * 4 * 6144, 6144, n, p.ada_b[l * 6144 + n], tid);
    }
    const int gt = GTID(), gs = GSIZE();
    for (int idx = gt; idx < 2 * 4 * 128; idx += gs) {
        const int type = idx / 512, h = (idx / 128) & 3, d = idx & 127;
        tb[idx] = p.rel_bias[t5_bucket(d) * 8 + type * 4 + h];
    }
    for (int idx = gt; idx < DEPTH * 32; idx += gs) {
        const int l = idx >> 5, e = idx & 31; float v = 0.f;
        if (e < 17) {
            const int type = (e < 5) ? 0 : 1, h = (e < 4) ? e : ((e == 4) ? 0 : ((e - 5) & 3));
            const int ng = (e < 4) ? 32 : 64;
            const float* gq = (e < 4) ? p.diff_qn + l * 32 : ((e == 4) ? p.fox_qn + l * 64 : p.nsa_qn + l * 64);
            const float* gk = (e < 4) ? p.diff_kn + l * 32 : ((e == 4) ? p.fox_kn + l * 64 : p.nsa_kn + (l * 3 + (e - 5) / 4) * 64);
            float mq = 0.f, mk = 0.f; for (int i = 0; i < ng; ++i) { mq = fmaxf(mq, fabsf(gq[i])); mk = fmaxf(mk, fabsf(gk[i])); }
            float tm = 0.f; if (e != 4) { tm = -INFINITY; for (int bk2 = 0; bk2 < 32; ++bk2) tm = fmaxf(tm, p.rel_bias[bk2 * 8 + type * 4 + h]); }
            v = sqrtf((float)ng) * mq * mk * 1.02f * LOG2E + tm * LOG2E;
        }
        ((float*)(p.ws + WS_BND))[idx] = v;
    }
    for (int idx = gt; idx < DEPTH; idx += gs) {
        const float* lv = p.diff_lam + idx * 4 * 32;
        float s1 = 0.f, s2 = 0.f;
        for (int i = 0; i < 32; ++i) { s1 += lv[i] * lv[32 + i]; s2 += lv[64 + i] * lv[96 + i]; }
        const float lam_init = 0.8f - 0.6f * expf(-0.3f * (float)idx);
        lamv[idx] = expf(s1) - expf(s2) + lam_init;
    }
}
__device__ void ph_cbias(const Params& p, unsigned char* lds) {
    const float* mod = (const float*)(p.ws + WS_MOD);
    LDSF float* vec = (LDSF float*)lds; LDSF float* red = (LDSF float*)(lds + 16384);
    const int tid = TID();
    for (int item = blockIdx.x; item < DEPTH * 136; item += gridDim.x) {
        const int l = item / 136, r = item % 136; const bool isin = r < 48; const int n = (isin ? r : r - 48) * 64 + (tid & 63);
        const int shoff = isin ? 0 : 3072;
        __syncthreads();
        for (int i = tid; i < 4096; i += NTHR) { const int bt = i >> 10, k = i & 1023; vec[k * 4 + bt] = mod[(size_t)(l * 4 + bt) * 6144 + shoff + k]; }
        __syncthreads();
        if (isin) gemv4_block(p.w_in + (size_t)l * DM * PIN, PIN, in_col_map(n), vec, red, (float*)(p.ws + WS_CBIN) + (size_t)l * 4 * PINP, PINP, n, 0.f, tid);
        else gemv4_block(p.w_up + (size_t)l * DM * NUP, NUP, up_col_map(n), vec, red, (float*)(p.ws + WS_CBUP) + (size_t)l * 4 * NUP, NUP, n, 0.f, tid);
    }
}
template <int MAPK>
__device__ void convert_weight(const float* W, int K, int Nsrc, int Npad, bf16_t* Wt, LDSF float* scr, int gw, int ngw, int lane) {
    const int nkb = K / 64, nnb = Npad / 32;
    for (int it = gw; it < nkb * nnb; it += ngw) {
        const int kb = it / nnb, nb = it % nnb, k0 = kb * 64, n0 = nb * 32;
        {
            const int nn = lane & 31; const int n = n0 + nn;
            const int oc = MAPK == 0 ? n : (MAPK == 1 ? in_col_map(n) : up_col_map(n));
            float tv[32];
            const float* wp = W + (size_t)(k0 + (lane >> 5)) * Nsrc + (oc >= 0 ? oc : 0);
#pragma unroll
            for (int i = 0; i < 32; ++i) tv[i] = wp[(size_t)(2 * i) * Nsrc];
#pragma unroll
            for (int i = 0; i < 32; ++i) scr[(2 * i + (lane >> 5)) * 33 + nn] = (oc >= 0) ? tv[i] : 0.f;
        }
        __builtin_amdgcn_s_waitcnt(0xc07f); __builtin_amdgcn_wave_barrier();
        {
            const int c = lane & 7;
#pragma unroll
            for (int j = 0; j < 4; ++j) { const int n = (lane >> 3) + 8 * j; const LDSF float* sp = scr + (8 * c) * 33 + n;
                u32x4 o; o[0] = pk2(sp[0], sp[33]); o[1] = pk2(sp[66], sp[99]); o[2] = pk2(sp[132], sp[165]); o[3] = pk2(sp[198], sp[231]);
                *(u32x4*)(Wt + (size_t)(n0 + n) * K + k0 + 8 * c) = o; }
        }
        __builtin_amdgcn_s_waitcnt(0xc07f); __builtin_amdgcn_wave_barrier();
    }
}
__device__ void ph_weights(const Params& p, int l, unsigned char* lds) {
    const int tid_ = TID(); const int lane = tid_ & 63, wv = tid_ >> 6;
    const int gw = blockIdx.x * (NTHR >> 6) + wv, ngw = gridDim.x * (NTHR >> 6);
    LDSF float* scr = (LDSF float*)lds + wv * (64 * 33);
    convert_weight<1>(p.w_in + (size_t)l * DM * PIN, DM, PIN, PINP, (bf16_t*)(p.ws + WS_WIN + l * WS_W1OFF), scr, gw, ngw, lane);
    convert_weight<0>(p.w_out + (size_t)l * DM * DM, DM, DM, DM, (bf16_t*)(p.ws + WS_WOUT + l * WS_W1OFF), scr, gw, ngw, lane);
    convert_weight<2>(p.w_up + (size_t)l * DM * NUP, DM, NUP, NUP, (bf16_t*)(p.ws + WS_WUP + l * WS_W1OFF), scr, gw, ngw, lane);
    convert_weight<0>(p.w_down + (size_t)l * DFF * DM, DFF, DM, DM, (bf16_t*)(p.ws + WS_WDN + l * WS_W1OFF), scr, gw, ngw, lane);
    for (int w2 = 0; w2 < 2; ++w2) convert_weight<0>(p.nsa_phi + (size_t)(l * 2 + w2) * 2048 * 64, 2048, 64, 64, (bf16_t*)(p.ws + WS_PHIT) + (size_t)(l * 2 + w2) * 64 * 2048, scr, gw, ngw, lane);
}
__device__ void ph_xa_from(const Params& p, const float* src, int l, int which  , bf16_t* XA, float* rowss, bool write_xa) {
    const float* mod = (const float*)(p.ws + WS_MOD);
    const float* g = (which == 0 ? p.norm_mix_g : p.norm_ffn_g) + l * DM;
    const int tid_ = TID(); const int lane = tid_ & 63, wv = tid_ >> 6;
    const int gw = blockIdx.x * (blockDim.x >> 6) + wv, ngw = gridDim.x * (blockDim.x >> 6);
    for (int row = gw; row < MTOK; row += ngw) {
        const int b = row / SEQ;
        const float* sc = mod + (size_t)(l * 4 + b) * 6144 + (which == 0 ? 1024 : 4096);
        float ss = 0.f;
#pragma unroll
        for (int j = 0; j < 4; ++j) {
            const int k = j * 256 + lane * 4;
            const f32x4 v = *(const f32x4*)(src + (size_t)row * DM + k);
            ss += v[0] * v[0] + v[1] * v[1] + v[2] * v[2] + v[3] * v[3];
            if (write_xa) {
                const f32x4 gv = *(const f32x4*)(g + k); const f32x4 sv = *(const f32x4*)(sc + k);
                uint2 o; o.x = pk2(v[0] * gv[0] * (1.f + sv[0]), v[1] * gv[1] * (1.f + sv[1])); o.y = pk2(v[2] * gv[2] * (1.f + sv[2]), v[3] * gv[3] * (1.f + sv[3]));
                *(uint2*)(XA + (size_t)row * DM + k) = o;
            }
        }
        ss = wave_sum(ss);
        if (lane < 16) rowss[(size_t)row * 16 + lane] = (lane == 0) ? ss : 0.f;
    }
}

namespace pg8 {
#define PG8_LAS __attribute__((address_space(3)))
typedef unsigned short bf16_t;
typedef short bf16x8 __attribute__((ext_vector_type(8)));
typedef float f32x4 __attribute__((ext_vector_type(4)));
typedef unsigned u32x4 __attribute__((ext_vector_type(4)));
constexpr int BM = 256, BK = 64, HALF = 128, HTB = HALF * BK * 2  , STAGE_BYTES = 8 * HTB, NXCD = 8, WGM = 8;

__host__ __device__ __forceinline__ int lds_byte(int r, int c) { const int st = (r >> 4) * 2 + (c >> 5), rr = r & 15, cc = c & 31, ob = rr * 64 + cc * 2; return st * 1024 + (ob ^ (((ob >> 9) & 1) << 5)); }
__host__ __device__ __forceinline__ void stage_rc(int b, int& R, int& C) { const int st = b / 1024, sb = b % 1024, swz = sb ^ (((sb >> 9) & 1) << 5); R = (st >> 1) * 16 + swz / 64; C = (st & 1) * 32 + (swz % 64) / 2; }
__host__ __device__ __forceinline__ int perm32(int rho) { const int n = rho >> 4, i = rho & 15; return 8 * (i >> 2) + 4 * n + (i & 3); }

struct Unit { int pm, pn; };
struct Gemm { const bf16_t* A; const bf16_t* Bt; int M, N, K; };

struct StaticOrder {
    int nM, nN, nwg, G, c;
    __host__ __device__ void init(int M, int N, int G_, int c_) { nM = M / BM; nN = N / BM; nwg = nM * nN; G = G_; c = c_; }
    __host__ __device__ bool next(int i, Unit& u) const {
        const long L = (long)i * G + c; if (L >= nwg) return false;
        int wgid = (int)L; { const int q = nwg / NXCD, r = nwg % NXCD, xcd = wgid % NXCD, off = wgid / NXCD; wgid = (xcd < r ? xcd * (q + 1) : r * (q + 1) + (xcd - r) * q) + off; }
        const int nig = WGM * nN, gid = wgid / nig, fm = gid * WGM, gsz = (nM - fm) < WGM ? (nM - fm) : WGM;
        u.pm = fm + ((wgid % nig) % gsz); u.pn = (wgid % nig) / gsz; return true;
    }
    __device__ __forceinline__ void a_ready(const Unit&) const {}
    __device__ __forceinline__ void done(const Unit&) const {}
};


__device__ __forceinline__ unsigned cvt_pk_bf16(float lo, float hi) { unsigned r; asm volatile("v_cvt_pk_bf16_f32 %0, %1, %2" : "=v"(r) : "v"(lo), "v"(hi)); return r; }
template <class Epi, class Sched, bool ALIGN_EPI = false, bool SP2 = false>
__device__ __forceinline__ void gemm_phase(PG8_LAS unsigned char* lds, const Gemm g, const Sched& S, const Epi& E) {
    const int tid = TID(), wid = __builtin_amdgcn_readfirstlane(tid >> 6), lane = tid & 63, wr = wid >> 2, wc = wid & 3, fr = lane & 15, fq = lane >> 4;
    const int K = g.K, nt = K / BK;
    unsigned voffA[2], voffB[2];
#pragma unroll
    for (int i = 0; i < 2; ++i) { int R, C; stage_rc(tid * 16 + i * 8192, R, C); const int Rb = Epi::PERM ? ((R & ~31) + perm32(R & 31)) : R;
        voffA[i] = (unsigned)(R * K + C) * 2u; voffB[i] = (unsigned)(Rb * K + C) * 2u; }
    const size_t kstep = (size_t)(BK * 2);
    const size_t hstep = (size_t)HALF * K * 2;
    const size_t tstep = 2 * hstep;
    const unsigned ldsw = (unsigned)wid * 1024u;
    const int aoff = lds_byte(wr * 64 + fr, fq * 8), boff = lds_byte(wc * 32 + fr, fq * 8);
#define PG8_SA(b, h) (((b) * 2 + (h)) * HTB)
#define PG8_SB(b, h) ((4 + (b) * 2 + (h)) * HTB)
#define PG8_STAGE(bufoff, gbase, voff) do { _Pragma("unroll") for (int _i = 0; _i < 2; ++_i) \
        __builtin_amdgcn_global_load_lds((const unsigned*)((const char*)(gbase) + (voff)[_i]), (PG8_LAS unsigned*)(lds + (bufoff) + ldsw + _i * 8192), 16, 0, 0); } while (0)
#define PG8_LDA(dst, b, h) do { _Pragma("unroll") for (int m = 0; m < 4; ++m) _Pragma("unroll") for (int k = 0; k < 2; ++k) dst[m][k] = *(const PG8_LAS bf16x8*)(lds + PG8_SA(b, h) + aoff + m * 2048 + k * 1024); } while (0)
#define PG8_LDB(dst, b, h) do { _Pragma("unroll") for (int n = 0; n < 2; ++n) _Pragma("unroll") for (int k = 0; k < 2; ++k) dst[n][k] = *(const PG8_LAS bf16x8*)(lds + PG8_SB(b, h) + boff + n * 2048 + k * 1024); } while (0)
#define PG8_MMA(ai, bj, At, Bt) do { __builtin_amdgcn_s_setprio(1); _Pragma("unroll") for (int m = 0; m < 4; ++m) _Pragma("unroll") for (int n = 0; n < 2; ++n) _Pragma("unroll") for (int k = 0; k < 2; ++k) \
        acc[ai][bj][m][n] = __builtin_amdgcn_mfma_f32_16x16x32_bf16(Bt[n][k], At[m][k], acc[ai][bj][m][n], 0, 0, 0); __builtin_amdgcn_s_setprio(0); } while (0)
#define PG8_WAIT_V(n) asm volatile("s_waitcnt vmcnt(" #n ")" ::: "memory")
#define PG8_WAIT_L(n) asm volatile("s_waitcnt lgkmcnt(" #n ")" ::: "memory")
#define PG8_BAR __builtin_amdgcn_s_barrier()
#define PG8_SCHED __builtin_amdgcn_sched_barrier(0)
    Unit cur, nxt; int ui = 0;
    if (!S.next(0, cur)) return;
    f32x4 acc[2][2][4][2];
#pragma unroll
    for (int a = 0; a < 2; ++a)
#pragma unroll
        for (int b = 0; b < 2; ++b)
#pragma unroll
            for (int m = 0; m < 4; ++m)
#pragma unroll
                for (int n = 0; n < 2; ++n) acc[a][b][m][n] = (f32x4){0.f, 0.f, 0.f, 0.f};
    bf16x8 At[4][2], B0[2][2], B1[2][2];
    const char* cA = (const char*)g.A + (size_t)cur.pm * tstep; const char* cB = (const char*)g.Bt + (size_t)cur.pn * tstep;
    S.a_ready(cur);
    if constexpr (SP2) {
        PG8_STAGE(PG8_SB(0, 0), cB, voffB); PG8_STAGE(PG8_SB(0, 1), cB + hstep, voffB); PG8_STAGE(PG8_SA(0, 0), cA, voffA); PG8_STAGE(PG8_SA(0, 1), cA + hstep, voffA);
        if (wr == 1) PG8_BAR;
        PG8_WAIT_V(2); PG8_BAR;
        PG8_STAGE(PG8_SB(1, 0), cB + kstep, voffB); PG8_STAGE(PG8_SA(1, 0), cA + kstep, voffA); PG8_STAGE(PG8_SB(1, 1), cB + hstep + kstep, voffB);
        PG8_WAIT_V(6); PG8_BAR;
    } else {
        PG8_STAGE(PG8_SB(0, 0), cB, voffB); PG8_STAGE(PG8_SA(0, 0), cA, voffA); PG8_STAGE(PG8_SB(0, 1), cB + hstep, voffB); PG8_STAGE(PG8_SA(0, 1), cA + hstep, voffA);
        if (wr == 1) PG8_BAR;
        PG8_WAIT_V(4); PG8_BAR;
        PG8_STAGE(PG8_SB(1, 0), cB + kstep, voffB); PG8_STAGE(PG8_SA(1, 0), cA + kstep, voffA); PG8_STAGE(PG8_SB(1, 1), cB + hstep + kstep, voffB);
        PG8_WAIT_V(6); PG8_BAR;
    }
    for (;;) {
        const bool has_next = S.next(ui + 1, nxt);
        const char* nA = has_next ? (const char*)g.A + (size_t)nxt.pm * tstep : cA; const char* nB = has_next ? (const char*)g.Bt + (size_t)nxt.pn * tstep : cB;
        for (int t = 0; t < nt; t += 2) {
            const bool last = (t == nt - 2);
            const char* a1 = cA + (size_t)(t + 1) * kstep;
            const char* a2 = last ? nA : cA + (size_t)(t + 2) * kstep; const char* b2 = last ? nB : cB + (size_t)(t + 2) * kstep;
            const char* a3 = a2 + kstep; const char* b3 = b2 + kstep;
            if (last && has_next) S.a_ready(nxt);
            if constexpr (SP2) {
            PG8_LDB(B0, 0, 0); PG8_LDB(B1, 0, 1); PG8_SCHED; PG8_LDA(At, 0, 0); PG8_STAGE(PG8_SA(1, 1), a1 + hstep, voffA);
            PG8_WAIT_V(8); PG8_WAIT_L(0); PG8_BAR; PG8_MMA(0, 0, At, B0); PG8_MMA(0, 1, At, B1); PG8_BAR; PG8_SCHED;
            PG8_LDA(At, 0, 1); PG8_STAGE(PG8_SB(0, 0), b2, voffB); PG8_STAGE(PG8_SB(0, 1), b2 + hstep, voffB); PG8_STAGE(PG8_SA(0, 0), a2, voffA);
            PG8_WAIT_V(8); PG8_WAIT_L(0); PG8_BAR; PG8_MMA(1, 0, At, B0); PG8_MMA(1, 1, At, B1); PG8_BAR; PG8_SCHED;
            PG8_LDB(B0, 1, 0); PG8_LDB(B1, 1, 1); PG8_SCHED; PG8_LDA(At, 1, 0); PG8_STAGE(PG8_SA(0, 1), a2 + hstep, voffA);
            PG8_WAIT_V(8); PG8_WAIT_L(0); PG8_BAR; PG8_MMA(0, 0, At, B0); PG8_MMA(0, 1, At, B1); PG8_BAR; PG8_SCHED;
            PG8_LDA(At, 1, 1); PG8_STAGE(PG8_SB(1, 0), b3, voffB); PG8_STAGE(PG8_SB(1, 1), b3 + hstep, voffB); PG8_STAGE(PG8_SA(1, 0), a3, voffA);
            PG8_WAIT_V(8); PG8_WAIT_L(0); PG8_BAR; PG8_MMA(1, 0, At, B0); PG8_MMA(1, 1, At, B1); PG8_BAR; PG8_SCHED;
            } else {
            PG8_LDB(B0, 0, 0); PG8_SCHED; PG8_LDA(At, 0, 0); PG8_STAGE(PG8_SA(1, 1), a1 + hstep, voffA);
            PG8_WAIT_L(8); PG8_BAR; PG8_WAIT_L(0); PG8_MMA(0, 0, At, B0); PG8_BAR; PG8_SCHED;
            PG8_LDB(B1, 0, 1); PG8_STAGE(PG8_SB(0, 0), b2, voffB);
            PG8_BAR; PG8_WAIT_L(0); PG8_MMA(0, 1, At, B1); PG8_BAR;
            PG8_LDA(At, 0, 1); PG8_STAGE(PG8_SA(0, 0), a2, voffA);
            PG8_BAR; PG8_WAIT_L(0); PG8_MMA(1, 0, At, B0); PG8_BAR; PG8_SCHED;
            PG8_STAGE(PG8_SB(0, 1), b2 + hstep, voffB);
            PG8_WAIT_V(6); PG8_BAR; PG8_MMA(1, 1, At, B1); PG8_BAR;
            PG8_LDB(B0, 1, 0); PG8_SCHED; PG8_LDA(At, 1, 0); PG8_STAGE(PG8_SA(0, 1), a2 + hstep, voffA);
            PG8_WAIT_L(8); PG8_BAR; PG8_WAIT_L(0); PG8_MMA(0, 0, At, B0); PG8_BAR; PG8_SCHED;
            PG8_LDB(B1, 1, 1); PG8_STAGE(PG8_SB(1, 0), b3, voffB);
            PG8_BAR; PG8_WAIT_L(0); PG8_MMA(0, 1, At, B1); PG8_BAR;
            PG8_LDA(At, 1, 1); PG8_STAGE(PG8_SA(1, 0), a3, voffA);
            PG8_BAR; PG8_WAIT_L(0); PG8_MMA(1, 0, At, B0); PG8_BAR; PG8_SCHED;
            PG8_STAGE(PG8_SB(1, 1), b3 + hstep, voffB);
            PG8_WAIT_V(6); PG8_BAR; PG8_MMA(1, 1, At, B1); PG8_BAR;
            }
        }
        if constexpr (ALIGN_EPI) { if (wr == 0) PG8_BAR; }
        if constexpr (!Epi::AFTER_DRAIN) { E(acc, cur, wr, wc, fr, fq); S.done(cur); }
        if (!has_next) break;
#pragma unroll
        for (int a = 0; a < 2; ++a)
#pragma unroll
            for (int b = 0; b < 2; ++b)
#pragma unroll
                for (int m = 0; m < 4; ++m)
#pragma unroll
                    for (int n = 0; n < 2; ++n) acc[a][b][m][n] = (f32x4){0.f, 0.f, 0.f, 0.f};
        cur = nxt; cA = nA; cB = nB; ++ui;
        if constexpr (ALIGN_EPI) { if (wr == 1) PG8_BAR; }
    }
    PG8_WAIT_V(0);
    if constexpr (!ALIGN_EPI) { if (wr == 0) PG8_BAR; }
    PG8_BAR;
    if constexpr (Epi::AFTER_DRAIN) { E.fused(acc, cur, wr, wc, fr, fq, lds, wid, lane); S.done(cur); }
#undef PG8_SA
#undef PG8_SB
#undef PG8_STAGE
#undef PG8_LDA
#undef PG8_LDB
#undef PG8_MMA
#undef PG8_WAIT_V
#undef PG8_WAIT_L
#undef PG8_BAR
#undef PG8_SCHED
}
}

#ifndef PG8_SP2
#define PG8_SP2 true
#endif
#ifndef PG8_ALIGN
#define PG8_ALIGN true
#endif

__device__ __forceinline__ float row_rstd16(const float* rowss, int row) {
    const f32x4* r = (const f32x4*)(rowss + (size_t)row * 16);
    const f32x4 a = r[0], b = r[1], c = r[2], d = r[3];
    const float s = ((a[0] + a[1]) + (a[2] + a[3])) + ((b[0] + b[1]) + (b[2] + b[3])) + ((c[0] + c[1]) + (c[2] + c[3])) + ((d[0] + d[1]) + (d[2] + d[3]));
    return rsqrtf(s * (1.f / DM) + EPS);
}
struct EpiProjF {
    static constexpr bool PERM = true, AFTER_DRAIN = false;
    const float* rowss; const float* cb; bf16_t* proj; float* side; const float* g_a; const float* g_b; const float* g_ds; const float* g_dw; LDSF float* xs  ;
    __device__ __forceinline__ void operator()(const pg8::f32x4 (&acc)[2][2][4][2], const pg8::Unit& u, int wr, int wc, int fr, int fq) const {
        const int b = u.pm >> 4, colt = u.pn * 256 + wc * 32 + 8 * fq;
        const int knmode = (u.pn == 1) ? 1 : (u.pn == 4) ? 2 : (u.pn == 10) ? 3 : (u.pn == 11) ? 4 : 0;
        f32x4 cv[2][2];
#pragma unroll
        for (int bj = 0; bj < 2; ++bj)
#pragma unroll
            for (int n = 0; n < 2; ++n) cv[bj][n] = *(const f32x4*)(cb + b * PINP + colt + bj * 128 + 4 * n);
        if (knmode != 0) {
#pragma unroll
            for (int ai = 0; ai < 2; ++ai)
#pragma unroll
                for (int m = 0; m < 4; ++m) {
                    const float rsm = row_rstd16(rowss, u.pm * 256 + ai * 128 + wr * 64 + m * 16 + fr);
#pragma unroll
                    for (int bj = 0; bj < 2; ++bj) {
                        const f32x4 v0 = acc[ai][bj][m][0] * rsm + cv[bj][0], v1 = acc[ai][bj][m][1] * rsm + cv[bj][1];
                        float ss = (v0[0] * v0[0] + v0[1] * v0[1]) + (v0[2] * v0[2] + v0[3] * v0[3]) + (v1[0] * v1[0] + v1[1] * v1[1]) + (v1[2] * v1[2] + v1[3] * v1[3]);
                        ss += __shfl_xor(ss, 16); ss += __shfl_xor(ss, 32);
                        if (fq == 0) xs[((wr * 4 + wc) * 16 + (ai * 4 + m) * 2 + bj) * 16 + fr] = ss;
                    }
                }
            asm volatile("s_waitcnt lgkmcnt(0)" ::: "memory"); __builtin_amdgcn_s_barrier(); asm volatile("" ::: "memory");
        }
#pragma unroll
        for (int ai = 0; ai < 2; ++ai)
#pragma unroll
            for (int m = 0; m < 4; ++m) {
                const int row = u.pm * 256 + ai * 128 + wr * 64 + m * 16 + fr; const float rs = row_rstd16(rowss, row);
#pragma unroll
                for (int bj = 0; bj < 2; ++bj) {
                    f32x4 v0 = acc[ai][bj][m][0] * rs + cv[bj][0], v1 = acc[ai][bj][m][1] * rs + cv[bj][1]; const int col0 = colt + bj * 128;
                    if (col0 >= C_BF && col0 < PIN) { *(f32x4*)(side + (size_t)row * 16 + (col0 - C_BF)) = v0; *(f32x4*)(side + (size_t)row * 16 + (col0 - C_BF) + 4) = v1; }
                    const bool on = (knmode == 1) || (knmode == 2) || (knmode == 3 && bj == 1 && wc < 2) || (knmode == 4 && bj == 0 && wc < 2);
                    if (on) {
                        const int xi = (ai * 4 + m) * 2 + bj;
                        float tot = xs[((wr * 4 + wc) * 16 + xi) * 16 + fr]; float dn = 1.f / 32.f;
                        if (knmode != 1) { tot += xs[((wr * 4 + (wc ^ 1)) * 16 + xi) * 16 + fr]; dn = 1.f / 64.f; }
                        const float nrm = rsqrtf(tot * dn + EPS);
                        const float* gp = (knmode == 1) ? g_a + 8 * fq : ((knmode == 2) ? g_b : (knmode == 3 ? g_ds : g_dw)) + (wc & 1) * 32 + 8 * fq;
                        v0 = v0 * nrm * *(const f32x4*)gp; v1 = v1 * nrm * *(const f32x4*)(gp + 4);
                    }
                    u32x4 w; w[0] = pg8::cvt_pk_bf16(v0[0], v0[1]); w[1] = pg8::cvt_pk_bf16(v0[2], v0[3]); w[2] = pg8::cvt_pk_bf16(v1[0], v1[1]); w[3] = pg8::cvt_pk_bf16(v1[2], v1[3]);
                    *(u32x4*)(proj + (size_t)row * PINP + col0) = w;
                }
            }
    }
};
struct EpiResF {
    static constexpr bool PERM = false, AFTER_DRAIN = false;
    const float* xin; float* xout; const float* gate; const float* g; const float* sc; bf16_t* xa; float* rowss;
    __device__ __forceinline__ void operator()(const pg8::f32x4 (&acc)[2][2][4][2], const pg8::Unit& u, int wr, int wc, int fr, int fq) const {
        const int b = u.pm >> 4, col0 = u.pn * 256 + wc * 32 + 4 * fq;
        f32x4 gt[2][2], gm[2][2];
#pragma unroll
        for (int bj = 0; bj < 2; ++bj)
#pragma unroll
            for (int n = 0; n < 2; ++n) { const int c = col0 + bj * 128 + n * 16; gt[bj][n] = *(const f32x4*)(gate + b * 6144 + c);
                if (xa) gm[bj][n] = *(const f32x4*)(g + c) * (*(const f32x4*)(sc + b * 6144 + c) + 1.0f); else gm[bj][n] = (f32x4){0.f, 0.f, 0.f, 0.f}; }
#pragma unroll
        for (int ai = 0; ai < 2; ++ai)
#pragma unroll
            for (int m = 0; m < 4; ++m) {
                const int row = u.pm * 256 + ai * 128 + wr * 64 + m * 16 + fr; float ss = 0.f;
#pragma unroll
                for (int bj = 0; bj < 2; ++bj)
#pragma unroll
                    for (int n = 0; n < 2; ++n) { const size_t off = (size_t)row * DM + col0 + bj * 128 + n * 16;
                        const f32x4 o = *(const f32x4*)(xin + off) + gt[bj][n] * acc[ai][bj][m][n];
                        *(f32x4*)(xout + off) = o; ss += (o[0] * o[0] + o[1] * o[1]) + (o[2] * o[2] + o[3] * o[3]);
                        if (xa) { const f32x4 q = o * gm[bj][n]; uint2 w; w.x = pg8::cvt_pk_bf16(q[0], q[1]); w.y = pg8::cvt_pk_bf16(q[2], q[3]); *(uint2*)(xa + off) = w; } }
                if (rowss) { ss += __shfl_xor(ss, 16); ss += __shfl_xor(ss, 32); if (fq == 0) rowss[(size_t)row * 16 + u.pn * 4 + wc] = ss; }
            }
    }
};


#define DPPF(oldv, src, CTRL) __builtin_bit_cast(float, __builtin_amdgcn_update_dpp(__builtin_bit_cast(int, (float)(oldv)), __builtin_bit_cast(int, (float)(src)), (CTRL), 0xf, 0xf, false))
struct EpiUpAct {
    static constexpr bool PERM = true, AFTER_DRAIN = false;
    const float* rowss; const float* cb; bf16_t* act; float* eg; float* ev; const float* cw; const float* cbias; LDSF float* xch; LDSF float* cst  ;
    __device__ __forceinline__ void operator()(const pg8::f32x4 (&acc)[2][2][4][2], const pg8::Unit& u, int wr, int wc, int fr, int fq) const {
        const int b = u.pm >> 4, cih = wc * 32 + 8 * fq, jcol = u.pn * 128 + cih;
        const float* cbg = cb + b * NUP + u.pn * 256 + cih; const float* cbv = cbg + 128;
        {
            const int tid = (wr * 4 + wc) * 64 + fq * 16 + fr, col = tid & 127, arr = tid >> 7;
            const float* src = (arr == 0) ? cb + b * NUP + u.pn * 256 + col : (arr == 1) ? cb + b * NUP + u.pn * 256 + 128 + col : cw + (arr - 2) * DFF + u.pn * 128 + col;
            cst[arr * 128 + col] = *src;
            if (tid < 256) { const int a2 = 4 + (tid >> 7); cst[a2 * 128 + col] = (a2 == 4) ? cw[2 * DFF + u.pn * 128 + col] : cbias[u.pn * 128 + col]; }
            else cst[768 + (tid - 256)] = row_rstd16(rowss, u.pm * 256 + (tid - 256));
            const f32x4 cg0 = *(const f32x4*)cbg, cg1 = *(const f32x4*)(cbg + 4);
#pragma unroll
            for (int ai = 0; ai < 2; ++ai) {
                const float r3 = row_rstd16(rowss, u.pm * 256 + ai * 128 + wr * 64 + 48 + fr);
                const f32x4 g0 = acc[ai][0][3][0] * r3 + cg0, g1 = acc[ai][0][3][1] * r3 + cg1;
                if (fr >= 14) { LDSF float* x = xch + ((((wr * 2 + ai) * 4 + wc) * 2 + (fr - 14)) * 32 + 8 * fq); *(LDSF f32x4*)x = g0; *(LDSF f32x4*)(x + 4) = g1;
                    if (wr == 1 && ai == 1) { float* e = eg + ((size_t)(u.pm * 4 + 2 + (fr - 14))) * DFF + jcol; *(f32x4*)e = g0; *(f32x4*)(e + 4) = g1; } }
            }
            if (wr == 0 && fr < 2) {
                const f32x4 cv0 = *(const f32x4*)cbv, cv1 = *(const f32x4*)(cbv + 4); const float r0 = row_rstd16(rowss, u.pm * 256 + fr);
                float* e = eg + ((size_t)(u.pm * 4 + fr)) * DFF + jcol; float* v = ev + ((size_t)(u.pm * 2 + fr)) * DFF + jcol;
                *(f32x4*)e = acc[0][0][0][0] * r0 + cg0; *(f32x4*)(e + 4) = acc[0][0][0][1] * r0 + cg1;
                *(f32x4*)v = acc[0][1][0][0] * r0 + cv0; *(f32x4*)(v + 4) = acc[0][1][0][1] * r0 + cv1;
            }
        }
        asm volatile("s_waitcnt vmcnt(0) lgkmcnt(0)" ::: "memory"); __builtin_amdgcn_s_barrier(); asm volatile("" ::: "memory");
#pragma unroll
        for (int ai = 0; ai < 2; ++ai) {
            f32x4 pvv[2];
            if (ai == 0 && wr == 0) { pvv[0] = (f32x4){0.f, 0.f, 0.f, 0.f}; pvv[1] = pvv[0]; }
            else { const int swr = (wr == 1) ? 0 : 1, sai = (wr == 1) ? ai : ai - 1;
                const LDSF float* x = xch + ((((swr * 2 + sai) * 4 + wc) * 2 + (fr & 1)) * 32 + 8 * fq); pvv[0] = *(const LDSF f32x4*)x; pvv[1] = *(const LDSF f32x4*)(x + 4); }
#pragma unroll
            for (int m = 0; m < 4; ++m) {
                asm volatile("" ::: "memory");
                const int row = u.pm * 256 + ai * 128 + wr * 64 + m * 16 + fr; const float rsm = cst[768 + ai * 128 + wr * 64 + m * 16 + fr];
                u32x4 w;
#pragma unroll
                for (int n = 0; n < 2; ++n) {
                    const LDSF float* cc = cst + cih + 4 * n;
                    const f32x4 cgn = *(const LDSF f32x4*)cc, cvn = *(const LDSF f32x4*)(cc + 128);
                    const f32x4 k0 = *(const LDSF f32x4*)(cc + 256), k1 = *(const LDSF f32x4*)(cc + 384), k2 = *(const LDSF f32x4*)(cc + 512), kb = *(const LDSF f32x4*)(cc + 640);
                    const f32x4 c = acc[ai][0][m][n] * rsm + cgn, v = acc[ai][1][m][n] * rsm + cvn; float o[4];
#pragma unroll
                    for (int i = 0; i < 4; ++i) {
                        const float gm1 = DPPF(DPPF(0.f, pvv[n][i], 0x121), c[i], 0x111);
                        const float gm2 = DPPF(DPPF(0.f, pvv[n][i], 0x122), c[i], 0x112);
                        const float cvv = k0[i] * gm2 + k1[i] * gm1 + k2[i] * c[i] + kb[i];
                        o[i] = cvv * __builtin_amdgcn_rcpf(1.f + __builtin_amdgcn_exp2f(-cvv * LOG2E)) * v[i];
                    }
                    w[2 * n] = pg8::cvt_pk_bf16(o[0], o[1]); w[2 * n + 1] = pg8::cvt_pk_bf16(o[2], o[3]);
                    pvv[n] = c;
                }
                *(u32x4*)(act + (size_t)row * DFF + jcol) = w;
            }
        }
    }
};
__device__ void act_fixup(const Params& p, int l, int pm) {
    if ((pm & 15) == 0) return;
    const float* eg = (const float*)(p.ws + WS_EG); const float* ev = (const float*)(p.ws + WS_EV); bf16_t* act = (bf16_t*)(p.ws + WS_ACT);
    const float* cw = p.conv_w + (size_t)l * 3 * DFF; const float* cbias = p.conv_b + (size_t)l * DFF;
    for (int idx = TID(); idx < 2 * DFF; idx += NTHR) {
        const int r = idx / DFF, j = idx - r * DFF;
        const float a = eg[((size_t)((pm - 1) * 4 + 2)) * DFF + j], bq = eg[((size_t)((pm - 1) * 4 + 3)) * DFF + j], c0 = eg[((size_t)(pm * 4 + 0)) * DFF + j], c1 = eg[((size_t)(pm * 4 + 1)) * DFF + j];
        const float gm2 = r ? bq : a, gm1 = r ? c0 : bq, gc = r ? c1 : c0;
        const float cvv = cw[j] * gm2 + cw[DFF + j] * gm1 + cw[2 * DFF + j] * gc + cbias[j];
        act[(size_t)(pm * 256 + r) * DFF + j] = f2bf(siluf(cvv) * ev[((size_t)(pm * 2 + r)) * DFF + j]);
    }
}

__device__ void ph_prep_knorm(const Params& p, int l) {
    bf16_t* proj = (bf16_t*)(p.ws + WS_PROJ);
    const int tid_ = TID(); const int lane = tid_ & 63, wv = tid_ >> 6;
    const int gw = blockIdx.x * (blockDim.x >> 6) + wv, ngw = gridDim.x * (blockDim.x >> 6);
    for (int row = gw; row < MTOK; row += ngw) {
        bf16_t* pr = proj + (size_t)row * PINP;
        {
            uint2 raw = *(const uint2*)(pr + CA_K + 4 * lane);
            float v0 = bf2f(raw.x & 0xffff), v1 = bf2f(raw.x >> 16), v2 = bf2f(raw.y & 0xffff), v3 = bf2f(raw.y >> 16);
            float ss = v0 * v0 + v1 * v1 + v2 * v2 + v3 * v3;
            ss += __shfl_xor(ss, 1); ss += __shfl_xor(ss, 2); ss += __shfl_xor(ss, 4);
            const float r = rsqrtf(ss * (1.f / 32.f) + EPS); const float* g = p.diff_kn + l * 32 + ((4 * lane) & 31);
            raw.x = pk2(v0 * r * g[0], v1 * r * g[1]); raw.y = pk2(v2 * r * g[2], v3 * r * g[3]);
            *(uint2*)(pr + CA_K + 4 * lane) = raw;
        }
        {
            uint2 raw = *(const uint2*)(pr + CB_K + 4 * lane);
            float v0 = bf2f(raw.x & 0xffff), v1 = bf2f(raw.x >> 16), v2 = bf2f(raw.y & 0xffff), v3 = bf2f(raw.y >> 16);
            float ss = v0 * v0 + v1 * v1 + v2 * v2 + v3 * v3;
            ss += __shfl_xor(ss, 1); ss += __shfl_xor(ss, 2); ss += __shfl_xor(ss, 4); ss += __shfl_xor(ss, 8);
            const float r = rsqrtf(ss * (1.f / 64.f) + EPS); const float* g = p.fox_kn + l * 64 + ((4 * lane) & 63);
            raw.x = pk2(v0 * r * g[0], v1 * r * g[1]); raw.y = pk2(v2 * r * g[2], v3 * r * g[3]);
            *(uint2*)(pr + CB_K + 4 * lane) = raw;
        }
        {
            const int hi = lane >> 5, li = lane & 31; bf16_t* q = pr + (hi ? CD_KW : CD_KS) + 2 * li;
            unsigned raw = *(const unsigned*)q; float v0 = bf2f(raw & 0xffff), v1 = bf2f(raw >> 16);
            float ss = v0 * v0 + v1 * v1;
            ss += __shfl_xor(ss, 1); ss += __shfl_xor(ss, 2); ss += __shfl_xor(ss, 4); ss += __shfl_xor(ss, 8); ss += __shfl_xor(ss, 16);
            const float r = rsqrtf(ss * (1.f / 64.f) + EPS); const float* g = p.nsa_kn + (l * 3 + (hi ? 2 : 1)) * 64 + 2 * li;
            *(unsigned*)q = pk2(v0 * r * g[0], v1 * r * g[1]);
        }
    }
}
__device__ void ph_prep_cum_bh(const Params& p, int l, int bh, unsigned char* lds) {
    const float* side = (const float*)(p.ws + WS_SIDE);
    float* cum = (float*)(p.ws + WS_CUM);
    LDSF float* wt = (LDSF float*)(lds + 70000);
    const int tid = TID(), lane = tid & 63, wv = tid >> 6;
    {
        const int b = bh >> 2, h = bh & 3; const float bf = p.fox_bf[l * 4 + h];
        float v[8]; float tot = 0.f;
#pragma unroll
        for (int i = 0; i < 8; ++i) { v[i] = logsigf(side[(size_t)(b * SEQ + tid * 8 + i) * 16 + h] + bf); tot += v[i]; v[i] = tot; }
        float inc = tot;
#pragma unroll
        for (int o = 1; o < 64; o <<= 1) { const float u = __shfl_up(inc, o); if (lane >= o) inc += u; }
        __syncthreads();
        if (lane == 63) wt[wv] = inc;
        __syncthreads();
        float base = inc - tot;
        for (int w8 = 0; w8 < wv; ++w8) base += wt[w8];
#pragma unroll
        for (int i = 0; i < 8; ++i) cum[bh * SEQ + tid * 8 + i] = base + v[i];
    }
}
__device__ void ph_prep_cmp(const Params& p, int l, unsigned char* lds) {
    const bf16_t* proj = (const bf16_t*)(p.ws + WS_PROJ);
    float* win = (float*)lds; float* red = (float*)(lds + 36864);
    const int tid = TID(), e = tid & 63, part = tid >> 6;
    for (int item = blockIdx.x; item < 4 * 2 * 32; item += gridDim.x) {
        const int b = item >> 6, which = (item >> 5) & 1, n0 = (item & 31) * 8;
        const int colbase = which ? CD_VC : CD_KC;
        __syncthreads();
        for (int i = tid; i < 144 * 64; i += NTHR) { const int tk = 16 * n0 + (i >> 6); win[i] = tk < SEQ ? bf2f(proj[(size_t)(b * SEQ + tk) * PINP + colbase + (i & 63)]) : 0.f; }
        __syncthreads();
        float acc[8];
#pragma unroll
        for (int nn = 0; nn < 8; ++nn) acc[nn] = 0.f;
        const float* phi = p.nsa_phi + (size_t)(l * 2 + which) * 2048 * 64; const float* pe = p.nsa_pe + (size_t)(l * 2 + which) * 32 * 64;
        for (int i = 4 * part; i < 4 * part + 4; ++i)
            for (int d = 0; d < 64; ++d) {
                const float ph = phi[(size_t)(i * 64 + d) * 64 + e], pv = pe[i * 64 + d];
#pragma unroll
                for (int nn = 0; nn < 8; ++nn) acc[nn] += (win[(16 * nn + i) * 64 + d] + pv) * ph;
            }
#pragma unroll
        for (int nn = 0; nn < 8; ++nn) red[(part * 8 + nn) * 64 + e] = acc[nn];
        __syncthreads();
        {
            const int nn = part, n = n0 + nn; float v = 0.f;
#pragma unroll
            for (int pp = 0; pp < 8; ++pp) v += red[(pp * 8 + nn) * 64 + e];
            bf16_t* dst = (bf16_t*)(p.ws + (which ? WS_VC : WS_KC)) + (size_t)(b * 256 + n) * 64 + e;
            if (n >= 255) *dst = 0;
            else if (which == 0) { const float ss = wave_sum(v * v); *dst = f2bf(v * rsqrtf(ss * (1.f / 64.f) + EPS) * p.nsa_kn[(l * 3 + 0) * 64 + e]); }
            else *dst = f2bf(v);
        }
    }
}

__device__ __forceinline__ void load8(const bf16_t* p, float* d) {
    const u32x4 r = *(const u32x4*)p;
    d[0] = bf2f(r[0] & 0xffff); d[1] = bf2f(r[0] >> 16); d[2] = bf2f(r[1] & 0xffff); d[3] = bf2f(r[1] >> 16);
    d[4] = bf2f(r[2] & 0xffff); d[5] = bf2f(r[2] >> 16); d[6] = bf2f(r[3] & 0xffff); d[7] = bf2f(r[3] >> 16);
}
template <int N> __device__ __forceinline__ float dotn(const float* q, const bf16_t* k) {
    float s = 0.f;
#pragma unroll
    for (int c = 0; c < N / 8; ++c) { float t[8]; load8(k + 8 * c, t);
#pragma unroll
        for (int j = 0; j < 8; ++j) s += q[8 * c + j] * t[j]; }
    return s;
}
template <int N> __device__ __forceinline__ void axpyn(float* o, float w, const bf16_t* v) {
#pragma unroll
    for (int c = 0; c < N / 8; ++c) { float t[8]; load8(v + 8 * c, t);
#pragma unroll
        for (int j = 0; j < 8; ++j) o[8 * c + j] += w * t[j]; }
}
template <int N> __device__ __forceinline__ void loadq_norm(float* q, const bf16_t* src, const float* g, float scale, bool norm) {
    float ss = 0.f;
#pragma unroll
    for (int c = 0; c < N / 8; ++c) load8(src + 8 * c, q + 8 * c);
#pragma unroll
    for (int j = 0; j < N; ++j) ss += q[j] * q[j];
    const float r = norm ? rsqrtf(ss * (1.f / N) + EPS) : 1.f;
#pragma unroll
    for (int j = 0; j < N; ++j) q[j] = q[j] * r * (norm ? g[j] : 1.f) * scale;
}
__device__ __forceinline__ void store64(bf16_t* dst, const float* o) {
#pragma unroll
    for (int c = 0; c < 8; ++c) { u32x4 w; w[0] = pk2(o[8 * c], o[8 * c + 1]); w[1] = pk2(o[8 * c + 2], o[8 * c + 3]); w[2] = pk2(o[8 * c + 4], o[8 * c + 5]); w[3] = pk2(o[8 * c + 6], o[8 * c + 7]); *(u32x4*)(dst + 8 * c) = w; }
}

typedef float f32x16 __attribute__((ext_vector_type(16)));
typedef short s16x4 __attribute__((ext_vector_type(4)));
#define LDSP __attribute__((address_space(3)))
constexpr int KSTR = 144;
constexpr int AL_KV = 17408;
constexpr int AL_BK = 2 * AL_KV  , AL_TB = AL_BK + 512  , AL_WSF = AL_TB + 512  , AL_MISC = AL_WSF + 2048  ,
              AL_IMP = 38912  , AL_SELM = AL_IMP + 65536  ,
              AL_TB4 = AL_SELM + 512  , AL_INVL = AL_TB4 + 2048  , AL_D_END = AL_INVL + 1024;
static_assert(AL_MISC + 64 <= AL_IMP && AL_D_END <= 131072, "attention LDS map");
__device__ __forceinline__ int crow(int r, int hi) { return (r & 3) + 8 * (r >> 2) + 4 * hi; }
__device__ __forceinline__ float ex2(float v) { return __builtin_amdgcn_exp2f(v); }
__device__ __forceinline__ s16x4 vtr(const LDSP unsigned char* p) { typedef short v4i16_t __attribute__((ext_vector_type(4))); return __builtin_bit_cast(s16x4, __builtin_amdgcn_ds_read_tr16_b64_v4i16((LDSP v4i16_t*)p)); }
__device__ __forceinline__ bf16x8 pack8(const f32x16& p, int b) {
    u32x4 w; w[0] = pg8::cvt_pk_bf16(p[b], p[b + 1]); w[1] = pg8::cvt_pk_bf16(p[b + 2], p[b + 3]); w[2] = pg8::cvt_pk_bf16(p[b + 4], p[b + 5]); w[3] = pg8::cvt_pk_bf16(p[b + 6], p[b + 7]);
    return __builtin_bit_cast(bf16x8, w);
}
__device__ __forceinline__ f32x16 splat16(float v) { return (f32x16){v, v, v, v, v, v, v, v, v, v, v, v, v, v, v, v}; }
template <int NK16>
__device__ __forceinline__ void qkt(f32x16& p0, f32x16& p1, const LDSP unsigned char* Kt, const bf16x8* qf, int dbase, int r32, int hi) {
    const LDSP unsigned char* kb = Kt + r32 * KSTR + hi * 16 + dbase * 32;
#pragma unroll
    for (int d0 = 0; d0 < NK16; ++d0) {
        const bf16x8 a0 = *(const LDSP bf16x8*)(kb + d0 * 32), a1 = *(const LDSP bf16x8*)(kb + 32 * KSTR + d0 * 32);
        p0 = __builtin_amdgcn_mfma_f32_32x32x16_bf16(a0, qf[d0], p0, 0, 0, 0);
        p1 = __builtin_amdgcn_mfma_f32_32x32x16_bf16(a1, qf[d0], p1, 0, 0, 0);
    }
}
__device__ __forceinline__ void pv(f32x16* o, const LDSP unsigned char* Vt, int vb, const f32x16& p0, const f32x16& p1) {
    bf16x8 pa[4]; pa[0] = pack8(p0, 0); pa[1] = pack8(p0, 8); pa[2] = pack8(p1, 0); pa[3] = pack8(p1, 8);
#pragma unroll
    for (int d0 = 0; d0 < 2; ++d0)
#pragma unroll
        for (int ks = 0; ks < 4; ++ks) {
            const s16x4 lo = vtr(Vt + vb + d0 * 4096 + ks * 1024), hh = vtr(Vt + vb + d0 * 4096 + ks * 1024 + 512);
            const bf16x8 vf = (bf16x8){lo[0], lo[1], lo[2], lo[3], hh[0], hh[1], hh[2], hh[3]};
            o[d0] = __builtin_amdgcn_mfma_f32_32x32x16_bf16(pa[ks], vf, o[d0], 0, 0, 0);
        }
}
__device__ __forceinline__ float exp_sum(f32x16& p0, f32x16& p1) {
    float s0 = 0.f, s1 = 0.f;
#pragma unroll
    for (int r = 0; r < 16; ++r) { p0[r] = ex2(p0[r]); p1[r] = ex2(p1[r]); s0 += p0[r]; s1 += p1[r]; }
    return s0 + s1;
}
__device__ __forceinline__ void scale_rows(f32x16* o, float f, LDSP float* wsf, int r32, int hi) {
    __builtin_amdgcn_wave_barrier();
    if (hi == 0) wsf[r32] = f;
    __builtin_amdgcn_s_waitcnt(0xc07f);
    __builtin_amdgcn_wave_barrier();
#pragma unroll
    for (int g = 0; g < 4; ++g) { const f32x4 a = *(const LDSP f32x4*)(wsf + 8 * g + 4 * hi);
#pragma unroll
        for (int i = 0; i < 4; ++i) { o[0][4 * g + i] *= a[i]; o[1][4 * g + i] *= a[i]; } }
    __builtin_amdgcn_wave_barrier();
}
__device__ __forceinline__ void store_o(const f32x16* o, LDSP bf16_t* stg, bf16_t* dst, int lane, int r32, int hi) {
    __builtin_amdgcn_wave_barrier();
#pragma unroll
    for (int r = 0; r < 16; ++r) { const int orow = crow(r, hi); stg[orow * 64 + r32] = f2bf(o[0][r]); stg[orow * 64 + 32 + r32] = f2bf(o[1][r]); }
    __builtin_amdgcn_s_waitcnt(0xc07f);
    __builtin_amdgcn_wave_barrier();
#pragma unroll
    for (int i = 0; i < 4; ++i) { const int row = i * 8 + (lane >> 3), ch = lane & 7; const u32x4 v = *(const LDSP u32x4*)(stg + row * 64 + ch * 8); *(u32x4*)(dst + (size_t)row * DM + ch * 8) = v; }
    __builtin_amdgcn_s_waitcnt(0xc07f);
    __builtin_amdgcn_wave_barrier();
}
template <int NG>
__device__ __forceinline__ void load_q(bf16x8* qf, const bf16_t* qrow  , const float* g, float sc, bool norm, int hi) {
    float v[4][8];
#pragma unroll
    for (int d0 = 0; d0 < 4; ++d0) load8(qrow + 16 * d0 + 8 * hi, v[d0]);
    float r0 = 1.f, r1 = 1.f;
    if (norm) {
        float s0 = 0.f, s1 = 0.f;
#pragma unroll
        for (int j = 0; j < 8; ++j) { s0 += v[0][j] * v[0][j] + v[1][j] * v[1][j]; s1 += v[2][j] * v[2][j] + v[3][j] * v[3][j]; }
        s0 += __shfl_xor(s0, 32); s1 += __shfl_xor(s1, 32);
        if (NG == 64) { r0 = rsqrtf((s0 + s1) * (1.f / 64.f) + EPS); r1 = r0; } else { r0 = rsqrtf(s0 * (1.f / 32.f) + EPS); r1 = rsqrtf(s1 * (1.f / 32.f) + EPS); }
    }
#pragma unroll
    for (int d0 = 0; d0 < 4; ++d0) {
        const float rr = (d0 < 2 ? r0 : r1) * sc; float w[8];
#pragma unroll
        for (int j = 0; j < 8; ++j) { const int d = 16 * d0 + 8 * hi + j; w[j] = v[d0][j] * rr * (norm ? g[d % NG] : 1.f); }
        u32x4 u; u[0] = pg8::cvt_pk_bf16(w[0], w[1]); u[1] = pg8::cvt_pk_bf16(w[2], w[3]); u[2] = pg8::cvt_pk_bf16(w[4], w[5]); u[3] = pg8::cvt_pk_bf16(w[6], w[7]);
        qf[d0] = __builtin_bit_cast(bf16x8, u);
    }
}
__device__ __forceinline__ void kv_load(u32x4& kr, u32x4& vr, const bf16_t* Kb, const bf16_t* Vb, int k0, int tid) {
    const size_t off = (size_t)(k0 + (tid >> 3)) * PINP + (tid & 7) * 8;
    kr = *(const u32x4*)(Kb + off); vr = *(const u32x4*)(Vb + off);
}
__device__ __forceinline__ void kv_load64(u32x4& kr, u32x4& vr, const bf16_t* Kb, const bf16_t* Vb, int n0, int tid) {
    const size_t off = (size_t)(n0 + (tid >> 3)) * 64 + (tid & 7) * 8;
    kr = *(const u32x4*)(Kb + off); vr = *(const u32x4*)(Vb + off);
}
__device__ __forceinline__ void kv_store(const u32x4& kr, const u32x4& vr, LDSP unsigned char* buf, int tid) {
    const int key = tid >> 3, ch = tid & 7;
    *(LDSP u32x4*)(buf + key * KSTR + ch * 16) = kr;
    *(LDSP u32x4*)(buf + 9216 + (ch >> 2) * 4096 + (key >> 4) * 1024 + ((key >> 3) & 1) * 512 + (key & 7) * 64 + (ch & 3) * 16) = vr;
}
template <int NG>
__device__ __forceinline__ void knorm_chunk(u32x4& kr, const float* gp  ) {
    float v[8];
    v[0] = bf2f(kr[0] & 0xffff); v[1] = bf2f(kr[0] >> 16); v[2] = bf2f(kr[1] & 0xffff); v[3] = bf2f(kr[1] >> 16);
    v[4] = bf2f(kr[2] & 0xffff); v[5] = bf2f(kr[2] >> 16); v[6] = bf2f(kr[3] & 0xffff); v[7] = bf2f(kr[3] >> 16);
    float ss = 0.f;
#pragma unroll
    for (int j = 0; j < 8; ++j) ss += v[j] * v[j];
    ss += __shfl_xor(ss, 1); ss += __shfl_xor(ss, 2); if (NG == 64) ss += __shfl_xor(ss, 4);
    const float r = rsqrtf(ss * (1.f / NG) + EPS);
    const f32x4 ga = *(const f32x4*)gp, gb = *(const f32x4*)(gp + 4);
    kr[0] = pg8::cvt_pk_bf16(v[0] * r * ga[0], v[1] * r * ga[1]); kr[1] = pg8::cvt_pk_bf16(v[2] * r * ga[2], v[3] * r * ga[3]);
    kr[2] = pg8::cvt_pk_bf16(v[4] * r * gb[0], v[5] * r * gb[1]); kr[3] = pg8::cvt_pk_bf16(v[6] * r * gb[2], v[7] * r * gb[3]);
}
__device__ __forceinline__ void bias_near(f32x16& p0, f32x16& p1, const LDSP float* tbl, int tk0  , int wnd, bool rowok, int hi) {
#pragma unroll
    for (int g = 0; g < 4; ++g) {
#pragma unroll
        for (int i = 0; i < 4; ++i) { const int r = 4 * g + i; const int d0_ = tk0 - crow(r, hi), d1_ = d0_ - 32;
            const float b0 = tbl[min(max(d0_, 0), 127)], b1 = tbl[min(max(d1_, 0), 127)];
            p0[r] = (d0_ < 0 || d0_ >= wnd || !rowok) ? -INFINITY : p0[r] + b0; p1[r] = (d1_ < 0 || d1_ >= wnd || !rowok) ? -INFINITY : p1[r] + b1; }
        asm volatile("" ::: "memory");
    }
}
#define KVBUF(L, i) ((L) + ((i) & 1) * AL_KV)

__device__ void fa_fox_unit(const Params& p, int l, int b, int h, int qb, LDSP unsigned char* L) {
    const int tid = TID(), lane = tid & 63, wid = __builtin_amdgcn_readfirstlane(tid >> 6), r32 = lane & 31, hi = lane >> 5;
    const bf16_t* proj = (const bf16_t*)(p.ws + WS_PROJ); bf16_t* mix = (bf16_t*)(p.ws + WS_MIX);
    const size_t rb = (size_t)b * SEQ; const int q0 = qb * 256, qw = q0 + 32 * wid, t = qw + r32;
    const bf16_t* Kb = proj + rb * PINP + CB_K + 64 * h; const bf16_t* Vb = proj + rb * PINP + CB_V + 64 * h;
    const float* cm = (const float*)(p.ws + WS_CUM) + (b * 4 + h) * SEQ;
    LDSP float* wsf = (LDSP float*)(L + AL_WSF) + wid * 64; LDSP float* bk = (LDSP float*)(L + AL_BK);
    const int vb = 9216 + ((lane >> 4) & 1) * 32 + (lane & 3) * 8 + (4 * hi + ((lane & 15) >> 2)) * 64;
    bf16x8 qf[4]; load_q<64>(qf, proj + (rb + t) * PINP + CB_Q + 64 * h, p.fox_qn + l * 64, 0.125f * LOG2E, true, hi);
    const float rowc = cm[t] * LOG2E - ((const float*)(p.ws + WS_BND))[l * 32 + 4];
    f32x16 o[2]; o[0] = (f32x16){}; o[1] = (f32x16){};
    float l_run = 0.f;
    const int NT = 4 * qb + 4, jd = 4 * qb + (wid >> 1);
    u32x4 kr, vr; float cr = 0.f; const float* gk = p.fox_kn + l * 64 + (tid & 7) * 8;
    __syncthreads();
    kv_load(kr, vr, Kb, Vb, 0, tid); if (tid < 64) cr = cm[tid];
    kv_store(kr, vr, KVBUF(L, 0), tid); if (tid < 64) bk[tid] = -cr * LOG2E;
    kv_load(kr, vr, Kb, Vb, 64, tid); if (tid < 64) cr = cm[64 + tid];
    for (int j = 0; j < NT; ++j) {
        __syncthreads();
        if (j + 1 < NT) { kv_store(kr, vr, KVBUF(L, j + 1), tid); if (tid < 64) bk[((j + 1) & 1) * 64 + tid] = -cr * LOG2E; }
        if (j + 2 < NT) { kv_load(kr, vr, Kb, Vb, 64 * (j + 2), tid); if (tid < 64) cr = cm[64 * (j + 2) + tid]; }
        if (j <= jd) {
            const LDSP unsigned char* buf = KVBUF(L, j); const LDSP float* bkj = bk + (j & 1) * 64;
            f32x16 p0, p1;
#pragma unroll
            for (int g = 0; g < 4; ++g) { const f32x4 b0 = *(const LDSP f32x4*)(bkj + 8 * g + 4 * hi), b1 = *(const LDSP f32x4*)(bkj + 32 + 8 * g + 4 * hi);
#pragma unroll
                for (int i = 0; i < 4; ++i) { p0[4 * g + i] = b0[i] + rowc; p1[4 * g + i] = b1[i] + rowc; } }
            qkt<4>(p0, p1, buf, qf, 0, r32, hi);
            if (j == jd) { const int k0 = 64 * j;
#pragma unroll
                for (int r = 0; r < 16; ++r) { const int kk = k0 + crow(r, hi); if (kk > t) p0[r] = -INFINITY; if (kk + 32 > t) p1[r] = -INFINITY; } }
            l_run += exp_sum(p0, p1);
            pv(o, buf, vb, p0, p1);
        }
    }
    l_run += __shfl_xor(l_run, 32);
    scale_rows(o, 1.f / l_run, wsf, r32, hi);
    store_o(o, (LDSP bf16_t*)(L + AL_IMP + wid * 8192), mix + (rb + qw) * DM + 256 + 64 * h, lane, r32, hi);
}

__device__ void fa_diff_unit(const Params& p, int l, int b, int h, int qb, LDSP unsigned char* L) {
    const int tid = TID(), lane = tid & 63, wid = __builtin_amdgcn_readfirstlane(tid >> 6), r32 = lane & 31, hi = lane >> 5;
    const bf16_t* proj = (const bf16_t*)(p.ws + WS_PROJ); bf16_t* mix = (bf16_t*)(p.ws + WS_MIX);
    const size_t rb = (size_t)b * SEQ; const int q0 = qb * 256, qw = q0 + 32 * wid, t = qw + r32;
    const bf16_t* Kb = proj + rb * PINP + CA_K + 64 * h; const bf16_t* Vb = proj + rb * PINP + CA_V + 64 * h;
    LDSP float* wsf = (LDSP float*)(L + AL_WSF) + wid * 64; LDSP float* tbl = (LDSP float*)(L + AL_TB);
    const int vb = 9216 + ((lane >> 4) & 1) * 32 + (lane & 3) * 8 + (4 * hi + ((lane & 15) >> 2)) * 64;
    const float lam = ((const float*)(p.ws + WS_LAM))[l]; const float lam_init = 0.8f - 0.6f * __expf(-0.3f * (float)l);
    const float nbound = -((const float*)(p.ws + WS_BND))[l * 32 + h];
    __syncthreads();
    if (tid < 128) tbl[tid] = ((const float*)(p.ws + WS_TB))[h * 128 + tid] * LOG2E;
    bf16x8 qf[4]; load_q<32>(qf, proj + (rb + t) * PINP + CA_Q + 64 * h, p.diff_qn + l * 32, 0.17677669529663687f * LOG2E, true, hi);
    f32x16 o1[2], o2[2]; o1[0] = (f32x16){}; o1[1] = (f32x16){}; o2[0] = (f32x16){}; o2[1] = (f32x16){};
    float l1 = 0.f, l2 = 0.f;
    const int NT = 4 * qb + 4, jd = 4 * qb + (wid >> 1);
    u32x4 kr, vr; const float* gk = p.diff_kn + l * 32 + (tid & 3) * 8;
    kv_load(kr, vr, Kb, Vb, 0, tid);
    kv_store(kr, vr, KVBUF(L, 0), tid);
    kv_load(kr, vr, Kb, Vb, 64, tid);
    for (int j = 0; j < NT; ++j) {
        __syncthreads();
        if (j + 1 < NT) { kv_store(kr, vr, KVBUF(L, j + 1), tid); }
        if (j + 2 < NT) kv_load(kr, vr, Kb, Vb, 64 * (j + 2), tid);
        if (j <= jd) {
            const LDSP unsigned char* buf = KVBUF(L, j);
            const int k0 = 64 * j; const bool nearb = (qw - (k0 + 63)) < 113; const float cfar = tbl[127] + nbound;
#pragma unroll
            for (int mp = 0; mp < 2; ++mp) {
                f32x16 p0 = splat16(nearb ? nbound : cfar), p1 = p0;
                qkt<2>(p0, p1, buf, qf + 2 * mp, 2 * mp, r32, hi);
                if (nearb) bias_near(p0, p1, tbl, t - k0, 1 << 30, true, hi);
                if (mp == 0) { l1 += exp_sum(p0, p1); pv(o1, buf, vb, p0, p1); }
                else { l2 += exp_sum(p0, p1); pv(o2, buf, vb, p0, p1); }
            }
        }
    }
    l1 += __shfl_xor(l1, 32); l2 += __shfl_xor(l2, 32);
    scale_rows(o1, 1.f / l1, wsf, r32, hi); scale_rows(o2, lam / l2, wsf, r32, hi);
    o1[0] -= o2[0]; o1[1] -= o2[1];
    const float g0 = p.diff_sub[l * 64 + r32] * (1.f - lam_init), g1 = p.diff_sub[l * 64 + 32 + r32] * (1.f - lam_init);
#pragma unroll
    for (int r = 0; r < 16; ++r) {
        float ss = o1[0][r] * o1[0][r] + o1[1][r] * o1[1][r];
        ss += __shfl_xor(ss, 1); ss += __shfl_xor(ss, 2); ss += __shfl_xor(ss, 4); ss += __shfl_xor(ss, 8); ss += __shfl_xor(ss, 16);
        const float rs = rsqrtf(ss * (1.f / 64.f) + EPS); o1[0][r] *= rs * g0; o1[1][r] *= rs * g1;
    }
    store_o(o1, (LDSP bf16_t*)(L + AL_IMP + wid * 8192), mix + (rb + qw) * DM + 0 + 64 * h, lane, r32, hi);
}

template <bool DIAG>
__device__ __forceinline__ void stick_sub(f32x16& y, float& carry, int kbase  , int t, int hi) {
    float lk[16];
#pragma unroll
    for (int r = 0; r < 16; ++r) {
        const float v = y[r]; const float e = ex2(-fabsf(v)); const float lb = fminf(v, 0.f) - __builtin_amdgcn_logf(1.f + e);
        if (DIAG) { const bool valid = (kbase + crow(r, hi) < t); lk[r] = valid ? (lb - v) : 0.f; y[r] = valid ? lb : -INFINITY; }
        else { lk[r] = lb - v; y[r] = lb; }
    }
    float T[4], Go[4];
#pragma unroll
    for (int g = 0; g < 4; ++g) { const float Gs = (lk[4 * g] + lk[4 * g + 1]) + (lk[4 * g + 2] + lk[4 * g + 3]); Go[g] = __shfl_xor(Gs, 32); T[g] = Gs + Go[g]; }
    float sx = 0.f;
#pragma unroll
    for (int g = 3; g >= 0; --g) {
        float tail = carry + sx + (hi == 0 ? Go[g] : 0.f);
#pragma unroll
        for (int i = 3; i >= 0; --i) { y[4 * g + i] = ex2(y[4 * g + i] + tail); tail += lk[4 * g + i]; }
        sx += T[g];
    }
    carry += sx;
}
__device__ void fa_stick_unit(const Params& p, int l, int b, int h, int qb, LDSP unsigned char* L) {
    const int tid = TID(), lane = tid & 63, wid = __builtin_amdgcn_readfirstlane(tid >> 6), r32 = lane & 31, hi = lane >> 5;
    const bf16_t* proj = (const bf16_t*)(p.ws + WS_PROJ); bf16_t* mix = (bf16_t*)(p.ws + WS_MIX);
    const size_t rb = (size_t)b * SEQ; const int q0 = qb * 256, qw = q0 + 32 * wid, t = qw + r32;
    const bf16_t* Kb = proj + rb * PINP + CC_K + 64 * h; const bf16_t* Vb = proj + rb * PINP + CC_V + 64 * h;
    const int vb = 9216 + ((lane >> 4) & 1) * 32 + (lane & 3) * 8 + (4 * hi + ((lane & 15) >> 2)) * 64;
    bf16x8 qf[4]; load_q<64>(qf, proj + (rb + t) * PINP + CC_Q + 64 * h, nullptr, 0.125f * LOG2E, false, hi);
    f32x16 o[2]; o[0] = (f32x16){}; o[1] = (f32x16){};
    float carry = 0.f;
    const int NT = 4 * qb + 4, jd = 4 * qb + (wid >> 1);
    u32x4 kr, vr;
#define SBUF(i) (((i) & 1) ? (L + 108544) : L)
    __syncthreads();
    kv_load(kr, vr, Kb, Vb, 64 * (NT - 1), tid);
    kv_store(kr, vr, SBUF(NT - 1), tid);
    kv_load(kr, vr, Kb, Vb, 64 * (NT - 2), tid);
    for (int j = NT - 1; j >= 0; --j) {
        __syncthreads();
        if (j >= 1) kv_store(kr, vr, SBUF(j - 1), tid);
        if (j >= 2) kv_load(kr, vr, Kb, Vb, 64 * (j - 2), tid);
        if (j <= jd) {
            const LDSP unsigned char* buf = SBUF(j);
            f32x16 p0 = (f32x16){}, p1 = (f32x16){};
            qkt<4>(p0, p1, buf, qf, 0, r32, hi);
            const int k0 = 64 * j; const bool diag = (j == jd);
            if (diag) { stick_sub<true>(p1, carry, k0 + 32, t, hi); stick_sub<true>(p0, carry, k0, t, hi); }
            else { stick_sub<false>(p1, carry, k0 + 32, t, hi); stick_sub<false>(p0, carry, k0, t, hi); }
            pv(o, buf, vb, p0, p1);
        }
    }
    store_o(o, (LDSP bf16_t*)(L + AL_IMP + wid * 8192), mix + (rb + qw) * DM + 512 + 64 * h, lane, r32, hi);
}

__device__ void fa_nsa_unit(const Params& p, int l, int b, int u, LDSP unsigned char* L) {
    const int tid = TID(), lane = tid & 63, wid = __builtin_amdgcn_readfirstlane(tid >> 6), r32 = lane & 31, hi = lane >> 5;
    const int hh = wid >> 1, sub = wid & 1;
    const bf16_t* proj = (const bf16_t*)(p.ws + WS_PROJ); bf16_t* mix = (bf16_t*)(p.ws + WS_MIX);
    const size_t rb = (size_t)b * SEQ; const int q0 = 64 * u, qw = q0 + 32 * sub, t = qw + r32; const int ql = 32 * sub + r32;
    LDSP float* wsf = (LDSP float*)(L + AL_WSF) + wid * 64; LDSP float* tbl = (LDSP float*)(L + AL_TB4) + hh * 128;
    LDSP float* imp = (LDSP float*)(L + AL_IMP); LDSP unsigned* selm = (LDSP unsigned*)(L + AL_SELM); LDSP float* invl = (LDSP float*)(L + AL_INVL);
    LDSP float* ofl = (LDSP float*)(L + AL_IMP) + wid * 2048 + lane;
    const int vb = 9216 + ((lane >> 4) & 1) * 32 + (lane & 3) * 8 + (4 * hi + ((lane & 15) >> 2)) * 64;
    const float* bnd = (const float*)(p.ws + WS_BND) + l * 32;
    __syncthreads();
    ((LDSP float*)(L + AL_TB4))[tid] = ((const float*)(p.ws + WS_TB))[512 + tid] * LOG2E;
    bf16x8 qf[4]; load_q<64>(qf, proj + (rb + t) * PINP + CD_Q + 64 * hh, p.nsa_qn + l * 64, 0.125f * LOG2E, true, hi);
    const float* sd = (const float*)(p.ws + WS_SIDE) + (rb + t) * 16 + 4 + hh;
    const float gc = 1.f / (1.f + __expf(-sd[0])), gs = 1.f / (1.f + __expf(-sd[4])), gwn = 1.f / (1.f + __expf(-sd[8]));
    f32x16 o[2]; o[0] = (f32x16){}; o[1] = (f32x16){};
    u32x4 kr, vr;
    {
        const bf16_t* Kc = (const bf16_t*)(p.ws + WS_KC) + (size_t)b * 256 * 64; const bf16_t* Vc = (const bf16_t*)(p.ws + WS_VC) + (size_t)b * 256 * 64;
        const int ntc = (4 * u + 2) / 64 + 1; const float nbound = -bnd[5 + hh];
        float l_run = 0.f, prevE3 = 0.f;
        kv_load64(kr, vr, Kc, Vc, 0, tid);
        kv_store(kr, vr, KVBUF(L, 0), tid);
        if (ntc > 1) kv_load64(kr, vr, Kc, Vc, 64, tid);
        for (int T = 0; T < ntc; ++T) {
            __syncthreads();
            if (T + 1 < ntc) kv_store(kr, vr, KVBUF(L, T + 1), tid);
            if (T + 2 < ntc) kv_load64(kr, vr, Kc, Vc, 64 * (T + 2), tid);
            const LDSP unsigned char* buf = KVBUF(L, T);
            f32x16 p0 = splat16(nbound), p1 = p0;
            qkt<4>(p0, p1, buf, qf, 0, r32, hi);
#pragma unroll
            for (int g = 0; g < 4; ++g) {
#pragma unroll
                for (int i = 0; i < 4; ++i) { const int r = 4 * g + i; const int d0_ = t - 16 * (64 * T + crow(r, hi)) - 31, d1_ = d0_ - 512;
                    const float b0 = tbl[min(max(d0_, 0), 127)], b1 = tbl[min(max(d1_, 0), 127)];
                    p0[r] = (d0_ < 0) ? -INFINITY : p0[r] + b0; p1[r] = (d1_ < 0) ? -INFINITY : p1[r] + b1; }
                asm volatile("" ::: "memory");
            }
            l_run += exp_sum(p0, p1);
#pragma unroll
            for (int s2 = 0; s2 < 2; ++s2) {
                float G[4], Eo[4];
#pragma unroll
                for (int g = 0; g < 4; ++g) { const float a0 = s2 ? p1[4 * g] : p0[4 * g], a1 = s2 ? p1[4 * g + 1] : p0[4 * g + 1], a2 = s2 ? p1[4 * g + 2] : p0[4 * g + 2], a3 = s2 ? p1[4 * g + 3] : p0[4 * g + 3];
                    G[g] = (a0 + a1) + (a2 + a3); Eo[g] = __shfl_xor(a3, 32); }
#pragma unroll
                for (int g = 0; g < 4; ++g) { const float eprev = hi ? Eo[g] : (g > 0 ? Eo[g - 1] : prevE3);
                    imp[(hh * 64 + ql) * 64 + 16 * T + 8 * s2 + 2 * g + hi] = G[g] + eprev; }
                prevE3 = Eo[3];
            }
            pv(o, buf, vb, p0, p1);
        }
        l_run += __shfl_xor(l_run, 32);
        const float inv = (l_run > 0.f) ? 1.f / l_run : 0.f;
        if (hi == 0) invl[hh * 64 + ql] = inv;
        scale_rows(o, gc * inv, wsf, r32, hi);
    }
    __syncthreads();
    {
        const int q = tid >> 3, part = tid & 7;
        const float i0 = invl[q], i1 = invl[64 + q], i2 = invl[128 + q], i3 = invl[192 + q];
        float vj[8];
#pragma unroll
        for (int jj = 0; jj < 8; ++jj) { const int j = part * 8 + jj;
            const float sum = ((imp[(0 * 64 + q) * 64 + j] * i0 + imp[(1 * 64 + q) * 64 + j] * i1) + imp[(2 * 64 + q) * 64 + j] * i2) + imp[(3 * 64 + q) * 64 + j] * i3;
            vj[jj] = (j > u) ? -1.0f : ((j == u || j == 0) ? 1.0e4f : sum); }
        __syncthreads();
#pragma unroll
        for (int jj = 0; jj < 8; ++jj) imp[q * 64 + part * 8 + jj] = vj[jj];
        __syncthreads();
        int rank[8];
#pragma unroll
        for (int jj = 0; jj < 8; ++jj) rank[jj] = 0;
        for (int i = 0; i < 64; ++i) { const float vi = imp[q * 64 + i];
#pragma unroll
            for (int jj = 0; jj < 8; ++jj) rank[jj] += (vi > vj[jj] || (vi == vj[jj] && i < part * 8 + jj)) ? 1 : 0; }
        unsigned bits = 0;
#pragma unroll
        for (int jj = 0; jj < 8; ++jj) if (rank[jj] < 16 && (part * 8 + jj) <= u) bits |= 1u << jj;
        unsigned mlo = (part < 4) ? (bits << (8 * part)) : 0u, mhi = (part >= 4) ? (bits << (8 * (part - 4))) : 0u;
        mlo |= __shfl_xor(mlo, 1); mhi |= __shfl_xor(mhi, 1); mlo |= __shfl_xor(mlo, 2); mhi |= __shfl_xor(mhi, 2); mlo |= __shfl_xor(mlo, 4); mhi |= __shfl_xor(mhi, 4);
        if (part == 0) { selm[2 * q] = mlo; selm[2 * q + 1] = mhi; }
    }
    __syncthreads();
#pragma unroll
    for (int r = 0; r < 16; ++r) { ofl[(2 * r) * 64] = o[0][r]; ofl[(2 * r + 1) * 64] = o[1][r]; }
    o[0] = (f32x16){}; o[1] = (f32x16){};
    {
        const unsigned long long mymask = (unsigned long long)selm[2 * ql] | ((unsigned long long)selm[2 * ql + 1] << 32);
        unsigned ulo = selm[2 * lane], uhi = selm[2 * lane + 1];
#pragma unroll
        for (int s2 = 1; s2 < 64; s2 <<= 1) { ulo |= __shfl_xor(ulo, s2); uhi |= __shfl_xor(uhi, s2); }
        unsigned long long um = (unsigned long long)(unsigned)__builtin_amdgcn_readfirstlane((int)ulo) | ((unsigned long long)(unsigned)__builtin_amdgcn_readfirstlane((int)uhi) << 32);
        const bf16_t* Kb = proj + rb * PINP + CD_KS; const bf16_t* Vb = proj + rb * PINP + CD_VS;
        float l_run = 0.f; const float nbound = -bnd[9 + hh]; const float cfar = tbl[127] + nbound; const float* gk = p.nsa_kn + (l * 3 + 1) * 64 + (tid & 7) * 8;
        int j = __builtin_ctzll(um); um &= um - 1;
        int jn = um ? __builtin_ctzll(um) : -1; um &= um - 1;
        kv_load(kr, vr, Kb, Vb, 64 * j, tid);
        kv_store(kr, vr, KVBUF(L, 0), tid);
        if (jn >= 0) kv_load(kr, vr, Kb, Vb, 64 * jn, tid);
        for (int it = 0;; ++it) {
            __syncthreads();
            const int jnn = um ? __builtin_ctzll(um) : -1; um &= um - 1;
            if (jn >= 0) { kv_store(kr, vr, KVBUF(L, it + 1), tid); }
            if (jnn >= 0) kv_load(kr, vr, Kb, Vb, 64 * jnn, tid);
            const bool mine = (mymask >> j) & 1ull;
            if (__any(mine)) {
                const LDSP unsigned char* buf = KVBUF(L, it);
                const int k0 = 64 * j; const bool nearb = (qw - (k0 + 63)) < 113;
                f32x16 p0 = splat16(nearb ? nbound : (mine ? cfar : -INFINITY)), p1 = p0;
                qkt<4>(p0, p1, buf, qf, 0, r32, hi);
                if (nearb) bias_near(p0, p1, tbl, t - k0, 1 << 30, mine, hi);
                l_run += exp_sum(p0, p1);
                pv(o, buf, vb, p0, p1);
            }
            if (jn < 0) break;
            j = jn; jn = jnn;
        }
        l_run += __shfl_xor(l_run, 32);
        scale_rows(o, gs / l_run, wsf, r32, hi);
#pragma unroll
        for (int r = 0; r < 16; ++r) { ofl[(2 * r) * 64] += o[0][r]; ofl[(2 * r + 1) * 64] += o[1][r]; }
        o[0] = (f32x16){}; o[1] = (f32x16){};
    }
    {
        const bf16_t* Kb = proj + rb * PINP + CD_KW; const bf16_t* Vb = proj + rb * PINP + CD_VW;
        float l_run = 0.f; const float nbound = -bnd[13 + hh]; const float cfar = tbl[127] + nbound; const float* gk = p.nsa_kn + (l * 3 + 2) * 64 + (tid & 7) * 8;
        const int jlo = max(0, u - 8);
        __syncthreads();
        kv_load(kr, vr, Kb, Vb, 64 * jlo, tid);
        kv_store(kr, vr, KVBUF(L, jlo), tid);
        if (jlo < u) kv_load(kr, vr, Kb, Vb, 64 * (jlo + 1), tid);
        for (int j = jlo; j <= u; ++j) {
            __syncthreads();
            if (j + 1 <= u) { kv_store(kr, vr, KVBUF(L, j + 1), tid); }
            if (j + 2 <= u) kv_load(kr, vr, Kb, Vb, 64 * (j + 2), tid);
            const LDSP unsigned char* buf = KVBUF(L, j);
            const int k0 = 64 * j; const bool nearb = (j == u || j == u - 8 || (qw - (k0 + 63)) < 113);
            f32x16 p0 = splat16(nearb ? nbound : cfar), p1 = p0;
            qkt<4>(p0, p1, buf, qf, 0, r32, hi);
            if (nearb) bias_near(p0, p1, tbl, t - k0, 512, true, hi);
            l_run += exp_sum(p0, p1);
            pv(o, buf, vb, p0, p1);
        }
        l_run += __shfl_xor(l_run, 32);
        scale_rows(o, gwn / l_run, wsf, r32, hi);
#pragma unroll
        for (int r = 0; r < 16; ++r) { o[0][r] += ofl[(2 * r) * 64]; o[1][r] += ofl[(2 * r + 1) * 64]; }
    }
    store_o(o, (LDSP bf16_t*)(L + AL_IMP + wid * 8192), mix + (rb + qw) * DM + 768 + 64 * hh, lane, r32, hi);
}

__device__ void ph_reset_queues(const Params& p) { unsigned* ctl = (unsigned*)(p.ws + WS_CTL); const int gt = GTID(); if (gt < 8) ctl[gt] = 0u; }
__device__ void prep_cmp_task(const Params& p, int l, int task, LDSP unsigned char* L) {
    const int tid = TID(), lane = tid & 63, wid = __builtin_amdgcn_readfirstlane(tid >> 6), r32 = lane & 31, hi = lane >> 5;
    const int b = task >> 4, which = (task >> 3) & 1, nt = task & 7;
    const bf16_t* proj = (const bf16_t*)(p.ws + WS_PROJ);
    const bf16_t* phiT = (const bf16_t*)(p.ws + WS_PHIT) + (size_t)(l * 2 + which) * 64 * 2048;
    const float* pe = p.nsa_pe + (size_t)(l * 2 + which) * 32 * 64;
    const int n = 32 * nt + r32, colbase = which ? CD_VC : CD_KC;
    f32x16 acc0 = (f32x16){}, acc1 = (f32x16){};
#pragma unroll
    for (int ii = 0; ii < 4; ++ii) {
        const int i = 4 * wid + ii; const int tok = min(16 * n + i, SEQ - 1);
        const bf16_t* xr = proj + (size_t)(b * SEQ + tok) * PINP + colbase;
#pragma unroll
        for (int d0 = 0; d0 < 4; ++d0) {
            float xv[8]; load8(xr + 16 * d0 + 8 * hi, xv);
            const f32x4 pe0 = *(const f32x4*)(pe + i * 64 + 16 * d0 + 8 * hi), pe1 = *(const f32x4*)(pe + i * 64 + 16 * d0 + 8 * hi + 4);
            u32x4 aw; aw[0] = pg8::cvt_pk_bf16(xv[0] + pe0[0], xv[1] + pe0[1]); aw[1] = pg8::cvt_pk_bf16(xv[2] + pe0[2], xv[3] + pe0[3]);
            aw[2] = pg8::cvt_pk_bf16(xv[4] + pe1[0], xv[5] + pe1[1]); aw[3] = pg8::cvt_pk_bf16(xv[6] + pe1[2], xv[7] + pe1[3]);
            const bf16x8 af = __builtin_bit_cast(bf16x8, aw);
            const bf16x8 b0 = *(const bf16x8*)(phiT + (size_t)r32 * 2048 + i * 64 + 16 * d0 + 8 * hi);
            const bf16x8 b1 = *(const bf16x8*)(phiT + (size_t)(32 + r32) * 2048 + i * 64 + 16 * d0 + 8 * hi);
            acc0 = __builtin_amdgcn_mfma_f32_32x32x16_bf16(af, b0, acc0, 0, 0, 0);
            acc1 = __builtin_amdgcn_mfma_f32_32x32x16_bf16(af, b1, acc1, 0, 0, 0);
        }
    }
    LDSP float* red = (LDSP float*)L;
    __syncthreads();
#pragma unroll
    for (int r = 0; r < 16; ++r) { red[(wid * 32 + crow(r, hi)) * 64 + r32] = acc0[r]; red[(wid * 32 + crow(r, hi)) * 64 + 32 + r32] = acc1[r]; }
    __syncthreads();
    {
        const int row = tid >> 4, e4 = (tid & 15) * 4; f32x4 v = (f32x4){0.f, 0.f, 0.f, 0.f};
#pragma unroll
        for (int w8 = 0; w8 < 8; ++w8) v += *(const LDSP f32x4*)(red + (w8 * 32 + row) * 64 + e4);
        const int nn = 32 * nt + row;
        if (which == 0) {
            float ss = (v[0] * v[0] + v[1] * v[1]) + (v[2] * v[2] + v[3] * v[3]);
            ss += __shfl_xor(ss, 1); ss += __shfl_xor(ss, 2); ss += __shfl_xor(ss, 4); ss += __shfl_xor(ss, 8);
            const float rs = rsqrtf(ss * (1.f / 64.f) + EPS); const f32x4 g = *(const f32x4*)(p.nsa_kn + (l * 3 + 0) * 64 + e4);
            v = v * rs * g;
        }
        uint2 o; o.x = pk2(v[0], v[1]); o.y = pk2(v[2], v[3]);
        if (nn >= 255) { o.x = 0u; o.y = 0u; }
        *(uint2*)((bf16_t*)(p.ws + (which ? WS_VC : WS_KC)) + (size_t)(b * 256 + nn) * 64 + e4) = o;
    }
}
__device__ void ph_prep(const Params& p, int l, LDSP unsigned char* L, unsigned char* lds) {
    for (int t = blockIdx.x; t < 80; t += gridDim.x) { if (t < 64) prep_cmp_task(p, l, t, L); }
    if (gridDim.x >= 80) { if (blockIdx.x >= 64 && blockIdx.x < 80) ph_prep_cum_bh(p, l, blockIdx.x - 64, lds); }
    else for (int bh = blockIdx.x; bh < 16; bh += gridDim.x) ph_prep_cum_bh(p, l, bh, lds);
}


__device__ void fa_phase_all(const Params& p, int l, LDSP unsigned char* L, unsigned char* lds, int qslot) {
    unsigned* ctl = (unsigned*)(p.ws + WS_CTL);
    LDSP unsigned* misc = (LDSP unsigned*)(L + AL_MISC);
    bool prep_ok = false;
    for (;;) {
        __syncthreads();
        if (threadIdx.x == 0) misc[0] = atomicAdd(&ctl[qslot], 1u);
        __syncthreads();
        const unsigned qi0 = misc[0];
        if (qi0 >= 1104u) break;
        if (qi0 < 80u) {
            if (qi0 < 64u) prep_cmp_task(p, l, (int)qi0, L); else ph_prep_cum_bh(p, l, (int)qi0 - 64, lds);
            asm volatile("s_waitcnt vmcnt(0)" ::: "memory");
            __syncthreads();
            if (threadIdx.x == 0) { __threadfence(); atomicAdd(&ctl[4 + qslot], 1u); }
            continue;
        }
        const unsigned qi = qi0 - 80u;
        const int r = 15 - (int)(qi >> 6), j = (int)(qi & 63), typ = j >> 4, sub = j & 15;
        if ((typ == 2 || typ == 3) && !prep_ok) {
            if (threadIdx.x == 0) { while (__hip_atomic_load(&ctl[4 + qslot], __ATOMIC_RELAXED, __HIP_MEMORY_SCOPE_AGENT) < 80u) __builtin_amdgcn_s_sleep(8); __threadfence(); }
            asm volatile("s_waitcnt vmcnt(0)" ::: "memory");
            __syncthreads();
            prep_ok = true;
        }
        if (typ == 0) fa_diff_unit(p, l, sub >> 2, sub & 3, r, L);
        else if (typ == 1) fa_stick_unit(p, l, sub >> 2, sub & 3, r, L);
        else if (typ == 2) fa_fox_unit(p, l, sub >> 2, sub & 3, r, L);
        else fa_nsa_unit(p, l, sub >> 2, 4 * r + (sub & 3), L);
    }
}

#define XB_TMO      128
#define XB_XCNT(j)  (256  + 64 * (j))
#define XB_XSUB(j)  (1280 + 64 * (j))
#define XB_XGEN(j)  (2304 + 64 * (j))
#define XB_TOP      3328
#define XB_TOPGEN   3392
#define XCD_BAR_WORDS 3456
#define XB_SPIN_CAP (1u << 18)

__device__ __forceinline__ unsigned xb_ld(unsigned* p)              { return __hip_atomic_load(p, __ATOMIC_RELAXED, __HIP_MEMORY_SCOPE_AGENT); }
__device__ __forceinline__ unsigned xb_add(unsigned* p, unsigned v) { return __hip_atomic_fetch_add(p, v, __ATOMIC_RELAXED, __HIP_MEMORY_SCOPE_AGENT); }
__device__ __forceinline__ unsigned xb_xcc_id() { return (unsigned)__builtin_amdgcn_s_getreg((3 << 11) | 20) & 0xFu; }
#define XB_SPIN(cond, bar) do { unsigned _sp = 0; while (cond) { __builtin_amdgcn_s_sleep(1); \
    if ((++_sp & 255u) == 0u) { if (xb_ld(&(bar)[XB_TMO])) break; if (_sp > XB_SPIN_CAP) { atomicAdd(&(bar)[XB_TMO], 1u); break; } } } } while (0)

struct XcdBarrier {
    unsigned* bar; unsigned x;
    volatile LDSF unsigned* st;
};

__device__ __forceinline__ XcdBarrier xcd_barrier_post(unsigned* bar, volatile LDSF unsigned* st) {
    XcdBarrier b; b.bar = bar; b.x = xb_xcc_id(); b.st = st;
    if (threadIdx.x == 0) (void)xb_add(&bar[XB_XCNT(b.x)], 1u);
    return b;
}
__device__ __forceinline__ void xcd_barrier_complete(unsigned* bar, unsigned x, unsigned& nloc, unsigned& nx) {
    const unsigned G = gridDim.x * gridDim.y * gridDim.z;
    unsigned sum, cnt, mine, sp = 0u;
    for (;;) {
        sum = 0u; cnt = 0u; mine = 0u;
#pragma unroll
        for (unsigned j = 0; j < 16; ++j) { const unsigned c = xb_ld(&bar[XB_XCNT(j)]); sum += c; cnt += (c > 0u) ? 1u : 0u; mine = (j == x) ? c : mine; }
        if (sum == G) break;
        __builtin_amdgcn_s_sleep(1);
        if ((++sp & 255u) == 0u) { if (xb_ld(&bar[XB_TMO])) break; if (sp > XB_SPIN_CAP) { atomicAdd(&bar[XB_TMO], 1u); break; } }
    }
    nloc = mine > 0u ? mine : 1u; nx = cnt > 0u ? cnt : 1u;
}

__device__ __forceinline__ void xcd_barrier(const XcdBarrier& b) {
    asm volatile("s_waitcnt vmcnt(0)" ::: "memory");
    __syncthreads();
    if (threadIdx.x == 0) {
        unsigned* bar = b.bar;
        __builtin_amdgcn_s_waitcnt(0);
        unsigned nloc = b.st[0], nx = b.st[1];
        if (nloc == 0u) { xcd_barrier_complete(bar, b.x, nloc, nx); b.st[0] = nloc; b.st[1] = nx; }
        const unsigned old = xb_add(&bar[XB_XSUB(b.x)], 1u);
        const unsigned gen = old / nloc;
        if (old + 1u == (gen + 1u) * nloc) {
            __builtin_amdgcn_fence(__ATOMIC_RELEASE, "agent");
            asm volatile("s_waitcnt vmcnt(0)" ::: "memory");
            const unsigned og = xb_add(&bar[XB_TOP], 1u);
            const unsigned tg = og / nx;
            if (og + 1u == (tg + 1u) * nx) xb_add(&bar[XB_TOPGEN], 1u);
            else XB_SPIN(xb_ld(&bar[XB_TOPGEN]) == tg, bar);
            __builtin_amdgcn_fence(__ATOMIC_ACQUIRE, "agent");
            xb_add(&bar[XB_XGEN(b.x)], 1u);
            asm volatile("s_waitcnt vmcnt(0)" ::: "memory");
        } else {
            XB_SPIN(xb_ld(&bar[XB_XGEN(b.x)]) == gen, bar);
            __builtin_amdgcn_fence(__ATOMIC_ACQUIRE, "agent");
            asm volatile("s_waitcnt vmcnt(0)" ::: "memory");
        }
    }
    __syncthreads();
}

namespace cg = cooperative_groups;
constexpr int LDS_BYTES = 131072 + 8192 + 4096;
#define LAS3 __attribute__((address_space(3)))
#ifndef PROBE
#define PROBE 0
#endif
__global__ void __launch_bounds__(NTHR, 2) mega(Params p) {
    extern __shared__ __attribute__((aligned(16))) unsigned char lds[];
    cg::grid_group grid = cg::this_grid();
#if PROBE
    unsigned long long tacc = 0, tph = 0, t0_;
#define GSYNC() do { t0_ = __builtin_amdgcn_s_memrealtime(); xcd_barrier(xbar); tacc += __builtin_amdgcn_s_memrealtime() - t0_; } while (0)
#define TPK(k, ...) do { if (PROBE == (k)) { t0_ = __builtin_amdgcn_s_memrealtime(); __VA_ARGS__; tph += __builtin_amdgcn_s_memrealtime() - t0_; } else { __VA_ARGS__; } } while (0)
#else
#define GSYNC() xcd_barrier(xbar)
#define TPK(k, ...) do { __VA_ARGS__; } while (0)
#endif
    LAS3 unsigned char* lds3 = (LAS3 unsigned char*)lds;
    volatile LDSF unsigned* bst = (volatile LDSF unsigned*)(lds3 + 131072 + 2048);
    if (threadIdx.x < 2) bst[threadIdx.x] = 0u;
    __syncthreads();
    XcdBarrier xbar = xcd_barrier_post((unsigned*)(p.ws + WS_CTL) + 16384, bst);
    TPK(2, ph_mod(p, lds); ph_reset_queues(p); ph_weights(p, 0, lds); ph_weights(p, 1, lds));
    grid.sync();
    for (int l = 0; l < DEPTH; ++l) {
        const float* mod = (const float*)(p.ws + WS_MOD) + (size_t)l * 4 * 6144;
        if (l == 0) {
            TPK(2, ph_cbias(p, lds); ph_xa_from(p, p.x, 0, 0, (bf16_t*)(p.ws + WS_XA), (float*)(p.ws + WS_RSA), true));
            GSYNC();
        }
        {   pg8::Gemm g{(const bf16_t*)(p.ws + WS_XA), (const bf16_t*)(p.ws + WS_WIN + l * WS_W1OFF), MTOK, PINP, DM}; pg8::StaticOrder S; S.init(MTOK, PINP, (int)gridDim.x, (int)blockIdx.x);
            EpiProjF E{(const float*)(p.ws + WS_RSA), (const float*)(p.ws + WS_CBIN) + (size_t)l * 4 * PINP, (bf16_t*)(p.ws + WS_PROJ), (float*)(p.ws + WS_SIDE),
                       p.diff_kn + l * 32, p.fox_kn + l * 64, p.nsa_kn + (l * 3 + 1) * 64, p.nsa_kn + (l * 3 + 2) * 64, (LDSF float*)(lds3 + 131072 + 4096)};
            TPK(6, pg8::gemm_phase<EpiProjF, pg8::StaticOrder, true, PG8_SP2>(lds3, g, S, E)); }
        GSYNC();
        TPK(7, fa_phase_all(p, l, lds3, lds, l));
        GSYNC();
        {   pg8::Gemm g{(const bf16_t*)(p.ws + WS_MIX), (const bf16_t*)(p.ws + WS_WOUT + l * WS_W1OFF), MTOK, DM, DM}; pg8::StaticOrder S; S.init(MTOK, DM, (int)gridDim.x, (int)blockIdx.x);
            EpiResF E{l == 0 ? p.x : p.out, p.out, mod + 2048, p.norm_ffn_g + l * DM, mod + 4096, (bf16_t*)(p.ws + WS_XA), (float*)(p.ws + WS_RSB)};
            TPK(6, pg8::gemm_phase<EpiResF, pg8::StaticOrder, PG8_ALIGN, PG8_SP2>(lds3, g, S, E)); }
        GSYNC();
        {   pg8::Gemm g{(const bf16_t*)(p.ws + WS_XA), (const bf16_t*)(p.ws + WS_WUP + l * WS_W1OFF), MTOK, NUP, DM}; pg8::StaticOrder S; S.init(MTOK, NUP, (int)gridDim.x, (int)blockIdx.x);
            EpiUpAct E{(const float*)(p.ws + WS_RSB), (const float*)(p.ws + WS_CBUP) + (size_t)l * 4 * NUP, (bf16_t*)(p.ws + WS_ACT), (float*)(p.ws + WS_EG), (float*)(p.ws + WS_EV),
                       p.conv_w + (size_t)l * 3 * DFF, p.conv_b + (size_t)l * DFF, (LDSF float*)(lds3 + 131072 + 4096), (LDSF float*)(lds3 + 131072 + 8192)};
            TPK(6, pg8::gemm_phase<EpiUpAct, pg8::StaticOrder, true, PG8_SP2>(lds3, g, S, E)); }
        GSYNC();
        {   const float* modn = (const float*)(p.ws + WS_MOD) + (size_t)(l + 1) * 4 * 6144; const bool more = (l + 1 < DEPTH);
            pg8::Gemm g{(const bf16_t*)(p.ws + WS_ACT), (const bf16_t*)(p.ws + WS_WDN + l * WS_W1OFF), MTOK, DM, DFF}; pg8::StaticOrder S; S.init(MTOK, DM, (int)gridDim.x, (int)blockIdx.x);
            { pg8::Unit fu; for (int i = 0; S.next(i, fu); ++i) act_fixup(p, l, fu.pm); }
            __builtin_amdgcn_fence(__ATOMIC_RELEASE, "agent"); __builtin_amdgcn_fence(__ATOMIC_ACQUIRE, "agent"); __syncthreads();
            EpiResF E{p.out, p.out, mod + 5120, p.norm_mix_g + (more ? l + 1 : l) * DM, more ? modn + 1024 : mod + 1024, more ? (bf16_t*)(p.ws + WS_XA) : nullptr, more ? (float*)(p.ws + WS_RSA) : nullptr};
            TPK(6, pg8::gemm_phase<EpiResF, pg8::StaticOrder, PG8_ALIGN, PG8_SP2>(lds3, g, S, E)); }
        if (l + 1 < DEPTH) GSYNC();
    }
#if PROBE == 1
    if (blockIdx.x == 0 && threadIdx.x == 0) p.out[0] += 0.05f + (float)tacc * 0.01f * 5e-4f;
#elif PROBE >= 2
    if (blockIdx.x == 0 && threadIdx.x == 0) p.out[0] += 0.05f + (float)tph * 0.01f * 1e-4f;
#endif
}

extern "C" void kernel_launch(void* const* d_in, const int* in_sizes, int in, void* d_out, int out_size, void* d_ws, size_t ws_size, hipStream_t stream) {
    if (in != 24 || ws_size < WS_END || out_size != MTOK * DM) { fprintf(stderr, "kernel_launch: unexpected sizes (in %d, ws %zu, out %d)\n", in, ws_size, out_size); return; }
    static int grid_blocks = 0;
    if (!grid_blocks) {
        int dev = 0, cus = 0, per_cu = 0;
        hipGetDevice(&dev);
        hipDeviceGetAttribute(&cus, hipDeviceAttributeMultiprocessorCount, dev);
        hipFuncSetAttribute((const void*)mega, hipFuncAttributeMaxDynamicSharedMemorySize, LDS_BYTES);
        hipOccupancyMaxActiveBlocksPerMultiprocessor(&per_cu, (const void*)mega, NTHR, LDS_BYTES);
        if (per_cu < 1) { fprintf(stderr, "kernel_launch: occupancy query returned %d\n", per_cu); per_cu = 1; }
        if (per_cu > 1) per_cu = 1;
        grid_blocks = cus * per_cu;
        fprintf(stderr, "kernel_launch: cus %d per_cu %d grid %d\n", cus, per_cu, grid_blocks);
    }
    if (hipMemsetAsync((char*)d_ws + WS_CTL + 65536, 0, XCD_BAR_WORDS * 4, stream) != hipSuccess) { fprintf(stderr, "kernel_launch: memset failed\n"); return; }
    Params p{};
    const float** f = (const float**)&p;
    for (int i = 0; i < 24; ++i) f[i] = (const float*)d_in[i];
    p.out = (float*)d_out; p.ws = (unsigned char*)d_ws;
    void* args[] = {&p};
    hipError_t e = hipLaunchCooperativeKernel((const void*)mega, dim3(grid_blocks), dim3(NTHR), args, LDS_BYTES, stream);
    if (e != hipSuccess) fprintf(stderr, "cooperative launch failed: %s (grid %d)\n", hipGetErrorString(e), grid_blocks);
}
```

```cpp
#include <hip/hip_runtime.h>
#include <hip/hip_cooperative_groups.h>
#include <cstdint>
#include <cstdio>

typedef unsigned short bf16_t;
typedef short bf16x8 __attribute__((ext_vector_type(8)));
typedef float f32x4 __attribute__((ext_vector_type(4)));
typedef unsigned u32x4 __attribute__((ext_vector_type(4)));

constexpr int NB = 4, SEQ = 4096, DM = 1024, MTOK = NB * SEQ, DEPTH = 2;
constexpr int HD = 64, HPM = 4, DFF = 2816, PIN = 2960, PINP = 3072, NUP = 2 * DFF;
constexpr float EPS = 1e-6f;
constexpr float LOG2E = 1.4426950408889634f;
constexpr int NTHR = 512;

constexpr int CA_Q = 0, CA_K = 256, CA_V = 512, CB_Q = 768, CB_K = 1024, CB_V = 1280, CC_Q = 1536, CC_K = 1792, CC_V = 2048;
constexpr int CD_Q = 2304, CD_KC = 2560, CD_VC = 2624, CD_KS = 2688, CD_VS = 2752, CD_KW = 2816, CD_VW = 2880, C_BF = 2944, C_DG = 2948;

constexpr size_t MiB = 1u << 20;
constexpr size_t WS_CTL = 0;
constexpr size_t WS_MOD = 1 * MiB;
constexpr size_t WS_CBIN = WS_MOD + 2 * 4 * 6144 * 4;
constexpr size_t WS_CBUP = WS_CBIN + 2 * 4 * 3072 * 4;
constexpr size_t WS_TB = WS_CBUP + 2 * 4 * 5632 * 4;
constexpr size_t WS_LAM = WS_TB + 2 * 4 * 128 * 4;
constexpr size_t WS_BND = WS_LAM + 64;
constexpr size_t WS_CUM = WS_LAM + 512;
constexpr size_t WS_KC = WS_CUM + 16 * 4096 * 4;
constexpr size_t WS_VC = WS_KC + 4 * 256 * 64 * 2;
constexpr size_t WS_SELM = WS_VC + 4 * 256 * 64 * 2;
constexpr size_t WS_SMALL_END = WS_SELM + 16384 * 8;
static_assert(WS_SMALL_END <= 4 * MiB, "small region");
constexpr size_t WS_RSA = 4 * MiB;
constexpr size_t WS_RSB = 5 * MiB;
constexpr size_t WS_SIDE = 6 * MiB;
constexpr size_t WS_IMP = 7 * MiB;
constexpr size_t WS_ML = 11 * MiB;
constexpr size_t WS_PHIT = 7 * MiB;
constexpr size_t WS_W = 12 * MiB;
constexpr size_t WS_WIN = WS_W;
constexpr size_t WS_WOUT = WS_WIN + (size_t)PINP * DM * 2;
constexpr size_t WS_WUP = WS_WOUT + (size_t)DM * DM * 2;
constexpr size_t WS_WDN = WS_WUP + (size_t)NUP * DM * 2;
constexpr size_t WS_W_END = WS_WDN + (size_t)DM * DFF * 2;
static_assert(WS_W_END <= 38 * MiB, "weights region");
constexpr size_t WS_XA = 38 * MiB;
constexpr size_t WS_BIG = 70 * MiB;
constexpr size_t WS_PROJ = WS_BIG;
constexpr size_t WS_MIX = WS_BIG + 96 * MiB;
constexpr size_t WS_ACT = WS_BIG;
constexpr size_t WS_W1OFF = 188 * MiB;
constexpr size_t WS_EG = 228 * MiB;
constexpr size_t WS_EV = 232 * MiB;
constexpr size_t WS_END = 236 * MiB;
static_assert(WS_W_END + WS_W1OFF <= WS_EG && WS_MIX + 32 * MiB <= WS_W + WS_W1OFF, "layer-1 weights");
static_assert(WS_END <= 256 * MiB, "workspace");

struct Params {
    const float *x, *c, *rel_bias, *ada_w, *ada_b, *norm_mix_g, *norm_ffn_g, *w_in, *w_out;
    const float *diff_qn, *diff_kn, *diff_lam, *diff_sub, *fox_qn, *fox_kn, *fox_bf;
    const float *nsa_qn, *nsa_kn, *nsa_pe, *nsa_phi, *w_up, *conv_w, *conv_b, *w_down;
    float* out;
    unsigned char* ws;
};

__device__ __forceinline__ float bf2f(bf16_t v) { return __uint_as_float(((unsigned)v) << 16); }
__device__ __forceinline__ bf16_t f2bf(float f) { unsigned u = __float_as_uint(f); return (bf16_t)((u + 0x7fffu + ((u >> 16) & 1u)) >> 16); }
__device__ __forceinline__ unsigned pk2(float lo, float hi) { return (unsigned)f2bf(lo) | ((unsigned)f2bf(hi) << 16); }
__device__ __forceinline__ float siluf(float v) { return v / (1.f + __expf(-v)); }
__device__ __forceinline__ float logsigf(float v) { return fminf(v, 0.f) - log1pf(__expf(-fabsf(v))); }
__device__ __forceinline__ float wave_sum(float v) {
#pragma unroll
    for (int o = 1; o < 64; o <<= 1) v += __shfl_xor(v, o);
    return v;
}
__device__ __forceinline__ int t5_bucket(int n) {
    if (n < 16) return n < 0 ? 0 : n;
    return 16 + (n >= 19) + (n >= 21) + (n >= 24) + (n >= 27) + (n >= 31) + (n >= 35) + (n >= 40) + (n >= 46) + (n >= 52) + (n >= 59) + (n >= 67) + (n >= 77) + (n >= 87) + (n >= 99) + (n >= 113);
}
__host__ __device__ __forceinline__ int in_col_map(int n) {
    if (n < 1536) return n;
    if (n < 2944) return n + 4;
    if (n < 2948) return 1536 + (n - 2944);
    if (n < 2960) return n;
    return -1;
}
__host__ __device__ __forceinline__ int up_col_map(int n) {
    const int pn = n >> 8, c = n & 255;
    return c < 128 ? (128 * pn + c) : (DFF + 128 * pn + (c - 128));
}

__device__ __forceinline__ int opaque_v(int v) { asm volatile("" : "+v"(v)); return v; }
#define TID() opaque_v((int)threadIdx.x)
#define GTID() ((int)(blockIdx.x * blockDim.x) + TID())
#define GSIZE() ((int)(gridDim.x * blockDim.x))

#define LDSF __attribute__((address_space(3)))
__device__ __forceinline__ void gemv4_block(const float* W, int ld, int oc, const LDSF float* vec, LDSF float* red, float* out0, int ostride, int n, float bias, int tid) {
    const int lane = tid & 63, wv = tid >> 6;
    float a0 = 0.f, a1 = 0.f, a2 = 0.f, a3 = 0.f;
    if (oc >= 0) {
        const float* w = W + (size_t)(wv * 128) * ld + oc;
#pragma unroll 32
        for (int k = 0; k < 128; ++k) { const float wk = w[(size_t)k * ld]; const f32x4 v = *(const LDSF f32x4*)(vec + (wv * 128 + k) * 4); a0 += v[0] * wk; a1 += v[1] * wk; a2 += v[2] * wk; a3 += v[3] * wk; }
    }
    red[(wv * 4 + 0) * 64 + lane] = a0; red[(wv * 4 + 1) * 64 + lane] = a1; red[(wv * 4 + 2) * 64 + lane] = a2; red[(wv * 4 + 3) * 64 + lane] = a3;
    __syncthreads();
    if (tid < 256) { const int bt = tid >> 6; float sacc = 0.f;
#pragma unroll
        for (int w8 = 0; w8 < 8; ++w8) sacc += red[(w8 * 4 + bt) * 64 + lane];
        out0[(size_t)bt * ostride + n] = sacc + bias; }
    __syncthreads();
}
__device__ void ph_mod(const Params& p, unsigned char* lds) {
    float* mod = (float*)(p.ws + WS_MOD);
    float* tb = (float*)(p.ws + WS_TB);
    float* lamv = (float*)(p.ws + WS_LAM);
    LDSF float* vec = (LDSF float*)lds; LDSF float* red = (LDSF float*)(lds + 16384);
    const int tid = TID();
    bool loaded = false;
    for (int item = blockIdx.x; item < DEPTH * 96; item += gridDim.x) {
        if (!loaded) { for (int i = tid; i < 4096; i += NTHR) { const int bt = i >> 10, k = i & 1023; vec[k * 4 + bt] = siluf(p.c[bt * DM + k]); } __syncthreads(); loaded = true; }
        const int l = item / 96, n = (item % 96) * 64 + (tid & 63);
        gemv4_block(p.ada_w + (size_t)l * DM * 6144, 6144, n, vec, red, mod + (size_t)l * 4 * 6144, 6144, n, p.ada_b[l * 6144 + n], tid);
    }
    const int gt = GTID(), gs = GSIZE();
    for (int idx = gt; idx < 2 * 4 * 128; idx += gs) {
        const int type = idx / 512, h = (idx / 128) & 3, d = idx & 127;
        tb[idx] = p.rel_bias[t5_bucket(d) * 8 + type * 4 + h];
    }
    for (int idx = gt; idx < DEPTH * 32; idx += gs) {
        const int l = idx >> 5, e = idx & 31; float v = 0.f;
        if (e < 17) {
            const int type = (e < 5) ? 0 : 1, h = (e < 4) ? e : ((e == 4) ? 0 : ((e - 5) & 3));
            const int ng = (e < 4) ? 32 : 64;
            const float* gq = (e < 4) ? p.diff_qn + l * 32 : ((e == 4) ? p.fox_qn + l * 64 : p.nsa_qn + l * 64);
            const float* gk = (e < 4) ? p.diff_kn + l * 32 : ((e == 4) ? p.fox_kn + l * 64 : p.nsa_kn + (l * 3 + (e - 5) / 4) * 64);
            float mq = 0.f, mk = 0.f; for (int i = 0; i < ng; ++i) { mq = fmaxf(mq, fabsf(gq[i])); mk = fmaxf(mk, fabsf(gk[i])); }
            float tm = 0.f; if (e != 4) { tm = -INFINITY; for (int bk2 = 0; bk2 < 32; ++bk2) tm = fmaxf(tm, p.rel_bias[bk2 * 8 + type * 4 + h]); }
            v = sqrtf((float)ng) * mq * mk * 1.02f * LOG2E + tm * LOG2E;
        }
        ((float*)(p.ws + WS_BND))[idx] = v;
    }
    for (int idx = gt; idx < DEPTH; idx += gs) {
        const float* lv = p.diff_lam + idx * 4 * 32;
        float s1 = 0.f, s2 = 0.f;
        for (int i = 0; i < 32; ++i) { s1 += lv[i] * lv[32 + i]; s2 += lv[64 + i] * lv[96 + i]; }
        const float lam_init = 0.8f - 0.6f * expf(-0.3f * (float)idx);
        lamv[idx] = expf(s1) - expf(s2) + lam_init;
    }
}
__device__ void ph_cbias(const Params& p, unsigned char* lds) {
    const float* mod = (const float*)(p.ws + WS_MOD);
    LDSF float* vec = (LDSF float*)lds; LDSF float* red = (LDSF float*)(lds + 16384);
    const int tid = TID();
    for (int item = blockIdx.x; item < DEPTH * 136; item += gridDim.x) {
        const int l = item / 136, r = item % 136; const bool isin = r < 48; const int n = (isin ? r : r - 48) * 64 + (tid & 63);
        const int shoff = isin ? 0 : 3072;
        __syncthreads();
        for (int i = tid; i < 4096; i += NTHR) { const int bt = i >> 10, k = i & 1023; vec[k * 4 + bt] = mod[(size_t)(l * 4 + bt) * 6144 + shoff + k]; }
        __syncthreads();
        if (isin) gemv4_block(p.w_in + (size_t)l * DM * PIN, PIN, in_col_map(n), vec, red, (float*)(p.ws + WS_CBIN) + (size_t)l * 4 * PINP, PINP, n, 0.f, tid);
        else gemv4_block(p.w_up + (size_t)l * DM * NUP, NUP, up_col_map(n), vec, red, (float*)(p.ws + WS_CBUP) + (size_t)l * 4 * NUP, NUP, n, 0.f, tid);
    }
}
template <int MAPK>
__device__ void convert_weight(const float* W, int K, int Nsrc, int Npad, bf16_t* Wt, LDSF float* scr, int gw, int ngw, int lane) {
    const int nkb = K / 64, nnb = Npad / 32;
    for (int it = gw; it < nkb * nnb; it += ngw) {
        const int kb = it / nnb, nb = it % nnb, k0 = kb * 64, n0 = nb * 32;
        {
            const int nn = lane & 31; const int n = n0 + nn;
            const int oc = MAPK == 0 ? n : (MAPK == 1 ? in_col_map(n) : up_col_map(n));
            float tv[32];
            const float* wp = W + (size_t)(k0 + (lane >> 5)) * Nsrc + (oc >= 0 ? oc : 0);
#pragma unroll
            for (int i = 0; i < 32; ++i) tv[i] = wp[(size_t)(2 * i) * Nsrc];
#pragma unroll
            for (int i = 0; i < 32; ++i) scr[(2 * i + (lane >> 5)) * 33 + nn] = (oc >= 0) ? tv[i] : 0.f;
        }
        __builtin_amdgcn_s_waitcnt(0xc07f); __builtin_amdgcn_wave_barrier();
        {
            const int c = lane & 7;
#pragma unroll
            for (int j = 0; j < 4; ++j) { const int n = (lane >> 3) + 8 * j; const LDSF float* sp = scr + (8 * c) * 33 + n;
                u32x4 o; o[0] = pk2(sp[0], sp[33]); o[1] = pk2(sp[66], sp[99]); o[2] = pk2(sp[132], sp[165]); o[3] = pk2(sp[198], sp[231]);
                *(u32x4*)(Wt + (size_t)(n0 + n) * K + k0 + 8 * c) = o; }
        }
        __builtin_amdgcn_s_waitcnt(0xc07f); __builtin_amdgcn_wave_barrier();
    }
}
__device__ void ph_weights(const Params& p, int l, unsigned char* lds) {
    const int tid_ = TID(); const int lane = tid_ & 63, wv = tid_ >> 6;
    const int gw = blockIdx.x * (NTHR >> 6) + wv, ngw = gridDim.x * (NTHR >> 6);
    LDSF float* scr = (LDSF float*)lds + wv * (64 * 33);
    convert_weight<1>(p.w_in + (size_t)l * DM * PIN, DM, PIN, PINP, (bf16_t*)(p.ws + WS_WIN + l * WS_W1OFF), scr, gw, ngw, lane);
    convert_weight<0>(p.w_out + (size_t)l * DM * DM, DM, DM, DM, (bf16_t*)(p.ws + WS_WOUT + l * WS_W1OFF), scr, gw, ngw, lane);
    convert_weight<2>(p.w_up + (size_t)l * DM * NUP, DM, NUP, NUP, (bf16_t*)(p.ws + WS_WUP + l * WS_W1OFF), scr, gw, ngw, lane);
    convert_weight<0>(p.w_down + (size_t)l * DFF * DM, DFF, DM, DM, (bf16_t*)(p.ws + WS_WDN + l * WS_W1OFF), scr, gw, ngw, lane);
    for (int w2 = 0; w2 < 2; ++w2) convert_weight<0>(p.nsa_phi + (size_t)(l * 2 + w2) * 2048 * 64, 2048, 64, 64, (bf16_t*)(p.ws + WS_PHIT) + (size_t)(l * 2 + w2) * 64 * 2048, scr, gw, ngw, lane);
}
__device__ void ph_xa_from(const Params& p, const float* src, int l, int which  , bf16_t* XA, float* rowss, bool write_xa) {
    const float* mod = (const float*)(p.ws + WS_MOD);
    const float* g = (which == 0 ? p.norm_mix_g : p.norm_ffn_g) + l * DM;
    const int tid_ = TID(); const int lane = tid_ & 63, wv = tid_ >> 6;
    const int gw = blockIdx.x * (blockDim.x >> 6) + wv, ngw = gridDim.x * (blockDim.x >> 6);
    for (int row = gw; row < MTOK; row += ngw) {
        const int b = row / SEQ;
        const float* sc = mod + (size_t)(l * 4 + b) * 6144 + (which == 0 ? 1024 : 4096);
        float ss = 0.f;
#pragma unroll
        for (int j = 0; j < 4; ++j) {
            const int k = j * 256 + lane * 4;
            const f32x4 v = *(const f32x4*)(src + (size_t)row * DM + k);
            ss += v[0] * v[0] + v[1] * v[1] + v[2] * v[2] + v[3] * v[3];
            if (write_xa) {
                const f32x4 gv = *(const f32x4*)(g + k); const f32x4 sv = *(const f32x4*)(sc + k);
                uint2 o; o.x = pk2(v[0] * gv[0] * (1.f + sv[0]), v[1] * gv[1] * (1.f + sv[1])); o.y = pk2(v[2] * gv[2] * (1.f + sv[2]), v[3] * gv[3] * (1.f + sv[3]));
                *(uint2*)(XA + (size_t)row * DM + k) = o;
            }
        }
        ss = wave_sum(ss);
        if (lane < 16) rowss[(size_t)row * 16 + lane] = (lane == 0) ? ss : 0.f;
    }
}

namespace pg8 {
#define PG8_LAS __attribute__((address_space(3)))
typedef unsigned short bf16_t;
typedef short bf16x8 __attribute__((ext_vector_type(8)));
typedef float f32x4 __attribute__((ext_vector_type(4)));
typedef unsigned u32x4 __attribute__((ext_vector_type(4)));
constexpr int BM = 256, BK = 64, HALF = 128, HTB = HALF * BK * 2  , STAGE_BYTES = 8 * HTB, NXCD = 8, WGM = 8;

__host__ __device__ __forceinline__ int lds_byte(int r, int c) { const int st = (r >> 4) * 2 + (c >> 5), rr = r & 15, cc = c & 31, ob = rr * 64 + cc * 2; return st * 1024 + (ob ^ (((ob >> 9) & 1) << 5)); }
__host__ __device__ __forceinline__ void stage_rc(int b, int& R, int& C) { const int st = b / 1024, sb = b % 1024, swz = sb ^ (((sb >> 9) & 1) << 5); R = (st >> 1) * 16 + swz / 64; C = (st & 1) * 32 + (swz % 64) / 2; }
__host__ __device__ __forceinline__ int perm32(int rho) { const int n = rho >> 4, i = rho & 15; return 8 * (i >> 2) + 4 * n + (i & 3); }

struct Unit { int pm, pn; };
struct Gemm { const bf16_t* A; const bf16_t* Bt; int M, N, K; };

struct StaticOrder {
    int nM, nN, nwg, G, c;
    __host__ __device__ void init(int M, int N, int G_, int c_) { nM = M / BM; nN = N / BM; nwg = nM * nN; G = G_; c = c_; }
    __host__ __device__ bool next(int i, Unit& u) const {
        const long L = (long)i * G + c; if (L >= nwg) return false;
        int wgid = (int)L; { const int q = nwg / NXCD, r = nwg % NXCD, xcd = wgid % NXCD, off = wgid / NXCD; wgid = (xcd < r ? xcd * (q + 1) : r * (q + 1) + (xcd - r) * q) + off; }
        const int nig = WGM * nN, gid = wgid / nig, fm = gid * WGM, gsz = (nM - fm) < WGM ? (nM - fm) : WGM;
        u.pm = fm + ((wgid % nig) % gsz); u.pn = (wgid % nig) / gsz; return true;
    }
    __device__ __forceinline__ void a_ready(const Unit&) const {}
    __device__ __forceinline__ void done(const Unit&) const {}
};


__device__ __forceinline__ unsigned cvt_pk_bf16(float lo, float hi) { unsigned r; asm volatile("v_cvt_pk_bf16_f32 %0, %1, %2" : "=v"(r) : "v"(lo), "v"(hi)); return r; }
template <class Epi, class Sched, bool ALIGN_EPI = false, bool SP2 = false>
__device__ __forceinline__ void gemm_phase(PG8_LAS unsigned char* lds, const Gemm g, const Sched& S, const Epi& E) {
    const int tid = TID(), wid = __builtin_amdgcn_readfirstlane(tid >> 6), lane = tid & 63, wr = wid >> 2, wc = wid & 3, fr = lane & 15, fq = lane >> 4;
    const int K = g.K, nt = K / BK;
    unsigned voffA[2], voffB[2];
#pragma unroll
    for (int i = 0; i < 2; ++i) { int R, C; stage_rc(tid * 16 + i * 8192, R, C); const int Rb = Epi::PERM ? ((R & ~31) + perm32(R & 31)) : R;
        voffA[i] = (unsigned)(R * K + C) * 2u; voffB[i] = (unsigned)(Rb * K + C) * 2u; }
    const size_t kstep = (size_t)(BK * 2);
    const size_t hstep = (size_t)HALF * K * 2;
    const size_t tstep = 2 * hstep;
    const unsigned ldsw = (unsigned)wid * 1024u;
    const int aoff = lds_byte(wr * 64 + fr, fq * 8), boff = lds_byte(wc * 32 + fr, fq * 8);
#define PG8_SA(b, h) (((b) * 2 + (h)) * HTB)
#define PG8_SB(b, h) ((4 + (b) * 2 + (h)) * HTB)
#define PG8_STAGE(bufoff, gbase, voff) do { _Pragma("unroll") for (int _i = 0; _i < 2; ++_i) \
        __builtin_amdgcn_global_load_lds((const unsigned*)((const char*)(gbase) + (voff)[_i]), (PG8_LAS unsigned*)(lds + (bufoff) + ldsw + _i * 8192), 16, 0, 0); } while (0)
#define PG8_LDA(dst, b, h) do { _Pragma("unroll") for (int m = 0; m < 4; ++m) _Pragma("unroll") for (int k = 0; k < 2; ++k) dst[m][k] = *(const PG8_LAS bf16x8*)(lds + PG8_SA(b, h) + aoff + m * 2048 + k * 1024); } while (0)
#define PG8_LDB(dst, b, h) do { _Pragma("unroll") for (int n = 0; n < 2; ++n) _Pragma("unroll") for (int k = 0; k < 2; ++k) dst[n][k] = *(const PG8_LAS bf16x8*)(lds + PG8_SB(b, h) + boff + n * 2048 + k * 1024); } while (0)
#define PG8_MMA(ai, bj, At, Bt) do { __builtin_amdgcn_s_setprio(1); _Pragma("unroll") for (int m = 0; m < 4; ++m) _Pragma("unroll") for (int n = 0; n < 2; ++n) _Pragma("unroll") for (int k = 0; k < 2; ++k) \
        acc[ai][bj][m][n] = __builtin_amdgcn_mfma_f32_16x16x32_bf16(Bt[n][k], At[m][k], acc[ai][bj][m][n], 0, 0, 0); __builtin_amdgcn_s_setprio(0); } while (0)
#define PG8_WAIT_V(n) asm volatile("s_waitcnt vmcnt(" #n ")" ::: "memory")
#define PG8_WAIT_L(n) asm volatile("s_waitcnt lgkmcnt(" #n ")" ::: "memory")
#define PG8_BAR __builtin_amdgcn_s_barrier()
#define PG8_SCHED __builtin_amdgcn_sched_barrier(0)
    Unit cur, nxt; int ui = 0;
    if (!S.next(0, cur)) return;
    f32x4 acc[2][2][4][2];
#pragma unroll
    for (int a = 0; a < 2; ++a)
#pragma unroll
        for (int b = 0; b < 2; ++b)
#pragma unroll
            for (int m = 0; m < 4; ++m)
#pragma unroll
                for (int n = 0; n < 2; ++n) acc[a][b][m][n] = (f32x4){0.f, 0.f, 0.f, 0.f};
    bf16x8 At[4][2], B0[2][2], B1[2][2];
    const char* cA = (const char*)g.A + (size_t)cur.pm * tstep; const char* cB = (const char*)g.Bt + (size_t)cur.pn * tstep;
    S.a_ready(cur);
    if constexpr (SP2) {
        PG8_STAGE(PG8_SB(0, 0), cB, voffB); PG8_STAGE(PG8_SB(0, 1), cB + hstep, voffB); PG8_STAGE(PG8_SA(0, 0), cA, voffA); PG8_STAGE(PG8_SA(0, 1), cA + hstep, voffA);
        if (wr == 1) PG8_BAR;
        PG8_WAIT_V(2); PG8_BAR;
        PG8_STAGE(PG8_SB(1, 0), cB + kstep, voffB); PG8_STAGE(PG8_SA(1, 0), cA + kstep, voffA); PG8_STAGE(PG8_SB(1, 1), cB + hstep + kstep, voffB);
        PG8_WAIT_V(6); PG8_BAR;
    } else {
        PG8_STAGE(PG8_SB(0, 0), cB, voffB); PG8_STAGE(PG8_SA(0, 0), cA, voffA); PG8_STAGE(PG8_SB(0, 1), cB + hstep, voffB); PG8_STAGE(PG8_SA(0, 1), cA + hstep, voffA);
        if (wr == 1) PG8_BAR;
        PG8_WAIT_V(4); PG8_BAR;
        PG8_STAGE(PG8_SB(1, 0), cB + kstep, voffB); PG8_STAGE(PG8_SA(1, 0), cA + kstep, voffA); PG8_STAGE(PG8_SB(1, 1), cB + hstep + kstep, voffB);
        PG8_WAIT_V(6); PG8_BAR;
    }
    for (;;) {
        const bool has_next = S.next(ui + 1, nxt);
        const char* nA = has_next ? (const char*)g.A + (size_t)nxt.pm * tstep : cA; const char* nB = has_next ? (const char*)g.Bt + (size_t)nxt.pn * tstep : cB;
        for (int t = 0; t < nt; t += 2) {
            const bool last = (t == nt - 2);
            const char* a1 = cA + (size_t)(t + 1) * kstep;
            const char* a2 = last ? nA : cA + (size_t)(t + 2) * kstep; const char* b2 = last ? nB : cB + (size_t)(t + 2) * kstep;
            const char* a3 = a2 + kstep; const char* b3 = b2 + kstep;
            if (last && has_next) S.a_ready(nxt);
            if constexpr (SP2) {
            PG8_LDB(B0, 0, 0); PG8_LDB(B1, 0, 1); PG8_SCHED; PG8_LDA(At, 0, 0); PG8_STAGE(PG8_SA(1, 1), a1 + hstep, voffA);
            PG8_WAIT_V(8); PG8_WAIT_L(0); PG8_BAR; PG8_MMA(0, 0, At, B0); PG8_MMA(0, 1, At, B1); PG8_BAR; PG8_SCHED;
            PG8_LDA(At, 0, 1); PG8_STAGE(PG8_SB(0, 0), b2, voffB); PG8_STAGE(PG8_SB(0, 1), b2 + hstep, voffB); PG8_STAGE(PG8_SA(0, 0), a2, voffA);
            PG8_WAIT_V(8); PG8_WAIT_L(0); PG8_BAR; PG8_MMA(1, 0, At, B0); PG8_MMA(1, 1, At, B1); PG8_BAR; PG8_SCHED;
            PG8_LDB(B0, 1, 0); PG8_LDB(B1, 1, 1); PG8_SCHED; PG8_LDA(At, 1, 0); PG8_STAGE(PG8_SA(0, 1), a2 + hstep, voffA);
            PG8_WAIT_V(8); PG8_WAIT_L(0); PG8_BAR; PG8_MMA(0, 0, At, B0); PG8_MMA(0, 1, At, B1); PG8_BAR; PG8_SCHED;
            PG8_LDA(At, 1, 1); PG8_STAGE(PG8_SB(1, 0), b3, voffB); PG8_STAGE(PG8_SB(1, 1), b3 + hstep, voffB); PG8_STAGE(PG8_SA(1, 0), a3, voffA);
            PG8_WAIT_V(8); PG8_WAIT_L(0); PG8_BAR; PG8_MMA(1, 0, At, B0); PG8_MMA(1, 1, At, B1); PG8_BAR; PG8_SCHED;
            } else {
            PG8_LDB(B0, 0, 0); PG8_SCHED; PG8_LDA(At, 0, 0); PG8_STAGE(PG8_SA(1, 1), a1 + hstep, voffA);
            PG8_WAIT_L(8); PG8_BAR; PG8_WAIT_L(0); PG8_MMA(0, 0, At, B0); PG8_BAR; PG8_SCHED;
            PG8_LDB(B1, 0, 1); PG8_STAGE(PG8_SB(0, 0), b2, voffB);
            PG8_BAR; PG8_WAIT_L(0); PG8_MMA(0, 1, At, B1); PG8_BAR;
            PG8_LDA(At, 0, 1); PG8_STAGE(PG8_SA(0, 0), a2, voffA);
            PG8_BAR; PG8_WAIT_L(0); PG8_MMA(1, 0, At, B0); PG8_BAR; PG8_SCHED;
            PG8_STAGE(PG8_SB(0, 1), b2 + hstep, voffB);
            PG8_WAIT_V(6); PG8_BAR; PG8_MMA(1, 1, At, B1); PG8_BAR;
            PG8_LDB(B0, 1, 0); PG8_SCHED; PG8_LDA(At, 1, 0); PG8_STAGE(PG8_SA(0, 1), a2 + hstep, voffA);
            PG8_WAIT_L(8); PG8_BAR; PG8_WAIT_L(0); PG8_MMA(0, 0, At, B0); PG8_BAR; PG8_SCHED;
            PG8_LDB(B1, 1, 1); PG8_STAGE(PG8_SB(1, 0), b3, voffB);
            PG8_BAR; PG8_WAIT_L(0); PG8_MMA(0, 1, At, B1); PG8_BAR;
            PG8_LDA(At, 1, 1); PG8_STAGE(PG8_SA(1, 0), a3, voffA);
            PG8_BAR; PG8_WAIT_L(0); PG8_MMA(1, 0, At, B0); PG8_BAR; PG8_SCHED;
            PG8_STAGE(PG8_SB(1, 1), b3 + hstep, voffB);
            PG8_WAIT_V(6); PG8_BAR; PG8_MMA(1, 1, At, B1); PG8_BAR;
            }
        }
        if constexpr (ALIGN_EPI) { if (wr == 0) PG8_BAR; }
        if constexpr (!Epi::AFTER_DRAIN) { E(acc, cur, wr, wc, fr, fq); S.done(cur); }
        if (!has_next) break;
#pragma unroll
        for (int a = 0; a < 2; ++a)
#pragma unroll
            for (int b = 0; b < 2; ++b)
#pragma unroll
                for (int m = 0; m < 4; ++m)
#pragma unroll
                    for (int n = 0; n < 2; ++n) acc[a][b][m][n] = (f32x4){0.f, 0.f, 0.f, 0.f};
        cur = nxt; cA = nA; cB = nB; ++ui;
        if constexpr (ALIGN_EPI) { if (wr == 1) PG8_BAR; }
    }
    PG8_WAIT_V(0);
    if constexpr (!ALIGN_EPI) { if (wr == 0) PG8_BAR; }
    PG8_BAR;
    if constexpr (Epi::AFTER_DRAIN) { E.fused(acc, cur, wr, wc, fr, fq, lds, wid, lane); S.done(cur); }
#undef PG8_SA
#undef PG8_SB
#undef PG8_STAGE
#undef PG8_LDA
#undef PG8_LDB
#undef PG8_MMA
#undef PG8_WAIT_V
#undef PG8_WAIT_L
#undef PG8_BAR
#undef PG8_SCHED
}
}

#ifndef PG8_SP2
#define PG8_SP2 true
#endif
#ifndef PG8_ALIGN
#define PG8_ALIGN true
#endif

__device__ __forceinline__ float row_rstd16(const float* rowss, int row) {
    const f32x4* r = (const f32x4*)(rowss + (size_t)row * 16);
    const f32x4 a = r[0], b = r[1], c = r[2], d = r[3];
    const float s = ((a[0] + a[1]) + (a[2] + a[3])) + ((b[0] + b[1]) + (b[2] + b[3])) + ((c[0] + c[1]) + (c[2] + c[3])) + ((d[0] + d[1]) + (d[2] + d[3]));
    return rsqrtf(s * (1.f / DM) + EPS);
}
struct EpiProjF {
    static constexpr bool PERM = true, AFTER_DRAIN = false;
    const float* rowss; const float* cb; bf16_t* proj; float* side; const float* g_a; const float* g_b; const float* g_ds; const float* g_dw; LDSF float* xs  ;
    __device__ __forceinline__ void operator()(const pg8::f32x4 (&acc)[2][2][4][2], const pg8::Unit& u, int wr, int wc, int fr, int fq) const {
        const int b = u.pm >> 4, colt = u.pn * 256 + wc * 32 + 8 * fq;
        const int knmode = (u.pn == 1) ? 1 : (u.pn == 4) ? 2 : (u.pn == 10) ? 3 : (u.pn == 11) ? 4 : 0;
        f32x4 cv[2][2];
#pragma unroll
        for (int bj = 0; bj < 2; ++bj)
#pragma unroll
            for (int n = 0; n < 2; ++n) cv[bj][n] = *(const f32x4*)(cb + b * PINP + colt + bj * 128 + 4 * n);
        if (knmode != 0) {
#pragma unroll
            for (int ai = 0; ai < 2; ++ai)
#pragma unroll
                for (int m = 0; m < 4; ++m) {
                    const float rsm = row_rstd16(rowss, u.pm * 256 + ai * 128 + wr * 64 + m * 16 + fr);
#pragma unroll
                    for (int bj = 0; bj < 2; ++bj) {
                        const f32x4 v0 = acc[ai][bj][m][0] * rsm + cv[bj][0], v1 = acc[ai][bj][m][1] * rsm + cv[bj][1];
                        float ss = (v0[0] * v0[0] + v0[1] * v0[1]) + (v0[2] * v0[2] + v0[3] * v0[3]) + (v1[0] * v1[0] + v1[1] * v1[1]) + (v1[2] * v1[2] + v1[3] * v1[3]);
                        ss += __shfl_xor(ss, 16); ss += __shfl_xor(ss, 32);
                        if (fq == 0) xs[((wr * 4 + wc) * 16 + (ai * 4 + m) * 2 + bj) * 16 + fr] = ss;
                    }
                }
            asm volatile("s_waitcnt lgkmcnt(0)" ::: "memory"); __builtin_amdgcn_s_barrier(); asm volatile("" ::: "memory");
        }
#pragma unroll
        for (int ai = 0; ai < 2; ++ai)
#pragma unroll
            for (int m = 0; m < 4; ++m) {
                const int row = u.pm * 256 + ai * 128 + wr * 64 + m * 16 + fr; const float rs = row_rstd16(rowss, row);
#pragma unroll
                for (int bj = 0; bj < 2; ++bj) {
                    f32x4 v0 = acc[ai][bj][m][0] * rs + cv[bj][0], v1 = acc[ai][bj][m][1] * rs + cv[bj][1]; const int col0 = colt + bj * 128;
                    if (col0 >= C_BF && col0 < PIN) { *(f32x4*)(side + (size_t)row * 16 + (col0 - C_BF)) = v0; *(f32x4*)(side + (size_t)row * 16 + (col0 - C_BF) + 4) = v1; }
                    const bool on = (knmode == 1) || (knmode == 2) || (knmode == 3 && bj == 1 && wc < 2) || (knmode == 4 && bj == 0 && wc < 2);
                    if (on) {
                        const int xi = (ai * 4 + m) * 2 + bj;
                        float tot = xs[((wr * 4 + wc) * 16 + xi) * 16 + fr]; float dn = 1.f / 32.f;
                        if (knmode != 1) { tot += xs[((wr * 4 + (wc ^ 1)) * 16 + xi) * 16 + fr]; dn = 1.f / 64.f; }
                        const float nrm = rsqrtf(tot * dn + EPS);
                        const float* gp = (knmode == 1) ? g_a + 8 * fq : ((knmode == 2) ? g_b : (knmode == 3 ? g_ds : g_dw)) + (wc & 1) * 32 + 8 * fq;
                        v0 = v0 * nrm * *(const f32x4*)gp; v1 = v1 * nrm * *(const f32x4*)(gp + 4);
                    }
                    u32x4 w; w[0] = pg8::cvt_pk_bf16(v0[0], v0[1]); w[1] = pg8::cvt_pk_bf16(v0[2], v0[3]); w[2] = pg8::cvt_pk_bf16(v1[0], v1[1]); w[3] = pg8::cvt_pk_bf16(v1[2], v1[3]);
                    *(u32x4*)(proj + (size_t)row * PINP + col0) = w;
                }
            }
    }
};
struct EpiResF {
    static constexpr bool PERM = false, AFTER_DRAIN = false;
    const float* xin; float* xout; const float* gate; const float* g; const float* sc; bf16_t* xa; float* rowss;
    __device__ __forceinline__ void operator()(const pg8::f32x4 (&acc)[2][2][4][2], const pg8::Unit& u, int wr, int wc, int fr, int fq) const {
        const int b = u.pm >> 4, col0 = u.pn * 256 + wc * 32 + 4 * fq;
        f32x4 gt[2][2], gm[2][2];
#pragma unroll
        for (int bj = 0; bj < 2; ++bj)
#pragma unroll
            for (int n = 0; n < 2; ++n) { const int c = col0 + bj * 128 + n * 16; gt[bj][n] = *(const f32x4*)(gate + b * 6144 + c);
                if (xa) gm[bj][n] = *(const f32x4*)(g + c) * (*(const f32x4*)(sc + b * 6144 + c) + 1.0f); else gm[bj][n] = (f32x4){0.f, 0.f, 0.f, 0.f}; }
#pragma unroll
        for (int ai = 0; ai < 2; ++ai)
#pragma unroll
            for (int m = 0; m < 4; ++m) {
                const int row = u.pm * 256 + ai * 128 + wr * 64 + m * 16 + fr; float ss = 0.f;
#pragma unroll
                for (int bj = 0; bj < 2; ++bj)
#pragma unroll
                    for (int n = 0; n < 2; ++n) { const size_t off = (size_t)row * DM + col0 + bj * 128 + n * 16;
                        const f32x4 o = *(const f32x4*)(xin + off) + gt[bj][n] * acc[ai][bj][m][n];
                        *(f32x4*)(xout + off) = o; ss += (o[0] * o[0] + o[1] * o[1]) + (o[2] * o[2] + o[3] * o[3]);
                        if (xa) { const f32x4 q = o * gm[bj][n]; uint2 w; w.x = pg8::cvt_pk_bf16(q[0], q[1]); w.y = pg8::cvt_pk_bf16(q[2], q[3]); *(uint2*)(xa + off) = w; } }
                if (rowss) { ss += __shfl_xor(ss, 16); ss += __shfl_xor(ss, 32); if (fq == 0) rowss[(size_t)row * 16 + u.pn * 4 + wc] = ss; }
            }
    }
};


#define DPPF(oldv, src, CTRL) __builtin_bit_cast(float, __builtin_amdgcn_update_dpp(__builtin_bit_cast(int, (float)(oldv)), __builtin_bit_cast(int, (float)(src)), (CTRL), 0xf, 0xf, false))
struct EpiUpAct {
    static constexpr bool PERM = true, AFTER_DRAIN = false;
    const float* rowss; const float* cb; bf16_t* act; float* eg; float* ev; const float* cw; const float* cbias; LDSF float* xch; LDSF float* cst  ;
    __device__ __forceinline__ void operator()(const pg8::f32x4 (&acc)[2][2][4][2], const pg8::Unit& u, int wr, int wc, int fr, int fq) const {
        const int b = u.pm >> 4, cih = wc * 32 + 8 * fq, jcol = u.pn * 128 + cih;
        const float* cbg = cb + b * NUP + u.pn * 256 + cih; const float* cbv = cbg + 128;
        {
            const int tid = (wr * 4 + wc) * 64 + fq * 16 + fr, col = tid & 127, arr = tid >> 7;
            const float* src = (arr == 0) ? cb + b * NUP + u.pn * 256 + col : (arr == 1) ? cb + b * NUP + u.pn * 256 + 128 + col : cw + (arr - 2) * DFF + u.pn * 128 + col;
            cst[arr * 128 + col] = *src;
            if (tid < 256) { const int a2 = 4 + (tid >> 7); cst[a2 * 128 + col] = (a2 == 4) ? cw[2 * DFF + u.pn * 128 + col] : cbias[u.pn * 128 + col]; }
            else cst[768 + (tid - 256)] = row_rstd16(rowss, u.pm * 256 + (tid - 256));
            const f32x4 cg0 = *(const f32x4*)cbg, cg1 = *(const f32x4*)(cbg + 4);
#pragma unroll
            for (int ai = 0; ai < 2; ++ai) {
                const float r3 = row_rstd16(rowss, u.pm * 256 + ai * 128 + wr * 64 + 48 + fr);
                const f32x4 g0 = acc[ai][0][3][0] * r3 + cg0, g1 = acc[ai][0][3][1] * r3 + cg1;
                if (fr >= 14) { LDSF float* x = xch + ((((wr * 2 + ai) * 4 + wc) * 2 + (fr - 14)) * 32 + 8 * fq); *(LDSF f32x4*)x = g0; *(LDSF f32x4*)(x + 4) = g1;
                    if (wr == 1 && ai == 1) { float* e = eg + ((size_t)(u.pm * 4 + 2 + (fr - 14))) * DFF + jcol; *(f32x4*)e = g0; *(f32x4*)(e + 4) = g1; } }
            }
            if (wr == 0 && fr < 2) {
                const f32x4 cv0 = *(const f32x4*)cbv, cv1 = *(const f32x4*)(cbv + 4); const float r0 = row_rstd16(rowss, u.pm * 256 + fr);
                float* e = eg + ((size_t)(u.pm * 4 + fr)) * DFF + jcol; float* v = ev + ((size_t)(u.pm * 2 + fr)) * DFF + jcol;
                *(f32x4*)e = acc[0][0][0][0] * r0 + cg0; *(f32x4*)(e + 4) = acc[0][0][0][1] * r0 + cg1;
                *(f32x4*)v = acc[0][1][0][0] * r0 + cv0; *(f32x4*)(v + 4) = acc[0][1][0][1] * r0 + cv1;
            }
        }
        asm volatile("s_waitcnt vmcnt(0) lgkmcnt(0)" ::: "memory"); __builtin_amdgcn_s_barrier(); asm volatile("" ::: "memory");
#pragma unroll
        for (int ai = 0; ai < 2; ++ai) {
            f32x4 pvv[2];
            if (ai == 0 && wr == 0) { pvv[0] = (f32x4){0.f, 0.f, 0.f, 0.f}; pvv[1] = pvv[0]; }
            else { const int swr = (wr == 1) ? 0 : 1, sai = (wr == 1) ? ai : ai - 1;
                const LDSF float* x = xch + ((((swr * 2 + sai) * 4 + wc) * 2 + (fr & 1)) * 32 + 8 * fq); pvv[0] = *(const LDSF f32x4*)x; pvv[1] = *(const LDSF f32x4*)(x + 4); }
#pragma unroll
            for (int m = 0; m < 4; ++m) {
                asm volatile("" ::: "memory");
                const int row = u.pm * 256 + ai * 128 + wr * 64 + m * 16 + fr; const float rsm = cst[768 + ai * 128 + wr * 64 + m * 16 + fr];
                u32x4 w;
#pragma unroll
                for (int n = 0; n < 2; ++n) {
                    const LDSF float* cc = cst + cih + 4 * n;
                    const f32x4 cgn = *(const LDSF f32x4*)cc, cvn = *(const LDSF f32x4*)(cc + 128);
                    const f32x4 k0 = *(const LDSF f32x4*)(cc + 256), k1 = *(const LDSF f32x4*)(cc + 384), k2 = *(const LDSF f32x4*)(cc + 512), kb = *(const LDSF f32x4*)(cc + 640);
                    const f32x4 c = acc[ai][0][m][n] * rsm + cgn, v = acc[ai][1][m][n] * rsm + cvn; float o[4];
#pragma unroll
                    for (int i = 0; i < 4; ++i) {
                        const float gm1 = DPPF(DPPF(0.f, pvv[n][i], 0x121), c[i], 0x111);
                        const float gm2 = DPPF(DPPF(0.f, pvv[n][i], 0x122), c[i], 0x112);
                        const float cvv = k0[i] * gm2 + k1[i] * gm1 + k2[i] * c[i] + kb[i];
                        o[i] = cvv * __builtin_amdgcn_rcpf(1.f + __builtin_amdgcn_exp2f(-cvv * LOG2E)) * v[i];
                    }
                    w[2 * n] = pg8::cvt_pk_bf16(o[0], o[1]); w[2 * n + 1] = pg8::cvt_pk_bf16(o[2], o[3]);
                    pvv[n] = c;
                }
                *(u32x4*)(act + (size_t)row * DFF + jcol) = w;
            }
        }
    }
};
__device__ void act_fixup(const Params& p, int l, int pm) {
    if ((pm & 15) == 0) return;
    const float* eg = (const float*)(p.ws + WS_EG); const float* ev = (const float*)(p.ws + WS_EV); bf16_t* act = (bf16_t*)(p.ws + WS_ACT);
    const float* cw = p.conv_w + (size_t)l * 3 * DFF; const float* cbias = p.conv_b + (size_t)l * DFF;
    for (int idx = TID(); idx < 2 * DFF; idx += NTHR) {
        const int r = idx / DFF, j = idx - r * DFF;
        const float a = eg[((size_t)((pm - 1) * 4 + 2)) * DFF + j], bq = eg[((size_t)((pm - 1) * 4 + 3)) * DFF + j], c0 = eg[((size_t)(pm * 4 + 0)) * DFF + j], c1 = eg[((size_t)(pm * 4 + 1)) * DFF + j];
        const float gm2 = r ? bq : a, gm1 = r ? c0 : bq, gc = r ? c1 : c0;
        const float cvv = cw[j] * gm2 + cw[DFF + j] * gm1 + cw[2 * DFF + j] * gc + cbias[j];
        act[(size_t)(pm * 256 + r) * DFF + j] = f2bf(siluf(cvv) * ev[((size_t)(pm * 2 + r)) * DFF + j]);
    }
}

__device__ void ph_prep_knorm(const Params& p, int l) {
    bf16_t* proj = (bf16_t*)(p.ws + WS_PROJ);
    const int tid_ = TID(); const int lane = tid_ & 63, wv = tid_ >> 6;
    const int gw = blockIdx.x * (blockDim.x >> 6) + wv, ngw = gridDim.x * (blockDim.x >> 6);
    for (int row = gw; row < MTOK; row += ngw) {
        bf16_t* pr = proj + (size_t)row * PINP;
        {
            uint2 raw = *(const uint2*)(pr + CA_K + 4 * lane);
            float v0 = bf2f(raw.x & 0xffff), v1 = bf2f(raw.x >> 16), v2 = bf2f(raw.y & 0xffff), v3 = bf2f(raw.y >> 16);
            float ss = v0 * v0 + v1 * v1 + v2 * v2 + v3 * v3;
            ss += __shfl_xor(ss, 1); ss += __shfl_xor(ss, 2); ss += __shfl_xor(ss, 4);
            const float r = rsqrtf(ss * (1.f / 32.f) + EPS); const float* g = p.diff_kn + l * 32 + ((4 * lane) & 31);
            raw.x = pk2(v0 * r * g[0], v1 * r * g[1]); raw.y = pk2(v2 * r * g[2], v3 * r * g[3]);
            *(uint2*)(pr + CA_K + 4 * lane) = raw;
        }
        {
            uint2 raw = *(const uint2*)(pr + CB_K + 4 * lane);
            float v0 = bf2f(raw.x & 0xffff), v1 = bf2f(raw.x >> 16), v2 = bf2f(raw.y & 0xffff), v3 = bf2f(raw.y >> 16);
            float ss = v0 * v0 + v1 * v1 + v2 * v2 + v3 * v3;
            ss += __shfl_xor(ss, 1); ss += __shfl_xor(ss, 2); ss += __shfl_xor(ss, 4); ss += __shfl_xor(ss, 8);
            const float r = rsqrtf(ss * (1.f / 64.f) + EPS); const float* g = p.fox_kn + l * 64 + ((4 * lane) & 63);
            raw.x = pk2(v0 * r * g[0], v1 * r * g[1]); raw.y = pk2(v2 * r * g[2], v3 * r * g[3]);
            *(uint2*)(pr + CB_K + 4 * lane) = raw;
        }
        {
            const int hi = lane >> 5, li = lane & 31; bf16_t* q = pr + (hi ? CD_KW : CD_KS) + 2 * li;
            unsigned raw = *(const unsigned*)q; float v0 = bf2f(raw & 0xffff), v1 = bf2f(raw >> 16);
            float ss = v0 * v0 + v1 * v1;
            ss += __shfl_xor(ss, 1); ss += __shfl_xor(ss, 2); ss += __shfl_xor(ss, 4); ss += __shfl_xor(ss, 8); ss += __shfl_xor(ss, 16);
            const float r = rsqrtf(ss * (1.f / 64.f) + EPS); const float* g = p.nsa_kn + (l * 3 + (hi ? 2 : 1)) * 64 + 2 * li;
            *(unsigned*)q = pk2(v0 * r * g[0], v1 * r * g[1]);
        }
    }
}
__device__ void ph_prep_cum_bh(const Params& p, int l, int bh, unsigned char* lds) {
    const float* side = (const float*)(p.ws + WS_SIDE);
    float* cum = (float*)(p.ws + WS_CUM);
    LDSF float* wt = (LDSF float*)(lds + 70000);
    const int tid = TID(), lane = tid & 63, wv = tid >> 6;
    {
        const int b = bh >> 2, h = bh & 3; const float bf = p.fox_bf[l * 4 + h];
        float v[8]; float tot = 0.f;
#pragma unroll
        for (int i = 0; i < 8; ++i) { v[i] = logsigf(side[(size_t)(b * SEQ + tid * 8 + i) * 16 + h] + bf); tot += v[i]; v[i] = tot; }
        float inc = tot;
#pragma unroll
        for (int o = 1; o < 64; o <<= 1) { const float u = __shfl_up(inc, o); if (lane >= o) inc += u; }
        __syncthreads();
        if (lane == 63) wt[wv] = inc;
        __syncthreads();
        float base = inc - tot;
        for (int w8 = 0; w8 < wv; ++w8) base += wt[w8];
#pragma unroll
        for (int i = 0; i < 8; ++i) cum[bh * SEQ + tid * 8 + i] = base + v[i];
    }
}
__device__ void ph_prep_cmp(const Params& p, int l, unsigned char* lds) {
    const bf16_t* proj = (const bf16_t*)(p.ws + WS_PROJ);
    float* win = (float*)lds; float* red = (float*)(lds + 36864);
    const int tid = TID(), e = tid & 63, part = tid >> 6;
    for (int item = blockIdx.x; item < 4 * 2 * 32; item += gridDim.x) {
        const int b = item >> 6, which = (item >> 5) & 1, n0 = (item & 31) * 8;
        const int colbase = which ? CD_VC : CD_KC;
        __syncthreads();
        for (int i = tid; i < 144 * 64; i += NTHR) { const int tk = 16 * n0 + (i >> 6); win[i] = tk < SEQ ? bf2f(proj[(size_t)(b * SEQ + tk) * PINP + colbase + (i & 63)]) : 0.f; }
        __syncthreads();
        float acc[8];
#pragma unroll
        for (int nn = 0; nn < 8; ++nn) acc[nn] = 0.f;
        const float* phi = p.nsa_phi + (size_t)(l * 2 + which) * 2048 * 64; const float* pe = p.nsa_pe + (size_t)(l * 2 + which) * 32 * 64;
        for (int i = 4 * part; i < 4 * part + 4; ++i)
            for (int d = 0; d < 64; ++d) {
                const float ph = phi[(size_t)(i * 64 + d) * 64 + e], pv = pe[i * 64 + d];
#pragma unroll
                for (int nn = 0; nn < 8; ++nn) acc[nn] += (win[(16 * nn + i) * 64 + d] + pv) * ph;
            }
#pragma unroll
        for (int nn = 0; nn < 8; ++nn) red[(part * 8 + nn) * 64 + e] = acc[nn];
        __syncthreads();
        {
            const int nn = part, n = n0 + nn; float v = 0.f;
#pragma unroll
            for (int pp = 0; pp < 8; ++pp) v += red[(pp * 8 + nn) * 64 + e];
            bf16_t* dst = (bf16_t*)(p.ws + (which ? WS_VC : WS_KC)) + (size_t)(b * 256 + n) * 64 + e;
            if (n >= 255) *dst = 0;
            else if (which == 0) { const float ss = wave_sum(v * v); *dst = f2bf(v * rsqrtf(ss * (1.f / 64.f) + EPS) * p.nsa_kn[(l * 3 + 0) * 64 + e]); }
            else *dst = f2bf(v);
        }
    }
}

__device__ __forceinline__ void load8(const bf16_t* p, float* d) {
    const u32x4 r = *(const u32x4*)p;
    d[0] = bf2f(r[0] & 0xffff); d[1] = bf2f(r[0] >> 16); d[2] = bf2f(r[1] & 0xffff); d[3] = bf2f(r[1] >> 16);
    d[4] = bf2f(r[2] & 0xffff); d[5] = bf2f(r[2] >> 16); d[6] = bf2f(r[3] & 0xffff); d[7] = bf2f(r[3] >> 16);
}
template <int N> __device__ __forceinline__ float dotn(const float* q, const bf16_t* k) {
    float s = 0.f;
#pragma unroll
    for (int c = 0; c < N / 8; ++c) { float t[8]; load8(k + 8 * c, t);
#pragma unroll
        for (int j = 0; j < 8; ++j) s += q[8 * c + j] * t[j]; }
    return s;
}
template <int N> __device__ __forceinline__ void axpyn(float* o, float w, const bf16_t* v) {
#pragma unroll
    for (int c = 0; c < N / 8; ++c) { float t[8]; load8(v + 8 * c, t);
#pragma unroll
        for (int j = 0; j < 8; ++j) o[8 * c + j] += w * t[j]; }
}
template <int N> __device__ __forceinline__ void loadq_norm(float* q, const bf16_t* src, const float* g, float scale, bool norm) {
    float ss = 0.f;
#pragma unroll
    for (int c = 0; c < N / 8; ++c) load8(src + 8 * c, q + 8 * c);
#pragma unroll
    for (int j = 0; j < N; ++j) ss += q[j] * q[j];
    const float r = norm ? rsqrtf(ss * (1.f / N) + EPS) : 1.f;
#pragma unroll
    for (int j = 0; j < N; ++j) q[j] = q[j] * r * (norm ? g[j] : 1.f) * scale;
}
__device__ __forceinline__ void store64(bf16_t* dst, const float* o) {
#pragma unroll
    for (int c = 0; c < 8; ++c) { u32x4 w; w[0] = pk2(o[8 * c], o[8 * c + 1]); w[1] = pk2(o[8 * c + 2], o[8 * c + 3]); w[2] = pk2(o[8 * c + 4], o[8 * c + 5]); w[3] = pk2(o[8 * c + 6], o[8 * c + 7]); *(u32x4*)(dst + 8 * c) = w; }
}

typedef float f32x16 __attribute__((ext_vector_type(16)));
typedef short s16x4 __attribute__((ext_vector_type(4)));
#define LDSP __attribute__((address_space(3)))
constexpr int KSTR = 144;
constexpr int AL_KV = 17408;
constexpr int AL_BK = 2 * AL_KV  , AL_TB = AL_BK + 512  , AL_WSF = AL_TB + 512  , AL_MISC = AL_WSF + 2048  ,
              AL_IMP = 38912  , AL_SELM = AL_IMP + 65536  ,
              AL_TB4 = AL_SELM + 512  , AL_INVL = AL_TB4 + 2048  , AL_D_END = AL_INVL + 1024;
static_assert(AL_MISC + 64 <= AL_IMP && AL_D_END <= 131072, "attention LDS map");
__device__ __forceinline__ int crow(int r, int hi) { return (r & 3) + 8 * (r >> 2) + 4 * hi; }
__device__ __forceinline__ float ex2(float v) { return __builtin_amdgcn_exp2f(v); }
__device__ __forceinline__ s16x4 vtr(const LDSP unsigned char* p) { typedef short v4i16_t __attribute__((ext_vector_type(4))); return __builtin_bit_cast(s16x4, __builtin_amdgcn_ds_read_tr16_b64_v4i16((LDSP v4i16_t*)p)); }
__device__ __forceinline__ bf16x8 pack8(const f32x16& p, int b) {
    u32x4 w; w[0] = pg8::cvt_pk_bf16(p[b], p[b + 1]); w[1] = pg8::cvt_pk_bf16(p[b + 2], p[b + 3]); w[2] = pg8::cvt_pk_bf16(p[b + 4], p[b + 5]); w[3] = pg8::cvt_pk_bf16(p[b + 6], p[b + 7]);
    return __builtin_bit_cast(bf16x8, w);
}
__device__ __forceinline__ f32x16 splat16(float v) { return (f32x16){v, v, v, v, v, v, v, v, v, v, v, v, v, v, v, v}; }
template <int NK16>
__device__ __forceinline__ void qkt(f32x16& p0, f32x16& p1, const LDSP unsigned char* Kt, const bf16x8* qf, int dbase, int r32, int hi) {
    const LDSP unsigned char* kb = Kt + r32 * KSTR + hi * 16 + dbase * 32;
#pragma unroll
    for (int d0 = 0; d0 < NK16; ++d0) {
        const bf16x8 a0 = *(const LDSP bf16x8*)(kb + d0 * 32), a1 = *(const LDSP bf16x8*)(kb + 32 * KSTR + d0 * 32);
        p0 = __builtin_amdgcn_mfma_f32_32x32x16_bf16(a0, qf[d0], p0, 0, 0, 0);
        p1 = __builtin_amdgcn_mfma_f32_32x32x16_bf16(a1, qf[d0], p1, 0, 0, 0);
    }
}
__device__ __forceinline__ void pv(f32x16* o, const LDSP unsigned char* Vt, int vb, const f32x16& p0, const f32x16& p1) {
    bf16x8 pa[4]; pa[0] = pack8(p0, 0); pa[1] = pack8(p0, 8); pa[2] = pack8(p1, 0); pa[3] = pack8(p1, 8);
#pragma unroll
    for (int d0 = 0; d0 < 2; ++d0)
#pragma unroll
        for (int ks = 0; ks < 4; ++ks) {
            const s16x4 lo = vtr(Vt + vb + d0 * 4096 + ks * 1024), hh = vtr(Vt + vb + d0 * 4096 + ks * 1024 + 512);
            const bf16x8 vf = (bf16x8){lo[0], lo[1], lo[2], lo[3], hh[0], hh[1], hh[2], hh[3]};
            o[d0] = __builtin_amdgcn_mfma_f32_32x32x16_bf16(pa[ks], vf, o[d0], 0, 0, 0);
        }
}
__device__ __forceinline__ float exp_sum(f32x16& p0, f32x16& p1) {
    float s0 = 0.f, s1 = 0.f;
#pragma unroll
    for (int r = 0; r < 16; ++r) { p0[r] = ex2(p0[r]); p1[r] = ex2(p1[r]); s0 += p0[r]; s1 += p1[r]; }
    return s0 + s1;
}
__device__ __forceinline__ void scale_rows(f32x16* o, float f, LDSP float* wsf, int r32, int hi) {
    __builtin_amdgcn_wave_barrier();
    if (hi == 0) wsf[r32] = f;
    __builtin_amdgcn_s_waitcnt(0xc07f);
    __builtin_amdgcn_wave_barrier();
#pragma unroll
    for (int g = 0; g < 4; ++g) { const f32x4 a = *(const LDSP f32x4*)(wsf + 8 * g + 4 * hi);
#pragma unroll
        for (int i = 0; i < 4; ++i) { o[0][4 * g + i] *= a[i]; o[1][4 * g + i] *= a[i]; } }
    __builtin_amdgcn_wave_barrier();
}
__device__ __forceinline__ void store_o(const f32x16* o, LDSP bf16_t* stg, bf16_t* dst, int lane, int r32, int hi) {
    __builtin_amdgcn_wave_barrier();
#pragma unroll
    for (int r = 0; r < 16; ++r) { const int orow = crow(r, hi); stg[orow * 64 + r32] = f2bf(o[0][r]); stg[orow * 64 + 32 + r32] = f2bf(o[1][r]); }
    __builtin_amdgcn_s_waitcnt(0xc07f);
    __builtin_amdgcn_wave_barrier();
#pragma unroll
    for (int i = 0; i < 4; ++i) { const int row = i * 8 + (lane >> 3), ch = lane & 7; const u32x4 v = *(const LDSP u32x4*)(stg + row * 64 + ch * 8); *(u32x4*)(dst + (size_t)row * DM + ch * 8) = v; }
    __builtin_amdgcn_s_waitcnt(0xc07f);
    __builtin_amdgcn_wave_barrier();
}
template <int NG>
__device__ __forceinline__ void load_q(bf16x8* qf, const bf16_t* qrow  , const float* g, float sc, bool norm, int hi) {
    float v[4][8];
#pragma unroll
    for (int d0 = 0; d0 < 4; ++d0) load8(qrow + 16 * d0 + 8 * hi, v[d0]);
    float r0 = 1.f, r1 = 1.f;
    if (norm) {
        float s0 = 0.f, s1 = 0.f;
#pragma unroll
        for (int j = 0; j < 8; ++j) { s0 += v[0][j] * v[0][j] + v[1][j] * v[1][j]; s1 += v[2][j] * v[2][j] + v[3][j] * v[3][j]; }
        s0 += __shfl_xor(s0, 32); s1 += __shfl_xor(s1, 32);
        if (NG == 64) { r0 = rsqrtf((s0 + s1) * (1.f / 64.f) + EPS); r1 = r0; } else { r0 = rsqrtf(s0 * (1.f / 32.f) + EPS); r1 = rsqrtf(s1 * (1.f / 32.f) + EPS); }
    }
#pragma unroll
    for (int d0 = 0; d0 < 4; ++d0) {
        const float rr = (d0 < 2 ? r0 : r1) * sc; float w[8];
#pragma unroll
        for (int j = 0; j < 8; ++j) { const int d = 16 * d0 + 8 * hi + j; w[j] = v[d0][j] * rr * (norm ? g[d % NG] : 1.f); }
        u32x4 u; u[0] = pg8::cvt_pk_bf16(w[0], w[1]); u[1] = pg8::cvt_pk_bf16(w[2], w[3]); u[2] = pg8::cvt_pk_bf16(w[4], w[5]); u[3] = pg8::cvt_pk_bf16(w[6], w[7]);
        qf[d0] = __builtin_bit_cast(bf16x8, u);
    }
}
__device__ __forceinline__ void kv_load(u32x4& kr, u32x4& vr, const bf16_t* Kb, const bf16_t* Vb, int k0, int tid) {
    const size_t off = (size_t)(k0 + (tid >> 3)) * PINP + (tid & 7) * 8;
    kr = *(const u32x4*)(Kb + off); vr = *(const u32x4*)(Vb + off);
}
__device__ __forceinline__ void kv_load64(u32x4& kr, u32x4& vr, const bf16_t* Kb, const bf16_t* Vb, int n0, int tid) {
    const size_t off = (size_t)(n0 + (tid >> 3)) * 64 + (tid & 7) * 8;
    kr = *(const u32x4*)(Kb + off); vr = *(const u32x4*)(Vb + off);
}
__device__ __forceinline__ void kv_store(const u32x4& kr, const u32x4& vr, LDSP unsigned char* buf, int tid) {
    const int key = tid >> 3, ch = tid & 7;
    *(LDSP u32x4*)(buf + key * KSTR + ch * 16) = kr;
    *(LDSP u32x4*)(buf + 9216 + (ch >> 2) * 4096 + (key >> 4) * 1024 + ((key >> 3) & 1) * 512 + (key & 7) * 64 + (ch & 3) * 16) = vr;
}
template <int NG>
__device__ __forceinline__ void knorm_chunk(u32x4& kr, const float* gp  ) {
    float v[8];
    v[0] = bf2f(kr[0] & 0xffff); v[1] = bf2f(kr[0] >> 16); v[2] = bf2f(kr[1] & 0xffff); v[3] = bf2f(kr[1] >> 16);
    v[4] = bf2f(kr[2] & 0xffff); v[5] = bf2f(kr[2] >> 16); v[6] = bf2f(kr[3] & 0xffff); v[7] = bf2f(kr[3] >> 16);
    float ss = 0.f;
#pragma unroll
    for (int j = 0; j < 8; ++j) ss += v[j] * v[j];
    ss += __shfl_xor(ss, 1); ss += __shfl_xor(ss, 2); if (NG == 64) ss += __shfl_xor(ss, 4);
    const float r = rsqrtf(ss * (1.f / NG) + EPS);
    const f32x4 ga = *(const f32x4*)gp, gb = *(const f32x4*)(gp + 4);
    kr[0] = pg8::cvt_pk_bf16(v[0] * r * ga[0], v[1] * r * ga[1]); kr[1] = pg8::cvt_pk_bf16(v[2] * r * ga[2], v[3] * r * ga[3]);
    kr[2] = pg8::cvt_pk_bf16(v[4] * r * gb[0], v[5] * r * gb[1]); kr[3] = pg8::cvt_pk_bf16(v[6] * r * gb[2], v[7] * r * gb[3]);
}
__device__ __forceinline__ void bias_near(f32x16& p0, f32x16& p1, const LDSP float* tbl, int tk0  , int wnd, bool rowok, int hi) {
#pragma unroll
    for (int g = 0; g < 4; ++g) {
#pragma unroll
        for (int i = 0; i < 4; ++i) { const int r = 4 * g + i; const int d0_ = tk0 - crow(r, hi), d1_ = d0_ - 32;
            const float b0 = tbl[min(max(d0_, 0), 127)], b1 = tbl[min(max(d1_, 0), 127)];
            p0[r] = (d0_ < 0 || d0_ >= wnd || !rowok) ? -INFINITY : p0[r] + b0; p1[r] = (d1_ < 0 || d1_ >= wnd || !rowok) ? -INFINITY : p1[r] + b1; }
        asm volatile("" ::: "memory");
    }
}
#define KVBUF(L, i) ((L) + ((i) & 1) * AL_KV)

__device__ void fa_fox_unit(const Params& p, int l, int b, int h, int qb, LDSP unsigned char* L) {
    const int tid = TID(), lane = tid & 63, wid = __builtin_amdgcn_readfirstlane(tid >> 6), r32 = lane & 31, hi = lane >> 5;
    const bf16_t* proj = (const bf16_t*)(p.ws + WS_PROJ); bf16_t* mix = (bf16_t*)(p.ws + WS_MIX);
    const size_t rb = (size_t)b * SEQ; const int q0 = qb * 256, qw = q0 + 32 * wid, t = qw + r32;
    const bf16_t* Kb = proj + rb * PINP + CB_K + 64 * h; const bf16_t* Vb = proj + rb * PINP + CB_V + 64 * h;
    const float* cm = (const float*)(p.ws + WS_CUM) + (b * 4 + h) * SEQ;
    LDSP float* wsf = (LDSP float*)(L + AL_WSF) + wid * 64; LDSP float* bk = (LDSP float*)(L + AL_BK);
    const int vb = 9216 + ((lane >> 4) & 1) * 32 + (lane & 3) * 8 + (4 * hi + ((lane & 15) >> 2)) * 64;
    bf16x8 qf[4]; load_q<64>(qf, proj + (rb + t) * PINP + CB_Q + 64 * h, p.fox_qn + l * 64, 0.125f * LOG2E, true, hi);
    const float rowc = cm[t] * LOG2E - ((const float*)(p.ws + WS_BND))[l * 32 + 4];
    f32x16 o[2]; o[0] = (f32x16){}; o[1] = (f32x16){};
    float l_run = 0.f;
    const int NT = 4 * qb + 4, jd = 4 * qb + (wid >> 1);
    u32x4 kr, vr; float cr = 0.f; const float* gk = p.fox_kn + l * 64 + (tid & 7) * 8;
    int js;
    {   const bool live = (lane < NT) ? ((cm[q0] - cm[64 * lane + 63]) * LOG2E >= -160.f) : false;
        const unsigned long long bm = __ballot(live);
        js = __builtin_amdgcn_readfirstlane((int)__builtin_ctzll(bm | (1ull << (NT - 1)))); if (js > NT - 2) js = NT - 2; }
    __syncthreads();
    kv_load(kr, vr, Kb, Vb, 64 * js, tid); if (tid < 64) cr = cm[64 * js + tid];
    kv_store(kr, vr, KVBUF(L, js), tid); if (tid < 64) bk[(js & 1) * 64 + tid] = -cr * LOG2E;
    kv_load(kr, vr, Kb, Vb, 64 * (js + 1), tid); if (tid < 64) cr = cm[64 * (js + 1) + tid];
    for (int j = js; j < NT; ++j) {
        __syncthreads();
        if (j + 1 < NT) { kv_store(kr, vr, KVBUF(L, j + 1), tid); if (tid < 64) bk[((j + 1) & 1) * 64 + tid] = -cr * LOG2E; }
        if (j + 2 < NT) { kv_load(kr, vr, Kb, Vb, 64 * (j + 2), tid); if (tid < 64) cr = cm[64 * (j + 2) + tid]; }
        if (j <= jd) {
            const LDSP unsigned char* buf = KVBUF(L, j); const LDSP float* bkj = bk + (j & 1) * 64;
            f32x16 p0, p1;
#pragma unroll
            for (int g = 0; g < 4; ++g) { const f32x4 b0 = *(const LDSP f32x4*)(bkj + 8 * g + 4 * hi), b1 = *(const LDSP f32x4*)(bkj + 32 + 8 * g + 4 * hi);
#pragma unroll
                for (int i = 0; i < 4; ++i) { p0[4 * g + i] = b0[i] + rowc; p1[4 * g + i] = b1[i] + rowc; } }
            qkt<4>(p0, p1, buf, qf, 0, r32, hi);
            if (j == jd) { const int k0 = 64 * j;
#pragma unroll
                for (int r = 0; r < 16; ++r) { const int kk = k0 + crow(r, hi); if (kk > t) p0[r] = -INFINITY; if (kk + 32 > t) p1[r] = -INFINITY; } }
            l_run += exp_sum(p0, p1);
            pv(o, buf, vb, p0, p1);
        }
    }
    l_run += __shfl_xor(l_run, 32);
    scale_rows(o, 1.f / l_run, wsf, r32, hi);
    store_o(o, (LDSP bf16_t*)(L + AL_IMP + wid * 8192), mix + (rb + qw) * DM + 256 + 64 * h, lane, r32, hi);
}

__device__ void fa_diff_unit(const Params& p, int l, int b, int h, int qb, LDSP unsigned char* L) {
    const int tid = TID(), lane = tid & 63, wid = __builtin_amdgcn_readfirstlane(tid >> 6), r32 = lane & 31, hi = lane >> 5;
    const bf16_t* proj = (const bf16_t*)(p.ws + WS_PROJ); bf16_t* mix = (bf16_t*)(p.ws + WS_MIX);
    const size_t rb = (size_t)b * SEQ; const int q0 = qb * 256, qw = q0 + 32 * wid, t = qw + r32;
    const bf16_t* Kb = proj + rb * PINP + CA_K + 64 * h; const bf16_t* Vb = proj + rb * PINP + CA_V + 64 * h;
    LDSP float* wsf = (LDSP float*)(L + AL_WSF) + wid * 64; LDSP float* tbl = (LDSP float*)(L + AL_TB);
    const int vb = 9216 + ((lane >> 4) & 1) * 32 + (lane & 3) * 8 + (4 * hi + ((lane & 15) >> 2)) * 64;
    const float lam = ((const float*)(p.ws + WS_LAM))[l]; const float lam_init = 0.8f - 0.6f * __expf(-0.3f * (float)l);
    const float nbound = -((const float*)(p.ws + WS_BND))[l * 32 + h];
    __syncthreads();
    if (tid < 128) tbl[tid] = ((const float*)(p.ws + WS_TB))[h * 128 + tid] * LOG2E;
    bf16x8 qf[4]; load_q<32>(qf, proj + (rb + t) * PINP + CA_Q + 64 * h, p.diff_qn + l * 32, 0.17677669529663687f * LOG2E, true, hi);
    f32x16 o1[2], o2[2]; o1[0] = (f32x16){}; o1[1] = (f32x16){}; o2[0] = (f32x16){}; o2[1] = (f32x16){};
    float l1 = 0.f, l2 = 0.f;
    const int NT = 4 * qb + 4, jd = 4 * qb + (wid >> 1);
    u32x4 kr, vr; const float* gk = p.diff_kn + l * 32 + (tid & 3) * 8;
    kv_load(kr, vr, Kb, Vb, 0, tid);
    kv_store(kr, vr, KVBUF(L, 0), tid);
    kv_load(kr, vr, Kb, Vb, 64, tid);
    for (int j = 0; j < NT; ++j) {
        __syncthreads();
        if (j + 1 < NT) { kv_store(kr, vr, KVBUF(L, j + 1), tid); }
        if (j + 2 < NT) kv_load(kr, vr, Kb, Vb, 64 * (j + 2), tid);
        if (j <= jd) {
            const LDSP unsigned char* buf = KVBUF(L, j);
            const int k0 = 64 * j; const bool nearb = (qw - (k0 + 63)) < 113; const float cfar = tbl[127] + nbound;
#pragma unroll
            for (int mp = 0; mp < 2; ++mp) {
                f32x16 p0 = splat16(nearb ? nbound : cfar), p1 = p0;
                qkt<2>(p0, p1, buf, qf + 2 * mp, 2 * mp, r32, hi);
                if (nearb) bias_near(p0, p1, tbl, t - k0, 1 << 30, true, hi);
                if (mp == 0) { l1 += exp_sum(p0, p1); pv(o1, buf, vb, p0, p1); }
                else { l2 += exp_sum(p0, p1); pv(o2, buf, vb, p0, p1); }
            }
        }
    }
    l1 += __shfl_xor(l1, 32); l2 += __shfl_xor(l2, 32);
    scale_rows(o1, 1.f / l1, wsf, r32, hi); scale_rows(o2, lam / l2, wsf, r32, hi);
    o1[0] -= o2[0]; o1[1] -= o2[1];
    const float g0 = p.diff_sub[l * 64 + r32] * (1.f - lam_init), g1 = p.diff_sub[l * 64 + 32 + r32] * (1.f - lam_init);
#pragma unroll
    for (int r = 0; r < 16; ++r) {
        float ss = o1[0][r] * o1[0][r] + o1[1][r] * o1[1][r];
        ss += __shfl_xor(ss, 1); ss += __shfl_xor(ss, 2); ss += __shfl_xor(ss, 4); ss += __shfl_xor(ss, 8); ss += __shfl_xor(ss, 16);
        const float rs = rsqrtf(ss * (1.f / 64.f) + EPS); o1[0][r] *= rs * g0; o1[1][r] *= rs * g1;
    }
    store_o(o1, (LDSP bf16_t*)(L + AL_IMP + wid * 8192), mix + (rb + qw) * DM + 0 + 64 * h, lane, r32, hi);
}

template <bool DIAG>
__device__ __forceinline__ void stick_sub(f32x16& y, float& carry, int kbase  , int t, int hi) {
    float lk[16];
#pragma unroll
    for (int r = 0; r < 16; ++r) {
        const float v = y[r]; const float e = ex2(-fabsf(v)); const float lb = fminf(v, 0.f) - __builtin_amdgcn_logf(1.f + e);
        if (DIAG) { const bool valid = (kbase + crow(r, hi) < t); lk[r] = valid ? (lb - v) : 0.f; y[r] = valid ? lb : -INFINITY; }
        else { lk[r] = lb - v; y[r] = lb; }
    }
    float T[4], Go[4];
#pragma unroll
    for (int g = 0; g < 4; ++g) { const float Gs = (lk[4 * g] + lk[4 * g + 1]) + (lk[4 * g + 2] + lk[4 * g + 3]); Go[g] = __shfl_xor(Gs, 32); T[g] = Gs + Go[g]; }
    float sx = 0.f;
#pragma unroll
    for (int g = 3; g >= 0; --g) {
        float tail = carry + sx + (hi == 0 ? Go[g] : 0.f);
#pragma unroll
        for (int i = 3; i >= 0; --i) { y[4 * g + i] = ex2(y[4 * g + i] + tail); tail += lk[4 * g + i]; }
        sx += T[g];
    }
    carry += sx;
}
__device__ void fa_stick_unit(const Params& p, int l, int b, int h, int qb, LDSP unsigned char* L) {
    const int tid = TID(), lane = tid & 63, wid = __builtin_amdgcn_readfirstlane(tid >> 6), r32 = lane & 31, hi = lane >> 5;
    const bf16_t* proj = (const bf16_t*)(p.ws + WS_PROJ); bf16_t* mix = (bf16_t*)(p.ws + WS_MIX);
    const size_t rb = (size_t)b * SEQ; const int q0 = qb * 256, qw = q0 + 32 * wid, t = qw + r32;
    const bf16_t* Kb = proj + rb * PINP + CC_K + 64 * h; const bf16_t* Vb = proj + rb * PINP + CC_V + 64 * h;
    const int vb = 9216 + ((lane >> 4) & 1) * 32 + (lane & 3) * 8 + (4 * hi + ((lane & 15) >> 2)) * 64;
    bf16x8 qf[4]; load_q<64>(qf, proj + (rb + t) * PINP + CC_Q + 64 * h, nullptr, 0.125f * LOG2E, false, hi);
    f32x16 o[2]; o[0] = (f32x16){}; o[1] = (f32x16){};
    float carry = 0.f;
    const int NT = 4 * qb + 4, jd = 4 * qb + (wid >> 1);
    u32x4 kr, vr;
#define SBUF(i) (((i) & 1) ? (L + 108544) : L)
    LDSP unsigned* dn = (LDSP unsigned*)(L + AL_MISC) + 8;
    bool wdone = false;
    __syncthreads();
    if (lane == 0) dn[wid] = 0u;
    kv_load(kr, vr, Kb, Vb, 64 * (NT - 1), tid);
    kv_store(kr, vr, SBUF(NT - 1), tid);
    kv_load(kr, vr, Kb, Vb, 64 * (NT - 2), tid);
    for (int j = NT - 1; j >= 0; --j) {
        __syncthreads();
        if (__all(dn[lane & 7] != 0u)) break;
        if (j >= 1) kv_store(kr, vr, SBUF(j - 1), tid);
        if (j >= 2) kv_load(kr, vr, Kb, Vb, 64 * (j - 2), tid);
        if (j <= jd && !wdone) {
            const LDSP unsigned char* buf = SBUF(j);
            f32x16 p0 = (f32x16){}, p1 = (f32x16){};
            qkt<4>(p0, p1, buf, qf, 0, r32, hi);
            const int k0 = 64 * j; const bool diag = (j == jd);
            if (diag) { stick_sub<true>(p1, carry, k0 + 32, t, hi); stick_sub<true>(p0, carry, k0, t, hi); }
            else { stick_sub<false>(p1, carry, k0 + 32, t, hi); stick_sub<false>(p0, carry, k0, t, hi); }
            pv(o, buf, vb, p0, p1);
            if (__all(carry < -160.f)) { wdone = true; if (lane == 0) dn[wid] = 1u; }
        }
    }
    store_o(o, (LDSP bf16_t*)(L + AL_IMP + wid * 8192), mix + (rb + qw) * DM + 512 + 64 * h, lane, r32, hi);
}

__device__ void fa_nsa_unit(const Params& p, int l, int b, int u, LDSP unsigned char* L) {
    const int tid = TID(), lane = tid & 63, wid = __builtin_amdgcn_readfirstlane(tid >> 6), r32 = lane & 31, hi = lane >> 5;
    const int hh = wid >> 1, sub = wid & 1;
    const bf16_t* proj = (const bf16_t*)(p.ws + WS_PROJ); bf16_t* mix = (bf16_t*)(p.ws + WS_MIX);
    const size_t rb = (size_t)b * SEQ; const int q0 = 64 * u, qw = q0 + 32 * sub, t = qw + r32; const int ql = 32 * sub + r32;
    LDSP float* wsf = (LDSP float*)(L + AL_WSF) + wid * 64; LDSP float* tbl = (LDSP float*)(L + AL_TB4) + hh * 128;
    LDSP float* imp = (LDSP float*)(L + AL_IMP); LDSP unsigned* selm = (LDSP unsigned*)(L + AL_SELM); LDSP float* invl = (LDSP float*)(L + AL_INVL);
    LDSP float* ofl = (LDSP float*)(L + AL_IMP) + wid * 2048 + lane;
    const int vb = 9216 + ((lane >> 4) & 1) * 32 + (lane & 3) * 8 + (4 * hi + ((lane & 15) >> 2)) * 64;
    const float* bnd = (const float*)(p.ws + WS_BND) + l * 32;
    __syncthreads();
    ((LDSP float*)(L + AL_TB4))[tid] = ((const float*)(p.ws + WS_TB))[512 + tid] * LOG2E;
    bf16x8 qf[4]; load_q<64>(qf, proj + (rb + t) * PINP + CD_Q + 64 * hh, p.nsa_qn + l * 64, 0.125f * LOG2E, true, hi);
    const float* sd = (const float*)(p.ws + WS_SIDE) + (rb + t) * 16 + 4 + hh;
    const float gc = 1.f / (1.f + __expf(-sd[0])), gs = 1.f / (1.f + __expf(-sd[4])), gwn = 1.f / (1.f + __expf(-sd[8]));
    f32x16 o[2]; o[0] = (f32x16){}; o[1] = (f32x16){};
    u32x4 kr, vr;
    {
        const bf16_t* Kc = (const bf16_t*)(p.ws + WS_KC) + (size_t)b * 256 * 64; const bf16_t* Vc = (const bf16_t*)(p.ws + WS_VC) + (size_t)b * 256 * 64;
        const int ntc = (4 * u + 2) / 64 + 1; const float nbound = -bnd[5 + hh];
        float l_run = 0.f, prevE3 = 0.f;
        kv_load64(kr, vr, Kc, Vc, 0, tid);
        kv_store(kr, vr, KVBUF(L, 0), tid);
        if (ntc > 1) kv_load64(kr, vr, Kc, Vc, 64, tid);
        for (int T = 0; T < ntc; ++T) {
            __syncthreads();
            if (T + 1 < ntc) kv_store(kr, vr, KVBUF(L, T + 1), tid);
            if (T + 2 < ntc) kv_load64(kr, vr, Kc, Vc, 64 * (T + 2), tid);
            const LDSP unsigned char* buf = KVBUF(L, T);
            f32x16 p0 = splat16(nbound), p1 = p0;
            qkt<4>(p0, p1, buf, qf, 0, r32, hi);
#pragma unroll
            for (int g = 0; g < 4; ++g) {
#pragma unroll
                for (int i = 0; i < 4; ++i) { const int r = 4 * g + i; const int d0_ = t - 16 * (64 * T + crow(r, hi)) - 31, d1_ = d0_ - 512;
                    const float b0 = tbl[min(max(d0_, 0), 127)], b1 = tbl[min(max(d1_, 0), 127)];
                    p0[r] = (d0_ < 0) ? -INFINITY : p0[r] + b0; p1[r] = (d1_ < 0) ? -INFINITY : p1[r] + b1; }
                asm volatile("" ::: "memory");
            }
            l_run += exp_sum(p0, p1);
#pragma unroll
            for (int s2 = 0; s2 < 2; ++s2) {
                float G[4], Eo[4];
#pragma unroll
                for (int g = 0; g < 4; ++g) { const float a0 = s2 ? p1[4 * g] : p0[4 * g], a1 = s2 ? p1[4 * g + 1] : p0[4 * g + 1], a2 = s2 ? p1[4 * g + 2] : p0[4 * g + 2], a3 = s2 ? p1[4 * g + 3] : p0[4 * g + 3];
                    G[g] = (a0 + a1) + (a2 + a3); Eo[g] = __shfl_xor(a3, 32); }
#pragma unroll
                for (int g = 0; g < 4; ++g) { const float eprev = hi ? Eo[g] : (g > 0 ? Eo[g - 1] : prevE3);
                    imp[(hh * 64 + ql) * 64 + 16 * T + 8 * s2 + 2 * g + hi] = G[g] + eprev; }
                prevE3 = Eo[3];
            }
            pv(o, buf, vb, p0, p1);
        }
        l_run += __shfl_xor(l_run, 32);
        const float inv = (l_run > 0.f) ? 1.f / l_run : 0.f;
        if (hi == 0) invl[hh * 64 + ql] = inv;
        scale_rows(o, gc * inv, wsf, r32, hi);
    }
    __syncthreads();
    {
        const int q = tid >> 3, part = tid & 7;
        const float i0 = invl[q], i1 = invl[64 + q], i2 = invl[128 + q], i3 = invl[192 + q];
        float vj[8];
#pragma unroll
        for (int jj = 0; jj < 8; ++jj) { const int j = part * 8 + jj;
            const float sum = ((imp[(0 * 64 + q) * 64 + j] * i0 + imp[(1 * 64 + q) * 64 + j] * i1) + imp[(2 * 64 + q) * 64 + j] * i2) + imp[(3 * 64 + q) * 64 + j] * i3;
            vj[jj] = (j > u) ? -1.0f : ((j == u || j == 0) ? 1.0e4f : sum); }
        __syncthreads();
#pragma unroll
        for (int jj = 0; jj < 8; ++jj) imp[q * 64 + part * 8 + jj] = vj[jj];
        __syncthreads();
        int rank[8];
#pragma unroll
        for (int jj = 0; jj < 8; ++jj) rank[jj] = 0;
        for (int i = 0; i < 64; ++i) { const float vi = imp[q * 64 + i];
#pragma unroll
            for (int jj = 0; jj < 8; ++jj) rank[jj] += (vi > vj[jj] || (vi == vj[jj] && i < part * 8 + jj)) ? 1 : 0; }
        unsigned bits = 0;
#pragma unroll
        for (int jj = 0; jj < 8; ++jj) if (rank[jj] < 16 && (part * 8 + jj) <= u) bits |= 1u << jj;
        unsigned mlo = (part < 4) ? (bits << (8 * part)) : 0u, mhi = (part >= 4) ? (bits << (8 * (part - 4))) : 0u;
        mlo |= __shfl_xor(mlo, 1); mhi |= __shfl_xor(mhi, 1); mlo |= __shfl_xor(mlo, 2); mhi |= __shfl_xor(mhi, 2); mlo |= __shfl_xor(mlo, 4); mhi |= __shfl_xor(mhi, 4);
        if (part == 0) { selm[2 * q] = mlo; selm[2 * q + 1] = mhi; }
    }
    __syncthreads();
#pragma unroll
    for (int r = 0; r < 16; ++r) { ofl[(2 * r) * 64] = o[0][r]; ofl[(2 * r + 1) * 64] = o[1][r]; }
    o[0] = (f32x16){}; o[1] = (f32x16){};
    {
        const unsigned long long mymask = (unsigned long long)selm[2 * ql] | ((unsigned long long)selm[2 * ql + 1] << 32);
        unsigned ulo = selm[2 * lane], uhi = selm[2 * lane + 1];
#pragma unroll
        for (int s2 = 1; s2 < 64; s2 <<= 1) { ulo |= __shfl_xor(ulo, s2); uhi |= __shfl_xor(uhi, s2); }
        unsigned long long um = (unsigned long long)(unsigned)__builtin_amdgcn_readfirstlane((int)ulo) | ((unsigned long long)(unsigned)__builtin_amdgcn_readfirstlane((int)uhi) << 32);
        const bf16_t* Kb = proj + rb * PINP + CD_KS; const bf16_t* Vb = proj + rb * PINP + CD_VS;
        float l_run = 0.f; const float nbound = -bnd[9 + hh]; const float cfar = tbl[127] + nbound; const float* gk = p.nsa_kn + (l * 3 + 1) * 64 + (tid & 7) * 8;
        int j = __builtin_ctzll(um); um &= um - 1;
        int jn = um ? __builtin_ctzll(um) : -1; um &= um - 1;
        kv_load(kr, vr, Kb, Vb, 64 * j, tid);
        kv_store(kr, vr, KVBUF(L, 0), tid);
        if (jn >= 0) kv_load(kr, vr, Kb, Vb, 64 * jn, tid);
        for (int it = 0;; ++it) {
            __syncthreads();
            const int jnn = um ? __builtin_ctzll(um) : -1; um &= um - 1;
            if (jn >= 0) { kv_store(kr, vr, KVBUF(L, it + 1), tid); }
            if (jnn >= 0) kv_load(kr, vr, Kb, Vb, 64 * jnn, tid);
            const bool mine = (mymask >> j) & 1ull;
            if (__any(mine)) {
                const LDSP unsigned char* buf = KVBUF(L, it);
                const int k0 = 64 * j; const bool nearb = (qw - (k0 + 63)) < 113;
                f32x16 p0 = splat16(nearb ? nbound : (mine ? cfar : -INFINITY)), p1 = p0;
                qkt<4>(p0, p1, buf, qf, 0, r32, hi);
                if (nearb) bias_near(p0, p1, tbl, t - k0, 1 << 30, mine, hi);
                l_run += exp_sum(p0, p1);
                pv(o, buf, vb, p0, p1);
            }
            if (jn < 0) break;
            j = jn; jn = jnn;
        }
        l_run += __shfl_xor(l_run, 32);
        scale_rows(o, gs / l_run, wsf, r32, hi);
#pragma unroll
        for (int r = 0; r < 16; ++r) { ofl[(2 * r) * 64] += o[0][r]; ofl[(2 * r + 1) * 64] += o[1][r]; }
        o[0] = (f32x16){}; o[1] = (f32x16){};
    }
    {
        const bf16_t* Kb = proj + rb * PINP + CD_KW; const bf16_t* Vb = proj + rb * PINP + CD_VW;
        float l_run = 0.f; const float nbound = -bnd[13 + hh]; const float cfar = tbl[127] + nbound; const float* gk = p.nsa_kn + (l * 3 + 2) * 64 + (tid & 7) * 8;
        const int jlo = max(0, u - 8);
        __syncthreads();
        kv_load(kr, vr, Kb, Vb, 64 * jlo, tid);
        kv_store(kr, vr, KVBUF(L, jlo), tid);
        if (jlo < u) kv_load(kr, vr, Kb, Vb, 64 * (jlo + 1), tid);
        for (int j = jlo; j <= u; ++j) {
            __syncthreads();
            if (j + 1 <= u) { kv_store(kr, vr, KVBUF(L, j + 1), tid); }
            if (j + 2 <= u) kv_load(kr, vr, Kb, Vb, 64 * (j + 2), tid);
            const LDSP unsigned char* buf = KVBUF(L, j);
            const int k0 = 64 * j; const bool nearb = (j == u || j == u - 8 || (qw - (k0 + 63)) < 113);
            f32x16 p0 = splat16(nearb ? nbound : cfar), p1 = p0;
            qkt<4>(p0, p1, buf, qf, 0, r32, hi);
            if (nearb) bias_near(p0, p1, tbl, t - k0, 512, true, hi);
            l_run += exp_sum(p0, p1);
            pv(o, buf, vb, p0, p1);
        }
        l_run += __shfl_xor(l_run, 32);
        scale_rows(o, gwn / l_run, wsf, r32, hi);
#pragma unroll
        for (int r = 0; r < 16; ++r) { o[0][r] += ofl[(2 * r) * 64]; o[1][r] += ofl[(2 * r + 1) * 64]; }
    }
    store_o(o, (LDSP bf16_t*)(L + AL_IMP + wid * 8192), mix + (rb + qw) * DM + 768 + 64 * hh, lane, r32, hi);
}

__device__ void ph_reset_queues(const Params& p) { unsigned* ctl = (unsigned*)(p.ws + WS_CTL); const int gt = GTID(); if (gt < 8) ctl[gt] = 0u; }
__device__ void prep_cmp_task(const Params& p, int l, int task, LDSP unsigned char* L) {
    const int tid = TID(), lane = tid & 63, wid = __builtin_amdgcn_readfirstlane(tid >> 6), r32 = lane & 31, hi = lane >> 5;
    const int b = task >> 4, which = (task >> 3) & 1, nt = task & 7;
    const bf16_t* proj = (const bf16_t*)(p.ws + WS_PROJ);
    const bf16_t* phiT = (const bf16_t*)(p.ws + WS_PHIT) + (size_t)(l * 2 + which) * 64 * 2048;
    const float* pe = p.nsa_pe + (size_t)(l * 2 + which) * 32 * 64;
    const int n = 32 * nt + r32, colbase = which ? CD_VC : CD_KC;
    f32x16 acc0 = (f32x16){}, acc1 = (f32x16){};
#pragma unroll
    for (int ii = 0; ii < 4; ++ii) {
        const int i = 4 * wid + ii; const int tok = min(16 * n + i, SEQ - 1);
        const bf16_t* xr = proj + (size_t)(b * SEQ + tok) * PINP + colbase;
#pragma unroll
        for (int d0 = 0; d0 < 4; ++d0) {
            float xv[8]; load8(xr + 16 * d0 + 8 * hi, xv);
            const f32x4 pe0 = *(const f32x4*)(pe + i * 64 + 16 * d0 + 8 * hi), pe1 = *(const f32x4*)(pe + i * 64 + 16 * d0 + 8 * hi + 4);
            u32x4 aw; aw[0] = pg8::cvt_pk_bf16(xv[0] + pe0[0], xv[1] + pe0[1]); aw[1] = pg8::cvt_pk_bf16(xv[2] + pe0[2], xv[3] + pe0[3]);
            aw[2] = pg8::cvt_pk_bf16(xv[4] + pe1[0], xv[5] + pe1[1]); aw[3] = pg8::cvt_pk_bf16(xv[6] + pe1[2], xv[7] + pe1[3]);
            const bf16x8 af = __builtin_bit_cast(bf16x8, aw);
            const bf16x8 b0 = *(const bf16x8*)(phiT + (size_t)r32 * 2048 + i * 64 + 16 * d0 + 8 * hi);
            const bf16x8 b1 = *(const bf16x8*)(phiT + (size_t)(32 + r32) * 2048 + i * 64 + 16 * d0 + 8 * hi);
            acc0 = __builtin_amdgcn_mfma_f32_32x32x16_bf16(af, b0, acc0, 0, 0, 0);
            acc1 = __builtin_amdgcn_mfma_f32_32x32x16_bf16(af, b1, acc1, 0, 0, 0);
        }
    }
    LDSP float* red = (LDSP float*)L;
    __syncthreads();
#pragma unroll
    for (int r = 0; r < 16; ++r) { red[(wid * 32 + crow(r, hi)) * 64 + r32] = acc0[r]; red[(wid * 32 + crow(r, hi)) * 64 + 32 + r32] = acc1[r]; }
    __syncthreads();
    {
        const int row = tid >> 4, e4 = (tid & 15) * 4; f32x4 v = (f32x4){0.f, 0.f, 0.f, 0.f};
#pragma unroll
        for (int w8 = 0; w8 < 8; ++w8) v += *(const LDSP f32x4*)(red + (w8 * 32 + row) * 64 + e4);
        const int nn = 32 * nt + row;
        if (which == 0) {
            float ss = (v[0] * v[0] + v[1] * v[1]) + (v[2] * v[2] + v[3] * v[3]);
            ss += __shfl_xor(ss, 1); ss += __shfl_xor(ss, 2); ss += __shfl_xor(ss, 4); ss += __shfl_xor(ss, 8);
            const float rs = rsqrtf(ss * (1.f / 64.f) + EPS); const f32x4 g = *(const f32x4*)(p.nsa_kn + (l * 3 + 0) * 64 + e4);
            v = v * rs * g;
        }
        uint2 o; o.x = pk2(v[0], v[1]); o.y = pk2(v[2], v[3]);
        if (nn >= 255) { o.x = 0u; o.y = 0u; }
        *(uint2*)((bf16_t*)(p.ws + (which ? WS_VC : WS_KC)) + (size_t)(b * 256 + nn) * 64 + e4) = o;
    }
}
__device__ void ph_prep(const Params& p, int l, LDSP unsigned char* L, unsigned char* lds) {
    for (int t = blockIdx.x; t < 80; t += gridDim.x) { if (t < 64) prep_cmp_task(p, l, t, L); }
    if (gridDim.x >= 80) { if (blockIdx.x >= 64 && blockIdx.x < 80) ph_prep_cum_bh(p, l, blockIdx.x - 64, lds); }
    else for (int bh = blockIdx.x; bh < 16; bh += gridDim.x) ph_prep_cum_bh(p, l, bh, lds);
}


__device__ void fa_phase_all(const Params& p, int l, LDSP unsigned char* L, unsigned char* lds, int qslot) {
    unsigned* ctl = (unsigned*)(p.ws + WS_CTL);
    LDSP unsigned* misc = (LDSP unsigned*)(L + AL_MISC);
    bool prep_ok = false;
    for (;;) {
        __syncthreads();
        if (threadIdx.x == 0) misc[0] = atomicAdd(&ctl[qslot], 1u);
        __syncthreads();
        const unsigned qi0 = misc[0];
        if (qi0 >= 1104u) break;
        if (qi0 < 80u) {
            if (qi0 < 64u) prep_cmp_task(p, l, (int)qi0, L); else ph_prep_cum_bh(p, l, (int)qi0 - 64, lds);
            asm volatile("s_waitcnt vmcnt(0)" ::: "memory");
            __syncthreads();
            if (threadIdx.x == 0) { __threadfence(); atomicAdd(&ctl[4 + qslot], 1u); }
            continue;
        }
        const unsigned qi = qi0 - 80u;
        const int r = 15 - (int)(qi >> 6), j = (int)(qi & 63), typ = j >> 4, sub = j & 15;
        if ((typ == 2 || typ == 3) && !prep_ok) {
            if (threadIdx.x == 0) { while (__hip_atomic_load(&ctl[4 + qslot], __ATOMIC_RELAXED, __HIP_MEMORY_SCOPE_AGENT) < 80u) __builtin_amdgcn_s_sleep(8); __threadfence(); }
            asm volatile("s_waitcnt vmcnt(0)" ::: "memory");
            __syncthreads();
            prep_ok = true;
        }
        if (typ == 0) fa_diff_unit(p, l, sub >> 2, sub & 3, r, L);
        else if (typ == 1) fa_stick_unit(p, l, sub >> 2, sub & 3, r, L);
        else if (typ == 2) fa_fox_unit(p, l, sub >> 2, sub & 3, r, L);
        else fa_nsa_unit(p, l, sub >> 2, 4 * r + (sub & 3), L);
    }
}

#define XB_TMO      128
#define XB_XCNT(j)  (256  + 64 * (j))
#define XB_XSUB(j)  (1280 + 64 * (j))
#define XB_XGEN(j)  (2304 + 64 * (j))
#define XB_TOP      3328
#define XB_TOPGEN   3392
#define XCD_BAR_WORDS 3456
#define XB_SPIN_CAP (1u << 18)

__device__ __forceinline__ unsigned xb_ld(unsigned* p)              { return __hip_atomic_load(p, __ATOMIC_RELAXED, __HIP_MEMORY_SCOPE_AGENT); }
__device__ __forceinline__ unsigned xb_add(unsigned* p, unsigned v) { return __hip_atomic_fetch_add(p, v, __ATOMIC_RELAXED, __HIP_MEMORY_SCOPE_AGENT); }
__device__ __forceinline__ unsigned xb_xcc_id() { return (unsigned)__builtin_amdgcn_s_getreg((3 << 11) | 20) & 0xFu; }
#define XB_SPIN(cond, bar) do { unsigned _sp = 0; while (cond) { __builtin_amdgcn_s_sleep(1); \
    if ((++_sp & 255u) == 0u) { if (xb_ld(&(bar)[XB_TMO])) break; if (_sp > XB_SPIN_CAP) { atomicAdd(&(bar)[XB_TMO], 1u); break; } } } } while (0)

struct XcdBarrier {
    unsigned* bar; unsigned x;
    volatile LDSF unsigned* st;
};

__device__ __forceinline__ XcdBarrier xcd_barrier_post(unsigned* bar, volatile LDSF unsigned* st) {
    XcdBarrier b; b.bar = bar; b.x = xb_xcc_id(); b.st = st;
    if (threadIdx.x == 0) (void)xb_add(&bar[XB_XCNT(b.x)], 1u);
    return b;
}
__device__ __forceinline__ void xcd_barrier_complete(unsigned* bar, unsigned x, unsigned& nloc, unsigned& nx) {
    const unsigned G = gridDim.x * gridDim.y * gridDim.z;
    unsigned sum, cnt, mine, sp = 0u;
    for (;;) {
        sum = 0u; cnt = 0u; mine = 0u;
#pragma unroll
        for (unsigned j = 0; j < 16; ++j) { const unsigned c = xb_ld(&bar[XB_XCNT(j)]); sum += c; cnt += (c > 0u) ? 1u : 0u; mine = (j == x) ? c : mine; }
        if (sum == G) break;
        __builtin_amdgcn_s_sleep(1);
        if ((++sp & 255u) == 0u) { if (xb_ld(&bar[XB_TMO])) break; if (sp > XB_SPIN_CAP) { atomicAdd(&bar[XB_TMO], 1u); break; } }
    }
    nloc = mine > 0u ? mine : 1u; nx = cnt > 0u ? cnt : 1u;
}

__device__ __forceinline__ void xcd_barrier(const XcdBarrier& b) {
    asm volatile("s_waitcnt vmcnt(0)" ::: "memory");
    __syncthreads();
    if (threadIdx.x == 0) {
        unsigned* bar = b.bar;
        __builtin_amdgcn_s_waitcnt(0);
        unsigned nloc = b.st[0], nx = b.st[1];
        if (nloc == 0u) { xcd_barrier_complete(bar, b.x, nloc, nx); b.st[0] = nloc; b.st[1] = nx; }
        const unsigned old = xb_add(&bar[XB_XSUB(b.x)], 1u);
        const unsigned gen = old / nloc;
        if (old + 1u == (gen + 1u) * nloc) {
            __builtin_amdgcn_fence(__ATOMIC_RELEASE, "agent");
            asm volatile("s_waitcnt vmcnt(0)" ::: "memory");
            const unsigned og = xb_add(&bar[XB_TOP], 1u);
            const unsigned tg = og / nx;
            if (og + 1u == (tg + 1u) * nx) xb_add(&bar[XB_TOPGEN], 1u);
            else XB_SPIN(xb_ld(&bar[XB_TOPGEN]) == tg, bar);
            __builtin_amdgcn_fence(__ATOMIC_ACQUIRE, "agent");
            xb_add(&bar[XB_XGEN(b.x)], 1u);
            asm volatile("s_waitcnt vmcnt(0)" ::: "memory");
        } else {
            XB_SPIN(xb_ld(&bar[XB_XGEN(b.x)]) == gen, bar);
            __builtin_amdgcn_fence(__ATOMIC_ACQUIRE, "agent");
            asm volatile("s_waitcnt vmcnt(0)" ::: "memory");
        }
    }
    __syncthreads();
}

namespace cg = cooperative_groups;
constexpr int LDS_BYTES = 131072 + 8192 + 4096;
#define LAS3 __attribute__((address_space(3)))
#ifndef PROBE
#define PROBE 0
#endif
__global__ void __launch_bounds__(NTHR, 2) mega(Params p) {
    extern __shared__ __attribute__((aligned(16))) unsigned char lds[];
    cg::grid_group grid = cg::this_grid();
#if PROBE
    unsigned long long tacc = 0, tph = 0, t0_;
#define GSYNC() do { t0_ = __builtin_amdgcn_s_memrealtime(); xcd_barrier(xbar); tacc += __builtin_amdgcn_s_memrealtime() - t0_; } while (0)
#define TPK(k, ...) do { if (PROBE == (k)) { t0_ = __builtin_amdgcn_s_memrealtime(); __VA_ARGS__; tph += __builtin_amdgcn_s_memrealtime() - t0_; } else { __VA_ARGS__; } } while (0)
#else
#define GSYNC() xcd_barrier(xbar)
#define TPK(k, ...) do { __VA_ARGS__; } while (0)
#endif
    LAS3 unsigned char* lds3 = (LAS3 unsigned char*)lds;
    volatile LDSF unsigned* bst = (volatile LDSF unsigned*)(lds3 + 131072 + 2048);
    if (threadIdx.x < 2) bst[threadIdx.x] = 0u;
    __syncthreads();
    XcdBarrier xbar = xcd_barrier_post((unsigned*)(p.ws + WS_CTL) + 16384, bst);
    TPK(2, ph_mod(p, lds); ph_reset_queues(p); ph_weights(p, 0, lds); ph_weights(p, 1, lds));
    grid.sync();
    for (int l = 0; l < DEPTH; ++l) {
        const float* mod = (const float*)(p.ws + WS_MOD) + (size_t)l * 4 * 6144;
        if (l == 0) {
            TPK(2, ph_cbias(p, lds); ph_xa_from(p, p.x, 0, 0, (bf16_t*)(p.ws + WS_XA), (float*)(p.ws + WS_RSA), true));
            GSYNC();
        }
        {   pg8::Gemm g{(const bf16_t*)(p.ws + WS_XA), (const bf16_t*)(p.ws + WS_WIN + l * WS_W1OFF), MTOK, PINP, DM}; pg8::StaticOrder S; S.init(MTOK, PINP, (int)gridDim.x, (int)blockIdx.x);
            EpiProjF E{(const float*)(p.ws + WS_RSA), (const float*)(p.ws + WS_CBIN) + (size_t)l * 4 * PINP, (bf16_t*)(p.ws + WS_PROJ), (float*)(p.ws + WS_SIDE),
                       p.diff_kn + l * 32, p.fox_kn + l * 64, p.nsa_kn + (l * 3 + 1) * 64, p.nsa_kn + (l * 3 + 2) * 64, (LDSF float*)(lds3 + 131072 + 4096)};
            TPK(6, pg8::gemm_phase<EpiProjF, pg8::StaticOrder, true, PG8_SP2>(lds3, g, S, E)); }
        GSYNC();
        TPK(7, fa_phase_all(p, l, lds3, lds, l));
        GSYNC();
        {   pg8::Gemm g{(const bf16_t*)(p.ws + WS_MIX), (const bf16_t*)(p.ws + WS_WOUT + l * WS_W1OFF), MTOK, DM, DM}; pg8::StaticOrder S; S.init(MTOK, DM, (int)gridDim.x, (int)blockIdx.x);
            EpiResF E{l == 0 ? p.x : p.out, p.out, mod + 2048, p.norm_ffn_g + l * DM, mod + 4096, (bf16_t*)(p.ws + WS_XA), (float*)(p.ws + WS_RSB)};
            TPK(6, pg8::gemm_phase<EpiResF, pg8::StaticOrder, PG8_ALIGN, PG8_SP2>(lds3, g, S, E)); }
        GSYNC();
        {   pg8::Gemm g{(const bf16_t*)(p.ws + WS_XA), (const bf16_t*)(p.ws + WS_WUP + l * WS_W1OFF), MTOK, NUP, DM}; pg8::StaticOrder S; S.init(MTOK, NUP, (int)gridDim.x, (int)blockIdx.x);
            EpiUpAct E{(const float*)(p.ws + WS_RSB), (const float*)(p.ws + WS_CBUP) + (size_t)l * 4 * NUP, (bf16_t*)(p.ws + WS_ACT), (float*)(p.ws + WS_EG), (float*)(p.ws + WS_EV),
                       p.conv_w + (size_t)l * 3 * DFF, p.conv_b + (size_t)l * DFF, (LDSF float*)(lds3 + 131072 + 4096), (LDSF float*)(lds3 + 131072 + 8192)};
            TPK(6, pg8::gemm_phase<EpiUpAct, pg8::StaticOrder, true, PG8_SP2>(lds3, g, S, E)); }
        GSYNC();
        {   const float* modn = (const float*)(p.ws + WS_MOD) + (size_t)(l + 1) * 4 * 6144; const bool more = (l + 1 < DEPTH);
            pg8::Gemm g{(const bf16_t*)(p.ws + WS_ACT), (const bf16_t*)(p.ws + WS_WDN + l * WS_W1OFF), MTOK, DM, DFF}; pg8::StaticOrder S; S.init(MTOK, DM, (int)gridDim.x, (int)blockIdx.x);
            { pg8::Unit fu; for (int i = 0; S.next(i, fu); ++i) act_fixup(p, l, fu.pm); }
            __builtin_amdgcn_fence(__ATOMIC_RELEASE, "agent"); __builtin_amdgcn_fence(__ATOMIC_ACQUIRE, "agent"); __syncthreads();
            EpiResF E{p.out, p.out, mod + 5120, p.norm_mix_g + (more ? l + 1 : l) * DM, more ? modn + 1024 : mod + 1024, more ? (bf16_t*)(p.ws + WS_XA) : nullptr, more ? (float*)(p.ws + WS_RSA) : nullptr};
            TPK(6, pg8::gemm_phase<EpiResF, pg8::StaticOrder, PG8_ALIGN, PG8_SP2>(lds3, g, S, E)); }
        if (l + 1 < DEPTH) GSYNC();
    }
#if PROBE == 1
    if (blockIdx.x == 0 && threadIdx.x == 0) p.out[0] += 0.05f + (float)tacc * 0.01f * 5e-4f;
#elif PROBE >= 2
    if (blockIdx.x == 0 && threadIdx.x == 0) p.out[0] += 0.05f + (float)tph * 0.01f * 1e-4f;
#endif
}

extern "C" void kernel_launch(void* const* d_in, const int* in_sizes, int in, void* d_out, int out_size, void* d_ws, size_t ws_size, hipStream_t stream) {
    if (in != 24 || ws_size < WS_END || out_size != MTOK * DM) { fprintf(stderr, "kernel_launch: unexpected sizes (in %d, ws %zu, out %d)\n", in, ws_size, out_size); return; }
    static int grid_blocks = 0;
    if (!grid_blocks) {
        int dev = 0, cus = 0, per_cu = 0;
        hipGetDevice(&dev);
        hipDeviceGetAttribute(&cus, hipDeviceAttributeMultiprocessorCount, dev);
        hipFuncSetAttribute((const void*)mega, hipFuncAttributeMaxDynamicSharedMemorySize, LDS_BYTES);
        hipOccupancyMaxActiveBlocksPerMultiprocessor(&per_cu, (const void*)mega, NTHR, LDS_BYTES);
        if (per_cu < 1) { fprintf(stderr, "kernel_launch: occupancy query returned %d\n", per_cu); per_cu = 1; }
        if (per_cu > 1) per_cu = 1;
        grid_blocks = cus * per_cu;
        fprintf(stderr, "kernel_launch: cus %d per_cu %d grid %d\n", cus, per_cu, grid_blocks);
    }
    if (hipMemsetAsync((char*)d_ws + WS_CTL + 65536, 0, XCD_BAR_WORDS * 4, stream) != hipSuccess) { fprintf(stderr, "kernel_launch: memset failed\n"); return; }
    Params p{};
    const float** f = (const float**)&p;
    for (int i = 0; i < 24; ++i) f[i] = (const float*)d_in[i];
    p.out = (float*)d_out; p.ws = (unsigned char*)d_ws;
    void* args[] = {&p};
    hipError_t e = hipLaunchCooperativeKernel((const void*)mega, dim3(grid_blocks), dim3(NTHR), args, LDS_BYTES, stream);
    if (e != hipSuccess) fprintf(stderr, "cooperative launch failed: %s (grid %d)\n", hipGetErrorString(e), grid_blocks);
}
```

```cpp
#include <hip/hip_runtime.h>
#include <hip/hip_cooperative_groups.h>
#include <cstdint>
#include <cstdio>

typedef unsigned short bf16_t;
typedef short bf16x8 __attribute__((ext_vector_type(8)));
typedef float f32x4 __attribute__((ext_vector_type(4)));
typedef unsigned u32x4 __attribute__((ext_vector_type(4)));

constexpr int NB = 4, SEQ = 4096, DM = 1024, MTOK = NB * SEQ, DEPTH = 2;
constexpr int HD = 64, HPM = 4, DFF = 2816, PIN = 2960, PINP = 3072, NUP = 2 * DFF;
constexpr float EPS = 1e-6f;
constexpr float LOG2E = 1.4426950408889634f;
constexpr int NTHR = 512;

constexpr int CA_Q = 0, CA_K = 256, CA_V = 512, CB_Q = 768, CB_K = 1024, CB_V = 1280, CC_Q = 1536, CC_K = 1792, CC_V = 2048;
constexpr int CD_Q = 2304, CD_KC = 2560, CD_VC = 2624, CD_KS = 2688, CD_VS = 2752, CD_KW = 2816, CD_VW = 2880, C_BF = 2944, C_DG = 2948;

constexpr size_t MiB = 1u << 20;
constexpr size_t WS_CTL = 0;
constexpr size_t WS_MOD = 1 * MiB;
constexpr size_t WS_CBIN = WS_MOD + 2 * 4 * 6144 * 4;
constexpr size_t WS_CBUP = WS_CBIN + 2 * 4 * 3072 * 4;
constexpr size_t WS_TB = WS_CBUP + 2 * 4 * 5632 * 4;
constexpr size_t WS_LAM = WS_TB + 2 * 4 * 128 * 4;
constexpr size_t WS_BND = WS_LAM + 64;
constexpr size_t WS_CUM = WS_LAM + 512;
constexpr size_t WS_KC = WS_CUM + 16 * 4096 * 4;
constexpr size_t WS_VC = WS_KC + 4 * 256 * 64 * 2;
constexpr size_t WS_SELM = WS_VC + 4 * 256 * 64 * 2;
constexpr size_t WS_SMALL_END = WS_SELM + 16384 * 8;
static_assert(WS_SMALL_END <= 4 * MiB, "small region");
constexpr size_t WS_RSA = 4 * MiB;
constexpr size_t WS_RSB = 5 * MiB;
constexpr size_t WS_SIDE = 6 * MiB;
constexpr size_t WS_IMP = 7 * MiB;
constexpr size_t WS_ML = 11 * MiB;
constexpr size_t WS_PHIT = 7 * MiB;
constexpr size_t WS_W = 12 * MiB;
constexpr size_t WS_WIN = WS_W;
constexpr size_t WS_WOUT = WS_WIN + (size_t)PINP * DM * 2;
constexpr size_t WS_WUP = WS_WOUT + (size_t)DM * DM * 2;
constexpr size_t WS_WDN = WS_WUP + (size_t)NUP * DM * 2;
constexpr size_t WS_W_END = WS_WDN + (size_t)DM * DFF * 2;
static_assert(WS_W_END <= 38 * MiB, "weights region");
constexpr size_t WS_XA = 38 * MiB;
constexpr size_t WS_BIG = 70 * MiB;
constexpr size_t WS_PROJ = WS_BIG;
constexpr size_t WS_MIX = WS_BIG + 96 * MiB;
constexpr size_t WS_ACT = WS_BIG;
constexpr size_t WS_W1OFF = 188 * MiB;
constexpr size_t WS_EG = 228 * MiB;
constexpr size_t WS_EV = 232 * MiB;
constexpr size_t WS_END = 236 * MiB;
static_assert(WS_W_END + WS_W1OFF <= WS_EG && WS_MIX + 32 * MiB <= WS_W + WS_W1OFF, "layer-1 weights");
static_assert(WS_END <= 256 * MiB, "workspace");

struct Params {
    const float *x, *c, *rel_bias, *ada_w, *ada_b, *norm_mix_g, *norm_ffn_g, *w_in, *w_out;
    const float *diff_qn, *diff_kn, *diff_lam, *diff_sub, *fox_qn, *fox_kn, *fox_bf;
    const float *nsa_qn, *nsa_kn, *nsa_pe, *nsa_phi, *w_up, *conv_w, *conv_b, *w_down;
    float* out;
    unsigned char* ws;
};

__device__ __forceinline__ float bf2f(bf16_t v) { return __uint_as_float(((unsigned)v) << 16); }
__device__ __forceinline__ bf16_t f2bf(float f) { unsigned u = __float_as_uint(f); return (bf16_t)((u + 0x7fffu + ((u >> 16) & 1u)) >> 16); }
__device__ __forceinline__ unsigned pk2(float lo, float hi) { return (unsigned)f2bf(lo) | ((unsigned)f2bf(hi) << 16); }
__device__ __forceinline__ float siluf(float v) { return v / (1.f + __expf(-v)); }
__device__ __forceinline__ float logsigf(float v) { return fminf(v, 0.f) - log1pf(__expf(-fabsf(v))); }
__device__ __forceinline__ float wave_sum(float v) {
#pragma unroll
    for (int o = 1; o < 64; o <<= 1) v += __shfl_xor(v, o);
    return v;
}
__device__ __forceinline__ int t5_bucket(int n) {
    if (n < 16) return n < 0 ? 0 : n;
    return 16 + (n >= 19) + (n >= 21) + (n >= 24) + (n >= 27) + (n >= 31) + (n >= 35) + (n >= 40) + (n >= 46) + (n >= 52) + (n >= 59) + (n >= 67) + (n >= 77) + (n >= 87) + (n >= 99) + (n >= 113);
}
__host__ __device__ __forceinline__ int in_col_map(int n) {
    if (n < 1536) return n;
    if (n < 2944) return n + 4;
    if (n < 2948) return 1536 + (n - 2944);
    if (n < 2960) return n;
    return -1;
}
__host__ __device__ __forceinline__ int up_col_map(int n) {
    const int pn = n >> 8, c = n & 255;
    return c < 128 ? (128 * pn + c) : (DFF + 128 * pn + (c - 128));
}

__device__ __forceinline__ int opaque_v(int v) { asm volatile("" : "+v"(v)); return v; }
#define TID() opaque_v((int)threadIdx.x)
#define GTID() ((int)(blockIdx.x * blockDim.x) + TID())
#define GSIZE() ((int)(gridDim.x * blockDim.x))

__device__ __forceinline__ void load8(const bf16_t* p, float* d) {
    const u32x4 r = *(const u32x4*)p;
    d[0] = bf2f(r[0] & 0xffff); d[1] = bf2f(r[0] >> 16); d[2] = bf2f(r[1] & 0xffff); d[3] = bf2f(r[1] >> 16);
    d[4] = bf2f(r[2] & 0xffff); d[5] = bf2f(r[2] >> 16); d[6] = bf2f(r[3] & 0xffff); d[7] = bf2f(r[3] >> 16);
}
#define LDSF __attribute__((address_space(3)))
__device__ __forceinline__ void gemv4_block(const float* W, int ld, int oc, const LDSF float* vec, LDSF float* red, float* out0, int ostride, int n, float bias, int tid) {
    const int lane = tid & 63, wv = tid >> 6;
    float a0 = 0.f, a1 = 0.f, a2 = 0.f, a3 = 0.f;
    if (oc >= 0) {
        const float* w = W + (size_t)(wv * 128) * ld + oc;
#pragma unroll 32
        for (int k = 0; k < 128; ++k) { const float wk = w[(size_t)k * ld]; const f32x4 v = *(const LDSF f32x4*)(vec + (wv * 128 + k) * 4); a0 += v[0] * wk; a1 += v[1] * wk; a2 += v[2] * wk; a3 += v[3] * wk; }
    }
    red[(wv * 4 + 0) * 64 + lane] = a0; red[(wv * 4 + 1) * 64 + lane] = a1; red[(wv * 4 + 2) * 64 + lane] = a2; red[(wv * 4 + 3) * 64 + lane] = a3;
    __syncthreads();
    if (tid < 256) { const int bt = tid >> 6; float sacc = 0.f;
#pragma unroll
        for (int w8 = 0; w8 < 8; ++w8) sacc += red[(w8 * 4 + bt) * 64 + lane];
        out0[(size_t)bt * ostride + n] = sacc + bias; }
    __syncthreads();
}
__device__ void ph_mod(const Params& p, unsigned char* lds) {
    float* mod = (float*)(p.ws + WS_MOD);
    float* tb = (float*)(p.ws + WS_TB);
    float* lamv = (float*)(p.ws + WS_LAM);
    LDSF float* vec = (LDSF float*)lds; LDSF float* red = (LDSF float*)(lds + 16384);
    const int tid = TID();
    bool loaded = false;
    for (int item = blockIdx.x; item < DEPTH * 96; item += gridDim.x) {
        if (!loaded) { for (int i = tid; i < 4096; i += NTHR) { const int bt = i >> 10, k = i & 1023; vec[k * 4 + bt] = siluf(p.c[bt * DM + k]); } __syncthreads(); loaded = true; }
        const int l = item / 96, n = (item % 96) * 64 + (tid & 63);
        gemv4_block(p.ada_w + (size_t)l * DM * 6144, 6144, n, vec, red, mod + (size_t)l * 4 * 6144, 6144, n, p.ada_b[l * 6144 + n], tid);
    }
    const int gt = GTID(), gs = GSIZE();
    for (int idx = gt; idx < 2 * 4 * 128; idx += gs) {
        const int type = idx / 512, h = (idx / 128) & 3, d = idx & 127;
        tb[idx] = p.rel_bias[t5_bucket(d) * 8 + type * 4 + h];
    }
    for (int idx = gt; idx < DEPTH * 32; idx += gs) {
        const int l = idx >> 5, e = idx & 31; float v = 0.f;
        if (e < 17) {
            const int type = (e < 5) ? 0 : 1, h = (e < 4) ? e : ((e == 4) ? 0 : ((e - 5) & 3));
            const int ng = (e < 4) ? 32 : 64;
            const float* gq = (e < 4) ? p.diff_qn + l * 32 : ((e == 4) ? p.fox_qn + l * 64 : p.nsa_qn + l * 64);
            const float* gk = (e < 4) ? p.diff_kn + l * 32 : ((e == 4) ? p.fox_kn + l * 64 : p.nsa_kn + (l * 3 + (e - 5) / 4) * 64);
            float mq = 0.f, mk = 0.f; for (int i = 0; i < ng; ++i) { mq = fmaxf(mq, fabsf(gq[i])); mk = fmaxf(mk, fabsf(gk[i])); }
            float tm = 0.f; if (e != 4) { tm = -INFINITY; for (int bk2 = 0; bk2 < 32; ++bk2) tm = fmaxf(tm, p.rel_bias[bk2 * 8 + type * 4 + h]); }
            v = sqrtf((float)ng) * mq * mk * 1.02f * LOG2E + tm * LOG2E;
        }
        ((float*)(p.ws + WS_BND))[idx] = v;
    }
    for (int idx = gt; idx < DEPTH; idx += gs) {
        const float* lv = p.diff_lam + idx * 4 * 32;
        float s1 = 0.f, s2 = 0.f;
        for (int i = 0; i < 32; ++i) { s1 += lv[i] * lv[32 + i]; s2 += lv[64 + i] * lv[96 + i]; }
        const float lam_init = 0.8f - 0.6f * expf(-0.3f * (float)idx);
        lamv[idx] = expf(s1) - expf(s2) + lam_init;
    }
}
__device__ void ph_cbias(const Params& p, unsigned char* lds) {
    const float* mod = (const float*)(p.ws + WS_MOD);
    const int tid_ = TID(); const int lane = tid_ & 63, wv = tid_ >> 6;
    const int gw = blockIdx.x * (NTHR >> 6) + wv, ngw = gridDim.x * (NTHR >> 6);
    constexpr int NCOL = PINP + NUP;
    const int per = (DEPTH * NCOL + ngw - 1) / ngw; const int c0 = gw * per, c1 = min(DEPTH * NCOL, c0 + per);
    int cur_key = -1; float sh[4][16];
    for (int c = c0; c < c1; ++c) {
        const int l = c / NCOL, r = c % NCOL; const bool isin = r < PINP; const int n = isin ? r : r - PINP; const int key = l * 2 + (isin ? 0 : 1);
        if (key != cur_key) { cur_key = key; const int shoff = isin ? 0 : 3072;
#pragma unroll
            for (int bt = 0; bt < 4; ++bt)
#pragma unroll
                for (int q4 = 0; q4 < 4; ++q4) { const f32x4 v = *(const f32x4*)(mod + (size_t)(l * 4 + bt) * 6144 + shoff + 16 * lane + 4 * q4); sh[bt][4 * q4] = v[0]; sh[bt][4 * q4 + 1] = v[1]; sh[bt][4 * q4 + 2] = v[2]; sh[bt][4 * q4 + 3] = v[3]; } }
        const bf16_t* wrow = (const bf16_t*)(p.ws + (isin ? WS_WIN : WS_WUP) + l * WS_W1OFF) + (size_t)n * DM + 16 * lane;
        float w[16]; load8(wrow, w); load8(wrow + 8, w + 8);
        float a0 = 0.f, a1 = 0.f, a2 = 0.f, a3 = 0.f;
#pragma unroll
        for (int j = 0; j < 16; ++j) { a0 += sh[0][j] * w[j]; a1 += sh[1][j] * w[j]; a2 += sh[2][j] * w[j]; a3 += sh[3][j] * w[j]; }
        a0 = wave_sum(a0); a1 = wave_sum(a1); a2 = wave_sum(a2); a3 = wave_sum(a3);
        if (lane == 0) { float* o = isin ? (float*)(p.ws + WS_CBIN) + (size_t)l * 4 * PINP : (float*)(p.ws + WS_CBUP) + (size_t)l * 4 * NUP; const int ld = isin ? PINP : NUP;
            o[n] = a0; o[ld + n] = a1; o[2 * ld + n] = a2; o[3 * ld + n] = a3; }
    }
}
template <int MAPK>
__device__ void convert_weight(const float* W, int K, int Nsrc, int Npad, bf16_t* Wt, LDSF float* scr, int gw, int ngw, int lane) {
    const int nkb = K / 64, nnb = Npad / 64;
    for (int it = gw; it < nkb * nnb; it += ngw) {
        const int kb = it / nnb, nb = it % nnb, k0 = kb * 64, n0 = nb * 64;
        {
            const int n = n0 + lane;
            const int oc = MAPK == 0 ? n : (MAPK == 1 ? in_col_map(n) : up_col_map(n));
            const float* wp = W + (size_t)k0 * Nsrc + (oc >= 0 ? oc : 0);
#pragma unroll 1
            for (int hh = 0; hh < 2; ++hh) {
                float tv[32];
#pragma unroll
                for (int i = 0; i < 32; ++i) tv[i] = wp[(size_t)(32 * hh + i) * Nsrc];
#pragma unroll
                for (int i = 0; i < 32; ++i) scr[(32 * hh + i) * 65 + lane] = (oc >= 0) ? tv[i] : 0.f;
            }
        }
        __builtin_amdgcn_s_waitcnt(0xc07f); __builtin_amdgcn_wave_barrier();
        {
            const int c = lane & 7;
#pragma unroll
            for (int j = 0; j < 8; ++j) { const int nn = 8 * j + (lane >> 3); const LDSF float* sp = scr + (8 * c) * 65 + nn;
                u32x4 o; o[0] = pk2(sp[0], sp[65]); o[1] = pk2(sp[130], sp[195]); o[2] = pk2(sp[260], sp[325]); o[3] = pk2(sp[390], sp[455]);
                *(u32x4*)(Wt + (size_t)(n0 + nn) * K + k0 + 8 * c) = o; }
        }
        __builtin_amdgcn_s_waitcnt(0xc07f); __builtin_amdgcn_wave_barrier();
    }
}
__device__ void ph_weights(const Params& p, int l, unsigned char* lds) {
    const int tid_ = TID(); const int lane = tid_ & 63, wv = tid_ >> 6;
    const int gw = blockIdx.x * (NTHR >> 6) + wv, ngw = gridDim.x * (NTHR >> 6);
    LDSF float* scr = (LDSF float*)lds + wv * (64 * 65);
    convert_weight<1>(p.w_in + (size_t)l * DM * PIN, DM, PIN, PINP, (bf16_t*)(p.ws + WS_WIN + l * WS_W1OFF), scr, gw, ngw, lane);
    convert_weight<0>(p.w_out + (size_t)l * DM * DM, DM, DM, DM, (bf16_t*)(p.ws + WS_WOUT + l * WS_W1OFF), scr, gw, ngw, lane);
    convert_weight<2>(p.w_up + (size_t)l * DM * NUP, DM, NUP, NUP, (bf16_t*)(p.ws + WS_WUP + l * WS_W1OFF), scr, gw, ngw, lane);
    convert_weight<0>(p.w_down + (size_t)l * DFF * DM, DFF, DM, DM, (bf16_t*)(p.ws + WS_WDN + l * WS_W1OFF), scr, gw, ngw, lane);
    for (int w2 = 0; w2 < 2; ++w2) convert_weight<0>(p.nsa_phi + (size_t)(l * 2 + w2) * 2048 * 64, 2048, 64, 64, (bf16_t*)(p.ws + WS_PHIT) + (size_t)(l * 2 + w2) * 64 * 2048, scr, gw, ngw, lane);
}
__device__ void ph_xa_from(const Params& p, const float* src, int l, int which  , bf16_t* XA, float* rowss, bool write_xa) {
    const float* mod = (const float*)(p.ws + WS_MOD);
    const float* g = (which == 0 ? p.norm_mix_g : p.norm_ffn_g) + l * DM;
    const int tid_ = TID(); const int lane = tid_ & 63, wv = tid_ >> 6;
    const int gw = blockIdx.x * (blockDim.x >> 6) + wv, ngw = gridDim.x * (blockDim.x >> 6);
    for (int row = gw; row < MTOK; row += ngw) {
        const int b = row / SEQ;
        const float* sc = mod + (size_t)(l * 4 + b) * 6144 + (which == 0 ? 1024 : 4096);
        float ss = 0.f;
#pragma unroll
        for (int j = 0; j < 4; ++j) {
            const int k = j * 256 + lane * 4;
            const f32x4 v = *(const f32x4*)(src + (size_t)row * DM + k);
            ss += v[0] * v[0] + v[1] * v[1] + v[2] * v[2] + v[3] * v[3];
            if (write_xa) {
                const f32x4 gv = *(const f32x4*)(g + k); const f32x4 sv = *(const f32x4*)(sc + k);
                uint2 o; o.x = pk2(v[0] * gv[0] * (1.f + sv[0]), v[1] * gv[1] * (1.f + sv[1])); o.y = pk2(v[2] * gv[2] * (1.f + sv[2]), v[3] * gv[3] * (1.f + sv[3]));
                *(uint2*)(XA + (size_t)row * DM + k) = o;
            }
        }
        ss = wave_sum(ss);
        if (lane < 16) rowss[(size_t)row * 16 + lane] = (lane == 0) ? ss : 0.f;
    }
}

namespace pg8 {
#define PG8_LAS __attribute__((address_space(3)))
typedef unsigned short bf16_t;
typedef short bf16x8 __attribute__((ext_vector_type(8)));
typedef float f32x4 __attribute__((ext_vector_type(4)));
typedef unsigned u32x4 __attribute__((ext_vector_type(4)));
constexpr int BM = 256, BK = 64, HALF = 128, HTB = HALF * BK * 2  , STAGE_BYTES = 8 * HTB, NXCD = 8, WGM = 8;

__host__ __device__ __forceinline__ int lds_byte(int r, int c) { const int st = (r >> 4) * 2 + (c >> 5), rr = r & 15, cc = c & 31, ob = rr * 64 + cc * 2; return st * 1024 + (ob ^ (((ob >> 9) & 1) << 5)); }
__host__ __device__ __forceinline__ void stage_rc(int b, int& R, int& C) { const int st = b / 1024, sb = b % 1024, swz = sb ^ (((sb >> 9) & 1) << 5); R = (st >> 1) * 16 + swz / 64; C = (st & 1) * 32 + (swz % 64) / 2; }
__host__ __device__ __forceinline__ int perm32(int rho) { const int n = rho >> 4, i = rho & 15; return 8 * (i >> 2) + 4 * n + (i & 3); }

struct Unit { int pm, pn; };
struct Gemm { const bf16_t* A; const bf16_t* Bt; int M, N, K; };

struct StaticOrder {
    int nM, nN, nwg, G, c;
    __host__ __device__ void init(int M, int N, int G_, int c_) { nM = M / BM; nN = N / BM; nwg = nM * nN; G = G_; c = c_; }
    __host__ __device__ bool next(int i, Unit& u) const {
        const long L = (long)i * G + c; if (L >= nwg) return false;
        int wgid = (int)L; { const int q = nwg / NXCD, r = nwg % NXCD, xcd = wgid % NXCD, off = wgid / NXCD; wgid = (xcd < r ? xcd * (q + 1) : r * (q + 1) + (xcd - r) * q) + off; }
        const int nig = WGM * nN, gid = wgid / nig, fm = gid * WGM, gsz = (nM - fm) < WGM ? (nM - fm) : WGM;
        u.pm = fm + ((wgid % nig) % gsz); u.pn = (wgid % nig) / gsz; return true;
    }
    __device__ __forceinline__ void a_ready(const Unit&) const {}
    __device__ __forceinline__ void done(const Unit&) const {}
};


__device__ __forceinline__ unsigned cvt_pk_bf16(float lo, float hi) { unsigned r; asm volatile("v_cvt_pk_bf16_f32 %0, %1, %2" : "=v"(r) : "v"(lo), "v"(hi)); return r; }
template <class Epi, class Sched, bool ALIGN_EPI = false, bool SP2 = false>
__device__ __forceinline__ void gemm_phase(PG8_LAS unsigned char* lds, const Gemm g, const Sched& S, const Epi& E) {
    const int tid = TID(), wid = __builtin_amdgcn_readfirstlane(tid >> 6), lane = tid & 63, wr = wid >> 2, wc = wid & 3, fr = lane & 15, fq = lane >> 4;
    const int K = g.K, nt = K / BK;
    unsigned voffA[2], voffB[2];
#pragma unroll
    for (int i = 0; i < 2; ++i) { int R, C; stage_rc(tid * 16 + i * 8192, R, C); const int Rb = Epi::PERM ? ((R & ~31) + perm32(R & 31)) : R;
        voffA[i] = (unsigned)(R * K + C) * 2u; voffB[i] = (unsigned)(Rb * K + C) * 2u; }
    const size_t kstep = (size_t)(BK * 2);
    const size_t hstep = (size_t)HALF * K * 2;
    const size_t tstep = 2 * hstep;
    const unsigned ldsw = (unsigned)wid * 1024u;
    const int aoff = lds_byte(wr * 64 + fr, fq * 8), boff = lds_byte(wc * 32 + fr, fq * 8);
#define PG8_SA(b, h) (((b) * 2 + (h)) * HTB)
#define PG8_SB(b, h) ((4 + (b) * 2 + (h)) * HTB)
#define PG8_STAGE(bufoff, gbase, voff) do { _Pragma("unroll") for (int _i = 0; _i < 2; ++_i) \
        __builtin_amdgcn_global_load_lds((const unsigned*)((const char*)(gbase) + (voff)[_i]), (PG8_LAS unsigned*)(lds + (bufoff) + ldsw + _i * 8192), 16, 0, 0); } while (0)
#define PG8_LDA(dst, b, h) do { _Pragma("unroll") for (int m = 0; m < 4; ++m) _Pragma("unroll") for (int k = 0; k < 2; ++k) dst[m][k] = *(const PG8_LAS bf16x8*)(lds + PG8_SA(b, h) + aoff + m * 2048 + k * 1024); } while (0)
#define PG8_LDB(dst, b, h) do { _Pragma("unroll") for (int n = 0; n < 2; ++n) _Pragma("unroll") for (int k = 0; k < 2; ++k) dst[n][k] = *(const PG8_LAS bf16x8*)(lds + PG8_SB(b, h) + boff + n * 2048 + k * 1024); } while (0)
#define PG8_MMA(ai, bj, At, Bt) do { __builtin_amdgcn_s_setprio(1); _Pragma("unroll") for (int m = 0; m < 4; ++m) _Pragma("unroll") for (int n = 0; n < 2; ++n) _Pragma("unroll") for (int k = 0; k < 2; ++k) \
        acc[ai][bj][m][n] = __builtin_amdgcn_mfma_f32_16x16x32_bf16(Bt[n][k], At[m][k], acc[ai][bj][m][n], 0, 0, 0); __builtin_amdgcn_s_setprio(0); } while (0)
#define PG8_WAIT_V(n) asm volatile("s_waitcnt vmcnt(" #n ")" ::: "memory")
#define PG8_WAIT_L(n) asm volatile("s_waitcnt lgkmcnt(" #n ")" ::: "memory")
#define PG8_BAR __builtin_amdgcn_s_barrier()
#define PG8_SCHED __builtin_amdgcn_sched_barrier(0)
    Unit cur, nxt; int ui = 0;
    if (!S.next(0, cur)) return;
    f32x4 acc[2][2][4][2];
#pragma unroll
    for (int a = 0; a < 2; ++a)
#pragma unroll
        for (int b = 0; b < 2; ++b)
#pragma unroll
            for (int m = 0; m < 4; ++m)
#pragma unroll
                for (int n = 0; n < 2; ++n) acc[a][b][m][n] = (f32x4){0.f, 0.f, 0.f, 0.f};
    bf16x8 At[4][2], B0[2][2], B1[2][2];
    const char* cA = (const char*)g.A + (size_t)cur.pm * tstep; const char* cB = (const char*)g.Bt + (size_t)cur.pn * tstep;
    S.a_ready(cur);
    if constexpr (SP2) {
        PG8_STAGE(PG8_SB(0, 0), cB, voffB); PG8_STAGE(PG8_SB(0, 1), cB + hstep, voffB); PG8_STAGE(PG8_SA(0, 0), cA, voffA); PG8_STAGE(PG8_SA(0, 1), cA + hstep, voffA);
        if (wr == 1) PG8_BAR;
        PG8_WAIT_V(2); PG8_BAR;
        PG8_STAGE(PG8_SB(1, 0), cB + kstep, voffB); PG8_STAGE(PG8_SA(1, 0), cA + kstep, voffA); PG8_STAGE(PG8_SB(1, 1), cB + hstep + kstep, voffB);
        PG8_WAIT_V(6); PG8_BAR;
    } else {
        PG8_STAGE(PG8_SB(0, 0), cB, voffB); PG8_STAGE(PG8_SA(0, 0), cA, voffA); PG8_STAGE(PG8_SB(0, 1), cB + hstep, voffB); PG8_STAGE(PG8_SA(0, 1), cA + hstep, voffA);
        if (wr == 1) PG8_BAR;
        PG8_WAIT_V(4); PG8_BAR;
        PG8_STAGE(PG8_SB(1, 0), cB + kstep, voffB); PG8_STAGE(PG8_SA(1, 0), cA + kstep, voffA); PG8_STAGE(PG8_SB(1, 1), cB + hstep + kstep, voffB);
        PG8_WAIT_V(6); PG8_BAR;
    }
    for (;;) {
        const bool has_next = S.next(ui + 1, nxt);
        const char* nA = has_next ? (const char*)g.A + (size_t)nxt.pm * tstep : cA; const char* nB = has_next ? (const char*)g.Bt + (size_t)nxt.pn * tstep : cB;
        for (int t = 0; t < nt; t += 2) {
            const bool last = (t == nt - 2);
            const char* a1 = cA + (size_t)(t + 1) * kstep;
            const char* a2 = last ? nA : cA + (size_t)(t + 2) * kstep; const char* b2 = last ? nB : cB + (size_t)(t + 2) * kstep;
            const char* a3 = a2 + kstep; const char* b3 = b2 + kstep;
            if (last && has_next) S.a_ready(nxt);
            if constexpr (SP2) {
            PG8_LDB(B0, 0, 0); PG8_LDB(B1, 0, 1); PG8_SCHED; PG8_LDA(At, 0, 0); PG8_STAGE(PG8_SA(1, 1), a1 + hstep, voffA);
            PG8_WAIT_V(8); PG8_WAIT_L(0); PG8_BAR; PG8_MMA(0, 0, At, B0); PG8_MMA(0, 1, At, B1); PG8_BAR; PG8_SCHED;
            PG8_LDA(At, 0, 1); PG8_STAGE(PG8_SB(0, 0), b2, voffB); PG8_STAGE(PG8_SB(0, 1), b2 + hstep, voffB); PG8_STAGE(PG8_SA(0, 0), a2, voffA);
            PG8_WAIT_V(8); PG8_WAIT_L(0); PG8_BAR; PG8_MMA(1, 0, At, B0); PG8_MMA(1, 1, At, B1); PG8_BAR; PG8_SCHED;
            PG8_LDB(B0, 1, 0); PG8_LDB(B1, 1, 1); PG8_SCHED; PG8_LDA(At, 1, 0); PG8_STAGE(PG8_SA(0, 1), a2 + hstep, voffA);
            PG8_WAIT_V(8); PG8_WAIT_L(0); PG8_BAR; PG8_MMA(0, 0, At, B0); PG8_MMA(0, 1, At, B1); PG8_BAR; PG8_SCHED;
            PG8_LDA(At, 1, 1); PG8_STAGE(PG8_SB(1, 0), b3, voffB); PG8_STAGE(PG8_SB(1, 1), b3 + hstep, voffB); PG8_STAGE(PG8_SA(1, 0), a3, voffA);
            PG8_WAIT_V(8); PG8_WAIT_L(0); PG8_BAR; PG8_MMA(1, 0, At, B0); PG8_MMA(1, 1, At, B1); PG8_BAR; PG8_SCHED;
            } else {
            PG8_LDB(B0, 0, 0); PG8_SCHED; PG8_LDA(At, 0, 0); PG8_STAGE(PG8_SA(1, 1), a1 + hstep, voffA);
            PG8_WAIT_L(8); PG8_BAR; PG8_WAIT_L(0); PG8_MMA(0, 0, At, B0); PG8_BAR; PG8_SCHED;
            PG8_LDB(B1, 0, 1); PG8_STAGE(PG8_SB(0, 0), b2, voffB);
            PG8_BAR; PG8_WAIT_L(0); PG8_MMA(0, 1, At, B1); PG8_BAR;
            PG8_LDA(At, 0, 1); PG8_STAGE(PG8_SA(0, 0), a2, voffA);
            PG8_BAR; PG8_WAIT_L(0); PG8_MMA(1, 0, At, B0); PG8_BAR; PG8_SCHED;
            PG8_STAGE(PG8_SB(0, 1), b2 + hstep, voffB);
            PG8_WAIT_V(6); PG8_BAR; PG8_MMA(1, 1, At, B1); PG8_BAR;
            PG8_LDB(B0, 1, 0); PG8_SCHED; PG8_LDA(At, 1, 0); PG8_STAGE(PG8_SA(0, 1), a2 + hstep, voffA);
            PG8_WAIT_L(8); PG8_BAR; PG8_WAIT_L(0); PG8_MMA(0, 0, At, B0); PG8_BAR; PG8_SCHED;
            PG8_LDB(B1, 1, 1); PG8_STAGE(PG8_SB(1, 0), b3, voffB);
            PG8_BAR; PG8_WAIT_L(0); PG8_MMA(0, 1, At, B1); PG8_BAR;
            PG8_LDA(At, 1, 1); PG8_STAGE(PG8_SA(1, 0), a3, voffA);
            PG8_BAR; PG8_WAIT_L(0); PG8_MMA(1, 0, At, B0); PG8_BAR; PG8_SCHED;
            PG8_STAGE(PG8_SB(1, 1), b3 + hstep, voffB);
            PG8_WAIT_V(6); PG8_BAR; PG8_MMA(1, 1, At, B1); PG8_BAR;
            }
        }
        if constexpr (ALIGN_EPI) { if (wr == 0) PG8_BAR; }
        if constexpr (!Epi::AFTER_DRAIN) { E(acc, cur, wr, wc, fr, fq); S.done(cur); }
        if (!has_next) break;
#pragma unroll
        for (int a = 0; a < 2; ++a)
#pragma unroll
            for (int b = 0; b < 2; ++b)
#pragma unroll
                for (int m = 0; m < 4; ++m)
#pragma unroll
                    for (int n = 0; n < 2; ++n) acc[a][b][m][n] = (f32x4){0.f, 0.f, 0.f, 0.f};
        cur = nxt; cA = nA; cB = nB; ++ui;
        if constexpr (ALIGN_EPI) { if (wr == 1) PG8_BAR; }
    }
    PG8_WAIT_V(0);
    if constexpr (!ALIGN_EPI) { if (wr == 0) PG8_BAR; }
    PG8_BAR;
    if constexpr (Epi::AFTER_DRAIN) { E.fused(acc, cur, wr, wc, fr, fq, lds, wid, lane); S.done(cur); }
#undef PG8_SA
#undef PG8_SB
#undef PG8_STAGE
#undef PG8_LDA
#undef PG8_LDB
#undef PG8_MMA
#undef PG8_WAIT_V
#undef PG8_WAIT_L
#undef PG8_BAR
#undef PG8_SCHED
}
}

#ifndef PG8_SP2
#define PG8_SP2 true
#endif
#ifndef PG8_ALIGN
#define PG8_ALIGN true
#endif

__device__ __forceinline__ float row_rstd16(const float* rowss, int row) {
    const f32x4* r = (const f32x4*)(rowss + (size_t)row * 16);
    const f32x4 a = r[0], b = r[1], c = r[2], d = r[3];
    const float s = ((a[0] + a[1]) + (a[2] + a[3])) + ((b[0] + b[1]) + (b[2] + b[3])) + ((c[0] + c[1]) + (c[2] + c[3])) + ((d[0] + d[1]) + (d[2] + d[3]));
    return rsqrtf(s * (1.f / DM) + EPS);
}
struct EpiProjF {
    static constexpr bool PERM = true, AFTER_DRAIN = false;
    const float* rowss; const float* cb; bf16_t* proj; float* side; const float* g_a; const float* g_b; const float* g_ds; const float* g_dw; LDSF float* xs  ;
    __device__ __forceinline__ void operator()(const pg8::f32x4 (&acc)[2][2][4][2], const pg8::Unit& u, int wr, int wc, int fr, int fq) const {
        const int b = u.pm >> 4, colt = u.pn * 256 + wc * 32 + 8 * fq;
        const int knmode = (u.pn == 1) ? 1 : (u.pn == 4) ? 2 : (u.pn == 10) ? 3 : (u.pn == 11) ? 4 : 0;
        f32x4 cv[2][2];
#pragma unroll
        for (int bj = 0; bj < 2; ++bj)
#pragma unroll
            for (int n = 0; n < 2; ++n) cv[bj][n] = *(const f32x4*)(cb + b * PINP + colt + bj * 128 + 4 * n);
        if (knmode != 0) {
#pragma unroll
            for (int ai = 0; ai < 2; ++ai)
#pragma unroll
                for (int m = 0; m < 4; ++m) {
                    const float rsm = row_rstd16(rowss, u.pm * 256 + ai * 128 + wr * 64 + m * 16 + fr);
#pragma unroll
                    for (int bj = 0; bj < 2; ++bj) {
                        const f32x4 v0 = acc[ai][bj][m][0] * rsm + cv[bj][0], v1 = acc[ai][bj][m][1] * rsm + cv[bj][1];
                        float ss = (v0[0] * v0[0] + v0[1] * v0[1]) + (v0[2] * v0[2] + v0[3] * v0[3]) + (v1[0] * v1[0] + v1[1] * v1[1]) + (v1[2] * v1[2] + v1[3] * v1[3]);
                        ss += __shfl_xor(ss, 16); ss += __shfl_xor(ss, 32);
                        if (fq == 0) xs[((wr * 4 + wc) * 16 + (ai * 4 + m) * 2 + bj) * 16 + fr] = ss;
                    }
                }
            asm volatile("s_waitcnt lgkmcnt(0)" ::: "memory"); __builtin_amdgcn_s_barrier(); asm volatile("" ::: "memory");
        }
#pragma unroll
        for (int ai = 0; ai < 2; ++ai)
#pragma unroll
            for (int m = 0; m < 4; ++m) {
                const int row = u.pm * 256 + ai * 128 + wr * 64 + m * 16 + fr; const float rs = row_rstd16(rowss, row);
#pragma unroll
                for (int bj = 0; bj < 2; ++bj) {
                    f32x4 v0 = acc[ai][bj][m][0] * rs + cv[bj][0], v1 = acc[ai][bj][m][1] * rs + cv[bj][1]; const int col0 = colt + bj * 128;
                    if (col0 >= C_BF && col0 < PIN) { *(f32x4*)(side + (size_t)row * 16 + (col0 - C_BF)) = v0; *(f32x4*)(side + (size_t)row * 16 + (col0 - C_BF) + 4) = v1; }
                    const bool on = (knmode == 1) || (knmode == 2) || (knmode == 3 && bj == 1 && wc < 2) || (knmode == 4 && bj == 0 && wc < 2);
                    if (on) {
                        const int xi = (ai * 4 + m) * 2 + bj;
                        float tot = xs[((wr * 4 + wc) * 16 + xi) * 16 + fr]; float dn = 1.f / 32.f;
                        if (knmode != 1) { tot += xs[((wr * 4 + (wc ^ 1)) * 16 + xi) * 16 + fr]; dn = 1.f / 64.f; }
                        const float nrm = rsqrtf(tot * dn + EPS);
                        const float* gp = (knmode == 1) ? g_a + 8 * fq : ((knmode == 2) ? g_b : (knmode == 3 ? g_ds : g_dw)) + (wc & 1) * 32 + 8 * fq;
                        v0 = v0 * nrm * *(const f32x4*)gp; v1 = v1 * nrm * *(const f32x4*)(gp + 4);
                    }
                    u32x4 w; w[0] = pg8::cvt_pk_bf16(v0[0], v0[1]); w[1] = pg8::cvt_pk_bf16(v0[2], v0[3]); w[2] = pg8::cvt_pk_bf16(v1[0], v1[1]); w[3] = pg8::cvt_pk_bf16(v1[2], v1[3]);
                    *(u32x4*)(proj + (size_t)row * PINP + col0) = w;
                }
            }
    }
};
struct EpiResF {
    static constexpr bool PERM = false, AFTER_DRAIN = false;
    const float* xin; float* xout; const float* gate; const float* g; const float* sc; bf16_t* xa; float* rowss;
    __device__ __forceinline__ void operator()(const pg8::f32x4 (&acc)[2][2][4][2], const pg8::Unit& u, int wr, int wc, int fr, int fq) const {
        const int b = u.pm >> 4, col0 = u.pn * 256 + wc * 32 + 4 * fq;
        f32x4 gt[2][2], gm[2][2];
#pragma unroll
        for (int bj = 0; bj < 2; ++bj)
#pragma unroll
            for (int n = 0; n < 2; ++n) { const int c = col0 + bj * 128 + n * 16; gt[bj][n] = *(const f32x4*)(gate + b * 6144 + c);
                if (xa) gm[bj][n] = *(const f32x4*)(g + c) * (*(const f32x4*)(sc + b * 6144 + c) + 1.0f); else gm[bj][n] = (f32x4){0.f, 0.f, 0.f, 0.f}; }
#pragma unroll
        for (int ai = 0; ai < 2; ++ai)
#pragma unroll
            for (int m = 0; m < 4; ++m) {
                const int row = u.pm * 256 + ai * 128 + wr * 64 + m * 16 + fr; float ss = 0.f;
#pragma unroll
                for (int bj = 0; bj < 2; ++bj)
#pragma unroll
                    for (int n = 0; n < 2; ++n) { const size_t off = (size_t)row * DM + col0 + bj * 128 + n * 16;
                        const f32x4 o = *(const f32x4*)(xin + off) + gt[bj][n] * acc[ai][bj][m][n];
                        *(f32x4*)(xout + off) = o; ss += (o[0] * o[0] + o[1] * o[1]) + (o[2] * o[2] + o[3] * o[3]);
                        if (xa) { const f32x4 q = o * gm[bj][n]; uint2 w; w.x = pg8::cvt_pk_bf16(q[0], q[1]); w.y = pg8::cvt_pk_bf16(q[2], q[3]); *(uint2*)(xa + off) = w; } }
                if (rowss) { ss += __shfl_xor(ss, 16); ss += __shfl_xor(ss, 32); if (fq == 0) rowss[(size_t)row * 16 + u.pn * 4 + wc] = ss; }
            }
    }
};


#define DPPF(oldv, src, CTRL) __builtin_bit_cast(float, __builtin_amdgcn_update_dpp(__builtin_bit_cast(int, (float)(oldv)), __builtin_bit_cast(int, (float)(src)), (CTRL), 0xf, 0xf, false))
struct EpiUpAct {
    static constexpr bool PERM = true, AFTER_DRAIN = false;
    const float* rowss; const float* cb; bf16_t* act; float* eg; float* ev; const float* cw; const float* cbias; LDSF float* xch; LDSF float* cst  ;
    __device__ __forceinline__ void operator()(const pg8::f32x4 (&acc)[2][2][4][2], const pg8::Unit& u, int wr, int wc, int fr, int fq) const {
        const int b = u.pm >> 4, cih = wc * 32 + 8 * fq, jcol = u.pn * 128 + cih;
        const float* cbg = cb + b * NUP + u.pn * 256 + cih; const float* cbv = cbg + 128;
        {
            const int tid = (wr * 4 + wc) * 64 + fq * 16 + fr, col = tid & 127, arr = tid >> 7;
            const float* src = (arr == 0) ? cb + b * NUP + u.pn * 256 + col : (arr == 1) ? cb + b * NUP + u.pn * 256 + 128 + col : cw + (arr - 2) * DFF + u.pn * 128 + col;
            cst[arr * 128 + col] = *src;
            if (tid < 256) { const int a2 = 4 + (tid >> 7); cst[a2 * 128 + col] = (a2 == 4) ? cw[2 * DFF + u.pn * 128 + col] : cbias[u.pn * 128 + col]; }
            else cst[768 + (tid - 256)] = row_rstd16(rowss, u.pm * 256 + (tid - 256));
            const f32x4 cg0 = *(const f32x4*)cbg, cg1 = *(const f32x4*)(cbg + 4);
#pragma unroll
            for (int ai = 0; ai < 2; ++ai) {
                const float r3 = row_rstd16(rowss, u.pm * 256 + ai * 128 + wr * 64 + 48 + fr);
                const f32x4 g0 = acc[ai][0][3][0] * r3 + cg0, g1 = acc[ai][0][3][1] * r3 + cg1;
                if (fr >= 14) { LDSF float* x = xch + ((((wr * 2 + ai) * 4 + wc) * 2 + (fr - 14)) * 32 + 8 * fq); *(LDSF f32x4*)x = g0; *(LDSF f32x4*)(x + 4) = g1;
                    if (wr == 1 && ai == 1) { float* e = eg + ((size_t)(u.pm * 4 + 2 + (fr - 14))) * DFF + jcol; *(f32x4*)e = g0; *(f32x4*)(e + 4) = g1; } }
            }
            if (wr == 0 && fr < 2) {
                const f32x4 cv0 = *(const f32x4*)cbv, cv1 = *(const f32x4*)(cbv + 4); const float r0 = row_rstd16(rowss, u.pm * 256 + fr);
                float* e = eg + ((size_t)(u.pm * 4 + fr)) * DFF + jcol; float* v = ev + ((size_t)(u.pm * 2 + fr)) * DFF + jcol;
                *(f32x4*)e = acc[0][0][0][0] * r0 + cg0; *(f32x4*)(e + 4) = acc[0][0][0][1] * r0 + cg1;
                *(f32x4*)v = acc[0][1][0][0] * r0 + cv0; *(f32x4*)(v + 4) = acc[0][1][0][1] * r0 + cv1;
            }
        }
        asm volatile("s_waitcnt vmcnt(0) lgkmcnt(0)" ::: "memory"); __builtin_amdgcn_s_barrier(); asm volatile("" ::: "memory");
#pragma unroll
        for (int ai = 0; ai < 2; ++ai) {
            f32x4 pvv[2];
            if (ai == 0 && wr == 0) { pvv[0] = (f32x4){0.f, 0.f, 0.f, 0.f}; pvv[1] = pvv[0]; }
            else { const int swr = (wr == 1) ? 0 : 1, sai = (wr == 1) ? ai : ai - 1;
                const LDSF float* x = xch + ((((swr * 2 + sai) * 4 + wc) * 2 + (fr & 1)) * 32 + 8 * fq); pvv[0] = *(const LDSF f32x4*)x; pvv[1] = *(const LDSF f32x4*)(x + 4); }
#pragma unroll
            for (int m = 0; m < 4; ++m) {
                asm volatile("" ::: "memory");
                const int row = u.pm * 256 + ai * 128 + wr * 64 + m * 16 + fr; const float rsm = cst[768 + ai * 128 + wr * 64 + m * 16 + fr];
                u32x4 w;
#pragma unroll
                for (int n = 0; n < 2; ++n) {
                    const LDSF float* cc = cst + cih + 4 * n;
                    const f32x4 cgn = *(const LDSF f32x4*)cc, cvn = *(const LDSF f32x4*)(cc + 128);
                    const f32x4 k0 = *(const LDSF f32x4*)(cc + 256), k1 = *(const LDSF f32x4*)(cc + 384), k2 = *(const LDSF f32x4*)(cc + 512), kb = *(const LDSF f32x4*)(cc + 640);
                    const f32x4 c = acc[ai][0][m][n] * rsm + cgn, v = acc[ai][1][m][n] * rsm + cvn; float o[4];
#pragma unroll
                    for (int i = 0; i < 4; ++i) {
                        const float gm1 = DPPF(DPPF(0.f, pvv[n][i], 0x121), c[i], 0x111);
                        const float gm2 = DPPF(DPPF(0.f, pvv[n][i], 0x122), c[i], 0x112);
                        const float cvv = k0[i] * gm2 + k1[i] * gm1 + k2[i] * c[i] + kb[i];
                        o[i] = cvv * __builtin_amdgcn_rcpf(1.f + __builtin_amdgcn_exp2f(-cvv * LOG2E)) * v[i];
                    }
                    w[2 * n] = pg8::cvt_pk_bf16(o[0], o[1]); w[2 * n + 1] = pg8::cvt_pk_bf16(o[2], o[3]);
                    pvv[n] = c;
                }
                *(u32x4*)(act + (size_t)row * DFF + jcol) = w;
            }
        }
    }
};
__device__ void act_fixup(const Params& p, int l, int pm) {
    if ((pm & 15) == 0) return;
    const float* eg = (const float*)(p.ws + WS_EG); const float* ev = (const float*)(p.ws + WS_EV); bf16_t* act = (bf16_t*)(p.ws + WS_ACT);
    const float* cw = p.conv_w + (size_t)l * 3 * DFF; const float* cbias = p.conv_b + (size_t)l * DFF;
    for (int idx = TID(); idx < 2 * DFF; idx += NTHR) {
        const int r = idx / DFF, j = idx - r * DFF;
        const float a = eg[((size_t)((pm - 1) * 4 + 2)) * DFF + j], bq = eg[((size_t)((pm - 1) * 4 + 3)) * DFF + j], c0 = eg[((size_t)(pm * 4 + 0)) * DFF + j], c1 = eg[((size_t)(pm * 4 + 1)) * DFF + j];
        const float gm2 = r ? bq : a, gm1 = r ? c0 : bq, gc = r ? c1 : c0;
        const float cvv = cw[j] * gm2 + cw[DFF + j] * gm1 + cw[2 * DFF + j] * gc + cbias[j];
        act[(size_t)(pm * 256 + r) * DFF + j] = f2bf(siluf(cvv) * ev[((size_t)(pm * 2 + r)) * DFF + j]);
    }
}

__device__ void ph_prep_knorm(const Params& p, int l) {
    bf16_t* proj = (bf16_t*)(p.ws + WS_PROJ);
    const int tid_ = TID(); const int lane = tid_ & 63, wv = tid_ >> 6;
    const int gw = blockIdx.x * (blockDim.x >> 6) + wv, ngw = gridDim.x * (blockDim.x >> 6);
    for (int row = gw; row < MTOK; row += ngw) {
        bf16_t* pr = proj + (size_t)row * PINP;
        {
            uint2 raw = *(const uint2*)(pr + CA_K + 4 * lane);
            float v0 = bf2f(raw.x & 0xffff), v1 = bf2f(raw.x >> 16), v2 = bf2f(raw.y & 0xffff), v3 = bf2f(raw.y >> 16);
            float ss = v0 * v0 + v1 * v1 + v2 * v2 + v3 * v3;
            ss += __shfl_xor(ss, 1); ss += __shfl_xor(ss, 2); ss += __shfl_xor(ss, 4);
            const float r = rsqrtf(ss * (1.f / 32.f) + EPS); const float* g = p.diff_kn + l * 32 + ((4 * lane) & 31);
            raw.x = pk2(v0 * r * g[0], v1 * r * g[1]); raw.y = pk2(v2 * r * g[2], v3 * r * g[3]);
            *(uint2*)(pr + CA_K + 4 * lane) = raw;
        }
        {
            uint2 raw = *(const uint2*)(pr + CB_K + 4 * lane);
            float v0 = bf2f(raw.x & 0xffff), v1 = bf2f(raw.x >> 16), v2 = bf2f(raw.y & 0xffff), v3 = bf2f(raw.y >> 16);
            float ss = v0 * v0 + v1 * v1 + v2 * v2 + v3 * v3;
            ss += __shfl_xor(ss, 1); ss += __shfl_xor(ss, 2); ss += __shfl_xor(ss, 4); ss += __shfl_xor(ss, 8);
            const float r = rsqrtf(ss * (1.f / 64.f) + EPS); const float* g = p.fox_kn + l * 64 + ((4 * lane) & 63);
            raw.x = pk2(v0 * r * g[0], v1 * r * g[1]); raw.y = pk2(v2 * r * g[2], v3 * r * g[3]);
            *(uint2*)(pr + CB_K + 4 * lane) = raw;
        }
        {
            const int hi = lane >> 5, li = lane & 31; bf16_t* q = pr + (hi ? CD_KW : CD_KS) + 2 * li;
            unsigned raw = *(const unsigned*)q; float v0 = bf2f(raw & 0xffff), v1 = bf2f(raw >> 16);
            float ss = v0 * v0 + v1 * v1;
            ss += __shfl_xor(ss, 1); ss += __shfl_xor(ss, 2); ss += __shfl_xor(ss, 4); ss += __shfl_xor(ss, 8); ss += __shfl_xor(ss, 16);
            const float r = rsqrtf(ss * (1.f / 64.f) + EPS); const float* g = p.nsa_kn + (l * 3 + (hi ? 2 : 1)) * 64 + 2 * li;
            *(unsigned*)q = pk2(v0 * r * g[0], v1 * r * g[1]);
        }
    }
}
__device__ void ph_prep_cum_bh(const Params& p, int l, int bh, unsigned char* lds) {
    const float* side = (const float*)(p.ws + WS_SIDE);
    float* cum = (float*)(p.ws + WS_CUM);
    LDSF float* wt = (LDSF float*)(lds + 70000);
    const int tid = TID(), lane = tid & 63, wv = tid >> 6;
    {
        const int b = bh >> 2, h = bh & 3; const float bf = p.fox_bf[l * 4 + h];
        float v[8]; float tot = 0.f;
#pragma unroll
        for (int i = 0; i < 8; ++i) { v[i] = logsigf(side[(size_t)(b * SEQ + tid * 8 + i) * 16 + h] + bf); tot += v[i]; v[i] = tot; }
        float inc = tot;
#pragma unroll
        for (int o = 1; o < 64; o <<= 1) { const float u = __shfl_up(inc, o); if (lane >= o) inc += u; }
        __syncthreads();
        if (lane == 63) wt[wv] = inc;
        __syncthreads();
        float base = inc - tot;
        for (int w8 = 0; w8 < wv; ++w8) base += wt[w8];
#pragma unroll
        for (int i = 0; i < 8; ++i) cum[bh * SEQ + tid * 8 + i] = base + v[i];
    }
}
__device__ void ph_prep_cmp(const Params& p, int l, unsigned char* lds) {
    const bf16_t* proj = (const bf16_t*)(p.ws + WS_PROJ);
    float* win = (float*)lds; float* red = (float*)(lds + 36864);
    const int tid = TID(), e = tid & 63, part = tid >> 6;
    for (int item = blockIdx.x; item < 4 * 2 * 32; item += gridDim.x) {
        const int b = item >> 6, which = (item >> 5) & 1, n0 = (item & 31) * 8;
        const int colbase = which ? CD_VC : CD_KC;
        __syncthreads();
        for (int i = tid; i < 144 * 64; i += NTHR) { const int tk = 16 * n0 + (i >> 6); win[i] = tk < SEQ ? bf2f(proj[(size_t)(b * SEQ + tk) * PINP + colbase + (i & 63)]) : 0.f; }
        __syncthreads();
        float acc[8];
#pragma unroll
        for (int nn = 0; nn < 8; ++nn) acc[nn] = 0.f;
        const float* phi = p.nsa_phi + (size_t)(l * 2 + which) * 2048 * 64; const float* pe = p.nsa_pe + (size_t)(l * 2 + which) * 32 * 64;
        for (int i = 4 * part; i < 4 * part + 4; ++i)
            for (int d = 0; d < 64; ++d) {
                const float ph = phi[(size_t)(i * 64 + d) * 64 + e], pv = pe[i * 64 + d];
#pragma unroll
                for (int nn = 0; nn < 8; ++nn) acc[nn] += (win[(16 * nn + i) * 64 + d] + pv) * ph;
            }
#pragma unroll
        for (int nn = 0; nn < 8; ++nn) red[(part * 8 + nn) * 64 + e] = acc[nn];
        __syncthreads();
        {
            const int nn = part, n = n0 + nn; float v = 0.f;
#pragma unroll
            for (int pp = 0; pp < 8; ++pp) v += red[(pp * 8 + nn) * 64 + e];
            bf16_t* dst = (bf16_t*)(p.ws + (which ? WS_VC : WS_KC)) + (size_t)(b * 256 + n) * 64 + e;
            if (n >= 255) *dst = 0;
            else if (which == 0) { const float ss = wave_sum(v * v); *dst = f2bf(v * rsqrtf(ss * (1.f / 64.f) + EPS) * p.nsa_kn[(l * 3 + 0) * 64 + e]); }
            else *dst = f2bf(v);
        }
    }
}

template <int N> __device__ __forceinline__ float dotn(const float* q, const bf16_t* k) {
    float s = 0.f;
#pragma unroll
    for (int c = 0; c < N / 8; ++c) { float t[8]; load8(k + 8 * c, t);
#pragma unroll
        for (int j = 0; j < 8; ++j) s += q[8 * c + j] * t[j]; }
    return s;
}
template <int N> __device__ __forceinline__ void axpyn(float* o, float w, const bf16_t* v) {
#pragma unroll
    for (int c = 0; c < N / 8; ++c) { float t[8]; load8(v + 8 * c, t);
#pragma unroll
        for (int j = 0; j < 8; ++j) o[8 * c + j] += w * t[j]; }
}
template <int N> __device__ __forceinline__ void loadq_norm(float* q, const bf16_t* src, const float* g, float scale, bool norm) {
    float ss = 0.f;
#pragma unroll
    for (int c = 0; c < N / 8; ++c) load8(src + 8 * c, q + 8 * c);
#pragma unroll
    for (int j = 0; j < N; ++j) ss += q[j] * q[j];
    const float r = norm ? rsqrtf(ss * (1.f / N) + EPS) : 1.f;
#pragma unroll
    for (int j = 0; j < N; ++j) q[j] = q[j] * r * (norm ? g[j] : 1.f) * scale;
}
__device__ __forceinline__ void store64(bf16_t* dst, const float* o) {
#pragma unroll
    for (int c = 0; c < 8; ++c) { u32x4 w; w[0] = pk2(o[8 * c], o[8 * c + 1]); w[1] = pk2(o[8 * c + 2], o[8 * c + 3]); w[2] = pk2(o[8 * c + 4], o[8 * c + 5]); w[3] = pk2(o[8 * c + 6], o[8 * c + 7]); *(u32x4*)(dst + 8 * c) = w; }
}

typedef float f32x16 __attribute__((ext_vector_type(16)));
typedef short s16x4 __attribute__((ext_vector_type(4)));
#define LDSP __attribute__((address_space(3)))
constexpr int KSTR = 144;
constexpr int AL_KV = 17408;
constexpr int AL_BK = 2 * AL_KV  , AL_TB = AL_BK + 512  , AL_WSF = AL_TB + 512  , AL_MISC = AL_WSF + 2048  ,
              AL_IMP = 38912  , AL_SELM = AL_IMP + 65536  ,
              AL_TB4 = AL_SELM + 512  , AL_INVL = AL_TB4 + 2048  , AL_D_END = AL_INVL + 1024;
static_assert(AL_MISC + 64 <= AL_IMP && AL_D_END <= 131072, "attention LDS map");
__device__ __forceinline__ int crow(int r, int hi) { return (r & 3) + 8 * (r >> 2) + 4 * hi; }
__device__ __forceinline__ float ex2(float v) { return __builtin_amdgcn_exp2f(v); }
__device__ __forceinline__ s16x4 vtr(const LDSP unsigned char* p) { typedef short v4i16_t __attribute__((ext_vector_type(4))); return __builtin_bit_cast(s16x4, __builtin_amdgcn_ds_read_tr16_b64_v4i16((LDSP v4i16_t*)p)); }
__device__ __forceinline__ bf16x8 pack8(const f32x16& p, int b) {
    u32x4 w; w[0] = pg8::cvt_pk_bf16(p[b], p[b + 1]); w[1] = pg8::cvt_pk_bf16(p[b + 2], p[b + 3]); w[2] = pg8::cvt_pk_bf16(p[b + 4], p[b + 5]); w[3] = pg8::cvt_pk_bf16(p[b + 6], p[b + 7]);
    return __builtin_bit_cast(bf16x8, w);
}
__device__ __forceinline__ f32x16 splat16(float v) { return (f32x16){v, v, v, v, v, v, v, v, v, v, v, v, v, v, v, v}; }
template <int NK16>
__device__ __forceinline__ void qkt(f32x16& p0, f32x16& p1, const LDSP unsigned char* Kt, const bf16x8* qf, int dbase, int r32, int hi) {
    const LDSP unsigned char* kb = Kt + r32 * KSTR + hi * 16 + dbase * 32;
#pragma unroll
    for (int d0 = 0; d0 < NK16; ++d0) {
        const bf16x8 a0 = *(const LDSP bf16x8*)(kb + d0 * 32), a1 = *(const LDSP bf16x8*)(kb + 32 * KSTR + d0 * 32);
        p0 = __builtin_amdgcn_mfma_f32_32x32x16_bf16(a0, qf[d0], p0, 0, 0, 0);
        p1 = __builtin_amdgcn_mfma_f32_32x32x16_bf16(a1, qf[d0], p1, 0, 0, 0);
    }
}
__device__ __forceinline__ void pv(f32x16* o, const LDSP unsigned char* Vt, int vb, const f32x16& p0, const f32x16& p1) {
    bf16x8 pa[4]; pa[0] = pack8(p0, 0); pa[1] = pack8(p0, 8); pa[2] = pack8(p1, 0); pa[3] = pack8(p1, 8);
#pragma unroll
    for (int d0 = 0; d0 < 2; ++d0)
#pragma unroll
        for (int ks = 0; ks < 4; ++ks) {
            const s16x4 lo = vtr(Vt + vb + d0 * 4096 + ks * 1024), hh = vtr(Vt + vb + d0 * 4096 + ks * 1024 + 512);
            const bf16x8 vf = (bf16x8){lo[0], lo[1], lo[2], lo[3], hh[0], hh[1], hh[2], hh[3]};
            o[d0] = __builtin_amdgcn_mfma_f32_32x32x16_bf16(pa[ks], vf, o[d0], 0, 0, 0);
        }
}
__device__ __forceinline__ float exp_sum(f32x16& p0, f32x16& p1) {
    float s0 = 0.f, s1 = 0.f;
#pragma unroll
    for (int r = 0; r < 16; ++r) { p0[r] = ex2(p0[r]); p1[r] = ex2(p1[r]); s0 += p0[r]; s1 += p1[r]; }
    return s0 + s1;
}
__device__ __forceinline__ void scale_rows(f32x16* o, float f, LDSP float* wsf, int r32, int hi) {
    __builtin_amdgcn_wave_barrier();
    if (hi == 0) wsf[r32] = f;
    __builtin_amdgcn_s_waitcnt(0xc07f);
    __builtin_amdgcn_wave_barrier();
#pragma unroll
    for (int g = 0; g < 4; ++g) { const f32x4 a = *(const LDSP f32x4*)(wsf + 8 * g + 4 * hi);
#pragma unroll
        for (int i = 0; i < 4; ++i) { o[0][4 * g + i] *= a[i]; o[1][4 * g + i] *= a[i]; } }
    __builtin_amdgcn_wave_barrier();
}
__device__ __forceinline__ void store_o(const f32x16* o, LDSP bf16_t* stg, bf16_t* dst, int lane, int r32, int hi) {
    __builtin_amdgcn_wave_barrier();
#pragma unroll
    for (int r = 0; r < 16; ++r) { const int orow = crow(r, hi); stg[orow * 64 + r32] = f2bf(o[0][r]); stg[orow * 64 + 32 + r32] = f2bf(o[1][r]); }
    __builtin_amdgcn_s_waitcnt(0xc07f);
    __builtin_amdgcn_wave_barrier();
#pragma unroll
    for (int i = 0; i < 4; ++i) { const int row = i * 8 + (lane >> 3), ch = lane & 7; const u32x4 v = *(const LDSP u32x4*)(stg + row * 64 + ch * 8); *(u32x4*)(dst + (size_t)row * DM + ch * 8) = v; }
    __builtin_amdgcn_s_waitcnt(0xc07f);
    __builtin_amdgcn_wave_barrier();
}
template <int NG>
__device__ __forceinline__ void load_q(bf16x8* qf, const bf16_t* qrow  , const float* g, float sc, bool norm, int hi) {
    float v[4][8];
#pragma unroll
    for (int d0 = 0; d0 < 4; ++d0) load8(qrow + 16 * d0 + 8 * hi, v[d0]);
    float r0 = 1.f, r1 = 1.f;
    if (norm) {
        float s0 = 0.f, s1 = 0.f;
#pragma unroll
        for (int j = 0; j < 8; ++j) { s0 += v[0][j] * v[0][j] + v[1][j] * v[1][j]; s1 += v[2][j] * v[2][j] + v[3][j] * v[3][j]; }
        s0 += __shfl_xor(s0, 32); s1 += __shfl_xor(s1, 32);
        if (NG == 64) { r0 = rsqrtf((s0 + s1) * (1.f / 64.f) + EPS); r1 = r0; } else { r0 = rsqrtf(s0 * (1.f / 32.f) + EPS); r1 = rsqrtf(s1 * (1.f / 32.f) + EPS); }
    }
#pragma unroll
    for (int d0 = 0; d0 < 4; ++d0) {
        const float rr = (d0 < 2 ? r0 : r1) * sc; float w[8];
#pragma unroll
        for (int j = 0; j < 8; ++j) { const int d = 16 * d0 + 8 * hi + j; w[j] = v[d0][j] * rr * (norm ? g[d % NG] : 1.f); }
        u32x4 u; u[0] = pg8::cvt_pk_bf16(w[0], w[1]); u[1] = pg8::cvt_pk_bf16(w[2], w[3]); u[2] = pg8::cvt_pk_bf16(w[4], w[5]); u[3] = pg8::cvt_pk_bf16(w[6], w[7]);
        qf[d0] = __builtin_bit_cast(bf16x8, u);
    }
}
__device__ __forceinline__ void kv_load(u32x4& kr, u32x4& vr, const bf16_t* Kb, const bf16_t* Vb, int k0, int tid) {
    const size_t off = (size_t)(k0 + (tid >> 3)) * PINP + (tid & 7) * 8;
    kr = *(const u32x4*)(Kb + off); vr = *(const u32x4*)(Vb + off);
}
__device__ __forceinline__ void kv_load64(u32x4& kr, u32x4& vr, const bf16_t* Kb, const bf16_t* Vb, int n0, int tid) {
    const size_t off = (size_t)(n0 + (tid >> 3)) * 64 + (tid & 7) * 8;
    kr = *(const u32x4*)(Kb + off); vr = *(const u32x4*)(Vb + off);
}
__device__ __forceinline__ void kv_store(const u32x4& kr, const u32x4& vr, LDSP unsigned char* buf, int tid) {
    const int key = tid >> 3, ch = tid & 7;
    *(LDSP u32x4*)(buf + key * KSTR + ch * 16) = kr;
    *(LDSP u32x4*)(buf + 9216 + (ch >> 2) * 4096 + (key >> 4) * 1024 + ((key >> 3) & 1) * 512 + (key & 7) * 64 + (ch & 3) * 16) = vr;
}
template <int NG>
__device__ __forceinline__ void knorm_chunk(u32x4& kr, const float* gp  ) {
    float v[8];
    v[0] = bf2f(kr[0] & 0xffff); v[1] = bf2f(kr[0] >> 16); v[2] = bf2f(kr[1] & 0xffff); v[3] = bf2f(kr[1] >> 16);
    v[4] = bf2f(kr[2] & 0xffff); v[5] = bf2f(kr[2] >> 16); v[6] = bf2f(kr[3] & 0xffff); v[7] = bf2f(kr[3] >> 16);
    float ss = 0.f;
#pragma unroll
    for (int j = 0; j < 8; ++j) ss += v[j] * v[j];
    ss += __shfl_xor(ss, 1); ss += __shfl_xor(ss, 2); if (NG == 64) ss += __shfl_xor(ss, 4);
    const float r = rsqrtf(ss * (1.f / NG) + EPS);
    const f32x4 ga = *(const f32x4*)gp, gb = *(const f32x4*)(gp + 4);
    kr[0] = pg8::cvt_pk_bf16(v[0] * r * ga[0], v[1] * r * ga[1]); kr[1] = pg8::cvt_pk_bf16(v[2] * r * ga[2], v[3] * r * ga[3]);
    kr[2] = pg8::cvt_pk_bf16(v[4] * r * gb[0], v[5] * r * gb[1]); kr[3] = pg8::cvt_pk_bf16(v[6] * r * gb[2], v[7] * r * gb[3]);
}
__device__ __forceinline__ void bias_near(f32x16& p0, f32x16& p1, const LDSP float* tbl, int tk0  , int wnd, bool rowok, int hi) {
#pragma unroll
    for (int g = 0; g < 4; ++g) {
#pragma unroll
        for (int i = 0; i < 4; ++i) { const int r = 4 * g + i; const int d0_ = tk0 - crow(r, hi), d1_ = d0_ - 32;
            const float b0 = tbl[min(max(d0_, 0), 127)], b1 = tbl[min(max(d1_, 0), 127)];
            p0[r] = (d0_ < 0 || d0_ >= wnd || !rowok) ? -INFINITY : p0[r] + b0; p1[r] = (d1_ < 0 || d1_ >= wnd || !rowok) ? -INFINITY : p1[r] + b1; }
        asm volatile("" ::: "memory");
    }
}
#define KVBUF(L, i) ((L) + ((i) & 1) * AL_KV)

__device__ void fa_fox_unit(const Params& p, int l, int b, int h, int qb, LDSP unsigned char* L) {
    const int tid = TID(), lane = tid & 63, wid = __builtin_amdgcn_readfirstlane(tid >> 6), r32 = lane & 31, hi = lane >> 5;
    const bf16_t* proj = (const bf16_t*)(p.ws + WS_PROJ); bf16_t* mix = (bf16_t*)(p.ws + WS_MIX);
    const size_t rb = (size_t)b * SEQ; const int q0 = qb * 256, qw = q0 + 32 * wid, t = qw + r32;
    const bf16_t* Kb = proj + rb * PINP + CB_K + 64 * h; const bf16_t* Vb = proj + rb * PINP + CB_V + 64 * h;
    const float* cm = (const float*)(p.ws + WS_CUM) + (b * 4 + h) * SEQ;
    LDSP float* wsf = (LDSP float*)(L + AL_WSF) + wid * 64; LDSP float* bk = (LDSP float*)(L + AL_BK);
    const int vb = 9216 + ((lane >> 4) & 1) * 32 + (lane & 3) * 8 + (4 * hi + ((lane & 15) >> 2)) * 64;
    bf16x8 qf[4]; load_q<64>(qf, proj + (rb + t) * PINP + CB_Q + 64 * h, p.fox_qn + l * 64, 0.125f * LOG2E, true, hi);
    const float rowc = cm[t] * LOG2E - ((const float*)(p.ws + WS_BND))[l * 32 + 4];
    f32x16 o[2]; o[0] = (f32x16){}; o[1] = (f32x16){};
    float l_run = 0.f;
    const int NT = 4 * qb + 4, jd = 4 * qb + (wid >> 1);
    u32x4 kr, vr; float cr = 0.f; const float* gk = p.fox_kn + l * 64 + (tid & 7) * 8;
    int js;
    {   const bool live = (lane < NT) ? ((cm[q0] - cm[64 * lane + 63]) * LOG2E >= -160.f) : false;
        const unsigned long long bm = __ballot(live);
        js = __builtin_amdgcn_readfirstlane((int)__builtin_ctzll(bm | (1ull << (NT - 1)))); if (js > NT - 2) js = NT - 2; }
    __syncthreads();
    kv_load(kr, vr, Kb, Vb, 64 * js, tid); if (tid < 64) cr = cm[64 * js + tid];
    kv_store(kr, vr, KVBUF(L, js), tid); if (tid < 64) bk[(js & 1) * 64 + tid] = -cr * LOG2E;
    kv_load(kr, vr, Kb, Vb, 64 * (js + 1), tid); if (tid < 64) cr = cm[64 * (js + 1) + tid];
    for (int j = js; j < NT; ++j) {
        __syncthreads();
        if (j + 1 < NT) { kv_store(kr, vr, KVBUF(L, j + 1), tid); if (tid < 64) bk[((j + 1) & 1) * 64 + tid] = -cr * LOG2E; }
        if (j + 2 < NT) { kv_load(kr, vr, Kb, Vb, 64 * (j + 2), tid); if (tid < 64) cr = cm[64 * (j + 2) + tid]; }
        if (j <= jd) {
            const LDSP unsigned char* buf = KVBUF(L, j); const LDSP float* bkj = bk + (j & 1) * 64;
            f32x16 p0, p1;
#pragma unroll
            for (int g = 0; g < 4; ++g) { const f32x4 b0 = *(const LDSP f32x4*)(bkj + 8 * g + 4 * hi), b1 = *(const LDSP f32x4*)(bkj + 32 + 8 * g + 4 * hi);
#pragma unroll
                for (int i = 0; i < 4; ++i) { p0[4 * g + i] = b0[i] + rowc; p1[4 * g + i] = b1[i] + rowc; } }
            qkt<4>(p0, p1, buf, qf, 0, r32, hi);
            if (j == jd) { const int k0 = 64 * j;
#pragma unroll
                for (int r = 0; r < 16; ++r) { const int kk = k0 + crow(r, hi); if (kk > t) p0[r] = -INFINITY; if (kk + 32 > t) p1[r] = -INFINITY; } }
            l_run += exp_sum(p0, p1);
            pv(o, buf, vb, p0, p1);
        }
    }
    l_run += __shfl_xor(l_run, 32);
    scale_rows(o, 1.f / l_run, wsf, r32, hi);
    store_o(o, (LDSP bf16_t*)(L + AL_IMP + wid * 8192), mix + (rb + qw) * DM + 256 + 64 * h, lane, r32, hi);
}

__device__ void fa_diff_unit(const Params& p, int l, int b, int h, int qb, LDSP unsigned char* L) {
    const int tid = TID(), lane = tid & 63, wid = __builtin_amdgcn_readfirstlane(tid >> 6), r32 = lane & 31, hi = lane >> 5;
    const bf16_t* proj = (const bf16_t*)(p.ws + WS_PROJ); bf16_t* mix = (bf16_t*)(p.ws + WS_MIX);
    const size_t rb = (size_t)b * SEQ; const int q0 = qb * 256, qw = q0 + 32 * wid, t = qw + r32;
    const bf16_t* Kb = proj + rb * PINP + CA_K + 64 * h; const bf16_t* Vb = proj + rb * PINP + CA_V + 64 * h;
    LDSP float* wsf = (LDSP float*)(L + AL_WSF) + wid * 64; LDSP float* tbl = (LDSP float*)(L + AL_TB);
    const int vb = 9216 + ((lane >> 4) & 1) * 32 + (lane & 3) * 8 + (4 * hi + ((lane & 15) >> 2)) * 64;
    const float lam = ((const float*)(p.ws + WS_LAM))[l]; const float lam_init = 0.8f - 0.6f * __expf(-0.3f * (float)l);
    const float nbound = -((const float*)(p.ws + WS_BND))[l * 32 + h];
    __syncthreads();
    if (tid < 128) tbl[tid] = ((const float*)(p.ws + WS_TB))[h * 128 + tid] * LOG2E;
    bf16x8 qf[4]; load_q<32>(qf, proj + (rb + t) * PINP + CA_Q + 64 * h, p.diff_qn + l * 32, 0.17677669529663687f * LOG2E, true, hi);
    f32x16 o1[2], o2[2]; o1[0] = (f32x16){}; o1[1] = (f32x16){}; o2[0] = (f32x16){}; o2[1] = (f32x16){};
    float l1 = 0.f, l2 = 0.f;
    const int NT = 4 * qb + 4, jd = 4 * qb + (wid >> 1);
    u32x4 kr, vr; const float* gk = p.diff_kn + l * 32 + (tid & 3) * 8;
    kv_load(kr, vr, Kb, Vb, 0, tid);
    kv_store(kr, vr, KVBUF(L, 0), tid);
    kv_load(kr, vr, Kb, Vb, 64, tid);
    for (int j = 0; j < NT; ++j) {
        __syncthreads();
        if (j + 1 < NT) { kv_store(kr, vr, KVBUF(L, j + 1), tid); }
        if (j + 2 < NT) kv_load(kr, vr, Kb, Vb, 64 * (j + 2), tid);
        if (j <= jd) {
            const LDSP unsigned char* buf = KVBUF(L, j);
            const int k0 = 64 * j; const bool nearb = (qw - (k0 + 63)) < 113; const float cfar = tbl[127] + nbound;
#pragma unroll
            for (int mp = 0; mp < 2; ++mp) {
                f32x16 p0 = splat16(nearb ? nbound : cfar), p1 = p0;
                qkt<2>(p0, p1, buf, qf + 2 * mp, 2 * mp, r32, hi);
                if (nearb) bias_near(p0, p1, tbl, t - k0, 1 << 30, true, hi);
                if (mp == 0) { l1 += exp_sum(p0, p1); pv(o1, buf, vb, p0, p1); }
                else { l2 += exp_sum(p0, p1); pv(o2, buf, vb, p0, p1); }
            }
        }
    }
    l1 += __shfl_xor(l1, 32); l2 += __shfl_xor(l2, 32);
    scale_rows(o1, 1.f / l1, wsf, r32, hi); scale_rows(o2, lam / l2, wsf, r32, hi);
    o1[0] -= o2[0]; o1[1] -= o2[1];
    const float g0 = p.diff_sub[l * 64 + r32] * (1.f - lam_init), g1 = p.diff_sub[l * 64 + 32 + r32] * (1.f - lam_init);
#pragma unroll
    for (int r = 0; r < 16; ++r) {
        float ss = o1[0][r] * o1[0][r] + o1[1][r] * o1[1][r];
        ss += __shfl_xor(ss, 1); ss += __shfl_xor(ss, 2); ss += __shfl_xor(ss, 4); ss += __shfl_xor(ss, 8); ss += __shfl_xor(ss, 16);
        const float rs = rsqrtf(ss * (1.f / 64.f) + EPS); o1[0][r] *= rs * g0; o1[1][r] *= rs * g1;
    }
    store_o(o1, (LDSP bf16_t*)(L + AL_IMP + wid * 8192), mix + (rb + qw) * DM + 0 + 64 * h, lane, r32, hi);
}

template <bool DIAG>
__device__ __forceinline__ void stick_sub(f32x16& y, float& carry, int kbase  , int t, int hi) {
    float lk[16];
#pragma unroll
    for (int r = 0; r < 16; ++r) {
        const float v = y[r]; const float e = ex2(-fabsf(v)); const float lb = fminf(v, 0.f) - __builtin_amdgcn_logf(1.f + e);
        if (DIAG) { const bool valid = (kbase + crow(r, hi) < t); lk[r] = valid ? (lb - v) : 0.f; y[r] = valid ? lb : -INFINITY; }
        else { lk[r] = lb - v; y[r] = lb; }
    }
    float T[4], Go[4];
#pragma unroll
    for (int g = 0; g < 4; ++g) { const float Gs = (lk[4 * g] + lk[4 * g + 1]) + (lk[4 * g + 2] + lk[4 * g + 3]); Go[g] = __shfl_xor(Gs, 32); T[g] = Gs + Go[g]; }
    float sx = 0.f;
#pragma unroll
    for (int g = 3; g >= 0; --g) {
        float tail = carry + sx + (hi == 0 ? Go[g] : 0.f);
#pragma unroll
        for (int i = 3; i >= 0; --i) { y[4 * g + i] = ex2(y[4 * g + i] + tail); tail += lk[4 * g + i]; }
        sx += T[g];
    }
    carry += sx;
}
__device__ void fa_stick_unit(const Params& p, int l, int b, int h, int qb, LDSP unsigned char* L) {
    const int tid = TID(), lane = tid & 63, wid = __builtin_amdgcn_readfirstlane(tid >> 6), r32 = lane & 31, hi = lane >> 5;
    const bf16_t* proj = (const bf16_t*)(p.ws + WS_PROJ); bf16_t* mix = (bf16_t*)(p.ws + WS_MIX);
    const size_t rb = (size_t)b * SEQ; const int q0 = qb * 256, qw = q0 + 32 * wid, t = qw + r32;
    const bf16_t* Kb = proj + rb * PINP + CC_K + 64 * h; const bf16_t* Vb = proj + rb * PINP + CC_V + 64 * h;
    const int vb = 9216 + ((lane >> 4) & 1) * 32 + (lane & 3) * 8 + (4 * hi + ((lane & 15) >> 2)) * 64;
    bf16x8 qf[4]; load_q<64>(qf, proj + (rb + t) * PINP + CC_Q + 64 * h, nullptr, 0.125f * LOG2E, false, hi);
    f32x16 o[2]; o[0] = (f32x16){}; o[1] = (f32x16){};
    float carry = 0.f;
    const int NT = 4 * qb + 4, jd = 4 * qb + (wid >> 1);
    u32x4 kr, vr;
#define SBUF(i) (((i) & 1) ? (L + 108544) : L)
    LDSP unsigned* dn = (LDSP unsigned*)(L + AL_MISC) + 8;
    bool wdone = false;
    __syncthreads();
    if (lane == 0) dn[wid] = 0u;
    kv_load(kr, vr, Kb, Vb, 64 * (NT - 1), tid);
    kv_store(kr, vr, SBUF(NT - 1), tid);
    kv_load(kr, vr, Kb, Vb, 64 * (NT - 2), tid);
    for (int j = NT - 1; j >= 0; --j) {
        __syncthreads();
        if (__all(dn[lane & 7] != 0u)) break;
        if (j >= 1) kv_store(kr, vr, SBUF(j - 1), tid);
        if (j >= 2) kv_load(kr, vr, Kb, Vb, 64 * (j - 2), tid);
        if (j <= jd && !wdone) {
            const LDSP unsigned char* buf = SBUF(j);
            f32x16 p0 = (f32x16){}, p1 = (f32x16){};
            qkt<4>(p0, p1, buf, qf, 0, r32, hi);
            const int k0 = 64 * j; const bool diag = (j == jd);
            if (diag) { stick_sub<true>(p1, carry, k0 + 32, t, hi); stick_sub<true>(p0, carry, k0, t, hi); }
            else { stick_sub<false>(p1, carry, k0 + 32, t, hi); stick_sub<false>(p0, carry, k0, t, hi); }
            pv(o, buf, vb, p0, p1);
            if (__all(carry < -160.f)) { wdone = true; if (lane == 0) dn[wid] = 1u; }
        }
    }
    store_o(o, (LDSP bf16_t*)(L + AL_IMP + wid * 8192), mix + (rb + qw) * DM + 512 + 64 * h, lane, r32, hi);
}

__device__ void fa_nsa_unit(const Params& p, int l, int b, int u, LDSP unsigned char* L) {
    const int tid = TID(), lane = tid & 63, wid = __builtin_amdgcn_readfirstlane(tid >> 6), r32 = lane & 31, hi = lane >> 5;
    const int hh = wid >> 1, sub = wid & 1;
    const bf16_t* proj = (const bf16_t*)(p.ws + WS_PROJ); bf16_t* mix = (bf16_t*)(p.ws + WS_MIX);
    const size_t rb = (size_t)b * SEQ; const int q0 = 64 * u, qw = q0 + 32 * sub, t = qw + r32; const int ql = 32 * sub + r32;
    LDSP float* wsf = (LDSP float*)(L + AL_WSF) + wid * 64; LDSP float* tbl = (LDSP float*)(L + AL_TB4) + hh * 128;
    LDSP float* imp = (LDSP float*)(L + AL_IMP); LDSP unsigned* selm = (LDSP unsigned*)(L + AL_SELM); LDSP float* invl = (LDSP float*)(L + AL_INVL);
    LDSP float* ofl = (LDSP float*)(L + AL_IMP) + wid * 2048 + lane;
    const int vb = 9216 + ((lane >> 4) & 1) * 32 + (lane & 3) * 8 + (4 * hi + ((lane & 15) >> 2)) * 64;
    const float* bnd = (const float*)(p.ws + WS_BND) + l * 32;
    __syncthreads();
    ((LDSP float*)(L + AL_TB4))[tid] = ((const float*)(p.ws + WS_TB))[512 + tid] * LOG2E;
    bf16x8 qf[4]; load_q<64>(qf, proj + (rb + t) * PINP + CD_Q + 64 * hh, p.nsa_qn + l * 64, 0.125f * LOG2E, true, hi);
    const float* sd = (const float*)(p.ws + WS_SIDE) + (rb + t) * 16 + 4 + hh;
    const float gc = 1.f / (1.f + __expf(-sd[0])), gs = 1.f / (1.f + __expf(-sd[4])), gwn = 1.f / (1.f + __expf(-sd[8]));
    f32x16 o[2]; o[0] = (f32x16){}; o[1] = (f32x16){};
    u32x4 kr, vr;
    {
        const bf16_t* Kc = (const bf16_t*)(p.ws + WS_KC) + (size_t)b * 256 * 64; const bf16_t* Vc = (const bf16_t*)(p.ws + WS_VC) + (size_t)b * 256 * 64;
        const int ntc = (4 * u + 2) / 64 + 1; const float nbound = -bnd[5 + hh];
        float l_run = 0.f, prevE3 = 0.f;
        kv_load64(kr, vr, Kc, Vc, 0, tid);
        kv_store(kr, vr, KVBUF(L, 0), tid);
        if (ntc > 1) kv_load64(kr, vr, Kc, Vc, 64, tid);
        for (int T = 0; T < ntc; ++T) {
            __syncthreads();
            if (T + 1 < ntc) kv_store(kr, vr, KVBUF(L, T + 1), tid);
            if (T + 2 < ntc) kv_load64(kr, vr, Kc, Vc, 64 * (T + 2), tid);
            const LDSP unsigned char* buf = KVBUF(L, T);
            f32x16 p0 = splat16(nbound), p1 = p0;
            qkt<4>(p0, p1, buf, qf, 0, r32, hi);
#pragma unroll
            for (int g = 0; g < 4; ++g) {
#pragma unroll
                for (int i = 0; i < 4; ++i) { const int r = 4 * g + i; const int d0_ = t - 16 * (64 * T + crow(r, hi)) - 31, d1_ = d0_ - 512;
                    const float b0 = tbl[min(max(d0_, 0), 127)], b1 = tbl[min(max(d1_, 0), 127)];
                    p0[r] = (d0_ < 0) ? -INFINITY : p0[r] + b0; p1[r] = (d1_ < 0) ? -INFINITY : p1[r] + b1; }
                asm volatile("" ::: "memory");
            }
            l_run += exp_sum(p0, p1);
#pragma unroll
            for (int s2 = 0; s2 < 2; ++s2) {
                float G[4], Eo[4];
#pragma unroll
                for (int g = 0; g < 4; ++g) { const float a0 = s2 ? p1[4 * g] : p0[4 * g], a1 = s2 ? p1[4 * g + 1] : p0[4 * g + 1], a2 = s2 ? p1[4 * g + 2] : p0[4 * g + 2], a3 = s2 ? p1[4 * g + 3] : p0[4 * g + 3];
                    G[g] = (a0 + a1) + (a2 + a3); Eo[g] = __shfl_xor(a3, 32); }
#pragma unroll
                for (int g = 0; g < 4; ++g) { const float eprev = hi ? Eo[g] : (g > 0 ? Eo[g - 1] : prevE3);
                    imp[(hh * 64 + ql) * 64 + 16 * T + 8 * s2 + 2 * g + hi] = G[g] + eprev; }
                prevE3 = Eo[3];
            }
            pv(o, buf, vb, p0, p1);
        }
        l_run += __shfl_xor(l_run, 32);
        const float inv = (l_run > 0.f) ? 1.f / l_run : 0.f;
        if (hi == 0) invl[hh * 64 + ql] = inv;
        scale_rows(o, gc * inv, wsf, r32, hi);
    }
    __syncthreads();
    {
        const int q = tid >> 3, part = tid & 7;
        const float i0 = invl[q], i1 = invl[64 + q], i2 = invl[128 + q], i3 = invl[192 + q];
        float vj[8];
#pragma unroll
        for (int jj = 0; jj < 8; ++jj) { const int j = part * 8 + jj;
            const float sum = ((imp[(0 * 64 + q) * 64 + j] * i0 + imp[(1 * 64 + q) * 64 + j] * i1) + imp[(2 * 64 + q) * 64 + j] * i2) + imp[(3 * 64 + q) * 64 + j] * i3;
            vj[jj] = (j > u) ? -1.0f : ((j == u || j == 0) ? 1.0e4f : sum); }
        __syncthreads();
#pragma unroll
        for (int jj = 0; jj < 8; ++jj) imp[q * 64 + part * 8 + jj] = vj[jj];
        __syncthreads();
        int rank[8];
#pragma unroll
        for (int jj = 0; jj < 8; ++jj) rank[jj] = 0;
        for (int i = 0; i < 64; ++i) { const float vi = imp[q * 64 + i];
#pragma unroll
            for (int jj = 0; jj < 8; ++jj) rank[jj] += (vi > vj[jj] || (vi == vj[jj] && i < part * 8 + jj)) ? 1 : 0; }
        unsigned bits = 0;
#pragma unroll
        for (int jj = 0; jj < 8; ++jj) if (rank[jj] < 16 && (part * 8 + jj) <= u) bits |= 1u << jj;
        unsigned mlo = (part < 4) ? (bits << (8 * part)) : 0u, mhi = (part >= 4) ? (bits << (8 * (part - 4))) : 0u;
        mlo |= __shfl_xor(mlo, 1); mhi |= __shfl_xor(mhi, 1); mlo |= __shfl_xor(mlo, 2); mhi |= __shfl_xor(mhi, 2); mlo |= __shfl_xor(mlo, 4); mhi |= __shfl_xor(mhi, 4);
        if (part == 0) { selm[2 * q] = mlo; selm[2 * q + 1] = mhi; }
    }
    __syncthreads();
#pragma unroll
    for (int r = 0; r < 16; ++r) { ofl[(2 * r) * 64] = o[0][r]; ofl[(2 * r + 1) * 64] = o[1][r]; }
    o[0] = (f32x16){}; o[1] = (f32x16){};
    {
        const unsigned long long mymask = (unsigned long long)selm[2 * ql] | ((unsigned long long)selm[2 * ql + 1] << 32);
        unsigned ulo = selm[2 * lane], uhi = selm[2 * lane + 1];
#pragma unroll
        for (int s2 = 1; s2 < 64; s2 <<= 1) { ulo |= __shfl_xor(ulo, s2); uhi |= __shfl_xor(uhi, s2); }
        unsigned long long um = (unsigned long long)(unsigned)__builtin_amdgcn_readfirstlane((int)ulo) | ((unsigned long long)(unsigned)__builtin_amdgcn_readfirstlane((int)uhi) << 32);
        const bf16_t* Kb = proj + rb * PINP + CD_KS; const bf16_t* Vb = proj + rb * PINP + CD_VS;
        float l_run = 0.f; const float nbound = -bnd[9 + hh]; const float cfar = tbl[127] + nbound; const float* gk = p.nsa_kn + (l * 3 + 1) * 64 + (tid & 7) * 8;
        int j = __builtin_ctzll(um); um &= um - 1;
        int jn = um ? __builtin_ctzll(um) : -1; um &= um - 1;
        kv_load(kr, vr, Kb, Vb, 64 * j, tid);
        kv_store(kr, vr, KVBUF(L, 0), tid);
        if (jn >= 0) kv_load(kr, vr, Kb, Vb, 64 * jn, tid);
        for (int it = 0;; ++it) {
            __syncthreads();
            const int jnn = um ? __builtin_ctzll(um) : -1; um &= um - 1;
            if (jn >= 0) { kv_store(kr, vr, KVBUF(L, it + 1), tid); }
            if (jnn >= 0) kv_load(kr, vr, Kb, Vb, 64 * jnn, tid);
            const bool mine = (mymask >> j) & 1ull;
            if (__any(mine)) {
                const LDSP unsigned char* buf = KVBUF(L, it);
                const int k0 = 64 * j; const bool nearb = (qw - (k0 + 63)) < 113;
                f32x16 p0 = splat16(nearb ? nbound : (mine ? cfar : -INFINITY)), p1 = p0;
                qkt<4>(p0, p1, buf, qf, 0, r32, hi);
                if (nearb) bias_near(p0, p1, tbl, t - k0, 1 << 30, mine, hi);
                l_run += exp_sum(p0, p1);
                pv(o, buf, vb, p0, p1);
            }
            if (jn < 0) break;
            j = jn; jn = jnn;
        }
        l_run += __shfl_xor(l_run, 32);
        scale_rows(o, gs / l_run, wsf, r32, hi);
#pragma unroll
        for (int r = 0; r < 16; ++r) { ofl[(2 * r) * 64] += o[0][r]; ofl[(2 * r + 1) * 64] += o[1][r]; }
        o[0] = (f32x16){}; o[1] = (f32x16){};
    }
    {
        const bf16_t* Kb = proj + rb * PINP + CD_KW; const bf16_t* Vb = proj + rb * PINP + CD_VW;
        float l_run = 0.f; const float nbound = -bnd[13 + hh]; const float cfar = tbl[127] + nbound; const float* gk = p.nsa_kn + (l * 3 + 2) * 64 + (tid & 7) * 8;
        const int jlo = max(0, u - 8);
        __syncthreads();
        kv_load(kr, vr, Kb, Vb, 64 * jlo, tid);
        kv_store(kr, vr, KVBUF(L, jlo), tid);
        if (jlo < u) kv_load(kr, vr, Kb, Vb, 64 * (jlo + 1), tid);
        for (int j = jlo; j <= u; ++j) {
            __syncthreads();
            if (j + 1 <= u) { kv_store(kr, vr, KVBUF(L, j + 1), tid); }
            if (j + 2 <= u) kv_load(kr, vr, Kb, Vb, 64 * (j + 2), tid);
            const LDSP unsigned char* buf = KVBUF(L, j);
            const int k0 = 64 * j; const bool nearb = (j == u || j == u - 8 || (qw - (k0 + 63)) < 113);
            f32x16 p0 = splat16(nearb ? nbound : cfar), p1 = p0;
            qkt<4>(p0, p1, buf, qf, 0, r32, hi);
            if (nearb) bias_near(p0, p1, tbl, t - k0, 512, true, hi);
            l_run += exp_sum(p0, p1);
            pv(o, buf, vb, p0, p1);
        }
        l_run += __shfl_xor(l_run, 32);
        scale_rows(o, gwn / l_run, wsf, r32, hi);
#pragma unroll
        for (int r = 0; r < 16; ++r) { o[0][r] += ofl[(2 * r) * 64]; o[1][r] += ofl[(2 * r + 1) * 64]; }
    }
    store_o(o, (LDSP bf16_t*)(L + AL_IMP + wid * 8192), mix + (rb + qw) * DM + 768 + 64 * hh, lane, r32, hi);
}

__device__ void ph_reset_queues(const Params& p) { unsigned* ctl = (unsigned*)(p.ws + WS_CTL); const int gt = GTID(); if (gt < 8) ctl[gt] = 0u; }
__device__ void prep_cmp_task(const Params& p, int l, int task, LDSP unsigned char* L) {
    const int tid = TID(), lane = tid & 63, wid = __builtin_amdgcn_readfirstlane(tid >> 6), r32 = lane & 31, hi = lane >> 5;
    const int b = task >> 4, which = (task >> 3) & 1, nt = task & 7;
    const bf16_t* proj = (const bf16_t*)(p.ws + WS_PROJ);
    const bf16_t* phiT = (const bf16_t*)(p.ws + WS_PHIT) + (size_t)(l * 2 + which) * 64 * 2048;
    const float* pe = p.nsa_pe + (size_t)(l * 2 + which) * 32 * 64;
    const int n = 32 * nt + r32, colbase = which ? CD_VC : CD_KC;
    f32x16 acc0 = (f32x16){}, acc1 = (f32x16){};
#pragma unroll
    for (int ii = 0; ii < 4; ++ii) {
        const int i = 4 * wid + ii; const int tok = min(16 * n + i, SEQ - 1);
        const bf16_t* xr = proj + (size_t)(b * SEQ + tok) * PINP + colbase;
#pragma unroll
        for (int d0 = 0; d0 < 4; ++d0) {
            float xv[8]; load8(xr + 16 * d0 + 8 * hi, xv);
            const f32x4 pe0 = *(const f32x4*)(pe + i * 64 + 16 * d0 + 8 * hi), pe1 = *(const f32x4*)(pe + i * 64 + 16 * d0 + 8 * hi + 4);
            u32x4 aw; aw[0] = pg8::cvt_pk_bf16(xv[0] + pe0[0], xv[1] + pe0[1]); aw[1] = pg8::cvt_pk_bf16(xv[2] + pe0[2], xv[3] + pe0[3]);
            aw[2] = pg8::cvt_pk_bf16(xv[4] + pe1[0], xv[5] + pe1[1]); aw[3] = pg8::cvt_pk_bf16(xv[6] + pe1[2], xv[7] + pe1[3]);
            const bf16x8 af = __builtin_bit_cast(bf16x8, aw);
            const bf16x8 b0 = *(const bf16x8*)(phiT + (size_t)r32 * 2048 + i * 64 + 16 * d0 + 8 * hi);
            const bf16x8 b1 = *(const bf16x8*)(phiT + (size_t)(32 + r32) * 2048 + i * 64 + 16 * d0 + 8 * hi);
            acc0 = __builtin_amdgcn_mfma_f32_32x32x16_bf16(af, b0, acc0, 0, 0, 0);
            acc1 = __builtin_amdgcn_mfma_f32_32x32x16_bf16(af, b1, acc1, 0, 0, 0);
        }
    }
    LDSP float* red = (LDSP float*)L;
    __syncthreads();
#pragma unroll
    for (int r = 0; r < 16; ++r) { red[(wid * 32 + crow(r, hi)) * 64 + r32] = acc0[r]; red[(wid * 32 + crow(r, hi)) * 64 + 32 + r32] = acc1[r]; }
    __syncthreads();
    {
        const int row = tid >> 4, e4 = (tid & 15) * 4; f32x4 v = (f32x4){0.f, 0.f, 0.f, 0.f};
#pragma unroll
        for (int w8 = 0; w8 < 8; ++w8) v += *(const LDSP f32x4*)(red + (w8 * 32 + row) * 64 + e4);
        const int nn = 32 * nt + row;
        if (which == 0) {
            float ss = (v[0] * v[0] + v[1] * v[1]) + (v[2] * v[2] + v[3] * v[3]);
            ss += __shfl_xor(ss, 1); ss += __shfl_xor(ss, 2); ss += __shfl_xor(ss, 4); ss += __shfl_xor(ss, 8);
            const float rs = rsqrtf(ss * (1.f / 64.f) + EPS); const f32x4 g = *(const f32x4*)(p.nsa_kn + (l * 3 + 0) * 64 + e4);
            v = v * rs * g;
        }
        uint2 o; o.x = pk2(v[0], v[1]); o.y = pk2(v[2], v[3]);
        if (nn >= 255) { o.x = 0u; o.y = 0u; }
        *(uint2*)((bf16_t*)(p.ws + (which ? WS_VC : WS_KC)) + (size_t)(b * 256 + nn) * 64 + e4) = o;
    }
}
__device__ void ph_prep(const Params& p, int l, LDSP unsigned char* L, unsigned char* lds) {
    for (int t = blockIdx.x; t < 80; t += gridDim.x) { if (t < 64) prep_cmp_task(p, l, t, L); }
    if (gridDim.x >= 80) { if (blockIdx.x >= 64 && blockIdx.x < 80) ph_prep_cum_bh(p, l, blockIdx.x - 64, lds); }
    else for (int bh = blockIdx.x; bh < 16; bh += gridDim.x) ph_prep_cum_bh(p, l, bh, lds);
}


__device__ void fa_phase_all(const Params& p, int l, LDSP unsigned char* L, unsigned char* lds, int qslot) {
    unsigned* ctl = (unsigned*)(p.ws + WS_CTL);
    LDSP unsigned* misc = (LDSP unsigned*)(L + AL_MISC);
    bool prep_ok = false;
    for (;;) {
        __syncthreads();
        if (threadIdx.x == 0) misc[0] = atomicAdd(&ctl[qslot], 1u);
        __syncthreads();
        const unsigned qi0 = misc[0];
        if (qi0 >= 1104u) break;
        if (qi0 < 80u) {
            if (qi0 < 64u) prep_cmp_task(p, l, (int)qi0, L); else ph_prep_cum_bh(p, l, (int)qi0 - 64, lds);
            asm volatile("s_waitcnt vmcnt(0)" ::: "memory");
            __syncthreads();
            if (threadIdx.x == 0) { __threadfence(); atomicAdd(&ctl[4 + qslot], 1u); }
            continue;
        }
        const unsigned qi = qi0 - 80u;
        const int r = 15 - (int)(qi >> 6), j = (int)(qi & 63), typ = j >> 4, sub = j & 15;
        if ((typ == 2 || typ == 3) && !prep_ok) {
            if (threadIdx.x == 0) { while (__hip_atomic_load(&ctl[4 + qslot], __ATOMIC_RELAXED, __HIP_MEMORY_SCOPE_AGENT) < 80u) __builtin_amdgcn_s_sleep(8); __threadfence(); }
            asm volatile("s_waitcnt vmcnt(0)" ::: "memory");
            __syncthreads();
            prep_ok = true;
        }
        if (typ == 0) fa_diff_unit(p, l, sub >> 2, sub & 3, r, L);
        else if (typ == 1) fa_stick_unit(p, l, sub >> 2, sub & 3, r, L);
        else if (typ == 2) fa_fox_unit(p, l, sub >> 2, sub & 3, r, L);
        else fa_nsa_unit(p, l, sub >> 2, 4 * r + (sub & 3), L);
    }
}

#define XB_TMO      128
#define XB_XCNT(j)  (256  + 64 * (j))
#define XB_XSUB(j)  (1280 + 64 * (j))
#define XB_XGEN(j)  (2304 + 64 * (j))
#define XB_TOP      3328
#define XB_TOPGEN   3392
#define XCD_BAR_WORDS 3456
#define XB_SPIN_CAP (1u << 18)

__device__ __forceinline__ unsigned xb_ld(unsigned* p)              { return __hip_atomic_load(p, __ATOMIC_RELAXED, __HIP_MEMORY_SCOPE_AGENT); }
__device__ __forceinline__ unsigned xb_add(unsigned* p, unsigned v) { return __hip_atomic_fetch_add(p, v, __ATOMIC_RELAXED, __HIP_MEMORY_SCOPE_AGENT); }
__device__ __forceinline__ unsigned xb_xcc_id() { return (unsigned)__builtin_amdgcn_s_getreg((3 << 11) | 20) & 0xFu; }
#define XB_SPIN(cond, bar) do { unsigned _sp = 0; while (cond) { __builtin_amdgcn_s_sleep(1); \
    if ((++_sp & 255u) == 0u) { if (xb_ld(&(bar)[XB_TMO])) break; if (_sp > XB_SPIN_CAP) { atomicAdd(&(bar)[XB_TMO], 1u); break; } } } } while (0)

struct XcdBarrier {
    unsigned* bar; unsigned x;
    volatile LDSF unsigned* st;
};

__device__ __forceinline__ XcdBarrier xcd_barrier_post(unsigned* bar, volatile LDSF unsigned* st) {
    XcdBarrier b; b.bar = bar; b.x = xb_xcc_id(); b.st = st;
    if (threadIdx.x == 0) (void)xb_add(&bar[XB_XCNT(b.x)], 1u);
    return b;
}
__device__ __forceinline__ void xcd_barrier_complete(unsigned* bar, unsigned x, unsigned& nloc, unsigned& nx) {
    const unsigned G = gridDim.x * gridDim.y * gridDim.z;
    unsigned sum, cnt, mine, sp = 0u;
    for (;;) {
        sum = 0u; cnt = 0u; mine = 0u;
#pragma unroll
        for (unsigned j = 0; j < 16; ++j) { const unsigned c = xb_ld(&bar[XB_XCNT(j)]); sum += c; cnt += (c > 0u) ? 1u : 0u; mine = (j == x) ? c : mine; }
        if (sum == G) break;
        __builtin_amdgcn_s_sleep(1);
        if ((++sp & 255u) == 0u) { if (xb_ld(&bar[XB_TMO])) break; if (sp > XB_SPIN_CAP) { atomicAdd(&bar[XB_TMO], 1u); break; } }
    }
    nloc = mine > 0u ? mine : 1u; nx = cnt > 0u ? cnt : 1u;
}

__device__ __forceinline__ void xcd_barrier(const XcdBarrier& b) {
    asm volatile("s_waitcnt vmcnt(0)" ::: "memory");
    __syncthreads();
    if (threadIdx.x == 0) {
        unsigned* bar = b.bar;
        __builtin_amdgcn_s_waitcnt(0);
        unsigned nloc = b.st[0], nx = b.st[1];
        if (nloc == 0u) { xcd_barrier_complete(bar, b.x, nloc, nx); b.st[0] = nloc; b.st[1] = nx; }
        const unsigned old = xb_add(&bar[XB_XSUB(b.x)], 1u);
        const unsigned gen = old / nloc;
        if (old + 1u == (gen + 1u) * nloc) {
            __builtin_amdgcn_fence(__ATOMIC_RELEASE, "agent");
            asm volatile("s_waitcnt vmcnt(0)" ::: "memory");
            const unsigned og = xb_add(&bar[XB_TOP], 1u);
            const unsigned tg = og / nx;
            if (og + 1u == (tg + 1u) * nx) xb_add(&bar[XB_TOPGEN], 1u);
            else XB_SPIN(xb_ld(&bar[XB_TOPGEN]) == tg, bar);
            __builtin_amdgcn_fence(__ATOMIC_ACQUIRE, "agent");
            xb_add(&bar[XB_XGEN(b.x)], 1u);
            asm volatile("s_waitcnt vmcnt(0)" ::: "memory");
        } else {
            XB_SPIN(xb_ld(&bar[XB_XGEN(b.x)]) == gen, bar);
            __builtin_amdgcn_fence(__ATOMIC_ACQUIRE, "agent");
            asm volatile("s_waitcnt vmcnt(0)" ::: "memory");
        }
    }
    __syncthreads();
}

namespace cg = cooperative_groups;
constexpr int LDS_BYTES = 131072 + 8192 + 4096;
#define LAS3 __attribute__((address_space(3)))
#ifndef PROBE
#define PROBE 0
#endif
__global__ void __launch_bounds__(NTHR, 2) mega(Params p) {
    extern __shared__ __attribute__((aligned(16))) unsigned char lds[];
    cg::grid_group grid = cg::this_grid();
#if PROBE
    unsigned long long tacc = 0, tph = 0, t0_;
#define GSYNC() do { t0_ = __builtin_amdgcn_s_memrealtime(); xcd_barrier(xbar); tacc += __builtin_amdgcn_s_memrealtime() - t0_; } while (0)
#define TPK(k, ...) do { if (PROBE == (k)) { t0_ = __builtin_amdgcn_s_memrealtime(); __VA_ARGS__; tph += __builtin_amdgcn_s_memrealtime() - t0_; } else { __VA_ARGS__; } } while (0)
#else
#define GSYNC() xcd_barrier(xbar)
#define TPK(k, ...) do { __VA_ARGS__; } while (0)
#endif
    LAS3 unsigned char* lds3 = (LAS3 unsigned char*)lds;
    volatile LDSF unsigned* bst = (volatile LDSF unsigned*)(lds3 + 131072 + 2048);
    if (threadIdx.x < 2) bst[threadIdx.x] = 0u;
    __syncthreads();
    XcdBarrier xbar = xcd_barrier_post((unsigned*)(p.ws + WS_CTL) + 16384, bst);
    TPK(2, ph_mod(p, lds); ph_reset_queues(p); ph_weights(p, 0, lds); ph_weights(p, 1, lds));
    grid.sync();
    for (int l = 0; l < DEPTH; ++l) {
        const float* mod = (const float*)(p.ws + WS_MOD) + (size_t)l * 4 * 6144;
        if (l == 0) {
            TPK(2, ph_cbias(p, lds); ph_xa_from(p, p.x, 0, 0, (bf16_t*)(p.ws + WS_XA), (float*)(p.ws + WS_RSA), true));
            GSYNC();
        }
        {   pg8::Gemm g{(const bf16_t*)(p.ws + WS_XA), (const bf16_t*)(p.ws + WS_WIN + l * WS_W1OFF), MTOK, PINP, DM}; pg8::StaticOrder S; S.init(MTOK, PINP, (int)gridDim.x, (int)blockIdx.x);
            EpiProjF E{(const float*)(p.ws + WS_RSA), (const float*)(p.ws + WS_CBIN) + (size_t)l * 4 * PINP, (bf16_t*)(p.ws + WS_PROJ), (float*)(p.ws + WS_SIDE),
                       p.diff_kn + l * 32, p.fox_kn + l * 64, p.nsa_kn + (l * 3 + 1) * 64, p.nsa_kn + (l * 3 + 2) * 64, (LDSF float*)(lds3 + 131072 + 4096)};
            TPK(6, pg8::gemm_phase<EpiProjF, pg8::StaticOrder, true, PG8_SP2>(lds3, g, S, E)); }
        GSYNC();
        TPK(7, fa_phase_all(p, l, lds3, lds, l));
        GSYNC();
        {   pg8::Gemm g{(const bf16_t*)(p.ws + WS_MIX), (const bf16_t*)(p.ws + WS_WOUT + l * WS_W1OFF), MTOK, DM, DM}; pg8::StaticOrder S; S.init(MTOK, DM, (int)gridDim.x, (int)blockIdx.x);
            EpiResF E{l == 0 ? p.x : p.out, p.out, mod + 2048, p.norm_ffn_g + l * DM, mod + 4096, (bf16_t*)(p.ws + WS_XA), (float*)(p.ws + WS_RSB)};
            TPK(6, pg8::gemm_phase<EpiResF, pg8::StaticOrder, PG8_ALIGN, PG8_SP2>(lds3, g, S, E)); }
        GSYNC();
        {   pg8::Gemm g{(const bf16_t*)(p.ws + WS_XA), (const bf16_t*)(p.ws + WS_WUP + l * WS_W1OFF), MTOK, NUP, DM}; pg8::StaticOrder S; S.init(MTOK, NUP, (int)gridDim.x, (int)blockIdx.x);
            EpiUpAct E{(const float*)(p.ws + WS_RSB), (const float*)(p.ws + WS_CBUP) + (size_t)l * 4 * NUP, (bf16_t*)(p.ws + WS_ACT), (float*)(p.ws + WS_EG), (float*)(p.ws + WS_EV),
                       p.conv_w + (size_t)l * 3 * DFF, p.conv_b + (size_t)l * DFF, (LDSF float*)(lds3 + 131072 + 4096), (LDSF float*)(lds3 + 131072 + 8192)};
            TPK(6, pg8::gemm_phase<EpiUpAct, pg8::StaticOrder, true, PG8_SP2>(lds3, g, S, E)); }
        GSYNC();
        {   const float* modn = (const float*)(p.ws + WS_MOD) + (size_t)(l + 1) * 4 * 6144; const bool more = (l + 1 < DEPTH);
            pg8::Gemm g{(const bf16_t*)(p.ws + WS_ACT), (const bf16_t*)(p.ws + WS_WDN + l * WS_W1OFF), MTOK, DM, DFF}; pg8::StaticOrder S; S.init(MTOK, DM, (int)gridDim.x, (int)blockIdx.x);
            { pg8::Unit fu; for (int i = 0; S.next(i, fu); ++i) act_fixup(p, l, fu.pm); }
            __builtin_amdgcn_fence(__ATOMIC_RELEASE, "agent"); __builtin_amdgcn_fence(__ATOMIC_ACQUIRE, "agent"); __syncthreads();
            EpiResF E{p.out, p.out, mod + 5120, p.norm_mix_g + (more ? l + 1 : l) * DM, more ? modn + 1024 : mod + 1024, more ? (bf16_t*)(p.ws + WS_XA) : nullptr, more ? (float*)(p.ws + WS_RSA) : nullptr};
            TPK(6, pg8::gemm_phase<EpiResF, pg8::StaticOrder, PG8_ALIGN, PG8_SP2>(lds3, g, S, E)); }
        if (l + 1 < DEPTH) GSYNC();
    }
#if PROBE == 1
    if (blockIdx.x == 0 && threadIdx.x == 0) p.out[0] += 0.05f + (float)tacc * 0.01f * 5e-4f;
#elif PROBE >= 2
    if (blockIdx.x == 0 && threadIdx.x == 0) p.out[0] += 0.05f + (float)tph * 0.01f * 1e-4f;
#endif
}

extern "C" void kernel_launch(void* const* d_in, const int* in_sizes, int in, void* d_out, int out_size, void* d_ws, size_t ws_size, hipStream_t stream) {
    if (in != 24 || ws_size < WS_END || out_size != MTOK * DM) { fprintf(stderr, "kernel_launch: unexpected sizes (in %d, ws %zu, out %d)\n", in, ws_size, out_size); return; }
    static int grid_blocks = 0;
    if (!grid_blocks) {
        int dev = 0, cus = 0, per_cu = 0;
        hipGetDevice(&dev);
        hipDeviceGetAttribute(&cus, hipDeviceAttributeMultiprocessorCount, dev);
        hipFuncSetAttribute((const void*)mega, hipFuncAttributeMaxDynamicSharedMemorySize, LDS_BYTES);
        hipOccupancyMaxActiveBlocksPerMultiprocessor(&per_cu, (const void*)mega, NTHR, LDS_BYTES);
        if (per_cu < 1) { fprintf(stderr, "kernel_launch: occupancy query returned %d\n", per_cu); per_cu = 1; }
        if (per_cu > 1) per_cu = 1;
        grid_blocks = cus * per_cu;
        fprintf(stderr, "kernel_launch: cus %d per_cu %d grid %d\n", cus, per_cu, grid_blocks);
    }
    if (hipMemsetAsync((char*)d_ws + WS_CTL + 65536, 0, XCD_BAR_WORDS * 4, stream) != hipSuccess) { fprintf(stderr, "kernel_launch: memset failed\n"); return; }
    Params p{};
    const float** f = (const float**)&p;
    for (int i = 0; i < 24; ++i) f[i] = (const float*)d_in[i];
    p.out = (float*)d_out; p.ws = (unsigned char*)d_ws;
    void* args[] = {&p};
    hipError_t e = hipLaunchCooperativeKernel((const void*)mega, dim3(grid_blocks), dim3(NTHR), args, LDS_BYTES, stream);
    if (e != hipSuccess) fprintf(stderr, "cooperative launch failed: %s (grid %d)\n", hipGetErrorString(e), grid_blocks);
}
```

```cpp
#include <hip/hip_runtime.h>
#include <hip/hip_cooperative_groups.h>
#include <cstdint>
#include <cstdio>

typedef unsigned short bf16_t;
typedef short bf16x8 __attribute__((ext_vector_type(8)));
typedef float f32x4 __attribute__((ext_vector_type(4)));
typedef unsigned u32x4 __attribute__((ext_vector_type(4)));

constexpr int NB = 4, SEQ = 4096, DM = 1024, MTOK = NB * SEQ, DEPTH = 2;
constexpr int HD = 64, HPM = 4, DFF = 2816, PIN = 2960, PINP = 3072, NUP = 2 * DFF;
constexpr float EPS = 1e-6f;
constexpr float LOG2E = 1.4426950408889634f;
constexpr int NTHR = 512;

constexpr int CA_Q = 0, CA_K = 256, CA_V = 512, CB_Q = 768, CB_K = 1024, CB_V = 1280, CC_Q = 1536, CC_K = 1792, CC_V = 2048;
constexpr int CD_Q = 2304, CD_KC = 2560, CD_VC = 2624, CD_KS = 2688, CD_VS = 2752, CD_KW = 2816, CD_VW = 2880, C_BF = 2944, C_DG = 2948;

constexpr size_t MiB = 1u << 20;
constexpr size_t WS_CTL = 0;
constexpr size_t WS_MOD = 1 * MiB;
constexpr size_t WS_CBIN = WS_MOD + 2 * 4 * 6144 * 4;
constexpr size_t WS_CBUP = WS_CBIN + 2 * 4 * 3072 * 4;
constexpr size_t WS_TB = WS_CBUP + 2 * 4 * 5632 * 4;
constexpr size_t WS_LAM = WS_TB + 2 * 4 * 128 * 4;
constexpr size_t WS_BND = WS_LAM + 64;
constexpr size_t WS_CUM = WS_LAM + 512;
constexpr size_t WS_KC = WS_CUM + 16 * 4096 * 4;
constexpr size_t WS_VC = WS_KC + 4 * 256 * 64 * 2;
constexpr size_t WS_SELM = WS_VC + 4 * 256 * 64 * 2;
constexpr size_t WS_SMALL_END = WS_SELM + 16384 * 8;
static_assert(WS_SMALL_END <= 4 * MiB, "small region");
constexpr size_t WS_RSA = 4 * MiB;
constexpr size_t WS_RSB = 5 * MiB;
constexpr size_t WS_SIDE = 6 * MiB;
constexpr size_t WS_IMP = 7 * MiB;
constexpr size_t WS_ML = 11 * MiB;
constexpr size_t WS_PHIT = 7 * MiB;
constexpr size_t WS_W = 12 * MiB;
constexpr size_t WS_WIN = WS_W;
constexpr size_t WS_WOUT = WS_WIN + (size_t)PINP * DM * 2;
constexpr size_t WS_WUP = WS_WOUT + (size_t)DM * DM * 2;
constexpr size_t WS_WDN = WS_WUP + (size_t)NUP * DM * 2;
constexpr size_t WS_W_END = WS_WDN + (size_t)DM * DFF * 2;
static_assert(WS_W_END <= 38 * MiB, "weights region");
constexpr size_t WS_XA = 38 * MiB;
constexpr size_t WS_BIG = 70 * MiB;
constexpr size_t WS_PROJ = WS_BIG;
constexpr size_t WS_MIX = WS_BIG + 96 * MiB;
constexpr size_t WS_ACT = WS_BIG;
constexpr size_t WS_W1OFF = 188 * MiB;
constexpr size_t WS_EG = 228 * MiB;
constexpr size_t WS_EV = 232 * MiB;
constexpr size_t WS_END = 236 * MiB;
static_assert(WS_W_END + WS_W1OFF <= WS_EG && WS_MIX + 32 * MiB <= WS_W + WS_W1OFF, "layer-1 weights");
static_assert(WS_END <= 256 * MiB, "workspace");

struct Params {
    const float *x, *c, *rel_bias, *ada_w, *ada_b, *norm_mix_g, *norm_ffn_g, *w_in, *w_out;
    const float *diff_qn, *diff_kn, *diff_lam, *diff_sub, *fox_qn, *fox_kn, *fox_bf;
    const float *nsa_qn, *nsa_kn, *nsa_pe, *nsa_phi, *w_up, *conv_w, *conv_b, *w_down;
    float* out;
    unsigned char* ws;
};

__device__ __forceinline__ float bf2f(bf16_t v) { return __uint_as_float(((unsigned)v) << 16); }
__device__ __forceinline__ bf16_t f2bf(float f) { unsigned u = __float_as_uint(f); return (bf16_t)((u + 0x7fffu + ((u >> 16) & 1u)) >> 16); }
__device__ __forceinline__ unsigned pk2(float lo, float hi) { return (unsigned)f2bf(lo) | ((unsigned)f2bf(hi) << 16); }
__device__ __forceinline__ float siluf(float v) { return v / (1.f + __expf(-v)); }
__device__ __forceinline__ float logsigf(float v) { return fminf(v, 0.f) - log1pf(__expf(-fabsf(v))); }
__device__ __forceinline__ float wave_sum(float v) {
#pragma unroll
    for (int o = 1; o < 64; o <<= 1) v += __shfl_xor(v, o);
    return v;
}
__device__ __forceinline__ int t5_bucket(int n) {
    if (n < 16) return n < 0 ? 0 : n;
    return 16 + (n >= 19) + (n >= 21) + (n >= 24) + (n >= 27) + (n >= 31) + (n >= 35) + (n >= 40) + (n >= 46) + (n >= 52) + (n >= 59) + (n >= 67) + (n >= 77) + (n >= 87) + (n >= 99) + (n >= 113);
}
__host__ __device__ __forceinline__ int in_col_map(int n) {
    if (n < 1536) return n;
    if (n < 2944) return n + 4;
    if (n < 2948) return 1536 + (n - 2944);
    if (n < 2960) return n;
    return -1;
}
__host__ __device__ __forceinline__ int up_col_map(int n) {
    const int pn = n >> 8, c = n & 255;
    return c < 128 ? (128 * pn + c) : (DFF + 128 * pn + (c - 128));
}

__device__ __forceinline__ int opaque_v(int v) { asm volatile("" : "+v"(v)); return v; }
#define TID() opaque_v((int)threadIdx.x)
#define GTID() ((int)(blockIdx.x * blockDim.x) + TID())
#define GSIZE() ((int)(gridDim.x * blockDim.x))

__device__ __forceinline__ void load8(const bf16_t* p, float* d) {
    const u32x4 r = *(const u32x4*)p;
    d[0] = bf2f(r[0] & 0xffff); d[1] = bf2f(r[0] >> 16); d[2] = bf2f(r[1] & 0xffff); d[3] = bf2f(r[1] >> 16);
    d[4] = bf2f(r[2] & 0xffff); d[5] = bf2f(r[2] >> 16); d[6] = bf2f(r[3] & 0xffff); d[7] = bf2f(r[3] >> 16);
}
#define LDSF __attribute__((address_space(3)))
__device__ __forceinline__ void gemv4_block(const float* W, int ld, int oc, const LDSF float* vec, LDSF float* red, float* out0, int ostride, int n, float bias, int tid) {
    const int lane = tid & 63, wv = tid >> 6;
    float a0 = 0.f, a1 = 0.f, a2 = 0.f, a3 = 0.f;
    if (oc >= 0) {
        const float* w = W + (size_t)(wv * 128) * ld + oc;
#pragma unroll 32
        for (int k = 0; k < 128; ++k) { const float wk = w[(size_t)k * ld]; const f32x4 v = *(const LDSF f32x4*)(vec + (wv * 128 + k) * 4); a0 += v[0] * wk; a1 += v[1] * wk; a2 += v[2] * wk; a3 += v[3] * wk; }
    }
    red[(wv * 4 + 0) * 64 + lane] = a0; red[(wv * 4 + 1) * 64 + lane] = a1; red[(wv * 4 + 2) * 64 + lane] = a2; red[(wv * 4 + 3) * 64 + lane] = a3;
    __syncthreads();
    if (tid < 256) { const int bt = tid >> 6; float sacc = 0.f;
#pragma unroll
        for (int w8 = 0; w8 < 8; ++w8) sacc += red[(w8 * 4 + bt) * 64 + lane];
        out0[(size_t)bt * ostride + n] = sacc + bias; }
    __syncthreads();
}
__device__ void ph_mod(const Params& p, unsigned char* lds) {
    float* mod = (float*)(p.ws + WS_MOD);
    float* tb = (float*)(p.ws + WS_TB);
    float* lamv = (float*)(p.ws + WS_LAM);
    LDSF float* vec = (LDSF float*)lds; LDSF float* red = (LDSF float*)(lds + 16384);
    const int tid = TID();
    bool loaded = false;
    for (int item = blockIdx.x; item < DEPTH * 96; item += gridDim.x) {
        if (!loaded) { for (int i = tid; i < 4096; i += NTHR) { const int bt = i >> 10, k = i & 1023; vec[k * 4 + bt] = siluf(p.c[bt * DM + k]); } __syncthreads(); loaded = true; }
        const int l = item / 96, n = (item % 96) * 64 + (tid & 63);
        gemv4_block(p.ada_w + (size_t)l * DM * 6144, 6144, n, vec, red, mod + (size_t)l * 4 * 6144, 6144, n, p.ada_b[l * 6144 + n], tid);
    }
    const int gt = GTID(), gs = GSIZE();
    for (int idx = gt; idx < 2 * 4 * 128; idx += gs) {
        const int type = idx / 512, h = (idx / 128) & 3, d = idx & 127;
        tb[idx] = p.rel_bias[t5_bucket(d) * 8 + type * 4 + h];
    }
    for (int idx = gt; idx < DEPTH * 32; idx += gs) {
        const int l = idx >> 5, e = idx & 31; float v = 0.f;
        if (e < 17) {
            const int type = (e < 5) ? 0 : 1, h = (e < 4) ? e : ((e == 4) ? 0 : ((e - 5) & 3));
            const int ng = (e < 4) ? 32 : 64;
            const float* gq = (e < 4) ? p.diff_qn + l * 32 : ((e == 4) ? p.fox_qn + l * 64 : p.nsa_qn + l * 64);
            const float* gk = (e < 4) ? p.diff_kn + l * 32 : ((e == 4) ? p.fox_kn + l * 64 : p.nsa_kn + (l * 3 + (e - 5) / 4) * 64);
            float mq = 0.f, mk = 0.f; for (int i = 0; i < ng; ++i) { mq = fmaxf(mq, fabsf(gq[i])); mk = fmaxf(mk, fabsf(gk[i])); }
            float tm = 0.f; if (e != 4) { tm = -INFINITY; for (int bk2 = 0; bk2 < 32; ++bk2) tm = fmaxf(tm, p.rel_bias[bk2 * 8 + type * 4 + h]); }
            v = sqrtf((float)ng) * mq * mk * 1.02f * LOG2E + tm * LOG2E;
        }
        ((float*)(p.ws + WS_BND))[idx] = v;
    }
    for (int idx = gt; idx < DEPTH; idx += gs) {
        const float* lv = p.diff_lam + idx * 4 * 32;
        float s1 = 0.f, s2 = 0.f;
        for (int i = 0; i < 32; ++i) { s1 += lv[i] * lv[32 + i]; s2 += lv[64 + i] * lv[96 + i]; }
        const float lam_init = 0.8f - 0.6f * expf(-0.3f * (float)idx);
        lamv[idx] = expf(s1) - expf(s2) + lam_init;
    }
}
__device__ void ph_cbias(const Params& p, unsigned char* lds) {
    const float* mod = (const float*)(p.ws + WS_MOD);
    const int tid_ = TID(); const int lane = tid_ & 63, wv = tid_ >> 6;
    const int gw = blockIdx.x * (NTHR >> 6) + wv, ngw = gridDim.x * (NTHR >> 6);
    constexpr int NCOL = PINP + NUP;
    const int per = (DEPTH * NCOL + ngw - 1) / ngw; const int c0 = gw * per, c1 = min(DEPTH * NCOL, c0 + per);
    int cur_key = -1; float sh[4][16];
    for (int c = c0; c < c1; ++c) {
        const int l = c / NCOL, r = c % NCOL; const bool isin = r < PINP; const int n = isin ? r : r - PINP; const int key = l * 2 + (isin ? 0 : 1);
        if (key != cur_key) { cur_key = key; const int shoff = isin ? 0 : 3072;
#pragma unroll
            for (int bt = 0; bt < 4; ++bt)
#pragma unroll
                for (int q4 = 0; q4 < 4; ++q4) { const f32x4 v = *(const f32x4*)(mod + (size_t)(l * 4 + bt) * 6144 + shoff + 16 * lane + 4 * q4); sh[bt][4 * q4] = v[0]; sh[bt][4 * q4 + 1] = v[1]; sh[bt][4 * q4 + 2] = v[2]; sh[bt][4 * q4 + 3] = v[3]; } }
        const bf16_t* wrow = (const bf16_t*)(p.ws + (isin ? WS_WIN : WS_WUP) + l * WS_W1OFF) + (size_t)n * DM + 16 * lane;
        float w[16]; load8(wrow, w); load8(wrow + 8, w + 8);
        float a0 = 0.f, a1 = 0.f, a2 = 0.f, a3 = 0.f;
#pragma unroll
        for (int j = 0; j < 16; ++j) { a0 += sh[0][j] * w[j]; a1 += sh[1][j] * w[j]; a2 += sh[2][j] * w[j]; a3 += sh[3][j] * w[j]; }
        a0 = wave_sum(a0); a1 = wave_sum(a1); a2 = wave_sum(a2); a3 = wave_sum(a3);
        if (lane == 0) { float* o = isin ? (float*)(p.ws + WS_CBIN) + (size_t)l * 4 * PINP : (float*)(p.ws + WS_CBUP) + (size_t)l * 4 * NUP; const int ld = isin ? PINP : NUP;
            o[n] = a0; o[ld + n] = a1; o[2 * ld + n] = a2; o[3 * ld + n] = a3; }
    }
}
template <int MAPK>
__device__ void convert_weight(const float* W, int K, int Nsrc, int Npad, bf16_t* Wt, LDSF float* scr, int gw, int ngw, int lane) {
    const int nkb = K / 64, nnb = Npad / 64;
    for (int it = gw; it < nkb * nnb; it += ngw) {
        const int kb = it / nnb, nb = it % nnb, k0 = kb * 64, n0 = nb * 64;
        {
            const int n = n0 + lane;
            const int oc = MAPK == 0 ? n : (MAPK == 1 ? in_col_map(n) : up_col_map(n));
            const float* wp = W + (size_t)k0 * Nsrc + (oc >= 0 ? oc : 0);
#pragma unroll 1
            for (int hh = 0; hh < 2; ++hh) {
                float tv[32];
#pragma unroll
                for (int i = 0; i < 32; ++i) tv[i] = wp[(size_t)(32 * hh + i) * Nsrc];
#pragma unroll
                for (int i = 0; i < 32; ++i) scr[(32 * hh + i) * 65 + lane] = (oc >= 0) ? tv[i] : 0.f;
            }
        }
        __builtin_amdgcn_s_waitcnt(0xc07f); __builtin_amdgcn_wave_barrier();
        {
            const int c = lane & 7;
#pragma unroll
            for (int j = 0; j < 8; ++j) { const int nn = 8 * j + (lane >> 3); const LDSF float* sp = scr + (8 * c) * 65 + nn;
                u32x4 o; o[0] = pk2(sp[0], sp[65]); o[1] = pk2(sp[130], sp[195]); o[2] = pk2(sp[260], sp[325]); o[3] = pk2(sp[390], sp[455]);
                *(u32x4*)(Wt + (size_t)(n0 + nn) * K + k0 + 8 * c) = o; }
        }
        __builtin_amdgcn_s_waitcnt(0xc07f); __builtin_amdgcn_wave_barrier();
    }
}
__device__ void ph_weights(const Params& p, int l, unsigned char* lds) {
    const int tid_ = TID(); const int lane = tid_ & 63, wv = tid_ >> 6;
    const int gw = blockIdx.x * (NTHR >> 6) + wv, ngw = gridDim.x * (NTHR >> 6);
    LDSF float* scr = (LDSF float*)lds + wv * (64 * 65);
    convert_weight<1>(p.w_in + (size_t)l * DM * PIN, DM, PIN, PINP, (bf16_t*)(p.ws + WS_WIN + l * WS_W1OFF), scr, gw, ngw, lane);
    convert_weight<0>(p.w_out + (size_t)l * DM * DM, DM, DM, DM, (bf16_t*)(p.ws + WS_WOUT + l * WS_W1OFF), scr, gw, ngw, lane);
    convert_weight<2>(p.w_up + (size_t)l * DM * NUP, DM, NUP, NUP, (bf16_t*)(p.ws + WS_WUP + l * WS_W1OFF), scr, gw, ngw, lane);
    convert_weight<0>(p.w_down + (size_t)l * DFF * DM, DFF, DM, DM, (bf16_t*)(p.ws + WS_WDN + l * WS_W1OFF), scr, gw, ngw, lane);
    for (int w2 = 0; w2 < 2; ++w2) convert_weight<0>(p.nsa_phi + (size_t)(l * 2 + w2) * 2048 * 64, 2048, 64, 64, (bf16_t*)(p.ws + WS_PHIT) + (size_t)(l * 2 + w2) * 64 * 2048, scr, gw, ngw, lane);
}
__device__ void ph_xa_from(const Params& p, const float* src, int l, int which  , bf16_t* XA, float* rowss, bool write_xa) {
    const float* mod = (const float*)(p.ws + WS_MOD);
    const float* g = (which == 0 ? p.norm_mix_g : p.norm_ffn_g) + l * DM;
    const int tid_ = TID(); const int lane = tid_ & 63, wv = tid_ >> 6;
    const int gw = blockIdx.x * (blockDim.x >> 6) + wv, ngw = gridDim.x * (blockDim.x >> 6);
    for (int row0 = gw; row0 < MTOK; row0 += 2 * ngw) {
        f32x4 v[2][4];
#pragma unroll
        for (int rr = 0; rr < 2; ++rr) { const int row = min(row0 + rr * ngw, MTOK - 1);
#pragma unroll
            for (int j = 0; j < 4; ++j) v[rr][j] = *(const f32x4*)(src + (size_t)row * DM + j * 256 + lane * 4); }
#pragma unroll
        for (int rr = 0; rr < 2; ++rr) {
            const int row = row0 + rr * ngw;
            if (row < MTOK) {
                const int b = row / SEQ; const float* sc = mod + (size_t)(l * 4 + b) * 6144 + (which == 0 ? 1024 : 4096);
                float ss = 0.f;
#pragma unroll
                for (int j = 0; j < 4; ++j) {
                    const int k = j * 256 + lane * 4; const f32x4 x = v[rr][j];
                    ss += x[0] * x[0] + x[1] * x[1] + x[2] * x[2] + x[3] * x[3];
                    if (write_xa) {
                        const f32x4 gv = *(const f32x4*)(g + k); const f32x4 sv = *(const f32x4*)(sc + k);
                        uint2 o; o.x = pk2(x[0] * gv[0] * (1.f + sv[0]), x[1] * gv[1] * (1.f + sv[1])); o.y = pk2(x[2] * gv[2] * (1.f + sv[2]), x[3] * gv[3] * (1.f + sv[3]));
                        *(uint2*)(XA + (size_t)row * DM + k) = o;
                    }
                }
                ss = wave_sum(ss);
                if (lane < 16) rowss[(size_t)row * 16 + lane] = (lane == 0) ? ss : 0.f;
            }
        }
    }
}

namespace pg8 {
#define PG8_LAS __attribute__((address_space(3)))
typedef unsigned short bf16_t;
typedef short bf16x8 __attribute__((ext_vector_type(8)));
typedef float f32x4 __attribute__((ext_vector_type(4)));
typedef unsigned u32x4 __attribute__((ext_vector_type(4)));
constexpr int BM = 256, BK = 64, HALF = 128, HTB = HALF * BK * 2  , STAGE_BYTES = 8 * HTB, NXCD = 8, WGM = 8;

__host__ __device__ __forceinline__ int lds_byte(int r, int c) { const int st = (r >> 4) * 2 + (c >> 5), rr = r & 15, cc = c & 31, ob = rr * 64 + cc * 2; return st * 1024 + (ob ^ (((ob >> 9) & 1) << 5)); }
__host__ __device__ __forceinline__ void stage_rc(int b, int& R, int& C) { const int st = b / 1024, sb = b % 1024, swz = sb ^ (((sb >> 9) & 1) << 5); R = (st >> 1) * 16 + swz / 64; C = (st & 1) * 32 + (swz % 64) / 2; }
__host__ __device__ __forceinline__ int perm32(int rho) { const int n = rho >> 4, i = rho & 15; return 8 * (i >> 2) + 4 * n + (i & 3); }

struct Unit { int pm, pn; };
struct Gemm { const bf16_t* A; const bf16_t* Bt; int M, N, K; };

struct StaticOrder {
    int nM, nN, nwg, G, c;
    __host__ __device__ void init(int M, int N, int G_, int c_) { nM = M / BM; nN = N / BM; nwg = nM * nN; G = G_; c = c_; }
    __host__ __device__ bool next(int i, Unit& u) const {
        const long L = (long)i * G + c; if (L >= nwg) return false;
        int wgid = (int)L; { const int q = nwg / NXCD, r = nwg % NXCD, xcd = wgid % NXCD, off = wgid / NXCD; wgid = (xcd < r ? xcd * (q + 1) : r * (q + 1) + (xcd - r) * q) + off; }
        const int nig = WGM * nN, gid = wgid / nig, fm = gid * WGM, gsz = (nM - fm) < WGM ? (nM - fm) : WGM;
        u.pm = fm + ((wgid % nig) % gsz); u.pn = (wgid % nig) / gsz; return true;
    }
    __device__ __forceinline__ void a_ready(const Unit&) const {}
    __device__ __forceinline__ void done(const Unit&) const {}
};


__device__ __forceinline__ unsigned cvt_pk_bf16(float lo, float hi) { unsigned r; asm volatile("v_cvt_pk_bf16_f32 %0, %1, %2" : "=v"(r) : "v"(lo), "v"(hi)); return r; }
template <class Epi, class Sched, bool ALIGN_EPI = false, bool SP2 = false>
__device__ __forceinline__ void gemm_phase(PG8_LAS unsigned char* lds, const Gemm g, const Sched& S, const Epi& E) {
    const int tid = TID(), wid = __builtin_amdgcn_readfirstlane(tid >> 6), lane = tid & 63, wr = wid >> 2, wc = wid & 3, fr = lane & 15, fq = lane >> 4;
    const int K = g.K, nt = K / BK;
    unsigned voffA[2], voffB[2];
#pragma unroll
    for (int i = 0; i < 2; ++i) { int R, C; stage_rc(tid * 16 + i * 8192, R, C); const int Rb = Epi::PERM ? ((R & ~31) + perm32(R & 31)) : R;
        voffA[i] = (unsigned)(R * K + C) * 2u; voffB[i] = (unsigned)(Rb * K + C) * 2u; }
    const size_t kstep = (size_t)(BK * 2);
    const size_t hstep = (size_t)HALF * K * 2;
    const size_t tstep = 2 * hstep;
    const unsigned ldsw = (unsigned)wid * 1024u;
    const int aoff = lds_byte(wr * 64 + fr, fq * 8), boff = lds_byte(wc * 32 + fr, fq * 8);
#define PG8_SA(b, h) (((b) * 2 + (h)) * HTB)
#define PG8_SB(b, h) ((4 + (b) * 2 + (h)) * HTB)
#define PG8_STAGE(bufoff, gbase, voff) do { _Pragma("unroll") for (int _i = 0; _i < 2; ++_i) \
        __builtin_amdgcn_global_load_lds((const unsigned*)((const char*)(gbase) + (voff)[_i]), (PG8_LAS unsigned*)(lds + (bufoff) + ldsw + _i * 8192), 16, 0, 0); } while (0)
#define PG8_LDA(dst, b, h) do { _Pragma("unroll") for (int m = 0; m < 4; ++m) _Pragma("unroll") for (int k = 0; k < 2; ++k) dst[m][k] = *(const PG8_LAS bf16x8*)(lds + PG8_SA(b, h) + aoff + m * 2048 + k * 1024); } while (0)
#define PG8_LDB(dst, b, h) do { _Pragma("unroll") for (int n = 0; n < 2; ++n) _Pragma("unroll") for (int k = 0; k < 2; ++k) dst[n][k] = *(const PG8_LAS bf16x8*)(lds + PG8_SB(b, h) + boff + n * 2048 + k * 1024); } while (0)
#define PG8_MMA(ai, bj, At, Bt) do { __builtin_amdgcn_s_setprio(1); _Pragma("unroll") for (int m = 0; m < 4; ++m) _Pragma("unroll") for (int n = 0; n < 2; ++n) _Pragma("unroll") for (int k = 0; k < 2; ++k) \
        acc[ai][bj][m][n] = __builtin_amdgcn_mfma_f32_16x16x32_bf16(Bt[n][k], At[m][k], acc[ai][bj][m][n], 0, 0, 0); __builtin_amdgcn_s_setprio(0); } while (0)
#define PG8_WAIT_V(n) asm volatile("s_waitcnt vmcnt(" #n ")" ::: "memory")
#define PG8_WAIT_L(n) asm volatile("s_waitcnt lgkmcnt(" #n ")" ::: "memory")
#define PG8_BAR __builtin_amdgcn_s_barrier()
#define PG8_SCHED __builtin_amdgcn_sched_barrier(0)
    Unit cur, nxt; int ui = 0;
    if (!S.next(0, cur)) return;
    f32x4 acc[2][2][4][2];
#pragma unroll
    for (int a = 0; a < 2; ++a)
#pragma unroll
        for (int b = 0; b < 2; ++b)
#pragma unroll
            for (int m = 0; m < 4; ++m)
#pragma unroll
                for (int n = 0; n < 2; ++n) acc[a][b][m][n] = (f32x4){0.f, 0.f, 0.f, 0.f};
    bf16x8 At[4][2], B0[2][2], B1[2][2];
    const char* cA = (const char*)g.A + (size_t)cur.pm * tstep; const char* cB = (const char*)g.Bt + (size_t)cur.pn * tstep;
    S.a_ready(cur);
    if constexpr (SP2) {
        PG8_STAGE(PG8_SB(0, 0), cB, voffB); PG8_STAGE(PG8_SB(0, 1), cB + hstep, voffB); PG8_STAGE(PG8_SA(0, 0), cA, voffA); PG8_STAGE(PG8_SA(0, 1), cA + hstep, voffA);
        if (wr == 1) PG8_BAR;
        PG8_WAIT_V(2); PG8_BAR;
        PG8_STAGE(PG8_SB(1, 0), cB + kstep, voffB); PG8_STAGE(PG8_SA(1, 0), cA + kstep, voffA); PG8_STAGE(PG8_SB(1, 1), cB + hstep + kstep, voffB);
        PG8_WAIT_V(6); PG8_BAR;
    } else {
        PG8_STAGE(PG8_SB(0, 0), cB, voffB); PG8_STAGE(PG8_SA(0, 0), cA, voffA); PG8_STAGE(PG8_SB(0, 1), cB + hstep, voffB); PG8_STAGE(PG8_SA(0, 1), cA + hstep, voffA);
        if (wr == 1) PG8_BAR;
        PG8_WAIT_V(4); PG8_BAR;
        PG8_STAGE(PG8_SB(1, 0), cB + kstep, voffB); PG8_STAGE(PG8_SA(1, 0), cA + kstep, voffA); PG8_STAGE(PG8_SB(1, 1), cB + hstep + kstep, voffB);
        PG8_WAIT_V(6); PG8_BAR;
    }
    for (;;) {
        const bool has_next = S.next(ui + 1, nxt);
        const char* nA = has_next ? (const char*)g.A + (size_t)nxt.pm * tstep : cA; const char* nB = has_next ? (const char*)g.Bt + (size_t)nxt.pn * tstep : cB;
        for (int t = 0; t < nt; t += 2) {
            const bool last = (t == nt - 2);
            const char* a1 = cA + (size_t)(t + 1) * kstep;
            const char* a2 = last ? nA : cA + (size_t)(t + 2) * kstep; const char* b2 = last ? nB : cB + (size_t)(t + 2) * kstep;
            const char* a3 = a2 + kstep; const char* b3 = b2 + kstep;
            if (last && has_next) S.a_ready(nxt);
            if constexpr (SP2) {
            PG8_LDB(B0, 0, 0); PG8_LDB(B1, 0, 1); PG8_SCHED; PG8_LDA(At, 0, 0); PG8_STAGE(PG8_SA(1, 1), a1 + hstep, voffA);
            PG8_WAIT_V(8); PG8_WAIT_L(0); PG8_BAR; PG8_MMA(0, 0, At, B0); PG8_MMA(0, 1, At, B1); PG8_BAR; PG8_SCHED;
            PG8_LDA(At, 0, 1); PG8_STAGE(PG8_SB(0, 0), b2, voffB); PG8_STAGE(PG8_SB(0, 1), b2 + hstep, voffB); PG8_STAGE(PG8_SA(0, 0), a2, voffA);
            PG8_WAIT_V(8); PG8_WAIT_L(0); PG8_BAR; PG8_MMA(1, 0, At, B0); PG8_MMA(1, 1, At, B1); PG8_BAR; PG8_SCHED;
            PG8_LDB(B0, 1, 0); PG8_LDB(B1, 1, 1); PG8_SCHED; PG8_LDA(At, 1, 0); PG8_STAGE(PG8_SA(0, 1), a2 + hstep, voffA);
            PG8_WAIT_V(8); PG8_WAIT_L(0); PG8_BAR; PG8_MMA(0, 0, At, B0); PG8_MMA(0, 1, At, B1); PG8_BAR; PG8_SCHED;
            PG8_LDA(At, 1, 1); PG8_STAGE(PG8_SB(1, 0), b3, voffB); PG8_STAGE(PG8_SB(1, 1), b3 + hstep, voffB); PG8_STAGE(PG8_SA(1, 0), a3, voffA);
            PG8_WAIT_V(8); PG8_WAIT_L(0); PG8_BAR; PG8_MMA(1, 0, At, B0); PG8_MMA(1, 1, At, B1); PG8_BAR; PG8_SCHED;
            } else {
            PG8_LDB(B0, 0, 0); PG8_SCHED; PG8_LDA(At, 0, 0); PG8_STAGE(PG8_SA(1, 1), a1 + hstep, voffA);
            PG8_WAIT_L(8); PG8_BAR; PG8_WAIT_L(0); PG8_MMA(0, 0, At, B0); PG8_BAR; PG8_SCHED;
            PG8_LDB(B1, 0, 1); PG8_STAGE(PG8_SB(0, 0), b2, voffB);
            PG8_BAR; PG8_WAIT_L(0); PG8_MMA(0, 1, At, B1); PG8_BAR;
            PG8_LDA(At, 0, 1); PG8_STAGE(PG8_SA(0, 0), a2, voffA);
            PG8_BAR; PG8_WAIT_L(0); PG8_MMA(1, 0, At, B0); PG8_BAR; PG8_SCHED;
            PG8_STAGE(PG8_SB(0, 1), b2 + hstep, voffB);
            PG8_WAIT_V(6); PG8_BAR; PG8_MMA(1, 1, At, B1); PG8_BAR;
            PG8_LDB(B0, 1, 0); PG8_SCHED; PG8_LDA(At, 1, 0); PG8_STAGE(PG8_SA(0, 1), a2 + hstep, voffA);
            PG8_WAIT_L(8); PG8_BAR; PG8_WAIT_L(0); PG8_MMA(0, 0, At, B0); PG8_BAR; PG8_SCHED;
            PG8_LDB(B1, 1, 1); PG8_STAGE(PG8_SB(1, 0), b3, voffB);
            PG8_BAR; PG8_WAIT_L(0); PG8_MMA(0, 1, At, B1); PG8_BAR;
            PG8_LDA(At, 1, 1); PG8_STAGE(PG8_SA(1, 0), a3, voffA);
            PG8_BAR; PG8_WAIT_L(0); PG8_MMA(1, 0, At, B0); PG8_BAR; PG8_SCHED;
            PG8_STAGE(PG8_SB(1, 1), b3 + hstep, voffB);
            PG8_WAIT_V(6); PG8_BAR; PG8_MMA(1, 1, At, B1); PG8_BAR;
            }
        }
        if constexpr (ALIGN_EPI) { if (wr == 0) PG8_BAR; }
        if constexpr (!Epi::AFTER_DRAIN) { E(acc, cur, wr, wc, fr, fq); S.done(cur); }
        if (!has_next) break;
#pragma unroll
        for (int a = 0; a < 2; ++a)
#pragma unroll
            for (int b = 0; b < 2; ++b)
#pragma unroll
                for (int m = 0; m < 4; ++m)
#pragma unroll
                    for (int n = 0; n < 2; ++n) acc[a][b][m][n] = (f32x4){0.f, 0.f, 0.f, 0.f};
        cur = nxt; cA = nA; cB = nB; ++ui;
        if constexpr (ALIGN_EPI) { if (wr == 1) PG8_BAR; }
    }
    PG8_WAIT_V(0);
    if constexpr (!ALIGN_EPI) { if (wr == 0) PG8_BAR; }
    PG8_BAR;
    if constexpr (Epi::AFTER_DRAIN) { E.fused(acc, cur, wr, wc, fr, fq, lds, wid, lane); S.done(cur); }
#undef PG8_SA
#undef PG8_SB
#undef PG8_STAGE
#undef PG8_LDA
#undef PG8_LDB
#undef PG8_MMA
#undef PG8_WAIT_V
#undef PG8_WAIT_L
#undef PG8_BAR
#undef PG8_SCHED
}
}

#ifndef PG8_SP2
#define PG8_SP2 true
#endif
#ifndef PG8_ALIGN
#define PG8_ALIGN true
#endif

__device__ __forceinline__ float row_rstd16(const float* rowss, int row) {
    const f32x4* r = (const f32x4*)(rowss + (size_t)row * 16);
    const f32x4 a = r[0], b = r[1], c = r[2], d = r[3];
    const float s = ((a[0] + a[1]) + (a[2] + a[3])) + ((b[0] + b[1]) + (b[2] + b[3])) + ((c[0] + c[1]) + (c[2] + c[3])) + ((d[0] + d[1]) + (d[2] + d[3]));
    return rsqrtf(s * (1.f / DM) + EPS);
}
struct EpiProjF {
    static constexpr bool PERM = true, AFTER_DRAIN = false;
    const float* rowss; const float* cb; bf16_t* proj; float* side; const float* g_a; const float* g_b; const float* g_ds; const float* g_dw; LDSF float* xs  ;
    __device__ __forceinline__ void operator()(const pg8::f32x4 (&acc)[2][2][4][2], const pg8::Unit& u, int wr, int wc, int fr, int fq) const {
        const int b = u.pm >> 4, colt = u.pn * 256 + wc * 32 + 8 * fq;
        const int knmode = (u.pn == 1) ? 1 : (u.pn == 4) ? 2 : (u.pn == 10) ? 3 : (u.pn == 11) ? 4 : 0;
        f32x4 cv[2][2];
#pragma unroll
        for (int bj = 0; bj < 2; ++bj)
#pragma unroll
            for (int n = 0; n < 2; ++n) cv[bj][n] = *(const f32x4*)(cb + b * PINP + colt + bj * 128 + 4 * n);
        if (knmode != 0) {
#pragma unroll
            for (int ai = 0; ai < 2; ++ai)
#pragma unroll
                for (int m = 0; m < 4; ++m) {
                    const float rsm = row_rstd16(rowss, u.pm * 256 + ai * 128 + wr * 64 + m * 16 + fr);
#pragma unroll
                    for (int bj = 0; bj < 2; ++bj) {
                        const f32x4 v0 = acc[ai][bj][m][0] * rsm + cv[bj][0], v1 = acc[ai][bj][m][1] * rsm + cv[bj][1];
                        float ss = (v0[0] * v0[0] + v0[1] * v0[1]) + (v0[2] * v0[2] + v0[3] * v0[3]) + (v1[0] * v1[0] + v1[1] * v1[1]) + (v1[2] * v1[2] + v1[3] * v1[3]);
                        ss += __shfl_xor(ss, 16); ss += __shfl_xor(ss, 32);
                        if (fq == 0) xs[((wr * 4 + wc) * 16 + (ai * 4 + m) * 2 + bj) * 16 + fr] = ss;
                    }
                }
            asm volatile("s_waitcnt lgkmcnt(0)" ::: "memory"); __builtin_amdgcn_s_barrier(); asm volatile("" ::: "memory");
        }
#pragma unroll
        for (int ai = 0; ai < 2; ++ai)
#pragma unroll
            for (int m = 0; m < 4; ++m) {
                const int row = u.pm * 256 + ai * 128 + wr * 64 + m * 16 + fr; const float rs = row_rstd16(rowss, row);
#pragma unroll
                for (int bj = 0; bj < 2; ++bj) {
                    f32x4 v0 = acc[ai][bj][m][0] * rs + cv[bj][0], v1 = acc[ai][bj][m][1] * rs + cv[bj][1]; const int col0 = colt + bj * 128;
                    if (col0 >= C_BF && col0 < PIN) { *(f32x4*)(side + (size_t)row * 16 + (col0 - C_BF)) = v0; *(f32x4*)(side + (size_t)row * 16 + (col0 - C_BF) + 4) = v1; }
                    const bool on = (knmode == 1) || (knmode == 2) || (knmode == 3 && bj == 1 && wc < 2) || (knmode == 4 && bj == 0 && wc < 2);
                    if (on) {
                        const int xi = (ai * 4 + m) * 2 + bj;
                        float tot = xs[((wr * 4 + wc) * 16 + xi) * 16 + fr]; float dn = 1.f / 32.f;
                        if (knmode != 1) { tot += xs[((wr * 4 + (wc ^ 1)) * 16 + xi) * 16 + fr]; dn = 1.f / 64.f; }
                        const float nrm = rsqrtf(tot * dn + EPS);
                        const float* gp = (knmode == 1) ? g_a + 8 * fq : ((knmode == 2) ? g_b : (knmode == 3 ? g_ds : g_dw)) + (wc & 1) * 32 + 8 * fq;
                        v0 = v0 * nrm * *(const f32x4*)gp; v1 = v1 * nrm * *(const f32x4*)(gp + 4);
                    }
                    u32x4 w; w[0] = pg8::cvt_pk_bf16(v0[0], v0[1]); w[1] = pg8::cvt_pk_bf16(v0[2], v0[3]); w[2] = pg8::cvt_pk_bf16(v1[0], v1[1]); w[3] = pg8::cvt_pk_bf16(v1[2], v1[3]);
                    *(u32x4*)(proj + (size_t)row * PINP + col0) = w;
                }
            }
    }
};
struct EpiResF {
    static constexpr bool PERM = false, AFTER_DRAIN = false;
    const float* xin; float* xout; const float* gate; const float* g; const float* sc; bf16_t* xa; float* rowss;
    __device__ __forceinline__ void operator()(const pg8::f32x4 (&acc)[2][2][4][2], const pg8::Unit& u, int wr, int wc, int fr, int fq) const {
        const int b = u.pm >> 4, col0 = u.pn * 256 + wc * 32 + 4 * fq;
        f32x4 gt[2][2], gm[2][2];
#pragma unroll
        for (int bj = 0; bj < 2; ++bj)
#pragma unroll
            for (int n = 0; n < 2; ++n) { const int c = col0 + bj * 128 + n * 16; gt[bj][n] = *(const f32x4*)(gate + b * 6144 + c);
                if (xa) gm[bj][n] = *(const f32x4*)(g + c) * (*(const f32x4*)(sc + b * 6144 + c) + 1.0f); else gm[bj][n] = (f32x4){0.f, 0.f, 0.f, 0.f}; }
#pragma unroll
        for (int ai = 0; ai < 2; ++ai)
#pragma unroll
            for (int m = 0; m < 4; ++m) {
                const int row = u.pm * 256 + ai * 128 + wr * 64 + m * 16 + fr; float ss = 0.f;
#pragma unroll
                for (int bj = 0; bj < 2; ++bj)
#pragma unroll
                    for (int n = 0; n < 2; ++n) { const size_t off = (size_t)row * DM + col0 + bj * 128 + n * 16;
                        const f32x4 o = *(const f32x4*)(xin + off) + gt[bj][n] * acc[ai][bj][m][n];
                        *(f32x4*)(xout + off) = o; ss += (o[0] * o[0] + o[1] * o[1]) + (o[2] * o[2] + o[3] * o[3]);
                        if (xa) { const f32x4 q = o * gm[bj][n]; uint2 w; w.x = pg8::cvt_pk_bf16(q[0], q[1]); w.y = pg8::cvt_pk_bf16(q[2], q[3]); *(uint2*)(xa + off) = w; } }
                if (rowss) { ss += __shfl_xor(ss, 16); ss += __shfl_xor(ss, 32); if (fq == 0) rowss[(size_t)row * 16 + u.pn * 4 + wc] = ss; }
            }
    }
};


#define DPPF(oldv, src, CTRL) __builtin_bit_cast(float, __builtin_amdgcn_update_dpp(__builtin_bit_cast(int, (float)(oldv)), __builtin_bit_cast(int, (float)(src)), (CTRL), 0xf, 0xf, false))
struct EpiUpAct {
    static constexpr bool PERM = true, AFTER_DRAIN = false;
    const float* rowss; const float* cb; bf16_t* act; float* eg; float* ev; const float* cw; const float* cbias; LDSF float* xch; LDSF float* cst  ;
    __device__ __forceinline__ void operator()(const pg8::f32x4 (&acc)[2][2][4][2], const pg8::Unit& u, int wr, int wc, int fr, int fq) const {
        const int b = u.pm >> 4, cih = wc * 32 + 8 * fq, jcol = u.pn * 128 + cih;
        const float* cbg = cb + b * NUP + u.pn * 256 + cih; const float* cbv = cbg + 128;
        {
            const int tid = (wr * 4 + wc) * 64 + fq * 16 + fr, col = tid & 127, arr = tid >> 7;
            const float* src = (arr == 0) ? cb + b * NUP + u.pn * 256 + col : (arr == 1) ? cb + b * NUP + u.pn * 256 + 128 + col : cw + (arr - 2) * DFF + u.pn * 128 + col;
            cst[arr * 128 + col] = *src;
            if (tid < 256) { const int a2 = 4 + (tid >> 7); cst[a2 * 128 + col] = (a2 == 4) ? cw[2 * DFF + u.pn * 128 + col] : cbias[u.pn * 128 + col]; }
            else cst[768 + (tid - 256)] = row_rstd16(rowss, u.pm * 256 + (tid - 256));
            const f32x4 cg0 = *(const f32x4*)cbg, cg1 = *(const f32x4*)(cbg + 4);
#pragma unroll
            for (int ai = 0; ai < 2; ++ai) {
                const float r3 = row_rstd16(rowss, u.pm * 256 + ai * 128 + wr * 64 + 48 + fr);
                const f32x4 g0 = acc[ai][0][3][0] * r3 + cg0, g1 = acc[ai][0][3][1] * r3 + cg1;
                if (fr >= 14) { LDSF float* x = xch + ((((wr * 2 + ai) * 4 + wc) * 2 + (fr - 14)) * 32 + 8 * fq); *(LDSF f32x4*)x = g0; *(LDSF f32x4*)(x + 4) = g1;
                    if (wr == 1 && ai == 1) { float* e = eg + ((size_t)(u.pm * 4 + 2 + (fr - 14))) * DFF + jcol; *(f32x4*)e = g0; *(f32x4*)(e + 4) = g1; } }
            }
            if (wr == 0 && fr < 2) {
                const f32x4 cv0 = *(const f32x4*)cbv, cv1 = *(const f32x4*)(cbv + 4); const float r0 = row_rstd16(rowss, u.pm * 256 + fr);
                float* e = eg + ((size_t)(u.pm * 4 + fr)) * DFF + jcol; float* v = ev + ((size_t)(u.pm * 2 + fr)) * DFF + jcol;
                *(f32x4*)e = acc[0][0][0][0] * r0 + cg0; *(f32x4*)(e + 4) = acc[0][0][0][1] * r0 + cg1;
                *(f32x4*)v = acc[0][1][0][0] * r0 + cv0; *(f32x4*)(v + 4) = acc[0][1][0][1] * r0 + cv1;
            }
        }
        asm volatile("s_waitcnt vmcnt(0) lgkmcnt(0)" ::: "memory"); __builtin_amdgcn_s_barrier(); asm volatile("" ::: "memory");
#pragma unroll
        for (int ai = 0; ai < 2; ++ai) {
            f32x4 pvv[2];
            if (ai == 0 && wr == 0) { pvv[0] = (f32x4){0.f, 0.f, 0.f, 0.f}; pvv[1] = pvv[0]; }
            else { const int swr = (wr == 1) ? 0 : 1, sai = (wr == 1) ? ai : ai - 1;
                const LDSF float* x = xch + ((((swr * 2 + sai) * 4 + wc) * 2 + (fr & 1)) * 32 + 8 * fq); pvv[0] = *(const LDSF f32x4*)x; pvv[1] = *(const LDSF f32x4*)(x + 4); }
#pragma unroll
            for (int m = 0; m < 4; ++m) {
                asm volatile("" ::: "memory");
                const int row = u.pm * 256 + ai * 128 + wr * 64 + m * 16 + fr; const float rsm = cst[768 + ai * 128 + wr * 64 + m * 16 + fr];
                u32x4 w;
#pragma unroll
                for (int n = 0; n < 2; ++n) {
                    const LDSF float* cc = cst + cih + 4 * n;
                    const f32x4 cgn = *(const LDSF f32x4*)cc, cvn = *(const LDSF f32x4*)(cc + 128);
                    const f32x4 k0 = *(const LDSF f32x4*)(cc + 256), k1 = *(const LDSF f32x4*)(cc + 384), k2 = *(const LDSF f32x4*)(cc + 512), kb = *(const LDSF f32x4*)(cc + 640);
                    const f32x4 c = acc[ai][0][m][n] * rsm + cgn, v = acc[ai][1][m][n] * rsm + cvn; float o[4];
#pragma unroll
                    for (int i = 0; i < 4; ++i) {
                        const float gm1 = DPPF(DPPF(0.f, pvv[n][i], 0x121), c[i], 0x111);
                        const float gm2 = DPPF(DPPF(0.f, pvv[n][i], 0x122), c[i], 0x112);
                        const float cvv = k0[i] * gm2 + k1[i] * gm1 + k2[i] * c[i] + kb[i];
                        o[i] = cvv * __builtin_amdgcn_rcpf(1.f + __builtin_amdgcn_exp2f(-cvv * LOG2E)) * v[i];
                    }
                    w[2 * n] = pg8::cvt_pk_bf16(o[0], o[1]); w[2 * n + 1] = pg8::cvt_pk_bf16(o[2], o[3]);
                    pvv[n] = c;
                }
                *(u32x4*)(act + (size_t)row * DFF + jcol) = w;
            }
        }
    }
};
__device__ void act_fixup(const Params& p, int l, int pm) {
    if ((pm & 15) == 0) return;
    const float* eg = (const float*)(p.ws + WS_EG); const float* ev = (const float*)(p.ws + WS_EV); bf16_t* act = (bf16_t*)(p.ws + WS_ACT);
    const float* cw = p.conv_w + (size_t)l * 3 * DFF; const float* cbias = p.conv_b + (size_t)l * DFF;
    for (int idx = TID(); idx < 2 * DFF; idx += NTHR) {
        const int r = idx / DFF, j = idx - r * DFF;
        const float a = eg[((size_t)((pm - 1) * 4 + 2)) * DFF + j], bq = eg[((size_t)((pm - 1) * 4 + 3)) * DFF + j], c0 = eg[((size_t)(pm * 4 + 0)) * DFF + j], c1 = eg[((size_t)(pm * 4 + 1)) * DFF + j];
        const float gm2 = r ? bq : a, gm1 = r ? c0 : bq, gc = r ? c1 : c0;
        const float cvv = cw[j] * gm2 + cw[DFF + j] * gm1 + cw[2 * DFF + j] * gc + cbias[j];
        act[(size_t)(pm * 256 + r) * DFF + j] = f2bf(siluf(cvv) * ev[((size_t)(pm * 2 + r)) * DFF + j]);
    }
}

__device__ void ph_prep_cum_bh(const Params& p, int l, int bh, unsigned char* lds) {
    const float* side = (const float*)(p.ws + WS_SIDE);
    float* cum = (float*)(p.ws + WS_CUM);
    LDSF float* wt = (LDSF float*)(lds + 70000);
    const int tid = TID(), lane = tid & 63, wv = tid >> 6;
    {
        const int b = bh >> 2, h = bh & 3; const float bf = p.fox_bf[l * 4 + h];
        float v[8]; float tot = 0.f;
#pragma unroll
        for (int i = 0; i < 8; ++i) { v[i] = logsigf(side[(size_t)(b * SEQ + tid * 8 + i) * 16 + h] + bf); tot += v[i]; v[i] = tot; }
        float inc = tot;
#pragma unroll
        for (int o = 1; o < 64; o <<= 1) { const float u = __shfl_up(inc, o); if (lane >= o) inc += u; }
        __syncthreads();
        if (lane == 63) wt[wv] = inc;
        __syncthreads();
        float base = inc - tot;
        for (int w8 = 0; w8 < wv; ++w8) base += wt[w8];
#pragma unroll
        for (int i = 0; i < 8; ++i) cum[bh * SEQ + tid * 8 + i] = base + v[i];
    }
}
template <int N> __device__ __forceinline__ float dotn(const float* q, const bf16_t* k) {
    float s = 0.f;
#pragma unroll
    for (int c = 0; c < N / 8; ++c) { float t[8]; load8(k + 8 * c, t);
#pragma unroll
        for (int j = 0; j < 8; ++j) s += q[8 * c + j] * t[j]; }
    return s;
}
template <int N> __device__ __forceinline__ void axpyn(float* o, float w, const bf16_t* v) {
#pragma unroll
    for (int c = 0; c < N / 8; ++c) { float t[8]; load8(v + 8 * c, t);
#pragma unroll
        for (int j = 0; j < 8; ++j) o[8 * c + j] += w * t[j]; }
}
template <int N> __device__ __forceinline__ void loadq_norm(float* q, const bf16_t* src, const float* g, float scale, bool norm) {
    float ss = 0.f;
#pragma unroll
    for (int c = 0; c < N / 8; ++c) load8(src + 8 * c, q + 8 * c);
#pragma unroll
    for (int j = 0; j < N; ++j) ss += q[j] * q[j];
    const float r = norm ? rsqrtf(ss * (1.f / N) + EPS) : 1.f;
#pragma unroll
    for (int j = 0; j < N; ++j) q[j] = q[j] * r * (norm ? g[j] : 1.f) * scale;
}
__device__ __forceinline__ void store64(bf16_t* dst, const float* o) {
#pragma unroll
    for (int c = 0; c < 8; ++c) { u32x4 w; w[0] = pk2(o[8 * c], o[8 * c + 1]); w[1] = pk2(o[8 * c + 2], o[8 * c + 3]); w[2] = pk2(o[8 * c + 4], o[8 * c + 5]); w[3] = pk2(o[8 * c + 6], o[8 * c + 7]); *(u32x4*)(dst + 8 * c) = w; }
}

typedef float f32x16 __attribute__((ext_vector_type(16)));
typedef short s16x4 __attribute__((ext_vector_type(4)));
#define LDSP __attribute__((address_space(3)))
constexpr int KSTR = 144;
constexpr int AL_KV = 17408;
constexpr int AL_BK = 2 * AL_KV  , AL_TB = AL_BK + 512  , AL_WSF = AL_TB + 512  , AL_MISC = AL_WSF + 2048  ,
              AL_IMP = 38912  , AL_SELM = AL_IMP + 65536  ,
              AL_TB4 = AL_SELM + 512  , AL_INVL = AL_TB4 + 2048  , AL_D_END = AL_INVL + 1024;
static_assert(AL_MISC + 64 <= AL_IMP && AL_D_END <= 131072, "attention LDS map");
__device__ __forceinline__ int crow(int r, int hi) { return (r & 3) + 8 * (r >> 2) + 4 * hi; }
__device__ __forceinline__ float ex2(float v) { return __builtin_amdgcn_exp2f(v); }
__device__ __forceinline__ s16x4 vtr(const LDSP unsigned char* p) { typedef short v4i16_t __attribute__((ext_vector_type(4))); return __builtin_bit_cast(s16x4, __builtin_amdgcn_ds_read_tr16_b64_v4i16((LDSP v4i16_t*)p)); }
__device__ __forceinline__ bf16x8 pack8(const f32x16& p, int b) {
    u32x4 w; w[0] = pg8::cvt_pk_bf16(p[b], p[b + 1]); w[1] = pg8::cvt_pk_bf16(p[b + 2], p[b + 3]); w[2] = pg8::cvt_pk_bf16(p[b + 4], p[b + 5]); w[3] = pg8::cvt_pk_bf16(p[b + 6], p[b + 7]);
    return __builtin_bit_cast(bf16x8, w);
}
__device__ __forceinline__ f32x16 splat16(float v) { return (f32x16){v, v, v, v, v, v, v, v, v, v, v, v, v, v, v, v}; }
template <int NK16>
__device__ __forceinline__ void qkt(f32x16& p0, f32x16& p1, const LDSP unsigned char* Kt, const bf16x8* qf, int dbase, int r32, int hi) {
    const LDSP unsigned char* kb = Kt + r32 * KSTR + hi * 16 + dbase * 32;
#pragma unroll
    for (int d0 = 0; d0 < NK16; ++d0) {
        const bf16x8 a0 = *(const LDSP bf16x8*)(kb + d0 * 32), a1 = *(const LDSP bf16x8*)(kb + 32 * KSTR + d0 * 32);
        p0 = __builtin_amdgcn_mfma_f32_32x32x16_bf16(a0, qf[d0], p0, 0, 0, 0);
        p1 = __builtin_amdgcn_mfma_f32_32x32x16_bf16(a1, qf[d0], p1, 0, 0, 0);
    }
}
__device__ __forceinline__ void pv(f32x16* o, const LDSP unsigned char* Vt, int vb, const f32x16& p0, const f32x16& p1) {
    bf16x8 pa[4]; pa[0] = pack8(p0, 0); pa[1] = pack8(p0, 8); pa[2] = pack8(p1, 0); pa[3] = pack8(p1, 8);
#pragma unroll
    for (int d0 = 0; d0 < 2; ++d0)
#pragma unroll
        for (int ks = 0; ks < 4; ++ks) {
            const s16x4 lo = vtr(Vt + vb + d0 * 4096 + ks * 1024), hh = vtr(Vt + vb + d0 * 4096 + ks * 1024 + 512);
            const bf16x8 vf = (bf16x8){lo[0], lo[1], lo[2], lo[3], hh[0], hh[1], hh[2], hh[3]};
            o[d0] = __builtin_amdgcn_mfma_f32_32x32x16_bf16(pa[ks], vf, o[d0], 0, 0, 0);
        }
}
__device__ __forceinline__ float exp_sum(f32x16& p0, f32x16& p1) {
    float s0 = 0.f, s1 = 0.f;
#pragma unroll
    for (int r = 0; r < 16; ++r) { p0[r] = ex2(p0[r]); p1[r] = ex2(p1[r]); s0 += p0[r]; s1 += p1[r]; }
    return s0 + s1;
}
__device__ __forceinline__ void scale_rows(f32x16* o, float f, LDSP float* wsf, int r32, int hi) {
    __builtin_amdgcn_wave_barrier();
    if (hi == 0) wsf[r32] = f;
    __builtin_amdgcn_s_waitcnt(0xc07f);
    __builtin_amdgcn_wave_barrier();
#pragma unroll
    for (int g = 0; g < 4; ++g) { const f32x4 a = *(const LDSP f32x4*)(wsf + 8 * g + 4 * hi);
#pragma unroll
        for (int i = 0; i < 4; ++i) { o[0][4 * g + i] *= a[i]; o[1][4 * g + i] *= a[i]; } }
    __builtin_amdgcn_wave_barrier();
}
__device__ __forceinline__ void store_o(const f32x16* o, LDSP bf16_t* stg, bf16_t* dst, int lane, int r32, int hi) {
    __builtin_amdgcn_wave_barrier();
#pragma unroll
    for (int r = 0; r < 16; ++r) { const int orow = crow(r, hi); stg[orow * 64 + r32] = f2bf(o[0][r]); stg[orow * 64 + 32 + r32] = f2bf(o[1][r]); }
    __builtin_amdgcn_s_waitcnt(0xc07f);
    __builtin_amdgcn_wave_barrier();
#pragma unroll
    for (int i = 0; i < 4; ++i) { const int row = i * 8 + (lane >> 3), ch = lane & 7; const u32x4 v = *(const LDSP u32x4*)(stg + row * 64 + ch * 8); *(u32x4*)(dst + (size_t)row * DM + ch * 8) = v; }
    __builtin_amdgcn_s_waitcnt(0xc07f);
    __builtin_amdgcn_wave_barrier();
}
template <int NG>
__device__ __forceinline__ void load_q(bf16x8* qf, const bf16_t* qrow  , const float* g, float sc, bool norm, int hi) {
    float v[4][8];
#pragma unroll
    for (int d0 = 0; d0 < 4; ++d0) load8(qrow + 16 * d0 + 8 * hi, v[d0]);
    float r0 = 1.f, r1 = 1.f;
    if (norm) {
        float s0 = 0.f, s1 = 0.f;
#pragma unroll
        for (int j = 0; j < 8; ++j) { s0 += v[0][j] * v[0][j] + v[1][j] * v[1][j]; s1 += v[2][j] * v[2][j] + v[3][j] * v[3][j]; }
        s0 += __shfl_xor(s0, 32); s1 += __shfl_xor(s1, 32);
        if (NG == 64) { r0 = rsqrtf((s0 + s1) * (1.f / 64.f) + EPS); r1 = r0; } else { r0 = rsqrtf(s0 * (1.f / 32.f) + EPS); r1 = rsqrtf(s1 * (1.f / 32.f) + EPS); }
    }
#pragma unroll
    for (int d0 = 0; d0 < 4; ++d0) {
        const float rr = (d0 < 2 ? r0 : r1) * sc; float w[8];
#pragma unroll
        for (int j = 0; j < 8; ++j) { const int d = 16 * d0 + 8 * hi + j; w[j] = v[d0][j] * rr * (norm ? g[d % NG] : 1.f); }
        u32x4 u; u[0] = pg8::cvt_pk_bf16(w[0], w[1]); u[1] = pg8::cvt_pk_bf16(w[2], w[3]); u[2] = pg8::cvt_pk_bf16(w[4], w[5]); u[3] = pg8::cvt_pk_bf16(w[6], w[7]);
        qf[d0] = __builtin_bit_cast(bf16x8, u);
    }
}
__device__ __forceinline__ void kv_load(u32x4& kr, u32x4& vr, const bf16_t* Kb, const bf16_t* Vb, int k0, int tid) {
    const size_t off = (size_t)(k0 + (tid >> 3)) * PINP + (tid & 7) * 8;
    kr = *(const u32x4*)(Kb + off); vr = *(const u32x4*)(Vb + off);
}
__device__ __forceinline__ void kv_load64(u32x4& kr, u32x4& vr, const bf16_t* Kb, const bf16_t* Vb, int n0, int tid) {
    const size_t off = (size_t)(n0 + (tid >> 3)) * 64 + (tid & 7) * 8;
    kr = *(const u32x4*)(Kb + off); vr = *(const u32x4*)(Vb + off);
}
__device__ __forceinline__ void kv_store(const u32x4& kr, const u32x4& vr, LDSP unsigned char* buf, int tid) {
    const int key = tid >> 3, ch = tid & 7;
    *(LDSP u32x4*)(buf + key * KSTR + ch * 16) = kr;
    *(LDSP u32x4*)(buf + 9216 + (ch >> 2) * 4096 + (key >> 4) * 1024 + ((key >> 3) & 1) * 512 + (key & 7) * 64 + (ch & 3) * 16) = vr;
}
template <int NG>
__device__ __forceinline__ void knorm_chunk(u32x4& kr, const float* gp  ) {
    float v[8];
    v[0] = bf2f(kr[0] & 0xffff); v[1] = bf2f(kr[0] >> 16); v[2] = bf2f(kr[1] & 0xffff); v[3] = bf2f(kr[1] >> 16);
    v[4] = bf2f(kr[2] & 0xffff); v[5] = bf2f(kr[2] >> 16); v[6] = bf2f(kr[3] & 0xffff); v[7] = bf2f(kr[3] >> 16);
    float ss = 0.f;
#pragma unroll
    for (int j = 0; j < 8; ++j) ss += v[j] * v[j];
    ss += __shfl_xor(ss, 1); ss += __shfl_xor(ss, 2); if (NG == 64) ss += __shfl_xor(ss, 4);
    const float r = rsqrtf(ss * (1.f / NG) + EPS);
    const f32x4 ga = *(const f32x4*)gp, gb = *(const f32x4*)(gp + 4);
    kr[0] = pg8::cvt_pk_bf16(v[0] * r * ga[0], v[1] * r * ga[1]); kr[1] = pg8::cvt_pk_bf16(v[2] * r * ga[2], v[3] * r * ga[3]);
    kr[2] = pg8::cvt_pk_bf16(v[4] * r * gb[0], v[5] * r * gb[1]); kr[3] = pg8::cvt_pk_bf16(v[6] * r * gb[2], v[7] * r * gb[3]);
}
__device__ __forceinline__ void bias_near(f32x16& p0, f32x16& p1, const LDSP float* tbl, int tk0  , int wnd, bool rowok, int hi) {
#pragma unroll
    for (int g = 0; g < 4; ++g) {
#pragma unroll
        for (int i = 0; i < 4; ++i) { const int r = 4 * g + i; const int d0_ = tk0 - crow(r, hi), d1_ = d0_ - 32;
            const float b0 = tbl[min(max(d0_, 0), 127)], b1 = tbl[min(max(d1_, 0), 127)];
            p0[r] = (d0_ < 0 || d0_ >= wnd || !rowok) ? -INFINITY : p0[r] + b0; p1[r] = (d1_ < 0 || d1_ >= wnd || !rowok) ? -INFINITY : p1[r] + b1; }
        asm volatile("" ::: "memory");
    }
}
#define KVBUF(L, i) ((L) + ((i) & 1) * AL_KV)

__device__ void fa_fox_unit(const Params& p, int l, int b, int h, int qb, LDSP unsigned char* L) {
    const int tid = TID(), lane = tid & 63, wid = __builtin_amdgcn_readfirstlane(tid >> 6), r32 = lane & 31, hi = lane >> 5;
    const bf16_t* proj = (const bf16_t*)(p.ws + WS_PROJ); bf16_t* mix = (bf16_t*)(p.ws + WS_MIX);
    const size_t rb = (size_t)b * SEQ; const int q0 = qb * 256, qw = q0 + 32 * wid, t = qw + r32;
    const bf16_t* Kb = proj + rb * PINP + CB_K + 64 * h; const bf16_t* Vb = proj + rb * PINP + CB_V + 64 * h;
    const float* cm = (const float*)(p.ws + WS_CUM) + (b * 4 + h) * SEQ;
    LDSP float* wsf = (LDSP float*)(L + AL_WSF) + wid * 64; LDSP float* bk = (LDSP float*)(L + AL_BK);
    const int vb = 9216 + ((lane >> 4) & 1) * 32 + (lane & 3) * 8 + (4 * hi + ((lane & 15) >> 2)) * 64;
    bf16x8 qf[4]; load_q<64>(qf, proj + (rb + t) * PINP + CB_Q + 64 * h, p.fox_qn + l * 64, 0.125f * LOG2E, true, hi);
    const float rowc = cm[t] * LOG2E - ((const float*)(p.ws + WS_BND))[l * 32 + 4];
    f32x16 o[2]; o[0] = (f32x16){}; o[1] = (f32x16){};
    float l_run = 0.f;
    const int NT = 4 * qb + 4, jd = 4 * qb + (wid >> 1);
    u32x4 kr, vr; float cr = 0.f; const float* gk = p.fox_kn + l * 64 + (tid & 7) * 8;
    int js;
    {   const bool live = (lane < NT) ? ((cm[q0] - cm[64 * lane + 63]) * LOG2E >= -160.f) : false;
        const unsigned long long bm = __ballot(live);
        js = __builtin_amdgcn_readfirstlane((int)__builtin_ctzll(bm | (1ull << (NT - 1)))); if (js > NT - 2) js = NT - 2; }
    __syncthreads();
    kv_load(kr, vr, Kb, Vb, 64 * js, tid); if (tid < 64) cr = cm[64 * js + tid];
    kv_store(kr, vr, KVBUF(L, js), tid); if (tid < 64) bk[(js & 1) * 64 + tid] = -cr * LOG2E;
    kv_load(kr, vr, Kb, Vb, 64 * (js + 1), tid); if (tid < 64) cr = cm[64 * (js + 1) + tid];
    for (int j = js; j < NT; ++j) {
        __syncthreads();
        if (j + 1 < NT) { kv_store(kr, vr, KVBUF(L, j + 1), tid); if (tid < 64) bk[((j + 1) & 1) * 64 + tid] = -cr * LOG2E; }
        if (j + 2 < NT) { kv_load(kr, vr, Kb, Vb, 64 * (j + 2), tid); if (tid < 64) cr = cm[64 * (j + 2) + tid]; }
        if (j <= jd) {
            const LDSP unsigned char* buf = KVBUF(L, j); const LDSP float* bkj = bk + (j & 1) * 64;
            f32x16 p0, p1;
#pragma unroll
            for (int g = 0; g < 4; ++g) { const f32x4 b0 = *(const LDSP f32x4*)(bkj + 8 * g + 4 * hi), b1 = *(const LDSP f32x4*)(bkj + 32 + 8 * g + 4 * hi);
#pragma unroll
                for (int i = 0; i < 4; ++i) { p0[4 * g + i] = b0[i] + rowc; p1[4 * g + i] = b1[i] + rowc; } }
            qkt<4>(p0, p1, buf, qf, 0, r32, hi);
            if (j == jd) { const int k0 = 64 * j;
#pragma unroll
                for (int r = 0; r < 16; ++r) { const int kk = k0 + crow(r, hi); if (kk > t) p0[r] = -INFINITY; if (kk + 32 > t) p1[r] = -INFINITY; } }
            l_run += exp_sum(p0, p1);
            pv(o, buf, vb, p0, p1);
        }
    }
    l_run += __shfl_xor(l_run, 32);
    scale_rows(o, 1.f / l_run, wsf, r32, hi);
    store_o(o, (LDSP bf16_t*)(L + AL_IMP + wid * 8192), mix + (rb + qw) * DM + 256 + 64 * h, lane, r32, hi);
}

__device__ void fa_diff_unit(const Params& p, int l, int b, int h, int qb, LDSP unsigned char* L) {
    const int tid = TID(), lane = tid & 63, wid = __builtin_amdgcn_readfirstlane(tid >> 6), r32 = lane & 31, hi = lane >> 5;
    const bf16_t* proj = (const bf16_t*)(p.ws + WS_PROJ); bf16_t* mix = (bf16_t*)(p.ws + WS_MIX);
    const size_t rb = (size_t)b * SEQ; const int q0 = qb * 256, qw = q0 + 32 * wid, t = qw + r32;
    const bf16_t* Kb = proj + rb * PINP + CA_K + 64 * h; const bf16_t* Vb = proj + rb * PINP + CA_V + 64 * h;
    LDSP float* wsf = (LDSP float*)(L + AL_WSF) + wid * 64; LDSP float* tbl = (LDSP float*)(L + AL_TB);
    const int vb = 9216 + ((lane >> 4) & 1) * 32 + (lane & 3) * 8 + (4 * hi + ((lane & 15) >> 2)) * 64;
    const float lam = ((const float*)(p.ws + WS_LAM))[l]; const float lam_init = 0.8f - 0.6f * __expf(-0.3f * (float)l);
    const float nbound = -((const float*)(p.ws + WS_BND))[l * 32 + h];
    __syncthreads();
    if (tid < 128) tbl[tid] = ((const float*)(p.ws + WS_TB))[h * 128 + tid] * LOG2E;
    bf16x8 qf[4]; load_q<32>(qf, proj + (rb + t) * PINP + CA_Q + 64 * h, p.diff_qn + l * 32, 0.17677669529663687f * LOG2E, true, hi);
    f32x16 o1[2], o2[2]; o1[0] = (f32x16){}; o1[1] = (f32x16){}; o2[0] = (f32x16){}; o2[1] = (f32x16){};
    float l1 = 0.f, l2 = 0.f;
    const int NT = 4 * qb + 4, jd = 4 * qb + (wid >> 1);
    u32x4 kr, vr; const float* gk = p.diff_kn + l * 32 + (tid & 3) * 8;
    kv_load(kr, vr, Kb, Vb, 0, tid);
    kv_store(kr, vr, KVBUF(L, 0), tid);
    kv_load(kr, vr, Kb, Vb, 64, tid);
    for (int j = 0; j < NT; ++j) {
        __syncthreads();
        if (j + 1 < NT) { kv_store(kr, vr, KVBUF(L, j + 1), tid); }
        if (j + 2 < NT) kv_load(kr, vr, Kb, Vb, 64 * (j + 2), tid);
        if (j <= jd) {
            const LDSP unsigned char* buf = KVBUF(L, j);
            const int k0 = 64 * j; const bool nearb = (qw - (k0 + 63)) < 113; const float cfar = tbl[127] + nbound;
#pragma unroll
            for (int mp = 0; mp < 2; ++mp) {
                f32x16 p0 = splat16(nearb ? nbound : cfar), p1 = p0;
                qkt<2>(p0, p1, buf, qf + 2 * mp, 2 * mp, r32, hi);
                if (nearb) bias_near(p0, p1, tbl, t - k0, 1 << 30, true, hi);
                if (mp == 0) { l1 += exp_sum(p0, p1); pv(o1, buf, vb, p0, p1); }
                else { l2 += exp_sum(p0, p1); pv(o2, buf, vb, p0, p1); }
            }
        }
    }
    l1 += __shfl_xor(l1, 32); l2 += __shfl_xor(l2, 32);
    scale_rows(o1, 1.f / l1, wsf, r32, hi); scale_rows(o2, lam / l2, wsf, r32, hi);
    o1[0] -= o2[0]; o1[1] -= o2[1];
    const float g0 = p.diff_sub[l * 64 + r32] * (1.f - lam_init), g1 = p.diff_sub[l * 64 + 32 + r32] * (1.f - lam_init);
#pragma unroll
    for (int r = 0; r < 16; ++r) {
        float ss = o1[0][r] * o1[0][r] + o1[1][r] * o1[1][r];
        ss += __shfl_xor(ss, 1); ss += __shfl_xor(ss, 2); ss += __shfl_xor(ss, 4); ss += __shfl_xor(ss, 8); ss += __shfl_xor(ss, 16);
        const float rs = rsqrtf(ss * (1.f / 64.f) + EPS); o1[0][r] *= rs * g0; o1[1][r] *= rs * g1;
    }
    store_o(o1, (LDSP bf16_t*)(L + AL_IMP + wid * 8192), mix + (rb + qw) * DM + 0 + 64 * h, lane, r32, hi);
}

template <bool DIAG>
__device__ __forceinline__ void stick_sub(f32x16& y, float& carry, int kbase  , int t, int hi) {
    float lk[16];
#pragma unroll
    for (int r = 0; r < 16; ++r) {
        const float v = y[r]; const float e = ex2(-fabsf(v)); const float lb = fminf(v, 0.f) - __builtin_amdgcn_logf(1.f + e);
        if (DIAG) { const bool valid = (kbase + crow(r, hi) < t); lk[r] = valid ? (lb - v) : 0.f; y[r] = valid ? lb : -INFINITY; }
        else { lk[r] = lb - v; y[r] = lb; }
    }
    float T[4], Go[4];
#pragma unroll
    for (int g = 0; g < 4; ++g) { const float Gs = (lk[4 * g] + lk[4 * g + 1]) + (lk[4 * g + 2] + lk[4 * g + 3]); Go[g] = __shfl_xor(Gs, 32); T[g] = Gs + Go[g]; }
    float sx = 0.f;
#pragma unroll
    for (int g = 3; g >= 0; --g) {
        float tail = carry + sx + (hi == 0 ? Go[g] : 0.f);
#pragma unroll
        for (int i = 3; i >= 0; --i) { y[4 * g + i] = ex2(y[4 * g + i] + tail); tail += lk[4 * g + i]; }
        sx += T[g];
    }
    carry += sx;
}
__device__ void fa_stick_unit(const Params& p, int l, int b, int h, int qb, LDSP unsigned char* L) {
    const int tid = TID(), lane = tid & 63, wid = __builtin_amdgcn_readfirstlane(tid >> 6), r32 = lane & 31, hi = lane >> 5;
    const bf16_t* proj = (const bf16_t*)(p.ws + WS_PROJ); bf16_t* mix = (bf16_t*)(p.ws + WS_MIX);
    const size_t rb = (size_t)b * SEQ; const int q0 = qb * 256, qw = q0 + 32 * wid, t = qw + r32;
    const bf16_t* Kb = proj + rb * PINP + CC_K + 64 * h; const bf16_t* Vb = proj + rb * PINP + CC_V + 64 * h;
    const int vb = 9216 + ((lane >> 4) & 1) * 32 + (lane & 3) * 8 + (4 * hi + ((lane & 15) >> 2)) * 64;
    bf16x8 qf[4]; load_q<64>(qf, proj + (rb + t) * PINP + CC_Q + 64 * h, nullptr, 0.125f * LOG2E, false, hi);
    f32x16 o[2]; o[0] = (f32x16){}; o[1] = (f32x16){};
    float carry = 0.f;
    const int NT = 4 * qb + 4, jd = 4 * qb + (wid >> 1);
    u32x4 kr, vr;
#define SBUF(i) (((i) & 1) ? (L + 108544) : L)
    LDSP unsigned* dn = (LDSP unsigned*)(L + AL_MISC) + 8;
    bool wdone = false;
    __syncthreads();
    if (lane == 0) dn[wid] = 0u;
    kv_load(kr, vr, Kb, Vb, 64 * (NT - 1), tid);
    kv_store(kr, vr, SBUF(NT - 1), tid);
    kv_load(kr, vr, Kb, Vb, 64 * (NT - 2), tid);
    for (int j = NT - 1; j >= 0; --j) {
        __syncthreads();
        if (__all(dn[lane & 7] != 0u)) break;
        if (j >= 1) kv_store(kr, vr, SBUF(j - 1), tid);
        if (j >= 2) kv_load(kr, vr, Kb, Vb, 64 * (j - 2), tid);
        if (j <= jd && !wdone) {
            const LDSP unsigned char* buf = SBUF(j);
            f32x16 p0 = (f32x16){}, p1 = (f32x16){};
            qkt<4>(p0, p1, buf, qf, 0, r32, hi);
            const int k0 = 64 * j; const bool diag = (j == jd);
            if (diag) { stick_sub<true>(p1, carry, k0 + 32, t, hi); stick_sub<true>(p0, carry, k0, t, hi); }
            else { stick_sub<false>(p1, carry, k0 + 32, t, hi); stick_sub<false>(p0, carry, k0, t, hi); }
            pv(o, buf, vb, p0, p1);
            if (__all(carry < -160.f)) { wdone = true; if (lane == 0) dn[wid] = 1u; }
        }
    }
    store_o(o, (LDSP bf16_t*)(L + AL_IMP + wid * 8192), mix + (rb + qw) * DM + 512 + 64 * h, lane, r32, hi);
}

__device__ void fa_nsa_unit(const Params& p, int l, int b, int u, LDSP unsigned char* L) {
    const int tid = TID(), lane = tid & 63, wid = __builtin_amdgcn_readfirstlane(tid >> 6), r32 = lane & 31, hi = lane >> 5;
    const int hh = wid >> 1, sub = wid & 1;
    const bf16_t* proj = (const bf16_t*)(p.ws + WS_PROJ); bf16_t* mix = (bf16_t*)(p.ws + WS_MIX);
    const size_t rb = (size_t)b * SEQ; const int q0 = 64 * u, qw = q0 + 32 * sub, t = qw + r32; const int ql = 32 * sub + r32;
    LDSP float* wsf = (LDSP float*)(L + AL_WSF) + wid * 64; LDSP float* tbl = (LDSP float*)(L + AL_TB4) + hh * 128;
    LDSP float* imp = (LDSP float*)(L + AL_IMP); LDSP unsigned* selm = (LDSP unsigned*)(L + AL_SELM); LDSP float* invl = (LDSP float*)(L + AL_INVL);
    LDSP float* ofl = (LDSP float*)(L + AL_IMP) + wid * 2048 + lane;
    const int vb = 9216 + ((lane >> 4) & 1) * 32 + (lane & 3) * 8 + (4 * hi + ((lane & 15) >> 2)) * 64;
    const float* bnd = (const float*)(p.ws + WS_BND) + l * 32;
    __syncthreads();
    ((LDSP float*)(L + AL_TB4))[tid] = ((const float*)(p.ws + WS_TB))[512 + tid] * LOG2E;
    bf16x8 qf[4]; load_q<64>(qf, proj + (rb + t) * PINP + CD_Q + 64 * hh, p.nsa_qn + l * 64, 0.125f * LOG2E, true, hi);
    const float* sd = (const float*)(p.ws + WS_SIDE) + (rb + t) * 16 + 4 + hh;
    const float gc = 1.f / (1.f + __expf(-sd[0])), gs = 1.f / (1.f + __expf(-sd[4])), gwn = 1.f / (1.f + __expf(-sd[8]));
    f32x16 o[2]; o[0] = (f32x16){}; o[1] = (f32x16){};
    u32x4 kr, vr;
    {
        const bf16_t* Kc = (const bf16_t*)(p.ws + WS_KC) + (size_t)b * 256 * 64; const bf16_t* Vc = (const bf16_t*)(p.ws + WS_VC) + (size_t)b * 256 * 64;
        const int ntc = (4 * u + 2) / 64 + 1; const float nbound = -bnd[5 + hh];
        float l_run = 0.f, prevE3 = 0.f;
        kv_load64(kr, vr, Kc, Vc, 0, tid);
        kv_store(kr, vr, KVBUF(L, 0), tid);
        if (ntc > 1) kv_load64(kr, vr, Kc, Vc, 64, tid);
        for (int T = 0; T < ntc; ++T) {
            __syncthreads();
            if (T + 1 < ntc) kv_store(kr, vr, KVBUF(L, T + 1), tid);
            if (T + 2 < ntc) kv_load64(kr, vr, Kc, Vc, 64 * (T + 2), tid);
            const LDSP unsigned char* buf = KVBUF(L, T);
            f32x16 p0 = splat16(nbound), p1 = p0;
            qkt<4>(p0, p1, buf, qf, 0, r32, hi);
#pragma unroll
            for (int g = 0; g < 4; ++g) {
#pragma unroll
                for (int i = 0; i < 4; ++i) { const int r = 4 * g + i; const int d0_ = t - 16 * (64 * T + crow(r, hi)) - 31, d1_ = d0_ - 512;
                    const float b0 = tbl[min(max(d0_, 0), 127)], b1 = tbl[min(max(d1_, 0), 127)];
                    p0[r] = (d0_ < 0) ? -INFINITY : p0[r] + b0; p1[r] = (d1_ < 0) ? -INFINITY : p1[r] + b1; }
                asm volatile("" ::: "memory");
            }
            l_run += exp_sum(p0, p1);
#pragma unroll
            for (int s2 = 0; s2 < 2; ++s2) {
                float G[4], Eo[4];
#pragma unroll
                for (int g = 0; g < 4; ++g) { const float a0 = s2 ? p1[4 * g] : p0[4 * g], a1 = s2 ? p1[4 * g + 1] : p0[4 * g + 1], a2 = s2 ? p1[4 * g + 2] : p0[4 * g + 2], a3 = s2 ? p1[4 * g + 3] : p0[4 * g + 3];
                    G[g] = (a0 + a1) + (a2 + a3); Eo[g] = __shfl_xor(a3, 32); }
#pragma unroll
                for (int g = 0; g < 4; ++g) { const float eprev = hi ? Eo[g] : (g > 0 ? Eo[g - 1] : prevE3);
                    imp[(hh * 64 + ql) * 64 + 16 * T + 8 * s2 + 2 * g + hi] = G[g] + eprev; }
                prevE3 = Eo[3];
            }
            pv(o, buf, vb, p0, p1);
        }
        l_run += __shfl_xor(l_run, 32);
        const float inv = (l_run > 0.f) ? 1.f / l_run : 0.f;
        if (hi == 0) invl[hh * 64 + ql] = inv;
        scale_rows(o, gc * inv, wsf, r32, hi);
    }
    __syncthreads();
    {
        const int q = tid >> 3, part = tid & 7;
        const float i0 = invl[q], i1 = invl[64 + q], i2 = invl[128 + q], i3 = invl[192 + q];
        float vj[8];
#pragma unroll
        for (int jj = 0; jj < 8; ++jj) { const int j = part * 8 + jj;
            const float sum = ((imp[(0 * 64 + q) * 64 + j] * i0 + imp[(1 * 64 + q) * 64 + j] * i1) + imp[(2 * 64 + q) * 64 + j] * i2) + imp[(3 * 64 + q) * 64 + j] * i3;
            vj[jj] = (j > u) ? -1.0f : ((j == u || j == 0) ? 1.0e4f : sum); }
        __syncthreads();
#pragma unroll
        for (int jj = 0; jj < 8; ++jj) imp[q * 64 + part * 8 + jj] = vj[jj];
        __syncthreads();
        int rank[8];
#pragma unroll
        for (int jj = 0; jj < 8; ++jj) rank[jj] = 0;
        for (int i = 0; i < 64; ++i) { const float vi = imp[q * 64 + i];
#pragma unroll
            for (int jj = 0; jj < 8; ++jj) rank[jj] += (vi > vj[jj] || (vi == vj[jj] && i < part * 8 + jj)) ? 1 : 0; }
        unsigned bits = 0;
#pragma unroll
        for (int jj = 0; jj < 8; ++jj) if (rank[jj] < 16 && (part * 8 + jj) <= u) bits |= 1u << jj;
        unsigned mlo = (part < 4) ? (bits << (8 * part)) : 0u, mhi = (part >= 4) ? (bits << (8 * (part - 4))) : 0u;
        mlo |= __shfl_xor(mlo, 1); mhi |= __shfl_xor(mhi, 1); mlo |= __shfl_xor(mlo, 2); mhi |= __shfl_xor(mhi, 2); mlo |= __shfl_xor(mlo, 4); mhi |= __shfl_xor(mhi, 4);
        if (part == 0) { selm[2 * q] = mlo; selm[2 * q + 1] = mhi; }
    }
    __syncthreads();
#pragma unroll
    for (int r = 0; r < 16; ++r) { ofl[(2 * r) * 64] = o[0][r]; ofl[(2 * r + 1) * 64] = o[1][r]; }
    o[0] = (f32x16){}; o[1] = (f32x16){};
    {
        const unsigned long long mymask = (unsigned long long)selm[2 * ql] | ((unsigned long long)selm[2 * ql + 1] << 32);
        unsigned ulo = selm[2 * lane], uhi = selm[2 * lane + 1];
#pragma unroll
        for (int s2 = 1; s2 < 64; s2 <<= 1) { ulo |= __shfl_xor(ulo, s2); uhi |= __shfl_xor(uhi, s2); }
        unsigned long long um = (unsigned long long)(unsigned)__builtin_amdgcn_readfirstlane((int)ulo) | ((unsigned long long)(unsigned)__builtin_amdgcn_readfirstlane((int)uhi) << 32);
        const bf16_t* Kb = proj + rb * PINP + CD_KS; const bf16_t* Vb = proj + rb * PINP + CD_VS;
        float l_run = 0.f; const float nbound = -bnd[9 + hh]; const float cfar = tbl[127] + nbound; const float* gk = p.nsa_kn + (l * 3 + 1) * 64 + (tid & 7) * 8;
        int j = __builtin_ctzll(um); um &= um - 1;
        int jn = um ? __builtin_ctzll(um) : -1; um &= um - 1;
        kv_load(kr, vr, Kb, Vb, 64 * j, tid);
        kv_store(kr, vr, KVBUF(L, 0), tid);
        if (jn >= 0) kv_load(kr, vr, Kb, Vb, 64 * jn, tid);
        for (int it = 0;; ++it) {
            __syncthreads();
            const int jnn = um ? __builtin_ctzll(um) : -1; um &= um - 1;
            if (jn >= 0) { kv_store(kr, vr, KVBUF(L, it + 1), tid); }
            if (jnn >= 0) kv_load(kr, vr, Kb, Vb, 64 * jnn, tid);
            const bool mine = (mymask >> j) & 1ull;
            if (__any(mine)) {
                const LDSP unsigned char* buf = KVBUF(L, it);
                const int k0 = 64 * j; const bool nearb = (qw - (k0 + 63)) < 113;
                f32x16 p0 = splat16(nearb ? nbound : (mine ? cfar : -INFINITY)), p1 = p0;
                qkt<4>(p0, p1, buf, qf, 0, r32, hi);
                if (nearb) bias_near(p0, p1, tbl, t - k0, 1 << 30, mine, hi);
                l_run += exp_sum(p0, p1);
                pv(o, buf, vb, p0, p1);
            }
            if (jn < 0) break;
            j = jn; jn = jnn;
        }
        l_run += __shfl_xor(l_run, 32);
        scale_rows(o, gs / l_run, wsf, r32, hi);
#pragma unroll
        for (int r = 0; r < 16; ++r) { ofl[(2 * r) * 64] += o[0][r]; ofl[(2 * r + 1) * 64] += o[1][r]; }
        o[0] = (f32x16){}; o[1] = (f32x16){};
    }
    {
        const bf16_t* Kb = proj + rb * PINP + CD_KW; const bf16_t* Vb = proj + rb * PINP + CD_VW;
        float l_run = 0.f; const float nbound = -bnd[13 + hh]; const float cfar = tbl[127] + nbound; const float* gk = p.nsa_kn + (l * 3 + 2) * 64 + (tid & 7) * 8;
        const int jlo = max(0, u - 8);
        __syncthreads();
        kv_load(kr, vr, Kb, Vb, 64 * jlo, tid);
        kv_store(kr, vr, KVBUF(L, jlo), tid);
        if (jlo < u) kv_load(kr, vr, Kb, Vb, 64 * (jlo + 1), tid);
        for (int j = jlo; j <= u; ++j) {
            __syncthreads();
            if (j + 1 <= u) { kv_store(kr, vr, KVBUF(L, j + 1), tid); }
            if (j + 2 <= u) kv_load(kr, vr, Kb, Vb, 64 * (j + 2), tid);
            const LDSP unsigned char* buf = KVBUF(L, j);
            const int k0 = 64 * j; const bool nearb = (j == u || j == u - 8 || (qw - (k0 + 63)) < 113);
            f32x16 p0 = splat16(nearb ? nbound : cfar), p1 = p0;
            qkt<4>(p0, p1, buf, qf, 0, r32, hi);
            if (nearb) bias_near(p0, p1, tbl, t - k0, 512, true, hi);
            l_run += exp_sum(p0, p1);
            pv(o, buf, vb, p0, p1);
        }
        l_run += __shfl_xor(l_run, 32);
        scale_rows(o, gwn / l_run, wsf, r32, hi);
#pragma unroll
        for (int r = 0; r < 16; ++r) { o[0][r] += ofl[(2 * r) * 64]; o[1][r] += ofl[(2 * r + 1) * 64]; }
    }
    store_o(o, (LDSP bf16_t*)(L + AL_IMP + wid * 8192), mix + (rb + qw) * DM + 768 + 64 * hh, lane, r32, hi);
}

__device__ void ph_reset_queues(const Params& p) { unsigned* ctl = (unsigned*)(p.ws + WS_CTL); const int gt = GTID(); if (gt < 8) ctl[gt] = 0u; }
__device__ void prep_cmp_task(const Params& p, int l, int task, LDSP unsigned char* L) {
    const int tid = TID(), lane = tid & 63, wid = __builtin_amdgcn_readfirstlane(tid >> 6), r32 = lane & 31, hi = lane >> 5;
    const int b = task >> 4, which = (task >> 3) & 1, nt = task & 7;
    const bf16_t* proj = (const bf16_t*)(p.ws + WS_PROJ);
    const bf16_t* phiT = (const bf16_t*)(p.ws + WS_PHIT) + (size_t)(l * 2 + which) * 64 * 2048;
    const float* pe = p.nsa_pe + (size_t)(l * 2 + which) * 32 * 64;
    const int n = 32 * nt + r32, colbase = which ? CD_VC : CD_KC;
    f32x16 acc0 = (f32x16){}, acc1 = (f32x16){};
#pragma unroll
    for (int ii = 0; ii < 4; ++ii) {
        const int i = 4 * wid + ii; const int tok = min(16 * n + i, SEQ - 1);
        const bf16_t* xr = proj + (size_t)(b * SEQ + tok) * PINP + colbase;
#pragma unroll
        for (int d0 = 0; d0 < 4; ++d0) {
            float xv[8]; load8(xr + 16 * d0 + 8 * hi, xv);
            const f32x4 pe0 = *(const f32x4*)(pe + i * 64 + 16 * d0 + 8 * hi), pe1 = *(const f32x4*)(pe + i * 64 + 16 * d0 + 8 * hi + 4);
            u32x4 aw; aw[0] = pg8::cvt_pk_bf16(xv[0] + pe0[0], xv[1] + pe0[1]); aw[1] = pg8::cvt_pk_bf16(xv[2] + pe0[2], xv[3] + pe0[3]);
            aw[2] = pg8::cvt_pk_bf16(xv[4] + pe1[0], xv[5] + pe1[1]); aw[3] = pg8::cvt_pk_bf16(xv[6] + pe1[2], xv[7] + pe1[3]);
            const bf16x8 af = __builtin_bit_cast(bf16x8, aw);
            const bf16x8 b0 = *(const bf16x8*)(phiT + (size_t)r32 * 2048 + i * 64 + 16 * d0 + 8 * hi);
            const bf16x8 b1 = *(const bf16x8*)(phiT + (size_t)(32 + r32) * 2048 + i * 64 + 16 * d0 + 8 * hi);
            acc0 = __builtin_amdgcn_mfma_f32_32x32x16_bf16(af, b0, acc0, 0, 0, 0);
            acc1 = __builtin_amdgcn_mfma_f32_32x32x16_bf16(af, b1, acc1, 0, 0, 0);
        }
    }
    LDSP float* red = (LDSP float*)L;
    __syncthreads();
#pragma unroll
    for (int r = 0; r < 16; ++r) { red[(wid * 32 + crow(r, hi)) * 64 + r32] = acc0[r]; red[(wid * 32 + crow(r, hi)) * 64 + 32 + r32] = acc1[r]; }
    __syncthreads();
    {
        const int row = tid >> 4, e4 = (tid & 15) * 4; f32x4 v = (f32x4){0.f, 0.f, 0.f, 0.f};
#pragma unroll
        for (int w8 = 0; w8 < 8; ++w8) v += *(const LDSP f32x4*)(red + (w8 * 32 + row) * 64 + e4);
        const int nn = 32 * nt + row;
        if (which == 0) {
            float ss = (v[0] * v[0] + v[1] * v[1]) + (v[2] * v[2] + v[3] * v[3]);
            ss += __shfl_xor(ss, 1); ss += __shfl_xor(ss, 2); ss += __shfl_xor(ss, 4); ss += __shfl_xor(ss, 8);
            const float rs = rsqrtf(ss * (1.f / 64.f) + EPS); const f32x4 g = *(const f32x4*)(p.nsa_kn + (l * 3 + 0) * 64 + e4);
            v = v * rs * g;
        }
        uint2 o; o.x = pk2(v[0], v[1]); o.y = pk2(v[2], v[3]);
        if (nn >= 255) { o.x = 0u; o.y = 0u; }
        *(uint2*)((bf16_t*)(p.ws + (which ? WS_VC : WS_KC)) + (size_t)(b * 256 + nn) * 64 + e4) = o;
    }
}
__device__ void ph_prep(const Params& p, int l, LDSP unsigned char* L, unsigned char* lds) {
    for (int t = blockIdx.x; t < 80; t += gridDim.x) { if (t < 64) prep_cmp_task(p, l, t, L); }
    if (gridDim.x >= 80) { if (blockIdx.x >= 64 && blockIdx.x < 80) ph_prep_cum_bh(p, l, blockIdx.x - 64, lds); }
    else for (int bh = blockIdx.x; bh < 16; bh += gridDim.x) ph_prep_cum_bh(p, l, bh, lds);
}


__device__ void fa_phase_all(const Params& p, int l, LDSP unsigned char* L, unsigned char* lds, int qslot) {
    unsigned* ctl = (unsigned*)(p.ws + WS_CTL);
    LDSP unsigned* misc = (LDSP unsigned*)(L + AL_MISC);
    bool prep_ok = false;
    for (;;) {
        __syncthreads();
        if (threadIdx.x == 0) misc[0] = atomicAdd(&ctl[qslot], 1u);
        __syncthreads();
        const unsigned qi0 = misc[0];
        if (qi0 >= 1104u) break;
        if (qi0 < 80u) {
            if (qi0 < 64u) prep_cmp_task(p, l, (int)qi0, L); else ph_prep_cum_bh(p, l, (int)qi0 - 64, lds);
            asm volatile("s_waitcnt vmcnt(0)" ::: "memory");
            __syncthreads();
            if (threadIdx.x == 0) { __threadfence(); atomicAdd(&ctl[4 + qslot], 1u); }
            continue;
        }
        const unsigned qi = qi0 - 80u;
        const int r = 15 - (int)(qi >> 6), j = (int)(qi & 63), typ = j >> 4, sub = j & 15;
        if ((typ == 2 || typ == 3) && !prep_ok) {
            if (threadIdx.x == 0) { while (__hip_atomic_load(&ctl[4 + qslot], __ATOMIC_RELAXED, __HIP_MEMORY_SCOPE_AGENT) < 80u) __builtin_amdgcn_s_sleep(8); __threadfence(); }
            asm volatile("s_waitcnt vmcnt(0)" ::: "memory");
            __syncthreads();
            prep_ok = true;
        }
        if (typ == 0) fa_diff_unit(p, l, sub >> 2, sub & 3, r, L);
        else if (typ == 1) fa_stick_unit(p, l, sub >> 2, sub & 3, r, L);
        else if (typ == 2) fa_fox_unit(p, l, sub >> 2, sub & 3, r, L);
        else fa_nsa_unit(p, l, sub >> 2, 4 * r + (sub & 3), L);
    }
}

#define XB_TMO      128
#define XB_XCNT(j)  (256  + 64 * (j))
#define XB_XSUB(j)  (1280 + 64 * (j))
#define XB_XGEN(j)  (2304 + 64 * (j))
#define XB_TOP      3328
#define XB_TOPGEN   3392
#define XCD_BAR_WORDS 3456
#define XB_SPIN_CAP (1u << 18)

__device__ __forceinline__ unsigned xb_ld(unsigned* p)              { return __hip_atomic_load(p, __ATOMIC_RELAXED, __HIP_MEMORY_SCOPE_AGENT); }
__device__ __forceinline__ unsigned xb_add(unsigned* p, unsigned v) { return __hip_atomic_fetch_add(p, v, __ATOMIC_RELAXED, __HIP_MEMORY_SCOPE_AGENT); }
__device__ __forceinline__ unsigned xb_xcc_id() { return (unsigned)__builtin_amdgcn_s_getreg((3 << 11) | 20) & 0xFu; }
#define XB_SPIN(cond, bar) do { unsigned _sp = 0; while (cond) { __builtin_amdgcn_s_sleep(1); \
    if ((++_sp & 255u) == 0u) { if (xb_ld(&(bar)[XB_TMO])) break; if (_sp > XB_SPIN_CAP) { atomicAdd(&(bar)[XB_TMO], 1u); break; } } } } while (0)

struct XcdBarrier {
    unsigned* bar; unsigned x;
    volatile LDSF unsigned* st;
};

__device__ __forceinline__ XcdBarrier xcd_barrier_post(unsigned* bar, volatile LDSF unsigned* st) {
    XcdBarrier b; b.bar = bar; b.x = xb_xcc_id(); b.st = st;
    if (threadIdx.x == 0) (void)xb_add(&bar[XB_XCNT(b.x)], 1u);
    return b;
}
__device__ __forceinline__ void xcd_barrier_complete(unsigned* bar, unsigned x, unsigned& nloc, unsigned& nx) {
    const unsigned G = gridDim.x * gridDim.y * gridDim.z;
    unsigned sum, cnt, mine, sp = 0u;
    for (;;) {
        sum = 0u; cnt = 0u; mine = 0u;
#pragma unroll
        for (unsigned j = 0; j < 16; ++j) { const unsigned c = xb_ld(&bar[XB_XCNT(j)]); sum += c; cnt += (c > 0u) ? 1u : 0u; mine = (j == x) ? c : mine; }
        if (sum == G) break;
        __builtin_amdgcn_s_sleep(1);
        if ((++sp & 255u) == 0u) { if (xb_ld(&bar[XB_TMO])) break; if (sp > XB_SPIN_CAP) { atomicAdd(&bar[XB_TMO], 1u); break; } }
    }
    nloc = mine > 0u ? mine : 1u; nx = cnt > 0u ? cnt : 1u;
}

__device__ __forceinline__ void xcd_barrier(const XcdBarrier& b) {
    asm volatile("s_waitcnt vmcnt(0)" ::: "memory");
    __syncthreads();
    if (threadIdx.x == 0) {
        unsigned* bar = b.bar;
        __builtin_amdgcn_s_waitcnt(0);
        unsigned nloc = b.st[0], nx = b.st[1];
        if (nloc == 0u) { xcd_barrier_complete(bar, b.x, nloc, nx); b.st[0] = nloc; b.st[1] = nx; }
        const unsigned old = xb_add(&bar[XB_XSUB(b.x)], 1u);
        const unsigned gen = old / nloc;
        if (old + 1u == (gen + 1u) * nloc) {
            __builtin_amdgcn_fence(__ATOMIC_RELEASE, "agent");
            asm volatile("s_waitcnt vmcnt(0)" ::: "memory");
            const unsigned og = xb_add(&bar[XB_TOP], 1u);
            const unsigned tg = og / nx;
            if (og + 1u == (tg + 1u) * nx) xb_add(&bar[XB_TOPGEN], 1u);
            else XB_SPIN(xb_ld(&bar[XB_TOPGEN]) == tg, bar);
            __builtin_amdgcn_fence(__ATOMIC_ACQUIRE, "agent");
            xb_add(&bar[XB_XGEN(b.x)], 1u);
            asm volatile("s_waitcnt vmcnt(0)" ::: "memory");
        } else {
            XB_SPIN(xb_ld(&bar[XB_XGEN(b.x)]) == gen, bar);
            __builtin_amdgcn_fence(__ATOMIC_ACQUIRE, "agent");
            asm volatile("s_waitcnt vmcnt(0)" ::: "memory");
        }
    }
    __syncthreads();
}

namespace cg = cooperative_groups;
constexpr int LDS_BYTES = 131072 + 8192 + 4096;
#define LAS3 __attribute__((address_space(3)))
#ifndef PROBE
#define PROBE 0
#endif
__global__ void __launch_bounds__(NTHR, 2) mega(Params p) {
    extern __shared__ __attribute__((aligned(16))) unsigned char lds[];
    cg::grid_group grid = cg::this_grid();
#if PROBE
    unsigned long long tacc = 0, tph = 0, t0_;
#define GSYNC() do { t0_ = __builtin_amdgcn_s_memrealtime(); xcd_barrier(xbar); tacc += __builtin_amdgcn_s_memrealtime() - t0_; } while (0)
#define TPK(k, ...) do { if (PROBE == (k)) { t0_ = __builtin_amdgcn_s_memrealtime(); __VA_ARGS__; tph += __builtin_amdgcn_s_memrealtime() - t0_; } else { __VA_ARGS__; } } while (0)
#else
#define GSYNC() xcd_barrier(xbar)
#define TPK(k, ...) do { __VA_ARGS__; } while (0)
#endif
    LAS3 unsigned char* lds3 = (LAS3 unsigned char*)lds;
    volatile LDSF unsigned* bst = (volatile LDSF unsigned*)(lds3 + 131072 + 2048);
    if (threadIdx.x < 2) bst[threadIdx.x] = 0u;
    __syncthreads();
    XcdBarrier xbar = xcd_barrier_post((unsigned*)(p.ws + WS_CTL) + 16384, bst);
    TPK(2, ph_mod(p, lds); ph_reset_queues(p); ph_weights(p, 0, lds); ph_weights(p, 1, lds));
    grid.sync();
    for (int l = 0; l < DEPTH; ++l) {
        const float* mod = (const float*)(p.ws + WS_MOD) + (size_t)l * 4 * 6144;
        if (l == 0) {
            TPK(2, ph_cbias(p, lds); ph_xa_from(p, p.x, 0, 0, (bf16_t*)(p.ws + WS_XA), (float*)(p.ws + WS_RSA), true));
            GSYNC();
        }
        {   pg8::Gemm g{(const bf16_t*)(p.ws + WS_XA), (const bf16_t*)(p.ws + WS_WIN + l * WS_W1OFF), MTOK, PINP, DM}; pg8::StaticOrder S; S.init(MTOK, PINP, (int)gridDim.x, (int)blockIdx.x);
            EpiProjF E{(const float*)(p.ws + WS_RSA), (const float*)(p.ws + WS_CBIN) + (size_t)l * 4 * PINP, (bf16_t*)(p.ws + WS_PROJ), (float*)(p.ws + WS_SIDE),
                       p.diff_kn + l * 32, p.fox_kn + l * 64, p.nsa_kn + (l * 3 + 1) * 64, p.nsa_kn + (l * 3 + 2) * 64, (LDSF float*)(lds3 + 131072 + 4096)};
            TPK(6, pg8::gemm_phase<EpiProjF, pg8::StaticOrder, true, PG8_SP2>(lds3, g, S, E)); }
        GSYNC();
        TPK(7, fa_phase_all(p, l, lds3, lds, l));
        GSYNC();
        {   pg8::Gemm g{(const bf16_t*)(p.ws + WS_MIX), (const bf16_t*)(p.ws + WS_WOUT + l * WS_W1OFF), MTOK, DM, DM}; pg8::StaticOrder S; S.init(MTOK, DM, (int)gridDim.x, (int)blockIdx.x);
            EpiResF E{l == 0 ? p.x : p.out, p.out, mod + 2048, p.norm_ffn_g + l * DM, mod + 4096, (bf16_t*)(p.ws + WS_XA), (float*)(p.ws + WS_RSB)};
            TPK(6, pg8::gemm_phase<EpiResF, pg8::StaticOrder, PG8_ALIGN, PG8_SP2>(lds3, g, S, E)); }
        GSYNC();
        {   pg8::Gemm g{(const bf16_t*)(p.ws + WS_XA), (const bf16_t*)(p.ws + WS_WUP + l * WS_W1OFF), MTOK, NUP, DM}; pg8::StaticOrder S; S.init(MTOK, NUP, (int)gridDim.x, (int)blockIdx.x);
            EpiUpAct E{(const float*)(p.ws + WS_RSB), (const float*)(p.ws + WS_CBUP) + (size_t)l * 4 * NUP, (bf16_t*)(p.ws + WS_ACT), (float*)(p.ws + WS_EG), (float*)(p.ws + WS_EV),
                       p.conv_w + (size_t)l * 3 * DFF, p.conv_b + (size_t)l * DFF, (LDSF float*)(lds3 + 131072 + 4096), (LDSF float*)(lds3 + 131072 + 8192)};
            TPK(6, pg8::gemm_phase<EpiUpAct, pg8::StaticOrder, true, PG8_SP2>(lds3, g, S, E)); }
        GSYNC();
        {   const float* modn = (const float*)(p.ws + WS_MOD) + (size_t)(l + 1) * 4 * 6144; const bool more = (l + 1 < DEPTH);
            pg8::Gemm g{(const bf16_t*)(p.ws + WS_ACT), (const bf16_t*)(p.ws + WS_WDN + l * WS_W1OFF), MTOK, DM, DFF}; pg8::StaticOrder S; S.init(MTOK, DM, (int)gridDim.x, (int)blockIdx.x);
            { pg8::Unit fu; for (int i = 0; S.next(i, fu); ++i) act_fixup(p, l, fu.pm); }
            __builtin_amdgcn_fence(__ATOMIC_RELEASE, "agent"); __builtin_amdgcn_fence(__ATOMIC_ACQUIRE, "agent"); __syncthreads();
            EpiResF E{p.out, p.out, mod + 5120, p.norm_mix_g + (more ? l + 1 : l) * DM, more ? modn + 1024 : mod + 1024, more ? (bf16_t*)(p.ws + WS_XA) : nullptr, more ? (float*)(p.ws + WS_RSA) : nullptr};
            TPK(6, pg8::gemm_phase<EpiResF, pg8::StaticOrder, PG8_ALIGN, PG8_SP2>(lds3, g, S, E)); }
        if (l + 1 < DEPTH) GSYNC();
    }
#if PROBE == 1
    if (blockIdx.x == 0 && threadIdx.x == 0) p.out[0] += 0.05f + (float)tacc * 0.01f * 5e-4f;
#elif PROBE >= 2
    if (blockIdx.x == 0 && threadIdx.x == 0) p.out[0] += 0.05f + (float)tph * 0.01f * 1e-4f;
#endif
}

extern "C" void kernel_launch(void* const* d_in, const int* in_sizes, int in, void* d_out, int out_size, void* d_ws, size_t ws_size, hipStream_t stream) {
    if (in != 24 || ws_size < WS_END || out_size != MTOK * DM) { fprintf(stderr, "kernel_launch: unexpected sizes (in %d, ws %zu, out %d)\n", in, ws_size, out_size); return; }
    static int grid_blocks = 0;
    if (!grid_blocks) {
        int dev = 0, cus = 0, per_cu = 0;
        hipGetDevice(&dev);
        hipDeviceGetAttribute(&cus, hipDeviceAttributeMultiprocessorCount, dev);
        hipFuncSetAttribute((const void*)mega, hipFuncAttributeMaxDynamicSharedMemorySize, LDS_BYTES);
        hipOccupancyMaxActiveBlocksPerMultiprocessor(&per_cu, (const void*)mega, NTHR, LDS_BYTES);
        if (per_cu < 1) { fprintf(stderr, "kernel_launch: occupancy query returned %d\n", per_cu); per_cu = 1; }
        if (per_cu > 1) per_cu = 1;
        grid_blocks = cus * per_cu;
        fprintf(stderr, "kernel_launch: cus %d per_cu %d grid %d\n", cus, per_cu, grid_blocks);
    }
    if (hipMemsetAsync((char*)d_ws + WS_CTL + 65536, 0, XCD_BAR_WORDS * 4, stream) != hipSuccess) { fprintf(stderr, "kernel_launch: memset failed\n"); return; }
    Params p{};
    const float** f = (const float**)&p;
    for (int i = 0; i < 24; ++i) f[i] = (const float*)d_in[i];
    p.out = (float*)d_out; p.ws = (unsigned char*)d_ws;
    void* args[] = {&p};
    hipError_t e = hipLaunchCooperativeKernel((const void*)mega, dim3(grid_blocks), dim3(NTHR), args, LDS_BYTES, stream);
    if (e != hipSuccess) fprintf(stderr, "cooperative launch failed: %s (grid %d)\n", hipGetErrorString(e), grid_blocks);
}
```

```cpp
#include <hip/hip_runtime.h>
#include <hip/hip_cooperative_groups.h>
#include <cstdint>
#include <cstdio>

typedef unsigned short bf16_t;
typedef short bf16x8 __attribute__((ext_vector_type(8)));
typedef float f32x4 __attribute__((ext_vector_type(4)));
typedef unsigned u32x4 __attribute__((ext_vector_type(4)));

constexpr int NB = 4, SEQ = 4096, DM = 1024, MTOK = NB * SEQ, DEPTH = 2;
constexpr int HD = 64, HPM = 4, DFF = 2816, PIN = 2960, PINP = 3072, NUP = 2 * DFF;
constexpr float EPS = 1e-6f;
constexpr float LOG2E = 1.4426950408889634f;
constexpr int NTHR = 512;

constexpr int CA_Q = 0, CA_K = 256, CA_V = 512, CB_Q = 768, CB_K = 1024, CB_V = 1280, CC_Q = 1536, CC_K = 1792, CC_V = 2048;
constexpr int CD_Q = 2304, CD_KC = 2560, CD_VC = 2624, CD_KS = 2688, CD_VS = 2752, CD_KW = 2816, CD_VW = 2880, C_BF = 2944, C_DG = 2948;

constexpr size_t MiB = 1u << 20;
constexpr size_t WS_CTL = 0;
constexpr size_t WS_MOD = 1 * MiB;
constexpr size_t WS_CBIN = WS_MOD + 2 * 4 * 6144 * 4;
constexpr size_t WS_CBUP = WS_CBIN + 2 * 4 * 3072 * 4;
constexpr size_t WS_TB = WS_CBUP + 2 * 4 * 5632 * 4;
constexpr size_t WS_LAM = WS_TB + 2 * 4 * 128 * 4;
constexpr size_t WS_BND = WS_LAM + 64;
constexpr size_t WS_CUM = WS_LAM + 512;
constexpr size_t WS_KC = WS_CUM + 16 * 4096 * 4;
constexpr size_t WS_VC = WS_KC + 4 * 256 * 64 * 2;
constexpr size_t WS_SELM = WS_VC + 4 * 256 * 64 * 2;
constexpr size_t WS_SMALL_END = WS_SELM + 16384 * 8;
static_assert(WS_SMALL_END <= 4 * MiB, "small region");
constexpr size_t WS_RSA = 4 * MiB;
constexpr size_t WS_RSB = 5 * MiB;
constexpr size_t WS_SIDE = 6 * MiB;
constexpr size_t WS_IMP = 7 * MiB;
constexpr size_t WS_ML = 11 * MiB;
constexpr size_t WS_PHIT = 7 * MiB;
constexpr size_t WS_W = 12 * MiB;
constexpr size_t WS_WIN = WS_W;
constexpr size_t WS_WOUT = WS_WIN + (size_t)PINP * DM * 2;
constexpr size_t WS_WUP = WS_WOUT + (size_t)DM * DM * 2;
constexpr size_t WS_WDN = WS_WUP + (size_t)NUP * DM * 2;
constexpr size_t WS_W_END = WS_WDN + (size_t)DM * DFF * 2;
static_assert(WS_W_END <= 38 * MiB, "weights region");
constexpr size_t WS_XA = 38 * MiB;
constexpr size_t WS_BIG = 70 * MiB;
constexpr size_t WS_PROJ = WS_BIG;
constexpr size_t WS_MIX = WS_BIG + 96 * MiB;
constexpr size_t WS_ACT = WS_BIG;
constexpr size_t WS_W1OFF = 188 * MiB;
constexpr size_t WS_EG = 228 * MiB;
constexpr size_t WS_EV = 232 * MiB;
constexpr size_t WS_END = 236 * MiB;
static_assert(WS_W_END + WS_W1OFF <= WS_EG && WS_MIX + 32 * MiB <= WS_W + WS_W1OFF, "layer-1 weights");
static_assert(WS_END <= 256 * MiB, "workspace");

struct Params {
    const float *x, *c, *rel_bias, *ada_w, *ada_b, *norm_mix_g, *norm_ffn_g, *w_in, *w_out;
    const float *diff_qn, *diff_kn, *diff_lam, *diff_sub, *fox_qn, *fox_kn, *fox_bf;
    const float *nsa_qn, *nsa_kn, *nsa_pe, *nsa_phi, *w_up, *conv_w, *conv_b, *w_down;
    float* out;
    unsigned char* ws;
};

__device__ __forceinline__ float bf2f(bf16_t v) { return __uint_as_float(((unsigned)v) << 16); }
__device__ __forceinline__ bf16_t f2bf(float f) { unsigned u = __float_as_uint(f); return (bf16_t)((u + 0x7fffu + ((u >> 16) & 1u)) >> 16); }
__device__ __forceinline__ unsigned pk2(float lo, float hi) { return (unsigned)f2bf(lo) | ((unsigned)f2bf(hi) << 16); }
__device__ __forceinline__ float siluf(float v) { return v / (1.f + __expf(-v)); }
__device__ __forceinline__ float logsigf(float v) { return fminf(v, 0.f) - log1pf(__expf(-fabsf(v))); }
__device__ __forceinline__ float wave_sum(float v) {
#pragma unroll
    for (int o = 1; o < 64; o <<= 1) v += __shfl_xor(v, o);
    return v;
}
__device__ __forceinline__ int t5_bucket(int n) {
    if (n < 16) return n < 0 ? 0 : n;
    return 16 + (n >= 19) + (n >= 21) + (n >= 24) + (n >= 27) + (n >= 31) + (n >= 35) + (n >= 40) + (n >= 46) + (n >= 52) + (n >= 59) + (n >= 67) + (n >= 77) + (n >= 87) + (n >= 99) + (n >= 113);
}
__host__ __device__ __forceinline__ int in_col_map(int n) {
    if (n < 1536) return n;
    if (n < 2944) return n + 4;
    if (n < 2948) return 1536 + (n - 2944);
    if (n < 2960) return n;
    return -1;
}
__host__ __device__ __forceinline__ int up_col_map(int n) {
    const int pn = n >> 8, c = n & 255;
    return c < 128 ? (128 * pn + c) : (DFF + 128 * pn + (c - 128));
}

__device__ __forceinline__ int opaque_v(int v) { asm volatile("" : "+v"(v)); return v; }
#define TID() opaque_v((int)threadIdx.x)
#define GTID() ((int)(blockIdx.x * blockDim.x) + TID())
#define GSIZE() ((int)(gridDim.x * blockDim.x))

__device__ __forceinline__ void load8(const bf16_t* p, float* d) {
    const u32x4 r = *(const u32x4*)p;
    d[0] = bf2f(r[0] & 0xffff); d[1] = bf2f(r[0] >> 16); d[2] = bf2f(r[1] & 0xffff); d[3] = bf2f(r[1] >> 16);
    d[4] = bf2f(r[2] & 0xffff); d[5] = bf2f(r[2] >> 16); d[6] = bf2f(r[3] & 0xffff); d[7] = bf2f(r[3] >> 16);
}
#define LDSF __attribute__((address_space(3)))
__device__ __forceinline__ void gemv4_block(const float* W, int ld, int oc, const LDSF float* vec, LDSF float* red, float* out0, int ostride, int n, float bias, int tid) {
    const int lane = tid & 63, wv = tid >> 6;
    float a0 = 0.f, a1 = 0.f, a2 = 0.f, a3 = 0.f;
    if (oc >= 0) {
        const float* w = W + (size_t)(wv * 128) * ld + oc;
#pragma unroll 32
        for (int k = 0; k < 128; ++k) { const float wk = w[(size_t)k * ld]; const f32x4 v = *(const LDSF f32x4*)(vec + (wv * 128 + k) * 4); a0 += v[0] * wk; a1 += v[1] * wk; a2 += v[2] * wk; a3 += v[3] * wk; }
    }
    red[(wv * 4 + 0) * 64 + lane] = a0; red[(wv * 4 + 1) * 64 + lane] = a1; red[(wv * 4 + 2) * 64 + lane] = a2; red[(wv * 4 + 3) * 64 + lane] = a3;
    __syncthreads();
    if (tid < 256) { const int bt = tid >> 6; float sacc = 0.f;
#pragma unroll
        for (int w8 = 0; w8 < 8; ++w8) sacc += red[(w8 * 4 + bt) * 64 + lane];
        out0[(size_t)bt * ostride + n] = sacc + bias; }
    __syncthreads();
}
__device__ void ph_mod(const Params& p, unsigned char* lds) {
    float* mod = (float*)(p.ws + WS_MOD);
    float* tb = (float*)(p.ws + WS_TB);
    float* lamv = (float*)(p.ws + WS_LAM);
    LDSF float* vec = (LDSF float*)lds; LDSF float* red = (LDSF float*)(lds + 16384);
    const int tid = TID();
    bool loaded = false;
    for (int item = blockIdx.x; item < DEPTH * 96; item += gridDim.x) {
        if (!loaded) { for (int i = tid; i < 4096; i += NTHR) { const int bt = i >> 10, k = i & 1023; vec[k * 4 + bt] = siluf(p.c[bt * DM + k]); } __syncthreads(); loaded = true; }
        const int l = item / 96, n = (item % 96) * 64 + (tid & 63);
        gemv4_block(p.ada_w + (size_t)l * DM * 6144, 6144, n, vec, red, mod + (size_t)l * 4 * 6144, 6144, n, p.ada_b[l * 6144 + n], tid);
    }
    const int gt = GTID(), gs = GSIZE();
    for (int idx = gt; idx < 2 * 4 * 128; idx += gs) {
        const int type = idx / 512, h = (idx / 128) & 3, d = idx & 127;
        tb[idx] = p.rel_bias[t5_bucket(d) * 8 + type * 4 + h];
    }
    for (int idx = gt; idx < DEPTH * 32; idx += gs) {
        const int l = idx >> 5, e = idx & 31; float v = 0.f;
        if (e < 17) {
            const int type = (e < 5) ? 0 : 1, h = (e < 4) ? e : ((e == 4) ? 0 : ((e - 5) & 3));
            const int ng = (e < 4) ? 32 : 64;
            const float* gq = (e < 4) ? p.diff_qn + l * 32 : ((e == 4) ? p.fox_qn + l * 64 : p.nsa_qn + l * 64);
            const float* gk = (e < 4) ? p.diff_kn + l * 32 : ((e == 4) ? p.fox_kn + l * 64 : p.nsa_kn + (l * 3 + (e - 5) / 4) * 64);
            float mq = 0.f, mk = 0.f; for (int i = 0; i < ng; ++i) { mq = fmaxf(mq, fabsf(gq[i])); mk = fmaxf(mk, fabsf(gk[i])); }
            float tm = 0.f; if (e != 4) { tm = -INFINITY; for (int bk2 = 0; bk2 < 32; ++bk2) tm = fmaxf(tm, p.rel_bias[bk2 * 8 + type * 4 + h]); }
            v = sqrtf((float)ng) * mq * mk * 1.02f * LOG2E + tm * LOG2E;
        }
        ((float*)(p.ws + WS_BND))[idx] = v;
    }
    for (int idx = gt; idx < DEPTH; idx += gs) {
        const float* lv = p.diff_lam + idx * 4 * 32;
        float s1 = 0.f, s2 = 0.f;
        for (int i = 0; i < 32; ++i) { s1 += lv[i] * lv[32 + i]; s2 += lv[64 + i] * lv[96 + i]; }
        const float lam_init = 0.8f - 0.6f * expf(-0.3f * (float)idx);
        lamv[idx] = expf(s1) - expf(s2) + lam_init;
    }
}
__device__ void ph_cbias(const Params& p, unsigned char* lds) {
    const float* mod = (const float*)(p.ws + WS_MOD);
    const int tid_ = TID(); const int lane = tid_ & 63, wv = tid_ >> 6;
    const int gw = blockIdx.x * (NTHR >> 6) + wv, ngw = gridDim.x * (NTHR >> 6);
    constexpr int NCOL = PINP + NUP;
    const int per = (DEPTH * NCOL + ngw - 1) / ngw; const int c0 = gw * per, c1 = min(DEPTH * NCOL, c0 + per);
    int cur_key = -1; float sh[4][16];
    for (int c = c0; c < c1; ++c) {
        const int l = c / NCOL, r = c % NCOL; const bool isin = r < PINP; const int n = isin ? r : r - PINP; const int key = l * 2 + (isin ? 0 : 1);
        if (key != cur_key) { cur_key = key; const int shoff = isin ? 0 : 3072;
#pragma unroll
            for (int bt = 0; bt < 4; ++bt)
#pragma unroll
                for (int q4 = 0; q4 < 4; ++q4) { const f32x4 v = *(const f32x4*)(mod + (size_t)(l * 4 + bt) * 6144 + shoff + 16 * lane + 4 * q4); sh[bt][4 * q4] = v[0]; sh[bt][4 * q4 + 1] = v[1]; sh[bt][4 * q4 + 2] = v[2]; sh[bt][4 * q4 + 3] = v[3]; } }
        const bf16_t* wrow = (const bf16_t*)(p.ws + (isin ? WS_WIN : WS_WUP) + l * WS_W1OFF) + (size_t)n * DM + 16 * lane;
        float w[16]; load8(wrow, w); load8(wrow + 8, w + 8);
        float a0 = 0.f, a1 = 0.f, a2 = 0.f, a3 = 0.f;
#pragma unroll
        for (int j = 0; j < 16; ++j) { a0 += sh[0][j] * w[j]; a1 += sh[1][j] * w[j]; a2 += sh[2][j] * w[j]; a3 += sh[3][j] * w[j]; }
        a0 = wave_sum(a0); a1 = wave_sum(a1); a2 = wave_sum(a2); a3 = wave_sum(a3);
        if (lane == 0) { float* o = isin ? (float*)(p.ws + WS_CBIN) + (size_t)l * 4 * PINP : (float*)(p.ws + WS_CBUP) + (size_t)l * 4 * NUP; const int ld = isin ? PINP : NUP;
            o[n] = a0; o[ld + n] = a1; o[2 * ld + n] = a2; o[3 * ld + n] = a3; }
    }
}
template <int MAPK>
__device__ void convert_weight(const float* W, int K, int Nsrc, int Npad, bf16_t* Wt, LDSF float* scr, int gw, int ngw, int lane) {
    const int nkb = K / 64, nnb = Npad / 64;
    for (int it = gw; it < nkb * nnb; it += ngw) {
        const int kb = it / nnb, nb = it % nnb, k0 = kb * 64, n0 = nb * 64;
        {
            const int n = n0 + lane;
            const int oc = MAPK == 0 ? n : (MAPK == 1 ? in_col_map(n) : up_col_map(n));
            const float* wp = W + (size_t)k0 * Nsrc + (oc >= 0 ? oc : 0);
#pragma unroll 1
            for (int hh = 0; hh < 2; ++hh) {
                float tv[32];
#pragma unroll
                for (int i = 0; i < 32; ++i) tv[i] = wp[(size_t)(32 * hh + i) * Nsrc];
#pragma unroll
                for (int i = 0; i < 32; ++i) scr[(32 * hh + i) * 65 + lane] = (oc >= 0) ? tv[i] : 0.f;
            }
        }
        __builtin_amdgcn_s_waitcnt(0xc07f); __builtin_amdgcn_wave_barrier();
        {
            const int c = lane & 7;
#pragma unroll
            for (int j = 0; j < 8; ++j) { const int nn = 8 * j + (lane >> 3); const LDSF float* sp = scr + (8 * c) * 65 + nn;
                u32x4 o; o[0] = pk2(sp[0], sp[65]); o[1] = pk2(sp[130], sp[195]); o[2] = pk2(sp[260], sp[325]); o[3] = pk2(sp[390], sp[455]);
                *(u32x4*)(Wt + (size_t)(n0 + nn) * K + k0 + 8 * c) = o; }
        }
        __builtin_amdgcn_s_waitcnt(0xc07f); __builtin_amdgcn_wave_barrier();
    }
}
__device__ void ph_weights(const Params& p, int l, unsigned char* lds) {
    const int tid_ = TID(); const int lane = tid_ & 63, wv = tid_ >> 6;
    const int gw = blockIdx.x * (NTHR >> 6) + wv, ngw = gridDim.x * (NTHR >> 6);
    LDSF float* scr = (LDSF float*)lds + wv * (64 * 65);
    convert_weight<1>(p.w_in + (size_t)l * DM * PIN, DM, PIN, PINP, (bf16_t*)(p.ws + WS_WIN + l * WS_W1OFF), scr, gw, ngw, lane);
    convert_weight<0>(p.w_out + (size_t)l * DM * DM, DM, DM, DM, (bf16_t*)(p.ws + WS_WOUT + l * WS_W1OFF), scr, gw, ngw, lane);
    convert_weight<2>(p.w_up + (size_t)l * DM * NUP, DM, NUP, NUP, (bf16_t*)(p.ws + WS_WUP + l * WS_W1OFF), scr, gw, ngw, lane);
    convert_weight<0>(p.w_down + (size_t)l * DFF * DM, DFF, DM, DM, (bf16_t*)(p.ws + WS_WDN + l * WS_W1OFF), scr, gw, ngw, lane);
    for (int w2 = 0; w2 < 2; ++w2) convert_weight<0>(p.nsa_phi + (size_t)(l * 2 + w2) * 2048 * 64, 2048, 64, 64, (bf16_t*)(p.ws + WS_PHIT) + (size_t)(l * 2 + w2) * 64 * 2048, scr, gw, ngw, lane);
}
__device__ void ph_xa_from(const Params& p, const float* src, int l, int which  , bf16_t* XA, float* rowss, bool write_xa) {
    const float* mod = (const float*)(p.ws + WS_MOD);
    const float* g = (which == 0 ? p.norm_mix_g : p.norm_ffn_g) + l * DM;
    const int tid_ = TID(); const int lane = tid_ & 63, wv = tid_ >> 6;
    const int gw = blockIdx.x * (blockDim.x >> 6) + wv, ngw = gridDim.x * (blockDim.x >> 6);
    for (int row0 = gw; row0 < MTOK; row0 += 2 * ngw) {
        f32x4 v[2][4];
#pragma unroll
        for (int rr = 0; rr < 2; ++rr) { const int row = min(row0 + rr * ngw, MTOK - 1);
#pragma unroll
            for (int j = 0; j < 4; ++j) v[rr][j] = *(const f32x4*)(src + (size_t)row * DM + j * 256 + lane * 4); }
#pragma unroll
        for (int rr = 0; rr < 2; ++rr) {
            const int row = row0 + rr * ngw;
            if (row < MTOK) {
                const int b = row / SEQ; const float* sc = mod + (size_t)(l * 4 + b) * 6144 + (which == 0 ? 1024 : 4096);
                float ss = 0.f;
#pragma unroll
                for (int j = 0; j < 4; ++j) {
                    const int k = j * 256 + lane * 4; const f32x4 x = v[rr][j];
                    ss += x[0] * x[0] + x[1] * x[1] + x[2] * x[2] + x[3] * x[3];
                    if (write_xa) {
                        const f32x4 gv = *(const f32x4*)(g + k); const f32x4 sv = *(const f32x4*)(sc + k);
                        uint2 o; o.x = pk2(x[0] * gv[0] * (1.f + sv[0]), x[1] * gv[1] * (1.f + sv[1])); o.y = pk2(x[2] * gv[2] * (1.f + sv[2]), x[3] * gv[3] * (1.f + sv[3]));
                        *(uint2*)(XA + (size_t)row * DM + k) = o;
                    }
                }
                ss = wave_sum(ss);
                if (lane < 16) rowss[(size_t)row * 16 + lane] = (lane == 0) ? ss : 0.f;
            }
        }
    }
}

namespace pg8 {
#define PG8_LAS __attribute__((address_space(3)))
typedef unsigned short bf16_t;
typedef short bf16x8 __attribute__((ext_vector_type(8)));
typedef float f32x4 __attribute__((ext_vector_type(4)));
typedef unsigned u32x4 __attribute__((ext_vector_type(4)));
constexpr int BM = 256, BK = 64, HALF = 128, HTB = HALF * BK * 2  , STAGE_BYTES = 8 * HTB, NXCD = 8, WGM = 8;

__host__ __device__ __forceinline__ int lds_byte(int r, int c) { const int st = (r >> 4) * 2 + (c >> 5), rr = r & 15, cc = c & 31, ob = rr * 64 + cc * 2; return st * 1024 + (ob ^ (((ob >> 9) & 1) << 5)); }
__host__ __device__ __forceinline__ void stage_rc(int b, int& R, int& C) { const int st = b / 1024, sb = b % 1024, swz = sb ^ (((sb >> 9) & 1) << 5); R = (st >> 1) * 16 + swz / 64; C = (st & 1) * 32 + (swz % 64) / 2; }
__host__ __device__ __forceinline__ int perm32(int rho) { const int n = rho >> 4, i = rho & 15; return 8 * (i >> 2) + 4 * n + (i & 3); }

struct Unit { int pm, pn; };
struct Gemm { const bf16_t* A; const bf16_t* Bt; int M, N, K; };

struct StaticOrder {
    int nM, nN, nwg, G, c;
    __host__ __device__ void init(int M, int N, int G_, int c_) { nM = M / BM; nN = N / BM; nwg = nM * nN; G = G_; c = c_; }
    __host__ __device__ bool next(int i, Unit& u) const {
        const long L = (long)i * G + c; if (L >= nwg) return false;
        int wgid = (int)L; { const int q = nwg / NXCD, r = nwg % NXCD, xcd = wgid % NXCD, off = wgid / NXCD; wgid = (xcd < r ? xcd * (q + 1) : r * (q + 1) + (xcd - r) * q) + off; }
        const int nig = WGM * nN, gid = wgid / nig, fm = gid * WGM, gsz = (nM - fm) < WGM ? (nM - fm) : WGM;
        u.pm = fm + ((wgid % nig) % gsz); u.pn = (wgid % nig) / gsz; return true;
    }
    __device__ __forceinline__ void a_ready(const Unit&) const {}
    __device__ __forceinline__ void done(const Unit&) const {}
};


__device__ __forceinline__ unsigned cvt_pk_bf16(float lo, float hi) { unsigned r; asm volatile("v_cvt_pk_bf16_f32 %0, %1, %2" : "=v"(r) : "v"(lo), "v"(hi)); return r; }
template <class Epi, class Sched, bool ALIGN_EPI = false, bool SP2 = false>
__device__ __forceinline__ void gemm_phase(PG8_LAS unsigned char* lds, const Gemm g, const Sched& S, const Epi& E) {
    const int tid = TID(), wid = __builtin_amdgcn_readfirstlane(tid >> 6), lane = tid & 63, wr = wid >> 2, wc = wid & 3, fr = lane & 15, fq = lane >> 4;
    const int K = g.K, nt = K / BK;
    unsigned voffA[2], voffB[2];
#pragma unroll
    for (int i = 0; i < 2; ++i) { int R, C; stage_rc(tid * 16 + i * 8192, R, C); const int Rb = Epi::PERM ? ((R & ~31) + perm32(R & 31)) : R;
        voffA[i] = (unsigned)(R * K + C) * 2u; voffB[i] = (unsigned)(Rb * K + C) * 2u; }
    const size_t kstep = (size_t)(BK * 2);
    const size_t hstep = (size_t)HALF * K * 2;
    const size_t tstep = 2 * hstep;
    const unsigned ldsw = (unsigned)wid * 1024u;
    const int aoff = lds_byte(wr * 64 + fr, fq * 8), boff = lds_byte(wc * 32 + fr, fq * 8);
#define PG8_SA(b, h) (((b) * 2 + (h)) * HTB)
#define PG8_SB(b, h) ((4 + (b) * 2 + (h)) * HTB)
#define PG8_STAGE(bufoff, gbase, voff) do { _Pragma("unroll") for (int _i = 0; _i < 2; ++_i) \
        __builtin_amdgcn_global_load_lds((const unsigned*)((const char*)(gbase) + (voff)[_i]), (PG8_LAS unsigned*)(lds + (bufoff) + ldsw + _i * 8192), 16, 0, 0); } while (0)
#define PG8_LDA(dst, b, h) do { _Pragma("unroll") for (int m = 0; m < 4; ++m) _Pragma("unroll") for (int k = 0; k < 2; ++k) dst[m][k] = *(const PG8_LAS bf16x8*)(lds + PG8_SA(b, h) + aoff + m * 2048 + k * 1024); } while (0)
#define PG8_LDB(dst, b, h) do { _Pragma("unroll") for (int n = 0; n < 2; ++n) _Pragma("unroll") for (int k = 0; k < 2; ++k) dst[n][k] = *(const PG8_LAS bf16x8*)(lds + PG8_SB(b, h) + boff + n * 2048 + k * 1024); } while (0)
#define PG8_MMA(ai, bj, At, Bt) do { __builtin_amdgcn_s_setprio(1); _Pragma("unroll") for (int m = 0; m < 4; ++m) _Pragma("unroll") for (int n = 0; n < 2; ++n) _Pragma("unroll") for (int k = 0; k < 2; ++k) \
        acc[ai][bj][m][n] = __builtin_amdgcn_mfma_f32_16x16x32_bf16(Bt[n][k], At[m][k], acc[ai][bj][m][n], 0, 0, 0); __builtin_amdgcn_s_setprio(0); } while (0)
#define PG8_WAIT_V(n) asm volatile("s_waitcnt vmcnt(" #n ")" ::: "memory")
#define PG8_WAIT_L(n) asm volatile("s_waitcnt lgkmcnt(" #n ")" ::: "memory")
#define PG8_BAR __builtin_amdgcn_s_barrier()
#define PG8_SCHED __builtin_amdgcn_sched_barrier(0)
    Unit cur, nxt; int ui = 0;
    if (!S.next(0, cur)) return;
    f32x4 acc[2][2][4][2];
#pragma unroll
    for (int a = 0; a < 2; ++a)
#pragma unroll
        for (int b = 0; b < 2; ++b)
#pragma unroll
            for (int m = 0; m < 4; ++m)
#pragma unroll
                for (int n = 0; n < 2; ++n) acc[a][b][m][n] = (f32x4){0.f, 0.f, 0.f, 0.f};
    bf16x8 At[4][2], B0[2][2], B1[2][2];
    const char* cA = (const char*)g.A + (size_t)cur.pm * tstep; const char* cB = (const char*)g.Bt + (size_t)cur.pn * tstep;
    S.a_ready(cur);
    if constexpr (SP2) {
        PG8_STAGE(PG8_SB(0, 0), cB, voffB); PG8_STAGE(PG8_SB(0, 1), cB + hstep, voffB); PG8_STAGE(PG8_SA(0, 0), cA, voffA); PG8_STAGE(PG8_SA(0, 1), cA + hstep, voffA);
        if (wr == 1) PG8_BAR;
        PG8_WAIT_V(2); PG8_BAR;
        PG8_STAGE(PG8_SB(1, 0), cB + kstep, voffB); PG8_STAGE(PG8_SA(1, 0), cA + kstep, voffA); PG8_STAGE(PG8_SB(1, 1), cB + hstep + kstep, voffB);
        PG8_WAIT_V(6); PG8_BAR;
    } else {
        PG8_STAGE(PG8_SB(0, 0), cB, voffB); PG8_STAGE(PG8_SA(0, 0), cA, voffA); PG8_STAGE(PG8_SB(0, 1), cB + hstep, voffB); PG8_STAGE(PG8_SA(0, 1), cA + hstep, voffA);
        if (wr == 1) PG8_BAR;
        PG8_WAIT_V(4); PG8_BAR;
        PG8_STAGE(PG8_SB(1, 0), cB + kstep, voffB); PG8_STAGE(PG8_SA(1, 0), cA + kstep, voffA); PG8_STAGE(PG8_SB(1, 1), cB + hstep + kstep, voffB);
        PG8_WAIT_V(6); PG8_BAR;
    }
    for (;;) {
        const bool has_next = S.next(ui + 1, nxt);
        const char* nA = has_next ? (const char*)g.A + (size_t)nxt.pm * tstep : cA; const char* nB = has_next ? (const char*)g.Bt + (size_t)nxt.pn * tstep : cB;
        for (int t = 0; t < nt; t += 2) {
            const bool last = (t == nt - 2);
            const char* a1 = cA + (size_t)(t + 1) * kstep;
            const char* a2 = last ? nA : cA + (size_t)(t + 2) * kstep; const char* b2 = last ? nB : cB + (size_t)(t + 2) * kstep;
            const char* a3 = a2 + kstep; const char* b3 = b2 + kstep;
            if (last && has_next) S.a_ready(nxt);
            if constexpr (SP2) {
            PG8_LDB(B0, 0, 0); PG8_LDB(B1, 0, 1); PG8_SCHED; PG8_LDA(At, 0, 0); PG8_STAGE(PG8_SA(1, 1), a1 + hstep, voffA);
            PG8_WAIT_V(8); PG8_WAIT_L(0); PG8_BAR; PG8_MMA(0, 0, At, B0); PG8_MMA(0, 1, At, B1); PG8_BAR; PG8_SCHED;
            PG8_LDA(At, 0, 1); PG8_STAGE(PG8_SB(0, 0), b2, voffB); PG8_STAGE(PG8_SB(0, 1), b2 + hstep, voffB); PG8_STAGE(PG8_SA(0, 0), a2, voffA);
            PG8_WAIT_V(8); PG8_WAIT_L(0); PG8_BAR; PG8_MMA(1, 0, At, B0); PG8_MMA(1, 1, At, B1); PG8_BAR; PG8_SCHED;
            PG8_LDB(B0, 1, 0); PG8_LDB(B1, 1, 1); PG8_SCHED; PG8_LDA(At, 1, 0); PG8_STAGE(PG8_SA(0, 1), a2 + hstep, voffA);
            PG8_WAIT_V(8); PG8_WAIT_L(0); PG8_BAR; PG8_MMA(0, 0, At, B0); PG8_MMA(0, 1, At, B1); PG8_BAR; PG8_SCHED;
            PG8_LDA(At, 1, 1); PG8_STAGE(PG8_SB(1, 0), b3, voffB); PG8_STAGE(PG8_SB(1, 1), b3 + hstep, voffB); PG8_STAGE(PG8_SA(1, 0), a3, voffA);
            PG8_WAIT_V(8); PG8_WAIT_L(0); PG8_BAR; PG8_MMA(1, 0, At, B0); PG8_MMA(1, 1, At, B1); PG8_BAR; PG8_SCHED;
            } else {
            PG8_LDB(B0, 0, 0); PG8_SCHED; PG8_LDA(At, 0, 0); PG8_STAGE(PG8_SA(1, 1), a1 + hstep, voffA);
            PG8_WAIT_L(8); PG8_BAR; PG8_WAIT_L(0); PG8_MMA(0, 0, At, B0); PG8_BAR; PG8_SCHED;
            PG8_LDB(B1, 0, 1); PG8_STAGE(PG8_SB(0, 0), b2, voffB);
            PG8_BAR; PG8_WAIT_L(0); PG8_MMA(0, 1, At, B1); PG8_BAR;
            PG8_LDA(At, 0, 1); PG8_STAGE(PG8_SA(0, 0), a2, voffA);
            PG8_BAR; PG8_WAIT_L(0); PG8_MMA(1, 0, At, B0); PG8_BAR; PG8_SCHED;
            PG8_STAGE(PG8_SB(0, 1), b2 + hstep, voffB);
            PG8_WAIT_V(6); PG8_BAR; PG8_MMA(1, 1, At, B1); PG8_BAR;
            PG8_LDB(B0, 1, 0); PG8_SCHED; PG8_LDA(At, 1, 0); PG8_STAGE(PG8_SA(0, 1), a2 + hstep, voffA);
            PG8_WAIT_L(8); PG8_BAR; PG8_WAIT_L(0); PG8_MMA(0, 0, At, B0); PG8_BAR; PG8_SCHED;
            PG8_LDB(B1, 1, 1); PG8_STAGE(PG8_SB(1, 0), b3, voffB);
            PG8_BAR; PG8_WAIT_L(0); PG8_MMA(0, 1, At, B1); PG8_BAR;
            PG8_LDA(At, 1, 1); PG8_STAGE(PG8_SA(1, 0), a3, voffA);
            PG8_BAR; PG8_WAIT_L(0); PG8_MMA(1, 0, At, B0); PG8_BAR; PG8_SCHED;
            PG8_STAGE(PG8_SB(1, 1), b3 + hstep, voffB);
            PG8_WAIT_V(6); PG8_BAR; PG8_MMA(1, 1, At, B1); PG8_BAR;
            }
        }
        if constexpr (ALIGN_EPI) { if (wr == 0) PG8_BAR; }
        if constexpr (!Epi::AFTER_DRAIN) { E(acc, cur, wr, wc, fr, fq); S.done(cur); }
        if (!has_next) break;
#pragma unroll
        for (int a = 0; a < 2; ++a)
#pragma unroll
            for (int b = 0; b < 2; ++b)
#pragma unroll
                for (int m = 0; m < 4; ++m)
#pragma unroll
                    for (int n = 0; n < 2; ++n) acc[a][b][m][n] = (f32x4){0.f, 0.f, 0.f, 0.f};
        cur = nxt; cA = nA; cB = nB; ++ui;
        if constexpr (ALIGN_EPI) { if (wr == 1) PG8_BAR; }
    }
    PG8_WAIT_V(0);
    if constexpr (!ALIGN_EPI) { if (wr == 0) PG8_BAR; }
    PG8_BAR;
    if constexpr (Epi::AFTER_DRAIN) { E.fused(acc, cur, wr, wc, fr, fq, lds, wid, lane); S.done(cur); }
#undef PG8_SA
#undef PG8_SB
#undef PG8_STAGE
#undef PG8_LDA
#undef PG8_LDB
#undef PG8_MMA
#undef PG8_WAIT_V
#undef PG8_WAIT_L
#undef PG8_BAR
#undef PG8_SCHED
}
}

#ifndef PG8_SP2
#define PG8_SP2 true
#endif
#ifndef PG8_ALIGN
#define PG8_ALIGN true
#endif

__device__ __forceinline__ float row_rstd16(const float* rowss, int row) {
    const f32x4* r = (const f32x4*)(rowss + (size_t)row * 16);
    const f32x4 a = r[0], b = r[1], c = r[2], d = r[3];
    const float s = ((a[0] + a[1]) + (a[2] + a[3])) + ((b[0] + b[1]) + (b[2] + b[3])) + ((c[0] + c[1]) + (c[2] + c[3])) + ((d[0] + d[1]) + (d[2] + d[3]));
    return rsqrtf(s * (1.f / DM) + EPS);
}
struct EpiProjF {
    static constexpr bool PERM = true, AFTER_DRAIN = false;
    const float* rowss; const float* cb; bf16_t* proj; float* side; const float* g_a; const float* g_b; const float* g_ds; const float* g_dw; LDSF float* xs  ;
    __device__ __forceinline__ void operator()(const pg8::f32x4 (&acc)[2][2][4][2], const pg8::Unit& u, int wr, int wc, int fr, int fq) const {
        const int b = u.pm >> 4, colt = u.pn * 256 + wc * 32 + 8 * fq;
        const int knmode = (u.pn == 1) ? 1 : (u.pn == 4) ? 2 : (u.pn == 10) ? 3 : (u.pn == 11) ? 4 : 0;
        f32x4 cv[2][2];
#pragma unroll
        for (int bj = 0; bj < 2; ++bj)
#pragma unroll
            for (int n = 0; n < 2; ++n) cv[bj][n] = *(const f32x4*)(cb + b * PINP + colt + bj * 128 + 4 * n);
        if (knmode != 0) {
#pragma unroll
            for (int ai = 0; ai < 2; ++ai)
#pragma unroll
                for (int m = 0; m < 4; ++m) {
                    const float rsm = row_rstd16(rowss, u.pm * 256 + ai * 128 + wr * 64 + m * 16 + fr);
#pragma unroll
                    for (int bj = 0; bj < 2; ++bj) {
                        const f32x4 v0 = acc[ai][bj][m][0] * rsm + cv[bj][0], v1 = acc[ai][bj][m][1] * rsm + cv[bj][1];
                        float ss = (v0[0] * v0[0] + v0[1] * v0[1]) + (v0[2] * v0[2] + v0[3] * v0[3]) + (v1[0] * v1[0] + v1[1] * v1[1]) + (v1[2] * v1[2] + v1[3] * v1[3]);
                        ss += __shfl_xor(ss, 16); ss += __shfl_xor(ss, 32);
                        if (fq == 0) xs[((wr * 4 + wc) * 16 + (ai * 4 + m) * 2 + bj) * 16 + fr] = ss;
                    }
                }
            asm volatile("s_waitcnt lgkmcnt(0)" ::: "memory"); __builtin_amdgcn_s_barrier(); asm volatile("" ::: "memory");
        }
#pragma unroll
        for (int ai = 0; ai < 2; ++ai)
#pragma unroll
            for (int m = 0; m < 4; ++m) {
                const int row = u.pm * 256 + ai * 128 + wr * 64 + m * 16 + fr; const float rs = row_rstd16(rowss, row);
#pragma unroll
                for (int bj = 0; bj < 2; ++bj) {
                    f32x4 v0 = acc[ai][bj][m][0] * rs + cv[bj][0], v1 = acc[ai][bj][m][1] * rs + cv[bj][1]; const int col0 = colt + bj * 128;
                    if (col0 >= C_BF && col0 < PIN) { *(f32x4*)(side + (size_t)row * 16 + (col0 - C_BF)) = v0; *(f32x4*)(side + (size_t)row * 16 + (col0 - C_BF) + 4) = v1; }
                    const bool on = (knmode == 1) || (knmode == 2) || (knmode == 3 && bj == 1 && wc < 2) || (knmode == 4 && bj == 0 && wc < 2);
                    if (on) {
                        const int xi = (ai * 4 + m) * 2 + bj;
                        float tot = xs[((wr * 4 + wc) * 16 + xi) * 16 + fr]; float dn = 1.f / 32.f;
                        if (knmode != 1) { tot += xs[((wr * 4 + (wc ^ 1)) * 16 + xi) * 16 + fr]; dn = 1.f / 64.f; }
                        const float nrm = rsqrtf(tot * dn + EPS);
                        const float* gp = (knmode == 1) ? g_a + 8 * fq : ((knmode == 2) ? g_b : (knmode == 3 ? g_ds : g_dw)) + (wc & 1) * 32 + 8 * fq;
                        v0 = v0 * nrm * *(const f32x4*)gp; v1 = v1 * nrm * *(const f32x4*)(gp + 4);
                    }
                    u32x4 w; w[0] = pg8::cvt_pk_bf16(v0[0], v0[1]); w[1] = pg8::cvt_pk_bf16(v0[2], v0[3]); w[2] = pg8::cvt_pk_bf16(v1[0], v1[1]); w[3] = pg8::cvt_pk_bf16(v1[2], v1[3]);
                    *(u32x4*)(proj + (size_t)row * PINP + col0) = w;
                }
            }
    }
};
struct EpiResF {
    static constexpr bool PERM = false, AFTER_DRAIN = false;
    const float* xin; float* xout; const float* gate; const float* g; const float* sc; bf16_t* xa; float* rowss;
    __device__ __forceinline__ void operator()(const pg8::f32x4 (&acc)[2][2][4][2], const pg8::Unit& u, int wr, int wc, int fr, int fq) const {
        const int b = u.pm >> 4, col0 = u.pn * 256 + wc * 32 + 4 * fq;
        f32x4 gt[2][2], gm[2][2];
#pragma unroll
        for (int bj = 0; bj < 2; ++bj)
#pragma unroll
            for (int n = 0; n < 2; ++n) { const int c = col0 + bj * 128 + n * 16; gt[bj][n] = *(const f32x4*)(gate + b * 6144 + c);
                if (xa) gm[bj][n] = *(const f32x4*)(g + c) * (*(const f32x4*)(sc + b * 6144 + c) + 1.0f); else gm[bj][n] = (f32x4){0.f, 0.f, 0.f, 0.f}; }
#pragma unroll
        for (int ai = 0; ai < 2; ++ai)
#pragma unroll
            for (int m = 0; m < 4; ++m) {
                const int row = u.pm * 256 + ai * 128 + wr * 64 + m * 16 + fr; float ss = 0.f;
#pragma unroll
                for (int bj = 0; bj < 2; ++bj)
#pragma unroll
                    for (int n = 0; n < 2; ++n) { const size_t off = (size_t)row * DM + col0 + bj * 128 + n * 16;
                        const f32x4 o = *(const f32x4*)(xin + off) + gt[bj][n] * acc[ai][bj][m][n];
                        *(f32x4*)(xout + off) = o; ss += (o[0] * o[0] + o[1] * o[1]) + (o[2] * o[2] + o[3] * o[3]);
                        if (xa) { const f32x4 q = o * gm[bj][n]; uint2 w; w.x = pg8::cvt_pk_bf16(q[0], q[1]); w.y = pg8::cvt_pk_bf16(q[2], q[3]); *(uint2*)(xa + off) = w; } }
                if (rowss) { ss += __shfl_xor(ss, 16); ss += __shfl_xor(ss, 32); if (fq == 0) rowss[(size_t)row * 16 + u.pn * 4 + wc] = ss; }
            }
    }
};


#define DPPF(oldv, src, CTRL) __builtin_bit_cast(float, __builtin_amdgcn_update_dpp(__builtin_bit_cast(int, (float)(oldv)), __builtin_bit_cast(int, (float)(src)), (CTRL), 0xf, 0xf, false))
struct EpiUpAct {
    static constexpr bool PERM = true, AFTER_DRAIN = false;
    const float* rowss; const float* cb; bf16_t* act; float* eg; float* ev; const float* cw; const float* cbias; LDSF float* xch; LDSF float* cst  ;
    __device__ __forceinline__ void operator()(const pg8::f32x4 (&acc)[2][2][4][2], const pg8::Unit& u, int wr, int wc, int fr, int fq) const {
        const int b = u.pm >> 4, cih = wc * 32 + 8 * fq, jcol = u.pn * 128 + cih;
        const float* cbg = cb + b * NUP + u.pn * 256 + cih; const float* cbv = cbg + 128;
        {
            const int tid = (wr * 4 + wc) * 64 + fq * 16 + fr, col = tid & 127, arr = tid >> 7;
            const float* src = (arr == 0) ? cb + b * NUP + u.pn * 256 + col : (arr == 1) ? cb + b * NUP + u.pn * 256 + 128 + col : cw + (arr - 2) * DFF + u.pn * 128 + col;
            cst[arr * 128 + col] = *src;
            if (tid < 256) { const int a2 = 4 + (tid >> 7); cst[a2 * 128 + col] = (a2 == 4) ? cw[2 * DFF + u.pn * 128 + col] : cbias[u.pn * 128 + col]; }
            else cst[768 + (tid - 256)] = row_rstd16(rowss, u.pm * 256 + (tid - 256));
            const f32x4 cg0 = *(const f32x4*)cbg, cg1 = *(const f32x4*)(cbg + 4);
#pragma unroll
            for (int ai = 0; ai < 2; ++ai) {
                const float r3 = row_rstd16(rowss, u.pm * 256 + ai * 128 + wr * 64 + 48 + fr);
                const f32x4 g0 = acc[ai][0][3][0] * r3 + cg0, g1 = acc[ai][0][3][1] * r3 + cg1;
                if (fr >= 14) { LDSF float* x = xch + ((((wr * 2 + ai) * 4 + wc) * 2 + (fr - 14)) * 32 + 8 * fq); *(LDSF f32x4*)x = g0; *(LDSF f32x4*)(x + 4) = g1;
                    if (wr == 1 && ai == 1) { float* e = eg + ((size_t)(u.pm * 4 + 2 + (fr - 14))) * DFF + jcol; *(f32x4*)e = g0; *(f32x4*)(e + 4) = g1; } }
            }
            if (wr == 0 && fr < 2) {
                const f32x4 cv0 = *(const f32x4*)cbv, cv1 = *(const f32x4*)(cbv + 4); const float r0 = row_rstd16(rowss, u.pm * 256 + fr);
                float* e = eg + ((size_t)(u.pm * 4 + fr)) * DFF + jcol; float* v = ev + ((size_t)(u.pm * 2 + fr)) * DFF + jcol;
                *(f32x4*)e = acc[0][0][0][0] * r0 + cg0; *(f32x4*)(e + 4) = acc[0][0][0][1] * r0 + cg1;
                *(f32x4*)v = acc[0][1][0][0] * r0 + cv0; *(f32x4*)(v + 4) = acc[0][1][0][1] * r0 + cv1;
            }
        }
        asm volatile("s_waitcnt vmcnt(0) lgkmcnt(0)" ::: "memory"); __builtin_amdgcn_s_barrier(); asm volatile("" ::: "memory");
#pragma unroll
        for (int ai = 0; ai < 2; ++ai) {
            f32x4 pvv[2];
            if (ai == 0 && wr == 0) { pvv[0] = (f32x4){0.f, 0.f, 0.f, 0.f}; pvv[1] = pvv[0]; }
            else { const int swr = (wr == 1) ? 0 : 1, sai = (wr == 1) ? ai : ai - 1;
                const LDSF float* x = xch + ((((swr * 2 + sai) * 4 + wc) * 2 + (fr & 1)) * 32 + 8 * fq); pvv[0] = *(const LDSF f32x4*)x; pvv[1] = *(const LDSF f32x4*)(x + 4); }
#pragma unroll
            for (int m = 0; m < 4; ++m) {
                asm volatile("" ::: "memory");
                const int row = u.pm * 256 + ai * 128 + wr * 64 + m * 16 + fr; const float rsm = cst[768 + ai * 128 + wr * 64 + m * 16 + fr];
                u32x4 w;
#pragma unroll
                for (int n = 0; n < 2; ++n) {
                    const LDSF float* cc = cst + cih + 4 * n;
                    const f32x4 cgn = *(const LDSF f32x4*)cc, cvn = *(const LDSF f32x4*)(cc + 128);
                    const f32x4 k0 = *(const LDSF f32x4*)(cc + 256), k1 = *(const LDSF f32x4*)(cc + 384), k2 = *(const LDSF f32x4*)(cc + 512), kb = *(const LDSF f32x4*)(cc + 640);
                    const f32x4 c = acc[ai][0][m][n] * rsm + cgn, v = acc[ai][1][m][n] * rsm + cvn; float o[4];
#pragma unroll
                    for (int i = 0; i < 4; ++i) {
                        const float gm1 = DPPF(DPPF(0.f, pvv[n][i], 0x121), c[i], 0x111);
                        const float gm2 = DPPF(DPPF(0.f, pvv[n][i], 0x122), c[i], 0x112);
                        const float cvv = k0[i] * gm2 + k1[i] * gm1 + k2[i] * c[i] + kb[i];
                        o[i] = cvv * __builtin_amdgcn_rcpf(1.f + __builtin_amdgcn_exp2f(-cvv * LOG2E)) * v[i];
                    }
                    w[2 * n] = pg8::cvt_pk_bf16(o[0], o[1]); w[2 * n + 1] = pg8::cvt_pk_bf16(o[2], o[3]);
                    pvv[n] = c;
                }
                *(u32x4*)(act + (size_t)row * DFF + jcol) = w;
            }
        }
    }
};
__device__ void act_fixup(const Params& p, int l, int pm) {
    if ((pm & 15) == 0) return;
    const float* eg = (const float*)(p.ws + WS_EG); const float* ev = (const float*)(p.ws + WS_EV); bf16_t* act = (bf16_t*)(p.ws + WS_ACT);
    const float* cw = p.conv_w + (size_t)l * 3 * DFF; const float* cbias = p.conv_b + (size_t)l * DFF;
    for (int idx = TID(); idx < 2 * DFF; idx += NTHR) {
        const int r = idx / DFF, j = idx - r * DFF;
        const float a = eg[((size_t)((pm - 1) * 4 + 2)) * DFF + j], bq = eg[((size_t)((pm - 1) * 4 + 3)) * DFF + j], c0 = eg[((size_t)(pm * 4 + 0)) * DFF + j], c1 = eg[((size_t)(pm * 4 + 1)) * DFF + j];
        const float gm2 = r ? bq : a, gm1 = r ? c0 : bq, gc = r ? c1 : c0;
        const float cvv = cw[j] * gm2 + cw[DFF + j] * gm1 + cw[2 * DFF + j] * gc + cbias[j];
        act[(size_t)(pm * 256 + r) * DFF + j] = f2bf(siluf(cvv) * ev[((size_t)(pm * 2 + r)) * DFF + j]);
    }
}

__device__ void ph_prep_cum_bh(const Params& p, int l, int bh, unsigned char* lds) {
    const float* side = (const float*)(p.ws + WS_SIDE);
    float* cum = (float*)(p.ws + WS_CUM);
    LDSF float* wt = (LDSF float*)(lds + 70000);
    const int tid = TID(), lane = tid & 63, wv = tid >> 6;
    {
        const int b = bh >> 2, h = bh & 3; const float bf = p.fox_bf[l * 4 + h];
        float v[8]; float tot = 0.f;
#pragma unroll
        for (int i = 0; i < 8; ++i) { v[i] = logsigf(side[(size_t)(b * SEQ + tid * 8 + i) * 16 + h] + bf); tot += v[i]; v[i] = tot; }
        float inc = tot;
#pragma unroll
        for (int o = 1; o < 64; o <<= 1) { const float u = __shfl_up(inc, o); if (lane >= o) inc += u; }
        __syncthreads();
        if (lane == 63) wt[wv] = inc;
        __syncthreads();
        float base = inc - tot;
        for (int w8 = 0; w8 < wv; ++w8) base += wt[w8];
#pragma unroll
        for (int i = 0; i < 8; ++i) cum[bh * SEQ + tid * 8 + i] = base + v[i];
    }
}
template <int N> __device__ __forceinline__ float dotn(const float* q, const bf16_t* k) {
    float s = 0.f;
#pragma unroll
    for (int c = 0; c < N / 8; ++c) { float t[8]; load8(k + 8 * c, t);
#pragma unroll
        for (int j = 0; j < 8; ++j) s += q[8 * c + j] * t[j]; }
    return s;
}
template <int N> __device__ __forceinline__ void axpyn(float* o, float w, const bf16_t* v) {
#pragma unroll
    for (int c = 0; c < N / 8; ++c) { float t[8]; load8(v + 8 * c, t);
#pragma unroll
        for (int j = 0; j < 8; ++j) o[8 * c + j] += w * t[j]; }
}
template <int N> __device__ __forceinline__ void loadq_norm(float* q, const bf16_t* src, const float* g, float scale, bool norm) {
    float ss = 0.f;
#pragma unroll
    for (int c = 0; c < N / 8; ++c) load8(src + 8 * c, q + 8 * c);
#pragma unroll
    for (int j = 0; j < N; ++j) ss += q[j] * q[j];
    const float r = norm ? rsqrtf(ss * (1.f / N) + EPS) : 1.f;
#pragma unroll
    for (int j = 0; j < N; ++j) q[j] = q[j] * r * (norm ? g[j] : 1.f) * scale;
}
__device__ __forceinline__ void store64(bf16_t* dst, const float* o) {
#pragma unroll
    for (int c = 0; c < 8; ++c) { u32x4 w; w[0] = pk2(o[8 * c], o[8 * c + 1]); w[1] = pk2(o[8 * c + 2], o[8 * c + 3]); w[2] = pk2(o[8 * c + 4], o[8 * c + 5]); w[3] = pk2(o[8 * c + 6], o[8 * c + 7]); *(u32x4*)(dst + 8 * c) = w; }
}

typedef float f32x16 __attribute__((ext_vector_type(16)));
typedef short s16x4 __attribute__((ext_vector_type(4)));
#define LDSP __attribute__((address_space(3)))
constexpr int KSTR = 144;
constexpr int AL_KV = 17408;
constexpr int AL_BK = 2 * AL_KV  , AL_TB = AL_BK + 512  , AL_WSF = AL_TB + 512  , AL_MISC = AL_WSF + 2048  ,
              AL_IMP = 38912  , AL_SELM = AL_IMP + 65536  ,
              AL_TB4 = AL_SELM + 512  , AL_INVL = AL_TB4 + 2048  , AL_D_END = AL_INVL + 1024;
static_assert(AL_MISC + 64 <= AL_IMP && AL_D_END <= 131072, "attention LDS map");
__device__ __forceinline__ int crow(int r, int hi) { return (r & 3) + 8 * (r >> 2) + 4 * hi; }
__device__ __forceinline__ float ex2(float v) { return __builtin_amdgcn_exp2f(v); }
__device__ __forceinline__ s16x4 vtr(const LDSP unsigned char* p) { typedef short v4i16_t __attribute__((ext_vector_type(4))); return __builtin_bit_cast(s16x4, __builtin_amdgcn_ds_read_tr16_b64_v4i16((LDSP v4i16_t*)p)); }
__device__ __forceinline__ bf16x8 pack8(const f32x16& p, int b) {
    u32x4 w; w[0] = pg8::cvt_pk_bf16(p[b], p[b + 1]); w[1] = pg8::cvt_pk_bf16(p[b + 2], p[b + 3]); w[2] = pg8::cvt_pk_bf16(p[b + 4], p[b + 5]); w[3] = pg8::cvt_pk_bf16(p[b + 6], p[b + 7]);
    return __builtin_bit_cast(bf16x8, w);
}
__device__ __forceinline__ f32x16 splat16(float v) { return (f32x16){v, v, v, v, v, v, v, v, v, v, v, v, v, v, v, v}; }
template <int NK16>
__device__ __forceinline__ void qkt(f32x16& p0, f32x16& p1, const LDSP unsigned char* Kt, const bf16x8* qf, int dbase, int r32, int hi) {
    const LDSP unsigned char* kb = Kt + r32 * KSTR + hi * 16 + dbase * 32;
#pragma unroll
    for (int d0 = 0; d0 < NK16; ++d0) {
        const bf16x8 a0 = *(const LDSP bf16x8*)(kb + d0 * 32), a1 = *(const LDSP bf16x8*)(kb + 32 * KSTR + d0 * 32);
        p0 = __builtin_amdgcn_mfma_f32_32x32x16_bf16(a0, qf[d0], p0, 0, 0, 0);
        p1 = __builtin_amdgcn_mfma_f32_32x32x16_bf16(a1, qf[d0], p1, 0, 0, 0);
    }
}
__device__ __forceinline__ void pv(f32x16* o, const LDSP unsigned char* Vt, int vb, const f32x16& p0, const f32x16& p1) {
    bf16x8 pa[4]; pa[0] = pack8(p0, 0); pa[1] = pack8(p0, 8); pa[2] = pack8(p1, 0); pa[3] = pack8(p1, 8);
#pragma unroll
    for (int d0 = 0; d0 < 2; ++d0)
#pragma unroll
        for (int ks = 0; ks < 4; ++ks) {
            const s16x4 lo = vtr(Vt + vb + d0 * 4096 + ks * 1024), hh = vtr(Vt + vb + d0 * 4096 + ks * 1024 + 512);
            const bf16x8 vf = (bf16x8){lo[0], lo[1], lo[2], lo[3], hh[0], hh[1], hh[2], hh[3]};
            o[d0] = __builtin_amdgcn_mfma_f32_32x32x16_bf16(pa[ks], vf, o[d0], 0, 0, 0);
        }
}
__device__ __forceinline__ float exp_sum(f32x16& p0, f32x16& p1) {
    float s0 = 0.f, s1 = 0.f;
#pragma unroll
    for (int r = 0; r < 16; ++r) { p0[r] = ex2(p0[r]); p1[r] = ex2(p1[r]); s0 += p0[r]; s1 += p1[r]; }
    return s0 + s1;
}
__device__ __forceinline__ void scale_rows(f32x16* o, float f, LDSP float* wsf, int r32, int hi) {
    __builtin_amdgcn_wave_barrier();
    if (hi == 0) wsf[r32] = f;
    __builtin_amdgcn_s_waitcnt(0xc07f);
    __builtin_amdgcn_wave_barrier();
#pragma unroll
    for (int g = 0; g < 4; ++g) { const f32x4 a = *(const LDSP f32x4*)(wsf + 8 * g + 4 * hi);
#pragma unroll
        for (int i = 0; i < 4; ++i) { o[0][4 * g + i] *= a[i]; o[1][4 * g + i] *= a[i]; } }
    __builtin_amdgcn_wave_barrier();
}
__device__ __forceinline__ void store_o(const f32x16* o, LDSP bf16_t* stg, bf16_t* dst, int lane, int r32, int hi) {
    __builtin_amdgcn_wave_barrier();
#pragma unroll
    for (int r = 0; r < 16; ++r) { const int orow = crow(r, hi); stg[orow * 64 + r32] = f2bf(o[0][r]); stg[orow * 64 + 32 + r32] = f2bf(o[1][r]); }
    __builtin_amdgcn_s_waitcnt(0xc07f);
    __builtin_amdgcn_wave_barrier();
#pragma unroll
    for (int i = 0; i < 4; ++i) { const int row = i * 8 + (lane >> 3), ch = lane & 7; const u32x4 v = *(const LDSP u32x4*)(stg + row * 64 + ch * 8); *(u32x4*)(dst + (size_t)row * DM + ch * 8) = v; }
    __builtin_amdgcn_s_waitcnt(0xc07f);
    __builtin_amdgcn_wave_barrier();
}
template <int NG>
__device__ __forceinline__ void load_q(bf16x8* qf, const bf16_t* qrow  , const float* g, float sc, bool norm, int hi) {
    float v[4][8];
#pragma unroll
    for (int d0 = 0; d0 < 4; ++d0) load8(qrow + 16 * d0 + 8 * hi, v[d0]);
    float r0 = 1.f, r1 = 1.f;
    if (norm) {
        float s0 = 0.f, s1 = 0.f;
#pragma unroll
        for (int j = 0; j < 8; ++j) { s0 += v[0][j] * v[0][j] + v[1][j] * v[1][j]; s1 += v[2][j] * v[2][j] + v[3][j] * v[3][j]; }
        s0 += __shfl_xor(s0, 32); s1 += __shfl_xor(s1, 32);
        if (NG == 64) { r0 = rsqrtf((s0 + s1) * (1.f / 64.f) + EPS); r1 = r0; } else { r0 = rsqrtf(s0 * (1.f / 32.f) + EPS); r1 = rsqrtf(s1 * (1.f / 32.f) + EPS); }
    }
#pragma unroll
    for (int d0 = 0; d0 < 4; ++d0) {
        const float rr = (d0 < 2 ? r0 : r1) * sc; float w[8];
#pragma unroll
        for (int j = 0; j < 8; ++j) { const int d = 16 * d0 + 8 * hi + j; w[j] = v[d0][j] * rr * (norm ? g[d % NG] : 1.f); }
        u32x4 u; u[0] = pg8::cvt_pk_bf16(w[0], w[1]); u[1] = pg8::cvt_pk_bf16(w[2], w[3]); u[2] = pg8::cvt_pk_bf16(w[4], w[5]); u[3] = pg8::cvt_pk_bf16(w[6], w[7]);
        qf[d0] = __builtin_bit_cast(bf16x8, u);
    }
}
__device__ __forceinline__ void kv_load(u32x4& kr, u32x4& vr, const bf16_t* Kb, const bf16_t* Vb, int k0, int tid) {
    const size_t off = (size_t)(k0 + (tid >> 3)) * PINP + (tid & 7) * 8;
    kr = *(const u32x4*)(Kb + off); vr = *(const u32x4*)(Vb + off);
}
__device__ __forceinline__ void kv_load64(u32x4& kr, u32x4& vr, const bf16_t* Kb, const bf16_t* Vb, int n0, int tid) {
    const size_t off = (size_t)(n0 + (tid >> 3)) * 64 + (tid & 7) * 8;
    kr = *(const u32x4*)(Kb + off); vr = *(const u32x4*)(Vb + off);
}
__device__ __forceinline__ void kv_store(const u32x4& kr, const u32x4& vr, LDSP unsigned char* buf, int tid) {
    const int key = tid >> 3, ch = tid & 7;
    *(LDSP u32x4*)(buf + key * KSTR + ch * 16) = kr;
    *(LDSP u32x4*)(buf + 9216 + (ch >> 2) * 4096 + (key >> 4) * 1024 + ((key >> 3) & 1) * 512 + (key & 7) * 64 + (ch & 3) * 16) = vr;
}
template <int NG>
__device__ __forceinline__ void knorm_chunk(u32x4& kr, const float* gp  ) {
    float v[8];
    v[0] = bf2f(kr[0] & 0xffff); v[1] = bf2f(kr[0] >> 16); v[2] = bf2f(kr[1] & 0xffff); v[3] = bf2f(kr[1] >> 16);
    v[4] = bf2f(kr[2] & 0xffff); v[5] = bf2f(kr[2] >> 16); v[6] = bf2f(kr[3] & 0xffff); v[7] = bf2f(kr[3] >> 16);
    float ss = 0.f;
#pragma unroll
    for (int j = 0; j < 8; ++j) ss += v[j] * v[j];
    ss += __shfl_xor(ss, 1); ss += __shfl_xor(ss, 2); if (NG == 64) ss += __shfl_xor(ss, 4);
    const float r = rsqrtf(ss * (1.f / NG) + EPS);
    const f32x4 ga = *(const f32x4*)gp, gb = *(const f32x4*)(gp + 4);
    kr[0] = pg8::cvt_pk_bf16(v[0] * r * ga[0], v[1] * r * ga[1]); kr[1] = pg8::cvt_pk_bf16(v[2] * r * ga[2], v[3] * r * ga[3]);
    kr[2] = pg8::cvt_pk_bf16(v[4] * r * gb[0], v[5] * r * gb[1]); kr[3] = pg8::cvt_pk_bf16(v[6] * r * gb[2], v[7] * r * gb[3]);
}
__device__ __forceinline__ void bias_near(f32x16& p0, f32x16& p1, const LDSP float* tbl, int tk0  , int wnd, bool rowok, int hi) {
#pragma unroll
    for (int g = 0; g < 4; ++g) {
#pragma unroll
        for (int i = 0; i < 4; ++i) { const int r = 4 * g + i; const int d0_ = tk0 - crow(r, hi), d1_ = d0_ - 32;
            const float b0 = tbl[min(max(d0_, 0), 127)], b1 = tbl[min(max(d1_, 0), 127)];
            p0[r] = (d0_ < 0 || d0_ >= wnd || !rowok) ? -INFINITY : p0[r] + b0; p1[r] = (d1_ < 0 || d1_ >= wnd || !rowok) ? -INFINITY : p1[r] + b1; }
        asm volatile("" ::: "memory");
    }
}
#define KVBUF(L, i) ((L) + ((i) & 1) * AL_KV)

__device__ void fa_fox_unit(const Params& p, int l, int b, int h, int qb, LDSP unsigned char* L) {
    const int tid = TID(), lane = tid & 63, wid = __builtin_amdgcn_readfirstlane(tid >> 6), r32 = lane & 31, hi = lane >> 5;
    const bf16_t* proj = (const bf16_t*)(p.ws + WS_PROJ); bf16_t* mix = (bf16_t*)(p.ws + WS_MIX);
    const size_t rb = (size_t)b * SEQ; const int q0 = qb * 256, qw = q0 + 32 * wid, t = qw + r32;
    const bf16_t* Kb = proj + rb * PINP + CB_K + 64 * h; const bf16_t* Vb = proj + rb * PINP + CB_V + 64 * h;
    const float* cm = (const float*)(p.ws + WS_CUM) + (b * 4 + h) * SEQ;
    LDSP float* wsf = (LDSP float*)(L + AL_WSF) + wid * 64; LDSP float* bk = (LDSP float*)(L + AL_BK);
    const int vb = 9216 + ((lane >> 4) & 1) * 32 + (lane & 3) * 8 + (4 * hi + ((lane & 15) >> 2)) * 64;
    bf16x8 qf[4]; load_q<64>(qf, proj + (rb + t) * PINP + CB_Q + 64 * h, p.fox_qn + l * 64, 0.125f * LOG2E, true, hi);
    const float rowc = cm[t] * LOG2E - ((const float*)(p.ws + WS_BND))[l * 32 + 4];
    f32x16 o[2]; o[0] = (f32x16){}; o[1] = (f32x16){};
    float l_run = 0.f;
    const int NT = 4 * qb + 4, jd = 4 * qb + (wid >> 1);
    u32x4 kr, vr; float cr = 0.f; const float* gk = p.fox_kn + l * 64 + (tid & 7) * 8;
    int js;
    {   const bool live = (lane < NT) ? ((cm[q0] - cm[64 * lane + 63]) * LOG2E >= -160.f) : false;
        const unsigned long long bm = __ballot(live);
        js = __builtin_amdgcn_readfirstlane((int)__builtin_ctzll(bm | (1ull << (NT - 1)))); if (js > NT - 2) js = NT - 2; }
    __syncthreads();
    kv_load(kr, vr, Kb, Vb, 64 * js, tid); if (tid < 64) cr = cm[64 * js + tid];
    kv_store(kr, vr, KVBUF(L, js), tid); if (tid < 64) bk[(js & 1) * 64 + tid] = -cr * LOG2E;
    kv_load(kr, vr, Kb, Vb, 64 * (js + 1), tid); if (tid < 64) cr = cm[64 * (js + 1) + tid];
    for (int j = js; j < NT; ++j) {
        __syncthreads();
        if (j + 1 < NT) { kv_store(kr, vr, KVBUF(L, j + 1), tid); if (tid < 64) bk[((j + 1) & 1) * 64 + tid] = -cr * LOG2E; }
        if (j + 2 < NT) { kv_load(kr, vr, Kb, Vb, 64 * (j + 2), tid); if (tid < 64) cr = cm[64 * (j + 2) + tid]; }
        if (j <= jd) {
            const LDSP unsigned char* buf = KVBUF(L, j); const LDSP float* bkj = bk + (j & 1) * 64;
            f32x16 p0, p1;
#pragma unroll
            for (int g = 0; g < 4; ++g) { const f32x4 b0 = *(const LDSP f32x4*)(bkj + 8 * g + 4 * hi), b1 = *(const LDSP f32x4*)(bkj + 32 + 8 * g + 4 * hi);
#pragma unroll
                for (int i = 0; i < 4; ++i) { p0[4 * g + i] = b0[i] + rowc; p1[4 * g + i] = b1[i] + rowc; } }
            qkt<4>(p0, p1, buf, qf, 0, r32, hi);
            if (j == jd) { const int k0 = 64 * j;
#pragma unroll
                for (int r = 0; r < 16; ++r) { const int kk = k0 + crow(r, hi); if (kk > t) p0[r] = -INFINITY; if (kk + 32 > t) p1[r] = -INFINITY; } }
            l_run += exp_sum(p0, p1);
            pv(o, buf, vb, p0, p1);
        }
    }
    l_run += __shfl_xor(l_run, 32);
    scale_rows(o, 1.f / l_run, wsf, r32, hi);
    store_o(o, (LDSP bf16_t*)(L + AL_IMP + wid * 8192), mix + (rb + qw) * DM + 256 + 64 * h, lane, r32, hi);
}

__device__ void fa_diff_unit(const Params& p, int l, int b, int h, int qb, LDSP unsigned char* L) {
    const int tid = TID(), lane = tid & 63, wid = __builtin_amdgcn_readfirstlane(tid >> 6), r32 = lane & 31, hi = lane >> 5;
    const bf16_t* proj = (const bf16_t*)(p.ws + WS_PROJ); bf16_t* mix = (bf16_t*)(p.ws + WS_MIX);
    const size_t rb = (size_t)b * SEQ; const int q0 = qb * 256, qw = q0 + 32 * wid, t = qw + r32;
    const bf16_t* Kb = proj + rb * PINP + CA_K + 64 * h; const bf16_t* Vb = proj + rb * PINP + CA_V + 64 * h;
    LDSP float* wsf = (LDSP float*)(L + AL_WSF) + wid * 64; LDSP float* tbl = (LDSP float*)(L + AL_TB);
    const int vb = 9216 + ((lane >> 4) & 1) * 32 + (lane & 3) * 8 + (4 * hi + ((lane & 15) >> 2)) * 64;
    const float lam = ((const float*)(p.ws + WS_LAM))[l]; const float lam_init = 0.8f - 0.6f * __expf(-0.3f * (float)l);
    const float nbound = -((const float*)(p.ws + WS_BND))[l * 32 + h];
    __syncthreads();
    if (tid < 128) tbl[tid] = ((const float*)(p.ws + WS_TB))[h * 128 + tid] * LOG2E;
    bf16x8 qf[4]; load_q<32>(qf, proj + (rb + t) * PINP + CA_Q + 64 * h, p.diff_qn + l * 32, 0.17677669529663687f * LOG2E, true, hi);
    f32x16 o1[2], o2[2]; o1[0] = (f32x16){}; o1[1] = (f32x16){}; o2[0] = (f32x16){}; o2[1] = (f32x16){};
    float l1 = 0.f, l2 = 0.f;
    const int NT = 4 * qb + 4, jd = 4 * qb + (wid >> 1);
    u32x4 kr, vr; const float* gk = p.diff_kn + l * 32 + (tid & 3) * 8;
    kv_load(kr, vr, Kb, Vb, 0, tid);
    kv_store(kr, vr, KVBUF(L, 0), tid);
    kv_load(kr, vr, Kb, Vb, 64, tid);
    for (int j = 0; j < NT; ++j) {
        __syncthreads();
        if (j + 1 < NT) { kv_store(kr, vr, KVBUF(L, j + 1), tid); }
        if (j + 2 < NT) kv_load(kr, vr, Kb, Vb, 64 * (j + 2), tid);
        if (j <= jd) {
            const LDSP unsigned char* buf = KVBUF(L, j);
            const int k0 = 64 * j; const bool nearb = (qw - (k0 + 63)) < 113; const float cfar = tbl[127] + nbound;
#pragma unroll
            for (int mp = 0; mp < 2; ++mp) {
                f32x16 p0 = splat16(nearb ? nbound : cfar), p1 = p0;
                qkt<2>(p0, p1, buf, qf + 2 * mp, 2 * mp, r32, hi);
                if (nearb) bias_near(p0, p1, tbl, t - k0, 1 << 30, true, hi);
                if (mp == 0) { l1 += exp_sum(p0, p1); pv(o1, buf, vb, p0, p1); }
                else { l2 += exp_sum(p0, p1); pv(o2, buf, vb, p0, p1); }
            }
        }
    }
    l1 += __shfl_xor(l1, 32); l2 += __shfl_xor(l2, 32);
    scale_rows(o1, 1.f / l1, wsf, r32, hi); scale_rows(o2, lam / l2, wsf, r32, hi);
    o1[0] -= o2[0]; o1[1] -= o2[1];
    const float g0 = p.diff_sub[l * 64 + r32] * (1.f - lam_init), g1 = p.diff_sub[l * 64 + 32 + r32] * (1.f - lam_init);
#pragma unroll
    for (int r = 0; r < 16; ++r) {
        float ss = o1[0][r] * o1[0][r] + o1[1][r] * o1[1][r];
        ss += __shfl_xor(ss, 1); ss += __shfl_xor(ss, 2); ss += __shfl_xor(ss, 4); ss += __shfl_xor(ss, 8); ss += __shfl_xor(ss, 16);
        const float rs = rsqrtf(ss * (1.f / 64.f) + EPS); o1[0][r] *= rs * g0; o1[1][r] *= rs * g1;
    }
    store_o(o1, (LDSP bf16_t*)(L + AL_IMP + wid * 8192), mix + (rb + qw) * DM + 0 + 64 * h, lane, r32, hi);
}

template <bool DIAG>
__device__ __forceinline__ void stick_sub(f32x16& y, float& carry, int kbase  , int t, int hi) {
    float lk[16];
#pragma unroll
    for (int r = 0; r < 16; ++r) {
        const float v = y[r]; const float e = ex2(-fabsf(v)); const float lb = fminf(v, 0.f) - __builtin_amdgcn_logf(1.f + e);
        if (DIAG) { const bool valid = (kbase + crow(r, hi) < t); lk[r] = valid ? (lb - v) : 0.f; y[r] = valid ? lb : -INFINITY; }
        else { lk[r] = lb - v; y[r] = lb; }
    }
    float T[4], Go[4];
#pragma unroll
    for (int g = 0; g < 4; ++g) { const float Gs = (lk[4 * g] + lk[4 * g + 1]) + (lk[4 * g + 2] + lk[4 * g + 3]); Go[g] = __shfl_xor(Gs, 32); T[g] = Gs + Go[g]; }
    float sx = 0.f;
#pragma unroll
    for (int g = 3; g >= 0; --g) {
        float tail = carry + sx + (hi == 0 ? Go[g] : 0.f);
#pragma unroll
        for (int i = 3; i >= 0; --i) { y[4 * g + i] = ex2(y[4 * g + i] + tail); tail += lk[4 * g + i]; }
        sx += T[g];
    }
    carry += sx;
}
__device__ void fa_stick_unit(const Params& p, int l, int b, int h, int qb, LDSP unsigned char* L) {
    const int tid = TID(), lane = tid & 63, wid = __builtin_amdgcn_readfirstlane(tid >> 6), r32 = lane & 31, hi = lane >> 5;
    const bf16_t* proj = (const bf16_t*)(p.ws + WS_PROJ); bf16_t* mix = (bf16_t*)(p.ws + WS_MIX);
    const size_t rb = (size_t)b * SEQ; const int q0 = qb * 256, qw = q0 + 32 * wid, t = qw + r32;
    const bf16_t* Kb = proj + rb * PINP + CC_K + 64 * h; const bf16_t* Vb = proj + rb * PINP + CC_V + 64 * h;
    const int vb = 9216 + ((lane >> 4) & 1) * 32 + (lane & 3) * 8 + (4 * hi + ((lane & 15) >> 2)) * 64;
    bf16x8 qf[4]; load_q<64>(qf, proj + (rb + t) * PINP + CC_Q + 64 * h, nullptr, 0.125f * LOG2E, false, hi);
    f32x16 o[2]; o[0] = (f32x16){}; o[1] = (f32x16){};
    float carry = 0.f;
    const int NT = 4 * qb + 4, jd = 4 * qb + (wid >> 1);
    u32x4 kr, vr;
#define SBUF(i) (((i) & 1) ? (L + 108544) : L)
    LDSP unsigned* dn = (LDSP unsigned*)(L + AL_MISC) + 8;
    bool wdone = false;
    __syncthreads();
    if (lane == 0) dn[wid] = 0u;
    kv_load(kr, vr, Kb, Vb, 64 * (NT - 1), tid);
    kv_store(kr, vr, SBUF(NT - 1), tid);
    kv_load(kr, vr, Kb, Vb, 64 * (NT - 2), tid);
    for (int j = NT - 1; j >= 0; --j) {
        __syncthreads();
        if (__all(dn[lane & 7] != 0u)) break;
        if (j >= 1) kv_store(kr, vr, SBUF(j - 1), tid);
        if (j >= 2) kv_load(kr, vr, Kb, Vb, 64 * (j - 2), tid);
        if (j <= jd && !wdone) {
            const LDSP unsigned char* buf = SBUF(j);
            f32x16 p0 = (f32x16){}, p1 = (f32x16){};
            qkt<4>(p0, p1, buf, qf, 0, r32, hi);
            const int k0 = 64 * j; const bool diag = (j == jd);
            if (diag) { stick_sub<true>(p1, carry, k0 + 32, t, hi); stick_sub<true>(p0, carry, k0, t, hi); }
            else { stick_sub<false>(p1, carry, k0 + 32, t, hi); stick_sub<false>(p0, carry, k0, t, hi); }
            pv(o, buf, vb, p0, p1);
            if (__all(carry < -160.f)) { wdone = true; if (lane == 0) dn[wid] = 1u; }
        }
    }
    store_o(o, (LDSP bf16_t*)(L + AL_IMP + wid * 8192), mix + (rb + qw) * DM + 512 + 64 * h, lane, r32, hi);
}

__device__ void fa_nsa_unit(const Params& p, int l, int b, int u, LDSP unsigned char* L) {
    const int tid = TID(), lane = tid & 63, wid = __builtin_amdgcn_readfirstlane(tid >> 6), r32 = lane & 31, hi = lane >> 5;
    const int hh = wid >> 1, sub = wid & 1;
    const bf16_t* proj = (const bf16_t*)(p.ws + WS_PROJ); bf16_t* mix = (bf16_t*)(p.ws + WS_MIX);
    const size_t rb = (size_t)b * SEQ; const int q0 = 64 * u, qw = q0 + 32 * sub, t = qw + r32; const int ql = 32 * sub + r32;
    LDSP float* wsf = (LDSP float*)(L + AL_WSF) + wid * 64; LDSP float* tbl = (LDSP float*)(L + AL_TB4) + hh * 128;
    LDSP float* imp = (LDSP float*)(L + AL_IMP); LDSP unsigned* selm = (LDSP unsigned*)(L + AL_SELM); LDSP float* invl = (LDSP float*)(L + AL_INVL);
    LDSP float* ofl = (LDSP float*)(L + AL_IMP) + wid * 2048 + lane;
    const int vb = 9216 + ((lane >> 4) & 1) * 32 + (lane & 3) * 8 + (4 * hi + ((lane & 15) >> 2)) * 64;
    const float* bnd = (const float*)(p.ws + WS_BND) + l * 32;
    __syncthreads();
    ((LDSP float*)(L + AL_TB4))[tid] = ((const float*)(p.ws + WS_TB))[512 + tid] * LOG2E;
    bf16x8 qf[4]; load_q<64>(qf, proj + (rb + t) * PINP + CD_Q + 64 * hh, p.nsa_qn + l * 64, 0.125f * LOG2E, true, hi);
    const float* sd = (const float*)(p.ws + WS_SIDE) + (rb + t) * 16 + 4 + hh;
    const float gc = 1.f / (1.f + __expf(-sd[0])), gs = 1.f / (1.f + __expf(-sd[4])), gwn = 1.f / (1.f + __expf(-sd[8]));
    f32x16 o[2]; o[0] = (f32x16){}; o[1] = (f32x16){};
    u32x4 kr, vr;
    {
        const bf16_t* Kc = (const bf16_t*)(p.ws + WS_KC) + (size_t)b * 256 * 64; const bf16_t* Vc = (const bf16_t*)(p.ws + WS_VC) + (size_t)b * 256 * 64;
        const int ntc = (4 * u + 2) / 64 + 1; const float nbound = -bnd[5 + hh];
        float l_run = 0.f, prevE3 = 0.f;
        kv_load64(kr, vr, Kc, Vc, 0, tid);
        kv_store(kr, vr, KVBUF(L, 0), tid);
        if (ntc > 1) kv_load64(kr, vr, Kc, Vc, 64, tid);
        for (int T = 0; T < ntc; ++T) {
            __syncthreads();
            if (T + 1 < ntc) kv_store(kr, vr, KVBUF(L, T + 1), tid);
            if (T + 2 < ntc) kv_load64(kr, vr, Kc, Vc, 64 * (T + 2), tid);
            const LDSP unsigned char* buf = KVBUF(L, T);
            f32x16 p0 = splat16(nbound), p1 = p0;
            qkt<4>(p0, p1, buf, qf, 0, r32, hi);
#pragma unroll
            for (int g = 0; g < 4; ++g) {
#pragma unroll
                for (int i = 0; i < 4; ++i) { const int r = 4 * g + i; const int d0_ = t - 16 * (64 * T + crow(r, hi)) - 31, d1_ = d0_ - 512;
                    const float b0 = tbl[min(max(d0_, 0), 127)], b1 = tbl[min(max(d1_, 0), 127)];
                    p0[r] = (d0_ < 0) ? -INFINITY : p0[r] + b0; p1[r] = (d1_ < 0) ? -INFINITY : p1[r] + b1; }
                asm volatile("" ::: "memory");
            }
            l_run += exp_sum(p0, p1);
#pragma unroll
            for (int s2 = 0; s2 < 2; ++s2) {
                float G[4], Eo[4];
#pragma unroll
                for (int g = 0; g < 4; ++g) { const float a0 = s2 ? p1[4 * g] : p0[4 * g], a1 = s2 ? p1[4 * g + 1] : p0[4 * g + 1], a2 = s2 ? p1[4 * g + 2] : p0[4 * g + 2], a3 = s2 ? p1[4 * g + 3] : p0[4 * g + 3];
                    G[g] = (a0 + a1) + (a2 + a3); Eo[g] = __shfl_xor(a3, 32); }
#pragma unroll
                for (int g = 0; g < 4; ++g) { const float eprev = hi ? Eo[g] : (g > 0 ? Eo[g - 1] : prevE3);
                    imp[(hh * 64 + ql) * 64 + 16 * T + 8 * s2 + 2 * g + hi] = G[g] + eprev; }
                prevE3 = Eo[3];
            }
            pv(o, buf, vb, p0, p1);
        }
        l_run += __shfl_xor(l_run, 32);
        const float inv = (l_run > 0.f) ? 1.f / l_run : 0.f;
        if (hi == 0) invl[hh * 64 + ql] = inv;
        scale_rows(o, gc * inv, wsf, r32, hi);
    }
    __syncthreads();
    {
        const int q = tid >> 3, part = tid & 7;
        const float i0 = invl[q], i1 = invl[64 + q], i2 = invl[128 + q], i3 = invl[192 + q];
        float vj[8];
#pragma unroll
        for (int jj = 0; jj < 8; ++jj) { const int j = part * 8 + jj;
            const float sum = ((imp[(0 * 64 + q) * 64 + j] * i0 + imp[(1 * 64 + q) * 64 + j] * i1) + imp[(2 * 64 + q) * 64 + j] * i2) + imp[(3 * 64 + q) * 64 + j] * i3;
            vj[jj] = (j > u) ? -1.0f : ((j == u || j == 0) ? 1.0e4f : sum); }
        __syncthreads();
#pragma unroll
        for (int jj = 0; jj < 8; ++jj) imp[q * 64 + part * 8 + jj] = vj[jj];
        __syncthreads();
        int rank[8];
#pragma unroll
        for (int jj = 0; jj < 8; ++jj) rank[jj] = 0;
        for (int i = 0; i < 64; ++i) { const float vi = imp[q * 64 + i];
#pragma unroll
            for (int jj = 0; jj < 8; ++jj) rank[jj] += (vi > vj[jj] || (vi == vj[jj] && i < part * 8 + jj)) ? 1 : 0; }
        unsigned bits = 0;
#pragma unroll
        for (int jj = 0; jj < 8; ++jj) if (rank[jj] < 16 && (part * 8 + jj) <= u) bits |= 1u << jj;
        unsigned mlo = (part < 4) ? (bits << (8 * part)) : 0u, mhi = (part >= 4) ? (bits << (8 * (part - 4))) : 0u;
        mlo |= __shfl_xor(mlo, 1); mhi |= __shfl_xor(mhi, 1); mlo |= __shfl_xor(mlo, 2); mhi |= __shfl_xor(mhi, 2); mlo |= __shfl_xor(mlo, 4); mhi |= __shfl_xor(mhi, 4);
        if (part == 0) { selm[2 * q] = mlo; selm[2 * q + 1] = mhi; }
    }
    __syncthreads();
#pragma unroll
    for (int r = 0; r < 16; ++r) { ofl[(2 * r) * 64] = o[0][r]; ofl[(2 * r + 1) * 64] = o[1][r]; }
    o[0] = (f32x16){}; o[1] = (f32x16){};
    {
        const unsigned long long mymask = (unsigned long long)selm[2 * ql] | ((unsigned long long)selm[2 * ql + 1] << 32);
        unsigned ulo = selm[2 * lane], uhi = selm[2 * lane + 1];
#pragma unroll
        for (int s2 = 1; s2 < 64; s2 <<= 1) { ulo |= __shfl_xor(ulo, s2); uhi |= __shfl_xor(uhi, s2); }
        unsigned long long um = (unsigned long long)(unsigned)__builtin_amdgcn_readfirstlane((int)ulo) | ((unsigned long long)(unsigned)__builtin_amdgcn_readfirstlane((int)uhi) << 32);
        const bf16_t* Kb = proj + rb * PINP + CD_KS; const bf16_t* Vb = proj + rb * PINP + CD_VS;
        float l_run = 0.f; const float nbound = -bnd[9 + hh]; const float cfar = tbl[127] + nbound; const float* gk = p.nsa_kn + (l * 3 + 1) * 64 + (tid & 7) * 8;
        int j = __builtin_ctzll(um); um &= um - 1;
        int jn = um ? __builtin_ctzll(um) : -1; um &= um - 1;
        kv_load(kr, vr, Kb, Vb, 64 * j, tid);
        kv_store(kr, vr, KVBUF(L, 0), tid);
        if (jn >= 0) kv_load(kr, vr, Kb, Vb, 64 * jn, tid);
        for (int it = 0;; ++it) {
            __syncthreads();
            const int jnn = um ? __builtin_ctzll(um) : -1; um &= um - 1;
            if (jn >= 0) { kv_store(kr, vr, KVBUF(L, it + 1), tid); }
            if (jnn >= 0) kv_load(kr, vr, Kb, Vb, 64 * jnn, tid);
            const bool mine = (mymask >> j) & 1ull;
            if (__any(mine)) {
                const LDSP unsigned char* buf = KVBUF(L, it);
                const int k0 = 64 * j; const bool nearb = (qw - (k0 + 63)) < 113;
                f32x16 p0 = splat16(nearb ? nbound : (mine ? cfar : -INFINITY)), p1 = p0;
                qkt<4>(p0, p1, buf, qf, 0, r32, hi);
                if (nearb) bias_near(p0, p1, tbl, t - k0, 1 << 30, mine, hi);
                l_run += exp_sum(p0, p1);
                pv(o, buf, vb, p0, p1);
            }
            if (jn < 0) break;
            j = jn; jn = jnn;
        }
        l_run += __shfl_xor(l_run, 32);
        scale_rows(o, gs / l_run, wsf, r32, hi);
#pragma unroll
        for (int r = 0; r < 16; ++r) { ofl[(2 * r) * 64] += o[0][r]; ofl[(2 * r + 1) * 64] += o[1][r]; }
        o[0] = (f32x16){}; o[1] = (f32x16){};
    }
    {
        const bf16_t* Kb = proj + rb * PINP + CD_KW; const bf16_t* Vb = proj + rb * PINP + CD_VW;
        float l_run = 0.f; const float nbound = -bnd[13 + hh]; const float cfar = tbl[127] + nbound; const float* gk = p.nsa_kn + (l * 3 + 2) * 64 + (tid & 7) * 8;
        const int jlo = max(0, u - 8);
        __syncthreads();
        kv_load(kr, vr, Kb, Vb, 64 * jlo, tid);
        kv_store(kr, vr, KVBUF(L, jlo), tid);
        if (jlo < u) kv_load(kr, vr, Kb, Vb, 64 * (jlo + 1), tid);
        for (int j = jlo; j <= u; ++j) {
            __syncthreads();
            if (j + 1 <= u) { kv_store(kr, vr, KVBUF(L, j + 1), tid); }
            if (j + 2 <= u) kv_load(kr, vr, Kb, Vb, 64 * (j + 2), tid);
            const LDSP unsigned char* buf = KVBUF(L, j);
            const int k0 = 64 * j; const bool nearb = (j == u || j == u - 8 || (qw - (k0 + 63)) < 113);
            f32x16 p0 = splat16(nearb ? nbound : cfar), p1 = p0;
            qkt<4>(p0, p1, buf, qf, 0, r32, hi);
            if (nearb) bias_near(p0, p1, tbl, t - k0, 512, true, hi);
            l_run += exp_sum(p0, p1);
            pv(o, buf, vb, p0, p1);
        }
        l_run += __shfl_xor(l_run, 32);
        scale_rows(o, gwn / l_run, wsf, r32, hi);
#pragma unroll
        for (int r = 0; r < 16; ++r) { o[0][r] += ofl[(2 * r) * 64]; o[1][r] += ofl[(2 * r + 1) * 64]; }
    }
    store_o(o, (LDSP bf16_t*)(L + AL_IMP + wid * 8192), mix + (rb + qw) * DM + 768 + 64 * hh, lane, r32, hi);
}

__device__ void ph_reset_queues(const Params& p) { unsigned* ctl = (unsigned*)(p.ws + WS_CTL); const int gt = GTID(); if (gt < 8) ctl[gt] = 0u; }
__device__ void prep_cmp_task(const Params& p, int l, int task, LDSP unsigned char* L) {
    const int tid = TID(), lane = tid & 63, wid = __builtin_amdgcn_readfirstlane(tid >> 6), r32 = lane & 31, hi = lane >> 5;
    const int b = task >> 4, which = (task >> 3) & 1, nt = task & 7;
    const bf16_t* proj = (const bf16_t*)(p.ws + WS_PROJ);
    const bf16_t* phiT = (const bf16_t*)(p.ws + WS_PHIT) + (size_t)(l * 2 + which) * 64 * 2048;
    const float* pe = p.nsa_pe + (size_t)(l * 2 + which) * 32 * 64;
    const int n = 32 * nt + r32, colbase = which ? CD_VC : CD_KC;
    f32x16 acc0 = (f32x16){}, acc1 = (f32x16){};
#pragma unroll
    for (int ii = 0; ii < 4; ++ii) {
        const int i = 4 * wid + ii; const int tok = min(16 * n + i, SEQ - 1);
        const bf16_t* xr = proj + (size_t)(b * SEQ + tok) * PINP + colbase;
#pragma unroll
        for (int d0 = 0; d0 < 4; ++d0) {
            float xv[8]; load8(xr + 16 * d0 + 8 * hi, xv);
            const f32x4 pe0 = *(const f32x4*)(pe + i * 64 + 16 * d0 + 8 * hi), pe1 = *(const f32x4*)(pe + i * 64 + 16 * d0 + 8 * hi + 4);
            u32x4 aw; aw[0] = pg8::cvt_pk_bf16(xv[0] + pe0[0], xv[1] + pe0[1]); aw[1] = pg8::cvt_pk_bf16(xv[2] + pe0[2], xv[3] + pe0[3]);
            aw[2] = pg8::cvt_pk_bf16(xv[4] + pe1[0], xv[5] + pe1[1]); aw[3] = pg8::cvt_pk_bf16(xv[6] + pe1[2], xv[7] + pe1[3]);
            const bf16x8 af = __builtin_bit_cast(bf16x8, aw);
            const bf16x8 b0 = *(const bf16x8*)(phiT + (size_t)r32 * 2048 + i * 64 + 16 * d0 + 8 * hi);
            const bf16x8 b1 = *(const bf16x8*)(phiT + (size_t)(32 + r32) * 2048 + i * 64 + 16 * d0 + 8 * hi);
            acc0 = __builtin_amdgcn_mfma_f32_32x32x16_bf16(af, b0, acc0, 0, 0, 0);
            acc1 = __builtin_amdgcn_mfma_f32_32x32x16_bf16(af, b1, acc1, 0, 0, 0);
        }
    }
    LDSP float* red = (LDSP float*)L;
    __syncthreads();
#pragma unroll
    for (int r = 0; r < 16; ++r) { red[(wid * 32 + crow(r, hi)) * 64 + r32] = acc0[r]; red[(wid * 32 + crow(r, hi)) * 64 + 32 + r32] = acc1[r]; }
    __syncthreads();
    {
        const int row = tid >> 4, e4 = (tid & 15) * 4; f32x4 v = (f32x4){0.f, 0.f, 0.f, 0.f};
#pragma unroll
        for (int w8 = 0; w8 < 8; ++w8) v += *(const LDSP f32x4*)(red + (w8 * 32 + row) * 64 + e4);
        const int nn = 32 * nt + row;
        if (which == 0) {
            float ss = (v[0] * v[0] + v[1] * v[1]) + (v[2] * v[2] + v[3] * v[3]);
            ss += __shfl_xor(ss, 1); ss += __shfl_xor(ss, 2); ss += __shfl_xor(ss, 4); ss += __shfl_xor(ss, 8);
            const float rs = rsqrtf(ss * (1.f / 64.f) + EPS); const f32x4 g = *(const f32x4*)(p.nsa_kn + (l * 3 + 0) * 64 + e4);
            v = v * rs * g;
        }
        uint2 o; o.x = pk2(v[0], v[1]); o.y = pk2(v[2], v[3]);
        if (nn >= 255) { o.x = 0u; o.y = 0u; }
        *(uint2*)((bf16_t*)(p.ws + (which ? WS_VC : WS_KC)) + (size_t)(b * 256 + nn) * 64 + e4) = o;
    }
}
__device__ void ph_prep(const Params& p, int l, LDSP unsigned char* L, unsigned char* lds) {
    for (int t = blockIdx.x; t < 80; t += gridDim.x) { if (t < 64) prep_cmp_task(p, l, t, L); }
    if (gridDim.x >= 80) { if (blockIdx.x >= 64 && blockIdx.x < 80) ph_prep_cum_bh(p, l, blockIdx.x - 64, lds); }
    else for (int bh = blockIdx.x; bh < 16; bh += gridDim.x) ph_prep_cum_bh(p, l, bh, lds);
}


__device__ void fa_phase_all(const Params& p, int l, LDSP unsigned char* L, unsigned char* lds, int qslot) {
    unsigned* ctl = (unsigned*)(p.ws + WS_CTL);
    LDSP unsigned* misc = (LDSP unsigned*)(L + AL_MISC);
    bool prep_ok = false;
    for (;;) {
        __syncthreads();
        if (threadIdx.x == 0) misc[0] = atomicAdd(&ctl[qslot], 1u);
        __syncthreads();
        const unsigned qi0 = misc[0];
        if (qi0 >= 1104u) break;
        if (qi0 < 80u) {
            if (qi0 < 64u) prep_cmp_task(p, l, (int)qi0, L); else ph_prep_cum_bh(p, l, (int)qi0 - 64, lds);
            asm volatile("s_waitcnt vmcnt(0)" ::: "memory");
            __syncthreads();
            if (threadIdx.x == 0) { __threadfence(); atomicAdd(&ctl[4 + qslot], 1u); }
            continue;
        }
        const unsigned qi = qi0 - 80u;
        int r, typ, sub;
        if (qi < 768u) { r = 15 - (int)(qi / 48u); const int j = (int)(qi % 48u); typ = j >> 4; typ = (typ == 0) ? 0 : (typ == 1 ? 2 : 3); sub = j & 15; }
        else { const int v = (int)qi - 768; r = 15 - (v >> 4); typ = 1; sub = v & 15; }
        if ((typ == 2 || typ == 3) && !prep_ok) {
            if (threadIdx.x == 0) { while (__hip_atomic_load(&ctl[4 + qslot], __ATOMIC_RELAXED, __HIP_MEMORY_SCOPE_AGENT) < 80u) __builtin_amdgcn_s_sleep(8); __threadfence(); }
            asm volatile("s_waitcnt vmcnt(0)" ::: "memory");
            __syncthreads();
            prep_ok = true;
        }
        if (typ == 0) fa_diff_unit(p, l, sub >> 2, sub & 3, r, L);
        else if (typ == 1) fa_stick_unit(p, l, sub >> 2, sub & 3, r, L);
        else if (typ == 2) fa_fox_unit(p, l, sub >> 2, sub & 3, r, L);
        else fa_nsa_unit(p, l, sub >> 2, 4 * r + (sub & 3), L);
    }
}

#define XB_TMO      128
#define XB_XCNT(j)  (256  + 64 * (j))
#define XB_XSUB(j)  (1280 + 64 * (j))
#define XB_XGEN(j)  (2304 + 64 * (j))
#define XB_TOP      3328
#define XB_TOPGEN   3392
#define XCD_BAR_WORDS 3456
#define XB_SPIN_CAP (1u << 18)

__device__ __forceinline__ unsigned xb_ld(unsigned* p)              { return __hip_atomic_load(p, __ATOMIC_RELAXED, __HIP_MEMORY_SCOPE_AGENT); }
__device__ __forceinline__ unsigned xb_add(unsigned* p, unsigned v) { return __hip_atomic_fetch_add(p, v, __ATOMIC_RELAXED, __HIP_MEMORY_SCOPE_AGENT); }
__device__ __forceinline__ unsigned xb_xcc_id() { return (unsigned)__builtin_amdgcn_s_getreg((3 << 11) | 20) & 0xFu; }
#define XB_SPIN(cond, bar) do { unsigned _sp = 0; while (cond) { __builtin_amdgcn_s_sleep(1); \
    if ((++_sp & 255u) == 0u) { if (xb_ld(&(bar)[XB_TMO])) break; if (_sp > XB_SPIN_CAP) { atomicAdd(&(bar)[XB_TMO], 1u); break; } } } } while (0)

struct XcdBarrier {
    unsigned* bar; unsigned x;
    volatile LDSF unsigned* st;
};

__device__ __forceinline__ XcdBarrier xcd_barrier_post(unsigned* bar, volatile LDSF unsigned* st) {
    XcdBarrier b; b.bar = bar; b.x = xb_xcc_id(); b.st = st;
    if (threadIdx.x == 0) (void)xb_add(&bar[XB_XCNT(b.x)], 1u);
    return b;
}
__device__ __forceinline__ void xcd_barrier_complete(unsigned* bar, unsigned x, unsigned& nloc, unsigned& nx) {
    const unsigned G = gridDim.x * gridDim.y * gridDim.z;
    unsigned sum, cnt, mine, sp = 0u;
    for (;;) {
        sum = 0u; cnt = 0u; mine = 0u;
#pragma unroll
        for (unsigned j = 0; j < 16; ++j) { const unsigned c = xb_ld(&bar[XB_XCNT(j)]); sum += c; cnt += (c > 0u) ? 1u : 0u; mine = (j == x) ? c : mine; }
        if (sum == G) break;
        __builtin_amdgcn_s_sleep(1);
        if ((++sp & 255u) == 0u) { if (xb_ld(&bar[XB_TMO])) break; if (sp > XB_SPIN_CAP) { atomicAdd(&bar[XB_TMO], 1u); break; } }
    }
    nloc = mine > 0u ? mine : 1u; nx = cnt > 0u ? cnt : 1u;
}

__device__ __forceinline__ void xcd_barrier(const XcdBarrier& b) {
    asm volatile("s_waitcnt vmcnt(0)" ::: "memory");
    __syncthreads();
    if (threadIdx.x == 0) {
        unsigned* bar = b.bar;
        __builtin_amdgcn_s_waitcnt(0);
        unsigned nloc = b.st[0], nx = b.st[1];
        if (nloc == 0u) { xcd_barrier_complete(bar, b.x, nloc, nx); b.st[0] = nloc; b.st[1] = nx; }
        const unsigned old = xb_add(&bar[XB_XSUB(b.x)], 1u);
        const unsigned gen = old / nloc;
        if (old + 1u == (gen + 1u) * nloc) {
            __builtin_amdgcn_fence(__ATOMIC_RELEASE, "agent");
            asm volatile("s_waitcnt vmcnt(0)" ::: "memory");
            const unsigned og = xb_add(&bar[XB_TOP], 1u);
            const unsigned tg = og / nx;
            if (og + 1u == (tg + 1u) * nx) xb_add(&bar[XB_TOPGEN], 1u);
            else XB_SPIN(xb_ld(&bar[XB_TOPGEN]) == tg, bar);
            __builtin_amdgcn_fence(__ATOMIC_ACQUIRE, "agent");
            xb_add(&bar[XB_XGEN(b.x)], 1u);
            asm volatile("s_waitcnt vmcnt(0)" ::: "memory");
        } else {
            XB_SPIN(xb_ld(&bar[XB_XGEN(b.x)]) == gen, bar);
            __builtin_amdgcn_fence(__ATOMIC_ACQUIRE, "agent");
            asm volatile("s_waitcnt vmcnt(0)" ::: "memory");
        }
    }
    __syncthreads();
}

namespace cg = cooperative_groups;
constexpr int LDS_BYTES = 131072 + 8192 + 4096;
#define LAS3 __attribute__((address_space(3)))
#ifndef PROBE
#define PROBE 0
#endif
__global__ void __launch_bounds__(NTHR, 2) mega(Params p) {
    extern __shared__ __attribute__((aligned(16))) unsigned char lds[];
    cg::grid_group grid = cg::this_grid();
#if PROBE
    unsigned long long tacc = 0, tph = 0, t0_;
#define GSYNC() do { t0_ = __builtin_amdgcn_s_memrealtime(); xcd_barrier(xbar); tacc += __builtin_amdgcn_s_memrealtime() - t0_; } while (0)
#define TPK(k, ...) do { if (PROBE == (k)) { t0_ = __builtin_amdgcn_s_memrealtime(); __VA_ARGS__; tph += __builtin_amdgcn_s_memrealtime() - t0_; } else { __VA_ARGS__; } } while (0)
#else
#define GSYNC() xcd_barrier(xbar)
#define TPK(k, ...) do { __VA_ARGS__; } while (0)
#endif
    LAS3 unsigned char* lds3 = (LAS3 unsigned char*)lds;
    volatile LDSF unsigned* bst = (volatile LDSF unsigned*)(lds3 + 131072 + 2048);
    if (threadIdx.x < 2) bst[threadIdx.x] = 0u;
    __syncthreads();
    XcdBarrier xbar = xcd_barrier_post((unsigned*)(p.ws + WS_CTL) + 16384, bst);
    TPK(2, ph_mod(p, lds); ph_reset_queues(p); ph_weights(p, 0, lds); ph_weights(p, 1, lds));
    grid.sync();
    for (int l = 0; l < DEPTH; ++l) {
        const float* mod = (const float*)(p.ws + WS_MOD) + (size_t)l * 4 * 6144;
        if (l == 0) {
            TPK(2, ph_cbias(p, lds); ph_xa_from(p, p.x, 0, 0, (bf16_t*)(p.ws + WS_XA), (float*)(p.ws + WS_RSA), true));
            GSYNC();
        }
        {   pg8::Gemm g{(const bf16_t*)(p.ws + WS_XA), (const bf16_t*)(p.ws + WS_WIN + l * WS_W1OFF), MTOK, PINP, DM}; pg8::StaticOrder S; S.init(MTOK, PINP, (int)gridDim.x, (int)blockIdx.x);
            EpiProjF E{(const float*)(p.ws + WS_RSA), (const float*)(p.ws + WS_CBIN) + (size_t)l * 4 * PINP, (bf16_t*)(p.ws + WS_PROJ), (float*)(p.ws + WS_SIDE),
                       p.diff_kn + l * 32, p.fox_kn + l * 64, p.nsa_kn + (l * 3 + 1) * 64, p.nsa_kn + (l * 3 + 2) * 64, (LDSF float*)(lds3 + 131072 + 4096)};
            TPK(6, pg8::gemm_phase<EpiProjF, pg8::StaticOrder, true, PG8_SP2>(lds3, g, S, E)); }
        GSYNC();
        TPK(7, fa_phase_all(p, l, lds3, lds, l));
        GSYNC();
        {   pg8::Gemm g{(const bf16_t*)(p.ws + WS_MIX), (const bf16_t*)(p.ws + WS_WOUT + l * WS_W1OFF), MTOK, DM, DM}; pg8::StaticOrder S; S.init(MTOK, DM, (int)gridDim.x, (int)blockIdx.x);
            EpiResF E{l == 0 ? p.x : p.out, p.out, mod + 2048, p.norm_ffn_g + l * DM, mod + 4096, (bf16_t*)(p.ws + WS_XA), (float*)(p.ws + WS_RSB)};
            TPK(6, pg8::gemm_phase<EpiResF, pg8::StaticOrder, PG8_ALIGN, PG8_SP2>(lds3, g, S, E)); }
        GSYNC();
        {   pg8::Gemm g{(const bf16_t*)(p.ws + WS_XA), (const bf16_t*)(p.ws + WS_WUP + l * WS_W1OFF), MTOK, NUP, DM}; pg8::StaticOrder S; S.init(MTOK, NUP, (int)gridDim.x, (int)blockIdx.x);
            EpiUpAct E{(const float*)(p.ws + WS_RSB), (const float*)(p.ws + WS_CBUP) + (size_t)l * 4 * NUP, (bf16_t*)(p.ws + WS_ACT), (float*)(p.ws + WS_EG), (float*)(p.ws + WS_EV),
                       p.conv_w + (size_t)l * 3 * DFF, p.conv_b + (size_t)l * DFF, (LDSF float*)(lds3 + 131072 + 4096), (LDSF float*)(lds3 + 131072 + 8192)};
            TPK(6, pg8::gemm_phase<EpiUpAct, pg8::StaticOrder, true, PG8_SP2>(lds3, g, S, E)); }
        GSYNC();
        {   const float* modn = (const float*)(p.ws + WS_MOD) + (size_t)(l + 1) * 4 * 6144; const bool more = (l + 1 < DEPTH);
            pg8::Gemm g{(const bf16_t*)(p.ws + WS_ACT), (const bf16_t*)(p.ws + WS_WDN + l * WS_W1OFF), MTOK, DM, DFF}; pg8::StaticOrder S; S.init(MTOK, DM, (int)gridDim.x, (int)blockIdx.x);
            { pg8::Unit fu; for (int i = 0; S.next(i, fu); ++i) act_fixup(p, l, fu.pm); }
            __builtin_amdgcn_fence(__ATOMIC_RELEASE, "agent"); __builtin_amdgcn_fence(__ATOMIC_ACQUIRE, "agent"); __syncthreads();
            EpiResF E{p.out, p.out, mod + 5120, p.norm_mix_g + (more ? l + 1 : l) * DM, more ? modn + 1024 : mod + 1024, more ? (bf16_t*)(p.ws + WS_XA) : nullptr, more ? (float*)(p.ws + WS_RSA) : nullptr};
            TPK(6, pg8::gemm_phase<EpiResF, pg8::StaticOrder, PG8_ALIGN, PG8_SP2>(lds3, g, S, E)); }
        if (l + 1 < DEPTH) GSYNC();
    }
#if PROBE == 1
    if (blockIdx.x == 0 && threadIdx.x == 0) p.out[0] += 0.05f + (float)tacc * 0.01f * 5e-4f;
#elif PROBE >= 2
    if (blockIdx.x == 0 && threadIdx.x == 0) p.out[0] += 0.05f + (float)tph * 0.01f * 1e-4f;
#endif
}

extern "C" void kernel_launch(void* const* d_in, const int* in_sizes, int in, void* d_out, int out_size, void* d_ws, size_t ws_size, hipStream_t stream) {
    if (in != 24 || ws_size < WS_END || out_size != MTOK * DM) { fprintf(stderr, "kernel_launch: unexpected sizes (in %d, ws %zu, out %d)\n", in, ws_size, out_size); return; }
    static int grid_blocks = 0;
    if (!grid_blocks) {
        int dev = 0, cus = 0, per_cu = 0;
        hipGetDevice(&dev);
        hipDeviceGetAttribute(&cus, hipDeviceAttributeMultiprocessorCount, dev);
        hipFuncSetAttribute((const void*)mega, hipFuncAttributeMaxDynamicSharedMemorySize, LDS_BYTES);
        hipOccupancyMaxActiveBlocksPerMultiprocessor(&per_cu, (const void*)mega, NTHR, LDS_BYTES);
        if (per_cu < 1) { fprintf(stderr, "kernel_launch: occupancy query returned %d\n", per_cu); per_cu = 1; }
        if (per_cu > 1) per_cu = 1;
        grid_blocks = cus * per_cu;
        fprintf(stderr, "kernel_launch: cus %d per_cu %d grid %d\n", cus, per_cu, grid_blocks);
    }
    if (hipMemsetAsync((char*)d_ws + WS_CTL + 65536, 0, XCD_BAR_WORDS * 4, stream) != hipSuccess) { fprintf(stderr, "kernel_launch: memset failed\n"); return; }
    Params p{};
    const float** f = (const float**)&p;
    for (int i = 0; i < 24; ++i) f[i] = (const float*)d_in[i];
    p.out = (float*)d_out; p.ws = (unsigned char*)d_ws;
    void* args[] = {&p};
    hipError_t e = hipLaunchCooperativeKernel((const void*)mega, dim3(grid_blocks), dim3(NTHR), args, LDS_BYTES, stream);
    if (e != hipSuccess) fprintf(stderr, "cooperative launch failed: %s (grid %d)\n", hipGetErrorString(e), grid_blocks);
}
```

```cpp
#include <hip/hip_runtime.h>
#include <hip/hip_cooperative_groups.h>
#include <cstdint>
#include <cstdio>

typedef unsigned short bf16_t;
typedef short bf16x8 __attribute__((ext_vector_type(8)));
typedef float f32x4 __attribute__((ext_vector_type(4)));
typedef unsigned u32x4 __attribute__((ext_vector_type(4)));

constexpr int NB = 4, SEQ = 4096, DM = 1024, MTOK = NB * SEQ, DEPTH = 2;
constexpr int HD = 64, HPM = 4, DFF = 2816, PIN = 2960, PINP = 3072, NUP = 2 * DFF;
constexpr float EPS = 1e-6f;
constexpr float LOG2E = 1.4426950408889634f;
constexpr int NTHR = 512;

constexpr int CA_Q = 0, CA_K = 256, CA_V = 512, CB_Q = 768, CB_K = 1024, CB_V = 1280, CC_Q = 1536, CC_K = 1792, CC_V = 2048;
constexpr int CD_Q = 2304, CD_KC = 2560, CD_VC = 2624, CD_KS = 2688, CD_VS = 2752, CD_KW = 2816, CD_VW = 2880, C_BF = 2944, C_DG = 2948;

constexpr size_t MiB = 1u << 20;
constexpr size_t WS_CTL = 0;
constexpr size_t WS_MOD = 1 * MiB;
constexpr size_t WS_CBIN = WS_MOD + 2 * 4 * 6144 * 4;
constexpr size_t WS_CBUP = WS_CBIN + 2 * 4 * 3072 * 4;
constexpr size_t WS_TB = WS_CBUP + 2 * 4 * 5632 * 4;
constexpr size_t WS_LAM = WS_TB + 2 * 4 * 128 * 4;
constexpr size_t WS_BND = WS_LAM + 64;
constexpr size_t WS_CUM = WS_LAM + 512;
constexpr size_t WS_KC = WS_CUM + 16 * 4096 * 4;
constexpr size_t WS_VC = WS_KC + 4 * 256 * 64 * 2;
constexpr size_t WS_SELM = WS_VC + 4 * 256 * 64 * 2;
constexpr size_t WS_SMALL_END = WS_SELM + 16384 * 8;
static_assert(WS_SMALL_END <= 4 * MiB, "small region");
constexpr size_t WS_RSA = 4 * MiB;
constexpr size_t WS_RSB = 5 * MiB;
constexpr size_t WS_SIDE = 6 * MiB;
constexpr size_t WS_IMP = 7 * MiB;
constexpr size_t WS_ML = 11 * MiB;
constexpr size_t WS_PHIT = 7 * MiB;
constexpr size_t WS_W = 12 * MiB;
constexpr size_t WS_WIN = WS_W;
constexpr size_t WS_WOUT = WS_WIN + (size_t)PINP * DM * 2;
constexpr size_t WS_WUP = WS_WOUT + (size_t)DM * DM * 2;
constexpr size_t WS_WDN = WS_WUP + (size_t)NUP * DM * 2;
constexpr size_t WS_W_END = WS_WDN + (size_t)DM * DFF * 2;
static_assert(WS_W_END <= 38 * MiB, "weights region");
constexpr size_t WS_XA = 38 * MiB;
constexpr size_t WS_BIG = 70 * MiB;
constexpr size_t WS_PROJ = WS_BIG;
constexpr size_t WS_MIX = WS_BIG + 96 * MiB;
constexpr size_t WS_ACT = WS_BIG;
constexpr size_t WS_W1OFF = 188 * MiB;
constexpr size_t WS_EG = 228 * MiB;
constexpr size_t WS_EV = 232 * MiB;
constexpr size_t WS_END = 236 * MiB;
static_assert(WS_W_END + WS_W1OFF <= WS_EG && WS_MIX + 32 * MiB <= WS_W + WS_W1OFF, "layer-1 weights");
static_assert(WS_END <= 256 * MiB, "workspace");

struct Params {
    const float *x, *c, *rel_bias, *ada_w, *ada_b, *norm_mix_g, *norm_ffn_g, *w_in, *w_out;
    const float *diff_qn, *diff_kn, *diff_lam, *diff_sub, *fox_qn, *fox_kn, *fox_bf;
    const float *nsa_qn, *nsa_kn, *nsa_pe, *nsa_phi, *w_up, *conv_w, *conv_b, *w_down;
    float* out;
    unsigned char* ws;
};

__device__ __forceinline__ float bf2f(bf16_t v) { return __uint_as_float(((unsigned)v) << 16); }
__device__ __forceinline__ bf16_t f2bf(float f) { unsigned u = __float_as_uint(f); return (bf16_t)((u + 0x7fffu + ((u >> 16) & 1u)) >> 16); }
__device__ __forceinline__ unsigned pk2(float lo, float hi) { return (unsigned)f2bf(lo) | ((unsigned)f2bf(hi) << 16); }
__device__ __forceinline__ float siluf(float v) { return v / (1.f + __expf(-v)); }
__device__ __forceinline__ float logsigf(float v) { return fminf(v, 0.f) - log1pf(__expf(-fabsf(v))); }
__device__ __forceinline__ float wave_sum(float v) {
#pragma unroll
    for (int o = 1; o < 64; o <<= 1) v += __shfl_xor(v, o);
    return v;
}
__device__ __forceinline__ int t5_bucket(int n) {
    if (n < 16) return n < 0 ? 0 : n;
    return 16 + (n >= 19) + (n >= 21) + (n >= 24) + (n >= 27) + (n >= 31) + (n >= 35) + (n >= 40) + (n >= 46) + (n >= 52) + (n >= 59) + (n >= 67) + (n >= 77) + (n >= 87) + (n >= 99) + (n >= 113);
}
__host__ __device__ __forceinline__ int in_col_map(int n) {
    if (n < 1536) return n;
    if (n < 2944) return n + 4;
    if (n < 2948) return 1536 + (n - 2944);
    if (n < 2960) return n;
    return -1;
}
__host__ __device__ __forceinline__ int up_col_map(int n) {
    const int pn = n >> 8, c = n & 255;
    return c < 128 ? (128 * pn + c) : (DFF + 128 * pn + (c - 128));
}

__device__ __forceinline__ int opaque_v(int v) { asm volatile("" : "+v"(v)); return v; }
#define TID() opaque_v((int)threadIdx.x)
#define GTID() ((int)(blockIdx.x * blockDim.x) + TID())
#define GSIZE() ((int)(gridDim.x * blockDim.x))

__device__ __forceinline__ void load8(const bf16_t* p, float* d) {
    const u32x4 r = *(const u32x4*)p;
    d[0] = bf2f(r[0] & 0xffff); d[1] = bf2f(r[0] >> 16); d[2] = bf2f(r[1] & 0xffff); d[3] = bf2f(r[1] >> 16);
    d[4] = bf2f(r[2] & 0xffff); d[5] = bf2f(r[2] >> 16); d[6] = bf2f(r[3] & 0xffff); d[7] = bf2f(r[3] >> 16);
}
#define LDSF __attribute__((address_space(3)))
__device__ __forceinline__ void gemv4_block(const float* W, int ld, int oc, const LDSF float* vec, LDSF float* red, float* out0, int ostride, int n, float bias, int tid) {
    const int lane = tid & 63, wv = tid >> 6;
    float a0 = 0.f, a1 = 0.f, a2 = 0.f, a3 = 0.f;
    if (oc >= 0) {
        const float* w = W + (size_t)(wv * 128) * ld + oc;
#pragma unroll 32
        for (int k = 0; k < 128; ++k) { const float wk = w[(size_t)k * ld]; const f32x4 v = *(const LDSF f32x4*)(vec + (wv * 128 + k) * 4); a0 += v[0] * wk; a1 += v[1] * wk; a2 += v[2] * wk; a3 += v[3] * wk; }
    }
    red[(wv * 4 + 0) * 64 + lane] = a0; red[(wv * 4 + 1) * 64 + lane] = a1; red[(wv * 4 + 2) * 64 + lane] = a2; red[(wv * 4 + 3) * 64 + lane] = a3;
    __syncthreads();
    if (tid < 256) { const int bt = tid >> 6; float sacc = 0.f;
#pragma unroll
        for (int w8 = 0; w8 < 8; ++w8) sacc += red[(w8 * 4 + bt) * 64 + lane];
        out0[(size_t)bt * ostride + n] = sacc + bias; }
    __syncthreads();
}
__device__ void ph_mod(const Params& p, unsigned char* lds) {
    float* mod = (float*)(p.ws + WS_MOD);
    float* tb = (float*)(p.ws + WS_TB);
    float* lamv = (float*)(p.ws + WS_LAM);
    LDSF float* vec = (LDSF float*)lds; LDSF float* red = (LDSF float*)(lds + 16384);
    const int tid = TID();
    bool loaded = false;
    for (int item = blockIdx.x; item < DEPTH * 96; item += gridDim.x) {
        if (!loaded) { for (int i = tid; i < 4096; i += NTHR) { const int bt = i >> 10, k = i & 1023; vec[k * 4 + bt] = siluf(p.c[bt * DM + k]); } __syncthreads(); loaded = true; }
        const int l = item / 96, n = (item % 96) * 64 + (tid & 63);
        gemv4_block(p.ada_w + (size_t)l * DM * 6144, 6144, n, vec, red, mod + (size_t)l * 4 * 6144, 6144, n, p.ada_b[l * 6144 + n], tid);
    }
    const int gt = GTID(), gs = GSIZE();
    for (int idx = gt; idx < 2 * 4 * 128; idx += gs) {
        const int type = idx / 512, h = (idx / 128) & 3, d = idx & 127;
        tb[idx] = p.rel_bias[t5_bucket(d) * 8 + type * 4 + h];
    }
    for (int idx = gt; idx < DEPTH * 32; idx += gs) {
        const int l = idx >> 5, e = idx & 31; float v = 0.f;
        if (e < 17) {
            const int type = (e < 5) ? 0 : 1, h = (e < 4) ? e : ((e == 4) ? 0 : ((e - 5) & 3));
            const int ng = (e < 4) ? 32 : 64;
            const float* gq = (e < 4) ? p.diff_qn + l * 32 : ((e == 4) ? p.fox_qn + l * 64 : p.nsa_qn + l * 64);
            const float* gk = (e < 4) ? p.diff_kn + l * 32 : ((e == 4) ? p.fox_kn + l * 64 : p.nsa_kn + (l * 3 + (e - 5) / 4) * 64);
            float mq = 0.f, mk = 0.f; for (int i = 0; i < ng; ++i) { mq = fmaxf(mq, fabsf(gq[i])); mk = fmaxf(mk, fabsf(gk[i])); }
            float tm = 0.f; if (e != 4) { tm = -INFINITY; for (int bk2 = 0; bk2 < 32; ++bk2) tm = fmaxf(tm, p.rel_bias[bk2 * 8 + type * 4 + h]); }
            v = sqrtf((float)ng) * mq * mk * 1.02f * LOG2E + tm * LOG2E;
        }
        ((float*)(p.ws + WS_BND))[idx] = v;
    }
    for (int idx = gt; idx < DEPTH; idx += gs) {
        const float* lv = p.diff_lam + idx * 4 * 32;
        float s1 = 0.f, s2 = 0.f;
        for (int i = 0; i < 32; ++i) { s1 += lv[i] * lv[32 + i]; s2 += lv[64 + i] * lv[96 + i]; }
        const float lam_init = 0.8f - 0.6f * expf(-0.3f * (float)idx);
        lamv[idx] = expf(s1) - expf(s2) + lam_init;
    }
}
__device__ void ph_cbias(const Params& p, int lfirst, int lcount) {
    const float* mod = (const float*)(p.ws + WS_MOD);
    const int tid_ = TID(); const int lane = tid_ & 63, wv = tid_ >> 6;
    const int gw = blockIdx.x * (NTHR >> 6) + wv, ngw = gridDim.x * (NTHR >> 6);
    constexpr int NCOL = PINP + NUP;
    const int per = (lcount * NCOL + ngw - 1) / ngw; const int c0 = gw * per, c1 = min(lcount * NCOL, c0 + per);
    int cur_key = -1; float sh[4][16];
    for (int c = c0; c < c1; ++c) {
        const int l = lfirst + c / NCOL, r = c % NCOL; const bool isin = r < PINP; const int n = isin ? r : r - PINP; const int key = l * 2 + (isin ? 0 : 1);
        if (key != cur_key) { cur_key = key; const int shoff = isin ? 0 : 3072;
#pragma unroll
            for (int bt = 0; bt < 4; ++bt)
#pragma unroll
                for (int q4 = 0; q4 < 4; ++q4) { const f32x4 v = *(const f32x4*)(mod + (size_t)(l * 4 + bt) * 6144 + shoff + 16 * lane + 4 * q4); sh[bt][4 * q4] = v[0]; sh[bt][4 * q4 + 1] = v[1]; sh[bt][4 * q4 + 2] = v[2]; sh[bt][4 * q4 + 3] = v[3]; } }
        const bf16_t* wrow = (const bf16_t*)(p.ws + (isin ? WS_WIN : WS_WUP) + l * WS_W1OFF) + (size_t)n * DM + 16 * lane;
        float w[16]; load8(wrow, w); load8(wrow + 8, w + 8);
        float a0 = 0.f, a1 = 0.f, a2 = 0.f, a3 = 0.f;
#pragma unroll
        for (int j = 0; j < 16; ++j) { a0 += sh[0][j] * w[j]; a1 += sh[1][j] * w[j]; a2 += sh[2][j] * w[j]; a3 += sh[3][j] * w[j]; }
        a0 = wave_sum(a0); a1 = wave_sum(a1); a2 = wave_sum(a2); a3 = wave_sum(a3);
        if (lane == 0) { float* o = isin ? (float*)(p.ws + WS_CBIN) + (size_t)l * 4 * PINP : (float*)(p.ws + WS_CBUP) + (size_t)l * 4 * NUP; const int ld = isin ? PINP : NUP;
            o[n] = a0; o[ld + n] = a1; o[2 * ld + n] = a2; o[3 * ld + n] = a3; }
    }
}
template <int MAPK>
__device__ __forceinline__ void convert_one(const float* W, int K, int Nsrc, int Npad, bf16_t* Wt, LDSF float* scr, int it, int lane) {
    const int nnb = Npad / 64;
    const int kb = it / nnb, nb = it % nnb, k0 = kb * 64, n0 = nb * 64;
    {
        const int n = n0 + lane;
        const int oc = MAPK == 0 ? n : (MAPK == 1 ? in_col_map(n) : up_col_map(n));
        const float* wp = W + (size_t)k0 * Nsrc + (oc >= 0 ? oc : 0);
#pragma unroll 1
        for (int hh = 0; hh < 2; ++hh) {
            float tv[32];
#pragma unroll
            for (int i = 0; i < 32; ++i) tv[i] = wp[(size_t)(32 * hh + i) * Nsrc];
#pragma unroll
            for (int i = 0; i < 32; ++i) scr[(32 * hh + i) * 65 + lane] = (oc >= 0) ? tv[i] : 0.f;
        }
    }
    __builtin_amdgcn_s_waitcnt(0xc07f); __builtin_amdgcn_wave_barrier();
    {
        const int c = lane & 7;
#pragma unroll
        for (int j = 0; j < 8; ++j) { const int nn = 8 * j + (lane >> 3); const LDSF float* sp = scr + (8 * c) * 65 + nn;
            u32x4 o; o[0] = pk2(sp[0], sp[65]); o[1] = pk2(sp[130], sp[195]); o[2] = pk2(sp[260], sp[325]); o[3] = pk2(sp[390], sp[455]);
            *(u32x4*)(Wt + (size_t)(n0 + nn) * K + k0 + 8 * c) = o; }
    }
    __builtin_amdgcn_s_waitcnt(0xc07f); __builtin_amdgcn_wave_barrier();
}
constexpr int CV_IN = 16 * (PINP / 64), CV_OUT = 16 * (DM / 64), CV_UP = 16 * (NUP / 64), CV_DN = (DFF / 64) * (DM / 64), CV_PHI = 32, CV_ITEMS = CV_IN + CV_OUT + CV_UP + CV_DN + 2 * CV_PHI;
static_assert(CV_ITEMS == 3200, "conversion item count");
__device__ void convert_item(const Params& p, int l, int idx, LDSF float* scr, int lane) {
    if (idx < CV_IN) { convert_one<1>(p.w_in + (size_t)l * DM * PIN, DM, PIN, PINP, (bf16_t*)(p.ws + WS_WIN + l * WS_W1OFF), scr, idx, lane); return; } idx -= CV_IN;
    if (idx < CV_OUT) { convert_one<0>(p.w_out + (size_t)l * DM * DM, DM, DM, DM, (bf16_t*)(p.ws + WS_WOUT + l * WS_W1OFF), scr, idx, lane); return; } idx -= CV_OUT;
    if (idx < CV_UP) { convert_one<2>(p.w_up + (size_t)l * DM * NUP, DM, NUP, NUP, (bf16_t*)(p.ws + WS_WUP + l * WS_W1OFF), scr, idx, lane); return; } idx -= CV_UP;
    if (idx < CV_DN) { convert_one<0>(p.w_down + (size_t)l * DFF * DM, DFF, DM, DM, (bf16_t*)(p.ws + WS_WDN + l * WS_W1OFF), scr, idx, lane); return; } idx -= CV_DN;
    const int w2 = idx / CV_PHI; idx -= w2 * CV_PHI;
    convert_one<0>(p.nsa_phi + (size_t)(l * 2 + w2) * 2048 * 64, 2048, 64, 64, (bf16_t*)(p.ws + WS_PHIT) + (size_t)(l * 2 + w2) * 64 * 2048, scr, idx, lane);
}
__device__ void ph_weights(const Params& p, int l, unsigned char* lds) {
    const int tid_ = TID(); const int lane = tid_ & 63, wv = tid_ >> 6;
    const int ngw = gridDim.x * (NTHR >> 6), gw = ngw - 1 - (blockIdx.x * (NTHR >> 6) + wv);
    LDSF float* scr = (LDSF float*)lds + wv * (64 * 65);
    for (int it = gw; it < CV_ITEMS; it += ngw) convert_item(p, l, it, scr, lane);
}
__device__ void ph_xa_from(const Params& p, const float* src, int l, int which  , bf16_t* XA, float* rowss, bool write_xa) {
    const float* mod = (const float*)(p.ws + WS_MOD);
    const float* g = (which == 0 ? p.norm_mix_g : p.norm_ffn_g) + l * DM;
    const int tid_ = TID(); const int lane = tid_ & 63, wv = tid_ >> 6;
    const int gw = blockIdx.x * (blockDim.x >> 6) + wv, ngw = gridDim.x * (blockDim.x >> 6);
    for (int row0 = gw; row0 < MTOK; row0 += 2 * ngw) {
        f32x4 v[2][4];
#pragma unroll
        for (int rr = 0; rr < 2; ++rr) { const int row = min(row0 + rr * ngw, MTOK - 1);
#pragma unroll
            for (int j = 0; j < 4; ++j) v[rr][j] = *(const f32x4*)(src + (size_t)row * DM + j * 256 + lane * 4); }
#pragma unroll
        for (int rr = 0; rr < 2; ++rr) {
            const int row = row0 + rr * ngw;
            if (row < MTOK) {
                const int b = row / SEQ; const float* sc = mod + (size_t)(l * 4 + b) * 6144 + (which == 0 ? 1024 : 4096);
                float ss = 0.f;
#pragma unroll
                for (int j = 0; j < 4; ++j) {
                    const int k = j * 256 + lane * 4; const f32x4 x = v[rr][j];
                    ss += x[0] * x[0] + x[1] * x[1] + x[2] * x[2] + x[3] * x[3];
                    if (write_xa) {
                        const f32x4 gv = *(const f32x4*)(g + k); const f32x4 sv = *(const f32x4*)(sc + k);
                        uint2 o; o.x = pk2(x[0] * gv[0] * (1.f + sv[0]), x[1] * gv[1] * (1.f + sv[1])); o.y = pk2(x[2] * gv[2] * (1.f + sv[2]), x[3] * gv[3] * (1.f + sv[3]));
                        *(uint2*)(XA + (size_t)row * DM + k) = o;
                    }
                }
                ss = wave_sum(ss);
                if (lane < 16) rowss[(size_t)row * 16 + lane] = (lane == 0) ? ss : 0.f;
            }
        }
    }
}

namespace pg8 {
#define PG8_LAS __attribute__((address_space(3)))
typedef unsigned short bf16_t;
typedef short bf16x8 __attribute__((ext_vector_type(8)));
typedef float f32x4 __attribute__((ext_vector_type(4)));
typedef unsigned u32x4 __attribute__((ext_vector_type(4)));
constexpr int BM = 256, BK = 64, HALF = 128, HTB = HALF * BK * 2  , STAGE_BYTES = 8 * HTB, NXCD = 8, WGM = 8;

__host__ __device__ __forceinline__ int lds_byte(int r, int c) { const int st = (r >> 4) * 2 + (c >> 5), rr = r & 15, cc = c & 31, ob = rr * 64 + cc * 2; return st * 1024 + (ob ^ (((ob >> 9) & 1) << 5)); }
__host__ __device__ __forceinline__ void stage_rc(int b, int& R, int& C) { const int st = b / 1024, sb = b % 1024, swz = sb ^ (((sb >> 9) & 1) << 5); R = (st >> 1) * 16 + swz / 64; C = (st & 1) * 32 + (swz % 64) / 2; }
__host__ __device__ __forceinline__ int perm32(int rho) { const int n = rho >> 4, i = rho & 15; return 8 * (i >> 2) + 4 * n + (i & 3); }

struct Unit { int pm, pn; };
struct Gemm { const bf16_t* A; const bf16_t* Bt; int M, N, K; };

struct StaticOrder {
    int nM, nN, nwg, G, c;
    __host__ __device__ void init(int M, int N, int G_, int c_) { nM = M / BM; nN = N / BM; nwg = nM * nN; G = G_; c = c_; }
    __host__ __device__ bool next(int i, Unit& u) const {
        const long L = (long)i * G + c; if (L >= nwg) return false;
        int wgid = (int)L; { const int q = nwg / NXCD, r = nwg % NXCD, xcd = wgid % NXCD, off = wgid / NXCD; wgid = (xcd < r ? xcd * (q + 1) : r * (q + 1) + (xcd - r) * q) + off; }
        const int nig = WGM * nN, gid = wgid / nig, fm = gid * WGM, gsz = (nM - fm) < WGM ? (nM - fm) : WGM;
        u.pm = fm + ((wgid % nig) % gsz); u.pn = (wgid % nig) / gsz; return true;
    }
    __device__ __forceinline__ void a_ready(const Unit&) const {}
    __device__ __forceinline__ void done(const Unit&) const {}
};


__device__ __forceinline__ unsigned cvt_pk_bf16(float lo, float hi) { unsigned r; asm volatile("v_cvt_pk_bf16_f32 %0, %1, %2" : "=v"(r) : "v"(lo), "v"(hi)); return r; }
template <class Epi, class Sched, bool ALIGN_EPI = false, bool SP2 = false>
__device__ __forceinline__ void gemm_phase(PG8_LAS unsigned char* lds, const Gemm g, const Sched& S, const Epi& E) {
    const int tid = TID(), wid = __builtin_amdgcn_readfirstlane(tid >> 6), lane = tid & 63, wr = wid >> 2, wc = wid & 3, fr = lane & 15, fq = lane >> 4;
    const int K = g.K, nt = K / BK;
    unsigned voffA[2], voffB[2];
#pragma unroll
    for (int i = 0; i < 2; ++i) { int R, C; stage_rc(tid * 16 + i * 8192, R, C); const int Rb = Epi::PERM ? ((R & ~31) + perm32(R & 31)) : R;
        voffA[i] = (unsigned)(R * K + C) * 2u; voffB[i] = (unsigned)(Rb * K + C) * 2u; }
    const size_t kstep = (size_t)(BK * 2);
    const size_t hstep = (size_t)HALF * K * 2;
    const size_t tstep = 2 * hstep;
    const unsigned ldsw = (unsigned)wid * 1024u;
    const int aoff = lds_byte(wr * 64 + fr, fq * 8), boff = lds_byte(wc * 32 + fr, fq * 8);
#define PG8_SA(b, h) (((b) * 2 + (h)) * HTB)
#define PG8_SB(b, h) ((4 + (b) * 2 + (h)) * HTB)
#define PG8_STAGE(bufoff, gbase, voff) do { _Pragma("unroll") for (int _i = 0; _i < 2; ++_i) \
        __builtin_amdgcn_global_load_lds((const unsigned*)((const char*)(gbase) + (voff)[_i]), (PG8_LAS unsigned*)(lds + (bufoff) + ldsw + _i * 8192), 16, 0, 0); } while (0)
#define PG8_LDA(dst, b, h) do { _Pragma("unroll") for (int m = 0; m < 4; ++m) _Pragma("unroll") for (int k = 0; k < 2; ++k) dst[m][k] = *(const PG8_LAS bf16x8*)(lds + PG8_SA(b, h) + aoff + m * 2048 + k * 1024); } while (0)
#define PG8_LDB(dst, b, h) do { _Pragma("unroll") for (int n = 0; n < 2; ++n) _Pragma("unroll") for (int k = 0; k < 2; ++k) dst[n][k] = *(const PG8_LAS bf16x8*)(lds + PG8_SB(b, h) + boff + n * 2048 + k * 1024); } while (0)
#define PG8_MMA(ai, bj, At, Bt) do { __builtin_amdgcn_s_setprio(1); _Pragma("unroll") for (int m = 0; m < 4; ++m) _Pragma("unroll") for (int n = 0; n < 2; ++n) _Pragma("unroll") for (int k = 0; k < 2; ++k) \
        acc[ai][bj][m][n] = __builtin_amdgcn_mfma_f32_16x16x32_bf16(Bt[n][k], At[m][k], acc[ai][bj][m][n], 0, 0, 0); __builtin_amdgcn_s_setprio(0); } while (0)
#define PG8_WAIT_V(n) asm volatile("s_waitcnt vmcnt(" #n ")" ::: "memory")
#define PG8_WAIT_L(n) asm volatile("s_waitcnt lgkmcnt(" #n ")" ::: "memory")
#define PG8_BAR __builtin_amdgcn_s_barrier()
#define PG8_SCHED __builtin_amdgcn_sched_barrier(0)
    Unit cur, nxt; int ui = 0;
    if (!S.next(0, cur)) return;
    f32x4 acc[2][2][4][2];
#pragma unroll
    for (int a = 0; a < 2; ++a)
#pragma unroll
        for (int b = 0; b < 2; ++b)
#pragma unroll
            for (int m = 0; m < 4; ++m)
#pragma unroll
                for (int n = 0; n < 2; ++n) acc[a][b][m][n] = (f32x4){0.f, 0.f, 0.f, 0.f};
    bf16x8 At[4][2], B0[2][2], B1[2][2];
    const char* cA = (const char*)g.A + (size_t)cur.pm * tstep; const char* cB = (const char*)g.Bt + (size_t)cur.pn * tstep;
    S.a_ready(cur);
    if constexpr (SP2) {
        PG8_STAGE(PG8_SB(0, 0), cB, voffB); PG8_STAGE(PG8_SB(0, 1), cB + hstep, voffB); PG8_STAGE(PG8_SA(0, 0), cA, voffA); PG8_STAGE(PG8_SA(0, 1), cA + hstep, voffA);
        if (wr == 1) PG8_BAR;
        PG8_WAIT_V(2); PG8_BAR;
        PG8_STAGE(PG8_SB(1, 0), cB + kstep, voffB); PG8_STAGE(PG8_SA(1, 0), cA + kstep, voffA); PG8_STAGE(PG8_SB(1, 1), cB + hstep + kstep, voffB);
        PG8_WAIT_V(6); PG8_BAR;
    } else {
        PG8_STAGE(PG8_SB(0, 0), cB, voffB); PG8_STAGE(PG8_SA(0, 0), cA, voffA); PG8_STAGE(PG8_SB(0, 1), cB + hstep, voffB); PG8_STAGE(PG8_SA(0, 1), cA + hstep, voffA);
        if (wr == 1) PG8_BAR;
        PG8_WAIT_V(4); PG8_BAR;
        PG8_STAGE(PG8_SB(1, 0), cB + kstep, voffB); PG8_STAGE(PG8_SA(1, 0), cA + kstep, voffA); PG8_STAGE(PG8_SB(1, 1), cB + hstep + kstep, voffB);
        PG8_WAIT_V(6); PG8_BAR;
    }
    for (;;) {
        const bool has_next = S.next(ui + 1, nxt);
        const char* nA = has_next ? (const char*)g.A + (size_t)nxt.pm * tstep : cA; const char* nB = has_next ? (const char*)g.Bt + (size_t)nxt.pn * tstep : cB;
        for (int t = 0; t < nt; t += 2) {
            const bool last = (t == nt - 2);
            const char* a1 = cA + (size_t)(t + 1) * kstep;
            const char* a2 = last ? nA : cA + (size_t)(t + 2) * kstep; const char* b2 = last ? nB : cB + (size_t)(t + 2) * kstep;
            const char* a3 = a2 + kstep; const char* b3 = b2 + kstep;
            if (last && has_next) S.a_ready(nxt);
            if constexpr (SP2) {
            PG8_LDB(B0, 0, 0); PG8_LDB(B1, 0, 1); PG8_SCHED; PG8_LDA(At, 0, 0); PG8_STAGE(PG8_SA(1, 1), a1 + hstep, voffA);
            PG8_WAIT_V(8); PG8_WAIT_L(0); PG8_BAR; PG8_MMA(0, 0, At, B0); PG8_MMA(0, 1, At, B1); PG8_BAR; PG8_SCHED;
            PG8_LDA(At, 0, 1); PG8_STAGE(PG8_SB(0, 0), b2, voffB); PG8_STAGE(PG8_SB(0, 1), b2 + hstep, voffB); PG8_STAGE(PG8_SA(0, 0), a2, voffA);
            PG8_WAIT_V(8); PG8_WAIT_L(0); PG8_BAR; PG8_MMA(1, 0, At, B0); PG8_MMA(1, 1, At, B1); PG8_BAR; PG8_SCHED;
            PG8_LDB(B0, 1, 0); PG8_LDB(B1, 1, 1); PG8_SCHED; PG8_LDA(At, 1, 0); PG8_STAGE(PG8_SA(0, 1), a2 + hstep, voffA);
            PG8_WAIT_V(8); PG8_WAIT_L(0); PG8_BAR; PG8_MMA(0, 0, At, B0); PG8_MMA(0, 1, At, B1); PG8_BAR; PG8_SCHED;
            PG8_LDA(At, 1, 1); PG8_STAGE(PG8_SB(1, 0), b3, voffB); PG8_STAGE(PG8_SB(1, 1), b3 + hstep, voffB); PG8_STAGE(PG8_SA(1, 0), a3, voffA);
            PG8_WAIT_V(8); PG8_WAIT_L(0); PG8_BAR; PG8_MMA(1, 0, At, B0); PG8_MMA(1, 1, At, B1); PG8_BAR; PG8_SCHED;
            } else {
            PG8_LDB(B0, 0, 0); PG8_SCHED; PG8_LDA(At, 0, 0); PG8_STAGE(PG8_SA(1, 1), a1 + hstep, voffA);
            PG8_WAIT_L(8); PG8_BAR; PG8_WAIT_L(0); PG8_MMA(0, 0, At, B0); PG8_BAR; PG8_SCHED;
            PG8_LDB(B1, 0, 1); PG8_STAGE(PG8_SB(0, 0), b2, voffB);
            PG8_BAR; PG8_WAIT_L(0); PG8_MMA(0, 1, At, B1); PG8_BAR;
            PG8_LDA(At, 0, 1); PG8_STAGE(PG8_SA(0, 0), a2, voffA);
            PG8_BAR; PG8_WAIT_L(0); PG8_MMA(1, 0, At, B0); PG8_BAR; PG8_SCHED;
            PG8_STAGE(PG8_SB(0, 1), b2 + hstep, voffB);
            PG8_WAIT_V(6); PG8_BAR; PG8_MMA(1, 1, At, B1); PG8_BAR;
            PG8_LDB(B0, 1, 0); PG8_SCHED; PG8_LDA(At, 1, 0); PG8_STAGE(PG8_SA(0, 1), a2 + hstep, voffA);
            PG8_WAIT_L(8); PG8_BAR; PG8_WAIT_L(0); PG8_MMA(0, 0, At, B0); PG8_BAR; PG8_SCHED;
            PG8_LDB(B1, 1, 1); PG8_STAGE(PG8_SB(1, 0), b3, voffB);
            PG8_BAR; PG8_WAIT_L(0); PG8_MMA(0, 1, At, B1); PG8_BAR;
            PG8_LDA(At, 1, 1); PG8_STAGE(PG8_SA(1, 0), a3, voffA);
            PG8_BAR; PG8_WAIT_L(0); PG8_MMA(1, 0, At, B0); PG8_BAR; PG8_SCHED;
            PG8_STAGE(PG8_SB(1, 1), b3 + hstep, voffB);
            PG8_WAIT_V(6); PG8_BAR; PG8_MMA(1, 1, At, B1); PG8_BAR;
            }
        }
        if constexpr (ALIGN_EPI) { if (wr == 0) PG8_BAR; }
        if constexpr (!Epi::AFTER_DRAIN) { E(acc, cur, wr, wc, fr, fq); S.done(cur); }
        if (!has_next) break;
#pragma unroll
        for (int a = 0; a < 2; ++a)
#pragma unroll
            for (int b = 0; b < 2; ++b)
#pragma unroll
                for (int m = 0; m < 4; ++m)
#pragma unroll
                    for (int n = 0; n < 2; ++n) acc[a][b][m][n] = (f32x4){0.f, 0.f, 0.f, 0.f};
        cur = nxt; cA = nA; cB = nB; ++ui;
        if constexpr (ALIGN_EPI) { if (wr == 1) PG8_BAR; }
    }
    PG8_WAIT_V(0);
    if constexpr (!ALIGN_EPI) { if (wr == 0) PG8_BAR; }
    PG8_BAR;
    if constexpr (Epi::AFTER_DRAIN) { E.fused(acc, cur, wr, wc, fr, fq, lds, wid, lane); S.done(cur); }
#undef PG8_SA
#undef PG8_SB
#undef PG8_STAGE
#undef PG8_LDA
#undef PG8_LDB
#undef PG8_MMA
#undef PG8_WAIT_V
#undef PG8_WAIT_L
#undef PG8_BAR
#undef PG8_SCHED
}
}

#ifndef PG8_SP2
#define PG8_SP2 true
#endif
#ifndef PG8_ALIGN
#define PG8_ALIGN true
#endif

__device__ __forceinline__ float row_rstd16(const float* rowss, int row) {
    const f32x4* r = (const f32x4*)(rowss + (size_t)row * 16);
    const f32x4 a = r[0], b = r[1], c = r[2], d = r[3];
    const float s = ((a[0] + a[1]) + (a[2] + a[3])) + ((b[0] + b[1]) + (b[2] + b[3])) + ((c[0] + c[1]) + (c[2] + c[3])) + ((d[0] + d[1]) + (d[2] + d[3]));
    return rsqrtf(s * (1.f / DM) + EPS);
}
struct EpiProjF {
    static constexpr bool PERM = true, AFTER_DRAIN = false;
    const float* rowss; const float* cb; bf16_t* proj; float* side; const float* g_a; const float* g_b; const float* g_ds; const float* g_dw; LDSF float* xs  ; LDSF float* rsl  ;
    __device__ __forceinline__ void operator()(const pg8::f32x4 (&acc)[2][2][4][2], const pg8::Unit& u, int wr, int wc, int fr, int fq) const {
        const int b = u.pm >> 4, colt = u.pn * 256 + wc * 32 + 8 * fq;
        const int knmode = (u.pn == 1) ? 1 : (u.pn == 4) ? 2 : (u.pn == 10) ? 3 : (u.pn == 11) ? 4 : 0;
        f32x4 cv[2][2];
#pragma unroll
        for (int bj = 0; bj < 2; ++bj)
#pragma unroll
            for (int n = 0; n < 2; ++n) cv[bj][n] = *(const f32x4*)(cb + b * PINP + colt + bj * 128 + 4 * n);
        {   const int tid = (wr * 4 + wc) * 64 + fq * 16 + fr;
            if (tid < 256) rsl[tid] = row_rstd16(rowss, u.pm * 256 + tid);
            asm volatile("s_waitcnt vmcnt(0) lgkmcnt(0)" ::: "memory"); __builtin_amdgcn_s_barrier(); asm volatile("" ::: "memory"); }
        if (knmode != 0) {
#pragma unroll
            for (int ai = 0; ai < 2; ++ai)
#pragma unroll
                for (int m = 0; m < 4; ++m) {
                    const float rsm = rsl[ai * 128 + wr * 64 + m * 16 + fr];
#pragma unroll
                    for (int bj = 0; bj < 2; ++bj) {
                        const f32x4 v0 = acc[ai][bj][m][0] * rsm + cv[bj][0], v1 = acc[ai][bj][m][1] * rsm + cv[bj][1];
                        float ss = (v0[0] * v0[0] + v0[1] * v0[1]) + (v0[2] * v0[2] + v0[3] * v0[3]) + (v1[0] * v1[0] + v1[1] * v1[1]) + (v1[2] * v1[2] + v1[3] * v1[3]);
                        ss += __shfl_xor(ss, 16); ss += __shfl_xor(ss, 32);
                        if (fq == 0) xs[((wr * 4 + wc) * 16 + (ai * 4 + m) * 2 + bj) * 16 + fr] = ss;
                    }
                }
            asm volatile("s_waitcnt lgkmcnt(0)" ::: "memory"); __builtin_amdgcn_s_barrier(); asm volatile("" ::: "memory");
        }
#pragma unroll
        for (int ai = 0; ai < 2; ++ai)
#pragma unroll
            for (int m = 0; m < 4; ++m) {
                const int row = u.pm * 256 + ai * 128 + wr * 64 + m * 16 + fr; const float rs = rsl[ai * 128 + wr * 64 + m * 16 + fr];
#pragma unroll
                for (int bj = 0; bj < 2; ++bj) {
                    f32x4 v0 = acc[ai][bj][m][0] * rs + cv[bj][0], v1 = acc[ai][bj][m][1] * rs + cv[bj][1]; const int col0 = colt + bj * 128;
                    if (col0 >= C_BF && col0 < PIN) { *(f32x4*)(side + (size_t)row * 16 + (col0 - C_BF)) = v0; *(f32x4*)(side + (size_t)row * 16 + (col0 - C_BF) + 4) = v1; }
                    const bool on = (knmode == 1) || (knmode == 2) || (knmode == 3 && bj == 1 && wc < 2) || (knmode == 4 && bj == 0 && wc < 2);
                    if (on) {
                        const int xi = (ai * 4 + m) * 2 + bj;
                        float tot = xs[((wr * 4 + wc) * 16 + xi) * 16 + fr]; float dn = 1.f / 32.f;
                        if (knmode != 1) { tot += xs[((wr * 4 + (wc ^ 1)) * 16 + xi) * 16 + fr]; dn = 1.f / 64.f; }
                        const float nrm = rsqrtf(tot * dn + EPS);
                        const float* gp = (knmode == 1) ? g_a + 8 * fq : ((knmode == 2) ? g_b : (knmode == 3 ? g_ds : g_dw)) + (wc & 1) * 32 + 8 * fq;
                        v0 = v0 * nrm * *(const f32x4*)gp; v1 = v1 * nrm * *(const f32x4*)(gp + 4);
                    }
                    u32x4 w; w[0] = pg8::cvt_pk_bf16(v0[0], v0[1]); w[1] = pg8::cvt_pk_bf16(v0[2], v0[3]); w[2] = pg8::cvt_pk_bf16(v1[0], v1[1]); w[3] = pg8::cvt_pk_bf16(v1[2], v1[3]);
                    *(u32x4*)(proj + (size_t)row * PINP + col0) = w;
                }
            }
    }
};
struct EpiResF {
    static constexpr bool PERM = false, AFTER_DRAIN = false;
    const float* xin; float* xout; const float* gate; const float* g; const float* sc; bf16_t* xa; float* rowss;
    __device__ __forceinline__ void operator()(const pg8::f32x4 (&acc)[2][2][4][2], const pg8::Unit& u, int wr, int wc, int fr, int fq) const {
        const int b = u.pm >> 4, col0 = u.pn * 256 + wc * 32 + 4 * fq;
        f32x4 gt[2][2], gm[2][2];
#pragma unroll
        for (int bj = 0; bj < 2; ++bj)
#pragma unroll
            for (int n = 0; n < 2; ++n) { const int c = col0 + bj * 128 + n * 16; gt[bj][n] = *(const f32x4*)(gate + b * 6144 + c);
                if (xa) gm[bj][n] = *(const f32x4*)(g + c) * (*(const f32x4*)(sc + b * 6144 + c) + 1.0f); else gm[bj][n] = (f32x4){0.f, 0.f, 0.f, 0.f}; }
#pragma unroll
        for (int ai = 0; ai < 2; ++ai)
#pragma unroll
            for (int mh = 0; mh < 2; ++mh) {
                f32x4 xi[2][2][2];
#pragma unroll
                for (int mm = 0; mm < 2; ++mm)
#pragma unroll
                    for (int bj = 0; bj < 2; ++bj)
#pragma unroll
                        for (int n = 0; n < 2; ++n)
                            xi[mm][bj][n] = *(const f32x4*)(xin + (size_t)(u.pm * 256 + ai * 128 + wr * 64 + (2 * mh + mm) * 16 + fr) * DM + col0 + bj * 128 + n * 16);
                asm volatile("" ::: "memory");
#pragma unroll
                for (int mm = 0; mm < 2; ++mm) {
                    const int m = 2 * mh + mm; const int row = u.pm * 256 + ai * 128 + wr * 64 + m * 16 + fr; float ss = 0.f;
#pragma unroll
                    for (int bj = 0; bj < 2; ++bj)
#pragma unroll
                        for (int n = 0; n < 2; ++n) { const size_t off = (size_t)row * DM + col0 + bj * 128 + n * 16;
                            const f32x4 o = xi[mm][bj][n] + gt[bj][n] * acc[ai][bj][m][n];
                            *(f32x4*)(xout + off) = o; ss += (o[0] * o[0] + o[1] * o[1]) + (o[2] * o[2] + o[3] * o[3]);
                            if (xa) { const f32x4 q = o * gm[bj][n]; uint2 w; w.x = pg8::cvt_pk_bf16(q[0], q[1]); w.y = pg8::cvt_pk_bf16(q[2], q[3]); *(uint2*)(xa + off) = w; } }
                    if (rowss) { ss += __shfl_xor(ss, 16); ss += __shfl_xor(ss, 32); if (fq == 0) rowss[(size_t)row * 16 + u.pn * 4 + wc] = ss; }
                }
            }
    }
};


#define DPPF(oldv, src, CTRL) __builtin_bit_cast(float, __builtin_amdgcn_update_dpp(__builtin_bit_cast(int, (float)(oldv)), __builtin_bit_cast(int, (float)(src)), (CTRL), 0xf, 0xf, false))
struct EpiUpAct {
    static constexpr bool PERM = true, AFTER_DRAIN = false;
    const float* rowss; const float* cb; bf16_t* act; float* eg; float* ev; const float* cw; const float* cbias; LDSF float* xch; LDSF float* cst  ;
    __device__ __forceinline__ void operator()(const pg8::f32x4 (&acc)[2][2][4][2], const pg8::Unit& u, int wr, int wc, int fr, int fq) const {
        const int b = u.pm >> 4, cih = wc * 32 + 8 * fq, jcol = u.pn * 128 + cih;
        const float* cbg = cb + b * NUP + u.pn * 256 + cih; const float* cbv = cbg + 128;
        {
            const int tid = (wr * 4 + wc) * 64 + fq * 16 + fr, col = tid & 127, arr = tid >> 7;
            const float* src = (arr == 0) ? cb + b * NUP + u.pn * 256 + col : (arr == 1) ? cb + b * NUP + u.pn * 256 + 128 + col : cw + (arr - 2) * DFF + u.pn * 128 + col;
            cst[arr * 128 + col] = *src;
            if (tid < 256) { const int a2 = 4 + (tid >> 7); cst[a2 * 128 + col] = (a2 == 4) ? cw[2 * DFF + u.pn * 128 + col] : cbias[u.pn * 128 + col]; }
            else cst[768 + (tid - 256)] = row_rstd16(rowss, u.pm * 256 + (tid - 256));
            const f32x4 cg0 = *(const f32x4*)cbg, cg1 = *(const f32x4*)(cbg + 4);
#pragma unroll
            for (int ai = 0; ai < 2; ++ai) {
                const float r3 = row_rstd16(rowss, u.pm * 256 + ai * 128 + wr * 64 + 48 + fr);
                const f32x4 g0 = acc[ai][0][3][0] * r3 + cg0, g1 = acc[ai][0][3][1] * r3 + cg1;
                if (fr >= 14) { LDSF float* x = xch + ((((wr * 2 + ai) * 4 + wc) * 2 + (fr - 14)) * 32 + 8 * fq); *(LDSF f32x4*)x = g0; *(LDSF f32x4*)(x + 4) = g1;
                    if (wr == 1 && ai == 1) { float* e = eg + ((size_t)(u.pm * 4 + 2 + (fr - 14))) * DFF + jcol; *(f32x4*)e = g0; *(f32x4*)(e + 4) = g1; } }
            }
            if (wr == 0 && fr < 2) {
                const f32x4 cv0 = *(const f32x4*)cbv, cv1 = *(const f32x4*)(cbv + 4); const float r0 = row_rstd16(rowss, u.pm * 256 + fr);
                float* e = eg + ((size_t)(u.pm * 4 + fr)) * DFF + jcol; float* v = ev + ((size_t)(u.pm * 2 + fr)) * DFF + jcol;
                *(f32x4*)e = acc[0][0][0][0] * r0 + cg0; *(f32x4*)(e + 4) = acc[0][0][0][1] * r0 + cg1;
                *(f32x4*)v = acc[0][1][0][0] * r0 + cv0; *(f32x4*)(v + 4) = acc[0][1][0][1] * r0 + cv1;
            }
        }
        asm volatile("s_waitcnt vmcnt(0) lgkmcnt(0)" ::: "memory"); __builtin_amdgcn_s_barrier(); asm volatile("" ::: "memory");
#pragma unroll
        for (int ai = 0; ai < 2; ++ai) {
            f32x4 pvv[2];
            if (ai == 0 && wr == 0) { pvv[0] = (f32x4){0.f, 0.f, 0.f, 0.f}; pvv[1] = pvv[0]; }
            else { const int swr = (wr == 1) ? 0 : 1, sai = (wr == 1) ? ai : ai - 1;
                const LDSF float* x = xch + ((((swr * 2 + sai) * 4 + wc) * 2 + (fr & 1)) * 32 + 8 * fq); pvv[0] = *(const LDSF f32x4*)x; pvv[1] = *(const LDSF f32x4*)(x + 4); }
#pragma unroll
            for (int m = 0; m < 4; ++m) {
                asm volatile("" ::: "memory");
                const int row = u.pm * 256 + ai * 128 + wr * 64 + m * 16 + fr; const float rsm = cst[768 + ai * 128 + wr * 64 + m * 16 + fr];
                u32x4 w;
#pragma unroll
                for (int n = 0; n < 2; ++n) {
                    const LDSF float* cc = cst + cih + 4 * n;
                    const f32x4 cgn = *(const LDSF f32x4*)cc, cvn = *(const LDSF f32x4*)(cc + 128);
                    const f32x4 k0 = *(const LDSF f32x4*)(cc + 256), k1 = *(const LDSF f32x4*)(cc + 384), k2 = *(const LDSF f32x4*)(cc + 512), kb = *(const LDSF f32x4*)(cc + 640);
                    const f32x4 c = acc[ai][0][m][n] * rsm + cgn, v = acc[ai][1][m][n] * rsm + cvn; float o[4];
#pragma unroll
                    for (int i = 0; i < 4; ++i) {
                        const float gm1 = DPPF(DPPF(0.f, pvv[n][i], 0x121), c[i], 0x111);
                        const float gm2 = DPPF(DPPF(0.f, pvv[n][i], 0x122), c[i], 0x112);
                        const float cvv = k0[i] * gm2 + k1[i] * gm1 + k2[i] * c[i] + kb[i];
                        o[i] = cvv * __builtin_amdgcn_rcpf(1.f + __builtin_amdgcn_exp2f(-cvv * LOG2E)) * v[i];
                    }
                    w[2 * n] = pg8::cvt_pk_bf16(o[0], o[1]); w[2 * n + 1] = pg8::cvt_pk_bf16(o[2], o[3]);
                    pvv[n] = c;
                }
                *(u32x4*)(act + (size_t)row * DFF + jcol) = w;
            }
        }
    }
};
__device__ void act_fixup(const Params& p, int l, int pm) {
    if ((pm & 15) == 0) return;
    const float* eg = (const float*)(p.ws + WS_EG); const float* ev = (const float*)(p.ws + WS_EV); bf16_t* act = (bf16_t*)(p.ws + WS_ACT);
    const float* cw = p.conv_w + (size_t)l * 3 * DFF; const float* cbias = p.conv_b + (size_t)l * DFF;
    for (int idx = TID(); idx < 2 * DFF; idx += NTHR) {
        const int r = idx / DFF, j = idx - r * DFF;
        const float a = eg[((size_t)((pm - 1) * 4 + 2)) * DFF + j], bq = eg[((size_t)((pm - 1) * 4 + 3)) * DFF + j], c0 = eg[((size_t)(pm * 4 + 0)) * DFF + j], c1 = eg[((size_t)(pm * 4 + 1)) * DFF + j];
        const float gm2 = r ? bq : a, gm1 = r ? c0 : bq, gc = r ? c1 : c0;
        const float cvv = cw[j] * gm2 + cw[DFF + j] * gm1 + cw[2 * DFF + j] * gc + cbias[j];
        act[(size_t)(pm * 256 + r) * DFF + j] = f2bf(siluf(cvv) * ev[((size_t)(pm * 2 + r)) * DFF + j]);
    }
}

__device__ void ph_prep_cum_bh(const Params& p, int l, int bh, unsigned char* lds) {
    const float* side = (const float*)(p.ws + WS_SIDE);
    float* cum = (float*)(p.ws + WS_CUM);
    LDSF float* wt = (LDSF float*)(lds + 70000);
    const int tid = TID(), lane = tid & 63, wv = tid >> 6;
    {
        const int b = bh >> 2, h = bh & 3; const float bf = p.fox_bf[l * 4 + h];
        float v[8]; float tot = 0.f;
#pragma unroll
        for (int i = 0; i < 8; ++i) { v[i] = logsigf(side[(size_t)(b * SEQ + tid * 8 + i) * 16 + h] + bf); tot += v[i]; v[i] = tot; }
        float inc = tot;
#pragma unroll
        for (int o = 1; o < 64; o <<= 1) { const float u = __shfl_up(inc, o); if (lane >= o) inc += u; }
        __syncthreads();
        if (lane == 63) wt[wv] = inc;
        __syncthreads();
        float base = inc - tot;
        for (int w8 = 0; w8 < wv; ++w8) base += wt[w8];
#pragma unroll
        for (int i = 0; i < 8; ++i) cum[bh * SEQ + tid * 8 + i] = base + v[i];
    }
}
template <int N> __device__ __forceinline__ float dotn(const float* q, const bf16_t* k) {
    float s = 0.f;
#pragma unroll
    for (int c = 0; c < N / 8; ++c) { float t[8]; load8(k + 8 * c, t);
#pragma unroll
        for (int j = 0; j < 8; ++j) s += q[8 * c + j] * t[j]; }
    return s;
}
template <int N> __device__ __forceinline__ void axpyn(float* o, float w, const bf16_t* v) {
#pragma unroll
    for (int c = 0; c < N / 8; ++c) { float t[8]; load8(v + 8 * c, t);
#pragma unroll
        for (int j = 0; j < 8; ++j) o[8 * c + j] += w * t[j]; }
}
template <int N> __device__ __forceinline__ void loadq_norm(float* q, const bf16_t* src, const float* g, float scale, bool norm) {
    float ss = 0.f;
#pragma unroll
    for (int c = 0; c < N / 8; ++c) load8(src + 8 * c, q + 8 * c);
#pragma unroll
    for (int j = 0; j < N; ++j) ss += q[j] * q[j];
    const float r = norm ? rsqrtf(ss * (1.f / N) + EPS) : 1.f;
#pragma unroll
    for (int j = 0; j < N; ++j) q[j] = q[j] * r * (norm ? g[j] : 1.f) * scale;
}
__device__ __forceinline__ void store64(bf16_t* dst, const float* o) {
#pragma unroll
    for (int c = 0; c < 8; ++c) { u32x4 w; w[0] = pk2(o[8 * c], o[8 * c + 1]); w[1] = pk2(o[8 * c + 2], o[8 * c + 3]); w[2] = pk2(o[8 * c + 4], o[8 * c + 5]); w[3] = pk2(o[8 * c + 6], o[8 * c + 7]); *(u32x4*)(dst + 8 * c) = w; }
}

typedef float f32x16 __attribute__((ext_vector_type(16)));
typedef short s16x4 __attribute__((ext_vector_type(4)));
#define LDSP __attribute__((address_space(3)))
constexpr int KSTR = 144;
constexpr int AL_KV = 17408;
constexpr int AL_BK = 2 * AL_KV  , AL_TB = AL_BK + 512  , AL_WSF = AL_TB + 512  , AL_MISC = AL_WSF + 2048  ,
              AL_IMP = 38912  , AL_SELM = AL_IMP + 65536  ,
              AL_TB4 = AL_SELM + 512  , AL_INVL = AL_TB4 + 2048  , AL_D_END = AL_INVL + 1024;
static_assert(AL_MISC + 64 <= AL_IMP && AL_D_END <= 131072, "attention LDS map");
__device__ __forceinline__ int crow(int r, int hi) { return (r & 3) + 8 * (r >> 2) + 4 * hi; }
__device__ __forceinline__ float ex2(float v) { return __builtin_amdgcn_exp2f(v); }
__device__ __forceinline__ s16x4 vtr(const LDSP unsigned char* p) { typedef short v4i16_t __attribute__((ext_vector_type(4))); return __builtin_bit_cast(s16x4, __builtin_amdgcn_ds_read_tr16_b64_v4i16((LDSP v4i16_t*)p)); }
__device__ __forceinline__ bf16x8 pack8(const f32x16& p, int b) {
    u32x4 w; w[0] = pg8::cvt_pk_bf16(p[b], p[b + 1]); w[1] = pg8::cvt_pk_bf16(p[b + 2], p[b + 3]); w[2] = pg8::cvt_pk_bf16(p[b + 4], p[b + 5]); w[3] = pg8::cvt_pk_bf16(p[b + 6], p[b + 7]);
    return __builtin_bit_cast(bf16x8, w);
}
__device__ __forceinline__ f32x16 splat16(float v) { return (f32x16){v, v, v, v, v, v, v, v, v, v, v, v, v, v, v, v}; }
template <int NK16>
__device__ __forceinline__ void qkt(f32x16& p0, f32x16& p1, const LDSP unsigned char* Kt, const bf16x8* qf, int dbase, int r32, int hi) {
    const LDSP unsigned char* kb = Kt + r32 * KSTR + hi * 16 + dbase * 32;
#pragma unroll
    for (int d0 = 0; d0 < NK16; ++d0) {
        const bf16x8 a0 = *(const LDSP bf16x8*)(kb + d0 * 32), a1 = *(const LDSP bf16x8*)(kb + 32 * KSTR + d0 * 32);
        p0 = __builtin_amdgcn_mfma_f32_32x32x16_bf16(a0, qf[d0], p0, 0, 0, 0);
        p1 = __builtin_amdgcn_mfma_f32_32x32x16_bf16(a1, qf[d0], p1, 0, 0, 0);
    }
}
__device__ __forceinline__ void pv(f32x16* o, const LDSP unsigned char* Vt, int vb, const f32x16& p0, const f32x16& p1) {
    bf16x8 pa[4]; pa[0] = pack8(p0, 0); pa[1] = pack8(p0, 8); pa[2] = pack8(p1, 0); pa[3] = pack8(p1, 8);
#pragma unroll
    for (int d0 = 0; d0 < 2; ++d0)
#pragma unroll
        for (int ks = 0; ks < 4; ++ks) {
            const s16x4 lo = vtr(Vt + vb + d0 * 4096 + ks * 1024), hh = vtr(Vt + vb + d0 * 4096 + ks * 1024 + 512);
            const bf16x8 vf = (bf16x8){lo[0], lo[1], lo[2], lo[3], hh[0], hh[1], hh[2], hh[3]};
            o[d0] = __builtin_amdgcn_mfma_f32_32x32x16_bf16(pa[ks], vf, o[d0], 0, 0, 0);
        }
}
__device__ __forceinline__ float exp_sum(f32x16& p0, f32x16& p1) {
    float s0 = 0.f, s1 = 0.f;
#pragma unroll
    for (int r = 0; r < 16; ++r) { p0[r] = ex2(p0[r]); p1[r] = ex2(p1[r]); s0 += p0[r]; s1 += p1[r]; }
    return s0 + s1;
}
__device__ __forceinline__ void scale_rows(f32x16* o, float f, LDSP float* wsf, int r32, int hi) {
    __builtin_amdgcn_wave_barrier();
    if (hi == 0) wsf[r32] = f;
    __builtin_amdgcn_s_waitcnt(0xc07f);
    __builtin_amdgcn_wave_barrier();
#pragma unroll
    for (int g = 0; g < 4; ++g) { const f32x4 a = *(const LDSP f32x4*)(wsf + 8 * g + 4 * hi);
#pragma unroll
        for (int i = 0; i < 4; ++i) { o[0][4 * g + i] *= a[i]; o[1][4 * g + i] *= a[i]; } }
    __builtin_amdgcn_wave_barrier();
}
__device__ __forceinline__ void store_o(const f32x16* o, LDSP bf16_t* stg, bf16_t* dst, int lane, int r32, int hi) {
    __builtin_amdgcn_wave_barrier();
#pragma unroll
    for (int r = 0; r < 16; ++r) { const int orow = crow(r, hi); stg[orow * 64 + r32] = f2bf(o[0][r]); stg[orow * 64 + 32 + r32] = f2bf(o[1][r]); }
    __builtin_amdgcn_s_waitcnt(0xc07f);
    __builtin_amdgcn_wave_barrier();
#pragma unroll
    for (int i = 0; i < 4; ++i) { const int row = i * 8 + (lane >> 3), ch = lane & 7; const u32x4 v = *(const LDSP u32x4*)(stg + row * 64 + ch * 8); *(u32x4*)(dst + (size_t)row * DM + ch * 8) = v; }
    __builtin_amdgcn_s_waitcnt(0xc07f);
    __builtin_amdgcn_wave_barrier();
}
template <int NG>
__device__ __forceinline__ void load_q(bf16x8* qf, const bf16_t* qrow  , const float* g, float sc, bool norm, int hi) {
    float v[4][8];
#pragma unroll
    for (int d0 = 0; d0 < 4; ++d0) load8(qrow + 16 * d0 + 8 * hi, v[d0]);
    float r0 = 1.f, r1 = 1.f;
    if (norm) {
        float s0 = 0.f, s1 = 0.f;
#pragma unroll
        for (int j = 0; j < 8; ++j) { s0 += v[0][j] * v[0][j] + v[1][j] * v[1][j]; s1 += v[2][j] * v[2][j] + v[3][j] * v[3][j]; }
        s0 += __shfl_xor(s0, 32); s1 += __shfl_xor(s1, 32);
        if (NG == 64) { r0 = rsqrtf((s0 + s1) * (1.f / 64.f) + EPS); r1 = r0; } else { r0 = rsqrtf(s0 * (1.f / 32.f) + EPS); r1 = rsqrtf(s1 * (1.f / 32.f) + EPS); }
    }
#pragma unroll
    for (int d0 = 0; d0 < 4; ++d0) {
        const float rr = (d0 < 2 ? r0 : r1) * sc; float w[8];
#pragma unroll
        for (int j = 0; j < 8; ++j) { const int d = 16 * d0 + 8 * hi + j; w[j] = v[d0][j] * rr * (norm ? g[d % NG] : 1.f); }
        u32x4 u; u[0] = pg8::cvt_pk_bf16(w[0], w[1]); u[1] = pg8::cvt_pk_bf16(w[2], w[3]); u[2] = pg8::cvt_pk_bf16(w[4], w[5]); u[3] = pg8::cvt_pk_bf16(w[6], w[7]);
        qf[d0] = __builtin_bit_cast(bf16x8, u);
    }
}
__device__ __forceinline__ void kv_load(u32x4& kr, u32x4& vr, const bf16_t* Kb, const bf16_t* Vb, int k0, int tid) {
    const size_t off = (size_t)(k0 + (tid >> 3)) * PINP + (tid & 7) * 8;
    kr = *(const u32x4*)(Kb + off); vr = *(const u32x4*)(Vb + off);
}
__device__ __forceinline__ void kv_load64(u32x4& kr, u32x4& vr, const bf16_t* Kb, const bf16_t* Vb, int n0, int tid) {
    const size_t off = (size_t)(n0 + (tid >> 3)) * 64 + (tid & 7) * 8;
    kr = *(const u32x4*)(Kb + off); vr = *(const u32x4*)(Vb + off);
}
__device__ __forceinline__ void kv_store(const u32x4& kr, const u32x4& vr, LDSP unsigned char* buf, int tid) {
    const int key = tid >> 3, ch = tid & 7;
    *(LDSP u32x4*)(buf + key * KSTR + ch * 16) = kr;
    *(LDSP u32x4*)(buf + 9216 + (ch >> 2) * 4096 + (key >> 4) * 1024 + ((key >> 3) & 1) * 512 + (key & 7) * 64 + (ch & 3) * 16) = vr;
}
template <int NG>
__device__ __forceinline__ void knorm_chunk(u32x4& kr, const float* gp  ) {
    float v[8];
    v[0] = bf2f(kr[0] & 0xffff); v[1] = bf2f(kr[0] >> 16); v[2] = bf2f(kr[1] & 0xffff); v[3] = bf2f(kr[1] >> 16);
    v[4] = bf2f(kr[2] & 0xffff); v[5] = bf2f(kr[2] >> 16); v[6] = bf2f(kr[3] & 0xffff); v[7] = bf2f(kr[3] >> 16);
    float ss = 0.f;
#pragma unroll
    for (int j = 0; j < 8; ++j) ss += v[j] * v[j];
    ss += __shfl_xor(ss, 1); ss += __shfl_xor(ss, 2); if (NG == 64) ss += __shfl_xor(ss, 4);
    const float r = rsqrtf(ss * (1.f / NG) + EPS);
    const f32x4 ga = *(const f32x4*)gp, gb = *(const f32x4*)(gp + 4);
    kr[0] = pg8::cvt_pk_bf16(v[0] * r * ga[0], v[1] * r * ga[1]); kr[1] = pg8::cvt_pk_bf16(v[2] * r * ga[2], v[3] * r * ga[3]);
    kr[2] = pg8::cvt_pk_bf16(v[4] * r * gb[0], v[5] * r * gb[1]); kr[3] = pg8::cvt_pk_bf16(v[6] * r * gb[2], v[7] * r * gb[3]);
}
__device__ __forceinline__ void bias_near(f32x16& p0, f32x16& p1, const LDSP float* tbl, int tk0  , int wnd, bool rowok, int hi) {
#pragma unroll
    for (int g = 0; g < 4; ++g) {
#pragma unroll
        for (int i = 0; i < 4; ++i) { const int r = 4 * g + i; const int d0_ = tk0 - crow(r, hi), d1_ = d0_ - 32;
            const float b0 = tbl[min(max(d0_, 0), 127)], b1 = tbl[min(max(d1_, 0), 127)];
            p0[r] = (d0_ < 0 || d0_ >= wnd || !rowok) ? -INFINITY : p0[r] + b0; p1[r] = (d1_ < 0 || d1_ >= wnd || !rowok) ? -INFINITY : p1[r] + b1; }
        asm volatile("" ::: "memory");
    }
}
#define KVBUF(L, i) ((L) + ((i) & 1) * AL_KV)

__device__ void fa_fox_unit(const Params& p, int l, int b, int h, int qb, LDSP unsigned char* L) {
    const int tid = TID(), lane = tid & 63, wid = __builtin_amdgcn_readfirstlane(tid >> 6), r32 = lane & 31, hi = lane >> 5;
    const bf16_t* proj = (const bf16_t*)(p.ws + WS_PROJ); bf16_t* mix = (bf16_t*)(p.ws + WS_MIX);
    const size_t rb = (size_t)b * SEQ; const int q0 = qb * 256, qw = q0 + 32 * wid, t = qw + r32;
    const bf16_t* Kb = proj + rb * PINP + CB_K + 64 * h; const bf16_t* Vb = proj + rb * PINP + CB_V + 64 * h;
    const float* cm = (const float*)(p.ws + WS_CUM) + (b * 4 + h) * SEQ;
    LDSP float* wsf = (LDSP float*)(L + AL_WSF) + wid * 64; LDSP float* bk = (LDSP float*)(L + AL_BK);
    const int vb = 9216 + ((lane >> 4) & 1) * 32 + (lane & 3) * 8 + (4 * hi + ((lane & 15) >> 2)) * 64;
    bf16x8 qf[4]; load_q<64>(qf, proj + (rb + t) * PINP + CB_Q + 64 * h, p.fox_qn + l * 64, 0.125f * LOG2E, true, hi);
    const float rowc = cm[t] * LOG2E - ((const float*)(p.ws + WS_BND))[l * 32 + 4];
    f32x16 o[2]; o[0] = (f32x16){}; o[1] = (f32x16){};
    float l_run = 0.f;
    const int NT = 4 * qb + 4, jd = 4 * qb + (wid >> 1);
    u32x4 kr, vr; float cr = 0.f; const float* gk = p.fox_kn + l * 64 + (tid & 7) * 8;
    int js;
    {   const bool live = (lane < NT) ? ((cm[q0] - cm[64 * lane + 63]) * LOG2E >= -160.f) : false;
        const unsigned long long bm = __ballot(live);
        js = __builtin_amdgcn_readfirstlane((int)__builtin_ctzll(bm | (1ull << (NT - 1)))); if (js > NT - 2) js = NT - 2; }
    __syncthreads();
    kv_load(kr, vr, Kb, Vb, 64 * js, tid); if (tid < 64) cr = cm[64 * js + tid];
    kv_store(kr, vr, KVBUF(L, js), tid); if (tid < 64) bk[(js & 1) * 64 + tid] = -cr * LOG2E;
    kv_load(kr, vr, Kb, Vb, 64 * (js + 1), tid); if (tid < 64) cr = cm[64 * (js + 1) + tid];
    for (int j = js; j < NT; ++j) {
        __syncthreads();
        if (j + 1 < NT) { kv_store(kr, vr, KVBUF(L, j + 1), tid); if (tid < 64) bk[((j + 1) & 1) * 64 + tid] = -cr * LOG2E; }
        if (j + 2 < NT) { kv_load(kr, vr, Kb, Vb, 64 * (j + 2), tid); if (tid < 64) cr = cm[64 * (j + 2) + tid]; }
        if (j <= jd) {
            const LDSP unsigned char* buf = KVBUF(L, j); const LDSP float* bkj = bk + (j & 1) * 64;
            f32x16 p0, p1;
#pragma unroll
            for (int g = 0; g < 4; ++g) { const f32x4 b0 = *(const LDSP f32x4*)(bkj + 8 * g + 4 * hi), b1 = *(const LDSP f32x4*)(bkj + 32 + 8 * g + 4 * hi);
#pragma unroll
                for (int i = 0; i < 4; ++i) { p0[4 * g + i] = b0[i] + rowc; p1[4 * g + i] = b1[i] + rowc; } }
            qkt<4>(p0, p1, buf, qf, 0, r32, hi);
            if (j == jd) { const int k0 = 64 * j;
#pragma unroll
                for (int r = 0; r < 16; ++r) { const int kk = k0 + crow(r, hi); if (kk > t) p0[r] = -INFINITY; if (kk + 32 > t) p1[r] = -INFINITY; } }
            l_run += exp_sum(p0, p1);
            pv(o, buf, vb, p0, p1);
        }
    }
    l_run += __shfl_xor(l_run, 32);
    scale_rows(o, 1.f / l_run, wsf, r32, hi);
    store_o(o, (LDSP bf16_t*)(L + AL_IMP + wid * 8192), mix + (rb + qw) * DM + 256 + 64 * h, lane, r32, hi);
}

__device__ void fa_diff_unit(const Params& p, int l, int b, int h, int qb, LDSP unsigned char* L) {
    const int tid = TID(), lane = tid & 63, wid = __builtin_amdgcn_readfirstlane(tid >> 6), r32 = lane & 31, hi = lane >> 5;
    const bf16_t* proj = (const bf16_t*)(p.ws + WS_PROJ); bf16_t* mix = (bf16_t*)(p.ws + WS_MIX);
    const size_t rb = (size_t)b * SEQ; const int q0 = qb * 256, qw = q0 + 32 * wid, t = qw + r32;
    const bf16_t* Kb = proj + rb * PINP + CA_K + 64 * h; const bf16_t* Vb = proj + rb * PINP + CA_V + 64 * h;
    LDSP float* wsf = (LDSP float*)(L + AL_WSF) + wid * 64; LDSP float* tbl = (LDSP float*)(L + AL_TB);
    const int vb = 9216 + ((lane >> 4) & 1) * 32 + (lane & 3) * 8 + (4 * hi + ((lane & 15) >> 2)) * 64;
    const float lam = ((const float*)(p.ws + WS_LAM))[l]; const float lam_init = 0.8f - 0.6f * __expf(-0.3f * (float)l);
    const float nbound = -((const float*)(p.ws + WS_BND))[l * 32 + h];
    __syncthreads();
    if (tid < 128) tbl[tid] = ((const float*)(p.ws + WS_TB))[h * 128 + tid] * LOG2E;
    bf16x8 qf[4]; load_q<32>(qf, proj + (rb + t) * PINP + CA_Q + 64 * h, p.diff_qn + l * 32, 0.17677669529663687f * LOG2E, true, hi);
    f32x16 o1[2], o2[2]; o1[0] = (f32x16){}; o1[1] = (f32x16){}; o2[0] = (f32x16){}; o2[1] = (f32x16){};
    float l1 = 0.f, l2 = 0.f;
    const int NT = 4 * qb + 4, jd = 4 * qb + (wid >> 1);
    u32x4 kr, vr; const float* gk = p.diff_kn + l * 32 + (tid & 3) * 8;
    kv_load(kr, vr, Kb, Vb, 0, tid);
    kv_store(kr, vr, KVBUF(L, 0), tid);
    kv_load(kr, vr, Kb, Vb, 64, tid);
    for (int j = 0; j < NT; ++j) {
        __syncthreads();
        if (j + 1 < NT) { kv_store(kr, vr, KVBUF(L, j + 1), tid); }
        if (j + 2 < NT) kv_load(kr, vr, Kb, Vb, 64 * (j + 2), tid);
        if (j <= jd) {
            const LDSP unsigned char* buf = KVBUF(L, j);
            const int k0 = 64 * j; const bool nearb = (qw - (k0 + 63)) < 113; const float cfar = tbl[127] + nbound;
#pragma unroll
            for (int mp = 0; mp < 2; ++mp) {
                f32x16 p0 = splat16(nearb ? nbound : cfar), p1 = p0;
                qkt<2>(p0, p1, buf, qf + 2 * mp, 2 * mp, r32, hi);
                if (nearb) bias_near(p0, p1, tbl, t - k0, 1 << 30, true, hi);
                if (mp == 0) { l1 += exp_sum(p0, p1); pv(o1, buf, vb, p0, p1); }
                else { l2 += exp_sum(p0, p1); pv(o2, buf, vb, p0, p1); }
            }
        }
    }
    l1 += __shfl_xor(l1, 32); l2 += __shfl_xor(l2, 32);
    scale_rows(o1, 1.f / l1, wsf, r32, hi); scale_rows(o2, lam / l2, wsf, r32, hi);
    o1[0] -= o2[0]; o1[1] -= o2[1];
    const float g0 = p.diff_sub[l * 64 + r32] * (1.f - lam_init), g1 = p.diff_sub[l * 64 + 32 + r32] * (1.f - lam_init);
#pragma unroll
    for (int r = 0; r < 16; ++r) {
        float ss = o1[0][r] * o1[0][r] + o1[1][r] * o1[1][r];
        ss += __shfl_xor(ss, 1); ss += __shfl_xor(ss, 2); ss += __shfl_xor(ss, 4); ss += __shfl_xor(ss, 8); ss += __shfl_xor(ss, 16);
        const float rs = rsqrtf(ss * (1.f / 64.f) + EPS); o1[0][r] *= rs * g0; o1[1][r] *= rs * g1;
    }
    store_o(o1, (LDSP bf16_t*)(L + AL_IMP + wid * 8192), mix + (rb + qw) * DM + 0 + 64 * h, lane, r32, hi);
}

template <bool DIAG>
__device__ __forceinline__ void stick_sub(f32x16& y, float& carry, int kbase  , int t, int hi) {
    float lk[16];
#pragma unroll
    for (int r = 0; r < 16; ++r) {
        const float v = y[r]; const float e = ex2(-fabsf(v)); const float lb = fminf(v, 0.f) - __builtin_amdgcn_logf(1.f + e);
        if (DIAG) { const bool valid = (kbase + crow(r, hi) < t); lk[r] = valid ? (lb - v) : 0.f; y[r] = valid ? lb : -INFINITY; }
        else { lk[r] = lb - v; y[r] = lb; }
    }
    float T[4], Go[4];
#pragma unroll
    for (int g = 0; g < 4; ++g) { const float Gs = (lk[4 * g] + lk[4 * g + 1]) + (lk[4 * g + 2] + lk[4 * g + 3]); Go[g] = __shfl_xor(Gs, 32); T[g] = Gs + Go[g]; }
    float sx = 0.f;
#pragma unroll
    for (int g = 3; g >= 0; --g) {
        float tail = carry + sx + (hi == 0 ? Go[g] : 0.f);
#pragma unroll
        for (int i = 3; i >= 0; --i) { y[4 * g + i] = ex2(y[4 * g + i] + tail); tail += lk[4 * g + i]; }
        sx += T[g];
    }
    carry += sx;
}
__device__ void fa_stick_unit(const Params& p, int l, int b, int h, int qb, LDSP unsigned char* L) {
    const int tid = TID(), lane = tid & 63, wid = __builtin_amdgcn_readfirstlane(tid >> 6), r32 = lane & 31, hi = lane >> 5;
    const bf16_t* proj = (const bf16_t*)(p.ws + WS_PROJ); bf16_t* mix = (bf16_t*)(p.ws + WS_MIX);
    const size_t rb = (size_t)b * SEQ; const int q0 = qb * 256, qw = q0 + 32 * wid, t = qw + r32;
    const bf16_t* Kb = proj + rb * PINP + CC_K + 64 * h; const bf16_t* Vb = proj + rb * PINP + CC_V + 64 * h;
    const int vb = 9216 + ((lane >> 4) & 1) * 32 + (lane & 3) * 8 + (4 * hi + ((lane & 15) >> 2)) * 64;
    bf16x8 qf[4]; load_q<64>(qf, proj + (rb + t) * PINP + CC_Q + 64 * h, nullptr, 0.125f * LOG2E, false, hi);
    f32x16 o[2]; o[0] = (f32x16){}; o[1] = (f32x16){};
    float carry = 0.f;
    const int NT = 4 * qb + 4, jd = 4 * qb + (wid >> 1);
    u32x4 kr, vr;
#define SBUF(i) (((i) & 1) ? (L + 108544) : L)
    LDSP unsigned* dn = (LDSP unsigned*)(L + AL_MISC) + 8;
    bool wdone = false;
    __syncthreads();
    if (lane == 0) dn[wid] = 0u;
    kv_load(kr, vr, Kb, Vb, 64 * (NT - 1), tid);
    kv_store(kr, vr, SBUF(NT - 1), tid);
    kv_load(kr, vr, Kb, Vb, 64 * (NT - 2), tid);
    for (int j = NT - 1; j >= 0; --j) {
        __syncthreads();
        if (__all(dn[lane & 7] != 0u)) break;
        if (j >= 1) kv_store(kr, vr, SBUF(j - 1), tid);
        if (j >= 2) kv_load(kr, vr, Kb, Vb, 64 * (j - 2), tid);
        if (j <= jd && !wdone) {
            const LDSP unsigned char* buf = SBUF(j);
            f32x16 p0 = (f32x16){}, p1 = (f32x16){};
            qkt<4>(p0, p1, buf, qf, 0, r32, hi);
            const int k0 = 64 * j; const bool diag = (j == jd);
            if (diag) { stick_sub<true>(p1, carry, k0 + 32, t, hi); stick_sub<true>(p0, carry, k0, t, hi); }
            else { stick_sub<false>(p1, carry, k0 + 32, t, hi); stick_sub<false>(p0, carry, k0, t, hi); }
            pv(o, buf, vb, p0, p1);
            if (__all(carry < -160.f)) { wdone = true; if (lane == 0) dn[wid] = 1u; }
        }
    }
    store_o(o, (LDSP bf16_t*)(L + AL_IMP + wid * 8192), mix + (rb + qw) * DM + 512 + 64 * h, lane, r32, hi);
}

__device__ void fa_nsa_unit(const Params& p, int l, int b, int u, LDSP unsigned char* L) {
    const int tid = TID(), lane = tid & 63, wid = __builtin_amdgcn_readfirstlane(tid >> 6), r32 = lane & 31, hi = lane >> 5;
    const int hh = wid >> 1, sub = wid & 1;
    const bf16_t* proj = (const bf16_t*)(p.ws + WS_PROJ); bf16_t* mix = (bf16_t*)(p.ws + WS_MIX);
    const size_t rb = (size_t)b * SEQ; const int q0 = 64 * u, qw = q0 + 32 * sub, t = qw + r32; const int ql = 32 * sub + r32;
    LDSP float* wsf = (LDSP float*)(L + AL_WSF) + wid * 64; LDSP float* tbl = (LDSP float*)(L + AL_TB4) + hh * 128;
    LDSP float* imp = (LDSP float*)(L + AL_IMP); LDSP unsigned* selm = (LDSP unsigned*)(L + AL_SELM); LDSP float* invl = (LDSP float*)(L + AL_INVL);
    LDSP float* ofl = (LDSP float*)(L + AL_IMP) + wid * 2048 + lane;
    const int vb = 9216 + ((lane >> 4) & 1) * 32 + (lane & 3) * 8 + (4 * hi + ((lane & 15) >> 2)) * 64;
    const float* bnd = (const float*)(p.ws + WS_BND) + l * 32;
    __syncthreads();
    ((LDSP float*)(L + AL_TB4))[tid] = ((const float*)(p.ws + WS_TB))[512 + tid] * LOG2E;
    bf16x8 qf[4]; load_q<64>(qf, proj + (rb + t) * PINP + CD_Q + 64 * hh, p.nsa_qn + l * 64, 0.125f * LOG2E, true, hi);
    const float* sd = (const float*)(p.ws + WS_SIDE) + (rb + t) * 16 + 4 + hh;
    const float gc = 1.f / (1.f + __expf(-sd[0])), gs = 1.f / (1.f + __expf(-sd[4])), gwn = 1.f / (1.f + __expf(-sd[8]));
    f32x16 o[2]; o[0] = (f32x16){}; o[1] = (f32x16){};
    u32x4 kr, vr;
    {
        const bf16_t* Kc = (const bf16_t*)(p.ws + WS_KC) + (size_t)b * 256 * 64; const bf16_t* Vc = (const bf16_t*)(p.ws + WS_VC) + (size_t)b * 256 * 64;
        const int ntc = (4 * u + 2) / 64 + 1; const float nbound = -bnd[5 + hh];
        float l_run = 0.f, prevE3 = 0.f;
        kv_load64(kr, vr, Kc, Vc, 0, tid);
        kv_store(kr, vr, KVBUF(L, 0), tid);
        if (ntc > 1) kv_load64(kr, vr, Kc, Vc, 64, tid);
        for (int T = 0; T < ntc; ++T) {
            __syncthreads();
            if (T + 1 < ntc) kv_store(kr, vr, KVBUF(L, T + 1), tid);
            if (T + 2 < ntc) kv_load64(kr, vr, Kc, Vc, 64 * (T + 2), tid);
            const LDSP unsigned char* buf = KVBUF(L, T);
            f32x16 p0 = splat16(nbound), p1 = p0;
            qkt<4>(p0, p1, buf, qf, 0, r32, hi);
#pragma unroll
            for (int g = 0; g < 4; ++g) {
#pragma unroll
                for (int i = 0; i < 4; ++i) { const int r = 4 * g + i; const int d0_ = t - 16 * (64 * T + crow(r, hi)) - 31, d1_ = d0_ - 512;
                    const float b0 = tbl[min(max(d0_, 0), 127)], b1 = tbl[min(max(d1_, 0), 127)];
                    p0[r] = (d0_ < 0) ? -INFINITY : p0[r] + b0; p1[r] = (d1_ < 0) ? -INFINITY : p1[r] + b1; }
                asm volatile("" ::: "memory");
            }
            l_run += exp_sum(p0, p1);
#pragma unroll
            for (int s2 = 0; s2 < 2; ++s2) {
                float G[4], Eo[4];
#pragma unroll
                for (int g = 0; g < 4; ++g) { const float a0 = s2 ? p1[4 * g] : p0[4 * g], a1 = s2 ? p1[4 * g + 1] : p0[4 * g + 1], a2 = s2 ? p1[4 * g + 2] : p0[4 * g + 2], a3 = s2 ? p1[4 * g + 3] : p0[4 * g + 3];
                    G[g] = (a0 + a1) + (a2 + a3); Eo[g] = __shfl_xor(a3, 32); }
#pragma unroll
                for (int g = 0; g < 4; ++g) { const float eprev = hi ? Eo[g] : (g > 0 ? Eo[g - 1] : prevE3);
                    imp[(hh * 64 + ql) * 64 + 16 * T + 8 * s2 + 2 * g + hi] = G[g] + eprev; }
                prevE3 = Eo[3];
            }
            pv(o, buf, vb, p0, p1);
        }
        l_run += __shfl_xor(l_run, 32);
        const float inv = (l_run > 0.f) ? 1.f / l_run : 0.f;
        if (hi == 0) invl[hh * 64 + ql] = inv;
        scale_rows(o, gc * inv, wsf, r32, hi);
    }
    __syncthreads();
    {
        const int q = tid >> 3, part = tid & 7;
        const float i0 = invl[q], i1 = invl[64 + q], i2 = invl[128 + q], i3 = invl[192 + q];
        float vj[8];
#pragma unroll
        for (int jj = 0; jj < 8; ++jj) { const int j = part * 8 + jj;
            const float sum = ((imp[(0 * 64 + q) * 64 + j] * i0 + imp[(1 * 64 + q) * 64 + j] * i1) + imp[(2 * 64 + q) * 64 + j] * i2) + imp[(3 * 64 + q) * 64 + j] * i3;
            vj[jj] = (j > u) ? -1.0f : ((j == u || j == 0) ? 1.0e4f : sum); }
        __syncthreads();
#pragma unroll
        for (int jj = 0; jj < 8; ++jj) imp[q * 64 + part * 8 + jj] = vj[jj];
        __syncthreads();
        int rank[8];
#pragma unroll
        for (int jj = 0; jj < 8; ++jj) rank[jj] = 0;
        for (int i = 0; i < 64; ++i) { const float vi = imp[q * 64 + i];
#pragma unroll
            for (int jj = 0; jj < 8; ++jj) rank[jj] += (vi > vj[jj] || (vi == vj[jj] && i < part * 8 + jj)) ? 1 : 0; }
        unsigned bits = 0;
#pragma unroll
        for (int jj = 0; jj < 8; ++jj) if (rank[jj] < 16 && (part * 8 + jj) <= u) bits |= 1u << jj;
        unsigned mlo = (part < 4) ? (bits << (8 * part)) : 0u, mhi = (part >= 4) ? (bits << (8 * (part - 4))) : 0u;
        mlo |= __shfl_xor(mlo, 1); mhi |= __shfl_xor(mhi, 1); mlo |= __shfl_xor(mlo, 2); mhi |= __shfl_xor(mhi, 2); mlo |= __shfl_xor(mlo, 4); mhi |= __shfl_xor(mhi, 4);
        if (part == 0) { selm[2 * q] = mlo; selm[2 * q + 1] = mhi; }
    }
    __syncthreads();
#pragma unroll
    for (int r = 0; r < 16; ++r) { ofl[(2 * r) * 64] = o[0][r]; ofl[(2 * r + 1) * 64] = o[1][r]; }
    o[0] = (f32x16){}; o[1] = (f32x16){};
    {
        const unsigned long long mymask = (unsigned long long)selm[2 * ql] | ((unsigned long long)selm[2 * ql + 1] << 32);
        unsigned ulo = selm[2 * lane], uhi = selm[2 * lane + 1];
#pragma unroll
        for (int s2 = 1; s2 < 64; s2 <<= 1) { ulo |= __shfl_xor(ulo, s2); uhi |= __shfl_xor(uhi, s2); }
        unsigned long long um = (unsigned long long)(unsigned)__builtin_amdgcn_readfirstlane((int)ulo) | ((unsigned long long)(unsigned)__builtin_amdgcn_readfirstlane((int)uhi) << 32);
        const bf16_t* Kb = proj + rb * PINP + CD_KS; const bf16_t* Vb = proj + rb * PINP + CD_VS;
        float l_run = 0.f; const float nbound = -bnd[9 + hh]; const float cfar = tbl[127] + nbound; const float* gk = p.nsa_kn + (l * 3 + 1) * 64 + (tid & 7) * 8;
        int j = __builtin_ctzll(um); um &= um - 1;
        int jn = um ? __builtin_ctzll(um) : -1; um &= um - 1;
        kv_load(kr, vr, Kb, Vb, 64 * j, tid);
        kv_store(kr, vr, KVBUF(L, 0), tid);
        if (jn >= 0) kv_load(kr, vr, Kb, Vb, 64 * jn, tid);
        for (int it = 0;; ++it) {
            __syncthreads();
            const int jnn = um ? __builtin_ctzll(um) : -1; um &= um - 1;
            if (jn >= 0) { kv_store(kr, vr, KVBUF(L, it + 1), tid); }
            if (jnn >= 0) kv_load(kr, vr, Kb, Vb, 64 * jnn, tid);
            const bool mine = (mymask >> j) & 1ull;
            if (__any(mine)) {
                const LDSP unsigned char* buf = KVBUF(L, it);
                const int k0 = 64 * j; const bool nearb = (qw - (k0 + 63)) < 113;
                f32x16 p0 = splat16(nearb ? nbound : (mine ? cfar : -INFINITY)), p1 = p0;
                qkt<4>(p0, p1, buf, qf, 0, r32, hi);
                if (nearb) bias_near(p0, p1, tbl, t - k0, 1 << 30, mine, hi);
                l_run += exp_sum(p0, p1);
                pv(o, buf, vb, p0, p1);
            }
            if (jn < 0) break;
            j = jn; jn = jnn;
        }
        l_run += __shfl_xor(l_run, 32);
        scale_rows(o, gs / l_run, wsf, r32, hi);
#pragma unroll
        for (int r = 0; r < 16; ++r) { ofl[(2 * r) * 64] += o[0][r]; ofl[(2 * r + 1) * 64] += o[1][r]; }
        o[0] = (f32x16){}; o[1] = (f32x16){};
    }
    {
        const bf16_t* Kb = proj + rb * PINP + CD_KW; const bf16_t* Vb = proj + rb * PINP + CD_VW;
        float l_run = 0.f; const float nbound = -bnd[13 + hh]; const float cfar = tbl[127] + nbound; const float* gk = p.nsa_kn + (l * 3 + 2) * 64 + (tid & 7) * 8;
        const int jlo = max(0, u - 8);
        __syncthreads();
        kv_load(kr, vr, Kb, Vb, 64 * jlo, tid);
        kv_store(kr, vr, KVBUF(L, jlo), tid);
        if (jlo < u) kv_load(kr, vr, Kb, Vb, 64 * (jlo + 1), tid);
        for (int j = jlo; j <= u; ++j) {
            __syncthreads();
            if (j + 1 <= u) { kv_store(kr, vr, KVBUF(L, j + 1), tid); }
            if (j + 2 <= u) kv_load(kr, vr, Kb, Vb, 64 * (j + 2), tid);
            const LDSP unsigned char* buf = KVBUF(L, j);
            const int k0 = 64 * j; const bool nearb = (j == u || j == u - 8 || (qw - (k0 + 63)) < 113);
            f32x16 p0 = splat16(nearb ? nbound : cfar), p1 = p0;
            qkt<4>(p0, p1, buf, qf, 0, r32, hi);
            if (nearb) bias_near(p0, p1, tbl, t - k0, 512, true, hi);
            l_run += exp_sum(p0, p1);
            pv(o, buf, vb, p0, p1);
        }
        l_run += __shfl_xor(l_run, 32);
        scale_rows(o, gwn / l_run, wsf, r32, hi);
#pragma unroll
        for (int r = 0; r < 16; ++r) { o[0][r] += ofl[(2 * r) * 64]; o[1][r] += ofl[(2 * r + 1) * 64]; }
    }
    store_o(o, (LDSP bf16_t*)(L + AL_IMP + wid * 8192), mix + (rb + qw) * DM + 768 + 64 * hh, lane, r32, hi);
}

__device__ void ph_reset_queues(const Params& p) { unsigned* ctl = (unsigned*)(p.ws + WS_CTL); const int gt = GTID(); if (gt < 8) ctl[gt] = 0u; }
__device__ void prep_cmp_task(const Params& p, int l, int task, LDSP unsigned char* L) {
    const int tid = TID(), lane = tid & 63, wid = __builtin_amdgcn_readfirstlane(tid >> 6), r32 = lane & 31, hi = lane >> 5;
    const int b = task >> 4, which = (task >> 3) & 1, nt = task & 7;
    const bf16_t* proj = (const bf16_t*)(p.ws + WS_PROJ);
    const bf16_t* phiT = (const bf16_t*)(p.ws + WS_PHIT) + (size_t)(l * 2 + which) * 64 * 2048;
    const float* pe = p.nsa_pe + (size_t)(l * 2 + which) * 32 * 64;
    const int n = 32 * nt + r32, colbase = which ? CD_VC : CD_KC;
    f32x16 acc0 = (f32x16){}, acc1 = (f32x16){};
#pragma unroll
    for (int ii = 0; ii < 4; ++ii) {
        const int i = 4 * wid + ii; const int tok = min(16 * n + i, SEQ - 1);
        const bf16_t* xr = proj + (size_t)(b * SEQ + tok) * PINP + colbase;
#pragma unroll
        for (int d0 = 0; d0 < 4; ++d0) {
            float xv[8]; load8(xr + 16 * d0 + 8 * hi, xv);
            const f32x4 pe0 = *(const f32x4*)(pe + i * 64 + 16 * d0 + 8 * hi), pe1 = *(const f32x4*)(pe + i * 64 + 16 * d0 + 8 * hi + 4);
            u32x4 aw; aw[0] = pg8::cvt_pk_bf16(xv[0] + pe0[0], xv[1] + pe0[1]); aw[1] = pg8::cvt_pk_bf16(xv[2] + pe0[2], xv[3] + pe0[3]);
            aw[2] = pg8::cvt_pk_bf16(xv[4] + pe1[0], xv[5] + pe1[1]); aw[3] = pg8::cvt_pk_bf16(xv[6] + pe1[2], xv[7] + pe1[3]);
            const bf16x8 af = __builtin_bit_cast(bf16x8, aw);
            const bf16x8 b0 = *(const bf16x8*)(phiT + (size_t)r32 * 2048 + i * 64 + 16 * d0 + 8 * hi);
            const bf16x8 b1 = *(const bf16x8*)(phiT + (size_t)(32 + r32) * 2048 + i * 64 + 16 * d0 + 8 * hi);
            acc0 = __builtin_amdgcn_mfma_f32_32x32x16_bf16(af, b0, acc0, 0, 0, 0);
            acc1 = __builtin_amdgcn_mfma_f32_32x32x16_bf16(af, b1, acc1, 0, 0, 0);
        }
    }
    LDSP float* red = (LDSP float*)L;
    __syncthreads();
#pragma unroll
    for (int r = 0; r < 16; ++r) { red[(wid * 32 + crow(r, hi)) * 64 + r32] = acc0[r]; red[(wid * 32 + crow(r, hi)) * 64 + 32 + r32] = acc1[r]; }
    __syncthreads();
    {
        const int row = tid >> 4, e4 = (tid & 15) * 4; f32x4 v = (f32x4){0.f, 0.f, 0.f, 0.f};
#pragma unroll
        for (int w8 = 0; w8 < 8; ++w8) v += *(const LDSP f32x4*)(red + (w8 * 32 + row) * 64 + e4);
        const int nn = 32 * nt + row;
        if (which == 0) {
            float ss = (v[0] * v[0] + v[1] * v[1]) + (v[2] * v[2] + v[3] * v[3]);
            ss += __shfl_xor(ss, 1); ss += __shfl_xor(ss, 2); ss += __shfl_xor(ss, 4); ss += __shfl_xor(ss, 8);
            const float rs = rsqrtf(ss * (1.f / 64.f) + EPS); const f32x4 g = *(const f32x4*)(p.nsa_kn + (l * 3 + 0) * 64 + e4);
            v = v * rs * g;
        }
        uint2 o; o.x = pk2(v[0], v[1]); o.y = pk2(v[2], v[3]);
        if (nn >= 255) { o.x = 0u; o.y = 0u; }
        *(uint2*)((bf16_t*)(p.ws + (which ? WS_VC : WS_KC)) + (size_t)(b * 256 + nn) * 64 + e4) = o;
    }
}
__device__ void ph_prep(const Params& p, int l, LDSP unsigned char* L, unsigned char* lds) {
    for (int t = blockIdx.x; t < 80; t += gridDim.x) { if (t < 64) prep_cmp_task(p, l, t, L); }
    if (gridDim.x >= 80) { if (blockIdx.x >= 64 && blockIdx.x < 80) ph_prep_cum_bh(p, l, blockIdx.x - 64, lds); }
    else for (int bh = blockIdx.x; bh < 16; bh += gridDim.x) ph_prep_cum_bh(p, l, bh, lds);
}


__device__ void fa_phase_all(const Params& p, int l, LDSP unsigned char* L, unsigned char* lds, int qslot, int n_conv  ) {
    unsigned* ctl = (unsigned*)(p.ws + WS_CTL);
    LDSP unsigned* misc = (LDSP unsigned*)(L + AL_MISC);
    bool prep_ok = false;
    for (;;) {
        __syncthreads();
        if (threadIdx.x == 0) misc[0] = atomicAdd(&ctl[qslot], 1u);
        __syncthreads();
        const unsigned qi0 = misc[0];
        if (qi0 >= 1104u + (unsigned)n_conv) break;
        if (qi0 >= 1104u) {
            const int it = ((int)qi0 - 1104) * 8 + (TID() >> 6);
            if (it < CV_ITEMS) convert_item(p, l + 1, it, (LDSF float*)lds + (TID() >> 6) * (64 * 65), TID() & 63);
            continue;
        }
        if (qi0 < 80u) {
            if (qi0 < 64u) prep_cmp_task(p, l, (int)qi0, L); else ph_prep_cum_bh(p, l, (int)qi0 - 64, lds);
            asm volatile("s_waitcnt vmcnt(0)" ::: "memory");
            __syncthreads();
            if (threadIdx.x == 0) { __threadfence(); atomicAdd(&ctl[4 + qslot], 1u); }
            continue;
        }
        const unsigned qi = qi0 - 80u;
        int r, typ, sub;
        if (qi < 768u) { r = 15 - (int)(qi / 48u); const int j = (int)(qi % 48u); typ = j >> 4; typ = (typ == 0) ? 0 : (typ == 1 ? 2 : 3); sub = j & 15; }
        else { const int v = (int)qi - 768; r = 15 - (v >> 4); typ = 1; sub = v & 15; }
        if ((typ == 2 || typ == 3) && !prep_ok) {
            if (threadIdx.x == 0) { while (__hip_atomic_load(&ctl[4 + qslot], __ATOMIC_RELAXED, __HIP_MEMORY_SCOPE_AGENT) < 80u) __builtin_amdgcn_s_sleep(8); __threadfence(); }
            asm volatile("s_waitcnt vmcnt(0)" ::: "memory");
            __syncthreads();
            prep_ok = true;
        }
        if (typ == 0) fa_diff_unit(p, l, sub >> 2, sub & 3, r, L);
        else if (typ == 1) fa_stick_unit(p, l, sub >> 2, sub & 3, r, L);
        else if (typ == 2) fa_fox_unit(p, l, sub >> 2, sub & 3, r, L);
        else fa_nsa_unit(p, l, sub >> 2, 4 * r + (sub & 3), L);
    }
}

#define XB_TMO      128
#define XB_XCNT(j)  (256  + 64 * (j))
#define XB_XSUB(j)  (1280 + 64 * (j))
#define XB_XGEN(j)  (2304 + 64 * (j))
#define XB_TOP      3328
#define XB_TOPGEN   3392
#define XCD_BAR_WORDS 3456
#define XB_SPIN_CAP (1u << 18)

__device__ __forceinline__ unsigned xb_ld(unsigned* p)              { return __hip_atomic_load(p, __ATOMIC_RELAXED, __HIP_MEMORY_SCOPE_AGENT); }
__device__ __forceinline__ unsigned xb_add(unsigned* p, unsigned v) { return __hip_atomic_fetch_add(p, v, __ATOMIC_RELAXED, __HIP_MEMORY_SCOPE_AGENT); }
__device__ __forceinline__ unsigned xb_xcc_id() { return (unsigned)__builtin_amdgcn_s_getreg((3 << 11) | 20) & 0xFu; }
#define XB_SPIN(cond, bar) do { unsigned _sp = 0; while (cond) { __builtin_amdgcn_s_sleep(1); \
    if ((++_sp & 255u) == 0u) { if (xb_ld(&(bar)[XB_TMO])) break; if (_sp > XB_SPIN_CAP) { atomicAdd(&(bar)[XB_TMO], 1u); break; } } } } while (0)

struct XcdBarrier {
    unsigned* bar; unsigned x;
    volatile LDSF unsigned* st;
};

__device__ __forceinline__ XcdBarrier xcd_barrier_post(unsigned* bar, volatile LDSF unsigned* st) {
    XcdBarrier b; b.bar = bar; b.x = xb_xcc_id(); b.st = st;
    if (threadIdx.x == 0) (void)xb_add(&bar[XB_XCNT(b.x)], 1u);
    return b;
}
__device__ __forceinline__ void xcd_barrier_complete(unsigned* bar, unsigned x, unsigned& nloc, unsigned& nx) {
    const unsigned G = gridDim.x * gridDim.y * gridDim.z;
    unsigned sum, cnt, mine, sp = 0u;
    for (;;) {
        sum = 0u; cnt = 0u; mine = 0u;
#pragma unroll
        for (unsigned j = 0; j < 16; ++j) { const unsigned c = xb_ld(&bar[XB_XCNT(j)]); sum += c; cnt += (c > 0u) ? 1u : 0u; mine = (j == x) ? c : mine; }
        if (sum == G) break;
        __builtin_amdgcn_s_sleep(1);
        if ((++sp & 255u) == 0u) { if (xb_ld(&bar[XB_TMO])) break; if (sp > XB_SPIN_CAP) { atomicAdd(&bar[XB_TMO], 1u); break; } }
    }
    nloc = mine > 0u ? mine : 1u; nx = cnt > 0u ? cnt : 1u;
}

__device__ __forceinline__ void xcd_barrier(const XcdBarrier& b) {
    asm volatile("s_waitcnt vmcnt(0)" ::: "memory");
    __syncthreads();
    if (threadIdx.x == 0) {
        unsigned* bar = b.bar;
        __builtin_amdgcn_s_waitcnt(0);
        unsigned nloc = b.st[0], nx = b.st[1];
        if (nloc == 0u) { xcd_barrier_complete(bar, b.x, nloc, nx); b.st[0] = nloc; b.st[1] = nx; }
        const unsigned old = xb_add(&bar[XB_XSUB(b.x)], 1u);
        const unsigned gen = old / nloc;
        if (old + 1u == (gen + 1u) * nloc) {
            __builtin_amdgcn_fence(__ATOMIC_RELEASE, "agent");
            asm volatile("s_waitcnt vmcnt(0)" ::: "memory");
            const unsigned og = xb_add(&bar[XB_TOP], 1u);
            const unsigned tg = og / nx;
            if (og + 1u == (tg + 1u) * nx) xb_add(&bar[XB_TOPGEN], 1u);
            else XB_SPIN(xb_ld(&bar[XB_TOPGEN]) == tg, bar);
            __builtin_amdgcn_fence(__ATOMIC_ACQUIRE, "agent");
            xb_add(&bar[XB_XGEN(b.x)], 1u);
            asm volatile("s_waitcnt vmcnt(0)" ::: "memory");
        } else {
            XB_SPIN(xb_ld(&bar[XB_XGEN(b.x)]) == gen, bar);
            __builtin_amdgcn_fence(__ATOMIC_ACQUIRE, "agent");
            asm volatile("s_waitcnt vmcnt(0)" ::: "memory");
        }
    }
    __syncthreads();
}

namespace cg = cooperative_groups;
constexpr int LDS_BYTES = 131072 + 8192 + 4096 + 1024;
#define LAS3 __attribute__((address_space(3)))
#ifndef PROBE
#define PROBE 0
#endif
__global__ void __launch_bounds__(NTHR, 2) mega(Params p) {
    extern __shared__ __attribute__((aligned(16))) unsigned char lds[];
    cg::grid_group grid = cg::this_grid();
#if PROBE
    unsigned long long tacc = 0, tph = 0, t0_;
#define GSYNC() do { t0_ = __builtin_amdgcn_s_memrealtime(); xcd_barrier(xbar); tacc += __builtin_amdgcn_s_memrealtime() - t0_; } while (0)
#define TPK(k, ...) do { if (PROBE == (k)) { t0_ = __builtin_amdgcn_s_memrealtime(); __VA_ARGS__; tph += __builtin_amdgcn_s_memrealtime() - t0_; } else { __VA_ARGS__; } } while (0)
#else
#define GSYNC() xcd_barrier(xbar)
#define TPK(k, ...) do { __VA_ARGS__; } while (0)
#endif
    LAS3 unsigned char* lds3 = (LAS3 unsigned char*)lds;
    volatile LDSF unsigned* bst = (volatile LDSF unsigned*)(lds3 + 131072 + 2048);
    if (threadIdx.x < 2) bst[threadIdx.x] = 0u;
    __syncthreads();
    XcdBarrier xbar = xcd_barrier_post((unsigned*)(p.ws + WS_CTL) + 16384, bst);
    TPK(2, ph_mod(p, lds); ph_reset_queues(p); ph_weights(p, 0, lds));
    grid.sync();
    for (int l = 0; l < DEPTH; ++l) {
        const float* mod = (const float*)(p.ws + WS_MOD) + (size_t)l * 4 * 6144;
        TPK(2, if (l == 0) ph_xa_from(p, p.x, 0, 0, (bf16_t*)(p.ws + WS_XA), (float*)(p.ws + WS_RSA), true); ph_cbias(p, l, 1));
        GSYNC();
        {   pg8::Gemm g{(const bf16_t*)(p.ws + WS_XA), (const bf16_t*)(p.ws + WS_WIN + l * WS_W1OFF), MTOK, PINP, DM}; pg8::StaticOrder S; S.init(MTOK, PINP, (int)gridDim.x, (int)blockIdx.x);
            EpiProjF E{(const float*)(p.ws + WS_RSA), (const float*)(p.ws + WS_CBIN) + (size_t)l * 4 * PINP, (bf16_t*)(p.ws + WS_PROJ), (float*)(p.ws + WS_SIDE),
                       p.diff_kn + l * 32, p.fox_kn + l * 64, p.nsa_kn + (l * 3 + 1) * 64, p.nsa_kn + (l * 3 + 2) * 64, (LDSF float*)(lds3 + 131072 + 4096), (LDSF float*)(lds3 + 131072 + 12288)};
            TPK(6, pg8::gemm_phase<EpiProjF, pg8::StaticOrder, true, PG8_SP2>(lds3, g, S, E)); }
        GSYNC();
        TPK(7, fa_phase_all(p, l, lds3, lds, l, (l + 1 < DEPTH) ? CV_ITEMS / 8 : 0));
        GSYNC();
        {   pg8::Gemm g{(const bf16_t*)(p.ws + WS_MIX), (const bf16_t*)(p.ws + WS_WOUT + l * WS_W1OFF), MTOK, DM, DM}; pg8::StaticOrder S; S.init(MTOK, DM, (int)gridDim.x, (int)blockIdx.x);
            EpiResF E{l == 0 ? p.x : p.out, p.out, mod + 2048, p.norm_ffn_g + l * DM, mod + 4096, (bf16_t*)(p.ws + WS_XA), (float*)(p.ws + WS_RSB)};
            TPK(6, pg8::gemm_phase<EpiResF, pg8::StaticOrder, PG8_ALIGN, PG8_SP2>(lds3, g, S, E)); }
        GSYNC();
        {   pg8::Gemm g{(const bf16_t*)(p.ws + WS_XA), (const bf16_t*)(p.ws + WS_WUP + l * WS_W1OFF), MTOK, NUP, DM}; pg8::StaticOrder S; S.init(MTOK, NUP, (int)gridDim.x, (int)blockIdx.x);
            EpiUpAct E{(const float*)(p.ws + WS_RSB), (const float*)(p.ws + WS_CBUP) + (size_t)l * 4 * NUP, (bf16_t*)(p.ws + WS_ACT), (float*)(p.ws + WS_EG), (float*)(p.ws + WS_EV),
                       p.conv_w + (size_t)l * 3 * DFF, p.conv_b + (size_t)l * DFF, (LDSF float*)(lds3 + 131072 + 4096), (LDSF float*)(lds3 + 131072 + 8192)};
            TPK(6, pg8::gemm_phase<EpiUpAct, pg8::StaticOrder, true, PG8_SP2>(lds3, g, S, E)); }
        GSYNC();
        {   const float* modn = (const float*)(p.ws + WS_MOD) + (size_t)(l + 1) * 4 * 6144; const bool more = (l + 1 < DEPTH);
            pg8::Gemm g{(const bf16_t*)(p.ws + WS_ACT), (const bf16_t*)(p.ws + WS_WDN + l * WS_W1OFF), MTOK, DM, DFF}; pg8::StaticOrder S; S.init(MTOK, DM, (int)gridDim.x, (int)blockIdx.x);
            { pg8::Unit fu; for (int i = 0; S.next(i, fu); ++i) act_fixup(p, l, fu.pm); }
            __builtin_amdgcn_fence(__ATOMIC_RELEASE, "agent"); __builtin_amdgcn_fence(__ATOMIC_ACQUIRE, "agent"); __syncthreads();
            EpiResF E{p.out, p.out, mod + 5120, p.norm_mix_g + (more ? l + 1 : l) * DM, more ? modn + 1024 : mod + 1024, more ? (bf16_t*)(p.ws + WS_XA) : nullptr, more ? (float*)(p.ws + WS_RSA) : nullptr};
            TPK(6, pg8::gemm_phase<EpiResF, pg8::StaticOrder, PG8_ALIGN, PG8_SP2>(lds3, g, S, E)); }
    }
#if PROBE == 1
    if (blockIdx.x == 0 && threadIdx.x == 0) p.out[0] += 0.05f + (float)tacc * 0.01f * 5e-4f;
#elif PROBE >= 2
    if (blockIdx.x == 0 && threadIdx.x == 0) p.out[0] += 0.05f + (float)tph * 0.01f * 1e-4f;
#endif
}

extern "C" void kernel_launch(void* const* d_in, const int* in_sizes, int in, void* d_out, int out_size, void* d_ws, size_t ws_size, hipStream_t stream) {
    if (in != 24 || ws_size < WS_END || out_size != MTOK * DM) { fprintf(stderr, "kernel_launch: unexpected sizes (in %d, ws %zu, out %d)\n", in, ws_size, out_size); return; }
    static int grid_blocks = 0;
    if (!grid_blocks) {
        int dev = 0, cus = 0, per_cu = 0;
        hipGetDevice(&dev);
        hipDeviceGetAttribute(&cus, hipDeviceAttributeMultiprocessorCount, dev);
        hipFuncSetAttribute((const void*)mega, hipFuncAttributeMaxDynamicSharedMemorySize, LDS_BYTES);
        hipOccupancyMaxActiveBlocksPerMultiprocessor(&per_cu, (const void*)mega, NTHR, LDS_BYTES);
        if (per_cu < 1) { fprintf(stderr, "kernel_launch: occupancy query returned %d\n", per_cu); per_cu = 1; }
        if (per_cu > 1) per_cu = 1;
        grid_blocks = cus * per_cu;
        fprintf(stderr, "kernel_launch: cus %d per_cu %d grid %d\n", cus, per_cu, grid_blocks);
    }
    if (hipMemsetAsync((char*)d_ws + WS_CTL + 65536, 0, XCD_BAR_WORDS * 4, stream) != hipSuccess) { fprintf(stderr, "kernel_launch: memset failed\n"); return; }
    Params p{};
    const float** f = (const float**)&p;
    for (int i = 0; i < 24; ++i) f[i] = (const float*)d_in[i];
    p.out = (float*)d_out; p.ws = (unsigned char*)d_ws;
    void* args[] = {&p};
    hipError_t e = hipLaunchCooperativeKernel((const void*)mega, dim3(grid_blocks), dim3(NTHR), args, LDS_BYTES, stream);
    if (e != hipSuccess) fprintf(stderr, "cooperative launch failed: %s (grid %d)\n", hipGetErrorString(e), grid_blocks);
}
```

```cpp
#include <hip/hip_runtime.h>
#include <hip/hip_cooperative_groups.h>
#include <cstdint>
#include <cstdio>

typedef unsigned short bf16_t;
typedef short bf16x8 __attribute__((ext_vector_type(8)));
typedef float f32x4 __attribute__((ext_vector_type(4)));
typedef unsigned u32x4 __attribute__((ext_vector_type(4)));

constexpr int NB = 4, SEQ = 4096, DM = 1024, MTOK = NB * SEQ, DEPTH = 2;
constexpr int HD = 64, HPM = 4, DFF = 2816, PIN = 2960, PINP = 3072, NUP = 2 * DFF;
constexpr float EPS = 1e-6f;
constexpr float LOG2E = 1.4426950408889634f;
constexpr int NTHR = 512;

constexpr int CA_Q = 0, CA_K = 256, CA_V = 512, CB_Q = 768, CB_K = 1024, CB_V = 1280, CC_Q = 1536, CC_K = 1792, CC_V = 2048;
constexpr int CD_Q = 2304, CD_KC = 2560, CD_VC = 2624, CD_KS = 2688, CD_VS = 2752, CD_KW = 2816, CD_VW = 2880, C_BF = 2944, C_DG = 2948;

constexpr size_t MiB = 1u << 20;
constexpr size_t WS_CTL = 0;
constexpr size_t WS_MOD = 1 * MiB;
constexpr size_t WS_CBIN = WS_MOD + 2 * 4 * 6144 * 4;
constexpr size_t WS_CBUP = WS_CBIN + 2 * 4 * 3072 * 4;
constexpr size_t WS_TB = WS_CBUP + 2 * 4 * 5632 * 4;
constexpr size_t WS_LAM = WS_TB + 2 * 4 * 128 * 4;
constexpr size_t WS_BND = WS_LAM + 64;
constexpr size_t WS_CUM = WS_LAM + 512;
constexpr size_t WS_KC = WS_CUM + 16 * 4096 * 4;
constexpr size_t WS_VC = WS_KC + 4 * 256 * 64 * 2;
constexpr size_t WS_SELM = WS_VC + 4 * 256 * 64 * 2;
constexpr size_t WS_SMALL_END = WS_SELM + 16384 * 8;
static_assert(WS_SMALL_END <= 4 * MiB, "small region");
constexpr size_t WS_RSA = 4 * MiB;
constexpr size_t WS_RSB = 5 * MiB;
constexpr size_t WS_SIDE = 6 * MiB;
constexpr size_t WS_IMP = 7 * MiB;
constexpr size_t WS_ML = 11 * MiB;
constexpr size_t WS_PHIT = 7 * MiB;
constexpr size_t WS_W = 12 * MiB;
constexpr size_t WS_WIN = WS_W;
constexpr size_t WS_WOUT = WS_WIN + (size_t)PINP * DM * 2;
constexpr size_t WS_WUP = WS_WOUT + (size_t)DM * DM * 2;
constexpr size_t WS_WDN = WS_WUP + (size_t)NUP * DM * 2;
constexpr size_t WS_W_END = WS_WDN + (size_t)DM * DFF * 2;
static_assert(WS_W_END <= 38 * MiB, "weights region");
constexpr size_t WS_XA = 38 * MiB;
constexpr size_t WS_BIG = 70 * MiB;
constexpr size_t WS_PROJ = WS_BIG;
constexpr size_t WS_MIX = WS_BIG + 96 * MiB;
constexpr size_t WS_ACT = WS_BIG;
constexpr size_t WS_W1OFF = 188 * MiB;
constexpr size_t WS_EG = 228 * MiB;
constexpr size_t WS_EV = 232 * MiB;
constexpr size_t WS_END = 236 * MiB;
static_assert(WS_W_END + WS_W1OFF <= WS_EG && WS_MIX + 32 * MiB <= WS_W + WS_W1OFF, "layer-1 weights");
static_assert(WS_END <= 256 * MiB, "workspace");

struct Params {
    const float *x, *c, *rel_bias, *ada_w, *ada_b, *norm_mix_g, *norm_ffn_g, *w_in, *w_out;
    const float *diff_qn, *diff_kn, *diff_lam, *diff_sub, *fox_qn, *fox_kn, *fox_bf;
    const float *nsa_qn, *nsa_kn, *nsa_pe, *nsa_phi, *w_up, *conv_w, *conv_b, *w_down;
    float* out;
    unsigned char* ws;
};

__device__ __forceinline__ float bf2f(bf16_t v) { return __uint_as_float(((unsigned)v) << 16); }
__device__ __forceinline__ bf16_t f2bf(float f) { unsigned u = __float_as_uint(f); return (bf16_t)((u + 0x7fffu + ((u >> 16) & 1u)) >> 16); }
__device__ __forceinline__ unsigned pk2(float lo, float hi) { return (unsigned)f2bf(lo) | ((unsigned)f2bf(hi) << 16); }
__device__ __forceinline__ float siluf(float v) { return v / (1.f + __expf(-v)); }
__device__ __forceinline__ float logsigf(float v) { return fminf(v, 0.f) - log1pf(__expf(-fabsf(v))); }
__device__ __forceinline__ float wave_sum(float v) {
#pragma unroll
    for (int o = 1; o < 64; o <<= 1) v += __shfl_xor(v, o);
    return v;
}
__device__ __forceinline__ int t5_bucket(int n) {
    if (n < 16) return n < 0 ? 0 : n;
    return 16 + (n >= 19) + (n >= 21) + (n >= 24) + (n >= 27) + (n >= 31) + (n >= 35) + (n >= 40) + (n >= 46) + (n >= 52) + (n >= 59) + (n >= 67) + (n >= 77) + (n >= 87) + (n >= 99) + (n >= 113);
}
__host__ __device__ __forceinline__ int in_col_map(int n) {
    if (n < 1536) return n;
    if (n < 2944) return n + 4;
    if (n < 2948) return 1536 + (n - 2944);
    if (n < 2960) return n;
    return -1;
}
__host__ __device__ __forceinline__ int up_col_map(int n) {
    const int pn = n >> 8, c = n & 255;
    return c < 128 ? (128 * pn + c) : (DFF + 128 * pn + (c - 128));
}

__device__ __forceinline__ int opaque_v(int v) { asm volatile("" : "+v"(v)); return v; }
#define TID() opaque_v((int)threadIdx.x)
#define GTID() ((int)(blockIdx.x * blockDim.x) + TID())
#define GSIZE() ((int)(gridDim.x * blockDim.x))

__device__ __forceinline__ void load8(const bf16_t* p, float* d) {
    const u32x4 r = *(const u32x4*)p;
    d[0] = bf2f(r[0] & 0xffff); d[1] = bf2f(r[0] >> 16); d[2] = bf2f(r[1] & 0xffff); d[3] = bf2f(r[1] >> 16);
    d[4] = bf2f(r[2] & 0xffff); d[5] = bf2f(r[2] >> 16); d[6] = bf2f(r[3] & 0xffff); d[7] = bf2f(r[3] >> 16);
}
#define LDSF __attribute__((address_space(3)))
__device__ __forceinline__ void gemv4_block(const float* W, int ld, int oc, const LDSF float* vec, LDSF float* red, float* out0, int ostride, int n, float bias, int tid) {
    const int lane = tid & 63, wv = tid >> 6;
    float a0 = 0.f, a1 = 0.f, a2 = 0.f, a3 = 0.f;
    if (oc >= 0) {
        const float* w = W + (size_t)(wv * 128) * ld + oc;
#pragma unroll 32
        for (int k = 0; k < 128; ++k) { const float wk = w[(size_t)k * ld]; const f32x4 v = *(const LDSF f32x4*)(vec + (wv * 128 + k) * 4); a0 += v[0] * wk; a1 += v[1] * wk; a2 += v[2] * wk; a3 += v[3] * wk; }
    }
    red[(wv * 4 + 0) * 64 + lane] = a0; red[(wv * 4 + 1) * 64 + lane] = a1; red[(wv * 4 + 2) * 64 + lane] = a2; red[(wv * 4 + 3) * 64 + lane] = a3;
    __syncthreads();
    if (tid < 256) { const int bt = tid >> 6; float sacc = 0.f;
#pragma unroll
        for (int w8 = 0; w8 < 8; ++w8) sacc += red[(w8 * 4 + bt) * 64 + lane];
        out0[(size_t)bt * ostride + n] = sacc + bias; }
    __syncthreads();
}
__device__ void ph_mod(const Params& p, unsigned char* lds) {
    float* mod = (float*)(p.ws + WS_MOD);
    float* tb = (float*)(p.ws + WS_TB);
    float* lamv = (float*)(p.ws + WS_LAM);
    LDSF float* vec = (LDSF float*)lds; LDSF float* red = (LDSF float*)(lds + 16384);
    const int tid = TID();
    bool loaded = false;
    for (int item = blockIdx.x; item < DEPTH * 96; item += gridDim.x) {
        if (!loaded) { for (int i = tid; i < 4096; i += NTHR) { const int bt = i >> 10, k = i & 1023; vec[k * 4 + bt] = siluf(p.c[bt * DM + k]); } __syncthreads(); loaded = true; }
        const int l = item / 96, n = (item % 96) * 64 + (tid & 63);
        gemv4_block(p.ada_w + (size_t)l * DM * 6144, 6144, n, vec, red, mod + (size_t)l * 4 * 6144, 6144, n, p.ada_b[l * 6144 + n], tid);
    }
    const int gt = GTID(), gs = GSIZE();
    for (int idx = gt; idx < 2 * 4 * 128; idx += gs) {
        const int type = idx / 512, h = (idx / 128) & 3, d = idx & 127;
        tb[idx] = p.rel_bias[t5_bucket(d) * 8 + type * 4 + h];
    }
    for (int idx = gt; idx < DEPTH * 32; idx += gs) {
        const int l = idx >> 5, e = idx & 31; float v = 0.f;
        if (e < 17) {
            const int type = (e < 5) ? 0 : 1, h = (e < 4) ? e : ((e == 4) ? 0 : ((e - 5) & 3));
            const int ng = (e < 4) ? 32 : 64;
            const float* gq = (e < 4) ? p.diff_qn + l * 32 : ((e == 4) ? p.fox_qn + l * 64 : p.nsa_qn + l * 64);
            const float* gk = (e < 4) ? p.diff_kn + l * 32 : ((e == 4) ? p.fox_kn + l * 64 : p.nsa_kn + (l * 3 + (e - 5) / 4) * 64);
            float mq = 0.f, mk = 0.f; for (int i = 0; i < ng; ++i) { mq = fmaxf(mq, fabsf(gq[i])); mk = fmaxf(mk, fabsf(gk[i])); }
            float tm = 0.f; if (e != 4) { tm = -INFINITY; for (int bk2 = 0; bk2 < 32; ++bk2) tm = fmaxf(tm, p.rel_bias[bk2 * 8 + type * 4 + h]); }
            v = sqrtf((float)ng) * mq * mk * 1.02f * LOG2E + tm * LOG2E;
        }
        ((float*)(p.ws + WS_BND))[idx] = v;
    }
    for (int idx = gt; idx < DEPTH; idx += gs) {
        const float* lv = p.diff_lam + idx * 4 * 32;
        float s1 = 0.f, s2 = 0.f;
        for (int i = 0; i < 32; ++i) { s1 += lv[i] * lv[32 + i]; s2 += lv[64 + i] * lv[96 + i]; }
        const float lam_init = 0.8f - 0.6f * expf(-0.3f * (float)idx);
        lamv[idx] = expf(s1) - expf(s2) + lam_init;
    }
}
__device__ void ph_cbias(const Params& p, int lfirst, int lcount) {
    const float* mod = (const float*)(p.ws + WS_MOD);
    const int tid_ = TID(); const int lane = tid_ & 63, wv = tid_ >> 6;
    const int gw = blockIdx.x * (NTHR >> 6) + wv, ngw = gridDim.x * (NTHR >> 6);
    constexpr int NCOL = PINP + NUP;
    const int per = (lcount * NCOL + ngw - 1) / ngw; const int c0 = gw * per, c1 = min(lcount * NCOL, c0 + per);
    int cur_key = -1; float sh[4][16];
    for (int c = c0; c < c1; ++c) {
        const int l = lfirst + c / NCOL, r = c % NCOL; const bool isin = r < PINP; const int n = isin ? r : r - PINP; const int key = l * 2 + (isin ? 0 : 1);
        if (key != cur_key) { cur_key = key; const int shoff = isin ? 0 : 3072;
#pragma unroll
            for (int bt = 0; bt < 4; ++bt)
#pragma unroll
                for (int q4 = 0; q4 < 4; ++q4) { const f32x4 v = *(const f32x4*)(mod + (size_t)(l * 4 + bt) * 6144 + shoff + 16 * lane + 4 * q4); sh[bt][4 * q4] = v[0]; sh[bt][4 * q4 + 1] = v[1]; sh[bt][4 * q4 + 2] = v[2]; sh[bt][4 * q4 + 3] = v[3]; } }
        const bf16_t* wrow = (const bf16_t*)(p.ws + (isin ? WS_WIN : WS_WUP) + l * WS_W1OFF) + (size_t)n * DM + 16 * lane;
        float w[16]; load8(wrow, w); load8(wrow + 8, w + 8);
        float a0 = 0.f, a1 = 0.f, a2 = 0.f, a3 = 0.f;
#pragma unroll
        for (int j = 0; j < 16; ++j) { a0 += sh[0][j] * w[j]; a1 += sh[1][j] * w[j]; a2 += sh[2][j] * w[j]; a3 += sh[3][j] * w[j]; }
        a0 = wave_sum(a0); a1 = wave_sum(a1); a2 = wave_sum(a2); a3 = wave_sum(a3);
        if (lane == 0) { float* o = isin ? (float*)(p.ws + WS_CBIN) + (size_t)l * 4 * PINP : (float*)(p.ws + WS_CBUP) + (size_t)l * 4 * NUP; const int ld = isin ? PINP : NUP;
            o[n] = a0; o[ld + n] = a1; o[2 * ld + n] = a2; o[3 * ld + n] = a3; }
    }
}
template <int MAPK>
__device__ __forceinline__ void convert_one(const float* W, int K, int Nsrc, int Npad, bf16_t* Wt, LDSF float* scr, int it, int lane) {
    const int nnb = Npad / 64;
    const int kb = it / nnb, nb = it % nnb, k0 = kb * 64, n0 = nb * 64;
    {
        const int n = n0 + lane;
        const int oc = MAPK == 0 ? n : (MAPK == 1 ? in_col_map(n) : up_col_map(n));
        const float* wp = W + (size_t)k0 * Nsrc + (oc >= 0 ? oc : 0);
#pragma unroll 1
        for (int hh = 0; hh < 2; ++hh) {
            float tv[32];
#pragma unroll
            for (int i = 0; i < 32; ++i) tv[i] = wp[(size_t)(32 * hh + i) * Nsrc];
#pragma unroll
            for (int i = 0; i < 32; ++i) scr[(32 * hh + i) * 65 + lane] = (oc >= 0) ? tv[i] : 0.f;
        }
    }
    __builtin_amdgcn_s_waitcnt(0xc07f); __builtin_amdgcn_wave_barrier();
    {
        const int c = lane & 7;
#pragma unroll
        for (int j = 0; j < 8; ++j) { const int nn = 8 * j + (lane >> 3); const LDSF float* sp = scr + (8 * c) * 65 + nn;
            u32x4 o; o[0] = pk2(sp[0], sp[65]); o[1] = pk2(sp[130], sp[195]); o[2] = pk2(sp[260], sp[325]); o[3] = pk2(sp[390], sp[455]);
            *(u32x4*)(Wt + (size_t)(n0 + nn) * K + k0 + 8 * c) = o; }
    }
    __builtin_amdgcn_s_waitcnt(0xc07f); __builtin_amdgcn_wave_barrier();
}
constexpr int CV_IN = 16 * (PINP / 64), CV_OUT = 16 * (DM / 64), CV_UP = 16 * (NUP / 64), CV_DN = (DFF / 64) * (DM / 64), CV_PHI = 32, CV_ITEMS = CV_IN + CV_OUT + CV_UP + CV_DN + 2 * CV_PHI;
static_assert(CV_ITEMS == 3200, "conversion item count");
__device__ void convert_item(const Params& p, int l, int idx, LDSF float* scr, int lane) {
    if (idx < CV_IN) { convert_one<1>(p.w_in + (size_t)l * DM * PIN, DM, PIN, PINP, (bf16_t*)(p.ws + WS_WIN + l * WS_W1OFF), scr, idx, lane); return; } idx -= CV_IN;
    if (idx < CV_OUT) { convert_one<0>(p.w_out + (size_t)l * DM * DM, DM, DM, DM, (bf16_t*)(p.ws + WS_WOUT + l * WS_W1OFF), scr, idx, lane); return; } idx -= CV_OUT;
    if (idx < CV_UP) { convert_one<2>(p.w_up + (size_t)l * DM * NUP, DM, NUP, NUP, (bf16_t*)(p.ws + WS_WUP + l * WS_W1OFF), scr, idx, lane); return; } idx -= CV_UP;
    if (idx < CV_DN) { convert_one<0>(p.w_down + (size_t)l * DFF * DM, DFF, DM, DM, (bf16_t*)(p.ws + WS_WDN + l * WS_W1OFF), scr, idx, lane); return; } idx -= CV_DN;
    const int w2 = idx / CV_PHI; idx -= w2 * CV_PHI;
    convert_one<0>(p.nsa_phi + (size_t)(l * 2 + w2) * 2048 * 64, 2048, 64, 64, (bf16_t*)(p.ws + WS_PHIT) + (size_t)(l * 2 + w2) * 64 * 2048, scr, idx, lane);
}
__device__ void ph_weights(const Params& p, int l, unsigned char* lds) {
    const int tid_ = TID(); const int lane = tid_ & 63, wv = tid_ >> 6;
    const int ngw = gridDim.x * (NTHR >> 6), gw = ngw - 1 - (blockIdx.x * (NTHR >> 6) + wv);
    LDSF float* scr = (LDSF float*)lds + wv * (64 * 65);
    for (int it = gw; it < CV_ITEMS; it += ngw) convert_item(p, l, it, scr, lane);
}
__device__ void ph_xa_from(const Params& p, const float* src, int l, int which  , bf16_t* XA, float* rowss, bool write_xa) {
    const float* mod = (const float*)(p.ws + WS_MOD);
    const float* g = (which == 0 ? p.norm_mix_g : p.norm_ffn_g) + l * DM;
    const int tid_ = TID(); const int lane = tid_ & 63, wv = tid_ >> 6;
    const int gw = blockIdx.x * (blockDim.x >> 6) + wv, ngw = gridDim.x * (blockDim.x >> 6);
    for (int row0 = gw; row0 < MTOK; row0 += 2 * ngw) {
        f32x4 v[2][4];
#pragma unroll
        for (int rr = 0; rr < 2; ++rr) { const int row = min(row0 + rr * ngw, MTOK - 1);
#pragma unroll
            for (int j = 0; j < 4; ++j) v[rr][j] = *(const f32x4*)(src + (size_t)row * DM + j * 256 + lane * 4); }
#pragma unroll
        for (int rr = 0; rr < 2; ++rr) {
            const int row = row0 + rr * ngw;
            if (row < MTOK) {
                const int b = row / SEQ; const float* sc = mod + (size_t)(l * 4 + b) * 6144 + (which == 0 ? 1024 : 4096);
                float ss = 0.f;
#pragma unroll
                for (int j = 0; j < 4; ++j) {
                    const int k = j * 256 + lane * 4; const f32x4 x = v[rr][j];
                    ss += x[0] * x[0] + x[1] * x[1] + x[2] * x[2] + x[3] * x[3];
                    if (write_xa) {
                        const f32x4 gv = *(const f32x4*)(g + k); const f32x4 sv = *(const f32x4*)(sc + k);
                        uint2 o; o.x = pk2(x[0] * gv[0] * (1.f + sv[0]), x[1] * gv[1] * (1.f + sv[1])); o.y = pk2(x[2] * gv[2] * (1.f + sv[2]), x[3] * gv[3] * (1.f + sv[3]));
                        *(uint2*)(XA + (size_t)row * DM + k) = o;
                    }
                }
                ss = wave_sum(ss);
                if (lane < 16) rowss[(size_t)row * 16 + lane] = (lane == 0) ? ss : 0.f;
            }
        }
    }
}

namespace pg8 {
#define PG8_LAS __attribute__((address_space(3)))
typedef unsigned short bf16_t;
typedef short bf16x8 __attribute__((ext_vector_type(8)));
typedef float f32x4 __attribute__((ext_vector_type(4)));
typedef unsigned u32x4 __attribute__((ext_vector_type(4)));
constexpr int BM = 256, BK = 64, HALF = 128, HTB = HALF * BK * 2  , STAGE_BYTES = 8 * HTB, NXCD = 8, WGM = 8;

__host__ __device__ __forceinline__ int lds_byte(int r, int c) { const int st = (r >> 4) * 2 + (c >> 5), rr = r & 15, cc = c & 31, ob = rr * 64 + cc * 2; return st * 1024 + (ob ^ (((ob >> 9) & 1) << 5)); }
__host__ __device__ __forceinline__ void stage_rc(int b, int& R, int& C) { const int st = b / 1024, sb = b % 1024, swz = sb ^ (((sb >> 9) & 1) << 5); R = (st >> 1) * 16 + swz / 64; C = (st & 1) * 32 + (swz % 64) / 2; }
__host__ __device__ __forceinline__ int perm32(int rho) { const int n = rho >> 4, i = rho & 15; return 8 * (i >> 2) + 4 * n + (i & 3); }

struct Unit { int pm, pn; };
struct Gemm { const bf16_t* A; const bf16_t* Bt; int M, N, K; };

struct StaticOrder {
    int nM, nN, nwg, G, c;
    __host__ __device__ void init(int M, int N, int G_, int c_) { nM = M / BM; nN = N / BM; nwg = nM * nN; G = G_; c = c_; }
    __host__ __device__ bool next(int i, Unit& u) const {
        const long L = (long)i * G + c; if (L >= nwg) return false;
        int wgid = (int)L; { const int q = nwg / NXCD, r = nwg % NXCD, xcd = wgid % NXCD, off = wgid / NXCD; wgid = (xcd < r ? xcd * (q + 1) : r * (q + 1) + (xcd - r) * q) + off; }
        const int nig = WGM * nN, gid = wgid / nig, fm = gid * WGM, gsz = (nM - fm) < WGM ? (nM - fm) : WGM;
        u.pm = fm + ((wgid % nig) % gsz); u.pn = (wgid % nig) / gsz; return true;
    }
    __device__ __forceinline__ void a_ready(const Unit&) const {}
    __device__ __forceinline__ void done(const Unit&) const {}
};


__device__ __forceinline__ unsigned cvt_pk_bf16(float lo, float hi) { unsigned r; asm volatile("v_cvt_pk_bf16_f32 %0, %1, %2" : "=v"(r) : "v"(lo), "v"(hi)); return r; }
template <class Epi, class Sched, bool ALIGN_EPI = false, bool SP2 = false>
__device__ __forceinline__ void gemm_phase(PG8_LAS unsigned char* lds, const Gemm g, const Sched& S, const Epi& E) {
    const int tid = TID(), wid = __builtin_amdgcn_readfirstlane(tid >> 6), lane = tid & 63, wr = wid >> 2, wc = wid & 3, fr = lane & 15, fq = lane >> 4;
    const int K = g.K, nt = K / BK;
    unsigned voffA[2], voffB[2];
#pragma unroll
    for (int i = 0; i < 2; ++i) { int R, C; stage_rc(tid * 16 + i * 8192, R, C); const int Rb = Epi::PERM ? ((R & ~31) + perm32(R & 31)) : R;
        voffA[i] = (unsigned)(R * K + C) * 2u; voffB[i] = (unsigned)(Rb * K + C) * 2u; }
    const size_t kstep = (size_t)(BK * 2);
    const size_t hstep = (size_t)HALF * K * 2;
    const size_t tstep = 2 * hstep;
    const unsigned ldsw = (unsigned)wid * 1024u;
    const int aoff = lds_byte(wr * 64 + fr, fq * 8), boff = lds_byte(wc * 32 + fr, fq * 8);
#define PG8_SA(b, h) (((b) * 2 + (h)) * HTB)
#define PG8_SB(b, h) ((4 + (b) * 2 + (h)) * HTB)
#define PG8_STAGE(bufoff, gbase, voff) do { _Pragma("unroll") for (int _i = 0; _i < 2; ++_i) \
        __builtin_amdgcn_global_load_lds((const unsigned*)((const char*)(gbase) + (voff)[_i]), (PG8_LAS unsigned*)(lds + (bufoff) + ldsw + _i * 8192), 16, 0, 0); } while (0)
#define PG8_LDA(dst, b, h) do { _Pragma("unroll") for (int m = 0; m < 4; ++m) _Pragma("unroll") for (int k = 0; k < 2; ++k) dst[m][k] = *(const PG8_LAS bf16x8*)(lds + PG8_SA(b, h) + aoff + m * 2048 + k * 1024); } while (0)
#define PG8_LDB(dst, b, h) do { _Pragma("unroll") for (int n = 0; n < 2; ++n) _Pragma("unroll") for (int k = 0; k < 2; ++k) dst[n][k] = *(const PG8_LAS bf16x8*)(lds + PG8_SB(b, h) + boff + n * 2048 + k * 1024); } while (0)
#define PG8_MMA(ai, bj, At, Bt) do { __builtin_amdgcn_s_setprio(1); _Pragma("unroll") for (int m = 0; m < 4; ++m) _Pragma("unroll") for (int n = 0; n < 2; ++n) _Pragma("unroll") for (int k = 0; k < 2; ++k) \
        acc[ai][bj][m][n] = __builtin_amdgcn_mfma_f32_16x16x32_bf16(Bt[n][k], At[m][k], acc[ai][bj][m][n], 0, 0, 0); __builtin_amdgcn_s_setprio(0); } while (0)
#define PG8_WAIT_V(n) asm volatile("s_waitcnt vmcnt(" #n ")" ::: "memory")
#define PG8_WAIT_L(n) asm volatile("s_waitcnt lgkmcnt(" #n ")" ::: "memory")
#define PG8_BAR __builtin_amdgcn_s_barrier()
#define PG8_SCHED __builtin_amdgcn_sched_barrier(0)
    Unit cur, nxt; int ui = 0;
    if (!S.next(0, cur)) return;
    f32x4 acc[2][2][4][2];
#pragma unroll
    for (int a = 0; a < 2; ++a)
#pragma unroll
        for (int b = 0; b < 2; ++b)
#pragma unroll
            for (int m = 0; m < 4; ++m)
#pragma unroll
                for (int n = 0; n < 2; ++n) acc[a][b][m][n] = (f32x4){0.f, 0.f, 0.f, 0.f};
    bf16x8 At[4][2], B0[2][2], B1[2][2];
    const char* cA = (const char*)g.A + (size_t)cur.pm * tstep; const char* cB = (const char*)g.Bt + (size_t)cur.pn * tstep;
    S.a_ready(cur);
    if constexpr (SP2) {
        PG8_STAGE(PG8_SB(0, 0), cB, voffB); PG8_STAGE(PG8_SB(0, 1), cB + hstep, voffB); PG8_STAGE(PG8_SA(0, 0), cA, voffA); PG8_STAGE(PG8_SA(0, 1), cA + hstep, voffA);
        if (wr == 1) PG8_BAR;
        PG8_WAIT_V(2); PG8_BAR;
        PG8_STAGE(PG8_SB(1, 0), cB + kstep, voffB); PG8_STAGE(PG8_SA(1, 0), cA + kstep, voffA); PG8_STAGE(PG8_SB(1, 1), cB + hstep + kstep, voffB);
        PG8_WAIT_V(6); PG8_BAR;
    } else {
        PG8_STAGE(PG8_SB(0, 0), cB, voffB); PG8_STAGE(PG8_SA(0, 0), cA, voffA); PG8_STAGE(PG8_SB(0, 1), cB + hstep, voffB); PG8_STAGE(PG8_SA(0, 1), cA + hstep, voffA);
        if (wr == 1) PG8_BAR;
        PG8_WAIT_V(4); PG8_BAR;
        PG8_STAGE(PG8_SB(1, 0), cB + kstep, voffB); PG8_STAGE(PG8_SA(1, 0), cA + kstep, voffA); PG8_STAGE(PG8_SB(1, 1), cB + hstep + kstep, voffB);
        PG8_WAIT_V(6); PG8_BAR;
    }
    for (;;) {
        const bool has_next = S.next(ui + 1, nxt);
        const char* nA = has_next ? (const char*)g.A + (size_t)nxt.pm * tstep : cA; const char* nB = has_next ? (const char*)g.Bt + (size_t)nxt.pn * tstep : cB;
        for (int t = 0; t < nt; t += 2) {
            const bool last = (t == nt - 2);
            const char* a1 = cA + (size_t)(t + 1) * kstep;
            const char* a2 = last ? nA : cA + (size_t)(t + 2) * kstep; const char* b2 = last ? nB : cB + (size_t)(t + 2) * kstep;
            const char* a3 = a2 + kstep; const char* b3 = b2 + kstep;
            if (last && has_next) S.a_ready(nxt);
            if constexpr (SP2) {
            PG8_LDB(B0, 0, 0); PG8_LDB(B1, 0, 1); PG8_SCHED; PG8_LDA(At, 0, 0); PG8_STAGE(PG8_SA(1, 1), a1 + hstep, voffA);
            PG8_WAIT_V(8); PG8_WAIT_L(0); PG8_BAR; PG8_MMA(0, 0, At, B0); PG8_MMA(0, 1, At, B1); PG8_BAR; PG8_SCHED;
            PG8_LDA(At, 0, 1); PG8_STAGE(PG8_SB(0, 0), b2, voffB); PG8_STAGE(PG8_SB(0, 1), b2 + hstep, voffB); PG8_STAGE(PG8_SA(0, 0), a2, voffA);
            PG8_WAIT_V(8); PG8_WAIT_L(0); PG8_BAR; PG8_MMA(1, 0, At, B0); PG8_MMA(1, 1, At, B1); PG8_BAR; PG8_SCHED;
            PG8_LDB(B0, 1, 0); PG8_LDB(B1, 1, 1); PG8_SCHED; PG8_LDA(At, 1, 0); PG8_STAGE(PG8_SA(0, 1), a2 + hstep, voffA);
            PG8_WAIT_V(8); PG8_WAIT_L(0); PG8_BAR; PG8_MMA(0, 0, At, B0); PG8_MMA(0, 1, At, B1); PG8_BAR; PG8_SCHED;
            PG8_LDA(At, 1, 1); PG8_STAGE(PG8_SB(1, 0), b3, voffB); PG8_STAGE(PG8_SB(1, 1), b3 + hstep, voffB); PG8_STAGE(PG8_SA(1, 0), a3, voffA);
            PG8_WAIT_V(8); PG8_WAIT_L(0); PG8_BAR; PG8_MMA(1, 0, At, B0); PG8_MMA(1, 1, At, B1); PG8_BAR; PG8_SCHED;
            } else {
            PG8_LDB(B0, 0, 0); PG8_SCHED; PG8_LDA(At, 0, 0); PG8_STAGE(PG8_SA(1, 1), a1 + hstep, voffA);
            PG8_WAIT_L(8); PG8_BAR; PG8_WAIT_L(0); PG8_MMA(0, 0, At, B0); PG8_BAR; PG8_SCHED;
            PG8_LDB(B1, 0, 1); PG8_STAGE(PG8_SB(0, 0), b2, voffB);
            PG8_BAR; PG8_WAIT_L(0); PG8_MMA(0, 1, At, B1); PG8_BAR;
            PG8_LDA(At, 0, 1); PG8_STAGE(PG8_SA(0, 0), a2, voffA);
            PG8_BAR; PG8_WAIT_L(0); PG8_MMA(1, 0, At, B0); PG8_BAR; PG8_SCHED;
            PG8_STAGE(PG8_SB(0, 1), b2 + hstep, voffB);
            PG8_WAIT_V(6); PG8_BAR; PG8_MMA(1, 1, At, B1); PG8_BAR;
            PG8_LDB(B0, 1, 0); PG8_SCHED; PG8_LDA(At, 1, 0); PG8_STAGE(PG8_SA(0, 1), a2 + hstep, voffA);
            PG8_WAIT_L(8); PG8_BAR; PG8_WAIT_L(0); PG8_MMA(0, 0, At, B0); PG8_BAR; PG8_SCHED;
            PG8_LDB(B1, 1, 1); PG8_STAGE(PG8_SB(1, 0), b3, voffB);
            PG8_BAR; PG8_WAIT_L(0); PG8_MMA(0, 1, At, B1); PG8_BAR;
            PG8_LDA(At, 1, 1); PG8_STAGE(PG8_SA(1, 0), a3, voffA);
            PG8_BAR; PG8_WAIT_L(0); PG8_MMA(1, 0, At, B0); PG8_BAR; PG8_SCHED;
            PG8_STAGE(PG8_SB(1, 1), b3 + hstep, voffB);
            PG8_WAIT_V(6); PG8_BAR; PG8_MMA(1, 1, At, B1); PG8_BAR;
            }
        }
        if constexpr (ALIGN_EPI) { if (wr == 0) PG8_BAR; }
        if constexpr (!Epi::AFTER_DRAIN) { E(acc, cur, wr, wc, fr, fq); S.done(cur); }
        if (!has_next) break;
#pragma unroll
        for (int a = 0; a < 2; ++a)
#pragma unroll
            for (int b = 0; b < 2; ++b)
#pragma unroll
                for (int m = 0; m < 4; ++m)
#pragma unroll
                    for (int n = 0; n < 2; ++n) acc[a][b][m][n] = (f32x4){0.f, 0.f, 0.f, 0.f};
        cur = nxt; cA = nA; cB = nB; ++ui;
        if constexpr (ALIGN_EPI) { if (wr == 1) PG8_BAR; }
    }
    PG8_WAIT_V(0);
    if constexpr (!ALIGN_EPI) { if (wr == 0) PG8_BAR; }
    PG8_BAR;
    if constexpr (Epi::AFTER_DRAIN) { E.fused(acc, cur, wr, wc, fr, fq, lds, wid, lane); S.done(cur); }
#undef PG8_SA
#undef PG8_SB
#undef PG8_STAGE
#undef PG8_LDA
#undef PG8_LDB
#undef PG8_MMA
#undef PG8_WAIT_V
#undef PG8_WAIT_L
#undef PG8_BAR
#undef PG8_SCHED
}
}

#ifndef PG8_SP2
#define PG8_SP2 true
#endif
#ifndef PG8_ALIGN
#define PG8_ALIGN true
#endif

__device__ __forceinline__ float row_rstd16(const float* rowss, int row) {
    const f32x4* r = (const f32x4*)(rowss + (size_t)row * 16);
    const f32x4 a = r[0], b = r[1], c = r[2], d = r[3];
    const float s = ((a[0] + a[1]) + (a[2] + a[3])) + ((b[0] + b[1]) + (b[2] + b[3])) + ((c[0] + c[1]) + (c[2] + c[3])) + ((d[0] + d[1]) + (d[2] + d[3]));
    return rsqrtf(s * (1.f / DM) + EPS);
}
struct EpiProjF {
    static constexpr bool PERM = true, AFTER_DRAIN = false;
    const float* rowss; const float* cb; bf16_t* proj; float* side; const float* g_a; const float* g_b; const float* g_ds; const float* g_dw; LDSF float* xs  ; LDSF float* rsl  ;
    __device__ __forceinline__ void operator()(const pg8::f32x4 (&acc)[2][2][4][2], const pg8::Unit& u, int wr, int wc, int fr, int fq) const {
        const int b = u.pm >> 4, colt = u.pn * 256 + wc * 32 + 8 * fq;
        const int knmode = (u.pn == 1) ? 1 : (u.pn == 4) ? 2 : (u.pn == 10) ? 3 : (u.pn == 11) ? 4 : 0;
        f32x4 cv[2][2];
#pragma unroll
        for (int bj = 0; bj < 2; ++bj)
#pragma unroll
            for (int n = 0; n < 2; ++n) cv[bj][n] = *(const f32x4*)(cb + b * PINP + colt + bj * 128 + 4 * n);
        {   const int tid = (wr * 4 + wc) * 64 + fq * 16 + fr;
            if (tid < 256) rsl[tid] = row_rstd16(rowss, u.pm * 256 + tid);
            asm volatile("s_waitcnt vmcnt(0) lgkmcnt(0)" ::: "memory"); __builtin_amdgcn_s_barrier(); asm volatile("" ::: "memory"); }
        if (knmode != 0) {
#pragma unroll
            for (int ai = 0; ai < 2; ++ai)
#pragma unroll
                for (int m = 0; m < 4; ++m) {
                    const float rsm = rsl[ai * 128 + wr * 64 + m * 16 + fr];
#pragma unroll
                    for (int bj = 0; bj < 2; ++bj) {
                        const f32x4 v0 = acc[ai][bj][m][0] * rsm + cv[bj][0], v1 = acc[ai][bj][m][1] * rsm + cv[bj][1];
                        float ss = (v0[0] * v0[0] + v0[1] * v0[1]) + (v0[2] * v0[2] + v0[3] * v0[3]) + (v1[0] * v1[0] + v1[1] * v1[1]) + (v1[2] * v1[2] + v1[3] * v1[3]);
                        ss += __shfl_xor(ss, 16); ss += __shfl_xor(ss, 32);
                        if (fq == 0) xs[((wr * 4 + wc) * 16 + (ai * 4 + m) * 2 + bj) * 16 + fr] = ss;
                    }
                }
            asm volatile("s_waitcnt lgkmcnt(0)" ::: "memory"); __builtin_amdgcn_s_barrier(); asm volatile("" ::: "memory");
        }
#pragma unroll
        for (int ai = 0; ai < 2; ++ai)
#pragma unroll
            for (int m = 0; m < 4; ++m) {
                const int row = u.pm * 256 + ai * 128 + wr * 64 + m * 16 + fr; const float rs = rsl[ai * 128 + wr * 64 + m * 16 + fr];
#pragma unroll
                for (int bj = 0; bj < 2; ++bj) {
                    f32x4 v0 = acc[ai][bj][m][0] * rs + cv[bj][0], v1 = acc[ai][bj][m][1] * rs + cv[bj][1]; const int col0 = colt + bj * 128;
                    if (col0 >= C_BF && col0 < PIN) { *(f32x4*)(side + (size_t)row * 16 + (col0 - C_BF)) = v0; *(f32x4*)(side + (size_t)row * 16 + (col0 - C_BF) + 4) = v1; }
                    const bool on = (knmode == 1) || (knmode == 2) || (knmode == 3 && bj == 1 && wc < 2) || (knmode == 4 && bj == 0 && wc < 2);
                    if (on) {
                        const int xi = (ai * 4 + m) * 2 + bj;
                        float tot = xs[((wr * 4 + wc) * 16 + xi) * 16 + fr]; float dn = 1.f / 32.f;
                        if (knmode != 1) { tot += xs[((wr * 4 + (wc ^ 1)) * 16 + xi) * 16 + fr]; dn = 1.f / 64.f; }
                        const float nrm = rsqrtf(tot * dn + EPS);
                        const float* gp = (knmode == 1) ? g_a + 8 * fq : ((knmode == 2) ? g_b : (knmode == 3 ? g_ds : g_dw)) + (wc & 1) * 32 + 8 * fq;
                        v0 = v0 * nrm * *(const f32x4*)gp; v1 = v1 * nrm * *(const f32x4*)(gp + 4);
                    }
                    u32x4 w; w[0] = pg8::cvt_pk_bf16(v0[0], v0[1]); w[1] = pg8::cvt_pk_bf16(v0[2], v0[3]); w[2] = pg8::cvt_pk_bf16(v1[0], v1[1]); w[3] = pg8::cvt_pk_bf16(v1[2], v1[3]);
                    *(u32x4*)(proj + (size_t)row * PINP + col0) = w;
                }
            }
    }
};
struct EpiResF {
    static constexpr bool PERM = false, AFTER_DRAIN = false;
    const float* xin; float* xout; const float* gate; const float* g; const float* sc; bf16_t* xa; float* rowss;
    __device__ __forceinline__ void operator()(const pg8::f32x4 (&acc)[2][2][4][2], const pg8::Unit& u, int wr, int wc, int fr, int fq) const {
        const int b = u.pm >> 4, col0 = u.pn * 256 + wc * 32 + 4 * fq;
        f32x4 gt[2][2], gm[2][2];
#pragma unroll
        for (int bj = 0; bj < 2; ++bj)
#pragma unroll
            for (int n = 0; n < 2; ++n) { const int c = col0 + bj * 128 + n * 16; gt[bj][n] = *(const f32x4*)(gate + b * 6144 + c);
                if (xa) gm[bj][n] = *(const f32x4*)(g + c) * (*(const f32x4*)(sc + b * 6144 + c) + 1.0f); else gm[bj][n] = (f32x4){0.f, 0.f, 0.f, 0.f}; }
#pragma unroll
        for (int ai = 0; ai < 2; ++ai)
#pragma unroll
            for (int mh = 0; mh < 2; ++mh) {
                f32x4 xi[2][2][2];
#pragma unroll
                for (int mm = 0; mm < 2; ++mm)
#pragma unroll
                    for (int bj = 0; bj < 2; ++bj)
#pragma unroll
                        for (int n = 0; n < 2; ++n)
                            xi[mm][bj][n] = *(const f32x4*)(xin + (size_t)(u.pm * 256 + ai * 128 + wr * 64 + (2 * mh + mm) * 16 + fr) * DM + col0 + bj * 128 + n * 16);
                asm volatile("" ::: "memory");
#pragma unroll
                for (int mm = 0; mm < 2; ++mm) {
                    const int m = 2 * mh + mm; const int row = u.pm * 256 + ai * 128 + wr * 64 + m * 16 + fr; float ss = 0.f;
#pragma unroll
                    for (int bj = 0; bj < 2; ++bj)
#pragma unroll
                        for (int n = 0; n < 2; ++n) { const size_t off = (size_t)row * DM + col0 + bj * 128 + n * 16;
                            const f32x4 o = xi[mm][bj][n] + gt[bj][n] * acc[ai][bj][m][n];
                            *(f32x4*)(xout + off) = o; ss += (o[0] * o[0] + o[1] * o[1]) + (o[2] * o[2] + o[3] * o[3]);
                            if (xa) { const f32x4 q = o * gm[bj][n]; uint2 w; w.x = pg8::cvt_pk_bf16(q[0], q[1]); w.y = pg8::cvt_pk_bf16(q[2], q[3]); *(uint2*)(xa + off) = w; } }
                    if (rowss) { ss += __shfl_xor(ss, 16); ss += __shfl_xor(ss, 32); if (fq == 0) rowss[(size_t)row * 16 + u.pn * 4 + wc] = ss; }
                }
            }
    }
};


#define DPPF(oldv, src, CTRL) __builtin_bit_cast(float, __builtin_amdgcn_update_dpp(__builtin_bit_cast(int, (float)(oldv)), __builtin_bit_cast(int, (float)(src)), (CTRL), 0xf, 0xf, false))
struct EpiUpAct {
    static constexpr bool PERM = true, AFTER_DRAIN = false;
    const float* rowss; const float* cb; bf16_t* act; float* eg; float* ev; const float* cw; const float* cbias; LDSF float* xch; LDSF float* cst  ;
    __device__ __forceinline__ void operator()(const pg8::f32x4 (&acc)[2][2][4][2], const pg8::Unit& u, int wr, int wc, int fr, int fq) const {
        const int b = u.pm >> 4, cih = wc * 32 + 8 * fq, jcol = u.pn * 128 + cih;
        const float* cbg = cb + b * NUP + u.pn * 256 + cih; const float* cbv = cbg + 128;
        {
            const int tid = (wr * 4 + wc) * 64 + fq * 16 + fr, col = tid & 127, arr = tid >> 7;
            const float* src = (arr == 0) ? cb + b * NUP + u.pn * 256 + col : (arr == 1) ? cb + b * NUP + u.pn * 256 + 128 + col : cw + (arr - 2) * DFF + u.pn * 128 + col;
            cst[arr * 128 + col] = *src;
            if (tid < 256) { const int a2 = 4 + (tid >> 7); cst[a2 * 128 + col] = (a2 == 4) ? cw[2 * DFF + u.pn * 128 + col] : cbias[u.pn * 128 + col]; }
            else cst[768 + (tid - 256)] = row_rstd16(rowss, u.pm * 256 + (tid - 256));
            const f32x4 cg0 = *(const f32x4*)cbg, cg1 = *(const f32x4*)(cbg + 4);
            const f32x4 cv0 = *(const f32x4*)cbv, cv1 = *(const f32x4*)(cbv + 4);
            asm volatile("s_waitcnt vmcnt(0) lgkmcnt(0)" ::: "memory"); __builtin_amdgcn_s_barrier(); asm volatile("" ::: "memory");
            const float r3a = cst[768 + 0 * 128 + wr * 64 + 48 + fr], r3b = cst[768 + 1 * 128 + wr * 64 + 48 + fr], r0 = cst[768 + (fr & 1)];
#pragma unroll
            for (int ai = 0; ai < 2; ++ai) {
                const float r3 = ai ? r3b : r3a;
                const f32x4 g0 = acc[ai][0][3][0] * r3 + cg0, g1 = acc[ai][0][3][1] * r3 + cg1;
                if (fr >= 14) { LDSF float* x = xch + ((((wr * 2 + ai) * 4 + wc) * 2 + (fr - 14)) * 32 + 8 * fq); *(LDSF f32x4*)x = g0; *(LDSF f32x4*)(x + 4) = g1;
                    if (wr == 1 && ai == 1) { float* e = eg + ((size_t)(u.pm * 4 + 2 + (fr - 14))) * DFF + jcol; *(f32x4*)e = g0; *(f32x4*)(e + 4) = g1; } }
            }
            if (wr == 0 && fr < 2) {
                float* e = eg + ((size_t)(u.pm * 4 + fr)) * DFF + jcol; float* v = ev + ((size_t)(u.pm * 2 + fr)) * DFF + jcol;
                *(f32x4*)e = acc[0][0][0][0] * r0 + cg0; *(f32x4*)(e + 4) = acc[0][0][0][1] * r0 + cg1;
                *(f32x4*)v = acc[0][1][0][0] * r0 + cv0; *(f32x4*)(v + 4) = acc[0][1][0][1] * r0 + cv1;
            }
        }
        asm volatile("s_waitcnt lgkmcnt(0)" ::: "memory"); __builtin_amdgcn_s_barrier(); asm volatile("" ::: "memory");
#pragma unroll
        for (int ai = 0; ai < 2; ++ai) {
            f32x4 pvv[2];
            if (ai == 0 && wr == 0) { pvv[0] = (f32x4){0.f, 0.f, 0.f, 0.f}; pvv[1] = pvv[0]; }
            else { const int swr = (wr == 1) ? 0 : 1, sai = (wr == 1) ? ai : ai - 1;
                const LDSF float* x = xch + ((((swr * 2 + sai) * 4 + wc) * 2 + (fr & 1)) * 32 + 8 * fq); pvv[0] = *(const LDSF f32x4*)x; pvv[1] = *(const LDSF f32x4*)(x + 4); }
#pragma unroll
            for (int m = 0; m < 4; ++m) {
                asm volatile("" ::: "memory");
                const int row = u.pm * 256 + ai * 128 + wr * 64 + m * 16 + fr; const float rsm = cst[768 + ai * 128 + wr * 64 + m * 16 + fr];
                u32x4 w;
#pragma unroll
                for (int n = 0; n < 2; ++n) {
                    const LDSF float* cc = cst + cih + 4 * n;
                    const f32x4 cgn = *(const LDSF f32x4*)cc, cvn = *(const LDSF f32x4*)(cc + 128);
                    const f32x4 k0 = *(const LDSF f32x4*)(cc + 256), k1 = *(const LDSF f32x4*)(cc + 384), k2 = *(const LDSF f32x4*)(cc + 512), kb = *(const LDSF f32x4*)(cc + 640);
                    const f32x4 c = acc[ai][0][m][n] * rsm + cgn, v = acc[ai][1][m][n] * rsm + cvn; float o[4];
#pragma unroll
                    for (int i = 0; i < 4; ++i) {
                        const float gm1 = DPPF(DPPF(0.f, pvv[n][i], 0x121), c[i], 0x111);
                        const float gm2 = DPPF(DPPF(0.f, pvv[n][i], 0x122), c[i], 0x112);
                        const float cvv = k0[i] * gm2 + k1[i] * gm1 + k2[i] * c[i] + kb[i];
                        o[i] = cvv * __builtin_amdgcn_rcpf(1.f + __builtin_amdgcn_exp2f(-cvv * LOG2E)) * v[i];
                    }
                    w[2 * n] = pg8::cvt_pk_bf16(o[0], o[1]); w[2 * n + 1] = pg8::cvt_pk_bf16(o[2], o[3]);
                    pvv[n] = c;
                }
                *(u32x4*)(act + (size_t)row * DFF + jcol) = w;
            }
        }
    }
};
__device__ void act_fixup(const Params& p, int l, int pm) {
    if ((pm & 15) == 0) return;
    const float* eg = (const float*)(p.ws + WS_EG); const float* ev = (const float*)(p.ws + WS_EV); bf16_t* act = (bf16_t*)(p.ws + WS_ACT);
    const float* cw = p.conv_w + (size_t)l * 3 * DFF; const float* cbias = p.conv_b + (size_t)l * DFF;
    const int tid = TID();
    constexpr int NB4 = 4;
#pragma unroll 1
    for (int bt = 0; bt < 3; ++bt) {
        float a[NB4], bq[NB4], c0[NB4], c1[NB4], vv[NB4], k0[NB4], k1[NB4], k2[NB4], kb[NB4];
#pragma unroll
        for (int i = 0; i < NB4; ++i) { const int idx = min(tid + (bt * NB4 + i) * NTHR, 2 * DFF - 1); const int r = idx / DFF, j = idx - r * DFF;
            a[i] = eg[((size_t)((pm - 1) * 4 + 2)) * DFF + j]; bq[i] = eg[((size_t)((pm - 1) * 4 + 3)) * DFF + j]; c0[i] = eg[((size_t)(pm * 4 + 0)) * DFF + j]; c1[i] = eg[((size_t)(pm * 4 + 1)) * DFF + j];
            vv[i] = ev[((size_t)(pm * 2 + r)) * DFF + j]; k0[i] = cw[j]; k1[i] = cw[DFF + j]; k2[i] = cw[2 * DFF + j]; kb[i] = cbias[j]; }
        asm volatile("" ::: "memory");
#pragma unroll
        for (int i = 0; i < NB4; ++i) { const int idx = tid + (bt * NB4 + i) * NTHR;
            if (idx < 2 * DFF) { const int r = idx / DFF, j = idx - r * DFF;
                const float gm2 = r ? bq[i] : a[i], gm1 = r ? c0[i] : bq[i], gc = r ? c1[i] : c0[i];
                const float cvv = k0[i] * gm2 + k1[i] * gm1 + k2[i] * gc + kb[i];
                act[(size_t)(pm * 256 + r) * DFF + j] = f2bf(siluf(cvv) * vv[i]); } }
    }
}

__device__ void ph_prep_cum_bh(const Params& p, int l, int bh, unsigned char* lds) {
    const float* side = (const float*)(p.ws + WS_SIDE);
    float* cum = (float*)(p.ws + WS_CUM);
    LDSF float* wt = (LDSF float*)(lds + 70000);
    const int tid = TID(), lane = tid & 63, wv = tid >> 6;
    {
        const int b = bh >> 2, h = bh & 3; const float bf = p.fox_bf[l * 4 + h];
        float v[8]; float tot = 0.f;
#pragma unroll
        for (int i = 0; i < 8; ++i) { v[i] = logsigf(side[(size_t)(b * SEQ + tid * 8 + i) * 16 + h] + bf); tot += v[i]; v[i] = tot; }
        float inc = tot;
#pragma unroll
        for (int o = 1; o < 64; o <<= 1) { const float u = __shfl_up(inc, o); if (lane >= o) inc += u; }
        __syncthreads();
        if (lane == 63) wt[wv] = inc;
        __syncthreads();
        float base = inc - tot;
        for (int w8 = 0; w8 < wv; ++w8) base += wt[w8];
#pragma unroll
        for (int i = 0; i < 8; ++i) cum[bh * SEQ + tid * 8 + i] = base + v[i];
    }
}
template <int N> __device__ __forceinline__ float dotn(const float* q, const bf16_t* k) {
    float s = 0.f;
#pragma unroll
    for (int c = 0; c < N / 8; ++c) { float t[8]; load8(k + 8 * c, t);
#pragma unroll
        for (int j = 0; j < 8; ++j) s += q[8 * c + j] * t[j]; }
    return s;
}
template <int N> __device__ __forceinline__ void axpyn(float* o, float w, const bf16_t* v) {
#pragma unroll
    for (int c = 0; c < N / 8; ++c) { float t[8]; load8(v + 8 * c, t);
#pragma unroll
        for (int j = 0; j < 8; ++j) o[8 * c + j] += w * t[j]; }
}
template <int N> __device__ __forceinline__ void loadq_norm(float* q, const bf16_t* src, const float* g, float scale, bool norm) {
    float ss = 0.f;
#pragma unroll
    for (int c = 0; c < N / 8; ++c) load8(src + 8 * c, q + 8 * c);
#pragma unroll
    for (int j = 0; j < N; ++j) ss += q[j] * q[j];
    const float r = norm ? rsqrtf(ss * (1.f / N) + EPS) : 1.f;
#pragma unroll
    for (int j = 0; j < N; ++j) q[j] = q[j] * r * (norm ? g[j] : 1.f) * scale;
}
__device__ __forceinline__ void store64(bf16_t* dst, const float* o) {
#pragma unroll
    for (int c = 0; c < 8; ++c) { u32x4 w; w[0] = pk2(o[8 * c], o[8 * c + 1]); w[1] = pk2(o[8 * c + 2], o[8 * c + 3]); w[2] = pk2(o[8 * c + 4], o[8 * c + 5]); w[3] = pk2(o[8 * c + 6], o[8 * c + 7]); *(u32x4*)(dst + 8 * c) = w; }
}

typedef float f32x16 __attribute__((ext_vector_type(16)));
typedef short s16x4 __attribute__((ext_vector_type(4)));
#define LDSP __attribute__((address_space(3)))
constexpr int KSTR = 144;
constexpr int AL_KV = 17408;
constexpr int AL_BK = 2 * AL_KV  , AL_TB = AL_BK + 512  , AL_WSF = AL_TB + 512  , AL_MISC = AL_WSF + 2048  ,
              AL_IMP = 38912  , AL_SELM = AL_IMP + 65536  ,
              AL_TB4 = AL_SELM + 512  , AL_INVL = AL_TB4 + 2048  , AL_D_END = AL_INVL + 1024;
static_assert(AL_MISC + 64 <= AL_IMP && AL_D_END <= 131072, "attention LDS map");
__device__ __forceinline__ int crow(int r, int hi) { return (r & 3) + 8 * (r >> 2) + 4 * hi; }
__device__ __forceinline__ float ex2(float v) { return __builtin_amdgcn_exp2f(v); }
__device__ __forceinline__ s16x4 vtr(const LDSP unsigned char* p) { typedef short v4i16_t __attribute__((ext_vector_type(4))); return __builtin_bit_cast(s16x4, __builtin_amdgcn_ds_read_tr16_b64_v4i16((LDSP v4i16_t*)p)); }
__device__ __forceinline__ bf16x8 pack8(const f32x16& p, int b) {
    u32x4 w; w[0] = pg8::cvt_pk_bf16(p[b], p[b + 1]); w[1] = pg8::cvt_pk_bf16(p[b + 2], p[b + 3]); w[2] = pg8::cvt_pk_bf16(p[b + 4], p[b + 5]); w[3] = pg8::cvt_pk_bf16(p[b + 6], p[b + 7]);
    return __builtin_bit_cast(bf16x8, w);
}
__device__ __forceinline__ f32x16 splat16(float v) { return (f32x16){v, v, v, v, v, v, v, v, v, v, v, v, v, v, v, v}; }
template <int NK16>
__device__ __forceinline__ void qkt(f32x16& p0, f32x16& p1, const LDSP unsigned char* Kt, const bf16x8* qf, int dbase, int r32, int hi) {
    const LDSP unsigned char* kb = Kt + r32 * KSTR + hi * 16 + dbase * 32;
#pragma unroll
    for (int d0 = 0; d0 < NK16; ++d0) {
        const bf16x8 a0 = *(const LDSP bf16x8*)(kb + d0 * 32), a1 = *(const LDSP bf16x8*)(kb + 32 * KSTR + d0 * 32);
        p0 = __builtin_amdgcn_mfma_f32_32x32x16_bf16(a0, qf[d0], p0, 0, 0, 0);
        p1 = __builtin_amdgcn_mfma_f32_32x32x16_bf16(a1, qf[d0], p1, 0, 0, 0);
    }
}
__device__ __forceinline__ void pv(f32x16* o, const LDSP unsigned char* Vt, int vb, const f32x16& p0, const f32x16& p1) {
    bf16x8 pa[4]; pa[0] = pack8(p0, 0); pa[1] = pack8(p0, 8); pa[2] = pack8(p1, 0); pa[3] = pack8(p1, 8);
#pragma unroll
    for (int d0 = 0; d0 < 2; ++d0)
#pragma unroll
        for (int ks = 0; ks < 4; ++ks) {
            const s16x4 lo = vtr(Vt + vb + d0 * 4096 + ks * 1024), hh = vtr(Vt + vb + d0 * 4096 + ks * 1024 + 512);
            const bf16x8 vf = (bf16x8){lo[0], lo[1], lo[2], lo[3], hh[0], hh[1], hh[2], hh[3]};
            o[d0] = __builtin_amdgcn_mfma_f32_32x32x16_bf16(pa[ks], vf, o[d0], 0, 0, 0);
        }
}
__device__ __forceinline__ float exp_sum(f32x16& p0, f32x16& p1) {
    float s0 = 0.f, s1 = 0.f;
#pragma unroll
    for (int r = 0; r < 16; ++r) { p0[r] = ex2(p0[r]); p1[r] = ex2(p1[r]); s0 += p0[r]; s1 += p1[r]; }
    return s0 + s1;
}
__device__ __forceinline__ void scale_rows(f32x16* o, float f, LDSP float* wsf, int r32, int hi) {
    __builtin_amdgcn_wave_barrier();
    if (hi == 0) wsf[r32] = f;
    __builtin_amdgcn_s_waitcnt(0xc07f);
    __builtin_amdgcn_wave_barrier();
#pragma unroll
    for (int g = 0; g < 4; ++g) { const f32x4 a = *(const LDSP f32x4*)(wsf + 8 * g + 4 * hi);
#pragma unroll
        for (int i = 0; i < 4; ++i) { o[0][4 * g + i] *= a[i]; o[1][4 * g + i] *= a[i]; } }
    __builtin_amdgcn_wave_barrier();
}
__device__ __forceinline__ void store_o(const f32x16* o, LDSP bf16_t* stg, bf16_t* dst, int lane, int r32, int hi) {
    __builtin_amdgcn_wave_barrier();
#pragma unroll
    for (int r = 0; r < 16; ++r) { const int orow = crow(r, hi); stg[orow * 64 + r32] = f2bf(o[0][r]); stg[orow * 64 + 32 + r32] = f2bf(o[1][r]); }
    __builtin_amdgcn_s_waitcnt(0xc07f);
    __builtin_amdgcn_wave_barrier();
#pragma unroll
    for (int i = 0; i < 4; ++i) { const int row = i * 8 + (lane >> 3), ch = lane & 7; const u32x4 v = *(const LDSP u32x4*)(stg + row * 64 + ch * 8); *(u32x4*)(dst + (size_t)row * DM + ch * 8) = v; }
    __builtin_amdgcn_s_waitcnt(0xc07f);
    __builtin_amdgcn_wave_barrier();
}
template <int NG>
__device__ __forceinline__ void load_q(bf16x8* qf, const bf16_t* qrow  , const float* g, float sc, bool norm, int hi) {
    float v[4][8];
#pragma unroll
    for (int d0 = 0; d0 < 4; ++d0) load8(qrow + 16 * d0 + 8 * hi, v[d0]);
    float r0 = 1.f, r1 = 1.f;
    if (norm) {
        float s0 = 0.f, s1 = 0.f;
#pragma unroll
        for (int j = 0; j < 8; ++j) { s0 += v[0][j] * v[0][j] + v[1][j] * v[1][j]; s1 += v[2][j] * v[2][j] + v[3][j] * v[3][j]; }
        s0 += __shfl_xor(s0, 32); s1 += __shfl_xor(s1, 32);
        if (NG == 64) { r0 = rsqrtf((s0 + s1) * (1.f / 64.f) + EPS); r1 = r0; } else { r0 = rsqrtf(s0 * (1.f / 32.f) + EPS); r1 = rsqrtf(s1 * (1.f / 32.f) + EPS); }
    }
#pragma unroll
    for (int d0 = 0; d0 < 4; ++d0) {
        const float rr = (d0 < 2 ? r0 : r1) * sc; float w[8];
#pragma unroll
        for (int j = 0; j < 8; ++j) { const int d = 16 * d0 + 8 * hi + j; w[j] = v[d0][j] * rr * (norm ? g[d % NG] : 1.f); }
        u32x4 u; u[0] = pg8::cvt_pk_bf16(w[0], w[1]); u[1] = pg8::cvt_pk_bf16(w[2], w[3]); u[2] = pg8::cvt_pk_bf16(w[4], w[5]); u[3] = pg8::cvt_pk_bf16(w[6], w[7]);
        qf[d0] = __builtin_bit_cast(bf16x8, u);
    }
}
__device__ __forceinline__ void kv_load(u32x4& kr, u32x4& vr, const bf16_t* Kb, const bf16_t* Vb, int k0, int tid) {
    const size_t off = (size_t)(k0 + (tid >> 3)) * PINP + (tid & 7) * 8;
    kr = *(const u32x4*)(Kb + off); vr = *(const u32x4*)(Vb + off);
}
__device__ __forceinline__ void kv_load64(u32x4& kr, u32x4& vr, const bf16_t* Kb, const bf16_t* Vb, int n0, int tid) {
    const size_t off = (size_t)(n0 + (tid >> 3)) * 64 + (tid & 7) * 8;
    kr = *(const u32x4*)(Kb + off); vr = *(const u32x4*)(Vb + off);
}
__device__ __forceinline__ void kv_store(const u32x4& kr, const u32x4& vr, LDSP unsigned char* buf, int tid) {
    const int key = tid >> 3, ch = tid & 7;
    *(LDSP u32x4*)(buf + key * KSTR + ch * 16) = kr;
    *(LDSP u32x4*)(buf + 9216 + (ch >> 2) * 4096 + (key >> 4) * 1024 + ((key >> 3) & 1) * 512 + (key & 7) * 64 + (ch & 3) * 16) = vr;
}
template <int NG>
__device__ __forceinline__ void knorm_chunk(u32x4& kr, const float* gp  ) {
    float v[8];
    v[0] = bf2f(kr[0] & 0xffff); v[1] = bf2f(kr[0] >> 16); v[2] = bf2f(kr[1] & 0xffff); v[3] = bf2f(kr[1] >> 16);
    v[4] = bf2f(kr[2] & 0xffff); v[5] = bf2f(kr[2] >> 16); v[6] = bf2f(kr[3] & 0xffff); v[7] = bf2f(kr[3] >> 16);
    float ss = 0.f;
#pragma unroll
    for (int j = 0; j < 8; ++j) ss += v[j] * v[j];
    ss += __shfl_xor(ss, 1); ss += __shfl_xor(ss, 2); if (NG == 64) ss += __shfl_xor(ss, 4);
    const float r = rsqrtf(ss * (1.f / NG) + EPS);
    const f32x4 ga = *(const f32x4*)gp, gb = *(const f32x4*)(gp + 4);
    kr[0] = pg8::cvt_pk_bf16(v[0] * r * ga[0], v[1] * r * ga[1]); kr[1] = pg8::cvt_pk_bf16(v[2] * r * ga[2], v[3] * r * ga[3]);
    kr[2] = pg8::cvt_pk_bf16(v[4] * r * gb[0], v[5] * r * gb[1]); kr[3] = pg8::cvt_pk_bf16(v[6] * r * gb[2], v[7] * r * gb[3]);
}
__device__ __forceinline__ void bias_near(f32x16& p0, f32x16& p1, const LDSP float* tbl, int tk0  , int wnd, bool rowok, int hi) {
#pragma unroll
    for (int g = 0; g < 4; ++g) {
#pragma unroll
        for (int i = 0; i < 4; ++i) { const int r = 4 * g + i; const int d0_ = tk0 - crow(r, hi), d1_ = d0_ - 32;
            const float b0 = tbl[min(max(d0_, 0), 127)], b1 = tbl[min(max(d1_, 0), 127)];
            p0[r] = (d0_ < 0 || d0_ >= wnd || !rowok) ? -INFINITY : p0[r] + b0; p1[r] = (d1_ < 0 || d1_ >= wnd || !rowok) ? -INFINITY : p1[r] + b1; }
        asm volatile("" ::: "memory");
    }
}
#define KVBUF(L, i) ((L) + ((i) & 1) * AL_KV)

__device__ void fa_fox_unit(const Params& p, int l, int b, int h, int qb, LDSP unsigned char* L) {
    const int tid = TID(), lane = tid & 63, wid = __builtin_amdgcn_readfirstlane(tid >> 6), r32 = lane & 31, hi = lane >> 5;
    const bf16_t* proj = (const bf16_t*)(p.ws + WS_PROJ); bf16_t* mix = (bf16_t*)(p.ws + WS_MIX);
    const size_t rb = (size_t)b * SEQ; const int q0 = qb * 256, qw = q0 + 32 * wid, t = qw + r32;
    const bf16_t* Kb = proj + rb * PINP + CB_K + 64 * h; const bf16_t* Vb = proj + rb * PINP + CB_V + 64 * h;
    const float* cm = (const float*)(p.ws + WS_CUM) + (b * 4 + h) * SEQ;
    LDSP float* wsf = (LDSP float*)(L + AL_WSF) + wid * 64; LDSP float* bk = (LDSP float*)(L + AL_BK);
    const int vb = 9216 + ((lane >> 4) & 1) * 32 + (lane & 3) * 8 + (4 * hi + ((lane & 15) >> 2)) * 64;
    bf16x8 qf[4]; load_q<64>(qf, proj + (rb + t) * PINP + CB_Q + 64 * h, p.fox_qn + l * 64, 0.125f * LOG2E, true, hi);
    const float rowc = cm[t] * LOG2E - ((const float*)(p.ws + WS_BND))[l * 32 + 4];
    f32x16 o[2]; o[0] = (f32x16){}; o[1] = (f32x16){};
    float l_run = 0.f;
    const int NT = 4 * qb + 4, jd = 4 * qb + (wid >> 1);
    u32x4 kr, vr; float cr = 0.f; const float* gk = p.fox_kn + l * 64 + (tid & 7) * 8;
    int js;
    {   const bool live = (lane < NT) ? ((cm[q0] - cm[64 * lane + 63]) * LOG2E >= -160.f) : false;
        const unsigned long long bm = __ballot(live);
        js = __builtin_amdgcn_readfirstlane((int)__builtin_ctzll(bm | (1ull << (NT - 1)))); if (js > NT - 2) js = NT - 2; }
    __syncthreads();
    kv_load(kr, vr, Kb, Vb, 64 * js, tid); if (tid < 64) cr = cm[64 * js + tid];
    kv_store(kr, vr, KVBUF(L, js), tid); if (tid < 64) bk[(js & 1) * 64 + tid] = -cr * LOG2E;
    kv_load(kr, vr, Kb, Vb, 64 * (js + 1), tid); if (tid < 64) cr = cm[64 * (js + 1) + tid];
    for (int j = js; j < NT; ++j) {
        __syncthreads();
        if (j + 1 < NT) { kv_store(kr, vr, KVBUF(L, j + 1), tid); if (tid < 64) bk[((j + 1) & 1) * 64 + tid] = -cr * LOG2E; }
        if (j + 2 < NT) { kv_load(kr, vr, Kb, Vb, 64 * (j + 2), tid); if (tid < 64) cr = cm[64 * (j + 2) + tid]; }
        if (j <= jd) {
            const LDSP unsigned char* buf = KVBUF(L, j); const LDSP float* bkj = bk + (j & 1) * 64;
            f32x16 p0, p1;
#pragma unroll
            for (int g = 0; g < 4; ++g) { const f32x4 b0 = *(const LDSP f32x4*)(bkj + 8 * g + 4 * hi), b1 = *(const LDSP f32x4*)(bkj + 32 + 8 * g + 4 * hi);
#pragma unroll
                for (int i = 0; i < 4; ++i) { p0[4 * g + i] = b0[i] + rowc; p1[4 * g + i] = b1[i] + rowc; } }
            qkt<4>(p0, p1, buf, qf, 0, r32, hi);
            if (j == jd) { const int k0 = 64 * j;
#pragma unroll
                for (int r = 0; r < 16; ++r) { const int kk = k0 + crow(r, hi); if (kk > t) p0[r] = -INFINITY; if (kk + 32 > t) p1[r] = -INFINITY; } }
            l_run += exp_sum(p0, p1);
            pv(o, buf, vb, p0, p1);
        }
    }
    l_run += __shfl_xor(l_run, 32);
    scale_rows(o, 1.f / l_run, wsf, r32, hi);
    store_o(o, (LDSP bf16_t*)(L + AL_IMP + wid * 8192), mix + (rb + qw) * DM + 256 + 64 * h, lane, r32, hi);
}

__device__ void fa_diff_unit(const Params& p, int l, int b, int h, int qb, LDSP unsigned char* L) {
    const int tid = TID(), lane = tid & 63, wid = __builtin_amdgcn_readfirstlane(tid >> 6), r32 = lane & 31, hi = lane >> 5;
    const bf16_t* proj = (const bf16_t*)(p.ws + WS_PROJ); bf16_t* mix = (bf16_t*)(p.ws + WS_MIX);
    const size_t rb = (size_t)b * SEQ; const int q0 = qb * 256, qw = q0 + 32 * wid, t = qw + r32;
    const bf16_t* Kb = proj + rb * PINP + CA_K + 64 * h; const bf16_t* Vb = proj + rb * PINP + CA_V + 64 * h;
    LDSP float* wsf = (LDSP float*)(L + AL_WSF) + wid * 64; LDSP float* tbl = (LDSP float*)(L + AL_TB);
    const int vb = 9216 + ((lane >> 4) & 1) * 32 + (lane & 3) * 8 + (4 * hi + ((lane & 15) >> 2)) * 64;
    const float lam = ((const float*)(p.ws + WS_LAM))[l]; const float lam_init = 0.8f - 0.6f * __expf(-0.3f * (float)l);
    const float nbound = -((const float*)(p.ws + WS_BND))[l * 32 + h];
    __syncthreads();
    if (tid < 128) tbl[tid] = ((const float*)(p.ws + WS_TB))[h * 128 + tid] * LOG2E;
    bf16x8 qf[4]; load_q<32>(qf, proj + (rb + t) * PINP + CA_Q + 64 * h, p.diff_qn + l * 32, 0.17677669529663687f * LOG2E, true, hi);
    f32x16 o1[2], o2[2]; o1[0] = (f32x16){}; o1[1] = (f32x16){}; o2[0] = (f32x16){}; o2[1] = (f32x16){};
    float l1 = 0.f, l2 = 0.f;
    const int NT = 4 * qb + 4, jd = 4 * qb + (wid >> 1);
    u32x4 kr, vr; const float* gk = p.diff_kn + l * 32 + (tid & 3) * 8;
    kv_load(kr, vr, Kb, Vb, 0, tid);
    kv_store(kr, vr, KVBUF(L, 0), tid);
    kv_load(kr, vr, Kb, Vb, 64, tid);
    for (int j = 0; j < NT; ++j) {
        __syncthreads();
        if (j + 1 < NT) { kv_store(kr, vr, KVBUF(L, j + 1), tid); }
        if (j + 2 < NT) kv_load(kr, vr, Kb, Vb, 64 * (j + 2), tid);
        if (j <= jd) {
            const LDSP unsigned char* buf = KVBUF(L, j);
            const int k0 = 64 * j; const bool nearb = (qw - (k0 + 63)) < 113; const float cfar = tbl[127] + nbound;
#pragma unroll
            for (int mp = 0; mp < 2; ++mp) {
                f32x16 p0 = splat16(nearb ? nbound : cfar), p1 = p0;
                qkt<2>(p0, p1, buf, qf + 2 * mp, 2 * mp, r32, hi);
                if (nearb) bias_near(p0, p1, tbl, t - k0, 1 << 30, true, hi);
                if (mp == 0) { l1 += exp_sum(p0, p1); pv(o1, buf, vb, p0, p1); }
                else { l2 += exp_sum(p0, p1); pv(o2, buf, vb, p0, p1); }
            }
        }
    }
    l1 += __shfl_xor(l1, 32); l2 += __shfl_xor(l2, 32);
    scale_rows(o1, 1.f / l1, wsf, r32, hi); scale_rows(o2, lam / l2, wsf, r32, hi);
    o1[0] -= o2[0]; o1[1] -= o2[1];
    const float g0 = p.diff_sub[l * 64 + r32] * (1.f - lam_init), g1 = p.diff_sub[l * 64 + 32 + r32] * (1.f - lam_init);
#pragma unroll
    for (int r = 0; r < 16; ++r) {
        float ss = o1[0][r] * o1[0][r] + o1[1][r] * o1[1][r];
        ss += __shfl_xor(ss, 1); ss += __shfl_xor(ss, 2); ss += __shfl_xor(ss, 4); ss += __shfl_xor(ss, 8); ss += __shfl_xor(ss, 16);
        const float rs = rsqrtf(ss * (1.f / 64.f) + EPS); o1[0][r] *= rs * g0; o1[1][r] *= rs * g1;
    }
    store_o(o1, (LDSP bf16_t*)(L + AL_IMP + wid * 8192), mix + (rb + qw) * DM + 0 + 64 * h, lane, r32, hi);
}

template <bool DIAG>
__device__ __forceinline__ void stick_sub(f32x16& y, float& carry, int kbase  , int t, int hi) {
    float lk[16];
#pragma unroll
    for (int r = 0; r < 16; ++r) {
        const float v = y[r]; const float e = ex2(-fabsf(v)); const float lb = fminf(v, 0.f) - __builtin_amdgcn_logf(1.f + e);
        if (DIAG) { const bool valid = (kbase + crow(r, hi) < t); lk[r] = valid ? (lb - v) : 0.f; y[r] = valid ? lb : -INFINITY; }
        else { lk[r] = lb - v; y[r] = lb; }
    }
    float T[4], Go[4];
#pragma unroll
    for (int g = 0; g < 4; ++g) { const float Gs = (lk[4 * g] + lk[4 * g + 1]) + (lk[4 * g + 2] + lk[4 * g + 3]); Go[g] = __shfl_xor(Gs, 32); T[g] = Gs + Go[g]; }
    float sx = 0.f;
#pragma unroll
    for (int g = 3; g >= 0; --g) {
        float tail = carry + sx + (hi == 0 ? Go[g] : 0.f);
#pragma unroll
        for (int i = 3; i >= 0; --i) { y[4 * g + i] = ex2(y[4 * g + i] + tail); tail += lk[4 * g + i]; }
        sx += T[g];
    }
    carry += sx;
}
__device__ void fa_stick_unit(const Params& p, int l, int b, int h, int qb, LDSP unsigned char* L) {
    const int tid = TID(), lane = tid & 63, wid = __builtin_amdgcn_readfirstlane(tid >> 6), r32 = lane & 31, hi = lane >> 5;
    const bf16_t* proj = (const bf16_t*)(p.ws + WS_PROJ); bf16_t* mix = (bf16_t*)(p.ws + WS_MIX);
    const size_t rb = (size_t)b * SEQ; const int q0 = qb * 256, qw = q0 + 32 * wid, t = qw + r32;
    const bf16_t* Kb = proj + rb * PINP + CC_K + 64 * h; const bf16_t* Vb = proj + rb * PINP + CC_V + 64 * h;
    const int vb = 9216 + ((lane >> 4) & 1) * 32 + (lane & 3) * 8 + (4 * hi + ((lane & 15) >> 2)) * 64;
    bf16x8 qf[4]; load_q<64>(qf, proj + (rb + t) * PINP + CC_Q + 64 * h, nullptr, 0.125f * LOG2E, false, hi);
    f32x16 o[2]; o[0] = (f32x16){}; o[1] = (f32x16){};
    float carry = 0.f;
    const int NT = 4 * qb + 4, jd = 4 * qb + (wid >> 1);
    u32x4 kr, vr;
#define SBUF(i) (((i) & 1) ? (L + 108544) : L)
    LDSP unsigned* dn = (LDSP unsigned*)(L + AL_MISC) + 8;
    bool wdone = false;
    __syncthreads();
    if (lane == 0) dn[wid] = 0u;
    kv_load(kr, vr, Kb, Vb, 64 * (NT - 1), tid);
    kv_store(kr, vr, SBUF(NT - 1), tid);
    kv_load(kr, vr, Kb, Vb, 64 * (NT - 2), tid);
    for (int j = NT - 1; j >= 0; --j) {
        __syncthreads();
        if (__all(dn[lane & 7] != 0u)) break;
        if (j >= 1) kv_store(kr, vr, SBUF(j - 1), tid);
        if (j >= 2) kv_load(kr, vr, Kb, Vb, 64 * (j - 2), tid);
        if (j <= jd && !wdone) {
            const LDSP unsigned char* buf = SBUF(j);
            f32x16 p0 = (f32x16){}, p1 = (f32x16){};
            qkt<4>(p0, p1, buf, qf, 0, r32, hi);
            const int k0 = 64 * j; const bool diag = (j == jd);
            if (diag) { stick_sub<true>(p1, carry, k0 + 32, t, hi); stick_sub<true>(p0, carry, k0, t, hi); }
            else { stick_sub<false>(p1, carry, k0 + 32, t, hi); stick_sub<false>(p0, carry, k0, t, hi); }
            pv(o, buf, vb, p0, p1);
            if (__all(carry < -160.f)) { wdone = true; if (lane == 0) dn[wid] = 1u; }
        }
    }
    store_o(o, (LDSP bf16_t*)(L + AL_IMP + wid * 8192), mix + (rb + qw) * DM + 512 + 64 * h, lane, r32, hi);
}

__device__ void fa_nsa_unit(const Params& p, int l, int b, int u, LDSP unsigned char* L) {
    const int tid = TID(), lane = tid & 63, wid = __builtin_amdgcn_readfirstlane(tid >> 6), r32 = lane & 31, hi = lane >> 5;
    const int hh = wid >> 1, sub = wid & 1;
    const bf16_t* proj = (const bf16_t*)(p.ws + WS_PROJ); bf16_t* mix = (bf16_t*)(p.ws + WS_MIX);
    const size_t rb = (size_t)b * SEQ; const int q0 = 64 * u, qw = q0 + 32 * sub, t = qw + r32; const int ql = 32 * sub + r32;
    LDSP float* wsf = (LDSP float*)(L + AL_WSF) + wid * 64; LDSP float* tbl = (LDSP float*)(L + AL_TB4) + hh * 128;
    LDSP float* imp = (LDSP float*)(L + AL_IMP); LDSP unsigned* selm = (LDSP unsigned*)(L + AL_SELM); LDSP float* invl = (LDSP float*)(L + AL_INVL);
    LDSP float* ofl = (LDSP float*)(L + AL_IMP) + wid * 2048 + lane;
    const int vb = 9216 + ((lane >> 4) & 1) * 32 + (lane & 3) * 8 + (4 * hi + ((lane & 15) >> 2)) * 64;
    const float* bnd = (const float*)(p.ws + WS_BND) + l * 32;
    __syncthreads();
    ((LDSP float*)(L + AL_TB4))[tid] = ((const float*)(p.ws + WS_TB))[512 + tid] * LOG2E;
    bf16x8 qf[4]; load_q<64>(qf, proj + (rb + t) * PINP + CD_Q + 64 * hh, p.nsa_qn + l * 64, 0.125f * LOG2E, true, hi);
    const float* sd = (const float*)(p.ws + WS_SIDE) + (rb + t) * 16 + 4 + hh;
    const float gc = 1.f / (1.f + __expf(-sd[0])), gs = 1.f / (1.f + __expf(-sd[4])), gwn = 1.f / (1.f + __expf(-sd[8]));
    f32x16 o[2]; o[0] = (f32x16){}; o[1] = (f32x16){};
    u32x4 kr, vr;
    {
        const bf16_t* Kc = (const bf16_t*)(p.ws + WS_KC) + (size_t)b * 256 * 64; const bf16_t* Vc = (const bf16_t*)(p.ws + WS_VC) + (size_t)b * 256 * 64;
        const int ntc = (4 * u + 2) / 64 + 1; const float nbound = -bnd[5 + hh];
        float l_run = 0.f, prevE3 = 0.f;
        kv_load64(kr, vr, Kc, Vc, 0, tid);
        kv_store(kr, vr, KVBUF(L, 0), tid);
        if (ntc > 1) kv_load64(kr, vr, Kc, Vc, 64, tid);
        for (int T = 0; T < ntc; ++T) {
            __syncthreads();
            if (T + 1 < ntc) kv_store(kr, vr, KVBUF(L, T + 1), tid);
            if (T + 2 < ntc) kv_load64(kr, vr, Kc, Vc, 64 * (T + 2), tid);
            const LDSP unsigned char* buf = KVBUF(L, T);
            f32x16 p0 = splat16(nbound), p1 = p0;
            qkt<4>(p0, p1, buf, qf, 0, r32, hi);
#pragma unroll
            for (int g = 0; g < 4; ++g) {
#pragma unroll
                for (int i = 0; i < 4; ++i) { const int r = 4 * g + i; const int d0_ = t - 16 * (64 * T + crow(r, hi)) - 31, d1_ = d0_ - 512;
                    const float b0 = tbl[min(max(d0_, 0), 127)], b1 = tbl[min(max(d1_, 0), 127)];
                    p0[r] = (d0_ < 0) ? -INFINITY : p0[r] + b0; p1[r] = (d1_ < 0) ? -INFINITY : p1[r] + b1; }
                asm volatile("" ::: "memory");
            }
            l_run += exp_sum(p0, p1);
#pragma unroll
            for (int s2 = 0; s2 < 2; ++s2) {
                float G[4], Eo[4];
#pragma unroll
                for (int g = 0; g < 4; ++g) { const float a0 = s2 ? p1[4 * g] : p0[4 * g], a1 = s2 ? p1[4 * g + 1] : p0[4 * g + 1], a2 = s2 ? p1[4 * g + 2] : p0[4 * g + 2], a3 = s2 ? p1[4 * g + 3] : p0[4 * g + 3];
                    G[g] = (a0 + a1) + (a2 + a3); Eo[g] = __shfl_xor(a3, 32); }
#pragma unroll
                for (int g = 0; g < 4; ++g) { const float eprev = hi ? Eo[g] : (g > 0 ? Eo[g - 1] : prevE3);
                    imp[(hh * 64 + ql) * 64 + 16 * T + 8 * s2 + 2 * g + hi] = G[g] + eprev; }
                prevE3 = Eo[3];
            }
            pv(o, buf, vb, p0, p1);
        }
        l_run += __shfl_xor(l_run, 32);
        const float inv = (l_run > 0.f) ? 1.f / l_run : 0.f;
        if (hi == 0) invl[hh * 64 + ql] = inv;
        scale_rows(o, gc * inv, wsf, r32, hi);
    }
    __syncthreads();
    {
        const int q = tid >> 3, part = tid & 7;
        const float i0 = invl[q], i1 = invl[64 + q], i2 = invl[128 + q], i3 = invl[192 + q];
        float vj[8];
#pragma unroll
        for (int jj = 0; jj < 8; ++jj) { const int j = part * 8 + jj;
            const float sum = ((imp[(0 * 64 + q) * 64 + j] * i0 + imp[(1 * 64 + q) * 64 + j] * i1) + imp[(2 * 64 + q) * 64 + j] * i2) + imp[(3 * 64 + q) * 64 + j] * i3;
            vj[jj] = (j > u) ? -1.0f : ((j == u || j == 0) ? 1.0e4f : sum); }
        __syncthreads();
#pragma unroll
        for (int jj = 0; jj < 8; ++jj) imp[q * 64 + part * 8 + jj] = vj[jj];
        __syncthreads();
        int rank[8];
#pragma unroll
        for (int jj = 0; jj < 8; ++jj) rank[jj] = 0;
        for (int i = 0; i < 64; ++i) { const float vi = imp[q * 64 + i];
#pragma unroll
            for (int jj = 0; jj < 8; ++jj) rank[jj] += (vi > vj[jj] || (vi == vj[jj] && i < part * 8 + jj)) ? 1 : 0; }
        unsigned bits = 0;
#pragma unroll
        for (int jj = 0; jj < 8; ++jj) if (rank[jj] < 16 && (part * 8 + jj) <= u) bits |= 1u << jj;
        unsigned mlo = (part < 4) ? (bits << (8 * part)) : 0u, mhi = (part >= 4) ? (bits << (8 * (part - 4))) : 0u;
        mlo |= __shfl_xor(mlo, 1); mhi |= __shfl_xor(mhi, 1); mlo |= __shfl_xor(mlo, 2); mhi |= __shfl_xor(mhi, 2); mlo |= __shfl_xor(mlo, 4); mhi |= __shfl_xor(mhi, 4);
        if (part == 0) { selm[2 * q] = mlo; selm[2 * q + 1] = mhi; }
    }
    __syncthreads();
#pragma unroll
    for (int r = 0; r < 16; ++r) { ofl[(2 * r) * 64] = o[0][r]; ofl[(2 * r + 1) * 64] = o[1][r]; }
    o[0] = (f32x16){}; o[1] = (f32x16){};
    {
        const unsigned long long mymask = (unsigned long long)selm[2 * ql] | ((unsigned long long)selm[2 * ql + 1] << 32);
        unsigned ulo = selm[2 * lane], uhi = selm[2 * lane + 1];
#pragma unroll
        for (int s2 = 1; s2 < 64; s2 <<= 1) { ulo |= __shfl_xor(ulo, s2); uhi |= __shfl_xor(uhi, s2); }
        unsigned long long um = (unsigned long long)(unsigned)__builtin_amdgcn_readfirstlane((int)ulo) | ((unsigned long long)(unsigned)__builtin_amdgcn_readfirstlane((int)uhi) << 32);
        const bf16_t* Kb = proj + rb * PINP + CD_KS; const bf16_t* Vb = proj + rb * PINP + CD_VS;
        float l_run = 0.f; const float nbound = -bnd[9 + hh]; const float cfar = tbl[127] + nbound; const float* gk = p.nsa_kn + (l * 3 + 1) * 64 + (tid & 7) * 8;
        int j = __builtin_ctzll(um); um &= um - 1;
        int jn = um ? __builtin_ctzll(um) : -1; um &= um - 1;
        kv_load(kr, vr, Kb, Vb, 64 * j, tid);
        kv_store(kr, vr, KVBUF(L, 0), tid);
        if (jn >= 0) kv_load(kr, vr, Kb, Vb, 64 * jn, tid);
        for (int it = 0;; ++it) {
            __syncthreads();
            const int jnn = um ? __builtin_ctzll(um) : -1; um &= um - 1;
            if (jn >= 0) { kv_store(kr, vr, KVBUF(L, it + 1), tid); }
            if (jnn >= 0) kv_load(kr, vr, Kb, Vb, 64 * jnn, tid);
            const bool mine = (mymask >> j) & 1ull;
            if (__any(mine)) {
                const LDSP unsigned char* buf = KVBUF(L, it);
                const int k0 = 64 * j; const bool nearb = (qw - (k0 + 63)) < 113;
                f32x16 p0 = splat16(nearb ? nbound : (mine ? cfar : -INFINITY)), p1 = p0;
                qkt<4>(p0, p1, buf, qf, 0, r32, hi);
                if (nearb) bias_near(p0, p1, tbl, t - k0, 1 << 30, mine, hi);
                l_run += exp_sum(p0, p1);
                pv(o, buf, vb, p0, p1);
            }
            if (jn < 0) break;
            j = jn; jn = jnn;
        }
        l_run += __shfl_xor(l_run, 32);
        scale_rows(o, gs / l_run, wsf, r32, hi);
#pragma unroll
        for (int r = 0; r < 16; ++r) { ofl[(2 * r) * 64] += o[0][r]; ofl[(2 * r + 1) * 64] += o[1][r]; }
        o[0] = (f32x16){}; o[1] = (f32x16){};
    }
    {
        const bf16_t* Kb = proj + rb * PINP + CD_KW; const bf16_t* Vb = proj + rb * PINP + CD_VW;
        float l_run = 0.f; const float nbound = -bnd[13 + hh]; const float cfar = tbl[127] + nbound; const float* gk = p.nsa_kn + (l * 3 + 2) * 64 + (tid & 7) * 8;
        const int jlo = max(0, u - 8);
        __syncthreads();
        kv_load(kr, vr, Kb, Vb, 64 * jlo, tid);
        kv_store(kr, vr, KVBUF(L, jlo), tid);
        if (jlo < u) kv_load(kr, vr, Kb, Vb, 64 * (jlo + 1), tid);
        for (int j = jlo; j <= u; ++j) {
            __syncthreads();
            if (j + 1 <= u) { kv_store(kr, vr, KVBUF(L, j + 1), tid); }
            if (j + 2 <= u) kv_load(kr, vr, Kb, Vb, 64 * (j + 2), tid);
            const LDSP unsigned char* buf = KVBUF(L, j);
            const int k0 = 64 * j; const bool nearb = (j == u || j == u - 8 || (qw - (k0 + 63)) < 113);
            f32x16 p0 = splat16(nearb ? nbound : cfar), p1 = p0;
            qkt<4>(p0, p1, buf, qf, 0, r32, hi);
            if (nearb) bias_near(p0, p1, tbl, t - k0, 512, true, hi);
            l_run += exp_sum(p0, p1);
            pv(o, buf, vb, p0, p1);
        }
        l_run += __shfl_xor(l_run, 32);
        scale_rows(o, gwn / l_run, wsf, r32, hi);
#pragma unroll
        for (int r = 0; r < 16; ++r) { o[0][r] += ofl[(2 * r) * 64]; o[1][r] += ofl[(2 * r + 1) * 64]; }
    }
    store_o(o, (LDSP bf16_t*)(L + AL_IMP + wid * 8192), mix + (rb + qw) * DM + 768 + 64 * hh, lane, r32, hi);
}

__device__ void ph_reset_queues(const Params& p) { unsigned* ctl = (unsigned*)(p.ws + WS_CTL); const int gt = GTID(); if (gt < 8) ctl[gt] = 0u; }
__device__ void prep_cmp_task(const Params& p, int l, int task, LDSP unsigned char* L) {
    const int tid = TID(), lane = tid & 63, wid = __builtin_amdgcn_readfirstlane(tid >> 6), r32 = lane & 31, hi = lane >> 5;
    const int b = task >> 4, which = (task >> 3) & 1, nt = task & 7;
    const bf16_t* proj = (const bf16_t*)(p.ws + WS_PROJ);
    const bf16_t* phiT = (const bf16_t*)(p.ws + WS_PHIT) + (size_t)(l * 2 + which) * 64 * 2048;
    const float* pe = p.nsa_pe + (size_t)(l * 2 + which) * 32 * 64;
    const int n = 32 * nt + r32, colbase = which ? CD_VC : CD_KC;
    f32x16 acc0 = (f32x16){}, acc1 = (f32x16){};
#pragma unroll
    for (int ii = 0; ii < 4; ++ii) {
        const int i = 4 * wid + ii; const int tok = min(16 * n + i, SEQ - 1);
        const bf16_t* xr = proj + (size_t)(b * SEQ + tok) * PINP + colbase;
#pragma unroll
        for (int d0 = 0; d0 < 4; ++d0) {
            float xv[8]; load8(xr + 16 * d0 + 8 * hi, xv);
            const f32x4 pe0 = *(const f32x4*)(pe + i * 64 + 16 * d0 + 8 * hi), pe1 = *(const f32x4*)(pe + i * 64 + 16 * d0 + 8 * hi + 4);
            u32x4 aw; aw[0] = pg8::cvt_pk_bf16(xv[0] + pe0[0], xv[1] + pe0[1]); aw[1] = pg8::cvt_pk_bf16(xv[2] + pe0[2], xv[3] + pe0[3]);
            aw[2] = pg8::cvt_pk_bf16(xv[4] + pe1[0], xv[5] + pe1[1]); aw[3] = pg8::cvt_pk_bf16(xv[6] + pe1[2], xv[7] + pe1[3]);
            const bf16x8 af = __builtin_bit_cast(bf16x8, aw);
            const bf16x8 b0 = *(const bf16x8*)(phiT + (size_t)r32 * 2048 + i * 64 + 16 * d0 + 8 * hi);
            const bf16x8 b1 = *(const bf16x8*)(phiT + (size_t)(32 + r32) * 2048 + i * 64 + 16 * d0 + 8 * hi);
            acc0 = __builtin_amdgcn_mfma_f32_32x32x16_bf16(af, b0, acc0, 0, 0, 0);
            acc1 = __builtin_amdgcn_mfma_f32_32x32x16_bf16(af, b1, acc1, 0, 0, 0);
        }
    }
    LDSP float* red = (LDSP float*)L;
    __syncthreads();
#pragma unroll
    for (int r = 0; r < 16; ++r) { red[(wid * 32 + crow(r, hi)) * 64 + r32] = acc0[r]; red[(wid * 32 + crow(r, hi)) * 64 + 32 + r32] = acc1[r]; }
    __syncthreads();
    {
        const int row = tid >> 4, e4 = (tid & 15) * 4; f32x4 v = (f32x4){0.f, 0.f, 0.f, 0.f};
#pragma unroll
        for (int w8 = 0; w8 < 8; ++w8) v += *(const LDSP f32x4*)(red + (w8 * 32 + row) * 64 + e4);
        const int nn = 32 * nt + row;
        if (which == 0) {
            float ss = (v[0] * v[0] + v[1] * v[1]) + (v[2] * v[2] + v[3] * v[3]);
            ss += __shfl_xor(ss, 1); ss += __shfl_xor(ss, 2); ss += __shfl_xor(ss, 4); ss += __shfl_xor(ss, 8);
            const float rs = rsqrtf(ss * (1.f / 64.f) + EPS); const f32x4 g = *(const f32x4*)(p.nsa_kn + (l * 3 + 0) * 64 + e4);
            v = v * rs * g;
        }
        uint2 o; o.x = pk2(v[0], v[1]); o.y = pk2(v[2], v[3]);
        if (nn >= 255) { o.x = 0u; o.y = 0u; }
        *(uint2*)((bf16_t*)(p.ws + (which ? WS_VC : WS_KC)) + (size_t)(b * 256 + nn) * 64 + e4) = o;
    }
}
__device__ void ph_prep(const Params& p, int l, LDSP unsigned char* L, unsigned char* lds) {
    for (int t = blockIdx.x; t < 80; t += gridDim.x) { if (t < 64) prep_cmp_task(p, l, t, L); }
    if (gridDim.x >= 80) { if (blockIdx.x >= 64 && blockIdx.x < 80) ph_prep_cum_bh(p, l, blockIdx.x - 64, lds); }
    else for (int bh = blockIdx.x; bh < 16; bh += gridDim.x) ph_prep_cum_bh(p, l, bh, lds);
}


__device__ void fa_phase_all(const Params& p, int l, LDSP unsigned char* L, unsigned char* lds, int qslot, int n_conv  ) {
    unsigned* ctl = (unsigned*)(p.ws + WS_CTL);
    LDSP unsigned* misc = (LDSP unsigned*)(L + AL_MISC);
    bool prep_ok = false;
    for (;;) {
        __syncthreads();
        if (threadIdx.x == 0) misc[0] = atomicAdd(&ctl[qslot], 1u);
        __syncthreads();
        const unsigned qi0 = misc[0];
        if (qi0 >= 1104u + (unsigned)n_conv) break;
        if (qi0 >= 1104u) {
            const int it = ((int)qi0 - 1104) * 8 + (TID() >> 6);
            if (it < CV_ITEMS) convert_item(p, l + 1, it, (LDSF float*)lds + (TID() >> 6) * (64 * 65), TID() & 63);
            continue;
        }
        if (qi0 < 80u) {
            if (qi0 < 64u) prep_cmp_task(p, l, (int)qi0, L); else ph_prep_cum_bh(p, l, (int)qi0 - 64, lds);
            asm volatile("s_waitcnt vmcnt(0)" ::: "memory");
            __syncthreads();
            if (threadIdx.x == 0) { __threadfence(); atomicAdd(&ctl[4 + qslot], 1u); }
            continue;
        }
        const unsigned qi = qi0 - 80u;
        int r, typ, sub;
        if (qi < 768u) { r = 15 - (int)(qi / 48u); const int j = (int)(qi % 48u); typ = j >> 4; typ = (typ == 0) ? 0 : (typ == 1 ? 2 : 3); sub = j & 15; }
        else { const int v = (int)qi - 768; r = 15 - (v >> 4); typ = 1; sub = v & 15; }
        if ((typ == 2 || typ == 3) && !prep_ok) {
            if (threadIdx.x == 0) { while (__hip_atomic_load(&ctl[4 + qslot], __ATOMIC_RELAXED, __HIP_MEMORY_SCOPE_AGENT) < 80u) __builtin_amdgcn_s_sleep(8); __threadfence(); }
            asm volatile("s_waitcnt vmcnt(0)" ::: "memory");
            __syncthreads();
            prep_ok = true;
        }
        if (typ == 0) fa_diff_unit(p, l, sub >> 2, sub & 3, r, L);
        else if (typ == 1) fa_stick_unit(p, l, sub >> 2, sub & 3, r, L);
        else if (typ == 2) fa_fox_unit(p, l, sub >> 2, sub & 3, r, L);
        else fa_nsa_unit(p, l, sub >> 2, 4 * r + (sub & 3), L);
    }
}

#define XB_TMO      128
#define XB_XCNT(j)  (256  + 64 * (j))
#define XB_XSUB(j)  (1280 + 64 * (j))
#define XB_XGEN(j)  (2304 + 64 * (j))
#define XB_TOP      3328
#define XB_TOPGEN   3392
#define XCD_BAR_WORDS 3456
#define XB_SPIN_CAP (1u << 18)

__device__ __forceinline__ unsigned xb_ld(unsigned* p)              { return __hip_atomic_load(p, __ATOMIC_RELAXED, __HIP_MEMORY_SCOPE_AGENT); }
__device__ __forceinline__ unsigned xb_add(unsigned* p, unsigned v) { return __hip_atomic_fetch_add(p, v, __ATOMIC_RELAXED, __HIP_MEMORY_SCOPE_AGENT); }
__device__ __forceinline__ unsigned xb_xcc_id() { return (unsigned)__builtin_amdgcn_s_getreg((3 << 11) | 20) & 0xFu; }
#define XB_SPIN(cond, bar) do { unsigned _sp = 0; while (cond) { __builtin_amdgcn_s_sleep(1); \
    if ((++_sp & 255u) == 0u) { if (xb_ld(&(bar)[XB_TMO])) break; if (_sp > XB_SPIN_CAP) { atomicAdd(&(bar)[XB_TMO], 1u); break; } } } } while (0)

struct XcdBarrier {
    unsigned* bar; unsigned x;
    volatile LDSF unsigned* st;
};

__device__ __forceinline__ XcdBarrier xcd_barrier_post(unsigned* bar, volatile LDSF unsigned* st) {
    XcdBarrier b; b.bar = bar; b.x = xb_xcc_id(); b.st = st;
    if (threadIdx.x == 0) (void)xb_add(&bar[XB_XCNT(b.x)], 1u);
    return b;
}
__device__ __forceinline__ void xcd_barrier_complete(unsigned* bar, unsigned x, unsigned& nloc, unsigned& nx) {
    const unsigned G = gridDim.x * gridDim.y * gridDim.z;
    unsigned sum, cnt, mine, sp = 0u;
    for (;;) {
        sum = 0u; cnt = 0u; mine = 0u;
#pragma unroll
        for (unsigned j = 0; j < 16; ++j) { const unsigned c = xb_ld(&bar[XB_XCNT(j)]); sum += c; cnt += (c > 0u) ? 1u : 0u; mine = (j == x) ? c : mine; }
        if (sum == G) break;
        __builtin_amdgcn_s_sleep(1);
        if ((++sp & 255u) == 0u) { if (xb_ld(&bar[XB_TMO])) break; if (sp > XB_SPIN_CAP) { atomicAdd(&bar[XB_TMO], 1u); break; } }
    }
    nloc = mine > 0u ? mine : 1u; nx = cnt > 0u ? cnt : 1u;
}

__device__ __forceinline__ void xcd_barrier(const XcdBarrier& b) {
    asm volatile("s_waitcnt vmcnt(0)" ::: "memory");
    __syncthreads();
    if (threadIdx.x == 0) {
        unsigned* bar = b.bar;
        __builtin_amdgcn_s_waitcnt(0);
        unsigned nloc = b.st[0], nx = b.st[1];
        if (nloc == 0u) { xcd_barrier_complete(bar, b.x, nloc, nx); b.st[0] = nloc; b.st[1] = nx; }
        const unsigned old = xb_add(&bar[XB_XSUB(b.x)], 1u);
        const unsigned gen = old / nloc;
        if (old + 1u == (gen + 1u) * nloc) {
            __builtin_amdgcn_fence(__ATOMIC_RELEASE, "agent");
            asm volatile("s_waitcnt vmcnt(0)" ::: "memory");
            const unsigned og = xb_add(&bar[XB_TOP], 1u);
            const unsigned tg = og / nx;
            if (og + 1u == (tg + 1u) * nx) xb_add(&bar[XB_TOPGEN], 1u);
            else XB_SPIN(xb_ld(&bar[XB_TOPGEN]) == tg, bar);
            __builtin_amdgcn_fence(__ATOMIC_ACQUIRE, "agent");
            xb_add(&bar[XB_XGEN(b.x)], 1u);
            asm volatile("s_waitcnt vmcnt(0)" ::: "memory");
        } else {
            XB_SPIN(xb_ld(&bar[XB_XGEN(b.x)]) == gen, bar);
            __builtin_amdgcn_fence(__ATOMIC_ACQUIRE, "agent");
            asm volatile("s_waitcnt vmcnt(0)" ::: "memory");
        }
    }
    __syncthreads();
}

namespace cg = cooperative_groups;
constexpr int LDS_BYTES = 131072 + 8192 + 4096 + 1024;
#define LAS3 __attribute__((address_space(3)))
#ifndef PROBE
#define PROBE 0
#endif
__global__ void __launch_bounds__(NTHR, 2) mega(Params p) {
    extern __shared__ __attribute__((aligned(16))) unsigned char lds[];
    cg::grid_group grid = cg::this_grid();
#if PROBE
    unsigned long long tacc = 0, tph = 0, t0_;
#define GSYNC() do { t0_ = __builtin_amdgcn_s_memrealtime(); xcd_barrier(xbar); tacc += __builtin_amdgcn_s_memrealtime() - t0_; } while (0)
#define TPK(k, ...) do { if (PROBE == (k)) { t0_ = __builtin_amdgcn_s_memrealtime(); __VA_ARGS__; tph += __builtin_amdgcn_s_memrealtime() - t0_; } else { __VA_ARGS__; } } while (0)
#else
#define GSYNC() xcd_barrier(xbar)
#define TPK(k, ...) do { __VA_ARGS__; } while (0)
#endif
    LAS3 unsigned char* lds3 = (LAS3 unsigned char*)lds;
    volatile LDSF unsigned* bst = (volatile LDSF unsigned*)(lds3 + 131072 + 2048);
    if (threadIdx.x < 2) bst[threadIdx.x] = 0u;
    __syncthreads();
    XcdBarrier xbar = xcd_barrier_post((unsigned*)(p.ws + WS_CTL) + 16384, bst);
    TPK(2, ph_mod(p, lds); ph_reset_queues(p); ph_weights(p, 0, lds));
    grid.sync();
    for (int l = 0; l < DEPTH; ++l) {
        const float* mod = (const float*)(p.ws + WS_MOD) + (size_t)l * 4 * 6144;
        TPK(2, if (l == 0) ph_xa_from(p, p.x, 0, 0, (bf16_t*)(p.ws + WS_XA), (float*)(p.ws + WS_RSA), true); ph_cbias(p, l, 1));
        GSYNC();
        {   pg8::Gemm g{(const bf16_t*)(p.ws + WS_XA), (const bf16_t*)(p.ws + WS_WIN + l * WS_W1OFF), MTOK, PINP, DM}; pg8::StaticOrder S; S.init(MTOK, PINP, (int)gridDim.x, (int)blockIdx.x);
            EpiProjF E{(const float*)(p.ws + WS_RSA), (const float*)(p.ws + WS_CBIN) + (size_t)l * 4 * PINP, (bf16_t*)(p.ws + WS_PROJ), (float*)(p.ws + WS_SIDE),
                       p.diff_kn + l * 32, p.fox_kn + l * 64, p.nsa_kn + (l * 3 + 1) * 64, p.nsa_kn + (l * 3 + 2) * 64, (LDSF float*)(lds3 + 131072 + 4096), (LDSF float*)(lds3 + 131072 + 12288)};
            TPK(6, pg8::gemm_phase<EpiProjF, pg8::StaticOrder, true, PG8_SP2>(lds3, g, S, E)); }
        GSYNC();
        TPK(7, fa_phase_all(p, l, lds3, lds, l, (l + 1 < DEPTH) ? CV_ITEMS / 8 : 0));
        GSYNC();
        {   pg8::Gemm g{(const bf16_t*)(p.ws + WS_MIX), (const bf16_t*)(p.ws + WS_WOUT + l * WS_W1OFF), MTOK, DM, DM}; pg8::StaticOrder S; S.init(MTOK, DM, (int)gridDim.x, (int)blockIdx.x);
            EpiResF E{l == 0 ? p.x : p.out, p.out, mod + 2048, p.norm_ffn_g + l * DM, mod + 4096, (bf16_t*)(p.ws + WS_XA), (float*)(p.ws + WS_RSB)};
            TPK(6, pg8::gemm_phase<EpiResF, pg8::StaticOrder, PG8_ALIGN, PG8_SP2>(lds3, g, S, E)); }
        GSYNC();
        {   pg8::Gemm g{(const bf16_t*)(p.ws + WS_XA), (const bf16_t*)(p.ws + WS_WUP + l * WS_W1OFF), MTOK, NUP, DM}; pg8::StaticOrder S; S.init(MTOK, NUP, (int)gridDim.x, (int)blockIdx.x);
            EpiUpAct E{(const float*)(p.ws + WS_RSB), (const float*)(p.ws + WS_CBUP) + (size_t)l * 4 * NUP, (bf16_t*)(p.ws + WS_ACT), (float*)(p.ws + WS_EG), (float*)(p.ws + WS_EV),
                       p.conv_w + (size_t)l * 3 * DFF, p.conv_b + (size_t)l * DFF, (LDSF float*)(lds3 + 131072 + 4096), (LDSF float*)(lds3 + 131072 + 8192)};
            TPK(6, pg8::gemm_phase<EpiUpAct, pg8::StaticOrder, true, PG8_SP2>(lds3, g, S, E)); }
        GSYNC();
        {   const float* modn = (const float*)(p.ws + WS_MOD) + (size_t)(l + 1) * 4 * 6144; const bool more = (l + 1 < DEPTH);
            pg8::Gemm g{(const bf16_t*)(p.ws + WS_ACT), (const bf16_t*)(p.ws + WS_WDN + l * WS_W1OFF), MTOK, DM, DFF}; pg8::StaticOrder S; S.init(MTOK, DM, (int)gridDim.x, (int)blockIdx.x);
            { pg8::Unit fu; for (int i = 0; S.next(i, fu); ++i) act_fixup(p, l, fu.pm); }
            __builtin_amdgcn_fence(__ATOMIC_RELEASE, "agent"); __builtin_amdgcn_fence(__ATOMIC_ACQUIRE, "agent"); __syncthreads();
            EpiResF E{p.out, p.out, mod + 5120, p.norm_mix_g + (more ? l + 1 : l) * DM, more ? modn + 1024 : mod + 1024, more ? (bf16_t*)(p.ws + WS_XA) : nullptr, more ? (float*)(p.ws + WS_RSA) : nullptr};
            TPK(6, pg8::gemm_phase<EpiResF, pg8::StaticOrder, PG8_ALIGN, PG8_SP2>(lds3, g, S, E)); }
    }
#if PROBE == 1
    if (blockIdx.x == 0 && threadIdx.x == 0) p.out[0] += 0.05f + (float)tacc * 0.01f * 5e-4f;
#elif PROBE >= 2
    if (blockIdx.x == 0 && threadIdx.x == 0) p.out[0] += 0.05f + (float)tph * 0.01f * 1e-4f;
#endif
}

extern "C" void kernel_launch(void* const* d_in, const int* in_sizes, int in, void* d_out, int out_size, void* d_ws, size_t ws_size, hipStream_t stream) {
    if (in != 24 || ws_size < WS_END || out_size != MTOK * DM) { fprintf(stderr, "kernel_launch: unexpected sizes (in %d, ws %zu, out %d)\n", in, ws_size, out_size); return; }
    static int grid_blocks = 0;
    if (!grid_blocks) {
        int dev = 0, cus = 0, per_cu = 0;
        hipGetDevice(&dev);
        hipDeviceGetAttribute(&cus, hipDeviceAttributeMultiprocessorCount, dev);
        hipFuncSetAttribute((const void*)mega, hipFuncAttributeMaxDynamicSharedMemorySize, LDS_BYTES);
        hipOccupancyMaxActiveBlocksPerMultiprocessor(&per_cu, (const void*)mega, NTHR, LDS_BYTES);
        if (per_cu < 1) { fprintf(stderr, "kernel_launch: occupancy query returned %d\n", per_cu); per_cu = 1; }
        if (per_cu > 1) per_cu = 1;
        grid_blocks = cus * per_cu;
        fprintf(stderr, "kernel_launch: cus %d per_cu %d grid %d\n", cus, per_cu, grid_blocks);
    }
    if (hipMemsetAsync((char*)d_ws + WS_CTL + 65536, 0, XCD_BAR_WORDS * 4, stream) != hipSuccess) { fprintf(stderr, "kernel_launch: memset failed\n"); return; }
    Params p{};
    const float** f = (const float**)&p;
    for (int i = 0; i < 24; ++i) f[i] = (const float*)d_in[i];
    p.out = (float*)d_out; p.ws = (unsigned char*)d_ws;
    void* args[] = {&p};
    hipError_t e = hipLaunchCooperativeKernel((const void*)mega, dim3(grid_blocks), dim3(NTHR), args, LDS_BYTES, stream);
    if (e != hipSuccess) fprintf(stderr, "cooperative launch failed: %s (grid %d)\n", hipGetErrorString(e), grid_blocks);
}
```

```cpp
#include <hip/hip_runtime.h>
#include <hip/hip_cooperative_groups.h>
#include <cstdint>
#include <cstdio>

typedef unsigned short bf16_t;
typedef short bf16x8 __attribute__((ext_vector_type(8)));
typedef float f32x4 __attribute__((ext_vector_type(4)));
typedef unsigned u32x4 __attribute__((ext_vector_type(4)));

constexpr int NB = 4, SEQ = 4096, DM = 1024, MTOK = NB * SEQ, DEPTH = 2;
constexpr int HD = 64, HPM = 4, DFF = 2816, PIN = 2960, PINP = 3072, NUP = 2 * DFF;
constexpr float EPS = 1e-6f;
constexpr float LOG2E = 1.4426950408889634f;
constexpr int NTHR = 512;

constexpr int CA_Q = 0, CA_K = 256, CA_V = 512, CB_Q = 768, CB_K = 1024, CB_V = 1280, CC_Q = 1536, CC_K = 1792, CC_V = 2048;
constexpr int CD_Q = 2304, CD_KC = 2560, CD_VC = 2624, CD_KS = 2688, CD_VS = 2752, CD_KW = 2816, CD_VW = 2880, C_BF = 2944, C_DG = 2948;

constexpr size_t MiB = 1u << 20;
constexpr size_t WS_CTL = 0;
constexpr size_t WS_MOD = 1 * MiB;
constexpr size_t WS_CBIN = WS_MOD + 2 * 4 * 6144 * 4;
constexpr size_t WS_CBUP = WS_CBIN + 2 * 4 * 3072 * 4;
constexpr size_t WS_TB = WS_CBUP + 2 * 4 * 5632 * 4;
constexpr size_t WS_LAM = WS_TB + 2 * 4 * 128 * 4;
constexpr size_t WS_BND = WS_LAM + 64;
constexpr size_t WS_CUM = WS_LAM + 512;
constexpr size_t WS_KC = WS_CUM + 16 * 4096 * 4;
constexpr size_t WS_VC = WS_KC + 4 * 256 * 64 * 2;
constexpr size_t WS_SELM = WS_VC + 4 * 256 * 64 * 2;
constexpr size_t WS_SMALL_END = WS_SELM + 16384 * 8;
static_assert(WS_SMALL_END <= 4 * MiB, "small region");
constexpr size_t WS_RSA = 4 * MiB;
constexpr size_t WS_RSB = 5 * MiB;
constexpr size_t WS_SIDE = 6 * MiB;
constexpr size_t WS_IMP = 7 * MiB;
constexpr size_t WS_ML = 11 * MiB;
constexpr size_t WS_PHIT = 7 * MiB;
constexpr size_t WS_W = 12 * MiB;
constexpr size_t WS_WIN = WS_W;
constexpr size_t WS_WOUT = WS_WIN + (size_t)PINP * DM * 2;
constexpr size_t WS_WUP = WS_WOUT + (size_t)DM * DM * 2;
constexpr size_t WS_WDN = WS_WUP + (size_t)NUP * DM * 2;
constexpr size_t WS_W_END = WS_WDN + (size_t)DM * DFF * 2;
static_assert(WS_W_END <= 38 * MiB, "weights region");
constexpr size_t WS_XA = 38 * MiB;
constexpr size_t WS_BIG = 70 * MiB;
constexpr size_t WS_PROJ = WS_BIG;
constexpr size_t WS_MIX = WS_BIG + 96 * MiB;
constexpr size_t WS_ACT = WS_BIG;
constexpr size_t WS_W1OFF = 188 * MiB;
constexpr size_t WS_EG = 228 * MiB;
constexpr size_t WS_EV = 232 * MiB;
constexpr size_t WS_END = 236 * MiB;
static_assert(WS_W_END + WS_W1OFF <= WS_EG && WS_MIX + 32 * MiB <= WS_W + WS_W1OFF, "layer-1 weights");
static_assert(WS_END <= 256 * MiB, "workspace");

struct Params {
    const float *x, *c, *rel_bias, *ada_w, *ada_b, *norm_mix_g, *norm_ffn_g, *w_in, *w_out;
    const float *diff_qn, *diff_kn, *diff_lam, *diff_sub, *fox_qn, *fox_kn, *fox_bf;
    const float *nsa_qn, *nsa_kn, *nsa_pe, *nsa_phi, *w_up, *conv_w, *conv_b, *w_down;
    float* out;
    unsigned char* ws;
};

__device__ __forceinline__ float bf2f(bf16_t v) { return __uint_as_float(((unsigned)v) << 16); }
__device__ __forceinline__ bf16_t f2bf(float f) { unsigned u = __float_as_uint(f); return (bf16_t)((u + 0x7fffu + ((u >> 16) & 1u)) >> 16); }
__device__ __forceinline__ unsigned pk2(float lo, float hi) { return (unsigned)f2bf(lo) | ((unsigned)f2bf(hi) << 16); }
__device__ __forceinline__ float siluf(float v) { return v / (1.f + __expf(-v)); }
__device__ __forceinline__ float logsigf(float v) { return fminf(v, 0.f) - log1pf(__expf(-fabsf(v))); }
__device__ __forceinline__ float wave_sum(float v) {
#pragma unroll
    for (int o = 1; o < 64; o <<= 1) v += __shfl_xor(v, o);
    return v;
}
__device__ __forceinline__ int t5_bucket(int n) {
    if (n < 16) return n < 0 ? 0 : n;
    return 16 + (n >= 19) + (n >= 21) + (n >= 24) + (n >= 27) + (n >= 31) + (n >= 35) + (n >= 40) + (n >= 46) + (n >= 52) + (n >= 59) + (n >= 67) + (n >= 77) + (n >= 87) + (n >= 99) + (n >= 113);
}
__host__ __device__ __forceinline__ int in_col_map(int n) {
    if (n < 1536) return n;
    if (n < 2944) return n + 4;
    if (n < 2948) return 1536 + (n - 2944);
    if (n < 2960) return n;
    return -1;
}
__host__ __device__ __forceinline__ int up_col_map(int n) {
    const int pn = n >> 8, c = n & 255;
    return c < 128 ? (128 * pn + c) : (DFF + 128 * pn + (c - 128));
}

__device__ __forceinline__ int opaque_v(int v) { asm volatile("" : "+v"(v)); return v; }
#define TID() opaque_v((int)threadIdx.x)
#define GTID() ((int)(blockIdx.x * blockDim.x) + TID())
#define GSIZE() ((int)(gridDim.x * blockDim.x))

__device__ __forceinline__ void load8(const bf16_t* p, float* d) {
    const u32x4 r = *(const u32x4*)p;
    d[0] = bf2f(r[0] & 0xffff); d[1] = bf2f(r[0] >> 16); d[2] = bf2f(r[1] & 0xffff); d[3] = bf2f(r[1] >> 16);
    d[4] = bf2f(r[2] & 0xffff); d[5] = bf2f(r[2] >> 16); d[6] = bf2f(r[3] & 0xffff); d[7] = bf2f(r[3] >> 16);
}
#define LDSF __attribute__((address_space(3)))
__device__ __forceinline__ void gemv4_block(const float* W, int ld, int oc, const LDSF float* vec, LDSF float* red, float* out0, int ostride, int n, float bias, int tid) {
    const int lane = tid & 63, wv = tid >> 6;
    float a0 = 0.f, a1 = 0.f, a2 = 0.f, a3 = 0.f;
    if (oc >= 0) {
        const float* w = W + (size_t)(wv * 128) * ld + oc;
#pragma unroll 32
        for (int k = 0; k < 128; ++k) { const float wk = w[(size_t)k * ld]; const f32x4 v = *(const LDSF f32x4*)(vec + (wv * 128 + k) * 4); a0 += v[0] * wk; a1 += v[1] * wk; a2 += v[2] * wk; a3 += v[3] * wk; }
    }
    red[(wv * 4 + 0) * 64 + lane] = a0; red[(wv * 4 + 1) * 64 + lane] = a1; red[(wv * 4 + 2) * 64 + lane] = a2; red[(wv * 4 + 3) * 64 + lane] = a3;
    __syncthreads();
    if (tid < 256) { const int bt = tid >> 6; float sacc = 0.f;
#pragma unroll
        for (int w8 = 0; w8 < 8; ++w8) sacc += red[(w8 * 4 + bt) * 64 + lane];
        out0[(size_t)bt * ostride + n] = sacc + bias; }
    __syncthreads();
}
__device__ void ph_mod(const Params& p, unsigned char* lds) {
    float* mod = (float*)(p.ws + WS_MOD);
    float* tb = (float*)(p.ws + WS_TB);
    float* lamv = (float*)(p.ws + WS_LAM);
    LDSF float* vec = (LDSF float*)lds; LDSF float* red = (LDSF float*)(lds + 16384);
    const int tid = TID();
    bool loaded = false;
    for (int item = blockIdx.x; item < DEPTH * 96; item += gridDim.x) {
        if (!loaded) { for (int i = tid; i < 4096; i += NTHR) { const int bt = i >> 10, k = i & 1023; vec[k * 4 + bt] = siluf(p.c[bt * DM + k]); } __syncthreads(); loaded = true; }
        const int l = item / 96, n = (item % 96) * 64 + (tid & 63);
        gemv4_block(p.ada_w + (size_t)l * DM * 6144, 6144, n, vec, red, mod + (size_t)l * 4 * 6144, 6144, n, p.ada_b[l * 6144 + n], tid);
    }
    const int gt = GTID(), gs = GSIZE();
    for (int idx = gt; idx < 2 * 4 * 128; idx += gs) {
        const int type = idx / 512, h = (idx / 128) & 3, d = idx & 127;
        tb[idx] = p.rel_bias[t5_bucket(d) * 8 + type * 4 + h];
    }
    for (int idx = gt; idx < DEPTH * 32; idx += gs) {
        const int l = idx >> 5, e = idx & 31; float v = 0.f;
        if (e < 17) {
            const int type = (e < 5) ? 0 : 1, h = (e < 4) ? e : ((e == 4) ? 0 : ((e - 5) & 3));
            const int ng = (e < 4) ? 32 : 64;
            const float* gq = (e < 4) ? p.diff_qn + l * 32 : ((e == 4) ? p.fox_qn + l * 64 : p.nsa_qn + l * 64);
            const float* gk = (e < 4) ? p.diff_kn + l * 32 : ((e == 4) ? p.fox_kn + l * 64 : p.nsa_kn + (l * 3 + (e - 5) / 4) * 64);
            float mq = 0.f, mk = 0.f; for (int i = 0; i < ng; ++i) { mq = fmaxf(mq, fabsf(gq[i])); mk = fmaxf(mk, fabsf(gk[i])); }
            float tm = 0.f; if (e != 4) { tm = -INFINITY; for (int bk2 = 0; bk2 < 32; ++bk2) tm = fmaxf(tm, p.rel_bias[bk2 * 8 + type * 4 + h]); }
            v = sqrtf((float)ng) * mq * mk * 1.02f * LOG2E + tm * LOG2E;
        }
        ((float*)(p.ws + WS_BND))[idx] = v;
    }
    for (int idx = gt; idx < DEPTH; idx += gs) {
        const float* lv = p.diff_lam + idx * 4 * 32;
        float s1 = 0.f, s2 = 0.f;
        for (int i = 0; i < 32; ++i) { s1 += lv[i] * lv[32 + i]; s2 += lv[64 + i] * lv[96 + i]; }
        const float lam_init = 0.8f - 0.6f * expf(-0.3f * (float)idx);
        lamv[idx] = expf(s1) - expf(s2) + lam_init;
    }
}
__device__ void ph_cbias(const Params& p, int lfirst, int lcount) {
    const float* mod = (const float*)(p.ws + WS_MOD);
    const int tid_ = TID(); const int lane = tid_ & 63, wv = tid_ >> 6;
    const int gw = blockIdx.x * (NTHR >> 6) + wv, ngw = gridDim.x * (NTHR >> 6);
    constexpr int NCOL = PINP + NUP;
    const int per = (lcount * NCOL + ngw - 1) / ngw; const int c0 = gw * per, c1 = min(lcount * NCOL, c0 + per);
    int cur_key = -1; float sh[4][16];
    for (int c = c0; c < c1; ++c) {
        const int l = lfirst + c / NCOL, r = c % NCOL; const bool isin = r < PINP; const int n = isin ? r : r - PINP; const int key = l * 2 + (isin ? 0 : 1);
        if (key != cur_key) { cur_key = key; const int shoff = isin ? 0 : 3072;
#pragma unroll
            for (int bt = 0; bt < 4; ++bt)
#pragma unroll
                for (int q4 = 0; q4 < 4; ++q4) { const f32x4 v = *(const f32x4*)(mod + (size_t)(l * 4 + bt) * 6144 + shoff + 16 * lane + 4 * q4); sh[bt][4 * q4] = v[0]; sh[bt][4 * q4 + 1] = v[1]; sh[bt][4 * q4 + 2] = v[2]; sh[bt][4 * q4 + 3] = v[3]; } }
        const bf16_t* wrow = (const bf16_t*)(p.ws + (isin ? WS_WIN : WS_WUP) + l * WS_W1OFF) + (size_t)n * DM + 16 * lane;
        float w[16]; load8(wrow, w); load8(wrow + 8, w + 8);
        float a0 = 0.f, a1 = 0.f, a2 = 0.f, a3 = 0.f;
#pragma unroll
        for (int j = 0; j < 16; ++j) { a0 += sh[0][j] * w[j]; a1 += sh[1][j] * w[j]; a2 += sh[2][j] * w[j]; a3 += sh[3][j] * w[j]; }
        a0 = wave_sum(a0); a1 = wave_sum(a1); a2 = wave_sum(a2); a3 = wave_sum(a3);
        if (lane == 0) { float* o = isin ? (float*)(p.ws + WS_CBIN) + (size_t)l * 4 * PINP : (float*)(p.ws + WS_CBUP) + (size_t)l * 4 * NUP; const int ld = isin ? PINP : NUP;
            o[n] = a0; o[ld + n] = a1; o[2 * ld + n] = a2; o[3 * ld + n] = a3; }
    }
}
template <int MAPK>
__device__ __forceinline__ void convert_one(const float* W, int K, int Nsrc, int Npad, bf16_t* Wt, LDSF float* scr, int it, int lane) {
    const int nnb = Npad / 64;
    const int kb = it / nnb, nb = it % nnb, k0 = kb * 64, n0 = nb * 64;
    {
        const int n = n0 + lane;
        const int oc = MAPK == 0 ? n : (MAPK == 1 ? in_col_map(n) : up_col_map(n));
        const float* wp = W + (size_t)k0 * Nsrc + (oc >= 0 ? oc : 0);
#pragma unroll 1
        for (int hh = 0; hh < 2; ++hh) {
            float tv[32];
#pragma unroll
            for (int i = 0; i < 32; ++i) tv[i] = wp[(size_t)(32 * hh + i) * Nsrc];
#pragma unroll
            for (int i = 0; i < 32; ++i) scr[(32 * hh + i) * 65 + lane] = (oc >= 0) ? tv[i] : 0.f;
        }
    }
    __builtin_amdgcn_s_waitcnt(0xc07f); __builtin_amdgcn_wave_barrier();
    {
        const int c = lane & 7;
#pragma unroll
        for (int j = 0; j < 8; ++j) { const int nn = 8 * j + (lane >> 3); const LDSF float* sp = scr + (8 * c) * 65 + nn;
            u32x4 o; o[0] = pk2(sp[0], sp[65]); o[1] = pk2(sp[130], sp[195]); o[2] = pk2(sp[260], sp[325]); o[3] = pk2(sp[390], sp[455]);
            *(u32x4*)(Wt + (size_t)(n0 + nn) * K + k0 + 8 * c) = o; }
    }
    __builtin_amdgcn_s_waitcnt(0xc07f); __builtin_amdgcn_wave_barrier();
}
constexpr int CV_IN = 16 * (PINP / 64), CV_OUT = 16 * (DM / 64), CV_UP = 16 * (NUP / 64), CV_DN = (DFF / 64) * (DM / 64), CV_PHI = 32, CV_ITEMS = CV_IN + CV_OUT + CV_UP + CV_DN + 2 * CV_PHI;
static_assert(CV_ITEMS == 3200, "conversion item count");
__device__ void convert_item(const Params& p, int l, int idx, LDSF float* scr, int lane) {
    if (idx < CV_IN) { convert_one<1>(p.w_in + (size_t)l * DM * PIN, DM, PIN, PINP, (bf16_t*)(p.ws + WS_WIN + l * WS_W1OFF), scr, idx, lane); return; } idx -= CV_IN;
    if (idx < CV_OUT) { convert_one<0>(p.w_out + (size_t)l * DM * DM, DM, DM, DM, (bf16_t*)(p.ws + WS_WOUT + l * WS_W1OFF), scr, idx, lane); return; } idx -= CV_OUT;
    if (idx < CV_UP) { convert_one<2>(p.w_up + (size_t)l * DM * NUP, DM, NUP, NUP, (bf16_t*)(p.ws + WS_WUP + l * WS_W1OFF), scr, idx, lane); return; } idx -= CV_UP;
    if (idx < CV_DN) { convert_one<0>(p.w_down + (size_t)l * DFF * DM, DFF, DM, DM, (bf16_t*)(p.ws + WS_WDN + l * WS_W1OFF), scr, idx, lane); return; } idx -= CV_DN;
    const int w2 = idx / CV_PHI; idx -= w2 * CV_PHI;
    convert_one<0>(p.nsa_phi + (size_t)(l * 2 + w2) * 2048 * 64, 2048, 64, 64, (bf16_t*)(p.ws + WS_PHIT) + (size_t)(l * 2 + w2) * 64 * 2048, scr, idx, lane);
}
__device__ void ph_weights(const Params& p, int l, unsigned char* lds) {
    const int tid_ = TID(); const int lane = tid_ & 63, wv = tid_ >> 6;
    const int ngw = gridDim.x * (NTHR >> 6), gw = ngw - 1 - (blockIdx.x * (NTHR >> 6) + wv);
    LDSF float* scr = (LDSF float*)lds + wv * (64 * 65);
    for (int it = gw; it < CV_ITEMS; it += ngw) convert_item(p, l, it, scr, lane);
}
__device__ void ph_xa_from(const Params& p, const float* src, int l, int which  , bf16_t* XA, float* rowss, bool write_xa) {
    const float* mod = (const float*)(p.ws + WS_MOD);
    const float* g = (which == 0 ? p.norm_mix_g : p.norm_ffn_g) + l * DM;
    const int tid_ = TID(); const int lane = tid_ & 63, wv = tid_ >> 6;
    const int gw = blockIdx.x * (blockDim.x >> 6) + wv, ngw = gridDim.x * (blockDim.x >> 6);
    for (int row0 = gw; row0 < MTOK; row0 += 2 * ngw) {
        f32x4 v[2][4];
#pragma unroll
        for (int rr = 0; rr < 2; ++rr) { const int row = min(row0 + rr * ngw, MTOK - 1);
#pragma unroll
            for (int j = 0; j < 4; ++j) v[rr][j] = *(const f32x4*)(src + (size_t)row * DM + j * 256 + lane * 4); }
#pragma unroll
        for (int rr = 0; rr < 2; ++rr) {
            const int row = row0 + rr * ngw;
            if (row < MTOK) {
                const int b = row / SEQ; const float* sc = mod + (size_t)(l * 4 + b) * 6144 + (which == 0 ? 1024 : 4096);
                float ss = 0.f;
#pragma unroll
                for (int j = 0; j < 4; ++j) {
                    const int k = j * 256 + lane * 4; const f32x4 x = v[rr][j];
                    ss += x[0] * x[0] + x[1] * x[1] + x[2] * x[2] + x[3] * x[3];
                    if (write_xa) {
                        const f32x4 gv = *(const f32x4*)(g + k); const f32x4 sv = *(const f32x4*)(sc + k);
                        uint2 o; o.x = pk2(x[0] * gv[0] * (1.f + sv[0]), x[1] * gv[1] * (1.f + sv[1])); o.y = pk2(x[2] * gv[2] * (1.f + sv[2]), x[3] * gv[3] * (1.f + sv[3]));
                        *(uint2*)(XA + (size_t)row * DM + k) = o;
                    }
                }
                ss = wave_sum(ss);
                if (lane < 16) rowss[(size_t)row * 16 + lane] = (lane == 0) ? ss : 0.f;
            }
        }
    }
}

namespace pg8 {
#define PG8_LAS __attribute__((address_space(3)))
typedef unsigned short bf16_t;
typedef short bf16x8 __attribute__((ext_vector_type(8)));
typedef float f32x4 __attribute__((ext_vector_type(4)));
typedef unsigned u32x4 __attribute__((ext_vector_type(4)));
constexpr int BM = 256, BK = 64, HALF = 128, HTB = HALF * BK * 2  , STAGE_BYTES = 8 * HTB, NXCD = 8, WGM = 8;

__host__ __device__ __forceinline__ int lds_byte(int r, int c) { const int st = (r >> 4) * 2 + (c >> 5), rr = r & 15, cc = c & 31, ob = rr * 64 + cc * 2; return st * 1024 + (ob ^ (((ob >> 9) & 1) << 5)); }
__host__ __device__ __forceinline__ void stage_rc(int b, int& R, int& C) { const int st = b / 1024, sb = b % 1024, swz = sb ^ (((sb >> 9) & 1) << 5); R = (st >> 1) * 16 + swz / 64; C = (st & 1) * 32 + (swz % 64) / 2; }
__host__ __device__ __forceinline__ int perm32(int rho) { const int n = rho >> 4, i = rho & 15; return 8 * (i >> 2) + 4 * n + (i & 3); }

struct Unit { int pm, pn; };
struct Gemm { const bf16_t* A; const bf16_t* Bt; int M, N, K; };

struct StaticOrder {
    int nM, nN, nwg, G, c;
    __host__ __device__ void init(int M, int N, int G_, int c_) { nM = M / BM; nN = N / BM; nwg = nM * nN; G = G_; c = c_; }
    __host__ __device__ bool next(int i, Unit& u) const {
        const long L = (long)i * G + c; if (L >= nwg) return false;
        int wgid = (int)L; { const int q = nwg / NXCD, r = nwg % NXCD, xcd = wgid % NXCD, off = wgid / NXCD; wgid = (xcd < r ? xcd * (q + 1) : r * (q + 1) + (xcd - r) * q) + off; }
        const int nig = WGM * nN, gid = wgid / nig, fm = gid * WGM, gsz = (nM - fm) < WGM ? (nM - fm) : WGM;
        u.pm = fm + ((wgid % nig) % gsz); u.pn = (wgid % nig) / gsz; return true;
    }
    __device__ __forceinline__ void a_ready(const Unit&) const {}
    __device__ __forceinline__ void done(const Unit&) const {}
};


__device__ __forceinline__ unsigned cvt_pk_bf16(float lo, float hi) { unsigned r; asm volatile("v_cvt_pk_bf16_f32 %0, %1, %2" : "=v"(r) : "v"(lo), "v"(hi)); return r; }
template <class Epi, class Sched, bool ALIGN_EPI = false, bool SP2 = false>
__device__ __forceinline__ void gemm_phase(PG8_LAS unsigned char* lds, const Gemm g, const Sched& S, const Epi& E) {
    const int tid = TID(), wid = __builtin_amdgcn_readfirstlane(tid >> 6), lane = tid & 63, wr = wid >> 2, wc = wid & 3, fr = lane & 15, fq = lane >> 4;
    const int K = g.K, nt = K / BK;
    unsigned voffA[2], voffB[2];
#pragma unroll
    for (int i = 0; i < 2; ++i) { int R, C; stage_rc(tid * 16 + i * 8192, R, C); const int Rb = Epi::PERM ? ((R & ~31) + perm32(R & 31)) : R;
        voffA[i] = (unsigned)(R * K + C) * 2u; voffB[i] = (unsigned)(Rb * K + C) * 2u; }
    const size_t kstep = (size_t)(BK * 2);
    const size_t hstep = (size_t)HALF * K * 2;
    const size_t tstep = 2 * hstep;
    const unsigned ldsw = (unsigned)wid * 1024u;
    const int aoff = lds_byte(wr * 64 + fr, fq * 8), boff = lds_byte(wc * 32 + fr, fq * 8);
#define PG8_SA(b, h) (((b) * 2 + (h)) * HTB)
#define PG8_SB(b, h) ((4 + (b) * 2 + (h)) * HTB)
#define PG8_STAGE(bufoff, gbase, voff) do { _Pragma("unroll") for (int _i = 0; _i < 2; ++_i) \
        __builtin_amdgcn_global_load_lds((const unsigned*)((const char*)(gbase) + (voff)[_i]), (PG8_LAS unsigned*)(lds + (bufoff) + ldsw + _i * 8192), 16, 0, 0); } while (0)
#define PG8_LDA(dst, b, h) do { _Pragma("unroll") for (int m = 0; m < 4; ++m) _Pragma("unroll") for (int k = 0; k < 2; ++k) dst[m][k] = *(const PG8_LAS bf16x8*)(lds + PG8_SA(b, h) + aoff + m * 2048 + k * 1024); } while (0)
#define PG8_LDB(dst, b, h) do { _Pragma("unroll") for (int n = 0; n < 2; ++n) _Pragma("unroll") for (int k = 0; k < 2; ++k) dst[n][k] = *(const PG8_LAS bf16x8*)(lds + PG8_SB(b, h) + boff + n * 2048 + k * 1024); } while (0)
#define PG8_MMA(ai, bj, At, Bt) do { __builtin_amdgcn_s_setprio(1); _Pragma("unroll") for (int m = 0; m < 4; ++m) _Pragma("unroll") for (int n = 0; n < 2; ++n) _Pragma("unroll") for (int k = 0; k < 2; ++k) \
        acc[ai][bj][m][n] = __builtin_amdgcn_mfma_f32_16x16x32_bf16(Bt[n][k], At[m][k], acc[ai][bj][m][n], 0, 0, 0); __builtin_amdgcn_s_setprio(0); } while (0)
#define PG8_WAIT_V(n) asm volatile("s_waitcnt vmcnt(" #n ")" ::: "memory")
#define PG8_WAIT_L(n) asm volatile("s_waitcnt lgkmcnt(" #n ")" ::: "memory")
#define PG8_BAR __builtin_amdgcn_s_barrier()
#define PG8_SCHED __builtin_amdgcn_sched_barrier(0)
    Unit cur, nxt; int ui = 0;
    if (!S.next(0, cur)) return;
    f32x4 acc[2][2][4][2];
#pragma unroll
    for (int a = 0; a < 2; ++a)
#pragma unroll
        for (int b = 0; b < 2; ++b)
#pragma unroll
            for (int m = 0; m < 4; ++m)
#pragma unroll
                for (int n = 0; n < 2; ++n) acc[a][b][m][n] = (f32x4){0.f, 0.f, 0.f, 0.f};
    bf16x8 At[4][2], B0[2][2], B1[2][2];
    const char* cA = (const char*)g.A + (size_t)cur.pm * tstep; const char* cB = (const char*)g.Bt + (size_t)cur.pn * tstep;
    S.a_ready(cur);
    if constexpr (SP2) {
        PG8_STAGE(PG8_SB(0, 0), cB, voffB); PG8_STAGE(PG8_SB(0, 1), cB + hstep, voffB); PG8_STAGE(PG8_SA(0, 0), cA, voffA); PG8_STAGE(PG8_SA(0, 1), cA + hstep, voffA);
        if (wr == 1) PG8_BAR;
        PG8_WAIT_V(2); PG8_BAR;
        PG8_STAGE(PG8_SB(1, 0), cB + kstep, voffB); PG8_STAGE(PG8_SA(1, 0), cA + kstep, voffA); PG8_STAGE(PG8_SB(1, 1), cB + hstep + kstep, voffB);
        PG8_WAIT_V(6); PG8_BAR;
    } else {
        PG8_STAGE(PG8_SB(0, 0), cB, voffB); PG8_STAGE(PG8_SA(0, 0), cA, voffA); PG8_STAGE(PG8_SB(0, 1), cB + hstep, voffB); PG8_STAGE(PG8_SA(0, 1), cA + hstep, voffA);
        if (wr == 1) PG8_BAR;
        PG8_WAIT_V(4); PG8_BAR;
        PG8_STAGE(PG8_SB(1, 0), cB + kstep, voffB); PG8_STAGE(PG8_SA(1, 0), cA + kstep, voffA); PG8_STAGE(PG8_SB(1, 1), cB + hstep + kstep, voffB);
        PG8_WAIT_V(6); PG8_BAR;
    }
    for (;;) {
        const bool has_next = S.next(ui + 1, nxt);
        const char* nA = has_next ? (const char*)g.A + (size_t)nxt.pm * tstep : cA; const char* nB = has_next ? (const char*)g.Bt + (size_t)nxt.pn * tstep : cB;
        for (int t = 0; t < nt; t += 2) {
            const bool last = (t == nt - 2);
            const char* a1 = cA + (size_t)(t + 1) * kstep;
            const char* a2 = last ? nA : cA + (size_t)(t + 2) * kstep; const char* b2 = last ? nB : cB + (size_t)(t + 2) * kstep;
            const char* a3 = a2 + kstep; const char* b3 = b2 + kstep;
            if (last && has_next) S.a_ready(nxt);
            if constexpr (SP2) {
            PG8_LDB(B0, 0, 0); PG8_LDB(B1, 0, 1); PG8_SCHED; PG8_LDA(At, 0, 0); PG8_STAGE(PG8_SA(1, 1), a1 + hstep, voffA);
            PG8_WAIT_V(8); PG8_WAIT_L(0); PG8_BAR; PG8_MMA(0, 0, At, B0); PG8_MMA(0, 1, At, B1); PG8_BAR; PG8_SCHED;
            PG8_LDA(At, 0, 1); PG8_STAGE(PG8_SB(0, 0), b2, voffB); PG8_STAGE(PG8_SB(0, 1), b2 + hstep, voffB); PG8_STAGE(PG8_SA(0, 0), a2, voffA);
            PG8_WAIT_V(8); PG8_WAIT_L(0); PG8_BAR; PG8_MMA(1, 0, At, B0); PG8_MMA(1, 1, At, B1); PG8_BAR; PG8_SCHED;
            PG8_LDB(B0, 1, 0); PG8_LDB(B1, 1, 1); PG8_SCHED; PG8_LDA(At, 1, 0); PG8_STAGE(PG8_SA(0, 1), a2 + hstep, voffA);
            PG8_WAIT_V(8); PG8_WAIT_L(0); PG8_BAR; PG8_MMA(0, 0, At, B0); PG8_MMA(0, 1, At, B1); PG8_BAR; PG8_SCHED;
            PG8_LDA(At, 1, 1); PG8_STAGE(PG8_SB(1, 0), b3, voffB); PG8_STAGE(PG8_SB(1, 1), b3 + hstep, voffB); PG8_STAGE(PG8_SA(1, 0), a3, voffA);
            PG8_WAIT_V(8); PG8_WAIT_L(0); PG8_BAR; PG8_MMA(1, 0, At, B0); PG8_MMA(1, 1, At, B1); PG8_BAR; PG8_SCHED;
            } else {
            PG8_LDB(B0, 0, 0); PG8_SCHED; PG8_LDA(At, 0, 0); PG8_STAGE(PG8_SA(1, 1), a1 + hstep, voffA);
            PG8_WAIT_L(8); PG8_BAR; PG8_WAIT_L(0); PG8_MMA(0, 0, At, B0); PG8_BAR; PG8_SCHED;
            PG8_LDB(B1, 0, 1); PG8_STAGE(PG8_SB(0, 0), b2, voffB);
            PG8_BAR; PG8_WAIT_L(0); PG8_MMA(0, 1, At, B1); PG8_BAR;
            PG8_LDA(At, 0, 1); PG8_STAGE(PG8_SA(0, 0), a2, voffA);
            PG8_BAR; PG8_WAIT_L(0); PG8_MMA(1, 0, At, B0); PG8_BAR; PG8_SCHED;
            PG8_STAGE(PG8_SB(0, 1), b2 + hstep, voffB);
            PG8_WAIT_V(6); PG8_BAR; PG8_MMA(1, 1, At, B1); PG8_BAR;
            PG8_LDB(B0, 1, 0); PG8_SCHED; PG8_LDA(At, 1, 0); PG8_STAGE(PG8_SA(0, 1), a2 + hstep, voffA);
            PG8_WAIT_L(8); PG8_BAR; PG8_WAIT_L(0); PG8_MMA(0, 0, At, B0); PG8_BAR; PG8_SCHED;
            PG8_LDB(B1, 1, 1); PG8_STAGE(PG8_SB(1, 0), b3, voffB);
            PG8_BAR; PG8_WAIT_L(0); PG8_MMA(0, 1, At, B1); PG8_BAR;
            PG8_LDA(At, 1, 1); PG8_STAGE(PG8_SA(1, 0), a3, voffA);
            PG8_BAR; PG8_WAIT_L(0); PG8_MMA(1, 0, At, B0); PG8_BAR; PG8_SCHED;
            PG8_STAGE(PG8_SB(1, 1), b3 + hstep, voffB);
            PG8_WAIT_V(6); PG8_BAR; PG8_MMA(1, 1, At, B1); PG8_BAR;
            }
        }
        if constexpr (ALIGN_EPI) { if (wr == 0) PG8_BAR; }
        if constexpr (!Epi::AFTER_DRAIN) { E(acc, cur, wr, wc, fr, fq); S.done(cur); }
        if (!has_next) break;
#pragma unroll
        for (int a = 0; a < 2; ++a)
#pragma unroll
            for (int b = 0; b < 2; ++b)
#pragma unroll
                for (int m = 0; m < 4; ++m)
#pragma unroll
                    for (int n = 0; n < 2; ++n) acc[a][b][m][n] = (f32x4){0.f, 0.f, 0.f, 0.f};
        cur = nxt; cA = nA; cB = nB; ++ui;
        if constexpr (ALIGN_EPI) { if (wr == 1) PG8_BAR; }
    }
    PG8_WAIT_V(0);
    if constexpr (!ALIGN_EPI) { if (wr == 0) PG8_BAR; }
    PG8_BAR;
    if constexpr (Epi::AFTER_DRAIN) { E.fused(acc, cur, wr, wc, fr, fq, lds, wid, lane); S.done(cur); }
#undef PG8_SA
#undef PG8_SB
#undef PG8_STAGE
#undef PG8_LDA
#undef PG8_LDB
#undef PG8_MMA
#undef PG8_WAIT_V
#undef PG8_WAIT_L
#undef PG8_BAR
#undef PG8_SCHED
}
}

#ifndef PG8_SP2
#define PG8_SP2 true
#endif
#ifndef PG8_ALIGN
#define PG8_ALIGN true
#endif

__device__ __forceinline__ float row_rstd16(const float* rowss, int row) {
    const f32x4* r = (const f32x4*)(rowss + (size_t)row * 16);
    const f32x4 a = r[0], b = r[1], c = r[2], d = r[3];
    const float s = ((a[0] + a[1]) + (a[2] + a[3])) + ((b[0] + b[1]) + (b[2] + b[3])) + ((c[0] + c[1]) + (c[2] + c[3])) + ((d[0] + d[1]) + (d[2] + d[3]));
    return rsqrtf(s * (1.f / DM) + EPS);
}
struct EpiProjF {
    static constexpr bool PERM = true, AFTER_DRAIN = false;
    const float* rowss; const float* cb; bf16_t* proj; float* side; const float* g_a; const float* g_b; const float* g_ds; const float* g_dw; LDSF float* xs  ; LDSF float* rsl  ;
    __device__ __forceinline__ void operator()(const pg8::f32x4 (&acc)[2][2][4][2], const pg8::Unit& u, int wr, int wc, int fr, int fq) const {
        const int b = u.pm >> 4, colt = u.pn * 256 + wc * 32 + 8 * fq;
        const int knmode = (u.pn == 1) ? 1 : (u.pn == 4) ? 2 : (u.pn == 10) ? 3 : (u.pn == 11) ? 4 : 0;
        f32x4 cv[2][2];
#pragma unroll
        for (int bj = 0; bj < 2; ++bj)
#pragma unroll
            for (int n = 0; n < 2; ++n) cv[bj][n] = *(const f32x4*)(cb + b * PINP + colt + bj * 128 + 4 * n);
        {   const int tid = (wr * 4 + wc) * 64 + fq * 16 + fr;
            if (tid < 256) rsl[tid] = row_rstd16(rowss, u.pm * 256 + tid);
            asm volatile("s_waitcnt vmcnt(0) lgkmcnt(0)" ::: "memory"); __builtin_amdgcn_s_barrier(); asm volatile("" ::: "memory"); }
        if (knmode != 0) {
#pragma unroll
            for (int ai = 0; ai < 2; ++ai)
#pragma unroll
                for (int m = 0; m < 4; ++m) {
                    const float rsm = rsl[ai * 128 + wr * 64 + m * 16 + fr];
#pragma unroll
                    for (int bj = 0; bj < 2; ++bj) {
                        const f32x4 v0 = acc[ai][bj][m][0] * rsm + cv[bj][0], v1 = acc[ai][bj][m][1] * rsm + cv[bj][1];
                        float ss = (v0[0] * v0[0] + v0[1] * v0[1]) + (v0[2] * v0[2] + v0[3] * v0[3]) + (v1[0] * v1[0] + v1[1] * v1[1]) + (v1[2] * v1[2] + v1[3] * v1[3]);
                        ss += __shfl_xor(ss, 16); ss += __shfl_xor(ss, 32);
                        if (fq == 0) xs[((wr * 4 + wc) * 16 + (ai * 4 + m) * 2 + bj) * 16 + fr] = ss;
                    }
                }
            asm volatile("s_waitcnt lgkmcnt(0)" ::: "memory"); __builtin_amdgcn_s_barrier(); asm volatile("" ::: "memory");
        }
#pragma unroll
        for (int ai = 0; ai < 2; ++ai)
#pragma unroll
            for (int m = 0; m < 4; ++m) {
                const int row = u.pm * 256 + ai * 128 + wr * 64 + m * 16 + fr; const float rs = rsl[ai * 128 + wr * 64 + m * 16 + fr];
#pragma unroll
                for (int bj = 0; bj < 2; ++bj) {
                    f32x4 v0 = acc[ai][bj][m][0] * rs + cv[bj][0], v1 = acc[ai][bj][m][1] * rs + cv[bj][1]; const int col0 = colt + bj * 128;
                    if (col0 >= C_BF && col0 < PIN) { *(f32x4*)(side + (size_t)row * 16 + (col0 - C_BF)) = v0; *(f32x4*)(side + (size_t)row * 16 + (col0 - C_BF) + 4) = v1; }
                    const bool on = (knmode == 1) || (knmode == 2) || (knmode == 3 && bj == 1 && wc < 2) || (knmode == 4 && bj == 0 && wc < 2);
                    if (on) {
                        const int xi = (ai * 4 + m) * 2 + bj;
                        float tot = xs[((wr * 4 + wc) * 16 + xi) * 16 + fr]; float dn = 1.f / 32.f;
                        if (knmode != 1) { tot += xs[((wr * 4 + (wc ^ 1)) * 16 + xi) * 16 + fr]; dn = 1.f / 64.f; }
                        const float nrm = rsqrtf(tot * dn + EPS);
                        const float* gp = (knmode == 1) ? g_a + 8 * fq : ((knmode == 2) ? g_b : (knmode == 3 ? g_ds : g_dw)) + (wc & 1) * 32 + 8 * fq;
                        v0 = v0 * nrm * *(const f32x4*)gp; v1 = v1 * nrm * *(const f32x4*)(gp + 4);
                    }
                    u32x4 w; w[0] = pg8::cvt_pk_bf16(v0[0], v0[1]); w[1] = pg8::cvt_pk_bf16(v0[2], v0[3]); w[2] = pg8::cvt_pk_bf16(v1[0], v1[1]); w[3] = pg8::cvt_pk_bf16(v1[2], v1[3]);
                    *(u32x4*)(proj + (size_t)row * PINP + col0) = w;
                }
            }
    }
};
struct EpiResF {
    static constexpr bool PERM = false, AFTER_DRAIN = false;
    const float* xin; float* xout; const float* gate; const float* g; const float* sc; bf16_t* xa; float* rowss;
    __device__ __forceinline__ void operator()(const pg8::f32x4 (&acc)[2][2][4][2], const pg8::Unit& u, int wr, int wc, int fr, int fq) const {
        const int b = u.pm >> 4, col0 = u.pn * 256 + wc * 32 + 4 * fq;
        f32x4 gt[2][2], gm[2][2];
#pragma unroll
        for (int bj = 0; bj < 2; ++bj)
#pragma unroll
            for (int n = 0; n < 2; ++n) { const int c = col0 + bj * 128 + n * 16; gt[bj][n] = *(const f32x4*)(gate + b * 6144 + c);
                if (xa) gm[bj][n] = *(const f32x4*)(g + c) * (*(const f32x4*)(sc + b * 6144 + c) + 1.0f); else gm[bj][n] = (f32x4){0.f, 0.f, 0.f, 0.f}; }
#pragma unroll
        for (int ai = 0; ai < 2; ++ai)
#pragma unroll
            for (int mh = 0; mh < 2; ++mh) {
                f32x4 xi[2][2][2];
#pragma unroll
                for (int mm = 0; mm < 2; ++mm)
#pragma unroll
                    for (int bj = 0; bj < 2; ++bj)
#pragma unroll
                        for (int n = 0; n < 2; ++n)
                            xi[mm][bj][n] = *(const f32x4*)(xin + (size_t)(u.pm * 256 + ai * 128 + wr * 64 + (2 * mh + mm) * 16 + fr) * DM + col0 + bj * 128 + n * 16);
                asm volatile("" ::: "memory");
#pragma unroll
                for (int mm = 0; mm < 2; ++mm) {
                    const int m = 2 * mh + mm; const int row = u.pm * 256 + ai * 128 + wr * 64 + m * 16 + fr; float ss = 0.f;
#pragma unroll
                    for (int bj = 0; bj < 2; ++bj)
#pragma unroll
                        for (int n = 0; n < 2; ++n) { const size_t off = (size_t)row * DM + col0 + bj * 128 + n * 16;
                            const f32x4 o = xi[mm][bj][n] + gt[bj][n] * acc[ai][bj][m][n];
                            *(f32x4*)(xout + off) = o; ss += (o[0] * o[0] + o[1] * o[1]) + (o[2] * o[2] + o[3] * o[3]);
                            if (xa) { const f32x4 q = o * gm[bj][n]; uint2 w; w.x = pg8::cvt_pk_bf16(q[0], q[1]); w.y = pg8::cvt_pk_bf16(q[2], q[3]); *(uint2*)(xa + off) = w; } }
                    if (rowss) { ss += __shfl_xor(ss, 16); ss += __shfl_xor(ss, 32); if (fq == 0) rowss[(size_t)row * 16 + u.pn * 4 + wc] = ss; }
                }
            }
    }
};


#define DPPF(oldv, src, CTRL) __builtin_bit_cast(float, __builtin_amdgcn_update_dpp(__builtin_bit_cast(int, (float)(oldv)), __builtin_bit_cast(int, (float)(src)), (CTRL), 0xf, 0xf, false))
struct EpiUpAct {
    static constexpr bool PERM = true, AFTER_DRAIN = false;
    const float* rowss; const float* cb; bf16_t* act; float* eg; float* ev; const float* cw; const float* cbias; LDSF float* xch; LDSF float* cst  ;
    __device__ __forceinline__ void operator()(const pg8::f32x4 (&acc)[2][2][4][2], const pg8::Unit& u, int wr, int wc, int fr, int fq) const {
        const int b = u.pm >> 4, cih = wc * 32 + 8 * fq, jcol = u.pn * 128 + cih;
        const float* cbg = cb + b * NUP + u.pn * 256 + cih; const float* cbv = cbg + 128;
        {
            const int tid = (wr * 4 + wc) * 64 + fq * 16 + fr, col = tid & 127, arr = tid >> 7;
            const float* src = (arr == 0) ? cb + b * NUP + u.pn * 256 + col : (arr == 1) ? cb + b * NUP + u.pn * 256 + 128 + col : cw + (arr - 2) * DFF + u.pn * 128 + col;
            cst[arr * 128 + col] = *src;
            if (tid < 256) { const int a2 = 4 + (tid >> 7); cst[a2 * 128 + col] = (a2 == 4) ? cw[2 * DFF + u.pn * 128 + col] : cbias[u.pn * 128 + col]; }
            else cst[768 + (tid - 256)] = row_rstd16(rowss, u.pm * 256 + (tid - 256));
            const f32x4 cg0 = *(const f32x4*)cbg, cg1 = *(const f32x4*)(cbg + 4);
            const f32x4 cv0 = *(const f32x4*)cbv, cv1 = *(const f32x4*)(cbv + 4);
            asm volatile("s_waitcnt vmcnt(0) lgkmcnt(0)" ::: "memory"); __builtin_amdgcn_s_barrier(); asm volatile("" ::: "memory");
            const float r3a = cst[768 + 0 * 128 + wr * 64 + 48 + fr], r3b = cst[768 + 1 * 128 + wr * 64 + 48 + fr], r0 = cst[768 + (fr & 1)];
#pragma unroll
            for (int ai = 0; ai < 2; ++ai) {
                const float r3 = ai ? r3b : r3a;
                const f32x4 g0 = acc[ai][0][3][0] * r3 + cg0, g1 = acc[ai][0][3][1] * r3 + cg1;
                if (fr >= 14) { LDSF float* x = xch + ((((wr * 2 + ai) * 4 + wc) * 2 + (fr - 14)) * 32 + 8 * fq); *(LDSF f32x4*)x = g0; *(LDSF f32x4*)(x + 4) = g1;
                    if (wr == 1 && ai == 1) { float* e = eg + ((size_t)(u.pm * 4 + 2 + (fr - 14))) * DFF + jcol; *(f32x4*)e = g0; *(f32x4*)(e + 4) = g1; } }
            }
            if (wr == 0 && fr < 2) {
                float* e = eg + ((size_t)(u.pm * 4 + fr)) * DFF + jcol; float* v = ev + ((size_t)(u.pm * 2 + fr)) * DFF + jcol;
                *(f32x4*)e = acc[0][0][0][0] * r0 + cg0; *(f32x4*)(e + 4) = acc[0][0][0][1] * r0 + cg1;
                *(f32x4*)v = acc[0][1][0][0] * r0 + cv0; *(f32x4*)(v + 4) = acc[0][1][0][1] * r0 + cv1;
            }
        }
        asm volatile("s_waitcnt lgkmcnt(0)" ::: "memory"); __builtin_amdgcn_s_barrier(); asm volatile("" ::: "memory");
#pragma unroll
        for (int ai = 0; ai < 2; ++ai) {
            f32x4 pvv[2];
            if (ai == 0 && wr == 0) { pvv[0] = (f32x4){0.f, 0.f, 0.f, 0.f}; pvv[1] = pvv[0]; }
            else { const int swr = (wr == 1) ? 0 : 1, sai = (wr == 1) ? ai : ai - 1;
                const LDSF float* x = xch + ((((swr * 2 + sai) * 4 + wc) * 2 + (fr & 1)) * 32 + 8 * fq); pvv[0] = *(const LDSF f32x4*)x; pvv[1] = *(const LDSF f32x4*)(x + 4); }
#pragma unroll
            for (int m = 0; m < 4; ++m) {
                asm volatile("" ::: "memory");
                const int row = u.pm * 256 + ai * 128 + wr * 64 + m * 16 + fr; const float rsm = cst[768 + ai * 128 + wr * 64 + m * 16 + fr];
                u32x4 w;
#pragma unroll
                for (int n = 0; n < 2; ++n) {
                    const LDSF float* cc = cst + cih + 4 * n;
                    const f32x4 cgn = *(const LDSF f32x4*)cc, cvn = *(const LDSF f32x4*)(cc + 128);
                    const f32x4 k0 = *(const LDSF f32x4*)(cc + 256), k1 = *(const LDSF f32x4*)(cc + 384), k2 = *(const LDSF f32x4*)(cc + 512), kb = *(const LDSF f32x4*)(cc + 640);
                    const f32x4 c = acc[ai][0][m][n] * rsm + cgn, v = acc[ai][1][m][n] * rsm + cvn; float o[4];
#pragma unroll
                    for (int i = 0; i < 4; ++i) {
                        const float gm1 = DPPF(DPPF(0.f, pvv[n][i], 0x121), c[i], 0x111);
                        const float gm2 = DPPF(DPPF(0.f, pvv[n][i], 0x122), c[i], 0x112);
                        const float cvv = k0[i] * gm2 + k1[i] * gm1 + k2[i] * c[i] + kb[i];
                        o[i] = cvv * __builtin_amdgcn_rcpf(1.f + __builtin_amdgcn_exp2f(-cvv * LOG2E)) * v[i];
                    }
                    w[2 * n] = pg8::cvt_pk_bf16(o[0], o[1]); w[2 * n + 1] = pg8::cvt_pk_bf16(o[2], o[3]);
                    pvv[n] = c;
                }
                *(u32x4*)(act + (size_t)row * DFF + jcol) = w;
            }
        }
    }
};
__device__ void act_fixup(const Params& p, int l, int pm) {
    if ((pm & 15) == 0) return;
    const float* eg = (const float*)(p.ws + WS_EG); const float* ev = (const float*)(p.ws + WS_EV); bf16_t* act = (bf16_t*)(p.ws + WS_ACT);
    const float* cw = p.conv_w + (size_t)l * 3 * DFF; const float* cbias = p.conv_b + (size_t)l * DFF;
    const int tid = TID();
    constexpr int NB4 = 4;
#pragma unroll 1
    for (int bt = 0; bt < 3; ++bt) {
        float a[NB4], bq[NB4], c0[NB4], c1[NB4], vv[NB4], k0[NB4], k1[NB4], k2[NB4], kb[NB4];
#pragma unroll
        for (int i = 0; i < NB4; ++i) { const int idx = min(tid + (bt * NB4 + i) * NTHR, 2 * DFF - 1); const int r = idx / DFF, j = idx - r * DFF;
            a[i] = eg[((size_t)((pm - 1) * 4 + 2)) * DFF + j]; bq[i] = eg[((size_t)((pm - 1) * 4 + 3)) * DFF + j]; c0[i] = eg[((size_t)(pm * 4 + 0)) * DFF + j]; c1[i] = eg[((size_t)(pm * 4 + 1)) * DFF + j];
            vv[i] = ev[((size_t)(pm * 2 + r)) * DFF + j]; k0[i] = cw[j]; k1[i] = cw[DFF + j]; k2[i] = cw[2 * DFF + j]; kb[i] = cbias[j]; }
        asm volatile("" ::: "memory");
#pragma unroll
        for (int i = 0; i < NB4; ++i) { const int idx = tid + (bt * NB4 + i) * NTHR;
            if (idx < 2 * DFF) { const int r = idx / DFF, j = idx - r * DFF;
                const float gm2 = r ? bq[i] : a[i], gm1 = r ? c0[i] : bq[i], gc = r ? c1[i] : c0[i];
                const float cvv = k0[i] * gm2 + k1[i] * gm1 + k2[i] * gc + kb[i];
                act[(size_t)(pm * 256 + r) * DFF + j] = f2bf(siluf(cvv) * vv[i]); } }
    }
}

__device__ void ph_prep_cum_bh(const Params& p, int l, int bh, unsigned char* lds) {
    const float* side = (const float*)(p.ws + WS_SIDE);
    float* cum = (float*)(p.ws + WS_CUM);
    LDSF float* wt = (LDSF float*)(lds + 70000);
    const int tid = TID(), lane = tid & 63, wv = tid >> 6;
    {
        const int b = bh >> 2, h = bh & 3; const float bf = p.fox_bf[l * 4 + h];
        float v[8]; float tot = 0.f;
#pragma unroll
        for (int i = 0; i < 8; ++i) { v[i] = logsigf(side[(size_t)(b * SEQ + tid * 8 + i) * 16 + h] + bf); tot += v[i]; v[i] = tot; }
        float inc = tot;
#pragma unroll
        for (int o = 1; o < 64; o <<= 1) { const float u = __shfl_up(inc, o); if (lane >= o) inc += u; }
        __syncthreads();
        if (lane == 63) wt[wv] = inc;
        __syncthreads();
        float base = inc - tot;
        for (int w8 = 0; w8 < wv; ++w8) base += wt[w8];
#pragma unroll
        for (int i = 0; i < 8; ++i) cum[bh * SEQ + tid * 8 + i] = base + v[i];
    }
}
template <int N> __device__ __forceinline__ float dotn(const float* q, const bf16_t* k) {
    float s = 0.f;
#pragma unroll
    for (int c = 0; c < N / 8; ++c) { float t[8]; load8(k + 8 * c, t);
#pragma unroll
        for (int j = 0; j < 8; ++j) s += q[8 * c + j] * t[j]; }
    return s;
}
template <int N> __device__ __forceinline__ void axpyn(float* o, float w, const bf16_t* v) {
#pragma unroll
    for (int c = 0; c < N / 8; ++c) { float t[8]; load8(v + 8 * c, t);
#pragma unroll
        for (int j = 0; j < 8; ++j) o[8 * c + j] += w * t[j]; }
}
template <int N> __device__ __forceinline__ void loadq_norm(float* q, const bf16_t* src, const float* g, float scale, bool norm) {
    float ss = 0.f;
#pragma unroll
    for (int c = 0; c < N / 8; ++c) load8(src + 8 * c, q + 8 * c);
#pragma unroll
    for (int j = 0; j < N; ++j) ss += q[j] * q[j];
    const float r = norm ? rsqrtf(ss * (1.f / N) + EPS) : 1.f;
#pragma unroll
    for (int j = 0; j < N; ++j) q[j] = q[j] * r * (norm ? g[j] : 1.f) * scale;
}
__device__ __forceinline__ void store64(bf16_t* dst, const float* o) {
#pragma unroll
    for (int c = 0; c < 8; ++c) { u32x4 w; w[0] = pk2(o[8 * c], o[8 * c + 1]); w[1] = pk2(o[8 * c + 2], o[8 * c + 3]); w[2] = pk2(o[8 * c + 4], o[8 * c + 5]); w[3] = pk2(o[8 * c + 6], o[8 * c + 7]); *(u32x4*)(dst + 8 * c) = w; }
}

typedef float f32x16 __attribute__((ext_vector_type(16)));
typedef short s16x4 __attribute__((ext_vector_type(4)));
#define LDSP __attribute__((address_space(3)))
constexpr int KSTR = 144;
constexpr int AL_KV = 17408;
constexpr int AL_BK = 2 * AL_KV  , AL_TB = AL_BK + 512  , AL_WSF = AL_TB + 512  , AL_MISC = AL_WSF + 2048  ,
              AL_IMP = 38912  , AL_SELM = AL_IMP + 65536  ,
              AL_TB4 = AL_SELM + 512  , AL_INVL = AL_TB4 + 2048  , AL_D_END = AL_INVL + 1024;
static_assert(AL_MISC + 64 <= AL_IMP && AL_D_END <= 131072, "attention LDS map");
__device__ __forceinline__ int crow(int r, int hi) { return (r & 3) + 8 * (r >> 2) + 4 * hi; }
__device__ __forceinline__ float ex2(float v) { return __builtin_amdgcn_exp2f(v); }
__device__ __forceinline__ s16x4 vtr(const LDSP unsigned char* p) { typedef short v4i16_t __attribute__((ext_vector_type(4))); return __builtin_bit_cast(s16x4, __builtin_amdgcn_ds_read_tr16_b64_v4i16((LDSP v4i16_t*)p)); }
__device__ __forceinline__ bf16x8 pack8(const f32x16& p, int b) {
    u32x4 w; w[0] = pg8::cvt_pk_bf16(p[b], p[b + 1]); w[1] = pg8::cvt_pk_bf16(p[b + 2], p[b + 3]); w[2] = pg8::cvt_pk_bf16(p[b + 4], p[b + 5]); w[3] = pg8::cvt_pk_bf16(p[b + 6], p[b + 7]);
    return __builtin_bit_cast(bf16x8, w);
}
__device__ __forceinline__ f32x16 splat16(float v) { return (f32x16){v, v, v, v, v, v, v, v, v, v, v, v, v, v, v, v}; }
template <int NK16>
__device__ __forceinline__ void qkt(f32x16& p0, f32x16& p1, const LDSP unsigned char* Kt, const bf16x8* qf, int dbase, int r32, int hi) {
    const LDSP unsigned char* kb = Kt + r32 * KSTR + hi * 16 + dbase * 32;
#pragma unroll
    for (int d0 = 0; d0 < NK16; ++d0) {
        const bf16x8 a0 = *(const LDSP bf16x8*)(kb + d0 * 32), a1 = *(const LDSP bf16x8*)(kb + 32 * KSTR + d0 * 32);
        p0 = __builtin_amdgcn_mfma_f32_32x32x16_bf16(a0, qf[d0], p0, 0, 0, 0);
        p1 = __builtin_amdgcn_mfma_f32_32x32x16_bf16(a1, qf[d0], p1, 0, 0, 0);
    }
}
__device__ __forceinline__ void pv(f32x16* o, const LDSP unsigned char* Vt, int vb, const f32x16& p0, const f32x16& p1) {
    bf16x8 pa[4]; pa[0] = pack8(p0, 0); pa[1] = pack8(p0, 8); pa[2] = pack8(p1, 0); pa[3] = pack8(p1, 8);
#pragma unroll
    for (int d0 = 0; d0 < 2; ++d0)
#pragma unroll
        for (int ks = 0; ks < 4; ++ks) {
            const s16x4 lo = vtr(Vt + vb + d0 * 4096 + ks * 1024), hh = vtr(Vt + vb + d0 * 4096 + ks * 1024 + 512);
            const bf16x8 vf = (bf16x8){lo[0], lo[1], lo[2], lo[3], hh[0], hh[1], hh[2], hh[3]};
            o[d0] = __builtin_amdgcn_mfma_f32_32x32x16_bf16(pa[ks], vf, o[d0], 0, 0, 0);
        }
}
__device__ __forceinline__ float exp_sum(f32x16& p0, f32x16& p1) {
    float s0 = 0.f, s1 = 0.f;
#pragma unroll
    for (int r = 0; r < 16; ++r) { p0[r] = ex2(p0[r]); p1[r] = ex2(p1[r]); s0 += p0[r]; s1 += p1[r]; }
    return s0 + s1;
}
__device__ __forceinline__ void scale_rows(f32x16* o, float f, LDSP float* wsf, int r32, int hi) {
    __builtin_amdgcn_wave_barrier();
    if (hi == 0) wsf[r32] = f;
    __builtin_amdgcn_s_waitcnt(0xc07f);
    __builtin_amdgcn_wave_barrier();
#pragma unroll
    for (int g = 0; g < 4; ++g) { const f32x4 a = *(const LDSP f32x4*)(wsf + 8 * g + 4 * hi);
#pragma unroll
        for (int i = 0; i < 4; ++i) { o[0][4 * g + i] *= a[i]; o[1][4 * g + i] *= a[i]; } }
    __builtin_amdgcn_wave_barrier();
}
__device__ __forceinline__ void store_o(const f32x16* o, LDSP bf16_t* stg, bf16_t* dst, int lane, int r32, int hi) {
    __builtin_amdgcn_wave_barrier();
#pragma unroll
    for (int r = 0; r < 16; ++r) { const int orow = crow(r, hi); stg[orow * 64 + r32] = f2bf(o[0][r]); stg[orow * 64 + 32 + r32] = f2bf(o[1][r]); }
    __builtin_amdgcn_s_waitcnt(0xc07f);
    __builtin_amdgcn_wave_barrier();
#pragma unroll
    for (int i = 0; i < 4; ++i) { const int row = i * 8 + (lane >> 3), ch = lane & 7; const u32x4 v = *(const LDSP u32x4*)(stg + row * 64 + ch * 8); *(u32x4*)(dst + (size_t)row * DM + ch * 8) = v; }
    __builtin_amdgcn_s_waitcnt(0xc07f);
    __builtin_amdgcn_wave_barrier();
}
template <int NG>
__device__ __forceinline__ void load_q(bf16x8* qf, const bf16_t* qrow  , const float* g, float sc, bool norm, int hi) {
    float v[4][8];
#pragma unroll
    for (int d0 = 0; d0 < 4; ++d0) load8(qrow + 16 * d0 + 8 * hi, v[d0]);
    float r0 = 1.f, r1 = 1.f;
    if (norm) {
        float s0 = 0.f, s1 = 0.f;
#pragma unroll
        for (int j = 0; j < 8; ++j) { s0 += v[0][j] * v[0][j] + v[1][j] * v[1][j]; s1 += v[2][j] * v[2][j] + v[3][j] * v[3][j]; }
        s0 += __shfl_xor(s0, 32); s1 += __shfl_xor(s1, 32);
        if (NG == 64) { r0 = rsqrtf((s0 + s1) * (1.f / 64.f) + EPS); r1 = r0; } else { r0 = rsqrtf(s0 * (1.f / 32.f) + EPS); r1 = rsqrtf(s1 * (1.f / 32.f) + EPS); }
    }
#pragma unroll
    for (int d0 = 0; d0 < 4; ++d0) {
        const float rr = (d0 < 2 ? r0 : r1) * sc; float w[8];
#pragma unroll
        for (int j = 0; j < 8; ++j) { const int d = 16 * d0 + 8 * hi + j; w[j] = v[d0][j] * rr * (norm ? g[d % NG] : 1.f); }
        u32x4 u; u[0] = pg8::cvt_pk_bf16(w[0], w[1]); u[1] = pg8::cvt_pk_bf16(w[2], w[3]); u[2] = pg8::cvt_pk_bf16(w[4], w[5]); u[3] = pg8::cvt_pk_bf16(w[6], w[7]);
        qf[d0] = __builtin_bit_cast(bf16x8, u);
    }
}
__device__ __forceinline__ void kv_load(u32x4& kr, u32x4& vr, const bf16_t* Kb, const bf16_t* Vb, int k0, int tid) {
    const size_t off = (size_t)(k0 + (tid >> 3)) * PINP + (tid & 7) * 8;
    kr = *(const u32x4*)(Kb + off); vr = *(const u32x4*)(Vb + off);
}
__device__ __forceinline__ void kv_load64(u32x4& kr, u32x4& vr, const bf16_t* Kb, const bf16_t* Vb, int n0, int tid) {
    const size_t off = (size_t)(n0 + (tid >> 3)) * 64 + (tid & 7) * 8;
    kr = *(const u32x4*)(Kb + off); vr = *(const u32x4*)(Vb + off);
}
__device__ __forceinline__ void kv_store(const u32x4& kr, const u32x4& vr, LDSP unsigned char* buf, int tid) {
    const int key = tid >> 3, ch = tid & 7;
    *(LDSP u32x4*)(buf + key * KSTR + ch * 16) = kr;
    *(LDSP u32x4*)(buf + 9216 + (ch >> 2) * 4096 + (key >> 4) * 1024 + ((key >> 3) & 1) * 512 + (key & 7) * 64 + (ch & 3) * 16) = vr;
}
template <int NG>
__device__ __forceinline__ void knorm_chunk(u32x4& kr, const float* gp  ) {
    float v[8];
    v[0] = bf2f(kr[0] & 0xffff); v[1] = bf2f(kr[0] >> 16); v[2] = bf2f(kr[1] & 0xffff); v[3] = bf2f(kr[1] >> 16);
    v[4] = bf2f(kr[2] & 0xffff); v[5] = bf2f(kr[2] >> 16); v[6] = bf2f(kr[3] & 0xffff); v[7] = bf2f(kr[3] >> 16);
    float ss = 0.f;
#pragma unroll
    for (int j = 0; j < 8; ++j) ss += v[j] * v[j];
    ss += __shfl_xor(ss, 1); ss += __shfl_xor(ss, 2); if (NG == 64) ss += __shfl_xor(ss, 4);
    const float r = rsqrtf(ss * (1.f / NG) + EPS);
    const f32x4 ga = *(const f32x4*)gp, gb = *(const f32x4*)(gp + 4);
    kr[0] = pg8::cvt_pk_bf16(v[0] * r * ga[0], v[1] * r * ga[1]); kr[1] = pg8::cvt_pk_bf16(v[2] * r * ga[2], v[3] * r * ga[3]);
    kr[2] = pg8::cvt_pk_bf16(v[4] * r * gb[0], v[5] * r * gb[1]); kr[3] = pg8::cvt_pk_bf16(v[6] * r * gb[2], v[7] * r * gb[3]);
}
__device__ __forceinline__ void bias_near(f32x16& p0, f32x16& p1, const LDSP float* tbl, int tk0  , int wnd, bool rowok, int hi) {
#pragma unroll
    for (int g = 0; g < 4; ++g) {
#pragma unroll
        for (int i = 0; i < 4; ++i) { const int r = 4 * g + i; const int d0_ = tk0 - crow(r, hi), d1_ = d0_ - 32;
            const float b0 = tbl[min(max(d0_, 0), 127)], b1 = tbl[min(max(d1_, 0), 127)];
            p0[r] = (d0_ < 0 || d0_ >= wnd || !rowok) ? -INFINITY : p0[r] + b0; p1[r] = (d1_ < 0 || d1_ >= wnd || !rowok) ? -INFINITY : p1[r] + b1; }
        asm volatile("" ::: "memory");
    }
}
#define KVBUF(L, i) ((L) + ((i) & 1) * AL_KV)

__device__ void fa_fox_unit(const Params& p, int l, int b, int h, int qb, LDSP unsigned char* L) {
    const int tid = TID(), lane = tid & 63, wid = __builtin_amdgcn_readfirstlane(tid >> 6), r32 = lane & 31, hi = lane >> 5;
    const bf16_t* proj = (const bf16_t*)(p.ws + WS_PROJ); bf16_t* mix = (bf16_t*)(p.ws + WS_MIX);
    const size_t rb = (size_t)b * SEQ; const int q0 = qb * 256, qw = q0 + 32 * wid, t = qw + r32;
    const bf16_t* Kb = proj + rb * PINP + CB_K + 64 * h; const bf16_t* Vb = proj + rb * PINP + CB_V + 64 * h;
    const float* cm = (const float*)(p.ws + WS_CUM) + (b * 4 + h) * SEQ;
    LDSP float* wsf = (LDSP float*)(L + AL_WSF) + wid * 64; LDSP float* bk = (LDSP float*)(L + AL_BK);
    const int vb = 9216 + ((lane >> 4) & 1) * 32 + (lane & 3) * 8 + (4 * hi + ((lane & 15) >> 2)) * 64;
    bf16x8 qf[4]; load_q<64>(qf, proj + (rb + t) * PINP + CB_Q + 64 * h, p.fox_qn + l * 64, 0.125f * LOG2E, true, hi);
    const float rowc = cm[t] * LOG2E - ((const float*)(p.ws + WS_BND))[l * 32 + 4];
    f32x16 o[2]; o[0] = (f32x16){}; o[1] = (f32x16){};
    float l_run = 0.f;
    const int NT = 4 * qb + 4, jd = 4 * qb + (wid >> 1);
    u32x4 krA, vrA, krB, vrB; float crA = 0.f, crB = 0.f;
    int js;
    {   const bool live = (lane < NT) ? ((cm[q0] - cm[64 * lane + 63]) * LOG2E >= -160.f) : false;
        const unsigned long long bm = __ballot(live);
        js = __builtin_amdgcn_readfirstlane((int)__builtin_ctzll(bm | (1ull << (NT - 1)))); if (js > NT - 2) js = NT - 2; js &= ~1; }
    __syncthreads();
    kv_load(krA, vrA, Kb, Vb, 64 * js, tid); if (tid < 64) crA = cm[64 * js + tid];
    kv_store(krA, vrA, KVBUF(L, js), tid); if (tid < 64) bk[(js & 1) * 64 + tid] = -crA * LOG2E;
    kv_load(krB, vrB, Kb, Vb, 64 * (js + 1), tid); if (tid < 64) crB = cm[64 * (js + 1) + tid];
    if (js + 2 < NT) { kv_load(krA, vrA, Kb, Vb, 64 * (js + 2), tid); if (tid < 64) crA = cm[64 * (js + 2) + tid]; }
#define FOX_STEP(J, KR, VR, CR) do { const int j = (J); \
        __syncthreads(); \
        if (j + 1 < NT) { kv_store(KR, VR, KVBUF(L, j + 1), tid); if (tid < 64) bk[((j + 1) & 1) * 64 + tid] = -CR * LOG2E; } \
        if (j + 3 < NT) { kv_load(KR, VR, Kb, Vb, 64 * (j + 3), tid); if (tid < 64) CR = cm[64 * (j + 3) + tid]; } \
        if (j <= jd) { \
            const LDSP unsigned char* buf = KVBUF(L, j); const LDSP float* bkj = bk + (j & 1) * 64; \
            f32x16 p0, p1; \
            _Pragma("unroll") for (int g = 0; g < 4; ++g) { const f32x4 b0 = *(const LDSP f32x4*)(bkj + 8 * g + 4 * hi), b1 = *(const LDSP f32x4*)(bkj + 32 + 8 * g + 4 * hi); \
                _Pragma("unroll") for (int i = 0; i < 4; ++i) { p0[4 * g + i] = b0[i] + rowc; p1[4 * g + i] = b1[i] + rowc; } } \
            qkt<4>(p0, p1, buf, qf, 0, r32, hi); \
            if (j == jd) { const int k0 = 64 * j; \
                _Pragma("unroll") for (int r = 0; r < 16; ++r) { const int kk = k0 + crow(r, hi); if (kk > t) p0[r] = -INFINITY; if (kk + 32 > t) p1[r] = -INFINITY; } } \
            l_run += exp_sum(p0, p1); \
            pv(o, buf, vb, p0, p1); \
        } } while (0)
    for (int jj = js; jj < NT; jj += 2) { FOX_STEP(jj, krB, vrB, crB); FOX_STEP(jj + 1, krA, vrA, crA); }
#undef FOX_STEP
    l_run += __shfl_xor(l_run, 32);
    scale_rows(o, 1.f / l_run, wsf, r32, hi);
    store_o(o, (LDSP bf16_t*)(L + AL_IMP + wid * 8192), mix + (rb + qw) * DM + 256 + 64 * h, lane, r32, hi);
}

__device__ void fa_diff_unit(const Params& p, int l, int b, int h, int qb, LDSP unsigned char* L) {
    const int tid = TID(), lane = tid & 63, wid = __builtin_amdgcn_readfirstlane(tid >> 6), r32 = lane & 31, hi = lane >> 5;
    const bf16_t* proj = (const bf16_t*)(p.ws + WS_PROJ); bf16_t* mix = (bf16_t*)(p.ws + WS_MIX);
    const size_t rb = (size_t)b * SEQ; const int q0 = qb * 256, qw = q0 + 32 * wid, t = qw + r32;
    const bf16_t* Kb = proj + rb * PINP + CA_K + 64 * h; const bf16_t* Vb = proj + rb * PINP + CA_V + 64 * h;
    LDSP float* wsf = (LDSP float*)(L + AL_WSF) + wid * 64; LDSP float* tbl = (LDSP float*)(L + AL_TB);
    const int vb = 9216 + ((lane >> 4) & 1) * 32 + (lane & 3) * 8 + (4 * hi + ((lane & 15) >> 2)) * 64;
    const float lam = ((const float*)(p.ws + WS_LAM))[l]; const float lam_init = 0.8f - 0.6f * __expf(-0.3f * (float)l);
    const float nbound = -((const float*)(p.ws + WS_BND))[l * 32 + h];
    __syncthreads();
    if (tid < 128) tbl[tid] = ((const float*)(p.ws + WS_TB))[h * 128 + tid] * LOG2E;
    bf16x8 qf[4]; load_q<32>(qf, proj + (rb + t) * PINP + CA_Q + 64 * h, p.diff_qn + l * 32, 0.17677669529663687f * LOG2E, true, hi);
    f32x16 o1[2], o2[2]; o1[0] = (f32x16){}; o1[1] = (f32x16){}; o2[0] = (f32x16){}; o2[1] = (f32x16){};
    float l1 = 0.f, l2 = 0.f;
    const int NT = 4 * qb + 4, jd = 4 * qb + (wid >> 1);
    u32x4 kr, vr; const float* gk = p.diff_kn + l * 32 + (tid & 3) * 8;
    kv_load(kr, vr, Kb, Vb, 0, tid);
    kv_store(kr, vr, KVBUF(L, 0), tid);
    kv_load(kr, vr, Kb, Vb, 64, tid);
    for (int j = 0; j < NT; ++j) {
        __syncthreads();
        if (j + 1 < NT) { kv_store(kr, vr, KVBUF(L, j + 1), tid); }
        if (j + 2 < NT) kv_load(kr, vr, Kb, Vb, 64 * (j + 2), tid);
        if (j <= jd) {
            const LDSP unsigned char* buf = KVBUF(L, j);
            const int k0 = 64 * j; const bool nearb = (qw - (k0 + 63)) < 113; const float cfar = tbl[127] + nbound;
#pragma unroll
            for (int mp = 0; mp < 2; ++mp) {
                f32x16 p0 = splat16(nearb ? nbound : cfar), p1 = p0;
                qkt<2>(p0, p1, buf, qf + 2 * mp, 2 * mp, r32, hi);
                if (nearb) bias_near(p0, p1, tbl, t - k0, 1 << 30, true, hi);
                if (mp == 0) { l1 += exp_sum(p0, p1); pv(o1, buf, vb, p0, p1); }
                else { l2 += exp_sum(p0, p1); pv(o2, buf, vb, p0, p1); }
            }
        }
    }
    l1 += __shfl_xor(l1, 32); l2 += __shfl_xor(l2, 32);
    scale_rows(o1, 1.f / l1, wsf, r32, hi); scale_rows(o2, lam / l2, wsf, r32, hi);
    o1[0] -= o2[0]; o1[1] -= o2[1];
    const float g0 = p.diff_sub[l * 64 + r32] * (1.f - lam_init), g1 = p.diff_sub[l * 64 + 32 + r32] * (1.f - lam_init);
#pragma unroll
    for (int r = 0; r < 16; ++r) {
        float ss = o1[0][r] * o1[0][r] + o1[1][r] * o1[1][r];
        ss += __shfl_xor(ss, 1); ss += __shfl_xor(ss, 2); ss += __shfl_xor(ss, 4); ss += __shfl_xor(ss, 8); ss += __shfl_xor(ss, 16);
        const float rs = rsqrtf(ss * (1.f / 64.f) + EPS); o1[0][r] *= rs * g0; o1[1][r] *= rs * g1;
    }
    store_o(o1, (LDSP bf16_t*)(L + AL_IMP + wid * 8192), mix + (rb + qw) * DM + 0 + 64 * h, lane, r32, hi);
}

template <bool DIAG>
__device__ __forceinline__ void stick_sub(f32x16& y, float& carry, int kbase  , int t, int hi) {
    float lk[16];
#pragma unroll
    for (int r = 0; r < 16; ++r) {
        const float v = y[r]; const float e = ex2(-fabsf(v)); const float lb = fminf(v, 0.f) - __builtin_amdgcn_logf(1.f + e);
        if (DIAG) { const bool valid = (kbase + crow(r, hi) < t); lk[r] = valid ? (lb - v) : 0.f; y[r] = valid ? lb : -INFINITY; }
        else { lk[r] = lb - v; y[r] = lb; }
    }
    float T[4], Go[4];
#pragma unroll
    for (int g = 0; g < 4; ++g) { const float Gs = (lk[4 * g] + lk[4 * g + 1]) + (lk[4 * g + 2] + lk[4 * g + 3]); Go[g] = __shfl_xor(Gs, 32); T[g] = Gs + Go[g]; }
    float sx = 0.f;
#pragma unroll
    for (int g = 3; g >= 0; --g) {
        float tail = carry + sx + (hi == 0 ? Go[g] : 0.f);
#pragma unroll
        for (int i = 3; i >= 0; --i) { y[4 * g + i] = ex2(y[4 * g + i] + tail); tail += lk[4 * g + i]; }
        sx += T[g];
    }
    carry += sx;
}
__device__ void fa_stick_unit(const Params& p, int l, int b, int h, int qb, LDSP unsigned char* L) {
    const int tid = TID(), lane = tid & 63, wid = __builtin_amdgcn_readfirstlane(tid >> 6), r32 = lane & 31, hi = lane >> 5;
    const bf16_t* proj = (const bf16_t*)(p.ws + WS_PROJ); bf16_t* mix = (bf16_t*)(p.ws + WS_MIX);
    const size_t rb = (size_t)b * SEQ; const int q0 = qb * 256, qw = q0 + 32 * wid, t = qw + r32;
    const bf16_t* Kb = proj + rb * PINP + CC_K + 64 * h; const bf16_t* Vb = proj + rb * PINP + CC_V + 64 * h;
    const int vb = 9216 + ((lane >> 4) & 1) * 32 + (lane & 3) * 8 + (4 * hi + ((lane & 15) >> 2)) * 64;
    bf16x8 qf[4]; load_q<64>(qf, proj + (rb + t) * PINP + CC_Q + 64 * h, nullptr, 0.125f * LOG2E, false, hi);
    f32x16 o[2]; o[0] = (f32x16){}; o[1] = (f32x16){};
    float carry = 0.f;
    const int NT = 4 * qb + 4, jd = 4 * qb + (wid >> 1);
    u32x4 kr, vr;
#define SBUF(i) (((i) & 1) ? (L + 108544) : L)
    LDSP unsigned* dn = (LDSP unsigned*)(L + AL_MISC) + 8;
    bool wdone = false;
    __syncthreads();
    if (lane == 0) dn[wid] = 0u;
    kv_load(kr, vr, Kb, Vb, 64 * (NT - 1), tid);
    kv_store(kr, vr, SBUF(NT - 1), tid);
    kv_load(kr, vr, Kb, Vb, 64 * (NT - 2), tid);
    for (int j = NT - 1; j >= 0; --j) {
        __syncthreads();
        if (__all(dn[lane & 7] != 0u)) break;
        if (j >= 1) kv_store(kr, vr, SBUF(j - 1), tid);
        if (j >= 2) kv_load(kr, vr, Kb, Vb, 64 * (j - 2), tid);
        if (j <= jd && !wdone) {
            const LDSP unsigned char* buf = SBUF(j);
            f32x16 p0 = (f32x16){}, p1 = (f32x16){};
            qkt<4>(p0, p1, buf, qf, 0, r32, hi);
            const int k0 = 64 * j; const bool diag = (j == jd);
            if (diag) { stick_sub<true>(p1, carry, k0 + 32, t, hi); stick_sub<true>(p0, carry, k0, t, hi); }
            else { stick_sub<false>(p1, carry, k0 + 32, t, hi); stick_sub<false>(p0, carry, k0, t, hi); }
            pv(o, buf, vb, p0, p1);
            if (__all(carry < -160.f)) { wdone = true; if (lane == 0) dn[wid] = 1u; }
        }
    }
    store_o(o, (LDSP bf16_t*)(L + AL_IMP + wid * 8192), mix + (rb + qw) * DM + 512 + 64 * h, lane, r32, hi);
}

__device__ void fa_nsa_unit(const Params& p, int l, int b, int u, LDSP unsigned char* L) {
    const int tid = TID(), lane = tid & 63, wid = __builtin_amdgcn_readfirstlane(tid >> 6), r32 = lane & 31, hi = lane >> 5;
    const int hh = wid >> 1, sub = wid & 1;
    const bf16_t* proj = (const bf16_t*)(p.ws + WS_PROJ); bf16_t* mix = (bf16_t*)(p.ws + WS_MIX);
    const size_t rb = (size_t)b * SEQ; const int q0 = 64 * u, qw = q0 + 32 * sub, t = qw + r32; const int ql = 32 * sub + r32;
    LDSP float* wsf = (LDSP float*)(L + AL_WSF) + wid * 64; LDSP float* tbl = (LDSP float*)(L + AL_TB4) + hh * 128;
    LDSP float* imp = (LDSP float*)(L + AL_IMP); LDSP unsigned* selm = (LDSP unsigned*)(L + AL_SELM); LDSP float* invl = (LDSP float*)(L + AL_INVL);
    LDSP float* ofl = (LDSP float*)(L + AL_IMP) + wid * 2048 + lane;
    const int vb = 9216 + ((lane >> 4) & 1) * 32 + (lane & 3) * 8 + (4 * hi + ((lane & 15) >> 2)) * 64;
    const float* bnd = (const float*)(p.ws + WS_BND) + l * 32;
    __syncthreads();
    ((LDSP float*)(L + AL_TB4))[tid] = ((const float*)(p.ws + WS_TB))[512 + tid] * LOG2E;
    bf16x8 qf[4]; load_q<64>(qf, proj + (rb + t) * PINP + CD_Q + 64 * hh, p.nsa_qn + l * 64, 0.125f * LOG2E, true, hi);
    const float* sd = (const float*)(p.ws + WS_SIDE) + (rb + t) * 16 + 4 + hh;
    const float gc = 1.f / (1.f + __expf(-sd[0])), gs = 1.f / (1.f + __expf(-sd[4])), gwn = 1.f / (1.f + __expf(-sd[8]));
    f32x16 o[2]; o[0] = (f32x16){}; o[1] = (f32x16){};
    u32x4 kr, vr;
    {
        const bf16_t* Kc = (const bf16_t*)(p.ws + WS_KC) + (size_t)b * 256 * 64; const bf16_t* Vc = (const bf16_t*)(p.ws + WS_VC) + (size_t)b * 256 * 64;
        const int ntc = (4 * u + 2) / 64 + 1; const float nbound = -bnd[5 + hh];
        float l_run = 0.f, prevE3 = 0.f;
        kv_load64(kr, vr, Kc, Vc, 0, tid);
        kv_store(kr, vr, KVBUF(L, 0), tid);
        if (ntc > 1) kv_load64(kr, vr, Kc, Vc, 64, tid);
        for (int T = 0; T < ntc; ++T) {
            __syncthreads();
            if (T + 1 < ntc) kv_store(kr, vr, KVBUF(L, T + 1), tid);
            if (T + 2 < ntc) kv_load64(kr, vr, Kc, Vc, 64 * (T + 2), tid);
            const LDSP unsigned char* buf = KVBUF(L, T);
            f32x16 p0 = splat16(nbound), p1 = p0;
            qkt<4>(p0, p1, buf, qf, 0, r32, hi);
#pragma unroll
            for (int g = 0; g < 4; ++g) {
#pragma unroll
                for (int i = 0; i < 4; ++i) { const int r = 4 * g + i; const int d0_ = t - 16 * (64 * T + crow(r, hi)) - 31, d1_ = d0_ - 512;
                    const float b0 = tbl[min(max(d0_, 0), 127)], b1 = tbl[min(max(d1_, 0), 127)];
                    p0[r] = (d0_ < 0) ? -INFINITY : p0[r] + b0; p1[r] = (d1_ < 0) ? -INFINITY : p1[r] + b1; }
                asm volatile("" ::: "memory");
            }
            l_run += exp_sum(p0, p1);
#pragma unroll
            for (int s2 = 0; s2 < 2; ++s2) {
                float G[4], Eo[4];
#pragma unroll
                for (int g = 0; g < 4; ++g) { const float a0 = s2 ? p1[4 * g] : p0[4 * g], a1 = s2 ? p1[4 * g + 1] : p0[4 * g + 1], a2 = s2 ? p1[4 * g + 2] : p0[4 * g + 2], a3 = s2 ? p1[4 * g + 3] : p0[4 * g + 3];
                    G[g] = (a0 + a1) + (a2 + a3); Eo[g] = __shfl_xor(a3, 32); }
#pragma unroll
                for (int g = 0; g < 4; ++g) { const float eprev = hi ? Eo[g] : (g > 0 ? Eo[g - 1] : prevE3);
                    imp[(hh * 64 + ql) * 64 + 16 * T + 8 * s2 + 2 * g + hi] = G[g] + eprev; }
                prevE3 = Eo[3];
            }
            pv(o, buf, vb, p0, p1);
        }
        l_run += __shfl_xor(l_run, 32);
        const float inv = (l_run > 0.f) ? 1.f / l_run : 0.f;
        if (hi == 0) invl[hh * 64 + ql] = inv;
        scale_rows(o, gc * inv, wsf, r32, hi);
    }
    __syncthreads();
    {
        const int q = tid >> 3, part = tid & 7;
        const float i0 = invl[q], i1 = invl[64 + q], i2 = invl[128 + q], i3 = invl[192 + q];
        float vj[8];
#pragma unroll
        for (int jj = 0; jj < 8; ++jj) { const int j = part * 8 + jj;
            const float sum = ((imp[(0 * 64 + q) * 64 + j] * i0 + imp[(1 * 64 + q) * 64 + j] * i1) + imp[(2 * 64 + q) * 64 + j] * i2) + imp[(3 * 64 + q) * 64 + j] * i3;
            vj[jj] = (j > u) ? -1.0f : ((j == u || j == 0) ? 1.0e4f : sum); }
        __syncthreads();
#pragma unroll
        for (int jj = 0; jj < 8; ++jj) imp[q * 64 + part * 8 + jj] = vj[jj];
        __syncthreads();
        int rank[8];
#pragma unroll
        for (int jj = 0; jj < 8; ++jj) rank[jj] = 0;
        for (int i = 0; i < 64; ++i) { const float vi = imp[q * 64 + i];
#pragma unroll
            for (int jj = 0; jj < 8; ++jj) rank[jj] += (vi > vj[jj] || (vi == vj[jj] && i < part * 8 + jj)) ? 1 : 0; }
        unsigned bits = 0;
#pragma unroll
        for (int jj = 0; jj < 8; ++jj) if (rank[jj] < 16 && (part * 8 + jj) <= u) bits |= 1u << jj;
        unsigned mlo = (part < 4) ? (bits << (8 * part)) : 0u, mhi = (part >= 4) ? (bits << (8 * (part - 4))) : 0u;
        mlo |= __shfl_xor(mlo, 1); mhi |= __shfl_xor(mhi, 1); mlo |= __shfl_xor(mlo, 2); mhi |= __shfl_xor(mhi, 2); mlo |= __shfl_xor(mlo, 4); mhi |= __shfl_xor(mhi, 4);
        if (part == 0) { selm[2 * q] = mlo; selm[2 * q + 1] = mhi; }
    }
    __syncthreads();
#pragma unroll
    for (int r = 0; r < 16; ++r) { ofl[(2 * r) * 64] = o[0][r]; ofl[(2 * r + 1) * 64] = o[1][r]; }
    o[0] = (f32x16){}; o[1] = (f32x16){};
    {
        const unsigned long long mymask = (unsigned long long)selm[2 * ql] | ((unsigned long long)selm[2 * ql + 1] << 32);
        unsigned ulo = selm[2 * lane], uhi = selm[2 * lane + 1];
#pragma unroll
        for (int s2 = 1; s2 < 64; s2 <<= 1) { ulo |= __shfl_xor(ulo, s2); uhi |= __shfl_xor(uhi, s2); }
        unsigned long long um = (unsigned long long)(unsigned)__builtin_amdgcn_readfirstlane((int)ulo) | ((unsigned long long)(unsigned)__builtin_amdgcn_readfirstlane((int)uhi) << 32);
        const bf16_t* Kb = proj + rb * PINP + CD_KS; const bf16_t* Vb = proj + rb * PINP + CD_VS;
        float l_run = 0.f; const float nbound = -bnd[9 + hh]; const float cfar = tbl[127] + nbound; const float* gk = p.nsa_kn + (l * 3 + 1) * 64 + (tid & 7) * 8;
        int j = __builtin_ctzll(um); um &= um - 1;
        int jn = um ? __builtin_ctzll(um) : -1; um &= um - 1;
        kv_load(kr, vr, Kb, Vb, 64 * j, tid);
        kv_store(kr, vr, KVBUF(L, 0), tid);
        if (jn >= 0) kv_load(kr, vr, Kb, Vb, 64 * jn, tid);
        for (int it = 0;; ++it) {
            __syncthreads();
            const int jnn = um ? __builtin_ctzll(um) : -1; um &= um - 1;
            if (jn >= 0) { kv_store(kr, vr, KVBUF(L, it + 1), tid); }
            if (jnn >= 0) kv_load(kr, vr, Kb, Vb, 64 * jnn, tid);
            const bool mine = (mymask >> j) & 1ull;
            if (__any(mine)) {
                const LDSP unsigned char* buf = KVBUF(L, it);
                const int k0 = 64 * j; const bool nearb = (qw - (k0 + 63)) < 113;
                f32x16 p0 = splat16(nearb ? nbound : (mine ? cfar : -INFINITY)), p1 = p0;
                qkt<4>(p0, p1, buf, qf, 0, r32, hi);
                if (nearb) bias_near(p0, p1, tbl, t - k0, 1 << 30, mine, hi);
                l_run += exp_sum(p0, p1);
                pv(o, buf, vb, p0, p1);
            }
            if (jn < 0) break;
            j = jn; jn = jnn;
        }
        l_run += __shfl_xor(l_run, 32);
        scale_rows(o, gs / l_run, wsf, r32, hi);
#pragma unroll
        for (int r = 0; r < 16; ++r) { ofl[(2 * r) * 64] += o[0][r]; ofl[(2 * r + 1) * 64] += o[1][r]; }
        o[0] = (f32x16){}; o[1] = (f32x16){};
    }
    {
        const bf16_t* Kb = proj + rb * PINP + CD_KW; const bf16_t* Vb = proj + rb * PINP + CD_VW;
        float l_run = 0.f; const float nbound = -bnd[13 + hh]; const float cfar = tbl[127] + nbound; const float* gk = p.nsa_kn + (l * 3 + 2) * 64 + (tid & 7) * 8;
        const int jlo = max(0, u - 8);
        __syncthreads();
        kv_load(kr, vr, Kb, Vb, 64 * jlo, tid);
        kv_store(kr, vr, KVBUF(L, jlo), tid);
        if (jlo < u) kv_load(kr, vr, Kb, Vb, 64 * (jlo + 1), tid);
        for (int j = jlo; j <= u; ++j) {
            __syncthreads();
            if (j + 1 <= u) { kv_store(kr, vr, KVBUF(L, j + 1), tid); }
            if (j + 2 <= u) kv_load(kr, vr, Kb, Vb, 64 * (j + 2), tid);
            const LDSP unsigned char* buf = KVBUF(L, j);
            const int k0 = 64 * j; const bool nearb = (j == u || j == u - 8 || (qw - (k0 + 63)) < 113);
            f32x16 p0 = splat16(nearb ? nbound : cfar), p1 = p0;
            qkt<4>(p0, p1, buf, qf, 0, r32, hi);
            if (nearb) bias_near(p0, p1, tbl, t - k0, 512, true, hi);
            l_run += exp_sum(p0, p1);
            pv(o, buf, vb, p0, p1);
        }
        l_run += __shfl_xor(l_run, 32);
        scale_rows(o, gwn / l_run, wsf, r32, hi);
#pragma unroll
        for (int r = 0; r < 16; ++r) { o[0][r] += ofl[(2 * r) * 64]; o[1][r] += ofl[(2 * r + 1) * 64]; }
    }
    store_o(o, (LDSP bf16_t*)(L + AL_IMP + wid * 8192), mix + (rb + qw) * DM + 768 + 64 * hh, lane, r32, hi);
}

__device__ void ph_reset_queues(const Params& p) { unsigned* ctl = (unsigned*)(p.ws + WS_CTL); const int gt = GTID(); if (gt < 8) ctl[gt] = 0u; }
__device__ void prep_cmp_task(const Params& p, int l, int task, LDSP unsigned char* L) {
    const int tid = TID(), lane = tid & 63, wid = __builtin_amdgcn_readfirstlane(tid >> 6), r32 = lane & 31, hi = lane >> 5;
    const int b = task >> 4, which = (task >> 3) & 1, nt = task & 7;
    const bf16_t* proj = (const bf16_t*)(p.ws + WS_PROJ);
    const bf16_t* phiT = (const bf16_t*)(p.ws + WS_PHIT) + (size_t)(l * 2 + which) * 64 * 2048;
    const float* pe = p.nsa_pe + (size_t)(l * 2 + which) * 32 * 64;
    const int n = 32 * nt + r32, colbase = which ? CD_VC : CD_KC;
    f32x16 acc0 = (f32x16){}, acc1 = (f32x16){};
#pragma unroll
    for (int ii = 0; ii < 4; ++ii) {
        const int i = 4 * wid + ii; const int tok = min(16 * n + i, SEQ - 1);
        const bf16_t* xr = proj + (size_t)(b * SEQ + tok) * PINP + colbase;
#pragma unroll
        for (int d0 = 0; d0 < 4; ++d0) {
            float xv[8]; load8(xr + 16 * d0 + 8 * hi, xv);
            const f32x4 pe0 = *(const f32x4*)(pe + i * 64 + 16 * d0 + 8 * hi), pe1 = *(const f32x4*)(pe + i * 64 + 16 * d0 + 8 * hi + 4);
            u32x4 aw; aw[0] = pg8::cvt_pk_bf16(xv[0] + pe0[0], xv[1] + pe0[1]); aw[1] = pg8::cvt_pk_bf16(xv[2] + pe0[2], xv[3] + pe0[3]);
            aw[2] = pg8::cvt_pk_bf16(xv[4] + pe1[0], xv[5] + pe1[1]); aw[3] = pg8::cvt_pk_bf16(xv[6] + pe1[2], xv[7] + pe1[3]);
            const bf16x8 af = __builtin_bit_cast(bf16x8, aw);
            const bf16x8 b0 = *(const bf16x8*)(phiT + (size_t)r32 * 2048 + i * 64 + 16 * d0 + 8 * hi);
            const bf16x8 b1 = *(const bf16x8*)(phiT + (size_t)(32 + r32) * 2048 + i * 64 + 16 * d0 + 8 * hi);
            acc0 = __builtin_amdgcn_mfma_f32_32x32x16_bf16(af, b0, acc0, 0, 0, 0);
            acc1 = __builtin_amdgcn_mfma_f32_32x32x16_bf16(af, b1, acc1, 0, 0, 0);
        }
    }
    LDSP float* red = (LDSP float*)L;
    __syncthreads();
#pragma unroll
    for (int r = 0; r < 16; ++r) { red[(wid * 32 + crow(r, hi)) * 64 + r32] = acc0[r]; red[(wid * 32 + crow(r, hi)) * 64 + 32 + r32] = acc1[r]; }
    __syncthreads();
    {
        const int row = tid >> 4, e4 = (tid & 15) * 4; f32x4 v = (f32x4){0.f, 0.f, 0.f, 0.f};
#pragma unroll
        for (int w8 = 0; w8 < 8; ++w8) v += *(const LDSP f32x4*)(red + (w8 * 32 + row) * 64 + e4);
        const int nn = 32 * nt + row;
        if (which == 0) {
            float ss = (v[0] * v[0] + v[1] * v[1]) + (v[2] * v[2] + v[3] * v[3]);
            ss += __shfl_xor(ss, 1); ss += __shfl_xor(ss, 2); ss += __shfl_xor(ss, 4); ss += __shfl_xor(ss, 8);
            const float rs = rsqrtf(ss * (1.f / 64.f) + EPS); const f32x4 g = *(const f32x4*)(p.nsa_kn + (l * 3 + 0) * 64 + e4);
            v = v * rs * g;
        }
        uint2 o; o.x = pk2(v[0], v[1]); o.y = pk2(v[2], v[3]);
        if (nn >= 255) { o.x = 0u; o.y = 0u; }
        *(uint2*)((bf16_t*)(p.ws + (which ? WS_VC : WS_KC)) + (size_t)(b * 256 + nn) * 64 + e4) = o;
    }
}
__device__ void ph_prep(const Params& p, int l, LDSP unsigned char* L, unsigned char* lds) {
    for (int t = blockIdx.x; t < 80; t += gridDim.x) { if (t < 64) prep_cmp_task(p, l, t, L); }
    if (gridDim.x >= 80) { if (blockIdx.x >= 64 && blockIdx.x < 80) ph_prep_cum_bh(p, l, blockIdx.x - 64, lds); }
    else for (int bh = blockIdx.x; bh < 16; bh += gridDim.x) ph_prep_cum_bh(p, l, bh, lds);
}


__device__ void fa_phase_all(const Params& p, int l, LDSP unsigned char* L, unsigned char* lds, int qslot, int n_conv  ) {
    unsigned* ctl = (unsigned*)(p.ws + WS_CTL);
    LDSP unsigned* misc = (LDSP unsigned*)(L + AL_MISC);
    bool prep_ok = false;
    for (;;) {
        __syncthreads();
        if (threadIdx.x == 0) misc[0] = atomicAdd(&ctl[qslot], 1u);
        __syncthreads();
        const unsigned qi0 = misc[0];
        if (qi0 >= 1104u + (unsigned)n_conv) break;
        if (qi0 >= 1104u) {
            const int it = ((int)qi0 - 1104) * 8 + (TID() >> 6);
            if (it < CV_ITEMS) convert_item(p, l + 1, it, (LDSF float*)lds + (TID() >> 6) * (64 * 65), TID() & 63);
            continue;
        }
        if (qi0 < 80u) {
            if (qi0 < 64u) prep_cmp_task(p, l, (int)qi0, L); else ph_prep_cum_bh(p, l, (int)qi0 - 64, lds);
            asm volatile("s_waitcnt vmcnt(0)" ::: "memory");
            __syncthreads();
            if (threadIdx.x == 0) { __threadfence(); atomicAdd(&ctl[4 + qslot], 1u); }
            continue;
        }
        const unsigned qi = qi0 - 80u;
        int r, typ, sub;
        if (qi < 768u) { r = 15 - (int)(qi / 48u); const int j = (int)(qi % 48u); typ = j >> 4; typ = (typ == 0) ? 0 : (typ == 1 ? 2 : 3); sub = j & 15; }
        else { const int v = (int)qi - 768; r = 15 - (v >> 4); typ = 1; sub = v & 15; }
        if ((typ == 2 || typ == 3) && !prep_ok) {
            if (threadIdx.x == 0) { while (__hip_atomic_load(&ctl[4 + qslot], __ATOMIC_RELAXED, __HIP_MEMORY_SCOPE_AGENT) < 80u) __builtin_amdgcn_s_sleep(8); __threadfence(); }
            asm volatile("s_waitcnt vmcnt(0)" ::: "memory");
            __syncthreads();
            prep_ok = true;
        }
        if (typ == 0) fa_diff_unit(p, l, sub >> 2, sub & 3, r, L);
        else if (typ == 1) fa_stick_unit(p, l, sub >> 2, sub & 3, r, L);
        else if (typ == 2) fa_fox_unit(p, l, sub >> 2, sub & 3, r, L);
        else fa_nsa_unit(p, l, sub >> 2, 4 * r + (sub & 3), L);
    }
}

#define XB_TMO      128
#define XB_XCNT(j)  (256  + 64 * (j))
#define XB_XSUB(j)  (1280 + 64 * (j))
#define XB_XGEN(j)  (2304 + 64 * (j))
#define XB_TOP      3328
#define XB_TOPGEN   3392
#define XCD_BAR_WORDS 3456
#define XB_SPIN_CAP (1u << 18)

__device__ __forceinline__ unsigned xb_ld(unsigned* p)              { return __hip_atomic_load(p, __ATOMIC_RELAXED, __HIP_MEMORY_SCOPE_AGENT); }
__device__ __forceinline__ unsigned xb_add(unsigned* p, unsigned v) { return __hip_atomic_fetch_add(p, v, __ATOMIC_RELAXED, __HIP_MEMORY_SCOPE_AGENT); }
__device__ __forceinline__ unsigned xb_xcc_id() { return (unsigned)__builtin_amdgcn_s_getreg((3 << 11) | 20) & 0xFu; }
#define XB_SPIN(cond, bar) do { unsigned _sp = 0; while (cond) { __builtin_amdgcn_s_sleep(1); \
    if ((++_sp & 255u) == 0u) { if (xb_ld(&(bar)[XB_TMO])) break; if (_sp > XB_SPIN_CAP) { atomicAdd(&(bar)[XB_TMO], 1u); break; } } } } while (0)

struct XcdBarrier {
    unsigned* bar; unsigned x;
    volatile LDSF unsigned* st;
};

__device__ __forceinline__ XcdBarrier xcd_barrier_post(unsigned* bar, volatile LDSF unsigned* st) {
    XcdBarrier b; b.bar = bar; b.x = xb_xcc_id(); b.st = st;
    if (threadIdx.x == 0) (void)xb_add(&bar[XB_XCNT(b.x)], 1u);
    return b;
}
__device__ __forceinline__ void xcd_barrier_complete(unsigned* bar, unsigned x, unsigned& nloc, unsigned& nx) {
    const unsigned G = gridDim.x * gridDim.y * gridDim.z;
    unsigned sum, cnt, mine, sp = 0u;
    for (;;) {
        sum = 0u; cnt = 0u; mine = 0u;
#pragma unroll
        for (unsigned j = 0; j < 16; ++j) { const unsigned c = xb_ld(&bar[XB_XCNT(j)]); sum += c; cnt += (c > 0u) ? 1u : 0u; mine = (j == x) ? c : mine; }
        if (sum == G) break;
        __builtin_amdgcn_s_sleep(1);
        if ((++sp & 255u) == 0u) { if (xb_ld(&bar[XB_TMO])) break; if (sp > XB_SPIN_CAP) { atomicAdd(&bar[XB_TMO], 1u); break; } }
    }
    nloc = mine > 0u ? mine : 1u; nx = cnt > 0u ? cnt : 1u;
}

__device__ __forceinline__ void xcd_barrier(const XcdBarrier& b) {
    asm volatile("s_waitcnt vmcnt(0)" ::: "memory");
    __syncthreads();
    if (threadIdx.x == 0) {
        unsigned* bar = b.bar;
        __builtin_amdgcn_s_waitcnt(0);
        unsigned nloc = b.st[0], nx = b.st[1];
        if (nloc == 0u) { xcd_barrier_complete(bar, b.x, nloc, nx); b.st[0] = nloc; b.st[1] = nx; }
        const unsigned old = xb_add(&bar[XB_XSUB(b.x)], 1u);
        const unsigned gen = old / nloc;
        if (old + 1u == (gen + 1u) * nloc) {
            __builtin_amdgcn_fence(__ATOMIC_RELEASE, "agent");
            asm volatile("s_waitcnt vmcnt(0)" ::: "memory");
            const unsigned og = xb_add(&bar[XB_TOP], 1u);
            const unsigned tg = og / nx;
            if (og + 1u == (tg + 1u) * nx) xb_add(&bar[XB_TOPGEN], 1u);
            else XB_SPIN(xb_ld(&bar[XB_TOPGEN]) == tg, bar);
            __builtin_amdgcn_fence(__ATOMIC_ACQUIRE, "agent");
            xb_add(&bar[XB_XGEN(b.x)], 1u);
            asm volatile("s_waitcnt vmcnt(0)" ::: "memory");
        } else {
            XB_SPIN(xb_ld(&bar[XB_XGEN(b.x)]) == gen, bar);
            __builtin_amdgcn_fence(__ATOMIC_ACQUIRE, "agent");
            asm volatile("s_waitcnt vmcnt(0)" ::: "memory");
        }
    }
    __syncthreads();
}

namespace cg = cooperative_groups;
constexpr int LDS_BYTES = 131072 + 8192 + 4096 + 1024;
#define LAS3 __attribute__((address_space(3)))
#ifndef PROBE
#define PROBE 0
#endif
__global__ void __launch_bounds__(NTHR, 2) mega(Params p) {
    extern __shared__ __attribute__((aligned(16))) unsigned char lds[];
    cg::grid_group grid = cg::this_grid();
#if PROBE
    unsigned long long tacc = 0, tph = 0, t0_;
#define GSYNC() do { t0_ = __builtin_amdgcn_s_memrealtime(); xcd_barrier(xbar); tacc += __builtin_amdgcn_s_memrealtime() - t0_; } while (0)
#define TPK(k, ...) do { if (PROBE == (k)) { t0_ = __builtin_amdgcn_s_memrealtime(); __VA_ARGS__; tph += __builtin_amdgcn_s_memrealtime() - t0_; } else { __VA_ARGS__; } } while (0)
#else
#define GSYNC() xcd_barrier(xbar)
#define TPK(k, ...) do { __VA_ARGS__; } while (0)
#endif
    LAS3 unsigned char* lds3 = (LAS3 unsigned char*)lds;
    volatile LDSF unsigned* bst = (volatile LDSF unsigned*)(lds3 + 131072 + 2048);
    if (threadIdx.x < 2) bst[threadIdx.x] = 0u;
    __syncthreads();
    XcdBarrier xbar = xcd_barrier_post((unsigned*)(p.ws + WS_CTL) + 16384, bst);
    TPK(2, ph_mod(p, lds); ph_reset_queues(p); ph_weights(p, 0, lds));
    grid.sync();
    for (int l = 0; l < DEPTH; ++l) {
        const float* mod = (const float*)(p.ws + WS_MOD) + (size_t)l * 4 * 6144;
        TPK(2, if (l == 0) ph_xa_from(p, p.x, 0, 0, (bf16_t*)(p.ws + WS_XA), (float*)(p.ws + WS_RSA), true); ph_cbias(p, l, 1));
        GSYNC();
        {   pg8::Gemm g{(const bf16_t*)(p.ws + WS_XA), (const bf16_t*)(p.ws + WS_WIN + l * WS_W1OFF), MTOK, PINP, DM}; pg8::StaticOrder S; S.init(MTOK, PINP, (int)gridDim.x, (int)blockIdx.x);
            EpiProjF E{(const float*)(p.ws + WS_RSA), (const float*)(p.ws + WS_CBIN) + (size_t)l * 4 * PINP, (bf16_t*)(p.ws + WS_PROJ), (float*)(p.ws + WS_SIDE),
                       p.diff_kn + l * 32, p.fox_kn + l * 64, p.nsa_kn + (l * 3 + 1) * 64, p.nsa_kn + (l * 3 + 2) * 64, (LDSF float*)(lds3 + 131072 + 4096), (LDSF float*)(lds3 + 131072 + 12288)};
            TPK(6, pg8::gemm_phase<EpiProjF, pg8::StaticOrder, true, PG8_SP2>(lds3, g, S, E)); }
        GSYNC();
        TPK(7, fa_phase_all(p, l, lds3, lds, l, (l + 1 < DEPTH) ? CV_ITEMS / 8 : 0));
        GSYNC();
        {   pg8::Gemm g{(const bf16_t*)(p.ws + WS_MIX), (const bf16_t*)(p.ws + WS_WOUT + l * WS_W1OFF), MTOK, DM, DM}; pg8::StaticOrder S; S.init(MTOK, DM, (int)gridDim.x, (int)blockIdx.x);
            EpiResF E{l == 0 ? p.x : p.out, p.out, mod + 2048, p.norm_ffn_g + l * DM, mod + 4096, (bf16_t*)(p.ws + WS_XA), (float*)(p.ws + WS_RSB)};
            TPK(6, pg8::gemm_phase<EpiResF, pg8::StaticOrder, PG8_ALIGN, PG8_SP2>(lds3, g, S, E)); }
        GSYNC();
        {   pg8::Gemm g{(const bf16_t*)(p.ws + WS_XA), (const bf16_t*)(p.ws + WS_WUP + l * WS_W1OFF), MTOK, NUP, DM}; pg8::StaticOrder S; S.init(MTOK, NUP, (int)gridDim.x, (int)blockIdx.x);
            EpiUpAct E{(const float*)(p.ws + WS_RSB), (const float*)(p.ws + WS_CBUP) + (size_t)l * 4 * NUP, (bf16_t*)(p.ws + WS_ACT), (float*)(p.ws + WS_EG), (float*)(p.ws + WS_EV),
                       p.conv_w + (size_t)l * 3 * DFF, p.conv_b + (size_t)l * DFF, (LDSF float*)(lds3 + 131072 + 4096), (LDSF float*)(lds3 + 131072 + 8192)};
            TPK(6, pg8::gemm_phase<EpiUpAct, pg8::StaticOrder, true, PG8_SP2>(lds3, g, S, E)); }
        GSYNC();
        {   const float* modn = (const float*)(p.ws + WS_MOD) + (size_t)(l + 1) * 4 * 6144; const bool more = (l + 1 < DEPTH);
            pg8::Gemm g{(const bf16_t*)(p.ws + WS_ACT), (const bf16_t*)(p.ws + WS_WDN + l * WS_W1OFF), MTOK, DM, DFF}; pg8::StaticOrder S; S.init(MTOK, DM, (int)gridDim.x, (int)blockIdx.x);
            { pg8::Unit fu; for (int i = 0; S.next(i, fu); ++i) act_fixup(p, l, fu.pm); }
            __builtin_amdgcn_fence(__ATOMIC_RELEASE, "agent"); __builtin_amdgcn_fence(__ATOMIC_ACQUIRE, "agent"); __syncthreads();
            EpiResF E{p.out, p.out, mod + 5120, p.norm_mix_g + (more ? l + 1 : l) * DM, more ? modn + 1024 : mod + 1024, more ? (bf16_t*)(p.ws + WS_XA) : nullptr, more ? (float*)(p.ws + WS_RSA) : nullptr};
            TPK(6, pg8::gemm_phase<EpiResF, pg8::StaticOrder, PG8_ALIGN, PG8_SP2>(lds3, g, S, E)); }
    }
#if PROBE == 1
    if (blockIdx.x == 0 && threadIdx.x == 0) p.out[0] += 0.05f + (float)tacc * 0.01f * 5e-4f;
#elif PROBE >= 2
    if (blockIdx.x == 0 && threadIdx.x == 0) p.out[0] += 0.05f + (float)tph * 0.01f * 1e-4f;
#endif
}

extern "C" void kernel_launch(void* const* d_in, const int* in_sizes, int in, void* d_out, int out_size, void* d_ws, size_t ws_size, hipStream_t stream) {
    if (in != 24 || ws_size < WS_END || out_size != MTOK * DM) { fprintf(stderr, "kernel_launch: unexpected sizes (in %d, ws %zu, out %d)\n", in, ws_size, out_size); return; }
    static int grid_blocks = 0;
    if (!grid_blocks) {
        int dev = 0, cus = 0, per_cu = 0;
        hipGetDevice(&dev);
        hipDeviceGetAttribute(&cus, hipDeviceAttributeMultiprocessorCount, dev);
        hipFuncSetAttribute((const void*)mega, hipFuncAttributeMaxDynamicSharedMemorySize, LDS_BYTES);
        hipOccupancyMaxActiveBlocksPerMultiprocessor(&per_cu, (const void*)mega, NTHR, LDS_BYTES);
        if (per_cu < 1) { fprintf(stderr, "kernel_launch: occupancy query returned %d\n", per_cu); per_cu = 1; }
        if (per_cu > 1) per_cu = 1;
        grid_blocks = cus * per_cu;
        fprintf(stderr, "kernel_launch: cus %d per_cu %d grid %d\n", cus, per_cu, grid_blocks);
    }
    if (hipMemsetAsync((char*)d_ws + WS_CTL + 65536, 0, XCD_BAR_WORDS * 4, stream) != hipSuccess) { fprintf(stderr, "kernel_launch: memset failed\n"); return; }
    Params p{};
    const float** f = (const float**)&p;
    for (int i = 0; i < 24; ++i) f[i] = (const float*)d_in[i];
    p.out = (float*)d_out; p.ws = (unsigned char*)d_ws;
    void* args[] = {&p};
    hipError_t e = hipLaunchCooperativeKernel((const void*)mega, dim3(grid_blocks), dim3(NTHR), args, LDS_BYTES, stream);
    if (e != hipSuccess) fprintf(stderr, "cooperative launch failed: %s (grid %d)\n", hipGetErrorString(e), grid_blocks);
}
```

```cpp
#include <hip/hip_runtime.h>
#include <hip/hip_cooperative_groups.h>
#include <cstdint>
#include <cstdio>

typedef unsigned short bf16_t;
typedef short bf16x8 __attribute__((ext_vector_type(8)));
typedef float f32x4 __attribute__((ext_vector_type(4)));
typedef unsigned u32x4 __attribute__((ext_vector_type(4)));

constexpr int NB = 4, SEQ = 4096, DM = 1024, MTOK = NB * SEQ, DEPTH = 2;
constexpr int HD = 64, HPM = 4, DFF = 2816, PIN = 2960, PINP = 3072, NUP = 2 * DFF;
constexpr float EPS = 1e-6f;
constexpr float LOG2E = 1.4426950408889634f;
constexpr int NTHR = 512;

constexpr int CA_Q = 0, CA_K = 256, CA_V = 512, CB_Q = 768, CB_K = 1024, CB_V = 1280, CC_Q = 1536, CC_K = 1792, CC_V = 2048;
constexpr int CD_Q = 2304, CD_KC = 2560, CD_VC = 2624, CD_KS = 2688, CD_VS = 2752, CD_KW = 2816, CD_VW = 2880, C_BF = 2944, C_DG = 2948;

constexpr size_t MiB = 1u << 20;
constexpr size_t WS_CTL = 0;
constexpr size_t WS_MOD = 1 * MiB;
constexpr size_t WS_CBIN = WS_MOD + 2 * 4 * 6144 * 4;
constexpr size_t WS_CBUP = WS_CBIN + 2 * 4 * 3072 * 4;
constexpr size_t WS_TB = WS_CBUP + 2 * 4 * 5632 * 4;
constexpr size_t WS_LAM = WS_TB + 2 * 4 * 128 * 4;
constexpr size_t WS_BND = WS_LAM + 64;
constexpr size_t WS_CUM = WS_LAM + 512;
constexpr size_t WS_KC = WS_CUM + 16 * 4096 * 4;
constexpr size_t WS_VC = WS_KC + 4 * 256 * 64 * 2;
constexpr size_t WS_SELM = WS_VC + 4 * 256 * 64 * 2;
constexpr size_t WS_SMALL_END = WS_SELM + 16384 * 8;
static_assert(WS_SMALL_END <= 4 * MiB, "small region");
constexpr size_t WS_RSA = 4 * MiB;
constexpr size_t WS_RSB = 5 * MiB;
constexpr size_t WS_SIDE = 6 * MiB;
constexpr size_t WS_IMP = 7 * MiB;
constexpr size_t WS_ML = 11 * MiB;
constexpr size_t WS_PHIT = 7 * MiB;
constexpr size_t WS_W = 12 * MiB;
constexpr size_t WS_WIN = WS_W;
constexpr size_t WS_WOUT = WS_WIN + (size_t)PINP * DM * 2;
constexpr size_t WS_WUP = WS_WOUT + (size_t)DM * DM * 2;
constexpr size_t WS_WDN = WS_WUP + (size_t)NUP * DM * 2;
constexpr size_t WS_W_END = WS_WDN + (size_t)DM * DFF * 2;
static_assert(WS_W_END <= 38 * MiB, "weights region");
constexpr size_t WS_XA = 38 * MiB;
constexpr size_t WS_BIG = 70 * MiB;
constexpr size_t WS_PROJ = WS_BIG;
constexpr size_t WS_XR = WS_BIG + 96 * MiB;
constexpr size_t WS_ACT = WS_BIG;
constexpr size_t WS_W1OFF = 188 * MiB;
constexpr size_t WS_EG = 228 * MiB;
constexpr size_t WS_EV = 232 * MiB;
constexpr size_t WS_END = 236 * MiB;
static_assert(WS_W_END + WS_W1OFF <= WS_EG && WS_XR + 32 * MiB <= WS_W + WS_W1OFF, "layer-1 weights");
static_assert(WS_END <= 256 * MiB, "workspace");

struct Params {
    const float *x, *c, *rel_bias, *ada_w, *ada_b, *norm_mix_g, *norm_ffn_g, *w_in, *w_out;
    const float *diff_qn, *diff_kn, *diff_lam, *diff_sub, *fox_qn, *fox_kn, *fox_bf;
    const float *nsa_qn, *nsa_kn, *nsa_pe, *nsa_phi, *w_up, *conv_w, *conv_b, *w_down;
    float* out;
    unsigned char* ws;
};

__device__ __forceinline__ float bf2f(bf16_t v) { return __uint_as_float(((unsigned)v) << 16); }
__device__ __forceinline__ bf16_t f2bf(float f) { unsigned u = __float_as_uint(f); return (bf16_t)((u + 0x7fffu + ((u >> 16) & 1u)) >> 16); }
__device__ __forceinline__ unsigned pk2(float lo, float hi) { return (unsigned)f2bf(lo) | ((unsigned)f2bf(hi) << 16); }
__device__ __forceinline__ float siluf(float v) { return v / (1.f + __expf(-v)); }
__device__ __forceinline__ float logsigf(float v) { return fminf(v, 0.f) - log1pf(__expf(-fabsf(v))); }
__device__ __forceinline__ float wave_sum(float v) {
#pragma unroll
    for (int o = 1; o < 64; o <<= 1) v += __shfl_xor(v, o);
    return v;
}
__device__ __forceinline__ int t5_bucket(int n) {
    if (n < 16) return n < 0 ? 0 : n;
    return 16 + (n >= 19) + (n >= 21) + (n >= 24) + (n >= 27) + (n >= 31) + (n >= 35) + (n >= 40) + (n >= 46) + (n >= 52) + (n >= 59) + (n >= 67) + (n >= 77) + (n >= 87) + (n >= 99) + (n >= 113);
}
__host__ __device__ __forceinline__ int in_col_map(int n) {
    if (n < 1536) return n;
    if (n < 2944) return n + 4;
    if (n < 2948) return 1536 + (n - 2944);
    if (n < 2960) return n;
    return -1;
}
__host__ __device__ __forceinline__ int up_col_map(int n) {
    const int pn = n >> 8, c = n & 255;
    return c < 128 ? (128 * pn + c) : (DFF + 128 * pn + (c - 128));
}

__device__ __forceinline__ int opaque_v(int v) { asm volatile("" : "+v"(v)); return v; }
#define TID() opaque_v((int)threadIdx.x)
#define GTID() ((int)(blockIdx.x * blockDim.x) + TID())
#define GSIZE() ((int)(gridDim.x * blockDim.x))

__device__ __forceinline__ void load8(const bf16_t* p, float* d) {
    const u32x4 r = *(const u32x4*)p;
    d[0] = bf2f(r[0] & 0xffff); d[1] = bf2f(r[0] >> 16); d[2] = bf2f(r[1] & 0xffff); d[3] = bf2f(r[1] >> 16);
    d[4] = bf2f(r[2] & 0xffff); d[5] = bf2f(r[2] >> 16); d[6] = bf2f(r[3] & 0xffff); d[7] = bf2f(r[3] >> 16);
}
#define LDSF __attribute__((address_space(3)))
__device__ __forceinline__ void gemv4_block(const float* W, int ld, int oc, const LDSF float* vec, LDSF float* red, float* out0, int ostride, int n, float bias, int tid) {
    const int lane = tid & 63, wv = tid >> 6;
    float a0 = 0.f, a1 = 0.f, a2 = 0.f, a3 = 0.f;
    if (oc >= 0) {
        const float* w = W + (size_t)(wv * 128) * ld + oc;
#pragma unroll 32
        for (int k = 0; k < 128; ++k) { const float wk = w[(size_t)k * ld]; const f32x4 v = *(const LDSF f32x4*)(vec + (wv * 128 + k) * 4); a0 += v[0] * wk; a1 += v[1] * wk; a2 += v[2] * wk; a3 += v[3] * wk; }
    }
    red[(wv * 4 + 0) * 64 + lane] = a0; red[(wv * 4 + 1) * 64 + lane] = a1; red[(wv * 4 + 2) * 64 + lane] = a2; red[(wv * 4 + 3) * 64 + lane] = a3;
    __syncthreads();
    if (tid < 256) { const int bt = tid >> 6; float sacc = 0.f;
#pragma unroll
        for (int w8 = 0; w8 < 8; ++w8) sacc += red[(w8 * 4 + bt) * 64 + lane];
        out0[(size_t)bt * ostride + n] = sacc + bias; }
    __syncthreads();
}
__device__ void ph_mod(const Params& p, unsigned char* lds) {
    float* mod = (float*)(p.ws + WS_MOD);
    float* tb = (float*)(p.ws + WS_TB);
    float* lamv = (float*)(p.ws + WS_LAM);
    LDSF float* vec = (LDSF float*)lds; LDSF float* red = (LDSF float*)(lds + 16384);
    const int tid = TID();
    bool loaded = false;
    for (int item = blockIdx.x; item < DEPTH * 96; item += gridDim.x) {
        if (!loaded) { for (int i = tid; i < 4096; i += NTHR) { const int bt = i >> 10, k = i & 1023; vec[k * 4 + bt] = siluf(p.c[bt * DM + k]); } __syncthreads(); loaded = true; }
        const int l = item / 96, n = (item % 96) * 64 + (tid & 63);
        gemv4_block(p.ada_w + (size_t)l * DM * 6144, 6144, n, vec, red, mod + (size_t)l * 4 * 6144, 6144, n, p.ada_b[l * 6144 + n], tid);
    }
    const int gt = GTID(), gs = GSIZE();
    for (int idx = gt; idx < 2 * 4 * 128; idx += gs) {
        const int type = idx / 512, h = (idx / 128) & 3, d = idx & 127;
        tb[idx] = p.rel_bias[t5_bucket(d) * 8 + type * 4 + h];
    }
    for (int idx = gt; idx < DEPTH * 32; idx += gs) {
        const int l = idx >> 5, e = idx & 31; float v = 0.f;
        if (e < 17) {
            const int type = (e < 5) ? 0 : 1, h = (e < 4) ? e : ((e == 4) ? 0 : ((e - 5) & 3));
            const int ng = (e < 4) ? 32 : 64;
            const float* gq = (e < 4) ? p.diff_qn + l * 32 : ((e == 4) ? p.fox_qn + l * 64 : p.nsa_qn + l * 64);
            const float* gk = (e < 4) ? p.diff_kn + l * 32 : ((e == 4) ? p.fox_kn + l * 64 : p.nsa_kn + (l * 3 + (e - 5) / 4) * 64);
            float mq = 0.f, mk = 0.f; for (int i = 0; i < ng; ++i) { mq = fmaxf(mq, fabsf(gq[i])); mk = fmaxf(mk, fabsf(gk[i])); }
            float tm = 0.f; if (e != 4) { tm = -INFINITY; for (int bk2 = 0; bk2 < 32; ++bk2) tm = fmaxf(tm, p.rel_bias[bk2 * 8 + type * 4 + h]); }
            v = sqrtf((float)ng) * mq * mk * 1.02f * LOG2E + tm * LOG2E;
        }
        ((float*)(p.ws + WS_BND))[idx] = v;
    }
    for (int idx = gt; idx < DEPTH; idx += gs) {
        const float* lv = p.diff_lam + idx * 4 * 32;
        float s1 = 0.f, s2 = 0.f;
        for (int i = 0; i < 32; ++i) { s1 += lv[i] * lv[32 + i]; s2 += lv[64 + i] * lv[96 + i]; }
        const float lam_init = 0.8f - 0.6f * expf(-0.3f * (float)idx);
        lamv[idx] = expf(s1) - expf(s2) + lam_init;
    }
}
__device__ void ph_cbias(const Params& p, int lfirst, int lcount) {
    const float* mod = (const float*)(p.ws + WS_MOD);
    const int tid_ = TID(); const int lane = tid_ & 63, wv = tid_ >> 6;
    const int gw = blockIdx.x * (NTHR >> 6) + wv, ngw = gridDim.x * (NTHR >> 6);
    constexpr int NCOL = PINP + NUP;
    const int per = (lcount * NCOL + ngw - 1) / ngw; const int c0 = gw * per, c1 = min(lcount * NCOL, c0 + per);
    int cur_key = -1; float sh[4][16];
    for (int c = c0; c < c1; ++c) {
        const int l = lfirst + c / NCOL, r = c % NCOL; const bool isin = r < PINP; const int n = isin ? r : r - PINP; const int key = l * 2 + (isin ? 0 : 1);
        if (key != cur_key) { cur_key = key; const int shoff = isin ? 0 : 3072;
#pragma unroll
            for (int bt = 0; bt < 4; ++bt)
#pragma unroll
                for (int q4 = 0; q4 < 4; ++q4) { const f32x4 v = *(const f32x4*)(mod + (size_t)(l * 4 + bt) * 6144 + shoff + 16 * lane + 4 * q4); sh[bt][4 * q4] = v[0]; sh[bt][4 * q4 + 1] = v[1]; sh[bt][4 * q4 + 2] = v[2]; sh[bt][4 * q4 + 3] = v[3]; } }
        const bf16_t* wrow = (const bf16_t*)(p.ws + (isin ? WS_WIN : WS_WUP) + l * WS_W1OFF) + (size_t)n * DM + 16 * lane;
        float w[16]; load8(wrow, w); load8(wrow + 8, w + 8);
        float a0 = 0.f, a1 = 0.f, a2 = 0.f, a3 = 0.f;
#pragma unroll
        for (int j = 0; j < 16; ++j) { a0 += sh[0][j] * w[j]; a1 += sh[1][j] * w[j]; a2 += sh[2][j] * w[j]; a3 += sh[3][j] * w[j]; }
        a0 = wave_sum(a0); a1 = wave_sum(a1); a2 = wave_sum(a2); a3 = wave_sum(a3);
        if (lane == 0) { float* o = isin ? (float*)(p.ws + WS_CBIN) + (size_t)l * 4 * PINP : (float*)(p.ws + WS_CBUP) + (size_t)l * 4 * NUP; const int ld = isin ? PINP : NUP;
            o[n] = a0; o[ld + n] = a1; o[2 * ld + n] = a2; o[3 * ld + n] = a3; }
    }
}
template <int MAPK>
__device__ __forceinline__ void convert_one(const float* W, int K, int Nsrc, int Npad, bf16_t* Wt, LDSF float* scr, int it, int lane) {
    const int nnb = Npad / 64;
    const int kb = it / nnb, nb = it % nnb, k0 = kb * 64, n0 = nb * 64;
    {
        const int n = n0 + lane;
        const int oc = MAPK == 0 ? n : (MAPK == 1 ? in_col_map(n) : up_col_map(n));
        const float* wp = W + (size_t)k0 * Nsrc + (oc >= 0 ? oc : 0);
#pragma unroll 1
        for (int hh = 0; hh < 2; ++hh) {
            float tv[32];
#pragma unroll
            for (int i = 0; i < 32; ++i) tv[i] = wp[(size_t)(32 * hh + i) * Nsrc];
#pragma unroll
            for (int i = 0; i < 32; ++i) scr[(32 * hh + i) * 65 + lane] = (oc >= 0) ? tv[i] : 0.f;
        }
    }
    __builtin_amdgcn_s_waitcnt(0xc07f); __builtin_amdgcn_wave_barrier();
    {
        const int c = lane & 7;
#pragma unroll
        for (int j = 0; j < 8; ++j) { const int nn = 8 * j + (lane >> 3); const LDSF float* sp = scr + (8 * c) * 65 + nn;
            u32x4 o; o[0] = pk2(sp[0], sp[65]); o[1] = pk2(sp[130], sp[195]); o[2] = pk2(sp[260], sp[325]); o[3] = pk2(sp[390], sp[455]);
            *(u32x4*)(Wt + (size_t)(n0 + nn) * K + k0 + 8 * c) = o; }
    }
    __builtin_amdgcn_s_waitcnt(0xc07f); __builtin_amdgcn_wave_barrier();
}
constexpr int CV_IN = 16 * (PINP / 64), CV_OUT = 16 * (DM / 64), CV_UP = 16 * (NUP / 64), CV_DN = (DFF / 64) * (DM / 64), CV_PHI = 32, CV_ITEMS = CV_IN + CV_OUT + CV_UP + CV_DN + 2 * CV_PHI;
static_assert(CV_ITEMS == 3200, "conversion item count");
__device__ void convert_item(const Params& p, int l, int idx, LDSF float* scr, int lane) {
    if (idx < CV_IN) { convert_one<1>(p.w_in + (size_t)l * DM * PIN, DM, PIN, PINP, (bf16_t*)(p.ws + WS_WIN + l * WS_W1OFF), scr, idx, lane); return; } idx -= CV_IN;
    if (idx < CV_OUT) { convert_one<0>(p.w_out + (size_t)l * DM * DM, DM, DM, DM, (bf16_t*)(p.ws + WS_WOUT + l * WS_W1OFF), scr, idx, lane); return; } idx -= CV_OUT;
    if (idx < CV_UP) { convert_one<2>(p.w_up + (size_t)l * DM * NUP, DM, NUP, NUP, (bf16_t*)(p.ws + WS_WUP + l * WS_W1OFF), scr, idx, lane); return; } idx -= CV_UP;
    if (idx < CV_DN) { convert_one<0>(p.w_down + (size_t)l * DFF * DM, DFF, DM, DM, (bf16_t*)(p.ws + WS_WDN + l * WS_W1OFF), scr, idx, lane); return; } idx -= CV_DN;
    const int w2 = idx / CV_PHI; idx -= w2 * CV_PHI;
    convert_one<0>(p.nsa_phi + (size_t)(l * 2 + w2) * 2048 * 64, 2048, 64, 64, (bf16_t*)(p.ws + WS_PHIT) + (size_t)(l * 2 + w2) * 64 * 2048, scr, idx, lane);
}
__device__ void ph_weights(const Params& p, int l, unsigned char* lds) {
    const int tid_ = TID(); const int lane = tid_ & 63, wv = tid_ >> 6;
    const int ngw = gridDim.x * (NTHR >> 6), gw = ngw - 1 - (blockIdx.x * (NTHR >> 6) + wv);
    LDSF float* scr = (LDSF float*)lds + wv * (64 * 65);
    for (int it = gw; it < CV_ITEMS; it += ngw) convert_item(p, l, it, scr, lane);
}
__device__ void ph_xa_from(const Params& p, const float* src, int l, int which  , bf16_t* XA, float* rowss, bool write_xa) {
    const float* mod = (const float*)(p.ws + WS_MOD);
    const float* g = (which == 0 ? p.norm_mix_g : p.norm_ffn_g) + l * DM;
    const int tid_ = TID(); const int lane = tid_ & 63, wv = tid_ >> 6;
    const int gw = blockIdx.x * (blockDim.x >> 6) + wv, ngw = gridDim.x * (blockDim.x >> 6);
    for (int row0 = gw; row0 < MTOK; row0 += 2 * ngw) {
        f32x4 v[2][4];
#pragma unroll
        for (int rr = 0; rr < 2; ++rr) { const int row = min(row0 + rr * ngw, MTOK - 1);
#pragma unroll
            for (int j = 0; j < 4; ++j) v[rr][j] = *(const f32x4*)(src + (size_t)row * DM + j * 256 + lane * 4); }
#pragma unroll
        for (int rr = 0; rr < 2; ++rr) {
            const int row = row0 + rr * ngw;
            if (row < MTOK) {
                const int b = row / SEQ; const float* sc = mod + (size_t)(l * 4 + b) * 6144 + (which == 0 ? 1024 : 4096);
                float ss = 0.f;
#pragma unroll
                for (int j = 0; j < 4; ++j) {
                    const int k = j * 256 + lane * 4; const f32x4 x = v[rr][j];
                    ss += x[0] * x[0] + x[1] * x[1] + x[2] * x[2] + x[3] * x[3];
                    if (write_xa) {
                        const f32x4 gv = *(const f32x4*)(g + k); const f32x4 sv = *(const f32x4*)(sc + k);
                        uint2 o; o.x = pk2(x[0] * gv[0] * (1.f + sv[0]), x[1] * gv[1] * (1.f + sv[1])); o.y = pk2(x[2] * gv[2] * (1.f + sv[2]), x[3] * gv[3] * (1.f + sv[3]));
                        *(uint2*)(XA + (size_t)row * DM + k) = o;
                        uint2 xo; xo.x = pk2(x[0], x[1]); xo.y = pk2(x[2], x[3]); *(uint2*)((bf16_t*)(p.ws + WS_XR) + (size_t)row * DM + k) = xo;
                    }
                }
                ss = wave_sum(ss);
                if (lane < 16) rowss[(size_t)row * 16 + lane] = (lane == 0) ? ss : 0.f;
            }
        }
    }
}

namespace pg8 {
#define PG8_LAS __attribute__((address_space(3)))
typedef unsigned short bf16_t;
typedef short bf16x8 __attribute__((ext_vector_type(8)));
typedef float f32x4 __attribute__((ext_vector_type(4)));
typedef unsigned u32x4 __attribute__((ext_vector_type(4)));
constexpr int BM = 256, BK = 64, HALF = 128, HTB = HALF * BK * 2  , STAGE_BYTES = 8 * HTB, NXCD = 8, WGM = 8;

__host__ __device__ __forceinline__ int lds_byte(int r, int c) { const int st = (r >> 4) * 2 + (c >> 5), rr = r & 15, cc = c & 31, ob = rr * 64 + cc * 2; return st * 1024 + (ob ^ (((ob >> 9) & 1) << 5)); }
__host__ __device__ __forceinline__ void stage_rc(int b, int& R, int& C) { const int st = b / 1024, sb = b % 1024, swz = sb ^ (((sb >> 9) & 1) << 5); R = (st >> 1) * 16 + swz / 64; C = (st & 1) * 32 + (swz % 64) / 2; }
__host__ __device__ __forceinline__ int perm32(int rho) { const int n = rho >> 4, i = rho & 15; return 8 * (i >> 2) + 4 * n + (i & 3); }

struct Unit { int pm, pn; };
struct Gemm { const bf16_t* A; const bf16_t* Bt; int M, N, K; };

struct StaticOrder {
    int nM, nN, nwg, G, c;
    __host__ __device__ void init(int M, int N, int G_, int c_) { nM = M / BM; nN = N / BM; nwg = nM * nN; G = G_; c = c_; }
    __host__ __device__ bool next(int i, Unit& u) const {
        const long L = (long)i * G + c; if (L >= nwg) return false;
        int wgid = (int)L; { const int q = nwg / NXCD, r = nwg % NXCD, xcd = wgid % NXCD, off = wgid / NXCD; wgid = (xcd < r ? xcd * (q + 1) : r * (q + 1) + (xcd - r) * q) + off; }
        const int nig = WGM * nN, gid = wgid / nig, fm = gid * WGM, gsz = (nM - fm) < WGM ? (nM - fm) : WGM;
        u.pm = fm + ((wgid % nig) % gsz); u.pn = (wgid % nig) / gsz; return true;
    }
    __device__ __forceinline__ void a_ready(const Unit&) const {}
    __device__ __forceinline__ void done(const Unit&) const {}
};


__device__ __forceinline__ unsigned cvt_pk_bf16(float lo, float hi) { unsigned r; asm volatile("v_cvt_pk_bf16_f32 %0, %1, %2" : "=v"(r) : "v"(lo), "v"(hi)); return r; }
template <class Epi, class Sched, bool ALIGN_EPI = false, bool SP2 = false>
__device__ __forceinline__ void gemm_phase(PG8_LAS unsigned char* lds, const Gemm g, const Sched& S, const Epi& E) {
    const int tid = TID(), wid = __builtin_amdgcn_readfirstlane(tid >> 6), lane = tid & 63, wr = wid >> 2, wc = wid & 3, fr = lane & 15, fq = lane >> 4;
    const int K = g.K, nt = K / BK;
    unsigned voffA[2], voffB[2];
#pragma unroll
    for (int i = 0; i < 2; ++i) { int R, C; stage_rc(tid * 16 + i * 8192, R, C); const int Rb = Epi::PERM ? ((R & ~31) + perm32(R & 31)) : R;
        voffA[i] = (unsigned)(R * K + C) * 2u; voffB[i] = (unsigned)(Rb * K + C) * 2u; }
    const size_t kstep = (size_t)(BK * 2);
    const size_t hstep = (size_t)HALF * K * 2;
    const size_t tstep = 2 * hstep;
    const unsigned ldsw = (unsigned)wid * 1024u;
    const int aoff = lds_byte(wr * 64 + fr, fq * 8), boff = lds_byte(wc * 32 + fr, fq * 8);
#define PG8_SA(b, h) (((b) * 2 + (h)) * HTB)
#define PG8_SB(b, h) ((4 + (b) * 2 + (h)) * HTB)
#define PG8_STAGE(bufoff, gbase, voff) do { _Pragma("unroll") for (int _i = 0; _i < 2; ++_i) \
        __builtin_amdgcn_global_load_lds((const unsigned*)((const char*)(gbase) + (voff)[_i]), (PG8_LAS unsigned*)(lds + (bufoff) + ldsw + _i * 8192), 16, 0, 0); } while (0)
#define PG8_LDA(dst, b, h) do { _Pragma("unroll") for (int m = 0; m < 4; ++m) _Pragma("unroll") for (int k = 0; k < 2; ++k) dst[m][k] = *(const PG8_LAS bf16x8*)(lds + PG8_SA(b, h) + aoff + m * 2048 + k * 1024); } while (0)
#define PG8_LDB(dst, b, h) do { _Pragma("unroll") for (int n = 0; n < 2; ++n) _Pragma("unroll") for (int k = 0; k < 2; ++k) dst[n][k] = *(const PG8_LAS bf16x8*)(lds + PG8_SB(b, h) + boff + n * 2048 + k * 1024); } while (0)
#define PG8_MMA(ai, bj, At, Bt) do { __builtin_amdgcn_s_setprio(1); _Pragma("unroll") for (int m = 0; m < 4; ++m) _Pragma("unroll") for (int n = 0; n < 2; ++n) _Pragma("unroll") for (int k = 0; k < 2; ++k) \
        acc[ai][bj][m][n] = __builtin_amdgcn_mfma_f32_16x16x32_bf16(Bt[n][k], At[m][k], acc[ai][bj][m][n], 0, 0, 0); __builtin_amdgcn_s_setprio(0); } while (0)
#define PG8_WAIT_V(n) asm volatile("s_waitcnt vmcnt(" #n ")" ::: "memory")
#define PG8_WAIT_L(n) asm volatile("s_waitcnt lgkmcnt(" #n ")" ::: "memory")
#define PG8_BAR __builtin_amdgcn_s_barrier()
#define PG8_SCHED __builtin_amdgcn_sched_barrier(0)
    Unit cur, nxt; int ui = 0;
    if (!S.next(0, cur)) return;
    f32x4 acc[2][2][4][2];
#pragma unroll
    for (int a = 0; a < 2; ++a)
#pragma unroll
        for (int b = 0; b < 2; ++b)
#pragma unroll
            for (int m = 0; m < 4; ++m)
#pragma unroll
                for (int n = 0; n < 2; ++n) acc[a][b][m][n] = (f32x4){0.f, 0.f, 0.f, 0.f};
    bf16x8 At[4][2], B0[2][2], B1[2][2];
    const char* cA = (const char*)g.A + (size_t)cur.pm * tstep; const char* cB = (const char*)g.Bt + (size_t)cur.pn * tstep;
    S.a_ready(cur);
    if constexpr (SP2) {
        PG8_STAGE(PG8_SB(0, 0), cB, voffB); PG8_STAGE(PG8_SB(0, 1), cB + hstep, voffB); PG8_STAGE(PG8_SA(0, 0), cA, voffA); PG8_STAGE(PG8_SA(0, 1), cA + hstep, voffA);
        if (wr == 1) PG8_BAR;
        PG8_WAIT_V(2); PG8_BAR;
        PG8_STAGE(PG8_SB(1, 0), cB + kstep, voffB); PG8_STAGE(PG8_SA(1, 0), cA + kstep, voffA); PG8_STAGE(PG8_SB(1, 1), cB + hstep + kstep, voffB);
        PG8_WAIT_V(6); PG8_BAR;
    } else {
        PG8_STAGE(PG8_SB(0, 0), cB, voffB); PG8_STAGE(PG8_SA(0, 0), cA, voffA); PG8_STAGE(PG8_SB(0, 1), cB + hstep, voffB); PG8_STAGE(PG8_SA(0, 1), cA + hstep, voffA);
        if (wr == 1) PG8_BAR;
        PG8_WAIT_V(4); PG8_BAR;
        PG8_STAGE(PG8_SB(1, 0), cB + kstep, voffB); PG8_STAGE(PG8_SA(1, 0), cA + kstep, voffA); PG8_STAGE(PG8_SB(1, 1), cB + hstep + kstep, voffB);
        PG8_WAIT_V(6); PG8_BAR;
    }
    for (;;) {
        const bool has_next = S.next(ui + 1, nxt);
        const char* nA = has_next ? (const char*)g.A + (size_t)nxt.pm * tstep : cA; const char* nB = has_next ? (const char*)g.Bt + (size_t)nxt.pn * tstep : cB;
        for (int t = 0; t < nt; t += 2) {
            const bool last = (t == nt - 2);
            const char* a1 = cA + (size_t)(t + 1) * kstep;
            const char* a2 = last ? nA : cA + (size_t)(t + 2) * kstep; const char* b2 = last ? nB : cB + (size_t)(t + 2) * kstep;
            const char* a3 = a2 + kstep; const char* b3 = b2 + kstep;
            if (last && has_next) S.a_ready(nxt);
            if constexpr (SP2) {
            PG8_LDB(B0, 0, 0); PG8_LDB(B1, 0, 1); PG8_SCHED; PG8_LDA(At, 0, 0); PG8_STAGE(PG8_SA(1, 1), a1 + hstep, voffA);
            PG8_WAIT_V(8); PG8_WAIT_L(0); PG8_BAR; PG8_MMA(0, 0, At, B0); PG8_MMA(0, 1, At, B1); PG8_BAR; PG8_SCHED;
            PG8_LDA(At, 0, 1); PG8_STAGE(PG8_SB(0, 0), b2, voffB); PG8_STAGE(PG8_SB(0, 1), b2 + hstep, voffB); PG8_STAGE(PG8_SA(0, 0), a2, voffA);
            PG8_WAIT_V(8); PG8_WAIT_L(0); PG8_BAR; PG8_MMA(1, 0, At, B0); PG8_MMA(1, 1, At, B1); PG8_BAR; PG8_SCHED;
            PG8_LDB(B0, 1, 0); PG8_LDB(B1, 1, 1); PG8_SCHED; PG8_LDA(At, 1, 0); PG8_STAGE(PG8_SA(0, 1), a2 + hstep, voffA);
            PG8_WAIT_V(8); PG8_WAIT_L(0); PG8_BAR; PG8_MMA(0, 0, At, B0); PG8_MMA(0, 1, At, B1); PG8_BAR; PG8_SCHED;
            PG8_LDA(At, 1, 1); PG8_STAGE(PG8_SB(1, 0), b3, voffB); PG8_STAGE(PG8_SB(1, 1), b3 + hstep, voffB); PG8_STAGE(PG8_SA(1, 0), a3, voffA);
            PG8_WAIT_V(8); PG8_WAIT_L(0); PG8_BAR; PG8_MMA(1, 0, At, B0); PG8_MMA(1, 1, At, B1); PG8_BAR; PG8_SCHED;
            } else {
            PG8_LDB(B0, 0, 0); PG8_SCHED; PG8_LDA(At, 0, 0); PG8_STAGE(PG8_SA(1, 1), a1 + hstep, voffA);
            PG8_WAIT_L(8); PG8_BAR; PG8_WAIT_L(0); PG8_MMA(0, 0, At, B0); PG8_BAR; PG8_SCHED;
            PG8_LDB(B1, 0, 1); PG8_STAGE(PG8_SB(0, 0), b2, voffB);
            PG8_BAR; PG8_WAIT_L(0); PG8_MMA(0, 1, At, B1); PG8_BAR;
            PG8_LDA(At, 0, 1); PG8_STAGE(PG8_SA(0, 0), a2, voffA);
            PG8_BAR; PG8_WAIT_L(0); PG8_MMA(1, 0, At, B0); PG8_BAR; PG8_SCHED;
            PG8_STAGE(PG8_SB(0, 1), b2 + hstep, voffB);
            PG8_WAIT_V(6); PG8_BAR; PG8_MMA(1, 1, At, B1); PG8_BAR;
            PG8_LDB(B0, 1, 0); PG8_SCHED; PG8_LDA(At, 1, 0); PG8_STAGE(PG8_SA(0, 1), a2 + hstep, voffA);
            PG8_WAIT_L(8); PG8_BAR; PG8_WAIT_L(0); PG8_MMA(0, 0, At, B0); PG8_BAR; PG8_SCHED;
            PG8_LDB(B1, 1, 1); PG8_STAGE(PG8_SB(1, 0), b3, voffB);
            PG8_BAR; PG8_WAIT_L(0); PG8_MMA(0, 1, At, B1); PG8_BAR;
            PG8_LDA(At, 1, 1); PG8_STAGE(PG8_SA(1, 0), a3, voffA);
            PG8_BAR; PG8_WAIT_L(0); PG8_MMA(1, 0, At, B0); PG8_BAR; PG8_SCHED;
            PG8_STAGE(PG8_SB(1, 1), b3 + hstep, voffB);
            PG8_WAIT_V(6); PG8_BAR; PG8_MMA(1, 1, At, B1); PG8_BAR;
            }
        }
        if constexpr (ALIGN_EPI) { if (wr == 0) PG8_BAR; }
        if constexpr (!Epi::AFTER_DRAIN) { E(acc, cur, wr, wc, fr, fq); S.done(cur); }
        if (!has_next) break;
#pragma unroll
        for (int a = 0; a < 2; ++a)
#pragma unroll
            for (int b = 0; b < 2; ++b)
#pragma unroll
                for (int m = 0; m < 4; ++m)
#pragma unroll
                    for (int n = 0; n < 2; ++n) acc[a][b][m][n] = (f32x4){0.f, 0.f, 0.f, 0.f};
        cur = nxt; cA = nA; cB = nB; ++ui;
        if constexpr (ALIGN_EPI) { if (wr == 1) PG8_BAR; }
    }
    PG8_WAIT_V(0);
    if constexpr (!ALIGN_EPI) { if (wr == 0) PG8_BAR; }
    PG8_BAR;
    if constexpr (Epi::AFTER_DRAIN) { E.fused(acc, cur, wr, wc, fr, fq, lds, wid, lane); S.done(cur); }
#undef PG8_SA
#undef PG8_SB
#undef PG8_STAGE
#undef PG8_LDA
#undef PG8_LDB
#undef PG8_MMA
#undef PG8_WAIT_V
#undef PG8_WAIT_L
#undef PG8_BAR
#undef PG8_SCHED
}
}

#ifndef PG8_SP2
#define PG8_SP2 true
#endif
#ifndef PG8_ALIGN
#define PG8_ALIGN true
#endif

__device__ __forceinline__ float row_rstd16(const float* rowss, int row) {
    const f32x4* r = (const f32x4*)(rowss + (size_t)row * 16);
    const f32x4 a = r[0], b = r[1], c = r[2], d = r[3];
    const float s = ((a[0] + a[1]) + (a[2] + a[3])) + ((b[0] + b[1]) + (b[2] + b[3])) + ((c[0] + c[1]) + (c[2] + c[3])) + ((d[0] + d[1]) + (d[2] + d[3]));
    return rsqrtf(s * (1.f / DM) + EPS);
}
struct EpiProjF {
    static constexpr bool PERM = true, AFTER_DRAIN = false;
    const float* rowss; const float* cb; bf16_t* proj; float* side; const float* g_a; const float* g_b; const float* g_ds; const float* g_dw; LDSF float* xs  ; LDSF float* rsl  ;
    __device__ __forceinline__ void operator()(const pg8::f32x4 (&acc)[2][2][4][2], const pg8::Unit& u, int wr, int wc, int fr, int fq) const {
        const int b = u.pm >> 4, colt = u.pn * 256 + wc * 32 + 8 * fq;
        const int knmode = (u.pn == 1) ? 1 : (u.pn == 4) ? 2 : (u.pn == 10) ? 3 : (u.pn == 11) ? 4 : 0;
        f32x4 cv[2][2];
#pragma unroll
        for (int bj = 0; bj < 2; ++bj)
#pragma unroll
            for (int n = 0; n < 2; ++n) cv[bj][n] = *(const f32x4*)(cb + b * PINP + colt + bj * 128 + 4 * n);
        {   const int tid = (wr * 4 + wc) * 64 + fq * 16 + fr;
            if (tid < 256) rsl[tid] = row_rstd16(rowss, u.pm * 256 + tid);
            asm volatile("s_waitcnt vmcnt(0) lgkmcnt(0)" ::: "memory"); __builtin_amdgcn_s_barrier(); asm volatile("" ::: "memory"); }
        if (knmode != 0) {
#pragma unroll
            for (int ai = 0; ai < 2; ++ai)
#pragma unroll
                for (int m = 0; m < 4; ++m) {
                    const float rsm = rsl[ai * 128 + wr * 64 + m * 16 + fr];
#pragma unroll
                    for (int bj = 0; bj < 2; ++bj) {
                        const f32x4 v0 = acc[ai][bj][m][0] * rsm + cv[bj][0], v1 = acc[ai][bj][m][1] * rsm + cv[bj][1];
                        float ss = (v0[0] * v0[0] + v0[1] * v0[1]) + (v0[2] * v0[2] + v0[3] * v0[3]) + (v1[0] * v1[0] + v1[1] * v1[1]) + (v1[2] * v1[2] + v1[3] * v1[3]);
                        ss += __shfl_xor(ss, 16); ss += __shfl_xor(ss, 32);
                        if (fq == 0) xs[((wr * 4 + wc) * 16 + (ai * 4 + m) * 2 + bj) * 16 + fr] = ss;
                    }
                }
            asm volatile("s_waitcnt lgkmcnt(0)" ::: "memory"); __builtin_amdgcn_s_barrier(); asm volatile("" ::: "memory");
        }
#pragma unroll
        for (int ai = 0; ai < 2; ++ai)
#pragma unroll
            for (int m = 0; m < 4; ++m) {
                const int row = u.pm * 256 + ai * 128 + wr * 64 + m * 16 + fr; const float rs = rsl[ai * 128 + wr * 64 + m * 16 + fr];
#pragma unroll
                for (int bj = 0; bj < 2; ++bj) {
                    f32x4 v0 = acc[ai][bj][m][0] * rs + cv[bj][0], v1 = acc[ai][bj][m][1] * rs + cv[bj][1]; const int col0 = colt + bj * 128;
                    if (col0 >= C_BF && col0 < PIN) { *(f32x4*)(side + (size_t)row * 16 + (col0 - C_BF)) = v0; *(f32x4*)(side + (size_t)row * 16 + (col0 - C_BF) + 4) = v1; }
                    const bool on = (knmode == 1) || (knmode == 2) || (knmode == 3 && bj == 1 && wc < 2) || (knmode == 4 && bj == 0 && wc < 2);
                    if (on) {
                        const int xi = (ai * 4 + m) * 2 + bj;
                        float tot = xs[((wr * 4 + wc) * 16 + xi) * 16 + fr]; float dn = 1.f / 32.f;
                        if (knmode != 1) { tot += xs[((wr * 4 + (wc ^ 1)) * 16 + xi) * 16 + fr]; dn = 1.f / 64.f; }
                        const float nrm = rsqrtf(tot * dn + EPS);
                        const float* gp = (knmode == 1) ? g_a + 8 * fq : ((knmode == 2) ? g_b : (knmode == 3 ? g_ds : g_dw)) + (wc & 1) * 32 + 8 * fq;
                        v0 = v0 * nrm * *(const f32x4*)gp; v1 = v1 * nrm * *(const f32x4*)(gp + 4);
                    }
                    u32x4 w; w[0] = pg8::cvt_pk_bf16(v0[0], v0[1]); w[1] = pg8::cvt_pk_bf16(v0[2], v0[3]); w[2] = pg8::cvt_pk_bf16(v1[0], v1[1]); w[3] = pg8::cvt_pk_bf16(v1[2], v1[3]);
                    *(u32x4*)(proj + (size_t)row * PINP + col0) = w;
                }
            }
    }
};
struct EpiResF {
    static constexpr bool PERM = false, AFTER_DRAIN = false;
    static constexpr int RB = 2;
    float* xout32; bf16_t* xr; const float* gate; const float* g; const float* sc; bf16_t* xa; float* rowss;
    __device__ __forceinline__ void operator()(const pg8::f32x4 (&acc)[2][2][4][2], const pg8::Unit& u, int wr, int wc, int fr, int fq) const {
        const int b = u.pm >> 4, col0 = u.pn * 256 + wc * 32 + 4 * fq;
        f32x4 gt[2][2], gm[2][2], sv[2][2];
#pragma unroll
        for (int bj = 0; bj < 2; ++bj)
#pragma unroll
            for (int n = 0; n < 2; ++n) { const int c = col0 + bj * 128 + n * 16; gt[bj][n] = *(const f32x4*)(gate + b * 6144 + c);
                if (xa) { gm[bj][n] = *(const f32x4*)(g + c); sv[bj][n] = *(const f32x4*)(sc + b * 6144 + c); } else { gm[bj][n] = (f32x4){0.f, 0.f, 0.f, 0.f}; sv[bj][n] = gm[bj][n]; } }
#pragma unroll
        for (int ai = 0; ai < 2; ++ai)
#pragma unroll
            for (int mh = 0; mh < 4 / RB; ++mh) {
                uint2 xw[RB][2][2];
#pragma unroll
                for (int mm = 0; mm < RB; ++mm)
#pragma unroll
                    for (int bj = 0; bj < 2; ++bj)
#pragma unroll
                        for (int n = 0; n < 2; ++n)
                            xw[mm][bj][n] = *(const uint2*)(xr + (size_t)(u.pm * 256 + ai * 128 + wr * 64 + (RB * mh + mm) * 16 + fr) * DM + col0 + bj * 128 + n * 16);
                asm volatile("" ::: "memory");
                if (ai == 0 && mh == 0) {
#pragma unroll
                    for (int bj = 0; bj < 2; ++bj)
#pragma unroll
                        for (int n = 0; n < 2; ++n) gm[bj][n] = gm[bj][n] * (sv[bj][n] + 1.0f);
                }
#pragma unroll
                for (int mm = 0; mm < RB; ++mm) {
                    const int m = RB * mh + mm; const int row = u.pm * 256 + ai * 128 + wr * 64 + m * 16 + fr; float ss = 0.f;
#pragma unroll
                    for (int bj = 0; bj < 2; ++bj)
#pragma unroll
                        for (int n = 0; n < 2; ++n) { const size_t off = (size_t)row * DM + col0 + bj * 128 + n * 16; const uint2 xv = xw[mm][bj][n];
                            const f32x4 xi = (f32x4){__uint_as_float(xv.x << 16), __uint_as_float(xv.x & 0xffff0000u), __uint_as_float(xv.y << 16), __uint_as_float(xv.y & 0xffff0000u)};
                            const f32x4 o = xi + gt[bj][n] * acc[ai][bj][m][n];
                            ss += (o[0] * o[0] + o[1] * o[1]) + (o[2] * o[2] + o[3] * o[3]);
                            if (xa) { uint2 w; w.x = pg8::cvt_pk_bf16(o[0], o[1]); w.y = pg8::cvt_pk_bf16(o[2], o[3]); *(uint2*)(xr + off) = w;
                                const f32x4 q = o * gm[bj][n]; uint2 w2; w2.x = pg8::cvt_pk_bf16(q[0], q[1]); w2.y = pg8::cvt_pk_bf16(q[2], q[3]); *(uint2*)(xa + off) = w2; }
                            else *(f32x4*)(xout32 + off) = o; }
                    if (rowss) { ss += __shfl_xor(ss, 16); ss += __shfl_xor(ss, 32); if (fq == 0) rowss[(size_t)row * 16 + u.pn * 4 + wc] = ss; }
                }
            }
    }
};


#define DPPF(oldv, src, CTRL) __builtin_bit_cast(float, __builtin_amdgcn_update_dpp(__builtin_bit_cast(int, (float)(oldv)), __builtin_bit_cast(int, (float)(src)), (CTRL), 0xf, 0xf, false))
struct EpiUpAct {
    static constexpr bool PERM = true, AFTER_DRAIN = false;
    const float* rowss; const float* cb; bf16_t* act; float* eg; float* ev; const float* cw; const float* cbias; LDSF float* xch; LDSF float* cst  ;
    __device__ __forceinline__ void operator()(const pg8::f32x4 (&acc)[2][2][4][2], const pg8::Unit& u, int wr, int wc, int fr, int fq) const {
        const int b = u.pm >> 4, cih = wc * 32 + 8 * fq, jcol = u.pn * 128 + cih;
        const float* cbg = cb + b * NUP + u.pn * 256 + cih; const float* cbv = cbg + 128;
        {
            const int tid = (wr * 4 + wc) * 64 + fq * 16 + fr, col = tid & 127, arr = tid >> 7;
            const float* src = (arr == 0) ? cb + b * NUP + u.pn * 256 + col : (arr == 1) ? cb + b * NUP + u.pn * 256 + 128 + col : cw + (arr - 2) * DFF + u.pn * 128 + col;
            cst[arr * 128 + col] = *src;
            if (tid < 256) { const int a2 = 4 + (tid >> 7); cst[a2 * 128 + col] = (a2 == 4) ? cw[2 * DFF + u.pn * 128 + col] : cbias[u.pn * 128 + col]; }
            else cst[768 + (tid - 256)] = row_rstd16(rowss, u.pm * 256 + (tid - 256));
            const f32x4 cg0 = *(const f32x4*)cbg, cg1 = *(const f32x4*)(cbg + 4);
            const f32x4 cv0 = *(const f32x4*)cbv, cv1 = *(const f32x4*)(cbv + 4);
            asm volatile("s_waitcnt vmcnt(0) lgkmcnt(0)" ::: "memory"); __builtin_amdgcn_s_barrier(); asm volatile("" ::: "memory");
            const float r3a = cst[768 + 0 * 128 + wr * 64 + 48 + fr], r3b = cst[768 + 1 * 128 + wr * 64 + 48 + fr], r0 = cst[768 + (fr & 1)];
#pragma unroll
            for (int ai = 0; ai < 2; ++ai) {
                const float r3 = ai ? r3b : r3a;
                const f32x4 g0 = acc[ai][0][3][0] * r3 + cg0, g1 = acc[ai][0][3][1] * r3 + cg1;
                if (fr >= 14) { LDSF float* x = xch + ((((wr * 2 + ai) * 4 + wc) * 2 + (fr - 14)) * 32 + 8 * fq); *(LDSF f32x4*)x = g0; *(LDSF f32x4*)(x + 4) = g1;
                    if (wr == 1 && ai == 1) { float* e = eg + ((size_t)(u.pm * 4 + 2 + (fr - 14))) * DFF + jcol; *(f32x4*)e = g0; *(f32x4*)(e + 4) = g1; } }
            }
            if (wr == 0 && fr < 2) {
                float* e = eg + ((size_t)(u.pm * 4 + fr)) * DFF + jcol; float* v = ev + ((size_t)(u.pm * 2 + fr)) * DFF + jcol;
                *(f32x4*)e = acc[0][0][0][0] * r0 + cg0; *(f32x4*)(e + 4) = acc[0][0][0][1] * r0 + cg1;
                *(f32x4*)v = acc[0][1][0][0] * r0 + cv0; *(f32x4*)(v + 4) = acc[0][1][0][1] * r0 + cv1;
            }
        }
        asm volatile("s_waitcnt lgkmcnt(0)" ::: "memory"); __builtin_amdgcn_s_barrier(); asm volatile("" ::: "memory");
#pragma unroll
        for (int ai = 0; ai < 2; ++ai) {
            f32x4 pvv[2];
            if (ai == 0 && wr == 0) { pvv[0] = (f32x4){0.f, 0.f, 0.f, 0.f}; pvv[1] = pvv[0]; }
            else { const int swr = (wr == 1) ? 0 : 1, sai = (wr == 1) ? ai : ai - 1;
                const LDSF float* x = xch + ((((swr * 2 + sai) * 4 + wc) * 2 + (fr & 1)) * 32 + 8 * fq); pvv[0] = *(const LDSF f32x4*)x; pvv[1] = *(const LDSF f32x4*)(x + 4); }
#pragma unroll
            for (int m = 0; m < 4; ++m) {
                asm volatile("" ::: "memory");
                const int row = u.pm * 256 + ai * 128 + wr * 64 + m * 16 + fr; const float rsm = cst[768 + ai * 128 + wr * 64 + m * 16 + fr];
                u32x4 w;
#pragma unroll
                for (int n = 0; n < 2; ++n) {
                    const LDSF float* cc = cst + cih + 4 * n;
                    const f32x4 cgn = *(const LDSF f32x4*)cc, cvn = *(const LDSF f32x4*)(cc + 128);
                    const f32x4 k0 = *(const LDSF f32x4*)(cc + 256), k1 = *(const LDSF f32x4*)(cc + 384), k2 = *(const LDSF f32x4*)(cc + 512), kb = *(const LDSF f32x4*)(cc + 640);
                    const f32x4 c = acc[ai][0][m][n] * rsm + cgn, v = acc[ai][1][m][n] * rsm + cvn; float o[4];
#pragma unroll
                    for (int i = 0; i < 4; ++i) {
                        const float gm1 = DPPF(DPPF(0.f, pvv[n][i], 0x121), c[i], 0x111);
                        const float gm2 = DPPF(DPPF(0.f, pvv[n][i], 0x122), c[i], 0x112);
                        const float cvv = k0[i] * gm2 + k1[i] * gm1 + k2[i] * c[i] + kb[i];
                        o[i] = cvv * __builtin_amdgcn_rcpf(1.f + __builtin_amdgcn_exp2f(-cvv * LOG2E)) * v[i];
                    }
                    w[2 * n] = pg8::cvt_pk_bf16(o[0], o[1]); w[2 * n + 1] = pg8::cvt_pk_bf16(o[2], o[3]);
                    pvv[n] = c;
                }
                *(u32x4*)(act + (size_t)row * DFF + jcol) = w;
            }
        }
    }
};
__device__ void act_fixup(const Params& p, int l, int pm) {
    if ((pm & 15) == 0) return;
    const float* eg = (const float*)(p.ws + WS_EG); const float* ev = (const float*)(p.ws + WS_EV); bf16_t* act = (bf16_t*)(p.ws + WS_ACT);
    const float* cw = p.conv_w + (size_t)l * 3 * DFF; const float* cbias = p.conv_b + (size_t)l * DFF;
    const int tid = TID();
    constexpr int NB4 = 4;
#pragma unroll 1
    for (int bt = 0; bt < 3; ++bt) {
        float a[NB4], bq[NB4], c0[NB4], c1[NB4], vv[NB4], k0[NB4], k1[NB4], k2[NB4], kb[NB4];
#pragma unroll
        for (int i = 0; i < NB4; ++i) { const int idx = min(tid + (bt * NB4 + i) * NTHR, 2 * DFF - 1); const int r = idx / DFF, j = idx - r * DFF;
            a[i] = eg[((size_t)((pm - 1) * 4 + 2)) * DFF + j]; bq[i] = eg[((size_t)((pm - 1) * 4 + 3)) * DFF + j]; c0[i] = eg[((size_t)(pm * 4 + 0)) * DFF + j]; c1[i] = eg[((size_t)(pm * 4 + 1)) * DFF + j];
            vv[i] = ev[((size_t)(pm * 2 + r)) * DFF + j]; k0[i] = cw[j]; k1[i] = cw[DFF + j]; k2[i] = cw[2 * DFF + j]; kb[i] = cbias[j]; }
        asm volatile("" ::: "memory");
#pragma unroll
        for (int i = 0; i < NB4; ++i) { const int idx = tid + (bt * NB4 + i) * NTHR;
            if (idx < 2 * DFF) { const int r = idx / DFF, j = idx - r * DFF;
                const float gm2 = r ? bq[i] : a[i], gm1 = r ? c0[i] : bq[i], gc = r ? c1[i] : c0[i];
                const float cvv = k0[i] * gm2 + k1[i] * gm1 + k2[i] * gc + kb[i];
                act[(size_t)(pm * 256 + r) * DFF + j] = f2bf(siluf(cvv) * vv[i]); } }
    }
}

__device__ void ph_prep_cum_bh(const Params& p, int l, int bh, unsigned char* lds) {
    const float* side = (const float*)(p.ws + WS_SIDE);
    float* cum = (float*)(p.ws + WS_CUM);
    LDSF float* wt = (LDSF float*)(lds + 70000);
    const int tid = TID(), lane = tid & 63, wv = tid >> 6;
    {
        const int b = bh >> 2, h = bh & 3; const float bf = p.fox_bf[l * 4 + h];
        float v[8]; float tot = 0.f;
#pragma unroll
        for (int i = 0; i < 8; ++i) { v[i] = logsigf(side[(size_t)(b * SEQ + tid * 8 + i) * 16 + h] + bf); tot += v[i]; v[i] = tot; }
        float inc = tot;
#pragma unroll
        for (int o = 1; o < 64; o <<= 1) { const float u = __shfl_up(inc, o); if (lane >= o) inc += u; }
        __syncthreads();
        if (lane == 63) wt[wv] = inc;
        __syncthreads();
        float base = inc - tot;
        for (int w8 = 0; w8 < wv; ++w8) base += wt[w8];
#pragma unroll
        for (int i = 0; i < 8; ++i) cum[bh * SEQ + tid * 8 + i] = base + v[i];
    }
}
template <int N> __device__ __forceinline__ float dotn(const float* q, const bf16_t* k) {
    float s = 0.f;
#pragma unroll
    for (int c = 0; c < N / 8; ++c) { float t[8]; load8(k + 8 * c, t);
#pragma unroll
        for (int j = 0; j < 8; ++j) s += q[8 * c + j] * t[j]; }
    return s;
}
template <int N> __device__ __forceinline__ void axpyn(float* o, float w, const bf16_t* v) {
#pragma unroll
    for (int c = 0; c < N / 8; ++c) { float t[8]; load8(v + 8 * c, t);
#pragma unroll
        for (int j = 0; j < 8; ++j) o[8 * c + j] += w * t[j]; }
}
template <int N> __device__ __forceinline__ void loadq_norm(float* q, const bf16_t* src, const float* g, float scale, bool norm) {
    float ss = 0.f;
#pragma unroll
    for (int c = 0; c < N / 8; ++c) load8(src + 8 * c, q + 8 * c);
#pragma unroll
    for (int j = 0; j < N; ++j) ss += q[j] * q[j];
    const float r = norm ? rsqrtf(ss * (1.f / N) + EPS) : 1.f;
#pragma unroll
    for (int j = 0; j < N; ++j) q[j] = q[j] * r * (norm ? g[j] : 1.f) * scale;
}
__device__ __forceinline__ void store64(bf16_t* dst, const float* o) {
#pragma unroll
    for (int c = 0; c < 8; ++c) { u32x4 w; w[0] = pk2(o[8 * c], o[8 * c + 1]); w[1] = pk2(o[8 * c + 2], o[8 * c + 3]); w[2] = pk2(o[8 * c + 4], o[8 * c + 5]); w[3] = pk2(o[8 * c + 6], o[8 * c + 7]); *(u32x4*)(dst + 8 * c) = w; }
}

typedef float f32x16 __attribute__((ext_vector_type(16)));
typedef short s16x4 __attribute__((ext_vector_type(4)));
#define LDSP __attribute__((address_space(3)))
constexpr int KSTR = 144;
constexpr int AL_KV = 17408;
constexpr int AL_BK = 2 * AL_KV  , AL_TB = AL_BK + 512  , AL_WSF = AL_TB + 512  , AL_MISC = AL_WSF + 2048  ,
              AL_IMP = 38912  , AL_SELM = AL_IMP + 65536  ,
              AL_TB4 = AL_SELM + 512  , AL_INVL = AL_TB4 + 2048  , AL_D_END = AL_INVL + 1024;
static_assert(AL_MISC + 64 <= AL_IMP && AL_D_END <= 131072, "attention LDS map");
__device__ __forceinline__ int crow(int r, int hi) { return (r & 3) + 8 * (r >> 2) + 4 * hi; }
__device__ __forceinline__ float ex2(float v) { return __builtin_amdgcn_exp2f(v); }
__device__ __forceinline__ s16x4 vtr(const LDSP unsigned char* p) { typedef short v4i16_t __attribute__((ext_vector_type(4))); return __builtin_bit_cast(s16x4, __builtin_amdgcn_ds_read_tr16_b64_v4i16((LDSP v4i16_t*)p)); }
__device__ __forceinline__ bf16x8 pack8(const f32x16& p, int b) {
    u32x4 w; w[0] = pg8::cvt_pk_bf16(p[b], p[b + 1]); w[1] = pg8::cvt_pk_bf16(p[b + 2], p[b + 3]); w[2] = pg8::cvt_pk_bf16(p[b + 4], p[b + 5]); w[3] = pg8::cvt_pk_bf16(p[b + 6], p[b + 7]);
    return __builtin_bit_cast(bf16x8, w);
}
__device__ __forceinline__ f32x16 splat16(float v) { return (f32x16){v, v, v, v, v, v, v, v, v, v, v, v, v, v, v, v}; }
template <int NK16>
__device__ __forceinline__ void qkt(f32x16& p0, f32x16& p1, const LDSP unsigned char* Kt, const bf16x8* qf, int dbase, int r32, int hi) {
    const LDSP unsigned char* kb = Kt + r32 * KSTR + hi * 16 + dbase * 32;
#pragma unroll
    for (int d0 = 0; d0 < NK16; ++d0) {
        const bf16x8 a0 = *(const LDSP bf16x8*)(kb + d0 * 32), a1 = *(const LDSP bf16x8*)(kb + 32 * KSTR + d0 * 32);
        p0 = __builtin_amdgcn_mfma_f32_32x32x16_bf16(a0, qf[d0], p0, 0, 0, 0);
        p1 = __builtin_amdgcn_mfma_f32_32x32x16_bf16(a1, qf[d0], p1, 0, 0, 0);
    }
}
__device__ __forceinline__ void pv(f32x16* o, const LDSP unsigned char* Vt, int vb, const f32x16& p0, const f32x16& p1) {
    bf16x8 pa[4]; pa[0] = pack8(p0, 0); pa[1] = pack8(p0, 8); pa[2] = pack8(p1, 0); pa[3] = pack8(p1, 8);
#pragma unroll
    for (int d0 = 0; d0 < 2; ++d0)
#pragma unroll
        for (int ks = 0; ks < 4; ++ks) {
            const s16x4 lo = vtr(Vt + vb + d0 * 4096 + ks * 1024), hh = vtr(Vt + vb + d0 * 4096 + ks * 1024 + 512);
            const bf16x8 vf = (bf16x8){lo[0], lo[1], lo[2], lo[3], hh[0], hh[1], hh[2], hh[3]};
            o[d0] = __builtin_amdgcn_mfma_f32_32x32x16_bf16(pa[ks], vf, o[d0], 0, 0, 0);
        }
}
__device__ __forceinline__ float exp_sum(f32x16& p0, f32x16& p1) {
    float s0 = 0.f, s1 = 0.f;
#pragma unroll
    for (int r = 0; r < 16; ++r) { p0[r] = ex2(p0[r]); p1[r] = ex2(p1[r]); s0 += p0[r]; s1 += p1[r]; }
    return s0 + s1;
}
__device__ __forceinline__ void scale_rows(f32x16* o, float f, LDSP float* wsf, int r32, int hi) {
    __builtin_amdgcn_wave_barrier();
    if (hi == 0) wsf[r32] = f;
    __builtin_amdgcn_s_waitcnt(0xc07f);
    __builtin_amdgcn_wave_barrier();
#pragma unroll
    for (int g = 0; g < 4; ++g) { const f32x4 a = *(const LDSP f32x4*)(wsf + 8 * g + 4 * hi);
#pragma unroll
        for (int i = 0; i < 4; ++i) { o[0][4 * g + i] *= a[i]; o[1][4 * g + i] *= a[i]; } }
    __builtin_amdgcn_wave_barrier();
}
__device__ __forceinline__ void store_o(const f32x16* o, LDSP bf16_t* stg, bf16_t* dst, int lane, int r32, int hi) {
    __builtin_amdgcn_wave_barrier();
#pragma unroll
    for (int r = 0; r < 16; ++r) { const int orow = crow(r, hi); stg[orow * 64 + r32] = f2bf(o[0][r]); stg[orow * 64 + 32 + r32] = f2bf(o[1][r]); }
    __builtin_amdgcn_s_waitcnt(0xc07f);
    __builtin_amdgcn_wave_barrier();
#pragma unroll
    for (int i = 0; i < 4; ++i) { const int row = i * 8 + (lane >> 3), ch = lane & 7; const u32x4 v = *(const LDSP u32x4*)(stg + row * 64 + ch * 8); *(u32x4*)(dst + (size_t)row * DM + ch * 8) = v; }
    __builtin_amdgcn_s_waitcnt(0xc07f);
    __builtin_amdgcn_wave_barrier();
}
template <int NG>
__device__ __forceinline__ void load_q(bf16x8* qf, const bf16_t* qrow  , const float* g, float sc, bool norm, int hi) {
    float v[4][8];
#pragma unroll
    for (int d0 = 0; d0 < 4; ++d0) load8(qrow + 16 * d0 + 8 * hi, v[d0]);
    float r0 = 1.f, r1 = 1.f;
    if (norm) {
        float s0 = 0.f, s1 = 0.f;
#pragma unroll
        for (int j = 0; j < 8; ++j) { s0 += v[0][j] * v[0][j] + v[1][j] * v[1][j]; s1 += v[2][j] * v[2][j] + v[3][j] * v[3][j]; }
        s0 += __shfl_xor(s0, 32); s1 += __shfl_xor(s1, 32);
        if (NG == 64) { r0 = rsqrtf((s0 + s1) * (1.f / 64.f) + EPS); r1 = r0; } else { r0 = rsqrtf(s0 * (1.f / 32.f) + EPS); r1 = rsqrtf(s1 * (1.f / 32.f) + EPS); }
    }
#pragma unroll
    for (int d0 = 0; d0 < 4; ++d0) {
        const float rr = (d0 < 2 ? r0 : r1) * sc; float w[8];
#pragma unroll
        for (int j = 0; j < 8; ++j) { const int d = 16 * d0 + 8 * hi + j; w[j] = v[d0][j] * rr * (norm ? g[d % NG] : 1.f); }
        u32x4 u; u[0] = pg8::cvt_pk_bf16(w[0], w[1]); u[1] = pg8::cvt_pk_bf16(w[2], w[3]); u[2] = pg8::cvt_pk_bf16(w[4], w[5]); u[3] = pg8::cvt_pk_bf16(w[6], w[7]);
        qf[d0] = __builtin_bit_cast(bf16x8, u);
    }
}
__device__ __forceinline__ void kv_load(u32x4& kr, u32x4& vr, const bf16_t* Kb, const bf16_t* Vb, int k0, int tid) {
    const size_t off = (size_t)(k0 + (tid >> 3)) * PINP + (tid & 7) * 8;
    kr = *(const u32x4*)(Kb + off); vr = *(const u32x4*)(Vb + off);
}
__device__ __forceinline__ void kv_load64(u32x4& kr, u32x4& vr, const bf16_t* Kb, const bf16_t* Vb, int n0, int tid) {
    const size_t off = (size_t)(n0 + (tid >> 3)) * 64 + (tid & 7) * 8;
    kr = *(const u32x4*)(Kb + off); vr = *(const u32x4*)(Vb + off);
}
__device__ __forceinline__ void kv_store(const u32x4& kr, const u32x4& vr, LDSP unsigned char* buf, int tid) {
    const int key = tid >> 3, ch = tid & 7;
    *(LDSP u32x4*)(buf + key * KSTR + ch * 16) = kr;
    *(LDSP u32x4*)(buf + 9216 + (ch >> 2) * 4096 + (key >> 4) * 1024 + ((key >> 3) & 1) * 512 + (key & 7) * 64 + (ch & 3) * 16) = vr;
}
template <int NG>
__device__ __forceinline__ void knorm_chunk(u32x4& kr, const float* gp  ) {
    float v[8];
    v[0] = bf2f(kr[0] & 0xffff); v[1] = bf2f(kr[0] >> 16); v[2] = bf2f(kr[1] & 0xffff); v[3] = bf2f(kr[1] >> 16);
    v[4] = bf2f(kr[2] & 0xffff); v[5] = bf2f(kr[2] >> 16); v[6] = bf2f(kr[3] & 0xffff); v[7] = bf2f(kr[3] >> 16);
    float ss = 0.f;
#pragma unroll
    for (int j = 0; j < 8; ++j) ss += v[j] * v[j];
    ss += __shfl_xor(ss, 1); ss += __shfl_xor(ss, 2); if (NG == 64) ss += __shfl_xor(ss, 4);
    const float r = rsqrtf(ss * (1.f / NG) + EPS);
    const f32x4 ga = *(const f32x4*)gp, gb = *(const f32x4*)(gp + 4);
    kr[0] = pg8::cvt_pk_bf16(v[0] * r * ga[0], v[1] * r * ga[1]); kr[1] = pg8::cvt_pk_bf16(v[2] * r * ga[2], v[3] * r * ga[3]);
    kr[2] = pg8::cvt_pk_bf16(v[4] * r * gb[0], v[5] * r * gb[1]); kr[3] = pg8::cvt_pk_bf16(v[6] * r * gb[2], v[7] * r * gb[3]);
}
__device__ __forceinline__ void bias_near(f32x16& p0, f32x16& p1, const LDSP float* tbl, int tk0  , int wnd, bool rowok, int hi) {
#pragma unroll
    for (int g = 0; g < 4; ++g) {
#pragma unroll
        for (int i = 0; i < 4; ++i) { const int r = 4 * g + i; const int d0_ = tk0 - crow(r, hi), d1_ = d0_ - 32;
            const float b0 = tbl[min(max(d0_, 0), 127)], b1 = tbl[min(max(d1_, 0), 127)];
            p0[r] = (d0_ < 0 || d0_ >= wnd || !rowok) ? -INFINITY : p0[r] + b0; p1[r] = (d1_ < 0 || d1_ >= wnd || !rowok) ? -INFINITY : p1[r] + b1; }
        asm volatile("" ::: "memory");
    }
}
#define KVBUF(L, i) ((L) + ((i) & 1) * AL_KV)

__device__ void fa_fox_unit(const Params& p, int l, int b, int h, int qb, LDSP unsigned char* L) {
    const int tid = TID(), lane = tid & 63, wid = __builtin_amdgcn_readfirstlane(tid >> 6), r32 = lane & 31, hi = lane >> 5;
    const bf16_t* proj = (const bf16_t*)(p.ws + WS_PROJ); bf16_t* mix = (bf16_t*)p.out;
    const size_t rb = (size_t)b * SEQ; const int q0 = qb * 256, qw = q0 + 32 * wid, t = qw + r32;
    const bf16_t* Kb = proj + rb * PINP + CB_K + 64 * h; const bf16_t* Vb = proj + rb * PINP + CB_V + 64 * h;
    const float* cm = (const float*)(p.ws + WS_CUM) + (b * 4 + h) * SEQ;
    LDSP float* wsf = (LDSP float*)(L + AL_WSF) + wid * 64; LDSP float* bk = (LDSP float*)(L + AL_BK);
    const int vb = 9216 + ((lane >> 4) & 1) * 32 + (lane & 3) * 8 + (4 * hi + ((lane & 15) >> 2)) * 64;
    bf16x8 qf[4]; load_q<64>(qf, proj + (rb + t) * PINP + CB_Q + 64 * h, p.fox_qn + l * 64, 0.125f * LOG2E, true, hi);
    const float rowc = cm[t] * LOG2E - ((const float*)(p.ws + WS_BND))[l * 32 + 4];
    f32x16 o[2]; o[0] = (f32x16){}; o[1] = (f32x16){};
    float l_run = 0.f;
    const int NT = 4 * qb + 4, jd = 4 * qb + (wid >> 1);
    u32x4 krA, vrA, krB, vrB; float crA = 0.f, crB = 0.f;
    int js;
    {   const bool live = (lane < NT) ? ((cm[q0] - cm[64 * lane + 63]) * LOG2E >= -160.f) : false;
        const unsigned long long bm = __ballot(live);
        js = __builtin_amdgcn_readfirstlane((int)__builtin_ctzll(bm | (1ull << (NT - 1)))); if (js > NT - 2) js = NT - 2; js &= ~1; }
    __syncthreads();
    kv_load(krA, vrA, Kb, Vb, 64 * js, tid); if (tid < 64) crA = cm[64 * js + tid];
    kv_store(krA, vrA, KVBUF(L, js), tid); if (tid < 64) bk[(js & 1) * 64 + tid] = -crA * LOG2E;
    kv_load(krB, vrB, Kb, Vb, 64 * (js + 1), tid); if (tid < 64) crB = cm[64 * (js + 1) + tid];
    if (js + 2 < NT) { kv_load(krA, vrA, Kb, Vb, 64 * (js + 2), tid); if (tid < 64) crA = cm[64 * (js + 2) + tid]; }
#define FOX_STEP(J, KR, VR, CR) do { const int j = (J); \
        __syncthreads(); \
        if (j + 1 < NT) { kv_store(KR, VR, KVBUF(L, j + 1), tid); if (tid < 64) bk[((j + 1) & 1) * 64 + tid] = -CR * LOG2E; } \
        if (j + 3 < NT) { kv_load(KR, VR, Kb, Vb, 64 * (j + 3), tid); if (tid < 64) CR = cm[64 * (j + 3) + tid]; } \
        if (j <= jd) { \
            const LDSP unsigned char* buf = KVBUF(L, j); const LDSP float* bkj = bk + (j & 1) * 64; \
            f32x16 p0, p1; \
            _Pragma("unroll") for (int g = 0; g < 4; ++g) { const f32x4 b0 = *(const LDSP f32x4*)(bkj + 8 * g + 4 * hi), b1 = *(const LDSP f32x4*)(bkj + 32 + 8 * g + 4 * hi); \
                _Pragma("unroll") for (int i = 0; i < 4; ++i) { p0[4 * g + i] = b0[i] + rowc; p1[4 * g + i] = b1[i] + rowc; } } \
            qkt<4>(p0, p1, buf, qf, 0, r32, hi); \
            if (j == jd) { const int k0 = 64 * j; \
                _Pragma("unroll") for (int r = 0; r < 16; ++r) { const int kk = k0 + crow(r, hi); if (kk > t) p0[r] = -INFINITY; if (kk + 32 > t) p1[r] = -INFINITY; } } \
            l_run += exp_sum(p0, p1); \
            pv(o, buf, vb, p0, p1); \
        } } while (0)
    for (int jj = js; jj < NT; jj += 2) { FOX_STEP(jj, krB, vrB, crB); FOX_STEP(jj + 1, krA, vrA, crA); }
#undef FOX_STEP
    l_run += __shfl_xor(l_run, 32);
    scale_rows(o, 1.f / l_run, wsf, r32, hi);
    store_o(o, (LDSP bf16_t*)(L + AL_IMP + wid * 8192), mix + (rb + qw) * DM + 256 + 64 * h, lane, r32, hi);
}

__device__ void fa_diff_unit(const Params& p, int l, int b, int h, int qb, LDSP unsigned char* L) {
    const int tid = TID(), lane = tid & 63, wid = __builtin_amdgcn_readfirstlane(tid >> 6), r32 = lane & 31, hi = lane >> 5;
    const bf16_t* proj = (const bf16_t*)(p.ws + WS_PROJ); bf16_t* mix = (bf16_t*)p.out;
    const size_t rb = (size_t)b * SEQ; const int q0 = qb * 256, qw = q0 + 32 * wid, t = qw + r32;
    const bf16_t* Kb = proj + rb * PINP + CA_K + 64 * h; const bf16_t* Vb = proj + rb * PINP + CA_V + 64 * h;
    LDSP float* wsf = (LDSP float*)(L + AL_WSF) + wid * 64; LDSP float* tbl = (LDSP float*)(L + AL_TB);
    const int vb = 9216 + ((lane >> 4) & 1) * 32 + (lane & 3) * 8 + (4 * hi + ((lane & 15) >> 2)) * 64;
    const float lam = ((const float*)(p.ws + WS_LAM))[l]; const float lam_init = 0.8f - 0.6f * __expf(-0.3f * (float)l);
    const float nbound = -((const float*)(p.ws + WS_BND))[l * 32 + h];
    __syncthreads();
    if (tid < 128) tbl[tid] = ((const float*)(p.ws + WS_TB))[h * 128 + tid] * LOG2E;
    bf16x8 qf[4]; load_q<32>(qf, proj + (rb + t) * PINP + CA_Q + 64 * h, p.diff_qn + l * 32, 0.17677669529663687f * LOG2E, true, hi);
    f32x16 o1[2], o2[2]; o1[0] = (f32x16){}; o1[1] = (f32x16){}; o2[0] = (f32x16){}; o2[1] = (f32x16){};
    float l1 = 0.f, l2 = 0.f;
    const int NT = 4 * qb + 4, jd = 4 * qb + (wid >> 1);
    u32x4 kr, vr; const float* gk = p.diff_kn + l * 32 + (tid & 3) * 8;
    kv_load(kr, vr, Kb, Vb, 0, tid);
    kv_store(kr, vr, KVBUF(L, 0), tid);
    kv_load(kr, vr, Kb, Vb, 64, tid);
    for (int j = 0; j < NT; ++j) {
        __syncthreads();
        if (j + 1 < NT) { kv_store(kr, vr, KVBUF(L, j + 1), tid); }
        if (j + 2 < NT) kv_load(kr, vr, Kb, Vb, 64 * (j + 2), tid);
        if (j <= jd) {
            const LDSP unsigned char* buf = KVBUF(L, j);
            const int k0 = 64 * j; const bool nearb = (qw - (k0 + 63)) < 113; const float cfar = tbl[127] + nbound;
#pragma unroll
            for (int mp = 0; mp < 2; ++mp) {
                f32x16 p0 = splat16(nearb ? nbound : cfar), p1 = p0;
                qkt<2>(p0, p1, buf, qf + 2 * mp, 2 * mp, r32, hi);
                if (nearb) bias_near(p0, p1, tbl, t - k0, 1 << 30, true, hi);
                if (mp == 0) { l1 += exp_sum(p0, p1); pv(o1, buf, vb, p0, p1); }
                else { l2 += exp_sum(p0, p1); pv(o2, buf, vb, p0, p1); }
            }
        }
    }
    l1 += __shfl_xor(l1, 32); l2 += __shfl_xor(l2, 32);
    scale_rows(o1, 1.f / l1, wsf, r32, hi); scale_rows(o2, lam / l2, wsf, r32, hi);
    o1[0] -= o2[0]; o1[1] -= o2[1];
    const float g0 = p.diff_sub[l * 64 + r32] * (1.f - lam_init), g1 = p.diff_sub[l * 64 + 32 + r32] * (1.f - lam_init);
#pragma unroll
    for (int r = 0; r < 16; ++r) {
        float ss = o1[0][r] * o1[0][r] + o1[1][r] * o1[1][r];
        ss += __shfl_xor(ss, 1); ss += __shfl_xor(ss, 2); ss += __shfl_xor(ss, 4); ss += __shfl_xor(ss, 8); ss += __shfl_xor(ss, 16);
        const float rs = rsqrtf(ss * (1.f / 64.f) + EPS); o1[0][r] *= rs * g0; o1[1][r] *= rs * g1;
    }
    store_o(o1, (LDSP bf16_t*)(L + AL_IMP + wid * 8192), mix + (rb + qw) * DM + 0 + 64 * h, lane, r32, hi);
}

template <bool DIAG>
__device__ __forceinline__ void stick_sub(f32x16& y, float& carry, int kbase  , int t, int hi) {
    float lk[16];
#pragma unroll
    for (int r = 0; r < 16; ++r) {
        const float v = y[r]; const float e = ex2(-fabsf(v)); const float lb = fminf(v, 0.f) - __builtin_amdgcn_logf(1.f + e);
        if (DIAG) { const bool valid = (kbase + crow(r, hi) < t); lk[r] = valid ? (lb - v) : 0.f; y[r] = valid ? lb : -INFINITY; }
        else { lk[r] = lb - v; y[r] = lb; }
    }
    float T[4], Go[4];
#pragma unroll
    for (int g = 0; g < 4; ++g) { const float Gs = (lk[4 * g] + lk[4 * g + 1]) + (lk[4 * g + 2] + lk[4 * g + 3]); Go[g] = __shfl_xor(Gs, 32); T[g] = Gs + Go[g]; }
    float sx = 0.f;
#pragma unroll
    for (int g = 3; g >= 0; --g) {
        float tail = carry + sx + (hi == 0 ? Go[g] : 0.f);
#pragma unroll
        for (int i = 3; i >= 0; --i) { y[4 * g + i] = ex2(y[4 * g + i] + tail); tail += lk[4 * g + i]; }
        sx += T[g];
    }
    carry += sx;
}
__device__ void fa_stick_unit(const Params& p, int l, int b, int h, int qb, LDSP unsigned char* L) {
    const int tid = TID(), lane = tid & 63, wid = __builtin_amdgcn_readfirstlane(tid >> 6), r32 = lane & 31, hi = lane >> 5;
    const bf16_t* proj = (const bf16_t*)(p.ws + WS_PROJ); bf16_t* mix = (bf16_t*)p.out;
    const size_t rb = (size_t)b * SEQ; const int q0 = qb * 256, qw = q0 + 32 * wid, t = qw + r32;
    const bf16_t* Kb = proj + rb * PINP + CC_K + 64 * h; const bf16_t* Vb = proj + rb * PINP + CC_V + 64 * h;
    const int vb = 9216 + ((lane >> 4) & 1) * 32 + (lane & 3) * 8 + (4 * hi + ((lane & 15) >> 2)) * 64;
    bf16x8 qf[4]; load_q<64>(qf, proj + (rb + t) * PINP + CC_Q + 64 * h, nullptr, 0.125f * LOG2E, false, hi);
    f32x16 o[2]; o[0] = (f32x16){}; o[1] = (f32x16){};
    float carry = 0.f;
    const int NT = 4 * qb + 4, jd = 4 * qb + (wid >> 1);
    u32x4 kr, vr;
#define SBUF(i) (((i) & 1) ? (L + 108544) : L)
    LDSP unsigned* dn = (LDSP unsigned*)(L + AL_MISC) + 8;
    bool wdone = false;
    __syncthreads();
    if (lane == 0) dn[wid] = 0u;
    kv_load(kr, vr, Kb, Vb, 64 * (NT - 1), tid);
    kv_store(kr, vr, SBUF(NT - 1), tid);
    kv_load(kr, vr, Kb, Vb, 64 * (NT - 2), tid);
    for (int j = NT - 1; j >= 0; --j) {
        __syncthreads();
        if (__all(dn[lane & 7] != 0u)) break;
        if (j >= 1) kv_store(kr, vr, SBUF(j - 1), tid);
        if (j >= 2) kv_load(kr, vr, Kb, Vb, 64 * (j - 2), tid);
        if (j <= jd && !wdone) {
            const LDSP unsigned char* buf = SBUF(j);
            f32x16 p0 = (f32x16){}, p1 = (f32x16){};
            qkt<4>(p0, p1, buf, qf, 0, r32, hi);
            const int k0 = 64 * j; const bool diag = (j == jd);
            if (diag) { stick_sub<true>(p1, carry, k0 + 32, t, hi); stick_sub<true>(p0, carry, k0, t, hi); }
            else { stick_sub<false>(p1, carry, k0 + 32, t, hi); stick_sub<false>(p0, carry, k0, t, hi); }
            pv(o, buf, vb, p0, p1);
            if (__all(carry < -160.f)) { wdone = true; if (lane == 0) dn[wid] = 1u; }
        }
    }
    store_o(o, (LDSP bf16_t*)(L + AL_IMP + wid * 8192), mix + (rb + qw) * DM + 512 + 64 * h, lane, r32, hi);
}

__device__ void fa_nsa_unit(const Params& p, int l, int b, int u, LDSP unsigned char* L) {
    const int tid = TID(), lane = tid & 63, wid = __builtin_amdgcn_readfirstlane(tid >> 6), r32 = lane & 31, hi = lane >> 5;
    const int hh = wid >> 1, sub = wid & 1;
    const bf16_t* proj = (const bf16_t*)(p.ws + WS_PROJ); bf16_t* mix = (bf16_t*)p.out;
    const size_t rb = (size_t)b * SEQ; const int q0 = 64 * u, qw = q0 + 32 * sub, t = qw + r32; const int ql = 32 * sub + r32;
    LDSP float* wsf = (LDSP float*)(L + AL_WSF) + wid * 64; LDSP float* tbl = (LDSP float*)(L + AL_TB4) + hh * 128;
    LDSP float* imp = (LDSP float*)(L + AL_IMP); LDSP unsigned* selm = (LDSP unsigned*)(L + AL_SELM); LDSP float* invl = (LDSP float*)(L + AL_INVL);
    LDSP float* ofl = (LDSP float*)(L + AL_IMP) + wid * 2048 + lane;
    const int vb = 9216 + ((lane >> 4) & 1) * 32 + (lane & 3) * 8 + (4 * hi + ((lane & 15) >> 2)) * 64;
    const float* bnd = (const float*)(p.ws + WS_BND) + l * 32;
    __syncthreads();
    ((LDSP float*)(L + AL_TB4))[tid] = ((const float*)(p.ws + WS_TB))[512 + tid] * LOG2E;
    bf16x8 qf[4]; load_q<64>(qf, proj + (rb + t) * PINP + CD_Q + 64 * hh, p.nsa_qn + l * 64, 0.125f * LOG2E, true, hi);
    const float* sd = (const float*)(p.ws + WS_SIDE) + (rb + t) * 16 + 4 + hh;
    const float gc = 1.f / (1.f + __expf(-sd[0])), gs = 1.f / (1.f + __expf(-sd[4])), gwn = 1.f / (1.f + __expf(-sd[8]));
    f32x16 o[2]; o[0] = (f32x16){}; o[1] = (f32x16){};
    u32x4 kr, vr;
    {
        const bf16_t* Kc = (const bf16_t*)(p.ws + WS_KC) + (size_t)b * 256 * 64; const bf16_t* Vc = (const bf16_t*)(p.ws + WS_VC) + (size_t)b * 256 * 64;
        const int ntc = (4 * u + 2) / 64 + 1; const float nbound = -bnd[5 + hh];
        float l_run = 0.f, prevE3 = 0.f;
        kv_load64(kr, vr, Kc, Vc, 0, tid);
        kv_store(kr, vr, KVBUF(L, 0), tid);
        if (ntc > 1) kv_load64(kr, vr, Kc, Vc, 64, tid);
        for (int T = 0; T < ntc; ++T) {
            __syncthreads();
            if (T + 1 < ntc) kv_store(kr, vr, KVBUF(L, T + 1), tid);
            if (T + 2 < ntc) kv_load64(kr, vr, Kc, Vc, 64 * (T + 2), tid);
            const LDSP unsigned char* buf = KVBUF(L, T);
            f32x16 p0 = splat16(nbound), p1 = p0;
            qkt<4>(p0, p1, buf, qf, 0, r32, hi);
#pragma unroll
            for (int g = 0; g < 4; ++g) {
#pragma unroll
                for (int i = 0; i < 4; ++i) { const int r = 4 * g + i; const int d0_ = t - 16 * (64 * T + crow(r, hi)) - 31, d1_ = d0_ - 512;
                    const float b0 = tbl[min(max(d0_, 0), 127)], b1 = tbl[min(max(d1_, 0), 127)];
                    p0[r] = (d0_ < 0) ? -INFINITY : p0[r] + b0; p1[r] = (d1_ < 0) ? -INFINITY : p1[r] + b1; }
                asm volatile("" ::: "memory");
            }
            l_run += exp_sum(p0, p1);
#pragma unroll
            for (int s2 = 0; s2 < 2; ++s2) {
                float G[4], Eo[4];
#pragma unroll
                for (int g = 0; g < 4; ++g) { const float a0 = s2 ? p1[4 * g] : p0[4 * g], a1 = s2 ? p1[4 * g + 1] : p0[4 * g + 1], a2 = s2 ? p1[4 * g + 2] : p0[4 * g + 2], a3 = s2 ? p1[4 * g + 3] : p0[4 * g + 3];
                    G[g] = (a0 + a1) + (a2 + a3); Eo[g] = __shfl_xor(a3, 32); }
#pragma unroll
                for (int g = 0; g < 4; ++g) { const float eprev = hi ? Eo[g] : (g > 0 ? Eo[g - 1] : prevE3);
                    imp[(hh * 64 + ql) * 64 + 16 * T + 8 * s2 + 2 * g + hi] = G[g] + eprev; }
                prevE3 = Eo[3];
            }
            pv(o, buf, vb, p0, p1);
        }
        l_run += __shfl_xor(l_run, 32);
        const float inv = (l_run > 0.f) ? 1.f / l_run : 0.f;
        if (hi == 0) invl[hh * 64 + ql] = inv;
        scale_rows(o, gc * inv, wsf, r32, hi);
    }
    __syncthreads();
    {
        const int q = tid >> 3, part = tid & 7;
        const float i0 = invl[q], i1 = invl[64 + q], i2 = invl[128 + q], i3 = invl[192 + q];
        float vj[8];
#pragma unroll
        for (int jj = 0; jj < 8; ++jj) { const int j = part * 8 + jj;
            const float sum = ((imp[(0 * 64 + q) * 64 + j] * i0 + imp[(1 * 64 + q) * 64 + j] * i1) + imp[(2 * 64 + q) * 64 + j] * i2) + imp[(3 * 64 + q) * 64 + j] * i3;
            vj[jj] = (j > u) ? -1.0f : ((j == u || j == 0) ? 1.0e4f : sum); }
        __syncthreads();
#pragma unroll
        for (int jj = 0; jj < 8; ++jj) imp[q * 64 + part * 8 + jj] = vj[jj];
        __syncthreads();
        int rank[8];
#pragma unroll
        for (int jj = 0; jj < 8; ++jj) rank[jj] = 0;
        for (int i = 0; i < 64; ++i) { const float vi = imp[q * 64 + i];
#pragma unroll
            for (int jj = 0; jj < 8; ++jj) rank[jj] += (vi > vj[jj] || (vi == vj[jj] && i < part * 8 + jj)) ? 1 : 0; }
        unsigned bits = 0;
#pragma unroll
        for (int jj = 0; jj < 8; ++jj) if (rank[jj] < 16 && (part * 8 + jj) <= u) bits |= 1u << jj;
        unsigned mlo = (part < 4) ? (bits << (8 * part)) : 0u, mhi = (part >= 4) ? (bits << (8 * (part - 4))) : 0u;
        mlo |= __shfl_xor(mlo, 1); mhi |= __shfl_xor(mhi, 1); mlo |= __shfl_xor(mlo, 2); mhi |= __shfl_xor(mhi, 2); mlo |= __shfl_xor(mlo, 4); mhi |= __shfl_xor(mhi, 4);
        if (part == 0) { selm[2 * q] = mlo; selm[2 * q + 1] = mhi; }
    }
    __syncthreads();
#pragma unroll
    for (int r = 0; r < 16; ++r) { ofl[(2 * r) * 64] = o[0][r]; ofl[(2 * r + 1) * 64] = o[1][r]; }
    o[0] = (f32x16){}; o[1] = (f32x16){};
    {
        const unsigned long long mymask = (unsigned long long)selm[2 * ql] | ((unsigned long long)selm[2 * ql + 1] << 32);
        unsigned ulo = selm[2 * lane], uhi = selm[2 * lane + 1];
#pragma unroll
        for (int s2 = 1; s2 < 64; s2 <<= 1) { ulo |= __shfl_xor(ulo, s2); uhi |= __shfl_xor(uhi, s2); }
        unsigned long long um = (unsigned long long)(unsigned)__builtin_amdgcn_readfirstlane((int)ulo) | ((unsigned long long)(unsigned)__builtin_amdgcn_readfirstlane((int)uhi) << 32);
        const bf16_t* Kb = proj + rb * PINP + CD_KS; const bf16_t* Vb = proj + rb * PINP + CD_VS;
        float l_run = 0.f; const float nbound = -bnd[9 + hh]; const float cfar = tbl[127] + nbound; const float* gk = p.nsa_kn + (l * 3 + 1) * 64 + (tid & 7) * 8;
        int j = __builtin_ctzll(um); um &= um - 1;
        int jn = um ? __builtin_ctzll(um) : -1; um &= um - 1;
        kv_load(kr, vr, Kb, Vb, 64 * j, tid);
        kv_store(kr, vr, KVBUF(L, 0), tid);
        if (jn >= 0) kv_load(kr, vr, Kb, Vb, 64 * jn, tid);
        for (int it = 0;; ++it) {
            __syncthreads();
            const int jnn = um ? __builtin_ctzll(um) : -1; um &= um - 1;
            if (jn >= 0) { kv_store(kr, vr, KVBUF(L, it + 1), tid); }
            if (jnn >= 0) kv_load(kr, vr, Kb, Vb, 64 * jnn, tid);
            const bool mine = (mymask >> j) & 1ull;
            if (__any(mine)) {
                const LDSP unsigned char* buf = KVBUF(L, it);
                const int k0 = 64 * j; const bool nearb = (qw - (k0 + 63)) < 113;
                f32x16 p0 = splat16(nearb ? nbound : (mine ? cfar : -INFINITY)), p1 = p0;
                qkt<4>(p0, p1, buf, qf, 0, r32, hi);
                if (nearb) bias_near(p0, p1, tbl, t - k0, 1 << 30, mine, hi);
                l_run += exp_sum(p0, p1);
                pv(o, buf, vb, p0, p1);
            }
            if (jn < 0) break;
            j = jn; jn = jnn;
        }
        l_run += __shfl_xor(l_run, 32);
        scale_rows(o, gs / l_run, wsf, r32, hi);
#pragma unroll
        for (int r = 0; r < 16; ++r) { ofl[(2 * r) * 64] += o[0][r]; ofl[(2 * r + 1) * 64] += o[1][r]; }
        o[0] = (f32x16){}; o[1] = (f32x16){};
    }
    {
        const bf16_t* Kb = proj + rb * PINP + CD_KW; const bf16_t* Vb = proj + rb * PINP + CD_VW;
        float l_run = 0.f; const float nbound = -bnd[13 + hh]; const float cfar = tbl[127] + nbound; const float* gk = p.nsa_kn + (l * 3 + 2) * 64 + (tid & 7) * 8;
        const int jlo = max(0, u - 8);
        __syncthreads();
        kv_load(kr, vr, Kb, Vb, 64 * jlo, tid);
        kv_store(kr, vr, KVBUF(L, jlo), tid);
        if (jlo < u) kv_load(kr, vr, Kb, Vb, 64 * (jlo + 1), tid);
        for (int j = jlo; j <= u; ++j) {
            __syncthreads();
            if (j + 1 <= u) { kv_store(kr, vr, KVBUF(L, j + 1), tid); }
            if (j + 2 <= u) kv_load(kr, vr, Kb, Vb, 64 * (j + 2), tid);
            const LDSP unsigned char* buf = KVBUF(L, j);
            const int k0 = 64 * j; const bool nearb = (j == u || j == u - 8 || (qw - (k0 + 63)) < 113);
            f32x16 p0 = splat16(nearb ? nbound : cfar), p1 = p0;
            qkt<4>(p0, p1, buf, qf, 0, r32, hi);
            if (nearb) bias_near(p0, p1, tbl, t - k0, 512, true, hi);
            l_run += exp_sum(p0, p1);
            pv(o, buf, vb, p0, p1);
        }
        l_run += __shfl_xor(l_run, 32);
        scale_rows(o, gwn / l_run, wsf, r32, hi);
#pragma unroll
        for (int r = 0; r < 16; ++r) { o[0][r] += ofl[(2 * r) * 64]; o[1][r] += ofl[(2 * r + 1) * 64]; }
    }
    store_o(o, (LDSP bf16_t*)(L + AL_IMP + wid * 8192), mix + (rb + qw) * DM + 768 + 64 * hh, lane, r32, hi);
}

__device__ void ph_reset_queues(const Params& p) { unsigned* ctl = (unsigned*)(p.ws + WS_CTL); const int gt = GTID(); if (gt < 8) ctl[gt] = 0u; }
__device__ void prep_cmp_task(const Params& p, int l, int task, LDSP unsigned char* L) {
    const int tid = TID(), lane = tid & 63, wid = __builtin_amdgcn_readfirstlane(tid >> 6), r32 = lane & 31, hi = lane >> 5;
    const int b = task >> 4, which = (task >> 3) & 1, nt = task & 7;
    const bf16_t* proj = (const bf16_t*)(p.ws + WS_PROJ);
    const bf16_t* phiT = (const bf16_t*)(p.ws + WS_PHIT) + (size_t)(l * 2 + which) * 64 * 2048;
    const float* pe = p.nsa_pe + (size_t)(l * 2 + which) * 32 * 64;
    const int n = 32 * nt + r32, colbase = which ? CD_VC : CD_KC;
    f32x16 acc0 = (f32x16){}, acc1 = (f32x16){};
#pragma unroll
    for (int ii = 0; ii < 4; ++ii) {
        const int i = 4 * wid + ii; const int tok = min(16 * n + i, SEQ - 1);
        const bf16_t* xr = proj + (size_t)(b * SEQ + tok) * PINP + colbase;
#pragma unroll
        for (int d0 = 0; d0 < 4; ++d0) {
            float xv[8]; load8(xr + 16 * d0 + 8 * hi, xv);
            const f32x4 pe0 = *(const f32x4*)(pe + i * 64 + 16 * d0 + 8 * hi), pe1 = *(const f32x4*)(pe + i * 64 + 16 * d0 + 8 * hi + 4);
            u32x4 aw; aw[0] = pg8::cvt_pk_bf16(xv[0] + pe0[0], xv[1] + pe0[1]); aw[1] = pg8::cvt_pk_bf16(xv[2] + pe0[2], xv[3] + pe0[3]);
            aw[2] = pg8::cvt_pk_bf16(xv[4] + pe1[0], xv[5] + pe1[1]); aw[3] = pg8::cvt_pk_bf16(xv[6] + pe1[2], xv[7] + pe1[3]);
            const bf16x8 af = __builtin_bit_cast(bf16x8, aw);
            const bf16x8 b0 = *(const bf16x8*)(phiT + (size_t)r32 * 2048 + i * 64 + 16 * d0 + 8 * hi);
            const bf16x8 b1 = *(const bf16x8*)(phiT + (size_t)(32 + r32) * 2048 + i * 64 + 16 * d0 + 8 * hi);
            acc0 = __builtin_amdgcn_mfma_f32_32x32x16_bf16(af, b0, acc0, 0, 0, 0);
            acc1 = __builtin_amdgcn_mfma_f32_32x32x16_bf16(af, b1, acc1, 0, 0, 0);
        }
    }
    LDSP float* red = (LDSP float*)L;
    __syncthreads();
#pragma unroll
    for (int r = 0; r < 16; ++r) { red[(wid * 32 + crow(r, hi)) * 64 + r32] = acc0[r]; red[(wid * 32 + crow(r, hi)) * 64 + 32 + r32] = acc1[r]; }
    __syncthreads();
    {
        const int row = tid >> 4, e4 = (tid & 15) * 4; f32x4 v = (f32x4){0.f, 0.f, 0.f, 0.f};
#pragma unroll
        for (int w8 = 0; w8 < 8; ++w8) v += *(const LDSP f32x4*)(red + (w8 * 32 + row) * 64 + e4);
        const int nn = 32 * nt + row;
        if (which == 0) {
            float ss = (v[0] * v[0] + v[1] * v[1]) + (v[2] * v[2] + v[3] * v[3]);
            ss += __shfl_xor(ss, 1); ss += __shfl_xor(ss, 2); ss += __shfl_xor(ss, 4); ss += __shfl_xor(ss, 8);
            const float rs = rsqrtf(ss * (1.f / 64.f) + EPS); const f32x4 g = *(const f32x4*)(p.nsa_kn + (l * 3 + 0) * 64 + e4);
            v = v * rs * g;
        }
        uint2 o; o.x = pk2(v[0], v[1]); o.y = pk2(v[2], v[3]);
        if (nn >= 255) { o.x = 0u; o.y = 0u; }
        *(uint2*)((bf16_t*)(p.ws + (which ? WS_VC : WS_KC)) + (size_t)(b * 256 + nn) * 64 + e4) = o;
    }
}
__device__ void ph_prep(const Params& p, int l, LDSP unsigned char* L, unsigned char* lds) {
    for (int t = blockIdx.x; t < 80; t += gridDim.x) { if (t < 64) prep_cmp_task(p, l, t, L); }
    if (gridDim.x >= 80) { if (blockIdx.x >= 64 && blockIdx.x < 80) ph_prep_cum_bh(p, l, blockIdx.x - 64, lds); }
    else for (int bh = blockIdx.x; bh < 16; bh += gridDim.x) ph_prep_cum_bh(p, l, bh, lds);
}


__device__ void fa_phase_all(const Params& p, int l, LDSP unsigned char* L, unsigned char* lds, int qslot, int n_conv  ) {
    unsigned* ctl = (unsigned*)(p.ws + WS_CTL);
    LDSP unsigned* misc = (LDSP unsigned*)(L + AL_MISC);
    bool prep_ok = false;
    for (;;) {
        __syncthreads();
        if (threadIdx.x == 0) misc[0] = atomicAdd(&ctl[qslot], 1u);
        __syncthreads();
        const unsigned qi0 = misc[0];
        if (qi0 >= 1104u + (unsigned)n_conv) break;
        if (qi0 >= 1104u) {
            const int it = ((int)qi0 - 1104) * 8 + (TID() >> 6);
            if (it < CV_ITEMS) convert_item(p, l + 1, it, (LDSF float*)lds + (TID() >> 6) * (64 * 65), TID() & 63);
            continue;
        }
        if (qi0 < 80u) {
            if (qi0 < 64u) prep_cmp_task(p, l, (int)qi0, L); else ph_prep_cum_bh(p, l, (int)qi0 - 64, lds);
            asm volatile("s_waitcnt vmcnt(0)" ::: "memory");
            __syncthreads();
            if (threadIdx.x == 0) { __threadfence(); atomicAdd(&ctl[4 + qslot], 1u); }
            continue;
        }
        const unsigned qi = qi0 - 80u;
        int r, typ, sub;
        if (qi < 768u) { r = 15 - (int)(qi / 48u); const int j = (int)(qi % 48u); typ = j >> 4; typ = (typ == 0) ? 0 : (typ == 1 ? 2 : 3); sub = j & 15; }
        else { const int v = (int)qi - 768; r = 15 - (v >> 4); typ = 1; sub = v & 15; }
        if ((typ == 2 || typ == 3) && !prep_ok) {
            if (threadIdx.x == 0) { while (__hip_atomic_load(&ctl[4 + qslot], __ATOMIC_RELAXED, __HIP_MEMORY_SCOPE_AGENT) < 80u) __builtin_amdgcn_s_sleep(8); __threadfence(); }
            asm volatile("s_waitcnt vmcnt(0)" ::: "memory");
            __syncthreads();
            prep_ok = true;
        }
        if (typ == 0) fa_diff_unit(p, l, sub >> 2, sub & 3, r, L);
        else if (typ == 1) fa_stick_unit(p, l, sub >> 2, sub & 3, r, L);
        else if (typ == 2) fa_fox_unit(p, l, sub >> 2, sub & 3, r, L);
        else fa_nsa_unit(p, l, sub >> 2, 4 * r + (sub & 3), L);
    }
}

#define XB_TMO      128
#define XB_XCNT(j)  (256  + 64 * (j))
#define XB_XSUB(j)  (1280 + 64 * (j))
#define XB_XGEN(j)  (2304 + 64 * (j))
#define XB_TOP      3328
#define XB_TOPGEN   3392
#define XCD_BAR_WORDS 3456
#define XB_SPIN_CAP (1u << 18)

__device__ __forceinline__ unsigned xb_ld(unsigned* p)              { return __hip_atomic_load(p, __ATOMIC_RELAXED, __HIP_MEMORY_SCOPE_AGENT); }
__device__ __forceinline__ unsigned xb_add(unsigned* p, unsigned v) { return __hip_atomic_fetch_add(p, v, __ATOMIC_RELAXED, __HIP_MEMORY_SCOPE_AGENT); }
__device__ __forceinline__ unsigned xb_xcc_id() { return (unsigned)__builtin_amdgcn_s_getreg((3 << 11) | 20) & 0xFu; }
#define XB_SPIN(cond, bar) do { unsigned _sp = 0; while (cond) { __builtin_amdgcn_s_sleep(1); \
    if ((++_sp & 255u) == 0u) { if (xb_ld(&(bar)[XB_TMO])) break; if (_sp > XB_SPIN_CAP) { atomicAdd(&(bar)[XB_TMO], 1u); break; } } } } while (0)

struct XcdBarrier {
    unsigned* bar; unsigned x;
    volatile LDSF unsigned* st;
};

__device__ __forceinline__ XcdBarrier xcd_barrier_post(unsigned* bar, volatile LDSF unsigned* st) {
    XcdBarrier b; b.bar = bar; b.x = xb_xcc_id(); b.st = st;
    if (threadIdx.x == 0) (void)xb_add(&bar[XB_XCNT(b.x)], 1u);
    return b;
}
__device__ __forceinline__ void xcd_barrier_complete(unsigned* bar, unsigned x, unsigned& nloc, unsigned& nx) {
    const unsigned G = gridDim.x * gridDim.y * gridDim.z;
    unsigned sum, cnt, mine, sp = 0u;
    for (;;) {
        sum = 0u; cnt = 0u; mine = 0u;
#pragma unroll
        for (unsigned j = 0; j < 16; ++j) { const unsigned c = xb_ld(&bar[XB_XCNT(j)]); sum += c; cnt += (c > 0u) ? 1u : 0u; mine = (j == x) ? c : mine; }
        if (sum == G) break;
        __builtin_amdgcn_s_sleep(1);
        if ((++sp & 255u) == 0u) { if (xb_ld(&bar[XB_TMO])) break; if (sp > XB_SPIN_CAP) { atomicAdd(&bar[XB_TMO], 1u); break; } }
    }
    nloc = mine > 0u ? mine : 1u; nx = cnt > 0u ? cnt : 1u;
}

__device__ __forceinline__ void xcd_barrier(const XcdBarrier& b) {
    asm volatile("s_waitcnt vmcnt(0)" ::: "memory");
    __syncthreads();
    if (threadIdx.x == 0) {
        unsigned* bar = b.bar;
        __builtin_amdgcn_s_waitcnt(0);
        unsigned nloc = b.st[0], nx = b.st[1];
        if (nloc == 0u) { xcd_barrier_complete(bar, b.x, nloc, nx); b.st[0] = nloc; b.st[1] = nx; }
        const unsigned old = xb_add(&bar[XB_XSUB(b.x)], 1u);
        const unsigned gen = old / nloc;
        if (old + 1u == (gen + 1u) * nloc) {
            __builtin_amdgcn_fence(__ATOMIC_RELEASE, "agent");
            asm volatile("s_waitcnt vmcnt(0)" ::: "memory");
            const unsigned og = xb_add(&bar[XB_TOP], 1u);
            const unsigned tg = og / nx;
            if (og + 1u == (tg + 1u) * nx) xb_add(&bar[XB_TOPGEN], 1u);
            else XB_SPIN(xb_ld(&bar[XB_TOPGEN]) == tg, bar);
            __builtin_amdgcn_fence(__ATOMIC_ACQUIRE, "agent");
            xb_add(&bar[XB_XGEN(b.x)], 1u);
            asm volatile("s_waitcnt vmcnt(0)" ::: "memory");
        } else {
            XB_SPIN(xb_ld(&bar[XB_XGEN(b.x)]) == gen, bar);
            __builtin_amdgcn_fence(__ATOMIC_ACQUIRE, "agent");
            asm volatile("s_waitcnt vmcnt(0)" ::: "memory");
        }
    }
    __syncthreads();
}

namespace cg = cooperative_groups;
constexpr int LDS_BYTES = 131072 + 8192 + 4096 + 1024;
#define LAS3 __attribute__((address_space(3)))
#ifndef PROBE
#define PROBE 0
#endif
__global__ void __launch_bounds__(NTHR, 2) mega(Params p) {
    extern __shared__ __attribute__((aligned(16))) unsigned char lds[];
    cg::grid_group grid = cg::this_grid();
#if PROBE
    unsigned long long tacc = 0, tph = 0, t0_;
#define GSYNC() do { t0_ = __builtin_amdgcn_s_memrealtime(); xcd_barrier(xbar); tacc += __builtin_amdgcn_s_memrealtime() - t0_; } while (0)
#define TPK(k, ...) do { if (PROBE == (k)) { t0_ = __builtin_amdgcn_s_memrealtime(); __VA_ARGS__; tph += __builtin_amdgcn_s_memrealtime() - t0_; } else { __VA_ARGS__; } } while (0)
#else
#define GSYNC() xcd_barrier(xbar)
#define TPK(k, ...) do { __VA_ARGS__; } while (0)
#endif
    LAS3 unsigned char* lds3 = (LAS3 unsigned char*)lds;
    volatile LDSF unsigned* bst = (volatile LDSF unsigned*)(lds3 + 131072 + 2048);
    if (threadIdx.x < 2) bst[threadIdx.x] = 0u;
    __syncthreads();
    XcdBarrier xbar = xcd_barrier_post((unsigned*)(p.ws + WS_CTL) + 16384, bst);
    TPK(2, ph_mod(p, lds); ph_reset_queues(p); ph_weights(p, 0, lds));
    grid.sync();
    for (int l = 0; l < DEPTH; ++l) {
        const float* mod = (const float*)(p.ws + WS_MOD) + (size_t)l * 4 * 6144;
        TPK(2, if (l == 0) ph_xa_from(p, p.x, 0, 0, (bf16_t*)(p.ws + WS_XA), (float*)(p.ws + WS_RSA), true); ph_cbias(p, l, 1));
        GSYNC();
        {   pg8::Gemm g{(const bf16_t*)(p.ws + WS_XA), (const bf16_t*)(p.ws + WS_WIN + l * WS_W1OFF), MTOK, PINP, DM}; pg8::StaticOrder S; S.init(MTOK, PINP, (int)gridDim.x, (int)blockIdx.x);
            EpiProjF E{(const float*)(p.ws + WS_RSA), (const float*)(p.ws + WS_CBIN) + (size_t)l * 4 * PINP, (bf16_t*)(p.ws + WS_PROJ), (float*)(p.ws + WS_SIDE),
                       p.diff_kn + l * 32, p.fox_kn + l * 64, p.nsa_kn + (l * 3 + 1) * 64, p.nsa_kn + (l * 3 + 2) * 64, (LDSF float*)(lds3 + 131072 + 4096), (LDSF float*)(lds3 + 131072 + 12288)};
            TPK(6, pg8::gemm_phase<EpiProjF, pg8::StaticOrder, true, PG8_SP2>(lds3, g, S, E)); }
        GSYNC();
        TPK(7, fa_phase_all(p, l, lds3, lds, l, (l + 1 < DEPTH) ? CV_ITEMS / 8 : 0));
        GSYNC();
        {   pg8::Gemm g{(const bf16_t*)p.out, (const bf16_t*)(p.ws + WS_WOUT + l * WS_W1OFF), MTOK, DM, DM}; pg8::StaticOrder S; S.init(MTOK, DM, (int)gridDim.x, (int)blockIdx.x);
            EpiResF E{nullptr, (bf16_t*)(p.ws + WS_XR), mod + 2048, p.norm_ffn_g + l * DM, mod + 4096, (bf16_t*)(p.ws + WS_XA), (float*)(p.ws + WS_RSB)};
            TPK(6, pg8::gemm_phase<EpiResF, pg8::StaticOrder, PG8_ALIGN, PG8_SP2>(lds3, g, S, E)); }
        GSYNC();
        {   pg8::Gemm g{(const bf16_t*)(p.ws + WS_XA), (const bf16_t*)(p.ws + WS_WUP + l * WS_W1OFF), MTOK, NUP, DM}; pg8::StaticOrder S; S.init(MTOK, NUP, (int)gridDim.x, (int)blockIdx.x);
            EpiUpAct E{(const float*)(p.ws + WS_RSB), (const float*)(p.ws + WS_CBUP) + (size_t)l * 4 * NUP, (bf16_t*)(p.ws + WS_ACT), (float*)(p.ws + WS_EG), (float*)(p.ws + WS_EV),
                       p.conv_w + (size_t)l * 3 * DFF, p.conv_b + (size_t)l * DFF, (LDSF float*)(lds3 + 131072 + 4096), (LDSF float*)(lds3 + 131072 + 8192)};
            TPK(6, pg8::gemm_phase<EpiUpAct, pg8::StaticOrder, true, PG8_SP2>(lds3, g, S, E)); }
        GSYNC();
        {   const float* modn = (const float*)(p.ws + WS_MOD) + (size_t)(l + 1) * 4 * 6144; const bool more = (l + 1 < DEPTH);
            pg8::Gemm g{(const bf16_t*)(p.ws + WS_ACT), (const bf16_t*)(p.ws + WS_WDN + l * WS_W1OFF), MTOK, DM, DFF}; pg8::StaticOrder S; S.init(MTOK, DM, (int)gridDim.x, (int)blockIdx.x);
            { pg8::Unit fu; for (int i = 0; S.next(i, fu); ++i) act_fixup(p, l, fu.pm); }
            __builtin_amdgcn_fence(__ATOMIC_RELEASE, "agent"); __builtin_amdgcn_fence(__ATOMIC_ACQUIRE, "agent"); __syncthreads();
            EpiResF E{more ? nullptr : p.out, (bf16_t*)(p.ws + WS_XR), mod + 5120, p.norm_mix_g + (more ? l + 1 : l) * DM, more ? modn + 1024 : mod + 1024, more ? (bf16_t*)(p.ws + WS_XA) : nullptr, more ? (float*)(p.ws + WS_RSA) : nullptr};
            TPK(6, pg8::gemm_phase<EpiResF, pg8::StaticOrder, PG8_ALIGN, PG8_SP2>(lds3, g, S, E)); }
    }
#if PROBE == 1
    if (blockIdx.x == 0 && threadIdx.x == 0) p.out[0] += 0.05f + (float)tacc * 0.01f * 5e-4f;
#elif PROBE >= 2
    if (blockIdx.x == 0 && threadIdx.x == 0) p.out[0] += 0.05f + (float)tph * 0.01f * 1e-4f;
#endif
}

extern "C" void kernel_launch(void* const* d_in, const int* in_sizes, int in, void* d_out, int out_size, void* d_ws, size_t ws_size, hipStream_t stream) {
    if (in != 24 || ws_size < WS_END || out_size != MTOK * DM) { fprintf(stderr, "kernel_launch: unexpected sizes (in %d, ws %zu, out %d)\n", in, ws_size, out_size); return; }
    static int grid_blocks = 0;
    if (!grid_blocks) {
        int dev = 0, cus = 0, per_cu = 0;
        hipGetDevice(&dev);
        hipDeviceGetAttribute(&cus, hipDeviceAttributeMultiprocessorCount, dev);
        hipFuncSetAttribute((const void*)mega, hipFuncAttributeMaxDynamicSharedMemorySize, LDS_BYTES);
        hipOccupancyMaxActiveBlocksPerMultiprocessor(&per_cu, (const void*)mega, NTHR, LDS_BYTES);
        if (per_cu < 1) { fprintf(stderr, "kernel_launch: occupancy query returned %d\n", per_cu); per_cu = 1; }
        if (per_cu > 1) per_cu = 1;
        grid_blocks = cus * per_cu;
        fprintf(stderr, "kernel_launch: cus %d per_cu %d grid %d\n", cus, per_cu, grid_blocks);
    }
    if (hipMemsetAsync((char*)d_ws + WS_CTL + 65536, 0, XCD_BAR_WORDS * 4, stream) != hipSuccess) { fprintf(stderr, "kernel_launch: memset failed\n"); return; }
    Params p{};
    const float** f = (const float**)&p;
    for (int i = 0; i < 24; ++i) f[i] = (const float*)d_in[i];
    p.out = (float*)d_out; p.ws = (unsigned char*)d_ws;
    void* args[] = {&p};
    hipError_t e = hipLaunchCooperativeKernel((const void*)mega, dim3(grid_blocks), dim3(NTHR), args, LDS_BYTES, stream);
    if (e != hipSuccess) fprintf(stderr, "cooperative launch failed: %s (grid %d)\n", hipGetErrorString(e), grid_blocks);
}
```

```cpp
#include <hip/hip_runtime.h>
#include <hip/hip_cooperative_groups.h>
#include <cstdint>
#include <cstdio>

typedef unsigned short bf16_t;
typedef short bf16x8 __attribute__((ext_vector_type(8)));
typedef float f32x4 __attribute__((ext_vector_type(4)));
typedef unsigned u32x4 __attribute__((ext_vector_type(4)));

constexpr int NB = 4, SEQ = 4096, DM = 1024, MTOK = NB * SEQ, DEPTH = 2;
constexpr int HD = 64, HPM = 4, DFF = 2816, PIN = 2960, PINP = 3072, NUP = 2 * DFF;
constexpr float EPS = 1e-6f;
constexpr float LOG2E = 1.4426950408889634f;
constexpr int NTHR = 512;

constexpr int CA_Q = 0, CA_K = 256, CA_V = 512, CB_Q = 768, CB_K = 1024, CB_V = 1280, CC_Q = 1536, CC_K = 1792, CC_V = 2048;
constexpr int CD_Q = 2304, CD_KC = 2560, CD_VC = 2624, CD_KS = 2688, CD_VS = 2752, CD_KW = 2816, CD_VW = 2880, C_BF = 2944, C_DG = 2948;

constexpr size_t MiB = 1u << 20;
constexpr size_t WS_CTL = 0;
constexpr size_t WS_MOD = 1 * MiB;
constexpr size_t WS_CBIN = WS_MOD + 2 * 4 * 6144 * 4;
constexpr size_t WS_CBUP = WS_CBIN + 2 * 4 * 3072 * 4;
constexpr size_t WS_TB = WS_CBUP + 2 * 4 * 5632 * 4;
constexpr size_t WS_LAM = WS_TB + 2 * 4 * 128 * 4;
constexpr size_t WS_BND = WS_LAM + 64;
constexpr size_t WS_CUM = WS_LAM + 512;
constexpr size_t WS_KC = WS_CUM + 16 * 4096 * 4;
constexpr size_t WS_VC = WS_KC + 4 * 256 * 64 * 2;
constexpr size_t WS_SELM = WS_VC + 4 * 256 * 64 * 2;
constexpr size_t WS_SMALL_END = WS_SELM + 16384 * 8;
static_assert(WS_SMALL_END <= 4 * MiB, "small region");
constexpr size_t WS_RSA = 4 * MiB;
constexpr size_t WS_RSB = 5 * MiB;
constexpr size_t WS_SIDE = 6 * MiB;
constexpr size_t WS_IMP = 7 * MiB;
constexpr size_t WS_ML = 11 * MiB;
constexpr size_t WS_PHIT = 7 * MiB;
constexpr size_t WS_W = 12 * MiB;
constexpr size_t WS_WIN = WS_W;
constexpr size_t WS_WOUT = WS_WIN + (size_t)PINP * DM * 2;
constexpr size_t WS_WUP = WS_WOUT + (size_t)DM * DM * 2;
constexpr size_t WS_WDN = WS_WUP + (size_t)NUP * DM * 2;
constexpr size_t WS_W_END = WS_WDN + (size_t)DM * DFF * 2;
static_assert(WS_W_END <= 38 * MiB, "weights region");
constexpr size_t WS_XA = 38 * MiB;
constexpr size_t WS_BIG = 70 * MiB;
constexpr size_t WS_PROJ = WS_BIG;
constexpr size_t WS_XR = WS_BIG + 96 * MiB;
constexpr size_t WS_ACT = WS_BIG;
constexpr size_t WS_W1OFF = 188 * MiB;
constexpr size_t WS_EG = 228 * MiB;
constexpr size_t WS_EV = 232 * MiB;
constexpr size_t WS_END = 236 * MiB;
static_assert(WS_W_END + WS_W1OFF <= WS_EG && WS_XR + 32 * MiB <= WS_W + WS_W1OFF, "layer-1 weights");
static_assert(WS_END <= 256 * MiB, "workspace");

struct Params {
    const float *x, *c, *rel_bias, *ada_w, *ada_b, *norm_mix_g, *norm_ffn_g, *w_in, *w_out;
    const float *diff_qn, *diff_kn, *diff_lam, *diff_sub, *fox_qn, *fox_kn, *fox_bf;
    const float *nsa_qn, *nsa_kn, *nsa_pe, *nsa_phi, *w_up, *conv_w, *conv_b, *w_down;
    float* out;
    unsigned char* ws;
};

__device__ __forceinline__ float bf2f(bf16_t v) { return __uint_as_float(((unsigned)v) << 16); }
__device__ __forceinline__ bf16_t f2bf(float f) { unsigned u = __float_as_uint(f); return (bf16_t)((u + 0x7fffu + ((u >> 16) & 1u)) >> 16); }
__device__ __forceinline__ unsigned pk2(float lo, float hi) { return (unsigned)f2bf(lo) | ((unsigned)f2bf(hi) << 16); }
__device__ __forceinline__ float siluf(float v) { return v / (1.f + __expf(-v)); }
__device__ __forceinline__ float logsigf(float v) { return fminf(v, 0.f) - log1pf(__expf(-fabsf(v))); }
__device__ __forceinline__ float wave_sum(float v) {
#pragma unroll
    for (int o = 1; o < 64; o <<= 1) v += __shfl_xor(v, o);
    return v;
}
__device__ __forceinline__ int t5_bucket(int n) {
    if (n < 16) return n < 0 ? 0 : n;
    return 16 + (n >= 19) + (n >= 21) + (n >= 24) + (n >= 27) + (n >= 31) + (n >= 35) + (n >= 40) + (n >= 46) + (n >= 52) + (n >= 59) + (n >= 67) + (n >= 77) + (n >= 87) + (n >= 99) + (n >= 113);
}
__host__ __device__ __forceinline__ int in_col_map(int n) {
    if (n < 1536) return n;
    if (n < 2944) return n + 4;
    if (n < 2948) return 1536 + (n - 2944);
    if (n < 2960) return n;
    return -1;
}
__host__ __device__ __forceinline__ int up_col_map(int n) {
    const int pn = n >> 8, c = n & 255;
    return c < 128 ? (128 * pn + c) : (DFF + 128 * pn + (c - 128));
}

__device__ __forceinline__ int opaque_v(int v) { asm volatile("" : "+v"(v)); return v; }
#define TID() opaque_v((int)threadIdx.x)
#define GTID() ((int)(blockIdx.x * blockDim.x) + TID())
#define GSIZE() ((int)(gridDim.x * blockDim.x))

__device__ __forceinline__ void load8(const bf16_t* p, float* d) {
    const u32x4 r = *(const u32x4*)p;
    d[0] = bf2f(r[0] & 0xffff); d[1] = bf2f(r[0] >> 16); d[2] = bf2f(r[1] & 0xffff); d[3] = bf2f(r[1] >> 16);
    d[4] = bf2f(r[2] & 0xffff); d[5] = bf2f(r[2] >> 16); d[6] = bf2f(r[3] & 0xffff); d[7] = bf2f(r[3] >> 16);
}
#define LDSF __attribute__((address_space(3)))
__device__ __forceinline__ void gemv4_block(const float* W, int ld, int oc, const LDSF float* vec, LDSF float* red, float* out0, int ostride, int n, float bias, int tid) {
    const int lane = tid & 63, wv = tid >> 6;
    float a0 = 0.f, a1 = 0.f, a2 = 0.f, a3 = 0.f;
    if (oc >= 0) {
        const float* w = W + (size_t)(wv * 128) * ld + oc;
#pragma unroll 32
        for (int k = 0; k < 128; ++k) { const float wk = w[(size_t)k * ld]; const f32x4 v = *(const LDSF f32x4*)(vec + (wv * 128 + k) * 4); a0 += v[0] * wk; a1 += v[1] * wk; a2 += v[2] * wk; a3 += v[3] * wk; }
    }
    red[(wv * 4 + 0) * 64 + lane] = a0; red[(wv * 4 + 1) * 64 + lane] = a1; red[(wv * 4 + 2) * 64 + lane] = a2; red[(wv * 4 + 3) * 64 + lane] = a3;
    __syncthreads();
    if (tid < 256) { const int bt = tid >> 6; float sacc = 0.f;
#pragma unroll
        for (int w8 = 0; w8 < 8; ++w8) sacc += red[(w8 * 4 + bt) * 64 + lane];
        out0[(size_t)bt * ostride + n] = sacc + bias; }
    __syncthreads();
}
__device__ void ph_mod(const Params& p, unsigned char* lds) {
    float* mod = (float*)(p.ws + WS_MOD);
    float* tb = (float*)(p.ws + WS_TB);
    float* lamv = (float*)(p.ws + WS_LAM);
    LDSF float* vec = (LDSF float*)lds; LDSF float* red = (LDSF float*)(lds + 16384);
    const int tid = TID();
    bool loaded = false;
    for (int item = blockIdx.x; item < DEPTH * 96; item += gridDim.x) {
        if (!loaded) { for (int i = tid; i < 4096; i += NTHR) { const int bt = i >> 10, k = i & 1023; vec[k * 4 + bt] = siluf(p.c[bt * DM + k]); } __syncthreads(); loaded = true; }
        const int l = item / 96, n = (item % 96) * 64 + (tid & 63);
        gemv4_block(p.ada_w + (size_t)l * DM * 6144, 6144, n, vec, red, mod + (size_t)l * 4 * 6144, 6144, n, p.ada_b[l * 6144 + n], tid);
    }
    const int gt = GTID(), gs = GSIZE();
    for (int idx = gt; idx < 2 * 4 * 128; idx += gs) {
        const int type = idx / 512, h = (idx / 128) & 3, d = idx & 127;
        tb[idx] = p.rel_bias[t5_bucket(d) * 8 + type * 4 + h];
    }
    for (int idx = gt; idx < DEPTH * 32; idx += gs) {
        const int l = idx >> 5, e = idx & 31; float v = 0.f;
        if (e < 17) {
            const int type = (e < 5) ? 0 : 1, h = (e < 4) ? e : ((e == 4) ? 0 : ((e - 5) & 3));
            const int ng = (e < 4) ? 32 : 64;
            const float* gq = (e < 4) ? p.diff_qn + l * 32 : ((e == 4) ? p.fox_qn + l * 64 : p.nsa_qn + l * 64);
            const float* gk = (e < 4) ? p.diff_kn + l * 32 : ((e == 4) ? p.fox_kn + l * 64 : p.nsa_kn + (l * 3 + (e - 5) / 4) * 64);
            float mq = 0.f, mk = 0.f; for (int i = 0; i < ng; ++i) { mq = fmaxf(mq, fabsf(gq[i])); mk = fmaxf(mk, fabsf(gk[i])); }
            float tm = 0.f; if (e != 4) { tm = -INFINITY; for (int bk2 = 0; bk2 < 32; ++bk2) tm = fmaxf(tm, p.rel_bias[bk2 * 8 + type * 4 + h]); }
            v = sqrtf((float)ng) * mq * mk * 1.02f * LOG2E + tm * LOG2E;
        }
        ((float*)(p.ws + WS_BND))[idx] = v;
    }
    for (int idx = gt; idx < DEPTH; idx += gs) {
        const float* lv = p.diff_lam + idx * 4 * 32;
        float s1 = 0.f, s2 = 0.f;
        for (int i = 0; i < 32; ++i) { s1 += lv[i] * lv[32 + i]; s2 += lv[64 + i] * lv[96 + i]; }
        const float lam_init = 0.8f - 0.6f * expf(-0.3f * (float)idx);
        lamv[idx] = expf(s1) - expf(s2) + lam_init;
    }
}
__device__ void ph_cbias(const Params& p, int lfirst, int lcount) {
    const float* mod = (const float*)(p.ws + WS_MOD);
    const int tid_ = TID(); const int lane = tid_ & 63, wv = tid_ >> 6;
    const int gw = blockIdx.x * (NTHR >> 6) + wv, ngw = gridDim.x * (NTHR >> 6);
    constexpr int NCOL = PINP + NUP;
    const int per = (lcount * NCOL + ngw - 1) / ngw; const int c0 = gw * per, c1 = min(lcount * NCOL, c0 + per);
    int cur_key = -1; float sh[4][16];
    for (int c = c0; c < c1; ++c) {
        const int l = lfirst + c / NCOL, r = c % NCOL; const bool isin = r < PINP; const int n = isin ? r : r - PINP; const int key = l * 2 + (isin ? 0 : 1);
        if (key != cur_key) { cur_key = key; const int shoff = isin ? 0 : 3072;
#pragma unroll
            for (int bt = 0; bt < 4; ++bt)
#pragma unroll
                for (int q4 = 0; q4 < 4; ++q4) { const f32x4 v = *(const f32x4*)(mod + (size_t)(l * 4 + bt) * 6144 + shoff + 16 * lane + 4 * q4); sh[bt][4 * q4] = v[0]; sh[bt][4 * q4 + 1] = v[1]; sh[bt][4 * q4 + 2] = v[2]; sh[bt][4 * q4 + 3] = v[3]; } }
        const bf16_t* wrow = (const bf16_t*)(p.ws + (isin ? WS_WIN : WS_WUP) + l * WS_W1OFF) + (size_t)n * DM + 16 * lane;
        float w[16]; load8(wrow, w); load8(wrow + 8, w + 8);
        float a0 = 0.f, a1 = 0.f, a2 = 0.f, a3 = 0.f;
#pragma unroll
        for (int j = 0; j < 16; ++j) { a0 += sh[0][j] * w[j]; a1 += sh[1][j] * w[j]; a2 += sh[2][j] * w[j]; a3 += sh[3][j] * w[j]; }
        a0 = wave_sum(a0); a1 = wave_sum(a1); a2 = wave_sum(a2); a3 = wave_sum(a3);
        if (lane == 0) { float* o = isin ? (float*)(p.ws + WS_CBIN) + (size_t)l * 4 * PINP : (float*)(p.ws + WS_CBUP) + (size_t)l * 4 * NUP; const int ld = isin ? PINP : NUP;
            o[n] = a0; o[ld + n] = a1; o[2 * ld + n] = a2; o[3 * ld + n] = a3; }
    }
}
template <int MAPK>
__device__ __forceinline__ void convert_one(const float* W, int K, int Nsrc, int Npad, bf16_t* Wt, LDSF float* scr, int it, int lane) {
    const int nnb = Npad / 64;
    const int kb = it / nnb, nb = it % nnb, k0 = kb * 64, n0 = nb * 64;
    {
        const int n = n0 + lane;
        const int oc = MAPK == 0 ? n : (MAPK == 1 ? in_col_map(n) : up_col_map(n));
        const float* wp = W + (size_t)k0 * Nsrc + (oc >= 0 ? oc : 0);
#pragma unroll 1
        for (int hh = 0; hh < 2; ++hh) {
            float tv[32];
#pragma unroll
            for (int i = 0; i < 32; ++i) tv[i] = wp[(size_t)(32 * hh + i) * Nsrc];
#pragma unroll
            for (int i = 0; i < 32; ++i) scr[(32 * hh + i) * 65 + lane] = (oc >= 0) ? tv[i] : 0.f;
        }
    }
    __builtin_amdgcn_s_waitcnt(0xc07f); __builtin_amdgcn_wave_barrier();
    {
        const int c = lane & 7;
#pragma unroll
        for (int j = 0; j < 8; ++j) { const int nn = 8 * j + (lane >> 3); const LDSF float* sp = scr + (8 * c) * 65 + nn;
            u32x4 o; o[0] = pk2(sp[0], sp[65]); o[1] = pk2(sp[130], sp[195]); o[2] = pk2(sp[260], sp[325]); o[3] = pk2(sp[390], sp[455]);
            *(u32x4*)(Wt + (size_t)(n0 + nn) * K + k0 + 8 * c) = o; }
    }
    __builtin_amdgcn_s_waitcnt(0xc07f); __builtin_amdgcn_wave_barrier();
}
constexpr int CV_IN = 16 * (PINP / 64), CV_OUT = 16 * (DM / 64), CV_UP = 16 * (NUP / 64), CV_DN = (DFF / 64) * (DM / 64), CV_PHI = 32, CV_ITEMS = CV_IN + CV_OUT + CV_UP + CV_DN + 2 * CV_PHI;
static_assert(CV_ITEMS == 3200, "conversion item count");
__device__ void convert_item(const Params& p, int l, int idx, LDSF float* scr, int lane) {
    if (idx < CV_IN) { convert_one<1>(p.w_in + (size_t)l * DM * PIN, DM, PIN, PINP, (bf16_t*)(p.ws + WS_WIN + l * WS_W1OFF), scr, idx, lane); return; } idx -= CV_IN;
    if (idx < CV_OUT) { convert_one<0>(p.w_out + (size_t)l * DM * DM, DM, DM, DM, (bf16_t*)(p.ws + WS_WOUT + l * WS_W1OFF), scr, idx, lane); return; } idx -= CV_OUT;
    if (idx < CV_UP) { convert_one<2>(p.w_up + (size_t)l * DM * NUP, DM, NUP, NUP, (bf16_t*)(p.ws + WS_WUP + l * WS_W1OFF), scr, idx, lane); return; } idx -= CV_UP;
    if (idx < CV_DN) { convert_one<0>(p.w_down + (size_t)l * DFF * DM, DFF, DM, DM, (bf16_t*)(p.ws + WS_WDN + l * WS_W1OFF), scr, idx, lane); return; } idx -= CV_DN;
    const int w2 = idx / CV_PHI; idx -= w2 * CV_PHI;
    convert_one<0>(p.nsa_phi + (size_t)(l * 2 + w2) * 2048 * 64, 2048, 64, 64, (bf16_t*)(p.ws + WS_PHIT) + (size_t)(l * 2 + w2) * 64 * 2048, scr, idx, lane);
}
__device__ void ph_weights(const Params& p, int l, unsigned char* lds) {
    const int tid_ = TID(); const int lane = tid_ & 63, wv = tid_ >> 6;
    const int ngw = gridDim.x * (NTHR >> 6), gw = ngw - 1 - (blockIdx.x * (NTHR >> 6) + wv);
    LDSF float* scr = (LDSF float*)lds + wv * (64 * 65);
    for (int it = gw; it < CV_ITEMS; it += ngw) convert_item(p, l, it, scr, lane);
}
__device__ void ph_xa_from(const Params& p, const float* src, int l, int which  , bf16_t* XA, float* rowss, bool write_xa) {
    const float* mod = (const float*)(p.ws + WS_MOD);
    const float* g = (which == 0 ? p.norm_mix_g : p.norm_ffn_g) + l * DM;
    const int tid_ = TID(); const int lane = tid_ & 63, wv = tid_ >> 6;
    const int gw = blockIdx.x * (blockDim.x >> 6) + wv, ngw = gridDim.x * (blockDim.x >> 6);
    for (int row0 = gw; row0 < MTOK; row0 += 2 * ngw) {
        f32x4 v[2][4];
#pragma unroll
        for (int rr = 0; rr < 2; ++rr) { const int row = min(row0 + rr * ngw, MTOK - 1);
#pragma unroll
            for (int j = 0; j < 4; ++j) v[rr][j] = *(const f32x4*)(src + (size_t)row * DM + j * 256 + lane * 4); }
#pragma unroll
        for (int rr = 0; rr < 2; ++rr) {
            const int row = row0 + rr * ngw;
            if (row < MTOK) {
                const int b = row / SEQ; const float* sc = mod + (size_t)(l * 4 + b) * 6144 + (which == 0 ? 1024 : 4096);
                float ss = 0.f;
#pragma unroll
                for (int j = 0; j < 4; ++j) {
                    const int k = j * 256 + lane * 4; const f32x4 x = v[rr][j];
                    ss += x[0] * x[0] + x[1] * x[1] + x[2] * x[2] + x[3] * x[3];
                    if (write_xa) {
                        const f32x4 gv = *(const f32x4*)(g + k); const f32x4 sv = *(const f32x4*)(sc + k);
                        uint2 o; o.x = pk2(x[0] * gv[0] * (1.f + sv[0]), x[1] * gv[1] * (1.f + sv[1])); o.y = pk2(x[2] * gv[2] * (1.f + sv[2]), x[3] * gv[3] * (1.f + sv[3]));
                        *(uint2*)(XA + (size_t)row * DM + k) = o;
                        uint2 xo; xo.x = pk2(x[0], x[1]); xo.y = pk2(x[2], x[3]); *(uint2*)((bf16_t*)(p.ws + WS_XR) + (size_t)row * DM + k) = xo;
                    }
                }
                ss = wave_sum(ss);
                if (lane < 16) rowss[(size_t)row * 16 + lane] = (lane == 0) ? ss : 0.f;
            }
        }
    }
}

namespace pg8 {
#define PG8_LAS __attribute__((address_space(3)))
typedef unsigned short bf16_t;
typedef short bf16x8 __attribute__((ext_vector_type(8)));
typedef float f32x4 __attribute__((ext_vector_type(4)));
typedef unsigned u32x4 __attribute__((ext_vector_type(4)));
constexpr int BM = 256, BK = 64, HALF = 128, HTB = HALF * BK * 2  , STAGE_BYTES = 8 * HTB, NXCD = 8, WGM = 8;

__host__ __device__ __forceinline__ int lds_byte(int r, int c) { const int st = (r >> 4) * 2 + (c >> 5), rr = r & 15, cc = c & 31, ob = rr * 64 + cc * 2; return st * 1024 + (ob ^ (((ob >> 9) & 1) << 5)); }
__host__ __device__ __forceinline__ void stage_rc(int b, int& R, int& C) { const int st = b / 1024, sb = b % 1024, swz = sb ^ (((sb >> 9) & 1) << 5); R = (st >> 1) * 16 + swz / 64; C = (st & 1) * 32 + (swz % 64) / 2; }
__host__ __device__ __forceinline__ int perm32(int rho) { const int n = rho >> 4, i = rho & 15; return 8 * (i >> 2) + 4 * n + (i & 3); }

struct Unit { int pm, pn; };
struct Gemm { const bf16_t* A; const bf16_t* Bt; int M, N, K; };

struct StaticOrder {
    int nM, nN, nwg, G, c;
    __host__ __device__ void init(int M, int N, int G_, int c_) { nM = M / BM; nN = N / BM; nwg = nM * nN; G = G_; c = c_; }
    __host__ __device__ bool next(int i, Unit& u) const {
        const long L = (long)i * G + c; if (L >= nwg) return false;
        int wgid = (int)L; { const int q = nwg / NXCD, r = nwg % NXCD, xcd = wgid % NXCD, off = wgid / NXCD; wgid = (xcd < r ? xcd * (q + 1) : r * (q + 1) + (xcd - r) * q) + off; }
        const int nig = WGM * nN, gid = wgid / nig, fm = gid * WGM, gsz = (nM - fm) < WGM ? (nM - fm) : WGM;
        u.pm = fm + ((wgid % nig) % gsz); u.pn = (wgid % nig) / gsz; return true;
    }
    __device__ __forceinline__ void a_ready(const Unit&) const {}
    __device__ __forceinline__ void done(const Unit&) const {}
};


__device__ __forceinline__ unsigned cvt_pk_bf16(float lo, float hi) { unsigned r; asm volatile("v_cvt_pk_bf16_f32 %0, %1, %2" : "=v"(r) : "v"(lo), "v"(hi)); return r; }
template <class Epi, class Sched, bool ALIGN_EPI = false, bool SP2 = false, bool ABLK = false>
__device__ __forceinline__ void gemm_phase(PG8_LAS unsigned char* lds, const Gemm g, const Sched& S, const Epi& E) {
    const int tid = TID(), wid = __builtin_amdgcn_readfirstlane(tid >> 6), lane = tid & 63, wr = wid >> 2, wc = wid & 3, fr = lane & 15, fq = lane >> 4;
    const int K = g.K, nt = K / BK;
    unsigned voffA[2], voffB[2];
#pragma unroll
    for (int i = 0; i < 2; ++i) { int R, C; stage_rc(tid * 16 + i * 8192, R, C); const int Rb = Epi::PERM ? ((R & ~31) + perm32(R & 31)) : R;
        voffA[i] = (unsigned)(R * (ABLK ? BK : K) + C) * 2u; voffB[i] = (unsigned)(Rb * K + C) * 2u; }
    const size_t kstep = (size_t)(BK * 2), kstepA = ABLK ? (size_t)(BM * BK * 2) : kstep;
    const size_t hstep = (size_t)HALF * K * 2, hstepA = ABLK ? (size_t)(HALF * BK * 2) : hstep;
    const size_t tstep = (size_t)BM * K * 2;
    const unsigned ldsw = (unsigned)wid * 1024u;
    const int aoff = lds_byte(wr * 64 + fr, fq * 8), boff = lds_byte(wc * 32 + fr, fq * 8);
#define PG8_SA(b, h) (((b) * 2 + (h)) * HTB)
#define PG8_SB(b, h) ((4 + (b) * 2 + (h)) * HTB)
#define PG8_STAGE(bufoff, gbase, voff) do { _Pragma("unroll") for (int _i = 0; _i < 2; ++_i) \
        __builtin_amdgcn_global_load_lds((const unsigned*)((const char*)(gbase) + (voff)[_i]), (PG8_LAS unsigned*)(lds + (bufoff) + ldsw + _i * 8192), 16, 0, 0); } while (0)
#define PG8_LDA(dst, b, h) do { _Pragma("unroll") for (int m = 0; m < 4; ++m) _Pragma("unroll") for (int k = 0; k < 2; ++k) dst[m][k] = *(const PG8_LAS bf16x8*)(lds + PG8_SA(b, h) + aoff + m * 2048 + k * 1024); } while (0)
#define PG8_LDB(dst, b, h) do { _Pragma("unroll") for (int n = 0; n < 2; ++n) _Pragma("unroll") for (int k = 0; k < 2; ++k) dst[n][k] = *(const PG8_LAS bf16x8*)(lds + PG8_SB(b, h) + boff + n * 2048 + k * 1024); } while (0)
#define PG8_MMA(ai, bj, At, Bt) do { __builtin_amdgcn_s_setprio(1); _Pragma("unroll") for (int m = 0; m < 4; ++m) _Pragma("unroll") for (int n = 0; n < 2; ++n) _Pragma("unroll") for (int k = 0; k < 2; ++k) \
        acc[ai][bj][m][n] = __builtin_amdgcn_mfma_f32_16x16x32_bf16(Bt[n][k], At[m][k], acc[ai][bj][m][n], 0, 0, 0); __builtin_amdgcn_s_setprio(0); } while (0)
#define PG8_WAIT_V(n) asm volatile("s_waitcnt vmcnt(" #n ")" ::: "memory")
#define PG8_WAIT_L(n) asm volatile("s_waitcnt lgkmcnt(" #n ")" ::: "memory")
#define PG8_BAR __builtin_amdgcn_s_barrier()
#define PG8_SCHED __builtin_amdgcn_sched_barrier(0)
    Unit cur, nxt; int ui = 0;
    if (!S.next(0, cur)) return;
    f32x4 acc[2][2][4][2];
#pragma unroll
    for (int a = 0; a < 2; ++a)
#pragma unroll
        for (int b = 0; b < 2; ++b)
#pragma unroll
            for (int m = 0; m < 4; ++m)
#pragma unroll
                for (int n = 0; n < 2; ++n) acc[a][b][m][n] = (f32x4){0.f, 0.f, 0.f, 0.f};
    bf16x8 At[4][2], B0[2][2], B1[2][2];
    const char* cA = (const char*)g.A + (size_t)cur.pm * tstep; const char* cB = (const char*)g.Bt + (size_t)cur.pn * tstep;
    S.a_ready(cur);
    if constexpr (SP2) {
        PG8_STAGE(PG8_SB(0, 0), cB, voffB); PG8_STAGE(PG8_SB(0, 1), cB + hstep, voffB); PG8_STAGE(PG8_SA(0, 0), cA, voffA); PG8_STAGE(PG8_SA(0, 1), cA + hstepA, voffA);
        if (wr == 1) PG8_BAR;
        PG8_WAIT_V(2); PG8_BAR;
        PG8_STAGE(PG8_SB(1, 0), cB + kstep, voffB); PG8_STAGE(PG8_SA(1, 0), cA + kstepA, voffA); PG8_STAGE(PG8_SB(1, 1), cB + hstep + kstep, voffB);
        PG8_WAIT_V(6); PG8_BAR;
    } else {
        PG8_STAGE(PG8_SB(0, 0), cB, voffB); PG8_STAGE(PG8_SA(0, 0), cA, voffA); PG8_STAGE(PG8_SB(0, 1), cB + hstep, voffB); PG8_STAGE(PG8_SA(0, 1), cA + hstepA, voffA);
        if (wr == 1) PG8_BAR;
        PG8_WAIT_V(4); PG8_BAR;
        PG8_STAGE(PG8_SB(1, 0), cB + kstep, voffB); PG8_STAGE(PG8_SA(1, 0), cA + kstepA, voffA); PG8_STAGE(PG8_SB(1, 1), cB + hstep + kstep, voffB);
        PG8_WAIT_V(6); PG8_BAR;
    }
    for (;;) {
        const bool has_next = S.next(ui + 1, nxt);
        const char* nA = has_next ? (const char*)g.A + (size_t)nxt.pm * tstep : cA; const char* nB = has_next ? (const char*)g.Bt + (size_t)nxt.pn * tstep : cB;
        for (int t = 0; t < nt; t += 2) {
            const bool last = (t == nt - 2);
            const char* a1 = cA + (size_t)(t + 1) * kstepA;
            const char* a2 = last ? nA : cA + (size_t)(t + 2) * kstepA; const char* b2 = last ? nB : cB + (size_t)(t + 2) * kstep;
            const char* a3 = a2 + kstepA; const char* b3 = b2 + kstep;
            if (last && has_next) S.a_ready(nxt);
            if constexpr (SP2) {
            PG8_LDB(B0, 0, 0); PG8_LDB(B1, 0, 1); PG8_SCHED; PG8_LDA(At, 0, 0); PG8_STAGE(PG8_SA(1, 1), a1 + hstepA, voffA);
            PG8_WAIT_V(8); PG8_WAIT_L(0); PG8_BAR; PG8_MMA(0, 0, At, B0); PG8_MMA(0, 1, At, B1); PG8_BAR; PG8_SCHED;
            PG8_LDA(At, 0, 1); PG8_STAGE(PG8_SB(0, 0), b2, voffB); PG8_STAGE(PG8_SB(0, 1), b2 + hstep, voffB); PG8_STAGE(PG8_SA(0, 0), a2, voffA);
            PG8_WAIT_V(8); PG8_WAIT_L(0); PG8_BAR; PG8_MMA(1, 0, At, B0); PG8_MMA(1, 1, At, B1); PG8_BAR; PG8_SCHED;
            PG8_LDB(B0, 1, 0); PG8_LDB(B1, 1, 1); PG8_SCHED; PG8_LDA(At, 1, 0); PG8_STAGE(PG8_SA(0, 1), a2 + hstepA, voffA);
            PG8_WAIT_V(8); PG8_WAIT_L(0); PG8_BAR; PG8_MMA(0, 0, At, B0); PG8_MMA(0, 1, At, B1); PG8_BAR; PG8_SCHED;
            PG8_LDA(At, 1, 1); PG8_STAGE(PG8_SB(1, 0), b3, voffB); PG8_STAGE(PG8_SB(1, 1), b3 + hstep, voffB); PG8_STAGE(PG8_SA(1, 0), a3, voffA);
            PG8_WAIT_V(8); PG8_WAIT_L(0); PG8_BAR; PG8_MMA(1, 0, At, B0); PG8_MMA(1, 1, At, B1); PG8_BAR; PG8_SCHED;
            } else {
            PG8_LDB(B0, 0, 0); PG8_SCHED; PG8_LDA(At, 0, 0); PG8_STAGE(PG8_SA(1, 1), a1 + hstepA, voffA);
            PG8_WAIT_L(8); PG8_BAR; PG8_WAIT_L(0); PG8_MMA(0, 0, At, B0); PG8_BAR; PG8_SCHED;
            PG8_LDB(B1, 0, 1); PG8_STAGE(PG8_SB(0, 0), b2, voffB);
            PG8_BAR; PG8_WAIT_L(0); PG8_MMA(0, 1, At, B1); PG8_BAR;
            PG8_LDA(At, 0, 1); PG8_STAGE(PG8_SA(0, 0), a2, voffA);
            PG8_BAR; PG8_WAIT_L(0); PG8_MMA(1, 0, At, B0); PG8_BAR; PG8_SCHED;
            PG8_STAGE(PG8_SB(0, 1), b2 + hstep, voffB);
            PG8_WAIT_V(6); PG8_BAR; PG8_MMA(1, 1, At, B1); PG8_BAR;
            PG8_LDB(B0, 1, 0); PG8_SCHED; PG8_LDA(At, 1, 0); PG8_STAGE(PG8_SA(0, 1), a2 + hstepA, voffA);
            PG8_WAIT_L(8); PG8_BAR; PG8_WAIT_L(0); PG8_MMA(0, 0, At, B0); PG8_BAR; PG8_SCHED;
            PG8_LDB(B1, 1, 1); PG8_STAGE(PG8_SB(1, 0), b3, voffB);
            PG8_BAR; PG8_WAIT_L(0); PG8_MMA(0, 1, At, B1); PG8_BAR;
            PG8_LDA(At, 1, 1); PG8_STAGE(PG8_SA(1, 0), a3, voffA);
            PG8_BAR; PG8_WAIT_L(0); PG8_MMA(1, 0, At, B0); PG8_BAR; PG8_SCHED;
            PG8_STAGE(PG8_SB(1, 1), b3 + hstep, voffB);
            PG8_WAIT_V(6); PG8_BAR; PG8_MMA(1, 1, At, B1); PG8_BAR;
            }
        }
        if constexpr (ALIGN_EPI) { if (wr == 0) PG8_BAR; }
        if constexpr (!Epi::AFTER_DRAIN) { E(acc, cur, wr, wc, fr, fq); S.done(cur); }
        if (!has_next) break;
#pragma unroll
        for (int a = 0; a < 2; ++a)
#pragma unroll
            for (int b = 0; b < 2; ++b)
#pragma unroll
                for (int m = 0; m < 4; ++m)
#pragma unroll
                    for (int n = 0; n < 2; ++n) acc[a][b][m][n] = (f32x4){0.f, 0.f, 0.f, 0.f};
        cur = nxt; cA = nA; cB = nB; ++ui;
        if constexpr (ALIGN_EPI) { if (wr == 1) PG8_BAR; }
    }
    PG8_WAIT_V(0);
    if constexpr (!ALIGN_EPI) { if (wr == 0) PG8_BAR; }
    PG8_BAR;
    if constexpr (Epi::AFTER_DRAIN) { E.fused(acc, cur, wr, wc, fr, fq, lds, wid, lane); S.done(cur); }
#undef PG8_SA
#undef PG8_SB
#undef PG8_STAGE
#undef PG8_LDA
#undef PG8_LDB
#undef PG8_MMA
#undef PG8_WAIT_V
#undef PG8_WAIT_L
#undef PG8_BAR
#undef PG8_SCHED
}
}

#ifndef PG8_SP2
#define PG8_SP2 true
#endif
#ifndef PG8_ALIGN
#define PG8_ALIGN true
#endif

__device__ __forceinline__ float row_rstd16(const float* rowss, int row) {
    const f32x4* r = (const f32x4*)(rowss + (size_t)row * 16);
    const f32x4 a = r[0], b = r[1], c = r[2], d = r[3];
    const float s = ((a[0] + a[1]) + (a[2] + a[3])) + ((b[0] + b[1]) + (b[2] + b[3])) + ((c[0] + c[1]) + (c[2] + c[3])) + ((d[0] + d[1]) + (d[2] + d[3]));
    return rsqrtf(s * (1.f / DM) + EPS);
}
struct EpiProjF {
    static constexpr bool PERM = true, AFTER_DRAIN = false;
    const float* rowss; const float* cb; bf16_t* proj; float* side; const float* g_a; const float* g_b; const float* g_ds; const float* g_dw; LDSF float* xs  ; LDSF float* rsl  ;
    __device__ __forceinline__ void operator()(const pg8::f32x4 (&acc)[2][2][4][2], const pg8::Unit& u, int wr, int wc, int fr, int fq) const {
        const int b = u.pm >> 4, colt = u.pn * 256 + wc * 32 + 8 * fq;
        const int knmode = (u.pn == 1) ? 1 : (u.pn == 4) ? 2 : (u.pn == 10) ? 3 : (u.pn == 11) ? 4 : 0;
        f32x4 cv[2][2];
#pragma unroll
        for (int bj = 0; bj < 2; ++bj)
#pragma unroll
            for (int n = 0; n < 2; ++n) cv[bj][n] = *(const f32x4*)(cb + b * PINP + colt + bj * 128 + 4 * n);
        {   const int tid = (wr * 4 + wc) * 64 + fq * 16 + fr;
            if (tid < 256) rsl[tid] = row_rstd16(rowss, u.pm * 256 + tid);
            asm volatile("s_waitcnt vmcnt(0) lgkmcnt(0)" ::: "memory"); __builtin_amdgcn_s_barrier(); asm volatile("" ::: "memory"); }
        if (knmode != 0) {
#pragma unroll
            for (int ai = 0; ai < 2; ++ai)
#pragma unroll
                for (int m = 0; m < 4; ++m) {
                    const float rsm = rsl[ai * 128 + wr * 64 + m * 16 + fr];
#pragma unroll
                    for (int bj = 0; bj < 2; ++bj) {
                        const f32x4 v0 = acc[ai][bj][m][0] * rsm + cv[bj][0], v1 = acc[ai][bj][m][1] * rsm + cv[bj][1];
                        float ss = (v0[0] * v0[0] + v0[1] * v0[1]) + (v0[2] * v0[2] + v0[3] * v0[3]) + (v1[0] * v1[0] + v1[1] * v1[1]) + (v1[2] * v1[2] + v1[3] * v1[3]);
                        ss += __shfl_xor(ss, 16); ss += __shfl_xor(ss, 32);
                        if (fq == 0) xs[((wr * 4 + wc) * 16 + (ai * 4 + m) * 2 + bj) * 16 + fr] = ss;
                    }
                }
            asm volatile("s_waitcnt lgkmcnt(0)" ::: "memory"); __builtin_amdgcn_s_barrier(); asm volatile("" ::: "memory");
        }
#pragma unroll
        for (int ai = 0; ai < 2; ++ai)
#pragma unroll
            for (int m = 0; m < 4; ++m) {
                const int row = u.pm * 256 + ai * 128 + wr * 64 + m * 16 + fr; const float rs = rsl[ai * 128 + wr * 64 + m * 16 + fr];
#pragma unroll
                for (int bj = 0; bj < 2; ++bj) {
                    f32x4 v0 = acc[ai][bj][m][0] * rs + cv[bj][0], v1 = acc[ai][bj][m][1] * rs + cv[bj][1]; const int col0 = colt + bj * 128;
                    if (col0 >= C_BF && col0 < PIN) { *(f32x4*)(side + (size_t)row * 16 + (col0 - C_BF)) = v0; *(f32x4*)(side + (size_t)row * 16 + (col0 - C_BF) + 4) = v1; }
                    const bool on = (knmode == 1) || (knmode == 2) || (knmode == 3 && bj == 1 && wc < 2) || (knmode == 4 && bj == 0 && wc < 2);
                    if (on) {
                        const int xi = (ai * 4 + m) * 2 + bj;
                        float tot = xs[((wr * 4 + wc) * 16 + xi) * 16 + fr]; float dn = 1.f / 32.f;
                        if (knmode != 1) { tot += xs[((wr * 4 + (wc ^ 1)) * 16 + xi) * 16 + fr]; dn = 1.f / 64.f; }
                        const float nrm = rsqrtf(tot * dn + EPS);
                        const float* gp = (knmode == 1) ? g_a + 8 * fq : ((knmode == 2) ? g_b : (knmode == 3 ? g_ds : g_dw)) + (wc & 1) * 32 + 8 * fq;
                        v0 = v0 * nrm * *(const f32x4*)gp; v1 = v1 * nrm * *(const f32x4*)(gp + 4);
                    }
                    u32x4 w; w[0] = pg8::cvt_pk_bf16(v0[0], v0[1]); w[1] = pg8::cvt_pk_bf16(v0[2], v0[3]); w[2] = pg8::cvt_pk_bf16(v1[0], v1[1]); w[3] = pg8::cvt_pk_bf16(v1[2], v1[3]);
                    *(u32x4*)(proj + (size_t)row * PINP + col0) = w;
                }
            }
    }
};
struct EpiResF {
    static constexpr bool PERM = false, AFTER_DRAIN = false;
    static constexpr int RB = 2;
    float* xout32; bf16_t* xr; const float* gate; const float* g; const float* sc; bf16_t* xa; float* rowss;
    __device__ __forceinline__ void operator()(const pg8::f32x4 (&acc)[2][2][4][2], const pg8::Unit& u, int wr, int wc, int fr, int fq) const {
        const int b = u.pm >> 4, col0 = u.pn * 256 + wc * 32 + 4 * fq;
        f32x4 gt[2][2], gm[2][2];
#pragma unroll
        for (int bj = 0; bj < 2; ++bj)
#pragma unroll
            for (int n = 0; n < 2; ++n) { const int c = col0 + bj * 128 + n * 16; gt[bj][n] = *(const f32x4*)(gate + b * 6144 + c);
                if (xa) gm[bj][n] = *(const f32x4*)(g + c) * (*(const f32x4*)(sc + b * 6144 + c) + 1.0f); else gm[bj][n] = (f32x4){0.f, 0.f, 0.f, 0.f}; }
#pragma unroll
        for (int ai = 0; ai < 2; ++ai)
#pragma unroll
            for (int mh = 0; mh < 4 / RB; ++mh) {
                uint2 xw[RB][2][2];
#pragma unroll
                for (int mm = 0; mm < RB; ++mm)
#pragma unroll
                    for (int bj = 0; bj < 2; ++bj)
#pragma unroll
                        for (int n = 0; n < 2; ++n)
                            xw[mm][bj][n] = *(const uint2*)(xr + (size_t)(u.pm * 256 + ai * 128 + wr * 64 + (RB * mh + mm) * 16 + fr) * DM + col0 + bj * 128 + n * 16);
                asm volatile("" ::: "memory");
#pragma unroll
                for (int mm = 0; mm < RB; ++mm) {
                    const int m = RB * mh + mm; const int row = u.pm * 256 + ai * 128 + wr * 64 + m * 16 + fr; float ss = 0.f;
#pragma unroll
                    for (int bj = 0; bj < 2; ++bj)
#pragma unroll
                        for (int n = 0; n < 2; ++n) { const size_t off = (size_t)row * DM + col0 + bj * 128 + n * 16; const uint2 xv = xw[mm][bj][n];
                            const f32x4 xi = (f32x4){__uint_as_float(xv.x << 16), __uint_as_float(xv.x & 0xffff0000u), __uint_as_float(xv.y << 16), __uint_as_float(xv.y & 0xffff0000u)};
                            const f32x4 o = xi + gt[bj][n] * acc[ai][bj][m][n];
                            ss += (o[0] * o[0] + o[1] * o[1]) + (o[2] * o[2] + o[3] * o[3]);
                            if (xa) { uint2 w; w.x = pg8::cvt_pk_bf16(o[0], o[1]); w.y = pg8::cvt_pk_bf16(o[2], o[3]); *(uint2*)(xr + off) = w;
                                const f32x4 q = o * gm[bj][n]; uint2 w2; w2.x = pg8::cvt_pk_bf16(q[0], q[1]); w2.y = pg8::cvt_pk_bf16(q[2], q[3]); *(uint2*)(xa + off) = w2; }
                            else *(f32x4*)(xout32 + off) = o; }
                    if (rowss) { ss += __shfl_xor(ss, 16); ss += __shfl_xor(ss, 32); if (fq == 0) rowss[(size_t)row * 16 + u.pn * 4 + wc] = ss; }
                }
            }
    }
};


#define DPPF(oldv, src, CTRL) __builtin_bit_cast(float, __builtin_amdgcn_update_dpp(__builtin_bit_cast(int, (float)(oldv)), __builtin_bit_cast(int, (float)(src)), (CTRL), 0xf, 0xf, false))
struct EpiUpAct {
    static constexpr bool PERM = true, AFTER_DRAIN = false;
    const float* rowss; const float* cb; bf16_t* act; float* eg; float* ev; const float* cw; const float* cbias; LDSF float* xch; LDSF float* cst  ;
    __device__ __forceinline__ void operator()(const pg8::f32x4 (&acc)[2][2][4][2], const pg8::Unit& u, int wr, int wc, int fr, int fq) const {
        const int b = u.pm >> 4, cih = wc * 32 + 8 * fq, jcol = u.pn * 128 + cih;
        const float* cbg = cb + b * NUP + u.pn * 256 + cih; const float* cbv = cbg + 128;
        {
            const int tid = (wr * 4 + wc) * 64 + fq * 16 + fr, col = tid & 127, arr = tid >> 7;
            const float* src = (arr == 0) ? cb + b * NUP + u.pn * 256 + col : (arr == 1) ? cb + b * NUP + u.pn * 256 + 128 + col : cw + (arr - 2) * DFF + u.pn * 128 + col;
            cst[arr * 128 + col] = *src;
            if (tid < 256) { const int a2 = 4 + (tid >> 7); cst[a2 * 128 + col] = (a2 == 4) ? cw[2 * DFF + u.pn * 128 + col] : cbias[u.pn * 128 + col]; }
            else cst[768 + (tid - 256)] = row_rstd16(rowss, u.pm * 256 + (tid - 256));
            const f32x4 cg0 = *(const f32x4*)cbg, cg1 = *(const f32x4*)(cbg + 4);
            const f32x4 cv0 = *(const f32x4*)cbv, cv1 = *(const f32x4*)(cbv + 4);
            asm volatile("s_waitcnt vmcnt(0) lgkmcnt(0)" ::: "memory"); __builtin_amdgcn_s_barrier(); asm volatile("" ::: "memory");
            const float r3a = cst[768 + 0 * 128 + wr * 64 + 48 + fr], r3b = cst[768 + 1 * 128 + wr * 64 + 48 + fr], r0 = cst[768 + (fr & 1)];
#pragma unroll
            for (int ai = 0; ai < 2; ++ai) {
                const float r3 = ai ? r3b : r3a;
                const f32x4 g0 = acc[ai][0][3][0] * r3 + cg0, g1 = acc[ai][0][3][1] * r3 + cg1;
                if (fr >= 14) { LDSF float* x = xch + ((((wr * 2 + ai) * 4 + wc) * 2 + (fr - 14)) * 32 + 8 * fq); *(LDSF f32x4*)x = g0; *(LDSF f32x4*)(x + 4) = g1;
                    if (wr == 1 && ai == 1) { float* e = eg + ((size_t)(u.pm * 4 + 2 + (fr - 14))) * DFF + jcol; *(f32x4*)e = g0; *(f32x4*)(e + 4) = g1; } }
            }
            if (wr == 0 && fr < 2) {
                float* e = eg + ((size_t)(u.pm * 4 + fr)) * DFF + jcol; float* v = ev + ((size_t)(u.pm * 2 + fr)) * DFF + jcol;
                *(f32x4*)e = acc[0][0][0][0] * r0 + cg0; *(f32x4*)(e + 4) = acc[0][0][0][1] * r0 + cg1;
                *(f32x4*)v = acc[0][1][0][0] * r0 + cv0; *(f32x4*)(v + 4) = acc[0][1][0][1] * r0 + cv1;
            }
        }
        asm volatile("s_waitcnt lgkmcnt(0)" ::: "memory"); __builtin_amdgcn_s_barrier(); asm volatile("" ::: "memory");
#pragma unroll
        for (int ai = 0; ai < 2; ++ai) {
            f32x4 pvv[2];
            if (ai == 0 && wr == 0) { pvv[0] = (f32x4){0.f, 0.f, 0.f, 0.f}; pvv[1] = pvv[0]; }
            else { const int swr = (wr == 1) ? 0 : 1, sai = (wr == 1) ? ai : ai - 1;
                const LDSF float* x = xch + ((((swr * 2 + sai) * 4 + wc) * 2 + (fr & 1)) * 32 + 8 * fq); pvv[0] = *(const LDSF f32x4*)x; pvv[1] = *(const LDSF f32x4*)(x + 4); }
#pragma unroll
            for (int m = 0; m < 4; ++m) {
                asm volatile("" ::: "memory");
                const int row = u.pm * 256 + ai * 128 + wr * 64 + m * 16 + fr; const float rsm = cst[768 + ai * 128 + wr * 64 + m * 16 + fr];
                u32x4 w;
#pragma unroll
                for (int n = 0; n < 2; ++n) {
                    const LDSF float* cc = cst + cih + 4 * n;
                    const f32x4 cgn = *(const LDSF f32x4*)cc, cvn = *(const LDSF f32x4*)(cc + 128);
                    const f32x4 k0 = *(const LDSF f32x4*)(cc + 256), k1 = *(const LDSF f32x4*)(cc + 384), k2 = *(const LDSF f32x4*)(cc + 512), kb = *(const LDSF f32x4*)(cc + 640);
                    const f32x4 c = acc[ai][0][m][n] * rsm + cgn, v = acc[ai][1][m][n] * rsm + cvn; float o[4];
#pragma unroll
                    for (int i = 0; i < 4; ++i) {
                        const float gm1 = DPPF(DPPF(0.f, pvv[n][i], 0x121), c[i], 0x111);
                        const float gm2 = DPPF(DPPF(0.f, pvv[n][i], 0x122), c[i], 0x112);
                        const float cvv = k0[i] * gm2 + k1[i] * gm1 + k2[i] * c[i] + kb[i];
                        o[i] = cvv * __builtin_amdgcn_rcpf(1.f + __builtin_amdgcn_exp2f(-cvv * LOG2E)) * v[i];
                    }
                    w[2 * n] = pg8::cvt_pk_bf16(o[0], o[1]); w[2 * n + 1] = pg8::cvt_pk_bf16(o[2], o[3]);
                    pvv[n] = c;
                }
                *(u32x4*)(act + (unsigned)(((u.pm * (DFF / 64) + (jcol >> 6)) * 256 + (row & 255)) * 64 + (jcol & 63))) = w;
            }
        }
    }
};
__device__ void act_fixup(const Params& p, int l, int pm) {
    if ((pm & 15) == 0) return;
    const float* eg = (const float*)(p.ws + WS_EG); const float* ev = (const float*)(p.ws + WS_EV); bf16_t* act = (bf16_t*)(p.ws + WS_ACT);
    const float* cw = p.conv_w + (size_t)l * 3 * DFF; const float* cbias = p.conv_b + (size_t)l * DFF;
    const int tid = TID();
    constexpr int NB4 = 4;
#pragma unroll 1
    for (int bt = 0; bt < 3; ++bt) {
        float a[NB4], bq[NB4], c0[NB4], c1[NB4], vv[NB4], k0[NB4], k1[NB4], k2[NB4], kb[NB4];
#pragma unroll
        for (int i = 0; i < NB4; ++i) { const int idx = min(tid + (bt * NB4 + i) * NTHR, 2 * DFF - 1); const int r = idx / DFF, j = idx - r * DFF;
            a[i] = eg[((size_t)((pm - 1) * 4 + 2)) * DFF + j]; bq[i] = eg[((size_t)((pm - 1) * 4 + 3)) * DFF + j]; c0[i] = eg[((size_t)(pm * 4 + 0)) * DFF + j]; c1[i] = eg[((size_t)(pm * 4 + 1)) * DFF + j];
            vv[i] = ev[((size_t)(pm * 2 + r)) * DFF + j]; k0[i] = cw[j]; k1[i] = cw[DFF + j]; k2[i] = cw[2 * DFF + j]; kb[i] = cbias[j]; }
        asm volatile("" ::: "memory");
#pragma unroll
        for (int i = 0; i < NB4; ++i) { const int idx = tid + (bt * NB4 + i) * NTHR;
            if (idx < 2 * DFF) { const int r = idx / DFF, j = idx - r * DFF;
                const float gm2 = r ? bq[i] : a[i], gm1 = r ? c0[i] : bq[i], gc = r ? c1[i] : c0[i];
                const float cvv = k0[i] * gm2 + k1[i] * gm1 + k2[i] * gc + kb[i];
                act[((size_t)(pm * (DFF / 64) + (j >> 6)) * 256 + r) * 64 + (j & 63)] = f2bf(siluf(cvv) * vv[i]); } }
    }
}

__device__ void ph_prep_cum_bh(const Params& p, int l, int bh, unsigned char* lds) {
    const float* side = (const float*)(p.ws + WS_SIDE);
    float* cum = (float*)(p.ws + WS_CUM);
    LDSF float* wt = (LDSF float*)(lds + 70000);
    const int tid = TID(), lane = tid & 63, wv = tid >> 6;
    {
        const int b = bh >> 2, h = bh & 3; const float bf = p.fox_bf[l * 4 + h];
        float v[8]; float tot = 0.f;
#pragma unroll
        for (int i = 0; i < 8; ++i) { v[i] = logsigf(side[(size_t)(b * SEQ + tid * 8 + i) * 16 + h] + bf); tot += v[i]; v[i] = tot; }
        float inc = tot;
#pragma unroll
        for (int o = 1; o < 64; o <<= 1) { const float u = __shfl_up(inc, o); if (lane >= o) inc += u; }
        __syncthreads();
        if (lane == 63) wt[wv] = inc;
        __syncthreads();
        float base = inc - tot;
        for (int w8 = 0; w8 < wv; ++w8) base += wt[w8];
#pragma unroll
        for (int i = 0; i < 8; ++i) cum[bh * SEQ + tid * 8 + i] = base + v[i];
    }
}
template <int N> __device__ __forceinline__ float dotn(const float* q, const bf16_t* k) {
    float s = 0.f;
#pragma unroll
    for (int c = 0; c < N / 8; ++c) { float t[8]; load8(k + 8 * c, t);
#pragma unroll
        for (int j = 0; j < 8; ++j) s += q[8 * c + j] * t[j]; }
    return s;
}
template <int N> __device__ __forceinline__ void axpyn(float* o, float w, const bf16_t* v) {
#pragma unroll
    for (int c = 0; c < N / 8; ++c) { float t[8]; load8(v + 8 * c, t);
#pragma unroll
        for (int j = 0; j < 8; ++j) o[8 * c + j] += w * t[j]; }
}
template <int N> __device__ __forceinline__ void loadq_norm(float* q, const bf16_t* src, const float* g, float scale, bool norm) {
    float ss = 0.f;
#pragma unroll
    for (int c = 0; c < N / 8; ++c) load8(src + 8 * c, q + 8 * c);
#pragma unroll
    for (int j = 0; j < N; ++j) ss += q[j] * q[j];
    const float r = norm ? rsqrtf(ss * (1.f / N) + EPS) : 1.f;
#pragma unroll
    for (int j = 0; j < N; ++j) q[j] = q[j] * r * (norm ? g[j] : 1.f) * scale;
}
__device__ __forceinline__ void store64(bf16_t* dst, const float* o) {
#pragma unroll
    for (int c = 0; c < 8; ++c) { u32x4 w; w[0] = pk2(o[8 * c], o[8 * c + 1]); w[1] = pk2(o[8 * c + 2], o[8 * c + 3]); w[2] = pk2(o[8 * c + 4], o[8 * c + 5]); w[3] = pk2(o[8 * c + 6], o[8 * c + 7]); *(u32x4*)(dst + 8 * c) = w; }
}

typedef float f32x16 __attribute__((ext_vector_type(16)));
typedef short s16x4 __attribute__((ext_vector_type(4)));
#define LDSP __attribute__((address_space(3)))
constexpr int KSTR = 144;
constexpr int AL_KV = 17408;
constexpr int AL_BK = 2 * AL_KV  , AL_TB = AL_BK + 512  , AL_WSF = AL_TB + 512  , AL_MISC = AL_WSF + 2048  ,
              AL_IMP = 38912  , AL_SELM = AL_IMP + 65536  ,
              AL_TB4 = AL_SELM + 512  , AL_INVL = AL_TB4 + 2048  , AL_D_END = AL_INVL + 1024;
static_assert(AL_MISC + 64 <= AL_IMP && AL_D_END <= 131072, "attention LDS map");
__device__ __forceinline__ int crow(int r, int hi) { return (r & 3) + 8 * (r >> 2) + 4 * hi; }
__device__ __forceinline__ float ex2(float v) { return __builtin_amdgcn_exp2f(v); }
__device__ __forceinline__ s16x4 vtr(const LDSP unsigned char* p) { typedef short v4i16_t __attribute__((ext_vector_type(4))); return __builtin_bit_cast(s16x4, __builtin_amdgcn_ds_read_tr16_b64_v4i16((LDSP v4i16_t*)p)); }
__device__ __forceinline__ bf16x8 pack8(const f32x16& p, int b) {
    u32x4 w; w[0] = pg8::cvt_pk_bf16(p[b], p[b + 1]); w[1] = pg8::cvt_pk_bf16(p[b + 2], p[b + 3]); w[2] = pg8::cvt_pk_bf16(p[b + 4], p[b + 5]); w[3] = pg8::cvt_pk_bf16(p[b + 6], p[b + 7]);
    return __builtin_bit_cast(bf16x8, w);
}
__device__ __forceinline__ f32x16 splat16(float v) { return (f32x16){v, v, v, v, v, v, v, v, v, v, v, v, v, v, v, v}; }
template <int NK16>
__device__ __forceinline__ void qkt(f32x16& p0, f32x16& p1, const LDSP unsigned char* Kt, const bf16x8* qf, int dbase, int r32, int hi) {
    const LDSP unsigned char* kb = Kt + r32 * KSTR + hi * 16 + dbase * 32;
#pragma unroll
    for (int d0 = 0; d0 < NK16; ++d0) {
        const bf16x8 a0 = *(const LDSP bf16x8*)(kb + d0 * 32), a1 = *(const LDSP bf16x8*)(kb + 32 * KSTR + d0 * 32);
        p0 = __builtin_amdgcn_mfma_f32_32x32x16_bf16(a0, qf[d0], p0, 0, 0, 0);
        p1 = __builtin_amdgcn_mfma_f32_32x32x16_bf16(a1, qf[d0], p1, 0, 0, 0);
    }
}
__device__ __forceinline__ void pv(f32x16* o, const LDSP unsigned char* Vt, int vb, const f32x16& p0, const f32x16& p1) {
    bf16x8 pa[4]; pa[0] = pack8(p0, 0); pa[1] = pack8(p0, 8); pa[2] = pack8(p1, 0); pa[3] = pack8(p1, 8);
#pragma unroll
    for (int d0 = 0; d0 < 2; ++d0)
#pragma unroll
        for (int ks = 0; ks < 4; ++ks) {
            const s16x4 lo = vtr(Vt + vb + d0 * 4096 + ks * 1024), hh = vtr(Vt + vb + d0 * 4096 + ks * 1024 + 512);
            const bf16x8 vf = (bf16x8){lo[0], lo[1], lo[2], lo[3], hh[0], hh[1], hh[2], hh[3]};
            o[d0] = __builtin_amdgcn_mfma_f32_32x32x16_bf16(pa[ks], vf, o[d0], 0, 0, 0);
        }
}
__device__ __forceinline__ float exp_sum(f32x16& p0, f32x16& p1) {
    float s0 = 0.f, s1 = 0.f;
#pragma unroll
    for (int r = 0; r < 16; ++r) { p0[r] = ex2(p0[r]); p1[r] = ex2(p1[r]); s0 += p0[r]; s1 += p1[r]; }
    return s0 + s1;
}
__device__ __forceinline__ void scale_rows(f32x16* o, float f, LDSP float* wsf, int r32, int hi) {
    __builtin_amdgcn_wave_barrier();
    if (hi == 0) wsf[r32] = f;
    __builtin_amdgcn_s_waitcnt(0xc07f);
    __builtin_amdgcn_wave_barrier();
#pragma unroll
    for (int g = 0; g < 4; ++g) { const f32x4 a = *(const LDSP f32x4*)(wsf + 8 * g + 4 * hi);
#pragma unroll
        for (int i = 0; i < 4; ++i) { o[0][4 * g + i] *= a[i]; o[1][4 * g + i] *= a[i]; } }
    __builtin_amdgcn_wave_barrier();
}
__device__ __forceinline__ void store_o(const f32x16* o, LDSP bf16_t* stg, bf16_t* dst, int lane, int r32, int hi) {
    __builtin_amdgcn_wave_barrier();
#pragma unroll
    for (int r = 0; r < 16; ++r) { const int orow = crow(r, hi); stg[orow * 64 + r32] = f2bf(o[0][r]); stg[orow * 64 + 32 + r32] = f2bf(o[1][r]); }
    __builtin_amdgcn_s_waitcnt(0xc07f);
    __builtin_amdgcn_wave_barrier();
#pragma unroll
    for (int i = 0; i < 4; ++i) { const int row = i * 8 + (lane >> 3), ch = lane & 7; const u32x4 v = *(const LDSP u32x4*)(stg + row * 64 + ch * 8); *(u32x4*)(dst + (size_t)row * DM + ch * 8) = v; }
    __builtin_amdgcn_s_waitcnt(0xc07f);
    __builtin_amdgcn_wave_barrier();
}
template <int NG>
__device__ __forceinline__ void load_q(bf16x8* qf, const bf16_t* qrow  , const float* g, float sc, bool norm, int hi) {
    float v[4][8];
#pragma unroll
    for (int d0 = 0; d0 < 4; ++d0) load8(qrow + 16 * d0 + 8 * hi, v[d0]);
    float r0 = 1.f, r1 = 1.f;
    if (norm) {
        float s0 = 0.f, s1 = 0.f;
#pragma unroll
        for (int j = 0; j < 8; ++j) { s0 += v[0][j] * v[0][j] + v[1][j] * v[1][j]; s1 += v[2][j] * v[2][j] + v[3][j] * v[3][j]; }
        s0 += __shfl_xor(s0, 32); s1 += __shfl_xor(s1, 32);
        if (NG == 64) { r0 = rsqrtf((s0 + s1) * (1.f / 64.f) + EPS); r1 = r0; } else { r0 = rsqrtf(s0 * (1.f / 32.f) + EPS); r1 = rsqrtf(s1 * (1.f / 32.f) + EPS); }
    }
#pragma unroll
    for (int d0 = 0; d0 < 4; ++d0) {
        const float rr = (d0 < 2 ? r0 : r1) * sc; float w[8];
#pragma unroll
        for (int j = 0; j < 8; ++j) { const int d = 16 * d0 + 8 * hi + j; w[j] = v[d0][j] * rr * (norm ? g[d % NG] : 1.f); }
        u32x4 u; u[0] = pg8::cvt_pk_bf16(w[0], w[1]); u[1] = pg8::cvt_pk_bf16(w[2], w[3]); u[2] = pg8::cvt_pk_bf16(w[4], w[5]); u[3] = pg8::cvt_pk_bf16(w[6], w[7]);
        qf[d0] = __builtin_bit_cast(bf16x8, u);
    }
}
__device__ __forceinline__ void kv_load(u32x4& kr, u32x4& vr, const bf16_t* Kb, const bf16_t* Vb, int k0, int tid) {
    const size_t off = (size_t)(k0 + (tid >> 3)) * PINP + (tid & 7) * 8;
    kr = *(const u32x4*)(Kb + off); vr = *(const u32x4*)(Vb + off);
}
__device__ __forceinline__ void kv_load64(u32x4& kr, u32x4& vr, const bf16_t* Kb, const bf16_t* Vb, int n0, int tid) {
    const size_t off = (size_t)(n0 + (tid >> 3)) * 64 + (tid & 7) * 8;
    kr = *(const u32x4*)(Kb + off); vr = *(const u32x4*)(Vb + off);
}
__device__ __forceinline__ void kv_store(const u32x4& kr, const u32x4& vr, LDSP unsigned char* buf, int tid) {
    const int key = tid >> 3, ch = tid & 7;
    *(LDSP u32x4*)(buf + key * KSTR + ch * 16) = kr;
    *(LDSP u32x4*)(buf + 9216 + (ch >> 2) * 4096 + (key >> 4) * 1024 + ((key >> 3) & 1) * 512 + (key & 7) * 64 + (ch & 3) * 16) = vr;
}
template <int NG>
__device__ __forceinline__ void knorm_chunk(u32x4& kr, const float* gp  ) {
    float v[8];
    v[0] = bf2f(kr[0] & 0xffff); v[1] = bf2f(kr[0] >> 16); v[2] = bf2f(kr[1] & 0xffff); v[3] = bf2f(kr[1] >> 16);
    v[4] = bf2f(kr[2] & 0xffff); v[5] = bf2f(kr[2] >> 16); v[6] = bf2f(kr[3] & 0xffff); v[7] = bf2f(kr[3] >> 16);
    float ss = 0.f;
#pragma unroll
    for (int j = 0; j < 8; ++j) ss += v[j] * v[j];
    ss += __shfl_xor(ss, 1); ss += __shfl_xor(ss, 2); if (NG == 64) ss += __shfl_xor(ss, 4);
    const float r = rsqrtf(ss * (1.f / NG) + EPS);
    const f32x4 ga = *(const f32x4*)gp, gb = *(const f32x4*)(gp + 4);
    kr[0] = pg8::cvt_pk_bf16(v[0] * r * ga[0], v[1] * r * ga[1]); kr[1] = pg8::cvt_pk_bf16(v[2] * r * ga[2], v[3] * r * ga[3]);
    kr[2] = pg8::cvt_pk_bf16(v[4] * r * gb[0], v[5] * r * gb[1]); kr[3] = pg8::cvt_pk_bf16(v[6] * r * gb[2], v[7] * r * gb[3]);
}
__device__ __forceinline__ void bias_near(f32x16& p0, f32x16& p1, const LDSP float* tbl, int tk0  , int wnd, bool rowok, int hi) {
#pragma unroll
    for (int g = 0; g < 4; ++g) {
#pragma unroll
        for (int i = 0; i < 4; ++i) { const int r = 4 * g + i; const int d0_ = tk0 - crow(r, hi), d1_ = d0_ - 32;
            const float b0 = tbl[min(max(d0_, 0), 127)], b1 = tbl[min(max(d1_, 0), 127)];
            p0[r] = (d0_ < 0 || d0_ >= wnd || !rowok) ? -INFINITY : p0[r] + b0; p1[r] = (d1_ < 0 || d1_ >= wnd || !rowok) ? -INFINITY : p1[r] + b1; }
        asm volatile("" ::: "memory");
    }
}
#define KVBUF(L, i) ((L) + ((i) & 1) * AL_KV)

__device__ void fa_fox_unit(const Params& p, int l, int b, int h, int qb, LDSP unsigned char* L) {
    const int tid = TID(), lane = tid & 63, wid = __builtin_amdgcn_readfirstlane(tid >> 6), r32 = lane & 31, hi = lane >> 5;
    const bf16_t* proj = (const bf16_t*)(p.ws + WS_PROJ); bf16_t* mix = (bf16_t*)p.out;
    const size_t rb = (size_t)b * SEQ; const int q0 = qb * 256, qw = q0 + 32 * wid, t = qw + r32;
    const bf16_t* Kb = proj + rb * PINP + CB_K + 64 * h; const bf16_t* Vb = proj + rb * PINP + CB_V + 64 * h;
    const float* cm = (const float*)(p.ws + WS_CUM) + (b * 4 + h) * SEQ;
    LDSP float* wsf = (LDSP float*)(L + AL_WSF) + wid * 64; LDSP float* bk = (LDSP float*)(L + AL_BK);
    const int vb = 9216 + ((lane >> 4) & 1) * 32 + (lane & 3) * 8 + (4 * hi + ((lane & 15) >> 2)) * 64;
    bf16x8 qf[4]; load_q<64>(qf, proj + (rb + t) * PINP + CB_Q + 64 * h, p.fox_qn + l * 64, 0.125f * LOG2E, true, hi);
    const float rowc = cm[t] * LOG2E - ((const float*)(p.ws + WS_BND))[l * 32 + 4];
    f32x16 o[2]; o[0] = (f32x16){}; o[1] = (f32x16){};
    float l_run = 0.f;
    const int NT = 4 * qb + 4, jd = 4 * qb + (wid >> 1);
    u32x4 krA, vrA, krB, vrB; float crA = 0.f, crB = 0.f;
    int js;
    {   const bool live = (lane < NT) ? ((cm[q0] - cm[64 * lane + 63]) * LOG2E >= -160.f) : false;
        const unsigned long long bm = __ballot(live);
        js = __builtin_amdgcn_readfirstlane((int)__builtin_ctzll(bm | (1ull << (NT - 1)))); if (js > NT - 2) js = NT - 2; js &= ~1; }
    __syncthreads();
    kv_load(krA, vrA, Kb, Vb, 64 * js, tid); if (tid < 64) crA = cm[64 * js + tid];
    kv_store(krA, vrA, KVBUF(L, js), tid); if (tid < 64) bk[(js & 1) * 64 + tid] = -crA * LOG2E;
    kv_load(krB, vrB, Kb, Vb, 64 * (js + 1), tid); if (tid < 64) crB = cm[64 * (js + 1) + tid];
    if (js + 2 < NT) { kv_load(krA, vrA, Kb, Vb, 64 * (js + 2), tid); if (tid < 64) crA = cm[64 * (js + 2) + tid]; }
#define FOX_STEP(J, KR, VR, CR) do { const int j = (J); \
        __syncthreads(); \
        if (j + 1 < NT) { kv_store(KR, VR, KVBUF(L, j + 1), tid); if (tid < 64) bk[((j + 1) & 1) * 64 + tid] = -CR * LOG2E; } \
        if (j + 3 < NT) { kv_load(KR, VR, Kb, Vb, 64 * (j + 3), tid); if (tid < 64) CR = cm[64 * (j + 3) + tid]; } \
        if (j <= jd) { \
            const LDSP unsigned char* buf = KVBUF(L, j); const LDSP float* bkj = bk + (j & 1) * 64; \
            f32x16 p0, p1; \
            _Pragma("unroll") for (int g = 0; g < 4; ++g) { const f32x4 b0 = *(const LDSP f32x4*)(bkj + 8 * g + 4 * hi), b1 = *(const LDSP f32x4*)(bkj + 32 + 8 * g + 4 * hi); \
                _Pragma("unroll") for (int i = 0; i < 4; ++i) { p0[4 * g + i] = b0[i] + rowc; p1[4 * g + i] = b1[i] + rowc; } } \
            qkt<4>(p0, p1, buf, qf, 0, r32, hi); \
            if (j == jd) { const int k0 = 64 * j; \
                _Pragma("unroll") for (int r = 0; r < 16; ++r) { const int kk = k0 + crow(r, hi); if (kk > t) p0[r] = -INFINITY; if (kk + 32 > t) p1[r] = -INFINITY; } } \
            l_run += exp_sum(p0, p1); \
            pv(o, buf, vb, p0, p1); \
        } } while (0)
    for (int jj = js; jj < NT; jj += 2) { FOX_STEP(jj, krB, vrB, crB); FOX_STEP(jj + 1, krA, vrA, crA); }
#undef FOX_STEP
    l_run += __shfl_xor(l_run, 32);
    scale_rows(o, 1.f / l_run, wsf, r32, hi);
    store_o(o, (LDSP bf16_t*)(L + AL_IMP + wid * 8192), mix + (rb + qw) * DM + 256 + 64 * h, lane, r32, hi);
}

__device__ void fa_diff_unit(const Params& p, int l, int b, int h, int qb, LDSP unsigned char* L) {
    const int tid = TID(), lane = tid & 63, wid = __builtin_amdgcn_readfirstlane(tid >> 6), r32 = lane & 31, hi = lane >> 5;
    const bf16_t* proj = (const bf16_t*)(p.ws + WS_PROJ); bf16_t* mix = (bf16_t*)p.out;
    const size_t rb = (size_t)b * SEQ; const int q0 = qb * 256, qw = q0 + 32 * wid, t = qw + r32;
    const bf16_t* Kb = proj + rb * PINP + CA_K + 64 * h; const bf16_t* Vb = proj + rb * PINP + CA_V + 64 * h;
    LDSP float* wsf = (LDSP float*)(L + AL_WSF) + wid * 64; LDSP float* tbl = (LDSP float*)(L + AL_TB);
    const int vb = 9216 + ((lane >> 4) & 1) * 32 + (lane & 3) * 8 + (4 * hi + ((lane & 15) >> 2)) * 64;
    const float lam = ((const float*)(p.ws + WS_LAM))[l]; const float lam_init = 0.8f - 0.6f * __expf(-0.3f * (float)l);
    const float nbound = -((const float*)(p.ws + WS_BND))[l * 32 + h];
    __syncthreads();
    if (tid < 128) tbl[tid] = ((const float*)(p.ws + WS_TB))[h * 128 + tid] * LOG2E;
    bf16x8 qf[4]; load_q<32>(qf, proj + (rb + t) * PINP + CA_Q + 64 * h, p.diff_qn + l * 32, 0.17677669529663687f * LOG2E, true, hi);
    f32x16 o1[2], o2[2]; o1[0] = (f32x16){}; o1[1] = (f32x16){}; o2[0] = (f32x16){}; o2[1] = (f32x16){};
    float l1 = 0.f, l2 = 0.f;
    const int NT = 4 * qb + 4, jd = 4 * qb + (wid >> 1);
    u32x4 kr, vr; const float* gk = p.diff_kn + l * 32 + (tid & 3) * 8;
    kv_load(kr, vr, Kb, Vb, 0, tid);
    kv_store(kr, vr, KVBUF(L, 0), tid);
    kv_load(kr, vr, Kb, Vb, 64, tid);
    for (int j = 0; j < NT; ++j) {
        __syncthreads();
        if (j + 1 < NT) { kv_store(kr, vr, KVBUF(L, j + 1), tid); }
        if (j + 2 < NT) kv_load(kr, vr, Kb, Vb, 64 * (j + 2), tid);
        if (j <= jd) {
            const LDSP unsigned char* buf = KVBUF(L, j);
            const int k0 = 64 * j; const bool nearb = (qw - (k0 + 63)) < 113; const float cfar = tbl[127] + nbound;
#pragma unroll
            for (int mp = 0; mp < 2; ++mp) {
                f32x16 p0 = splat16(nearb ? nbound : cfar), p1 = p0;
                qkt<2>(p0, p1, buf, qf + 2 * mp, 2 * mp, r32, hi);
                if (nearb) bias_near(p0, p1, tbl, t - k0, 1 << 30, true, hi);
                if (mp == 0) { l1 += exp_sum(p0, p1); pv(o1, buf, vb, p0, p1); }
                else { l2 += exp_sum(p0, p1); pv(o2, buf, vb, p0, p1); }
            }
        }
    }
    l1 += __shfl_xor(l1, 32); l2 += __shfl_xor(l2, 32);
    scale_rows(o1, 1.f / l1, wsf, r32, hi); scale_rows(o2, lam / l2, wsf, r32, hi);
    o1[0] -= o2[0]; o1[1] -= o2[1];
    const float g0 = p.diff_sub[l * 64 + r32] * (1.f - lam_init), g1 = p.diff_sub[l * 64 + 32 + r32] * (1.f - lam_init);
#pragma unroll
    for (int r = 0; r < 16; ++r) {
        float ss = o1[0][r] * o1[0][r] + o1[1][r] * o1[1][r];
        ss += __shfl_xor(ss, 1); ss += __shfl_xor(ss, 2); ss += __shfl_xor(ss, 4); ss += __shfl_xor(ss, 8); ss += __shfl_xor(ss, 16);
        const float rs = rsqrtf(ss * (1.f / 64.f) + EPS); o1[0][r] *= rs * g0; o1[1][r] *= rs * g1;
    }
    store_o(o1, (LDSP bf16_t*)(L + AL_IMP + wid * 8192), mix + (rb + qw) * DM + 0 + 64 * h, lane, r32, hi);
}

template <bool DIAG>
__device__ __forceinline__ void stick_sub(f32x16& y, float& carry, int kbase  , int t, int hi) {
    float lk[16];
#pragma unroll
    for (int r = 0; r < 16; ++r) {
        const float v = y[r]; const float e = ex2(-fabsf(v)); const float lb = fminf(v, 0.f) - __builtin_amdgcn_logf(1.f + e);
        if (DIAG) { const bool valid = (kbase + crow(r, hi) < t); lk[r] = valid ? (lb - v) : 0.f; y[r] = valid ? lb : -INFINITY; }
        else { lk[r] = lb - v; y[r] = lb; }
    }
    float T[4], Go[4];
#pragma unroll
    for (int g = 0; g < 4; ++g) { const float Gs = (lk[4 * g] + lk[4 * g + 1]) + (lk[4 * g + 2] + lk[4 * g + 3]); Go[g] = __shfl_xor(Gs, 32); T[g] = Gs + Go[g]; }
    float sx = 0.f;
#pragma unroll
    for (int g = 3; g >= 0; --g) {
        float tail = carry + sx + (hi == 0 ? Go[g] : 0.f);
#pragma unroll
        for (int i = 3; i >= 0; --i) { y[4 * g + i] = ex2(y[4 * g + i] + tail); tail += lk[4 * g + i]; }
        sx += T[g];
    }
    carry += sx;
}
__device__ void fa_stick_unit(const Params& p, int l, int b, int h, int qb, LDSP unsigned char* L) {
    const int tid = TID(), lane = tid & 63, wid = __builtin_amdgcn_readfirstlane(tid >> 6), r32 = lane & 31, hi = lane >> 5;
    const bf16_t* proj = (const bf16_t*)(p.ws + WS_PROJ); bf16_t* mix = (bf16_t*)p.out;
    const size_t rb = (size_t)b * SEQ; const int q0 = qb * 256, qw = q0 + 32 * wid, t = qw + r32;
    const bf16_t* Kb = proj + rb * PINP + CC_K + 64 * h; const bf16_t* Vb = proj + rb * PINP + CC_V + 64 * h;
    const int vb = 9216 + ((lane >> 4) & 1) * 32 + (lane & 3) * 8 + (4 * hi + ((lane & 15) >> 2)) * 64;
    bf16x8 qf[4]; load_q<64>(qf, proj + (rb + t) * PINP + CC_Q + 64 * h, nullptr, 0.125f * LOG2E, false, hi);
    f32x16 o[2]; o[0] = (f32x16){}; o[1] = (f32x16){};
    float carry = 0.f;
    const int NT = 4 * qb + 4, jd = 4 * qb + (wid >> 1);
    u32x4 kr, vr;
#define SBUF(i) (((i) & 1) ? (L + 108544) : L)
    LDSP unsigned* dn = (LDSP unsigned*)(L + AL_MISC) + 8;
    bool wdone = false;
    __syncthreads();
    if (lane == 0) dn[wid] = 0u;
    kv_load(kr, vr, Kb, Vb, 64 * (NT - 1), tid);
    kv_store(kr, vr, SBUF(NT - 1), tid);
    kv_load(kr, vr, Kb, Vb, 64 * (NT - 2), tid);
    for (int j = NT - 1; j >= 0; --j) {
        __syncthreads();
        if (__all(dn[lane & 7] != 0u)) break;
        if (j >= 1) kv_store(kr, vr, SBUF(j - 1), tid);
        if (j >= 2) kv_load(kr, vr, Kb, Vb, 64 * (j - 2), tid);
        if (j <= jd && !wdone) {
            const LDSP unsigned char* buf = SBUF(j);
            f32x16 p0 = (f32x16){}, p1 = (f32x16){};
            qkt<4>(p0, p1, buf, qf, 0, r32, hi);
            const int k0 = 64 * j; const bool diag = (j == jd);
            if (diag) { stick_sub<true>(p1, carry, k0 + 32, t, hi); stick_sub<true>(p0, carry, k0, t, hi); }
            else { stick_sub<false>(p1, carry, k0 + 32, t, hi); stick_sub<false>(p0, carry, k0, t, hi); }
            pv(o, buf, vb, p0, p1);
            if (__all(carry < -160.f)) { wdone = true; if (lane == 0) dn[wid] = 1u; }
        }
    }
    store_o(o, (LDSP bf16_t*)(L + AL_IMP + wid * 8192), mix + (rb + qw) * DM + 512 + 64 * h, lane, r32, hi);
}

__device__ void fa_nsa_unit(const Params& p, int l, int b, int u, LDSP unsigned char* L) {
    const int tid = TID(), lane = tid & 63, wid = __builtin_amdgcn_readfirstlane(tid >> 6), r32 = lane & 31, hi = lane >> 5;
    const int hh = wid >> 1, sub = wid & 1;
    const bf16_t* proj = (const bf16_t*)(p.ws + WS_PROJ); bf16_t* mix = (bf16_t*)p.out;
    const size_t rb = (size_t)b * SEQ; const int q0 = 64 * u, qw = q0 + 32 * sub, t = qw + r32; const int ql = 32 * sub + r32;
    LDSP float* wsf = (LDSP float*)(L + AL_WSF) + wid * 64; LDSP float* tbl = (LDSP float*)(L + AL_TB4) + hh * 128;
    LDSP float* imp = (LDSP float*)(L + AL_IMP); LDSP unsigned* selm = (LDSP unsigned*)(L + AL_SELM); LDSP float* invl = (LDSP float*)(L + AL_INVL);
    LDSP float* ofl = (LDSP float*)(L + AL_IMP) + wid * 2048 + lane;
    const int vb = 9216 + ((lane >> 4) & 1) * 32 + (lane & 3) * 8 + (4 * hi + ((lane & 15) >> 2)) * 64;
    const float* bnd = (const float*)(p.ws + WS_BND) + l * 32;
    __syncthreads();
    ((LDSP float*)(L + AL_TB4))[tid] = ((const float*)(p.ws + WS_TB))[512 + tid] * LOG2E;
    bf16x8 qf[4]; load_q<64>(qf, proj + (rb + t) * PINP + CD_Q + 64 * hh, p.nsa_qn + l * 64, 0.125f * LOG2E, true, hi);
    const float* sd = (const float*)(p.ws + WS_SIDE) + (rb + t) * 16 + 4 + hh;
    const float gc = 1.f / (1.f + __expf(-sd[0])), gs = 1.f / (1.f + __expf(-sd[4])), gwn = 1.f / (1.f + __expf(-sd[8]));
    f32x16 o[2]; o[0] = (f32x16){}; o[1] = (f32x16){};
    u32x4 kr, vr;
    {
        const bf16_t* Kc = (const bf16_t*)(p.ws + WS_KC) + (size_t)b * 256 * 64; const bf16_t* Vc = (const bf16_t*)(p.ws + WS_VC) + (size_t)b * 256 * 64;
        const int ntc = (4 * u + 2) / 64 + 1; const float nbound = -bnd[5 + hh];
        float l_run = 0.f, prevE3 = 0.f;
        kv_load64(kr, vr, Kc, Vc, 0, tid);
        kv_store(kr, vr, KVBUF(L, 0), tid);
        if (ntc > 1) kv_load64(kr, vr, Kc, Vc, 64, tid);
        for (int T = 0; T < ntc; ++T) {
            __syncthreads();
            if (T + 1 < ntc) kv_store(kr, vr, KVBUF(L, T + 1), tid);
            if (T + 2 < ntc) kv_load64(kr, vr, Kc, Vc, 64 * (T + 2), tid);
            const LDSP unsigned char* buf = KVBUF(L, T);
            f32x16 p0 = splat16(nbound), p1 = p0;
            qkt<4>(p0, p1, buf, qf, 0, r32, hi);
#pragma unroll
            for (int g = 0; g < 4; ++g) {
#pragma unroll
                for (int i = 0; i < 4; ++i) { const int r = 4 * g + i; const int d0_ = t - 16 * (64 * T + crow(r, hi)) - 31, d1_ = d0_ - 512;
                    const float b0 = tbl[min(max(d0_, 0), 127)], b1 = tbl[min(max(d1_, 0), 127)];
                    p0[r] = (d0_ < 0) ? -INFINITY : p0[r] + b0; p1[r] = (d1_ < 0) ? -INFINITY : p1[r] + b1; }
                asm volatile("" ::: "memory");
            }
            l_run += exp_sum(p0, p1);
#pragma unroll
            for (int s2 = 0; s2 < 2; ++s2) {
                float G[4], Eo[4];
#pragma unroll
                for (int g = 0; g < 4; ++g) { const float a0 = s2 ? p1[4 * g] : p0[4 * g], a1 = s2 ? p1[4 * g + 1] : p0[4 * g + 1], a2 = s2 ? p1[4 * g + 2] : p0[4 * g + 2], a3 = s2 ? p1[4 * g + 3] : p0[4 * g + 3];
                    G[g] = (a0 + a1) + (a2 + a3); Eo[g] = __shfl_xor(a3, 32); }
#pragma unroll
                for (int g = 0; g < 4; ++g) { const float eprev = hi ? Eo[g] : (g > 0 ? Eo[g - 1] : prevE3);
                    imp[(hh * 64 + ql) * 64 + 16 * T + 8 * s2 + 2 * g + hi] = G[g] + eprev; }
                prevE3 = Eo[3];
            }
            pv(o, buf, vb, p0, p1);
        }
        l_run += __shfl_xor(l_run, 32);
        const float inv = (l_run > 0.f) ? 1.f / l_run : 0.f;
        if (hi == 0) invl[hh * 64 + ql] = inv;
        scale_rows(o, gc * inv, wsf, r32, hi);
    }
    __syncthreads();
    {
        const int q = tid >> 3, part = tid & 7;
        const float i0 = invl[q], i1 = invl[64 + q], i2 = invl[128 + q], i3 = invl[192 + q];
        float vj[8];
#pragma unroll
        for (int jj = 0; jj < 8; ++jj) { const int j = part * 8 + jj;
            const float sum = ((imp[(0 * 64 + q) * 64 + j] * i0 + imp[(1 * 64 + q) * 64 + j] * i1) + imp[(2 * 64 + q) * 64 + j] * i2) + imp[(3 * 64 + q) * 64 + j] * i3;
            vj[jj] = (j > u) ? -1.0f : ((j == u || j == 0) ? 1.0e4f : sum); }
        __syncthreads();
#pragma unroll
        for (int jj = 0; jj < 8; ++jj) imp[q * 64 + part * 8 + jj] = vj[jj];
        __syncthreads();
        int rank[8];
#pragma unroll
        for (int jj = 0; jj < 8; ++jj) rank[jj] = 0;
        for (int i = 0; i < 64; ++i) { const float vi = imp[q * 64 + i];
#pragma unroll
            for (int jj = 0; jj < 8; ++jj) rank[jj] += (vi > vj[jj] || (vi == vj[jj] && i < part * 8 + jj)) ? 1 : 0; }
        unsigned bits = 0;
#pragma unroll
        for (int jj = 0; jj < 8; ++jj) if (rank[jj] < 16 && (part * 8 + jj) <= u) bits |= 1u << jj;
        unsigned mlo = (part < 4) ? (bits << (8 * part)) : 0u, mhi = (part >= 4) ? (bits << (8 * (part - 4))) : 0u;
        mlo |= __shfl_xor(mlo, 1); mhi |= __shfl_xor(mhi, 1); mlo |= __shfl_xor(mlo, 2); mhi |= __shfl_xor(mhi, 2); mlo |= __shfl_xor(mlo, 4); mhi |= __shfl_xor(mhi, 4);
        if (part == 0) { selm[2 * q] = mlo; selm[2 * q + 1] = mhi; }
    }
    __syncthreads();
#pragma unroll
    for (int r = 0; r < 16; ++r) { ofl[(2 * r) * 64] = o[0][r]; ofl[(2 * r + 1) * 64] = o[1][r]; }
    o[0] = (f32x16){}; o[1] = (f32x16){};
    {
        const unsigned long long mymask = (unsigned long long)selm[2 * ql] | ((unsigned long long)selm[2 * ql + 1] << 32);
        unsigned ulo = selm[2 * lane], uhi = selm[2 * lane + 1];
#pragma unroll
        for (int s2 = 1; s2 < 64; s2 <<= 1) { ulo |= __shfl_xor(ulo, s2); uhi |= __shfl_xor(uhi, s2); }
        unsigned long long um = (unsigned long long)(unsigned)__builtin_amdgcn_readfirstlane((int)ulo) | ((unsigned long long)(unsigned)__builtin_amdgcn_readfirstlane((int)uhi) << 32);
        const bf16_t* Kb = proj + rb * PINP + CD_KS; const bf16_t* Vb = proj + rb * PINP + CD_VS;
        float l_run = 0.f; const float nbound = -bnd[9 + hh]; const float cfar = tbl[127] + nbound; const float* gk = p.nsa_kn + (l * 3 + 1) * 64 + (tid & 7) * 8;
        int j = __builtin_ctzll(um); um &= um - 1;
        int jn = um ? __builtin_ctzll(um) : -1; um &= um - 1;
        kv_load(kr, vr, Kb, Vb, 64 * j, tid);
        kv_store(kr, vr, KVBUF(L, 0), tid);
        if (jn >= 0) kv_load(kr, vr, Kb, Vb, 64 * jn, tid);
        for (int it = 0;; ++it) {
            __syncthreads();
            const int jnn = um ? __builtin_ctzll(um) : -1; um &= um - 1;
            if (jn >= 0) { kv_store(kr, vr, KVBUF(L, it + 1), tid); }
            if (jnn >= 0) kv_load(kr, vr, Kb, Vb, 64 * jnn, tid);
            const bool mine = (mymask >> j) & 1ull;
            if (__any(mine)) {
                const LDSP unsigned char* buf = KVBUF(L, it);
                const int k0 = 64 * j; const bool nearb = (qw - (k0 + 63)) < 113;
                f32x16 p0 = splat16(nearb ? nbound : (mine ? cfar : -INFINITY)), p1 = p0;
                qkt<4>(p0, p1, buf, qf, 0, r32, hi);
                if (nearb) bias_near(p0, p1, tbl, t - k0, 1 << 30, mine, hi);
                l_run += exp_sum(p0, p1);
                pv(o, buf, vb, p0, p1);
            }
            if (jn < 0) break;
            j = jn; jn = jnn;
        }
        l_run += __shfl_xor(l_run, 32);
        scale_rows(o, gs / l_run, wsf, r32, hi);
#pragma unroll
        for (int r = 0; r < 16; ++r) { ofl[(2 * r) * 64] += o[0][r]; ofl[(2 * r + 1) * 64] += o[1][r]; }
        o[0] = (f32x16){}; o[1] = (f32x16){};
    }
    {
        const bf16_t* Kb = proj + rb * PINP + CD_KW; const bf16_t* Vb = proj + rb * PINP + CD_VW;
        float l_run = 0.f; const float nbound = -bnd[13 + hh]; const float cfar = tbl[127] + nbound; const float* gk = p.nsa_kn + (l * 3 + 2) * 64 + (tid & 7) * 8;
        const int jlo = max(0, u - 8);
        __syncthreads();
        kv_load(kr, vr, Kb, Vb, 64 * jlo, tid);
        kv_store(kr, vr, KVBUF(L, jlo), tid);
        if (jlo < u) kv_load(kr, vr, Kb, Vb, 64 * (jlo + 1), tid);
        for (int j = jlo; j <= u; ++j) {
            __syncthreads();
            if (j + 1 <= u) { kv_store(kr, vr, KVBUF(L, j + 1), tid); }
            if (j + 2 <= u) kv_load(kr, vr, Kb, Vb, 64 * (j + 2), tid);
            const LDSP unsigned char* buf = KVBUF(L, j);
            const int k0 = 64 * j; const bool nearb = (j == u || j == u - 8 || (qw - (k0 + 63)) < 113);
            f32x16 p0 = splat16(nearb ? nbound : cfar), p1 = p0;
            qkt<4>(p0, p1, buf, qf, 0, r32, hi);
            if (nearb) bias_near(p0, p1, tbl, t - k0, 512, true, hi);
            l_run += exp_sum(p0, p1);
            pv(o, buf, vb, p0, p1);
        }
        l_run += __shfl_xor(l_run, 32);
        scale_rows(o, gwn / l_run, wsf, r32, hi);
#pragma unroll
        for (int r = 0; r < 16; ++r) { o[0][r] += ofl[(2 * r) * 64]; o[1][r] += ofl[(2 * r + 1) * 64]; }
    }
    store_o(o, (LDSP bf16_t*)(L + AL_IMP + wid * 8192), mix + (rb + qw) * DM + 768 + 64 * hh, lane, r32, hi);
}

__device__ void ph_reset_queues(const Params& p) { unsigned* ctl = (unsigned*)(p.ws + WS_CTL); const int gt = GTID(); if (gt < 8) ctl[gt] = 0u; }
__device__ void prep_cmp_task(const Params& p, int l, int task, LDSP unsigned char* L) {
    const int tid = TID(), lane = tid & 63, wid = __builtin_amdgcn_readfirstlane(tid >> 6), r32 = lane & 31, hi = lane >> 5;
    const int b = task >> 4, which = (task >> 3) & 1, nt = task & 7;
    const bf16_t* proj = (const bf16_t*)(p.ws + WS_PROJ);
    const bf16_t* phiT = (const bf16_t*)(p.ws + WS_PHIT) + (size_t)(l * 2 + which) * 64 * 2048;
    const float* pe = p.nsa_pe + (size_t)(l * 2 + which) * 32 * 64;
    const int n = 32 * nt + r32, colbase = which ? CD_VC : CD_KC;
    f32x16 acc0 = (f32x16){}, acc1 = (f32x16){};
#pragma unroll
    for (int ii = 0; ii < 4; ++ii) {
        const int i = 4 * wid + ii; const int tok = min(16 * n + i, SEQ - 1);
        const bf16_t* xr = proj + (size_t)(b * SEQ + tok) * PINP + colbase;
#pragma unroll
        for (int d0 = 0; d0 < 4; ++d0) {
            float xv[8]; load8(xr + 16 * d0 + 8 * hi, xv);
            const f32x4 pe0 = *(const f32x4*)(pe + i * 64 + 16 * d0 + 8 * hi), pe1 = *(const f32x4*)(pe + i * 64 + 16 * d0 + 8 * hi + 4);
            u32x4 aw; aw[0] = pg8::cvt_pk_bf16(xv[0] + pe0[0], xv[1] + pe0[1]); aw[1] = pg8::cvt_pk_bf16(xv[2] + pe0[2], xv[3] + pe0[3]);
            aw[2] = pg8::cvt_pk_bf16(xv[4] + pe1[0], xv[5] + pe1[1]); aw[3] = pg8::cvt_pk_bf16(xv[6] + pe1[2], xv[7] + pe1[3]);
            const bf16x8 af = __builtin_bit_cast(bf16x8, aw);
            const bf16x8 b0 = *(const bf16x8*)(phiT + (size_t)r32 * 2048 + i * 64 + 16 * d0 + 8 * hi);
            const bf16x8 b1 = *(const bf16x8*)(phiT + (size_t)(32 + r32) * 2048 + i * 64 + 16 * d0 + 8 * hi);
            acc0 = __builtin_amdgcn_mfma_f32_32x32x16_bf16(af, b0, acc0, 0, 0, 0);
            acc1 = __builtin_amdgcn_mfma_f32_32x32x16_bf16(af, b1, acc1, 0, 0, 0);
        }
    }
    LDSP float* red = (LDSP float*)L;
    __syncthreads();
#pragma unroll
    for (int r = 0; r < 16; ++r) { red[(wid * 32 + crow(r, hi)) * 64 + r32] = acc0[r]; red[(wid * 32 + crow(r, hi)) * 64 + 32 + r32] = acc1[r]; }
    __syncthreads();
    {
        const int row = tid >> 4, e4 = (tid & 15) * 4; f32x4 v = (f32x4){0.f, 0.f, 0.f, 0.f};
#pragma unroll
        for (int w8 = 0; w8 < 8; ++w8) v += *(const LDSP f32x4*)(red + (w8 * 32 + row) * 64 + e4);
        const int nn = 32 * nt + row;
        if (which == 0) {
            float ss = (v[0] * v[0] + v[1] * v[1]) + (v[2] * v[2] + v[3] * v[3]);
            ss += __shfl_xor(ss, 1); ss += __shfl_xor(ss, 2); ss += __shfl_xor(ss, 4); ss += __shfl_xor(ss, 8);
            const float rs = rsqrtf(ss * (1.f / 64.f) + EPS); const f32x4 g = *(const f32x4*)(p.nsa_kn + (l * 3 + 0) * 64 + e4);
            v = v * rs * g;
        }
        uint2 o; o.x = pk2(v[0], v[1]); o.y = pk2(v[2], v[3]);
        if (nn >= 255) { o.x = 0u; o.y = 0u; }
        *(uint2*)((bf16_t*)(p.ws + (which ? WS_VC : WS_KC)) + (size_t)(b * 256 + nn) * 64 + e4) = o;
    }
}
__device__ void ph_prep(const Params& p, int l, LDSP unsigned char* L, unsigned char* lds) {
    for (int t = blockIdx.x; t < 80; t += gridDim.x) { if (t < 64) prep_cmp_task(p, l, t, L); }
    if (gridDim.x >= 80) { if (blockIdx.x >= 64 && blockIdx.x < 80) ph_prep_cum_bh(p, l, blockIdx.x - 64, lds); }
    else for (int bh = blockIdx.x; bh < 16; bh += gridDim.x) ph_prep_cum_bh(p, l, bh, lds);
}


__device__ void fa_phase_all(const Params& p, int l, LDSP unsigned char* L, unsigned char* lds, int qslot, int n_conv  ) {
    unsigned* ctl = (unsigned*)(p.ws + WS_CTL);
    LDSP unsigned* misc = (LDSP unsigned*)(L + AL_MISC);
    bool prep_ok = false;
    for (;;) {
        __syncthreads();
        if (threadIdx.x == 0) misc[0] = atomicAdd(&ctl[qslot], 1u);
        __syncthreads();
        const unsigned qi0 = misc[0];
        if (qi0 >= 1104u + (unsigned)n_conv) break;
        if (qi0 >= 1104u) {
            const int it = ((int)qi0 - 1104) * 8 + (TID() >> 6);
            if (it < CV_ITEMS) convert_item(p, l + 1, it, (LDSF float*)lds + (TID() >> 6) * (64 * 65), TID() & 63);
            continue;
        }
        if (qi0 < 80u) {
            if (qi0 < 64u) prep_cmp_task(p, l, (int)qi0, L); else ph_prep_cum_bh(p, l, (int)qi0 - 64, lds);
            asm volatile("s_waitcnt vmcnt(0)" ::: "memory");
            __syncthreads();
            if (threadIdx.x == 0) { __threadfence(); atomicAdd(&ctl[4 + qslot], 1u); }
            continue;
        }
        const unsigned qi = qi0 - 80u;
        int r, typ, sub;
        if (qi < 768u) { r = 15 - (int)(qi / 48u); const int j = (int)(qi % 48u); typ = j >> 4; typ = (typ == 0) ? 0 : (typ == 1 ? 2 : 3); sub = j & 15; }
        else { const int v = (int)qi - 768; r = 15 - (v >> 4); typ = 1; sub = v & 15; }
        if ((typ == 2 || typ == 3) && !prep_ok) {
            if (threadIdx.x == 0) { while (__hip_atomic_load(&ctl[4 + qslot], __ATOMIC_RELAXED, __HIP_MEMORY_SCOPE_AGENT) < 80u) __builtin_amdgcn_s_sleep(8); __threadfence(); }
            asm volatile("s_waitcnt vmcnt(0)" ::: "memory");
            __syncthreads();
            prep_ok = true;
        }
        if (typ == 0) fa_diff_unit(p, l, sub >> 2, sub & 3, r, L);
        else if (typ == 1) fa_stick_unit(p, l, sub >> 2, sub & 3, r, L);
        else if (typ == 2) fa_fox_unit(p, l, sub >> 2, sub & 3, r, L);
        else fa_nsa_unit(p, l, sub >> 2, 4 * r + (sub & 3), L);
    }
}

#define XB_TMO      128
#define XB_XCNT(j)  (256  + 64 * (j))
#define XB_XSUB(j)  (1280 + 64 * (j))
#define XB_XGEN(j)  (2304 + 64 * (j))
#define XB_TOP      3328
#define XB_TOPGEN   3392
#define XCD_BAR_WORDS 3456
#define XB_SPIN_CAP (1u << 18)

__device__ __forceinline__ unsigned xb_ld(unsigned* p)              { return __hip_atomic_load(p, __ATOMIC_RELAXED, __HIP_MEMORY_SCOPE_AGENT); }
__device__ __forceinline__ unsigned xb_add(unsigned* p, unsigned v) { return __hip_atomic_fetch_add(p, v, __ATOMIC_RELAXED, __HIP_MEMORY_SCOPE_AGENT); }
__device__ __forceinline__ unsigned xb_xcc_id() { return (unsigned)__builtin_amdgcn_s_getreg((3 << 11) | 20) & 0xFu; }
#define XB_SPIN(cond, bar) do { unsigned _sp = 0; while (cond) { __builtin_amdgcn_s_sleep(1); \
    if ((++_sp & 255u) == 0u) { if (xb_ld(&(bar)[XB_TMO])) break; if (_sp > XB_SPIN_CAP) { atomicAdd(&(bar)[XB_TMO], 1u); break; } } } } while (0)

struct XcdBarrier {
    unsigned* bar; unsigned x;
    volatile LDSF unsigned* st;
};

__device__ __forceinline__ XcdBarrier xcd_barrier_post(unsigned* bar, volatile LDSF unsigned* st) {
    XcdBarrier b; b.bar = bar; b.x = xb_xcc_id(); b.st = st;
    if (threadIdx.x == 0) (void)xb_add(&bar[XB_XCNT(b.x)], 1u);
    return b;
}
__device__ __forceinline__ void xcd_barrier_complete(unsigned* bar, unsigned x, unsigned& nloc, unsigned& nx) {
    const unsigned G = gridDim.x * gridDim.y * gridDim.z;
    unsigned sum, cnt, mine, sp = 0u;
    for (;;) {
        sum = 0u; cnt = 0u; mine = 0u;
#pragma unroll
        for (unsigned j = 0; j < 16; ++j) { const unsigned c = xb_ld(&bar[XB_XCNT(j)]); sum += c; cnt += (c > 0u) ? 1u : 0u; mine = (j == x) ? c : mine; }
        if (sum == G) break;
        __builtin_amdgcn_s_sleep(1);
        if ((++sp & 255u) == 0u) { if (xb_ld(&bar[XB_TMO])) break; if (sp > XB_SPIN_CAP) { atomicAdd(&bar[XB_TMO], 1u); break; } }
    }
    nloc = mine > 0u ? mine : 1u; nx = cnt > 0u ? cnt : 1u;
}

__device__ __forceinline__ void xcd_barrier(const XcdBarrier& b) {
    asm volatile("s_waitcnt vmcnt(0)" ::: "memory");
    __syncthreads();
    if (threadIdx.x == 0) {
        unsigned* bar = b.bar;
        __builtin_amdgcn_s_waitcnt(0);
        unsigned nloc = b.st[0], nx = b.st[1];
        if (nloc == 0u) { xcd_barrier_complete(bar, b.x, nloc, nx); b.st[0] = nloc; b.st[1] = nx; }
        const unsigned old = xb_add(&bar[XB_XSUB(b.x)], 1u);
        const unsigned gen = old / nloc;
        if (old + 1u == (gen + 1u) * nloc) {
            __builtin_amdgcn_fence(__ATOMIC_RELEASE, "agent");
            asm volatile("s_waitcnt vmcnt(0)" ::: "memory");
            const unsigned og = xb_add(&bar[XB_TOP], 1u);
            const unsigned tg = og / nx;
            if (og + 1u == (tg + 1u) * nx) xb_add(&bar[XB_TOPGEN], 1u);
            else XB_SPIN(xb_ld(&bar[XB_TOPGEN]) == tg, bar);
            __builtin_amdgcn_fence(__ATOMIC_ACQUIRE, "agent");
            xb_add(&bar[XB_XGEN(b.x)], 1u);
            asm volatile("s_waitcnt vmcnt(0)" ::: "memory");
        } else {
            XB_SPIN(xb_ld(&bar[XB_XGEN(b.x)]) == gen, bar);
            __builtin_amdgcn_fence(__ATOMIC_ACQUIRE, "agent");
            asm volatile("s_waitcnt vmcnt(0)" ::: "memory");
        }
    }
    __syncthreads();
}

namespace cg = cooperative_groups;
constexpr int LDS_BYTES = 131072 + 8192 + 4096 + 1024;
#define LAS3 __attribute__((address_space(3)))
#ifndef PROBE
#define PROBE 0
#endif
__global__ void __launch_bounds__(NTHR, 2) mega(Params p) {
    extern __shared__ __attribute__((aligned(16))) unsigned char lds[];
    cg::grid_group grid = cg::this_grid();
#if PROBE
    unsigned long long tacc = 0, tph = 0, t0_;
#define GSYNC() do { t0_ = __builtin_amdgcn_s_memrealtime(); xcd_barrier(xbar); tacc += __builtin_amdgcn_s_memrealtime() - t0_; } while (0)
#define TPK(k, ...) do { if (PROBE == (k)) { t0_ = __builtin_amdgcn_s_memrealtime(); __VA_ARGS__; tph += __builtin_amdgcn_s_memrealtime() - t0_; } else { __VA_ARGS__; } } while (0)
#else
#define GSYNC() xcd_barrier(xbar)
#define TPK(k, ...) do { __VA_ARGS__; } while (0)
#endif
    LAS3 unsigned char* lds3 = (LAS3 unsigned char*)lds;
    volatile LDSF unsigned* bst = (volatile LDSF unsigned*)(lds3 + 131072 + 2048);
    if (threadIdx.x < 2) bst[threadIdx.x] = 0u;
    __syncthreads();
    XcdBarrier xbar = xcd_barrier_post((unsigned*)(p.ws + WS_CTL) + 16384, bst);
    TPK(2, ph_mod(p, lds); ph_reset_queues(p); ph_weights(p, 0, lds));
    grid.sync();
    for (int l = 0; l < DEPTH; ++l) {
        const float* mod = (const float*)(p.ws + WS_MOD) + (size_t)l * 4 * 6144;
        TPK(2, if (l == 0) ph_xa_from(p, p.x, 0, 0, (bf16_t*)(p.ws + WS_XA), (float*)(p.ws + WS_RSA), true); ph_cbias(p, l, 1));
        GSYNC();
        {   pg8::Gemm g{(const bf16_t*)(p.ws + WS_XA), (const bf16_t*)(p.ws + WS_WIN + l * WS_W1OFF), MTOK, PINP, DM}; pg8::StaticOrder S; S.init(MTOK, PINP, (int)gridDim.x, (int)blockIdx.x);
            EpiProjF E{(const float*)(p.ws + WS_RSA), (const float*)(p.ws + WS_CBIN) + (size_t)l * 4 * PINP, (bf16_t*)(p.ws + WS_PROJ), (float*)(p.ws + WS_SIDE),
                       p.diff_kn + l * 32, p.fox_kn + l * 64, p.nsa_kn + (l * 3 + 1) * 64, p.nsa_kn + (l * 3 + 2) * 64, (LDSF float*)(lds3 + 131072 + 4096), (LDSF float*)(lds3 + 131072 + 12288)};
            TPK(6, pg8::gemm_phase<EpiProjF, pg8::StaticOrder, true, PG8_SP2>(lds3, g, S, E)); }
        GSYNC();
        TPK(7, fa_phase_all(p, l, lds3, lds, l, (l + 1 < DEPTH) ? CV_ITEMS / 8 : 0));
        GSYNC();
        {   pg8::Gemm g{(const bf16_t*)p.out, (const bf16_t*)(p.ws + WS_WOUT + l * WS_W1OFF), MTOK, DM, DM}; pg8::StaticOrder S; S.init(MTOK, DM, (int)gridDim.x, (int)blockIdx.x);
            EpiResF E{nullptr, (bf16_t*)(p.ws + WS_XR), mod + 2048, p.norm_ffn_g + l * DM, mod + 4096, (bf16_t*)(p.ws + WS_XA), (float*)(p.ws + WS_RSB)};
            TPK(6, pg8::gemm_phase<EpiResF, pg8::StaticOrder, PG8_ALIGN, PG8_SP2>(lds3, g, S, E)); }
        GSYNC();
        {   pg8::Gemm g{(const bf16_t*)(p.ws + WS_XA), (const bf16_t*)(p.ws + WS_WUP + l * WS_W1OFF), MTOK, NUP, DM}; pg8::StaticOrder S; S.init(MTOK, NUP, (int)gridDim.x, (int)blockIdx.x);
            EpiUpAct E{(const float*)(p.ws + WS_RSB), (const float*)(p.ws + WS_CBUP) + (size_t)l * 4 * NUP, (bf16_t*)(p.ws + WS_ACT), (float*)(p.ws + WS_EG), (float*)(p.ws + WS_EV),
                       p.conv_w + (size_t)l * 3 * DFF, p.conv_b + (size_t)l * DFF, (LDSF float*)(lds3 + 131072 + 4096), (LDSF float*)(lds3 + 131072 + 8192)};
            TPK(6, pg8::gemm_phase<EpiUpAct, pg8::StaticOrder, true, PG8_SP2>(lds3, g, S, E)); }
        GSYNC();
        {   const float* modn = (const float*)(p.ws + WS_MOD) + (size_t)(l + 1) * 4 * 6144; const bool more = (l + 1 < DEPTH);
            pg8::Gemm g{(const bf16_t*)(p.ws + WS_ACT), (const bf16_t*)(p.ws + WS_WDN + l * WS_W1OFF), MTOK, DM, DFF}; pg8::StaticOrder S; S.init(MTOK, DM, (int)gridDim.x, (int)blockIdx.x);
            { pg8::Unit fu; for (int i = 0; S.next(i, fu); ++i) act_fixup(p, l, fu.pm); }
            __builtin_amdgcn_fence(__ATOMIC_RELEASE, "agent"); __builtin_amdgcn_fence(__ATOMIC_ACQUIRE, "agent"); __syncthreads();
            EpiResF E{more ? nullptr : p.out, (bf16_t*)(p.ws + WS_XR), mod + 5120, p.norm_mix_g + (more ? l + 1 : l) * DM, more ? modn + 1024 : mod + 1024, more ? (bf16_t*)(p.ws + WS_XA) : nullptr, more ? (float*)(p.ws + WS_RSA) : nullptr};
            TPK(6, pg8::gemm_phase<EpiResF, pg8::StaticOrder, PG8_ALIGN, PG8_SP2, true>(lds3, g, S, E)); }
    }
#if PROBE == 1
    if (blockIdx.x == 0 && threadIdx.x == 0) p.out[0] += 0.05f + (float)tacc * 0.01f * 5e-4f;
#elif PROBE >= 2
    if (blockIdx.x == 0 && threadIdx.x == 0) p.out[0] += 0.05f + (float)tph * 0.01f * 1e-4f;
#endif
}

extern "C" void kernel_launch(void* const* d_in, const int* in_sizes, int in, void* d_out, int out_size, void* d_ws, size_t ws_size, hipStream_t stream) {
    if (in != 24 || ws_size < WS_END || out_size != MTOK * DM) { fprintf(stderr, "kernel_launch: unexpected sizes (in %d, ws %zu, out %d)\n", in, ws_size, out_size); return; }
    static int grid_blocks = 0;
    if (!grid_blocks) {
        int dev = 0, cus = 0, per_cu = 0;
        hipGetDevice(&dev);
        hipDeviceGetAttribute(&cus, hipDeviceAttributeMultiprocessorCount, dev);
        hipFuncSetAttribute((const void*)mega, hipFuncAttributeMaxDynamicSharedMemorySize, LDS_BYTES);
        hipOccupancyMaxActiveBlocksPerMultiprocessor(&per_cu, (const void*)mega, NTHR, LDS_BYTES);
        if (per_cu < 1) { fprintf(stderr, "kernel_launch: occupancy query returned %d\n", per_cu); per_cu = 1; }
        if (per_cu > 1) per_cu = 1;
        grid_blocks = cus * per_cu;
        fprintf(stderr, "kernel_launch: cus %d per_cu %d grid %d\n", cus, per_cu, grid_blocks);
    }
    if (hipMemsetAsync((char*)d_ws + WS_CTL + 65536, 0, XCD_BAR_WORDS * 4, stream) != hipSuccess) { fprintf(stderr, "kernel_launch: memset failed\n"); return; }
    Params p{};
    const float** f = (const float**)&p;
    for (int i = 0; i < 24; ++i) f[i] = (const float*)d_in[i];
    p.out = (float*)d_out; p.ws = (unsigned char*)d_ws;
    void* args[] = {&p};
    hipError_t e = hipLaunchCooperativeKernel((const void*)mega, dim3(grid_blocks), dim3(NTHR), args, LDS_BYTES, stream);
    if (e != hipSuccess) fprintf(stderr, "cooperative launch failed: %s (grid %d)\n", hipGetErrorString(e), grid_blocks);
}
```

```cpp
#include <hip/hip_runtime.h>
#include <hip/hip_cooperative_groups.h>
#include <cstdint>
#include <cstdio>

typedef unsigned short bf16_t;
typedef short bf16x8 __attribute__((ext_vector_type(8)));
typedef float f32x4 __attribute__((ext_vector_type(4)));
typedef unsigned u32x4 __attribute__((ext_vector_type(4)));

constexpr int NB = 4, SEQ = 4096, DM = 1024, MTOK = NB * SEQ, DEPTH = 2;
constexpr int HD = 64, HPM = 4, DFF = 2816, PIN = 2960, PINP = 3072, NUP = 2 * DFF;
constexpr float EPS = 1e-6f;
constexpr float LOG2E = 1.4426950408889634f;
constexpr int NTHR = 512;

constexpr int CA_Q = 0, CA_K = 256, CA_V = 512, CB_Q = 768, CB_K = 1024, CB_V = 1280, CC_Q = 1536, CC_K = 1792, CC_V = 2048;
constexpr int CD_Q = 2304, CD_KC = 2560, CD_VC = 2624, CD_KS = 2688, CD_VS = 2752, CD_KW = 2816, CD_VW = 2880, C_BF = 2944, C_DG = 2948;

constexpr size_t MiB = 1u << 20;
constexpr size_t WS_CTL = 0;
constexpr size_t WS_MOD = 1 * MiB;
constexpr size_t WS_CBIN = WS_MOD + 2 * 4 * 6144 * 4;
constexpr size_t WS_CBUP = WS_CBIN + 2 * 4 * 3072 * 4;
constexpr size_t WS_TB = WS_CBUP + 2 * 4 * 5632 * 4;
constexpr size_t WS_LAM = WS_TB + 2 * 4 * 128 * 4;
constexpr size_t WS_BND = WS_LAM + 64;
constexpr size_t WS_CUM = WS_LAM + 512;
constexpr size_t WS_KC = WS_CUM + 16 * 4096 * 4;
constexpr size_t WS_VC = WS_KC + 4 * 256 * 64 * 2;
constexpr size_t WS_SELM = WS_VC + 4 * 256 * 64 * 2;
constexpr size_t WS_SMALL_END = WS_SELM + 16384 * 8;
static_assert(WS_SMALL_END <= 4 * MiB, "small region");
constexpr size_t WS_RSA = 4 * MiB;
constexpr size_t WS_RSB = 5 * MiB;
constexpr size_t WS_SIDE = 6 * MiB;
constexpr size_t WS_IMP = 7 * MiB;
constexpr size_t WS_ML = 11 * MiB;
constexpr size_t WS_PHIT = 7 * MiB;
constexpr size_t WS_W = 12 * MiB;
constexpr size_t WS_WIN = WS_W;
constexpr size_t WS_WOUT = WS_WIN + (size_t)PINP * DM * 2;
constexpr size_t WS_WUP = WS_WOUT + (size_t)DM * DM * 2;
constexpr size_t WS_WDN = WS_WUP + (size_t)NUP * DM * 2;
constexpr size_t WS_W_END = WS_WDN + (size_t)DM * DFF * 2;
static_assert(WS_W_END <= 38 * MiB, "weights region");
constexpr size_t WS_XA = 38 * MiB;
constexpr size_t WS_BIG = 70 * MiB;
constexpr size_t WS_PROJ = WS_BIG;
constexpr size_t WS_XR = WS_BIG + 96 * MiB;
constexpr size_t WS_ACT = WS_BIG;
constexpr size_t WS_W1OFF = 188 * MiB;
constexpr size_t WS_EG = 228 * MiB;
constexpr size_t WS_EV = 232 * MiB;
constexpr size_t WS_END = 236 * MiB;
static_assert(WS_W_END + WS_W1OFF <= WS_EG && WS_XR + 32 * MiB <= WS_W + WS_W1OFF, "layer-1 weights");
static_assert(WS_END <= 256 * MiB, "workspace");

struct Params {
    const float *x, *c, *rel_bias, *ada_w, *ada_b, *norm_mix_g, *norm_ffn_g, *w_in, *w_out;
    const float *diff_qn, *diff_kn, *diff_lam, *diff_sub, *fox_qn, *fox_kn, *fox_bf;
    const float *nsa_qn, *nsa_kn, *nsa_pe, *nsa_phi, *w_up, *conv_w, *conv_b, *w_down;
    float* out;
    unsigned char* ws;
};

__device__ __forceinline__ float bf2f(bf16_t v) { return __uint_as_float(((unsigned)v) << 16); }
__device__ __forceinline__ bf16_t f2bf(float f) { unsigned u = __float_as_uint(f); return (bf16_t)((u + 0x7fffu + ((u >> 16) & 1u)) >> 16); }
__device__ __forceinline__ unsigned pk2(float lo, float hi) { return (unsigned)f2bf(lo) | ((unsigned)f2bf(hi) << 16); }
__device__ __forceinline__ float siluf(float v) { return v / (1.f + __expf(-v)); }
__device__ __forceinline__ float logsigf(float v) { return fminf(v, 0.f) - log1pf(__expf(-fabsf(v))); }
__device__ __forceinline__ float wave_sum(float v) {
#pragma unroll
    for (int o = 1; o < 64; o <<= 1) v += __shfl_xor(v, o);
    return v;
}
__device__ __forceinline__ int t5_bucket(int n) {
    if (n < 16) return n < 0 ? 0 : n;
    return 16 + (n >= 19) + (n >= 21) + (n >= 24) + (n >= 27) + (n >= 31) + (n >= 35) + (n >= 40) + (n >= 46) + (n >= 52) + (n >= 59) + (n >= 67) + (n >= 77) + (n >= 87) + (n >= 99) + (n >= 113);
}
__host__ __device__ __forceinline__ int in_col_map(int n) {
    if (n < 1536) return n;
    if (n < 2944) return n + 4;
    if (n < 2948) return 1536 + (n - 2944);
    if (n < 2960) return n;
    return -1;
}
__host__ __device__ __forceinline__ int up_col_map(int n) {
    const int pn = n >> 8, c = n & 255;
    return c < 128 ? (128 * pn + c) : (DFF + 128 * pn + (c - 128));
}

__device__ __forceinline__ int opaque_v(int v) { asm volatile("" : "+v"(v)); return v; }
#define TID() opaque_v((int)threadIdx.x)
#define GTID() ((int)(blockIdx.x * blockDim.x) + TID())
#define GSIZE() ((int)(gridDim.x * blockDim.x))

__device__ __forceinline__ void load8(const bf16_t* p, float* d) {
    const u32x4 r = *(const u32x4*)p;
    d[0] = bf2f(r[0] & 0xffff); d[1] = bf2f(r[0] >> 16); d[2] = bf2f(r[1] & 0xffff); d[3] = bf2f(r[1] >> 16);
    d[4] = bf2f(r[2] & 0xffff); d[5] = bf2f(r[2] >> 16); d[6] = bf2f(r[3] & 0xffff); d[7] = bf2f(r[3] >> 16);
}
#define LDSF __attribute__((address_space(3)))
__device__ __forceinline__ void gemv4_block(const float* W, int ld, int oc, const LDSF float* vec, LDSF float* red, float* out0, int ostride, int n, float bias, int tid) {
    const int lane = tid & 63, wv = tid >> 6;
    float a0 = 0.f, a1 = 0.f, a2 = 0.f, a3 = 0.f;
    if (oc >= 0) {
        const float* w = W + (size_t)(wv * 128) * ld + oc;
#pragma unroll 32
        for (int k = 0; k < 128; ++k) { const float wk = w[(size_t)k * ld]; const f32x4 v = *(const LDSF f32x4*)(vec + (wv * 128 + k) * 4); a0 += v[0] * wk; a1 += v[1] * wk; a2 += v[2] * wk; a3 += v[3] * wk; }
    }
    red[(wv * 4 + 0) * 64 + lane] = a0; red[(wv * 4 + 1) * 64 + lane] = a1; red[(wv * 4 + 2) * 64 + lane] = a2; red[(wv * 4 + 3) * 64 + lane] = a3;
    __syncthreads();
    if (tid < 256) { const int bt = tid >> 6; float sacc = 0.f;
#pragma unroll
        for (int w8 = 0; w8 < 8; ++w8) sacc += red[(w8 * 4 + bt) * 64 + lane];
        out0[(size_t)bt * ostride + n] = sacc + bias; }
    __syncthreads();
}
__device__ void ph_mod(const Params& p, unsigned char* lds) {
    float* mod = (float*)(p.ws + WS_MOD);
    float* tb = (float*)(p.ws + WS_TB);
    float* lamv = (float*)(p.ws + WS_LAM);
    LDSF float* vec = (LDSF float*)lds; LDSF float* red = (LDSF float*)(lds + 16384);
    const int tid = TID();
    bool loaded = false;
    for (int item = blockIdx.x; item < DEPTH * 96; item += gridDim.x) {
        if (!loaded) { for (int i = tid; i < 4096; i += NTHR) { const int bt = i >> 10, k = i & 1023; vec[k * 4 + bt] = siluf(p.c[bt * DM + k]); } __syncthreads(); loaded = true; }
        const int l = item / 96, n = (item % 96) * 64 + (tid & 63);
        gemv4_block(p.ada_w + (size_t)l * DM * 6144, 6144, n, vec, red, mod + (size_t)l * 4 * 6144, 6144, n, p.ada_b[l * 6144 + n], tid);
    }
    const int gt = GTID(), gs = GSIZE();
    for (int idx = gt; idx < 2 * 4 * 128; idx += gs) {
        const int type = idx / 512, h = (idx / 128) & 3, d = idx & 127;
        tb[idx] = p.rel_bias[t5_bucket(d) * 8 + type * 4 + h];
    }
    for (int idx = gt; idx < DEPTH * 32; idx += gs) {
        const int l = idx >> 5, e = idx & 31; float v = 0.f;
        if (e < 17) {
            const int type = (e < 5) ? 0 : 1, h = (e < 4) ? e : ((e == 4) ? 0 : ((e - 5) & 3));
            const int ng = (e < 4) ? 32 : 64;
            const float* gq = (e < 4) ? p.diff_qn + l * 32 : ((e == 4) ? p.fox_qn + l * 64 : p.nsa_qn + l * 64);
            const float* gk = (e < 4) ? p.diff_kn + l * 32 : ((e == 4) ? p.fox_kn + l * 64 : p.nsa_kn + (l * 3 + (e - 5) / 4) * 64);
            float mq = 0.f, mk = 0.f; for (int i = 0; i < ng; ++i) { mq = fmaxf(mq, fabsf(gq[i])); mk = fmaxf(mk, fabsf(gk[i])); }
            float tm = 0.f; if (e != 4) { tm = -INFINITY; for (int bk2 = 0; bk2 < 32; ++bk2) tm = fmaxf(tm, p.rel_bias[bk2 * 8 + type * 4 + h]); }
            v = sqrtf((float)ng) * mq * mk * 1.02f * LOG2E + tm * LOG2E;
        }
        ((float*)(p.ws + WS_BND))[idx] = v;
    }
    for (int idx = gt; idx < DEPTH; idx += gs) {
        const float* lv = p.diff_lam + idx * 4 * 32;
        float s1 = 0.f, s2 = 0.f;
        for (int i = 0; i < 32; ++i) { s1 += lv[i] * lv[32 + i]; s2 += lv[64 + i] * lv[96 + i]; }
        const float lam_init = 0.8f - 0.6f * expf(-0.3f * (float)idx);
        lamv[idx] = expf(s1) - expf(s2) + lam_init;
    }
}
__device__ void ph_cbias(const Params& p, int lfirst, int lcount) {
    const float* mod = (const float*)(p.ws + WS_MOD);
    const int tid_ = TID(); const int lane = tid_ & 63, wv = tid_ >> 6;
    const int gw = blockIdx.x * (NTHR >> 6) + wv, ngw = gridDim.x * (NTHR >> 6);
    constexpr int NCOL = PINP + NUP;
    const int per = (lcount * NCOL + ngw - 1) / ngw; const int c0 = gw * per, c1 = min(lcount * NCOL, c0 + per);
    int cur_key = -1; float sh[4][16];
    for (int c = c0; c < c1; ++c) {
        const int l = lfirst + c / NCOL, r = c % NCOL; const bool isin = r < PINP; const int n = isin ? r : r - PINP; const int key = l * 2 + (isin ? 0 : 1);
        if (key != cur_key) { cur_key = key; const int shoff = isin ? 0 : 3072;
#pragma unroll
            for (int bt = 0; bt < 4; ++bt)
#pragma unroll
                for (int q4 = 0; q4 < 4; ++q4) { const f32x4 v = *(const f32x4*)(mod + (size_t)(l * 4 + bt) * 6144 + shoff + 16 * lane + 4 * q4); sh[bt][4 * q4] = v[0]; sh[bt][4 * q4 + 1] = v[1]; sh[bt][4 * q4 + 2] = v[2]; sh[bt][4 * q4 + 3] = v[3]; } }
        const bf16_t* wrow = (const bf16_t*)(p.ws + (isin ? WS_WIN : WS_WUP) + l * WS_W1OFF) + (size_t)n * DM + 16 * lane;
        float w[16]; load8(wrow, w); load8(wrow + 8, w + 8);
        float a0 = 0.f, a1 = 0.f, a2 = 0.f, a3 = 0.f;
#pragma unroll
        for (int j = 0; j < 16; ++j) { a0 += sh[0][j] * w[j]; a1 += sh[1][j] * w[j]; a2 += sh[2][j] * w[j]; a3 += sh[3][j] * w[j]; }
        a0 = wave_sum(a0); a1 = wave_sum(a1); a2 = wave_sum(a2); a3 = wave_sum(a3);
        if (lane == 0) { float* o = isin ? (float*)(p.ws + WS_CBIN) + (size_t)l * 4 * PINP : (float*)(p.ws + WS_CBUP) + (size_t)l * 4 * NUP; const int ld = isin ? PINP : NUP;
            o[n] = a0; o[ld + n] = a1; o[2 * ld + n] = a2; o[3 * ld + n] = a3; }
    }
}
template <int MAPK>
__device__ __forceinline__ void convert_one(const float* W, int K, int Nsrc, int Npad, bf16_t* Wt, LDSF float* scr, int it, int lane) {
    const int nnb = Npad / 64;
    const int kb = it / nnb, nb = it % nnb, k0 = kb * 64, n0 = nb * 64;
    {
        const int n = n0 + lane;
        const int oc = MAPK == 0 ? n : (MAPK == 1 ? in_col_map(n) : up_col_map(n));
        const float* wp = W + (size_t)k0 * Nsrc + (oc >= 0 ? oc : 0);
#pragma unroll 1
        for (int hh = 0; hh < 2; ++hh) {
            float tv[32];
#pragma unroll
            for (int i = 0; i < 32; ++i) tv[i] = wp[(size_t)(32 * hh + i) * Nsrc];
#pragma unroll
            for (int i = 0; i < 32; ++i) scr[(32 * hh + i) * 65 + lane] = (oc >= 0) ? tv[i] : 0.f;
        }
    }
    __builtin_amdgcn_s_waitcnt(0xc07f); __builtin_amdgcn_wave_barrier();
    {
        const int c = lane & 7;
#pragma unroll
        for (int j = 0; j < 8; ++j) { const int nn = 8 * j + (lane >> 3); const LDSF float* sp = scr + (8 * c) * 65 + nn;
            u32x4 o; o[0] = pk2(sp[0], sp[65]); o[1] = pk2(sp[130], sp[195]); o[2] = pk2(sp[260], sp[325]); o[3] = pk2(sp[390], sp[455]);
            *(u32x4*)(Wt + (size_t)(n0 + nn) * K + k0 + 8 * c) = o; }
    }
    __builtin_amdgcn_s_waitcnt(0xc07f); __builtin_amdgcn_wave_barrier();
}
constexpr int CV_IN = 16 * (PINP / 64), CV_OUT = 16 * (DM / 64), CV_UP = 16 * (NUP / 64), CV_DN = (DFF / 64) * (DM / 64), CV_PHI = 32, CV_ITEMS = CV_IN + CV_OUT + CV_UP + CV_DN + 2 * CV_PHI;
static_assert(CV_ITEMS == 3200, "conversion item count");
__device__ void convert_item(const Params& p, int l, int idx, LDSF float* scr, int lane) {
    if (idx < CV_IN) { convert_one<1>(p.w_in + (size_t)l * DM * PIN, DM, PIN, PINP, (bf16_t*)(p.ws + WS_WIN + l * WS_W1OFF), scr, idx, lane); return; } idx -= CV_IN;
    if (idx < CV_OUT) { convert_one<0>(p.w_out + (size_t)l * DM * DM, DM, DM, DM, (bf16_t*)(p.ws + WS_WOUT + l * WS_W1OFF), scr, idx, lane); return; } idx -= CV_OUT;
    if (idx < CV_UP) { convert_one<2>(p.w_up + (size_t)l * DM * NUP, DM, NUP, NUP, (bf16_t*)(p.ws + WS_WUP + l * WS_W1OFF), scr, idx, lane); return; } idx -= CV_UP;
    if (idx < CV_DN) { convert_one<0>(p.w_down + (size_t)l * DFF * DM, DFF, DM, DM, (bf16_t*)(p.ws + WS_WDN + l * WS_W1OFF), scr, idx, lane); return; } idx -= CV_DN;
    const int w2 = idx / CV_PHI; idx -= w2 * CV_PHI;
    convert_one<0>(p.nsa_phi + (size_t)(l * 2 + w2) * 2048 * 64, 2048, 64, 64, (bf16_t*)(p.ws + WS_PHIT) + (size_t)(l * 2 + w2) * 64 * 2048, scr, idx, lane);
}
__device__ void ph_weights(const Params& p, int l, unsigned char* lds) {
    const int tid_ = TID(); const int lane = tid_ & 63, wv = tid_ >> 6;
    const int ngw = gridDim.x * (NTHR >> 6), gw = ngw - 1 - (blockIdx.x * (NTHR >> 6) + wv);
    LDSF float* scr = (LDSF float*)lds + wv * (64 * 65);
    for (int it = gw; it < CV_ITEMS; it += ngw) convert_item(p, l, it, scr, lane);
}
__device__ void ph_xa_from(const Params& p, const float* src, int l, int which  , bf16_t* XA, float* rowss, bool write_xa) {
    const float* mod = (const float*)(p.ws + WS_MOD);
    const float* g = (which == 0 ? p.norm_mix_g : p.norm_ffn_g) + l * DM;
    const int tid_ = TID(); const int lane = tid_ & 63, wv = tid_ >> 6;
    const int gw = blockIdx.x * (blockDim.x >> 6) + wv, ngw = gridDim.x * (blockDim.x >> 6);
    for (int row0 = gw; row0 < MTOK; row0 += 2 * ngw) {
        f32x4 v[2][4];
#pragma unroll
        for (int rr = 0; rr < 2; ++rr) { const int row = min(row0 + rr * ngw, MTOK - 1);
#pragma unroll
            for (int j = 0; j < 4; ++j) v[rr][j] = *(const f32x4*)(src + (size_t)row * DM + j * 256 + lane * 4); }
#pragma unroll
        for (int rr = 0; rr < 2; ++rr) {
            const int row = row0 + rr * ngw;
            if (row < MTOK) {
                const int b = row / SEQ; const float* sc = mod + (size_t)(l * 4 + b) * 6144 + (which == 0 ? 1024 : 4096);
                float ss = 0.f;
#pragma unroll
                for (int j = 0; j < 4; ++j) {
                    const int k = j * 256 + lane * 4; const f32x4 x = v[rr][j];
                    ss += x[0] * x[0] + x[1] * x[1] + x[2] * x[2] + x[3] * x[3];
                    if (write_xa) {
                        const f32x4 gv = *(const f32x4*)(g + k); const f32x4 sv = *(const f32x4*)(sc + k);
                        uint2 o; o.x = pk2(x[0] * gv[0] * (1.f + sv[0]), x[1] * gv[1] * (1.f + sv[1])); o.y = pk2(x[2] * gv[2] * (1.f + sv[2]), x[3] * gv[3] * (1.f + sv[3]));
                        *(uint2*)(XA + (size_t)row * DM + k) = o;
                        uint2 xo; xo.x = pk2(x[0], x[1]); xo.y = pk2(x[2], x[3]); *(uint2*)((bf16_t*)(p.ws + WS_XR) + (size_t)row * DM + k) = xo;
                    }
                }
                ss = wave_sum(ss);
                if (lane < 16) rowss[(size_t)row * 16 + lane] = (lane == 0) ? ss : 0.f;
            }
        }
    }
}

namespace pg8 {
#define PG8_LAS __attribute__((address_space(3)))
typedef unsigned short bf16_t;
typedef short bf16x8 __attribute__((ext_vector_type(8)));
typedef float f32x4 __attribute__((ext_vector_type(4)));
typedef unsigned u32x4 __attribute__((ext_vector_type(4)));
constexpr int BM = 256, BK = 64, HALF = 128, HTB = HALF * BK * 2  , STAGE_BYTES = 8 * HTB, NXCD = 8, WGM = 8;

__host__ __device__ __forceinline__ int lds_byte(int r, int c) { const int st = (r >> 4) * 2 + (c >> 5), rr = r & 15, cc = c & 31, ob = rr * 64 + cc * 2; return st * 1024 + (ob ^ (((ob >> 9) & 1) << 5)); }
__host__ __device__ __forceinline__ void stage_rc(int b, int& R, int& C) { const int st = b / 1024, sb = b % 1024, swz = sb ^ (((sb >> 9) & 1) << 5); R = (st >> 1) * 16 + swz / 64; C = (st & 1) * 32 + (swz % 64) / 2; }
__host__ __device__ __forceinline__ int perm32(int rho) { const int n = rho >> 4, i = rho & 15; return 8 * (i >> 2) + 4 * n + (i & 3); }

struct Unit { int pm, pn; };
struct Gemm { const bf16_t* A; const bf16_t* Bt; int M, N, K; };

struct StaticOrder {
    int nM, nN, nwg, G, c;
    __host__ __device__ void init(int M, int N, int G_, int c_) { nM = M / BM; nN = N / BM; nwg = nM * nN; G = G_; c = c_; }
    __host__ __device__ bool next(int i, Unit& u) const {
        const long L = (long)i * G + c; if (L >= nwg) return false;
        int wgid = (int)L; { const int q = nwg / NXCD, r = nwg % NXCD, xcd = wgid % NXCD, off = wgid / NXCD; wgid = (xcd < r ? xcd * (q + 1) : r * (q + 1) + (xcd - r) * q) + off; }
        const int nig = WGM * nN, gid = wgid / nig, fm = gid * WGM, gsz = (nM - fm) < WGM ? (nM - fm) : WGM;
        u.pm = fm + ((wgid % nig) % gsz); u.pn = (wgid % nig) / gsz; return true;
    }
    __device__ __forceinline__ void a_ready(const Unit&) const {}
    __device__ __forceinline__ void done(const Unit&) const {}
};


__device__ __forceinline__ unsigned cvt_pk_bf16(float lo, float hi) { unsigned r; asm volatile("v_cvt_pk_bf16_f32 %0, %1, %2" : "=v"(r) : "v"(lo), "v"(hi)); return r; }
template <class Epi, class Sched, bool ALIGN_EPI = false, bool SP2 = false>
__device__ __forceinline__ void gemm_phase(PG8_LAS unsigned char* lds, const Gemm g, const Sched& S, const Epi& E) {
    const int tid = TID(), wid = __builtin_amdgcn_readfirstlane(tid >> 6), lane = tid & 63, wr = wid >> 2, wc = wid & 3, fr = lane & 15, fq = lane >> 4;
    const int K = g.K, nt = K / BK;
    unsigned voffA[2], voffB[2];
#pragma unroll
    for (int i = 0; i < 2; ++i) { int R, C; stage_rc(tid * 16 + i * 8192, R, C); const int Rb = Epi::PERM ? ((R & ~31) + perm32(R & 31)) : R;
        voffA[i] = (unsigned)(R * K + C) * 2u; voffB[i] = (unsigned)(Rb * K + C) * 2u; }
    const size_t kstep = (size_t)(BK * 2);
    const size_t hstep = (size_t)HALF * K * 2;
    const size_t tstep = 2 * hstep;
    const unsigned ldsw = (unsigned)wid * 1024u;
    const int aoff = lds_byte(wr * 64 + fr, fq * 8), boff = lds_byte(wc * 32 + fr, fq * 8);
#define PG8_SA(b, h) (((b) * 2 + (h)) * HTB)
#define PG8_SB(b, h) ((4 + (b) * 2 + (h)) * HTB)
#define PG8_STAGE(bufoff, gbase, voff) do { _Pragma("unroll") for (int _i = 0; _i < 2; ++_i) \
        __builtin_amdgcn_global_load_lds((const unsigned*)((const char*)(gbase) + (voff)[_i]), (PG8_LAS unsigned*)(lds + (bufoff) + ldsw + _i * 8192), 16, 0, 0); } while (0)
#define PG8_LDA(dst, b, h) do { _Pragma("unroll") for (int m = 0; m < 4; ++m) _Pragma("unroll") for (int k = 0; k < 2; ++k) dst[m][k] = *(const PG8_LAS bf16x8*)(lds + PG8_SA(b, h) + aoff + m * 2048 + k * 1024); } while (0)
#define PG8_LDB(dst, b, h) do { _Pragma("unroll") for (int n = 0; n < 2; ++n) _Pragma("unroll") for (int k = 0; k < 2; ++k) dst[n][k] = *(const PG8_LAS bf16x8*)(lds + PG8_SB(b, h) + boff + n * 2048 + k * 1024); } while (0)
#define PG8_MMA(ai, bj, At, Bt) do { __builtin_amdgcn_s_setprio(1); _Pragma("unroll") for (int m = 0; m < 4; ++m) _Pragma("unroll") for (int n = 0; n < 2; ++n) _Pragma("unroll") for (int k = 0; k < 2; ++k) \
        acc[ai][bj][m][n] = __builtin_amdgcn_mfma_f32_16x16x32_bf16(Bt[n][k], At[m][k], acc[ai][bj][m][n], 0, 0, 0); __builtin_amdgcn_s_setprio(0); } while (0)
#define PG8_WAIT_V(n) asm volatile("s_waitcnt vmcnt(" #n ")" ::: "memory")
#define PG8_WAIT_L(n) asm volatile("s_waitcnt lgkmcnt(" #n ")" ::: "memory")
#define PG8_BAR __builtin_amdgcn_s_barrier()
#define PG8_SCHED __builtin_amdgcn_sched_barrier(0)
    Unit cur, nxt; int ui = 0;
    if (!S.next(0, cur)) return;
    f32x4 acc[2][2][4][2];
#pragma unroll
    for (int a = 0; a < 2; ++a)
#pragma unroll
        for (int b = 0; b < 2; ++b)
#pragma unroll
            for (int m = 0; m < 4; ++m)
#pragma unroll
                for (int n = 0; n < 2; ++n) acc[a][b][m][n] = (f32x4){0.f, 0.f, 0.f, 0.f};
    bf16x8 At[4][2], B0[2][2], B1[2][2];
    const char* cA = (const char*)g.A + (size_t)cur.pm * tstep; const char* cB = (const char*)g.Bt + (size_t)cur.pn * tstep;
    S.a_ready(cur);
    if constexpr (SP2) {
        PG8_STAGE(PG8_SB(0, 0), cB, voffB); PG8_STAGE(PG8_SB(0, 1), cB + hstep, voffB); PG8_STAGE(PG8_SA(0, 0), cA, voffA); PG8_STAGE(PG8_SA(0, 1), cA + hstep, voffA);
        if (wr == 1) PG8_BAR;
        PG8_WAIT_V(2); PG8_BAR;
        PG8_STAGE(PG8_SB(1, 0), cB + kstep, voffB); PG8_STAGE(PG8_SA(1, 0), cA + kstep, voffA); PG8_STAGE(PG8_SB(1, 1), cB + hstep + kstep, voffB);
        PG8_WAIT_V(6); PG8_BAR;
    } else {
        PG8_STAGE(PG8_SB(0, 0), cB, voffB); PG8_STAGE(PG8_SA(0, 0), cA, voffA); PG8_STAGE(PG8_SB(0, 1), cB + hstep, voffB); PG8_STAGE(PG8_SA(0, 1), cA + hstep, voffA);
        if (wr == 1) PG8_BAR;
        PG8_WAIT_V(4); PG8_BAR;
        PG8_STAGE(PG8_SB(1, 0), cB + kstep, voffB); PG8_STAGE(PG8_SA(1, 0), cA + kstep, voffA); PG8_STAGE(PG8_SB(1, 1), cB + hstep + kstep, voffB);
        PG8_WAIT_V(6); PG8_BAR;
    }
    for (;;) {
        const bool has_next = S.next(ui + 1, nxt);
        const char* nA = has_next ? (const char*)g.A + (size_t)nxt.pm * tstep : cA; const char* nB = has_next ? (const char*)g.Bt + (size_t)nxt.pn * tstep : cB;
        for (int t = 0; t < nt; t += 2) {
            const bool last = (t == nt - 2);
            const char* a1 = cA + (size_t)(t + 1) * kstep;
            const char* a2 = last ? nA : cA + (size_t)(t + 2) * kstep; const char* b2 = last ? nB : cB + (size_t)(t + 2) * kstep;
            const char* a3 = a2 + kstep; const char* b3 = b2 + kstep;
            if (last && has_next) S.a_ready(nxt);
            if constexpr (SP2) {
            PG8_LDB(B0, 0, 0); PG8_LDB(B1, 0, 1); PG8_SCHED; PG8_LDA(At, 0, 0); PG8_STAGE(PG8_SA(1, 1), a1 + hstep, voffA);
            PG8_WAIT_V(8); PG8_WAIT_L(0); PG8_BAR; PG8_MMA(0, 0, At, B0); PG8_MMA(0, 1, At, B1); PG8_BAR; PG8_SCHED;
            PG8_LDA(At, 0, 1); PG8_STAGE(PG8_SB(0, 0), b2, voffB); PG8_STAGE(PG8_SB(0, 1), b2 + hstep, voffB); PG8_STAGE(PG8_SA(0, 0), a2, voffA);
            PG8_WAIT_V(8); PG8_WAIT_L(0); PG8_BAR; PG8_MMA(1, 0, At, B0); PG8_MMA(1, 1, At, B1); PG8_BAR; PG8_SCHED;
            PG8_LDB(B0, 1, 0); PG8_LDB(B1, 1, 1); PG8_SCHED; PG8_LDA(At, 1, 0); PG8_STAGE(PG8_SA(0, 1), a2 + hstep, voffA);
            PG8_WAIT_V(8); PG8_WAIT_L(0); PG8_BAR; PG8_MMA(0, 0, At, B0); PG8_MMA(0, 1, At, B1); PG8_BAR; PG8_SCHED;
            PG8_LDA(At, 1, 1); PG8_STAGE(PG8_SB(1, 0), b3, voffB); PG8_STAGE(PG8_SB(1, 1), b3 + hstep, voffB); PG8_STAGE(PG8_SA(1, 0), a3, voffA);
            PG8_WAIT_V(8); PG8_WAIT_L(0); PG8_BAR; PG8_MMA(1, 0, At, B0); PG8_MMA(1, 1, At, B1); PG8_BAR; PG8_SCHED;
            } else {
            PG8_LDB(B0, 0, 0); PG8_SCHED; PG8_LDA(At, 0, 0); PG8_STAGE(PG8_SA(1, 1), a1 + hstep, voffA);
            PG8_WAIT_L(8); PG8_BAR; PG8_WAIT_L(0); PG8_MMA(0, 0, At, B0); PG8_BAR; PG8_SCHED;
            PG8_LDB(B1, 0, 1); PG8_STAGE(PG8_SB(0, 0), b2, voffB);
            PG8_BAR; PG8_WAIT_L(0); PG8_MMA(0, 1, At, B1); PG8_BAR;
            PG8_LDA(At, 0, 1); PG8_STAGE(PG8_SA(0, 0), a2, voffA);
            PG8_BAR; PG8_WAIT_L(0); PG8_MMA(1, 0, At, B0); PG8_BAR; PG8_SCHED;
            PG8_STAGE(PG8_SB(0, 1), b2 + hstep, voffB);
            PG8_WAIT_V(6); PG8_BAR; PG8_MMA(1, 1, At, B1); PG8_BAR;
            PG8_LDB(B0, 1, 0); PG8_SCHED; PG8_LDA(At, 1, 0); PG8_STAGE(PG8_SA(0, 1), a2 + hstep, voffA);
            PG8_WAIT_L(8); PG8_BAR; PG8_WAIT_L(0); PG8_MMA(0, 0, At, B0); PG8_BAR; PG8_SCHED;
            PG8_LDB(B1, 1, 1); PG8_STAGE(PG8_SB(1, 0), b3, voffB);
            PG8_BAR; PG8_WAIT_L(0); PG8_MMA(0, 1, At, B1); PG8_BAR;
            PG8_LDA(At, 1, 1); PG8_STAGE(PG8_SA(1, 0), a3, voffA);
            PG8_BAR; PG8_WAIT_L(0); PG8_MMA(1, 0, At, B0); PG8_BAR; PG8_SCHED;
            PG8_STAGE(PG8_SB(1, 1), b3 + hstep, voffB);
            PG8_WAIT_V(6); PG8_BAR; PG8_MMA(1, 1, At, B1); PG8_BAR;
            }
        }
        if constexpr (ALIGN_EPI) { if (wr == 0) PG8_BAR; }
        if constexpr (!Epi::AFTER_DRAIN) { E(acc, cur, wr, wc, fr, fq); S.done(cur); }
        if (!has_next) break;
#pragma unroll
        for (int a = 0; a < 2; ++a)
#pragma unroll
            for (int b = 0; b < 2; ++b)
#pragma unroll
                for (int m = 0; m < 4; ++m)
#pragma unroll
                    for (int n = 0; n < 2; ++n) acc[a][b][m][n] = (f32x4){0.f, 0.f, 0.f, 0.f};
        cur = nxt; cA = nA; cB = nB; ++ui;
        if constexpr (ALIGN_EPI) { if (wr == 1) PG8_BAR; }
    }
    PG8_WAIT_V(0);
    if constexpr (!ALIGN_EPI) { if (wr == 0) PG8_BAR; }
    PG8_BAR;
    if constexpr (Epi::AFTER_DRAIN) { E.fused(acc, cur, wr, wc, fr, fq, lds, wid, lane); S.done(cur); }
#undef PG8_SA
#undef PG8_SB
#undef PG8_STAGE
#undef PG8_LDA
#undef PG8_LDB
#undef PG8_MMA
#undef PG8_WAIT_V
#undef PG8_WAIT_L
#undef PG8_BAR
#undef PG8_SCHED
}
}

#ifndef PG8_SP2
#define PG8_SP2 true
#endif
#ifndef PG8_ALIGN
#define PG8_ALIGN true
#endif

__device__ __forceinline__ float row_rstd16(const float* rowss, int row) {
    const f32x4* r = (const f32x4*)(rowss + (size_t)row * 16);
    const f32x4 a = r[0], b = r[1], c = r[2], d = r[3];
    const float s = ((a[0] + a[1]) + (a[2] + a[3])) + ((b[0] + b[1]) + (b[2] + b[3])) + ((c[0] + c[1]) + (c[2] + c[3])) + ((d[0] + d[1]) + (d[2] + d[3]));
    return rsqrtf(s * (1.f / DM) + EPS);
}
struct EpiProjF {
    static constexpr bool PERM = true, AFTER_DRAIN = false;
    const float* rowss; const float* cb; bf16_t* proj; float* side; const float* g_a; const float* g_b; const float* g_ds; const float* g_dw; LDSF float* xs  ; LDSF float* rsl  ;
    __device__ __forceinline__ void operator()(const pg8::f32x4 (&acc)[2][2][4][2], const pg8::Unit& u, int wr, int wc, int fr, int fq) const {
        const int b = u.pm >> 4, colt = u.pn * 256 + wc * 32 + 8 * fq;
        const int knmode = (u.pn == 1) ? 1 : (u.pn == 4) ? 2 : (u.pn == 10) ? 3 : (u.pn == 11) ? 4 : 0;
        f32x4 cv[2][2];
#pragma unroll
        for (int bj = 0; bj < 2; ++bj)
#pragma unroll
            for (int n = 0; n < 2; ++n) cv[bj][n] = *(const f32x4*)(cb + b * PINP + colt + bj * 128 + 4 * n);
        {   const int tid = (wr * 4 + wc) * 64 + fq * 16 + fr;
            if (tid < 256) rsl[tid] = row_rstd16(rowss, u.pm * 256 + tid);
            asm volatile("s_waitcnt vmcnt(0) lgkmcnt(0)" ::: "memory"); __builtin_amdgcn_s_barrier(); asm volatile("" ::: "memory"); }
        if (knmode != 0) {
#pragma unroll
            for (int ai = 0; ai < 2; ++ai)
#pragma unroll
                for (int m = 0; m < 4; ++m) {
                    const float rsm = rsl[ai * 128 + wr * 64 + m * 16 + fr];
#pragma unroll
                    for (int bj = 0; bj < 2; ++bj) {
                        const f32x4 v0 = acc[ai][bj][m][0] * rsm + cv[bj][0], v1 = acc[ai][bj][m][1] * rsm + cv[bj][1];
                        float ss = (v0[0] * v0[0] + v0[1] * v0[1]) + (v0[2] * v0[2] + v0[3] * v0[3]) + (v1[0] * v1[0] + v1[1] * v1[1]) + (v1[2] * v1[2] + v1[3] * v1[3]);
                        ss += __shfl_xor(ss, 16); ss += __shfl_xor(ss, 32);
                        if (fq == 0) xs[((wr * 4 + wc) * 16 + (ai * 4 + m) * 2 + bj) * 16 + fr] = ss;
                    }
                }
            asm volatile("s_waitcnt lgkmcnt(0)" ::: "memory"); __builtin_amdgcn_s_barrier(); asm volatile("" ::: "memory");
        }
#pragma unroll
        for (int ai = 0; ai < 2; ++ai)
#pragma unroll
            for (int m = 0; m < 4; ++m) {
                const int row = u.pm * 256 + ai * 128 + wr * 64 + m * 16 + fr; const float rs = rsl[ai * 128 + wr * 64 + m * 16 + fr];
#pragma unroll
                for (int bj = 0; bj < 2; ++bj) {
                    f32x4 v0 = acc[ai][bj][m][0] * rs + cv[bj][0], v1 = acc[ai][bj][m][1] * rs + cv[bj][1]; const int col0 = colt + bj * 128;
                    if (col0 >= C_BF && col0 < PIN) { *(f32x4*)(side + (size_t)row * 16 + (col0 - C_BF)) = v0; *(f32x4*)(side + (size_t)row * 16 + (col0 - C_BF) + 4) = v1; }
                    const bool on = (knmode == 1) || (knmode == 2) || (knmode == 3 && bj == 1 && wc < 2) || (knmode == 4 && bj == 0 && wc < 2);
                    if (on) {
                        const int xi = (ai * 4 + m) * 2 + bj;
                        float tot = xs[((wr * 4 + wc) * 16 + xi) * 16 + fr]; float dn = 1.f / 32.f;
                        if (knmode != 1) { tot += xs[((wr * 4 + (wc ^ 1)) * 16 + xi) * 16 + fr]; dn = 1.f / 64.f; }
                        const float nrm = rsqrtf(tot * dn + EPS);
                        const float* gp = (knmode == 1) ? g_a + 8 * fq : ((knmode == 2) ? g_b : (knmode == 3 ? g_ds : g_dw)) + (wc & 1) * 32 + 8 * fq;
                        v0 = v0 * nrm * *(const f32x4*)gp; v1 = v1 * nrm * *(const f32x4*)(gp + 4);
                    }
                    u32x4 w; w[0] = pg8::cvt_pk_bf16(v0[0], v0[1]); w[1] = pg8::cvt_pk_bf16(v0[2], v0[3]); w[2] = pg8::cvt_pk_bf16(v1[0], v1[1]); w[3] = pg8::cvt_pk_bf16(v1[2], v1[3]);
                    *(u32x4*)(proj + (size_t)row * PINP + col0) = w;
                }
            }
    }
};
struct EpiResF {
    static constexpr bool PERM = false, AFTER_DRAIN = false;
    static constexpr int RB = 2;
    float* xout32; bf16_t* xr; const float* gate; const float* g; const float* sc; bf16_t* xa; float* rowss;
    __device__ __forceinline__ void operator()(const pg8::f32x4 (&acc)[2][2][4][2], const pg8::Unit& u, int wr, int wc, int fr, int fq) const {
        const int b = u.pm >> 4, col0 = u.pn * 256 + wc * 32 + 4 * fq;
        f32x4 gt[2][2], gm[2][2];
#pragma unroll
        for (int bj = 0; bj < 2; ++bj)
#pragma unroll
            for (int n = 0; n < 2; ++n) { const int c = col0 + bj * 128 + n * 16; gt[bj][n] = *(const f32x4*)(gate + b * 6144 + c);
                if (xa) gm[bj][n] = *(const f32x4*)(g + c) * (*(const f32x4*)(sc + b * 6144 + c) + 1.0f); else gm[bj][n] = (f32x4){0.f, 0.f, 0.f, 0.f}; }
#pragma unroll
        for (int ai = 0; ai < 2; ++ai)
#pragma unroll
            for (int mh = 0; mh < 4 / RB; ++mh) {
                uint2 xw[RB][2][2];
#pragma unroll
                for (int mm = 0; mm < RB; ++mm)
#pragma unroll
                    for (int bj = 0; bj < 2; ++bj)
#pragma unroll
                        for (int n = 0; n < 2; ++n)
                            xw[mm][bj][n] = *(const uint2*)(xr + (size_t)(u.pm * 256 + ai * 128 + wr * 64 + (RB * mh + mm) * 16 + fr) * DM + col0 + bj * 128 + n * 16);
                asm volatile("" ::: "memory");
#pragma unroll
                for (int mm = 0; mm < RB; ++mm) {
                    const int m = RB * mh + mm; const int row = u.pm * 256 + ai * 128 + wr * 64 + m * 16 + fr; float ss = 0.f;
#pragma unroll
                    for (int bj = 0; bj < 2; ++bj)
#pragma unroll
                        for (int n = 0; n < 2; ++n) { const size_t off = (size_t)row * DM + col0 + bj * 128 + n * 16; const uint2 xv = xw[mm][bj][n];
                            const f32x4 xi = (f32x4){__uint_as_float(xv.x << 16), __uint_as_float(xv.x & 0xffff0000u), __uint_as_float(xv.y << 16), __uint_as_float(xv.y & 0xffff0000u)};
                            const f32x4 o = xi + gt[bj][n] * acc[ai][bj][m][n];
                            ss += (o[0] * o[0] + o[1] * o[1]) + (o[2] * o[2] + o[3] * o[3]);
                            if (xa) { uint2 w; w.x = pg8::cvt_pk_bf16(o[0], o[1]); w.y = pg8::cvt_pk_bf16(o[2], o[3]); *(uint2*)(xr + off) = w;
                                const f32x4 q = o * gm[bj][n]; uint2 w2; w2.x = pg8::cvt_pk_bf16(q[0], q[1]); w2.y = pg8::cvt_pk_bf16(q[2], q[3]); *(uint2*)(xa + off) = w2; }
                            else *(f32x4*)(xout32 + off) = o; }
                    if (rowss) { ss += __shfl_xor(ss, 16); ss += __shfl_xor(ss, 32); if (fq == 0) rowss[(size_t)row * 16 + u.pn * 4 + wc] = ss; }
                }
            }
    }
};


#define DPPF(oldv, src, CTRL) __builtin_bit_cast(float, __builtin_amdgcn_update_dpp(__builtin_bit_cast(int, (float)(oldv)), __builtin_bit_cast(int, (float)(src)), (CTRL), 0xf, 0xf, false))
struct EpiUpAct {
    static constexpr bool PERM = true, AFTER_DRAIN = false;
    const float* rowss; const float* cb; bf16_t* act; float* eg; float* ev; const float* cw; const float* cbias; LDSF float* xch; LDSF float* cst  ;
    __device__ __forceinline__ void operator()(const pg8::f32x4 (&acc)[2][2][4][2], const pg8::Unit& u, int wr, int wc, int fr, int fq) const {
        const int b = u.pm >> 4, cih = wc * 32 + 8 * fq, jcol = u.pn * 128 + cih;
        const float* cbg = cb + b * NUP + u.pn * 256 + cih; const float* cbv = cbg + 128;
        {
            const int tid = (wr * 4 + wc) * 64 + fq * 16 + fr, col = tid & 127, arr = tid >> 7;
            const float* src = (arr == 0) ? cb + b * NUP + u.pn * 256 + col : (arr == 1) ? cb + b * NUP + u.pn * 256 + 128 + col : cw + (arr - 2) * DFF + u.pn * 128 + col;
            cst[arr * 128 + col] = *src;
            if (tid < 256) { const int a2 = 4 + (tid >> 7); cst[a2 * 128 + col] = (a2 == 4) ? cw[2 * DFF + u.pn * 128 + col] : cbias[u.pn * 128 + col]; }
            else cst[768 + (tid - 256)] = row_rstd16(rowss, u.pm * 256 + (tid - 256));
            const f32x4 cg0 = *(const f32x4*)cbg, cg1 = *(const f32x4*)(cbg + 4);
            const f32x4 cv0 = *(const f32x4*)cbv, cv1 = *(const f32x4*)(cbv + 4);
            asm volatile("s_waitcnt vmcnt(0) lgkmcnt(0)" ::: "memory"); __builtin_amdgcn_s_barrier(); asm volatile("" ::: "memory");
            const float r3a = cst[768 + 0 * 128 + wr * 64 + 48 + fr], r3b = cst[768 + 1 * 128 + wr * 64 + 48 + fr], r0 = cst[768 + (fr & 1)];
#pragma unroll
            for (int ai = 0; ai < 2; ++ai) {
                const float r3 = ai ? r3b : r3a;
                const f32x4 g0 = acc[ai][0][3][0] * r3 + cg0, g1 = acc[ai][0][3][1] * r3 + cg1;
                if (fr >= 14) { LDSF float* x = xch + ((((wr * 2 + ai) * 4 + wc) * 2 + (fr - 14)) * 32 + 8 * fq); *(LDSF f32x4*)x = g0; *(LDSF f32x4*)(x + 4) = g1;
                    if (wr == 1 && ai == 1) { float* e = eg + ((size_t)(u.pm * 4 + 2 + (fr - 14))) * DFF + jcol; *(f32x4*)e = g0; *(f32x4*)(e + 4) = g1; } }
            }
            if (wr == 0 && fr < 2) {
                float* e = eg + ((size_t)(u.pm * 4 + fr)) * DFF + jcol; float* v = ev + ((size_t)(u.pm * 2 + fr)) * DFF + jcol;
                *(f32x4*)e = acc[0][0][0][0] * r0 + cg0; *(f32x4*)(e + 4) = acc[0][0][0][1] * r0 + cg1;
                *(f32x4*)v = acc[0][1][0][0] * r0 + cv0; *(f32x4*)(v + 4) = acc[0][1][0][1] * r0 + cv1;
            }
        }
        asm volatile("s_waitcnt lgkmcnt(0)" ::: "memory"); __builtin_amdgcn_s_barrier(); asm volatile("" ::: "memory");
#pragma unroll
        for (int ai = 0; ai < 2; ++ai) {
            f32x4 pvv[2];
            if (ai == 0 && wr == 0) { pvv[0] = (f32x4){0.f, 0.f, 0.f, 0.f}; pvv[1] = pvv[0]; }
            else { const int swr = (wr == 1) ? 0 : 1, sai = (wr == 1) ? ai : ai - 1;
                const LDSF float* x = xch + ((((swr * 2 + sai) * 4 + wc) * 2 + (fr & 1)) * 32 + 8 * fq); pvv[0] = *(const LDSF f32x4*)x; pvv[1] = *(const LDSF f32x4*)(x + 4); }
#pragma unroll
            for (int m = 0; m < 4; ++m) {
                asm volatile("" ::: "memory");
                const int row = u.pm * 256 + ai * 128 + wr * 64 + m * 16 + fr; const float rsm = cst[768 + ai * 128 + wr * 64 + m * 16 + fr];
                u32x4 w;
#pragma unroll
                for (int n = 0; n < 2; ++n) {
                    const LDSF float* cc = cst + cih + 4 * n;
                    const f32x4 cgn = *(const LDSF f32x4*)cc, cvn = *(const LDSF f32x4*)(cc + 128);
                    const f32x4 k0 = *(const LDSF f32x4*)(cc + 256), k1 = *(const LDSF f32x4*)(cc + 384), k2 = *(const LDSF f32x4*)(cc + 512), kb = *(const LDSF f32x4*)(cc + 640);
                    const f32x4 c = acc[ai][0][m][n] * rsm + cgn, v = acc[ai][1][m][n] * rsm + cvn; float o[4];
#pragma unroll
                    for (int i = 0; i < 4; ++i) {
                        const float gm1 = DPPF(DPPF(0.f, pvv[n][i], 0x121), c[i], 0x111);
                        const float gm2 = DPPF(DPPF(0.f, pvv[n][i], 0x122), c[i], 0x112);
                        const float cvv = k0[i] * gm2 + k1[i] * gm1 + k2[i] * c[i] + kb[i];
                        o[i] = cvv * __builtin_amdgcn_rcpf(1.f + __builtin_amdgcn_exp2f(-cvv * LOG2E)) * v[i];
                    }
                    w[2 * n] = pg8::cvt_pk_bf16(o[0], o[1]); w[2 * n + 1] = pg8::cvt_pk_bf16(o[2], o[3]);
                    pvv[n] = c;
                }
                *(u32x4*)(act + (size_t)row * DFF + jcol) = w;
            }
        }
    }
};
__device__ void act_fixup(const Params& p, int l, int pm) {
    if ((pm & 15) == 0) return;
    const float* eg = (const float*)(p.ws + WS_EG); const float* ev = (const float*)(p.ws + WS_EV); bf16_t* act = (bf16_t*)(p.ws + WS_ACT);
    const float* cw = p.conv_w + (size_t)l * 3 * DFF; const float* cbias = p.conv_b + (size_t)l * DFF;
    const int tid = TID();
    constexpr int NB4 = 4;
#pragma unroll 1
    for (int bt = 0; bt < 3; ++bt) {
        float a[NB4], bq[NB4], c0[NB4], c1[NB4], vv[NB4], k0[NB4], k1[NB4], k2[NB4], kb[NB4];
#pragma unroll
        for (int i = 0; i < NB4; ++i) { const int idx = min(tid + (bt * NB4 + i) * NTHR, 2 * DFF - 1); const int r = idx / DFF, j = idx - r * DFF;
            a[i] = eg[((size_t)((pm - 1) * 4 + 2)) * DFF + j]; bq[i] = eg[((size_t)((pm - 1) * 4 + 3)) * DFF + j]; c0[i] = eg[((size_t)(pm * 4 + 0)) * DFF + j]; c1[i] = eg[((size_t)(pm * 4 + 1)) * DFF + j];
            vv[i] = ev[((size_t)(pm * 2 + r)) * DFF + j]; k0[i] = cw[j]; k1[i] = cw[DFF + j]; k2[i] = cw[2 * DFF + j]; kb[i] = cbias[j]; }
        asm volatile("" ::: "memory");
#pragma unroll
        for (int i = 0; i < NB4; ++i) { const int idx = tid + (bt * NB4 + i) * NTHR;
            if (idx < 2 * DFF) { const int r = idx / DFF, j = idx - r * DFF;
                const float gm2 = r ? bq[i] : a[i], gm1 = r ? c0[i] : bq[i], gc = r ? c1[i] : c0[i];
                const float cvv = k0[i] * gm2 + k1[i] * gm1 + k2[i] * gc + kb[i];
                act[(size_t)(pm * 256 + r) * DFF + j] = f2bf(siluf(cvv) * vv[i]); } }
    }
}

__device__ void ph_prep_cum_bh(const Params& p, int l, int bh, unsigned char* lds) {
    const float* side = (const float*)(p.ws + WS_SIDE);
    float* cum = (float*)(p.ws + WS_CUM);
    LDSF float* wt = (LDSF float*)(lds + 70000);
    const int tid = TID(), lane = tid & 63, wv = tid >> 6;
    {
        const int b = bh >> 2, h = bh & 3; const float bf = p.fox_bf[l * 4 + h];
        float v[8]; float tot = 0.f;
#pragma unroll
        for (int i = 0; i < 8; ++i) { v[i] = logsigf(side[(size_t)(b * SEQ + tid * 8 + i) * 16 + h] + bf); tot += v[i]; v[i] = tot; }
        float inc = tot;
#pragma unroll
        for (int o = 1; o < 64; o <<= 1) { const float u = __shfl_up(inc, o); if (lane >= o) inc += u; }
        __syncthreads();
        if (lane == 63) wt[wv] = inc;
        __syncthreads();
        float base = inc - tot;
        for (int w8 = 0; w8 < wv; ++w8) base += wt[w8];
#pragma unroll
        for (int i = 0; i < 8; ++i) cum[bh * SEQ + tid * 8 + i] = base + v[i];
    }
}
template <int N> __device__ __forceinline__ float dotn(const float* q, const bf16_t* k) {
    float s = 0.f;
#pragma unroll
    for (int c = 0; c < N / 8; ++c) { float t[8]; load8(k + 8 * c, t);
#pragma unroll
        for (int j = 0; j < 8; ++j) s += q[8 * c + j] * t[j]; }
    return s;
}
template <int N> __device__ __forceinline__ void axpyn(float* o, float w, const bf16_t* v) {
#pragma unroll
    for (int c = 0; c < N / 8; ++c) { float t[8]; load8(v + 8 * c, t);
#pragma unroll
        for (int j = 0; j < 8; ++j) o[8 * c + j] += w * t[j]; }
}
template <int N> __device__ __forceinline__ void loadq_norm(float* q, const bf16_t* src, const float* g, float scale, bool norm) {
    float ss = 0.f;
#pragma unroll
    for (int c = 0; c < N / 8; ++c) load8(src + 8 * c, q + 8 * c);
#pragma unroll
    for (int j = 0; j < N; ++j) ss += q[j] * q[j];
    const float r = norm ? rsqrtf(ss * (1.f / N) + EPS) : 1.f;
#pragma unroll
    for (int j = 0; j < N; ++j) q[j] = q[j] * r * (norm ? g[j] : 1.f) * scale;
}
__device__ __forceinline__ void store64(bf16_t* dst, const float* o) {
#pragma unroll
    for (int c = 0; c < 8; ++c) { u32x4 w; w[0] = pk2(o[8 * c], o[8 * c + 1]); w[1] = pk2(o[8 * c + 2], o[8 * c + 3]); w[2] = pk2(o[8 * c + 4], o[8 * c + 5]); w[3] = pk2(o[8 * c + 6], o[8 * c + 7]); *(u32x4*)(dst + 8 * c) = w; }
}

typedef float f32x16 __attribute__((ext_vector_type(16)));
typedef short s16x4 __attribute__((ext_vector_type(4)));
#define LDSP __attribute__((address_space(3)))
constexpr int KSTR = 144;
constexpr int AL_KV = 17408;
constexpr int AL_BK = 2 * AL_KV  , AL_TB = AL_BK + 512  , AL_WSF = AL_TB + 512  , AL_MISC = AL_WSF + 2048  ,
              AL_IMP = 38912  , AL_SELM = AL_IMP + 65536  ,
              AL_TB4 = AL_SELM + 512  , AL_INVL = AL_TB4 + 2048  , AL_D_END = AL_INVL + 1024;
static_assert(AL_MISC + 64 <= AL_IMP && AL_D_END <= 131072, "attention LDS map");
__device__ __forceinline__ int crow(int r, int hi) { return (r & 3) + 8 * (r >> 2) + 4 * hi; }
__device__ __forceinline__ float ex2(float v) { return __builtin_amdgcn_exp2f(v); }
__device__ __forceinline__ s16x4 vtr(const LDSP unsigned char* p) { typedef short v4i16_t __attribute__((ext_vector_type(4))); return __builtin_bit_cast(s16x4, __builtin_amdgcn_ds_read_tr16_b64_v4i16((LDSP v4i16_t*)p)); }
__device__ __forceinline__ bf16x8 pack8(const f32x16& p, int b) {
    u32x4 w; w[0] = pg8::cvt_pk_bf16(p[b], p[b + 1]); w[1] = pg8::cvt_pk_bf16(p[b + 2], p[b + 3]); w[2] = pg8::cvt_pk_bf16(p[b + 4], p[b + 5]); w[3] = pg8::cvt_pk_bf16(p[b + 6], p[b + 7]);
    return __builtin_bit_cast(bf16x8, w);
}
__device__ __forceinline__ f32x16 splat16(float v) { return (f32x16){v, v, v, v, v, v, v, v, v, v, v, v, v, v, v, v}; }
template <int NK16>
__device__ __forceinline__ void qkt(f32x16& p0, f32x16& p1, const LDSP unsigned char* Kt, const bf16x8* qf, int dbase, int r32, int hi) {
    const LDSP unsigned char* kb = Kt + r32 * KSTR + hi * 16 + dbase * 32;
#pragma unroll
    for (int d0 = 0; d0 < NK16; ++d0) {
        const bf16x8 a0 = *(const LDSP bf16x8*)(kb + d0 * 32), a1 = *(const LDSP bf16x8*)(kb + 32 * KSTR + d0 * 32);
        p0 = __builtin_amdgcn_mfma_f32_32x32x16_bf16(a0, qf[d0], p0, 0, 0, 0);
        p1 = __builtin_amdgcn_mfma_f32_32x32x16_bf16(a1, qf[d0], p1, 0, 0, 0);
    }
}
__device__ __forceinline__ void pv(f32x16* o, const LDSP unsigned char* Vt, int vb, const f32x16& p0, const f32x16& p1) {
    bf16x8 pa[4]; pa[0] = pack8(p0, 0); pa[1] = pack8(p0, 8); pa[2] = pack8(p1, 0); pa[3] = pack8(p1, 8);
#pragma unroll
    for (int d0 = 0; d0 < 2; ++d0)
#pragma unroll
        for (int ks = 0; ks < 4; ++ks) {
            const s16x4 lo = vtr(Vt + vb + d0 * 4096 + ks * 1024), hh = vtr(Vt + vb + d0 * 4096 + ks * 1024 + 512);
            const bf16x8 vf = (bf16x8){lo[0], lo[1], lo[2], lo[3], hh[0], hh[1], hh[2], hh[3]};
            o[d0] = __builtin_amdgcn_mfma_f32_32x32x16_bf16(pa[ks], vf, o[d0], 0, 0, 0);
        }
}
__device__ __forceinline__ float exp_sum(f32x16& p0, f32x16& p1) {
    float s0 = 0.f, s1 = 0.f;
#pragma unroll
    for (int r = 0; r < 16; ++r) { p0[r] = ex2(p0[r]); p1[r] = ex2(p1[r]); s0 += p0[r]; s1 += p1[r]; }
    return s0 + s1;
}
__device__ __forceinline__ void scale_rows(f32x16* o, float f, LDSP float* wsf, int r32, int hi) {
    __builtin_amdgcn_wave_barrier();
    if (hi == 0) wsf[r32] = f;
    __builtin_amdgcn_s_waitcnt(0xc07f);
    __builtin_amdgcn_wave_barrier();
#pragma unroll
    for (int g = 0; g < 4; ++g) { const f32x4 a = *(const LDSP f32x4*)(wsf + 8 * g + 4 * hi);
#pragma unroll
        for (int i = 0; i < 4; ++i) { o[0][4 * g + i] *= a[i]; o[1][4 * g + i] *= a[i]; } }
    __builtin_amdgcn_wave_barrier();
}
__device__ __forceinline__ void store_o(const f32x16* o, LDSP bf16_t* stg, bf16_t* dst, int lane, int r32, int hi) {
    __builtin_amdgcn_wave_barrier();
#pragma unroll
    for (int r = 0; r < 16; ++r) { const int orow = crow(r, hi); stg[orow * 64 + r32] = f2bf(o[0][r]); stg[orow * 64 + 32 + r32] = f2bf(o[1][r]); }
    __builtin_amdgcn_s_waitcnt(0xc07f);
    __builtin_amdgcn_wave_barrier();
#pragma unroll
    for (int i = 0; i < 4; ++i) { const int row = i * 8 + (lane >> 3), ch = lane & 7; const u32x4 v = *(const LDSP u32x4*)(stg + row * 64 + ch * 8); *(u32x4*)(dst + (size_t)row * DM + ch * 8) = v; }
    __builtin_amdgcn_s_waitcnt(0xc07f);
    __builtin_amdgcn_wave_barrier();
}
template <int NG>
__device__ __forceinline__ void load_q(bf16x8* qf, const bf16_t* qrow  , const float* g, float sc, bool norm, int hi) {
    float v[4][8];
#pragma unroll
    for (int d0 = 0; d0 < 4; ++d0) load8(qrow + 16 * d0 + 8 * hi, v[d0]);
    float r0 = 1.f, r1 = 1.f;
    if (norm) {
        float s0 = 0.f, s1 = 0.f;
#pragma unroll
        for (int j = 0; j < 8; ++j) { s0 += v[0][j] * v[0][j] + v[1][j] * v[1][j]; s1 += v[2][j] * v[2][j] + v[3][j] * v[3][j]; }
        s0 += __shfl_xor(s0, 32); s1 += __shfl_xor(s1, 32);
        if (NG == 64) { r0 = rsqrtf((s0 + s1) * (1.f / 64.f) + EPS); r1 = r0; } else { r0 = rsqrtf(s0 * (1.f / 32.f) + EPS); r1 = rsqrtf(s1 * (1.f / 32.f) + EPS); }
    }
#pragma unroll
    for (int d0 = 0; d0 < 4; ++d0) {
        const float rr = (d0 < 2 ? r0 : r1) * sc; float w[8];
#pragma unroll
        for (int j = 0; j < 8; ++j) { const int d = 16 * d0 + 8 * hi + j; w[j] = v[d0][j] * rr * (norm ? g[d % NG] : 1.f); }
        u32x4 u; u[0] = pg8::cvt_pk_bf16(w[0], w[1]); u[1] = pg8::cvt_pk_bf16(w[2], w[3]); u[2] = pg8::cvt_pk_bf16(w[4], w[5]); u[3] = pg8::cvt_pk_bf16(w[6], w[7]);
        qf[d0] = __builtin_bit_cast(bf16x8, u);
    }
}
__device__ __forceinline__ void kv_load(u32x4& kr, u32x4& vr, const bf16_t* Kb, const bf16_t* Vb, int k0, int tid) {
    const size_t off = (size_t)(k0 + (tid >> 3)) * PINP + (tid & 7) * 8;
    kr = *(const u32x4*)(Kb + off); vr = *(const u32x4*)(Vb + off);
}
__device__ __forceinline__ void kv_load64(u32x4& kr, u32x4& vr, const bf16_t* Kb, const bf16_t* Vb, int n0, int tid) {
    const size_t off = (size_t)(n0 + (tid >> 3)) * 64 + (tid & 7) * 8;
    kr = *(const u32x4*)(Kb + off); vr = *(const u32x4*)(Vb + off);
}
__device__ __forceinline__ void kv_store(const u32x4& kr, const u32x4& vr, LDSP unsigned char* buf, int tid) {
    const int key = tid >> 3, ch = tid & 7;
    *(LDSP u32x4*)(buf + key * KSTR + ch * 16) = kr;
    *(LDSP u32x4*)(buf + 9216 + (ch >> 2) * 4096 + (key >> 4) * 1024 + ((key >> 3) & 1) * 512 + (key & 7) * 64 + (ch & 3) * 16) = vr;
}
template <int NG>
__device__ __forceinline__ void knorm_chunk(u32x4& kr, const float* gp  ) {
    float v[8];
    v[0] = bf2f(kr[0] & 0xffff); v[1] = bf2f(kr[0] >> 16); v[2] = bf2f(kr[1] & 0xffff); v[3] = bf2f(kr[1] >> 16);
    v[4] = bf2f(kr[2] & 0xffff); v[5] = bf2f(kr[2] >> 16); v[6] = bf2f(kr[3] & 0xffff); v[7] = bf2f(kr[3] >> 16);
    float ss = 0.f;
#pragma unroll
    for (int j = 0; j < 8; ++j) ss += v[j] * v[j];
    ss += __shfl_xor(ss, 1); ss += __shfl_xor(ss, 2); if (NG == 64) ss += __shfl_xor(ss, 4);
    const float r = rsqrtf(ss * (1.f / NG) + EPS);
    const f32x4 ga = *(const f32x4*)gp, gb = *(const f32x4*)(gp + 4);
    kr[0] = pg8::cvt_pk_bf16(v[0] * r * ga[0], v[1] * r * ga[1]); kr[1] = pg8::cvt_pk_bf16(v[2] * r * ga[2], v[3] * r * ga[3]);
    kr[2] = pg8::cvt_pk_bf16(v[4] * r * gb[0], v[5] * r * gb[1]); kr[3] = pg8::cvt_pk_bf16(v[6] * r * gb[2], v[7] * r * gb[3]);
}
__device__ __forceinline__ void bias_near(f32x16& p0, f32x16& p1, const LDSP float* tbl, int tk0  , int wnd, bool rowok, int hi) {
#pragma unroll
    for (int g = 0; g < 4; ++g) {
#pragma unroll
        for (int i = 0; i < 4; ++i) { const int r = 4 * g + i; const int d0_ = tk0 - crow(r, hi), d1_ = d0_ - 32;
            const float b0 = tbl[min(max(d0_, 0), 127)], b1 = tbl[min(max(d1_, 0), 127)];
            p0[r] = (d0_ < 0 || d0_ >= wnd || !rowok) ? -INFINITY : p0[r] + b0; p1[r] = (d1_ < 0 || d1_ >= wnd || !rowok) ? -INFINITY : p1[r] + b1; }
        asm volatile("" ::: "memory");
    }
}
#define KVBUF(L, i) ((L) + ((i) & 1) * AL_KV)

__device__ void fa_fox_unit(const Params& p, int l, int b, int h, int qb, LDSP unsigned char* L) {
    const int tid = TID(), lane = tid & 63, wid = __builtin_amdgcn_readfirstlane(tid >> 6), r32 = lane & 31, hi = lane >> 5;
    const bf16_t* proj = (const bf16_t*)(p.ws + WS_PROJ); bf16_t* mix = (bf16_t*)p.out;
    const size_t rb = (size_t)b * SEQ; const int q0 = qb * 256, qw = q0 + 32 * wid, t = qw + r32;
    const bf16_t* Kb = proj + rb * PINP + CB_K + 64 * h; const bf16_t* Vb = proj + rb * PINP + CB_V + 64 * h;
    const float* cm = (const float*)(p.ws + WS_CUM) + (b * 4 + h) * SEQ;
    LDSP float* wsf = (LDSP float*)(L + AL_WSF) + wid * 64; LDSP float* bk = (LDSP float*)(L + AL_BK);
    const int vb = 9216 + ((lane >> 4) & 1) * 32 + (lane & 3) * 8 + (4 * hi + ((lane & 15) >> 2)) * 64;
    bf16x8 qf[4]; load_q<64>(qf, proj + (rb + t) * PINP + CB_Q + 64 * h, p.fox_qn + l * 64, 0.125f * LOG2E, true, hi);
    const float rowc = cm[t] * LOG2E - ((const float*)(p.ws + WS_BND))[l * 32 + 4];
    f32x16 o[2]; o[0] = (f32x16){}; o[1] = (f32x16){};
    float l_run = 0.f;
    const int NT = 4 * qb + 4, jd = 4 * qb + (wid >> 1);
    u32x4 krA, vrA, krB, vrB; float crA = 0.f, crB = 0.f;
    int js;
    {   const bool live = (lane < NT) ? ((cm[q0] - cm[64 * lane + 63]) * LOG2E >= -160.f) : false;
        const unsigned long long bm = __ballot(live);
        js = __builtin_amdgcn_readfirstlane((int)__builtin_ctzll(bm | (1ull << (NT - 1)))); if (js > NT - 2) js = NT - 2; js &= ~1; }
    __syncthreads();
    kv_load(krA, vrA, Kb, Vb, 64 * js, tid); if (tid < 64) crA = cm[64 * js + tid];
    kv_store(krA, vrA, KVBUF(L, js), tid); if (tid < 64) bk[(js & 1) * 64 + tid] = -crA * LOG2E;
    kv_load(krB, vrB, Kb, Vb, 64 * (js + 1), tid); if (tid < 64) crB = cm[64 * (js + 1) + tid];
    if (js + 2 < NT) { kv_load(krA, vrA, Kb, Vb, 64 * (js + 2), tid); if (tid < 64) crA = cm[64 * (js + 2) + tid]; }
#define FOX_STEP(J, KR, VR, CR) do { const int j = (J); \
        __syncthreads(); \
        if (j + 1 < NT) { kv_store(KR, VR, KVBUF(L, j + 1), tid); if (tid < 64) bk[((j + 1) & 1) * 64 + tid] = -CR * LOG2E; } \
        if (j + 3 < NT) { kv_load(KR, VR, Kb, Vb, 64 * (j + 3), tid); if (tid < 64) CR = cm[64 * (j + 3) + tid]; } \
        if (j <= jd) { \
            const LDSP unsigned char* buf = KVBUF(L, j); const LDSP float* bkj = bk + (j & 1) * 64; \
            f32x16 p0, p1; \
            _Pragma("unroll") for (int g = 0; g < 4; ++g) { const f32x4 b0 = *(const LDSP f32x4*)(bkj + 8 * g + 4 * hi), b1 = *(const LDSP f32x4*)(bkj + 32 + 8 * g + 4 * hi); \
                _Pragma("unroll") for (int i = 0; i < 4; ++i) { p0[4 * g + i] = b0[i] + rowc; p1[4 * g + i] = b1[i] + rowc; } } \
            qkt<4>(p0, p1, buf, qf, 0, r32, hi); \
            if (j == jd) { const int k0 = 64 * j; \
                _Pragma("unroll") for (int r = 0; r < 16; ++r) { const int kk = k0 + crow(r, hi); if (kk > t) p0[r] = -INFINITY; if (kk + 32 > t) p1[r] = -INFINITY; } } \
            l_run += exp_sum(p0, p1); \
            pv(o, buf, vb, p0, p1); \
        } } while (0)
    for (int jj = js; jj < NT; jj += 2) { FOX_STEP(jj, krB, vrB, crB); FOX_STEP(jj + 1, krA, vrA, crA); }
#undef FOX_STEP
    l_run += __shfl_xor(l_run, 32);
    scale_rows(o, 1.f / l_run, wsf, r32, hi);
    store_o(o, (LDSP bf16_t*)(L + AL_IMP + wid * 8192), mix + (rb + qw) * DM + 256 + 64 * h, lane, r32, hi);
}

__device__ void fa_diff_unit(const Params& p, int l, int b, int h, int qb, LDSP unsigned char* L) {
    const int tid = TID(), lane = tid & 63, wid = __builtin_amdgcn_readfirstlane(tid >> 6), r32 = lane & 31, hi = lane >> 5;
    const bf16_t* proj = (const bf16_t*)(p.ws + WS_PROJ); bf16_t* mix = (bf16_t*)p.out;
    const size_t rb = (size_t)b * SEQ; const int q0 = qb * 256, qw = q0 + 32 * wid, t = qw + r32;
    const bf16_t* Kb = proj + rb * PINP + CA_K + 64 * h; const bf16_t* Vb = proj + rb * PINP + CA_V + 64 * h;
    LDSP float* wsf = (LDSP float*)(L + AL_WSF) + wid * 64; LDSP float* tbl = (LDSP float*)(L + AL_TB);
    const int vb = 9216 + ((lane >> 4) & 1) * 32 + (lane & 3) * 8 + (4 * hi + ((lane & 15) >> 2)) * 64;
    const float lam = ((const float*)(p.ws + WS_LAM))[l]; const float lam_init = 0.8f - 0.6f * __expf(-0.3f * (float)l);
    const float nbound = -((const float*)(p.ws + WS_BND))[l * 32 + h];
    __syncthreads();
    if (tid < 128) tbl[tid] = ((const float*)(p.ws + WS_TB))[h * 128 + tid] * LOG2E;
    bf16x8 qf[4]; load_q<32>(qf, proj + (rb + t) * PINP + CA_Q + 64 * h, p.diff_qn + l * 32, 0.17677669529663687f * LOG2E, true, hi);
    f32x16 o1[2], o2[2]; o1[0] = (f32x16){}; o1[1] = (f32x16){}; o2[0] = (f32x16){}; o2[1] = (f32x16){};
    float l1 = 0.f, l2 = 0.f;
    const int NT = 4 * qb + 4, jd = 4 * qb + (wid >> 1);
    u32x4 kr, vr; const float* gk = p.diff_kn + l * 32 + (tid & 3) * 8;
    kv_load(kr, vr, Kb, Vb, 0, tid);
    kv_store(kr, vr, KVBUF(L, 0), tid);
    kv_load(kr, vr, Kb, Vb, 64, tid);
    for (int j = 0; j < NT; ++j) {
        __syncthreads();
        if (j + 1 < NT) { kv_store(kr, vr, KVBUF(L, j + 1), tid); }
        if (j + 2 < NT) kv_load(kr, vr, Kb, Vb, 64 * (j + 2), tid);
        if (j <= jd) {
            const LDSP unsigned char* buf = KVBUF(L, j);
            const int k0 = 64 * j; const bool nearb = (qw - (k0 + 63)) < 113; const float cfar = tbl[127] + nbound;
#pragma unroll
            for (int mp = 0; mp < 2; ++mp) {
                f32x16 p0 = splat16(nearb ? nbound : cfar), p1 = p0;
                qkt<2>(p0, p1, buf, qf + 2 * mp, 2 * mp, r32, hi);
                if (nearb) bias_near(p0, p1, tbl, t - k0, 1 << 30, true, hi);
                if (mp == 0) { l1 += exp_sum(p0, p1); pv(o1, buf, vb, p0, p1); }
                else { l2 += exp_sum(p0, p1); pv(o2, buf, vb, p0, p1); }
            }
        }
    }
    l1 += __shfl_xor(l1, 32); l2 += __shfl_xor(l2, 32);
    scale_rows(o1, 1.f / l1, wsf, r32, hi); scale_rows(o2, lam / l2, wsf, r32, hi);
    o1[0] -= o2[0]; o1[1] -= o2[1];
    const float g0 = p.diff_sub[l * 64 + r32] * (1.f - lam_init), g1 = p.diff_sub[l * 64 + 32 + r32] * (1.f - lam_init);
#pragma unroll
    for (int r = 0; r < 16; ++r) {
        float ss = o1[0][r] * o1[0][r] + o1[1][r] * o1[1][r];
        ss += __shfl_xor(ss, 1); ss += __shfl_xor(ss, 2); ss += __shfl_xor(ss, 4); ss += __shfl_xor(ss, 8); ss += __shfl_xor(ss, 16);
        const float rs = rsqrtf(ss * (1.f / 64.f) + EPS); o1[0][r] *= rs * g0; o1[1][r] *= rs * g1;
    }
    store_o(o1, (LDSP bf16_t*)(L + AL_IMP + wid * 8192), mix + (rb + qw) * DM + 0 + 64 * h, lane, r32, hi);
}

template <bool DIAG>
__device__ __forceinline__ void stick_sub(f32x16& y, float& carry, int kbase  , int t, int hi) {
    float lk[16];
#pragma unroll
    for (int r = 0; r < 16; ++r) {
        const float v = y[r]; const float e = ex2(-fabsf(v)); const float lb = fminf(v, 0.f) - __builtin_amdgcn_logf(1.f + e);
        if (DIAG) { const bool valid = (kbase + crow(r, hi) < t); lk[r] = valid ? (lb - v) : 0.f; y[r] = valid ? lb : -INFINITY; }
        else { lk[r] = lb - v; y[r] = lb; }
    }
    float T[4], Go[4];
#pragma unroll
    for (int g = 0; g < 4; ++g) { const float Gs = (lk[4 * g] + lk[4 * g + 1]) + (lk[4 * g + 2] + lk[4 * g + 3]); Go[g] = __shfl_xor(Gs, 32); T[g] = Gs + Go[g]; }
    float sx = 0.f;
#pragma unroll
    for (int g = 3; g >= 0; --g) {
        float tail = carry + sx + (hi == 0 ? Go[g] : 0.f);
#pragma unroll
        for (int i = 3; i >= 0; --i) { y[4 * g + i] = ex2(y[4 * g + i] + tail); tail += lk[4 * g + i]; }
        sx += T[g];
    }
    carry += sx;
}
__device__ void fa_stick_unit(const Params& p, int l, int b, int h, int qb, LDSP unsigned char* L) {
    const int tid = TID(), lane = tid & 63, wid = __builtin_amdgcn_readfirstlane(tid >> 6), r32 = lane & 31, hi = lane >> 5;
    const bf16_t* proj = (const bf16_t*)(p.ws + WS_PROJ); bf16_t* mix = (bf16_t*)p.out;
    const size_t rb = (size_t)b * SEQ; const int q0 = qb * 256, qw = q0 + 32 * wid, t = qw + r32;
    const bf16_t* Kb = proj + rb * PINP + CC_K + 64 * h; const bf16_t* Vb = proj + rb * PINP + CC_V + 64 * h;
    const int vb = 9216 + ((lane >> 4) & 1) * 32 + (lane & 3) * 8 + (4 * hi + ((lane & 15) >> 2)) * 64;
    bf16x8 qf[4]; load_q<64>(qf, proj + (rb + t) * PINP + CC_Q + 64 * h, nullptr, 0.125f * LOG2E, false, hi);
    f32x16 o[2]; o[0] = (f32x16){}; o[1] = (f32x16){};
    float carry = 0.f;
    const int NT = 4 * qb + 4, jd = 4 * qb + (wid >> 1);
    u32x4 kr, vr;
#define SBUF(i) (((i) & 1) ? (L + 108544) : L)
    LDSP unsigned* dn = (LDSP unsigned*)(L + AL_MISC) + 8;
    bool wdone = false;
    __syncthreads();
    if (lane == 0) dn[wid] = 0u;
    kv_load(kr, vr, Kb, Vb, 64 * (NT - 1), tid);
    kv_store(kr, vr, SBUF(NT - 1), tid);
    kv_load(kr, vr, Kb, Vb, 64 * (NT - 2), tid);
    for (int j = NT - 1; j >= 0; --j) {
        __syncthreads();
        if (__all(dn[lane & 7] != 0u)) break;
        if (j >= 1) kv_store(kr, vr, SBUF(j - 1), tid);
        if (j >= 2) kv_load(kr, vr, Kb, Vb, 64 * (j - 2), tid);
        if (j <= jd && !wdone) {
            const LDSP unsigned char* buf = SBUF(j);
            f32x16 p0 = (f32x16){}, p1 = (f32x16){};
            qkt<4>(p0, p1, buf, qf, 0, r32, hi);
            const int k0 = 64 * j; const bool diag = (j == jd);
            if (diag) { stick_sub<true>(p1, carry, k0 + 32, t, hi); stick_sub<true>(p0, carry, k0, t, hi); }
            else { stick_sub<false>(p1, carry, k0 + 32, t, hi); stick_sub<false>(p0, carry, k0, t, hi); }
            pv(o, buf, vb, p0, p1);
            if (__all(carry < -160.f)) { wdone = true; if (lane == 0) dn[wid] = 1u; }
        }
    }
    store_o(o, (LDSP bf16_t*)(L + AL_IMP + wid * 8192), mix + (rb + qw) * DM + 512 + 64 * h, lane, r32, hi);
}

__device__ void fa_nsa_unit(const Params& p, int l, int b, int u, LDSP unsigned char* L) {
    const int tid = TID(), lane = tid & 63, wid = __builtin_amdgcn_readfirstlane(tid >> 6), r32 = lane & 31, hi = lane >> 5;
    const int hh = wid >> 1, sub = wid & 1;
    const bf16_t* proj = (const bf16_t*)(p.ws + WS_PROJ); bf16_t* mix = (bf16_t*)p.out;
    const size_t rb = (size_t)b * SEQ; const int q0 = 64 * u, qw = q0 + 32 * sub, t = qw + r32; const int ql = 32 * sub + r32;
    LDSP float* wsf = (LDSP float*)(L + AL_WSF) + wid * 64; LDSP float* tbl = (LDSP float*)(L + AL_TB4) + hh * 128;
    LDSP float* imp = (LDSP float*)(L + AL_IMP); LDSP unsigned* selm = (LDSP unsigned*)(L + AL_SELM); LDSP float* invl = (LDSP float*)(L + AL_INVL);
    LDSP float* ofl = (LDSP float*)(L + AL_IMP) + wid * 2048 + lane;
    const int vb = 9216 + ((lane >> 4) & 1) * 32 + (lane & 3) * 8 + (4 * hi + ((lane & 15) >> 2)) * 64;
    const float* bnd = (const float*)(p.ws + WS_BND) + l * 32;
    __syncthreads();
    ((LDSP float*)(L + AL_TB4))[tid] = ((const float*)(p.ws + WS_TB))[512 + tid] * LOG2E;
    bf16x8 qf[4]; load_q<64>(qf, proj + (rb + t) * PINP + CD_Q + 64 * hh, p.nsa_qn + l * 64, 0.125f * LOG2E, true, hi);
    const float* sd = (const float*)(p.ws + WS_SIDE) + (rb + t) * 16 + 4 + hh;
    const float gc = 1.f / (1.f + __expf(-sd[0])), gs = 1.f / (1.f + __expf(-sd[4])), gwn = 1.f / (1.f + __expf(-sd[8]));
    f32x16 o[2]; o[0] = (f32x16){}; o[1] = (f32x16){};
    u32x4 kr, vr;
    {
        const bf16_t* Kc = (const bf16_t*)(p.ws + WS_KC) + (size_t)b * 256 * 64; const bf16_t* Vc = (const bf16_t*)(p.ws + WS_VC) + (size_t)b * 256 * 64;
        const int ntc = (4 * u + 2) / 64 + 1; const float nbound = -bnd[5 + hh];
        float l_run = 0.f, prevE3 = 0.f;
        kv_load64(kr, vr, Kc, Vc, 0, tid);
        kv_store(kr, vr, KVBUF(L, 0), tid);
        if (ntc > 1) kv_load64(kr, vr, Kc, Vc, 64, tid);
        for (int T = 0; T < ntc; ++T) {
            __syncthreads();
            if (T + 1 < ntc) kv_store(kr, vr, KVBUF(L, T + 1), tid);
            if (T + 2 < ntc) kv_load64(kr, vr, Kc, Vc, 64 * (T + 2), tid);
            const LDSP unsigned char* buf = KVBUF(L, T);
            f32x16 p0 = splat16(nbound), p1 = p0;
            qkt<4>(p0, p1, buf, qf, 0, r32, hi);
#pragma unroll
            for (int g = 0; g < 4; ++g) {
#pragma unroll
                for (int i = 0; i < 4; ++i) { const int r = 4 * g + i; const int d0_ = t - 16 * (64 * T + crow(r, hi)) - 31, d1_ = d0_ - 512;
                    const float b0 = tbl[min(max(d0_, 0), 127)], b1 = tbl[min(max(d1_, 0), 127)];
                    p0[r] = (d0_ < 0) ? -INFINITY : p0[r] + b0; p1[r] = (d1_ < 0) ? -INFINITY : p1[r] + b1; }
                asm volatile("" ::: "memory");
            }
            l_run += exp_sum(p0, p1);
#pragma unroll
            for (int s2 = 0; s2 < 2; ++s2) {
                float G[4], Eo[4];
#pragma unroll
                for (int g = 0; g < 4; ++g) { const float a0 = s2 ? p1[4 * g] : p0[4 * g], a1 = s2 ? p1[4 * g + 1] : p0[4 * g + 1], a2 = s2 ? p1[4 * g + 2] : p0[4 * g + 2], a3 = s2 ? p1[4 * g + 3] : p0[4 * g + 3];
                    G[g] = (a0 + a1) + (a2 + a3); Eo[g] = __shfl_xor(a3, 32); }
#pragma unroll
                for (int g = 0; g < 4; ++g) { const float eprev = hi ? Eo[g] : (g > 0 ? Eo[g - 1] : prevE3);
                    imp[(hh * 64 + ql) * 64 + 16 * T + 8 * s2 + 2 * g + hi] = G[g] + eprev; }
                prevE3 = Eo[3];
            }
            pv(o, buf, vb, p0, p1);
        }
        l_run += __shfl_xor(l_run, 32);
        const float inv = (l_run > 0.f) ? 1.f / l_run : 0.f;
        if (hi == 0) invl[hh * 64 + ql] = inv;
        scale_rows(o, gc * inv, wsf, r32, hi);
    }
    __syncthreads();
    {
        const int q = tid >> 3, part = tid & 7;
        const float i0 = invl[q], i1 = invl[64 + q], i2 = invl[128 + q], i3 = invl[192 + q];
        float vj[8];
#pragma unroll
        for (int jj = 0; jj < 8; ++jj) { const int j = part * 8 + jj;
            const float sum = ((imp[(0 * 64 + q) * 64 + j] * i0 + imp[(1 * 64 + q) * 64 + j] * i1) + imp[(2 * 64 + q) * 64 + j] * i2) + imp[(3 * 64 + q) * 64 + j] * i3;
            vj[jj] = (j > u) ? -1.0f : ((j == u || j == 0) ? 1.0e4f : sum); }
        __syncthreads();
#pragma unroll
        for (int jj = 0; jj < 8; ++jj) imp[q * 64 + part * 8 + jj] = vj[jj];
        __syncthreads();
        int rank[8];
#pragma unroll
        for (int jj = 0; jj < 8; ++jj) rank[jj] = 0;
        for (int i = 0; i < 64; ++i) { const float vi = imp[q * 64 + i];
#pragma unroll
            for (int jj = 0; jj < 8; ++jj) rank[jj] += (vi > vj[jj] || (vi == vj[jj] && i < part * 8 + jj)) ? 1 : 0; }
        unsigned bits = 0;
#pragma unroll
        for (int jj = 0; jj < 8; ++jj) if (rank[jj] < 16 && (part * 8 + jj) <= u) bits |= 1u << jj;
        unsigned mlo = (part < 4) ? (bits << (8 * part)) : 0u, mhi = (part >= 4) ? (bits << (8 * (part - 4))) : 0u;
        mlo |= __shfl_xor(mlo, 1); mhi |= __shfl_xor(mhi, 1); mlo |= __shfl_xor(mlo, 2); mhi |= __shfl_xor(mhi, 2); mlo |= __shfl_xor(mlo, 4); mhi |= __shfl_xor(mhi, 4);
        if (part == 0) { selm[2 * q] = mlo; selm[2 * q + 1] = mhi; }
    }
    __syncthreads();
#pragma unroll
    for (int r = 0; r < 16; ++r) { ofl[(2 * r) * 64] = o[0][r]; ofl[(2 * r + 1) * 64] = o[1][r]; }
    o[0] = (f32x16){}; o[1] = (f32x16){};
    {
        const unsigned long long mymask = (unsigned long long)selm[2 * ql] | ((unsigned long long)selm[2 * ql + 1] << 32);
        unsigned ulo = selm[2 * lane], uhi = selm[2 * lane + 1];
#pragma unroll
        for (int s2 = 1; s2 < 64; s2 <<= 1) { ulo |= __shfl_xor(ulo, s2); uhi |= __shfl_xor(uhi, s2); }
        unsigned long long um = (unsigned long long)(unsigned)__builtin_amdgcn_readfirstlane((int)ulo) | ((unsigned long long)(unsigned)__builtin_amdgcn_readfirstlane((int)uhi) << 32);
        const bf16_t* Kb = proj + rb * PINP + CD_KS; const bf16_t* Vb = proj + rb * PINP + CD_VS;
        float l_run = 0.f; const float nbound = -bnd[9 + hh]; const float cfar = tbl[127] + nbound; const float* gk = p.nsa_kn + (l * 3 + 1) * 64 + (tid & 7) * 8;
        int j = __builtin_ctzll(um); um &= um - 1;
        int jn = um ? __builtin_ctzll(um) : -1; um &= um - 1;
        kv_load(kr, vr, Kb, Vb, 64 * j, tid);
        kv_store(kr, vr, KVBUF(L, 0), tid);
        if (jn >= 0) kv_load(kr, vr, Kb, Vb, 64 * jn, tid);
        for (int it = 0;; ++it) {
            __syncthreads();
            const int jnn = um ? __builtin_ctzll(um) : -1; um &= um - 1;
            if (jn >= 0) { kv_store(kr, vr, KVBUF(L, it + 1), tid); }
            if (jnn >= 0) kv_load(kr, vr, Kb, Vb, 64 * jnn, tid);
            const bool mine = (mymask >> j) & 1ull;
            if (__any(mine)) {
                const LDSP unsigned char* buf = KVBUF(L, it);
                const int k0 = 64 * j; const bool nearb = (qw - (k0 + 63)) < 113;
                f32x16 p0 = splat16(nearb ? nbound : (mine ? cfar : -INFINITY)), p1 = p0;
                qkt<4>(p0, p1, buf, qf, 0, r32, hi);
                if (nearb) bias_near(p0, p1, tbl, t - k0, 1 << 30, mine, hi);
                l_run += exp_sum(p0, p1);
                pv(o, buf, vb, p0, p1);
            }
            if (jn < 0) break;
            j = jn; jn = jnn;
        }
        l_run += __shfl_xor(l_run, 32);
        scale_rows(o, gs / l_run, wsf, r32, hi);
#pragma unroll
        for (int r = 0; r < 16; ++r) { ofl[(2 * r) * 64] += o[0][r]; ofl[(2 * r + 1) * 64] += o[1][r]; }
        o[0] = (f32x16){}; o[1] = (f32x16){};
    }
    {
        const bf16_t* Kb = proj + rb * PINP + CD_KW; const bf16_t* Vb = proj + rb * PINP + CD_VW;
        float l_run = 0.f; const float nbound = -bnd[13 + hh]; const float cfar = tbl[127] + nbound; const float* gk = p.nsa_kn + (l * 3 + 2) * 64 + (tid & 7) * 8;
        const int jlo = max(0, u - 8);
        __syncthreads();
        kv_load(kr, vr, Kb, Vb, 64 * jlo, tid);
        kv_store(kr, vr, KVBUF(L, jlo), tid);
        if (jlo < u) kv_load(kr, vr, Kb, Vb, 64 * (jlo + 1), tid);
        for (int j = jlo; j <= u; ++j) {
            __syncthreads();
            if (j + 1 <= u) { kv_store(kr, vr, KVBUF(L, j + 1), tid); }
            if (j + 2 <= u) kv_load(kr, vr, Kb, Vb, 64 * (j + 2), tid);
            const LDSP unsigned char* buf = KVBUF(L, j);
            const int k0 = 64 * j; const bool nearb = (j == u || j == u - 8 || (qw - (k0 + 63)) < 113);
            f32x16 p0 = splat16(nearb ? nbound : cfar), p1 = p0;
            qkt<4>(p0, p1, buf, qf, 0, r32, hi);
            if (nearb) bias_near(p0, p1, tbl, t - k0, 512, true, hi);
            l_run += exp_sum(p0, p1);
            pv(o, buf, vb, p0, p1);
        }
        l_run += __shfl_xor(l_run, 32);
        scale_rows(o, gwn / l_run, wsf, r32, hi);
#pragma unroll
        for (int r = 0; r < 16; ++r) { o[0][r] += ofl[(2 * r) * 64]; o[1][r] += ofl[(2 * r + 1) * 64]; }
    }
    store_o(o, (LDSP bf16_t*)(L + AL_IMP + wid * 8192), mix + (rb + qw) * DM + 768 + 64 * hh, lane, r32, hi);
}

__device__ void ph_reset_queues(const Params& p) { unsigned* ctl = (unsigned*)(p.ws + WS_CTL); const int gt = GTID(); if (gt < 8) ctl[gt] = 0u; }
__device__ void prep_cmp_task(const Params& p, int l, int task, LDSP unsigned char* L) {
    const int tid = TID(), lane = tid & 63, wid = __builtin_amdgcn_readfirstlane(tid >> 6), r32 = lane & 31, hi = lane >> 5;
    const int b = task >> 4, which = (task >> 3) & 1, nt = task & 7;
    const bf16_t* proj = (const bf16_t*)(p.ws + WS_PROJ);
    const bf16_t* phiT = (const bf16_t*)(p.ws + WS_PHIT) + (size_t)(l * 2 + which) * 64 * 2048;
    const float* pe = p.nsa_pe + (size_t)(l * 2 + which) * 32 * 64;
    const int n = 32 * nt + r32, colbase = which ? CD_VC : CD_KC;
    f32x16 acc0 = (f32x16){}, acc1 = (f32x16){};
#pragma unroll
    for (int ii = 0; ii < 4; ++ii) {
        const int i = 4 * wid + ii; const int tok = min(16 * n + i, SEQ - 1);
        const bf16_t* xr = proj + (size_t)(b * SEQ + tok) * PINP + colbase;
#pragma unroll
        for (int d0 = 0; d0 < 4; ++d0) {
            float xv[8]; load8(xr + 16 * d0 + 8 * hi, xv);
            const f32x4 pe0 = *(const f32x4*)(pe + i * 64 + 16 * d0 + 8 * hi), pe1 = *(const f32x4*)(pe + i * 64 + 16 * d0 + 8 * hi + 4);
            u32x4 aw; aw[0] = pg8::cvt_pk_bf16(xv[0] + pe0[0], xv[1] + pe0[1]); aw[1] = pg8::cvt_pk_bf16(xv[2] + pe0[2], xv[3] + pe0[3]);
            aw[2] = pg8::cvt_pk_bf16(xv[4] + pe1[0], xv[5] + pe1[1]); aw[3] = pg8::cvt_pk_bf16(xv[6] + pe1[2], xv[7] + pe1[3]);
            const bf16x8 af = __builtin_bit_cast(bf16x8, aw);
            const bf16x8 b0 = *(const bf16x8*)(phiT + (size_t)r32 * 2048 + i * 64 + 16 * d0 + 8 * hi);
            const bf16x8 b1 = *(const bf16x8*)(phiT + (size_t)(32 + r32) * 2048 + i * 64 + 16 * d0 + 8 * hi);
            acc0 = __builtin_amdgcn_mfma_f32_32x32x16_bf16(af, b0, acc0, 0, 0, 0);
            acc1 = __builtin_amdgcn_mfma_f32_32x32x16_bf16(af, b1, acc1, 0, 0, 0);
        }
    }
    LDSP float* red = (LDSP float*)L;
    __syncthreads();
#pragma unroll
    for (int r = 0; r < 16; ++r) { red[(wid * 32 + crow(r, hi)) * 64 + r32] = acc0[r]; red[(wid * 32 + crow(r, hi)) * 64 + 32 + r32] = acc1[r]; }
    __syncthreads();
    {
        const int row = tid >> 4, e4 = (tid & 15) * 4; f32x4 v = (f32x4){0.f, 0.f, 0.f, 0.f};
#pragma unroll
        for (int w8 = 0; w8 < 8; ++w8) v += *(const LDSP f32x4*)(red + (w8 * 32 + row) * 64 + e4);
        const int nn = 32 * nt + row;
        if (which == 0) {
            float ss = (v[0] * v[0] + v[1] * v[1]) + (v[2] * v[2] + v[3] * v[3]);
            ss += __shfl_xor(ss, 1); ss += __shfl_xor(ss, 2); ss += __shfl_xor(ss, 4); ss += __shfl_xor(ss, 8);
            const float rs = rsqrtf(ss * (1.f / 64.f) + EPS); const f32x4 g = *(const f32x4*)(p.nsa_kn + (l * 3 + 0) * 64 + e4);
            v = v * rs * g;
        }
        uint2 o; o.x = pk2(v[0], v[1]); o.y = pk2(v[2], v[3]);
        if (nn >= 255) { o.x = 0u; o.y = 0u; }
        *(uint2*)((bf16_t*)(p.ws + (which ? WS_VC : WS_KC)) + (size_t)(b * 256 + nn) * 64 + e4) = o;
    }
}
__device__ void ph_prep(const Params& p, int l, LDSP unsigned char* L, unsigned char* lds) {
    for (int t = blockIdx.x; t < 80; t += gridDim.x) { if (t < 64) prep_cmp_task(p, l, t, L); }
    if (gridDim.x >= 80) { if (blockIdx.x >= 64 && blockIdx.x < 80) ph_prep_cum_bh(p, l, blockIdx.x - 64, lds); }
    else for (int bh = blockIdx.x; bh < 16; bh += gridDim.x) ph_prep_cum_bh(p, l, bh, lds);
}


__device__ void fa_phase_all(const Params& p, int l, LDSP unsigned char* L, unsigned char* lds, int qslot, int n_conv  ) {
    unsigned* ctl = (unsigned*)(p.ws + WS_CTL);
    LDSP unsigned* misc = (LDSP unsigned*)(L + AL_MISC);
    bool prep_ok = false;
    for (;;) {
        __syncthreads();
        if (threadIdx.x == 0) misc[0] = atomicAdd(&ctl[qslot], 1u);
        __syncthreads();
        const unsigned qi0 = misc[0];
        if (qi0 >= 1104u + (unsigned)n_conv) break;
        if (qi0 >= 1104u) {
            const int it = ((int)qi0 - 1104) * 8 + (TID() >> 6);
            if (it < CV_ITEMS) convert_item(p, l + 1, it, (LDSF float*)lds + (TID() >> 6) * (64 * 65), TID() & 63);
            continue;
        }
        if (qi0 < 80u) {
            if (qi0 < 64u) prep_cmp_task(p, l, (int)qi0, L); else ph_prep_cum_bh(p, l, (int)qi0 - 64, lds);
            asm volatile("s_waitcnt vmcnt(0)" ::: "memory");
            __syncthreads();
            if (threadIdx.x == 0) { __threadfence(); atomicAdd(&ctl[4 + qslot], 1u); }
            continue;
        }
        const unsigned qi = qi0 - 80u;
        int r, typ, sub;
        if (qi < 768u) { r = 15 - (int)(qi / 48u); const int j = (int)(qi % 48u); typ = j >> 4; typ = (typ == 0) ? 0 : (typ == 1 ? 2 : 3); sub = j & 15; }
        else { const int v = (int)qi - 768; r = 15 - (v >> 4); typ = 1; sub = v & 15; }
        if ((typ == 2 || typ == 3) && !prep_ok) {
            if (threadIdx.x == 0) { while (__hip_atomic_load(&ctl[4 + qslot], __ATOMIC_RELAXED, __HIP_MEMORY_SCOPE_AGENT) < 80u) __builtin_amdgcn_s_sleep(8); __threadfence(); }
            asm volatile("s_waitcnt vmcnt(0)" ::: "memory");
            __syncthreads();
            prep_ok = true;
        }
        if (typ == 0) fa_diff_unit(p, l, sub >> 2, sub & 3, r, L);
        else if (typ == 1) fa_stick_unit(p, l, sub >> 2, sub & 3, r, L);
        else if (typ == 2) fa_fox_unit(p, l, sub >> 2, sub & 3, r, L);
        else fa_nsa_unit(p, l, sub >> 2, 4 * r + (sub & 3), L);
    }
}

#define XB_TMO      128
#define XB_XCNT(j)  (256  + 64 * (j))
#define XB_XSUB(j)  (1280 + 64 * (j))
#define XB_XGEN(j)  (2304 + 64 * (j))
#define XB_TOP      3328
#define XB_TOPGEN   3392
#define XCD_BAR_WORDS 3456
#define XB_SPIN_CAP (1u << 18)

__device__ __forceinline__ unsigned xb_ld(unsigned* p)              { return __hip_atomic_load(p, __ATOMIC_RELAXED, __HIP_MEMORY_SCOPE_AGENT); }
__device__ __forceinline__ unsigned xb_add(unsigned* p, unsigned v) { return __hip_atomic_fetch_add(p, v, __ATOMIC_RELAXED, __HIP_MEMORY_SCOPE_AGENT); }
__device__ __forceinline__ unsigned xb_xcc_id() { return (unsigned)__builtin_amdgcn_s_getreg((3 << 11) | 20) & 0xFu; }
#define XB_SPIN(cond, bar) do { unsigned _sp = 0; while (cond) { __builtin_amdgcn_s_sleep(1); \
    if ((++_sp & 255u) == 0u) { if (xb_ld(&(bar)[XB_TMO])) break; if (_sp > XB_SPIN_CAP) { atomicAdd(&(bar)[XB_TMO], 1u); break; } } } } while (0)

struct XcdBarrier {
    unsigned* bar; unsigned x;
    volatile LDSF unsigned* st;
};

__device__ __forceinline__ XcdBarrier xcd_barrier_post(unsigned* bar, volatile LDSF unsigned* st) {
    XcdBarrier b; b.bar = bar; b.x = xb_xcc_id(); b.st = st;
    if (threadIdx.x == 0) (void)xb_add(&bar[XB_XCNT(b.x)], 1u);
    return b;
}
__device__ __forceinline__ void xcd_barrier_complete(unsigned* bar, unsigned x, unsigned& nloc, unsigned& nx) {
    const unsigned G = gridDim.x * gridDim.y * gridDim.z;
    unsigned sum, cnt, mine, sp = 0u;
    for (;;) {
        sum = 0u; cnt = 0u; mine = 0u;
#pragma unroll
        for (unsigned j = 0; j < 16; ++j) { const unsigned c = xb_ld(&bar[XB_XCNT(j)]); sum += c; cnt += (c > 0u) ? 1u : 0u; mine = (j == x) ? c : mine; }
        if (sum == G) break;
        __builtin_amdgcn_s_sleep(1);
        if ((++sp & 255u) == 0u) { if (xb_ld(&bar[XB_TMO])) break; if (sp > XB_SPIN_CAP) { atomicAdd(&bar[XB_TMO], 1u); break; } }
    }
    nloc = mine > 0u ? mine : 1u; nx = cnt > 0u ? cnt : 1u;
}

__device__ __forceinline__ void xcd_barrier(const XcdBarrier& b) {
    asm volatile("s_waitcnt vmcnt(0)" ::: "memory");
    __syncthreads();
    if (threadIdx.x == 0) {
        unsigned* bar = b.bar;
        __builtin_amdgcn_s_waitcnt(0);
        unsigned nloc = b.st[0], nx = b.st[1];
        if (nloc == 0u) { xcd_barrier_complete(bar, b.x, nloc, nx); b.st[0] = nloc; b.st[1] = nx; }
        const unsigned old = xb_add(&bar[XB_XSUB(b.x)], 1u);
        const unsigned gen = old / nloc;
        if (old + 1u == (gen + 1u) * nloc) {
            __builtin_amdgcn_fence(__ATOMIC_RELEASE, "agent");
            asm volatile("s_waitcnt vmcnt(0)" ::: "memory");
            const unsigned og = xb_add(&bar[XB_TOP], 1u);
            const unsigned tg = og / nx;
            if (og + 1u == (tg + 1u) * nx) xb_add(&bar[XB_TOPGEN], 1u);
            else XB_SPIN(xb_ld(&bar[XB_TOPGEN]) == tg, bar);
            __builtin_amdgcn_fence(__ATOMIC_ACQUIRE, "agent");
            xb_add(&bar[XB_XGEN(b.x)], 1u);
            asm volatile("s_waitcnt vmcnt(0)" ::: "memory");
        } else {
            XB_SPIN(xb_ld(&bar[XB_XGEN(b.x)]) == gen, bar);
            __builtin_amdgcn_fence(__ATOMIC_ACQUIRE, "agent");
            asm volatile("s_waitcnt vmcnt(0)" ::: "memory");
        }
    }
    __syncthreads();
}

namespace cg = cooperative_groups;
constexpr int LDS_BYTES = 131072 + 8192 + 4096 + 1024;
#define LAS3 __attribute__((address_space(3)))
#ifndef PROBE
#define PROBE 0
#endif
__global__ void __launch_bounds__(NTHR, 2) mega(Params p) {
    extern __shared__ __attribute__((aligned(16))) unsigned char lds[];
    cg::grid_group grid = cg::this_grid();
#if PROBE
    unsigned long long tacc = 0, tph = 0, t0_;
#define GSYNC() do { t0_ = __builtin_amdgcn_s_memrealtime(); xcd_barrier(xbar); tacc += __builtin_amdgcn_s_memrealtime() - t0_; } while (0)
#define TPK(k, ...) do { if (PROBE == (k)) { t0_ = __builtin_amdgcn_s_memrealtime(); __VA_ARGS__; tph += __builtin_amdgcn_s_memrealtime() - t0_; } else { __VA_ARGS__; } } while (0)
#else
#define GSYNC() xcd_barrier(xbar)
#define TPK(k, ...) do { __VA_ARGS__; } while (0)
#endif
    LAS3 unsigned char* lds3 = (LAS3 unsigned char*)lds;
    volatile LDSF unsigned* bst = (volatile LDSF unsigned*)(lds3 + 131072 + 2048);
    if (threadIdx.x < 2) bst[threadIdx.x] = 0u;
    __syncthreads();
    XcdBarrier xbar = xcd_barrier_post((unsigned*)(p.ws + WS_CTL) + 16384, bst);
    TPK(2, ph_mod(p, lds); ph_reset_queues(p); ph_weights(p, 0, lds));
    grid.sync();
    for (int l = 0; l < DEPTH; ++l) {
        const float* mod = (const float*)(p.ws + WS_MOD) + (size_t)l * 4 * 6144;
        TPK(2, if (l == 0) ph_xa_from(p, p.x, 0, 0, (bf16_t*)(p.ws + WS_XA), (float*)(p.ws + WS_RSA), true); ph_cbias(p, l, 1));
        GSYNC();
        {   pg8::Gemm g{(const bf16_t*)(p.ws + WS_XA), (const bf16_t*)(p.ws + WS_WIN + l * WS_W1OFF), MTOK, PINP, DM}; pg8::StaticOrder S; S.init(MTOK, PINP, (int)gridDim.x, (int)blockIdx.x);
            EpiProjF E{(const float*)(p.ws + WS_RSA), (const float*)(p.ws + WS_CBIN) + (size_t)l * 4 * PINP, (bf16_t*)(p.ws + WS_PROJ), (float*)(p.ws + WS_SIDE),
                       p.diff_kn + l * 32, p.fox_kn + l * 64, p.nsa_kn + (l * 3 + 1) * 64, p.nsa_kn + (l * 3 + 2) * 64, (LDSF float*)(lds3 + 131072 + 4096), (LDSF float*)(lds3 + 131072 + 12288)};
            TPK(6, pg8::gemm_phase<EpiProjF, pg8::StaticOrder, true, PG8_SP2>(lds3, g, S, E)); }
        GSYNC();
        TPK(7, fa_phase_all(p, l, lds3, lds, l, (l + 1 < DEPTH) ? CV_ITEMS / 8 : 0));
        GSYNC();
        {   pg8::Gemm g{(const bf16_t*)p.out, (const bf16_t*)(p.ws + WS_WOUT + l * WS_W1OFF), MTOK, DM, DM}; pg8::StaticOrder S; S.init(MTOK, DM, (int)gridDim.x, (int)blockIdx.x);
            EpiResF E{nullptr, (bf16_t*)(p.ws + WS_XR), mod + 2048, p.norm_ffn_g + l * DM, mod + 4096, (bf16_t*)(p.ws + WS_XA), (float*)(p.ws + WS_RSB)};
            TPK(6, pg8::gemm_phase<EpiResF, pg8::StaticOrder, PG8_ALIGN, PG8_SP2>(lds3, g, S, E)); }
        GSYNC();
        {   pg8::Gemm g{(const bf16_t*)(p.ws + WS_XA), (const bf16_t*)(p.ws + WS_WUP + l * WS_W1OFF), MTOK, NUP, DM}; pg8::StaticOrder S; S.init(MTOK, NUP, (int)gridDim.x, (int)blockIdx.x);
            EpiUpAct E{(const float*)(p.ws + WS_RSB), (const float*)(p.ws + WS_CBUP) + (size_t)l * 4 * NUP, (bf16_t*)(p.ws + WS_ACT), (float*)(p.ws + WS_EG), (float*)(p.ws + WS_EV),
                       p.conv_w + (size_t)l * 3 * DFF, p.conv_b + (size_t)l * DFF, (LDSF float*)(lds3 + 131072 + 4096), (LDSF float*)(lds3 + 131072 + 8192)};
            TPK(6, pg8::gemm_phase<EpiUpAct, pg8::StaticOrder, true, PG8_SP2>(lds3, g, S, E)); }
        GSYNC();
        {   const float* modn = (const float*)(p.ws + WS_MOD) + (size_t)(l + 1) * 4 * 6144; const bool more = (l + 1 < DEPTH);
            pg8::Gemm g{(const bf16_t*)(p.ws + WS_ACT), (const bf16_t*)(p.ws + WS_WDN + l * WS_W1OFF), MTOK, DM, DFF}; pg8::StaticOrder S; S.init(MTOK, DM, (int)gridDim.x, (int)blockIdx.x);
            { pg8::Unit fu; for (int i = 0; S.next(i, fu); ++i) act_fixup(p, l, fu.pm); }
            asm volatile("s_waitcnt vmcnt(0)" ::: "memory"); __syncthreads();
            EpiResF E{more ? nullptr : p.out, (bf16_t*)(p.ws + WS_XR), mod + 5120, p.norm_mix_g + (more ? l + 1 : l) * DM, more ? modn + 1024 : mod + 1024, more ? (bf16_t*)(p.ws + WS_XA) : nullptr, more ? (float*)(p.ws + WS_RSA) : nullptr};
            TPK(6, pg8::gemm_phase<EpiResF, pg8::StaticOrder, PG8_ALIGN, PG8_SP2>(lds3, g, S, E)); }
    }
#if PROBE == 1
    if (blockIdx.x == 0 && threadIdx.x == 0) p.out[0] += 0.05f + (float)tacc * 0.01f * 5e-4f;
#elif PROBE >= 2
    if (blockIdx.x == 0 && threadIdx.x == 0) p.out[0] += 0.05f + (float)tph * 0.01f * 1e-4f;
#endif
}

extern "C" void kernel_launch(void* const* d_in, const int* in_sizes, int in, void* d_out, int out_size, void* d_ws, size_t ws_size, hipStream_t stream) {
    if (in != 24 || ws_size < WS_END || out_size != MTOK * DM) { fprintf(stderr, "kernel_launch: unexpected sizes (in %d, ws %zu, out %d)\n", in, ws_size, out_size); return; }
    static int grid_blocks = 0;
    if (!grid_blocks) {
        int dev = 0, cus = 0, per_cu = 0;
        hipGetDevice(&dev);
        hipDeviceGetAttribute(&cus, hipDeviceAttributeMultiprocessorCount, dev);
        hipFuncSetAttribute((const void*)mega, hipFuncAttributeMaxDynamicSharedMemorySize, LDS_BYTES);
        hipOccupancyMaxActiveBlocksPerMultiprocessor(&per_cu, (const void*)mega, NTHR, LDS_BYTES);
        if (per_cu < 1) { fprintf(stderr, "kernel_launch: occupancy query returned %d\n", per_cu); per_cu = 1; }
        if (per_cu > 1) per_cu = 1;
        grid_blocks = cus * per_cu;
        fprintf(stderr, "kernel_launch: cus %d per_cu %d grid %d\n", cus, per_cu, grid_blocks);
    }
    if (hipMemsetAsync((char*)d_ws + WS_CTL + 65536, 0, XCD_BAR_WORDS * 4, stream) != hipSuccess) { fprintf(stderr, "kernel_launch: memset failed\n"); return; }
    Params p{};
    const float** f = (const float**)&p;
    for (int i = 0; i < 24; ++i) f[i] = (const float*)d_in[i];
    p.out = (float*)d_out; p.ws = (unsigned char*)d_ws;
    void* args[] = {&p};
    hipError_t e = hipLaunchCooperativeKernel((const void*)mega, dim3(grid_blocks), dim3(NTHR), args, LDS_BYTES, stream);
    if (e != hipSuccess) fprintf(stderr, "cooperative launch failed: %s (grid %d)\n", hipGetErrorString(e), grid_blocks);
}
```

```cpp
#include <hip/hip_runtime.h>
#include <hip/hip_cooperative_groups.h>
#include <cstdint>
#include <cstdio>

typedef unsigned short bf16_t;
typedef short bf16x8 __attribute__((ext_vector_type(8)));
typedef float f32x4 __attribute__((ext_vector_type(4)));
typedef unsigned u32x4 __attribute__((ext_vector_type(4)));

constexpr int NB = 4, SEQ = 4096, DM = 1024, MTOK = NB * SEQ, DEPTH = 2;
constexpr int HD = 64, HPM = 4, DFF = 2816, PIN = 2960, PINP = 3072, NUP = 2 * DFF;
constexpr float EPS = 1e-6f;
constexpr float LOG2E = 1.4426950408889634f;
constexpr int NTHR = 512;

constexpr int CA_Q = 0, CA_K = 256, CA_V = 512, CB_Q = 768, CB_K = 1024, CB_V = 1280, CC_Q = 1536, CC_K = 1792, CC_V = 2048;
constexpr int CD_Q = 2304, CD_KC = 2560, CD_VC = 2624, CD_KS = 2688, CD_VS = 2752, CD_KW = 2816, CD_VW = 2880, C_BF = 2944, C_DG = 2948;

constexpr size_t MiB = 1u << 20;
constexpr size_t WS_CTL = 0;
constexpr size_t WS_MOD = 1 * MiB;
constexpr size_t WS_CBIN = WS_MOD + 2 * 4 * 6144 * 4;
constexpr size_t WS_CBUP = WS_CBIN + 2 * 4 * 3072 * 4;
constexpr size_t WS_TB = WS_CBUP + 2 * 4 * 5632 * 4;
constexpr size_t WS_LAM = WS_TB + 2 * 4 * 128 * 4;
constexpr size_t WS_BND = WS_LAM + 64;
constexpr size_t WS_CUM = WS_LAM + 512;
constexpr size_t WS_KC = WS_CUM + 16 * 4096 * 4;
constexpr size_t WS_VC = WS_KC + 4 * 256 * 64 * 2;
constexpr size_t WS_SELM = WS_VC + 4 * 256 * 64 * 2;
constexpr size_t WS_SMALL_END = WS_SELM + 16384 * 8;
static_assert(WS_SMALL_END <= 4 * MiB, "small region");
constexpr size_t WS_RSA = 4 * MiB;
constexpr size_t WS_RSB = 5 * MiB;
constexpr size_t WS_SIDE = 6 * MiB;
constexpr size_t WS_IMP = 7 * MiB;
constexpr size_t WS_ML = 11 * MiB;
constexpr size_t WS_PHIT = 7 * MiB;
constexpr size_t WS_W = 12 * MiB;
constexpr size_t WS_WIN = WS_W;
constexpr size_t WS_WOUT = WS_WIN + (size_t)PINP * DM * 2;
constexpr size_t WS_WUP = WS_WOUT + (size_t)DM * DM * 2;
constexpr size_t WS_WDN = WS_WUP + (size_t)NUP * DM * 2;
constexpr size_t WS_W_END = WS_WDN + (size_t)DM * DFF * 2;
static_assert(WS_W_END <= 38 * MiB, "weights region");
constexpr size_t WS_XA = 38 * MiB;
constexpr size_t WS_BIG = 70 * MiB;
constexpr size_t WS_PROJ = WS_BIG;
constexpr size_t WS_XR = WS_BIG + 96 * MiB;
constexpr size_t WS_ACT = WS_BIG;
constexpr size_t WS_W1OFF = 188 * MiB;
constexpr size_t WS_EG = 228 * MiB;
constexpr size_t WS_EV = 232 * MiB;
constexpr size_t WS_END = 236 * MiB;
static_assert(WS_W_END + WS_W1OFF <= WS_EG && WS_XR + 32 * MiB <= WS_W + WS_W1OFF, "layer-1 weights");
static_assert(WS_END <= 256 * MiB, "workspace");

struct Params {
    const float *x, *c, *rel_bias, *ada_w, *ada_b, *norm_mix_g, *norm_ffn_g, *w_in, *w_out;
    const float *diff_qn, *diff_kn, *diff_lam, *diff_sub, *fox_qn, *fox_kn, *fox_bf;
    const float *nsa_qn, *nsa_kn, *nsa_pe, *nsa_phi, *w_up, *conv_w, *conv_b, *w_down;
    float* out;
    unsigned char* ws;
};

__device__ __forceinline__ float bf2f(bf16_t v) { return __uint_as_float(((unsigned)v) << 16); }
__device__ __forceinline__ bf16_t f2bf(float f) { unsigned u = __float_as_uint(f); return (bf16_t)((u + 0x7fffu + ((u >> 16) & 1u)) >> 16); }
__device__ __forceinline__ unsigned pk2(float lo, float hi) { return (unsigned)f2bf(lo) | ((unsigned)f2bf(hi) << 16); }
__device__ __forceinline__ float siluf(float v) { return v / (1.f + __expf(-v)); }
__device__ __forceinline__ float logsigf(float v) { return fminf(v, 0.f) - log1pf(__expf(-fabsf(v))); }
__device__ __forceinline__ float wave_sum(float v) {
#pragma unroll
    for (int o = 1; o < 64; o <<= 1) v += __shfl_xor(v, o);
    return v;
}
__device__ __forceinline__ int t5_bucket(int n) {
    if (n < 16) return n < 0 ? 0 : n;
    return 16 + (n >= 19) + (n >= 21) + (n >= 24) + (n >= 27) + (n >= 31) + (n >= 35) + (n >= 40) + (n >= 46) + (n >= 52) + (n >= 59) + (n >= 67) + (n >= 77) + (n >= 87) + (n >= 99) + (n >= 113);
}
__host__ __device__ __forceinline__ int in_col_map(int n) {
    if (n < 1536) return n;
    if (n < 2944) return n + 4;
    if (n < 2948) return 1536 + (n - 2944);
    if (n < 2960) return n;
    return -1;
}
__host__ __device__ __forceinline__ int up_col_map(int n) {
    const int pn = n >> 8, c = n & 255;
    return c < 128 ? (128 * pn + c) : (DFF + 128 * pn + (c - 128));
}

__device__ __forceinline__ int opaque_v(int v) { asm volatile("" : "+v"(v)); return v; }
#define TID() opaque_v((int)threadIdx.x)
typedef unsigned st_u32x4 __attribute__((ext_vector_type(4)));
__device__ __forceinline__ void st_wt(void* p, st_u32x4 v) { asm volatile("global_store_dwordx4 %0, %1, off sc1\n\ts_nop 2" :: "v"(p), "v"(v) : "memory"); }
#define GTID() ((int)(blockIdx.x * blockDim.x) + TID())
#define GSIZE() ((int)(gridDim.x * blockDim.x))

__device__ __forceinline__ void load8(const bf16_t* p, float* d) {
    const u32x4 r = *(const u32x4*)p;
    d[0] = bf2f(r[0] & 0xffff); d[1] = bf2f(r[0] >> 16); d[2] = bf2f(r[1] & 0xffff); d[3] = bf2f(r[1] >> 16);
    d[4] = bf2f(r[2] & 0xffff); d[5] = bf2f(r[2] >> 16); d[6] = bf2f(r[3] & 0xffff); d[7] = bf2f(r[3] >> 16);
}
#define LDSF __attribute__((address_space(3)))
__device__ __forceinline__ void gemv4_block(const float* W, int ld, int n0, const LDSF float* vec, LDSF float* red, float* out0, int ostride, const float* bias, int tid) {
    const int lane = tid & 63, wv = tid >> 6, r4 = lane >> 4, c16 = lane & 15;
    const float* w = W + (size_t)(wv * 128 + r4) * ld + n0 + c16 * 4;
    f32x4 a0 = (f32x4){0.f, 0.f, 0.f, 0.f}, a1 = a0, a2 = a0, a3 = a0;
#pragma unroll
    for (int h = 0; h < 2; ++h) {
        f32x4 wr[16];
#pragma unroll
        for (int i = 0; i < 16; ++i) wr[i] = *(const f32x4*)(w + (size_t)(4 * (16 * h + i)) * ld);
        asm volatile("" ::: "memory");
#pragma unroll
        for (int i = 0; i < 16; ++i) { const f32x4 v = *(const LDSF f32x4*)(vec + (wv * 128 + 4 * (16 * h + i) + r4) * 4);
            a0 += wr[i] * v[0]; a1 += wr[i] * v[1]; a2 += wr[i] * v[2]; a3 += wr[i] * v[3]; }
        asm volatile("" : "+v"(a0), "+v"(a1), "+v"(a2), "+v"(a3) :: "memory");
    }
#pragma unroll
    for (int c = 0; c < 4; ++c) {
        float t0 = a0[c], t1 = a1[c], t2 = a2[c], t3 = a3[c];
        t0 += __shfl_xor(t0, 16); t0 += __shfl_xor(t0, 32); t1 += __shfl_xor(t1, 16); t1 += __shfl_xor(t1, 32);
        t2 += __shfl_xor(t2, 16); t2 += __shfl_xor(t2, 32); t3 += __shfl_xor(t3, 16); t3 += __shfl_xor(t3, 32);
        if (r4 == 0) { red[(wv * 4 + 0) * 64 + c16 * 4 + c] = t0; red[(wv * 4 + 1) * 64 + c16 * 4 + c] = t1; red[(wv * 4 + 2) * 64 + c16 * 4 + c] = t2; red[(wv * 4 + 3) * 64 + c16 * 4 + c] = t3; }
    }
    __syncthreads();
    if (tid < 256) { const int bt = tid >> 6; float sacc = 0.f;
#pragma unroll
        for (int w8 = 0; w8 < 8; ++w8) sacc += red[(w8 * 4 + bt) * 64 + lane];
        out0[(size_t)bt * ostride + n0 + lane] = sacc + bias[n0 + lane]; }
    __syncthreads();
}
__device__ void ph_mod(const Params& p, unsigned char* lds) {
    float* mod = (float*)(p.ws + WS_MOD);
    float* tb = (float*)(p.ws + WS_TB);
    float* lamv = (float*)(p.ws + WS_LAM);
    LDSF float* vec = (LDSF float*)lds; LDSF float* red = (LDSF float*)(lds + 16384);
    const int tid = TID();
    bool loaded = false;
    for (int item = blockIdx.x; item < DEPTH * 96; item += gridDim.x) {
        if (!loaded) { for (int i = tid; i < 4096; i += NTHR) { const int bt = i >> 10, k = i & 1023; vec[k * 4 + bt] = siluf(p.c[bt * DM + k]); } __syncthreads(); loaded = true; }
        const int l = item / 96, n0 = (item % 96) * 64;
        gemv4_block(p.ada_w + (size_t)l * DM * 6144, 6144, n0, vec, red, mod + (size_t)l * 4 * 6144, 6144, p.ada_b + l * 6144, tid);
    }
    const int gt = GTID(), gs = GSIZE();
    for (int idx = gt; idx < 2 * 4 * 128; idx += gs) {
        const int type = idx / 512, h = (idx / 128) & 3, d = idx & 127;
        tb[idx] = p.rel_bias[t5_bucket(d) * 8 + type * 4 + h];
    }
    const int lane = tid & 63, gwr = ((int)gridDim.x - 1 - (int)blockIdx.x) * (NTHR >> 6) + (tid >> 6);
    if (gwr < DEPTH * 32) {
        const int idx = gwr, l = idx >> 5, e = idx & 31; float v = 0.f;
        if (e < 17) {
            const int type = (e < 5) ? 0 : 1, h = (e < 4) ? e : ((e == 4) ? 0 : ((e - 5) & 3));
            const int ng = (e < 4) ? 32 : 64;
            const float* gq = (e < 4) ? p.diff_qn + l * 32 : ((e == 4) ? p.fox_qn + l * 64 : p.nsa_qn + l * 64);
            const float* gk = (e < 4) ? p.diff_kn + l * 32 : ((e == 4) ? p.fox_kn + l * 64 : p.nsa_kn + (l * 3 + (e - 5) / 4) * 64);
            float mq = (lane < ng) ? fabsf(gq[lane]) : 0.f, mk = (lane < ng) ? fabsf(gk[lane]) : 0.f;
            float tm = (e != 4 && lane < 32) ? p.rel_bias[lane * 8 + type * 4 + h] : -INFINITY;
#pragma unroll
            for (int o = 32; o > 0; o >>= 1) { mq = fmaxf(mq, __shfl_xor(mq, o)); mk = fmaxf(mk, __shfl_xor(mk, o)); tm = fmaxf(tm, __shfl_xor(tm, o)); }
            if (e == 4) tm = 0.f;
            v = sqrtf((float)ng) * mq * mk * 1.02f * LOG2E + tm * LOG2E;
        }
        if (lane == 0) ((float*)(p.ws + WS_BND))[idx] = v;
    } else if (gwr < DEPTH * 32 + DEPTH) {
        const int idx = gwr - DEPTH * 32; const float* lv = p.diff_lam + idx * 4 * 32;
        float s1 = (lane < 32) ? lv[lane] * lv[32 + lane] : 0.f, s2 = (lane < 32) ? lv[64 + lane] * lv[96 + lane] : 0.f;
        s1 = wave_sum(s1); s2 = wave_sum(s2);
        const float lam_init = 0.8f - 0.6f * expf(-0.3f * (float)idx);
        if (lane == 0) lamv[idx] = expf(s1) - expf(s2) + lam_init;
    }
}
__device__ void ph_cbias(const Params& p, int lfirst, int lcount, int blk, int nblk) {
    const float* mod = (const float*)(p.ws + WS_MOD);
    const int tid_ = TID(); const int lane = tid_ & 63, wv = tid_ >> 6;
    const int gw = blk * (NTHR >> 6) + wv, ngw = nblk * (NTHR >> 6);
    constexpr int NCOL = PINP + NUP;
    const int per = (lcount * NCOL + ngw - 1) / ngw; const int c0 = gw * per, c1 = min(lcount * NCOL, c0 + per);
    int cur_key = -1; float sh[4][16];
    for (int c = c0; c < c1; ++c) {
        const int l = lfirst + c / NCOL, r = c % NCOL; const bool isin = r < PINP; const int n = isin ? r : r - PINP; const int key = l * 2 + (isin ? 0 : 1);
        if (key != cur_key) { cur_key = key; const int shoff = isin ? 0 : 3072;
#pragma unroll
            for (int bt = 0; bt < 4; ++bt)
#pragma unroll
                for (int q4 = 0; q4 < 4; ++q4) { const f32x4 v = *(const f32x4*)(mod + (size_t)(l * 4 + bt) * 6144 + shoff + 16 * lane + 4 * q4); sh[bt][4 * q4] = v[0]; sh[bt][4 * q4 + 1] = v[1]; sh[bt][4 * q4 + 2] = v[2]; sh[bt][4 * q4 + 3] = v[3]; } }
        const bf16_t* wrow = (const bf16_t*)(p.ws + (isin ? WS_WIN : WS_WUP) + l * WS_W1OFF) + (size_t)n * DM + 16 * lane;
        float w[16]; load8(wrow, w); load8(wrow + 8, w + 8);
        float a0 = 0.f, a1 = 0.f, a2 = 0.f, a3 = 0.f;
#pragma unroll
        for (int j = 0; j < 16; ++j) { a0 += sh[0][j] * w[j]; a1 += sh[1][j] * w[j]; a2 += sh[2][j] * w[j]; a3 += sh[3][j] * w[j]; }
        a0 = wave_sum(a0); a1 = wave_sum(a1); a2 = wave_sum(a2); a3 = wave_sum(a3);
        if (lane == 0) { float* o = isin ? (float*)(p.ws + WS_CBIN) + (size_t)l * 4 * PINP : (float*)(p.ws + WS_CBUP) + (size_t)l * 4 * NUP; const int ld = isin ? PINP : NUP;
            o[n] = a0; o[ld + n] = a1; o[2 * ld + n] = a2; o[3 * ld + n] = a3; }
    }
}
template <int MAPK>
__device__ __forceinline__ void convert_one(const float* W, int K, int Nsrc, int Npad, bf16_t* Wt, LDSF float* scr, int it, int lane) {
    const int nnb = Npad / 64;
    const int kb = it / nnb, nb = it % nnb, k0 = kb * 64, n0 = nb * 64;
    {
        const int n = n0 + lane;
        const int oc = MAPK == 0 ? n : (MAPK == 1 ? in_col_map(n) : up_col_map(n));
        const float* wp = W + (size_t)k0 * Nsrc + (oc >= 0 ? oc : 0);
        {
            float tv[64];
#pragma unroll
            for (int i = 0; i < 64; ++i) tv[i] = wp[(size_t)i * Nsrc];
#pragma unroll
            for (int i = 0; i < 64; ++i) scr[i * 65 + lane] = (oc >= 0) ? tv[i] : 0.f;
        }
    }
    __builtin_amdgcn_s_waitcnt(0xc07f); __builtin_amdgcn_wave_barrier();
    {
        const int c = lane & 7;
#pragma unroll
        for (int j = 0; j < 8; ++j) { const int nn = 8 * j + (lane >> 3); const LDSF float* sp = scr + (8 * c) * 65 + nn;
            u32x4 o; o[0] = pk2(sp[0], sp[65]); o[1] = pk2(sp[130], sp[195]); o[2] = pk2(sp[260], sp[325]); o[3] = pk2(sp[390], sp[455]);
            *(u32x4*)(Wt + (size_t)(n0 + nn) * K + k0 + 8 * c) = o; }
    }
    __builtin_amdgcn_s_waitcnt(0xc07f); __builtin_amdgcn_wave_barrier();
}
constexpr int CV_IN = 16 * (PINP / 64), CV_OUT = 16 * (DM / 64), CV_UP = 16 * (NUP / 64), CV_DN = (DFF / 64) * (DM / 64), CV_PHI = 32, CV_ITEMS = CV_IN + CV_OUT + CV_UP + CV_DN + 2 * CV_PHI;
static_assert(CV_ITEMS == 3200, "conversion item count");
__device__ void convert_item(const Params& p, int l, int idx, LDSF float* scr, int lane) {
    if (idx < CV_IN) { convert_one<1>(p.w_in + (size_t)l * DM * PIN, DM, PIN, PINP, (bf16_t*)(p.ws + WS_WIN + l * WS_W1OFF), scr, idx, lane); return; } idx -= CV_IN;
    if (idx < CV_OUT) { convert_one<0>(p.w_out + (size_t)l * DM * DM, DM, DM, DM, (bf16_t*)(p.ws + WS_WOUT + l * WS_W1OFF), scr, idx, lane); return; } idx -= CV_OUT;
    if (idx < CV_UP) { convert_one<2>(p.w_up + (size_t)l * DM * NUP, DM, NUP, NUP, (bf16_t*)(p.ws + WS_WUP + l * WS_W1OFF), scr, idx, lane); return; } idx -= CV_UP;
    if (idx < CV_DN) { convert_one<0>(p.w_down + (size_t)l * DFF * DM, DFF, DM, DM, (bf16_t*)(p.ws + WS_WDN + l * WS_W1OFF), scr, idx, lane); return; } idx -= CV_DN;
    const int w2 = idx / CV_PHI; idx -= w2 * CV_PHI;
    convert_one<0>(p.nsa_phi + (size_t)(l * 2 + w2) * 2048 * 64, 2048, 64, 64, (bf16_t*)(p.ws + WS_PHIT) + (size_t)(l * 2 + w2) * 64 * 2048, scr, idx, lane);
}
__device__ void ph_weights(const Params& p, int l, unsigned char* lds) {
    const int tid_ = TID(); const int lane = tid_ & 63, wv = tid_ >> 6;
    const int ngw = gridDim.x * (NTHR >> 6), gw = ngw - 1 - (blockIdx.x * (NTHR >> 6) + wv);
    LDSF float* scr = (LDSF float*)lds + wv * (64 * 65);
    for (int it = gw; it < CV_ITEMS; it += ngw) convert_item(p, l, it, scr, lane);
}
__device__ void ph_xa_from(const Params& p, const float* src, int l, int which  , bf16_t* XA, float* rowss, bool write_xa) {
    const float* mod = (const float*)(p.ws + WS_MOD);
    const float* g = (which == 0 ? p.norm_mix_g : p.norm_ffn_g) + l * DM;
    const int tid_ = TID(); const int lane = tid_ & 63, wv = tid_ >> 6;
    const int gw = blockIdx.x * (blockDim.x >> 6) + wv, ngw = gridDim.x * (blockDim.x >> 6);
    for (int row0 = gw; row0 < MTOK; row0 += 2 * ngw) {
        f32x4 v[2][2][2];
#pragma unroll
        for (int rr = 0; rr < 2; ++rr) { const int row = min(row0 + rr * ngw, MTOK - 1);
#pragma unroll
            for (int j = 0; j < 2; ++j) { const float* sp = src + (size_t)row * DM + j * 512 + lane * 8; v[rr][j][0] = *(const f32x4*)sp; v[rr][j][1] = *(const f32x4*)(sp + 4); } }
#pragma unroll
        for (int rr = 0; rr < 2; ++rr) {
            const int row = row0 + rr * ngw;
            if (row < MTOK) {
                const int b = row / SEQ; const float* sc = mod + (size_t)(l * 4 + b) * 6144 + (which == 0 ? 1024 : 4096);
                float ss = 0.f;
#pragma unroll
                for (int j = 0; j < 2; ++j) {
                    const int k = j * 512 + lane * 8; const f32x4 x0 = v[rr][j][0], x1 = v[rr][j][1];
                    ss += (x0[0] * x0[0] + x0[1] * x0[1] + x0[2] * x0[2] + x0[3] * x0[3]) + (x1[0] * x1[0] + x1[1] * x1[1] + x1[2] * x1[2] + x1[3] * x1[3]);
                    if (write_xa) {
                        const f32x4 g0 = *(const f32x4*)(g + k), g1 = *(const f32x4*)(g + k + 4); const f32x4 s0 = *(const f32x4*)(sc + k), s1 = *(const f32x4*)(sc + k + 4);
                        u32x4 o; o[0] = pk2(x0[0] * g0[0] * (1.f + s0[0]), x0[1] * g0[1] * (1.f + s0[1])); o[1] = pk2(x0[2] * g0[2] * (1.f + s0[2]), x0[3] * g0[3] * (1.f + s0[3]));
                        o[2] = pk2(x1[0] * g1[0] * (1.f + s1[0]), x1[1] * g1[1] * (1.f + s1[1])); o[3] = pk2(x1[2] * g1[2] * (1.f + s1[2]), x1[3] * g1[3] * (1.f + s1[3]));
                        *(u32x4*)(XA + (size_t)row * DM + k) = o;
                        u32x4 xo; xo[0] = pk2(x0[0], x0[1]); xo[1] = pk2(x0[2], x0[3]); xo[2] = pk2(x1[0], x1[1]); xo[3] = pk2(x1[2], x1[3]);
                        *(u32x4*)((bf16_t*)(p.ws + WS_XR) + (size_t)row * DM + k) = xo;
                    }
                }
                ss = wave_sum(ss);
                if (lane < 16) rowss[(size_t)row * 16 + lane] = (lane == 0) ? ss : 0.f;
            }
        }
    }
}

namespace pg8 {
#define PG8_LAS __attribute__((address_space(3)))
typedef unsigned short bf16_t;
typedef short bf16x8 __attribute__((ext_vector_type(8)));
typedef float f32x4 __attribute__((ext_vector_type(4)));
typedef unsigned u32x4 __attribute__((ext_vector_type(4)));
constexpr int BM = 256, BK = 64, HALF = 128, HTB = HALF * BK * 2  , STAGE_BYTES = 8 * HTB, NXCD = 8, WGM = 8;

__host__ __device__ __forceinline__ int lds_byte(int r, int c) { const int st = (r >> 4) * 2 + (c >> 5), rr = r & 15, cc = c & 31, ob = rr * 64 + cc * 2; return st * 1024 + (ob ^ (((ob >> 9) & 1) << 5)); }
__host__ __device__ __forceinline__ void stage_rc(int b, int& R, int& C) { const int st = b / 1024, sb = b % 1024, swz = sb ^ (((sb >> 9) & 1) << 5); R = (st >> 1) * 16 + swz / 64; C = (st & 1) * 32 + (swz % 64) / 2; }
__host__ __device__ __forceinline__ int perm32(int rho) { const int n = rho >> 4, i = rho & 15; return 8 * (i >> 2) + 4 * n + (i & 3); }

struct Unit { int pm, pn; };
struct Gemm { const bf16_t* A; const bf16_t* Bt; int M, N, K; };

struct StaticOrder {
    int nM, nN, nwg, G, c;
    __host__ __device__ void init(int M, int N, int G_, int c_) { nM = M / BM; nN = N / BM; nwg = nM * nN; G = G_; c = c_; }
    __host__ __device__ bool next(int i, Unit& u) const {
        const long L = (long)i * G + c; if (L >= nwg) return false;
        int wgid = (int)L; { const int q = nwg / NXCD, r = nwg % NXCD, xcd = wgid % NXCD, off = wgid / NXCD; wgid = (xcd < r ? xcd * (q + 1) : r * (q + 1) + (xcd - r) * q) + off; }
        const int nig = WGM * nN, gid = wgid / nig, fm = gid * WGM, gsz = (nM - fm) < WGM ? (nM - fm) : WGM;
        u.pm = fm + ((wgid % nig) % gsz); u.pn = (wgid % nig) / gsz; return true;
    }
    __device__ __forceinline__ void a_ready(const Unit&) const {}
    __device__ __forceinline__ void done(const Unit&) const {}
};


__device__ __forceinline__ unsigned cvt_pk_bf16(float lo, float hi) { unsigned r; asm volatile("v_cvt_pk_bf16_f32 %0, %1, %2" : "=v"(r) : "v"(lo), "v"(hi)); return r; }
template <class Epi, class Sched, bool ALIGN_EPI = false, bool SP2 = false>
__device__ __forceinline__ void gemm_phase(PG8_LAS unsigned char* lds, const Gemm g, const Sched& S, const Epi& E) {
    const int tid = TID(), wid = __builtin_amdgcn_readfirstlane(tid >> 6), lane = tid & 63, wr = wid >> 2, wc = wid & 3, fr = lane & 15, fq = lane >> 4;
    const int K = g.K, nt = K / BK;
    unsigned voffA[2], voffB[2];
#pragma unroll
    for (int i = 0; i < 2; ++i) { int R, C; stage_rc(tid * 16 + i * 8192, R, C); const int Rb = Epi::PERM ? ((R & ~31) + perm32(R & 31)) : R;
        voffA[i] = (unsigned)(R * K + C) * 2u; voffB[i] = (unsigned)(Rb * K + C) * 2u; }
    const size_t kstep = (size_t)(BK * 2);
    const size_t hstep = (size_t)HALF * K * 2;
    const size_t tstep = 2 * hstep;
    const unsigned ldsw = (unsigned)wid * 1024u;
    const int aoff = lds_byte(wr * 64 + fr, fq * 8), boff = lds_byte(wc * 32 + fr, fq * 8);
#define PG8_SA(b, h) (((b) * 2 + (h)) * HTB)
#define PG8_SB(b, h) ((4 + (b) * 2 + (h)) * HTB)
#define PG8_STAGE(bufoff, gbase, voff) do { _Pragma("unroll") for (int _i = 0; _i < 2; ++_i) \
        __builtin_amdgcn_global_load_lds((const unsigned*)((const char*)(gbase) + (voff)[_i]), (PG8_LAS unsigned*)(lds + (bufoff) + ldsw + _i * 8192), 16, 0, 0); } while (0)
#define PG8_LDA(dst, b, h) do { _Pragma("unroll") for (int m = 0; m < 4; ++m) _Pragma("unroll") for (int k = 0; k < 2; ++k) dst[m][k] = *(const PG8_LAS bf16x8*)(lds + PG8_SA(b, h) + aoff + m * 2048 + k * 1024); } while (0)
#define PG8_LDB(dst, b, h) do { _Pragma("unroll") for (int n = 0; n < 2; ++n) _Pragma("unroll") for (int k = 0; k < 2; ++k) dst[n][k] = *(const PG8_LAS bf16x8*)(lds + PG8_SB(b, h) + boff + n * 2048 + k * 1024); } while (0)
#define PG8_MMA(ai, bj, At, Bt) do { __builtin_amdgcn_s_setprio(1); _Pragma("unroll") for (int m = 0; m < 4; ++m) _Pragma("unroll") for (int n = 0; n < 2; ++n) _Pragma("unroll") for (int k = 0; k < 2; ++k) \
        acc[ai][bj][m][n] = __builtin_amdgcn_mfma_f32_16x16x32_bf16(Bt[n][k], At[m][k], acc[ai][bj][m][n], 0, 0, 0); __builtin_amdgcn_s_setprio(0); } while (0)
#define PG8_WAIT_V(n) asm volatile("s_waitcnt vmcnt(" #n ")" ::: "memory")
#define PG8_WAIT_L(n) asm volatile("s_waitcnt lgkmcnt(" #n ")" ::: "memory")
#define PG8_BAR __builtin_amdgcn_s_barrier()
#define PG8_SCHED __builtin_amdgcn_sched_barrier(0)
    Unit cur, nxt; int ui = 0;
    if (!S.next(0, cur)) return;
    f32x4 acc[2][2][4][2];
#pragma unroll
    for (int a = 0; a < 2; ++a)
#pragma unroll
        for (int b = 0; b < 2; ++b)
#pragma unroll
            for (int m = 0; m < 4; ++m)
#pragma unroll
                for (int n = 0; n < 2; ++n) acc[a][b][m][n] = (f32x4){0.f, 0.f, 0.f, 0.f};
    bf16x8 At[4][2], B0[2][2], B1[2][2];
    const char* cA = (const char*)g.A + (size_t)cur.pm * tstep; const char* cB = (const char*)g.Bt + (size_t)cur.pn * tstep;
    S.a_ready(cur);
    if constexpr (SP2) {
        PG8_STAGE(PG8_SB(0, 0), cB, voffB); PG8_STAGE(PG8_SB(0, 1), cB + hstep, voffB); PG8_STAGE(PG8_SA(0, 0), cA, voffA); PG8_STAGE(PG8_SA(0, 1), cA + hstep, voffA);
        if (wr == 1) PG8_BAR;
        PG8_WAIT_V(2); PG8_BAR;
        PG8_STAGE(PG8_SB(1, 0), cB + kstep, voffB); PG8_STAGE(PG8_SA(1, 0), cA + kstep, voffA); PG8_STAGE(PG8_SB(1, 1), cB + hstep + kstep, voffB);
        PG8_WAIT_V(6); PG8_BAR;
    } else {
        PG8_STAGE(PG8_SB(0, 0), cB, voffB); PG8_STAGE(PG8_SA(0, 0), cA, voffA); PG8_STAGE(PG8_SB(0, 1), cB + hstep, voffB); PG8_STAGE(PG8_SA(0, 1), cA + hstep, voffA);
        if (wr == 1) PG8_BAR;
        PG8_WAIT_V(4); PG8_BAR;
        PG8_STAGE(PG8_SB(1, 0), cB + kstep, voffB); PG8_STAGE(PG8_SA(1, 0), cA + kstep, voffA); PG8_STAGE(PG8_SB(1, 1), cB + hstep + kstep, voffB);
        PG8_WAIT_V(6); PG8_BAR;
    }
    for (;;) {
        const bool has_next = S.next(ui + 1, nxt);
        const char* nA = has_next ? (const char*)g.A + (size_t)nxt.pm * tstep : cA; const char* nB = has_next ? (const char*)g.Bt + (size_t)nxt.pn * tstep : cB;
        for (int t = 0; t < nt; t += 2) {
            const bool last = (t == nt - 2);
            const char* a1 = cA + (size_t)(t + 1) * kstep;
            const char* a2 = last ? nA : cA + (size_t)(t + 2) * kstep; const char* b2 = last ? nB : cB + (size_t)(t + 2) * kstep;
            const char* a3 = a2 + kstep; const char* b3 = b2 + kstep;
            if (last && has_next) S.a_ready(nxt);
            if constexpr (SP2) {
            PG8_LDB(B0, 0, 0); PG8_LDB(B1, 0, 1); PG8_SCHED; PG8_LDA(At, 0, 0); PG8_STAGE(PG8_SA(1, 1), a1 + hstep, voffA);
            PG8_WAIT_V(8); PG8_WAIT_L(0); PG8_BAR; PG8_MMA(0, 0, At, B0); PG8_MMA(0, 1, At, B1); PG8_BAR; PG8_SCHED;
            PG8_LDA(At, 0, 1); PG8_STAGE(PG8_SB(0, 0), b2, voffB); PG8_STAGE(PG8_SB(0, 1), b2 + hstep, voffB); PG8_STAGE(PG8_SA(0, 0), a2, voffA);
            PG8_WAIT_V(8); PG8_WAIT_L(0); PG8_BAR; PG8_MMA(1, 0, At, B0); PG8_MMA(1, 1, At, B1); PG8_BAR; PG8_SCHED;
            PG8_LDB(B0, 1, 0); PG8_LDB(B1, 1, 1); PG8_SCHED; PG8_LDA(At, 1, 0); PG8_STAGE(PG8_SA(0, 1), a2 + hstep, voffA);
            PG8_WAIT_V(8); PG8_WAIT_L(0); PG8_BAR; PG8_MMA(0, 0, At, B0); PG8_MMA(0, 1, At, B1); PG8_BAR; PG8_SCHED;
            PG8_LDA(At, 1, 1); PG8_STAGE(PG8_SB(1, 0), b3, voffB); PG8_STAGE(PG8_SB(1, 1), b3 + hstep, voffB); PG8_STAGE(PG8_SA(1, 0), a3, voffA);
            PG8_WAIT_V(8); PG8_WAIT_L(0); PG8_BAR; PG8_MMA(1, 0, At, B0); PG8_MMA(1, 1, At, B1); PG8_BAR; PG8_SCHED;
            } else {
            PG8_LDB(B0, 0, 0); PG8_SCHED; PG8_LDA(At, 0, 0); PG8_STAGE(PG8_SA(1, 1), a1 + hstep, voffA);
            PG8_WAIT_L(8); PG8_BAR; PG8_WAIT_L(0); PG8_MMA(0, 0, At, B0); PG8_BAR; PG8_SCHED;
            PG8_LDB(B1, 0, 1); PG8_STAGE(PG8_SB(0, 0), b2, voffB);
            PG8_BAR; PG8_WAIT_L(0); PG8_MMA(0, 1, At, B1); PG8_BAR;
            PG8_LDA(At, 0, 1); PG8_STAGE(PG8_SA(0, 0), a2, voffA);
            PG8_BAR; PG8_WAIT_L(0); PG8_MMA(1, 0, At, B0); PG8_BAR; PG8_SCHED;
            PG8_STAGE(PG8_SB(0, 1), b2 + hstep, voffB);
            PG8_WAIT_V(6); PG8_BAR; PG8_MMA(1, 1, At, B1); PG8_BAR;
            PG8_LDB(B0, 1, 0); PG8_SCHED; PG8_LDA(At, 1, 0); PG8_STAGE(PG8_SA(0, 1), a2 + hstep, voffA);
            PG8_WAIT_L(8); PG8_BAR; PG8_WAIT_L(0); PG8_MMA(0, 0, At, B0); PG8_BAR; PG8_SCHED;
            PG8_LDB(B1, 1, 1); PG8_STAGE(PG8_SB(1, 0), b3, voffB);
            PG8_BAR; PG8_WAIT_L(0); PG8_MMA(0, 1, At, B1); PG8_BAR;
            PG8_LDA(At, 1, 1); PG8_STAGE(PG8_SA(1, 0), a3, voffA);
            PG8_BAR; PG8_WAIT_L(0); PG8_MMA(1, 0, At, B0); PG8_BAR; PG8_SCHED;
            PG8_STAGE(PG8_SB(1, 1), b3 + hstep, voffB);
            PG8_WAIT_V(6); PG8_BAR; PG8_MMA(1, 1, At, B1); PG8_BAR;
            }
        }
        if constexpr (ALIGN_EPI) { if (wr == 0) PG8_BAR; }
        if constexpr (!Epi::AFTER_DRAIN) { E(acc, cur, wr, wc, fr, fq); S.done(cur); }
        if (!has_next) break;
#pragma unroll
        for (int a = 0; a < 2; ++a)
#pragma unroll
            for (int b = 0; b < 2; ++b)
#pragma unroll
                for (int m = 0; m < 4; ++m)
#pragma unroll
                    for (int n = 0; n < 2; ++n) acc[a][b][m][n] = (f32x4){0.f, 0.f, 0.f, 0.f};
        cur = nxt; cA = nA; cB = nB; ++ui;
        if constexpr (ALIGN_EPI) { if (wr == 1) PG8_BAR; }
    }
    PG8_WAIT_V(0);
    if constexpr (!ALIGN_EPI) { if (wr == 0) PG8_BAR; }
    PG8_BAR;
    if constexpr (Epi::AFTER_DRAIN) { E.fused(acc, cur, wr, wc, fr, fq, lds, wid, lane); S.done(cur); }
#undef PG8_SA
#undef PG8_SB
#undef PG8_STAGE
#undef PG8_LDA
#undef PG8_LDB
#undef PG8_MMA
#undef PG8_WAIT_V
#undef PG8_WAIT_L
#undef PG8_BAR
#undef PG8_SCHED
}
}

#ifndef PG8_SP2
#define PG8_SP2 true
#endif
#ifndef PG8_ALIGN
#define PG8_ALIGN true
#endif

__device__ __forceinline__ float row_rstd16(const float* rowss, int row) {
    const f32x4* r = (const f32x4*)(rowss + (size_t)row * 16);
    const f32x4 a = r[0], b = r[1], c = r[2], d = r[3];
    const float s = ((a[0] + a[1]) + (a[2] + a[3])) + ((b[0] + b[1]) + (b[2] + b[3])) + ((c[0] + c[1]) + (c[2] + c[3])) + ((d[0] + d[1]) + (d[2] + d[3]));
    return rsqrtf(s * (1.f / DM) + EPS);
}
struct EpiProjF {
    static constexpr bool PERM = true, AFTER_DRAIN = false;
    const float* rowss; const float* cb; bf16_t* proj; float* side; const float* g_a; const float* g_b; const float* g_ds; const float* g_dw; LDSF float* xs  ; LDSF float* rsl  ;
    __device__ __forceinline__ void operator()(const pg8::f32x4 (&acc)[2][2][4][2], const pg8::Unit& u, int wr, int wc, int fr, int fq) const {
        const int b = u.pm >> 4, colt = u.pn * 256 + wc * 32 + 8 * fq;
        const int knmode = (u.pn == 1) ? 1 : (u.pn == 4) ? 2 : (u.pn == 10) ? 3 : (u.pn == 11) ? 4 : 0;
        f32x4 cv[2][2];
#pragma unroll
        for (int bj = 0; bj < 2; ++bj)
#pragma unroll
            for (int n = 0; n < 2; ++n) cv[bj][n] = *(const f32x4*)(cb + b * PINP + colt + bj * 128 + 4 * n);
        {   const int tid = (wr * 4 + wc) * 64 + fq * 16 + fr;
            if (tid < 256) rsl[tid] = row_rstd16(rowss, u.pm * 256 + tid);
            asm volatile("s_waitcnt vmcnt(0) lgkmcnt(0)" ::: "memory"); __builtin_amdgcn_s_barrier(); asm volatile("" ::: "memory"); }
        if (knmode != 0) {
#pragma unroll
            for (int ai = 0; ai < 2; ++ai)
#pragma unroll
                for (int m = 0; m < 4; ++m) {
                    const float rsm = rsl[ai * 128 + wr * 64 + m * 16 + fr];
#pragma unroll
                    for (int bj = 0; bj < 2; ++bj) {
                        const f32x4 v0 = acc[ai][bj][m][0] * rsm + cv[bj][0], v1 = acc[ai][bj][m][1] * rsm + cv[bj][1];
                        float ss = (v0[0] * v0[0] + v0[1] * v0[1]) + (v0[2] * v0[2] + v0[3] * v0[3]) + (v1[0] * v1[0] + v1[1] * v1[1]) + (v1[2] * v1[2] + v1[3] * v1[3]);
                        ss += __shfl_xor(ss, 16); ss += __shfl_xor(ss, 32);
                        if (fq == 0) xs[((wr * 4 + wc) * 16 + (ai * 4 + m) * 2 + bj) * 16 + fr] = ss;
                    }
                }
            asm volatile("s_waitcnt lgkmcnt(0)" ::: "memory"); __builtin_amdgcn_s_barrier(); asm volatile("" ::: "memory");
        }
#pragma unroll
        for (int ai = 0; ai < 2; ++ai)
#pragma unroll
            for (int m = 0; m < 4; ++m) {
                const int row = u.pm * 256 + ai * 128 + wr * 64 + m * 16 + fr; const float rs = rsl[ai * 128 + wr * 64 + m * 16 + fr];
#pragma unroll
                for (int bj = 0; bj < 2; ++bj) {
                    f32x4 v0 = acc[ai][bj][m][0] * rs + cv[bj][0], v1 = acc[ai][bj][m][1] * rs + cv[bj][1]; const int col0 = colt + bj * 128;
                    if (col0 >= C_BF && col0 < PIN) { *(f32x4*)(side + (size_t)row * 16 + (col0 - C_BF)) = v0; *(f32x4*)(side + (size_t)row * 16 + (col0 - C_BF) + 4) = v1; }
                    const bool on = (knmode == 1) || (knmode == 2) || (knmode == 3 && bj == 1 && wc < 2) || (knmode == 4 && bj == 0 && wc < 2);
                    if (on) {
                        const int xi = (ai * 4 + m) * 2 + bj;
                        float tot = xs[((wr * 4 + wc) * 16 + xi) * 16 + fr]; float dn = 1.f / 32.f;
                        if (knmode != 1) { tot += xs[((wr * 4 + (wc ^ 1)) * 16 + xi) * 16 + fr]; dn = 1.f / 64.f; }
                        const float nrm = rsqrtf(tot * dn + EPS);
                        const float* gp = (knmode == 1) ? g_a + 8 * fq : ((knmode == 2) ? g_b : (knmode == 3 ? g_ds : g_dw)) + (wc & 1) * 32 + 8 * fq;
                        v0 = v0 * nrm * *(const f32x4*)gp; v1 = v1 * nrm * *(const f32x4*)(gp + 4);
                    }
                    u32x4 w; w[0] = pg8::cvt_pk_bf16(v0[0], v0[1]); w[1] = pg8::cvt_pk_bf16(v0[2], v0[3]); w[2] = pg8::cvt_pk_bf16(v1[0], v1[1]); w[3] = pg8::cvt_pk_bf16(v1[2], v1[3]);
                    *(u32x4*)(proj + (size_t)row * PINP + col0) = w;
                }
            }
    }
};
struct EpiResF {
    static constexpr bool PERM = true, AFTER_DRAIN = false;
    static constexpr int RB = 2;
    float* xout32; bf16_t* xr; const float* gate; const float* g; const float* sc; bf16_t* xa; float* rowss;
    __device__ __forceinline__ void operator()(const pg8::f32x4 (&acc)[2][2][4][2], const pg8::Unit& u, int wr, int wc, int fr, int fq) const {
        const int b = u.pm >> 4, colt = u.pn * 256 + wc * 32 + 8 * fq;
        f32x4 gt[2][2], gm[2][2];
#pragma unroll
        for (int bj = 0; bj < 2; ++bj)
#pragma unroll
            for (int n = 0; n < 2; ++n) { const int c = colt + bj * 128 + 4 * n; gt[bj][n] = *(const f32x4*)(gate + b * 6144 + c);
                if (xa) gm[bj][n] = *(const f32x4*)(g + c) * (*(const f32x4*)(sc + b * 6144 + c) + 1.0f); else gm[bj][n] = (f32x4){0.f, 0.f, 0.f, 0.f}; }
#pragma unroll
        for (int ai = 0; ai < 2; ++ai)
#pragma unroll
            for (int mh = 0; mh < 4 / RB; ++mh) {
                u32x4 xw[RB][2];
#pragma unroll
                for (int mm = 0; mm < RB; ++mm)
#pragma unroll
                    for (int bj = 0; bj < 2; ++bj)
                        xw[mm][bj] = *(const u32x4*)(xr + (size_t)(u.pm * 256 + ai * 128 + wr * 64 + (RB * mh + mm) * 16 + fr) * DM + colt + bj * 128);
                asm volatile("" ::: "memory");
#pragma unroll
                for (int mm = 0; mm < RB; ++mm) {
                    const int m = RB * mh + mm; const int row = u.pm * 256 + ai * 128 + wr * 64 + m * 16 + fr; float ss = 0.f;
#pragma unroll
                    for (int bj = 0; bj < 2; ++bj) {
                        const size_t off = (size_t)row * DM + colt + bj * 128;
                        const u32x4 L = xw[mm][bj];
                        f32x4 o[2];
#pragma unroll
                        for (int n = 0; n < 2; ++n) {
                            const f32x4 xi = (f32x4){__uint_as_float(L[2 * n] << 16), __uint_as_float(L[2 * n] & 0xffff0000u), __uint_as_float(L[2 * n + 1] << 16), __uint_as_float(L[2 * n + 1] & 0xffff0000u)};
                            o[n] = xi + gt[bj][n] * acc[ai][bj][m][n];
                            ss += (o[n][0] * o[n][0] + o[n][1] * o[n][1]) + (o[n][2] * o[n][2] + o[n][3] * o[n][3]);
                        }
                        if (xa) {
                            const f32x4 q0 = o[0] * gm[bj][0], q1 = o[1] * gm[bj][1];
                            *(u32x4*)(xr + off) = (u32x4){pg8::cvt_pk_bf16(o[0][0], o[0][1]), pg8::cvt_pk_bf16(o[0][2], o[0][3]), pg8::cvt_pk_bf16(o[1][0], o[1][1]), pg8::cvt_pk_bf16(o[1][2], o[1][3])};
                            *(u32x4*)(xa + off) = (u32x4){pg8::cvt_pk_bf16(q0[0], q0[1]), pg8::cvt_pk_bf16(q0[2], q0[3]), pg8::cvt_pk_bf16(q1[0], q1[1]), pg8::cvt_pk_bf16(q1[2], q1[3])};
                        } else {
                            *(f32x4*)(xout32 + off) = o[0]; *(f32x4*)(xout32 + off + 4) = o[1];
                        }
                    }
                    if (rowss) { ss += __shfl_xor(ss, 16); ss += __shfl_xor(ss, 32); if (fq == 0) rowss[(size_t)row * 16 + u.pn * 4 + wc] = ss; }
                }
            }
    }
};


#define DPPF(oldv, src, CTRL) __builtin_bit_cast(float, __builtin_amdgcn_update_dpp(__builtin_bit_cast(int, (float)(oldv)), __builtin_bit_cast(int, (float)(src)), (CTRL), 0xf, 0xf, false))
struct EpiUpAct {
    static constexpr bool PERM = true, AFTER_DRAIN = false;
    const float* rowss; const float* cb; bf16_t* act; float* eg; float* ev; const float* cw; const float* cbias; LDSF float* xch; LDSF float* cst  ;
    __device__ __forceinline__ void operator()(const pg8::f32x4 (&acc)[2][2][4][2], const pg8::Unit& u, int wr, int wc, int fr, int fq) const {
        const int b = u.pm >> 4, cih = wc * 32 + 8 * fq, jcol = u.pn * 128 + cih;
        const float* cbg = cb + b * NUP + u.pn * 256 + cih; const float* cbv = cbg + 128;
        {
            const int tid = (wr * 4 + wc) * 64 + fq * 16 + fr, col = tid & 127, arr = tid >> 7;
            const float* src = (arr == 0) ? cb + b * NUP + u.pn * 256 + col : (arr == 1) ? cb + b * NUP + u.pn * 256 + 128 + col : cw + (arr - 2) * DFF + u.pn * 128 + col;
            cst[arr * 128 + col] = *src * ((arr == 0) ? 1.f : (arr == 1) ? (1.f / LOG2E) : LOG2E);
            if (tid < 256) { const int a2 = 4 + (tid >> 7); cst[a2 * 128 + col] = ((a2 == 4) ? cw[2 * DFF + u.pn * 128 + col] : cbias[u.pn * 128 + col]) * LOG2E; }
            else cst[768 + (tid - 256)] = row_rstd16(rowss, u.pm * 256 + (tid - 256));
            const f32x4 cg0 = *(const f32x4*)cbg, cg1 = *(const f32x4*)(cbg + 4);
            const f32x4 cv0 = *(const f32x4*)cbv, cv1 = *(const f32x4*)(cbv + 4);
            asm volatile("s_waitcnt vmcnt(0) lgkmcnt(0)" ::: "memory"); __builtin_amdgcn_s_barrier(); asm volatile("" ::: "memory");
            const float r3a = cst[768 + 0 * 128 + wr * 64 + 48 + fr], r3b = cst[768 + 1 * 128 + wr * 64 + 48 + fr], r0 = cst[768 + (fr & 1)];
#pragma unroll
            for (int ai = 0; ai < 2; ++ai) {
                const float r3 = ai ? r3b : r3a;
                const f32x4 g0 = acc[ai][0][3][0] * r3 + cg0, g1 = acc[ai][0][3][1] * r3 + cg1;
                if (fr >= 14) { LDSF float* x = xch + ((((wr * 2 + ai) * 4 + wc) * 2 + (fr - 14)) * 32 + 8 * fq); *(LDSF f32x4*)x = g0; *(LDSF f32x4*)(x + 4) = g1;
                    if (wr == 1 && ai == 1) { float* e = eg + ((size_t)(u.pm * 4 + 2 + (fr - 14))) * DFF + jcol; *(f32x4*)e = g0; *(f32x4*)(e + 4) = g1; } }
            }
            if (wr == 0 && fr < 2) {
                float* e = eg + ((size_t)(u.pm * 4 + fr)) * DFF + jcol; float* v = ev + ((size_t)(u.pm * 2 + fr)) * DFF + jcol;
                *(f32x4*)e = acc[0][0][0][0] * r0 + cg0; *(f32x4*)(e + 4) = acc[0][0][0][1] * r0 + cg1;
                *(f32x4*)v = acc[0][1][0][0] * r0 + cv0; *(f32x4*)(v + 4) = acc[0][1][0][1] * r0 + cv1;
            }
        }
        asm volatile("s_waitcnt lgkmcnt(0)" ::: "memory"); __builtin_amdgcn_s_barrier(); asm volatile("" ::: "memory");
#define DPPZ(src, CTRL) __builtin_bit_cast(float, __builtin_amdgcn_update_dpp(0, __builtin_bit_cast(int, (float)(src)), (CTRL), 0xf, 0xf, true))
        const bool l15 = (fr == 15), l14 = (fr >= 14);
#pragma unroll
        for (int ai = 0; ai < 2; ++ai) {
            f32x4 pvv[2];
            if (ai == 0 && wr == 0) { pvv[0] = (f32x4){0.f, 0.f, 0.f, 0.f}; pvv[1] = pvv[0]; }
            else { const int swr = (wr == 1) ? 0 : 1, sai = (wr == 1) ? ai : ai - 1;
                const LDSF float* x = xch + ((((swr * 2 + sai) * 4 + wc) * 2 + (fr & 1)) * 32 + 8 * fq); pvv[0] = *(const LDSF f32x4*)x; pvv[1] = *(const LDSF f32x4*)(x + 4); }
            f32x4 pm1[2], pm0[2];
#pragma unroll
            for (int n = 0; n < 2; ++n) { const LDSF float* cc = cst + cih + 4 * n; const f32x4 k0 = *(const LDSF f32x4*)(cc + 256), k1 = *(const LDSF f32x4*)(cc + 384);
                pm1[n] = k1 * pvv[n]; pm0[n] = k0 * pvv[n]; }
#pragma unroll
            for (int m = 0; m < 4; ++m) {
                asm volatile("" ::: "memory");
                const int row = u.pm * 256 + ai * 128 + wr * 64 + m * 16 + fr; const float rsm = cst[768 + ai * 128 + wr * 64 + m * 16 + fr]; const float rsmv = rsm * (1.f / LOG2E);
                u32x4 w;
#pragma unroll
                for (int n = 0; n < 2; ++n) {
                    const LDSF float* cc = cst + cih + 4 * n;
                    const f32x4 cgn = *(const LDSF f32x4*)cc, cvn = *(const LDSF f32x4*)(cc + 128);
                    const f32x4 k0 = *(const LDSF f32x4*)(cc + 256), k1 = *(const LDSF f32x4*)(cc + 384), k2 = *(const LDSF f32x4*)(cc + 512), kb = *(const LDSF f32x4*)(cc + 640);
                    f32x4 c, v; float o[4];
#pragma unroll
                    for (int i = 0; i < 4; ++i) { c[i] = __builtin_fmaf(acc[ai][0][m][n][i], rsm, cgn[i]); v[i] = __builtin_fmaf(acc[ai][1][m][n][i], rsmv, cvn[i]); }
                    const f32x4 a1 = k1 * c, a0 = k0 * c;
#pragma unroll
                    for (int i = 0; i < 4; ++i) {
                        float cvv = __builtin_fmaf(k2[i], c[i], kb[i]);
                        cvv += DPPZ(l15 ? pm1[n][i] : a1[i], 0x121);
                        cvv += DPPZ(l14 ? pm0[n][i] : a0[i], 0x122);
                        o[i] = cvv * __builtin_amdgcn_rcpf(1.f + __builtin_amdgcn_exp2f(-cvv)) * v[i];
                    }
                    w[2 * n] = pg8::cvt_pk_bf16(o[0], o[1]); w[2 * n + 1] = pg8::cvt_pk_bf16(o[2], o[3]);
                    pm1[n] = a1; pm0[n] = a0;
                }
                st_wt(act + (size_t)row * DFF + jcol, w);
            }
        }
#undef DPPZ
    }
};
__device__ void act_fixup(const Params& p, int l, int pm) {
    if ((pm & 15) == 0) return;
    const float* eg = (const float*)(p.ws + WS_EG); const float* ev = (const float*)(p.ws + WS_EV); bf16_t* act = (bf16_t*)(p.ws + WS_ACT);
    const float* cw = p.conv_w + (size_t)l * 3 * DFF; const float* cbias = p.conv_b + (size_t)l * DFF;
    const int tid = TID();
    constexpr int NB4 = 11;
#pragma unroll 1
    for (int bt = 0; bt < 1; ++bt) {
        float a[NB4], bq[NB4], c0[NB4], c1[NB4], vv[NB4], k0[NB4], k1[NB4], k2[NB4], kb[NB4];
#pragma unroll
        for (int i = 0; i < NB4; ++i) { const int idx = min(tid + (bt * NB4 + i) * NTHR, 2 * DFF - 1); const int r = idx / DFF, j = idx - r * DFF;
            a[i] = eg[((size_t)((pm - 1) * 4 + 2)) * DFF + j]; bq[i] = eg[((size_t)((pm - 1) * 4 + 3)) * DFF + j]; c0[i] = eg[((size_t)(pm * 4 + 0)) * DFF + j]; c1[i] = eg[((size_t)(pm * 4 + 1)) * DFF + j];
            vv[i] = ev[((size_t)(pm * 2 + r)) * DFF + j]; k0[i] = cw[j]; k1[i] = cw[DFF + j]; k2[i] = cw[2 * DFF + j]; kb[i] = cbias[j]; }
        asm volatile("" ::: "memory");
#pragma unroll
        for (int i = 0; i < NB4; ++i) { const int idx = tid + (bt * NB4 + i) * NTHR;
            if (idx < 2 * DFF) { const int r = idx / DFF, j = idx - r * DFF;
                const float gm2 = r ? bq[i] : a[i], gm1 = r ? c0[i] : bq[i], gc = r ? c1[i] : c0[i];
                const float cvv = k0[i] * gm2 + k1[i] * gm1 + k2[i] * gc + kb[i];
                act[(size_t)(pm * 256 + r) * DFF + j] = f2bf(siluf(cvv) * vv[i]); } }
    }
}

__device__ void ph_prep_cum_bh(const Params& p, int l, int bh, unsigned char* lds) {
    const float* side = (const float*)(p.ws + WS_SIDE);
    float* cum = (float*)(p.ws + WS_CUM);
    LDSF float* wt = (LDSF float*)(lds + 70000);
    const int tid = TID(), lane = tid & 63, wv = tid >> 6;
    {
        const int b = bh >> 2, h = bh & 3; const float bf = p.fox_bf[l * 4 + h];
        float v[8]; float tot = 0.f;
#pragma unroll
        for (int i = 0; i < 8; ++i) { v[i] = logsigf(side[(size_t)(b * SEQ + tid * 8 + i) * 16 + h] + bf); tot += v[i]; v[i] = tot; }
        float inc = tot;
#pragma unroll
        for (int o = 1; o < 64; o <<= 1) { const float u = __shfl_up(inc, o); if (lane >= o) inc += u; }
        __syncthreads();
        if (lane == 63) wt[wv] = inc;
        __syncthreads();
        float base = inc - tot;
        for (int w8 = 0; w8 < wv; ++w8) base += wt[w8];
#pragma unroll
        for (int i = 0; i < 8; ++i) cum[bh * SEQ + tid * 8 + i] = base + v[i];
    }
}
template <int N> __device__ __forceinline__ float dotn(const float* q, const bf16_t* k) {
    float s = 0.f;
#pragma unroll
    for (int c = 0; c < N / 8; ++c) { float t[8]; load8(k + 8 * c, t);
#pragma unroll
        for (int j = 0; j < 8; ++j) s += q[8 * c + j] * t[j]; }
    return s;
}
template <int N> __device__ __forceinline__ void axpyn(float* o, float w, const bf16_t* v) {
#pragma unroll
    for (int c = 0; c < N / 8; ++c) { float t[8]; load8(v + 8 * c, t);
#pragma unroll
        for (int j = 0; j < 8; ++j) o[8 * c + j] += w * t[j]; }
}
template <int N> __device__ __forceinline__ void loadq_norm(float* q, const bf16_t* src, const float* g, float scale, bool norm) {
    float ss = 0.f;
#pragma unroll
    for (int c = 0; c < N / 8; ++c) load8(src + 8 * c, q + 8 * c);
#pragma unroll
    for (int j = 0; j < N; ++j) ss += q[j] * q[j];
    const float r = norm ? rsqrtf(ss * (1.f / N) + EPS) : 1.f;
#pragma unroll
    for (int j = 0; j < N; ++j) q[j] = q[j] * r * (norm ? g[j] : 1.f) * scale;
}
__device__ __forceinline__ void store64(bf16_t* dst, const float* o) {
#pragma unroll
    for (int c = 0; c < 8; ++c) { u32x4 w; w[0] = pk2(o[8 * c], o[8 * c + 1]); w[1] = pk2(o[8 * c + 2], o[8 * c + 3]); w[2] = pk2(o[8 * c + 4], o[8 * c + 5]); w[3] = pk2(o[8 * c + 6], o[8 * c + 7]); *(u32x4*)(dst + 8 * c) = w; }
}

typedef float f32x16 __attribute__((ext_vector_type(16)));
typedef short s16x4 __attribute__((ext_vector_type(4)));
#define LDSP __attribute__((address_space(3)))
constexpr int KSTR = 144;
constexpr int AL_KV = 17408;
constexpr int AL_BK = 2 * AL_KV  , AL_TB = AL_BK + 512  , AL_WSF = AL_TB + 512  , AL_MISC = AL_WSF + 2048  ,
              AL_IMP = 38912  , AL_SELM = AL_IMP + 65536  ,
              AL_TB4 = AL_SELM + 512  , AL_INVL = AL_TB4 + 2048  , AL_D_END = AL_INVL + 1024;
static_assert(AL_MISC + 64 <= AL_IMP && AL_D_END <= 131072, "attention LDS map");
__device__ __forceinline__ int crow(int r, int hi) { return (r & 3) + 8 * (r >> 2) + 4 * hi; }
__device__ __forceinline__ float ex2(float v) { return __builtin_amdgcn_exp2f(v); }
__device__ __forceinline__ s16x4 vtr(const LDSP unsigned char* p) { typedef short v4i16_t __attribute__((ext_vector_type(4))); return __builtin_bit_cast(s16x4, __builtin_amdgcn_ds_read_tr16_b64_v4i16((LDSP v4i16_t*)p)); }
__device__ __forceinline__ bf16x8 pack8(const f32x16& p, int b) {
    u32x4 w; w[0] = pg8::cvt_pk_bf16(p[b], p[b + 1]); w[1] = pg8::cvt_pk_bf16(p[b + 2], p[b + 3]); w[2] = pg8::cvt_pk_bf16(p[b + 4], p[b + 5]); w[3] = pg8::cvt_pk_bf16(p[b + 6], p[b + 7]);
    return __builtin_bit_cast(bf16x8, w);
}
__device__ __forceinline__ f32x16 splat16(float v) { return (f32x16){v, v, v, v, v, v, v, v, v, v, v, v, v, v, v, v}; }
template <int NK16>
__device__ __forceinline__ void qkt(f32x16& p0, f32x16& p1, const LDSP unsigned char* Kt, const bf16x8* qf, int dbase, int r32, int hi) {
    const LDSP unsigned char* kb = Kt + r32 * KSTR + hi * 16 + dbase * 32;
#pragma unroll
    for (int d0 = 0; d0 < NK16; ++d0) {
        const bf16x8 a0 = *(const LDSP bf16x8*)(kb + d0 * 32), a1 = *(const LDSP bf16x8*)(kb + 32 * KSTR + d0 * 32);
        p0 = __builtin_amdgcn_mfma_f32_32x32x16_bf16(a0, qf[d0], p0, 0, 0, 0);
        p1 = __builtin_amdgcn_mfma_f32_32x32x16_bf16(a1, qf[d0], p1, 0, 0, 0);
    }
}
__device__ __forceinline__ void pv(f32x16* o, const LDSP unsigned char* Vt, int vb, const f32x16& p0, const f32x16& p1) {
    bf16x8 pa[4]; pa[0] = pack8(p0, 0); pa[1] = pack8(p0, 8); pa[2] = pack8(p1, 0); pa[3] = pack8(p1, 8);
#pragma unroll
    for (int d0 = 0; d0 < 2; ++d0)
#pragma unroll
        for (int ks = 0; ks < 4; ++ks) {
            const s16x4 lo = vtr(Vt + vb + d0 * 4096 + ks * 1024), hh = vtr(Vt + vb + d0 * 4096 + ks * 1024 + 512);
            const bf16x8 vf = (bf16x8){lo[0], lo[1], lo[2], lo[3], hh[0], hh[1], hh[2], hh[3]};
            o[d0] = __builtin_amdgcn_mfma_f32_32x32x16_bf16(pa[ks], vf, o[d0], 0, 0, 0);
        }
}
__device__ __forceinline__ float exp_sum(f32x16& p0, f32x16& p1) {
    float s0 = 0.f, s1 = 0.f;
#pragma unroll
    for (int r = 0; r < 16; ++r) { p0[r] = ex2(p0[r]); p1[r] = ex2(p1[r]); s0 += p0[r]; s1 += p1[r]; }
    return s0 + s1;
}
__device__ __forceinline__ void scale_rows(f32x16* o, float f, LDSP float* wsf, int r32, int hi) {
    __builtin_amdgcn_wave_barrier();
    if (hi == 0) wsf[r32] = f;
    __builtin_amdgcn_s_waitcnt(0xc07f);
    __builtin_amdgcn_wave_barrier();
#pragma unroll
    for (int g = 0; g < 4; ++g) { const f32x4 a = *(const LDSP f32x4*)(wsf + 8 * g + 4 * hi);
#pragma unroll
        for (int i = 0; i < 4; ++i) { o[0][4 * g + i] *= a[i]; o[1][4 * g + i] *= a[i]; } }
    __builtin_amdgcn_wave_barrier();
}
__device__ __forceinline__ void store_o(const f32x16* o, LDSP bf16_t* stg, bf16_t* dst, int lane, int r32, int hi) {
    __builtin_amdgcn_wave_barrier();
#pragma unroll
    for (int r = 0; r < 16; ++r) { const int orow = crow(r, hi); stg[orow * 64 + r32] = f2bf(o[0][r]); stg[orow * 64 + 32 + r32] = f2bf(o[1][r]); }
    __builtin_amdgcn_s_waitcnt(0xc07f);
    __builtin_amdgcn_wave_barrier();
#pragma unroll
    for (int i = 0; i < 4; ++i) { const int row = i * 8 + (lane >> 3), ch = lane & 7; const u32x4 v = *(const LDSP u32x4*)(stg + row * 64 + ch * 8); *(u32x4*)(dst + (size_t)row * DM + ch * 8) = v; }
    __builtin_amdgcn_s_waitcnt(0xc07f);
    __builtin_amdgcn_wave_barrier();
}
template <int NG>
__device__ __forceinline__ void load_q(bf16x8* qf, const bf16_t* qrow  , const float* g, float sc, bool norm, int hi) {
    float v[4][8];
#pragma unroll
    for (int d0 = 0; d0 < 4; ++d0) load8(qrow + 16 * d0 + 8 * hi, v[d0]);
    float r0 = 1.f, r1 = 1.f;
    if (norm) {
        float s0 = 0.f, s1 = 0.f;
#pragma unroll
        for (int j = 0; j < 8; ++j) { s0 += v[0][j] * v[0][j] + v[1][j] * v[1][j]; s1 += v[2][j] * v[2][j] + v[3][j] * v[3][j]; }
        s0 += __shfl_xor(s0, 32); s1 += __shfl_xor(s1, 32);
        if (NG == 64) { r0 = rsqrtf((s0 + s1) * (1.f / 64.f) + EPS); r1 = r0; } else { r0 = rsqrtf(s0 * (1.f / 32.f) + EPS); r1 = rsqrtf(s1 * (1.f / 32.f) + EPS); }
    }
#pragma unroll
    for (int d0 = 0; d0 < 4; ++d0) {
        const float rr = (d0 < 2 ? r0 : r1) * sc; float w[8];
#pragma unroll
        for (int j = 0; j < 8; ++j) { const int d = 16 * d0 + 8 * hi + j; w[j] = v[d0][j] * rr * (norm ? g[d % NG] : 1.f); }
        u32x4 u; u[0] = pg8::cvt_pk_bf16(w[0], w[1]); u[1] = pg8::cvt_pk_bf16(w[2], w[3]); u[2] = pg8::cvt_pk_bf16(w[4], w[5]); u[3] = pg8::cvt_pk_bf16(w[6], w[7]);
        qf[d0] = __builtin_bit_cast(bf16x8, u);
    }
}
__device__ __forceinline__ void kv_load(u32x4& kr, u32x4& vr, const bf16_t* Kb, const bf16_t* Vb, int k0, int tid) {
    const size_t off = (size_t)(k0 + (tid >> 3)) * PINP + (tid & 7) * 8;
    kr = *(const u32x4*)(Kb + off); vr = *(const u32x4*)(Vb + off);
}
__device__ __forceinline__ void kv_load64(u32x4& kr, u32x4& vr, const bf16_t* Kb, const bf16_t* Vb, int n0, int tid) {
    const size_t off = (size_t)(n0 + (tid >> 3)) * 64 + (tid & 7) * 8;
    kr = *(const u32x4*)(Kb + off); vr = *(const u32x4*)(Vb + off);
}
__device__ __forceinline__ void kv_store(const u32x4& kr, const u32x4& vr, LDSP unsigned char* buf, int tid) {
    const int key = tid >> 3, ch = tid & 7;
    *(LDSP u32x4*)(buf + key * KSTR + ch * 16) = kr;
    *(LDSP u32x4*)(buf + 9216 + (ch >> 2) * 4096 + (key >> 4) * 1024 + ((key >> 3) & 1) * 512 + (key & 7) * 64 + (ch & 3) * 16) = vr;
}
template <int NG>
__device__ __forceinline__ void knorm_chunk(u32x4& kr, const float* gp  ) {
    float v[8];
    v[0] = bf2f(kr[0] & 0xffff); v[1] = bf2f(kr[0] >> 16); v[2] = bf2f(kr[1] & 0xffff); v[3] = bf2f(kr[1] >> 16);
    v[4] = bf2f(kr[2] & 0xffff); v[5] = bf2f(kr[2] >> 16); v[6] = bf2f(kr[3] & 0xffff); v[7] = bf2f(kr[3] >> 16);
    float ss = 0.f;
#pragma unroll
    for (int j = 0; j < 8; ++j) ss += v[j] * v[j];
    ss += __shfl_xor(ss, 1); ss += __shfl_xor(ss, 2); if (NG == 64) ss += __shfl_xor(ss, 4);
    const float r = rsqrtf(ss * (1.f / NG) + EPS);
    const f32x4 ga = *(const f32x4*)gp, gb = *(const f32x4*)(gp + 4);
    kr[0] = pg8::cvt_pk_bf16(v[0] * r * ga[0], v[1] * r * ga[1]); kr[1] = pg8::cvt_pk_bf16(v[2] * r * ga[2], v[3] * r * ga[3]);
    kr[2] = pg8::cvt_pk_bf16(v[4] * r * gb[0], v[5] * r * gb[1]); kr[3] = pg8::cvt_pk_bf16(v[6] * r * gb[2], v[7] * r * gb[3]);
}
__device__ __forceinline__ void bias_near(f32x16& p0, f32x16& p1, const LDSP float* tbl, int tk0  , int wnd, bool rowok, int hi) {
#pragma unroll
    for (int g = 0; g < 4; ++g) {
#pragma unroll
        for (int i = 0; i < 4; ++i) { const int r = 4 * g + i; const int d0_ = tk0 - crow(r, hi), d1_ = d0_ - 32;
            const float b0 = tbl[min(max(d0_, 0), 127)], b1 = tbl[min(max(d1_, 0), 127)];
            p0[r] = (d0_ < 0 || d0_ >= wnd || !rowok) ? -INFINITY : p0[r] + b0; p1[r] = (d1_ < 0 || d1_ >= wnd || !rowok) ? -INFINITY : p1[r] + b1; }
        asm volatile("" ::: "memory");
    }
}
#define KVBUF(L, i) ((L) + ((i) & 1) * AL_KV)

__device__ void fa_fox_unit(const Params& p, int l, int b, int h, int qb, LDSP unsigned char* L, unsigned* qctr, unsigned& pend) {
    const int tid = TID(), lane = tid & 63, wid = __builtin_amdgcn_readfirstlane(tid >> 6), r32 = lane & 31, hi = lane >> 5;
    const bf16_t* proj = (const bf16_t*)(p.ws + WS_PROJ); bf16_t* mix = (bf16_t*)p.out;
    const size_t rb = (size_t)b * SEQ; const int q0 = qb * 256, qw = q0 + 32 * wid, t = qw + r32;
    const bf16_t* Kb = proj + rb * PINP + CB_K + 64 * h; const bf16_t* Vb = proj + rb * PINP + CB_V + 64 * h;
    const float* cm = (const float*)(p.ws + WS_CUM) + (b * 4 + h) * SEQ;
    LDSP float* wsf = (LDSP float*)(L + AL_WSF) + wid * 64; LDSP float* bk = (LDSP float*)(L + AL_BK);
    const int vb = 9216 + ((lane >> 4) & 1) * 32 + (lane & 3) * 8 + (4 * hi + ((lane & 15) >> 2)) * 64;
    bf16x8 qf[4]; load_q<64>(qf, proj + (rb + t) * PINP + CB_Q + 64 * h, p.fox_qn + l * 64, 0.125f * LOG2E, true, hi);
    const float rowc = cm[t] * LOG2E - ((const float*)(p.ws + WS_BND))[l * 32 + 4];
    f32x16 o[2]; o[0] = (f32x16){}; o[1] = (f32x16){};
    float l_run = 0.f;
    const int NT = 4 * qb + 4, jd = 4 * qb + (wid >> 1);
    u32x4 krA, vrA, krB, vrB; float crA = 0.f, crB = 0.f;
    int js;
    {   const bool live = (lane < NT) ? ((cm[q0] - cm[64 * lane + 63]) * LOG2E >= -160.f) : false;
        const unsigned long long bm = __ballot(live);
        js = __builtin_amdgcn_readfirstlane((int)__builtin_ctzll(bm | (1ull << (NT - 1)))); if (js > NT - 2) js = NT - 2; js &= ~1; }
    __syncthreads();
    kv_load(krA, vrA, Kb, Vb, 64 * js, tid); if (tid < 64) crA = cm[64 * js + tid];
    kv_store(krA, vrA, KVBUF(L, js), tid); if (tid < 64) bk[(js & 1) * 64 + tid] = -crA * LOG2E;
    kv_load(krB, vrB, Kb, Vb, 64 * (js + 1), tid); if (tid < 64) crB = cm[64 * (js + 1) + tid];
    if (js + 2 < NT) { kv_load(krA, vrA, Kb, Vb, 64 * (js + 2), tid); if (tid < 64) crA = cm[64 * (js + 2) + tid]; }
#define FOX_STEP(J, KR, VR, CR) do { const int j = (J); \
        __syncthreads(); \
        if (j + 1 < NT) { kv_store(KR, VR, KVBUF(L, j + 1), tid); if (tid < 64) bk[((j + 1) & 1) * 64 + tid] = -CR * LOG2E; } \
        if (j + 3 < NT) { kv_load(KR, VR, Kb, Vb, 64 * (j + 3), tid); if (tid < 64) CR = cm[64 * (j + 3) + tid]; } \
        if (j <= jd) { \
            const LDSP unsigned char* buf = KVBUF(L, j); const LDSP float* bkj = bk + (j & 1) * 64; \
            f32x16 p0, p1; \
            _Pragma("unroll") for (int g = 0; g < 4; ++g) { const f32x4 b0 = *(const LDSP f32x4*)(bkj + 8 * g + 4 * hi), b1 = *(const LDSP f32x4*)(bkj + 32 + 8 * g + 4 * hi); \
                _Pragma("unroll") for (int i = 0; i < 4; ++i) { p0[4 * g + i] = b0[i] + rowc; p1[4 * g + i] = b1[i] + rowc; } } \
            qkt<4>(p0, p1, buf, qf, 0, r32, hi); \
            if (j == jd) { const int k0 = 64 * j; \
                _Pragma("unroll") for (int r = 0; r < 16; ++r) { const int kk = k0 + crow(r, hi); if (kk > t) p0[r] = -INFINITY; if (kk + 32 > t) p1[r] = -INFINITY; } } \
            l_run += exp_sum(p0, p1); \
            pv(o, buf, vb, p0, p1); \
        } } while (0)
    for (int jj = js; jj < NT; jj += 2) { FOX_STEP(jj, krB, vrB, crB); FOX_STEP(jj + 1, krA, vrA, crA); }
#undef FOX_STEP
    if (tid == 0) pend = atomicAdd(qctr, 1u);
    l_run += __shfl_xor(l_run, 32);
    scale_rows(o, 1.f / l_run, wsf, r32, hi);
    store_o(o, (LDSP bf16_t*)(L + AL_IMP + wid * 8192), mix + (rb + qw) * DM + 256 + 64 * h, lane, r32, hi);
}

__device__ void fa_diff_unit(const Params& p, int l, int b, int h, int qb, LDSP unsigned char* L, unsigned* qctr, unsigned& pend) {
    const int tid = TID(), lane = tid & 63, wid = __builtin_amdgcn_readfirstlane(tid >> 6), r32 = lane & 31, hi = lane >> 5;
    const bf16_t* proj = (const bf16_t*)(p.ws + WS_PROJ); bf16_t* mix = (bf16_t*)p.out;
    const size_t rb = (size_t)b * SEQ; const int q0 = qb * 256, qw = q0 + 32 * wid, t = qw + r32;
    const bf16_t* Kb = proj + rb * PINP + CA_K + 64 * h; const bf16_t* Vb = proj + rb * PINP + CA_V + 64 * h;
    LDSP float* wsf = (LDSP float*)(L + AL_WSF) + wid * 64; LDSP float* tbl = (LDSP float*)(L + AL_TB);
    const int vb = 9216 + ((lane >> 4) & 1) * 32 + (lane & 3) * 8 + (4 * hi + ((lane & 15) >> 2)) * 64;
    const float lam = ((const float*)(p.ws + WS_LAM))[l]; const float lam_init = 0.8f - 0.6f * __expf(-0.3f * (float)l);
    const float nbound = -((const float*)(p.ws + WS_BND))[l * 32 + h];
    __syncthreads();
    if (tid < 128) tbl[tid] = ((const float*)(p.ws + WS_TB))[h * 128 + tid] * LOG2E;
    bf16x8 qf[4]; load_q<32>(qf, proj + (rb + t) * PINP + CA_Q + 64 * h, p.diff_qn + l * 32, 0.17677669529663687f * LOG2E, true, hi);
    f32x16 o1[2], o2[2]; o1[0] = (f32x16){}; o1[1] = (f32x16){}; o2[0] = (f32x16){}; o2[1] = (f32x16){};
    float l1 = 0.f, l2 = 0.f;
    const int NT = 4 * qb + 4, jd = 4 * qb + (wid >> 1);
    u32x4 kr, vr; const float* gk = p.diff_kn + l * 32 + (tid & 3) * 8;
    kv_load(kr, vr, Kb, Vb, 0, tid);
    kv_store(kr, vr, KVBUF(L, 0), tid);
    kv_load(kr, vr, Kb, Vb, 64, tid);
    for (int j = 0; j < NT; ++j) {
        __syncthreads();
        if (j + 1 < NT) { kv_store(kr, vr, KVBUF(L, j + 1), tid); }
        if (j + 2 < NT) kv_load(kr, vr, Kb, Vb, 64 * (j + 2), tid);
        if (j <= jd) {
            const LDSP unsigned char* buf = KVBUF(L, j);
            const int k0 = 64 * j; const bool nearb = (qw - (k0 + 63)) < 113; const float cfar = tbl[127] + nbound;
#pragma unroll
            for (int mp = 0; mp < 2; ++mp) {
                f32x16 p0 = splat16(nearb ? nbound : cfar), p1 = p0;
                qkt<2>(p0, p1, buf, qf + 2 * mp, 2 * mp, r32, hi);
                if (nearb) bias_near(p0, p1, tbl, t - k0, 1 << 30, true, hi);
                if (mp == 0) { l1 += exp_sum(p0, p1); pv(o1, buf, vb, p0, p1); }
                else { l2 += exp_sum(p0, p1); pv(o2, buf, vb, p0, p1); }
            }
        }
    }
    if (tid == 0) pend = atomicAdd(qctr, 1u);
    l1 += __shfl_xor(l1, 32); l2 += __shfl_xor(l2, 32);
    scale_rows(o1, 1.f / l1, wsf, r32, hi); scale_rows(o2, lam / l2, wsf, r32, hi);
    o1[0] -= o2[0]; o1[1] -= o2[1];
    const float g0 = p.diff_sub[l * 64 + r32] * (1.f - lam_init), g1 = p.diff_sub[l * 64 + 32 + r32] * (1.f - lam_init);
#pragma unroll
    for (int r = 0; r < 16; ++r) {
        float ss = o1[0][r] * o1[0][r] + o1[1][r] * o1[1][r];
        ss += __shfl_xor(ss, 1); ss += __shfl_xor(ss, 2); ss += __shfl_xor(ss, 4); ss += __shfl_xor(ss, 8); ss += __shfl_xor(ss, 16);
        const float rs = rsqrtf(ss * (1.f / 64.f) + EPS); o1[0][r] *= rs * g0; o1[1][r] *= rs * g1;
    }
    store_o(o1, (LDSP bf16_t*)(L + AL_IMP + wid * 8192), mix + (rb + qw) * DM + 0 + 64 * h, lane, r32, hi);
}

template <bool DIAG>
__device__ __forceinline__ void stick_sub(f32x16& y, float& carry, int kbase  , int t, int hi) {
    float lk[16];
#pragma unroll
    for (int r = 0; r < 16; ++r) {
        const float v = y[r]; const float e = ex2(-fabsf(v)); const float lb = fminf(v, 0.f) - __builtin_amdgcn_logf(1.f + e);
        if (DIAG) { const bool valid = (kbase + crow(r, hi) < t); lk[r] = valid ? (lb - v) : 0.f; y[r] = valid ? lb : -INFINITY; }
        else { lk[r] = lb - v; y[r] = lb; }
    }
    float T[4], Go[4];
#pragma unroll
    for (int g = 0; g < 4; ++g) { const float Gs = (lk[4 * g] + lk[4 * g + 1]) + (lk[4 * g + 2] + lk[4 * g + 3]); Go[g] = __shfl_xor(Gs, 32); T[g] = Gs + Go[g]; }
    float sx = 0.f;
#pragma unroll
    for (int g = 3; g >= 0; --g) {
        float tail = carry + sx + (hi == 0 ? Go[g] : 0.f);
#pragma unroll
        for (int i = 3; i >= 0; --i) { y[4 * g + i] = ex2(y[4 * g + i] + tail); tail += lk[4 * g + i]; }
        sx += T[g];
    }
    carry += sx;
}
__device__ void fa_stick_unit(const Params& p, int l, int b, int h, int qb, LDSP unsigned char* L, unsigned* qctr, unsigned& pend) {
    const int tid = TID(), lane = tid & 63, wid = __builtin_amdgcn_readfirstlane(tid >> 6), r32 = lane & 31, hi = lane >> 5;
    const bf16_t* proj = (const bf16_t*)(p.ws + WS_PROJ); bf16_t* mix = (bf16_t*)p.out;
    const size_t rb = (size_t)b * SEQ; const int q0 = qb * 256, qw = q0 + 32 * wid, t = qw + r32;
    const bf16_t* Kb = proj + rb * PINP + CC_K + 64 * h; const bf16_t* Vb = proj + rb * PINP + CC_V + 64 * h;
    const int vb = 9216 + ((lane >> 4) & 1) * 32 + (lane & 3) * 8 + (4 * hi + ((lane & 15) >> 2)) * 64;
    bf16x8 qf[4]; load_q<64>(qf, proj + (rb + t) * PINP + CC_Q + 64 * h, nullptr, 0.125f * LOG2E, false, hi);
    f32x16 o[2]; o[0] = (f32x16){}; o[1] = (f32x16){};
    float carry = 0.f;
    const int NT = 4 * qb + 4, jd = 4 * qb + (wid >> 1);
    u32x4 kr, vr;
#define SBUF(i) (((i) & 1) ? (L + 108544) : L)
    LDSP unsigned* dn = (LDSP unsigned*)(L + AL_MISC) + 8;
    bool wdone = false;
    __syncthreads();
    if (lane == 0) dn[wid] = 0u;
    kv_load(kr, vr, Kb, Vb, 64 * (NT - 1), tid);
    kv_store(kr, vr, SBUF(NT - 1), tid);
    kv_load(kr, vr, Kb, Vb, 64 * (NT - 2), tid);
    for (int j = NT - 1; j >= 0; --j) {
        __syncthreads();
        if (__all(dn[lane & 7] != 0u)) break;
        if (j >= 1) kv_store(kr, vr, SBUF(j - 1), tid);
        if (j >= 2) kv_load(kr, vr, Kb, Vb, 64 * (j - 2), tid);
        if (j <= jd && !wdone) {
            const LDSP unsigned char* buf = SBUF(j);
            f32x16 p0 = (f32x16){}, p1 = (f32x16){};
            qkt<4>(p0, p1, buf, qf, 0, r32, hi);
            const int k0 = 64 * j; const bool diag = (j == jd);
            if (diag) { stick_sub<true>(p1, carry, k0 + 32, t, hi); stick_sub<true>(p0, carry, k0, t, hi); }
            else { stick_sub<false>(p1, carry, k0 + 32, t, hi); stick_sub<false>(p0, carry, k0, t, hi); }
            pv(o, buf, vb, p0, p1);
            if (__all(carry < -160.f)) { wdone = true; if (lane == 0) dn[wid] = 1u; }
        }
    }
    if (tid == 0) pend = atomicAdd(qctr, 1u);
    store_o(o, (LDSP bf16_t*)(L + AL_IMP + wid * 8192), mix + (rb + qw) * DM + 512 + 64 * h, lane, r32, hi);
}

__device__ void fa_nsa_unit(const Params& p, int l, int b, int u, LDSP unsigned char* L, unsigned* qctr, unsigned& pend) {
    const int tid = TID(), lane = tid & 63, wid = __builtin_amdgcn_readfirstlane(tid >> 6), r32 = lane & 31, hi = lane >> 5;
    const int hh = wid >> 1, sub = wid & 1;
    const bf16_t* proj = (const bf16_t*)(p.ws + WS_PROJ); bf16_t* mix = (bf16_t*)p.out;
    const size_t rb = (size_t)b * SEQ; const int q0 = 64 * u, qw = q0 + 32 * sub, t = qw + r32; const int ql = 32 * sub + r32;
    LDSP float* wsf = (LDSP float*)(L + AL_WSF) + wid * 64; LDSP float* tbl = (LDSP float*)(L + AL_TB4) + hh * 128;
    LDSP float* imp = (LDSP float*)(L + AL_IMP); LDSP unsigned* selm = (LDSP unsigned*)(L + AL_SELM); LDSP float* invl = (LDSP float*)(L + AL_INVL);
    LDSP float* ofl = (LDSP float*)(L + AL_IMP) + wid * 2048 + lane;
    const int vb = 9216 + ((lane >> 4) & 1) * 32 + (lane & 3) * 8 + (4 * hi + ((lane & 15) >> 2)) * 64;
    const float* bnd = (const float*)(p.ws + WS_BND) + l * 32;
    __syncthreads();
    ((LDSP float*)(L + AL_TB4))[tid] = ((const float*)(p.ws + WS_TB))[512 + tid] * LOG2E;
    bf16x8 qf[4]; load_q<64>(qf, proj + (rb + t) * PINP + CD_Q + 64 * hh, p.nsa_qn + l * 64, 0.125f * LOG2E, true, hi);
    const float* sd = (const float*)(p.ws + WS_SIDE) + (rb + t) * 16 + 4 + hh;
    const float gc = 1.f / (1.f + __expf(-sd[0])), gs = 1.f / (1.f + __expf(-sd[4])), gwn = 1.f / (1.f + __expf(-sd[8]));
    f32x16 o[2]; o[0] = (f32x16){}; o[1] = (f32x16){};
    u32x4 kr, vr;
    {
        const bf16_t* Kc = (const bf16_t*)(p.ws + WS_KC) + (size_t)b * 256 * 64; const bf16_t* Vc = (const bf16_t*)(p.ws + WS_VC) + (size_t)b * 256 * 64;
        const int ntc = (4 * u + 2) / 64 + 1; const float nbound = -bnd[5 + hh];
        float l_run = 0.f, prevE3 = 0.f;
        kv_load64(kr, vr, Kc, Vc, 0, tid);
        kv_store(kr, vr, KVBUF(L, 0), tid);
        if (ntc > 1) kv_load64(kr, vr, Kc, Vc, 64, tid);
        for (int T = 0; T < ntc; ++T) {
            __syncthreads();
            if (T + 1 < ntc) kv_store(kr, vr, KVBUF(L, T + 1), tid);
            if (T + 2 < ntc) kv_load64(kr, vr, Kc, Vc, 64 * (T + 2), tid);
            const LDSP unsigned char* buf = KVBUF(L, T);
            f32x16 p0 = splat16(nbound), p1 = p0;
            qkt<4>(p0, p1, buf, qf, 0, r32, hi);
#pragma unroll
            for (int g = 0; g < 4; ++g) {
#pragma unroll
                for (int i = 0; i < 4; ++i) { const int r = 4 * g + i; const int d0_ = t - 16 * (64 * T + crow(r, hi)) - 31, d1_ = d0_ - 512;
                    const float b0 = tbl[min(max(d0_, 0), 127)], b1 = tbl[min(max(d1_, 0), 127)];
                    p0[r] = (d0_ < 0) ? -INFINITY : p0[r] + b0; p1[r] = (d1_ < 0) ? -INFINITY : p1[r] + b1; }
                asm volatile("" ::: "memory");
            }
            l_run += exp_sum(p0, p1);
#pragma unroll
            for (int s2 = 0; s2 < 2; ++s2) {
                float G[4], Eo[4];
#pragma unroll
                for (int g = 0; g < 4; ++g) { const float a0 = s2 ? p1[4 * g] : p0[4 * g], a1 = s2 ? p1[4 * g + 1] : p0[4 * g + 1], a2 = s2 ? p1[4 * g + 2] : p0[4 * g + 2], a3 = s2 ? p1[4 * g + 3] : p0[4 * g + 3];
                    G[g] = (a0 + a1) + (a2 + a3); Eo[g] = __shfl_xor(a3, 32); }
#pragma unroll
                for (int g = 0; g < 4; ++g) { const float eprev = hi ? Eo[g] : (g > 0 ? Eo[g - 1] : prevE3);
                    imp[(hh * 64 + 16 * T + 8 * s2 + 2 * g + hi) * 64 + ql] = G[g] + eprev; }
                prevE3 = Eo[3];
            }
            pv(o, buf, vb, p0, p1);
        }
        l_run += __shfl_xor(l_run, 32);
        const float inv = (l_run > 0.f) ? 1.f / l_run : 0.f;
        if (hi == 0) invl[hh * 64 + ql] = inv;
        scale_rows(o, gc * inv, wsf, r32, hi);
    }
    __syncthreads();
    {
        const int q = lane, part = wid;
        const float i0 = invl[q], i1 = invl[64 + q], i2 = invl[128 + q], i3 = invl[192 + q];
        float vj[8];
#pragma unroll
        for (int jj = 0; jj < 8; ++jj) { const int j = part * 8 + jj;
            const float sum = ((imp[(0 * 64 + j) * 64 + q] * i0 + imp[(1 * 64 + j) * 64 + q] * i1) + imp[(2 * 64 + j) * 64 + q] * i2) + imp[(3 * 64 + j) * 64 + q] * i3;
            vj[jj] = (j > u) ? -1.0f : ((j == u || j == 0) ? 1.0e4f : sum); }
        __syncthreads();
#pragma unroll
        for (int jj = 0; jj < 8; ++jj) imp[(part * 8 + jj) * 64 + q] = vj[jj];
        __syncthreads();
        unsigned bits = 0;
        if (part * 8 <= u) {
            int rank[8];
#pragma unroll
            for (int jj = 0; jj < 8; ++jj) rank[jj] = 0;
            for (int i = 0; i < part * 8; ++i) { const float vi = imp[i * 64 + q];
#pragma unroll
                for (int jj = 0; jj < 8; ++jj) rank[jj] += (vi >= vj[jj]) ? 1 : 0; }
#pragma unroll
            for (int ii = 0; ii < 8; ++ii) { const float vi = imp[(part * 8 + ii) * 64 + q];
#pragma unroll
                for (int jj = 0; jj < 8; ++jj) rank[jj] += (vi > vj[jj] || (vi == vj[jj] && ii < jj)) ? 1 : 0; }
            for (int i = part * 8 + 8; i <= u; ++i) { const float vi = imp[i * 64 + q];
#pragma unroll
                for (int jj = 0; jj < 8; ++jj) rank[jj] += (vi > vj[jj]) ? 1 : 0; }
#pragma unroll
            for (int jj = 0; jj < 8; ++jj) if (rank[jj] < 16 && (part * 8 + jj) <= u) bits |= 1u << jj;
        }
        ((LDSP unsigned char*)selm)[q * 8 + part] = (unsigned char)bits;
    }
    __syncthreads();
#pragma unroll
    for (int r = 0; r < 16; ++r) { ofl[(2 * r) * 64] = o[0][r]; ofl[(2 * r + 1) * 64] = o[1][r]; }
    o[0] = (f32x16){}; o[1] = (f32x16){};
    {
        const unsigned long long mymask = (unsigned long long)selm[2 * ql] | ((unsigned long long)selm[2 * ql + 1] << 32);
        unsigned ulo = selm[2 * lane], uhi = selm[2 * lane + 1];
#pragma unroll
        for (int s2 = 1; s2 < 64; s2 <<= 1) { ulo |= __shfl_xor(ulo, s2); uhi |= __shfl_xor(uhi, s2); }
        unsigned long long um = (unsigned long long)(unsigned)__builtin_amdgcn_readfirstlane((int)ulo) | ((unsigned long long)(unsigned)__builtin_amdgcn_readfirstlane((int)uhi) << 32);
        const bf16_t* Kb = proj + rb * PINP + CD_KS; const bf16_t* Vb = proj + rb * PINP + CD_VS;
        float l_run = 0.f; const float nbound = -bnd[9 + hh]; const float cfar = tbl[127] + nbound; const float* gk = p.nsa_kn + (l * 3 + 1) * 64 + (tid & 7) * 8;
        u32x4 krB, vrB;
        int j = __builtin_ctzll(um); um &= um - 1;
        int j1 = um ? __builtin_ctzll(um) : -1; um &= um - 1;
        int j2 = um ? __builtin_ctzll(um) : -1; um &= um - 1;
        kv_load(kr, vr, Kb, Vb, 64 * j, tid);
        kv_store(kr, vr, KVBUF(L, 0), tid);
        if (j1 >= 0) kv_load(krB, vrB, Kb, Vb, 64 * j1, tid);
        if (j2 >= 0) kv_load(kr, vr, Kb, Vb, 64 * j2, tid);
#define SEL_STEP(IT, KR, VR) { \
            __syncthreads(); \
            const int j3 = um ? __builtin_ctzll(um) : -1; um &= um - 1; \
            if (j1 >= 0) { kv_store(KR, VR, KVBUF(L, (IT) + 1), tid); } \
            if (j3 >= 0) kv_load(KR, VR, Kb, Vb, 64 * j3, tid); \
            const bool mine = (mymask >> j) & 1ull; \
            if (__any(mine)) { \
                const LDSP unsigned char* buf = KVBUF(L, (IT)); \
                const int k0 = 64 * j; const bool nearb = (qw - (k0 + 63)) < 113; \
                f32x16 p0 = splat16(nearb ? nbound : (mine ? cfar : -INFINITY)), p1 = p0; \
                qkt<4>(p0, p1, buf, qf, 0, r32, hi); \
                if (nearb) bias_near(p0, p1, tbl, t - k0, 1 << 30, mine, hi); \
                l_run += exp_sum(p0, p1); \
                pv(o, buf, vb, p0, p1); \
            } \
            if (j1 < 0) break; \
            j = j1; j1 = j2; j2 = j3; }
        for (int it = 0;; it += 2) { SEL_STEP(it, krB, vrB) SEL_STEP(it + 1, kr, vr) }
#undef SEL_STEP
        l_run += __shfl_xor(l_run, 32);
        scale_rows(o, gs / l_run, wsf, r32, hi);
#pragma unroll
        for (int r = 0; r < 16; ++r) { ofl[(2 * r) * 64] += o[0][r]; ofl[(2 * r + 1) * 64] += o[1][r]; }
        o[0] = (f32x16){}; o[1] = (f32x16){};
    }
    {
        const bf16_t* Kb = proj + rb * PINP + CD_KW; const bf16_t* Vb = proj + rb * PINP + CD_VW;
        float l_run = 0.f; const float nbound = -bnd[13 + hh]; const float cfar = tbl[127] + nbound; const float* gk = p.nsa_kn + (l * 3 + 2) * 64 + (tid & 7) * 8;
        const int jlo = max(0, u - 8);
        __syncthreads();
        kv_load(kr, vr, Kb, Vb, 64 * jlo, tid);
        kv_store(kr, vr, KVBUF(L, jlo), tid);
        if (jlo < u) kv_load(kr, vr, Kb, Vb, 64 * (jlo + 1), tid);
        for (int j = jlo; j <= u; ++j) {
            __syncthreads();
            if (j + 1 <= u) { kv_store(kr, vr, KVBUF(L, j + 1), tid); }
            if (j + 2 <= u) kv_load(kr, vr, Kb, Vb, 64 * (j + 2), tid);
            const LDSP unsigned char* buf = KVBUF(L, j);
            const int k0 = 64 * j; const bool nearb = (j == u || j == u - 8 || (qw - (k0 + 63)) < 113);
            f32x16 p0 = splat16(nearb ? nbound : cfar), p1 = p0;
            qkt<4>(p0, p1, buf, qf, 0, r32, hi);
            if (nearb) bias_near(p0, p1, tbl, t - k0, 512, true, hi);
            l_run += exp_sum(p0, p1);
            pv(o, buf, vb, p0, p1);
        }
        if (tid == 0) pend = atomicAdd(qctr, 1u);
        l_run += __shfl_xor(l_run, 32);
        scale_rows(o, gwn / l_run, wsf, r32, hi);
#pragma unroll
        for (int r = 0; r < 16; ++r) { o[0][r] += ofl[(2 * r) * 64]; o[1][r] += ofl[(2 * r + 1) * 64]; }
    }
    store_o(o, (LDSP bf16_t*)(L + AL_IMP + wid * 8192), mix + (rb + qw) * DM + 768 + 64 * hh, lane, r32, hi);
}

__device__ void ph_reset_queues(const Params& p) { unsigned* ctl = (unsigned*)(p.ws + WS_CTL); const int gt = GTID(); if (gt < 8) ctl[gt] = 0u; }
__device__ void prep_cmp_task(const Params& p, int l, int task, LDSP unsigned char* L) {
    const int tid = TID(), lane = tid & 63, wid = __builtin_amdgcn_readfirstlane(tid >> 6), r32 = lane & 31, hi = lane >> 5;
    const int b = task >> 4, which = (task >> 3) & 1, nt = task & 7;
    const bf16_t* proj = (const bf16_t*)(p.ws + WS_PROJ);
    const bf16_t* phiT = (const bf16_t*)(p.ws + WS_PHIT) + (size_t)(l * 2 + which) * 64 * 2048;
    const float* pe = p.nsa_pe + (size_t)(l * 2 + which) * 32 * 64;
    const int n = 32 * nt + r32, colbase = which ? CD_VC : CD_KC;
    f32x16 acc0 = (f32x16){}, acc1 = (f32x16){};
#pragma unroll
    for (int ii = 0; ii < 4; ++ii) {
        const int i = 4 * wid + ii; const int tok = min(16 * n + i, SEQ - 1);
        const bf16_t* xr = proj + (size_t)(b * SEQ + tok) * PINP + colbase;
#pragma unroll
        for (int d0 = 0; d0 < 4; ++d0) {
            float xv[8]; load8(xr + 16 * d0 + 8 * hi, xv);
            const f32x4 pe0 = *(const f32x4*)(pe + i * 64 + 16 * d0 + 8 * hi), pe1 = *(const f32x4*)(pe + i * 64 + 16 * d0 + 8 * hi + 4);
            u32x4 aw; aw[0] = pg8::cvt_pk_bf16(xv[0] + pe0[0], xv[1] + pe0[1]); aw[1] = pg8::cvt_pk_bf16(xv[2] + pe0[2], xv[3] + pe0[3]);
            aw[2] = pg8::cvt_pk_bf16(xv[4] + pe1[0], xv[5] + pe1[1]); aw[3] = pg8::cvt_pk_bf16(xv[6] + pe1[2], xv[7] + pe1[3]);
            const bf16x8 af = __builtin_bit_cast(bf16x8, aw);
            const bf16x8 b0 = *(const bf16x8*)(phiT + (size_t)r32 * 2048 + i * 64 + 16 * d0 + 8 * hi);
            const bf16x8 b1 = *(const bf16x8*)(phiT + (size_t)(32 + r32) * 2048 + i * 64 + 16 * d0 + 8 * hi);
            acc0 = __builtin_amdgcn_mfma_f32_32x32x16_bf16(af, b0, acc0, 0, 0, 0);
            acc1 = __builtin_amdgcn_mfma_f32_32x32x16_bf16(af, b1, acc1, 0, 0, 0);
        }
    }
    LDSP float* red = (LDSP float*)L;
    __syncthreads();
#pragma unroll
    for (int r = 0; r < 16; ++r) { red[(wid * 32 + crow(r, hi)) * 64 + r32] = acc0[r]; red[(wid * 32 + crow(r, hi)) * 64 + 32 + r32] = acc1[r]; }
    __syncthreads();
    {
        const int row = tid >> 4, e4 = (tid & 15) * 4; f32x4 v = (f32x4){0.f, 0.f, 0.f, 0.f};
#pragma unroll
        for (int w8 = 0; w8 < 8; ++w8) v += *(const LDSP f32x4*)(red + (w8 * 32 + row) * 64 + e4);
        const int nn = 32 * nt + row;
        if (which == 0) {
            float ss = (v[0] * v[0] + v[1] * v[1]) + (v[2] * v[2] + v[3] * v[3]);
            ss += __shfl_xor(ss, 1); ss += __shfl_xor(ss, 2); ss += __shfl_xor(ss, 4); ss += __shfl_xor(ss, 8);
            const float rs = rsqrtf(ss * (1.f / 64.f) + EPS); const f32x4 g = *(const f32x4*)(p.nsa_kn + (l * 3 + 0) * 64 + e4);
            v = v * rs * g;
        }
        uint2 o; o.x = pk2(v[0], v[1]); o.y = pk2(v[2], v[3]);
        if (nn >= 255) { o.x = 0u; o.y = 0u; }
        *(uint2*)((bf16_t*)(p.ws + (which ? WS_VC : WS_KC)) + (size_t)(b * 256 + nn) * 64 + e4) = o;
    }
}
__device__ void ph_prep(const Params& p, int l, LDSP unsigned char* L, unsigned char* lds) {
    for (int t = blockIdx.x; t < 80; t += gridDim.x) { if (t < 64) prep_cmp_task(p, l, t, L); }
    if (gridDim.x >= 80) { if (blockIdx.x >= 64 && blockIdx.x < 80) ph_prep_cum_bh(p, l, blockIdx.x - 64, lds); }
    else for (int bh = blockIdx.x; bh < 16; bh += gridDim.x) ph_prep_cum_bh(p, l, bh, lds);
}


__device__ void fa_phase_all(const Params& p, int l, LDSP unsigned char* L, unsigned char* lds, int qslot, int n_conv  ) {
    unsigned* ctl = (unsigned*)(p.ws + WS_CTL);
    LDSP unsigned* misc = (LDSP unsigned*)(L + AL_MISC);
    bool prep_ok = false;
    unsigned pend = 0xffffffffu;
    for (;;) {
        __syncthreads();
        if (threadIdx.x == 0) misc[0] = (pend != 0xffffffffu) ? pend : atomicAdd(&ctl[qslot], 1u);
        __syncthreads();
        const unsigned qi0 = misc[0]; pend = 0xffffffffu;
        if (qi0 >= 1104u + (unsigned)n_conv) break;
        if (qi0 >= 1104u) {
            const int it = ((int)qi0 - 1104) * 8 + (TID() >> 6);
            if (it < CV_ITEMS) convert_item(p, l + 1, it, (LDSF float*)lds + (TID() >> 6) * (64 * 65), TID() & 63);
            continue;
        }
        if (qi0 < 80u) {
            if (qi0 < 64u) prep_cmp_task(p, l, (int)qi0, L); else ph_prep_cum_bh(p, l, (int)qi0 - 64, lds);
            asm volatile("s_waitcnt vmcnt(0)" ::: "memory");
            __syncthreads();
            if (threadIdx.x == 0) { __builtin_amdgcn_fence(__ATOMIC_RELEASE, "agent"); asm volatile("s_waitcnt vmcnt(0)" ::: "memory"); atomicAdd(&ctl[4 + qslot], 1u); }
            continue;
        }
        const unsigned qi = qi0 - 80u;
        int r, typ, sub;
        if (qi < 256u) { r = 15 - (int)(qi >> 4); typ = 0; sub = (int)qi & 15; }
        else if (qi < 768u) { const int v = (int)qi - 256; r = 15 - (v >> 5); typ = (v & 16) ? 2 : 3; sub = v & 15; }
        else { const int v = (int)qi - 768; r = 15 - (v >> 4); typ = 1; sub = v & 15; }
        if ((typ == 2 || typ == 3) && !prep_ok) {
            if (threadIdx.x == 0) { while (__hip_atomic_load(&ctl[4 + qslot], __ATOMIC_RELAXED, __HIP_MEMORY_SCOPE_AGENT) < 80u) __builtin_amdgcn_s_sleep(8); __builtin_amdgcn_fence(__ATOMIC_ACQUIRE, "agent"); }
            asm volatile("s_waitcnt vmcnt(0)" ::: "memory");
            __syncthreads();
            prep_ok = true;
        }
        if (typ == 0) fa_diff_unit(p, l, sub >> 2, sub & 3, r, L, &ctl[qslot], pend);
        else if (typ == 1) fa_stick_unit(p, l, sub >> 2, sub & 3, r, L, &ctl[qslot], pend);
        else if (typ == 2) fa_fox_unit(p, l, sub >> 2, sub & 3, r, L, &ctl[qslot], pend);
        else fa_nsa_unit(p, l, sub >> 2, 4 * r + (sub & 3), L, &ctl[qslot], pend);
    }
}

#define XB_TMO      128
#define XB_XCNT(j)  (256  + 64 * (j))
#define XB_XSUB(j)  (1280 + 64 * (j))
#define XB_XGEN(j)  (2304 + 64 * (j))
#define XB_TOP      3328
#define XB_TOPGEN   3392
#define XCD_BAR_WORDS 3456
#define XB_SPIN_CAP (1u << 18)

__device__ __forceinline__ unsigned xb_ld(unsigned* p)              { return __hip_atomic_load(p, __ATOMIC_RELAXED, __HIP_MEMORY_SCOPE_AGENT); }
__device__ __forceinline__ unsigned xb_add(unsigned* p, unsigned v) { return __hip_atomic_fetch_add(p, v, __ATOMIC_RELAXED, __HIP_MEMORY_SCOPE_AGENT); }
__device__ __forceinline__ unsigned xb_xcc_id() { return (unsigned)__builtin_amdgcn_s_getreg((3 << 11) | 20) & 0xFu; }
#define XB_SPIN(cond, bar) do { unsigned _sp = 0; while (cond) { __builtin_amdgcn_s_sleep(1); \
    if ((++_sp & 255u) == 0u) { if (xb_ld(&(bar)[XB_TMO])) break; if (_sp > XB_SPIN_CAP) { atomicAdd(&(bar)[XB_TMO], 1u); break; } } } } while (0)

struct XcdBarrier {
    unsigned* bar; unsigned x;
    volatile LDSF unsigned* st;
};

__device__ __forceinline__ XcdBarrier xcd_barrier_post(unsigned* bar, volatile LDSF unsigned* st) {
    XcdBarrier b; b.bar = bar; b.x = xb_xcc_id(); b.st = st;
    if (threadIdx.x == 0) (void)xb_add(&bar[XB_XCNT(b.x)], 1u);
    return b;
}
__device__ __forceinline__ void xcd_barrier_complete(unsigned* bar, unsigned x, unsigned& nloc, unsigned& nx) {
    const unsigned G = gridDim.x * gridDim.y * gridDim.z;
    unsigned sum, cnt, mine, sp = 0u;
    for (;;) {
        sum = 0u; cnt = 0u; mine = 0u;
#pragma unroll
        for (unsigned j = 0; j < 16; ++j) { const unsigned c = xb_ld(&bar[XB_XCNT(j)]); sum += c; cnt += (c > 0u) ? 1u : 0u; mine = (j == x) ? c : mine; }
        if (sum == G) break;
        __builtin_amdgcn_s_sleep(1);
        if ((++sp & 255u) == 0u) { if (xb_ld(&bar[XB_TMO])) break; if (sp > XB_SPIN_CAP) { atomicAdd(&bar[XB_TMO], 1u); break; } }
    }
    nloc = mine > 0u ? mine : 1u; nx = cnt > 0u ? cnt : 1u;
}

__device__ __forceinline__ void xcd_barrier(const XcdBarrier& b) {
    asm volatile("s_waitcnt vmcnt(0)" ::: "memory");
    __syncthreads();
    if (threadIdx.x == 0) {
        unsigned* bar = b.bar; asm volatile("" : "+s"(bar));
        __builtin_amdgcn_s_waitcnt(0);
        unsigned nloc = b.st[0], nx = b.st[1];
        if (nloc == 0u) { xcd_barrier_complete(bar, b.x, nloc, nx); b.st[0] = nloc; b.st[1] = nx; }
        const unsigned old = xb_add(&bar[XB_XSUB(b.x)], 1u);
        const unsigned gen = old / nloc;
        if (old + 1u == (gen + 1u) * nloc) {
            __builtin_amdgcn_fence(__ATOMIC_RELEASE, "agent");
            asm volatile("s_waitcnt vmcnt(0)" ::: "memory");
            const unsigned og = xb_add(&bar[XB_TOP], 1u);
            const unsigned tg = og / nx;
            if (og + 1u == (tg + 1u) * nx) xb_add(&bar[XB_TOPGEN], 1u);
            else XB_SPIN(xb_ld(&bar[XB_TOPGEN]) == tg, bar);
            __builtin_amdgcn_fence(__ATOMIC_ACQUIRE, "agent");
            xb_add(&bar[XB_XGEN(b.x)], 1u);
            asm volatile("s_waitcnt vmcnt(0)" ::: "memory");
        } else {
            XB_SPIN(xb_ld(&bar[XB_XGEN(b.x)]) == gen, bar);
            __builtin_amdgcn_fence(__ATOMIC_ACQUIRE, "agent");
            asm volatile("s_waitcnt vmcnt(0)" ::: "memory");
        }
    }
    __syncthreads();
}

namespace cg = cooperative_groups;
constexpr int LDS_BYTES = 131072 + 8192 + 4096 + 1024;
#define LAS3 __attribute__((address_space(3)))
#ifndef PROBE
#define PROBE 0
#endif
__global__ void __launch_bounds__(NTHR, 2) mega(Params p) {
    extern __shared__ __attribute__((aligned(16))) unsigned char lds[];
    cg::grid_group grid = cg::this_grid();
#if PROBE
    unsigned long long tacc = 0, tph = 0, t0_;
#define GSYNC() do { t0_ = __builtin_amdgcn_s_memrealtime(); xcd_barrier(xbar); tacc += __builtin_amdgcn_s_memrealtime() - t0_; } while (0)
#define TPK(k, ...) do { if (PROBE == (k)) { t0_ = __builtin_amdgcn_s_memrealtime(); __VA_ARGS__; tph += __builtin_amdgcn_s_memrealtime() - t0_; } else { __VA_ARGS__; } } while (0)
#else
#define GSYNC() xcd_barrier(xbar)
#define TPK(k, ...) do { __VA_ARGS__; } while (0)
#endif
    LAS3 unsigned char* lds3 = (LAS3 unsigned char*)lds;
    volatile LDSF unsigned* bst = (volatile LDSF unsigned*)(lds3 + 131072 + 2048);
    if (threadIdx.x < 2) bst[threadIdx.x] = 0u;
    __syncthreads();
    XcdBarrier xbar = xcd_barrier_post((unsigned*)(p.ws + WS_CTL) + 16384, bst);
    TPK(2, ph_mod(p, lds); ph_reset_queues(p); ph_weights(p, 0, lds));
    grid.sync();
    for (int l = 0; l < DEPTH; ++l) {
        const float* mod = (const float*)(p.ws + WS_MOD) + (size_t)l * 4 * 6144;
        TPK(2, if (l == 0) { ph_xa_from(p, p.x, 0, 0, (bf16_t*)(p.ws + WS_XA), (float*)(p.ws + WS_RSA), true); ph_cbias(p, 0, 1, (int)blockIdx.x, (int)gridDim.x); });
        GSYNC();
        {   pg8::Gemm g{(const bf16_t*)(p.ws + WS_XA), (const bf16_t*)(p.ws + WS_WIN + l * WS_W1OFF), MTOK, PINP, DM}; pg8::StaticOrder S; S.init(MTOK, PINP, (int)gridDim.x, (int)blockIdx.x);
            EpiProjF E{(const float*)(p.ws + WS_RSA), (const float*)(p.ws + WS_CBIN) + (size_t)l * 4 * PINP, (bf16_t*)(p.ws + WS_PROJ), (float*)(p.ws + WS_SIDE),
                       p.diff_kn + l * 32, p.fox_kn + l * 64, p.nsa_kn + (l * 3 + 1) * 64, p.nsa_kn + (l * 3 + 2) * 64, (LDSF float*)(lds3 + 131072 + 4096), (LDSF float*)(lds3 + 131072 + 12288)};
            TPK(6, pg8::gemm_phase<EpiProjF, pg8::StaticOrder, true, PG8_SP2>(lds3, g, S, E)); }
        GSYNC();
        TPK(7, fa_phase_all(p, l, lds3, lds, l, (l + 1 < DEPTH) ? CV_ITEMS / 8 : 0));
        GSYNC();
        {   pg8::Gemm g{(const bf16_t*)p.out, (const bf16_t*)(p.ws + WS_WOUT + l * WS_W1OFF), MTOK, DM, DM}; pg8::StaticOrder S; S.init(MTOK, DM, (int)gridDim.x, (int)blockIdx.x);
            EpiResF E{nullptr, (bf16_t*)(p.ws + WS_XR), mod + 2048, p.norm_ffn_g + l * DM, mod + 4096, (bf16_t*)(p.ws + WS_XA), (float*)(p.ws + WS_RSB)};
            TPK(6, pg8::gemm_phase<EpiResF, pg8::StaticOrder, PG8_ALIGN, PG8_SP2>(lds3, g, S, E)); }
        GSYNC();
        {   pg8::Gemm g{(const bf16_t*)(p.ws + WS_XA), (const bf16_t*)(p.ws + WS_WUP + l * WS_W1OFF), MTOK, NUP, DM}; pg8::StaticOrder S; S.init(MTOK, NUP, (int)gridDim.x, (int)blockIdx.x);
            EpiUpAct E{(const float*)(p.ws + WS_RSB), (const float*)(p.ws + WS_CBUP) + (size_t)l * 4 * NUP, (bf16_t*)(p.ws + WS_ACT), (float*)(p.ws + WS_EG), (float*)(p.ws + WS_EV),
                       p.conv_w + (size_t)l * 3 * DFF, p.conv_b + (size_t)l * DFF, (LDSF float*)(lds3 + 131072 + 4096), (LDSF float*)(lds3 + 131072 + 8192)};
            TPK(6, pg8::gemm_phase<EpiUpAct, pg8::StaticOrder, true, PG8_SP2>(lds3, g, S, E));
            const int nfull = (MTOK / 256) * (NUP / 256) % (int)gridDim.x;
            if (l + 1 < DEPTH && (int)blockIdx.x >= nfull) ph_cbias(p, l + 1, 1, (int)blockIdx.x - nfull, (int)gridDim.x - nfull); }
        GSYNC();
        {   const float* modn = (const float*)(p.ws + WS_MOD) + (size_t)(l + 1) * 4 * 6144; const bool more = (l + 1 < DEPTH);
            pg8::Gemm g{(const bf16_t*)(p.ws + WS_ACT), (const bf16_t*)(p.ws + WS_WDN + l * WS_W1OFF), MTOK, DM, DFF}; pg8::StaticOrder S; S.init(MTOK, DM, (int)gridDim.x, (int)blockIdx.x);
            { pg8::Unit fu; for (int i = 0; S.next(i, fu); ++i) act_fixup(p, l, fu.pm); }
            asm volatile("s_waitcnt vmcnt(0)" ::: "memory"); __syncthreads();
            EpiResF E{more ? nullptr : p.out, (bf16_t*)(p.ws + WS_XR), mod + 5120, p.norm_mix_g + (more ? l + 1 : l) * DM, more ? modn + 1024 : mod + 1024, more ? (bf16_t*)(p.ws + WS_XA) : nullptr, more ? (float*)(p.ws + WS_RSA) : nullptr};
            TPK(6, pg8::gemm_phase<EpiResF, pg8::StaticOrder, PG8_ALIGN, PG8_SP2>(lds3, g, S, E)); }
    }
#if PROBE == 1
    if (blockIdx.x == 0 && threadIdx.x == 0) p.out[0] += 0.05f + (float)tacc * 0.01f * 5e-4f;
#elif PROBE >= 2
    if (blockIdx.x == 0 && threadIdx.x == 0) p.out[0] += 0.05f + (float)tph * 0.01f * 1e-4f;
#endif
}

extern "C" void kernel_launch(void* const* d_in, const int* in_sizes, int in, void* d_out, int out_size, void* d_ws, size_t ws_size, hipStream_t stream) {
    if (in != 24 || ws_size < WS_END || out_size != MTOK * DM) { fprintf(stderr, "kernel_launch: unexpected sizes (in %d, ws %zu, out %d)\n", in, ws_size, out_size); return; }
    static int grid_blocks = 0;
    if (!grid_blocks) {
        int dev = 0, cus = 0, per_cu = 0;
        hipGetDevice(&dev);
        hipDeviceGetAttribute(&cus, hipDeviceAttributeMultiprocessorCount, dev);
        hipFuncSetAttribute((const void*)mega, hipFuncAttributeMaxDynamicSharedMemorySize, LDS_BYTES);
        hipOccupancyMaxActiveBlocksPerMultiprocessor(&per_cu, (const void*)mega, NTHR, LDS_BYTES);
        if (per_cu < 1) { fprintf(stderr, "kernel_launch: occupancy query returned %d\n", per_cu); per_cu = 1; }
        if (per_cu > 1) per_cu = 1;
        grid_blocks = cus * per_cu;
        fprintf(stderr, "kernel_launch: cus %d per_cu %d grid %d\n", cus, per_cu, grid_blocks);
    }
    if (hipMemsetAsync((char*)d_ws + WS_CTL + 65536, 0, XCD_BAR_WORDS * 4, stream) != hipSuccess) { fprintf(stderr, "kernel_launch: memset failed\n"); return; }
    Params p{};
    const float** f = (const float**)&p;
    for (int i = 0; i < 24; ++i) f[i] = (const float*)d_in[i];
    p.out = (float*)d_out; p.ws = (unsigned char*)d_ws;
    void* args[] = {&p};
    hipError_t e = hipLaunchCooperativeKernel((const void*)mega, dim3(grid_blocks), dim3(NTHR), args, LDS_BYTES, stream);
    if (e != hipSuccess) fprintf(stderr, "cooperative launch failed: %s (grid %d)\n", hipGetErrorString(e), grid_blocks);
}
```
